# Optimizing an MI355X kernel written in HIP

```python
import jax, jax.numpy as jnp
from jax import lax
import numpy as np

D_MODEL = 4096
BATCH = 4
SEQ = 4096
DEPTH = 1

N_META = 16
ROPE_THETA = 500000.0
Q_BLOCK = 128
NORM_EPS = 1e-6
MLA_HEADS = 16
MLA_Q_LORA = 1024
MLA_KV_LORA = 512
MLA_NOPE = 128
MLA_ROPE = 64
MLA_V = 128
DSA_HEADS = 16
DSA_KV_HEADS = 4
DSA_HEAD_DIM = 128
DSA_ROT = DSA_HEAD_DIM // 4
IDX_HEADS = 16
IDX_DIM = 64
IDX_ROT = IDX_DIM // 4
DSA_TOPK_MAX = 256
PEER_HEADS = 8
PEER_N_KEYS = 128
PEER_N_EXPERTS = PEER_N_KEYS * PEER_N_KEYS
PEER_KEY_DIM = 256
PEER_HALF = PEER_KEY_DIM // 2
PEER_TOPK = 16
PEER_BLOCK = 64

IN_SPLITS = (
    MLA_Q_LORA,
    MLA_KV_LORA,
    MLA_ROPE,
    DSA_HEADS * DSA_HEAD_DIM,
    DSA_KV_HEADS * DSA_HEAD_DIM,
    DSA_KV_HEADS * DSA_HEAD_DIM,
    IDX_HEADS * IDX_DIM,
    IDX_DIM,
    IDX_HEADS,
    D_MODEL,
    D_MODEL,
)
IN_WIDTH = sum(IN_SPLITS)
BRANCH_A_WIDTH = MLA_HEADS * MLA_V
BRANCH_B_WIDTH = DSA_HEADS * DSA_HEAD_DIM

kernel_name = "hybrid_mla_dsa_peer_block"


def rms_norm(x, g):
    xf = x.astype(jnp.float32)
    y = xf * lax.rsqrt(jnp.mean(xf * xf, axis=-1, keepdims=True) + NORM_EPS)
    return (y * g.astype(jnp.float32)).astype(x.dtype)


def rope_tables(pos, rot_dim):
    inv = ROPE_THETA ** (-jnp.arange(0, rot_dim, 2, dtype=jnp.float32) / rot_dim)
    ang = pos.astype(jnp.float32)[:, None] * inv[None, :]
    return jnp.cos(ang), jnp.sin(ang)


def apply_rope(x, cos, sin, rot_dim):
    xr, xp = x[..., :rot_dim], x[..., rot_dim:]
    x1, x2 = jnp.split(xr.astype(jnp.float32), 2, axis=-1)
    c, s = cos[:, None, :], sin[:, None, :]
    rot = jnp.concatenate([x1 * c - x2 * s, x2 * c + x1 * s], axis=-1).astype(x.dtype)
    return jnp.concatenate([rot, xp], axis=-1)


def to_blocks(a, nb):
    return jnp.swapaxes(a.reshape((a.shape[0], nb, Q_BLOCK) + a.shape[2:]), 0, 1)


def causal_dense_attention(q, k, v, scale):
    B, T, H, _ = q.shape
    nb = T // Q_BLOCK
    kpos = jnp.arange(T)

    def one(args):
        qi, i = args
        qpos = i * Q_BLOCK + jnp.arange(Q_BLOCK)
        s = jnp.einsum('bqhd,bkhd->bhqk', qi, k, preferred_element_type=jnp.float32) * scale
        s = jnp.where((kpos[None, :] <= qpos[:, None])[None, None], s, -jnp.inf)
        p = jax.nn.softmax(s, axis=-1)
        o = jnp.einsum('bhqk,bkhd->bqhd', p, v.astype(jnp.float32))
        return o.astype(q.dtype)

    out = lax.map(one, (to_blocks(q, nb), jnp.arange(nb)))
    return jnp.swapaxes(out, 0, 1).reshape(B, T, -1)


def dsa_attention(q, k, v, q_ix, k_ix, w_ix, topk):
    B, T, H, Dh = q.shape
    G = k.shape[2]
    nb = T // Q_BLOCK
    kpos = jnp.arange(T)
    gather = jax.vmap(lambda src, idx: src[idx])

    def one(args):
        qi, qix, wix, i = args
        qpos = i * Q_BLOCK + jnp.arange(Q_BLOCK)
        dots = jnp.einsum('bqhd,bkd->bqhk', qix, k_ix,
                          preferred_element_type=jnp.float32) * (IDX_DIM ** -0.5)
        score = jnp.einsum('bqh,bqhk->bqk', wix.astype(jnp.float32) * (IDX_HEADS ** -0.5),
                           jax.nn.relu(dots))
        score = jnp.where((kpos[None, :] <= qpos[:, None])[None], score, -jnp.inf)
        _, idx = lax.top_k(score, topk)
        sel_ok = idx <= qpos[None, :, None]
        k_sel = gather(k, idx)
        v_sel = gather(v, idx)
        qg = qi.reshape(B, Q_BLOCK, G, H // G, Dh)
        s = jnp.einsum('bqghd,bqkgd->bqghk', qg, k_sel,
                       preferred_element_type=jnp.float32) * (DSA_HEAD_DIM ** -0.5)
        s = jnp.where(sel_ok[:, :, None, None, :], s, -jnp.inf)
        p = jax.nn.softmax(s, axis=-1)
        o = jnp.einsum('bqghk,bqkgd->bqghd', p, v_sel.astype(jnp.float32))
        return o.reshape(B, Q_BLOCK, H * Dh).astype(q.dtype)

    out = lax.map(one, (to_blocks(q, nb), to_blocks(q_ix, nb), to_blocks(w_ix, nb), jnp.arange(nb)))
    return jnp.swapaxes(out, 0, 1).reshape(B, T, H * Dh)


def hybrid_mixer(hn, w_in, q_norm_g, w_uq, kv_norm_g, w_ukv, w_branch, w_out,
                 rope_mla, rope_dsa, rope_idx, topk):
    B, T, _ = hn.shape
    proj = hn @ w_in
    offs = np.cumsum(IN_SPLITS)[:-1].tolist()
    (c_q, c_kv, k_pe, q_b, k_b, v_b, q_ix, k_ix, w_ix, gate_a, gate_b) = jnp.split(proj, offs, axis=-1)

    q_a = (rms_norm(c_q, q_norm_g) @ w_uq).reshape(B, T, MLA_HEADS, MLA_NOPE + MLA_ROPE)
    q_a = jnp.concatenate([q_a[..., :MLA_NOPE],
                           apply_rope(q_a[..., MLA_NOPE:], *rope_mla, MLA_ROPE)], axis=-1)
    kv = (rms_norm(c_kv, kv_norm_g) @ w_ukv).reshape(B, T, MLA_HEADS, MLA_NOPE + MLA_V)
    k_pe = apply_rope(k_pe[:, :, None, :], *rope_mla, MLA_ROPE)
    k_a = jnp.concatenate([kv[..., :MLA_NOPE],
                           jnp.broadcast_to(k_pe, (B, T, MLA_HEADS, MLA_ROPE))], axis=-1)
    v_a = kv[..., MLA_NOPE:]
    o_a = causal_dense_attention(q_a, k_a, v_a, (MLA_NOPE + MLA_ROPE) ** -0.5)

    q_b = apply_rope(q_b.reshape(B, T, DSA_HEADS, DSA_HEAD_DIM), *rope_dsa, DSA_ROT)
    k_b = apply_rope(k_b.reshape(B, T, DSA_KV_HEADS, DSA_HEAD_DIM), *rope_dsa, DSA_ROT)
    v_b = v_b.reshape(B, T, DSA_KV_HEADS, DSA_HEAD_DIM)
    q_ix = apply_rope(q_ix.reshape(B, T, IDX_HEADS, IDX_DIM), *rope_idx, IDX_ROT)
    k_ix = apply_rope(k_ix[:, :, None, :], *rope_idx, IDX_ROT)[:, :, 0, :]
    o_b = dsa_attention(q_b, k_b, v_b, q_ix, k_ix, w_ix, topk)

    y_a = o_a @ w_branch[:BRANCH_A_WIDTH]
    y_b = o_b @ w_branch[BRANCH_A_WIDTH:]
    merged = jax.nn.sigmoid(gate_a) * y_a + jax.nn.sigmoid(gate_b) * y_b
    return merged @ w_out


def peer_ffn(hn, w_q, sub_keys, u_tab, v_tab):
    B, T, D = hn.shape
    q = (hn @ w_q).reshape(B, T, PEER_HEADS, 2, PEER_HALF)
    s = jnp.einsum('bthcd,hcnd->bthcn', q, sub_keys, preferred_element_type=jnp.float32)
    s1, i1 = lax.top_k(s[..., 0, :], PEER_TOPK)
    s2, i2 = lax.top_k(s[..., 1, :], PEER_TOPK)
    cand_s = (s1[..., :, None] + s2[..., None, :]).reshape(B, T, PEER_HEADS, PEER_TOPK * PEER_TOPK)
    cand_i = (i1[..., :, None] * PEER_N_KEYS + i2[..., None, :]).reshape(B, T, PEER_HEADS, PEER_TOPK * PEER_TOPK)
    top_s, top_pos = lax.top_k(cand_s, PEER_TOPK)
    experts = jnp.take_along_axis(cand_i, top_pos, axis=-1)
    gates = jax.nn.softmax(top_s, axis=-1)

    n_sel = PEER_HEADS * PEER_TOPK
    nblk = (B * T) // PEER_BLOCK
    hb = hn.reshape(nblk, PEER_BLOCK, D)
    eb = experts.reshape(nblk, PEER_BLOCK, n_sel)
    gb = gates.reshape(nblk, PEER_BLOCK, n_sel)

    def one(args):
        h_blk, e_blk, g_blk = args
        u = u_tab[e_blk]
        a = jnp.einsum('pd,ped->pe', h_blk, u, preferred_element_type=jnp.float32)
        a = jax.nn.gelu(a) * g_blk
        v = v_tab[e_blk]
        o = jnp.einsum('pe,ped->pd', a.astype(v.dtype), v, preferred_element_type=jnp.float32)
        return o.astype(h_blk.dtype)

    return lax.map(one, (hb, eb, gb)).reshape(B, T, D)


def setup_inputs(seed: int = 0) -> dict:
    key = jax.random.key(seed)
    ks = jax.random.split(key, 16)
    f32 = jnp.float32

    def nrm(k, shape, fan_in):
        return jax.random.normal(k, shape, f32) * (fan_in ** -0.5)

    def gain(k, shape):
        return 1.0 + 0.05 * jax.random.normal(k, shape, f32)

    return {
        "x": jax.random.normal(ks[0], (BATCH, SEQ, D_MODEL), f32),
        "meta_tokens": jax.random.normal(ks[1], (N_META, D_MODEL), f32),
        "attn_norm_g": gain(ks[2], (DEPTH, D_MODEL)),
        "w_in": nrm(ks[3], (DEPTH, D_MODEL, IN_WIDTH), D_MODEL),
        "q_norm_g": gain(ks[4], (DEPTH, MLA_Q_LORA)),
        "w_uq": nrm(ks[5], (DEPTH, MLA_Q_LORA, MLA_HEADS * (MLA_NOPE + MLA_ROPE)), MLA_Q_LORA),
        "kv_norm_g": gain(ks[6], (DEPTH, MLA_KV_LORA)),
        "w_ukv": nrm(ks[7], (DEPTH, MLA_KV_LORA, MLA_HEADS * (MLA_NOPE + MLA_V)), MLA_KV_LORA),
        "w_branch": nrm(ks[8], (DEPTH, BRANCH_A_WIDTH + BRANCH_B_WIDTH, D_MODEL), BRANCH_A_WIDTH),
        "w_out": nrm(ks[9], (DEPTH, D_MODEL, D_MODEL), D_MODEL),
        "ffn_norm_g": gain(ks[10], (DEPTH, D_MODEL)),
        "peer_w_q": nrm(ks[11], (DEPTH, D_MODEL, PEER_HEADS * PEER_KEY_DIM), D_MODEL),
        "peer_sub_keys": nrm(ks[12], (DEPTH, PEER_HEADS, 2, PEER_N_KEYS, PEER_HALF), PEER_HALF),
        "peer_u": nrm(ks[13], (DEPTH, PEER_N_EXPERTS, D_MODEL), D_MODEL),
        "peer_v": nrm(ks[14], (DEPTH, PEER_N_EXPERTS, D_MODEL), PEER_HEADS * PEER_TOPK),
        "final_norm_g": gain(ks[15], (D_MODEL,)),
    }


def reference(x, meta_tokens, attn_norm_g, w_in, q_norm_g, w_uq, kv_norm_g, w_ukv,
              w_branch, w_out, ffn_norm_g, peer_w_q, peer_sub_keys, peer_u, peer_v,
              final_norm_g):
    B, S, D = x.shape
    T = S + N_META
    T_pad = -(-T // Q_BLOCK) * Q_BLOCK
    topk = min(DSA_TOPK_MAX, S // 4)

    meta = jnp.broadcast_to(meta_tokens.astype(x.dtype)[None], (B, N_META, D))
    h = jnp.concatenate([meta, x, jnp.zeros((B, T_pad - T, D), x.dtype)], axis=1)

    pos = jnp.arange(T_pad)
    rope_mla = rope_tables(pos, MLA_ROPE)
    rope_dsa = rope_tables(pos, DSA_ROT)
    rope_idx = rope_tables(pos, IDX_ROT)

    for l in range(DEPTH):
        h = h + hybrid_mixer(rms_norm(h, attn_norm_g[l]), w_in[l], q_norm_g[l], w_uq[l],
                             kv_norm_g[l], w_ukv[l], w_branch[l], w_out[l],
                             rope_mla, rope_dsa, rope_idx, topk)
        h = h + peer_ffn(rms_norm(h, ffn_norm_g[l]), peer_w_q[l], peer_sub_keys[l],
                         peer_u[l], peer_v[l])

    h = rms_norm(h, final_norm_g)
    return h[:, N_META:N_META + S]
```

```cpp
#define MK_PER_PHASE 1
#include <hip/hip_runtime.h>
#include <cstdio>
#include <cstdint>

#define LAS __attribute__((address_space(3)))
#define GAS __attribute__((address_space(1)))
typedef unsigned short bf16_t;
typedef short bf16x8 __attribute__((ext_vector_type(8)));
typedef short s16x4 __attribute__((ext_vector_type(4)));
typedef float f32x2 __attribute__((ext_vector_type(2)));
typedef float f32x4 __attribute__((ext_vector_type(4)));
typedef float f32x16 __attribute__((ext_vector_type(16)));
typedef unsigned u32x2 __attribute__((ext_vector_type(2)));
typedef unsigned u32x4 __attribute__((ext_vector_type(4)));
typedef GAS unsigned gu32;

#ifndef MK_PER_PHASE
#define MK_PER_PHASE 0
#endif
#ifndef MK_LAST_PHASE
#define MK_LAST_PHASE 8
#endif

constexpr int NB = 4, SEQ = 4096, DM = 4096, NMETA = 16, TR = SEQ + NMETA  , TP = 4224  , M = NB * TP  ;
constexpr float EPS = 1e-6f;
constexpr int NV1 = 14080;
constexpr float LOG2E = 1.4426950408889634f;
constexpr float QB_SCALE = 0.08838834764831845f * LOG2E;
constexpr float QA_SCALE = 0.07216878364870323f * LOG2E;
constexpr int NWAVES = 8;
constexpr int MW = 132;

constexpr size_t HM = 512u * 1024u;
constexpr size_t WS_CTL = 0, CTL_ZERO_BYTES = 2 * HM;
constexpr size_t WS_ROPE_M = 2 * HM;
constexpr size_t WS_ROPE_D = 5 * HM;
constexpr size_t WS_ROPE_I = 7 * HM;
constexpr size_t WS_SK   = 8 * HM;
constexpr size_t WS_WUQ  = 10 * HM;
constexpr size_t WS_WUKV = 22 * HM;
constexpr size_t WS_WBR  = 30 * HM;
constexpr size_t WS_WOUT = 94 * HM;
constexpr size_t WS_WQ   = 158 * HM;
constexpr size_t WS_EID  = 190 * HM;
constexpr size_t WS_GATE = 207 * HM;
constexpr size_t WS_MASK = 224 * HM;
constexpr size_t WS_KPE  = 242 * HM;
constexpr size_t WS_KIX  = 247 * HM;
constexpr size_t WS_WIX  = 252 * HM;
constexpr size_t R23 = 260 * HM;
constexpr size_t WS_XN   = R23;
constexpr size_t WS_WIN  = R23 + 264 * HM;
constexpr size_t P1O = R23 + 484 * HM;
constexpr size_t WS_CQ   = P1O;
constexpr size_t WS_CKV  = P1O + 66 * HM;
constexpr size_t WS_QB   = P1O + 99 * HM;
constexpr size_t WS_KB   = P1O + 231 * HM;
constexpr size_t WS_VB   = P1O + 264 * HM;
constexpr size_t WS_QIX  = P1O + 297 * HM;
constexpr size_t WS_GA   = P1O + 363 * HM;
constexpr size_t WS_GB   = P1O + 627 * HM;
constexpr size_t R4 = P1O + 892 * HM;
constexpr size_t WS_OAB  = R4;
constexpr size_t WS_PQ   = R4;
constexpr size_t WS_END  = R4 + 264 * HM;
constexpr size_t WS_QN   = R23;
constexpr size_t WS_QR   = R23 + 132 * HM;
constexpr size_t WS_KN   = R23 + 198 * HM;
constexpr size_t WS_VA   = R23 + 330 * HM;
constexpr size_t WS_MRG  = R23;
constexpr size_t WS_U    = R23;
constexpr size_t WS_V    = R23 + 256 * HM;
constexpr size_t WS_H1F  = R23 + 512 * HM;
constexpr size_t WS_H1B  = R23 + 1040 * HM;
static_assert(WS_VA + 132 * HM <= P1O && WS_H1F >= P1O && WS_H1B + 264 * HM <= R4 && WS_GB + 264 * HM <= R4, "ws map");
constexpr int CW_TMO = 0;
constexpr int CW_BAR = 4096;
constexpr int CW_QUEUE = 8192;
constexpr int CW_SSQ_CQ = 16384, CW_SSQ_CKV = 16384 + 2 * 17408, CW_SSQ_H1 = 16384 + 4 * 17408;
static_assert((CW_SSQ_H1 + 2 * 17408) * 4 <= (int)CTL_ZERO_BYTES, "ctl");

constexpr int RING_BYTES = 131072;
constexpr int LDSCTL_OFF = RING_BYTES;
constexpr int LDS_BYTES = 147456;

__device__ __forceinline__ unsigned f2bf(float f) { unsigned u = __float_as_uint(f); return (u + 0x7fffu + ((u >> 16) & 1u)) >> 16; }
__device__ __forceinline__ unsigned pk2(float lo, float hi) { return f2bf(lo) | (f2bf(hi) << 16); }
typedef __bf16 bf16x2_t __attribute__((ext_vector_type(2)));
__device__ __forceinline__ unsigned cvt_pk_bf16(float lo, float hi) { return __builtin_bit_cast(unsigned, __builtin_convertvector((f32x2){lo, hi}, bf16x2_t)); }
__device__ __forceinline__ float bf_lo(unsigned w) { return __uint_as_float(w << 16); }
__device__ __forceinline__ float bf_hi(unsigned w) { return __uint_as_float(w & 0xffff0000u); }
__device__ __forceinline__ u32x4 pack8(f32x4 a, f32x4 b) { u32x4 w; w.x = cvt_pk_bf16(a[0], a[1]); w.y = cvt_pk_bf16(a[2], a[3]); w.z = cvt_pk_bf16(b[0], b[1]); w.w = cvt_pk_bf16(b[2], b[3]); return w; }
__device__ __forceinline__ float wave_sum(float v) {
#pragma unroll
    for (int o = 1; o < 64; o <<= 1) v += __shfl_xor(v, o);
    return v;
}
#define LDS_WAIT() asm volatile("s_waitcnt lgkmcnt(0)" ::: "memory")
#define VM_WAIT() asm volatile("s_waitcnt vmcnt(0)" ::: "memory")
typedef unsigned long long u64;
__device__ __forceinline__ void ssq_add(u64* p, float v) { (void)__hip_atomic_fetch_add(p, (u64)(v * 16777216.0f), __ATOMIC_RELAXED, __HIP_MEMORY_SCOPE_AGENT); }
__device__ __forceinline__ float ssq_get(const u64* p) { return (float)((double)(*p) * (1.0 / 16777216.0)); }
namespace pg8 {
#define PG8_LAS __attribute__((address_space(3)))
typedef unsigned short bf16_t;
typedef short bf16x8 __attribute__((ext_vector_type(8)));
typedef float f32x4 __attribute__((ext_vector_type(4)));
typedef unsigned u32x4 __attribute__((ext_vector_type(4)));
constexpr int BM = 256, BK = 64, HALF = 128, HTB = HALF * BK * 2  , STAGE_BYTES = 8 * HTB, NXCD = 8, WGM = 8;

__host__ __device__ __forceinline__ int lds_byte(int r, int c) { const int st = (r >> 4) * 2 + (c >> 5), rr = r & 15, cc = c & 31, ob = rr * 64 + cc * 2; return st * 1024 + (ob ^ (((ob >> 9) & 1) << 5)); }
__host__ __device__ __forceinline__ void stage_rc(int b, int& R, int& C) { const int st = b / 1024, sb = b % 1024, swz = sb ^ (((sb >> 9) & 1) << 5); R = (st >> 1) * 16 + swz / 64; C = (st & 1) * 32 + (swz % 64) / 2; }
__host__ __device__ __forceinline__ int perm32(int rho) { const int n = rho >> 4, i = rho & 15; return 8 * (i >> 2) + 4 * n + (i & 3); }

struct Unit { int pm, pn, kh; };
struct Gemm { const bf16_t* A; const bf16_t* Bt; int M, N, K, KL; };

struct StaticOrder {
    int nM, nN, nwg, G, c;
    __host__ __device__ void init(int M, int N, int G_, int c_) { nM = M / BM; nN = N / BM; nwg = nM * nN; G = G_; c = c_; }
    __host__ __device__ bool next(int i, Unit& u) const {
        const long L = (long)i * G + c; if (L >= nwg) return false;
        int wgid = (int)L; { const int q = nwg / NXCD, r = nwg % NXCD, xcd = wgid % NXCD, off = wgid / NXCD; wgid = (xcd < r ? xcd * (q + 1) : r * (q + 1) + (xcd - r) * q) + off; }
        const int nig = WGM * nN, gid = wgid / nig, fm = gid * WGM, gsz = (nM - fm) < WGM ? (nM - fm) : WGM;
        u.pm = fm + ((wgid % nig) % gsz); u.pn = (wgid % nig) / gsz; u.kh = 0; return true;
    }
    __device__ __forceinline__ void a_ready(const Unit&) const {}
    __device__ __forceinline__ void done(const Unit&) const {}
};

struct StaticOrder2 {
    StaticOrder base;
    __host__ __device__ void init(int M, int N, int G_, int c_) { base.init(M, N, G_, c_); }
    __host__ __device__ bool next(int i, Unit& u) const { if (!base.next(i >> 1, u)) return false; u.kh = i & 1; return true; }
    __device__ __forceinline__ void a_ready(const Unit&) const {}
    __device__ __forceinline__ void done(const Unit&) const {}
};

template <class Epi, class Sched, bool ALIGN_EPI = false, bool SP2 = false>
__device__ __forceinline__ void gemm_phase(PG8_LAS unsigned char* lds, const Gemm g, const Sched& S, const Epi& E) {
    const int tid = threadIdx.x, wid = __builtin_amdgcn_readfirstlane(tid >> 6), lane = tid & 63, wr = wid >> 2, wc = wid & 3, fr = lane & 15, fq = lane >> 4;
    const int K = g.K, nt = g.KL / BK; const size_t khoff = (size_t)g.KL * 2;
    unsigned voffA[2], voffB[2];
#pragma unroll
    for (int i = 0; i < 2; ++i) { int R, C; stage_rc(tid * 16 + i * 8192, R, C); const int Rb = Epi::PERM ? ((R & ~31) + perm32(R & 31)) : R;
        voffA[i] = (unsigned)(R * K + C) * 2u; voffB[i] = (unsigned)(Rb * K + C) * 2u; }
    const size_t kstep = (size_t)(BK * 2);
    const size_t hstep = (size_t)HALF * K * 2;
    const size_t tstep = 2 * hstep;
    const unsigned ldsw = (unsigned)wid * 1024u;
    const int aoff = lds_byte(wr * 64 + fr, fq * 8), boff = lds_byte(wc * 32 + fr, fq * 8);
#define PG8_SA(b, h) (((b) * 2 + (h)) * HTB)
#define PG8_SB(b, h) ((4 + (b) * 2 + (h)) * HTB)
#define PG8_STAGE(bufoff, gbase, voff) do { _Pragma("unroll") for (int _i = 0; _i < 2; ++_i) \
        __builtin_amdgcn_global_load_lds((const unsigned*)((const char*)(gbase) + (voff)[_i]), (PG8_LAS unsigned*)(lds + (bufoff) + ldsw + _i * 8192), 16, 0, 0); } while (0)
#define PG8_LDA(dst, b, h) do { _Pragma("unroll") for (int m = 0; m < 4; ++m) _Pragma("unroll") for (int k = 0; k < 2; ++k) dst[m][k] = *(const PG8_LAS bf16x8*)(lds + PG8_SA(b, h) + aoff + m * 2048 + k * 1024); } while (0)
#define PG8_LDB(dst, b, h) do { _Pragma("unroll") for (int n = 0; n < 2; ++n) _Pragma("unroll") for (int k = 0; k < 2; ++k) dst[n][k] = *(const PG8_LAS bf16x8*)(lds + PG8_SB(b, h) + boff + n * 2048 + k * 1024); } while (0)
#define PG8_MMA(ai, bj, At, Bt) do { __builtin_amdgcn_s_setprio(1); _Pragma("unroll") for (int m = 0; m < 4; ++m) _Pragma("unroll") for (int n = 0; n < 2; ++n) _Pragma("unroll") for (int k = 0; k < 2; ++k) \
        acc[ai][bj][m][n] = __builtin_amdgcn_mfma_f32_16x16x32_bf16(Bt[n][k], At[m][k], acc[ai][bj][m][n], 0, 0, 0); __builtin_amdgcn_s_setprio(0); } while (0)
#define PG8_WAIT_V(n) asm volatile("s_waitcnt vmcnt(" #n ")" ::: "memory")
#define PG8_WAIT_L(n) asm volatile("s_waitcnt lgkmcnt(" #n ")" ::: "memory")
#define PG8_BAR __builtin_amdgcn_s_barrier()
#define PG8_SCHED __builtin_amdgcn_sched_barrier(0)
    Unit cur, nxt; int ui = 0;
    if (!S.next(0, cur)) return;
    f32x4 acc[2][2][4][2];
#pragma unroll
    for (int a = 0; a < 2; ++a)
#pragma unroll
        for (int b = 0; b < 2; ++b)
#pragma unroll
            for (int m = 0; m < 4; ++m)
#pragma unroll
                for (int n = 0; n < 2; ++n) acc[a][b][m][n] = (f32x4){0.f, 0.f, 0.f, 0.f};
    bf16x8 At[4][2], B0[2][2], B1[2][2];
    const char* cA = (const char*)g.A + (size_t)cur.pm * tstep + (size_t)cur.kh * khoff; const char* cB = (const char*)g.Bt + (size_t)cur.pn * tstep + (size_t)cur.kh * khoff;
    S.a_ready(cur);
    if constexpr (SP2) {
        PG8_STAGE(PG8_SB(0, 0), cB, voffB); PG8_STAGE(PG8_SB(0, 1), cB + hstep, voffB); PG8_STAGE(PG8_SA(0, 0), cA, voffA); PG8_STAGE(PG8_SA(0, 1), cA + hstep, voffA);
        if (wr == 1) PG8_BAR;
        PG8_WAIT_V(2); PG8_BAR;
        PG8_STAGE(PG8_SB(1, 0), cB + kstep, voffB); PG8_STAGE(PG8_SA(1, 0), cA + kstep, voffA); PG8_STAGE(PG8_SB(1, 1), cB + hstep + kstep, voffB);
        PG8_WAIT_V(6); PG8_BAR;
    } else {
        PG8_STAGE(PG8_SB(0, 0), cB, voffB); PG8_STAGE(PG8_SA(0, 0), cA, voffA); PG8_STAGE(PG8_SB(0, 1), cB + hstep, voffB); PG8_STAGE(PG8_SA(0, 1), cA + hstep, voffA);
        if (wr == 1) PG8_BAR;
        PG8_WAIT_V(4); PG8_BAR;
        PG8_STAGE(PG8_SB(1, 0), cB + kstep, voffB); PG8_STAGE(PG8_SA(1, 0), cA + kstep, voffA); PG8_STAGE(PG8_SB(1, 1), cB + hstep + kstep, voffB);
        PG8_WAIT_V(6); PG8_BAR;
    }
    for (;;) {
        const bool has_next = S.next(ui + 1, nxt);
        const char* nA = has_next ? (const char*)g.A + (size_t)nxt.pm * tstep + (size_t)nxt.kh * khoff : cA; const char* nB = has_next ? (const char*)g.Bt + (size_t)nxt.pn * tstep + (size_t)nxt.kh * khoff : cB;
        for (int t = 0; t < nt; t += 2) {
            const bool last = (t == nt - 2);
            const char* a1 = cA + (size_t)(t + 1) * kstep;
            const char* a2 = last ? nA : cA + (size_t)(t + 2) * kstep; const char* b2 = last ? nB : cB + (size_t)(t + 2) * kstep;
            const char* a3 = a2 + kstep; const char* b3 = b2 + kstep;
            if (last && has_next) S.a_ready(nxt);
            if constexpr (SP2) {
            PG8_LDB(B0, 0, 0); PG8_LDB(B1, 0, 1); PG8_SCHED; PG8_LDA(At, 0, 0); PG8_STAGE(PG8_SA(1, 1), a1 + hstep, voffA);
            PG8_WAIT_V(8); PG8_WAIT_L(0); PG8_BAR; PG8_MMA(0, 0, At, B0); PG8_MMA(0, 1, At, B1); PG8_BAR; PG8_SCHED;
            PG8_LDA(At, 0, 1); PG8_STAGE(PG8_SB(0, 0), b2, voffB); PG8_STAGE(PG8_SB(0, 1), b2 + hstep, voffB); PG8_STAGE(PG8_SA(0, 0), a2, voffA);
            PG8_WAIT_V(8); PG8_WAIT_L(0); PG8_BAR; PG8_MMA(1, 0, At, B0); PG8_MMA(1, 1, At, B1); PG8_BAR; PG8_SCHED;
            PG8_LDB(B0, 1, 0); PG8_LDB(B1, 1, 1); PG8_SCHED; PG8_LDA(At, 1, 0); PG8_STAGE(PG8_SA(0, 1), a2 + hstep, voffA);
            PG8_WAIT_V(8); PG8_WAIT_L(0); PG8_BAR; PG8_MMA(0, 0, At, B0); PG8_MMA(0, 1, At, B1); PG8_BAR; PG8_SCHED;
            PG8_LDA(At, 1, 1); PG8_STAGE(PG8_SB(1, 0), b3, voffB); PG8_STAGE(PG8_SB(1, 1), b3 + hstep, voffB); PG8_STAGE(PG8_SA(1, 0), a3, voffA);
            PG8_WAIT_V(8); PG8_WAIT_L(0); PG8_BAR; PG8_MMA(1, 0, At, B0); PG8_MMA(1, 1, At, B1); PG8_BAR; PG8_SCHED;
            } else {
            PG8_LDB(B0, 0, 0); PG8_SCHED; PG8_LDA(At, 0, 0); PG8_STAGE(PG8_SA(1, 1), a1 + hstep, voffA);
            PG8_WAIT_L(8); PG8_BAR; PG8_WAIT_L(0); PG8_MMA(0, 0, At, B0); PG8_BAR; PG8_SCHED;
            PG8_LDB(B1, 0, 1); PG8_STAGE(PG8_SB(0, 0), b2, voffB);
            PG8_BAR; PG8_WAIT_L(0); PG8_MMA(0, 1, At, B1); PG8_BAR;
            PG8_LDA(At, 0, 1); PG8_STAGE(PG8_SA(0, 0), a2, voffA);
            PG8_BAR; PG8_WAIT_L(0); PG8_MMA(1, 0, At, B0); PG8_BAR; PG8_SCHED;
            PG8_STAGE(PG8_SB(0, 1), b2 + hstep, voffB);
            PG8_WAIT_V(6); PG8_BAR; PG8_MMA(1, 1, At, B1); PG8_BAR;
            PG8_LDB(B0, 1, 0); PG8_SCHED; PG8_LDA(At, 1, 0); PG8_STAGE(PG8_SA(0, 1), a2 + hstep, voffA);
            PG8_WAIT_L(8); PG8_BAR; PG8_WAIT_L(0); PG8_MMA(0, 0, At, B0); PG8_BAR; PG8_SCHED;
            PG8_LDB(B1, 1, 1); PG8_STAGE(PG8_SB(1, 0), b3, voffB);
            PG8_BAR; PG8_WAIT_L(0); PG8_MMA(0, 1, At, B1); PG8_BAR;
            PG8_LDA(At, 1, 1); PG8_STAGE(PG8_SA(1, 0), a3, voffA);
            PG8_BAR; PG8_WAIT_L(0); PG8_MMA(1, 0, At, B0); PG8_BAR; PG8_SCHED;
            PG8_STAGE(PG8_SB(1, 1), b3 + hstep, voffB);
            PG8_WAIT_V(6); PG8_BAR; PG8_MMA(1, 1, At, B1); PG8_BAR;
            }
        }
        if constexpr (ALIGN_EPI) { if (wr == 0) PG8_BAR; }
        if constexpr (!Epi::AFTER_DRAIN) { E(acc, cur, wr, wc, fr, fq); S.done(cur); }
        if (!has_next) break;
        if (!(Epi::SPLITK2 && cur.kh == 0))
#pragma unroll
        for (int a = 0; a < 2; ++a)
#pragma unroll
            for (int b = 0; b < 2; ++b)
#pragma unroll
                for (int m = 0; m < 4; ++m)
#pragma unroll
                    for (int n = 0; n < 2; ++n) acc[a][b][m][n] = (f32x4){0.f, 0.f, 0.f, 0.f};
        cur = nxt; cA = nA; cB = nB; ++ui;
        if constexpr (ALIGN_EPI) { if (wr == 1) PG8_BAR; }
    }
    PG8_WAIT_V(0);
    if constexpr (!ALIGN_EPI) { if (wr == 0) PG8_BAR; }
    PG8_BAR;
    if constexpr (Epi::AFTER_DRAIN) { E.fused(acc, cur, wr, wc, fr, fq, lds, wid, lane); S.done(cur); }
#undef PG8_SA
#undef PG8_SB
#undef PG8_STAGE
#undef PG8_LDA
#undef PG8_LDB
#undef PG8_MMA
#undef PG8_WAIT_V
#undef PG8_WAIT_L
#undef PG8_BAR
#undef PG8_SCHED
}
}
namespace epi {
using pg8::Unit;
typedef f32x4 Acc[2][2][4][2];

__device__ __forceinline__ void rot2(f32x4& v, const f32x4 cs) {
    const float a1 = v[0] * cs[0] - v[1] * cs[1], a2 = v[1] * cs[0] + v[0] * cs[1];
    const float b1 = v[2] * cs[2] - v[3] * cs[3], b2 = v[3] * cs[2] + v[2] * cs[3];
    v = (f32x4){a1, a2, b1, b2};
}
__device__ __forceinline__ float sigm(float x) { return 1.0f / (1.0f + __expf(-x)); }

struct EpiIn {
    static constexpr bool PERM = true, AFTER_DRAIN = false, SPLITK2 = false;
    bf16_t *cq, *ckv, *qb, *kb, *vb, *qix, *kpe, *kix, *ga, *gb; float* wix; u64 *ssq_cq, *ssq_ckv;
    const float *ropeM, *ropeD, *ropeI;
    __device__ __forceinline__ void operator()(const Acc& acc, const Unit& u, int wr, int wc, int fr, int fq) const {
        const int vt = u.pn, rowb = u.pm * 256 + wr * 64 + fr, ct = wc * 32 + 8 * fq;
        if (vt < 6) {
            bf16_t* dst = vt < 4 ? cq : ckv; const int ld = vt < 4 ? 1024 : 512, cb = (vt < 4 ? vt : vt - 4) * 256 + ct; u64* ssq = vt < 4 ? ssq_cq : ssq_ckv;
#pragma unroll
            for (int ai = 0; ai < 2; ++ai)
#pragma unroll
                for (int m = 0; m < 4; ++m) { const int row = rowb + ai * 128 + m * 16; float s = 0.f;
#pragma unroll
                    for (int bj = 0; bj < 2; ++bj) { const f32x4 v0 = acc[ai][bj][m][0], v1 = acc[ai][bj][m][1];
                        s += (v0[0] * v0[0] + v0[1] * v0[1]) + (v0[2] * v0[2] + v0[3] * v0[3]) + (v1[0] * v1[0] + v1[1] * v1[1]) + (v1[2] * v1[2] + v1[3] * v1[3]);
                        *(u32x4*)(dst + (size_t)row * ld + cb + bj * 128) = pack8(v0, v1); }
                    s += __shfl_xor(s, 16); s += __shfl_xor(s, 32);
                    if (fq == 0) ssq_add(ssq + row, s); }
        } else if (vt < 16) {
            const bool isq = vt < 14; bf16_t* dst = isq ? qb : kb; const int ld = isq ? 2048 : 512, cb = (isq ? vt - 6 : vt - 14) * 256 + ct; const float sc = isq ? QB_SCALE : 1.f;
#pragma unroll
            for (int ai = 0; ai < 2; ++ai)
#pragma unroll
                for (int m = 0; m < 4; ++m) { const int row = rowb + ai * 128 + m * 16, t = row % TP;
                    f32x4 cs0 = (f32x4){1.f, 0.f, 1.f, 0.f}, cs1 = cs0;
                    if (wc == 0) { const f32x4* p = (const f32x4*)(ropeD + ((size_t)t * 16 + 4 * fq) * 2); cs0 = p[0]; cs1 = p[1]; }
#pragma unroll
                    for (int bj = 0; bj < 2; ++bj) { f32x4 v0 = acc[ai][bj][m][0], v1 = acc[ai][bj][m][1];
                        if (wc == 0) { rot2(v0, cs0); rot2(v1, cs1); }
                        v0 = v0 * sc; v1 = v1 * sc;
                        *(u32x4*)(dst + (size_t)row * ld + cb + bj * 128) = pack8(v0, v1); } }
        } else if (vt < 18) {
            const int cb = (vt - 16) * 256 + ct;
#pragma unroll
            for (int ai = 0; ai < 2; ++ai)
#pragma unroll
                for (int m = 0; m < 4; ++m) { const int row = rowb + ai * 128 + m * 16;
#pragma unroll
                    for (int bj = 0; bj < 2; ++bj) *(u32x4*)(vb + (size_t)row * 512 + cb + bj * 128) = pack8(acc[ai][bj][m][0], acc[ai][bj][m][1]); }
        } else if (vt < 22) {
            const int cb = (vt - 18) * 256 + ct; const bool rt = ((wc & 1) == 0) && (fq < 2);
#pragma unroll
            for (int ai = 0; ai < 2; ++ai)
#pragma unroll
                for (int m = 0; m < 4; ++m) { const int row = rowb + ai * 128 + m * 16, t = row % TP;
                    f32x4 cs0 = (f32x4){1.f, 0.f, 1.f, 0.f}, cs1 = cs0;
                    if (rt) { const f32x4* p = (const f32x4*)(ropeI + ((size_t)t * 8 + 4 * fq) * 2); cs0 = p[0]; cs1 = p[1]; }
#pragma unroll
                    for (int bj = 0; bj < 2; ++bj) { f32x4 v0 = acc[ai][bj][m][0], v1 = acc[ai][bj][m][1];
                        if (rt) { rot2(v0, cs0); rot2(v1, cs1); }
                        *(u32x4*)(qix + (size_t)row * 1024 + cb + bj * 128) = pack8(v0, v1); } }
        } else if (vt == 22) {
#pragma unroll
            for (int ai = 0; ai < 2; ++ai)
#pragma unroll
                for (int m = 0; m < 4; ++m) { const int row = rowb + ai * 128 + m * 16, t = row % TP;
                    f32x4 v0 = acc[ai][0][m][0], v1 = acc[ai][0][m][1];
                    if (wc < 2) { const f32x4* p = (const f32x4*)(ropeM + ((size_t)t * 32 + 16 * wc + 4 * fq) * 2); rot2(v0, p[0]); rot2(v1, p[1]);
                        *(u32x4*)(kpe + (size_t)row * 64 + ct) = pack8(v0, v1);
                    } else { if (wc == 2 && fq < 2) { const f32x4* p = (const f32x4*)(ropeI + ((size_t)t * 8 + 4 * fq) * 2); rot2(v0, p[0]); rot2(v1, p[1]); }
                        *(u32x4*)(kix + (size_t)row * 64 + (ct - 64)) = pack8(v0, v1); }
                    if (wc == 0 && fq < 2) { float* w = wix + (size_t)row * 16 + 8 * fq; *(f32x4*)w = acc[ai][1][m][0]; *(f32x4*)(w + 4) = acc[ai][1][m][1]; } }
        } else {
            const bool isa = vt < 39; bf16_t* dst = isa ? ga : gb; const int cb = (isa ? vt - 23 : vt - 39) * 256 + ct;
#pragma unroll
            for (int ai = 0; ai < 2; ++ai)
#pragma unroll
                for (int m = 0; m < 4; ++m) { const int row = rowb + ai * 128 + m * 16;
#pragma unroll
                    for (int bj = 0; bj < 2; ++bj) { f32x4 v0 = acc[ai][bj][m][0], v1 = acc[ai][bj][m][1];
#pragma unroll
                        for (int e = 0; e < 4; ++e) { v0[e] = sigm(v0[e]); v1[e] = sigm(v1[e]); }
                        *(u32x4*)(dst + (size_t)row * 4096 + cb + bj * 128) = pack8(v0, v1); } }
        }
    }
};

struct EpiUp {
    static constexpr bool PERM = true, AFTER_DRAIN = false, SPLITK2 = false;
    bf16_t *d0, *d1; int nt0, ld0, ld1; const u64* ssq; float invK, scale; const float* rope;
    __device__ __forceinline__ void operator()(const Acc& acc, const Unit& u, int wr, int wc, int fr, int fq) const {
        const int vt = u.pn, rowb = u.pm * 256 + wr * 64 + fr, ct = wc * 32 + 8 * fq; const bool first = vt < nt0;
        bf16_t* dst = first ? d0 : d1; const int ld = first ? ld0 : ld1, cb = (first ? vt : vt - nt0) * 256 + ct; const bool rt = (!first) && (rope != nullptr);
#pragma unroll
        for (int ai = 0; ai < 2; ++ai)
#pragma unroll
            for (int m = 0; m < 4; ++m) { const int row = rowb + ai * 128 + m * 16, t = row % TP;
                const float rs = __builtin_amdgcn_rsqf(ssq_get(ssq + row) * invK + EPS) * scale;
                f32x4 cs0 = (f32x4){1.f, 0.f, 1.f, 0.f}, cs1 = cs0;
                if (rt) { const f32x4* p = (const f32x4*)(rope + ((size_t)t * 32 + 16 * (wc & 1) + 4 * fq) * 2); cs0 = p[0]; cs1 = p[1]; }
#pragma unroll
                for (int bj = 0; bj < 2; ++bj) { f32x4 v0 = acc[ai][bj][m][0] * rs, v1 = acc[ai][bj][m][1] * rs;
                    if (rt) { rot2(v0, cs0); rot2(v1, cs1); }
                    *(u32x4*)(dst + (size_t)row * ld + cb + bj * 128) = pack8(v0, v1); } }
    }
};

struct EpiBranch {
    static constexpr bool PERM = true, AFTER_DRAIN = false, SPLITK2 = true;
    const bf16_t *ga, *gb; bf16_t* out;
    __device__ __forceinline__ void operator()(Acc& acc, const Unit& u, int wr, int wc, int fr, int fq) const {
        const int rowb = u.pm * 256 + wr * 64 + fr, cb = u.pn * 256 + wc * 32 + 8 * fq;
        if (u.kh == 0) {
#pragma unroll
            for (int ai = 0; ai < 2; ++ai)
#pragma unroll
                for (int m = 0; m < 4; ++m) { const size_t ro = (size_t)(rowb + ai * 128 + m * 16) * 4096 + cb;
#pragma unroll
                    for (int bj = 0; bj < 2; ++bj) { const u32x4 a = *(const u32x4*)(ga + ro + bj * 128), b = *(const u32x4*)(gb + ro + bj * 128);
                        f32x4 r0, r1;
#define RQ(x, y) ((x) * __builtin_amdgcn_rcpf(y))
                        r0[0] = RQ(bf_lo(a.x), bf_lo(b.x)); r0[1] = RQ(bf_hi(a.x), bf_hi(b.x)); r0[2] = RQ(bf_lo(a.y), bf_lo(b.y)); r0[3] = RQ(bf_hi(a.y), bf_hi(b.y));
                        r1[0] = RQ(bf_lo(a.z), bf_lo(b.z)); r1[1] = RQ(bf_hi(a.z), bf_hi(b.z)); r1[2] = RQ(bf_lo(a.w), bf_lo(b.w)); r1[3] = RQ(bf_hi(a.w), bf_hi(b.w));
#undef RQ
                        acc[ai][bj][m][0] = acc[ai][bj][m][0] * r0; acc[ai][bj][m][1] = acc[ai][bj][m][1] * r1; }
                    asm volatile("" ::: "memory"); }
        } else {
#pragma unroll
            for (int ai = 0; ai < 2; ++ai)
#pragma unroll
                for (int m = 0; m < 4; ++m) { const size_t ro = (size_t)(rowb + ai * 128 + m * 16) * 4096 + cb;
#pragma unroll
                    for (int bj = 0; bj < 2; ++bj) { const u32x4 b = *(const u32x4*)(gb + ro + bj * 128);
                        const f32x4 s0 = (f32x4){bf_lo(b.x), bf_hi(b.x), bf_lo(b.y), bf_hi(b.y)}, s1 = (f32x4){bf_lo(b.z), bf_hi(b.z), bf_lo(b.w), bf_hi(b.w)};
                        *(u32x4*)(out + ro + bj * 128) = pack8(acc[ai][bj][m][0] * s0, acc[ai][bj][m][1] * s1); } }
        }
    }
};

struct EpiOut {
    static constexpr bool PERM = true, AFTER_DRAIN = false, SPLITK2 = false;
    const float *x, *meta; float* h1f; bf16_t* h1b; u64* ssq;
    __device__ __forceinline__ void operator()(const Acc& acc, const Unit& u, int wr, int wc, int fr, int fq) const {
        const int rowb = u.pm * 256 + wr * 64 + fr, cb = u.pn * 256 + wc * 32 + 8 * fq;
#pragma unroll
        for (int ai = 0; ai < 2; ++ai)
#pragma unroll
            for (int m = 0; m < 4; ++m) { const int row = rowb + ai * 128 + m * 16, b = row / TP, t = row % TP;
                const float* src = t < NMETA ? meta + (size_t)t * DM : (t < TR ? x + ((size_t)b * SEQ + (t - NMETA)) * DM : nullptr);
                float s = 0.f;
#pragma unroll
                for (int bj = 0; bj < 2; ++bj) { f32x4 v0 = acc[ai][bj][m][0], v1 = acc[ai][bj][m][1];
                    if (src) { v0 = v0 + *(const f32x4*)(src + cb + bj * 128); v1 = v1 + *(const f32x4*)(src + cb + bj * 128 + 4); }
                    s += (v0[0] * v0[0] + v0[1] * v0[1]) + (v0[2] * v0[2] + v0[3] * v0[3]) + (v1[0] * v1[0] + v1[1] * v1[1]) + (v1[2] * v1[2] + v1[3] * v1[3]);
                    float* o = h1f + (size_t)row * DM + cb + bj * 128; *(f32x4*)o = v0; *(f32x4*)(o + 4) = v1;
                    *(u32x4*)(h1b + (size_t)row * DM + cb + bj * 128) = pack8(v0, v1); }
                s += __shfl_xor(s, 16); s += __shfl_xor(s, 32);
                if (fq == 0) ssq_add(ssq + row, s); }
    }
};

struct EpiPQ {
    static constexpr bool PERM = true, AFTER_DRAIN = false, SPLITK2 = false;
    bf16_t* pq; const u64* ssq;
    __device__ __forceinline__ void operator()(const Acc& acc, const Unit& u, int wr, int wc, int fr, int fq) const {
        const int rowb = u.pm * 256 + wr * 64 + fr, cb = u.pn * 256 + wc * 32 + 8 * fq;
#pragma unroll
        for (int ai = 0; ai < 2; ++ai)
#pragma unroll
            for (int m = 0; m < 4; ++m) { const int row = rowb + ai * 128 + m * 16; const float rs = __builtin_amdgcn_rsqf(ssq_get(ssq + row) * (1.0f / DM) + EPS);
#pragma unroll
                for (int bj = 0; bj < 2; ++bj) *(u32x4*)(pq + (size_t)row * 2048 + cb + bj * 128) = pack8(acc[ai][bj][m][0] * rs, acc[ai][bj][m][1] * rs); }
    }
};
}
#define XB_TMO      128
#define XB_XCNT(j)  (256  + 64 * (j))
#define XB_XSUB(j)  (1280 + 64 * (j))
#define XB_XGEN(j)  (2304 + 64 * (j))
#define XB_TOP      3328
#define XB_TOPGEN   3392
#define XCD_BAR_WORDS 3456
#define XB_SPIN_CAP (1u << 18)
__device__ __forceinline__ unsigned xb_ld(unsigned* p)              { return __hip_atomic_load(p, __ATOMIC_RELAXED, __HIP_MEMORY_SCOPE_AGENT); }
__device__ __forceinline__ unsigned xb_add(unsigned* p, unsigned v) { return __hip_atomic_fetch_add(p, v, __ATOMIC_RELAXED, __HIP_MEMORY_SCOPE_AGENT); }
__device__ __forceinline__ unsigned xb_xcc_id() { return (unsigned)__builtin_amdgcn_s_getreg((3 << 11) | 20) & 0xFu; }
#define XB_SPIN(cond, bar) do { unsigned _sp = 0; while (cond) { __builtin_amdgcn_s_sleep(1); \
    if ((++_sp & 255u) == 0u) { if (xb_ld(&(bar)[XB_TMO])) break; if (_sp > XB_SPIN_CAP) { atomicAdd(&(bar)[XB_TMO], 1u); break; } } } } while (0)
struct XcdBarrier { unsigned* bar; unsigned x; volatile LAS unsigned* st; };
__device__ __forceinline__ XcdBarrier xcd_barrier_post(unsigned* bar, volatile LAS unsigned* st) {
    XcdBarrier b; b.bar = bar; b.x = xb_xcc_id(); b.st = st;
    if (threadIdx.x == 0) (void)xb_add(&bar[XB_XCNT(b.x)], 1u);
    return b;
}
__device__ __forceinline__ void xcd_barrier_complete(unsigned* bar, unsigned x, unsigned& nloc, unsigned& nx) {
    const unsigned G = gridDim.x * gridDim.y * gridDim.z;
    unsigned sum, cnt, mine, sp = 0u;
    for (;;) {
        sum = 0u; cnt = 0u; mine = 0u;
#pragma unroll
        for (unsigned j = 0; j < 16; ++j) { const unsigned c = xb_ld(&bar[XB_XCNT(j)]); sum += c; cnt += (c > 0u) ? 1u : 0u; mine = (j == x) ? c : mine; }
        if (sum == G) break;
        __builtin_amdgcn_s_sleep(1);
        if ((++sp & 255u) == 0u) { if (xb_ld(&bar[XB_TMO])) break; if (sp > XB_SPIN_CAP) { atomicAdd(&bar[XB_TMO], 1u); break; } }
    }
    nloc = mine > 0u ? mine : 1u; nx = cnt > 0u ? cnt : 1u;
}
__device__ __forceinline__ void xcd_barrier(const XcdBarrier& b) {
    asm volatile("s_waitcnt vmcnt(0)" ::: "memory");
    __syncthreads();
    if (threadIdx.x == 0) {
        unsigned* bar = b.bar;
        __builtin_amdgcn_s_waitcnt(0);
        unsigned nloc = b.st[0], nx = b.st[1];
        if (nloc == 0u) { xcd_barrier_complete(bar, b.x, nloc, nx); b.st[0] = nloc; b.st[1] = nx; }
        const unsigned old = xb_add(&bar[XB_XSUB(b.x)], 1u);
        const unsigned gen = old / nloc;
        if (old + 1u == (gen + 1u) * nloc) {
            __builtin_amdgcn_fence(__ATOMIC_RELEASE, "agent");
            asm volatile("s_waitcnt vmcnt(0)" ::: "memory");
            const unsigned og = xb_add(&bar[XB_TOP], 1u);
            const unsigned tg = og / nx;
            if (og + 1u == (tg + 1u) * nx) xb_add(&bar[XB_TOPGEN], 1u);
            else XB_SPIN(xb_ld(&bar[XB_TOPGEN]) == tg, bar);
            __builtin_amdgcn_fence(__ATOMIC_ACQUIRE, "agent");
            xb_add(&bar[XB_XGEN(b.x)], 1u);
            asm volatile("s_waitcnt vmcnt(0)" ::: "memory");
        } else {
            XB_SPIN(xb_ld(&bar[XB_XGEN(b.x)]) == gen, bar);
            __builtin_amdgcn_fence(__ATOMIC_ACQUIRE, "agent");
            asm volatile("s_waitcnt vmcnt(0)" ::: "memory");
        }
    }
    __syncthreads();
}

struct Frame {
    LAS unsigned char* lds;
    unsigned char* ws;
    unsigned* ctl;
    int tid, lane, wave, vcu, G;
    __device__ __forceinline__ const float* in(int i) const { return ((const float* const __attribute__((address_space(4)))*)__builtin_amdgcn_kernarg_segment_ptr())[i]; }
    __device__ __forceinline__ float* out() const { return ((float* const __attribute__((address_space(4)))*)__builtin_amdgcn_kernarg_segment_ptr())[16]; }
};

struct MapId { __device__ __forceinline__ int operator()(int v) const { return v; } };
struct MapIn { __device__ __forceinline__ int operator()(int v) const {
    if (v < 1536) return v;
    if (v < 3584) { const int w = v - 1536, hd = w >> 7; int o = w & 127; if (o < 32) o = (o & 1) ? (o >> 1) + 16 : (o >> 1); return 1600 + hd * 128 + o; }
    if (v < 4096) { const int w = v - 3584, hd = w >> 7; int o = w & 127; if (o < 32) o = (o & 1) ? (o >> 1) + 16 : (o >> 1); return 3648 + hd * 128 + o; }
    if (v < 4608) return 4160 + (v - 4096);
    if (v < 5632) { const int w = v - 4608, hd = w >> 6; int o = w & 63; if (o < 16) o = (o & 1) ? (o >> 1) + 8 : (o >> 1); return 4672 + hd * 64 + o; }
    if (v < 5888) { const int w = v - 5632;
        if (w < 64) return 1536 + ((w & 1) ? (w >> 1) + 32 : (w >> 1));
        if (w < 128) { int o = w - 64; if (o < 16) o = (o & 1) ? (o >> 1) + 8 : (o >> 1); return 5696 + o; }
        if (w < 144) return 5760 + (w - 128);
        return -1; }
    if (v < 9984) return 5776 + (v - 5888);
    return 9872 + (v - 9984);
} };
struct MapUq { __device__ __forceinline__ int operator()(int v) const {
    if (v < 2048) return (v >> 7) * 192 + (v & 127);
    const int w = v - 2048, hd = w >> 6, o = w & 63; return hd * 192 + 128 + ((o & 1) ? (o >> 1) + 32 : (o >> 1)); } };
struct MapUkv { __device__ __forceinline__ int operator()(int v) const {
    if (v < 2048) return (v >> 7) * 256 + (v & 127);
    const int w = v - 2048; return (w >> 7) * 256 + 128 + (w & 127); } };

template <class Map>
__device__ __forceinline__ void p0_transpose_item(const float* W, int K, int Nsrc, int Nvirt, bf16_t* WT, const float* gk, LAS float* scr, int item, int lane, Map map) {
    const int nblk = Nvirt / 32, kb = item / nblk, nb = item % nblk, k0 = 64 * kb, n0 = 32 * nb;
    const int sc = map(n0 + (lane & 31));
#pragma unroll 8
    for (int i = 0; i < 32; ++i) { const int kk = 2 * i + (lane >> 5); float v = 0.f;
        if (sc >= 0) v = W[(size_t)(k0 + kk) * Nsrc + sc];
        if (gk) v *= gk[k0 + kk];
        scr[kk * 33 + (lane & 31)] = v; }
    LDS_WAIT(); asm volatile("" ::: "memory");
    const int c = lane & 7;
#pragma unroll
    for (int j = 0; j < 4; ++j) { const int n = (lane >> 3) + 8 * j; const LAS float* s = scr + (8 * c) * 33 + n;
        u32x4 o; o.x = pk2(s[0 * 33], s[1 * 33]); o.y = pk2(s[2 * 33], s[3 * 33]); o.z = pk2(s[4 * 33], s[5 * 33]); o.w = pk2(s[6 * 33], s[7 * 33]);
        *(u32x4*)(WT + (size_t)(n0 + n) * K + k0 + 8 * c) = o; }
    LDS_WAIT(); asm volatile("" ::: "memory");
}
__device__ __forceinline__ void p0_xn_row(const Frame& F, int m) {
    const int b = m / TP, t = m % TP; const float* x = F.in(0); const float* meta = F.in(1); const float* g = F.in(2);
    bf16_t* o = (bf16_t*)(F.ws + WS_XN) + (size_t)m * DM;
    u32x2* o8 = (u32x2*)o + F.lane;
    if (t >= TR) {
#pragma unroll
        for (int j = 0; j < 16; ++j) o8[64 * j] = (u32x2){0u, 0u};
        return; }
    const float* src = t < NMETA ? meta + (size_t)t * DM : x + ((size_t)b * SEQ + (t - NMETA)) * DM;
    const f32x4* xr = (const f32x4*)src + F.lane; const f32x4* gr = (const f32x4*)g + F.lane;
    f32x4 v[16]; float s = 0.f;
#pragma unroll
    for (int j = 0; j < 16; ++j) { v[j] = xr[64 * j]; s += (v[j][0] * v[j][0] + v[j][1] * v[j][1]) + (v[j][2] * v[j][2] + v[j][3] * v[j][3]); }
    const float rstd = 1.0f / sqrtf(wave_sum(s) * (1.0f / DM) + EPS);
#pragma unroll
    for (int j = 0; j < 16; ++j) { const f32x4 gg = gr[64 * j]; const f32x4 y = v[j] * rstd * gg; o8[64 * j] = (u32x2){pk2(y[0], y[1]), pk2(y[2], y[3])}; }
}
__device__ __forceinline__ void p0_prologue(const Frame& F) {
    LAS float* scr = (LAS float*)(F.lds + F.wave * 16384);
    const int gw = F.vcu * NWAVES + F.wave, NGW = F.G * NWAVES;
    const float* w_in = F.in(3); const float* qg = F.in(4); const float* w_uq = F.in(5); const float* kvg = F.in(6); const float* w_ukv = F.in(7);
    const float* w_br = F.in(8); const float* w_out = F.in(9); const float* fg = F.in(10); const float* w_q = F.in(11); const float* sk = F.in(12);
    constexpr int I_IN = 64 * (NV1 / 32), I_UQ = 16 * (3072 / 32), I_UKV = 8 * (4096 / 32), I_BR = 64 * 128, I_OUT = 64 * 128, I_Q = 64 * 64;
    constexpr int NITEMS = I_IN + I_UQ + I_UKV + I_BR + I_OUT + I_Q;
    for (int it = gw; it < NITEMS; it += NGW) {
        int r = it;
        if (r < I_IN) { p0_transpose_item(w_in, 4096, 13968, NV1, (bf16_t*)(F.ws + WS_WIN), nullptr, scr, r, F.lane, MapIn()); continue; } r -= I_IN;
        if (r < I_UQ) { p0_transpose_item(w_uq, 1024, 3072, 3072, (bf16_t*)(F.ws + WS_WUQ), qg, scr, r, F.lane, MapUq()); continue; } r -= I_UQ;
        if (r < I_UKV) { p0_transpose_item(w_ukv, 512, 4096, 4096, (bf16_t*)(F.ws + WS_WUKV), kvg, scr, r, F.lane, MapUkv()); continue; } r -= I_UKV;
        if (r < I_BR) { p0_transpose_item(w_br, 4096, 4096, 4096, (bf16_t*)(F.ws + WS_WBR), nullptr, scr, r, F.lane, MapId()); continue; } r -= I_BR;
        if (r < I_OUT) { p0_transpose_item(w_out, 4096, 4096, 4096, (bf16_t*)(F.ws + WS_WOUT), nullptr, scr, r, F.lane, MapId()); continue; } r -= I_OUT;
        p0_transpose_item(w_q, 4096, 2048, 2048, (bf16_t*)(F.ws + WS_WQ), fg, scr, r, F.lane, MapId());
    }
    for (int m = gw; m < M; m += NGW) p0_xn_row(F, m);
    const int gt = (F.vcu * NWAVES + F.wave) * 64 + F.lane, NGT = NGW * 64;
    for (int i = gt; i < TP * 56; i += NGT) {
        const int t = i / 56, r = i % 56; int j, rot; float* dst;
        if (r < 32) { j = r; rot = 64; dst = (float*)(F.ws + WS_ROPE_M) + ((size_t)t * 32 + j) * 2; }
        else if (r < 48) { j = r - 32; rot = 32; dst = (float*)(F.ws + WS_ROPE_D) + ((size_t)t * 16 + j) * 2; }
        else { j = r - 48; rot = 16; dst = (float*)(F.ws + WS_ROPE_I) + ((size_t)t * 8 + j) * 2; }
        const float ex = (float)(2 * j) / (float)rot;
        const float inv = powf(500000.0f, -ex);
        const float ang = (float)t * inv;
        const double a = (double)ang, kq = rint(a * 0.15915494309189535), rr = fma(-kq, 6.283185307179586, a);
        const float rf = (float)rr;
        dst[0] = cosf(rf); dst[1] = sinf(rf);
    }
    for (int i = gt; i < 16 * 128 * 128 / 8; i += NGT) { const f32x4* s = (const f32x4*)sk + 2 * (size_t)i; const f32x4 a = s[0], b2 = s[1];
        u32x4 o; o.x = pk2(a[0], a[1]); o.y = pk2(a[2], a[3]); o.z = pk2(b2[0], b2[1]); o.w = pk2(b2[2], b2[3]); ((u32x4*)(F.ws + WS_SK))[i] = o; }
}
__device__ __forceinline__ void p6_tables(const Frame& F) {
    const float* fg = F.in(10); const float* pu = F.in(13); const float* pv = F.in(14);
    const size_t gt = (size_t)(F.vcu * NWAVES + F.wave) * 64 + F.lane, NGT = (size_t)F.G * NWAVES * 64;
    const size_t n8 = (size_t)16384 * 4096 / 8;
    for (size_t i = gt; i < n8; i += NGT) { const f32x4* s = (const f32x4*)pu + 2 * i; const f32x4* gq = (const f32x4*)fg + 2 * (i & 511);
        const f32x4 a = s[0] * gq[0], b2 = s[1] * gq[1];
        u32x4 o; o.x = pk2(a[0], a[1]); o.y = pk2(a[2], a[3]); o.z = pk2(b2[0], b2[1]); o.w = pk2(b2[2], b2[3]); ((u32x4*)(F.ws + WS_U))[i] = o; }
    for (size_t i = gt; i < n8; i += NGT) { const f32x4* s = (const f32x4*)pv + 2 * i; const f32x4 a = s[0], b2 = s[1];
        u32x4 o; o.x = pk2(a[0], a[1]); o.y = pk2(a[2], a[3]); o.z = pk2(b2[0], b2[1]); o.w = pk2(b2[2], b2[3]); ((u32x4*)(F.ws + WS_V))[i] = o; }
}
#define MFMA32(a, b, c) __builtin_amdgcn_mfma_f32_32x32x16_bf16((a), (b), (c), 0, 0, 0)
__device__ __forceinline__ int crow(int i, int h) { return (i & 3) + 8 * (i >> 2) + 4 * h; }
__device__ __forceinline__ float half_sum_f(float v) {
#pragma unroll
    for (int o = 1; o < 32; o <<= 1) v += __shfl_xor(v, o);
    return v;
}
__device__ __forceinline__ int half_sum_i(int v) {
#pragma unroll
    for (int o = 1; o < 32; o <<= 1) v += __shfl_xor(v, o);
    return v;
}
__device__ __forceinline__ float half_max_f(float v) {
#pragma unroll
    for (int o = 1; o < 32; o <<= 1) v = fmaxf(v, __shfl_xor(v, o));
    return v;
}
__device__ __forceinline__ float half_min_f(float v) {
#pragma unroll
    for (int o = 1; o < 32; o <<= 1) v = fminf(v, __shfl_xor(v, o));
    return v;
}
__device__ __forceinline__ void idx_task(const Frame& F, int b, int t0) {
    const int lane = F.lane, r = lane & 31, h = lane >> 5;
    const bf16_t* qix = (const bf16_t*)(F.ws + WS_QIX); const bf16_t* kix = (const bf16_t*)(F.ws + WS_KIX); const float* wix = (const float*)(F.ws + WS_WIX);
    unsigned* mask = (unsigned*)(F.ws + WS_MASK);
    const int tok = (r >> 2) & 1, head = (r & 3) + 4 * (r >> 3);
    const bf16_t* qp = qix + (size_t)(b * TP + t0 + tok) * 1024 + head * 64 + 8 * h;
    bf16x8 af[4];
#pragma unroll
    for (int ks = 0; ks < 4; ++ks) af[ks] = *(const bf16x8*)(qp + 16 * ks);
    const f32x4* wp = (const f32x4*)(wix + (size_t)(b * TP + t0 + h) * 16);
    float w[16];
#pragma unroll
    for (int q = 0; q < 4; ++q) { const f32x4 x = wp[q]; w[4 * q] = x[0]; w[4 * q + 1] = x[1]; w[4 * q + 2] = x[2]; w[4 * q + 3] = x[3]; }
    const int tq = t0 + h;
    const int ngrp = ((t0 + 1) >> 6) + 1;
    const bf16_t* kbase = kix + (size_t)(b * TP + r) * 64 + 8 * h;
    float row[MW];
#pragma unroll
    for (int g = 0; g < MW / 2; ++g) {
        float s0 = -INFINITY, s1 = -INFINITY;
        if (g < ngrp) {
            const bf16_t* kp = kbase + (size_t)(g * 64) * 64;
            bf16x8 b0[4], b1[4];
#pragma unroll
            for (int ks = 0; ks < 4; ++ks) { b0[ks] = *(const bf16x8*)(kp + 16 * ks); b1[ks] = *(const bf16x8*)(kp + 32 * 64 + 16 * ks); }
            float x0 = 0.f, x1 = 0.f;
            { f32x16 a0;
#pragma unroll
              for (int i = 0; i < 16; ++i) a0[i] = 0.f;
#pragma unroll
              for (int ks = 0; ks < 4; ++ks) a0 = MFMA32(af[ks], b0[ks], a0);
#pragma unroll
              for (int i = 0; i < 16; ++i) x0 += w[i] * fmaxf(a0[i], 0.f); }
            { f32x16 a1;
#pragma unroll
              for (int i = 0; i < 16; ++i) a1[i] = 0.f;
#pragma unroll
              for (int ks = 0; ks < 4; ++ks) a1 = MFMA32(af[ks], b1[ks], a1);
#pragma unroll
              for (int i = 0; i < 16; ++i) x1 += w[i] * fmaxf(a1[i], 0.f); }
            s0 = (g * 64 + r <= tq) ? x0 : -INFINITY; s1 = (g * 64 + 32 + r <= tq) ? x1 : -INFINITY;
        }
        row[2 * g] = s0; row[2 * g + 1] = s1;
    }
    float tau = -3.0e38f;
    bool done = (tq + 1 <= 256);
    float mx = -INFINITY, mn = INFINITY;
#pragma unroll
    for (int k = 0; k < MW; ++k) { const float v = row[k]; mx = fmaxf(mx, v); mn = fminf(mn, v > -INFINITY ? v : INFINITY); }
    float lo = half_min_f(mn), hi = half_max_f(mx);
    if (!done) tau = hi;
    for (int it = 0; it < 64; ++it) {
        if (!__any(!done)) break;
        const float mid = lo + (hi - lo) * 0.5f;
        int c = 0;
#pragma unroll
        for (int k = 0; k < MW; ++k) c += (row[k] >= mid) ? 1 : 0;
        c = half_sum_i(c);
        if (!done) {
            if (!(mid > lo && mid < hi)) { tau = hi; done = true; }
            else if (c == 256) { tau = mid; done = true; }
            else if (c > 256) lo = mid;
            else { hi = mid; tau = hi; }
        }
    }
    unsigned* mrow = mask + (size_t)(b * TP + tq) * MW;
    unsigned mw = 0u;
#pragma unroll
    for (int k = 0; k < MW; ++k) {
        const unsigned long long bal = __ballot(row[k] >= tau);
        const unsigned wd = h ? (unsigned)(bal >> 32) : (unsigned)bal;
        if ((k & 31) == r) mw = wd;
        if ((k & 31) == 31 || k == MW - 1) { const int kk = (k & ~31) + r; if (kk < MW) mrow[kk] = mw; }
    }
}
__device__ __forceinline__ void p2_indexer(const Frame& F) {
    volatile LAS unsigned* qw = (volatile LAS unsigned*)(F.lds + LDSCTL_OFF + 16);
    constexpr int NCH = M / 16;
    for (;;) {
        if (F.tid == 0) qw[0] = atomicAdd(F.ctl + CW_QUEUE, 1u);
        __syncthreads();
        const int c = (int)qw[0];
        __syncthreads();
        if (c >= NCH) break;
        const int b = c & 3, tblk = (TP / 16 - 1) - (c >> 2);
        idx_task(F, b, tblk * 16 + 2 * F.wave);
    }
}
template <bool MLA> struct AttnCfg {
    static constexpr int DQK = MLA ? 192 : 128, PK = DQK * 2 + 16, PV = 320, KCH = DQK / 8, NKC = 64 * KCH / 512, KBYTES = 64 * PK, BUFB = 64 * PK + 64 * PV;
};
struct AttnUnit { int type, b, hx, blk; };

template <bool MLA>
__device__ __forceinline__ void attn_unit(const Frame& F, const AttnUnit u) {
    typedef AttnCfg<MLA> C;
    const int tid = F.tid, lane = F.lane, wave = F.wave, r = lane & 31, h = lane >> 5;
    LAS unsigned char* lds = F.lds;
    const bf16_t* qn = (const bf16_t*)(F.ws + WS_QN); const bf16_t* qr = (const bf16_t*)(F.ws + WS_QR); const bf16_t* kn = (const bf16_t*)(F.ws + WS_KN);
    const bf16_t* va = (const bf16_t*)(F.ws + WS_VA); const bf16_t* kpe = (const bf16_t*)(F.ws + WS_KPE);
    const bf16_t* qb = (const bf16_t*)(F.ws + WS_QB); const bf16_t* kb = (const bf16_t*)(F.ws + WS_KB); const bf16_t* vb = (const bf16_t*)(F.ws + WS_VB);
    const unsigned* mask = (const unsigned*)(F.ws + WS_MASK); bf16_t* oab = (bf16_t*)(F.ws + WS_OAB);
    const int b = u.b;
    const size_t rowb = (size_t)b * TP;
    int head, tw0, ntiles;
    if (MLA) { head = u.hx; tw0 = u.blk * 256 + 32 * wave; const int tend = (u.blk * 256 + 256 < TP) ? u.blk * 256 + 256 : TP; ntiles = tend / 64; }
    else { head = 4 * u.hx + (wave & 3); tw0 = u.blk * 64 + 32 * (wave >> 2); ntiles = u.blk + 1; }
    const bool active = tw0 < TP;
    const int tq = tw0 + r;
    bf16x8 qf[C::DQK / 16];
    if (active) {
        if (MLA) {
            const bf16_t* p0 = qn + (rowb + tq) * 2048 + head * 128 + 8 * h; const bf16_t* p1 = qr + (rowb + tq) * 1024 + head * 64 + 8 * h;
#pragma unroll
            for (int ks = 0; ks < 8; ++ks) qf[ks] = *(const bf16x8*)(p0 + 16 * ks);
#pragma unroll
            for (int ks = 0; ks < 4; ++ks) qf[8 + ks] = *(const bf16x8*)(p1 + 16 * ks);
        } else {
            const bf16_t* p0 = qb + (rowb + tq) * 2048 + head * 128 + 8 * h;
#pragma unroll
            for (int ks = 0; ks < 8; ++ks) qf[ks] = *(const bf16x8*)(p0 + 16 * ks);
        }
    } else {
#pragma unroll
        for (int ks = 0; ks < C::DQK / 16; ++ks) qf[ks] = (bf16x8){0, 0, 0, 0, 0, 0, 0, 0};
    }
    const int ldkv = MLA ? 2048 : 512;
    const bf16_t* kbase = (MLA ? kn + rowb * 2048 + head * 128 : kb + rowb * 512 + u.hx * 128);
    const bf16_t* vbase = (MLA ? va + rowb * 2048 + head * 128 : vb + rowb * 512 + u.hx * 128);
    const bf16_t* pbase = kpe + rowb * 64;
    unsigned soff[2]; int kdst[2], vdst[2];
#pragma unroll
    for (int i = 0; i < 2; ++i) { const int c = tid + 512 * i, key = c >> 4, pc = c & 15; soff[i] = (unsigned)(key * ldkv + pc * 8); kdst[i] = key * C::PK + pc * 16; vdst[i] = C::KBYTES + key * C::PV + pc * 16; }
    const unsigned poff = (unsigned)((tid >> 3) * 64 + (tid & 7) * 8); const int pdst = (tid >> 3) * C::PK + 256 + (tid & 7) * 16;
    u32x4 kst[2], vst[2], pst = (u32x4){0u, 0u, 0u, 0u};
#pragma unroll
    for (int i = 0; i < 2; ++i) { kst[i] = *(const u32x4*)(kbase + soff[i]); vst[i] = *(const u32x4*)(vbase + soff[i]); }
    if (MLA) pst = *(const u32x4*)(pbase + poff);
#pragma unroll
    for (int i = 0; i < 2; ++i) { *(LAS u32x4*)(lds + kdst[i]) = kst[i]; *(LAS u32x4*)(lds + vdst[i]) = vst[i]; }
    if (MLA) *(LAS u32x4*)(lds + pdst) = pst;
    __syncthreads();
    f32x16 oacc[4];
#pragma unroll
    for (int d = 0; d < 4; ++d)
#pragma unroll
        for (int i = 0; i < 16; ++i) oacc[d][i] = 0.f;
    float mrun = -INFINITY, lrun = 0.f;
    const int koff = r * C::PK + 16 * h;
    const int voff = C::KBYTES + (4 * h + ((lane & 15) >> 2)) * C::PV + (16 * ((lane >> 4) & 1) + 4 * (lane & 3)) * 2;
    const unsigned* mrow = mask + (rowb + (active ? tq : 0)) * MW;
    for (int kt = 0; kt < ntiles; ++kt) {
        const int cur = (kt & 1) * C::BUFB, nxt = ((kt + 1) & 1) * C::BUFB;
        const bool more = kt + 1 < ntiles;
        if (more) {
            const bf16_t* kb2 = kbase + (size_t)(kt + 1) * 64 * ldkv; const bf16_t* vb2 = vbase + (size_t)(kt + 1) * 64 * ldkv;
#pragma unroll
            for (int i = 0; i < 2; ++i) { kst[i] = *(const u32x4*)(kb2 + soff[i]); vst[i] = *(const u32x4*)(vb2 + soff[i]); }
            if (MLA) pst = *(const u32x4*)(pbase + (size_t)(kt + 1) * 64 * 64 + poff);
        }
        if (active && kt * 64 <= tw0 + 31) {
            u32x2 mwd = (u32x2){0u, 0u};
            if (!MLA) mwd = *(const u32x2*)(mrow + 2 * kt);
            f32x16 s0, s1;
#pragma unroll
            for (int i = 0; i < 16; ++i) { s0[i] = 0.f; s1[i] = 0.f; }
#pragma unroll
            for (int ks = 0; ks < C::DQK / 16; ++ks) {
                const bf16x8 k0 = *(const LAS bf16x8*)(lds + cur + koff + 32 * ks), k1 = *(const LAS bf16x8*)(lds + cur + koff + 32 * C::PK + 32 * ks);
                s0 = MFMA32(k0, qf[ks], s0); s1 = MFMA32(k1, qf[ks], s1);
            }
            if (MLA) {
                if (kt * 64 + 63 > tw0) {
                    const int kb0 = kt * 64 + 4 * h;
#pragma unroll
                    for (int i = 0; i < 16; ++i) { const int key = kb0 + (i & 3) + 8 * (i >> 2); if (key > tq) s0[i] = -INFINITY; if (key + 32 > tq) s1[i] = -INFINITY; }
                }
            } else {
                const unsigned m0 = mwd.x >> (4 * h), m1 = mwd.y >> (4 * h);
#pragma unroll
                for (int i = 0; i < 16; ++i) { const int bit = (i & 3) + 8 * (i >> 2); if (!((m0 >> bit) & 1u)) s0[i] = -INFINITY; if (!((m1 >> bit) & 1u)) s1[i] = -INFINITY; }
            }
            float mx = s0[0];
#pragma unroll
            for (int i = 1; i < 16; ++i) mx = fmaxf(mx, s0[i]);
#pragma unroll
            for (int i = 0; i < 16; ++i) mx = fmaxf(mx, s1[i]);
            mx = fmaxf(mx, __shfl_xor(mx, 32));
            const float mnew = fmaxf(mrun, mx);
            const float msafe = (mnew == -INFINITY) ? 0.f : mnew;
            const float alpha = __builtin_amdgcn_exp2f(mrun - msafe);
            mrun = mnew;
            float ps = 0.f;
#pragma unroll
            for (int i = 0; i < 16; ++i) { s0[i] = __builtin_amdgcn_exp2f(s0[i] - msafe); s1[i] = __builtin_amdgcn_exp2f(s1[i] - msafe); ps += s0[i] + s1[i]; }
            lrun = lrun * alpha + ps;
#pragma unroll
            for (int d = 0; d < 4; ++d)
#pragma unroll
                for (int i = 0; i < 16; ++i) oacc[d][i] *= alpha;
            bf16x8 pf[4];
            { u32x4 w;
              w.x = cvt_pk_bf16(s0[0], s0[1]); w.y = cvt_pk_bf16(s0[2], s0[3]); w.z = cvt_pk_bf16(s0[4], s0[5]); w.w = cvt_pk_bf16(s0[6], s0[7]); pf[0] = __builtin_bit_cast(bf16x8, w);
              w.x = cvt_pk_bf16(s0[8], s0[9]); w.y = cvt_pk_bf16(s0[10], s0[11]); w.z = cvt_pk_bf16(s0[12], s0[13]); w.w = cvt_pk_bf16(s0[14], s0[15]); pf[1] = __builtin_bit_cast(bf16x8, w);
              w.x = cvt_pk_bf16(s1[0], s1[1]); w.y = cvt_pk_bf16(s1[2], s1[3]); w.z = cvt_pk_bf16(s1[4], s1[5]); w.w = cvt_pk_bf16(s1[6], s1[7]); pf[2] = __builtin_bit_cast(bf16x8, w);
              w.x = cvt_pk_bf16(s1[8], s1[9]); w.y = cvt_pk_bf16(s1[10], s1[11]); w.z = cvt_pk_bf16(s1[12], s1[13]); w.w = cvt_pk_bf16(s1[14], s1[15]); pf[3] = __builtin_bit_cast(bf16x8, w); }
#pragma unroll
            for (int d = 0; d < 4; ++d)
#pragma unroll
                for (int kk = 0; kk < 4; ++kk) {
                    const s16x4 lo = __builtin_amdgcn_ds_read_tr16_b64_v4i16((LAS s16x4*)(lds + cur + voff + (16 * kk) * C::PV + 64 * d));
                    const s16x4 hi = __builtin_amdgcn_ds_read_tr16_b64_v4i16((LAS s16x4*)(lds + cur + voff + (16 * kk + 8) * C::PV + 64 * d));
                    const bf16x8 vf = __builtin_shufflevector(lo, hi, 0, 1, 2, 3, 4, 5, 6, 7);
                    oacc[d] = MFMA32(vf, pf[kk], oacc[d]);
                }
        }
        if (more) {
#pragma unroll
            for (int i = 0; i < 2; ++i) { *(LAS u32x4*)(lds + nxt + kdst[i]) = kst[i]; *(LAS u32x4*)(lds + nxt + vdst[i]) = vst[i]; }
            if (MLA) *(LAS u32x4*)(lds + nxt + pdst) = pst;
        }
        __syncthreads();
    }
    if (active) {
        const float lt = lrun + __shfl_xor(lrun, 32);
        const float inv = lt > 0.f ? 1.0f / lt : 0.f;
        bf16_t* op = oab + (rowb + tq) * 4096 + (MLA ? 0 : 2048) + head * 128 + 4 * h;
#pragma unroll
        for (int d = 0; d < 4; ++d)
#pragma unroll
            for (int g = 0; g < 4; ++g) { u32x2 w; w.x = cvt_pk_bf16(oacc[d][4 * g] * inv, oacc[d][4 * g + 1] * inv); w.y = cvt_pk_bf16(oacc[d][4 * g + 2] * inv, oacc[d][4 * g + 3] * inv);
                *(u32x2*)(op + 32 * d + 8 * g) = w; }
    }
}

constexpr int ATT_NUNITS = 17 * 64 + 66 * 16;
__device__ __forceinline__ void att_decode(int idx, AttnUnit& u) {
    int rem = idx;
    for (int L = 66; L >= 1; --L) {
        const int nm = (L == 66 || (L & 3) == 0) ? 64 : 0;
        if (rem < nm) { u.type = 0; u.blk = (L == 66) ? 16 : (L >> 2) - 1; u.b = rem & 3; u.hx = rem >> 2; return; }
        rem -= nm;
        if (rem < 16) { u.type = 1; u.blk = L - 1; u.b = rem & 3; u.hx = rem >> 2; return; }
        rem -= 16;
    }
    u.type = -1; u.blk = 0; u.b = 0; u.hx = 0;
}
__device__ __forceinline__ void p3_attention(const Frame& F) {
#ifdef MK_SKIP_ATT
    {
        const u32x4* qn = (const u32x4*)(F.ws + WS_QN); const u32x4* qb = (const u32x4*)(F.ws + WS_QB); u32x4* o = (u32x4*)(F.ws + WS_OAB);
        const size_t gt = (size_t)(F.vcu * NWAVES + F.wave) * 64 + F.lane, NGT = (size_t)F.G * NWAVES * 64;
        for (size_t i = gt; i < (size_t)M * 256; i += NGT) { const size_t row = i >> 8, c = i & 255; o[row * 512 + c] = qn[row * 256 + c]; o[row * 512 + 256 + c] = qb[row * 256 + c]; }
        return;
    }
#endif
    volatile LAS int* qw = (volatile LAS int*)(F.lds + LDSCTL_OFF + 32);
    for (;;) {
        if (F.tid == 0) { const int idx = (int)atomicAdd(F.ctl + CW_QUEUE + 64, 1u); AttnUnit u; u.type = -1; u.b = 0; u.hx = 0; u.blk = 0; if (idx < ATT_NUNITS) att_decode(idx, u);
            qw[0] = u.type; qw[1] = u.b; qw[2] = u.hx; qw[3] = u.blk; }
        __syncthreads();
        AttnUnit u; u.type = qw[0]; u.b = qw[1]; u.hx = qw[2]; u.blk = qw[3];
        __syncthreads();
        if (u.type < 0) break;
        if (u.type == 0) attn_unit<true>(F, u); else attn_unit<false>(F, u);
    }
}
__device__ __forceinline__ float pk_idx(float v, int n) { return __uint_as_float((__float_as_uint(v) & ~127u) | (unsigned)n); }
__device__ __forceinline__ void route_task(const Frame& F, int tb, int hd) {
    const int lane = F.lane, r = lane & 31, h = lane >> 5;
    const bf16_t* pq = (const bf16_t*)(F.ws + WS_PQ); const bf16_t* skb = (const bf16_t*)(F.ws + WS_SK);
    int* eid = (int*)(F.ws + WS_EID); float* gate = (float*)(F.ws + WS_GATE);
    LAS float* wl = (LAS float*)(F.lds + F.wave * 16384);
    const int m = tb * 32 + r;
#pragma unroll 1
    for (int c = 0; c < 2; ++c) {
        const bf16_t* qp = pq + (size_t)m * 2048 + hd * 256 + c * 128 + 8 * h;
        bf16x8 qf[8];
#pragma unroll
        for (int ks = 0; ks < 8; ++ks) qf[ks] = *(const bf16x8*)(qp + 16 * ks);
        float v[64];
#pragma unroll
        for (int blk = 0; blk < 4; ++blk) {
            const bf16_t* sp = skb + (size_t)((hd * 2 + c) * 128 + 32 * blk + r) * 128 + 8 * h;
            f32x16 acc;
#pragma unroll
            for (int i = 0; i < 16; ++i) acc[i] = 0.f;
#pragma unroll
            for (int ks = 0; ks < 8; ++ks) acc = MFMA32(*(const bf16x8*)(sp + 16 * ks), qf[ks], acc);
#pragma unroll
            for (int i = 0; i < 16; ++i) v[blk * 16 + i] = pk_idx(acc[i], 32 * blk + (i & 3) + 8 * (i >> 2) + 4 * h);
        }
#pragma unroll 1
        for (int k = 0; k < 16; ++k) {
            float mx = v[0];
#pragma unroll
            for (int j = 1; j < 64; ++j) mx = fmaxf(mx, v[j]);
            mx = fmaxf(mx, __shfl_xor(mx, 32));
            if (h == 0) wl[(c * 16 + k) * 32 + r] = mx;
#pragma unroll
            for (int j = 0; j < 64; ++j) v[j] = (v[j] == mx) ? -INFINITY : v[j];
        }
    }
    LDS_WAIT(); asm volatile("" ::: "memory");
    float cs[50]; int ce[50];
    {
        unsigned t0[16], t1[16];
#pragma unroll
        for (int i = 0; i < 16; ++i) { t0[i] = __float_as_uint(wl[i * 32 + r]); t1[i] = __float_as_uint(wl[(16 + i) * 32 + r]); }
        int n = 0;
#pragma unroll
        for (int i = 0; i < 16; ++i)
#pragma unroll
            for (int j = 0; j < 16; ++j)
                if ((i + 1) * (j + 1) <= 16) {
                    const float s = __uint_as_float(t0[i] & ~127u) + __uint_as_float(t1[j] & ~127u);
                    cs[n] = __uint_as_float((__float_as_uint(s) & ~63u) | (unsigned)n); ce[n] = (int)((t0[i] & 127u) * 128u + (t1[j] & 127u)); ++n;
                }
    }
    float sum = 0.f, first = 0.f;
#pragma unroll 1
    for (int k = 0; k < 16; ++k) {
        float mx = cs[0];
#pragma unroll
        for (int j = 1; j < 50; ++j) mx = fmaxf(mx, cs[j]);
        int se = 0;
#pragma unroll
        for (int j = 0; j < 50; ++j) { const bool hit = (cs[j] == mx); se = hit ? ce[j] : se; cs[j] = hit ? -INFINITY : cs[j]; }
        if (k == 0) first = mx;
        const float ev = __expf(mx - first); sum += ev;
        if (h == 0) { wl[1024 + k * 32 + r] = ev; wl[1536 + k * 32 + r] = __int_as_float(se); }
    }
    LDS_WAIT(); asm volatile("" ::: "memory");
    const float inv = 1.0f / sum;
    if (h == 0) {
        int* ep = eid + (size_t)m * 128 + hd * 16; float* gp = gate + (size_t)m * 128 + hd * 16;
#pragma unroll
        for (int q = 0; q < 4; ++q) {
            *(int4*)(ep + 4 * q) = make_int4(__float_as_int(wl[1536 + (4 * q) * 32 + r]), __float_as_int(wl[1536 + (4 * q + 1) * 32 + r]), __float_as_int(wl[1536 + (4 * q + 2) * 32 + r]), __float_as_int(wl[1536 + (4 * q + 3) * 32 + r]));
            *(f32x4*)(gp + 4 * q) = (f32x4){wl[1024 + (4 * q) * 32 + r] * inv, wl[1024 + (4 * q + 1) * 32 + r] * inv, wl[1024 + (4 * q + 2) * 32 + r] * inv, wl[1024 + (4 * q + 3) * 32 + r] * inv}; }
    }
    LDS_WAIT(); asm volatile("" ::: "memory");
}
__device__ __forceinline__ void p7_routing(const Frame& F) {
    const int gw = F.vcu * NWAVES + F.wave, NGW = F.G * NWAVES;
    for (int it = gw; it < (M / 32) * 8; it += NGW) route_task(F, it >> 3, it & 7);
}

typedef __bf16 bf2_t __attribute__((ext_vector_type(2)));
__device__ __forceinline__ float dot2bf(unsigned a, unsigned b, float c) { return __builtin_amdgcn_fdot2_f32_bf16(__builtin_bit_cast(bf2_t, a), __builtin_bit_cast(bf2_t, b), c, false); }
__device__ __forceinline__ float dot8(const u32x4 a, const u32x4 b, float c) { c = dot2bf(a.x, b.x, c); c = dot2bf(a.y, b.y, c); c = dot2bf(a.z, b.z, c); return dot2bf(a.w, b.w, c); }
__device__ __forceinline__ float rl_f(float v, int l) { return __int_as_float(__builtin_amdgcn_readlane(__float_as_int(v), l)); }
__device__ __forceinline__ float gelu_tanh(float x) {
    const float u = 0.7978845608028654f * (x + 0.044715f * x * x * x);
    const float e = __expf(2.0f * u);
    const float th = 1.0f - 2.0f / (e + 1.0f);
    return 0.5f * x * (1.0f + th);
}
__device__ __forceinline__ void expert_token(const Frame& F, int m, size_t orow) {
    const int lane = F.lane;
    const bf16_t* U = (const bf16_t*)(F.ws + WS_U); const bf16_t* V = (const bf16_t*)(F.ws + WS_V);
    const int* eid = (const int*)(F.ws + WS_EID); const float* gate = (const float*)(F.ws + WS_GATE);
    const bf16_t* h1b = (const bf16_t*)(F.ws + WS_H1B); const float* h1f = (const float*)(F.ws + WS_H1F);
    const u64* ssq = (const u64*)(F.ctl + CW_SSQ_H1); const float* gfin = F.in(15);
    u32x4 hb[8];
#pragma unroll
    for (int j = 0; j < 8; ++j) hb[j] = *((const u32x4*)(h1b + (size_t)m * DM) + lane + 64 * j);
    const int e0 = eid[(size_t)m * 128 + lane], e1 = eid[(size_t)m * 128 + 64 + lane];
    const float g0 = gate[(size_t)m * 128 + lane], g1 = gate[(size_t)m * 128 + 64 + lane];
    const float rstd = __builtin_amdgcn_rsqf(ssq_get(ssq + m) * (1.0f / DM) + EPS);
    float a0 = 0.f, a1 = 0.f;
    {
        u32x4 ra[8], rb[8];
        { const u32x4* up = (const u32x4*)(U + (size_t)__builtin_amdgcn_readlane(e0, 0) * DM) + lane;
#pragma unroll
          for (int j = 0; j < 8; ++j) ra[j] = up[64 * j]; }
        for (int e = 0; e < 128; e += 2) {
            { const int ex = (e + 1 < 64) ? __builtin_amdgcn_readlane(e0, e + 1) : __builtin_amdgcn_readlane(e1, e + 1 - 64);
              const u32x4* up = (const u32x4*)(U + (size_t)ex * DM) + lane;
#pragma unroll
              for (int j = 0; j < 8; ++j) rb[j] = up[64 * j]; }
            { float p = 0.f;
#pragma unroll
              for (int j = 0; j < 8; ++j) p = dot8(ra[j], hb[j], p);
              p = wave_sum(p);
              if (e < 64) { if (lane == e) a0 = p; } else { if (lane == e - 64) a1 = p; } }
            if (e + 2 < 128) { const int ex = (e + 2 < 64) ? __builtin_amdgcn_readlane(e0, e + 2) : __builtin_amdgcn_readlane(e1, e + 2 - 64);
              const u32x4* up = (const u32x4*)(U + (size_t)ex * DM) + lane;
#pragma unroll
              for (int j = 0; j < 8; ++j) ra[j] = up[64 * j]; }
            { float p = 0.f;
#pragma unroll
              for (int j = 0; j < 8; ++j) p = dot8(rb[j], hb[j], p);
              p = wave_sum(p);
              if (e + 1 < 64) { if (lane == e + 1) a0 = p; } else { if (lane == e + 1 - 64) a1 = p; } }
        }
    }
    const float c0 = gelu_tanh(a0 * rstd) * g0, c1 = gelu_tanh(a1 * rstd) * g1;
    float o[64];
#pragma unroll
    for (int i = 0; i < 64; ++i) o[i] = 0.f;
    {
        u32x4 ra[8], rb[8];
        { const u32x4* vp = (const u32x4*)(V + (size_t)__builtin_amdgcn_readlane(e0, 0) * DM) + lane;
#pragma unroll
          for (int j = 0; j < 8; ++j) ra[j] = vp[64 * j]; }
        for (int e = 0; e < 128; e += 2) {
            { const int ex = (e + 1 < 64) ? __builtin_amdgcn_readlane(e0, e + 1) : __builtin_amdgcn_readlane(e1, e + 1 - 64);
              const u32x4* vp = (const u32x4*)(V + (size_t)ex * DM) + lane;
#pragma unroll
              for (int j = 0; j < 8; ++j) rb[j] = vp[64 * j]; }
            { const float c = (e < 64) ? rl_f(c0, e) : rl_f(c1, e - 64);
#pragma unroll
              for (int j = 0; j < 8; ++j) { o[8 * j + 0] += c * bf_lo(ra[j].x); o[8 * j + 1] += c * bf_hi(ra[j].x); o[8 * j + 2] += c * bf_lo(ra[j].y); o[8 * j + 3] += c * bf_hi(ra[j].y);
                  o[8 * j + 4] += c * bf_lo(ra[j].z); o[8 * j + 5] += c * bf_hi(ra[j].z); o[8 * j + 6] += c * bf_lo(ra[j].w); o[8 * j + 7] += c * bf_hi(ra[j].w); } }
            if (e + 2 < 128) { const int ex = (e + 2 < 64) ? __builtin_amdgcn_readlane(e0, e + 2) : __builtin_amdgcn_readlane(e1, e + 2 - 64);
              const u32x4* vp = (const u32x4*)(V + (size_t)ex * DM) + lane;
#pragma unroll
              for (int j = 0; j < 8; ++j) ra[j] = vp[64 * j]; }
            { const float c = (e + 1 < 64) ? rl_f(c0, e + 1) : rl_f(c1, e + 1 - 64);
#pragma unroll
              for (int j = 0; j < 8; ++j) { o[8 * j + 0] += c * bf_lo(rb[j].x); o[8 * j + 1] += c * bf_hi(rb[j].x); o[8 * j + 2] += c * bf_lo(rb[j].y); o[8 * j + 3] += c * bf_hi(rb[j].y);
                  o[8 * j + 4] += c * bf_lo(rb[j].z); o[8 * j + 5] += c * bf_hi(rb[j].z); o[8 * j + 6] += c * bf_lo(rb[j].w); o[8 * j + 7] += c * bf_hi(rb[j].w); } }
        }
    }
    float s = 0.f;
#pragma unroll
    for (int j = 0; j < 8; ++j) { const f32x4* hp = (const f32x4*)(h1f + (size_t)m * DM + 512 * j + 8 * lane); const f32x4 x0 = hp[0], x1 = hp[1];
#pragma unroll
        for (int q = 0; q < 4; ++q) { o[8 * j + q] += x0[q]; o[8 * j + 4 + q] += x1[q]; }
#pragma unroll
        for (int q = 0; q < 8; ++q) s += o[8 * j + q] * o[8 * j + q]; }
    const float rs = 1.0f / sqrtf(wave_sum(s) * (1.0f / DM) + EPS);
    float* op = F.out() + orow * DM;
#pragma unroll
    for (int j = 0; j < 8; ++j) { const f32x4* gp = (const f32x4*)(gfin + 512 * j + 8 * lane); const f32x4 ga = gp[0], gb2 = gp[1];
        *(f32x4*)(op + 512 * j + 8 * lane) = (f32x4){o[8 * j] * rs * ga[0], o[8 * j + 1] * rs * ga[1], o[8 * j + 2] * rs * ga[2], o[8 * j + 3] * rs * ga[3]};
        *(f32x4*)(op + 512 * j + 8 * lane + 4) = (f32x4){o[8 * j + 4] * rs * gb2[0], o[8 * j + 5] * rs * gb2[1], o[8 * j + 6] * rs * gb2[2], o[8 * j + 7] * rs * gb2[3]}; }
}
#ifdef MK_STEP_B
__device__ __forceinline__ void stepb_token(const Frame& F, int m, size_t orow) {
    const int lane = F.lane; const float* x = (const float*)(F.ws + WS_H1F) + (size_t)m * DM; const float* gfin = F.in(15);
    f32x4 v[16]; float s = 0.f;
#pragma unroll
    for (int j = 0; j < 16; ++j) { v[j] = *((const f32x4*)x + lane + 64 * j); s += (v[j][0] * v[j][0] + v[j][1] * v[j][1]) + (v[j][2] * v[j][2] + v[j][3] * v[j][3]); }
    const float rs = 1.0f / sqrtf(wave_sum(s) * (1.0f / DM) + EPS);
#pragma unroll
    for (int j = 0; j < 16; ++j) { const f32x4 g = *((const f32x4*)gfin + lane + 64 * j); *((f32x4*)(F.out() + orow * DM) + lane + 64 * j) = v[j] * rs * g; }
}
#endif
#ifdef MK_STEP_A
__device__ __forceinline__ void stepa_token(const Frame& F, size_t orow) {
    const int lane = F.lane; const float* x = F.in(0) + orow * DM; const float* gfin = F.in(15);
    f32x4 v[16]; float s = 0.f;
#pragma unroll
    for (int j = 0; j < 16; ++j) { v[j] = *((const f32x4*)x + lane + 64 * j); s += (v[j][0] * v[j][0] + v[j][1] * v[j][1]) + (v[j][2] * v[j][2] + v[j][3] * v[j][3]); }
    const float rs = 1.0f / sqrtf(wave_sum(s) * (1.0f / DM) + EPS);
#pragma unroll
    for (int j = 0; j < 16; ++j) { const f32x4 g = *((const f32x4*)gfin + lane + 64 * j); *((f32x4*)(F.out() + orow * DM) + lane + 64 * j) = v[j] * rs * g; }
}
#endif
__device__ __forceinline__ void p8_experts(const Frame& F) {
    const int gw = F.vcu * NWAVES + F.wave, NGW = F.G * NWAVES;
#if defined(MK_STEP_A)
    for (int it = gw; it < NB * SEQ; it += NGW) stepa_token(F, (size_t)it);
#elif defined(MK_STEP_B)
    for (int it = gw; it < NB * SEQ; it += NGW) { const int b = it / SEQ, s = it % SEQ; stepb_token(F, b * TP + NMETA + s, (size_t)it); }
#else
    for (int it = gw; it < NB * SEQ; it += NGW) { const int b = it / SEQ, s = it % SEQ; expert_token(F, b * TP + NMETA + s, (size_t)it); }
#endif
}
struct Args { const float* in[16]; float* out; unsigned char* ws; int ph_lo, ph_hi; };
#define GEMM_RUN(EPI_T, g_, S_, E_) pg8::gemm_phase<EPI_T, pg8::StaticOrder, true, true>(F.lds, g_, S_, E_)
#define GEMM_RUN2(EPI_T, g_, S_, E_) pg8::gemm_phase<EPI_T, pg8::StaticOrder2, true, true>(F.lds, g_, S_, E_)

__global__ void __launch_bounds__(NWAVES * 64, 2) mk_fwd(Args args) {
    extern __shared__ __attribute__((aligned(16))) unsigned char lds_raw[];
    Frame F;
    F.lds = (LAS unsigned char*)lds_raw;
    F.ws = args.ws; F.ctl = (unsigned*)(args.ws + WS_CTL);
    F.tid = threadIdx.x; F.lane = F.tid & 63; F.wave = __builtin_amdgcn_readfirstlane(F.tid >> 6);
#define PHASE_BEGIN() do { int t_; asm volatile("v_mov_b32 %0, %1" : "=v"(t_) : "v"(threadIdx.x)); F.tid = t_; F.lane = t_ & 63; } while (0)
    F.G = gridDim.x; { const int bx = blockIdx.x; F.vcu = (F.G % 8 == 0) ? (bx % 8) * (F.G / 8) + bx / 8 : bx; }
    for (int u = F.tid; u < (LDS_BYTES - LDSCTL_OFF) / 4; u += NWAVES * 64) ((LAS unsigned*)(F.lds + LDSCTL_OFF))[u] = 0u;
    __syncthreads();
    XcdBarrier bar; bar.bar = F.ctl + CW_BAR; bar.x = 0; bar.st = nullptr;
    if (!MK_PER_PHASE) bar = xcd_barrier_post(F.ctl + CW_BAR, (volatile LAS unsigned*)(F.lds + LDSCTL_OFF));
    const int lo = args.ph_lo, hi = args.ph_hi;
#ifndef PH_MASK
#define PH_MASK 0x1FF
#endif
#define IN(k) (((PH_MASK >> (k)) & 1) && lo <= (k) && (k) < hi)
#define SEAM(k) do { if (IN(k) && IN((k) + 1)) xcd_barrier(bar); } while (0)
    unsigned char* ws = F.ws;

    if (IN(0)) { PHASE_BEGIN(); p0_prologue(F); }
    SEAM(0);
    if (IN(1)) { PHASE_BEGIN();
        pg8::Gemm g{(const bf16_t*)(ws + WS_XN), (const bf16_t*)(ws + WS_WIN), M, NV1, DM, DM}; pg8::StaticOrder S; S.init(M, NV1, F.G, (int)blockIdx.x);
        epi::EpiIn E{(bf16_t*)(ws + WS_CQ), (bf16_t*)(ws + WS_CKV), (bf16_t*)(ws + WS_QB), (bf16_t*)(ws + WS_KB), (bf16_t*)(ws + WS_VB), (bf16_t*)(ws + WS_QIX), (bf16_t*)(ws + WS_KPE), (bf16_t*)(ws + WS_KIX),
                      (bf16_t*)(ws + WS_GA), (bf16_t*)(ws + WS_GB), (float*)(ws + WS_WIX), (u64*)(F.ctl + CW_SSQ_CQ), (u64*)(F.ctl + CW_SSQ_CKV),
                      (const float*)(ws + WS_ROPE_M), (const float*)(ws + WS_ROPE_D), (const float*)(ws + WS_ROPE_I)};
        GEMM_RUN(epi::EpiIn, g, S, E);
    }
    SEAM(1);
    if (IN(2)) { PHASE_BEGIN();
        { pg8::Gemm g{(const bf16_t*)(ws + WS_CQ), (const bf16_t*)(ws + WS_WUQ), M, 3072, 1024, 1024}; pg8::StaticOrder S; S.init(M, 3072, F.G, (int)blockIdx.x);
          epi::EpiUp E{(bf16_t*)(ws + WS_QN), (bf16_t*)(ws + WS_QR), 8, 2048, 1024, (const u64*)(F.ctl + CW_SSQ_CQ), 1.0f / 1024.0f, QA_SCALE, (const float*)(ws + WS_ROPE_M)};
          GEMM_RUN(epi::EpiUp, g, S, E); }
        __syncthreads();
        { pg8::Gemm g{(const bf16_t*)(ws + WS_CKV), (const bf16_t*)(ws + WS_WUKV), M, 4096, 512, 512}; pg8::StaticOrder S; S.init(M, 4096, F.G, (int)blockIdx.x);
          epi::EpiUp E{(bf16_t*)(ws + WS_KN), (bf16_t*)(ws + WS_VA), 8, 2048, 2048, (const u64*)(F.ctl + CW_SSQ_CKV), 1.0f / 512.0f, 1.0f, nullptr};
          GEMM_RUN(epi::EpiUp, g, S, E); }
        __syncthreads();
        p2_indexer(F);
    }
    SEAM(2);
    if (IN(3)) { PHASE_BEGIN(); p3_attention(F); }
    SEAM(3);
    if (IN(4)) { PHASE_BEGIN();
        pg8::Gemm g{(const bf16_t*)(ws + WS_OAB), (const bf16_t*)(ws + WS_WBR), M, 4096, 4096, 2048}; pg8::StaticOrder2 S; S.init(M, 4096, F.G, (int)blockIdx.x);
        epi::EpiBranch E{(const bf16_t*)(ws + WS_GA), (const bf16_t*)(ws + WS_GB), (bf16_t*)(ws + WS_MRG)};
        GEMM_RUN2(epi::EpiBranch, g, S, E);
    }
    SEAM(4);
    if (IN(5)) { PHASE_BEGIN();
        pg8::Gemm g{(const bf16_t*)(ws + WS_MRG), (const bf16_t*)(ws + WS_WOUT), M, 4096, 4096, 4096}; pg8::StaticOrder S; S.init(M, 4096, F.G, (int)blockIdx.x);
        epi::EpiOut E{F.in(0), F.in(1), (float*)(ws + WS_H1F), (bf16_t*)(ws + WS_H1B), (u64*)(F.ctl + CW_SSQ_H1)};
        GEMM_RUN(epi::EpiOut, g, S, E);
    }
    SEAM(5);
    if (IN(6)) { PHASE_BEGIN();
        pg8::Gemm g{(const bf16_t*)(ws + WS_H1B), (const bf16_t*)(ws + WS_WQ), M, 2048, 4096, 4096}; pg8::StaticOrder S; S.init(M, 2048, F.G, (int)blockIdx.x);
        epi::EpiPQ E{(bf16_t*)(ws + WS_PQ), (const u64*)(F.ctl + CW_SSQ_H1)};
        GEMM_RUN(epi::EpiPQ, g, S, E);
        p6_tables(F);
    }
    SEAM(6);
    if (IN(7)) { PHASE_BEGIN(); p7_routing(F); }
    SEAM(7);
    if (IN(8)) { PHASE_BEGIN(); p8_experts(F); }
#undef IN
#undef SEAM
}

extern "C" void kernel_launch(void* const* d_in, const int* in_sizes, int n_in, void* d_out, int out_size, void* d_ws, size_t ws_size, hipStream_t stream) {
    static int grid = 0;
    if (grid == 0) {
        if (n_in != 16 || in_sizes[0] != NB * SEQ * DM || out_size != NB * SEQ * DM || ws_size < WS_END) {
            fprintf(stderr, "kernel_launch: unexpected problem shape (n_in %d, in0 %d, out %d, ws %zu < %zu); nothing launched\n", n_in, n_in > 0 ? in_sizes[0] : -1, out_size, ws_size, (size_t)WS_END); grid = -1; return; }
        int dev = 0, cus = 0, per_cu = 0;
        if (hipGetDevice(&dev) != hipSuccess || hipDeviceGetAttribute(&cus, hipDeviceAttributeMultiprocessorCount, dev) != hipSuccess) { grid = -1; return; }
        if (hipFuncSetAttribute((const void*)mk_fwd, hipFuncAttributeMaxDynamicSharedMemorySize, LDS_BYTES) != hipSuccess) { fprintf(stderr, "kernel_launch: hipFuncSetAttribute failed\n"); grid = -1; return; }
        if (hipOccupancyMaxActiveBlocksPerMultiprocessor(&per_cu, (const void*)mk_fwd, NWAVES * 64, LDS_BYTES) != hipSuccess || per_cu < 1) {
            fprintf(stderr, "kernel_launch: occupancy query reports %d workgroups per CU\n", per_cu); }
        (void)hipGetLastError();
        grid = cus;
    }
    if (grid < 0) return;
    if (hipMemsetAsync((char*)d_ws + WS_CTL, 0, CTL_ZERO_BYTES, stream) != hipSuccess) return;
    Args a{};
    for (int i = 0; i < 16; ++i) a.in[i] = (const float*)d_in[i];
    a.out = (float*)d_out; a.ws = (unsigned char*)d_ws;
#if MK_PER_PHASE
    for (int p = 0; p <= MK_LAST_PHASE; ++p) { a.ph_lo = p; a.ph_hi = p + 1; hipLaunchKernelGGL(mk_fwd, dim3(grid), dim3(NWAVES * 64), LDS_BYTES, stream, a); }
#else
    a.ph_lo = 0; a.ph_hi = MK_LAST_PHASE + 1;
    hipLaunchKernelGGL(mk_fwd, dim3(grid), dim3(NWAVES * 64), LDS_BYTES, stream, a);
#endif
}
```

```cpp
#include <hip/hip_runtime.h>
#include <cstdio>
#include <cstdint>

#define LAS __attribute__((address_space(3)))
#define GAS __attribute__((address_space(1)))
typedef unsigned short bf16_t;
typedef short bf16x8 __attribute__((ext_vector_type(8)));
typedef short s16x4 __attribute__((ext_vector_type(4)));
typedef float f32x2 __attribute__((ext_vector_type(2)));
typedef float f32x4 __attribute__((ext_vector_type(4)));
typedef float f32x16 __attribute__((ext_vector_type(16)));
typedef unsigned u32x2 __attribute__((ext_vector_type(2)));
typedef unsigned u32x4 __attribute__((ext_vector_type(4)));
typedef GAS unsigned gu32;

#ifndef MK_PER_PHASE
#define MK_PER_PHASE 0
#endif
#ifndef MK_LAST_PHASE
#define MK_LAST_PHASE 8
#endif

constexpr int NB = 4, SEQ = 4096, DM = 4096, NMETA = 16, TR = SEQ + NMETA  , TP = 4224  , M = NB * TP  ;
constexpr float EPS = 1e-6f;
constexpr int NV1 = 14080;
constexpr float LOG2E = 1.4426950408889634f;
constexpr float QB_SCALE = 0.08838834764831845f * LOG2E;
constexpr float QA_SCALE = 0.07216878364870323f * LOG2E;
constexpr int NWAVES = 8;
constexpr int MW = 132;

constexpr size_t HM = 512u * 1024u;
constexpr size_t WS_CTL = 0, CTL_ZERO_BYTES = 2 * HM;
constexpr size_t WS_ROPE_M = 2 * HM;
constexpr size_t WS_ROPE_D = 5 * HM;
constexpr size_t WS_ROPE_I = 7 * HM;
constexpr size_t WS_SK   = 8 * HM;
constexpr size_t WS_WUQ  = 10 * HM;
constexpr size_t WS_WUKV = 22 * HM;
constexpr size_t WS_WBR  = 30 * HM;
constexpr size_t WS_WOUT = 94 * HM;
constexpr size_t WS_WQ   = 158 * HM;
constexpr size_t WS_EID  = 190 * HM;
constexpr size_t WS_GATE = 207 * HM;
constexpr size_t WS_MASK = 224 * HM;
constexpr size_t WS_KPE  = 242 * HM;
constexpr size_t WS_KIX  = 247 * HM;
constexpr size_t WS_WIX  = 252 * HM;
constexpr size_t R23 = 260 * HM;
constexpr size_t WS_XN   = R23;
constexpr size_t WS_WIN  = R23 + 264 * HM;
constexpr size_t P1O = R23 + 484 * HM;
constexpr size_t WS_CQ   = P1O;
constexpr size_t WS_CKV  = P1O + 66 * HM;
constexpr size_t WS_QB   = P1O + 99 * HM;
constexpr size_t WS_KB   = P1O + 231 * HM;
constexpr size_t WS_VB   = P1O + 264 * HM;
constexpr size_t WS_QIX  = P1O + 297 * HM;
constexpr size_t WS_GA   = P1O + 363 * HM;
constexpr size_t WS_GB   = P1O + 627 * HM;
constexpr size_t R4 = P1O + 892 * HM;
constexpr size_t WS_OAB  = R4;
constexpr size_t WS_PQ   = R4;
constexpr size_t WS_END  = R4 + 264 * HM;
constexpr size_t WS_QN   = R23;
constexpr size_t WS_QR   = R23 + 132 * HM;
constexpr size_t WS_KN   = R23 + 198 * HM;
constexpr size_t WS_VA   = R23 + 330 * HM;
constexpr size_t WS_MRG  = R23;
constexpr size_t WS_U    = R23;
constexpr size_t WS_V    = R23 + 256 * HM;
constexpr size_t WS_H1F  = R23 + 512 * HM;
constexpr size_t WS_H1B  = R23 + 1040 * HM;
static_assert(WS_VA + 132 * HM <= P1O && WS_H1F >= P1O && WS_H1B + 264 * HM <= R4 && WS_GB + 264 * HM <= R4, "ws map");
constexpr int CW_TMO = 0;
constexpr int CW_BAR = 4096;
constexpr int CW_QUEUE = 8192;
constexpr int CW_SSQ_CQ = 16384, CW_SSQ_CKV = 16384 + 2 * 17408, CW_SSQ_H1 = 16384 + 4 * 17408;
static_assert((CW_SSQ_H1 + 2 * 17408) * 4 <= (int)CTL_ZERO_BYTES, "ctl");

constexpr int RING_BYTES = 131072;
constexpr int LDSCTL_OFF = RING_BYTES;
constexpr int LDS_BYTES = 147456;

__device__ __forceinline__ unsigned f2bf(float f) { unsigned u = __float_as_uint(f); return (u + 0x7fffu + ((u >> 16) & 1u)) >> 16; }
__device__ __forceinline__ unsigned pk2(float lo, float hi) { return f2bf(lo) | (f2bf(hi) << 16); }
typedef __bf16 bf16x2_t __attribute__((ext_vector_type(2)));
__device__ __forceinline__ unsigned cvt_pk_bf16(float lo, float hi) { return __builtin_bit_cast(unsigned, __builtin_convertvector((f32x2){lo, hi}, bf16x2_t)); }
__device__ __forceinline__ float bf_lo(unsigned w) { return __uint_as_float(w << 16); }
__device__ __forceinline__ float bf_hi(unsigned w) { return __uint_as_float(w & 0xffff0000u); }
__device__ __forceinline__ u32x4 pack8(f32x4 a, f32x4 b) { u32x4 w; w.x = cvt_pk_bf16(a[0], a[1]); w.y = cvt_pk_bf16(a[2], a[3]); w.z = cvt_pk_bf16(b[0], b[1]); w.w = cvt_pk_bf16(b[2], b[3]); return w; }
__device__ __forceinline__ float wave_sum(float v) {
#pragma unroll
    for (int o = 1; o < 64; o <<= 1) v += __shfl_xor(v, o);
    return v;
}
#define LDS_WAIT() asm volatile("s_waitcnt lgkmcnt(0)" ::: "memory")
#define VM_WAIT() asm volatile("s_waitcnt vmcnt(0)" ::: "memory")
typedef unsigned long long u64;
__device__ __forceinline__ void ssq_add(u64* p, float v) { (void)__hip_atomic_fetch_add(p, (u64)(v * 16777216.0f), __ATOMIC_RELAXED, __HIP_MEMORY_SCOPE_AGENT); }
__device__ __forceinline__ float ssq_get(const u64* p) { return (float)((double)(*p) * (1.0 / 16777216.0)); }
namespace pg8 {
#define PG8_LAS __attribute__((address_space(3)))
typedef unsigned short bf16_t;
typedef short bf16x8 __attribute__((ext_vector_type(8)));
typedef float f32x4 __attribute__((ext_vector_type(4)));
typedef unsigned u32x4 __attribute__((ext_vector_type(4)));
constexpr int BM = 256, BK = 64, HALF = 128, HTB = HALF * BK * 2  , STAGE_BYTES = 8 * HTB, NXCD = 8, WGM = 8;

__host__ __device__ __forceinline__ int lds_byte(int r, int c) { const int st = (r >> 4) * 2 + (c >> 5), rr = r & 15, cc = c & 31, ob = rr * 64 + cc * 2; return st * 1024 + (ob ^ (((ob >> 9) & 1) << 5)); }
__host__ __device__ __forceinline__ void stage_rc(int b, int& R, int& C) { const int st = b / 1024, sb = b % 1024, swz = sb ^ (((sb >> 9) & 1) << 5); R = (st >> 1) * 16 + swz / 64; C = (st & 1) * 32 + (swz % 64) / 2; }
__host__ __device__ __forceinline__ int perm32(int rho) { const int n = rho >> 4, i = rho & 15; return 8 * (i >> 2) + 4 * n + (i & 3); }

struct Unit { int pm, pn, kh; };
struct Gemm { const bf16_t* A; const bf16_t* Bt; int M, N, K, KL; };

struct StaticOrder {
    int nM, nN, nwg, G, c;
    __host__ __device__ void init(int M, int N, int G_, int c_) { nM = M / BM; nN = N / BM; nwg = nM * nN; G = G_; c = c_; }
    __host__ __device__ bool next(int i, Unit& u) const {
        const long L = (long)i * G + c; if (L >= nwg) return false;
        int wgid = (int)L; { const int q = nwg / NXCD, r = nwg % NXCD, xcd = wgid % NXCD, off = wgid / NXCD; wgid = (xcd < r ? xcd * (q + 1) : r * (q + 1) + (xcd - r) * q) + off; }
        const int nig = WGM * nN, gid = wgid / nig, fm = gid * WGM, gsz = (nM - fm) < WGM ? (nM - fm) : WGM;
        u.pm = fm + ((wgid % nig) % gsz); u.pn = (wgid % nig) / gsz; u.kh = 0; return true;
    }
    __device__ __forceinline__ void a_ready(const Unit&) const {}
    __device__ __forceinline__ void done(const Unit&) const {}
};

struct StaticOrder2 {
    StaticOrder base;
    __host__ __device__ void init(int M, int N, int G_, int c_) { base.init(M, N, G_, c_); }
    __host__ __device__ bool next(int i, Unit& u) const { if (!base.next(i >> 1, u)) return false; u.kh = i & 1; return true; }
    __device__ __forceinline__ void a_ready(const Unit&) const {}
    __device__ __forceinline__ void done(const Unit&) const {}
};

template <class Epi, class Sched, bool ALIGN_EPI = false, bool SP2 = false>
__device__ __forceinline__ void gemm_phase(PG8_LAS unsigned char* lds, const Gemm g, const Sched& S, const Epi& E) {
    const int tid = threadIdx.x, wid = __builtin_amdgcn_readfirstlane(tid >> 6), lane = tid & 63, wr = wid >> 2, wc = wid & 3, fr = lane & 15, fq = lane >> 4;
    const int K = g.K, nt = g.KL / BK; const size_t khoff = (size_t)g.KL * 2;
    unsigned voffA[2], voffB[2];
#pragma unroll
    for (int i = 0; i < 2; ++i) { int R, C; stage_rc(tid * 16 + i * 8192, R, C); const int Rb = Epi::PERM ? ((R & ~31) + perm32(R & 31)) : R;
        voffA[i] = (unsigned)(R * K + C) * 2u; voffB[i] = (unsigned)(Rb * K + C) * 2u; }
    const size_t kstep = (size_t)(BK * 2);
    const size_t hstep = (size_t)HALF * K * 2;
    const size_t tstep = 2 * hstep;
    const unsigned ldsw = (unsigned)wid * 1024u;
    const int aoff = lds_byte(wr * 64 + fr, fq * 8), boff = lds_byte(wc * 32 + fr, fq * 8);
#define PG8_SA(b, h) (((b) * 2 + (h)) * HTB)
#define PG8_SB(b, h) ((4 + (b) * 2 + (h)) * HTB)
#define PG8_STAGE(bufoff, gbase, voff) do { _Pragma("unroll") for (int _i = 0; _i < 2; ++_i) \
        __builtin_amdgcn_global_load_lds((const unsigned*)((const char*)(gbase) + (voff)[_i]), (PG8_LAS unsigned*)(lds + (bufoff) + ldsw + _i * 8192), 16, 0, 0); } while (0)
#define PG8_LDA(dst, b, h) do { _Pragma("unroll") for (int m = 0; m < 4; ++m) _Pragma("unroll") for (int k = 0; k < 2; ++k) dst[m][k] = *(const PG8_LAS bf16x8*)(lds + PG8_SA(b, h) + aoff + m * 2048 + k * 1024); } while (0)
#define PG8_LDB(dst, b, h) do { _Pragma("unroll") for (int n = 0; n < 2; ++n) _Pragma("unroll") for (int k = 0; k < 2; ++k) dst[n][k] = *(const PG8_LAS bf16x8*)(lds + PG8_SB(b, h) + boff + n * 2048 + k * 1024); } while (0)
#define PG8_MMA(ai, bj, At, Bt) do { __builtin_amdgcn_s_setprio(1); _Pragma("unroll") for (int m = 0; m < 4; ++m) _Pragma("unroll") for (int n = 0; n < 2; ++n) _Pragma("unroll") for (int k = 0; k < 2; ++k) \
        acc[ai][bj][m][n] = __builtin_amdgcn_mfma_f32_16x16x32_bf16(Bt[n][k], At[m][k], acc[ai][bj][m][n], 0, 0, 0); __builtin_amdgcn_s_setprio(0); } while (0)
#define PG8_WAIT_V(n) asm volatile("s_waitcnt vmcnt(" #n ")" ::: "memory")
#define PG8_WAIT_L(n) asm volatile("s_waitcnt lgkmcnt(" #n ")" ::: "memory")
#define PG8_BAR __builtin_amdgcn_s_barrier()
#define PG8_SCHED __builtin_amdgcn_sched_barrier(0)
    Unit cur, nxt; int ui = 0;
    if (!S.next(0, cur)) return;
    f32x4 acc[2][2][4][2];
#pragma unroll
    for (int a = 0; a < 2; ++a)
#pragma unroll
        for (int b = 0; b < 2; ++b)
#pragma unroll
            for (int m = 0; m < 4; ++m)
#pragma unroll
                for (int n = 0; n < 2; ++n) acc[a][b][m][n] = (f32x4){0.f, 0.f, 0.f, 0.f};
    bf16x8 At[4][2], B0[2][2], B1[2][2];
    const char* cA = (const char*)g.A + (size_t)cur.pm * tstep + (size_t)cur.kh * khoff; const char* cB = (const char*)g.Bt + (size_t)cur.pn * tstep + (size_t)cur.kh * khoff;
    S.a_ready(cur);
    if constexpr (SP2) {
        PG8_STAGE(PG8_SB(0, 0), cB, voffB); PG8_STAGE(PG8_SB(0, 1), cB + hstep, voffB); PG8_STAGE(PG8_SA(0, 0), cA, voffA); PG8_STAGE(PG8_SA(0, 1), cA + hstep, voffA);
        if (wr == 1) PG8_BAR;
        PG8_WAIT_V(2); PG8_BAR;
        PG8_STAGE(PG8_SB(1, 0), cB + kstep, voffB); PG8_STAGE(PG8_SA(1, 0), cA + kstep, voffA); PG8_STAGE(PG8_SB(1, 1), cB + hstep + kstep, voffB);
        PG8_WAIT_V(6); PG8_BAR;
    } else {
        PG8_STAGE(PG8_SB(0, 0), cB, voffB); PG8_STAGE(PG8_SA(0, 0), cA, voffA); PG8_STAGE(PG8_SB(0, 1), cB + hstep, voffB); PG8_STAGE(PG8_SA(0, 1), cA + hstep, voffA);
        if (wr == 1) PG8_BAR;
        PG8_WAIT_V(4); PG8_BAR;
        PG8_STAGE(PG8_SB(1, 0), cB + kstep, voffB); PG8_STAGE(PG8_SA(1, 0), cA + kstep, voffA); PG8_STAGE(PG8_SB(1, 1), cB + hstep + kstep, voffB);
        PG8_WAIT_V(6); PG8_BAR;
    }
    for (;;) {
        const bool has_next = S.next(ui + 1, nxt);
        const char* nA = has_next ? (const char*)g.A + (size_t)nxt.pm * tstep + (size_t)nxt.kh * khoff : cA; const char* nB = has_next ? (const char*)g.Bt + (size_t)nxt.pn * tstep + (size_t)nxt.kh * khoff : cB;
        for (int t = 0; t < nt; t += 2) {
            const bool last = (t == nt - 2);
            const char* a1 = cA + (size_t)(t + 1) * kstep;
            const char* a2 = last ? nA : cA + (size_t)(t + 2) * kstep; const char* b2 = last ? nB : cB + (size_t)(t + 2) * kstep;
            const char* a3 = a2 + kstep; const char* b3 = b2 + kstep;
            if (last && has_next) S.a_ready(nxt);
            if constexpr (SP2) {
            PG8_LDB(B0, 0, 0); PG8_LDB(B1, 0, 1); PG8_SCHED; PG8_LDA(At, 0, 0); PG8_STAGE(PG8_SA(1, 1), a1 + hstep, voffA);
            PG8_WAIT_V(8); PG8_WAIT_L(0); PG8_BAR; PG8_MMA(0, 0, At, B0); PG8_MMA(0, 1, At, B1); PG8_BAR; PG8_SCHED;
            PG8_LDA(At, 0, 1); PG8_STAGE(PG8_SB(0, 0), b2, voffB); PG8_STAGE(PG8_SB(0, 1), b2 + hstep, voffB); PG8_STAGE(PG8_SA(0, 0), a2, voffA);
            PG8_WAIT_V(8); PG8_WAIT_L(0); PG8_BAR; PG8_MMA(1, 0, At, B0); PG8_MMA(1, 1, At, B1); PG8_BAR; PG8_SCHED;
            PG8_LDB(B0, 1, 0); PG8_LDB(B1, 1, 1); PG8_SCHED; PG8_LDA(At, 1, 0); PG8_STAGE(PG8_SA(0, 1), a2 + hstep, voffA);
            PG8_WAIT_V(8); PG8_WAIT_L(0); PG8_BAR; PG8_MMA(0, 0, At, B0); PG8_MMA(0, 1, At, B1); PG8_BAR; PG8_SCHED;
            PG8_LDA(At, 1, 1); PG8_STAGE(PG8_SB(1, 0), b3, voffB); PG8_STAGE(PG8_SB(1, 1), b3 + hstep, voffB); PG8_STAGE(PG8_SA(1, 0), a3, voffA);
            PG8_WAIT_V(8); PG8_WAIT_L(0); PG8_BAR; PG8_MMA(1, 0, At, B0); PG8_MMA(1, 1, At, B1); PG8_BAR; PG8_SCHED;
            } else {
            PG8_LDB(B0, 0, 0); PG8_SCHED; PG8_LDA(At, 0, 0); PG8_STAGE(PG8_SA(1, 1), a1 + hstep, voffA);
            PG8_WAIT_L(8); PG8_BAR; PG8_WAIT_L(0); PG8_MMA(0, 0, At, B0); PG8_BAR; PG8_SCHED;
            PG8_LDB(B1, 0, 1); PG8_STAGE(PG8_SB(0, 0), b2, voffB);
            PG8_BAR; PG8_WAIT_L(0); PG8_MMA(0, 1, At, B1); PG8_BAR;
            PG8_LDA(At, 0, 1); PG8_STAGE(PG8_SA(0, 0), a2, voffA);
            PG8_BAR; PG8_WAIT_L(0); PG8_MMA(1, 0, At, B0); PG8_BAR; PG8_SCHED;
            PG8_STAGE(PG8_SB(0, 1), b2 + hstep, voffB);
            PG8_WAIT_V(6); PG8_BAR; PG8_MMA(1, 1, At, B1); PG8_BAR;
            PG8_LDB(B0, 1, 0); PG8_SCHED; PG8_LDA(At, 1, 0); PG8_STAGE(PG8_SA(0, 1), a2 + hstep, voffA);
            PG8_WAIT_L(8); PG8_BAR; PG8_WAIT_L(0); PG8_MMA(0, 0, At, B0); PG8_BAR; PG8_SCHED;
            PG8_LDB(B1, 1, 1); PG8_STAGE(PG8_SB(1, 0), b3, voffB);
            PG8_BAR; PG8_WAIT_L(0); PG8_MMA(0, 1, At, B1); PG8_BAR;
            PG8_LDA(At, 1, 1); PG8_STAGE(PG8_SA(1, 0), a3, voffA);
            PG8_BAR; PG8_WAIT_L(0); PG8_MMA(1, 0, At, B0); PG8_BAR; PG8_SCHED;
            PG8_STAGE(PG8_SB(1, 1), b3 + hstep, voffB);
            PG8_WAIT_V(6); PG8_BAR; PG8_MMA(1, 1, At, B1); PG8_BAR;
            }
        }
        if constexpr (ALIGN_EPI) { if (wr == 0) PG8_BAR; }
        if constexpr (!Epi::AFTER_DRAIN) { E(acc, cur, wr, wc, fr, fq); S.done(cur); }
        if (!has_next) break;
        if (!(Epi::SPLITK2 && cur.kh == 0))
#pragma unroll
        for (int a = 0; a < 2; ++a)
#pragma unroll
            for (int b = 0; b < 2; ++b)
#pragma unroll
                for (int m = 0; m < 4; ++m)
#pragma unroll
                    for (int n = 0; n < 2; ++n) acc[a][b][m][n] = (f32x4){0.f, 0.f, 0.f, 0.f};
        cur = nxt; cA = nA; cB = nB; ++ui;
        if constexpr (ALIGN_EPI) { if (wr == 1) PG8_BAR; }
    }
    PG8_WAIT_V(0);
    if constexpr (!ALIGN_EPI) { if (wr == 0) PG8_BAR; }
    PG8_BAR;
    if constexpr (Epi::AFTER_DRAIN) { E.fused(acc, cur, wr, wc, fr, fq, lds, wid, lane); S.done(cur); }
#undef PG8_SA
#undef PG8_SB
#undef PG8_STAGE
#undef PG8_LDA
#undef PG8_LDB
#undef PG8_MMA
#undef PG8_WAIT_V
#undef PG8_WAIT_L
#undef PG8_BAR
#undef PG8_SCHED
}
}
namespace epi {
using pg8::Unit;
typedef f32x4 Acc[2][2][4][2];

__device__ __forceinline__ void rot2(f32x4& v, const f32x4 cs) {
    const float a1 = v[0] * cs[0] - v[1] * cs[1], a2 = v[1] * cs[0] + v[0] * cs[1];
    const float b1 = v[2] * cs[2] - v[3] * cs[3], b2 = v[3] * cs[2] + v[2] * cs[3];
    v = (f32x4){a1, a2, b1, b2};
}
__device__ __forceinline__ float sigm(float x) { return 1.0f / (1.0f + __expf(-x)); }

struct EpiIn {
    static constexpr bool PERM = true, AFTER_DRAIN = false, SPLITK2 = false;
    bf16_t *cq, *ckv, *qb, *kb, *vb, *qix, *kpe, *kix, *ga, *gb; float* wix; u64 *ssq_cq, *ssq_ckv;
    const float *ropeM, *ropeD, *ropeI;
    __device__ __forceinline__ void operator()(const Acc& acc, const Unit& u, int wr, int wc, int fr, int fq) const {
        const int vt = u.pn, rowb = u.pm * 256 + wr * 64 + fr, ct = wc * 32 + 8 * fq;
        if (vt < 6) {
            bf16_t* dst = vt < 4 ? cq : ckv; const int ld = vt < 4 ? 1024 : 512, cb = (vt < 4 ? vt : vt - 4) * 256 + ct; u64* ssq = vt < 4 ? ssq_cq : ssq_ckv;
#pragma unroll
            for (int ai = 0; ai < 2; ++ai)
#pragma unroll
                for (int m = 0; m < 4; ++m) { const int row = rowb + ai * 128 + m * 16; float s = 0.f;
#pragma unroll
                    for (int bj = 0; bj < 2; ++bj) { const f32x4 v0 = acc[ai][bj][m][0], v1 = acc[ai][bj][m][1];
                        s += (v0[0] * v0[0] + v0[1] * v0[1]) + (v0[2] * v0[2] + v0[3] * v0[3]) + (v1[0] * v1[0] + v1[1] * v1[1]) + (v1[2] * v1[2] + v1[3] * v1[3]);
                        *(u32x4*)(dst + (size_t)row * ld + cb + bj * 128) = pack8(v0, v1); }
                    s += __shfl_xor(s, 16); s += __shfl_xor(s, 32);
                    if (fq == 0) ssq_add(ssq + row, s); }
        } else if (vt < 16) {
            const bool isq = vt < 14; bf16_t* dst = isq ? qb : kb; const int ld = isq ? 2048 : 512, cb = (isq ? vt - 6 : vt - 14) * 256 + ct; const float sc = isq ? QB_SCALE : 1.f;
#pragma unroll
            for (int ai = 0; ai < 2; ++ai)
#pragma unroll
                for (int m = 0; m < 4; ++m) { const int row = rowb + ai * 128 + m * 16, t = row % TP;
                    f32x4 cs0 = (f32x4){1.f, 0.f, 1.f, 0.f}, cs1 = cs0;
                    if (wc == 0) { const f32x4* p = (const f32x4*)(ropeD + ((size_t)t * 16 + 4 * fq) * 2); cs0 = p[0]; cs1 = p[1]; }
#pragma unroll
                    for (int bj = 0; bj < 2; ++bj) { f32x4 v0 = acc[ai][bj][m][0], v1 = acc[ai][bj][m][1];
                        if (wc == 0) { rot2(v0, cs0); rot2(v1, cs1); }
                        v0 = v0 * sc; v1 = v1 * sc;
                        *(u32x4*)(dst + (size_t)row * ld + cb + bj * 128) = pack8(v0, v1); } }
        } else if (vt < 18) {
            const int cb = (vt - 16) * 256 + ct;
#pragma unroll
            for (int ai = 0; ai < 2; ++ai)
#pragma unroll
                for (int m = 0; m < 4; ++m) { const int row = rowb + ai * 128 + m * 16;
#pragma unroll
                    for (int bj = 0; bj < 2; ++bj) *(u32x4*)(vb + (size_t)row * 512 + cb + bj * 128) = pack8(acc[ai][bj][m][0], acc[ai][bj][m][1]); }
        } else if (vt < 22) {
            const int cb = (vt - 18) * 256 + ct; const bool rt = ((wc & 1) == 0) && (fq < 2);
#pragma unroll
            for (int ai = 0; ai < 2; ++ai)
#pragma unroll
                for (int m = 0; m < 4; ++m) { const int row = rowb + ai * 128 + m * 16, t = row % TP;
                    f32x4 cs0 = (f32x4){1.f, 0.f, 1.f, 0.f}, cs1 = cs0;
                    if (rt) { const f32x4* p = (const f32x4*)(ropeI + ((size_t)t * 8 + 4 * fq) * 2); cs0 = p[0]; cs1 = p[1]; }
#pragma unroll
                    for (int bj = 0; bj < 2; ++bj) { f32x4 v0 = acc[ai][bj][m][0], v1 = acc[ai][bj][m][1];
                        if (rt) { rot2(v0, cs0); rot2(v1, cs1); }
                        *(u32x4*)(qix + (size_t)row * 1024 + cb + bj * 128) = pack8(v0, v1); } }
        } else if (vt == 22) {
#pragma unroll
            for (int ai = 0; ai < 2; ++ai)
#pragma unroll
                for (int m = 0; m < 4; ++m) { const int row = rowb + ai * 128 + m * 16, t = row % TP;
                    f32x4 v0 = acc[ai][0][m][0], v1 = acc[ai][0][m][1];
                    if (wc < 2) { const f32x4* p = (const f32x4*)(ropeM + ((size_t)t * 32 + 16 * wc + 4 * fq) * 2); rot2(v0, p[0]); rot2(v1, p[1]);
                        *(u32x4*)(kpe + (size_t)row * 64 + ct) = pack8(v0, v1);
                    } else { if (wc == 2 && fq < 2) { const f32x4* p = (const f32x4*)(ropeI + ((size_t)t * 8 + 4 * fq) * 2); rot2(v0, p[0]); rot2(v1, p[1]); }
                        *(u32x4*)(kix + (size_t)row * 64 + (ct - 64)) = pack8(v0, v1); }
                    if (wc == 0 && fq < 2) { float* w = wix + (size_t)row * 16 + 8 * fq; *(f32x4*)w = acc[ai][1][m][0]; *(f32x4*)(w + 4) = acc[ai][1][m][1]; } }
        } else {
            const bool isa = vt < 39; bf16_t* dst = isa ? ga : gb; const int cb = (isa ? vt - 23 : vt - 39) * 256 + ct;
#pragma unroll
            for (int ai = 0; ai < 2; ++ai)
#pragma unroll
                for (int m = 0; m < 4; ++m) { const int row = rowb + ai * 128 + m * 16;
#pragma unroll
                    for (int bj = 0; bj < 2; ++bj) { f32x4 v0 = acc[ai][bj][m][0], v1 = acc[ai][bj][m][1];
#pragma unroll
                        for (int e = 0; e < 4; ++e) { v0[e] = sigm(v0[e]); v1[e] = sigm(v1[e]); }
                        *(u32x4*)(dst + (size_t)row * 4096 + cb + bj * 128) = pack8(v0, v1); } }
        }
    }
};

struct EpiUp {
    static constexpr bool PERM = true, AFTER_DRAIN = false, SPLITK2 = false;
    bf16_t *d0, *d1; int nt0, ld0, ld1; const u64* ssq; float invK, scale; const float* rope;
    __device__ __forceinline__ void operator()(const Acc& acc, const Unit& u, int wr, int wc, int fr, int fq) const {
        const int vt = u.pn, rowb = u.pm * 256 + wr * 64 + fr, ct = wc * 32 + 8 * fq; const bool first = vt < nt0;
        bf16_t* dst = first ? d0 : d1; const int ld = first ? ld0 : ld1, cb = (first ? vt : vt - nt0) * 256 + ct; const bool rt = (!first) && (rope != nullptr);
#pragma unroll
        for (int ai = 0; ai < 2; ++ai)
#pragma unroll
            for (int m = 0; m < 4; ++m) { const int row = rowb + ai * 128 + m * 16, t = row % TP;
                const float rs = __builtin_amdgcn_rsqf(ssq_get(ssq + row) * invK + EPS) * scale;
                f32x4 cs0 = (f32x4){1.f, 0.f, 1.f, 0.f}, cs1 = cs0;
                if (rt) { const f32x4* p = (const f32x4*)(rope + ((size_t)t * 32 + 16 * (wc & 1) + 4 * fq) * 2); cs0 = p[0]; cs1 = p[1]; }
#pragma unroll
                for (int bj = 0; bj < 2; ++bj) { f32x4 v0 = acc[ai][bj][m][0] * rs, v1 = acc[ai][bj][m][1] * rs;
                    if (rt) { rot2(v0, cs0); rot2(v1, cs1); }
                    *(u32x4*)(dst + (size_t)row * ld + cb + bj * 128) = pack8(v0, v1); } }
    }
};

struct EpiBranch {
    static constexpr bool PERM = true, AFTER_DRAIN = false, SPLITK2 = true;
    const bf16_t *ga, *gb; bf16_t* out;
    __device__ __forceinline__ void operator()(Acc& acc, const Unit& u, int wr, int wc, int fr, int fq) const {
        const int rowb = u.pm * 256 + wr * 64 + fr, cb = u.pn * 256 + wc * 32 + 8 * fq;
        if (u.kh == 0) {
#pragma unroll
            for (int ai = 0; ai < 2; ++ai)
#pragma unroll
                for (int m = 0; m < 4; ++m) { const size_t ro = (size_t)(rowb + ai * 128 + m * 16) * 4096 + cb;
#pragma unroll
                    for (int bj = 0; bj < 2; ++bj) { const u32x4 a = *(const u32x4*)(ga + ro + bj * 128), b = *(const u32x4*)(gb + ro + bj * 128);
                        f32x4 r0, r1;
#define RQ(x, y) ((x) * __builtin_amdgcn_rcpf(y))
                        r0[0] = RQ(bf_lo(a.x), bf_lo(b.x)); r0[1] = RQ(bf_hi(a.x), bf_hi(b.x)); r0[2] = RQ(bf_lo(a.y), bf_lo(b.y)); r0[3] = RQ(bf_hi(a.y), bf_hi(b.y));
                        r1[0] = RQ(bf_lo(a.z), bf_lo(b.z)); r1[1] = RQ(bf_hi(a.z), bf_hi(b.z)); r1[2] = RQ(bf_lo(a.w), bf_lo(b.w)); r1[3] = RQ(bf_hi(a.w), bf_hi(b.w));
#undef RQ
                        acc[ai][bj][m][0] = acc[ai][bj][m][0] * r0; acc[ai][bj][m][1] = acc[ai][bj][m][1] * r1; }
                    asm volatile("" ::: "memory"); }
        } else {
#pragma unroll
            for (int ai = 0; ai < 2; ++ai)
#pragma unroll
                for (int m = 0; m < 4; ++m) { const size_t ro = (size_t)(rowb + ai * 128 + m * 16) * 4096 + cb;
#pragma unroll
                    for (int bj = 0; bj < 2; ++bj) { const u32x4 b = *(const u32x4*)(gb + ro + bj * 128);
                        const f32x4 s0 = (f32x4){bf_lo(b.x), bf_hi(b.x), bf_lo(b.y), bf_hi(b.y)}, s1 = (f32x4){bf_lo(b.z), bf_hi(b.z), bf_lo(b.w), bf_hi(b.w)};
                        *(u32x4*)(out + ro + bj * 128) = pack8(acc[ai][bj][m][0] * s0, acc[ai][bj][m][1] * s1); } }
        }
    }
};

struct EpiOut {
    static constexpr bool PERM = true, AFTER_DRAIN = false, SPLITK2 = false;
    const float *x, *meta; float* h1f; bf16_t* h1b; u64* ssq;
    __device__ __forceinline__ void operator()(const Acc& acc, const Unit& u, int wr, int wc, int fr, int fq) const {
        const int rowb = u.pm * 256 + wr * 64 + fr, cb = u.pn * 256 + wc * 32 + 8 * fq;
#pragma unroll
        for (int ai = 0; ai < 2; ++ai)
#pragma unroll
            for (int m = 0; m < 4; ++m) { const int row = rowb + ai * 128 + m * 16, b = row / TP, t = row % TP;
                const float* src = t < NMETA ? meta + (size_t)t * DM : (t < TR ? x + ((size_t)b * SEQ + (t - NMETA)) * DM : nullptr);
                float s = 0.f;
#pragma unroll
                for (int bj = 0; bj < 2; ++bj) { f32x4 v0 = acc[ai][bj][m][0], v1 = acc[ai][bj][m][1];
                    if (src) { v0 = v0 + *(const f32x4*)(src + cb + bj * 128); v1 = v1 + *(const f32x4*)(src + cb + bj * 128 + 4); }
                    s += (v0[0] * v0[0] + v0[1] * v0[1]) + (v0[2] * v0[2] + v0[3] * v0[3]) + (v1[0] * v1[0] + v1[1] * v1[1]) + (v1[2] * v1[2] + v1[3] * v1[3]);
                    float* o = h1f + (size_t)row * DM + cb + bj * 128; *(f32x4*)o = v0; *(f32x4*)(o + 4) = v1;
                    *(u32x4*)(h1b + (size_t)row * DM + cb + bj * 128) = pack8(v0, v1); }
                s += __shfl_xor(s, 16); s += __shfl_xor(s, 32);
                if (fq == 0) ssq_add(ssq + row, s); }
    }
};

struct EpiPQ {
    static constexpr bool PERM = true, AFTER_DRAIN = false, SPLITK2 = false;
    bf16_t* pq; const u64* ssq;
    __device__ __forceinline__ void operator()(const Acc& acc, const Unit& u, int wr, int wc, int fr, int fq) const {
        const int rowb = u.pm * 256 + wr * 64 + fr, cb = u.pn * 256 + wc * 32 + 8 * fq;
#pragma unroll
        for (int ai = 0; ai < 2; ++ai)
#pragma unroll
            for (int m = 0; m < 4; ++m) { const int row = rowb + ai * 128 + m * 16; const float rs = __builtin_amdgcn_rsqf(ssq_get(ssq + row) * (1.0f / DM) + EPS);
#pragma unroll
                for (int bj = 0; bj < 2; ++bj) *(u32x4*)(pq + (size_t)row * 2048 + cb + bj * 128) = pack8(acc[ai][bj][m][0] * rs, acc[ai][bj][m][1] * rs); }
    }
};
}
#define XB_TMO      128
#define XB_XCNT(j)  (256  + 64 * (j))
#define XB_XSUB(j)  (1280 + 64 * (j))
#define XB_XGEN(j)  (2304 + 64 * (j))
#define XB_TOP      3328
#define XB_TOPGEN   3392
#define XCD_BAR_WORDS 3456
#define XB_SPIN_CAP (1u << 18)
__device__ __forceinline__ unsigned xb_ld(unsigned* p)              { return __hip_atomic_load(p, __ATOMIC_RELAXED, __HIP_MEMORY_SCOPE_AGENT); }
__device__ __forceinline__ unsigned xb_add(unsigned* p, unsigned v) { return __hip_atomic_fetch_add(p, v, __ATOMIC_RELAXED, __HIP_MEMORY_SCOPE_AGENT); }
__device__ __forceinline__ unsigned xb_xcc_id() { return (unsigned)__builtin_amdgcn_s_getreg((3 << 11) | 20) & 0xFu; }
#define XB_SPIN(cond, bar) do { unsigned _sp = 0; while (cond) { __builtin_amdgcn_s_sleep(1); \
    if ((++_sp & 255u) == 0u) { if (xb_ld(&(bar)[XB_TMO])) break; if (_sp > XB_SPIN_CAP) { atomicAdd(&(bar)[XB_TMO], 1u); break; } } } } while (0)
struct XcdBarrier { unsigned* bar; unsigned x; volatile LAS unsigned* st; };
__device__ __forceinline__ XcdBarrier xcd_barrier_post(unsigned* bar, volatile LAS unsigned* st) {
    XcdBarrier b; b.bar = bar; b.x = xb_xcc_id(); b.st = st;
    if (threadIdx.x == 0) (void)xb_add(&bar[XB_XCNT(b.x)], 1u);
    return b;
}
__device__ __forceinline__ void xcd_barrier_complete(unsigned* bar, unsigned x, unsigned& nloc, unsigned& nx) {
    const unsigned G = gridDim.x * gridDim.y * gridDim.z;
    unsigned sum, cnt, mine, sp = 0u;
    for (;;) {
        sum = 0u; cnt = 0u; mine = 0u;
#pragma unroll
        for (unsigned j = 0; j < 16; ++j) { const unsigned c = xb_ld(&bar[XB_XCNT(j)]); sum += c; cnt += (c > 0u) ? 1u : 0u; mine = (j == x) ? c : mine; }
        if (sum == G) break;
        __builtin_amdgcn_s_sleep(1);
        if ((++sp & 255u) == 0u) { if (xb_ld(&bar[XB_TMO])) break; if (sp > XB_SPIN_CAP) { atomicAdd(&bar[XB_TMO], 1u); break; } }
    }
    nloc = mine > 0u ? mine : 1u; nx = cnt > 0u ? cnt : 1u;
}
__device__ __forceinline__ void xcd_barrier(const XcdBarrier& b) {
    asm volatile("s_waitcnt vmcnt(0)" ::: "memory");
    __syncthreads();
    if (threadIdx.x == 0) {
        unsigned* bar = b.bar;
        __builtin_amdgcn_s_waitcnt(0);
        unsigned nloc = b.st[0], nx = b.st[1];
        if (nloc == 0u) { xcd_barrier_complete(bar, b.x, nloc, nx); b.st[0] = nloc; b.st[1] = nx; }
        const unsigned old = xb_add(&bar[XB_XSUB(b.x)], 1u);
        const unsigned gen = old / nloc;
        if (old + 1u == (gen + 1u) * nloc) {
            __builtin_amdgcn_fence(__ATOMIC_RELEASE, "agent");
            asm volatile("s_waitcnt vmcnt(0)" ::: "memory");
            const unsigned og = xb_add(&bar[XB_TOP], 1u);
            const unsigned tg = og / nx;
            if (og + 1u == (tg + 1u) * nx) xb_add(&bar[XB_TOPGEN], 1u);
            else XB_SPIN(xb_ld(&bar[XB_TOPGEN]) == tg, bar);
            __builtin_amdgcn_fence(__ATOMIC_ACQUIRE, "agent");
            xb_add(&bar[XB_XGEN(b.x)], 1u);
            asm volatile("s_waitcnt vmcnt(0)" ::: "memory");
        } else {
            XB_SPIN(xb_ld(&bar[XB_XGEN(b.x)]) == gen, bar);
            __builtin_amdgcn_fence(__ATOMIC_ACQUIRE, "agent");
            asm volatile("s_waitcnt vmcnt(0)" ::: "memory");
        }
    }
    __syncthreads();
}

struct Frame {
    LAS unsigned char* lds;
    unsigned char* ws;
    unsigned* ctl;
    int tid, lane, wave, vcu, G;
    __device__ __forceinline__ const float* in(int i) const { return ((const float* const __attribute__((address_space(4)))*)__builtin_amdgcn_kernarg_segment_ptr())[i]; }
    __device__ __forceinline__ float* out() const { return ((float* const __attribute__((address_space(4)))*)__builtin_amdgcn_kernarg_segment_ptr())[16]; }
};

struct MapId { __device__ __forceinline__ int operator()(int v) const { return v; } };
struct MapIn { __device__ __forceinline__ int operator()(int v) const {
    if (v < 1536) return v;
    if (v < 3584) { const int w = v - 1536, hd = w >> 7; int o = w & 127; if (o < 32) o = (o & 1) ? (o >> 1) + 16 : (o >> 1); return 1600 + hd * 128 + o; }
    if (v < 4096) { const int w = v - 3584, hd = w >> 7; int o = w & 127; if (o < 32) o = (o & 1) ? (o >> 1) + 16 : (o >> 1); return 3648 + hd * 128 + o; }
    if (v < 4608) return 4160 + (v - 4096);
    if (v < 5632) { const int w = v - 4608, hd = w >> 6; int o = w & 63; if (o < 16) o = (o & 1) ? (o >> 1) + 8 : (o >> 1); return 4672 + hd * 64 + o; }
    if (v < 5888) { const int w = v - 5632;
        if (w < 64) return 1536 + ((w & 1) ? (w >> 1) + 32 : (w >> 1));
        if (w < 128) { int o = w - 64; if (o < 16) o = (o & 1) ? (o >> 1) + 8 : (o >> 1); return 5696 + o; }
        if (w < 144) return 5760 + (w - 128);
        return -1; }
    if (v < 9984) return 5776 + (v - 5888);
    return 9872 + (v - 9984);
} };
struct MapUq { __device__ __forceinline__ int operator()(int v) const {
    if (v < 2048) return (v >> 7) * 192 + (v & 127);
    const int w = v - 2048, hd = w >> 6, o = w & 63; return hd * 192 + 128 + ((o & 1) ? (o >> 1) + 32 : (o >> 1)); } };
struct MapUkv { __device__ __forceinline__ int operator()(int v) const {
    if (v < 2048) return (v >> 7) * 256 + (v & 127);
    const int w = v - 2048; return (w >> 7) * 256 + 128 + (w & 127); } };

template <class Map>
__device__ __forceinline__ void p0_transpose_item(const float* W, int K, int Nsrc, int Nvirt, bf16_t* WT, const float* gk, LAS float* scr, int item, int lane, Map map) {
    const int nblk = Nvirt / 32, kb = item / nblk, nb = item % nblk, k0 = 64 * kb, n0 = 32 * nb;
    const int sc = map(n0 + (lane & 31));
#pragma unroll 8
    for (int i = 0; i < 32; ++i) { const int kk = 2 * i + (lane >> 5); float v = 0.f;
        if (sc >= 0) v = W[(size_t)(k0 + kk) * Nsrc + sc];
        if (gk) v *= gk[k0 + kk];
        scr[kk * 33 + (lane & 31)] = v; }
    LDS_WAIT(); asm volatile("" ::: "memory");
    const int c = lane & 7;
#pragma unroll
    for (int j = 0; j < 4; ++j) { const int n = (lane >> 3) + 8 * j; const LAS float* s = scr + (8 * c) * 33 + n;
        u32x4 o; o.x = pk2(s[0 * 33], s[1 * 33]); o.y = pk2(s[2 * 33], s[3 * 33]); o.z = pk2(s[4 * 33], s[5 * 33]); o.w = pk2(s[6 * 33], s[7 * 33]);
        *(u32x4*)(WT + (size_t)(n0 + n) * K + k0 + 8 * c) = o; }
    LDS_WAIT(); asm volatile("" ::: "memory");
}
__device__ __forceinline__ void p0_xn_row(const Frame& F, int m) {
    const int b = m / TP, t = m % TP; const float* x = F.in(0); const float* meta = F.in(1); const float* g = F.in(2);
    bf16_t* o = (bf16_t*)(F.ws + WS_XN) + (size_t)m * DM;
    u32x2* o8 = (u32x2*)o + F.lane;
    if (t >= TR) {
#pragma unroll
        for (int j = 0; j < 16; ++j) o8[64 * j] = (u32x2){0u, 0u};
        return; }
    const float* src = t < NMETA ? meta + (size_t)t * DM : x + ((size_t)b * SEQ + (t - NMETA)) * DM;
    const f32x4* xr = (const f32x4*)src + F.lane; const f32x4* gr = (const f32x4*)g + F.lane;
    f32x4 v[16]; float s = 0.f;
#pragma unroll
    for (int j = 0; j < 16; ++j) { v[j] = xr[64 * j]; s += (v[j][0] * v[j][0] + v[j][1] * v[j][1]) + (v[j][2] * v[j][2] + v[j][3] * v[j][3]); }
    const float rstd = 1.0f / sqrtf(wave_sum(s) * (1.0f / DM) + EPS);
#pragma unroll
    for (int j = 0; j < 16; ++j) { const f32x4 gg = gr[64 * j]; const f32x4 y = v[j] * rstd * gg; o8[64 * j] = (u32x2){pk2(y[0], y[1]), pk2(y[2], y[3])}; }
}
__device__ __forceinline__ void p0_prologue(const Frame& F) {
    LAS float* scr = (LAS float*)(F.lds + F.wave * 16384);
    const int gw = F.vcu * NWAVES + F.wave, NGW = F.G * NWAVES;
    const float* w_in = F.in(3); const float* qg = F.in(4); const float* w_uq = F.in(5); const float* kvg = F.in(6); const float* w_ukv = F.in(7);
    const float* w_br = F.in(8); const float* w_out = F.in(9); const float* fg = F.in(10); const float* w_q = F.in(11); const float* sk = F.in(12);
    constexpr int I_IN = 64 * (NV1 / 32), I_UQ = 16 * (3072 / 32), I_UKV = 8 * (4096 / 32), I_BR = 64 * 128, I_OUT = 64 * 128, I_Q = 64 * 64;
    constexpr int NITEMS = I_IN + I_UQ + I_UKV + I_BR + I_OUT + I_Q;
    for (int it = gw; it < NITEMS; it += NGW) {
        int r = it;
        if (r < I_IN) { p0_transpose_item(w_in, 4096, 13968, NV1, (bf16_t*)(F.ws + WS_WIN), nullptr, scr, r, F.lane, MapIn()); continue; } r -= I_IN;
        if (r < I_UQ) { p0_transpose_item(w_uq, 1024, 3072, 3072, (bf16_t*)(F.ws + WS_WUQ), qg, scr, r, F.lane, MapUq()); continue; } r -= I_UQ;
        if (r < I_UKV) { p0_transpose_item(w_ukv, 512, 4096, 4096, (bf16_t*)(F.ws + WS_WUKV), kvg, scr, r, F.lane, MapUkv()); continue; } r -= I_UKV;
        if (r < I_BR) { p0_transpose_item(w_br, 4096, 4096, 4096, (bf16_t*)(F.ws + WS_WBR), nullptr, scr, r, F.lane, MapId()); continue; } r -= I_BR;
        if (r < I_OUT) { p0_transpose_item(w_out, 4096, 4096, 4096, (bf16_t*)(F.ws + WS_WOUT), nullptr, scr, r, F.lane, MapId()); continue; } r -= I_OUT;
        p0_transpose_item(w_q, 4096, 2048, 2048, (bf16_t*)(F.ws + WS_WQ), fg, scr, r, F.lane, MapId());
    }
    for (int m = gw; m < M; m += NGW) p0_xn_row(F, m);
    const int gt = (F.vcu * NWAVES + F.wave) * 64 + F.lane, NGT = NGW * 64;
    for (int i = gt; i < TP * 56; i += NGT) {
        const int t = i / 56, r = i % 56; int j, rot; float* dst;
        if (r < 32) { j = r; rot = 64; dst = (float*)(F.ws + WS_ROPE_M) + ((size_t)t * 32 + j) * 2; }
        else if (r < 48) { j = r - 32; rot = 32; dst = (float*)(F.ws + WS_ROPE_D) + ((size_t)t * 16 + j) * 2; }
        else { j = r - 48; rot = 16; dst = (float*)(F.ws + WS_ROPE_I) + ((size_t)t * 8 + j) * 2; }
        const float ex = (float)(2 * j) / (float)rot;
        const float inv = powf(500000.0f, -ex);
        const float ang = (float)t * inv;
        const double a = (double)ang, kq = rint(a * 0.15915494309189535), rr = fma(-kq, 6.283185307179586, a);
        const float rf = (float)rr;
        dst[0] = cosf(rf); dst[1] = sinf(rf);
    }
    for (int i = gt; i < 16 * 128 * 128 / 8; i += NGT) { const f32x4* s = (const f32x4*)sk + 2 * (size_t)i; const f32x4 a = s[0], b2 = s[1];
        u32x4 o; o.x = pk2(a[0], a[1]); o.y = pk2(a[2], a[3]); o.z = pk2(b2[0], b2[1]); o.w = pk2(b2[2], b2[3]); ((u32x4*)(F.ws + WS_SK))[i] = o; }
}
__device__ __forceinline__ void p6_tables(const Frame& F) {
    const float* fg = F.in(10); const float* pu = F.in(13); const float* pv = F.in(14);
    const size_t gt = (size_t)(F.vcu * NWAVES + F.wave) * 64 + F.lane, NGT = (size_t)F.G * NWAVES * 64;
    const size_t n8 = (size_t)16384 * 4096 / 8;
    for (size_t i = gt; i < n8; i += NGT) { const f32x4* s = (const f32x4*)pu + 2 * i; const f32x4* gq = (const f32x4*)fg + 2 * (i & 511);
        const f32x4 a = s[0] * gq[0], b2 = s[1] * gq[1];
        u32x4 o; o.x = pk2(a[0], a[1]); o.y = pk2(a[2], a[3]); o.z = pk2(b2[0], b2[1]); o.w = pk2(b2[2], b2[3]); ((u32x4*)(F.ws + WS_U))[i] = o; }
    for (size_t i = gt; i < n8; i += NGT) { const f32x4* s = (const f32x4*)pv + 2 * i; const f32x4 a = s[0], b2 = s[1];
        u32x4 o; o.x = pk2(a[0], a[1]); o.y = pk2(a[2], a[3]); o.z = pk2(b2[0], b2[1]); o.w = pk2(b2[2], b2[3]); ((u32x4*)(F.ws + WS_V))[i] = o; }
}
#define MFMA32(a, b, c) __builtin_amdgcn_mfma_f32_32x32x16_bf16((a), (b), (c), 0, 0, 0)
__device__ __forceinline__ int crow(int i, int h) { return (i & 3) + 8 * (i >> 2) + 4 * h; }
__device__ __forceinline__ float half_sum_f(float v) {
#pragma unroll
    for (int o = 1; o < 32; o <<= 1) v += __shfl_xor(v, o);
    return v;
}
__device__ __forceinline__ int half_sum_i(int v) {
#pragma unroll
    for (int o = 1; o < 32; o <<= 1) v += __shfl_xor(v, o);
    return v;
}
__device__ __forceinline__ float half_max_f(float v) {
#pragma unroll
    for (int o = 1; o < 32; o <<= 1) v = fmaxf(v, __shfl_xor(v, o));
    return v;
}
__device__ __forceinline__ float half_min_f(float v) {
#pragma unroll
    for (int o = 1; o < 32; o <<= 1) v = fminf(v, __shfl_xor(v, o));
    return v;
}
__device__ __forceinline__ void idx_task(const Frame& F, int b, int t0) {
    const int lane = F.lane, r = lane & 31, h = lane >> 5;
    const bf16_t* qix = (const bf16_t*)(F.ws + WS_QIX); const bf16_t* kix = (const bf16_t*)(F.ws + WS_KIX); const float* wix = (const float*)(F.ws + WS_WIX);
    unsigned* mask = (unsigned*)(F.ws + WS_MASK);
    const int tok = (r >> 2) & 1, head = (r & 3) + 4 * (r >> 3);
    const bf16_t* qp = qix + (size_t)(b * TP + t0 + tok) * 1024 + head * 64 + 8 * h;
    bf16x8 af[4];
#pragma unroll
    for (int ks = 0; ks < 4; ++ks) af[ks] = *(const bf16x8*)(qp + 16 * ks);
    const f32x4* wp = (const f32x4*)(wix + (size_t)(b * TP + t0 + h) * 16);
    float w[16];
#pragma unroll
    for (int q = 0; q < 4; ++q) { const f32x4 x = wp[q]; w[4 * q] = x[0]; w[4 * q + 1] = x[1]; w[4 * q + 2] = x[2]; w[4 * q + 3] = x[3]; }
    const int tq = t0 + h;
    const int ngrp = ((t0 + 1) >> 6) + 1;
    const bf16_t* kbase = kix + (size_t)(b * TP + r) * 64 + 8 * h;
    float row[MW];
#pragma unroll
    for (int g = 0; g < MW / 2; ++g) {
        float s0 = -INFINITY, s1 = -INFINITY;
        if (g < ngrp) {
            const bf16_t* kp = kbase + (size_t)(g * 64) * 64;
            bf16x8 b0[4], b1[4];
#pragma unroll
            for (int ks = 0; ks < 4; ++ks) { b0[ks] = *(const bf16x8*)(kp + 16 * ks); b1[ks] = *(const bf16x8*)(kp + 32 * 64 + 16 * ks); }
            float x0 = 0.f, x1 = 0.f;
            { f32x16 a0;
#pragma unroll
              for (int i = 0; i < 16; ++i) a0[i] = 0.f;
#pragma unroll
              for (int ks = 0; ks < 4; ++ks) a0 = MFMA32(af[ks], b0[ks], a0);
#pragma unroll
              for (int i = 0; i < 16; ++i) x0 += w[i] * fmaxf(a0[i], 0.f); }
            { f32x16 a1;
#pragma unroll
              for (int i = 0; i < 16; ++i) a1[i] = 0.f;
#pragma unroll
              for (int ks = 0; ks < 4; ++ks) a1 = MFMA32(af[ks], b1[ks], a1);
#pragma unroll
              for (int i = 0; i < 16; ++i) x1 += w[i] * fmaxf(a1[i], 0.f); }
            s0 = (g * 64 + r <= tq) ? x0 : -INFINITY; s1 = (g * 64 + 32 + r <= tq) ? x1 : -INFINITY;
        }
        row[2 * g] = s0; row[2 * g + 1] = s1;
    }
    float tau = -3.0e38f;
    bool done = (tq + 1 <= 256);
    float mx = -INFINITY, mn = INFINITY;
#pragma unroll
    for (int k = 0; k < MW; ++k) { const float v = row[k]; mx = fmaxf(mx, v); mn = fminf(mn, v > -INFINITY ? v : INFINITY); }
    float lo = half_min_f(mn), hi = half_max_f(mx);
    if (!done) tau = hi;
    for (int it = 0; it < 64; ++it) {
        if (!__any(!done)) break;
        const float mid = lo + (hi - lo) * 0.5f;
        int c = 0;
#pragma unroll
        for (int k = 0; k < MW; ++k) c += (row[k] >= mid) ? 1 : 0;
        c = half_sum_i(c);
        if (!done) {
            if (!(mid > lo && mid < hi)) { tau = hi; done = true; }
            else if (c == 256) { tau = mid; done = true; }
            else if (c > 256) lo = mid;
            else { hi = mid; tau = hi; }
        }
    }
    unsigned* mrow = mask + (size_t)(b * TP + tq) * MW;
    unsigned mw = 0u;
#pragma unroll
    for (int k = 0; k < MW; ++k) {
        const unsigned long long bal = __ballot(row[k] >= tau);
        const unsigned wd = h ? (unsigned)(bal >> 32) : (unsigned)bal;
        if ((k & 31) == r) mw = wd;
        if ((k & 31) == 31 || k == MW - 1) { const int kk = (k & ~31) + r; if (kk < MW) mrow[kk] = mw; }
    }
}
__device__ __forceinline__ void p2_indexer(const Frame& F) {
    volatile LAS unsigned* qw = (volatile LAS unsigned*)(F.lds + LDSCTL_OFF + 16);
    constexpr int NCH = M / 16;
    for (;;) {
        if (F.tid == 0) qw[0] = atomicAdd(F.ctl + CW_QUEUE, 1u);
        __syncthreads();
        const int c = (int)qw[0];
        __syncthreads();
        if (c >= NCH) break;
        const int b = c & 3, tblk = (TP / 16 - 1) - (c >> 2);
        idx_task(F, b, tblk * 16 + 2 * F.wave);
    }
}
template <bool MLA> struct AttnCfg {
    static constexpr int DQK = MLA ? 192 : 128, PK = DQK * 2 + 16, PV = 320, KCH = DQK / 8, NKC = 64 * KCH / 512, KBYTES = 64 * PK, BUFB = 64 * PK + 64 * PV;
};
struct AttnUnit { int type, b, hx, blk; };

template <bool MLA>
__device__ __forceinline__ void attn_unit(const Frame& F, const AttnUnit u) {
    typedef AttnCfg<MLA> C;
    const int tid = F.tid, lane = F.lane, wave = F.wave, r = lane & 31, h = lane >> 5;
    LAS unsigned char* lds = F.lds;
    const bf16_t* qn = (const bf16_t*)(F.ws + WS_QN); const bf16_t* qr = (const bf16_t*)(F.ws + WS_QR); const bf16_t* kn = (const bf16_t*)(F.ws + WS_KN);
    const bf16_t* va = (const bf16_t*)(F.ws + WS_VA); const bf16_t* kpe = (const bf16_t*)(F.ws + WS_KPE);
    const bf16_t* qb = (const bf16_t*)(F.ws + WS_QB); const bf16_t* kb = (const bf16_t*)(F.ws + WS_KB); const bf16_t* vb = (const bf16_t*)(F.ws + WS_VB);
    const unsigned* mask = (const unsigned*)(F.ws + WS_MASK); bf16_t* oab = (bf16_t*)(F.ws + WS_OAB);
    const int b = u.b;
    const size_t rowb = (size_t)b * TP;
    int head, tw0, ntiles;
    if (MLA) { head = u.hx; tw0 = u.blk * 256 + 32 * wave; const int tend = (u.blk * 256 + 256 < TP) ? u.blk * 256 + 256 : TP; ntiles = tend / 64; }
    else { head = 4 * u.hx + (wave & 3); tw0 = u.blk * 64 + 32 * (wave >> 2); ntiles = u.blk + 1; }
    const bool active = tw0 < TP;
    const int tq = tw0 + r;
    bf16x8 qf[C::DQK / 16];
    if (active) {
        if (MLA) {
            const bf16_t* p0 = qn + (rowb + tq) * 2048 + head * 128 + 8 * h; const bf16_t* p1 = qr + (rowb + tq) * 1024 + head * 64 + 8 * h;
#pragma unroll
            for (int ks = 0; ks < 8; ++ks) qf[ks] = *(const bf16x8*)(p0 + 16 * ks);
#pragma unroll
            for (int ks = 0; ks < 4; ++ks) qf[8 + ks] = *(const bf16x8*)(p1 + 16 * ks);
        } else {
            const bf16_t* p0 = qb + (rowb + tq) * 2048 + head * 128 + 8 * h;
#pragma unroll
            for (int ks = 0; ks < 8; ++ks) qf[ks] = *(const bf16x8*)(p0 + 16 * ks);
        }
    } else {
#pragma unroll
        for (int ks = 0; ks < C::DQK / 16; ++ks) qf[ks] = (bf16x8){0, 0, 0, 0, 0, 0, 0, 0};
    }
    const int ldkv = MLA ? 2048 : 512;
    const bf16_t* kbase = (MLA ? kn + rowb * 2048 + head * 128 : kb + rowb * 512 + u.hx * 128);
    const bf16_t* vbase = (MLA ? va + rowb * 2048 + head * 128 : vb + rowb * 512 + u.hx * 128);
    const bf16_t* pbase = kpe + rowb * 64;
    unsigned soff[2]; int kdst[2], vdst[2];
#pragma unroll
    for (int i = 0; i < 2; ++i) { const int c = tid + 512 * i, key = c >> 4, pc = c & 15; soff[i] = (unsigned)(key * ldkv + pc * 8); kdst[i] = key * C::PK + pc * 16; vdst[i] = C::KBYTES + key * C::PV + pc * 16; }
    const unsigned poff = (unsigned)((tid >> 3) * 64 + (tid & 7) * 8); const int pdst = (tid >> 3) * C::PK + 256 + (tid & 7) * 16;
    u32x4 kst[2], vst[2], pst = (u32x4){0u, 0u, 0u, 0u};
#pragma unroll
    for (int i = 0; i < 2; ++i) { kst[i] = *(const u32x4*)(kbase + soff[i]); vst[i] = *(const u32x4*)(vbase + soff[i]); }
    if (MLA) pst = *(const u32x4*)(pbase + poff);
#pragma unroll
    for (int i = 0; i < 2; ++i) { *(LAS u32x4*)(lds + kdst[i]) = kst[i]; *(LAS u32x4*)(lds + vdst[i]) = vst[i]; }
    if (MLA) *(LAS u32x4*)(lds + pdst) = pst;
    __syncthreads();
    f32x16 oacc[4];
#pragma unroll
    for (int d = 0; d < 4; ++d)
#pragma unroll
        for (int i = 0; i < 16; ++i) oacc[d][i] = 0.f;
    float mrun = -INFINITY, lrun = 0.f;
    const int koff = r * C::PK + 16 * h;
    const int voff = C::KBYTES + (4 * h + ((lane & 15) >> 2)) * C::PV + (16 * ((lane >> 4) & 1) + 4 * (lane & 3)) * 2;
    const unsigned* mrow = mask + (rowb + (active ? tq : 0)) * MW;
    for (int kt = 0; kt < ntiles; ++kt) {
        const int cur = (kt & 1) * C::BUFB, nxt = ((kt + 1) & 1) * C::BUFB;
        const bool more = kt + 1 < ntiles;
        if (more) {
            const bf16_t* kb2 = kbase + (size_t)(kt + 1) * 64 * ldkv; const bf16_t* vb2 = vbase + (size_t)(kt + 1) * 64 * ldkv;
#pragma unroll
            for (int i = 0; i < 2; ++i) { kst[i] = *(const u32x4*)(kb2 + soff[i]); vst[i] = *(const u32x4*)(vb2 + soff[i]); }
            if (MLA) pst = *(const u32x4*)(pbase + (size_t)(kt + 1) * 64 * 64 + poff);
        }
        if (active && kt * 64 <= tw0 + 31) {
            u32x2 mwd = (u32x2){0u, 0u};
            if (!MLA) mwd = *(const u32x2*)(mrow + 2 * kt);
            f32x16 s0, s1;
#pragma unroll
            for (int i = 0; i < 16; ++i) { s0[i] = 0.f; s1[i] = 0.f; }
#pragma unroll
            for (int ks = 0; ks < C::DQK / 16; ++ks) {
                const bf16x8 k0 = *(const LAS bf16x8*)(lds + cur + koff + 32 * ks), k1 = *(const LAS bf16x8*)(lds + cur + koff + 32 * C::PK + 32 * ks);
                s0 = MFMA32(k0, qf[ks], s0); s1 = MFMA32(k1, qf[ks], s1);
            }
            if (MLA) {
                if (kt * 64 + 63 > tw0) {
                    const int kb0 = kt * 64 + 4 * h;
#pragma unroll
                    for (int i = 0; i < 16; ++i) { const int key = kb0 + (i & 3) + 8 * (i >> 2); if (key > tq) s0[i] = -INFINITY; if (key + 32 > tq) s1[i] = -INFINITY; }
                }
            } else {
                const unsigned m0 = mwd.x >> (4 * h), m1 = mwd.y >> (4 * h);
#pragma unroll
                for (int i = 0; i < 16; ++i) { const int bit = (i & 3) + 8 * (i >> 2); if (!((m0 >> bit) & 1u)) s0[i] = -INFINITY; if (!((m1 >> bit) & 1u)) s1[i] = -INFINITY; }
            }
            float mx = s0[0];
#pragma unroll
            for (int i = 1; i < 16; ++i) mx = fmaxf(mx, s0[i]);
#pragma unroll
            for (int i = 0; i < 16; ++i) mx = fmaxf(mx, s1[i]);
            mx = fmaxf(mx, __shfl_xor(mx, 32));
            const float mnew = fmaxf(mrun, mx);
            const float msafe = (mnew == -INFINITY) ? 0.f : mnew;
            const float alpha = __builtin_amdgcn_exp2f(mrun - msafe);
            mrun = mnew;
            float ps = 0.f;
#pragma unroll
            for (int i = 0; i < 16; ++i) { s0[i] = __builtin_amdgcn_exp2f(s0[i] - msafe); s1[i] = __builtin_amdgcn_exp2f(s1[i] - msafe); ps += s0[i] + s1[i]; }
            lrun = lrun * alpha + ps;
#pragma unroll
            for (int d = 0; d < 4; ++d)
#pragma unroll
                for (int i = 0; i < 16; ++i) oacc[d][i] *= alpha;
            bf16x8 pf[4];
            { u32x4 w;
              w.x = cvt_pk_bf16(s0[0], s0[1]); w.y = cvt_pk_bf16(s0[2], s0[3]); w.z = cvt_pk_bf16(s0[4], s0[5]); w.w = cvt_pk_bf16(s0[6], s0[7]); pf[0] = __builtin_bit_cast(bf16x8, w);
              w.x = cvt_pk_bf16(s0[8], s0[9]); w.y = cvt_pk_bf16(s0[10], s0[11]); w.z = cvt_pk_bf16(s0[12], s0[13]); w.w = cvt_pk_bf16(s0[14], s0[15]); pf[1] = __builtin_bit_cast(bf16x8, w);
              w.x = cvt_pk_bf16(s1[0], s1[1]); w.y = cvt_pk_bf16(s1[2], s1[3]); w.z = cvt_pk_bf16(s1[4], s1[5]); w.w = cvt_pk_bf16(s1[6], s1[7]); pf[2] = __builtin_bit_cast(bf16x8, w);
              w.x = cvt_pk_bf16(s1[8], s1[9]); w.y = cvt_pk_bf16(s1[10], s1[11]); w.z = cvt_pk_bf16(s1[12], s1[13]); w.w = cvt_pk_bf16(s1[14], s1[15]); pf[3] = __builtin_bit_cast(bf16x8, w); }
#pragma unroll
            for (int d = 0; d < 4; ++d)
#pragma unroll
                for (int kk = 0; kk < 4; ++kk) {
                    const s16x4 lo = __builtin_amdgcn_ds_read_tr16_b64_v4i16((LAS s16x4*)(lds + cur + voff + (16 * kk) * C::PV + 64 * d));
                    const s16x4 hi = __builtin_amdgcn_ds_read_tr16_b64_v4i16((LAS s16x4*)(lds + cur + voff + (16 * kk + 8) * C::PV + 64 * d));
                    const bf16x8 vf = __builtin_shufflevector(lo, hi, 0, 1, 2, 3, 4, 5, 6, 7);
                    oacc[d] = MFMA32(vf, pf[kk], oacc[d]);
                }
        }
        if (more) {
#pragma unroll
            for (int i = 0; i < 2; ++i) { *(LAS u32x4*)(lds + nxt + kdst[i]) = kst[i]; *(LAS u32x4*)(lds + nxt + vdst[i]) = vst[i]; }
            if (MLA) *(LAS u32x4*)(lds + nxt + pdst) = pst;
        }
        __syncthreads();
    }
    if (active) {
        const float lt = lrun + __shfl_xor(lrun, 32);
        const float inv = lt > 0.f ? 1.0f / lt : 0.f;
        bf16_t* op = oab + (rowb + tq) * 4096 + (MLA ? 0 : 2048) + head * 128 + 4 * h;
#pragma unroll
        for (int d = 0; d < 4; ++d)
#pragma unroll
            for (int g = 0; g < 4; ++g) { u32x2 w; w.x = cvt_pk_bf16(oacc[d][4 * g] * inv, oacc[d][4 * g + 1] * inv); w.y = cvt_pk_bf16(oacc[d][4 * g + 2] * inv, oacc[d][4 * g + 3] * inv);
                *(u32x2*)(op + 32 * d + 8 * g) = w; }
    }
}

constexpr int ATT_NUNITS = 17 * 64 + 66 * 16;
__device__ __forceinline__ void att_decode(int idx, AttnUnit& u) {
    int rem = idx;
    for (int L = 66; L >= 1; --L) {
        const int nm = (L == 66 || (L & 3) == 0) ? 64 : 0;
        if (rem < nm) { u.type = 0; u.blk = (L == 66) ? 16 : (L >> 2) - 1; u.b = rem & 3; u.hx = rem >> 2; return; }
        rem -= nm;
        if (rem < 16) { u.type = 1; u.blk = L - 1; u.b = rem & 3; u.hx = rem >> 2; return; }
        rem -= 16;
    }
    u.type = -1; u.blk = 0; u.b = 0; u.hx = 0;
}
__device__ __forceinline__ void p3_attention(const Frame& F) {
#ifdef MK_SKIP_ATT
    {
        const u32x4* qn = (const u32x4*)(F.ws + WS_QN); const u32x4* qb = (const u32x4*)(F.ws + WS_QB); u32x4* o = (u32x4*)(F.ws + WS_OAB);
        const size_t gt = (size_t)(F.vcu * NWAVES + F.wave) * 64 + F.lane, NGT = (size_t)F.G * NWAVES * 64;
        for (size_t i = gt; i < (size_t)M * 256; i += NGT) { const size_t row = i >> 8, c = i & 255; o[row * 512 + c] = qn[row * 256 + c]; o[row * 512 + 256 + c] = qb[row * 256 + c]; }
        return;
    }
#endif
    volatile LAS int* qw = (volatile LAS int*)(F.lds + LDSCTL_OFF + 32);
    for (;;) {
        if (F.tid == 0) { const int idx = (int)atomicAdd(F.ctl + CW_QUEUE + 64, 1u); AttnUnit u; u.type = -1; u.b = 0; u.hx = 0; u.blk = 0; if (idx < ATT_NUNITS) att_decode(idx, u);
            qw[0] = u.type; qw[1] = u.b; qw[2] = u.hx; qw[3] = u.blk; }
        __syncthreads();
        AttnUnit u; u.type = qw[0]; u.b = qw[1]; u.hx = qw[2]; u.blk = qw[3];
        __syncthreads();
        if (u.type < 0) break;
        if (u.type == 0) attn_unit<true>(F, u); else attn_unit<false>(F, u);
    }
}
__device__ __forceinline__ float pk_idx(float v, int n) { return __uint_as_float((__float_as_uint(v) & ~127u) | (unsigned)n); }
__device__ __forceinline__ void route_task(const Frame& F, int tb, int hd) {
    const int lane = F.lane, r = lane & 31, h = lane >> 5;
    const bf16_t* pq = (const bf16_t*)(F.ws + WS_PQ); const bf16_t* skb = (const bf16_t*)(F.ws + WS_SK);
    int* eid = (int*)(F.ws + WS_EID); float* gate = (float*)(F.ws + WS_GATE);
    LAS float* wl = (LAS float*)(F.lds + F.wave * 16384);
    const int m = tb * 32 + r;
#pragma unroll 1
    for (int c = 0; c < 2; ++c) {
        const bf16_t* qp = pq + (size_t)m * 2048 + hd * 256 + c * 128 + 8 * h;
        bf16x8 qf[8];
#pragma unroll
        for (int ks = 0; ks < 8; ++ks) qf[ks] = *(const bf16x8*)(qp + 16 * ks);
        float v[64];
#pragma unroll
        for (int blk = 0; blk < 4; ++blk) {
            const bf16_t* sp = skb + (size_t)((hd * 2 + c) * 128 + 32 * blk + r) * 128 + 8 * h;
            f32x16 acc;
#pragma unroll
            for (int i = 0; i < 16; ++i) acc[i] = 0.f;
#pragma unroll
            for (int ks = 0; ks < 8; ++ks) acc = MFMA32(*(const bf16x8*)(sp + 16 * ks), qf[ks], acc);
#pragma unroll
            for (int i = 0; i < 16; ++i) v[blk * 16 + i] = pk_idx(acc[i], 32 * blk + (i & 3) + 8 * (i >> 2) + 4 * h);
        }
#pragma unroll 1
        for (int k = 0; k < 16; ++k) {
            float mx = v[0];
#pragma unroll
            for (int j = 1; j < 64; ++j) mx = fmaxf(mx, v[j]);
            mx = fmaxf(mx, __shfl_xor(mx, 32));
            if (h == 0) wl[(c * 16 + k) * 32 + r] = mx;
#pragma unroll
            for (int j = 0; j < 64; ++j) v[j] = (v[j] == mx) ? -INFINITY : v[j];
        }
    }
    LDS_WAIT(); asm volatile("" ::: "memory");
    float cs[50]; int ce[50];
    {
        unsigned t0[16], t1[16];
#pragma unroll
        for (int i = 0; i < 16; ++i) { t0[i] = __float_as_uint(wl[i * 32 + r]); t1[i] = __float_as_uint(wl[(16 + i) * 32 + r]); }
        int n = 0;
#pragma unroll
        for (int i = 0; i < 16; ++i)
#pragma unroll
            for (int j = 0; j < 16; ++j)
                if ((i + 1) * (j + 1) <= 16) {
                    const float s = __uint_as_float(t0[i] & ~127u) + __uint_as_float(t1[j] & ~127u);
                    cs[n] = __uint_as_float((__float_as_uint(s) & ~63u) | (unsigned)n); ce[n] = (int)((t0[i] & 127u) * 128u + (t1[j] & 127u)); ++n;
                }
    }
    float sum = 0.f, first = 0.f;
#pragma unroll 1
    for (int k = 0; k < 16; ++k) {
        float mx = cs[0];
#pragma unroll
        for (int j = 1; j < 50; ++j) mx = fmaxf(mx, cs[j]);
        int se = 0;
#pragma unroll
        for (int j = 0; j < 50; ++j) { const bool hit = (cs[j] == mx); se = hit ? ce[j] : se; cs[j] = hit ? -INFINITY : cs[j]; }
        if (k == 0) first = mx;
        const float ev = __expf(mx - first); sum += ev;
        if (h == 0) { wl[1024 + k * 32 + r] = ev; wl[1536 + k * 32 + r] = __int_as_float(se); }
    }
    LDS_WAIT(); asm volatile("" ::: "memory");
    const float inv = 1.0f / sum;
    if (h == 0) {
        int* ep = eid + (size_t)m * 128 + hd * 16; float* gp = gate + (size_t)m * 128 + hd * 16;
#pragma unroll
        for (int q = 0; q < 4; ++q) {
            *(int4*)(ep + 4 * q) = make_int4(__float_as_int(wl[1536 + (4 * q) * 32 + r]), __float_as_int(wl[1536 + (4 * q + 1) * 32 + r]), __float_as_int(wl[1536 + (4 * q + 2) * 32 + r]), __float_as_int(wl[1536 + (4 * q + 3) * 32 + r]));
            *(f32x4*)(gp + 4 * q) = (f32x4){wl[1024 + (4 * q) * 32 + r] * inv, wl[1024 + (4 * q + 1) * 32 + r] * inv, wl[1024 + (4 * q + 2) * 32 + r] * inv, wl[1024 + (4 * q + 3) * 32 + r] * inv}; }
    }
    LDS_WAIT(); asm volatile("" ::: "memory");
}
__device__ __forceinline__ void p7_routing(const Frame& F) {
    const int gw = F.vcu * NWAVES + F.wave, NGW = F.G * NWAVES;
    for (int it = gw; it < (M / 32) * 8; it += NGW) route_task(F, it >> 3, it & 7);
}

typedef __bf16 bf2_t __attribute__((ext_vector_type(2)));
__device__ __forceinline__ float dot2bf(unsigned a, unsigned b, float c) { return __builtin_amdgcn_fdot2_f32_bf16(__builtin_bit_cast(bf2_t, a), __builtin_bit_cast(bf2_t, b), c, false); }
__device__ __forceinline__ float dot8(const u32x4 a, const u32x4 b, float c) { c = dot2bf(a.x, b.x, c); c = dot2bf(a.y, b.y, c); c = dot2bf(a.z, b.z, c); return dot2bf(a.w, b.w, c); }
__device__ __forceinline__ float rl_f(float v, int l) { return __int_as_float(__builtin_amdgcn_readlane(__float_as_int(v), l)); }
__device__ __forceinline__ float gelu_tanh(float x) {
    const float u = 0.7978845608028654f * (x + 0.044715f * x * x * x);
    const float e = __expf(2.0f * u);
    const float th = 1.0f - 2.0f / (e + 1.0f);
    return 0.5f * x * (1.0f + th);
}
__device__ __forceinline__ void expert_token(const Frame& F, int m, size_t orow) {
    const int lane = F.lane;
    const bf16_t* U = (const bf16_t*)(F.ws + WS_U); const bf16_t* V = (const bf16_t*)(F.ws + WS_V);
    const int* eid = (const int*)(F.ws + WS_EID); const float* gate = (const float*)(F.ws + WS_GATE);
    const bf16_t* h1b = (const bf16_t*)(F.ws + WS_H1B); const float* h1f = (const float*)(F.ws + WS_H1F);
    const u64* ssq = (const u64*)(F.ctl + CW_SSQ_H1); const float* gfin = F.in(15);
    u32x4 hb[8];
#pragma unroll
    for (int j = 0; j < 8; ++j) hb[j] = *((const u32x4*)(h1b + (size_t)m * DM) + lane + 64 * j);
    const int e0 = eid[(size_t)m * 128 + lane], e1 = eid[(size_t)m * 128 + 64 + lane];
    const float g0 = gate[(size_t)m * 128 + lane], g1 = gate[(size_t)m * 128 + 64 + lane];
    const float rstd = __builtin_amdgcn_rsqf(ssq_get(ssq + m) * (1.0f / DM) + EPS);
    float a0 = 0.f, a1 = 0.f;
    {
        u32x4 ra[8], rb[8];
        { const u32x4* up = (const u32x4*)(U + (size_t)__builtin_amdgcn_readlane(e0, 0) * DM) + lane;
#pragma unroll
          for (int j = 0; j < 8; ++j) ra[j] = up[64 * j]; }
        for (int e = 0; e < 128; e += 2) {
            { const int ex = (e + 1 < 64) ? __builtin_amdgcn_readlane(e0, e + 1) : __builtin_amdgcn_readlane(e1, e + 1 - 64);
              const u32x4* up = (const u32x4*)(U + (size_t)ex * DM) + lane;
#pragma unroll
              for (int j = 0; j < 8; ++j) rb[j] = up[64 * j]; }
            { float p = 0.f;
#pragma unroll
              for (int j = 0; j < 8; ++j) p = dot8(ra[j], hb[j], p);
              p = wave_sum(p);
              if (e < 64) { if (lane == e) a0 = p; } else { if (lane == e - 64) a1 = p; } }
            if (e + 2 < 128) { const int ex = (e + 2 < 64) ? __builtin_amdgcn_readlane(e0, e + 2) : __builtin_amdgcn_readlane(e1, e + 2 - 64);
              const u32x4* up = (const u32x4*)(U + (size_t)ex * DM) + lane;
#pragma unroll
              for (int j = 0; j < 8; ++j) ra[j] = up[64 * j]; }
            { float p = 0.f;
#pragma unroll
              for (int j = 0; j < 8; ++j) p = dot8(rb[j], hb[j], p);
              p = wave_sum(p);
              if (e + 1 < 64) { if (lane == e + 1) a0 = p; } else { if (lane == e + 1 - 64) a1 = p; } }
        }
    }
    const float c0 = gelu_tanh(a0 * rstd) * g0, c1 = gelu_tanh(a1 * rstd) * g1;
    float o[64];
#pragma unroll
    for (int i = 0; i < 64; ++i) o[i] = 0.f;
    {
        u32x4 ra[8], rb[8];
        { const u32x4* vp = (const u32x4*)(V + (size_t)__builtin_amdgcn_readlane(e0, 0) * DM) + lane;
#pragma unroll
          for (int j = 0; j < 8; ++j) ra[j] = vp[64 * j]; }
        for (int e = 0; e < 128; e += 2) {
            { const int ex = (e + 1 < 64) ? __builtin_amdgcn_readlane(e0, e + 1) : __builtin_amdgcn_readlane(e1, e + 1 - 64);
              const u32x4* vp = (const u32x4*)(V + (size_t)ex * DM) + lane;
#pragma unroll
              for (int j = 0; j < 8; ++j) rb[j] = vp[64 * j]; }
            { const float c = (e < 64) ? rl_f(c0, e) : rl_f(c1, e - 64);
#pragma unroll
              for (int j = 0; j < 8; ++j) { o[8 * j + 0] += c * bf_lo(ra[j].x); o[8 * j + 1] += c * bf_hi(ra[j].x); o[8 * j + 2] += c * bf_lo(ra[j].y); o[8 * j + 3] += c * bf_hi(ra[j].y);
                  o[8 * j + 4] += c * bf_lo(ra[j].z); o[8 * j + 5] += c * bf_hi(ra[j].z); o[8 * j + 6] += c * bf_lo(ra[j].w); o[8 * j + 7] += c * bf_hi(ra[j].w); } }
            if (e + 2 < 128) { const int ex = (e + 2 < 64) ? __builtin_amdgcn_readlane(e0, e + 2) : __builtin_amdgcn_readlane(e1, e + 2 - 64);
              const u32x4* vp = (const u32x4*)(V + (size_t)ex * DM) + lane;
#pragma unroll
              for (int j = 0; j < 8; ++j) ra[j] = vp[64 * j]; }
            { const float c = (e + 1 < 64) ? rl_f(c0, e + 1) : rl_f(c1, e + 1 - 64);
#pragma unroll
              for (int j = 0; j < 8; ++j) { o[8 * j + 0] += c * bf_lo(rb[j].x); o[8 * j + 1] += c * bf_hi(rb[j].x); o[8 * j + 2] += c * bf_lo(rb[j].y); o[8 * j + 3] += c * bf_hi(rb[j].y);
                  o[8 * j + 4] += c * bf_lo(rb[j].z); o[8 * j + 5] += c * bf_hi(rb[j].z); o[8 * j + 6] += c * bf_lo(rb[j].w); o[8 * j + 7] += c * bf_hi(rb[j].w); } }
        }
    }
    float s = 0.f;
#pragma unroll
    for (int j = 0; j < 8; ++j) { const f32x4* hp = (const f32x4*)(h1f + (size_t)m * DM + 512 * j + 8 * lane); const f32x4 x0 = hp[0], x1 = hp[1];
#pragma unroll
        for (int q = 0; q < 4; ++q) { o[8 * j + q] += x0[q]; o[8 * j + 4 + q] += x1[q]; }
#pragma unroll
        for (int q = 0; q < 8; ++q) s += o[8 * j + q] * o[8 * j + q]; }
    const float rs = 1.0f / sqrtf(wave_sum(s) * (1.0f / DM) + EPS);
    float* op = F.out() + orow * DM;
#pragma unroll
    for (int j = 0; j < 8; ++j) { const f32x4* gp = (const f32x4*)(gfin + 512 * j + 8 * lane); const f32x4 ga = gp[0], gb2 = gp[1];
        *(f32x4*)(op + 512 * j + 8 * lane) = (f32x4){o[8 * j] * rs * ga[0], o[8 * j + 1] * rs * ga[1], o[8 * j + 2] * rs * ga[2], o[8 * j + 3] * rs * ga[3]};
        *(f32x4*)(op + 512 * j + 8 * lane + 4) = (f32x4){o[8 * j + 4] * rs * gb2[0], o[8 * j + 5] * rs * gb2[1], o[8 * j + 6] * rs * gb2[2], o[8 * j + 7] * rs * gb2[3]}; }
}
#ifdef MK_STEP_B
__device__ __forceinline__ void stepb_token(const Frame& F, int m, size_t orow) {
    const int lane = F.lane; const float* x = (const float*)(F.ws + WS_H1F) + (size_t)m * DM; const float* gfin = F.in(15);
    f32x4 v[16]; float s = 0.f;
#pragma unroll
    for (int j = 0; j < 16; ++j) { v[j] = *((const f32x4*)x + lane + 64 * j); s += (v[j][0] * v[j][0] + v[j][1] * v[j][1]) + (v[j][2] * v[j][2] + v[j][3] * v[j][3]); }
    const float rs = 1.0f / sqrtf(wave_sum(s) * (1.0f / DM) + EPS);
#pragma unroll
    for (int j = 0; j < 16; ++j) { const f32x4 g = *((const f32x4*)gfin + lane + 64 * j); *((f32x4*)(F.out() + orow * DM) + lane + 64 * j) = v[j] * rs * g; }
}
#endif
#ifdef MK_STEP_A
__device__ __forceinline__ void stepa_token(const Frame& F, size_t orow) {
    const int lane = F.lane; const float* x = F.in(0) + orow * DM; const float* gfin = F.in(15);
    f32x4 v[16]; float s = 0.f;
#pragma unroll
    for (int j = 0; j < 16; ++j) { v[j] = *((const f32x4*)x + lane + 64 * j); s += (v[j][0] * v[j][0] + v[j][1] * v[j][1]) + (v[j][2] * v[j][2] + v[j][3] * v[j][3]); }
    const float rs = 1.0f / sqrtf(wave_sum(s) * (1.0f / DM) + EPS);
#pragma unroll
    for (int j = 0; j < 16; ++j) { const f32x4 g = *((const f32x4*)gfin + lane + 64 * j); *((f32x4*)(F.out() + orow * DM) + lane + 64 * j) = v[j] * rs * g; }
}
#endif
__device__ __forceinline__ void p8_experts(const Frame& F) {
    const int gw = F.vcu * NWAVES + F.wave, NGW = F.G * NWAVES;
#if defined(MK_STEP_A)
    for (int it = gw; it < NB * SEQ; it += NGW) stepa_token(F, (size_t)it);
#elif defined(MK_STEP_B)
    for (int it = gw; it < NB * SEQ; it += NGW) { const int b = it / SEQ, s = it % SEQ; stepb_token(F, b * TP + NMETA + s, (size_t)it); }
#else
    for (int it = gw; it < NB * SEQ; it += NGW) { const int b = it / SEQ, s = it % SEQ; expert_token(F, b * TP + NMETA + s, (size_t)it); }
#endif
}
struct Args { const float* in[16]; float* out; unsigned char* ws; int ph_lo, ph_hi; };
#define GEMM_RUN(EPI_T, g_, S_, E_) pg8::gemm_phase<EPI_T, pg8::StaticOrder, true, true>(F.lds, g_, S_, E_)
#define GEMM_RUN2(EPI_T, g_, S_, E_) pg8::gemm_phase<EPI_T, pg8::StaticOrder2, true, true>(F.lds, g_, S_, E_)

__global__ void __launch_bounds__(NWAVES * 64, 2) mk_fwd(Args args) {
    extern __shared__ __attribute__((aligned(16))) unsigned char lds_raw[];
    Frame F;
    F.lds = (LAS unsigned char*)lds_raw;
    F.ws = args.ws; F.ctl = (unsigned*)(args.ws + WS_CTL);
    F.tid = threadIdx.x; F.lane = F.tid & 63; F.wave = __builtin_amdgcn_readfirstlane(F.tid >> 6);
#define PHASE_BEGIN() do { int t_; asm volatile("v_mov_b32 %0, %1" : "=v"(t_) : "v"(threadIdx.x)); F.tid = t_; F.lane = t_ & 63; } while (0)
    F.G = gridDim.x; { const int bx = blockIdx.x; F.vcu = (F.G % 8 == 0) ? (bx % 8) * (F.G / 8) + bx / 8 : bx; }
    for (int u = F.tid; u < (LDS_BYTES - LDSCTL_OFF) / 4; u += NWAVES * 64) ((LAS unsigned*)(F.lds + LDSCTL_OFF))[u] = 0u;
    __syncthreads();
    XcdBarrier bar; bar.bar = F.ctl + CW_BAR; bar.x = 0; bar.st = nullptr;
    if (!MK_PER_PHASE) bar = xcd_barrier_post(F.ctl + CW_BAR, (volatile LAS unsigned*)(F.lds + LDSCTL_OFF));
    const int lo = args.ph_lo, hi = args.ph_hi;
#ifndef PH_MASK
#define PH_MASK 0x1FF
#endif
#define IN(k) (((PH_MASK >> (k)) & 1) && lo <= (k) && (k) < hi)
#define SEAM(k) do { if (IN(k) && IN((k) + 1)) xcd_barrier(bar); } while (0)
    unsigned char* ws = F.ws;

    if (IN(0)) { PHASE_BEGIN(); p0_prologue(F); }
    SEAM(0);
    if (IN(1)) { PHASE_BEGIN();
        pg8::Gemm g{(const bf16_t*)(ws + WS_XN), (const bf16_t*)(ws + WS_WIN), M, NV1, DM, DM}; pg8::StaticOrder S; S.init(M, NV1, F.G, (int)blockIdx.x);
        epi::EpiIn E{(bf16_t*)(ws + WS_CQ), (bf16_t*)(ws + WS_CKV), (bf16_t*)(ws + WS_QB), (bf16_t*)(ws + WS_KB), (bf16_t*)(ws + WS_VB), (bf16_t*)(ws + WS_QIX), (bf16_t*)(ws + WS_KPE), (bf16_t*)(ws + WS_KIX),
                      (bf16_t*)(ws + WS_GA), (bf16_t*)(ws + WS_GB), (float*)(ws + WS_WIX), (u64*)(F.ctl + CW_SSQ_CQ), (u64*)(F.ctl + CW_SSQ_CKV),
                      (const float*)(ws + WS_ROPE_M), (const float*)(ws + WS_ROPE_D), (const float*)(ws + WS_ROPE_I)};
        GEMM_RUN(epi::EpiIn, g, S, E);
    }
    SEAM(1);
    if (IN(2)) { PHASE_BEGIN();
        { pg8::Gemm g{(const bf16_t*)(ws + WS_CQ), (const bf16_t*)(ws + WS_WUQ), M, 3072, 1024, 1024}; pg8::StaticOrder S; S.init(M, 3072, F.G, (int)blockIdx.x);
          epi::EpiUp E{(bf16_t*)(ws + WS_QN), (bf16_t*)(ws + WS_QR), 8, 2048, 1024, (const u64*)(F.ctl + CW_SSQ_CQ), 1.0f / 1024.0f, QA_SCALE, (const float*)(ws + WS_ROPE_M)};
          GEMM_RUN(epi::EpiUp, g, S, E); }
        __syncthreads();
        { pg8::Gemm g{(const bf16_t*)(ws + WS_CKV), (const bf16_t*)(ws + WS_WUKV), M, 4096, 512, 512}; pg8::StaticOrder S; S.init(M, 4096, F.G, (int)blockIdx.x);
          epi::EpiUp E{(bf16_t*)(ws + WS_KN), (bf16_t*)(ws + WS_VA), 8, 2048, 2048, (const u64*)(F.ctl + CW_SSQ_CKV), 1.0f / 512.0f, 1.0f, nullptr};
          GEMM_RUN(epi::EpiUp, g, S, E); }
        __syncthreads();
        p2_indexer(F);
    }
    SEAM(2);
    if (IN(3)) { PHASE_BEGIN(); p3_attention(F); }
    SEAM(3);
    if (IN(4)) { PHASE_BEGIN();
        pg8::Gemm g{(const bf16_t*)(ws + WS_OAB), (const bf16_t*)(ws + WS_WBR), M, 4096, 4096, 2048}; pg8::StaticOrder2 S; S.init(M, 4096, F.G, (int)blockIdx.x);
        epi::EpiBranch E{(const bf16_t*)(ws + WS_GA), (const bf16_t*)(ws + WS_GB), (bf16_t*)(ws + WS_MRG)};
        GEMM_RUN2(epi::EpiBranch, g, S, E);
    }
    SEAM(4);
    if (IN(5)) { PHASE_BEGIN();
        pg8::Gemm g{(const bf16_t*)(ws + WS_MRG), (const bf16_t*)(ws + WS_WOUT), M, 4096, 4096, 4096}; pg8::StaticOrder S; S.init(M, 4096, F.G, (int)blockIdx.x);
        epi::EpiOut E{F.in(0), F.in(1), (float*)(ws + WS_H1F), (bf16_t*)(ws + WS_H1B), (u64*)(F.ctl + CW_SSQ_H1)};
        GEMM_RUN(epi::EpiOut, g, S, E);
    }
    SEAM(5);
    if (IN(6)) { PHASE_BEGIN();
        pg8::Gemm g{(const bf16_t*)(ws + WS_H1B), (const bf16_t*)(ws + WS_WQ), M, 2048, 4096, 4096}; pg8::StaticOrder S; S.init(M, 2048, F.G, (int)blockIdx.x);
        epi::EpiPQ E{(bf16_t*)(ws + WS_PQ), (const u64*)(F.ctl + CW_SSQ_H1)};
        GEMM_RUN(epi::EpiPQ, g, S, E);
        p6_tables(F);
    }
    SEAM(6);
    if (IN(7)) { PHASE_BEGIN(); p7_routing(F); }
    SEAM(7);
    if (IN(8)) { PHASE_BEGIN(); p8_experts(F); }
#undef IN
#undef SEAM
}

extern "C" void kernel_launch(void* const* d_in, const int* in_sizes, int n_in, void* d_out, int out_size, void* d_ws, size_t ws_size, hipStream_t stream) {
    static int grid = 0;
    if (grid == 0) {
        if (n_in != 16 || in_sizes[0] != NB * SEQ * DM || out_size != NB * SEQ * DM || ws_size < WS_END) {
            fprintf(stderr, "kernel_launch: unexpected problem shape (n_in %d, in0 %d, out %d, ws %zu < %zu); nothing launched\n", n_in, n_in > 0 ? in_sizes[0] : -1, out_size, ws_size, (size_t)WS_END); grid = -1; return; }
        int dev = 0, cus = 0, per_cu = 0;
        if (hipGetDevice(&dev) != hipSuccess || hipDeviceGetAttribute(&cus, hipDeviceAttributeMultiprocessorCount, dev) != hipSuccess) { grid = -1; return; }
        if (hipFuncSetAttribute((const void*)mk_fwd, hipFuncAttributeMaxDynamicSharedMemorySize, LDS_BYTES) != hipSuccess) { fprintf(stderr, "kernel_launch: hipFuncSetAttribute failed\n"); grid = -1; return; }
        if (hipOccupancyMaxActiveBlocksPerMultiprocessor(&per_cu, (const void*)mk_fwd, NWAVES * 64, LDS_BYTES) != hipSuccess || per_cu < 1) {
            fprintf(stderr, "kernel_launch: occupancy query reports %d workgroups per CU\n", per_cu); }
        (void)hipGetLastError();
        grid = cus;
    }
    if (grid < 0) return;
    if (hipMemsetAsync((char*)d_ws + WS_CTL, 0, CTL_ZERO_BYTES, stream) != hipSuccess) return;
    Args a{};
    for (int i = 0; i < 16; ++i) a.in[i] = (const float*)d_in[i];
    a.out = (float*)d_out; a.ws = (unsigned char*)d_ws;
#if MK_PER_PHASE
    for (int p = 0; p <= MK_LAST_PHASE; ++p) { a.ph_lo = p; a.ph_hi = p + 1; hipLaunchKernelGGL(mk_fwd, dim3(grid), dim3(NWAVES * 64), LDS_BYTES, stream, a); }
#else
    a.ph_lo = 0; a.ph_hi = MK_LAST_PHASE + 1;
    hipLaunchKernelGGL(mk_fwd, dim3(grid), dim3(NWAVES * 64), LDS_BYTES, stream, a);
#endif
}
```

```cpp
#include <hip/hip_runtime.h>
#include <cstdio>
#include <cstdint>

#define LAS __attribute__((address_space(3)))
#define GAS __attribute__((address_space(1)))
typedef unsigned short bf16_t;
typedef short bf16x8 __attribute__((ext_vector_type(8)));
typedef short s16x4 __attribute__((ext_vector_type(4)));
typedef float f32x2 __attribute__((ext_vector_type(2)));
typedef float f32x4 __attribute__((ext_vector_type(4)));
typedef float f32x16 __attribute__((ext_vector_type(16)));
typedef unsigned u32x2 __attribute__((ext_vector_type(2)));
typedef unsigned u32x4 __attribute__((ext_vector_type(4)));
typedef GAS unsigned gu32;

#ifndef MK_PER_PHASE
#define MK_PER_PHASE 0
#endif
#ifndef MK_LAST_PHASE
#define MK_LAST_PHASE 8
#endif

constexpr int NB = 4, SEQ = 4096, DM = 4096, NMETA = 16, TR = SEQ + NMETA  , TP = 4224  , M = NB * TP  ;
constexpr float EPS = 1e-6f;
constexpr int NV1 = 14080;
constexpr float LOG2E = 1.4426950408889634f;
constexpr float QB_SCALE = 0.08838834764831845f * LOG2E;
constexpr float QA_SCALE = 0.07216878364870323f * LOG2E;
constexpr int NWAVES = 8;
constexpr int MW = 132;

constexpr size_t HM = 512u * 1024u;
constexpr size_t WS_CTL = 0, CTL_ZERO_BYTES = 2 * HM;
constexpr size_t WS_ROPE_M = 2 * HM;
constexpr size_t WS_ROPE_D = 5 * HM;
constexpr size_t WS_ROPE_I = 7 * HM;
constexpr size_t WS_SK   = 8 * HM;
constexpr size_t WS_WUQ  = 10 * HM;
constexpr size_t WS_WUKV = 22 * HM;
constexpr size_t WS_WBR  = 30 * HM;
constexpr size_t WS_WOUT = 94 * HM;
constexpr size_t WS_WQ   = 158 * HM;
constexpr size_t WS_EID  = 190 * HM;
constexpr size_t WS_GATE = 207 * HM;
constexpr size_t WS_MASK = 224 * HM;
constexpr size_t WS_KPE  = 242 * HM;
constexpr size_t WS_KIX  = 247 * HM;
constexpr size_t WS_WIX  = 252 * HM;
constexpr size_t WS_SCU  = 255 * HM;
constexpr size_t WS_SCV  = 255 * HM + 65536;
constexpr size_t R23 = 260 * HM;
constexpr size_t WS_XN   = R23;
constexpr size_t WS_WIN  = R23 + 264 * HM;
constexpr size_t P1O = R23 + 484 * HM;
constexpr size_t WS_CQ   = P1O;
constexpr size_t WS_CKV  = P1O + 66 * HM;
constexpr size_t WS_QB   = P1O + 99 * HM;
constexpr size_t WS_KB   = P1O + 231 * HM;
constexpr size_t WS_VB   = P1O + 264 * HM;
constexpr size_t WS_QIX  = P1O + 297 * HM;
constexpr size_t WS_GA   = P1O + 363 * HM;
constexpr size_t WS_GB   = P1O + 627 * HM;
constexpr size_t R4 = P1O + 892 * HM;
constexpr size_t WS_OAB  = R4;
constexpr size_t WS_PQ   = R4;
constexpr size_t WS_END  = R4 + 264 * HM;
constexpr size_t WS_QN   = R23;
constexpr size_t WS_QR   = R23 + 132 * HM;
constexpr size_t WS_KN   = R23 + 198 * HM;
constexpr size_t WS_VA   = R23 + 330 * HM;
constexpr size_t WS_MRG  = R23;
constexpr size_t WS_U    = R23;
constexpr size_t WS_V    = R23 + 256 * HM;
constexpr size_t WS_H1F  = R23 + 512 * HM;
constexpr size_t WS_H1B  = R23 + 1040 * HM;
static_assert(WS_VA + 132 * HM <= P1O && WS_H1F >= P1O && WS_H1B + 264 * HM <= R4 && WS_GB + 264 * HM <= R4, "ws map");
constexpr int CW_TMO = 0;
constexpr int CW_BAR = 4096;
constexpr int CW_QUEUE = 8192;
constexpr int CW_SSQ_CQ = 16384, CW_SSQ_CKV = 16384 + 2 * 17408, CW_SSQ_H1 = 16384 + 4 * 17408;
static_assert((CW_SSQ_H1 + 2 * 17408) * 4 <= (int)CTL_ZERO_BYTES, "ctl");

constexpr int RING_BYTES = 131072;
constexpr int LDSCTL_OFF = RING_BYTES;
constexpr int LDS_BYTES = 147456;

__device__ __forceinline__ unsigned f2bf(float f) { unsigned u = __float_as_uint(f); return (u + 0x7fffu + ((u >> 16) & 1u)) >> 16; }
__device__ __forceinline__ unsigned pk2(float lo, float hi) { return f2bf(lo) | (f2bf(hi) << 16); }
typedef __bf16 bf16x2_t __attribute__((ext_vector_type(2)));
__device__ __forceinline__ unsigned cvt_pk_bf16(float lo, float hi) { return __builtin_bit_cast(unsigned, __builtin_convertvector((f32x2){lo, hi}, bf16x2_t)); }
__device__ __forceinline__ float bf_lo(unsigned w) { return __uint_as_float(w << 16); }
__device__ __forceinline__ float bf_hi(unsigned w) { return __uint_as_float(w & 0xffff0000u); }
__device__ __forceinline__ u32x4 pack8(f32x4 a, f32x4 b) { u32x4 w; w.x = cvt_pk_bf16(a[0], a[1]); w.y = cvt_pk_bf16(a[2], a[3]); w.z = cvt_pk_bf16(b[0], b[1]); w.w = cvt_pk_bf16(b[2], b[3]); return w; }
__device__ __forceinline__ float wave_sum(float v) {
#pragma unroll
    for (int o = 1; o < 64; o <<= 1) v += __shfl_xor(v, o);
    return v;
}
#define LDS_WAIT() asm volatile("s_waitcnt lgkmcnt(0)" ::: "memory")
#define VM_WAIT() asm volatile("s_waitcnt vmcnt(0)" ::: "memory")
typedef unsigned long long u64;
__device__ __forceinline__ void ssq_add(u64* p, float v) { (void)__hip_atomic_fetch_add(p, (u64)(v * 16777216.0f), __ATOMIC_RELAXED, __HIP_MEMORY_SCOPE_AGENT); }
__device__ __forceinline__ float ssq_get(const u64* p) { return (float)((double)(*p) * (1.0 / 16777216.0)); }
namespace pg8 {
#define PG8_LAS __attribute__((address_space(3)))
typedef unsigned short bf16_t;
typedef short bf16x8 __attribute__((ext_vector_type(8)));
typedef float f32x4 __attribute__((ext_vector_type(4)));
typedef unsigned u32x4 __attribute__((ext_vector_type(4)));
constexpr int BM = 256, BK = 64, HALF = 128, HTB = HALF * BK * 2  , STAGE_BYTES = 8 * HTB, NXCD = 8, WGM = 8;

__host__ __device__ __forceinline__ int lds_byte(int r, int c) { const int st = (r >> 4) * 2 + (c >> 5), rr = r & 15, cc = c & 31, ob = rr * 64 + cc * 2; return st * 1024 + (ob ^ (((ob >> 9) & 1) << 5)); }
__host__ __device__ __forceinline__ void stage_rc(int b, int& R, int& C) { const int st = b / 1024, sb = b % 1024, swz = sb ^ (((sb >> 9) & 1) << 5); R = (st >> 1) * 16 + swz / 64; C = (st & 1) * 32 + (swz % 64) / 2; }
__host__ __device__ __forceinline__ int perm32(int rho) { const int n = rho >> 4, i = rho & 15; return 8 * (i >> 2) + 4 * n + (i & 3); }

struct Unit { int pm, pn, kh; };
struct Gemm { const bf16_t* A; const bf16_t* Bt; int M, N, K, KL; };

struct StaticOrder {
    int nM, nN, nwg, G, c;
    __host__ __device__ void init(int M, int N, int G_, int c_) { nM = M / BM; nN = N / BM; nwg = nM * nN; G = G_; c = c_; }
    __host__ __device__ bool next(int i, Unit& u) const {
        const long L = (long)i * G + c; if (L >= nwg) return false;
        int wgid = (int)L; { const int q = nwg / NXCD, r = nwg % NXCD, xcd = wgid % NXCD, off = wgid / NXCD; wgid = (xcd < r ? xcd * (q + 1) : r * (q + 1) + (xcd - r) * q) + off; }
        const int nig = WGM * nN, gid = wgid / nig, fm = gid * WGM, gsz = (nM - fm) < WGM ? (nM - fm) : WGM;
        u.pm = fm + ((wgid % nig) % gsz); u.pn = (wgid % nig) / gsz; u.kh = 0; return true;
    }
    __device__ __forceinline__ void a_ready(const Unit&) const {}
    __device__ __forceinline__ void done(const Unit&) const {}
};

struct StaticOrder2 {
    StaticOrder base;
    __host__ __device__ void init(int M, int N, int G_, int c_) { base.init(M, N, G_, c_); }
    __host__ __device__ bool next(int i, Unit& u) const { if (!base.next(i >> 1, u)) return false; u.kh = i & 1; return true; }
    __device__ __forceinline__ void a_ready(const Unit&) const {}
    __device__ __forceinline__ void done(const Unit&) const {}
};

template <class Epi, class Sched, bool ALIGN_EPI = false, bool SP2 = false>
__device__ __forceinline__ void gemm_phase(PG8_LAS unsigned char* lds, const Gemm g, const Sched& S, const Epi& E) {
    const int tid = threadIdx.x, wid = __builtin_amdgcn_readfirstlane(tid >> 6), lane = tid & 63, wr = wid >> 2, wc = wid & 3, fr = lane & 15, fq = lane >> 4;
    const int K = g.K, nt = g.KL / BK; const size_t khoff = (size_t)g.KL * 2;
    unsigned voffA[2], voffB[2];
#pragma unroll
    for (int i = 0; i < 2; ++i) { int R, C; stage_rc(tid * 16 + i * 8192, R, C); const int Rb = Epi::PERM ? ((R & ~31) + perm32(R & 31)) : R;
        voffA[i] = (unsigned)(R * K + C) * 2u; voffB[i] = (unsigned)(Rb * K + C) * 2u; }
    const size_t kstep = (size_t)(BK * 2);
    const size_t hstep = (size_t)HALF * K * 2;
    const size_t tstep = 2 * hstep;
    const unsigned ldsw = (unsigned)wid * 1024u;
    const int aoff = lds_byte(wr * 64 + fr, fq * 8), boff = lds_byte(wc * 32 + fr, fq * 8);
#define PG8_SA(b, h) (((b) * 2 + (h)) * HTB)
#define PG8_SB(b, h) ((4 + (b) * 2 + (h)) * HTB)
#define PG8_STAGE(bufoff, gbase, voff) do { _Pragma("unroll") for (int _i = 0; _i < 2; ++_i) \
        __builtin_amdgcn_global_load_lds((const unsigned*)((const char*)(gbase) + (voff)[_i]), (PG8_LAS unsigned*)(lds + (bufoff) + ldsw + _i * 8192), 16, 0, 0); } while (0)
#define PG8_LDA(dst, b, h) do { _Pragma("unroll") for (int m = 0; m < 4; ++m) _Pragma("unroll") for (int k = 0; k < 2; ++k) dst[m][k] = *(const PG8_LAS bf16x8*)(lds + PG8_SA(b, h) + aoff + m * 2048 + k * 1024); } while (0)
#define PG8_LDB(dst, b, h) do { _Pragma("unroll") for (int n = 0; n < 2; ++n) _Pragma("unroll") for (int k = 0; k < 2; ++k) dst[n][k] = *(const PG8_LAS bf16x8*)(lds + PG8_SB(b, h) + boff + n * 2048 + k * 1024); } while (0)
#define PG8_MMA(ai, bj, At, Bt) do { __builtin_amdgcn_s_setprio(1); _Pragma("unroll") for (int m = 0; m < 4; ++m) _Pragma("unroll") for (int n = 0; n < 2; ++n) _Pragma("unroll") for (int k = 0; k < 2; ++k) \
        acc[ai][bj][m][n] = __builtin_amdgcn_mfma_f32_16x16x32_bf16(Bt[n][k], At[m][k], acc[ai][bj][m][n], 0, 0, 0); __builtin_amdgcn_s_setprio(0); } while (0)
#define PG8_WAIT_V(n) asm volatile("s_waitcnt vmcnt(" #n ")" ::: "memory")
#define PG8_WAIT_L(n) asm volatile("s_waitcnt lgkmcnt(" #n ")" ::: "memory")
#define PG8_BAR __builtin_amdgcn_s_barrier()
#define PG8_SCHED __builtin_amdgcn_sched_barrier(0)
    Unit cur, nxt; int ui = 0;
    if (!S.next(0, cur)) return;
    f32x4 acc[2][2][4][2];
#pragma unroll
    for (int a = 0; a < 2; ++a)
#pragma unroll
        for (int b = 0; b < 2; ++b)
#pragma unroll
            for (int m = 0; m < 4; ++m)
#pragma unroll
                for (int n = 0; n < 2; ++n) acc[a][b][m][n] = (f32x4){0.f, 0.f, 0.f, 0.f};
    bf16x8 At[4][2], B0[2][2], B1[2][2];
    const char* cA = (const char*)g.A + (size_t)cur.pm * tstep + (size_t)cur.kh * khoff; const char* cB = (const char*)g.Bt + (size_t)cur.pn * tstep + (size_t)cur.kh * khoff;
    S.a_ready(cur);
    if constexpr (SP2) {
        PG8_STAGE(PG8_SB(0, 0), cB, voffB); PG8_STAGE(PG8_SB(0, 1), cB + hstep, voffB); PG8_STAGE(PG8_SA(0, 0), cA, voffA); PG8_STAGE(PG8_SA(0, 1), cA + hstep, voffA);
        if (wr == 1) PG8_BAR;
        PG8_WAIT_V(2); PG8_BAR;
        PG8_STAGE(PG8_SB(1, 0), cB + kstep, voffB); PG8_STAGE(PG8_SA(1, 0), cA + kstep, voffA); PG8_STAGE(PG8_SB(1, 1), cB + hstep + kstep, voffB);
        PG8_WAIT_V(6); PG8_BAR;
    } else {
        PG8_STAGE(PG8_SB(0, 0), cB, voffB); PG8_STAGE(PG8_SA(0, 0), cA, voffA); PG8_STAGE(PG8_SB(0, 1), cB + hstep, voffB); PG8_STAGE(PG8_SA(0, 1), cA + hstep, voffA);
        if (wr == 1) PG8_BAR;
        PG8_WAIT_V(4); PG8_BAR;
        PG8_STAGE(PG8_SB(1, 0), cB + kstep, voffB); PG8_STAGE(PG8_SA(1, 0), cA + kstep, voffA); PG8_STAGE(PG8_SB(1, 1), cB + hstep + kstep, voffB);
        PG8_WAIT_V(6); PG8_BAR;
    }
    for (;;) {
        const bool has_next = S.next(ui + 1, nxt);
        const char* nA = has_next ? (const char*)g.A + (size_t)nxt.pm * tstep + (size_t)nxt.kh * khoff : cA; const char* nB = has_next ? (const char*)g.Bt + (size_t)nxt.pn * tstep + (size_t)nxt.kh * khoff : cB;
        for (int t = 0; t < nt; t += 2) {
            const bool last = (t == nt - 2);
            const char* a1 = cA + (size_t)(t + 1) * kstep;
            const char* a2 = last ? nA : cA + (size_t)(t + 2) * kstep; const char* b2 = last ? nB : cB + (size_t)(t + 2) * kstep;
            const char* a3 = a2 + kstep; const char* b3 = b2 + kstep;
            if (last && has_next) S.a_ready(nxt);
            if constexpr (SP2) {
            PG8_LDB(B0, 0, 0); PG8_LDB(B1, 0, 1); PG8_SCHED; PG8_LDA(At, 0, 0); PG8_STAGE(PG8_SA(1, 1), a1 + hstep, voffA);
            PG8_WAIT_V(8); PG8_WAIT_L(0); PG8_BAR; PG8_MMA(0, 0, At, B0); PG8_MMA(0, 1, At, B1); PG8_BAR; PG8_SCHED;
            PG8_LDA(At, 0, 1); PG8_STAGE(PG8_SB(0, 0), b2, voffB); PG8_STAGE(PG8_SB(0, 1), b2 + hstep, voffB); PG8_STAGE(PG8_SA(0, 0), a2, voffA);
            PG8_WAIT_V(8); PG8_WAIT_L(0); PG8_BAR; PG8_MMA(1, 0, At, B0); PG8_MMA(1, 1, At, B1); PG8_BAR; PG8_SCHED;
            PG8_LDB(B0, 1, 0); PG8_LDB(B1, 1, 1); PG8_SCHED; PG8_LDA(At, 1, 0); PG8_STAGE(PG8_SA(0, 1), a2 + hstep, voffA);
            PG8_WAIT_V(8); PG8_WAIT_L(0); PG8_BAR; PG8_MMA(0, 0, At, B0); PG8_MMA(0, 1, At, B1); PG8_BAR; PG8_SCHED;
            PG8_LDA(At, 1, 1); PG8_STAGE(PG8_SB(1, 0), b3, voffB); PG8_STAGE(PG8_SB(1, 1), b3 + hstep, voffB); PG8_STAGE(PG8_SA(1, 0), a3, voffA);
            PG8_WAIT_V(8); PG8_WAIT_L(0); PG8_BAR; PG8_MMA(1, 0, At, B0); PG8_MMA(1, 1, At, B1); PG8_BAR; PG8_SCHED;
            } else {
            PG8_LDB(B0, 0, 0); PG8_SCHED; PG8_LDA(At, 0, 0); PG8_STAGE(PG8_SA(1, 1), a1 + hstep, voffA);
            PG8_WAIT_L(8); PG8_BAR; PG8_WAIT_L(0); PG8_MMA(0, 0, At, B0); PG8_BAR; PG8_SCHED;
            PG8_LDB(B1, 0, 1); PG8_STAGE(PG8_SB(0, 0), b2, voffB);
            PG8_BAR; PG8_WAIT_L(0); PG8_MMA(0, 1, At, B1); PG8_BAR;
            PG8_LDA(At, 0, 1); PG8_STAGE(PG8_SA(0, 0), a2, voffA);
            PG8_BAR; PG8_WAIT_L(0); PG8_MMA(1, 0, At, B0); PG8_BAR; PG8_SCHED;
            PG8_STAGE(PG8_SB(0, 1), b2 + hstep, voffB);
            PG8_WAIT_V(6); PG8_BAR; PG8_MMA(1, 1, At, B1); PG8_BAR;
            PG8_LDB(B0, 1, 0); PG8_SCHED; PG8_LDA(At, 1, 0); PG8_STAGE(PG8_SA(0, 1), a2 + hstep, voffA);
            PG8_WAIT_L(8); PG8_BAR; PG8_WAIT_L(0); PG8_MMA(0, 0, At, B0); PG8_BAR; PG8_SCHED;
            PG8_LDB(B1, 1, 1); PG8_STAGE(PG8_SB(1, 0), b3, voffB);
            PG8_BAR; PG8_WAIT_L(0); PG8_MMA(0, 1, At, B1); PG8_BAR;
            PG8_LDA(At, 1, 1); PG8_STAGE(PG8_SA(1, 0), a3, voffA);
            PG8_BAR; PG8_WAIT_L(0); PG8_MMA(1, 0, At, B0); PG8_BAR; PG8_SCHED;
            PG8_STAGE(PG8_SB(1, 1), b3 + hstep, voffB);
            PG8_WAIT_V(6); PG8_BAR; PG8_MMA(1, 1, At, B1); PG8_BAR;
            }
        }
        if constexpr (ALIGN_EPI) { if (wr == 0) PG8_BAR; }
        if constexpr (!Epi::AFTER_DRAIN) { E(acc, cur, wr, wc, fr, fq); S.done(cur); }
        if (!has_next) break;
        if (!(Epi::SPLITK2 && cur.kh == 0))
#pragma unroll
        for (int a = 0; a < 2; ++a)
#pragma unroll
            for (int b = 0; b < 2; ++b)
#pragma unroll
                for (int m = 0; m < 4; ++m)
#pragma unroll
                    for (int n = 0; n < 2; ++n) acc[a][b][m][n] = (f32x4){0.f, 0.f, 0.f, 0.f};
        cur = nxt; cA = nA; cB = nB; ++ui;
        if constexpr (ALIGN_EPI) { if (wr == 1) PG8_BAR; }
    }
    PG8_WAIT_V(0);
    if constexpr (!ALIGN_EPI) { if (wr == 0) PG8_BAR; }
    PG8_BAR;
    if constexpr (Epi::AFTER_DRAIN) { E.fused(acc, cur, wr, wc, fr, fq, lds, wid, lane); S.done(cur); }
#undef PG8_SA
#undef PG8_SB
#undef PG8_STAGE
#undef PG8_LDA
#undef PG8_LDB
#undef PG8_MMA
#undef PG8_WAIT_V
#undef PG8_WAIT_L
#undef PG8_BAR
#undef PG8_SCHED
}
}
namespace epi {
using pg8::Unit;
typedef f32x4 Acc[2][2][4][2];

__device__ __forceinline__ void rot2(f32x4& v, const f32x4 cs) {
    const float a1 = v[0] * cs[0] - v[1] * cs[1], a2 = v[1] * cs[0] + v[0] * cs[1];
    const float b1 = v[2] * cs[2] - v[3] * cs[3], b2 = v[3] * cs[2] + v[2] * cs[3];
    v = (f32x4){a1, a2, b1, b2};
}
__device__ __forceinline__ float sigm(float x) { return 1.0f / (1.0f + __expf(-x)); }

struct EpiIn {
    static constexpr bool PERM = true, AFTER_DRAIN = false, SPLITK2 = false;
    bf16_t *cq, *ckv, *qb, *kb, *vb, *qix, *kpe, *kix, *ga, *gb; float* wix; u64 *ssq_cq, *ssq_ckv;
    const float *ropeM, *ropeD, *ropeI;
    __device__ __forceinline__ void operator()(const Acc& acc, const Unit& u, int wr, int wc, int fr, int fq) const {
        const int vt = u.pn, rowb = u.pm * 256 + wr * 64 + fr, ct = wc * 32 + 8 * fq;
        if (vt < 6) {
            bf16_t* dst = vt < 4 ? cq : ckv; const int ld = vt < 4 ? 1024 : 512, cb = (vt < 4 ? vt : vt - 4) * 256 + ct; u64* ssq = vt < 4 ? ssq_cq : ssq_ckv;
#pragma unroll
            for (int ai = 0; ai < 2; ++ai)
#pragma unroll
                for (int m = 0; m < 4; ++m) { const int row = rowb + ai * 128 + m * 16; float s = 0.f;
#pragma unroll
                    for (int bj = 0; bj < 2; ++bj) { const f32x4 v0 = acc[ai][bj][m][0], v1 = acc[ai][bj][m][1];
                        s += (v0[0] * v0[0] + v0[1] * v0[1]) + (v0[2] * v0[2] + v0[3] * v0[3]) + (v1[0] * v1[0] + v1[1] * v1[1]) + (v1[2] * v1[2] + v1[3] * v1[3]);
                        *(u32x4*)(dst + (size_t)row * ld + cb + bj * 128) = pack8(v0, v1); }
                    s += __shfl_xor(s, 16); s += __shfl_xor(s, 32);
                    if (fq == 0) ssq_add(ssq + row, s); }
        } else if (vt < 16) {
            const bool isq = vt < 14; bf16_t* dst = isq ? qb : kb; const int ld = isq ? 2048 : 512, cb = (isq ? vt - 6 : vt - 14) * 256 + ct; const float sc = isq ? QB_SCALE : 1.f;
#pragma unroll
            for (int ai = 0; ai < 2; ++ai)
#pragma unroll
                for (int m = 0; m < 4; ++m) { const int row = rowb + ai * 128 + m * 16, t = row % TP;
                    f32x4 cs0 = (f32x4){1.f, 0.f, 1.f, 0.f}, cs1 = cs0;
                    if (wc == 0) { const f32x4* p = (const f32x4*)(ropeD + ((size_t)t * 16 + 4 * fq) * 2); cs0 = p[0]; cs1 = p[1]; }
#pragma unroll
                    for (int bj = 0; bj < 2; ++bj) { f32x4 v0 = acc[ai][bj][m][0], v1 = acc[ai][bj][m][1];
                        if (wc == 0) { rot2(v0, cs0); rot2(v1, cs1); }
                        v0 = v0 * sc; v1 = v1 * sc;
                        *(u32x4*)(dst + (size_t)row * ld + cb + bj * 128) = pack8(v0, v1); } }
        } else if (vt < 18) {
            const int cb = (vt - 16) * 256 + ct;
#pragma unroll
            for (int ai = 0; ai < 2; ++ai)
#pragma unroll
                for (int m = 0; m < 4; ++m) { const int row = rowb + ai * 128 + m * 16;
#pragma unroll
                    for (int bj = 0; bj < 2; ++bj) *(u32x4*)(vb + (size_t)row * 512 + cb + bj * 128) = pack8(acc[ai][bj][m][0], acc[ai][bj][m][1]); }
        } else if (vt < 22) {
            const int cb = (vt - 18) * 256 + ct; const bool rt = ((wc & 1) == 0) && (fq < 2);
#pragma unroll
            for (int ai = 0; ai < 2; ++ai)
#pragma unroll
                for (int m = 0; m < 4; ++m) { const int row = rowb + ai * 128 + m * 16, t = row % TP;
                    f32x4 cs0 = (f32x4){1.f, 0.f, 1.f, 0.f}, cs1 = cs0;
                    if (rt) { const f32x4* p = (const f32x4*)(ropeI + ((size_t)t * 8 + 4 * fq) * 2); cs0 = p[0]; cs1 = p[1]; }
#pragma unroll
                    for (int bj = 0; bj < 2; ++bj) { f32x4 v0 = acc[ai][bj][m][0], v1 = acc[ai][bj][m][1];
                        if (rt) { rot2(v0, cs0); rot2(v1, cs1); }
                        *(u32x4*)(qix + (size_t)row * 1024 + cb + bj * 128) = pack8(v0, v1); } }
        } else if (vt == 22) {
#pragma unroll
            for (int ai = 0; ai < 2; ++ai)
#pragma unroll
                for (int m = 0; m < 4; ++m) { const int row = rowb + ai * 128 + m * 16, t = row % TP;
                    f32x4 v0 = acc[ai][0][m][0], v1 = acc[ai][0][m][1];
                    if (wc < 2) { const f32x4* p = (const f32x4*)(ropeM + ((size_t)t * 32 + 16 * wc + 4 * fq) * 2); rot2(v0, p[0]); rot2(v1, p[1]);
                        *(u32x4*)(kpe + (size_t)row * 64 + ct) = pack8(v0, v1);
                    } else { if (wc == 2 && fq < 2) { const f32x4* p = (const f32x4*)(ropeI + ((size_t)t * 8 + 4 * fq) * 2); rot2(v0, p[0]); rot2(v1, p[1]); }
                        *(u32x4*)(kix + (size_t)row * 64 + (ct - 64)) = pack8(v0, v1); }
                    if (wc == 0 && fq < 2) { float* w = wix + (size_t)row * 16 + 8 * fq; *(f32x4*)w = acc[ai][1][m][0]; *(f32x4*)(w + 4) = acc[ai][1][m][1]; } }
        } else {
            const bool isa = vt < 39; bf16_t* dst = isa ? ga : gb; const int cb = (isa ? vt - 23 : vt - 39) * 256 + ct;
#pragma unroll
            for (int ai = 0; ai < 2; ++ai)
#pragma unroll
                for (int m = 0; m < 4; ++m) { const int row = rowb + ai * 128 + m * 16;
#pragma unroll
                    for (int bj = 0; bj < 2; ++bj) { f32x4 v0 = acc[ai][bj][m][0], v1 = acc[ai][bj][m][1];
#pragma unroll
                        for (int e = 0; e < 4; ++e) { v0[e] = sigm(v0[e]); v1[e] = sigm(v1[e]); }
                        *(u32x4*)(dst + (size_t)row * 4096 + cb + bj * 128) = pack8(v0, v1); } }
        }
    }
};

struct EpiUp {
    static constexpr bool PERM = true, AFTER_DRAIN = false, SPLITK2 = false;
    bf16_t *d0, *d1; int nt0, ld0, ld1; const u64* ssq; float invK, scale; const float* rope;
    __device__ __forceinline__ void operator()(const Acc& acc, const Unit& u, int wr, int wc, int fr, int fq) const {
        const int vt = u.pn, rowb = u.pm * 256 + wr * 64 + fr, ct = wc * 32 + 8 * fq; const bool first = vt < nt0;
        bf16_t* dst = first ? d0 : d1; const int ld = first ? ld0 : ld1, cb = (first ? vt : vt - nt0) * 256 + ct; const bool rt = (!first) && (rope != nullptr);
#pragma unroll
        for (int ai = 0; ai < 2; ++ai)
#pragma unroll
            for (int m = 0; m < 4; ++m) { const int row = rowb + ai * 128 + m * 16, t = row % TP;
                const float rs = __builtin_amdgcn_rsqf(ssq_get(ssq + row) * invK + EPS) * scale;
                f32x4 cs0 = (f32x4){1.f, 0.f, 1.f, 0.f}, cs1 = cs0;
                if (rt) { const f32x4* p = (const f32x4*)(rope + ((size_t)t * 32 + 16 * (wc & 1) + 4 * fq) * 2); cs0 = p[0]; cs1 = p[1]; }
#pragma unroll
                for (int bj = 0; bj < 2; ++bj) { f32x4 v0 = acc[ai][bj][m][0] * rs, v1 = acc[ai][bj][m][1] * rs;
                    if (rt) { rot2(v0, cs0); rot2(v1, cs1); }
                    *(u32x4*)(dst + (size_t)row * ld + cb + bj * 128) = pack8(v0, v1); } }
    }
};

struct EpiBranch {
    static constexpr bool PERM = true, AFTER_DRAIN = false, SPLITK2 = true;
    const bf16_t *ga, *gb; bf16_t* out;
    __device__ __forceinline__ void operator()(Acc& acc, const Unit& u, int wr, int wc, int fr, int fq) const {
        const int rowb = u.pm * 256 + wr * 64 + fr, cb = u.pn * 256 + wc * 32 + 8 * fq;
        if (u.kh == 0) {
#pragma unroll
            for (int ai = 0; ai < 2; ++ai)
#pragma unroll
                for (int m = 0; m < 4; ++m) { const size_t ro = (size_t)(rowb + ai * 128 + m * 16) * 4096 + cb;
#pragma unroll
                    for (int bj = 0; bj < 2; ++bj) { const u32x4 a = *(const u32x4*)(ga + ro + bj * 128), b = *(const u32x4*)(gb + ro + bj * 128);
                        f32x4 r0, r1;
#define RQ(x, y) ((x) * __builtin_amdgcn_rcpf(y))
                        r0[0] = RQ(bf_lo(a.x), bf_lo(b.x)); r0[1] = RQ(bf_hi(a.x), bf_hi(b.x)); r0[2] = RQ(bf_lo(a.y), bf_lo(b.y)); r0[3] = RQ(bf_hi(a.y), bf_hi(b.y));
                        r1[0] = RQ(bf_lo(a.z), bf_lo(b.z)); r1[1] = RQ(bf_hi(a.z), bf_hi(b.z)); r1[2] = RQ(bf_lo(a.w), bf_lo(b.w)); r1[3] = RQ(bf_hi(a.w), bf_hi(b.w));
#undef RQ
                        acc[ai][bj][m][0] = acc[ai][bj][m][0] * r0; acc[ai][bj][m][1] = acc[ai][bj][m][1] * r1; }
                    asm volatile("" ::: "memory"); }
        } else {
#pragma unroll
            for (int ai = 0; ai < 2; ++ai)
#pragma unroll
                for (int m = 0; m < 4; ++m) { const size_t ro = (size_t)(rowb + ai * 128 + m * 16) * 4096 + cb;
#pragma unroll
                    for (int bj = 0; bj < 2; ++bj) { const u32x4 b = *(const u32x4*)(gb + ro + bj * 128);
                        const f32x4 s0 = (f32x4){bf_lo(b.x), bf_hi(b.x), bf_lo(b.y), bf_hi(b.y)}, s1 = (f32x4){bf_lo(b.z), bf_hi(b.z), bf_lo(b.w), bf_hi(b.w)};
                        *(u32x4*)(out + ro + bj * 128) = pack8(acc[ai][bj][m][0] * s0, acc[ai][bj][m][1] * s1); } }
        }
    }
};

struct EpiOut {
    static constexpr bool PERM = true, AFTER_DRAIN = false, SPLITK2 = false;
    const float *x, *meta; float* h1f; bf16_t* h1b; u64* ssq;
    __device__ __forceinline__ void operator()(const Acc& acc, const Unit& u, int wr, int wc, int fr, int fq) const {
        const int rowb = u.pm * 256 + wr * 64 + fr, cb = u.pn * 256 + wc * 32 + 8 * fq;
#pragma unroll
        for (int ai = 0; ai < 2; ++ai)
#pragma unroll
            for (int m = 0; m < 4; ++m) { const int row = rowb + ai * 128 + m * 16, b = row / TP, t = row % TP;
                const float* src = t < NMETA ? meta + (size_t)t * DM : (t < TR ? x + ((size_t)b * SEQ + (t - NMETA)) * DM : nullptr);
                float s = 0.f;
#pragma unroll
                for (int bj = 0; bj < 2; ++bj) { f32x4 v0 = acc[ai][bj][m][0], v1 = acc[ai][bj][m][1];
                    if (src) { v0 = v0 + *(const f32x4*)(src + cb + bj * 128); v1 = v1 + *(const f32x4*)(src + cb + bj * 128 + 4); }
                    s += (v0[0] * v0[0] + v0[1] * v0[1]) + (v0[2] * v0[2] + v0[3] * v0[3]) + (v1[0] * v1[0] + v1[1] * v1[1]) + (v1[2] * v1[2] + v1[3] * v1[3]);
                    float* o = h1f + (size_t)row * DM + cb + bj * 128; *(f32x4*)o = v0; *(f32x4*)(o + 4) = v1;
                    *(u32x4*)(h1b + (size_t)row * DM + cb + bj * 128) = pack8(v0, v1); }
                s += __shfl_xor(s, 16); s += __shfl_xor(s, 32);
                if (fq == 0) ssq_add(ssq + row, s); }
    }
};

struct EpiPQ {
    static constexpr bool PERM = true, AFTER_DRAIN = false, SPLITK2 = false;
    bf16_t* pq; const u64* ssq;
    __device__ __forceinline__ void operator()(const Acc& acc, const Unit& u, int wr, int wc, int fr, int fq) const {
        const int rowb = u.pm * 256 + wr * 64 + fr, cb = u.pn * 256 + wc * 32 + 8 * fq;
#pragma unroll
        for (int ai = 0; ai < 2; ++ai)
#pragma unroll
            for (int m = 0; m < 4; ++m) { const int row = rowb + ai * 128 + m * 16; const float rs = __builtin_amdgcn_rsqf(ssq_get(ssq + row) * (1.0f / DM) + EPS);
#pragma unroll
                for (int bj = 0; bj < 2; ++bj) *(u32x4*)(pq + (size_t)row * 2048 + cb + bj * 128) = pack8(acc[ai][bj][m][0] * rs, acc[ai][bj][m][1] * rs); }
    }
};
}
#define XB_TMO      128
#define XB_XCNT(j)  (256  + 64 * (j))
#define XB_XSUB(j)  (1280 + 64 * (j))
#define XB_XGEN(j)  (2304 + 64 * (j))
#define XB_TOP      3328
#define XB_TOPGEN   3392
#define XCD_BAR_WORDS 3456
#define XB_SPIN_CAP (1u << 18)
__device__ __forceinline__ unsigned xb_ld(unsigned* p)              { return __hip_atomic_load(p, __ATOMIC_RELAXED, __HIP_MEMORY_SCOPE_AGENT); }
__device__ __forceinline__ unsigned xb_add(unsigned* p, unsigned v) { return __hip_atomic_fetch_add(p, v, __ATOMIC_RELAXED, __HIP_MEMORY_SCOPE_AGENT); }
__device__ __forceinline__ unsigned xb_xcc_id() { return (unsigned)__builtin_amdgcn_s_getreg((3 << 11) | 20) & 0xFu; }
#define XB_SPIN(cond, bar) do { unsigned _sp = 0; while (cond) { __builtin_amdgcn_s_sleep(1); \
    if ((++_sp & 255u) == 0u) { if (xb_ld(&(bar)[XB_TMO])) break; if (_sp > XB_SPIN_CAP) { atomicAdd(&(bar)[XB_TMO], 1u); break; } } } } while (0)
struct XcdBarrier { unsigned* bar; unsigned x; volatile LAS unsigned* st; };
__device__ __forceinline__ XcdBarrier xcd_barrier_post(unsigned* bar, volatile LAS unsigned* st) {
    XcdBarrier b; b.bar = bar; b.x = xb_xcc_id(); b.st = st;
    if (threadIdx.x == 0) (void)xb_add(&bar[XB_XCNT(b.x)], 1u);
    return b;
}
__device__ __forceinline__ void xcd_barrier_complete(unsigned* bar, unsigned x, unsigned& nloc, unsigned& nx) {
    const unsigned G = gridDim.x * gridDim.y * gridDim.z;
    unsigned sum, cnt, mine, sp = 0u;
    for (;;) {
        sum = 0u; cnt = 0u; mine = 0u;
#pragma unroll
        for (unsigned j = 0; j < 16; ++j) { const unsigned c = xb_ld(&bar[XB_XCNT(j)]); sum += c; cnt += (c > 0u) ? 1u : 0u; mine = (j == x) ? c : mine; }
        if (sum == G) break;
        __builtin_amdgcn_s_sleep(1);
        if ((++sp & 255u) == 0u) { if (xb_ld(&bar[XB_TMO])) break; if (sp > XB_SPIN_CAP) { atomicAdd(&bar[XB_TMO], 1u); break; } }
    }
    nloc = mine > 0u ? mine : 1u; nx = cnt > 0u ? cnt : 1u;
}
__device__ __forceinline__ void xcd_barrier(const XcdBarrier& b) {
    asm volatile("s_waitcnt vmcnt(0)" ::: "memory");
    __syncthreads();
    if (threadIdx.x == 0) {
        unsigned* bar = b.bar;
        __builtin_amdgcn_s_waitcnt(0);
        unsigned nloc = b.st[0], nx = b.st[1];
        if (nloc == 0u) { xcd_barrier_complete(bar, b.x, nloc, nx); b.st[0] = nloc; b.st[1] = nx; }
        const unsigned old = xb_add(&bar[XB_XSUB(b.x)], 1u);
        const unsigned gen = old / nloc;
        if (old + 1u == (gen + 1u) * nloc) {
            __builtin_amdgcn_fence(__ATOMIC_RELEASE, "agent");
            asm volatile("s_waitcnt vmcnt(0)" ::: "memory");
            const unsigned og = xb_add(&bar[XB_TOP], 1u);
            const unsigned tg = og / nx;
            if (og + 1u == (tg + 1u) * nx) xb_add(&bar[XB_TOPGEN], 1u);
            else XB_SPIN(xb_ld(&bar[XB_TOPGEN]) == tg, bar);
            __builtin_amdgcn_fence(__ATOMIC_ACQUIRE, "agent");
            xb_add(&bar[XB_XGEN(b.x)], 1u);
            asm volatile("s_waitcnt vmcnt(0)" ::: "memory");
        } else {
            XB_SPIN(xb_ld(&bar[XB_XGEN(b.x)]) == gen, bar);
            __builtin_amdgcn_fence(__ATOMIC_ACQUIRE, "agent");
            asm volatile("s_waitcnt vmcnt(0)" ::: "memory");
        }
    }
    __syncthreads();
}

struct Frame {
    LAS unsigned char* lds;
    unsigned char* ws;
    unsigned* ctl;
    int tid, lane, wave, vcu, G;
    __device__ __forceinline__ const float* in(int i) const { return ((const float* const __attribute__((address_space(4)))*)__builtin_amdgcn_kernarg_segment_ptr())[i]; }
    __device__ __forceinline__ float* out() const { return ((float* const __attribute__((address_space(4)))*)__builtin_amdgcn_kernarg_segment_ptr())[16]; }
};

struct MapId { __device__ __forceinline__ int operator()(int v) const { return v; } };
struct MapIn { __device__ __forceinline__ int operator()(int v) const {
    if (v < 1536) return v;
    if (v < 3584) { const int w = v - 1536, hd = w >> 7; int o = w & 127; if (o < 32) o = (o & 1) ? (o >> 1) + 16 : (o >> 1); return 1600 + hd * 128 + o; }
    if (v < 4096) { const int w = v - 3584, hd = w >> 7; int o = w & 127; if (o < 32) o = (o & 1) ? (o >> 1) + 16 : (o >> 1); return 3648 + hd * 128 + o; }
    if (v < 4608) return 4160 + (v - 4096);
    if (v < 5632) { const int w = v - 4608, hd = w >> 6; int o = w & 63; if (o < 16) o = (o & 1) ? (o >> 1) + 8 : (o >> 1); return 4672 + hd * 64 + o; }
    if (v < 5888) { const int w = v - 5632;
        if (w < 64) return 1536 + ((w & 1) ? (w >> 1) + 32 : (w >> 1));
        if (w < 128) { int o = w - 64; if (o < 16) o = (o & 1) ? (o >> 1) + 8 : (o >> 1); return 5696 + o; }
        if (w < 144) return 5760 + (w - 128);
        return -1; }
    if (v < 9984) return 5776 + (v - 5888);
    return 9872 + (v - 9984);
} };
struct MapUq { __device__ __forceinline__ int operator()(int v) const {
    if (v < 2048) return (v >> 7) * 192 + (v & 127);
    const int w = v - 2048, hd = w >> 6, o = w & 63; return hd * 192 + 128 + ((o & 1) ? (o >> 1) + 32 : (o >> 1)); } };
struct MapUkv { __device__ __forceinline__ int operator()(int v) const {
    if (v < 2048) return (v >> 7) * 256 + (v & 127);
    const int w = v - 2048; return (w >> 7) * 256 + 128 + (w & 127); } };

template <class Map>
__device__ __forceinline__ void p0_transpose_item(const float* W, int K, int Nsrc, int Nvirt, bf16_t* WT, const float* gk, LAS float* scr, int item, int lane, Map map) {
    const int nblk = Nvirt / 32, kb = item / nblk, nb = item % nblk, k0 = 64 * kb, n0 = 32 * nb;
    const int sc = map(n0 + (lane & 31));
#pragma unroll 8
    for (int i = 0; i < 32; ++i) { const int kk = 2 * i + (lane >> 5); float v = 0.f;
        if (sc >= 0) v = W[(size_t)(k0 + kk) * Nsrc + sc];
        if (gk) v *= gk[k0 + kk];
        scr[kk * 33 + (lane & 31)] = v; }
    LDS_WAIT(); asm volatile("" ::: "memory");
    const int c = lane & 7;
#pragma unroll
    for (int j = 0; j < 4; ++j) { const int n = (lane >> 3) + 8 * j; const LAS float* s = scr + (8 * c) * 33 + n;
        u32x4 o; o.x = pk2(s[0 * 33], s[1 * 33]); o.y = pk2(s[2 * 33], s[3 * 33]); o.z = pk2(s[4 * 33], s[5 * 33]); o.w = pk2(s[6 * 33], s[7 * 33]);
        *(u32x4*)(WT + (size_t)(n0 + n) * K + k0 + 8 * c) = o; }
    LDS_WAIT(); asm volatile("" ::: "memory");
}
__device__ __forceinline__ void p0_xn_row(const Frame& F, int m) {
    const int b = m / TP, t = m % TP; const float* x = F.in(0); const float* meta = F.in(1); const float* g = F.in(2);
    bf16_t* o = (bf16_t*)(F.ws + WS_XN) + (size_t)m * DM;
    u32x2* o8 = (u32x2*)o + F.lane;
    if (t >= TR) {
#pragma unroll
        for (int j = 0; j < 16; ++j) o8[64 * j] = (u32x2){0u, 0u};
        return; }
    const float* src = t < NMETA ? meta + (size_t)t * DM : x + ((size_t)b * SEQ + (t - NMETA)) * DM;
    const f32x4* xr = (const f32x4*)src + F.lane; const f32x4* gr = (const f32x4*)g + F.lane;
    f32x4 v[16]; float s = 0.f;
#pragma unroll
    for (int j = 0; j < 16; ++j) { v[j] = xr[64 * j]; s += (v[j][0] * v[j][0] + v[j][1] * v[j][1]) + (v[j][2] * v[j][2] + v[j][3] * v[j][3]); }
    const float rstd = 1.0f / sqrtf(wave_sum(s) * (1.0f / DM) + EPS);
#pragma unroll
    for (int j = 0; j < 16; ++j) { const f32x4 gg = gr[64 * j]; const f32x4 y = v[j] * rstd * gg; o8[64 * j] = (u32x2){pk2(y[0], y[1]), pk2(y[2], y[3])}; }
}
__device__ __forceinline__ void p0_prologue(const Frame& F) {
    LAS float* scr = (LAS float*)(F.lds + F.wave * 16384);
    const int gw = F.vcu * NWAVES + F.wave, NGW = F.G * NWAVES;
    const float* w_in = F.in(3); const float* qg = F.in(4); const float* w_uq = F.in(5); const float* kvg = F.in(6); const float* w_ukv = F.in(7);
    const float* w_br = F.in(8); const float* w_out = F.in(9); const float* fg = F.in(10); const float* w_q = F.in(11); const float* sk = F.in(12);
    constexpr int I_IN = 64 * (NV1 / 32), I_UQ = 16 * (3072 / 32), I_UKV = 8 * (4096 / 32), I_BR = 64 * 128, I_OUT = 64 * 128, I_Q = 64 * 64;
    constexpr int NITEMS = I_IN + I_UQ + I_UKV + I_BR + I_OUT + I_Q;
    for (int it = gw; it < NITEMS; it += NGW) {
        int r = it;
        if (r < I_IN) { p0_transpose_item(w_in, 4096, 13968, NV1, (bf16_t*)(F.ws + WS_WIN), nullptr, scr, r, F.lane, MapIn()); continue; } r -= I_IN;
        if (r < I_UQ) { p0_transpose_item(w_uq, 1024, 3072, 3072, (bf16_t*)(F.ws + WS_WUQ), qg, scr, r, F.lane, MapUq()); continue; } r -= I_UQ;
        if (r < I_UKV) { p0_transpose_item(w_ukv, 512, 4096, 4096, (bf16_t*)(F.ws + WS_WUKV), kvg, scr, r, F.lane, MapUkv()); continue; } r -= I_UKV;
        if (r < I_BR) { p0_transpose_item(w_br, 4096, 4096, 4096, (bf16_t*)(F.ws + WS_WBR), nullptr, scr, r, F.lane, MapId()); continue; } r -= I_BR;
        if (r < I_OUT) { p0_transpose_item(w_out, 4096, 4096, 4096, (bf16_t*)(F.ws + WS_WOUT), nullptr, scr, r, F.lane, MapId()); continue; } r -= I_OUT;
        p0_transpose_item(w_q, 4096, 2048, 2048, (bf16_t*)(F.ws + WS_WQ), fg, scr, r, F.lane, MapId());
    }
    for (int m = gw; m < M; m += NGW) p0_xn_row(F, m);
    const int gt = (F.vcu * NWAVES + F.wave) * 64 + F.lane, NGT = NGW * 64;
    for (int i = gt; i < TP * 56; i += NGT) {
        const int t = i / 56, r = i % 56; int j, rot; float* dst;
        if (r < 32) { j = r; rot = 64; dst = (float*)(F.ws + WS_ROPE_M) + ((size_t)t * 32 + j) * 2; }
        else if (r < 48) { j = r - 32; rot = 32; dst = (float*)(F.ws + WS_ROPE_D) + ((size_t)t * 16 + j) * 2; }
        else { j = r - 48; rot = 16; dst = (float*)(F.ws + WS_ROPE_I) + ((size_t)t * 8 + j) * 2; }
        const float ex = (float)(2 * j) / (float)rot;
        const float inv = powf(500000.0f, -ex);
        const float ang = (float)t * inv;
        const double a = (double)ang, kq = rint(a * 0.15915494309189535), rr = fma(-kq, 6.283185307179586, a);
        const float rf = (float)rr;
        dst[0] = cosf(rf); dst[1] = sinf(rf);
    }
    for (int i = gt; i < 16 * 128 * 128 / 8; i += NGT) { const f32x4* s = (const f32x4*)sk + 2 * (size_t)i; const f32x4 a = s[0], b2 = s[1];
        u32x4 o; o.x = pk2(a[0], a[1]); o.y = pk2(a[2], a[3]); o.z = pk2(b2[0], b2[1]); o.w = pk2(b2[2], b2[3]); ((u32x4*)(F.ws + WS_SK))[i] = o; }
}
__device__ __forceinline__ float wave_max(float v) {
#pragma unroll
    for (int o = 1; o < 64; o <<= 1) v = fmaxf(v, __shfl_xor(v, o));
    return v;
}
__device__ __forceinline__ void p6_quant_row(const float* src, const float* gain, unsigned* dst, float* scale_out, int lane) {
    const f32x4* s = (const f32x4*)src + lane; f32x4 v[16]; float mx = 0.f;
#pragma unroll
    for (int j = 0; j < 16; ++j) { v[j] = s[64 * j]; if (gain) v[j] = v[j] * ((const f32x4*)gain)[lane + 64 * j];
        mx = fmaxf(mx, fmaxf(fmaxf(fabsf(v[j][0]), fabsf(v[j][1])), fmaxf(fabsf(v[j][2]), fabsf(v[j][3])))); }
    mx = fmaxf(wave_max(mx), 1e-30f);
    const float sc = mx * (1.0f / 448.0f), inv = 448.0f / mx;
    if (lane == 0) *scale_out = sc;
#pragma unroll
    for (int j = 0; j < 16; ++j) { f32x4 q = v[j] * inv;
#pragma unroll
        for (int e = 0; e < 4; ++e) q[e] = fminf(fmaxf(q[e], -448.0f), 448.0f);
        int p = 0; p = __builtin_amdgcn_cvt_pk_fp8_f32(q[0], q[1], p, false); p = __builtin_amdgcn_cvt_pk_fp8_f32(q[2], q[3], p, true);
        dst[lane + 64 * j] = (unsigned)p; }
}
__device__ __forceinline__ void p6_tables(const Frame& F) {
    const float* fg = F.in(10); const float* pu = F.in(13); const float* pv = F.in(14);
    const int gw = F.vcu * NWAVES + F.wave, NGW = F.G * NWAVES;
    for (int it = gw; it < 2 * 16384; it += NGW) { const int e = it >> 1;
        if (it & 1) p6_quant_row(pv + (size_t)e * DM, nullptr, (unsigned*)(F.ws + WS_V) + (size_t)e * 1024, (float*)(F.ws + WS_SCV) + e, F.lane);
        else p6_quant_row(pu + (size_t)e * DM, fg, (unsigned*)(F.ws + WS_U) + (size_t)e * 1024, (float*)(F.ws + WS_SCU) + e, F.lane); }
}
#define MFMA32(a, b, c) __builtin_amdgcn_mfma_f32_32x32x16_bf16((a), (b), (c), 0, 0, 0)
__device__ __forceinline__ int crow(int i, int h) { return (i & 3) + 8 * (i >> 2) + 4 * h; }
__device__ __forceinline__ float half_sum_f(float v) {
#pragma unroll
    for (int o = 1; o < 32; o <<= 1) v += __shfl_xor(v, o);
    return v;
}
__device__ __forceinline__ int half_sum_i(int v) {
#pragma unroll
    for (int o = 1; o < 32; o <<= 1) v += __shfl_xor(v, o);
    return v;
}
__device__ __forceinline__ float half_max_f(float v) {
#pragma unroll
    for (int o = 1; o < 32; o <<= 1) v = fmaxf(v, __shfl_xor(v, o));
    return v;
}
__device__ __forceinline__ float half_min_f(float v) {
#pragma unroll
    for (int o = 1; o < 32; o <<= 1) v = fminf(v, __shfl_xor(v, o));
    return v;
}
__device__ __forceinline__ void idx_task(const Frame& F, int b, int t0) {
    const int lane = F.lane, r = lane & 31, h = lane >> 5;
    const bf16_t* qix = (const bf16_t*)(F.ws + WS_QIX); const bf16_t* kix = (const bf16_t*)(F.ws + WS_KIX); const float* wix = (const float*)(F.ws + WS_WIX);
    unsigned* mask = (unsigned*)(F.ws + WS_MASK);
    const int tok = (r >> 2) & 1, head = (r & 3) + 4 * (r >> 3);
    const bf16_t* qp = qix + (size_t)(b * TP + t0 + tok) * 1024 + head * 64 + 8 * h;
    bf16x8 af[4];
#pragma unroll
    for (int ks = 0; ks < 4; ++ks) af[ks] = *(const bf16x8*)(qp + 16 * ks);
    const f32x4* wp = (const f32x4*)(wix + (size_t)(b * TP + t0 + h) * 16);
    float w[16];
#pragma unroll
    for (int q = 0; q < 4; ++q) { const f32x4 x = wp[q]; w[4 * q] = x[0]; w[4 * q + 1] = x[1]; w[4 * q + 2] = x[2]; w[4 * q + 3] = x[3]; }
    const int tq = t0 + h;
    const int ngrp = ((t0 + 1) >> 6) + 1;
    const bf16_t* kbase = kix + (size_t)(b * TP + r) * 64 + 8 * h;
    float row[MW];
#pragma unroll
    for (int g = 0; g < MW / 2; ++g) {
        float s0 = -INFINITY, s1 = -INFINITY;
        if (g < ngrp) {
            const bf16_t* kp = kbase + (size_t)(g * 64) * 64;
            bf16x8 b0[4], b1[4];
#pragma unroll
            for (int ks = 0; ks < 4; ++ks) { b0[ks] = *(const bf16x8*)(kp + 16 * ks); b1[ks] = *(const bf16x8*)(kp + 32 * 64 + 16 * ks); }
            float x0 = 0.f, x1 = 0.f;
            { f32x16 a0;
#pragma unroll
              for (int i = 0; i < 16; ++i) a0[i] = 0.f;
#pragma unroll
              for (int ks = 0; ks < 4; ++ks) a0 = MFMA32(af[ks], b0[ks], a0);
#pragma unroll
              for (int i = 0; i < 16; ++i) x0 += w[i] * fmaxf(a0[i], 0.f); }
            { f32x16 a1;
#pragma unroll
              for (int i = 0; i < 16; ++i) a1[i] = 0.f;
#pragma unroll
              for (int ks = 0; ks < 4; ++ks) a1 = MFMA32(af[ks], b1[ks], a1);
#pragma unroll
              for (int i = 0; i < 16; ++i) x1 += w[i] * fmaxf(a1[i], 0.f); }
            s0 = (g * 64 + r <= tq) ? x0 : -INFINITY; s1 = (g * 64 + 32 + r <= tq) ? x1 : -INFINITY;
        }
        row[2 * g] = s0; row[2 * g + 1] = s1;
    }
    float tau = -3.0e38f;
    bool done = (tq + 1 <= 256);
    float mx = -INFINITY, mn = INFINITY;
#pragma unroll
    for (int k = 0; k < MW; ++k) { const float v = row[k]; mx = fmaxf(mx, v); mn = fminf(mn, v > -INFINITY ? v : INFINITY); }
    float lo = half_min_f(mn), hi = half_max_f(mx);
    if (!done) tau = hi;
    for (int it = 0; it < 64; ++it) {
        if (!__any(!done)) break;
        const float mid = lo + (hi - lo) * 0.5f;
        int c = 0;
#pragma unroll
        for (int k = 0; k < MW; ++k) c += (row[k] >= mid) ? 1 : 0;
        c = half_sum_i(c);
        if (!done) {
            if (!(mid > lo && mid < hi)) { tau = hi; done = true; }
            else if (c == 256) { tau = mid; done = true; }
            else if (c > 256) lo = mid;
            else { hi = mid; tau = hi; }
        }
    }
    unsigned* mrow = mask + (size_t)(b * TP + tq) * MW;
    unsigned mw = 0u;
#pragma unroll
    for (int k = 0; k < MW; ++k) {
        const unsigned long long bal = __ballot(row[k] >= tau);
        const unsigned wd = h ? (unsigned)(bal >> 32) : (unsigned)bal;
        if ((k & 31) == r) mw = wd;
        if ((k & 31) == 31 || k == MW - 1) { const int kk = (k & ~31) + r; if (kk < MW) mrow[kk] = mw; }
    }
}
__device__ __forceinline__ void p2_indexer(const Frame& F) {
    volatile LAS unsigned* qw = (volatile LAS unsigned*)(F.lds + LDSCTL_OFF + 16);
    constexpr int NCH = M / 16;
    for (;;) {
        if (F.tid == 0) qw[0] = atomicAdd(F.ctl + CW_QUEUE, 1u);
        __syncthreads();
        const int c = (int)qw[0];
        __syncthreads();
        if (c >= NCH) break;
        const int b = c & 3, tblk = (TP / 16 - 1) - (c >> 2);
        idx_task(F, b, tblk * 16 + 2 * F.wave);
    }
}
template <bool MLA> struct AttnCfg {
    static constexpr int DQK = MLA ? 192 : 128, PK = DQK * 2 + 16, PV = 320, KCH = DQK / 8, NKC = 64 * KCH / 512, KBYTES = 64 * PK, BUFB = 64 * PK + 64 * PV;
};
struct AttnUnit { int type, b, hx, blk; };

template <bool MLA>
__device__ __forceinline__ void attn_unit(const Frame& F, const AttnUnit u) {
    typedef AttnCfg<MLA> C;
    const int tid = F.tid, lane = F.lane, wave = F.wave, r = lane & 31, h = lane >> 5;
    LAS unsigned char* lds = F.lds;
    const bf16_t* qn = (const bf16_t*)(F.ws + WS_QN); const bf16_t* qr = (const bf16_t*)(F.ws + WS_QR); const bf16_t* kn = (const bf16_t*)(F.ws + WS_KN);
    const bf16_t* va = (const bf16_t*)(F.ws + WS_VA); const bf16_t* kpe = (const bf16_t*)(F.ws + WS_KPE);
    const bf16_t* qb = (const bf16_t*)(F.ws + WS_QB); const bf16_t* kb = (const bf16_t*)(F.ws + WS_KB); const bf16_t* vb = (const bf16_t*)(F.ws + WS_VB);
    const unsigned* mask = (const unsigned*)(F.ws + WS_MASK); bf16_t* oab = (bf16_t*)(F.ws + WS_OAB);
    const int b = u.b;
    const size_t rowb = (size_t)b * TP;
    int head, tw0, ntiles;
    if (MLA) { head = u.hx; tw0 = u.blk * 256 + 32 * wave; const int tend = (u.blk * 256 + 256 < TP) ? u.blk * 256 + 256 : TP; ntiles = tend / 64; }
    else { head = 4 * u.hx + (wave & 3); tw0 = u.blk * 64 + 32 * (wave >> 2); ntiles = u.blk + 1; }
    const bool active = tw0 < TP;
    const int tq = tw0 + r;
    bf16x8 qf[C::DQK / 16];
    if (active) {
        if (MLA) {
            const bf16_t* p0 = qn + (rowb + tq) * 2048 + head * 128 + 8 * h; const bf16_t* p1 = qr + (rowb + tq) * 1024 + head * 64 + 8 * h;
#pragma unroll
            for (int ks = 0; ks < 8; ++ks) qf[ks] = *(const bf16x8*)(p0 + 16 * ks);
#pragma unroll
            for (int ks = 0; ks < 4; ++ks) qf[8 + ks] = *(const bf16x8*)(p1 + 16 * ks);
        } else {
            const bf16_t* p0 = qb + (rowb + tq) * 2048 + head * 128 + 8 * h;
#pragma unroll
            for (int ks = 0; ks < 8; ++ks) qf[ks] = *(const bf16x8*)(p0 + 16 * ks);
        }
    } else {
#pragma unroll
        for (int ks = 0; ks < C::DQK / 16; ++ks) qf[ks] = (bf16x8){0, 0, 0, 0, 0, 0, 0, 0};
    }
    const int ldkv = MLA ? 2048 : 512;
    const bf16_t* kbase = (MLA ? kn + rowb * 2048 + head * 128 : kb + rowb * 512 + u.hx * 128);
    const bf16_t* vbase = (MLA ? va + rowb * 2048 + head * 128 : vb + rowb * 512 + u.hx * 128);
    const bf16_t* pbase = kpe + rowb * 64;
    unsigned soff[2]; int kdst[2], vdst[2];
#pragma unroll
    for (int i = 0; i < 2; ++i) { const int c = tid + 512 * i, key = c >> 4, pc = c & 15; soff[i] = (unsigned)(key * ldkv + pc * 8); kdst[i] = key * C::PK + pc * 16; vdst[i] = C::KBYTES + key * C::PV + pc * 16; }
    const unsigned poff = (unsigned)((tid >> 3) * 64 + (tid & 7) * 8); const int pdst = (tid >> 3) * C::PK + 256 + (tid & 7) * 16;
    u32x4 kst[2], vst[2], pst = (u32x4){0u, 0u, 0u, 0u};
#pragma unroll
    for (int i = 0; i < 2; ++i) { kst[i] = *(const u32x4*)(kbase + soff[i]); vst[i] = *(const u32x4*)(vbase + soff[i]); }
    if (MLA) pst = *(const u32x4*)(pbase + poff);
#pragma unroll
    for (int i = 0; i < 2; ++i) { *(LAS u32x4*)(lds + kdst[i]) = kst[i]; *(LAS u32x4*)(lds + vdst[i]) = vst[i]; }
    if (MLA) *(LAS u32x4*)(lds + pdst) = pst;
    __syncthreads();
    f32x16 oacc[4];
#pragma unroll
    for (int d = 0; d < 4; ++d)
#pragma unroll
        for (int i = 0; i < 16; ++i) oacc[d][i] = 0.f;
    float mrun = -INFINITY, lrun = 0.f;
    const int koff = r * C::PK + 16 * h;
    const int voff = C::KBYTES + (4 * h + ((lane & 15) >> 2)) * C::PV + (16 * ((lane >> 4) & 1) + 4 * (lane & 3)) * 2;
    const unsigned* mrow = mask + (rowb + (active ? tq : 0)) * MW;
    for (int kt = 0; kt < ntiles; ++kt) {
        const int cur = (kt & 1) * C::BUFB, nxt = ((kt + 1) & 1) * C::BUFB;
        const bool more = kt + 1 < ntiles;
        if (more) {
            const bf16_t* kb2 = kbase + (size_t)(kt + 1) * 64 * ldkv; const bf16_t* vb2 = vbase + (size_t)(kt + 1) * 64 * ldkv;
#pragma unroll
            for (int i = 0; i < 2; ++i) { kst[i] = *(const u32x4*)(kb2 + soff[i]); vst[i] = *(const u32x4*)(vb2 + soff[i]); }
            if (MLA) pst = *(const u32x4*)(pbase + (size_t)(kt + 1) * 64 * 64 + poff);
        }
        if (active && kt * 64 <= tw0 + 31) {
            u32x2 mwd = (u32x2){0u, 0u};
            if (!MLA) mwd = *(const u32x2*)(mrow + 2 * kt);
            f32x16 s0, s1;
#pragma unroll
            for (int i = 0; i < 16; ++i) { s0[i] = 0.f; s1[i] = 0.f; }
#pragma unroll
            for (int ks = 0; ks < C::DQK / 16; ++ks) {
                const bf16x8 k0 = *(const LAS bf16x8*)(lds + cur + koff + 32 * ks), k1 = *(const LAS bf16x8*)(lds + cur + koff + 32 * C::PK + 32 * ks);
                s0 = MFMA32(k0, qf[ks], s0); s1 = MFMA32(k1, qf[ks], s1);
            }
            if (MLA) {
                if (kt * 64 + 63 > tw0) {
                    const int kb0 = kt * 64 + 4 * h;
#pragma unroll
                    for (int i = 0; i < 16; ++i) { const int key = kb0 + (i & 3) + 8 * (i >> 2); if (key > tq) s0[i] = -INFINITY; if (key + 32 > tq) s1[i] = -INFINITY; }
                }
            } else {
                const unsigned m0 = mwd.x >> (4 * h), m1 = mwd.y >> (4 * h);
#pragma unroll
                for (int i = 0; i < 16; ++i) { const int bit = (i & 3) + 8 * (i >> 2); if (!((m0 >> bit) & 1u)) s0[i] = -INFINITY; if (!((m1 >> bit) & 1u)) s1[i] = -INFINITY; }
            }
            float mx = s0[0];
#pragma unroll
            for (int i = 1; i < 16; ++i) mx = fmaxf(mx, s0[i]);
#pragma unroll
            for (int i = 0; i < 16; ++i) mx = fmaxf(mx, s1[i]);
            mx = fmaxf(mx, __shfl_xor(mx, 32));
            const float mnew = fmaxf(mrun, mx);
            const float msafe = (mnew == -INFINITY) ? 0.f : mnew;
            const float alpha = __builtin_amdgcn_exp2f(mrun - msafe);
            mrun = mnew;
            float ps = 0.f;
#pragma unroll
            for (int i = 0; i < 16; ++i) { s0[i] = __builtin_amdgcn_exp2f(s0[i] - msafe); s1[i] = __builtin_amdgcn_exp2f(s1[i] - msafe); ps += s0[i] + s1[i]; }
            lrun = lrun * alpha + ps;
#pragma unroll
            for (int d = 0; d < 4; ++d)
#pragma unroll
                for (int i = 0; i < 16; ++i) oacc[d][i] *= alpha;
            bf16x8 pf[4];
            { u32x4 w;
              w.x = cvt_pk_bf16(s0[0], s0[1]); w.y = cvt_pk_bf16(s0[2], s0[3]); w.z = cvt_pk_bf16(s0[4], s0[5]); w.w = cvt_pk_bf16(s0[6], s0[7]); pf[0] = __builtin_bit_cast(bf16x8, w);
              w.x = cvt_pk_bf16(s0[8], s0[9]); w.y = cvt_pk_bf16(s0[10], s0[11]); w.z = cvt_pk_bf16(s0[12], s0[13]); w.w = cvt_pk_bf16(s0[14], s0[15]); pf[1] = __builtin_bit_cast(bf16x8, w);
              w.x = cvt_pk_bf16(s1[0], s1[1]); w.y = cvt_pk_bf16(s1[2], s1[3]); w.z = cvt_pk_bf16(s1[4], s1[5]); w.w = cvt_pk_bf16(s1[6], s1[7]); pf[2] = __builtin_bit_cast(bf16x8, w);
              w.x = cvt_pk_bf16(s1[8], s1[9]); w.y = cvt_pk_bf16(s1[10], s1[11]); w.z = cvt_pk_bf16(s1[12], s1[13]); w.w = cvt_pk_bf16(s1[14], s1[15]); pf[3] = __builtin_bit_cast(bf16x8, w); }
#pragma unroll
            for (int d = 0; d < 4; ++d)
#pragma unroll
                for (int kk = 0; kk < 4; ++kk) {
                    const s16x4 lo = __builtin_amdgcn_ds_read_tr16_b64_v4i16((LAS s16x4*)(lds + cur + voff + (16 * kk) * C::PV + 64 * d));
                    const s16x4 hi = __builtin_amdgcn_ds_read_tr16_b64_v4i16((LAS s16x4*)(lds + cur + voff + (16 * kk + 8) * C::PV + 64 * d));
                    const bf16x8 vf = __builtin_shufflevector(lo, hi, 0, 1, 2, 3, 4, 5, 6, 7);
                    oacc[d] = MFMA32(vf, pf[kk], oacc[d]);
                }
        }
        if (more) {
#pragma unroll
            for (int i = 0; i < 2; ++i) { *(LAS u32x4*)(lds + nxt + kdst[i]) = kst[i]; *(LAS u32x4*)(lds + nxt + vdst[i]) = vst[i]; }
            if (MLA) *(LAS u32x4*)(lds + nxt + pdst) = pst;
        }
        __syncthreads();
    }
    if (active) {
        const float lt = lrun + __shfl_xor(lrun, 32);
        const float inv = lt > 0.f ? 1.0f / lt : 0.f;
        bf16_t* op = oab + (rowb + tq) * 4096 + (MLA ? 0 : 2048) + head * 128 + 4 * h;
#pragma unroll
        for (int d = 0; d < 4; ++d)
#pragma unroll
            for (int g = 0; g < 4; ++g) { u32x2 w; w.x = cvt_pk_bf16(oacc[d][4 * g] * inv, oacc[d][4 * g + 1] * inv); w.y = cvt_pk_bf16(oacc[d][4 * g + 2] * inv, oacc[d][4 * g + 3] * inv);
                *(u32x2*)(op + 32 * d + 8 * g) = w; }
    }
}

constexpr int ATT_NUNITS = 17 * 64 + 66 * 16;
__device__ __forceinline__ void att_decode(int idx, AttnUnit& u) {
    int rem = idx;
    for (int L = 66; L >= 1; --L) {
        const int nm = (L == 66 || (L & 3) == 0) ? 64 : 0;
        if (rem < nm) { u.type = 0; u.blk = (L == 66) ? 16 : (L >> 2) - 1; u.b = rem & 3; u.hx = rem >> 2; return; }
        rem -= nm;
        if (rem < 16) { u.type = 1; u.blk = L - 1; u.b = rem & 3; u.hx = rem >> 2; return; }
        rem -= 16;
    }
    u.type = -1; u.blk = 0; u.b = 0; u.hx = 0;
}
__device__ __forceinline__ void p3_attention(const Frame& F) {
#ifdef MK_SKIP_ATT
    {
        const u32x4* qn = (const u32x4*)(F.ws + WS_QN); const u32x4* qb = (const u32x4*)(F.ws + WS_QB); u32x4* o = (u32x4*)(F.ws + WS_OAB);
        const size_t gt = (size_t)(F.vcu * NWAVES + F.wave) * 64 + F.lane, NGT = (size_t)F.G * NWAVES * 64;
        for (size_t i = gt; i < (size_t)M * 256; i += NGT) { const size_t row = i >> 8, c = i & 255; o[row * 512 + c] = qn[row * 256 + c]; o[row * 512 + 256 + c] = qb[row * 256 + c]; }
        return;
    }
#endif
    volatile LAS int* qw = (volatile LAS int*)(F.lds + LDSCTL_OFF + 32);
    for (;;) {
        if (F.tid == 0) { const int idx = (int)atomicAdd(F.ctl + CW_QUEUE + 64, 1u); AttnUnit u; u.type = -1; u.b = 0; u.hx = 0; u.blk = 0; if (idx < ATT_NUNITS) att_decode(idx, u);
            qw[0] = u.type; qw[1] = u.b; qw[2] = u.hx; qw[3] = u.blk; }
        __syncthreads();
        AttnUnit u; u.type = qw[0]; u.b = qw[1]; u.hx = qw[2]; u.blk = qw[3];
        __syncthreads();
        if (u.type < 0) break;
        if (u.type == 0) attn_unit<true>(F, u); else attn_unit<false>(F, u);
    }
}
__device__ __forceinline__ float pk_idx(float v, int n) { return __uint_as_float((__float_as_uint(v) & ~127u) | (unsigned)n); }
__device__ __forceinline__ void route_task(const Frame& F, int tb, int hd) {
    const int lane = F.lane, r = lane & 31, h = lane >> 5;
    const bf16_t* pq = (const bf16_t*)(F.ws + WS_PQ); const bf16_t* skb = (const bf16_t*)(F.ws + WS_SK);
    int* eid = (int*)(F.ws + WS_EID); float* gate = (float*)(F.ws + WS_GATE);
    LAS float* wl = (LAS float*)(F.lds + F.wave * 16384);
    const int m = tb * 32 + r;
#pragma unroll 1
    for (int c = 0; c < 2; ++c) {
        const bf16_t* qp = pq + (size_t)m * 2048 + hd * 256 + c * 128 + 8 * h;
        bf16x8 qf[8];
#pragma unroll
        for (int ks = 0; ks < 8; ++ks) qf[ks] = *(const bf16x8*)(qp + 16 * ks);
        float v[64];
#pragma unroll
        for (int blk = 0; blk < 4; ++blk) {
            const bf16_t* sp = skb + (size_t)((hd * 2 + c) * 128 + 32 * blk + r) * 128 + 8 * h;
            f32x16 acc;
#pragma unroll
            for (int i = 0; i < 16; ++i) acc[i] = 0.f;
#pragma unroll
            for (int ks = 0; ks < 8; ++ks) acc = MFMA32(*(const bf16x8*)(sp + 16 * ks), qf[ks], acc);
#pragma unroll
            for (int i = 0; i < 16; ++i) v[blk * 16 + i] = pk_idx(acc[i], 32 * blk + (i & 3) + 8 * (i >> 2) + 4 * h);
        }
#pragma unroll 1
        for (int k = 0; k < 16; ++k) {
            float mx = v[0];
#pragma unroll
            for (int j = 1; j < 64; ++j) mx = fmaxf(mx, v[j]);
            mx = fmaxf(mx, __shfl_xor(mx, 32));
            if (h == 0) wl[(c * 16 + k) * 32 + r] = mx;
#pragma unroll
            for (int j = 0; j < 64; ++j) v[j] = (v[j] == mx) ? -INFINITY : v[j];
        }
    }
    LDS_WAIT(); asm volatile("" ::: "memory");
    float cs[50]; int ce[50];
    {
        unsigned t0[16], t1[16];
#pragma unroll
        for (int i = 0; i < 16; ++i) { t0[i] = __float_as_uint(wl[i * 32 + r]); t1[i] = __float_as_uint(wl[(16 + i) * 32 + r]); }
        int n = 0;
#pragma unroll
        for (int i = 0; i < 16; ++i)
#pragma unroll
            for (int j = 0; j < 16; ++j)
                if ((i + 1) * (j + 1) <= 16) {
                    const float s = __uint_as_float(t0[i] & ~127u) + __uint_as_float(t1[j] & ~127u);
                    cs[n] = __uint_as_float((__float_as_uint(s) & ~63u) | (unsigned)n); ce[n] = (int)((t0[i] & 127u) * 128u + (t1[j] & 127u)); ++n;
                }
    }
    float sum = 0.f, first = 0.f;
#pragma unroll 1
    for (int k = 0; k < 16; ++k) {
        float mx = cs[0];
#pragma unroll
        for (int j = 1; j < 50; ++j) mx = fmaxf(mx, cs[j]);
        int se = 0;
#pragma unroll
        for (int j = 0; j < 50; ++j) { const bool hit = (cs[j] == mx); se = hit ? ce[j] : se; cs[j] = hit ? -INFINITY : cs[j]; }
        if (k == 0) first = mx;
        const float ev = __expf(mx - first); sum += ev;
        if (h == 0) { wl[1024 + k * 32 + r] = ev; wl[1536 + k * 32 + r] = __int_as_float(se); }
    }
    LDS_WAIT(); asm volatile("" ::: "memory");
    const float inv = 1.0f / sum;
    if (h == 0) {
        int* ep = eid + (size_t)m * 128 + hd * 16; float* gp = gate + (size_t)m * 128 + hd * 16;
#pragma unroll
        for (int q = 0; q < 4; ++q) {
            *(int4*)(ep + 4 * q) = make_int4(__float_as_int(wl[1536 + (4 * q) * 32 + r]), __float_as_int(wl[1536 + (4 * q + 1) * 32 + r]), __float_as_int(wl[1536 + (4 * q + 2) * 32 + r]), __float_as_int(wl[1536 + (4 * q + 3) * 32 + r]));
            *(f32x4*)(gp + 4 * q) = (f32x4){wl[1024 + (4 * q) * 32 + r] * inv, wl[1024 + (4 * q + 1) * 32 + r] * inv, wl[1024 + (4 * q + 2) * 32 + r] * inv, wl[1024 + (4 * q + 3) * 32 + r] * inv}; }
    }
    LDS_WAIT(); asm volatile("" ::: "memory");
}
__device__ __forceinline__ void p7_routing(const Frame& F) {
    const int gw = F.vcu * NWAVES + F.wave, NGW = F.G * NWAVES;
    for (int it = gw; it < (M / 32) * 8; it += NGW) route_task(F, it >> 3, it & 7);
}

__device__ __forceinline__ float rl_f(float v, int l) { return __int_as_float(__builtin_amdgcn_readlane(__float_as_int(v), l)); }
__device__ __forceinline__ float gelu_tanh(float x) {
    const float u = 0.7978845608028654f * (x + 0.044715f * x * x * x);
    const float e = __expf(2.0f * u);
    const float th = 1.0f - 2.0f / (e + 1.0f);
    return 0.5f * x * (1.0f + th);
}
__device__ __forceinline__ float wave_sum_dpp(float v) {
#define DPP_ADD(ctrl, rmask) v += __int_as_float(__builtin_amdgcn_update_dpp(0, __float_as_int(v), ctrl, rmask, 0xF, false))
    DPP_ADD(0xB1, 0xF); DPP_ADD(0x4E, 0xF); DPP_ADD(0x141, 0xF); DPP_ADD(0x140, 0xF); DPP_ADD(0x142, 0xA); DPP_ADD(0x143, 0xC);
#undef DPP_ADD
    return rl_f(v, 63);
}
struct Row8 { u32x4 q[4]; };
__device__ __forceinline__ void row8_load(Row8& r, const unsigned char* tab, int e, int lane) {
    const u32x4* p = (const u32x4*)(tab + (size_t)e * DM) + lane;
#pragma unroll
    for (int j = 0; j < 4; ++j) r.q[j] = p[64 * j];
}
__device__ __forceinline__ float row8_dot(const Row8& r, const f32x2 (&hf)[32]) {
    f32x2 acc0 = (f32x2){0.f, 0.f}, acc1 = (f32x2){0.f, 0.f};
#pragma unroll
    for (int j = 0; j < 4; ++j)
#pragma unroll
        for (int d = 0; d < 4; ++d) { const int w = (int)r.q[j][d];
            acc0 = __builtin_elementwise_fma(__builtin_amdgcn_cvt_pk_f32_fp8(w, false), hf[8 * j + 2 * d], acc0);
            acc1 = __builtin_elementwise_fma(__builtin_amdgcn_cvt_pk_f32_fp8(w, true), hf[8 * j + 2 * d + 1], acc1); }
    const f32x2 s = acc0 + acc1;
    return s.x + s.y;
}
__device__ __forceinline__ void row8_axpy(const Row8& r, float c, f32x2 (&o)[32]) {
    const f32x2 c2 = (f32x2){c, c};
#pragma unroll
    for (int j = 0; j < 4; ++j)
#pragma unroll
        for (int d = 0; d < 4; ++d) { const int w = (int)r.q[j][d];
            o[8 * j + 2 * d] = __builtin_elementwise_fma(__builtin_amdgcn_cvt_pk_f32_fp8(w, false), c2, o[8 * j + 2 * d]);
            o[8 * j + 2 * d + 1] = __builtin_elementwise_fma(__builtin_amdgcn_cvt_pk_f32_fp8(w, true), c2, o[8 * j + 2 * d + 1]); }
}
__device__ __forceinline__ void expert_token(const Frame& F, int m, size_t orow) {
    const int lane = F.lane;
    const unsigned char* U = F.ws + WS_U; const unsigned char* V = F.ws + WS_V;
    const float* scu = (const float*)(F.ws + WS_SCU); const float* scv = (const float*)(F.ws + WS_SCV);
    const int* eid = (const int*)(F.ws + WS_EID); const float* gate = (const float*)(F.ws + WS_GATE);
    const bf16_t* h1b = (const bf16_t*)(F.ws + WS_H1B); const float* h1f = (const float*)(F.ws + WS_H1F);
    const u64* ssq = (const u64*)(F.ctl + CW_SSQ_H1); const float* gfin = F.in(15);
    const int e0 = eid[(size_t)m * 128 + lane], e1 = eid[(size_t)m * 128 + 64 + lane];
    f32x2 hf[32];
#pragma unroll
    for (int j = 0; j < 4; ++j) { const u32x4* hp = (const u32x4*)(h1b + (size_t)m * DM + 1024 * j + 16 * lane); const u32x4 x0 = hp[0], x1 = hp[1];
        hf[8 * j + 0] = (f32x2){bf_lo(x0.x), bf_hi(x0.x)}; hf[8 * j + 1] = (f32x2){bf_lo(x0.y), bf_hi(x0.y)}; hf[8 * j + 2] = (f32x2){bf_lo(x0.z), bf_hi(x0.z)}; hf[8 * j + 3] = (f32x2){bf_lo(x0.w), bf_hi(x0.w)};
        hf[8 * j + 4] = (f32x2){bf_lo(x1.x), bf_hi(x1.x)}; hf[8 * j + 5] = (f32x2){bf_lo(x1.y), bf_hi(x1.y)}; hf[8 * j + 6] = (f32x2){bf_lo(x1.z), bf_hi(x1.z)}; hf[8 * j + 7] = (f32x2){bf_lo(x1.w), bf_hi(x1.w)}; }
    const float g0 = gate[(size_t)m * 128 + lane] * scv[e0], g1 = gate[(size_t)m * 128 + 64 + lane] * scv[e1];
    const float rstd = __builtin_amdgcn_rsqf(ssq_get(ssq + m) * (1.0f / DM) + EPS);
    const float su0 = scu[e0] * rstd, su1 = scu[e1] * rstd;
    float a0 = 0.f, a1 = 0.f;
#define EIDX(e) (((e) < 64) ? __builtin_amdgcn_readlane(e0, (e)) : __builtin_amdgcn_readlane(e1, (e) - 64))
    {
        Row8 r0, r1, r2, r3;
        row8_load(r0, U, EIDX(0), lane); row8_load(r1, U, EIDX(1), lane); row8_load(r2, U, EIDX(2), lane); row8_load(r3, U, EIDX(3), lane);
#pragma unroll 1
        for (int e = 0; e < 128; e += 4) {
            const bool more = e + 4 < 128; float p;
            p = wave_sum_dpp(row8_dot(r0, hf)); if (more) row8_load(r0, U, EIDX(e + 4), lane); if (e < 64) { if (lane == e) a0 = p; } else { if (lane == e - 64) a1 = p; }
            p = wave_sum_dpp(row8_dot(r1, hf)); if (more) row8_load(r1, U, EIDX(e + 5), lane); if (e < 64) { if (lane == e + 1) a0 = p; } else { if (lane == e - 63) a1 = p; }
            p = wave_sum_dpp(row8_dot(r2, hf)); if (more) row8_load(r2, U, EIDX(e + 6), lane); if (e < 64) { if (lane == e + 2) a0 = p; } else { if (lane == e - 62) a1 = p; }
            p = wave_sum_dpp(row8_dot(r3, hf)); if (more) row8_load(r3, U, EIDX(e + 7), lane); if (e < 64) { if (lane == e + 3) a0 = p; } else { if (lane == e - 61) a1 = p; }
        }
    }
    const float c0 = gelu_tanh(a0 * su0) * g0, c1 = gelu_tanh(a1 * su1) * g1;
#define CIDX(e) (((e) < 64) ? rl_f(c0, (e)) : rl_f(c1, (e) - 64))
    f32x2 o[32];
#pragma unroll
    for (int i = 0; i < 32; ++i) o[i] = (f32x2){0.f, 0.f};
    {
        Row8 r0, r1, r2, r3;
        row8_load(r0, V, EIDX(0), lane); row8_load(r1, V, EIDX(1), lane); row8_load(r2, V, EIDX(2), lane); row8_load(r3, V, EIDX(3), lane);
#pragma unroll 1
        for (int e = 0; e < 128; e += 4) {
            const bool more = e + 4 < 128;
            row8_axpy(r0, CIDX(e), o); if (more) row8_load(r0, V, EIDX(e + 4), lane);
            row8_axpy(r1, CIDX(e + 1), o); if (more) row8_load(r1, V, EIDX(e + 5), lane);
            row8_axpy(r2, CIDX(e + 2), o); if (more) row8_load(r2, V, EIDX(e + 6), lane);
            row8_axpy(r3, CIDX(e + 3), o); if (more) row8_load(r3, V, EIDX(e + 7), lane);
        }
    }
#undef EIDX
#undef CIDX
    float s = 0.f;
#pragma unroll
    for (int j = 0; j < 4; ++j) { const f32x4* hp = (const f32x4*)(h1f + (size_t)m * DM + 1024 * j + 16 * lane);
#pragma unroll
        for (int q = 0; q < 4; ++q) { const f32x4 x = hp[q]; o[8 * j + 2 * q] += (f32x2){x[0], x[1]}; o[8 * j + 2 * q + 1] += (f32x2){x[2], x[3]};
            s += (o[8 * j + 2 * q].x * o[8 * j + 2 * q].x + o[8 * j + 2 * q].y * o[8 * j + 2 * q].y) + (o[8 * j + 2 * q + 1].x * o[8 * j + 2 * q + 1].x + o[8 * j + 2 * q + 1].y * o[8 * j + 2 * q + 1].y); } }
    const float rs = 1.0f / sqrtf(wave_sum(s) * (1.0f / DM) + EPS);
    float* op = F.out() + orow * DM;
#pragma unroll
    for (int j = 0; j < 4; ++j) { const f32x4* gp = (const f32x4*)(gfin + 1024 * j + 16 * lane);
#pragma unroll
        for (int q = 0; q < 4; ++q) { const f32x4 g = gp[q];
            *(f32x4*)(op + 1024 * j + 16 * lane + 4 * q) = (f32x4){o[8 * j + 2 * q].x * rs * g[0], o[8 * j + 2 * q].y * rs * g[1], o[8 * j + 2 * q + 1].x * rs * g[2], o[8 * j + 2 * q + 1].y * rs * g[3]}; } }
}
#ifdef MK_STEP_B
__device__ __forceinline__ void stepb_token(const Frame& F, int m, size_t orow) {
    const int lane = F.lane; const float* x = (const float*)(F.ws + WS_H1F) + (size_t)m * DM; const float* gfin = F.in(15);
    f32x4 v[16]; float s = 0.f;
#pragma unroll
    for (int j = 0; j < 16; ++j) { v[j] = *((const f32x4*)x + lane + 64 * j); s += (v[j][0] * v[j][0] + v[j][1] * v[j][1]) + (v[j][2] * v[j][2] + v[j][3] * v[j][3]); }
    const float rs = 1.0f / sqrtf(wave_sum(s) * (1.0f / DM) + EPS);
#pragma unroll
    for (int j = 0; j < 16; ++j) { const f32x4 g = *((const f32x4*)gfin + lane + 64 * j); *((f32x4*)(F.out() + orow * DM) + lane + 64 * j) = v[j] * rs * g; }
}
#endif
#ifdef MK_STEP_A
__device__ __forceinline__ void stepa_token(const Frame& F, size_t orow) {
    const int lane = F.lane; const float* x = F.in(0) + orow * DM; const float* gfin = F.in(15);
    f32x4 v[16]; float s = 0.f;
#pragma unroll
    for (int j = 0; j < 16; ++j) { v[j] = *((const f32x4*)x + lane + 64 * j); s += (v[j][0] * v[j][0] + v[j][1] * v[j][1]) + (v[j][2] * v[j][2] + v[j][3] * v[j][3]); }
    const float rs = 1.0f / sqrtf(wave_sum(s) * (1.0f / DM) + EPS);
#pragma unroll
    for (int j = 0; j < 16; ++j) { const f32x4 g = *((const f32x4*)gfin + lane + 64 * j); *((f32x4*)(F.out() + orow * DM) + lane + 64 * j) = v[j] * rs * g; }
}
#endif
__device__ __forceinline__ void p8_experts(const Frame& F) {
    const int gw = F.vcu * NWAVES + F.wave, NGW = F.G * NWAVES;
#if defined(MK_STEP_A)
    for (int it = gw; it < NB * SEQ; it += NGW) stepa_token(F, (size_t)it);
#elif defined(MK_STEP_B)
    for (int it = gw; it < NB * SEQ; it += NGW) { const int b = it / SEQ, s = it % SEQ; stepb_token(F, b * TP + NMETA + s, (size_t)it); }
#else
    for (int it = gw; it < NB * SEQ; it += NGW) { const int b = it / SEQ, s = it % SEQ; expert_token(F, b * TP + NMETA + s, (size_t)it); }
#endif
}
struct Args { const float* in[16]; float* out; unsigned char* ws; int ph_lo, ph_hi; };
#define GEMM_RUN(EPI_T, g_, S_, E_) pg8::gemm_phase<EPI_T, pg8::StaticOrder, true, true>(F.lds, g_, S_, E_)
#define GEMM_RUN2(EPI_T, g_, S_, E_) pg8::gemm_phase<EPI_T, pg8::StaticOrder2, true, true>(F.lds, g_, S_, E_)

__global__ void __launch_bounds__(NWAVES * 64, 2) mk_fwd(Args args) {
    extern __shared__ __attribute__((aligned(16))) unsigned char lds_raw[];
    Frame F;
    F.lds = (LAS unsigned char*)lds_raw;
    F.ws = args.ws; F.ctl = (unsigned*)(args.ws + WS_CTL);
    F.tid = threadIdx.x; F.lane = F.tid & 63; F.wave = __builtin_amdgcn_readfirstlane(F.tid >> 6);
#define PHASE_BEGIN() do { int t_; asm volatile("v_mov_b32 %0, %1" : "=v"(t_) : "v"(threadIdx.x)); F.tid = t_; F.lane = t_ & 63; } while (0)
    F.G = gridDim.x; { const int bx = blockIdx.x; F.vcu = (F.G % 8 == 0) ? (bx % 8) * (F.G / 8) + bx / 8 : bx; }
    for (int u = F.tid; u < (LDS_BYTES - LDSCTL_OFF) / 4; u += NWAVES * 64) ((LAS unsigned*)(F.lds + LDSCTL_OFF))[u] = 0u;
    __syncthreads();
    XcdBarrier bar; bar.bar = F.ctl + CW_BAR; bar.x = 0; bar.st = nullptr;
    if (!MK_PER_PHASE) bar = xcd_barrier_post(F.ctl + CW_BAR, (volatile LAS unsigned*)(F.lds + LDSCTL_OFF));
    const int lo = args.ph_lo, hi = args.ph_hi;
#ifndef PH_MASK
#define PH_MASK 0x1FF
#endif
#define IN(k) (((PH_MASK >> (k)) & 1) && lo <= (k) && (k) < hi)
#define SEAM(k) do { if (IN(k) && IN((k) + 1)) xcd_barrier(bar); } while (0)
    unsigned char* ws = F.ws;

    if (IN(0)) { PHASE_BEGIN(); p0_prologue(F); }
    SEAM(0);
    if (IN(1)) { PHASE_BEGIN();
        pg8::Gemm g{(const bf16_t*)(ws + WS_XN), (const bf16_t*)(ws + WS_WIN), M, NV1, DM, DM}; pg8::StaticOrder S; S.init(M, NV1, F.G, (int)blockIdx.x);
        epi::EpiIn E{(bf16_t*)(ws + WS_CQ), (bf16_t*)(ws + WS_CKV), (bf16_t*)(ws + WS_QB), (bf16_t*)(ws + WS_KB), (bf16_t*)(ws + WS_VB), (bf16_t*)(ws + WS_QIX), (bf16_t*)(ws + WS_KPE), (bf16_t*)(ws + WS_KIX),
                      (bf16_t*)(ws + WS_GA), (bf16_t*)(ws + WS_GB), (float*)(ws + WS_WIX), (u64*)(F.ctl + CW_SSQ_CQ), (u64*)(F.ctl + CW_SSQ_CKV),
                      (const float*)(ws + WS_ROPE_M), (const float*)(ws + WS_ROPE_D), (const float*)(ws + WS_ROPE_I)};
        GEMM_RUN(epi::EpiIn, g, S, E);
    }
    SEAM(1);
    if (IN(2)) { PHASE_BEGIN();
        { pg8::Gemm g{(const bf16_t*)(ws + WS_CQ), (const bf16_t*)(ws + WS_WUQ), M, 3072, 1024, 1024}; pg8::StaticOrder S; S.init(M, 3072, F.G, (int)blockIdx.x);
          epi::EpiUp E{(bf16_t*)(ws + WS_QN), (bf16_t*)(ws + WS_QR), 8, 2048, 1024, (const u64*)(F.ctl + CW_SSQ_CQ), 1.0f / 1024.0f, QA_SCALE, (const float*)(ws + WS_ROPE_M)};
          GEMM_RUN(epi::EpiUp, g, S, E); }
        __syncthreads();
        { pg8::Gemm g{(const bf16_t*)(ws + WS_CKV), (const bf16_t*)(ws + WS_WUKV), M, 4096, 512, 512}; pg8::StaticOrder S; S.init(M, 4096, F.G, (int)blockIdx.x);
          epi::EpiUp E{(bf16_t*)(ws + WS_KN), (bf16_t*)(ws + WS_VA), 8, 2048, 2048, (const u64*)(F.ctl + CW_SSQ_CKV), 1.0f / 512.0f, 1.0f, nullptr};
          GEMM_RUN(epi::EpiUp, g, S, E); }
        __syncthreads();
        p2_indexer(F);
    }
    SEAM(2);
    if (IN(3)) { PHASE_BEGIN(); p3_attention(F); }
    SEAM(3);
    if (IN(4)) { PHASE_BEGIN();
        pg8::Gemm g{(const bf16_t*)(ws + WS_OAB), (const bf16_t*)(ws + WS_WBR), M, 4096, 4096, 2048}; pg8::StaticOrder2 S; S.init(M, 4096, F.G, (int)blockIdx.x);
        epi::EpiBranch E{(const bf16_t*)(ws + WS_GA), (const bf16_t*)(ws + WS_GB), (bf16_t*)(ws + WS_MRG)};
        GEMM_RUN2(epi::EpiBranch, g, S, E);
    }
    SEAM(4);
    if (IN(5)) { PHASE_BEGIN();
        pg8::Gemm g{(const bf16_t*)(ws + WS_MRG), (const bf16_t*)(ws + WS_WOUT), M, 4096, 4096, 4096}; pg8::StaticOrder S; S.init(M, 4096, F.G, (int)blockIdx.x);
        epi::EpiOut E{F.in(0), F.in(1), (float*)(ws + WS_H1F), (bf16_t*)(ws + WS_H1B), (u64*)(F.ctl + CW_SSQ_H1)};
        GEMM_RUN(epi::EpiOut, g, S, E);
    }
    SEAM(5);
    if (IN(6)) { PHASE_BEGIN();
        pg8::Gemm g{(const bf16_t*)(ws + WS_H1B), (const bf16_t*)(ws + WS_WQ), M, 2048, 4096, 4096}; pg8::StaticOrder S; S.init(M, 2048, F.G, (int)blockIdx.x);
        epi::EpiPQ E{(bf16_t*)(ws + WS_PQ), (const u64*)(F.ctl + CW_SSQ_H1)};
        GEMM_RUN(epi::EpiPQ, g, S, E);
        p6_tables(F);
    }
    SEAM(6);
    if (IN(7)) { PHASE_BEGIN(); p7_routing(F); }
    SEAM(7);
    if (IN(8)) { PHASE_BEGIN(); p8_experts(F); }
#undef IN
#undef SEAM
}

extern "C" void kernel_launch(void* const* d_in, const int* in_sizes, int n_in, void* d_out, int out_size, void* d_ws, size_t ws_size, hipStream_t stream) {
    static int grid = 0;
    if (grid == 0) {
        if (n_in != 16 || in_sizes[0] != NB * SEQ * DM || out_size != NB * SEQ * DM || ws_size < WS_END) {
            fprintf(stderr, "kernel_launch: unexpected problem shape (n_in %d, in0 %d, out %d, ws %zu < %zu); nothing launched\n", n_in, n_in > 0 ? in_sizes[0] : -1, out_size, ws_size, (size_t)WS_END); grid = -1; return; }
        int dev = 0, cus = 0, per_cu = 0;
        if (hipGetDevice(&dev) != hipSuccess || hipDeviceGetAttribute(&cus, hipDeviceAttributeMultiprocessorCount, dev) != hipSuccess) { grid = -1; return; }
        if (hipFuncSetAttribute((const void*)mk_fwd, hipFuncAttributeMaxDynamicSharedMemorySize, LDS_BYTES) != hipSuccess) { fprintf(stderr, "kernel_launch: hipFuncSetAttribute failed\n"); grid = -1; return; }
        if (hipOccupancyMaxActiveBlocksPerMultiprocessor(&per_cu, (const void*)mk_fwd, NWAVES * 64, LDS_BYTES) != hipSuccess || per_cu < 1) {
            fprintf(stderr, "kernel_launch: occupancy query reports %d workgroups per CU\n", per_cu); }
        (void)hipGetLastError();
        grid = cus;
    }
    if (grid < 0) return;
    if (hipMemsetAsync((char*)d_ws + WS_CTL, 0, CTL_ZERO_BYTES, stream) != hipSuccess) return;
    Args a{};
    for (int i = 0; i < 16; ++i) a.in[i] = (const float*)d_in[i];
    a.out = (float*)d_out; a.ws = (unsigned char*)d_ws;
#if MK_PER_PHASE
    for (int p = 0; p <= MK_LAST_PHASE; ++p) { a.ph_lo = p; a.ph_hi = p + 1; hipLaunchKernelGGL(mk_fwd, dim3(grid), dim3(NWAVES * 64), LDS_BYTES, stream, a); }
#else
    a.ph_lo = 0; a.ph_hi = MK_LAST_PHASE + 1;
    hipLaunchKernelGGL(mk_fwd, dim3(grid), dim3(NWAVES * 64), LDS_BYTES, stream, a);
#endif
}
```

```cpp
#include <hip/hip_runtime.h>
#include <cstdio>
#include <cstdint>

#define LAS __attribute__((address_space(3)))
#define GAS __attribute__((address_space(1)))
typedef unsigned short bf16_t;
typedef short bf16x8 __attribute__((ext_vector_type(8)));
typedef short s16x4 __attribute__((ext_vector_type(4)));
typedef float f32x2 __attribute__((ext_vector_type(2)));
typedef float f32x4 __attribute__((ext_vector_type(4)));
typedef float f32x16 __attribute__((ext_vector_type(16)));
typedef unsigned u32x2 __attribute__((ext_vector_type(2)));
typedef unsigned u32x4 __attribute__((ext_vector_type(4)));
typedef GAS unsigned gu32;

#ifndef MK_PER_PHASE
#define MK_PER_PHASE 0
#endif
#ifndef MK_LAST_PHASE
#define MK_LAST_PHASE 8
#endif

constexpr int NB = 4, SEQ = 4096, DM = 4096, NMETA = 16, TR = SEQ + NMETA  , TP = 4224  , M = NB * TP  ;
constexpr float EPS = 1e-6f;
constexpr int NV1 = 14080;
constexpr float LOG2E = 1.4426950408889634f;
constexpr float QB_SCALE = 0.08838834764831845f * LOG2E;
constexpr float QA_SCALE = 0.07216878364870323f * LOG2E;
constexpr int NWAVES = 8;
constexpr int MW = 132;

constexpr size_t HM = 512u * 1024u;
constexpr size_t WS_CTL = 0, CTL_ZERO_BYTES = 2 * HM;
constexpr size_t WS_ROPE_M = 2 * HM;
constexpr size_t WS_ROPE_D = 5 * HM;
constexpr size_t WS_ROPE_I = 7 * HM;
constexpr size_t WS_SK   = 8 * HM;
constexpr size_t WS_WUQ  = 10 * HM;
constexpr size_t WS_WUKV = 22 * HM;
constexpr size_t WS_WBR  = 30 * HM;
constexpr size_t WS_WOUT = 94 * HM;
constexpr size_t WS_WQ   = 158 * HM;
constexpr size_t WS_EID  = 190 * HM;
constexpr size_t WS_GATE = 207 * HM;
constexpr size_t WS_MASK = 224 * HM;
constexpr size_t WS_KPE  = 242 * HM;
constexpr size_t WS_KIX  = 247 * HM;
constexpr size_t WS_WIX  = 252 * HM;
constexpr size_t WS_SCU  = 255 * HM;
constexpr size_t WS_SCV  = 255 * HM + 65536;
constexpr size_t R23 = 260 * HM;
constexpr size_t WS_XN   = R23;
constexpr size_t WS_WIN  = R23 + 264 * HM;
constexpr size_t P1O = R23 + 484 * HM;
constexpr size_t WS_CQ   = P1O;
constexpr size_t WS_CKV  = P1O + 66 * HM;
constexpr size_t WS_QB   = P1O + 99 * HM;
constexpr size_t WS_KB   = P1O + 231 * HM;
constexpr size_t WS_VB   = P1O + 264 * HM;
constexpr size_t WS_QIX  = P1O + 297 * HM;
constexpr size_t WS_GA   = P1O + 363 * HM;
constexpr size_t WS_GB   = P1O + 627 * HM;
constexpr size_t R4 = P1O + 892 * HM;
constexpr size_t WS_OAB  = R4;
constexpr size_t WS_PQ   = R4;
constexpr size_t WS_END  = R4 + 264 * HM;
constexpr size_t WS_QN   = R23;
constexpr size_t WS_QR   = R23 + 132 * HM;
constexpr size_t WS_KN   = R23 + 198 * HM;
constexpr size_t WS_VA   = R23 + 330 * HM;
constexpr size_t WS_MRG  = R23;
constexpr size_t WS_U    = R23;
constexpr size_t WS_V    = R23 + 256 * HM;
constexpr size_t WS_H1F  = R23 + 512 * HM;
constexpr size_t WS_H1B  = R23 + 1040 * HM;
static_assert(WS_VA + 132 * HM <= P1O && WS_H1F >= P1O && WS_H1B + 264 * HM <= R4 && WS_GB + 264 * HM <= R4, "ws map");
constexpr int CW_TMO = 0;
constexpr int CW_BAR = 4096;
constexpr int CW_QUEUE = 8192;
constexpr int CW_SSQ_CQ = 16384, CW_SSQ_CKV = 16384 + 2 * 17408, CW_SSQ_H1 = 16384 + 4 * 17408;
static_assert((CW_SSQ_H1 + 2 * 17408) * 4 <= (int)CTL_ZERO_BYTES, "ctl");

constexpr int RING_BYTES = 131072;
constexpr int LDSCTL_OFF = RING_BYTES;
constexpr int LDS_BYTES = 147456;

__device__ __forceinline__ unsigned f2bf(float f) { unsigned u = __float_as_uint(f); return (u + 0x7fffu + ((u >> 16) & 1u)) >> 16; }
__device__ __forceinline__ unsigned pk2(float lo, float hi) { return f2bf(lo) | (f2bf(hi) << 16); }
typedef __bf16 bf16x2_t __attribute__((ext_vector_type(2)));
__device__ __forceinline__ unsigned cvt_pk_bf16(float lo, float hi) { return __builtin_bit_cast(unsigned, __builtin_convertvector((f32x2){lo, hi}, bf16x2_t)); }
__device__ __forceinline__ float bf_lo(unsigned w) { return __uint_as_float(w << 16); }
__device__ __forceinline__ float bf_hi(unsigned w) { return __uint_as_float(w & 0xffff0000u); }
__device__ __forceinline__ u32x4 pack8(f32x4 a, f32x4 b) { u32x4 w; w.x = cvt_pk_bf16(a[0], a[1]); w.y = cvt_pk_bf16(a[2], a[3]); w.z = cvt_pk_bf16(b[0], b[1]); w.w = cvt_pk_bf16(b[2], b[3]); return w; }
__device__ __forceinline__ float wave_sum(float v) {
#pragma unroll
    for (int o = 1; o < 64; o <<= 1) v += __shfl_xor(v, o);
    return v;
}
#define LDS_WAIT() asm volatile("s_waitcnt lgkmcnt(0)" ::: "memory")
#define VM_WAIT() asm volatile("s_waitcnt vmcnt(0)" ::: "memory")
typedef unsigned long long u64;
__device__ __forceinline__ void ssq_add(u64* p, float v) { (void)__hip_atomic_fetch_add(p, (u64)(v * 16777216.0f), __ATOMIC_RELAXED, __HIP_MEMORY_SCOPE_AGENT); }
__device__ __forceinline__ float ssq_get(const u64* p) { return (float)((double)(*p) * (1.0 / 16777216.0)); }
namespace pg8 {
#define PG8_LAS __attribute__((address_space(3)))
typedef unsigned short bf16_t;
typedef short bf16x8 __attribute__((ext_vector_type(8)));
typedef float f32x4 __attribute__((ext_vector_type(4)));
typedef unsigned u32x4 __attribute__((ext_vector_type(4)));
constexpr int BM = 256, BK = 64, HALF = 128, HTB = HALF * BK * 2  , STAGE_BYTES = 8 * HTB, NXCD = 8, WGM = 8;

__host__ __device__ __forceinline__ int lds_byte(int r, int c) { const int st = (r >> 4) * 2 + (c >> 5), rr = r & 15, cc = c & 31, ob = rr * 64 + cc * 2; return st * 1024 + (ob ^ (((ob >> 9) & 1) << 5)); }
__host__ __device__ __forceinline__ void stage_rc(int b, int& R, int& C) { const int st = b / 1024, sb = b % 1024, swz = sb ^ (((sb >> 9) & 1) << 5); R = (st >> 1) * 16 + swz / 64; C = (st & 1) * 32 + (swz % 64) / 2; }
__host__ __device__ __forceinline__ int perm32(int rho) { const int n = rho >> 4, i = rho & 15; return 8 * (i >> 2) + 4 * n + (i & 3); }

struct Unit { int pm, pn, kh; };
struct Gemm { const bf16_t* A; const bf16_t* Bt; int M, N, K, KL; };

struct StaticOrder {
    int nM, nN, nwg, G, c;
    __host__ __device__ void init(int M, int N, int G_, int c_) { nM = M / BM; nN = N / BM; nwg = nM * nN; G = G_; c = c_; }
    __host__ __device__ bool next(int i, Unit& u) const {
        const long L = (long)i * G + c; if (L >= nwg) return false;
        int wgid = (int)L; { const int q = nwg / NXCD, r = nwg % NXCD, xcd = wgid % NXCD, off = wgid / NXCD; wgid = (xcd < r ? xcd * (q + 1) : r * (q + 1) + (xcd - r) * q) + off; }
        const int nig = WGM * nN, gid = wgid / nig, fm = gid * WGM, gsz = (nM - fm) < WGM ? (nM - fm) : WGM;
        u.pm = fm + ((wgid % nig) % gsz); u.pn = (wgid % nig) / gsz; u.kh = 0; return true;
    }
    __device__ __forceinline__ void a_ready(const Unit&) const {}
    __device__ __forceinline__ void done(const Unit&) const {}
};

struct StaticOrder2 {
    StaticOrder base;
    __host__ __device__ void init(int M, int N, int G_, int c_) { base.init(M, N, G_, c_); }
    __host__ __device__ bool next(int i, Unit& u) const { if (!base.next(i >> 1, u)) return false; u.kh = i & 1; return true; }
    __device__ __forceinline__ void a_ready(const Unit&) const {}
    __device__ __forceinline__ void done(const Unit&) const {}
};

template <class Epi, class Sched, bool ALIGN_EPI = false, bool SP2 = false>
__device__ __forceinline__ void gemm_phase(PG8_LAS unsigned char* lds, const Gemm g, const Sched& S, const Epi& E) {
    const int tid = threadIdx.x, wid = __builtin_amdgcn_readfirstlane(tid >> 6), lane = tid & 63, wr = wid >> 2, wc = wid & 3, fr = lane & 15, fq = lane >> 4;
    const int K = g.K, nt = g.KL / BK; const size_t khoff = (size_t)g.KL * 2;
    unsigned voffA[2], voffB[2];
#pragma unroll
    for (int i = 0; i < 2; ++i) { int R, C; stage_rc(tid * 16 + i * 8192, R, C); const int Rb = Epi::PERM ? ((R & ~31) + perm32(R & 31)) : R;
        voffA[i] = (unsigned)(R * K + C) * 2u; voffB[i] = (unsigned)(Rb * K + C) * 2u; }
    const size_t kstep = (size_t)(BK * 2);
    const size_t hstep = (size_t)HALF * K * 2;
    const size_t tstep = 2 * hstep;
    const unsigned ldsw = (unsigned)wid * 1024u;
    const int aoff = lds_byte(wr * 64 + fr, fq * 8), boff = lds_byte(wc * 32 + fr, fq * 8);
#define PG8_SA(b, h) (((b) * 2 + (h)) * HTB)
#define PG8_SB(b, h) ((4 + (b) * 2 + (h)) * HTB)
#define PG8_STAGE(bufoff, gbase, voff) do { _Pragma("unroll") for (int _i = 0; _i < 2; ++_i) \
        __builtin_amdgcn_global_load_lds((const unsigned*)((const char*)(gbase) + (voff)[_i]), (PG8_LAS unsigned*)(lds + (bufoff) + ldsw + _i * 8192), 16, 0, 0); } while (0)
#define PG8_LDA(dst, b, h) do { _Pragma("unroll") for (int m = 0; m < 4; ++m) _Pragma("unroll") for (int k = 0; k < 2; ++k) dst[m][k] = *(const PG8_LAS bf16x8*)(lds + PG8_SA(b, h) + aoff + m * 2048 + k * 1024); } while (0)
#define PG8_LDB(dst, b, h) do { _Pragma("unroll") for (int n = 0; n < 2; ++n) _Pragma("unroll") for (int k = 0; k < 2; ++k) dst[n][k] = *(const PG8_LAS bf16x8*)(lds + PG8_SB(b, h) + boff + n * 2048 + k * 1024); } while (0)
#define PG8_MMA(ai, bj, At, Bt) do { __builtin_amdgcn_s_setprio(1); _Pragma("unroll") for (int m = 0; m < 4; ++m) _Pragma("unroll") for (int n = 0; n < 2; ++n) _Pragma("unroll") for (int k = 0; k < 2; ++k) \
        acc[ai][bj][m][n] = __builtin_amdgcn_mfma_f32_16x16x32_bf16(Bt[n][k], At[m][k], acc[ai][bj][m][n], 0, 0, 0); __builtin_amdgcn_s_setprio(0); } while (0)
#define PG8_WAIT_V(n) asm volatile("s_waitcnt vmcnt(" #n ")" ::: "memory")
#define PG8_WAIT_L(n) asm volatile("s_waitcnt lgkmcnt(" #n ")" ::: "memory")
#define PG8_BAR __builtin_amdgcn_s_barrier()
#define PG8_SCHED __builtin_amdgcn_sched_barrier(0)
    Unit cur, nxt; int ui = 0;
    if (!S.next(0, cur)) return;
    f32x4 acc[2][2][4][2];
#pragma unroll
    for (int a = 0; a < 2; ++a)
#pragma unroll
        for (int b = 0; b < 2; ++b)
#pragma unroll
            for (int m = 0; m < 4; ++m)
#pragma unroll
                for (int n = 0; n < 2; ++n) acc[a][b][m][n] = (f32x4){0.f, 0.f, 0.f, 0.f};
    bf16x8 At[4][2], B0[2][2], B1[2][2];
    const char* cA = (const char*)g.A + (size_t)cur.pm * tstep + (size_t)cur.kh * khoff; const char* cB = (const char*)g.Bt + (size_t)cur.pn * tstep + (size_t)cur.kh * khoff;
    S.a_ready(cur);
    if constexpr (SP2) {
        PG8_STAGE(PG8_SB(0, 0), cB, voffB); PG8_STAGE(PG8_SB(0, 1), cB + hstep, voffB); PG8_STAGE(PG8_SA(0, 0), cA, voffA); PG8_STAGE(PG8_SA(0, 1), cA + hstep, voffA);
        if (wr == 1) PG8_BAR;
        PG8_WAIT_V(2); PG8_BAR;
        PG8_STAGE(PG8_SB(1, 0), cB + kstep, voffB); PG8_STAGE(PG8_SA(1, 0), cA + kstep, voffA); PG8_STAGE(PG8_SB(1, 1), cB + hstep + kstep, voffB);
        PG8_WAIT_V(6); PG8_BAR;
    } else {
        PG8_STAGE(PG8_SB(0, 0), cB, voffB); PG8_STAGE(PG8_SA(0, 0), cA, voffA); PG8_STAGE(PG8_SB(0, 1), cB + hstep, voffB); PG8_STAGE(PG8_SA(0, 1), cA + hstep, voffA);
        if (wr == 1) PG8_BAR;
        PG8_WAIT_V(4); PG8_BAR;
        PG8_STAGE(PG8_SB(1, 0), cB + kstep, voffB); PG8_STAGE(PG8_SA(1, 0), cA + kstep, voffA); PG8_STAGE(PG8_SB(1, 1), cB + hstep + kstep, voffB);
        PG8_WAIT_V(6); PG8_BAR;
    }
    for (;;) {
        const bool has_next = S.next(ui + 1, nxt);
        const char* nA = has_next ? (const char*)g.A + (size_t)nxt.pm * tstep + (size_t)nxt.kh * khoff : cA; const char* nB = has_next ? (const char*)g.Bt + (size_t)nxt.pn * tstep + (size_t)nxt.kh * khoff : cB;
        for (int t = 0; t < nt; t += 2) {
            const bool last = (t == nt - 2);
            const char* a1 = cA + (size_t)(t + 1) * kstep;
            const char* a2 = last ? nA : cA + (size_t)(t + 2) * kstep; const char* b2 = last ? nB : cB + (size_t)(t + 2) * kstep;
            const char* a3 = a2 + kstep; const char* b3 = b2 + kstep;
            if (last && has_next) S.a_ready(nxt);
            if constexpr (SP2) {
            PG8_LDB(B0, 0, 0); PG8_LDB(B1, 0, 1); PG8_SCHED; PG8_LDA(At, 0, 0); PG8_STAGE(PG8_SA(1, 1), a1 + hstep, voffA);
            PG8_WAIT_V(8); PG8_WAIT_L(0); PG8_BAR; PG8_MMA(0, 0, At, B0); PG8_MMA(0, 1, At, B1); PG8_BAR; PG8_SCHED;
            PG8_LDA(At, 0, 1); PG8_STAGE(PG8_SB(0, 0), b2, voffB); PG8_STAGE(PG8_SB(0, 1), b2 + hstep, voffB); PG8_STAGE(PG8_SA(0, 0), a2, voffA);
            PG8_WAIT_V(8); PG8_WAIT_L(0); PG8_BAR; PG8_MMA(1, 0, At, B0); PG8_MMA(1, 1, At, B1); PG8_BAR; PG8_SCHED;
            PG8_LDB(B0, 1, 0); PG8_LDB(B1, 1, 1); PG8_SCHED; PG8_LDA(At, 1, 0); PG8_STAGE(PG8_SA(0, 1), a2 + hstep, voffA);
            PG8_WAIT_V(8); PG8_WAIT_L(0); PG8_BAR; PG8_MMA(0, 0, At, B0); PG8_MMA(0, 1, At, B1); PG8_BAR; PG8_SCHED;
            PG8_LDA(At, 1, 1); PG8_STAGE(PG8_SB(1, 0), b3, voffB); PG8_STAGE(PG8_SB(1, 1), b3 + hstep, voffB); PG8_STAGE(PG8_SA(1, 0), a3, voffA);
            PG8_WAIT_V(8); PG8_WAIT_L(0); PG8_BAR; PG8_MMA(1, 0, At, B0); PG8_MMA(1, 1, At, B1); PG8_BAR; PG8_SCHED;
            } else {
            PG8_LDB(B0, 0, 0); PG8_SCHED; PG8_LDA(At, 0, 0); PG8_STAGE(PG8_SA(1, 1), a1 + hstep, voffA);
            PG8_WAIT_L(8); PG8_BAR; PG8_WAIT_L(0); PG8_MMA(0, 0, At, B0); PG8_BAR; PG8_SCHED;
            PG8_LDB(B1, 0, 1); PG8_STAGE(PG8_SB(0, 0), b2, voffB);
            PG8_BAR; PG8_WAIT_L(0); PG8_MMA(0, 1, At, B1); PG8_BAR;
            PG8_LDA(At, 0, 1); PG8_STAGE(PG8_SA(0, 0), a2, voffA);
            PG8_BAR; PG8_WAIT_L(0); PG8_MMA(1, 0, At, B0); PG8_BAR; PG8_SCHED;
            PG8_STAGE(PG8_SB(0, 1), b2 + hstep, voffB);
            PG8_WAIT_V(6); PG8_BAR; PG8_MMA(1, 1, At, B1); PG8_BAR;
            PG8_LDB(B0, 1, 0); PG8_SCHED; PG8_LDA(At, 1, 0); PG8_STAGE(PG8_SA(0, 1), a2 + hstep, voffA);
            PG8_WAIT_L(8); PG8_BAR; PG8_WAIT_L(0); PG8_MMA(0, 0, At, B0); PG8_BAR; PG8_SCHED;
            PG8_LDB(B1, 1, 1); PG8_STAGE(PG8_SB(1, 0), b3, voffB);
            PG8_BAR; PG8_WAIT_L(0); PG8_MMA(0, 1, At, B1); PG8_BAR;
            PG8_LDA(At, 1, 1); PG8_STAGE(PG8_SA(1, 0), a3, voffA);
            PG8_BAR; PG8_WAIT_L(0); PG8_MMA(1, 0, At, B0); PG8_BAR; PG8_SCHED;
            PG8_STAGE(PG8_SB(1, 1), b3 + hstep, voffB);
            PG8_WAIT_V(6); PG8_BAR; PG8_MMA(1, 1, At, B1); PG8_BAR;
            }
        }
        if constexpr (ALIGN_EPI) { if (wr == 0) PG8_BAR; }
        if constexpr (!Epi::AFTER_DRAIN) { E(acc, cur, wr, wc, fr, fq); S.done(cur); }
        if (!has_next) break;
        if (!(Epi::SPLITK2 && cur.kh == 0))
#pragma unroll
        for (int a = 0; a < 2; ++a)
#pragma unroll
            for (int b = 0; b < 2; ++b)
#pragma unroll
                for (int m = 0; m < 4; ++m)
#pragma unroll
                    for (int n = 0; n < 2; ++n) acc[a][b][m][n] = (f32x4){0.f, 0.f, 0.f, 0.f};
        cur = nxt; cA = nA; cB = nB; ++ui;
        if constexpr (ALIGN_EPI) { if (wr == 1) PG8_BAR; }
    }
    PG8_WAIT_V(0);
    if constexpr (!ALIGN_EPI) { if (wr == 0) PG8_BAR; }
    PG8_BAR;
    if constexpr (Epi::AFTER_DRAIN) { E.fused(acc, cur, wr, wc, fr, fq, lds, wid, lane); S.done(cur); }
#undef PG8_SA
#undef PG8_SB
#undef PG8_STAGE
#undef PG8_LDA
#undef PG8_LDB
#undef PG8_MMA
#undef PG8_WAIT_V
#undef PG8_WAIT_L
#undef PG8_BAR
#undef PG8_SCHED
}
}
namespace epi {
using pg8::Unit;
typedef f32x4 Acc[2][2][4][2];

__device__ __forceinline__ void rot2(f32x4& v, const f32x4 cs) {
    const float a1 = v[0] * cs[0] - v[1] * cs[1], a2 = v[1] * cs[0] + v[0] * cs[1];
    const float b1 = v[2] * cs[2] - v[3] * cs[3], b2 = v[3] * cs[2] + v[2] * cs[3];
    v = (f32x4){a1, a2, b1, b2};
}
__device__ __forceinline__ float sigm(float x) { return 1.0f / (1.0f + __expf(-x)); }

struct EpiIn {
    static constexpr bool PERM = true, AFTER_DRAIN = false, SPLITK2 = false;
    bf16_t *cq, *ckv, *qb, *kb, *vb, *qix, *kpe, *kix, *ga, *gb; float* wix; u64 *ssq_cq, *ssq_ckv;
    const float *ropeM, *ropeD, *ropeI;
    __device__ __forceinline__ void operator()(const Acc& acc, const Unit& u, int wr, int wc, int fr, int fq) const {
        const int vt = u.pn, rowb = u.pm * 256 + wr * 64 + fr, ct = wc * 32 + 8 * fq;
        if (vt < 6) {
            bf16_t* dst = vt < 4 ? cq : ckv; const int ld = vt < 4 ? 1024 : 512, cb = (vt < 4 ? vt : vt - 4) * 256 + ct; u64* ssq = vt < 4 ? ssq_cq : ssq_ckv;
#pragma unroll
            for (int ai = 0; ai < 2; ++ai)
#pragma unroll
                for (int m = 0; m < 4; ++m) { const int row = rowb + ai * 128 + m * 16; float s = 0.f;
#pragma unroll
                    for (int bj = 0; bj < 2; ++bj) { const f32x4 v0 = acc[ai][bj][m][0], v1 = acc[ai][bj][m][1];
                        s += (v0[0] * v0[0] + v0[1] * v0[1]) + (v0[2] * v0[2] + v0[3] * v0[3]) + (v1[0] * v1[0] + v1[1] * v1[1]) + (v1[2] * v1[2] + v1[3] * v1[3]);
                        *(u32x4*)(dst + (size_t)row * ld + cb + bj * 128) = pack8(v0, v1); }
                    s += __shfl_xor(s, 16); s += __shfl_xor(s, 32);
                    if (fq == 0 && ssq) ssq_add(ssq + row, s); }
        } else if (vt < 16) {
            const bool isq = vt < 14; bf16_t* dst = isq ? qb : kb; const int ld = isq ? 2048 : 512, cb = (isq ? vt - 6 : vt - 14) * 256 + ct; const float sc = isq ? QB_SCALE : 1.f;
#pragma unroll
            for (int ai = 0; ai < 2; ++ai)
#pragma unroll
                for (int m = 0; m < 4; ++m) { const int row = rowb + ai * 128 + m * 16, t = row % TP;
                    f32x4 cs0 = (f32x4){1.f, 0.f, 1.f, 0.f}, cs1 = cs0;
                    if (wc == 0) { const f32x4* p = (const f32x4*)(ropeD + ((size_t)t * 16 + 4 * fq) * 2); cs0 = p[0]; cs1 = p[1]; }
#pragma unroll
                    for (int bj = 0; bj < 2; ++bj) { f32x4 v0 = acc[ai][bj][m][0], v1 = acc[ai][bj][m][1];
                        if (wc == 0) { rot2(v0, cs0); rot2(v1, cs1); }
                        v0 = v0 * sc; v1 = v1 * sc;
                        *(u32x4*)(dst + (size_t)row * ld + cb + bj * 128) = pack8(v0, v1); } }
        } else if (vt < 18) {
            const int cb = (vt - 16) * 256 + ct;
#pragma unroll
            for (int ai = 0; ai < 2; ++ai)
#pragma unroll
                for (int m = 0; m < 4; ++m) { const int row = rowb + ai * 128 + m * 16;
#pragma unroll
                    for (int bj = 0; bj < 2; ++bj) *(u32x4*)(vb + (size_t)row * 512 + cb + bj * 128) = pack8(acc[ai][bj][m][0], acc[ai][bj][m][1]); }
        } else if (vt < 22) {
            const int cb = (vt - 18) * 256 + ct; const bool rt = ((wc & 1) == 0) && (fq < 2);
#pragma unroll
            for (int ai = 0; ai < 2; ++ai)
#pragma unroll
                for (int m = 0; m < 4; ++m) { const int row = rowb + ai * 128 + m * 16, t = row % TP;
                    f32x4 cs0 = (f32x4){1.f, 0.f, 1.f, 0.f}, cs1 = cs0;
                    if (rt) { const f32x4* p = (const f32x4*)(ropeI + ((size_t)t * 8 + 4 * fq) * 2); cs0 = p[0]; cs1 = p[1]; }
#pragma unroll
                    for (int bj = 0; bj < 2; ++bj) { f32x4 v0 = acc[ai][bj][m][0], v1 = acc[ai][bj][m][1];
                        if (rt) { rot2(v0, cs0); rot2(v1, cs1); }
                        *(u32x4*)(qix + (size_t)row * 1024 + cb + bj * 128) = pack8(v0, v1); } }
        } else if (vt == 22) {
#pragma unroll
            for (int ai = 0; ai < 2; ++ai)
#pragma unroll
                for (int m = 0; m < 4; ++m) { const int row = rowb + ai * 128 + m * 16, t = row % TP;
                    f32x4 v0 = acc[ai][0][m][0], v1 = acc[ai][0][m][1];
                    if (wc < 2) { const f32x4* p = (const f32x4*)(ropeM + ((size_t)t * 32 + 16 * wc + 4 * fq) * 2); rot2(v0, p[0]); rot2(v1, p[1]);
                        *(u32x4*)(kpe + (size_t)row * 64 + ct) = pack8(v0, v1);
                    } else { if (wc == 2 && fq < 2) { const f32x4* p = (const f32x4*)(ropeI + ((size_t)t * 8 + 4 * fq) * 2); rot2(v0, p[0]); rot2(v1, p[1]); }
                        *(u32x4*)(kix + (size_t)row * 64 + (ct - 64)) = pack8(v0, v1); }
                    if (wc == 0 && fq < 2) { float* w = wix + (size_t)row * 16 + 8 * fq; *(f32x4*)w = acc[ai][1][m][0]; *(f32x4*)(w + 4) = acc[ai][1][m][1]; } }
        } else {
            const bool isa = vt < 39; bf16_t* dst = isa ? ga : gb; const int cb = (isa ? vt - 23 : vt - 39) * 256 + ct;
#pragma unroll
            for (int ai = 0; ai < 2; ++ai)
#pragma unroll
                for (int m = 0; m < 4; ++m) { const int row = rowb + ai * 128 + m * 16;
#pragma unroll
                    for (int bj = 0; bj < 2; ++bj) { f32x4 v0 = acc[ai][bj][m][0], v1 = acc[ai][bj][m][1];
#pragma unroll
                        for (int e = 0; e < 4; ++e) { v0[e] = sigm(v0[e]); v1[e] = sigm(v1[e]); }
                        *(u32x4*)(dst + (size_t)row * 4096 + cb + bj * 128) = pack8(v0, v1); } }
        }
    }
};

struct EpiUp {
    static constexpr bool PERM = true, AFTER_DRAIN = false, SPLITK2 = false;
    bf16_t *d0, *d1; int nt0, ld0, ld1; const u64* ssq; float invK, scale; const float* rope;
    __device__ __forceinline__ void operator()(const Acc& acc, const Unit& u, int wr, int wc, int fr, int fq) const {
        const int vt = u.pn, rowb = u.pm * 256 + wr * 64 + fr, ct = wc * 32 + 8 * fq; const bool first = vt < nt0;
        bf16_t* dst = first ? d0 : d1; const int ld = first ? ld0 : ld1, cb = (first ? vt : vt - nt0) * 256 + ct; const bool rt = (!first) && (rope != nullptr);
#pragma unroll
        for (int ai = 0; ai < 2; ++ai)
#pragma unroll
            for (int m = 0; m < 4; ++m) { const int row = rowb + ai * 128 + m * 16, t = row % TP;
                const float rs = __builtin_amdgcn_rsqf(ssq_get(ssq + row) * invK + EPS) * scale;
                f32x4 cs0 = (f32x4){1.f, 0.f, 1.f, 0.f}, cs1 = cs0;
                if (rt) { const f32x4* p = (const f32x4*)(rope + ((size_t)t * 32 + 16 * (wc & 1) + 4 * fq) * 2); cs0 = p[0]; cs1 = p[1]; }
#pragma unroll
                for (int bj = 0; bj < 2; ++bj) { f32x4 v0 = acc[ai][bj][m][0] * rs, v1 = acc[ai][bj][m][1] * rs;
                    if (rt) { rot2(v0, cs0); rot2(v1, cs1); }
                    *(u32x4*)(dst + (size_t)row * ld + cb + bj * 128) = pack8(v0, v1); } }
    }
};

struct EpiBranch {
    static constexpr bool PERM = true, AFTER_DRAIN = false, SPLITK2 = true;
    const bf16_t *ga, *gb; bf16_t* out;
    __device__ __forceinline__ void operator()(Acc& acc, const Unit& u, int wr, int wc, int fr, int fq) const {
        const int rowb = u.pm * 256 + wr * 64 + fr, cb = u.pn * 256 + wc * 32 + 8 * fq;
        if (u.kh == 0) {
#pragma unroll
            for (int ai = 0; ai < 2; ++ai)
#pragma unroll
                for (int m = 0; m < 4; ++m) { const size_t ro = (size_t)(rowb + ai * 128 + m * 16) * 4096 + cb;
#pragma unroll
                    for (int bj = 0; bj < 2; ++bj) { const u32x4 a = *(const u32x4*)(ga + ro + bj * 128), b = *(const u32x4*)(gb + ro + bj * 128);
                        f32x4 r0, r1;
#define RQ(x, y) ((x) * __builtin_amdgcn_rcpf(y))
                        r0[0] = RQ(bf_lo(a.x), bf_lo(b.x)); r0[1] = RQ(bf_hi(a.x), bf_hi(b.x)); r0[2] = RQ(bf_lo(a.y), bf_lo(b.y)); r0[3] = RQ(bf_hi(a.y), bf_hi(b.y));
                        r1[0] = RQ(bf_lo(a.z), bf_lo(b.z)); r1[1] = RQ(bf_hi(a.z), bf_hi(b.z)); r1[2] = RQ(bf_lo(a.w), bf_lo(b.w)); r1[3] = RQ(bf_hi(a.w), bf_hi(b.w));
#undef RQ
                        acc[ai][bj][m][0] = acc[ai][bj][m][0] * r0; acc[ai][bj][m][1] = acc[ai][bj][m][1] * r1; }
                    asm volatile("" ::: "memory"); }
        } else {
#pragma unroll
            for (int ai = 0; ai < 2; ++ai)
#pragma unroll
                for (int m = 0; m < 4; ++m) { const size_t ro = (size_t)(rowb + ai * 128 + m * 16) * 4096 + cb;
#pragma unroll
                    for (int bj = 0; bj < 2; ++bj) { const u32x4 b = *(const u32x4*)(gb + ro + bj * 128);
                        const f32x4 s0 = (f32x4){bf_lo(b.x), bf_hi(b.x), bf_lo(b.y), bf_hi(b.y)}, s1 = (f32x4){bf_lo(b.z), bf_hi(b.z), bf_lo(b.w), bf_hi(b.w)};
                        *(u32x4*)(out + ro + bj * 128) = pack8(acc[ai][bj][m][0] * s0, acc[ai][bj][m][1] * s1); } }
        }
    }
};

struct EpiOut {
    static constexpr bool PERM = true, AFTER_DRAIN = false, SPLITK2 = false;
    const float *x, *meta; float* h1f; bf16_t* h1b; u64* ssq;
    __device__ __forceinline__ void operator()(const Acc& acc, const Unit& u, int wr, int wc, int fr, int fq) const {
        const int rowb = u.pm * 256 + wr * 64 + fr, cb = u.pn * 256 + wc * 32 + 8 * fq;
#pragma unroll
        for (int ai = 0; ai < 2; ++ai)
#pragma unroll
            for (int m = 0; m < 4; ++m) { const int row = rowb + ai * 128 + m * 16, b = row / TP, t = row % TP;
                const float* src = t < NMETA ? meta + (size_t)t * DM : (t < TR ? x + ((size_t)b * SEQ + (t - NMETA)) * DM : nullptr);
                float s = 0.f;
#pragma unroll
                for (int bj = 0; bj < 2; ++bj) { f32x4 v0 = acc[ai][bj][m][0], v1 = acc[ai][bj][m][1];
                    if (src) { v0 = v0 + *(const f32x4*)(src + cb + bj * 128); v1 = v1 + *(const f32x4*)(src + cb + bj * 128 + 4); }
                    s += (v0[0] * v0[0] + v0[1] * v0[1]) + (v0[2] * v0[2] + v0[3] * v0[3]) + (v1[0] * v1[0] + v1[1] * v1[1]) + (v1[2] * v1[2] + v1[3] * v1[3]);
                    float* o = h1f + (size_t)row * DM + cb + bj * 128; *(f32x4*)o = v0; *(f32x4*)(o + 4) = v1;
                    *(u32x4*)(h1b + (size_t)row * DM + cb + bj * 128) = pack8(v0, v1); }
                s += __shfl_xor(s, 16); s += __shfl_xor(s, 32);
                if (fq == 0 && ssq) ssq_add(ssq + row, s); }
    }
};

struct EpiPQ {
    static constexpr bool PERM = true, AFTER_DRAIN = false, SPLITK2 = false;
    bf16_t* pq; const u64* ssq;
    __device__ __forceinline__ void operator()(const Acc& acc, const Unit& u, int wr, int wc, int fr, int fq) const {
        const int rowb = u.pm * 256 + wr * 64 + fr, cb = u.pn * 256 + wc * 32 + 8 * fq;
#pragma unroll
        for (int ai = 0; ai < 2; ++ai)
#pragma unroll
            for (int m = 0; m < 4; ++m) { const int row = rowb + ai * 128 + m * 16; const float rs = __builtin_amdgcn_rsqf(ssq_get(ssq + row) * (1.0f / DM) + EPS);
#pragma unroll
                for (int bj = 0; bj < 2; ++bj) *(u32x4*)(pq + (size_t)row * 2048 + cb + bj * 128) = pack8(acc[ai][bj][m][0] * rs, acc[ai][bj][m][1] * rs); }
    }
};
}
#define XB_TMO      128
#define XB_XCNT(j)  (256  + 64 * (j))
#define XB_XSUB(j)  (1280 + 64 * (j))
#define XB_XGEN(j)  (2304 + 64 * (j))
#define XB_TOP      3328
#define XB_TOPGEN   3392
#define XCD_BAR_WORDS 3456
#define XB_SPIN_CAP (1u << 18)
__device__ __forceinline__ unsigned xb_ld(unsigned* p)              { return __hip_atomic_load(p, __ATOMIC_RELAXED, __HIP_MEMORY_SCOPE_AGENT); }
__device__ __forceinline__ unsigned xb_add(unsigned* p, unsigned v) { return __hip_atomic_fetch_add(p, v, __ATOMIC_RELAXED, __HIP_MEMORY_SCOPE_AGENT); }
__device__ __forceinline__ unsigned xb_xcc_id() { return (unsigned)__builtin_amdgcn_s_getreg((3 << 11) | 20) & 0xFu; }
#define XB_SPIN(cond, bar) do { unsigned _sp = 0; while (cond) { __builtin_amdgcn_s_sleep(1); \
    if ((++_sp & 255u) == 0u) { if (xb_ld(&(bar)[XB_TMO])) break; if (_sp > XB_SPIN_CAP) { atomicAdd(&(bar)[XB_TMO], 1u); break; } } } } while (0)
struct XcdBarrier { unsigned* bar; unsigned x; volatile LAS unsigned* st; };
__device__ __forceinline__ XcdBarrier xcd_barrier_post(unsigned* bar, volatile LAS unsigned* st) {
    XcdBarrier b; b.bar = bar; b.x = xb_xcc_id(); b.st = st;
    if (threadIdx.x == 0) (void)xb_add(&bar[XB_XCNT(b.x)], 1u);
    return b;
}
__device__ __forceinline__ void xcd_barrier_complete(unsigned* bar, unsigned x, unsigned& nloc, unsigned& nx) {
    const unsigned G = gridDim.x * gridDim.y * gridDim.z;
    unsigned sum, cnt, mine, sp = 0u;
    for (;;) {
        sum = 0u; cnt = 0u; mine = 0u;
#pragma unroll
        for (unsigned j = 0; j < 16; ++j) { const unsigned c = xb_ld(&bar[XB_XCNT(j)]); sum += c; cnt += (c > 0u) ? 1u : 0u; mine = (j == x) ? c : mine; }
        if (sum == G) break;
        __builtin_amdgcn_s_sleep(1);
        if ((++sp & 255u) == 0u) { if (xb_ld(&bar[XB_TMO])) break; if (sp > XB_SPIN_CAP) { atomicAdd(&bar[XB_TMO], 1u); break; } }
    }
    nloc = mine > 0u ? mine : 1u; nx = cnt > 0u ? cnt : 1u;
}
__device__ __forceinline__ void xcd_barrier(const XcdBarrier& b) {
    asm volatile("s_waitcnt vmcnt(0)" ::: "memory");
    __syncthreads();
    if (threadIdx.x == 0) {
        unsigned* bar = b.bar;
        __builtin_amdgcn_s_waitcnt(0);
        unsigned nloc = b.st[0], nx = b.st[1];
        if (nloc == 0u) { xcd_barrier_complete(bar, b.x, nloc, nx); b.st[0] = nloc; b.st[1] = nx; }
        const unsigned old = xb_add(&bar[XB_XSUB(b.x)], 1u);
        const unsigned gen = old / nloc;
        if (old + 1u == (gen + 1u) * nloc) {
            __builtin_amdgcn_fence(__ATOMIC_RELEASE, "agent");
            asm volatile("s_waitcnt vmcnt(0)" ::: "memory");
            const unsigned og = xb_add(&bar[XB_TOP], 1u);
            const unsigned tg = og / nx;
            if (og + 1u == (tg + 1u) * nx) xb_add(&bar[XB_TOPGEN], 1u);
            else XB_SPIN(xb_ld(&bar[XB_TOPGEN]) == tg, bar);
            __builtin_amdgcn_fence(__ATOMIC_ACQUIRE, "agent");
            xb_add(&bar[XB_XGEN(b.x)], 1u);
            asm volatile("s_waitcnt vmcnt(0)" ::: "memory");
        } else {
            XB_SPIN(xb_ld(&bar[XB_XGEN(b.x)]) == gen, bar);
            __builtin_amdgcn_fence(__ATOMIC_ACQUIRE, "agent");
            asm volatile("s_waitcnt vmcnt(0)" ::: "memory");
        }
    }
    __syncthreads();
}

struct Frame {
    LAS unsigned char* lds;
    unsigned char* ws;
    unsigned* ctl;
    int tid, lane, wave, vcu, G;
    __device__ __forceinline__ const float* in(int i) const { return ((const float* const __attribute__((address_space(4)))*)__builtin_amdgcn_kernarg_segment_ptr())[i]; }
    __device__ __forceinline__ float* out() const { return ((float* const __attribute__((address_space(4)))*)__builtin_amdgcn_kernarg_segment_ptr())[16]; }
};

struct MapId { __device__ __forceinline__ int operator()(int v) const { return v; } };
struct MapIn { __device__ __forceinline__ int operator()(int v) const {
    if (v < 1536) return v;
    if (v < 3584) { const int w = v - 1536, hd = w >> 7; int o = w & 127; if (o < 32) o = (o & 1) ? (o >> 1) + 16 : (o >> 1); return 1600 + hd * 128 + o; }
    if (v < 4096) { const int w = v - 3584, hd = w >> 7; int o = w & 127; if (o < 32) o = (o & 1) ? (o >> 1) + 16 : (o >> 1); return 3648 + hd * 128 + o; }
    if (v < 4608) return 4160 + (v - 4096);
    if (v < 5632) { const int w = v - 4608, hd = w >> 6; int o = w & 63; if (o < 16) o = (o & 1) ? (o >> 1) + 8 : (o >> 1); return 4672 + hd * 64 + o; }
    if (v < 5888) { const int w = v - 5632;
        if (w < 64) return 1536 + ((w & 1) ? (w >> 1) + 32 : (w >> 1));
        if (w < 128) { int o = w - 64; if (o < 16) o = (o & 1) ? (o >> 1) + 8 : (o >> 1); return 5696 + o; }
        if (w < 144) return 5760 + (w - 128);
        return -1; }
    if (v < 9984) return 5776 + (v - 5888);
    return 9872 + (v - 9984);
} };
struct MapUq { __device__ __forceinline__ int operator()(int v) const {
    if (v < 2048) return (v >> 7) * 192 + (v & 127);
    const int w = v - 2048, hd = w >> 6, o = w & 63; return hd * 192 + 128 + ((o & 1) ? (o >> 1) + 32 : (o >> 1)); } };
struct MapUkv { __device__ __forceinline__ int operator()(int v) const {
    if (v < 2048) return (v >> 7) * 256 + (v & 127);
    const int w = v - 2048; return (w >> 7) * 256 + 128 + (w & 127); } };

template <class Map>
__device__ __forceinline__ void p0_transpose_item(const float* W, int K, int Nsrc, int Nvirt, bf16_t* WT, const float* gk, LAS float* scr, int item, int lane, Map map) {
    const int nblk = Nvirt / 32, kb = item / nblk, nb = item % nblk, k0 = 64 * kb, n0 = 32 * nb;
    const int sc = map(n0 + (lane & 31));
#pragma unroll 8
    for (int i = 0; i < 32; ++i) { const int kk = 2 * i + (lane >> 5); float v = 0.f;
        if (sc >= 0) v = W[(size_t)(k0 + kk) * Nsrc + sc];
        if (gk) v *= gk[k0 + kk];
        scr[kk * 33 + (lane & 31)] = v; }
    LDS_WAIT(); asm volatile("" ::: "memory");
    const int c = lane & 7;
#pragma unroll
    for (int j = 0; j < 4; ++j) { const int n = (lane >> 3) + 8 * j; const LAS float* s = scr + (8 * c) * 33 + n;
        u32x4 o; o.x = pk2(s[0 * 33], s[1 * 33]); o.y = pk2(s[2 * 33], s[3 * 33]); o.z = pk2(s[4 * 33], s[5 * 33]); o.w = pk2(s[6 * 33], s[7 * 33]);
        *(u32x4*)(WT + (size_t)(n0 + n) * K + k0 + 8 * c) = o; }
    LDS_WAIT(); asm volatile("" ::: "memory");
}
__device__ __forceinline__ void p0_xn_row(const Frame& F, int m) {
    const int b = m / TP, t = m % TP; const float* x = F.in(0); const float* meta = F.in(1); const float* g = F.in(2);
    bf16_t* o = (bf16_t*)(F.ws + WS_XN) + (size_t)m * DM;
    u32x2* o8 = (u32x2*)o + F.lane;
    if (t >= TR) {
#pragma unroll
        for (int j = 0; j < 16; ++j) o8[64 * j] = (u32x2){0u, 0u};
        return; }
    const float* src = t < NMETA ? meta + (size_t)t * DM : x + ((size_t)b * SEQ + (t - NMETA)) * DM;
    const f32x4* xr = (const f32x4*)src + F.lane; const f32x4* gr = (const f32x4*)g + F.lane;
    f32x4 v[16]; float s = 0.f;
#pragma unroll
    for (int j = 0; j < 16; ++j) { v[j] = xr[64 * j]; s += (v[j][0] * v[j][0] + v[j][1] * v[j][1]) + (v[j][2] * v[j][2] + v[j][3] * v[j][3]); }
    const float rstd = 1.0f / sqrtf(wave_sum(s) * (1.0f / DM) + EPS);
#pragma unroll
    for (int j = 0; j < 16; ++j) { const f32x4 gg = gr[64 * j]; const f32x4 y = v[j] * rstd * gg; o8[64 * j] = (u32x2){pk2(y[0], y[1]), pk2(y[2], y[3])}; }
}
__device__ __forceinline__ void p0_prologue(const Frame& F) {
    LAS float* scr = (LAS float*)(F.lds + F.wave * 16384);
    const int gw = F.vcu * NWAVES + F.wave, NGW = F.G * NWAVES;
    const float* w_in = F.in(3); const float* qg = F.in(4); const float* w_uq = F.in(5); const float* kvg = F.in(6); const float* w_ukv = F.in(7);
    const float* w_br = F.in(8); const float* w_out = F.in(9); const float* fg = F.in(10); const float* w_q = F.in(11); const float* sk = F.in(12);
    constexpr int I_IN = 64 * (NV1 / 32), I_UQ = 16 * (3072 / 32), I_UKV = 8 * (4096 / 32), I_BR = 64 * 128, I_OUT = 64 * 128, I_Q = 64 * 64;
    constexpr int NITEMS = I_IN + I_UQ + I_UKV + I_BR + I_OUT + I_Q;
    for (int it = gw; it < NITEMS; it += NGW) {
        int r = it;
        if (r < I_IN) { p0_transpose_item(w_in, 4096, 13968, NV1, (bf16_t*)(F.ws + WS_WIN), nullptr, scr, r, F.lane, MapIn()); continue; } r -= I_IN;
        if (r < I_UQ) { p0_transpose_item(w_uq, 1024, 3072, 3072, (bf16_t*)(F.ws + WS_WUQ), qg, scr, r, F.lane, MapUq()); continue; } r -= I_UQ;
        if (r < I_UKV) { p0_transpose_item(w_ukv, 512, 4096, 4096, (bf16_t*)(F.ws + WS_WUKV), kvg, scr, r, F.lane, MapUkv()); continue; } r -= I_UKV;
        if (r < I_BR) { p0_transpose_item(w_br, 4096, 4096, 4096, (bf16_t*)(F.ws + WS_WBR), nullptr, scr, r, F.lane, MapId()); continue; } r -= I_BR;
        if (r < I_OUT) { p0_transpose_item(w_out, 4096, 4096, 4096, (bf16_t*)(F.ws + WS_WOUT), nullptr, scr, r, F.lane, MapId()); continue; } r -= I_OUT;
        p0_transpose_item(w_q, 4096, 2048, 2048, (bf16_t*)(F.ws + WS_WQ), fg, scr, r, F.lane, MapId());
    }
    for (int m = gw; m < M; m += NGW) p0_xn_row(F, m);
    const int gt = (F.vcu * NWAVES + F.wave) * 64 + F.lane, NGT = NGW * 64;
    for (int i = gt; i < TP * 56; i += NGT) {
        const int t = i / 56, r = i % 56; int j, rot; float* dst;
        if (r < 32) { j = r; rot = 64; dst = (float*)(F.ws + WS_ROPE_M) + ((size_t)t * 32 + j) * 2; }
        else if (r < 48) { j = r - 32; rot = 32; dst = (float*)(F.ws + WS_ROPE_D) + ((size_t)t * 16 + j) * 2; }
        else { j = r - 48; rot = 16; dst = (float*)(F.ws + WS_ROPE_I) + ((size_t)t * 8 + j) * 2; }
        const float ex = (float)(2 * j) / (float)rot;
        const float inv = powf(500000.0f, -ex);
        const float ang = (float)t * inv;
        const double a = (double)ang, kq = rint(a * 0.15915494309189535), rr = fma(-kq, 6.283185307179586, a);
        const float rf = (float)rr;
        dst[0] = cosf(rf); dst[1] = sinf(rf);
    }
    for (int i = gt; i < 16 * 128 * 128 / 8; i += NGT) { const f32x4* s = (const f32x4*)sk + 2 * (size_t)i; const f32x4 a = s[0], b2 = s[1];
        u32x4 o; o.x = pk2(a[0], a[1]); o.y = pk2(a[2], a[3]); o.z = pk2(b2[0], b2[1]); o.w = pk2(b2[2], b2[3]); ((u32x4*)(F.ws + WS_SK))[i] = o; }
}
__device__ __forceinline__ float wave_max(float v) {
#pragma unroll
    for (int o = 1; o < 64; o <<= 1) v = fmaxf(v, __shfl_xor(v, o));
    return v;
}
__device__ __forceinline__ unsigned fp6_code(float q) {
    const unsigned b = __float_as_uint(q), sgn = (b >> 31) << 5; const float aq = fabsf(q);
    const unsigned sub = (unsigned)rintf(aq * 8.0f);
    unsigned ab = b & 0x7fffffffu; ab = ab + 0x7FFFFu + ((ab >> 20) & 1u);
    const unsigned nrm = (ab >> 20) - (126u << 3);
    unsigned code = aq < 1.0f ? sub : nrm; code = code > 31u ? 31u : code;
    return code | sgn;
}
__device__ __forceinline__ void fp6_pack32(const unsigned (&c)[32], unsigned (&w)[6]) {
#pragma unroll
    for (int i = 0; i < 6; ++i) w[i] = 0u;
#pragma unroll
    for (int k = 0; k < 32; ++k) { const int bit = 6 * k, d = bit >> 5, sh = bit & 31; w[d] |= c[k] << sh; if (sh > 26) w[d + 1] |= c[k] >> (32 - sh); }
}
__device__ __forceinline__ void p6_quant_row(const float* src, const float* gain, unsigned char* dst, float* scale_out, int lane) {
    const f32x4* s = (const f32x4*)src + lane; f32x4 v[16]; float mx = 0.f;
#pragma unroll
    for (int j = 0; j < 16; ++j) { v[j] = s[64 * j]; if (gain) v[j] = v[j] * ((const f32x4*)gain)[lane + 64 * j];
        mx = fmaxf(mx, fmaxf(fmaxf(fabsf(v[j][0]), fabsf(v[j][1])), fmaxf(fabsf(v[j][2]), fabsf(v[j][3])))); }
    mx = fmaxf(wave_max(mx), 1e-30f);
    const float sc = mx * (1.0f / 7.5f), inv = 7.5f / mx;
    if (lane == 0) *scale_out = sc;
    unsigned w[12];
#pragma unroll
    for (int g = 0; g < 2; ++g) { unsigned c[32];
#pragma unroll
        for (int j = 0; j < 8; ++j)
#pragma unroll
            for (int i = 0; i < 4; ++i) c[4 * j + i] = fp6_code(v[8 * g + j][i] * inv);
        unsigned ww[6]; fp6_pack32(c, ww);
#pragma unroll
        for (int i = 0; i < 6; ++i) w[6 * g + i] = ww[i]; }
#pragma unroll
    for (int q = 0; q < 3; ++q) *(u32x4*)(dst + 1024 * q + 16 * lane) = (u32x4){w[4 * q], w[4 * q + 1], w[4 * q + 2], w[4 * q + 3]};
}
__device__ __forceinline__ void p6_tables(const Frame& F) {
    const float* fg = F.in(10); const float* pu = F.in(13); const float* pv = F.in(14);
    const int gw = F.vcu * NWAVES + F.wave, NGW = F.G * NWAVES;
    for (int it = gw; it < 2 * 16384; it += NGW) { const int e = it >> 1;
        if (it & 1) p6_quant_row(pv + (size_t)e * DM, nullptr, F.ws + WS_V + (size_t)e * 3072, (float*)(F.ws + WS_SCV) + e, F.lane);
        else p6_quant_row(pu + (size_t)e * DM, fg, F.ws + WS_U + (size_t)e * 3072, (float*)(F.ws + WS_SCU) + e, F.lane); }
}
#define MFMA32(a, b, c) __builtin_amdgcn_mfma_f32_32x32x16_bf16((a), (b), (c), 0, 0, 0)
__device__ __forceinline__ int crow(int i, int h) { return (i & 3) + 8 * (i >> 2) + 4 * h; }
__device__ __forceinline__ float half_sum_f(float v) {
#pragma unroll
    for (int o = 1; o < 32; o <<= 1) v += __shfl_xor(v, o);
    return v;
}
__device__ __forceinline__ int half_sum_i(int v) {
#pragma unroll
    for (int o = 1; o < 32; o <<= 1) v += __shfl_xor(v, o);
    return v;
}
__device__ __forceinline__ float half_max_f(float v) {
#pragma unroll
    for (int o = 1; o < 32; o <<= 1) v = fmaxf(v, __shfl_xor(v, o));
    return v;
}
__device__ __forceinline__ float half_min_f(float v) {
#pragma unroll
    for (int o = 1; o < 32; o <<= 1) v = fminf(v, __shfl_xor(v, o));
    return v;
}
__device__ __forceinline__ void idx_task(const Frame& F, int b, int t0) {
    const int lane = F.lane, r = lane & 31, h = lane >> 5;
    const bf16_t* qix = (const bf16_t*)(F.ws + WS_QIX); const bf16_t* kix = (const bf16_t*)(F.ws + WS_KIX); const float* wix = (const float*)(F.ws + WS_WIX);
    unsigned* mask = (unsigned*)(F.ws + WS_MASK);
    const int tok = (r >> 2) & 1, head = (r & 3) + 4 * (r >> 3);
    const bf16_t* qp = qix + (size_t)(b * TP + t0 + tok) * 1024 + head * 64 + 8 * h;
    bf16x8 af[4];
#pragma unroll
    for (int ks = 0; ks < 4; ++ks) af[ks] = *(const bf16x8*)(qp + 16 * ks);
    const f32x4* wp = (const f32x4*)(wix + (size_t)(b * TP + t0 + h) * 16);
    float w[16];
#pragma unroll
    for (int q = 0; q < 4; ++q) { const f32x4 x = wp[q]; w[4 * q] = x[0]; w[4 * q + 1] = x[1]; w[4 * q + 2] = x[2]; w[4 * q + 3] = x[3]; }
    const int tq = t0 + h;
    const int ngrp = ((t0 + 1) >> 6) + 1;
    const bf16_t* kbase = kix + (size_t)(b * TP + r) * 64 + 8 * h;
    float row[MW];
#pragma unroll
    for (int g = 0; g < MW / 2; ++g) {
        float s0 = -INFINITY, s1 = -INFINITY;
        if (g < ngrp) {
            const bf16_t* kp = kbase + (size_t)(g * 64) * 64;
            bf16x8 b0[4], b1[4];
#pragma unroll
            for (int ks = 0; ks < 4; ++ks) { b0[ks] = *(const bf16x8*)(kp + 16 * ks); b1[ks] = *(const bf16x8*)(kp + 32 * 64 + 16 * ks); }
            float x0 = 0.f, x1 = 0.f;
            { f32x16 a0;
#pragma unroll
              for (int i = 0; i < 16; ++i) a0[i] = 0.f;
#pragma unroll
              for (int ks = 0; ks < 4; ++ks) a0 = MFMA32(af[ks], b0[ks], a0);
#pragma unroll
              for (int i = 0; i < 16; ++i) x0 += w[i] * fmaxf(a0[i], 0.f); }
            { f32x16 a1;
#pragma unroll
              for (int i = 0; i < 16; ++i) a1[i] = 0.f;
#pragma unroll
              for (int ks = 0; ks < 4; ++ks) a1 = MFMA32(af[ks], b1[ks], a1);
#pragma unroll
              for (int i = 0; i < 16; ++i) x1 += w[i] * fmaxf(a1[i], 0.f); }
            s0 = (g * 64 + r <= tq) ? x0 : -INFINITY; s1 = (g * 64 + 32 + r <= tq) ? x1 : -INFINITY;
        }
        row[2 * g] = s0; row[2 * g + 1] = s1;
    }
    float tau = -3.0e38f;
    bool done = (tq + 1 <= 256);
    float mx = -INFINITY, mn = INFINITY;
#pragma unroll
    for (int k = 0; k < MW; ++k) { const float v = row[k]; mx = fmaxf(mx, v); mn = fminf(mn, v > -INFINITY ? v : INFINITY); }
    float lo = half_min_f(mn), hi = half_max_f(mx);
    if (!done) tau = hi;
    for (int it = 0; it < 64; ++it) {
        if (!__any(!done)) break;
        const float mid = lo + (hi - lo) * 0.5f;
        int c = 0;
#pragma unroll
        for (int k = 0; k < MW; ++k) c += (row[k] >= mid) ? 1 : 0;
        c = half_sum_i(c);
        if (!done) {
            if (!(mid > lo && mid < hi)) { tau = hi; done = true; }
            else if (c == 256) { tau = mid; done = true; }
            else if (c > 256) lo = mid;
            else { hi = mid; tau = hi; }
        }
    }
    unsigned* mrow = mask + (size_t)(b * TP + tq) * MW;
    unsigned mw = 0u;
#pragma unroll
    for (int k = 0; k < MW; ++k) {
        const unsigned long long bal = __ballot(row[k] >= tau);
        const unsigned wd = h ? (unsigned)(bal >> 32) : (unsigned)bal;
        if ((k & 31) == r) mw = wd;
        if ((k & 31) == 31 || k == MW - 1) { const int kk = (k & ~31) + r; if (kk < MW) mrow[kk] = mw; }
    }
}
__device__ __forceinline__ void p2_indexer(const Frame& F, int qslot) {
    volatile LAS unsigned* qw = (volatile LAS unsigned*)(F.lds + LDSCTL_OFF + 16);
    constexpr int NCH = M / 16;
    for (;;) {
        if (F.tid == 0) qw[0] = atomicAdd(F.ctl + CW_QUEUE + 64 * qslot, 1u);
        __syncthreads();
        const int c = (int)qw[0];
        __syncthreads();
        if (c >= NCH) break;
        const int b = c & 3, tblk = (TP / 16 - 1) - (c >> 2);
        idx_task(F, b, tblk * 16 + 2 * F.wave);
    }
}
template <bool MLA> struct AttnCfg {
    static constexpr int DQK = MLA ? 192 : 128, PK = DQK * 2 + 16, PV = 320, KCH = DQK / 8, NKC = 64 * KCH / 512, KBYTES = 64 * PK, BUFB = 64 * PK + 64 * PV;
};
struct AttnUnit { int type, b, hx, blk; };

template <bool MLA>
__device__ __forceinline__ void attn_unit(const Frame& F, const AttnUnit u) {
    typedef AttnCfg<MLA> C;
    const int tid = F.tid, lane = F.lane, wave = F.wave, r = lane & 31, h = lane >> 5;
    LAS unsigned char* lds = F.lds;
    const bf16_t* qn = (const bf16_t*)(F.ws + WS_QN); const bf16_t* qr = (const bf16_t*)(F.ws + WS_QR); const bf16_t* kn = (const bf16_t*)(F.ws + WS_KN);
    const bf16_t* va = (const bf16_t*)(F.ws + WS_VA); const bf16_t* kpe = (const bf16_t*)(F.ws + WS_KPE);
    const bf16_t* qb = (const bf16_t*)(F.ws + WS_QB); const bf16_t* kb = (const bf16_t*)(F.ws + WS_KB); const bf16_t* vb = (const bf16_t*)(F.ws + WS_VB);
    const unsigned* mask = (const unsigned*)(F.ws + WS_MASK); bf16_t* oab = (bf16_t*)(F.ws + WS_OAB);
    const int b = u.b;
    const size_t rowb = (size_t)b * TP;
    int head, tw0, ntiles;
    if (MLA) { head = u.hx; tw0 = u.blk * 256 + 32 * wave; const int tend = (u.blk * 256 + 256 < TP) ? u.blk * 256 + 256 : TP; ntiles = tend / 64; }
    else { head = 4 * u.hx + (wave & 3); tw0 = u.blk * 64 + 32 * (wave >> 2); ntiles = u.blk + 1; }
    const bool active = tw0 < TP;
    const int tq = tw0 + r;
    bf16x8 qf[C::DQK / 16];
    if (active) {
        if (MLA) {
            const bf16_t* p0 = qn + (rowb + tq) * 2048 + head * 128 + 8 * h; const bf16_t* p1 = qr + (rowb + tq) * 1024 + head * 64 + 8 * h;
#pragma unroll
            for (int ks = 0; ks < 8; ++ks) qf[ks] = *(const bf16x8*)(p0 + 16 * ks);
#pragma unroll
            for (int ks = 0; ks < 4; ++ks) qf[8 + ks] = *(const bf16x8*)(p1 + 16 * ks);
        } else {
            const bf16_t* p0 = qb + (rowb + tq) * 2048 + head * 128 + 8 * h;
#pragma unroll
            for (int ks = 0; ks < 8; ++ks) qf[ks] = *(const bf16x8*)(p0 + 16 * ks);
        }
    } else {
#pragma unroll
        for (int ks = 0; ks < C::DQK / 16; ++ks) qf[ks] = (bf16x8){0, 0, 0, 0, 0, 0, 0, 0};
    }
    const int ldkv = MLA ? 2048 : 512;
    const bf16_t* kbase = (MLA ? kn + rowb * 2048 + head * 128 : kb + rowb * 512 + u.hx * 128);
    const bf16_t* vbase = (MLA ? va + rowb * 2048 + head * 128 : vb + rowb * 512 + u.hx * 128);
    const bf16_t* pbase = kpe + rowb * 64;
    unsigned soff[2]; int kdst[2], vdst[2];
#pragma unroll
    for (int i = 0; i < 2; ++i) { const int c = tid + 512 * i, key = c >> 4, pc = c & 15; soff[i] = (unsigned)(key * ldkv + pc * 8); kdst[i] = key * C::PK + pc * 16; vdst[i] = C::KBYTES + key * C::PV + pc * 16; }
    const unsigned poff = (unsigned)((tid >> 3) * 64 + (tid & 7) * 8); const int pdst = (tid >> 3) * C::PK + 256 + (tid & 7) * 16;
    u32x4 kst[2], vst[2], pst = (u32x4){0u, 0u, 0u, 0u};
#pragma unroll
    for (int i = 0; i < 2; ++i) { kst[i] = *(const u32x4*)(kbase + soff[i]); vst[i] = *(const u32x4*)(vbase + soff[i]); }
    if (MLA) pst = *(const u32x4*)(pbase + poff);
#pragma unroll
    for (int i = 0; i < 2; ++i) { *(LAS u32x4*)(lds + kdst[i]) = kst[i]; *(LAS u32x4*)(lds + vdst[i]) = vst[i]; }
    if (MLA) *(LAS u32x4*)(lds + pdst) = pst;
    __syncthreads();
    f32x16 oacc[4];
#pragma unroll
    for (int d = 0; d < 4; ++d)
#pragma unroll
        for (int i = 0; i < 16; ++i) oacc[d][i] = 0.f;
    float mrun = -INFINITY, lrun = 0.f;
    const int koff = r * C::PK + 16 * h;
    const int voff = C::KBYTES + (4 * h + ((lane & 15) >> 2)) * C::PV + (16 * ((lane >> 4) & 1) + 4 * (lane & 3)) * 2;
    const unsigned* mrow = mask + (rowb + (active ? tq : 0)) * MW;
    for (int kt = 0; kt < ntiles; ++kt) {
        const int cur = (kt & 1) * C::BUFB, nxt = ((kt + 1) & 1) * C::BUFB;
        const bool more = kt + 1 < ntiles;
        if (more) {
            const bf16_t* kb2 = kbase + (size_t)(kt + 1) * 64 * ldkv; const bf16_t* vb2 = vbase + (size_t)(kt + 1) * 64 * ldkv;
#pragma unroll
            for (int i = 0; i < 2; ++i) { kst[i] = *(const u32x4*)(kb2 + soff[i]); vst[i] = *(const u32x4*)(vb2 + soff[i]); }
            if (MLA) pst = *(const u32x4*)(pbase + (size_t)(kt + 1) * 64 * 64 + poff);
        }
        if (active && kt * 64 <= tw0 + 31) {
            u32x2 mwd = (u32x2){0u, 0u};
            if (!MLA) mwd = *(const u32x2*)(mrow + 2 * kt);
            f32x16 s0, s1;
#pragma unroll
            for (int i = 0; i < 16; ++i) { s0[i] = 0.f; s1[i] = 0.f; }
#pragma unroll
            for (int ks = 0; ks < C::DQK / 16; ++ks) {
                const bf16x8 k0 = *(const LAS bf16x8*)(lds + cur + koff + 32 * ks), k1 = *(const LAS bf16x8*)(lds + cur + koff + 32 * C::PK + 32 * ks);
                s0 = MFMA32(k0, qf[ks], s0); s1 = MFMA32(k1, qf[ks], s1);
            }
            if (MLA) {
                if (kt * 64 + 63 > tw0) {
                    const int kb0 = kt * 64 + 4 * h;
#pragma unroll
                    for (int i = 0; i < 16; ++i) { const int key = kb0 + (i & 3) + 8 * (i >> 2); if (key > tq) s0[i] = -INFINITY; if (key + 32 > tq) s1[i] = -INFINITY; }
                }
            } else {
                const unsigned m0 = mwd.x >> (4 * h), m1 = mwd.y >> (4 * h);
#pragma unroll
                for (int i = 0; i < 16; ++i) { const int bit = (i & 3) + 8 * (i >> 2); if (!((m0 >> bit) & 1u)) s0[i] = -INFINITY; if (!((m1 >> bit) & 1u)) s1[i] = -INFINITY; }
            }
            float mx = s0[0];
#pragma unroll
            for (int i = 1; i < 16; ++i) mx = fmaxf(mx, s0[i]);
#pragma unroll
            for (int i = 0; i < 16; ++i) mx = fmaxf(mx, s1[i]);
            mx = fmaxf(mx, __shfl_xor(mx, 32));
            const float mnew = fmaxf(mrun, mx);
            const float msafe = (mnew == -INFINITY) ? 0.f : mnew;
            const float alpha = __builtin_amdgcn_exp2f(mrun - msafe);
            mrun = mnew;
            float ps = 0.f;
#pragma unroll
            for (int i = 0; i < 16; ++i) { s0[i] = __builtin_amdgcn_exp2f(s0[i] - msafe); s1[i] = __builtin_amdgcn_exp2f(s1[i] - msafe); ps += s0[i] + s1[i]; }
            lrun = lrun * alpha + ps;
#pragma unroll
            for (int d = 0; d < 4; ++d)
#pragma unroll
                for (int i = 0; i < 16; ++i) oacc[d][i] *= alpha;
            bf16x8 pf[4];
            { u32x4 w;
              w.x = cvt_pk_bf16(s0[0], s0[1]); w.y = cvt_pk_bf16(s0[2], s0[3]); w.z = cvt_pk_bf16(s0[4], s0[5]); w.w = cvt_pk_bf16(s0[6], s0[7]); pf[0] = __builtin_bit_cast(bf16x8, w);
              w.x = cvt_pk_bf16(s0[8], s0[9]); w.y = cvt_pk_bf16(s0[10], s0[11]); w.z = cvt_pk_bf16(s0[12], s0[13]); w.w = cvt_pk_bf16(s0[14], s0[15]); pf[1] = __builtin_bit_cast(bf16x8, w);
              w.x = cvt_pk_bf16(s1[0], s1[1]); w.y = cvt_pk_bf16(s1[2], s1[3]); w.z = cvt_pk_bf16(s1[4], s1[5]); w.w = cvt_pk_bf16(s1[6], s1[7]); pf[2] = __builtin_bit_cast(bf16x8, w);
              w.x = cvt_pk_bf16(s1[8], s1[9]); w.y = cvt_pk_bf16(s1[10], s1[11]); w.z = cvt_pk_bf16(s1[12], s1[13]); w.w = cvt_pk_bf16(s1[14], s1[15]); pf[3] = __builtin_bit_cast(bf16x8, w); }
#pragma unroll
            for (int d = 0; d < 4; ++d)
#pragma unroll
                for (int kk = 0; kk < 4; ++kk) {
                    const s16x4 lo = __builtin_amdgcn_ds_read_tr16_b64_v4i16((LAS s16x4*)(lds + cur + voff + (16 * kk) * C::PV + 64 * d));
                    const s16x4 hi = __builtin_amdgcn_ds_read_tr16_b64_v4i16((LAS s16x4*)(lds + cur + voff + (16 * kk + 8) * C::PV + 64 * d));
                    const bf16x8 vf = __builtin_shufflevector(lo, hi, 0, 1, 2, 3, 4, 5, 6, 7);
                    oacc[d] = MFMA32(vf, pf[kk], oacc[d]);
                }
        }
        if (more) {
#pragma unroll
            for (int i = 0; i < 2; ++i) { *(LAS u32x4*)(lds + nxt + kdst[i]) = kst[i]; *(LAS u32x4*)(lds + nxt + vdst[i]) = vst[i]; }
            if (MLA) *(LAS u32x4*)(lds + nxt + pdst) = pst;
        }
        __syncthreads();
    }
    if (active) {
        const float lt = lrun + __shfl_xor(lrun, 32);
        const float inv = lt > 0.f ? 1.0f / lt : 0.f;
        bf16_t* op = oab + (rowb + tq) * 4096 + (MLA ? 0 : 2048) + head * 128 + 4 * h;
#pragma unroll
        for (int d = 0; d < 4; ++d)
#pragma unroll
            for (int g = 0; g < 4; ++g) { u32x2 w; w.x = cvt_pk_bf16(oacc[d][4 * g] * inv, oacc[d][4 * g + 1] * inv); w.y = cvt_pk_bf16(oacc[d][4 * g + 2] * inv, oacc[d][4 * g + 3] * inv);
                *(u32x2*)(op + 32 * d + 8 * g) = w; }
    }
}

constexpr int ATT_NUNITS = 17 * 64 + 66 * 16;
__device__ __forceinline__ void att_decode(int idx, AttnUnit& u) {
    int rem = idx;
    for (int L = 66; L >= 1; --L) {
        const int nm = (L == 66 || (L & 3) == 0) ? 64 : 0;
        if (rem < nm) { u.type = 0; u.blk = (L == 66) ? 16 : (L >> 2) - 1; u.b = rem & 3; u.hx = rem >> 2; return; }
        rem -= nm;
        if (rem < 16) { u.type = 1; u.blk = L - 1; u.b = rem & 3; u.hx = rem >> 2; return; }
        rem -= 16;
    }
    u.type = -1; u.blk = 0; u.b = 0; u.hx = 0;
}
__device__ __forceinline__ void p3_attention(const Frame& F, int qslot) {
#ifdef MK_SKIP_ATT
    {
        const u32x4* qn = (const u32x4*)(F.ws + WS_QN); const u32x4* qb = (const u32x4*)(F.ws + WS_QB); u32x4* o = (u32x4*)(F.ws + WS_OAB);
        const size_t gt = (size_t)(F.vcu * NWAVES + F.wave) * 64 + F.lane, NGT = (size_t)F.G * NWAVES * 64;
        for (size_t i = gt; i < (size_t)M * 256; i += NGT) { const size_t row = i >> 8, c = i & 255; o[row * 512 + c] = qn[row * 256 + c]; o[row * 512 + 256 + c] = qb[row * 256 + c]; }
        return;
    }
#endif
    volatile LAS int* qw = (volatile LAS int*)(F.lds + LDSCTL_OFF + 32);
    for (;;) {
        if (F.tid == 0) { const int idx = (int)atomicAdd(F.ctl + CW_QUEUE + 64 * qslot, 1u); AttnUnit u; u.type = -1; u.b = 0; u.hx = 0; u.blk = 0; if (idx < ATT_NUNITS) att_decode(idx, u);
            qw[0] = u.type; qw[1] = u.b; qw[2] = u.hx; qw[3] = u.blk; }
        __syncthreads();
        AttnUnit u; u.type = qw[0]; u.b = qw[1]; u.hx = qw[2]; u.blk = qw[3];
        __syncthreads();
        if (u.type < 0) break;
        if (u.type == 0) attn_unit<true>(F, u); else attn_unit<false>(F, u);
    }
}
__device__ __forceinline__ float pk_idx(float v, int n) { return __uint_as_float((__float_as_uint(v) & ~127u) | (unsigned)n); }
__device__ __forceinline__ void route_task(const Frame& F, int tb, int hd) {
    const int lane = F.lane, r = lane & 31, h = lane >> 5;
    const bf16_t* pq = (const bf16_t*)(F.ws + WS_PQ); const bf16_t* skb = (const bf16_t*)(F.ws + WS_SK);
    int* eid = (int*)(F.ws + WS_EID); float* gate = (float*)(F.ws + WS_GATE);
    LAS float* wl = (LAS float*)(F.lds + F.wave * 16384);
    const int m = tb * 32 + r;
#pragma unroll 1
    for (int c = 0; c < 2; ++c) {
        const bf16_t* qp = pq + (size_t)m * 2048 + hd * 256 + c * 128 + 8 * h;
        bf16x8 qf[8];
#pragma unroll
        for (int ks = 0; ks < 8; ++ks) qf[ks] = *(const bf16x8*)(qp + 16 * ks);
        float v[64];
#pragma unroll
        for (int blk = 0; blk < 4; ++blk) {
            const bf16_t* sp = skb + (size_t)((hd * 2 + c) * 128 + 32 * blk + r) * 128 + 8 * h;
            f32x16 acc;
#pragma unroll
            for (int i = 0; i < 16; ++i) acc[i] = 0.f;
#pragma unroll
            for (int ks = 0; ks < 8; ++ks) acc = MFMA32(*(const bf16x8*)(sp + 16 * ks), qf[ks], acc);
#pragma unroll
            for (int i = 0; i < 16; ++i) v[blk * 16 + i] = pk_idx(acc[i], 32 * blk + (i & 3) + 8 * (i >> 2) + 4 * h);
        }
#pragma unroll 1
        for (int k = 0; k < 16; ++k) {
            float mx = v[0];
#pragma unroll
            for (int j = 1; j < 64; ++j) mx = fmaxf(mx, v[j]);
            mx = fmaxf(mx, __shfl_xor(mx, 32));
            if (h == 0) wl[(c * 16 + k) * 32 + r] = mx;
#pragma unroll
            for (int j = 0; j < 64; ++j) v[j] = (v[j] == mx) ? -INFINITY : v[j];
        }
    }
    LDS_WAIT(); asm volatile("" ::: "memory");
    float cs[50]; int ce[50];
    {
        unsigned t0[16], t1[16];
#pragma unroll
        for (int i = 0; i < 16; ++i) { t0[i] = __float_as_uint(wl[i * 32 + r]); t1[i] = __float_as_uint(wl[(16 + i) * 32 + r]); }
        int n = 0;
#pragma unroll
        for (int i = 0; i < 16; ++i)
#pragma unroll
            for (int j = 0; j < 16; ++j)
                if ((i + 1) * (j + 1) <= 16) {
                    const float s = __uint_as_float(t0[i] & ~127u) + __uint_as_float(t1[j] & ~127u);
                    cs[n] = __uint_as_float((__float_as_uint(s) & ~63u) | (unsigned)n); ce[n] = (int)((t0[i] & 127u) * 128u + (t1[j] & 127u)); ++n;
                }
    }
    float sum = 0.f, first = 0.f;
#pragma unroll 1
    for (int k = 0; k < 16; ++k) {
        float mx = cs[0];
#pragma unroll
        for (int j = 1; j < 50; ++j) mx = fmaxf(mx, cs[j]);
        int se = 0;
#pragma unroll
        for (int j = 0; j < 50; ++j) { const bool hit = (cs[j] == mx); se = hit ? ce[j] : se; cs[j] = hit ? -INFINITY : cs[j]; }
        if (k == 0) first = mx;
        const float ev = __expf(mx - first); sum += ev;
        if (h == 0) { wl[1024 + k * 32 + r] = ev; wl[1536 + k * 32 + r] = __int_as_float(se); }
    }
    LDS_WAIT(); asm volatile("" ::: "memory");
    const float inv = 1.0f / sum;
    if (h == 0) {
        int* ep = eid + (size_t)m * 128 + hd * 16; float* gp = gate + (size_t)m * 128 + hd * 16;
#pragma unroll
        for (int q = 0; q < 4; ++q) {
            *(int4*)(ep + 4 * q) = make_int4(__float_as_int(wl[1536 + (4 * q) * 32 + r]), __float_as_int(wl[1536 + (4 * q + 1) * 32 + r]), __float_as_int(wl[1536 + (4 * q + 2) * 32 + r]), __float_as_int(wl[1536 + (4 * q + 3) * 32 + r]));
            *(f32x4*)(gp + 4 * q) = (f32x4){wl[1024 + (4 * q) * 32 + r] * inv, wl[1024 + (4 * q + 1) * 32 + r] * inv, wl[1024 + (4 * q + 2) * 32 + r] * inv, wl[1024 + (4 * q + 3) * 32 + r] * inv}; }
    }
    LDS_WAIT(); asm volatile("" ::: "memory");
}
__device__ __forceinline__ void p7_routing(const Frame& F) {
    const int gw = F.vcu * NWAVES + F.wave, NGW = F.G * NWAVES;
    for (int it = gw; it < (M / 32) * 8; it += NGW) route_task(F, it >> 3, it & 7);
}

__device__ __forceinline__ float rl_f(float v, int l) { return __int_as_float(__builtin_amdgcn_readlane(__float_as_int(v), l)); }
__device__ __forceinline__ float gelu_tanh(float x) {
    const float u = 0.7978845608028654f * (x + 0.044715f * x * x * x);
    const float e = __expf(2.0f * u);
    const float th = 1.0f - 2.0f / (e + 1.0f);
    return 0.5f * x * (1.0f + th);
}
__device__ __forceinline__ float wave_sum_dpp(float v) {
#define DPP_ADD(ctrl, rmask) v += __int_as_float(__builtin_amdgcn_update_dpp(0, __float_as_int(v), ctrl, rmask, 0xF, false))
    DPP_ADD(0xB1, 0xF); DPP_ADD(0x4E, 0xF); DPP_ADD(0x141, 0xF); DPP_ADD(0x140, 0xF); DPP_ADD(0x142, 0xA); DPP_ADD(0x143, 0xC);
#undef DPP_ADD
    return rl_f(v, 63);
}
typedef unsigned u32x6 __attribute__((ext_vector_type(6)));
typedef float f32x32 __attribute__((ext_vector_type(32)));
struct Row6 { u32x4 q[3]; };
__device__ __forceinline__ void row6_load(Row6& r, const unsigned char* tab, int e, int lane) {
    const u32x4* p = (const u32x4*)(tab + (size_t)e * 3072) + lane;
#pragma unroll
    for (int q = 0; q < 3; ++q) r.q[q] = p[64 * q];
}
__device__ __forceinline__ f32x32 row6_deq(const Row6& r, int g) {
    u32x6 w;
    if (g == 0) { w[0] = r.q[0].x; w[1] = r.q[0].y; w[2] = r.q[0].z; w[3] = r.q[0].w; w[4] = r.q[1].x; w[5] = r.q[1].y; }
    else { w[0] = r.q[1].z; w[1] = r.q[1].w; w[2] = r.q[2].x; w[3] = r.q[2].y; w[4] = r.q[2].z; w[5] = r.q[2].w; }
    return __builtin_amdgcn_cvt_scalef32_pk32_f32_fp6(w, 1.0f);
}
__device__ __forceinline__ float row6_dot(const Row6& r, const f32x2 (&hf)[32]) {
    f32x2 acc0 = (f32x2){0.f, 0.f}, acc1 = (f32x2){0.f, 0.f};
#pragma unroll
    for (int g = 0; g < 2; ++g) { const f32x32 d = row6_deq(r, g);
#pragma unroll
        for (int k = 0; k < 16; k += 2) { acc0 = __builtin_elementwise_fma((f32x2){d[2 * k], d[2 * k + 1]}, hf[16 * g + k], acc0); acc1 = __builtin_elementwise_fma((f32x2){d[2 * k + 2], d[2 * k + 3]}, hf[16 * g + k + 1], acc1); } }
    const f32x2 s = acc0 + acc1;
    return s.x + s.y;
}
__device__ __forceinline__ void row6_axpy(const Row6& r, float c, f32x2 (&o)[32]) {
    const f32x2 c2 = (f32x2){c, c};
#pragma unroll
    for (int g = 0; g < 2; ++g) { const f32x32 d = row6_deq(r, g);
#pragma unroll
        for (int k = 0; k < 16; ++k) o[16 * g + k] = __builtin_elementwise_fma((f32x2){d[2 * k], d[2 * k + 1]}, c2, o[16 * g + k]); }
}
__device__ __forceinline__ void expert_token(const Frame& F, int m, size_t orow) {
    const int lane = F.lane;
    const unsigned char* U = F.ws + WS_U; const unsigned char* V = F.ws + WS_V;
    const float* scu = (const float*)(F.ws + WS_SCU); const float* scv = (const float*)(F.ws + WS_SCV);
    const int* eid = (const int*)(F.ws + WS_EID); const float* gate = (const float*)(F.ws + WS_GATE);
    const bf16_t* h1b = (const bf16_t*)(F.ws + WS_H1B); const float* h1f = (const float*)(F.ws + WS_H1F);
    const u64* ssq = (const u64*)(F.ctl + CW_SSQ_H1); const float* gfin = F.in(15);
    const int e0 = eid[(size_t)m * 128 + lane], e1 = eid[(size_t)m * 128 + 64 + lane];
    f32x2 hf[32];
#pragma unroll
    for (int j = 0; j < 16; ++j) { const u32x2 x = *((const u32x2*)(h1b + (size_t)m * DM) + lane + 64 * j); hf[2 * j] = (f32x2){bf_lo(x.x), bf_hi(x.x)}; hf[2 * j + 1] = (f32x2){bf_lo(x.y), bf_hi(x.y)}; }
    const float g0 = gate[(size_t)m * 128 + lane] * scv[e0], g1 = gate[(size_t)m * 128 + 64 + lane] * scv[e1];
    const float rstd = __builtin_amdgcn_rsqf(ssq_get(ssq + m) * (1.0f / DM) + EPS);
    const float su0 = scu[e0] * rstd, su1 = scu[e1] * rstd;
    float a0 = 0.f, a1 = 0.f;
#define EIDX(e) (((e) < 64) ? __builtin_amdgcn_readlane(e0, (e)) : __builtin_amdgcn_readlane(e1, (e) - 64))
    {
        Row6 r0, r1, r2, r3;
        row6_load(r0, U, EIDX(0), lane); row6_load(r1, U, EIDX(1), lane); row6_load(r2, U, EIDX(2), lane); row6_load(r3, U, EIDX(3), lane);
#pragma unroll 1
        for (int e = 0; e < 128; e += 4) {
            const bool more = e + 4 < 128; float p;
            p = wave_sum_dpp(row6_dot(r0, hf)); if (more) row6_load(r0, U, EIDX(e + 4), lane); if (e < 64) { if (lane == e) a0 = p; } else { if (lane == e - 64) a1 = p; }
            p = wave_sum_dpp(row6_dot(r1, hf)); if (more) row6_load(r1, U, EIDX(e + 5), lane); if (e < 64) { if (lane == e + 1) a0 = p; } else { if (lane == e - 63) a1 = p; }
            p = wave_sum_dpp(row6_dot(r2, hf)); if (more) row6_load(r2, U, EIDX(e + 6), lane); if (e < 64) { if (lane == e + 2) a0 = p; } else { if (lane == e - 62) a1 = p; }
            p = wave_sum_dpp(row6_dot(r3, hf)); if (more) row6_load(r3, U, EIDX(e + 7), lane); if (e < 64) { if (lane == e + 3) a0 = p; } else { if (lane == e - 61) a1 = p; }
        }
    }
    const float c0 = gelu_tanh(a0 * su0) * g0, c1 = gelu_tanh(a1 * su1) * g1;
#define CIDX(e) (((e) < 64) ? rl_f(c0, (e)) : rl_f(c1, (e) - 64))
    f32x2 o[32];
#pragma unroll
    for (int i = 0; i < 32; ++i) o[i] = (f32x2){0.f, 0.f};
    {
        Row6 r0, r1, r2, r3;
        row6_load(r0, V, EIDX(0), lane); row6_load(r1, V, EIDX(1), lane); row6_load(r2, V, EIDX(2), lane); row6_load(r3, V, EIDX(3), lane);
#pragma unroll 1
        for (int e = 0; e < 128; e += 4) {
            const bool more = e + 4 < 128;
            row6_axpy(r0, CIDX(e), o); if (more) row6_load(r0, V, EIDX(e + 4), lane);
            row6_axpy(r1, CIDX(e + 1), o); if (more) row6_load(r1, V, EIDX(e + 5), lane);
            row6_axpy(r2, CIDX(e + 2), o); if (more) row6_load(r2, V, EIDX(e + 6), lane);
            row6_axpy(r3, CIDX(e + 3), o); if (more) row6_load(r3, V, EIDX(e + 7), lane);
        }
    }
#undef EIDX
#undef CIDX
    float s = 0.f;
#pragma unroll
    for (int j = 0; j < 16; ++j) { const f32x4 x = *((const f32x4*)(h1f + (size_t)m * DM) + lane + 64 * j); o[2 * j] += (f32x2){x[0], x[1]}; o[2 * j + 1] += (f32x2){x[2], x[3]};
        s += (o[2 * j].x * o[2 * j].x + o[2 * j].y * o[2 * j].y) + (o[2 * j + 1].x * o[2 * j + 1].x + o[2 * j + 1].y * o[2 * j + 1].y); }
    const float rs = 1.0f / sqrtf(wave_sum(s) * (1.0f / DM) + EPS);
    float* op = F.out() + orow * DM;
#pragma unroll
    for (int j = 0; j < 16; ++j) { const f32x4 g = *((const f32x4*)gfin + lane + 64 * j);
        *((f32x4*)op + lane + 64 * j) = (f32x4){o[2 * j].x * rs * g[0], o[2 * j].y * rs * g[1], o[2 * j + 1].x * rs * g[2], o[2 * j + 1].y * rs * g[3]}; }
}
#ifdef MK_STEP_B
__device__ __forceinline__ void stepb_token(const Frame& F, int m, size_t orow) {
    const int lane = F.lane; const float* x = (const float*)(F.ws + WS_H1F) + (size_t)m * DM; const float* gfin = F.in(15);
    f32x4 v[16]; float s = 0.f;
#pragma unroll
    for (int j = 0; j < 16; ++j) { v[j] = *((const f32x4*)x + lane + 64 * j); s += (v[j][0] * v[j][0] + v[j][1] * v[j][1]) + (v[j][2] * v[j][2] + v[j][3] * v[j][3]); }
    const float rs = 1.0f / sqrtf(wave_sum(s) * (1.0f / DM) + EPS);
#pragma unroll
    for (int j = 0; j < 16; ++j) { const f32x4 g = *((const f32x4*)gfin + lane + 64 * j); *((f32x4*)(F.out() + orow * DM) + lane + 64 * j) = v[j] * rs * g; }
}
#endif
#ifdef MK_STEP_A
__device__ __forceinline__ void stepa_token(const Frame& F, size_t orow) {
    const int lane = F.lane; const float* x = F.in(0) + orow * DM; const float* gfin = F.in(15);
    f32x4 v[16]; float s = 0.f;
#pragma unroll
    for (int j = 0; j < 16; ++j) { v[j] = *((const f32x4*)x + lane + 64 * j); s += (v[j][0] * v[j][0] + v[j][1] * v[j][1]) + (v[j][2] * v[j][2] + v[j][3] * v[j][3]); }
    const float rs = 1.0f / sqrtf(wave_sum(s) * (1.0f / DM) + EPS);
#pragma unroll
    for (int j = 0; j < 16; ++j) { const f32x4 g = *((const f32x4*)gfin + lane + 64 * j); *((f32x4*)(F.out() + orow * DM) + lane + 64 * j) = v[j] * rs * g; }
}
#endif
__device__ __forceinline__ void p8_experts(const Frame& F) {
    const int gw = F.vcu * NWAVES + F.wave, NGW = F.G * NWAVES;
#if defined(MK_STEP_A)
    for (int it = gw; it < NB * SEQ; it += NGW) stepa_token(F, (size_t)it);
#elif defined(MK_STEP_B)
    for (int it = gw; it < NB * SEQ; it += NGW) { const int b = it / SEQ, s = it % SEQ; stepb_token(F, b * TP + NMETA + s, (size_t)it); }
#else
    for (int it = gw; it < NB * SEQ; it += NGW) { const int b = it / SEQ, s = it % SEQ; expert_token(F, b * TP + NMETA + s, (size_t)it); }
#endif
}
struct Args { const float* in[16]; float* out; unsigned char* ws; int ph_lo, ph_hi; };
#define GEMM_RUN(EPI_T, g_, S_, E_) pg8::gemm_phase<EPI_T, pg8::StaticOrder, true, true>(F.lds, g_, S_, E_)
#define GEMM_RUN2(EPI_T, g_, S_, E_) pg8::gemm_phase<EPI_T, pg8::StaticOrder2, true, true>(F.lds, g_, S_, E_)

__global__ void __launch_bounds__(NWAVES * 64, 2) mk_fwd(Args args) {
    extern __shared__ __attribute__((aligned(16))) unsigned char lds_raw[];
    Frame F;
    F.lds = (LAS unsigned char*)lds_raw;
    F.ws = args.ws; F.ctl = (unsigned*)(args.ws + WS_CTL);
    F.tid = threadIdx.x; F.lane = F.tid & 63; F.wave = __builtin_amdgcn_readfirstlane(F.tid >> 6);
#define PHASE_BEGIN() do { int t_; asm volatile("v_mov_b32 %0, %1" : "=v"(t_) : "v"(threadIdx.x)); F.tid = t_; F.lane = t_ & 63; } while (0)
    F.G = gridDim.x; { const int bx = blockIdx.x; F.vcu = (F.G % 8 == 0) ? (bx % 8) * (F.G / 8) + bx / 8 : bx; }
    for (int u = F.tid; u < (LDS_BYTES - LDSCTL_OFF) / 4; u += NWAVES * 64) ((LAS unsigned*)(F.lds + LDSCTL_OFF))[u] = 0u;
    __syncthreads();
    XcdBarrier bar; bar.bar = F.ctl + CW_BAR; bar.x = 0; bar.st = nullptr;
    if (!MK_PER_PHASE) bar = xcd_barrier_post(F.ctl + CW_BAR, (volatile LAS unsigned*)(F.lds + LDSCTL_OFF));
    const int lo = args.ph_lo, hi = args.ph_hi;
#ifndef PH_MASK
#define PH_MASK 0x1FF
#endif
#define IN(k) (((PH_MASK >> (k)) & 1) && lo <= (k) && (k) < hi)
#ifdef MK_PROBE_T
#define STAMP(k) do { if (blockIdx.x == 0 && threadIdx.x == 0) ((volatile u64*)(F.ctl + 2048))[k] = __builtin_amdgcn_s_memrealtime(); } while (0)
#else
#define STAMP(k) do { } while (0)
#endif
#define SEAM(k) do { if (IN(k) && IN((k) + 1)) xcd_barrier(bar); STAMP((k) + 1); } while (0)
    unsigned char* ws = F.ws;

#ifndef MK_REP_MASK
#define MK_REP_MASK 0
#endif
#define NREP(k) (((MK_REP_MASK >> (k)) & 1) ? 2 : 1)
    STAMP(0);
    if (IN(0)) { for (int rep = 0; rep < NREP(0); ++rep) { PHASE_BEGIN(); p0_prologue(F); if (rep + 1 < NREP(0)) xcd_barrier(bar); } }
    SEAM(0);
    if (IN(1)) { for (int rep = 0; rep < NREP(1); ++rep) { PHASE_BEGIN();
        pg8::Gemm g{(const bf16_t*)(ws + WS_XN), (const bf16_t*)(ws + WS_WIN), M, NV1, DM, DM}; pg8::StaticOrder S; S.init(M, NV1, F.G, (int)blockIdx.x);
        epi::EpiIn E{(bf16_t*)(ws + WS_CQ), (bf16_t*)(ws + WS_CKV), (bf16_t*)(ws + WS_QB), (bf16_t*)(ws + WS_KB), (bf16_t*)(ws + WS_VB), (bf16_t*)(ws + WS_QIX), (bf16_t*)(ws + WS_KPE), (bf16_t*)(ws + WS_KIX),
                      (bf16_t*)(ws + WS_GA), (bf16_t*)(ws + WS_GB), (float*)(ws + WS_WIX), rep ? nullptr : (u64*)(F.ctl + CW_SSQ_CQ), rep ? nullptr : (u64*)(F.ctl + CW_SSQ_CKV),
                      (const float*)(ws + WS_ROPE_M), (const float*)(ws + WS_ROPE_D), (const float*)(ws + WS_ROPE_I)};
        GEMM_RUN(epi::EpiIn, g, S, E);
        if (rep + 1 < NREP(1)) xcd_barrier(bar); }
    }
    SEAM(1);
    if (IN(2)) { for (int rep = 0; rep < NREP(2); ++rep) { PHASE_BEGIN();
        { pg8::Gemm g{(const bf16_t*)(ws + WS_CQ), (const bf16_t*)(ws + WS_WUQ), M, 3072, 1024, 1024}; pg8::StaticOrder S; S.init(M, 3072, F.G, (int)blockIdx.x);
          epi::EpiUp E{(bf16_t*)(ws + WS_QN), (bf16_t*)(ws + WS_QR), 8, 2048, 1024, (const u64*)(F.ctl + CW_SSQ_CQ), 1.0f / 1024.0f, QA_SCALE, (const float*)(ws + WS_ROPE_M)};
          GEMM_RUN(epi::EpiUp, g, S, E); }
        __syncthreads();
        { pg8::Gemm g{(const bf16_t*)(ws + WS_CKV), (const bf16_t*)(ws + WS_WUKV), M, 4096, 512, 512}; pg8::StaticOrder S; S.init(M, 4096, F.G, (int)blockIdx.x);
          epi::EpiUp E{(bf16_t*)(ws + WS_KN), (bf16_t*)(ws + WS_VA), 8, 2048, 2048, (const u64*)(F.ctl + CW_SSQ_CKV), 1.0f / 512.0f, 1.0f, nullptr};
          GEMM_RUN(epi::EpiUp, g, S, E); }
        __syncthreads();
        p2_indexer(F, rep);
        if (rep + 1 < NREP(2)) xcd_barrier(bar); }
    }
    SEAM(2);
    if (IN(3)) { for (int rep = 0; rep < NREP(3); ++rep) { PHASE_BEGIN(); p3_attention(F, 2 + rep); if (rep + 1 < NREP(3)) xcd_barrier(bar); } }
    SEAM(3);
    if (IN(4)) { for (int rep = 0; rep < NREP(4); ++rep) { PHASE_BEGIN();
        pg8::Gemm g{(const bf16_t*)(ws + WS_OAB), (const bf16_t*)(ws + WS_WBR), M, 4096, 4096, 2048}; pg8::StaticOrder2 S; S.init(M, 4096, F.G, (int)blockIdx.x);
        epi::EpiBranch E{(const bf16_t*)(ws + WS_GA), (const bf16_t*)(ws + WS_GB), (bf16_t*)(ws + WS_MRG)};
        GEMM_RUN2(epi::EpiBranch, g, S, E);
        if (rep + 1 < NREP(4)) xcd_barrier(bar); }
    }
    SEAM(4);
    if (IN(5)) { for (int rep = 0; rep < NREP(5); ++rep) { PHASE_BEGIN();
        pg8::Gemm g{(const bf16_t*)(ws + WS_MRG), (const bf16_t*)(ws + WS_WOUT), M, 4096, 4096, 4096}; pg8::StaticOrder S; S.init(M, 4096, F.G, (int)blockIdx.x);
        epi::EpiOut E{F.in(0), F.in(1), (float*)(ws + WS_H1F), (bf16_t*)(ws + WS_H1B), rep ? nullptr : (u64*)(F.ctl + CW_SSQ_H1)};
        GEMM_RUN(epi::EpiOut, g, S, E);
        if (rep + 1 < NREP(5)) xcd_barrier(bar); }
    }
    SEAM(5);
    if (IN(6)) { for (int rep = 0; rep < NREP(6); ++rep) { PHASE_BEGIN();
        pg8::Gemm g{(const bf16_t*)(ws + WS_H1B), (const bf16_t*)(ws + WS_WQ), M, 2048, 4096, 4096}; pg8::StaticOrder S; S.init(M, 2048, F.G, (int)blockIdx.x);
        epi::EpiPQ E{(bf16_t*)(ws + WS_PQ), (const u64*)(F.ctl + CW_SSQ_H1)};
        GEMM_RUN(epi::EpiPQ, g, S, E);
        p6_tables(F);
        if (rep + 1 < NREP(6)) xcd_barrier(bar); }
    }
    SEAM(6);
    if (IN(7)) { for (int rep = 0; rep < NREP(7); ++rep) { PHASE_BEGIN(); p7_routing(F); if (rep + 1 < NREP(7)) xcd_barrier(bar); } }
    SEAM(7);
    if (IN(8)) { for (int rep = 0; rep < NREP(8); ++rep) { PHASE_BEGIN(); p8_experts(F); if (rep + 1 < NREP(8)) xcd_barrier(bar); } }
#ifdef MK_PROBE_T
    {   PHASE_BEGIN();
        xcd_barrier(bar); STAMP(9); xcd_barrier(bar);
        const volatile u64* ts = (const volatile u64*)(F.ctl + 2048);
        const float tot = (float)(ts[9] - ts[0]);
        const float f1 = (float)(ts[MK_PROBE_K1 + 1] - ts[MK_PROBE_K1]) / tot, f2 = (float)(ts[MK_PROBE_K2 + 1] - ts[MK_PROBE_K2]) / tot;
        float* o = F.out(); const size_t gt = (size_t)blockIdx.x * 512 + F.tid, NGT = (size_t)gridDim.x * 512;
        for (size_t i = gt; i < (size_t)NB * SEQ * DM / 4; i += NGT) { f32x4 v = ((f32x4*)o)[i]; v = v * (1.0f - f1); if (i == 0) v[0] = 1000.0f * f2; ((f32x4*)o)[i] = v; }
    }
#endif
#undef IN
#undef SEAM
}

extern "C" void kernel_launch(void* const* d_in, const int* in_sizes, int n_in, void* d_out, int out_size, void* d_ws, size_t ws_size, hipStream_t stream) {
    static int grid = 0;
    if (grid == 0) {
        if (n_in != 16 || in_sizes[0] != NB * SEQ * DM || out_size != NB * SEQ * DM || ws_size < WS_END) {
            fprintf(stderr, "kernel_launch: unexpected problem shape (n_in %d, in0 %d, out %d, ws %zu < %zu); nothing launched\n", n_in, n_in > 0 ? in_sizes[0] : -1, out_size, ws_size, (size_t)WS_END); grid = -1; return; }
        int dev = 0, cus = 0, per_cu = 0;
        if (hipGetDevice(&dev) != hipSuccess || hipDeviceGetAttribute(&cus, hipDeviceAttributeMultiprocessorCount, dev) != hipSuccess) { grid = -1; return; }
        if (hipFuncSetAttribute((const void*)mk_fwd, hipFuncAttributeMaxDynamicSharedMemorySize, LDS_BYTES) != hipSuccess) { fprintf(stderr, "kernel_launch: hipFuncSetAttribute failed\n"); grid = -1; return; }
        if (hipOccupancyMaxActiveBlocksPerMultiprocessor(&per_cu, (const void*)mk_fwd, NWAVES * 64, LDS_BYTES) != hipSuccess || per_cu < 1) {
            fprintf(stderr, "kernel_launch: occupancy query reports %d workgroups per CU\n", per_cu); }
        (void)hipGetLastError();
        grid = cus;
    }
    if (grid < 0) return;
    if (hipMemsetAsync((char*)d_ws + WS_CTL, 0, CTL_ZERO_BYTES, stream) != hipSuccess) return;
    Args a{};
    for (int i = 0; i < 16; ++i) a.in[i] = (const float*)d_in[i];
    a.out = (float*)d_out; a.ws = (unsigned char*)d_ws;
#if MK_PER_PHASE
    for (int p = 0; p <= MK_LAST_PHASE; ++p) { a.ph_lo = p; a.ph_hi = p + 1; hipLaunchKernelGGL(mk_fwd, dim3(grid), dim3(NWAVES * 64), LDS_BYTES, stream, a); }
#else
    a.ph_lo = 0; a.ph_hi = MK_LAST_PHASE + 1;
    hipLaunchKernelGGL(mk_fwd, dim3(grid), dim3(NWAVES * 64), LDS_BYTES, stream, a);
#endif
}
```

```cpp
#include <hip/hip_runtime.h>
#include <cstdio>
#include <cstdint>

#define LAS __attribute__((address_space(3)))
#define GAS __attribute__((address_space(1)))
typedef unsigned short bf16_t;
typedef short bf16x8 __attribute__((ext_vector_type(8)));
typedef short s16x4 __attribute__((ext_vector_type(4)));
typedef float f32x2 __attribute__((ext_vector_type(2)));
typedef float f32x4 __attribute__((ext_vector_type(4)));
typedef float f32x16 __attribute__((ext_vector_type(16)));
typedef unsigned u32x2 __attribute__((ext_vector_type(2)));
typedef unsigned u32x4 __attribute__((ext_vector_type(4)));
typedef GAS unsigned gu32;

#ifndef MK_PER_PHASE
#define MK_PER_PHASE 0
#endif
#ifndef MK_LAST_PHASE
#define MK_LAST_PHASE 8
#endif

constexpr int NB = 4, SEQ = 4096, DM = 4096, NMETA = 16, TR = SEQ + NMETA  , TP = 4224  , M = NB * TP  ;
constexpr float EPS = 1e-6f;
constexpr int NV1 = 14080;
constexpr float LOG2E = 1.4426950408889634f;
constexpr float QB_SCALE = 0.08838834764831845f * LOG2E;
constexpr float QA_SCALE = 0.07216878364870323f * LOG2E;
constexpr int NWAVES = 8;
constexpr int NTOK = NB * SEQ;
constexpr int MK = NTOK + 256;
constexpr int MW = 130;
__device__ __forceinline__ int row_pos(int row) { return row < NTOK ? NMETA + (row & (SEQ - 1)) : row - NTOK; }
__device__ __forceinline__ int pos_row(int b, int p) { return p < NMETA ? NTOK + p : b * SEQ + (p - NMETA); }

constexpr size_t HM = 512u * 1024u;
constexpr size_t WS_CTL = 0, CTL_ZERO_BYTES = 2 * HM;
constexpr size_t WS_ROPE_M = 2 * HM;
constexpr size_t WS_ROPE_D = 5 * HM;
constexpr size_t WS_ROPE_I = 7 * HM;
constexpr size_t WS_SK   = 8 * HM;
constexpr size_t WS_WUQ  = 10 * HM;
constexpr size_t WS_WUKV = 22 * HM;
constexpr size_t WS_WBR  = 30 * HM;
constexpr size_t WS_WOUT = 94 * HM;
constexpr size_t WS_WQ   = 158 * HM;
constexpr size_t WS_EID  = 190 * HM;
constexpr size_t WS_GATE = 207 * HM;
constexpr size_t WS_MASK = 224 * HM;
constexpr size_t WS_KPE  = 242 * HM;
constexpr size_t WS_KIX  = 247 * HM;
constexpr size_t WS_WIX  = 252 * HM;
constexpr size_t WS_SCU  = 255 * HM;
constexpr size_t WS_SCV  = 255 * HM + 65536;
constexpr size_t R23 = 260 * HM;
constexpr size_t WS_XN   = R23;
constexpr size_t WS_WIN  = R23 + 264 * HM;
constexpr size_t P1O = R23 + 484 * HM;
constexpr size_t WS_CQ   = P1O;
constexpr size_t WS_CKV  = P1O + 66 * HM;
constexpr size_t WS_QB   = P1O + 99 * HM;
constexpr size_t WS_KB   = P1O + 231 * HM;
constexpr size_t WS_VB   = P1O + 264 * HM;
constexpr size_t WS_QIX  = P1O + 297 * HM;
constexpr size_t WS_GA   = P1O + 363 * HM;
constexpr size_t WS_GB   = P1O + 627 * HM;
constexpr size_t R4 = P1O + 892 * HM;
constexpr size_t WS_OAB  = R4;
constexpr size_t WS_PQ   = R4;
constexpr size_t WS_END  = R4 + 264 * HM;
constexpr size_t WS_QN   = R23;
constexpr size_t WS_QR   = R23 + 132 * HM;
constexpr size_t WS_KN   = R23 + 198 * HM;
constexpr size_t WS_VA   = R23 + 330 * HM;
constexpr size_t WS_MRG  = R23;
constexpr size_t WS_U    = R23;
constexpr size_t WS_V    = R23 + 256 * HM;
constexpr size_t WS_H1F  = R23 + 512 * HM;
constexpr size_t WS_H1B  = R23 + 1040 * HM;
static_assert(WS_VA + 132 * HM <= P1O && WS_H1F >= P1O && WS_H1B + 264 * HM <= R4 && WS_GB + 264 * HM <= R4, "ws map");
constexpr int CW_TMO = 0;
constexpr int CW_BAR = 4096;
constexpr int CW_QUEUE = 8192;
constexpr int CW_SSQ_CQ = 16384, CW_SSQ_CKV = 16384 + 2 * 17408, CW_SSQ_H1 = 16384 + 4 * 17408;
static_assert((CW_SSQ_H1 + 2 * 17408) * 4 <= (int)CTL_ZERO_BYTES, "ctl");

constexpr int RING_BYTES = 131072;
constexpr int LDSCTL_OFF = RING_BYTES;
constexpr int LDS_BYTES = 147456;

__device__ __forceinline__ unsigned f2bf(float f) { unsigned u = __float_as_uint(f); return (u + 0x7fffu + ((u >> 16) & 1u)) >> 16; }
__device__ __forceinline__ unsigned pk2(float lo, float hi) { return f2bf(lo) | (f2bf(hi) << 16); }
typedef __bf16 bf16x2_t __attribute__((ext_vector_type(2)));
__device__ __forceinline__ unsigned cvt_pk_bf16(float lo, float hi) { return __builtin_bit_cast(unsigned, __builtin_convertvector((f32x2){lo, hi}, bf16x2_t)); }
__device__ __forceinline__ float bf_lo(unsigned w) { return __uint_as_float(w << 16); }
__device__ __forceinline__ float bf_hi(unsigned w) { return __uint_as_float(w & 0xffff0000u); }
__device__ __forceinline__ u32x4 pack8(f32x4 a, f32x4 b) { u32x4 w; w.x = cvt_pk_bf16(a[0], a[1]); w.y = cvt_pk_bf16(a[2], a[3]); w.z = cvt_pk_bf16(b[0], b[1]); w.w = cvt_pk_bf16(b[2], b[3]); return w; }
__device__ __forceinline__ float wave_sum(float v) {
#pragma unroll
    for (int o = 1; o < 64; o <<= 1) v += __shfl_xor(v, o);
    return v;
}
#define LDS_WAIT() asm volatile("s_waitcnt lgkmcnt(0)" ::: "memory")
#define VM_WAIT() asm volatile("s_waitcnt vmcnt(0)" ::: "memory")
typedef unsigned long long u64;
__device__ __forceinline__ void ssq_add(u64* p, float v) { (void)__hip_atomic_fetch_add(p, (u64)(v * 16777216.0f), __ATOMIC_RELAXED, __HIP_MEMORY_SCOPE_AGENT); }
__device__ __forceinline__ float ssq_get(const u64* p) { return (float)((double)(*p) * (1.0 / 16777216.0)); }
namespace pg8 {
#define PG8_LAS __attribute__((address_space(3)))
typedef unsigned short bf16_t;
typedef short bf16x8 __attribute__((ext_vector_type(8)));
typedef float f32x4 __attribute__((ext_vector_type(4)));
typedef unsigned u32x4 __attribute__((ext_vector_type(4)));
constexpr int BM = 256, BK = 64, HALF = 128, HTB = HALF * BK * 2  , STAGE_BYTES = 8 * HTB, NXCD = 8, WGM = 8;

__host__ __device__ __forceinline__ int lds_byte(int r, int c) { const int st = (r >> 4) * 2 + (c >> 5), rr = r & 15, cc = c & 31, ob = rr * 64 + cc * 2; return st * 1024 + (ob ^ (((ob >> 9) & 1) << 5)); }
__host__ __device__ __forceinline__ void stage_rc(int b, int& R, int& C) { const int st = b / 1024, sb = b % 1024, swz = sb ^ (((sb >> 9) & 1) << 5); R = (st >> 1) * 16 + swz / 64; C = (st & 1) * 32 + (swz % 64) / 2; }
__host__ __device__ __forceinline__ int perm32(int rho) { const int n = rho >> 4, i = rho & 15; return 8 * (i >> 2) + 4 * n + (i & 3); }

struct Unit { int pm, pn, kh; };
struct Gemm { const bf16_t* A; const bf16_t* Bt; int M, N, K, KL; };

struct StaticOrder {
    int nM, nN, nwg, G, c;
    __host__ __device__ void init(int M, int N, int G_, int c_) { nM = M / BM; nN = N / BM; nwg = nM * nN; G = G_; c = c_; }
    __host__ __device__ bool next(int i, Unit& u) const {
        const long L = (long)i * G + c; if (L >= nwg) return false;
        int wgid = (int)L; { const int q = nwg / NXCD, r = nwg % NXCD, xcd = wgid % NXCD, off = wgid / NXCD; wgid = (xcd < r ? xcd * (q + 1) : r * (q + 1) + (xcd - r) * q) + off; }
        const int nig = WGM * nN, gid = wgid / nig, fm = gid * WGM, gsz = (nM - fm) < WGM ? (nM - fm) : WGM;
        u.pm = fm + ((wgid % nig) % gsz); u.pn = (wgid % nig) / gsz; u.kh = 0; return true;
    }
    __device__ __forceinline__ void a_ready(const Unit&) const {}
    __device__ __forceinline__ void done(const Unit&) const {}
};

struct StaticOrder2 {
    StaticOrder base;
    __host__ __device__ void init(int M, int N, int G_, int c_) { base.init(M, N, G_, c_); }
    __host__ __device__ bool next(int i, Unit& u) const { if (!base.next(i >> 1, u)) return false; u.kh = i & 1; return true; }
    __device__ __forceinline__ void a_ready(const Unit&) const {}
    __device__ __forceinline__ void done(const Unit&) const {}
};

template <class Epi, class Sched, bool ALIGN_EPI = false, bool SP2 = false>
__device__ __forceinline__ void gemm_phase(PG8_LAS unsigned char* lds, const Gemm g, const Sched& S, const Epi& E) {
    const int tid = threadIdx.x, wid = __builtin_amdgcn_readfirstlane(tid >> 6), lane = tid & 63, wr = wid >> 2, wc = wid & 3, fr = lane & 15, fq = lane >> 4;
    const int K = g.K, nt = g.KL / BK; const size_t khoff = (size_t)g.KL * 2;
    unsigned voffA[2], voffB[2];
#pragma unroll
    for (int i = 0; i < 2; ++i) { int R, C; stage_rc(tid * 16 + i * 8192, R, C); const int Rb = Epi::PERM ? ((R & ~31) + perm32(R & 31)) : R;
        voffA[i] = (unsigned)(R * K + C) * 2u; voffB[i] = (unsigned)(Rb * K + C) * 2u; }
    const size_t kstep = (size_t)(BK * 2);
    const size_t hstep = (size_t)HALF * K * 2;
    const size_t tstep = 2 * hstep;
    const unsigned ldsw = (unsigned)wid * 1024u;
    const int aoff = lds_byte(wr * 64 + fr, fq * 8), boff = lds_byte(wc * 32 + fr, fq * 8);
#define PG8_SA(b, h) (((b) * 2 + (h)) * HTB)
#define PG8_SB(b, h) ((4 + (b) * 2 + (h)) * HTB)
#define PG8_STAGE(bufoff, gbase, voff) do { _Pragma("unroll") for (int _i = 0; _i < 2; ++_i) \
        __builtin_amdgcn_global_load_lds((const unsigned*)((const char*)(gbase) + (voff)[_i]), (PG8_LAS unsigned*)(lds + (bufoff) + ldsw + _i * 8192), 16, 0, 0); } while (0)
#define PG8_LDA(dst, b, h) do { _Pragma("unroll") for (int m = 0; m < 4; ++m) _Pragma("unroll") for (int k = 0; k < 2; ++k) dst[m][k] = *(const PG8_LAS bf16x8*)(lds + PG8_SA(b, h) + aoff + m * 2048 + k * 1024); } while (0)
#define PG8_LDB(dst, b, h) do { _Pragma("unroll") for (int n = 0; n < 2; ++n) _Pragma("unroll") for (int k = 0; k < 2; ++k) dst[n][k] = *(const PG8_LAS bf16x8*)(lds + PG8_SB(b, h) + boff + n * 2048 + k * 1024); } while (0)
#define PG8_MMA(ai, bj, At, Bt) do { __builtin_amdgcn_s_setprio(1); _Pragma("unroll") for (int m = 0; m < 4; ++m) _Pragma("unroll") for (int n = 0; n < 2; ++n) _Pragma("unroll") for (int k = 0; k < 2; ++k) \
        acc[ai][bj][m][n] = __builtin_amdgcn_mfma_f32_16x16x32_bf16(Bt[n][k], At[m][k], acc[ai][bj][m][n], 0, 0, 0); __builtin_amdgcn_s_setprio(0); } while (0)
#define PG8_WAIT_V(n) asm volatile("s_waitcnt vmcnt(" #n ")" ::: "memory")
#define PG8_WAIT_L(n) asm volatile("s_waitcnt lgkmcnt(" #n ")" ::: "memory")
#define PG8_BAR __builtin_amdgcn_s_barrier()
#define PG8_SCHED __builtin_amdgcn_sched_barrier(0)
    Unit cur, nxt; int ui = 0;
    if (!S.next(0, cur)) return;
    f32x4 acc[2][2][4][2];
#pragma unroll
    for (int a = 0; a < 2; ++a)
#pragma unroll
        for (int b = 0; b < 2; ++b)
#pragma unroll
            for (int m = 0; m < 4; ++m)
#pragma unroll
                for (int n = 0; n < 2; ++n) acc[a][b][m][n] = (f32x4){0.f, 0.f, 0.f, 0.f};
    bf16x8 At[4][2], B0[2][2], B1[2][2];
    const char* cA = (const char*)g.A + (size_t)cur.pm * tstep + (size_t)cur.kh * khoff; const char* cB = (const char*)g.Bt + (size_t)cur.pn * tstep + (size_t)cur.kh * khoff;
    S.a_ready(cur);
    if constexpr (SP2) {
        PG8_STAGE(PG8_SB(0, 0), cB, voffB); PG8_STAGE(PG8_SB(0, 1), cB + hstep, voffB); PG8_STAGE(PG8_SA(0, 0), cA, voffA); PG8_STAGE(PG8_SA(0, 1), cA + hstep, voffA);
        if (wr == 1) PG8_BAR;
        PG8_WAIT_V(2); PG8_BAR;
        PG8_STAGE(PG8_SB(1, 0), cB + kstep, voffB); PG8_STAGE(PG8_SA(1, 0), cA + kstep, voffA); PG8_STAGE(PG8_SB(1, 1), cB + hstep + kstep, voffB);
        PG8_WAIT_V(6); PG8_BAR;
    } else {
        PG8_STAGE(PG8_SB(0, 0), cB, voffB); PG8_STAGE(PG8_SA(0, 0), cA, voffA); PG8_STAGE(PG8_SB(0, 1), cB + hstep, voffB); PG8_STAGE(PG8_SA(0, 1), cA + hstep, voffA);
        if (wr == 1) PG8_BAR;
        PG8_WAIT_V(4); PG8_BAR;
        PG8_STAGE(PG8_SB(1, 0), cB + kstep, voffB); PG8_STAGE(PG8_SA(1, 0), cA + kstep, voffA); PG8_STAGE(PG8_SB(1, 1), cB + hstep + kstep, voffB);
        PG8_WAIT_V(6); PG8_BAR;
    }
    for (;;) {
        const bool has_next = S.next(ui + 1, nxt);
        const char* nA = has_next ? (const char*)g.A + (size_t)nxt.pm * tstep + (size_t)nxt.kh * khoff : cA; const char* nB = has_next ? (const char*)g.Bt + (size_t)nxt.pn * tstep + (size_t)nxt.kh * khoff : cB;
        for (int t = 0; t < nt; t += 2) {
            const bool last = (t == nt - 2);
            const char* a1 = cA + (size_t)(t + 1) * kstep;
            const char* a2 = last ? nA : cA + (size_t)(t + 2) * kstep; const char* b2 = last ? nB : cB + (size_t)(t + 2) * kstep;
            const char* a3 = a2 + kstep; const char* b3 = b2 + kstep;
            if (last && has_next) S.a_ready(nxt);
            if constexpr (SP2) {
            PG8_LDB(B0, 0, 0); PG8_LDB(B1, 0, 1); PG8_SCHED; PG8_LDA(At, 0, 0); PG8_STAGE(PG8_SA(1, 1), a1 + hstep, voffA);
            PG8_WAIT_V(8); PG8_WAIT_L(0); PG8_BAR; PG8_MMA(0, 0, At, B0); PG8_MMA(0, 1, At, B1); PG8_BAR; PG8_SCHED;
            PG8_LDA(At, 0, 1); PG8_STAGE(PG8_SB(0, 0), b2, voffB); PG8_STAGE(PG8_SB(0, 1), b2 + hstep, voffB); PG8_STAGE(PG8_SA(0, 0), a2, voffA);
            PG8_WAIT_V(8); PG8_WAIT_L(0); PG8_BAR; PG8_MMA(1, 0, At, B0); PG8_MMA(1, 1, At, B1); PG8_BAR; PG8_SCHED;
            PG8_LDB(B0, 1, 0); PG8_LDB(B1, 1, 1); PG8_SCHED; PG8_LDA(At, 1, 0); PG8_STAGE(PG8_SA(0, 1), a2 + hstep, voffA);
            PG8_WAIT_V(8); PG8_WAIT_L(0); PG8_BAR; PG8_MMA(0, 0, At, B0); PG8_MMA(0, 1, At, B1); PG8_BAR; PG8_SCHED;
            PG8_LDA(At, 1, 1); PG8_STAGE(PG8_SB(1, 0), b3, voffB); PG8_STAGE(PG8_SB(1, 1), b3 + hstep, voffB); PG8_STAGE(PG8_SA(1, 0), a3, voffA);
            PG8_WAIT_V(8); PG8_WAIT_L(0); PG8_BAR; PG8_MMA(1, 0, At, B0); PG8_MMA(1, 1, At, B1); PG8_BAR; PG8_SCHED;
            } else {
            PG8_LDB(B0, 0, 0); PG8_SCHED; PG8_LDA(At, 0, 0); PG8_STAGE(PG8_SA(1, 1), a1 + hstep, voffA);
            PG8_WAIT_L(8); PG8_BAR; PG8_WAIT_L(0); PG8_MMA(0, 0, At, B0); PG8_BAR; PG8_SCHED;
            PG8_LDB(B1, 0, 1); PG8_STAGE(PG8_SB(0, 0), b2, voffB);
            PG8_BAR; PG8_WAIT_L(0); PG8_MMA(0, 1, At, B1); PG8_BAR;
            PG8_LDA(At, 0, 1); PG8_STAGE(PG8_SA(0, 0), a2, voffA);
            PG8_BAR; PG8_WAIT_L(0); PG8_MMA(1, 0, At, B0); PG8_BAR; PG8_SCHED;
            PG8_STAGE(PG8_SB(0, 1), b2 + hstep, voffB);
            PG8_WAIT_V(6); PG8_BAR; PG8_MMA(1, 1, At, B1); PG8_BAR;
            PG8_LDB(B0, 1, 0); PG8_SCHED; PG8_LDA(At, 1, 0); PG8_STAGE(PG8_SA(0, 1), a2 + hstep, voffA);
            PG8_WAIT_L(8); PG8_BAR; PG8_WAIT_L(0); PG8_MMA(0, 0, At, B0); PG8_BAR; PG8_SCHED;
            PG8_LDB(B1, 1, 1); PG8_STAGE(PG8_SB(1, 0), b3, voffB);
            PG8_BAR; PG8_WAIT_L(0); PG8_MMA(0, 1, At, B1); PG8_BAR;
            PG8_LDA(At, 1, 1); PG8_STAGE(PG8_SA(1, 0), a3, voffA);
            PG8_BAR; PG8_WAIT_L(0); PG8_MMA(1, 0, At, B0); PG8_BAR; PG8_SCHED;
            PG8_STAGE(PG8_SB(1, 1), b3 + hstep, voffB);
            PG8_WAIT_V(6); PG8_BAR; PG8_MMA(1, 1, At, B1); PG8_BAR;
            }
        }
        if constexpr (ALIGN_EPI) { if (wr == 0) PG8_BAR; }
        if constexpr (!Epi::AFTER_DRAIN) { E(acc, cur, wr, wc, fr, fq); S.done(cur); }
        if (!has_next) break;
        if (!(Epi::SPLITK2 && cur.kh == 0))
#pragma unroll
        for (int a = 0; a < 2; ++a)
#pragma unroll
            for (int b = 0; b < 2; ++b)
#pragma unroll
                for (int m = 0; m < 4; ++m)
#pragma unroll
                    for (int n = 0; n < 2; ++n) acc[a][b][m][n] = (f32x4){0.f, 0.f, 0.f, 0.f};
        cur = nxt; cA = nA; cB = nB; ++ui;
        if constexpr (ALIGN_EPI) { if (wr == 1) PG8_BAR; }
    }
    PG8_WAIT_V(0);
    if constexpr (!ALIGN_EPI) { if (wr == 0) PG8_BAR; }
    PG8_BAR;
    if constexpr (Epi::AFTER_DRAIN) { E.fused(acc, cur, wr, wc, fr, fq, lds, wid, lane); S.done(cur); }
#undef PG8_SA
#undef PG8_SB
#undef PG8_STAGE
#undef PG8_LDA
#undef PG8_LDB
#undef PG8_MMA
#undef PG8_WAIT_V
#undef PG8_WAIT_L
#undef PG8_BAR
#undef PG8_SCHED
}
}
namespace epi {
using pg8::Unit;
typedef f32x4 Acc[2][2][4][2];

__device__ __forceinline__ void rot2(f32x4& v, const f32x4 cs) {
    const float a1 = v[0] * cs[0] - v[1] * cs[1], a2 = v[1] * cs[0] + v[0] * cs[1];
    const float b1 = v[2] * cs[2] - v[3] * cs[3], b2 = v[3] * cs[2] + v[2] * cs[3];
    v = (f32x4){a1, a2, b1, b2};
}
__device__ __forceinline__ float sigm(float x) { return 1.0f / (1.0f + __expf(-x)); }

struct EpiIn {
    static constexpr bool PERM = true, AFTER_DRAIN = false, SPLITK2 = false;
    bf16_t *cq, *ckv, *qb, *kb, *vb, *qix, *kpe, *kix, *ga, *gb; float* wix; u64 *ssq_cq, *ssq_ckv;
    const float *ropeM, *ropeD, *ropeI;
    __device__ __forceinline__ void operator()(const Acc& acc, const Unit& u, int wr, int wc, int fr, int fq) const {
        const int vt = u.pn, rowb = u.pm * 256 + wr * 64 + fr, ct = wc * 32 + 8 * fq;
        if (vt < 6) {
            bf16_t* dst = vt < 4 ? cq : ckv; const int ld = vt < 4 ? 1024 : 512, cb = (vt < 4 ? vt : vt - 4) * 256 + ct; u64* ssq = vt < 4 ? ssq_cq : ssq_ckv;
#pragma unroll
            for (int ai = 0; ai < 2; ++ai)
#pragma unroll
                for (int m = 0; m < 4; ++m) { const int row = rowb + ai * 128 + m * 16; float s = 0.f;
#pragma unroll
                    for (int bj = 0; bj < 2; ++bj) { const f32x4 v0 = acc[ai][bj][m][0], v1 = acc[ai][bj][m][1];
                        s += (v0[0] * v0[0] + v0[1] * v0[1]) + (v0[2] * v0[2] + v0[3] * v0[3]) + (v1[0] * v1[0] + v1[1] * v1[1]) + (v1[2] * v1[2] + v1[3] * v1[3]);
                        *(u32x4*)(dst + (size_t)row * ld + cb + bj * 128) = pack8(v0, v1); }
                    s += __shfl_xor(s, 16); s += __shfl_xor(s, 32);
                    if (fq == 0 && ssq) ssq_add(ssq + row, s); }
        } else if (vt < 16) {
            const bool isq = vt < 14; bf16_t* dst = isq ? qb : kb; const int ld = isq ? 2048 : 512, cb = (isq ? vt - 6 : vt - 14) * 256 + ct; const float sc = isq ? QB_SCALE : 1.f;
#pragma unroll
            for (int ai = 0; ai < 2; ++ai)
#pragma unroll
                for (int m = 0; m < 4; ++m) { const int row = rowb + ai * 128 + m * 16, t = row_pos(row);
                    f32x4 cs0 = (f32x4){1.f, 0.f, 1.f, 0.f}, cs1 = cs0;
                    if (wc == 0) { const f32x4* p = (const f32x4*)(ropeD + ((size_t)t * 16 + 4 * fq) * 2); cs0 = p[0]; cs1 = p[1]; }
#pragma unroll
                    for (int bj = 0; bj < 2; ++bj) { f32x4 v0 = acc[ai][bj][m][0], v1 = acc[ai][bj][m][1];
                        if (wc == 0) { rot2(v0, cs0); rot2(v1, cs1); }
                        v0 = v0 * sc; v1 = v1 * sc;
                        *(u32x4*)(dst + (size_t)row * ld + cb + bj * 128) = pack8(v0, v1); } }
        } else if (vt < 18) {
            const int cb = (vt - 16) * 256 + ct;
#pragma unroll
            for (int ai = 0; ai < 2; ++ai)
#pragma unroll
                for (int m = 0; m < 4; ++m) { const int row = rowb + ai * 128 + m * 16;
#pragma unroll
                    for (int bj = 0; bj < 2; ++bj) *(u32x4*)(vb + (size_t)row * 512 + cb + bj * 128) = pack8(acc[ai][bj][m][0], acc[ai][bj][m][1]); }
        } else if (vt < 22) {
            const int cb = (vt - 18) * 256 + ct; const bool rt = ((wc & 1) == 0) && (fq < 2);
#pragma unroll
            for (int ai = 0; ai < 2; ++ai)
#pragma unroll
                for (int m = 0; m < 4; ++m) { const int row = rowb + ai * 128 + m * 16, t = row_pos(row);
                    f32x4 cs0 = (f32x4){1.f, 0.f, 1.f, 0.f}, cs1 = cs0;
                    if (rt) { const f32x4* p = (const f32x4*)(ropeI + ((size_t)t * 8 + 4 * fq) * 2); cs0 = p[0]; cs1 = p[1]; }
#pragma unroll
                    for (int bj = 0; bj < 2; ++bj) { f32x4 v0 = acc[ai][bj][m][0], v1 = acc[ai][bj][m][1];
                        if (rt) { rot2(v0, cs0); rot2(v1, cs1); }
                        *(u32x4*)(qix + (size_t)row * 1024 + cb + bj * 128) = pack8(v0, v1); } }
        } else if (vt == 22) {
#pragma unroll
            for (int ai = 0; ai < 2; ++ai)
#pragma unroll
                for (int m = 0; m < 4; ++m) { const int row = rowb + ai * 128 + m * 16, t = row_pos(row);
                    f32x4 v0 = acc[ai][0][m][0], v1 = acc[ai][0][m][1];
                    if (wc < 2) { const f32x4* p = (const f32x4*)(ropeM + ((size_t)t * 32 + 16 * wc + 4 * fq) * 2); rot2(v0, p[0]); rot2(v1, p[1]);
                        *(u32x4*)(kpe + (size_t)row * 64 + ct) = pack8(v0, v1);
                    } else { if (wc == 2 && fq < 2) { const f32x4* p = (const f32x4*)(ropeI + ((size_t)t * 8 + 4 * fq) * 2); rot2(v0, p[0]); rot2(v1, p[1]); }
                        *(u32x4*)(kix + (size_t)row * 64 + (ct - 64)) = pack8(v0, v1); }
                    if (wc == 0 && fq < 2) { float* w = wix + (size_t)row * 16 + 8 * fq; *(f32x4*)w = acc[ai][1][m][0]; *(f32x4*)(w + 4) = acc[ai][1][m][1]; } }
        } else {
            const bool isa = vt < 39; bf16_t* dst = isa ? ga : gb; const int cb = (isa ? vt - 23 : vt - 39) * 256 + ct;
#pragma unroll
            for (int ai = 0; ai < 2; ++ai)
#pragma unroll
                for (int m = 0; m < 4; ++m) { const int row = rowb + ai * 128 + m * 16;
#pragma unroll
                    for (int bj = 0; bj < 2; ++bj) { f32x4 v0 = acc[ai][bj][m][0], v1 = acc[ai][bj][m][1];
#pragma unroll
                        for (int e = 0; e < 4; ++e) { v0[e] = sigm(v0[e]); v1[e] = sigm(v1[e]); }
                        *(u32x4*)(dst + (size_t)row * 4096 + cb + bj * 128) = pack8(v0, v1); } }
        }
    }
};

struct EpiUp {
    static constexpr bool PERM = true, AFTER_DRAIN = false, SPLITK2 = false;
    bf16_t *d0, *d1; int nt0, ld0, ld1; const u64* ssq; float invK, scale; const float* rope;
    __device__ __forceinline__ void operator()(const Acc& acc, const Unit& u, int wr, int wc, int fr, int fq) const {
        const int vt = u.pn, rowb = u.pm * 256 + wr * 64 + fr, ct = wc * 32 + 8 * fq; const bool first = vt < nt0;
        bf16_t* dst = first ? d0 : d1; const int ld = first ? ld0 : ld1, cb = (first ? vt : vt - nt0) * 256 + ct; const bool rt = (!first) && (rope != nullptr);
#pragma unroll
        for (int ai = 0; ai < 2; ++ai)
#pragma unroll
            for (int m = 0; m < 4; ++m) { const int row = rowb + ai * 128 + m * 16, t = row_pos(row);
                const float rs = __builtin_amdgcn_rsqf(ssq_get(ssq + row) * invK + EPS) * scale;
                f32x4 cs0 = (f32x4){1.f, 0.f, 1.f, 0.f}, cs1 = cs0;
                if (rt) { const f32x4* p = (const f32x4*)(rope + ((size_t)t * 32 + 16 * (wc & 1) + 4 * fq) * 2); cs0 = p[0]; cs1 = p[1]; }
#pragma unroll
                for (int bj = 0; bj < 2; ++bj) { f32x4 v0 = acc[ai][bj][m][0] * rs, v1 = acc[ai][bj][m][1] * rs;
                    if (rt) { rot2(v0, cs0); rot2(v1, cs1); }
                    *(u32x4*)(dst + (size_t)row * ld + cb + bj * 128) = pack8(v0, v1); } }
    }
};

struct EpiBranch {
    static constexpr bool PERM = true, AFTER_DRAIN = false, SPLITK2 = true;
    const bf16_t *ga, *gb; bf16_t* out;
    __device__ __forceinline__ void operator()(Acc& acc, const Unit& u, int wr, int wc, int fr, int fq) const {
        const int rowb = u.pm * 256 + wr * 64 + fr, cb = u.pn * 256 + wc * 32 + 8 * fq;
        if (u.kh == 0) {
#pragma unroll
            for (int ai = 0; ai < 2; ++ai)
#pragma unroll
                for (int m = 0; m < 4; ++m) { const size_t ro = (size_t)(rowb + ai * 128 + m * 16) * 4096 + cb;
#pragma unroll
                    for (int bj = 0; bj < 2; ++bj) { const u32x4 a = *(const u32x4*)(ga + ro + bj * 128), b = *(const u32x4*)(gb + ro + bj * 128);
                        f32x4 r0, r1;
#define RQ(x, y) ((x) * __builtin_amdgcn_rcpf(y))
                        r0[0] = RQ(bf_lo(a.x), bf_lo(b.x)); r0[1] = RQ(bf_hi(a.x), bf_hi(b.x)); r0[2] = RQ(bf_lo(a.y), bf_lo(b.y)); r0[3] = RQ(bf_hi(a.y), bf_hi(b.y));
                        r1[0] = RQ(bf_lo(a.z), bf_lo(b.z)); r1[1] = RQ(bf_hi(a.z), bf_hi(b.z)); r1[2] = RQ(bf_lo(a.w), bf_lo(b.w)); r1[3] = RQ(bf_hi(a.w), bf_hi(b.w));
#undef RQ
                        acc[ai][bj][m][0] = acc[ai][bj][m][0] * r0; acc[ai][bj][m][1] = acc[ai][bj][m][1] * r1; }
                    asm volatile("" ::: "memory"); }
        } else {
#pragma unroll
            for (int ai = 0; ai < 2; ++ai)
#pragma unroll
                for (int m = 0; m < 4; ++m) { const size_t ro = (size_t)(rowb + ai * 128 + m * 16) * 4096 + cb;
#pragma unroll
                    for (int bj = 0; bj < 2; ++bj) { const u32x4 b = *(const u32x4*)(gb + ro + bj * 128);
                        const f32x4 s0 = (f32x4){bf_lo(b.x), bf_hi(b.x), bf_lo(b.y), bf_hi(b.y)}, s1 = (f32x4){bf_lo(b.z), bf_hi(b.z), bf_lo(b.w), bf_hi(b.w)};
                        *(u32x4*)(out + ro + bj * 128) = pack8(acc[ai][bj][m][0] * s0, acc[ai][bj][m][1] * s1); } }
        }
    }
};

struct EpiOut {
    static constexpr bool PERM = true, AFTER_DRAIN = false, SPLITK2 = false;
    const float *x, *meta; float* h1f; bf16_t* h1b; u64* ssq;
    __device__ __forceinline__ void operator()(const Acc& acc, const Unit& u, int wr, int wc, int fr, int fq) const {
        const int rowb = u.pm * 256 + wr * 64 + fr, cb = u.pn * 256 + wc * 32 + 8 * fq;
#pragma unroll
        for (int ai = 0; ai < 2; ++ai)
#pragma unroll
            for (int m = 0; m < 4; ++m) { const int row = rowb + ai * 128 + m * 16;
                const float* src = x + (size_t)row * DM;
                float s = 0.f;
#pragma unroll
                for (int bj = 0; bj < 2; ++bj) { f32x4 v0 = acc[ai][bj][m][0], v1 = acc[ai][bj][m][1];
                    v0 = v0 + *(const f32x4*)(src + cb + bj * 128); v1 = v1 + *(const f32x4*)(src + cb + bj * 128 + 4);
                    s += (v0[0] * v0[0] + v0[1] * v0[1]) + (v0[2] * v0[2] + v0[3] * v0[3]) + (v1[0] * v1[0] + v1[1] * v1[1]) + (v1[2] * v1[2] + v1[3] * v1[3]);
                    float* o = h1f + (size_t)row * DM + cb + bj * 128; *(f32x4*)o = v0; *(f32x4*)(o + 4) = v1;
                    *(u32x4*)(h1b + (size_t)row * DM + cb + bj * 128) = pack8(v0, v1); }
                s += __shfl_xor(s, 16); s += __shfl_xor(s, 32);
                if (fq == 0 && ssq) ssq_add(ssq + row, s); }
    }
};

struct EpiPQ {
    static constexpr bool PERM = true, AFTER_DRAIN = false, SPLITK2 = false;
    bf16_t* pq; const u64* ssq;
    __device__ __forceinline__ void operator()(const Acc& acc, const Unit& u, int wr, int wc, int fr, int fq) const {
        const int rowb = u.pm * 256 + wr * 64 + fr, cb = u.pn * 256 + wc * 32 + 8 * fq;
#pragma unroll
        for (int ai = 0; ai < 2; ++ai)
#pragma unroll
            for (int m = 0; m < 4; ++m) { const int row = rowb + ai * 128 + m * 16; const float rs = __builtin_amdgcn_rsqf(ssq_get(ssq + row) * (1.0f / DM) + EPS);
#pragma unroll
                for (int bj = 0; bj < 2; ++bj) *(u32x4*)(pq + (size_t)row * 2048 + cb + bj * 128) = pack8(acc[ai][bj][m][0] * rs, acc[ai][bj][m][1] * rs); }
    }
};
}
#define XB_TMO      128
#define XB_XCNT(j)  (256  + 64 * (j))
#define XB_XSUB(j)  (1280 + 64 * (j))
#define XB_XGEN(j)  (2304 + 64 * (j))
#define XB_TOP      3328
#define XB_TOPGEN   3392
#define XCD_BAR_WORDS 3456
#define XB_SPIN_CAP (1u << 18)
__device__ __forceinline__ unsigned xb_ld(unsigned* p)              { return __hip_atomic_load(p, __ATOMIC_RELAXED, __HIP_MEMORY_SCOPE_AGENT); }
__device__ __forceinline__ unsigned xb_add(unsigned* p, unsigned v) { return __hip_atomic_fetch_add(p, v, __ATOMIC_RELAXED, __HIP_MEMORY_SCOPE_AGENT); }
__device__ __forceinline__ unsigned xb_xcc_id() { return (unsigned)__builtin_amdgcn_s_getreg((3 << 11) | 20) & 0xFu; }
#define XB_SPIN(cond, bar) do { unsigned _sp = 0; while (cond) { __builtin_amdgcn_s_sleep(1); \
    if ((++_sp & 255u) == 0u) { if (xb_ld(&(bar)[XB_TMO])) break; if (_sp > XB_SPIN_CAP) { atomicAdd(&(bar)[XB_TMO], 1u); break; } } } } while (0)
struct XcdBarrier { unsigned* bar; unsigned x; volatile LAS unsigned* st; };
__device__ __forceinline__ XcdBarrier xcd_barrier_post(unsigned* bar, volatile LAS unsigned* st) {
    XcdBarrier b; b.bar = bar; b.x = xb_xcc_id(); b.st = st;
    if (threadIdx.x == 0) (void)xb_add(&bar[XB_XCNT(b.x)], 1u);
    return b;
}
__device__ __forceinline__ void xcd_barrier_complete(unsigned* bar, unsigned x, unsigned& nloc, unsigned& nx) {
    const unsigned G = gridDim.x * gridDim.y * gridDim.z;
    unsigned sum, cnt, mine, sp = 0u;
    for (;;) {
        sum = 0u; cnt = 0u; mine = 0u;
#pragma unroll
        for (unsigned j = 0; j < 16; ++j) { const unsigned c = xb_ld(&bar[XB_XCNT(j)]); sum += c; cnt += (c > 0u) ? 1u : 0u; mine = (j == x) ? c : mine; }
        if (sum == G) break;
        __builtin_amdgcn_s_sleep(1);
        if ((++sp & 255u) == 0u) { if (xb_ld(&bar[XB_TMO])) break; if (sp > XB_SPIN_CAP) { atomicAdd(&bar[XB_TMO], 1u); break; } }
    }
    nloc = mine > 0u ? mine : 1u; nx = cnt > 0u ? cnt : 1u;
}
__device__ __forceinline__ void xcd_barrier(const XcdBarrier& b) {
    asm volatile("s_waitcnt vmcnt(0)" ::: "memory");
    __syncthreads();
    if (threadIdx.x == 0) {
        unsigned* bar = b.bar;
        __builtin_amdgcn_s_waitcnt(0);
        unsigned nloc = b.st[0], nx = b.st[1];
        if (nloc == 0u) { xcd_barrier_complete(bar, b.x, nloc, nx); b.st[0] = nloc; b.st[1] = nx; }
        const unsigned old = xb_add(&bar[XB_XSUB(b.x)], 1u);
        const unsigned gen = old / nloc;
        if (old + 1u == (gen + 1u) * nloc) {
            __builtin_amdgcn_fence(__ATOMIC_RELEASE, "agent");
            asm volatile("s_waitcnt vmcnt(0)" ::: "memory");
            const unsigned og = xb_add(&bar[XB_TOP], 1u);
            const unsigned tg = og / nx;
            if (og + 1u == (tg + 1u) * nx) xb_add(&bar[XB_TOPGEN], 1u);
            else XB_SPIN(xb_ld(&bar[XB_TOPGEN]) == tg, bar);
            __builtin_amdgcn_fence(__ATOMIC_ACQUIRE, "agent");
            xb_add(&bar[XB_XGEN(b.x)], 1u);
            asm volatile("s_waitcnt vmcnt(0)" ::: "memory");
        } else {
            XB_SPIN(xb_ld(&bar[XB_XGEN(b.x)]) == gen, bar);
            __builtin_amdgcn_fence(__ATOMIC_ACQUIRE, "agent");
            asm volatile("s_waitcnt vmcnt(0)" ::: "memory");
        }
    }
    __syncthreads();
}

struct Frame {
    LAS unsigned char* lds;
    unsigned char* ws;
    unsigned* ctl;
    int tid, lane, wave, vcu, G;
    __device__ __forceinline__ const float* in(int i) const { return ((const float* const __attribute__((address_space(4)))*)__builtin_amdgcn_kernarg_segment_ptr())[i]; }
    __device__ __forceinline__ float* out() const { return ((float* const __attribute__((address_space(4)))*)__builtin_amdgcn_kernarg_segment_ptr())[16]; }
};

struct MapId { __device__ __forceinline__ int operator()(int v) const { return v; } };
struct MapIn { __device__ __forceinline__ int operator()(int v) const {
    if (v < 1536) return v;
    if (v < 3584) { const int w = v - 1536, hd = w >> 7; int o = w & 127; if (o < 32) o = (o & 1) ? (o >> 1) + 16 : (o >> 1); return 1600 + hd * 128 + o; }
    if (v < 4096) { const int w = v - 3584, hd = w >> 7; int o = w & 127; if (o < 32) o = (o & 1) ? (o >> 1) + 16 : (o >> 1); return 3648 + hd * 128 + o; }
    if (v < 4608) return 4160 + (v - 4096);
    if (v < 5632) { const int w = v - 4608, hd = w >> 6; int o = w & 63; if (o < 16) o = (o & 1) ? (o >> 1) + 8 : (o >> 1); return 4672 + hd * 64 + o; }
    if (v < 5888) { const int w = v - 5632;
        if (w < 64) return 1536 + ((w & 1) ? (w >> 1) + 32 : (w >> 1));
        if (w < 128) { int o = w - 64; if (o < 16) o = (o & 1) ? (o >> 1) + 8 : (o >> 1); return 5696 + o; }
        if (w < 144) return 5760 + (w - 128);
        return -1; }
    if (v < 9984) return 5776 + (v - 5888);
    return 9872 + (v - 9984);
} };
struct MapUq { __device__ __forceinline__ int operator()(int v) const {
    if (v < 2048) return (v >> 7) * 192 + (v & 127);
    const int w = v - 2048, hd = w >> 6, o = w & 63; return hd * 192 + 128 + ((o & 1) ? (o >> 1) + 32 : (o >> 1)); } };
struct MapUkv { __device__ __forceinline__ int operator()(int v) const {
    if (v < 2048) return (v >> 7) * 256 + (v & 127);
    const int w = v - 2048; return (w >> 7) * 256 + 128 + (w & 127); } };

template <class Map>
__device__ __forceinline__ void p0_transpose_item(const float* W, int K, int Nsrc, int Nvirt, bf16_t* WT, const float* gk, LAS float* scr, int item, int lane, Map map) {
    const int nblk = Nvirt / 32, kb = item / nblk, nb = item % nblk, k0 = 64 * kb, n0 = 32 * nb;
    const int sc = map(n0 + (lane & 31));
#pragma unroll 8
    for (int i = 0; i < 32; ++i) { const int kk = 2 * i + (lane >> 5); float v = 0.f;
        if (sc >= 0) v = W[(size_t)(k0 + kk) * Nsrc + sc];
        if (gk) v *= gk[k0 + kk];
        scr[kk * 33 + (lane & 31)] = v; }
    LDS_WAIT(); asm volatile("" ::: "memory");
    const int c = lane & 7;
#pragma unroll
    for (int j = 0; j < 4; ++j) { const int n = (lane >> 3) + 8 * j; const LAS float* s = scr + (8 * c) * 33 + n;
        u32x4 o; o.x = pk2(s[0 * 33], s[1 * 33]); o.y = pk2(s[2 * 33], s[3 * 33]); o.z = pk2(s[4 * 33], s[5 * 33]); o.w = pk2(s[6 * 33], s[7 * 33]);
        *(u32x4*)(WT + (size_t)(n0 + n) * K + k0 + 8 * c) = o; }
    LDS_WAIT(); asm volatile("" ::: "memory");
}
__device__ __forceinline__ void p0_xn_row(const Frame& F, int m) {
    const float* x = F.in(0); const float* meta = F.in(1); const float* g = F.in(2);
    bf16_t* o = (bf16_t*)(F.ws + WS_XN) + (size_t)m * DM;
    u32x2* o8 = (u32x2*)o + F.lane;
    if (m >= NTOK + NMETA) {
#pragma unroll
        for (int j = 0; j < 16; ++j) o8[64 * j] = (u32x2){0u, 0u};
        return; }
    const float* src = m < NTOK ? x + (size_t)m * DM : meta + (size_t)(m - NTOK) * DM;
    const f32x4* xr = (const f32x4*)src + F.lane; const f32x4* gr = (const f32x4*)g + F.lane;
    f32x4 v[16]; float s = 0.f;
#pragma unroll
    for (int j = 0; j < 16; ++j) { v[j] = xr[64 * j]; s += (v[j][0] * v[j][0] + v[j][1] * v[j][1]) + (v[j][2] * v[j][2] + v[j][3] * v[j][3]); }
    const float rstd = 1.0f / sqrtf(wave_sum(s) * (1.0f / DM) + EPS);
#pragma unroll
    for (int j = 0; j < 16; ++j) { const f32x4 gg = gr[64 * j]; const f32x4 y = v[j] * rstd * gg; o8[64 * j] = (u32x2){pk2(y[0], y[1]), pk2(y[2], y[3])}; }
}
__device__ __forceinline__ void p0_prologue(const Frame& F) {
    LAS float* scr = (LAS float*)(F.lds + F.wave * 16384);
    const int gw = F.vcu * NWAVES + F.wave, NGW = F.G * NWAVES;
    const float* w_in = F.in(3); const float* qg = F.in(4); const float* w_uq = F.in(5); const float* kvg = F.in(6); const float* w_ukv = F.in(7);
    const float* w_br = F.in(8); const float* w_out = F.in(9); const float* fg = F.in(10); const float* w_q = F.in(11); const float* sk = F.in(12);
    constexpr int I_IN = 64 * (NV1 / 32), I_UQ = 16 * (3072 / 32), I_UKV = 8 * (4096 / 32), I_BR = 64 * 128, I_OUT = 64 * 128, I_Q = 64 * 64;
    constexpr int NITEMS = I_IN + I_UQ + I_UKV + I_BR + I_OUT + I_Q;
    for (int it = gw; it < NITEMS; it += NGW) {
        int r = it;
        if (r < I_IN) { p0_transpose_item(w_in, 4096, 13968, NV1, (bf16_t*)(F.ws + WS_WIN), nullptr, scr, r, F.lane, MapIn()); continue; } r -= I_IN;
        if (r < I_UQ) { p0_transpose_item(w_uq, 1024, 3072, 3072, (bf16_t*)(F.ws + WS_WUQ), qg, scr, r, F.lane, MapUq()); continue; } r -= I_UQ;
        if (r < I_UKV) { p0_transpose_item(w_ukv, 512, 4096, 4096, (bf16_t*)(F.ws + WS_WUKV), kvg, scr, r, F.lane, MapUkv()); continue; } r -= I_UKV;
        if (r < I_BR) { p0_transpose_item(w_br, 4096, 4096, 4096, (bf16_t*)(F.ws + WS_WBR), nullptr, scr, r, F.lane, MapId()); continue; } r -= I_BR;
        if (r < I_OUT) { p0_transpose_item(w_out, 4096, 4096, 4096, (bf16_t*)(F.ws + WS_WOUT), nullptr, scr, r, F.lane, MapId()); continue; } r -= I_OUT;
        p0_transpose_item(w_q, 4096, 2048, 2048, (bf16_t*)(F.ws + WS_WQ), fg, scr, r, F.lane, MapId());
    }
    for (int m = gw; m < MK; m += NGW) p0_xn_row(F, m);
    const int gt = (F.vcu * NWAVES + F.wave) * 64 + F.lane, NGT = NGW * 64;
    for (int i = gt; i < TP * 56; i += NGT) {
        const int t = i / 56, r = i % 56; int j, rot; float* dst;
        if (r < 32) { j = r; rot = 64; dst = (float*)(F.ws + WS_ROPE_M) + ((size_t)t * 32 + j) * 2; }
        else if (r < 48) { j = r - 32; rot = 32; dst = (float*)(F.ws + WS_ROPE_D) + ((size_t)t * 16 + j) * 2; }
        else { j = r - 48; rot = 16; dst = (float*)(F.ws + WS_ROPE_I) + ((size_t)t * 8 + j) * 2; }
        const float ex = (float)(2 * j) / (float)rot;
        const float inv = powf(500000.0f, -ex);
        const float ang = (float)t * inv;
        const double a = (double)ang, kq = rint(a * 0.15915494309189535), rr = fma(-kq, 6.283185307179586, a);
        const float rf = (float)rr;
        dst[0] = cosf(rf); dst[1] = sinf(rf);
    }
    for (int i = gt; i < 16 * 128 * 128 / 8; i += NGT) { const f32x4* s = (const f32x4*)sk + 2 * (size_t)i; const f32x4 a = s[0], b2 = s[1];
        u32x4 o; o.x = pk2(a[0], a[1]); o.y = pk2(a[2], a[3]); o.z = pk2(b2[0], b2[1]); o.w = pk2(b2[2], b2[3]); ((u32x4*)(F.ws + WS_SK))[i] = o; }
}
__device__ __forceinline__ float wave_max(float v) {
#pragma unroll
    for (int o = 1; o < 64; o <<= 1) v = fmaxf(v, __shfl_xor(v, o));
    return v;
}
__device__ __forceinline__ unsigned fp6_code(float q) {
    const unsigned b = __float_as_uint(q), sgn = (b >> 31) << 5; const float aq = fabsf(q);
    const unsigned sub = (unsigned)rintf(aq * 8.0f);
    unsigned ab = b & 0x7fffffffu; ab = ab + 0x7FFFFu + ((ab >> 20) & 1u);
    const unsigned nrm = (ab >> 20) - (126u << 3);
    unsigned code = aq < 1.0f ? sub : nrm; code = code > 31u ? 31u : code;
    return code | sgn;
}
__device__ __forceinline__ void fp6_pack32(const unsigned (&c)[32], unsigned (&w)[6]) {
#pragma unroll
    for (int i = 0; i < 6; ++i) w[i] = 0u;
#pragma unroll
    for (int k = 0; k < 32; ++k) { const int bit = 6 * k, d = bit >> 5, sh = bit & 31; w[d] |= c[k] << sh; if (sh > 26) w[d + 1] |= c[k] >> (32 - sh); }
}
__device__ __forceinline__ void p6_quant_row(const float* src, const float* gain, unsigned char* dst, float* scale_out, int lane) {
    const f32x4* s = (const f32x4*)src + lane; f32x4 v[16]; float mx = 0.f;
#pragma unroll
    for (int j = 0; j < 16; ++j) { v[j] = s[64 * j]; if (gain) v[j] = v[j] * ((const f32x4*)gain)[lane + 64 * j];
        mx = fmaxf(mx, fmaxf(fmaxf(fabsf(v[j][0]), fabsf(v[j][1])), fmaxf(fabsf(v[j][2]), fabsf(v[j][3])))); }
    mx = fmaxf(wave_max(mx), 1e-30f);
    const float sc = mx * (1.0f / 7.5f), inv = 7.5f / mx;
    if (lane == 0) *scale_out = sc;
    unsigned w[12];
#pragma unroll
    for (int g = 0; g < 2; ++g) { unsigned c[32];
#pragma unroll
        for (int j = 0; j < 8; ++j)
#pragma unroll
            for (int i = 0; i < 4; ++i) c[4 * j + i] = fp6_code(v[8 * g + j][i] * inv);
        unsigned ww[6]; fp6_pack32(c, ww);
#pragma unroll
        for (int i = 0; i < 6; ++i) w[6 * g + i] = ww[i]; }
#pragma unroll
    for (int q = 0; q < 3; ++q) *(u32x4*)(dst + 1024 * q + 16 * lane) = (u32x4){w[4 * q], w[4 * q + 1], w[4 * q + 2], w[4 * q + 3]};
}
__device__ __forceinline__ void p6_tables(const Frame& F) {
    const float* fg = F.in(10); const float* pu = F.in(13); const float* pv = F.in(14);
    const int gw = F.vcu * NWAVES + F.wave, NGW = F.G * NWAVES;
    for (int it = gw; it < 2 * 16384; it += NGW) { const int e = it >> 1;
        if (it & 1) p6_quant_row(pv + (size_t)e * DM, nullptr, F.ws + WS_V + (size_t)e * 3072, (float*)(F.ws + WS_SCV) + e, F.lane);
        else p6_quant_row(pu + (size_t)e * DM, fg, F.ws + WS_U + (size_t)e * 3072, (float*)(F.ws + WS_SCU) + e, F.lane); }
}
#define MFMA32(a, b, c) __builtin_amdgcn_mfma_f32_32x32x16_bf16((a), (b), (c), 0, 0, 0)
__device__ __forceinline__ int crow(int i, int h) { return (i & 3) + 8 * (i >> 2) + 4 * h; }
__device__ __forceinline__ float half_sum_f(float v) {
#pragma unroll
    for (int o = 1; o < 32; o <<= 1) v += __shfl_xor(v, o);
    return v;
}
__device__ __forceinline__ int half_sum_i(int v) {
#pragma unroll
    for (int o = 1; o < 32; o <<= 1) v += __shfl_xor(v, o);
    return v;
}
__device__ __forceinline__ float half_max_f(float v) {
#pragma unroll
    for (int o = 1; o < 32; o <<= 1) v = fmaxf(v, __shfl_xor(v, o));
    return v;
}
__device__ __forceinline__ float half_min_f(float v) {
#pragma unroll
    for (int o = 1; o < 32; o <<= 1) v = fminf(v, __shfl_xor(v, o));
    return v;
}
__device__ __forceinline__ void idx_task(const Frame& F, int b, int s0) {
    const int lane = F.lane, r = lane & 31, h = lane >> 5;
    const bf16_t* qix = (const bf16_t*)(F.ws + WS_QIX); const bf16_t* kix = (const bf16_t*)(F.ws + WS_KIX); const float* wix = (const float*)(F.ws + WS_WIX);
    unsigned* mask = (unsigned*)(F.ws + WS_MASK);
    const int tok = (r >> 2) & 1, head = (r & 3) + 4 * (r >> 3);
    const bf16_t* qp = qix + (size_t)(b * SEQ + s0 + tok) * 1024 + head * 64 + 8 * h;
    bf16x8 af[4];
#pragma unroll
    for (int ks = 0; ks < 4; ++ks) af[ks] = *(const bf16x8*)(qp + 16 * ks);
    const f32x4* wp = (const f32x4*)(wix + (size_t)(b * SEQ + s0 + h) * 16);
    float w[16];
#pragma unroll
    for (int q = 0; q < 4; ++q) { const f32x4 x = wp[q]; w[4 * q] = x[0]; w[4 * q + 1] = x[1]; w[4 * q + 2] = x[2]; w[4 * q + 3] = x[3]; }
    const int tq = NMETA + s0 + h;
    const int ngrp = ((NMETA + s0 + 1) >> 6) + 1;
    int brow = b * SEQ - NMETA; asm volatile("" : "+s"(brow));
    const bf16_t* kbase = kix + ((long)brow + r) * 64 + 8 * h;
    float row[MW];
    const bf16_t* kcur = kbase;
#pragma unroll
    for (int g = 0; g < MW / 2; ++g) {
        float s0v = -INFINITY, s1v = -INFINITY;
        if (g < ngrp) {
            const bf16_t* kp0 = kcur; const bf16_t* kp1 = kcur + 32 * 64;
            if (g == 0 && r < NMETA) kp0 = kix + (size_t)(NTOK + r) * 64 + 8 * h;
            bf16x8 b0[4], b1[4];
#pragma unroll
            for (int ks = 0; ks < 4; ++ks) { b0[ks] = *(const bf16x8*)(kp0 + 16 * ks); b1[ks] = *(const bf16x8*)(kp1 + 16 * ks); }
            float x0 = 0.f, x1 = 0.f;
            { f32x16 a0;
#pragma unroll
              for (int i = 0; i < 16; ++i) a0[i] = 0.f;
#pragma unroll
              for (int ks = 0; ks < 4; ++ks) a0 = MFMA32(af[ks], b0[ks], a0);
#pragma unroll
              for (int i = 0; i < 16; ++i) x0 += w[i] * fmaxf(a0[i], 0.f); }
            { f32x16 a1;
#pragma unroll
              for (int i = 0; i < 16; ++i) a1[i] = 0.f;
#pragma unroll
              for (int ks = 0; ks < 4; ++ks) a1 = MFMA32(af[ks], b1[ks], a1);
#pragma unroll
              for (int i = 0; i < 16; ++i) x1 += w[i] * fmaxf(a1[i], 0.f); }
            s0v = (g * 64 + r <= tq) ? x0 : -INFINITY; s1v = (g * 64 + 32 + r <= tq) ? x1 : -INFINITY;
        }
        row[2 * g] = s0v; row[2 * g + 1] = s1v;
        kcur += 64 * 64; asm volatile("" : "+v"(kcur));
    }
    float tau = -3.0e38f;
    bool done = (tq + 1 <= 256);
    float mx = -INFINITY, mn = INFINITY;
#pragma unroll
    for (int k = 0; k < MW; ++k) { const float v = row[k]; mx = fmaxf(mx, v); mn = fminf(mn, v > -INFINITY ? v : INFINITY); }
    float lo = half_min_f(mn), hi = half_max_f(mx);
    if (!done) tau = hi;
    for (int it = 0; it < 64; ++it) {
        if (!__any(!done)) break;
        const float mid = lo + (hi - lo) * 0.5f;
        int c = 0;
#pragma unroll
        for (int k = 0; k < MW; ++k) c += (row[k] >= mid) ? 1 : 0;
        c = half_sum_i(c);
        if (!done) {
            if (!(mid > lo && mid < hi)) { tau = hi; done = true; }
            else if (c == 256) { tau = mid; done = true; }
            else if (c > 256) lo = mid;
            else { hi = mid; tau = hi; }
        }
    }
    unsigned* mrow = mask + (size_t)(b * SEQ + s0 + h) * MW;
    unsigned mw = 0u;
#pragma unroll
    for (int k = 0; k < MW; ++k) {
        const unsigned long long bal = __ballot(row[k] >= tau);
        const unsigned wd = h ? (unsigned)(bal >> 32) : (unsigned)bal;
        if ((k & 31) == r) mw = wd;
        if ((k & 31) == 31 || k == MW - 1) { const int kk = (k & ~31) + r; if (kk < MW) mrow[kk] = mw; }
    }
}
__device__ __forceinline__ void p2_indexer(const Frame& F, int qslot) {
    volatile LAS unsigned* qw = (volatile LAS unsigned*)(F.lds + LDSCTL_OFF + 16);
    constexpr int NCH = NTOK / 16;
    for (;;) {
        if (F.tid == 0) qw[0] = atomicAdd(F.ctl + CW_QUEUE + 64 * qslot, 1u);
        __syncthreads();
        const int c = (int)qw[0];
        __syncthreads();
        if (c >= NCH) break;
        const int b = c & 3, tblk = (SEQ / 16 - 1) - (c >> 2);
        idx_task(F, b, tblk * 16 + 2 * F.wave);
    }
}
template <bool MLA> struct AttnCfg {
    static constexpr int DQK = MLA ? 192 : 128, PK = DQK * 2 + 16, PV = 320, KCH = DQK / 8, NKC = 64 * KCH / 512, KBYTES = 64 * PK, BUFB = 64 * PK + 64 * PV;
};
struct AttnUnit { int type, b, hx, blk; };

template <bool MLA>
__device__ __forceinline__ void attn_unit(const Frame& F, const AttnUnit u) {
    typedef AttnCfg<MLA> C;
    const int tid = F.tid, lane = F.lane, wave = F.wave, r = lane & 31, h = lane >> 5;
    LAS unsigned char* lds = F.lds;
    const bf16_t* qn = (const bf16_t*)(F.ws + WS_QN); const bf16_t* qr = (const bf16_t*)(F.ws + WS_QR); const bf16_t* kn = (const bf16_t*)(F.ws + WS_KN);
    const bf16_t* va = (const bf16_t*)(F.ws + WS_VA); const bf16_t* kpe = (const bf16_t*)(F.ws + WS_KPE);
    const bf16_t* qb = (const bf16_t*)(F.ws + WS_QB); const bf16_t* kb = (const bf16_t*)(F.ws + WS_KB); const bf16_t* vb = (const bf16_t*)(F.ws + WS_VB);
    const unsigned* mask = (const unsigned*)(F.ws + WS_MASK); bf16_t* oab = (bf16_t*)(F.ws + WS_OAB);
    const int b = u.b;
    const size_t rowb = (size_t)b * SEQ;
    int head, tw0, ntiles;
    if (MLA) { head = u.hx; tw0 = u.blk * 256 + 32 * wave; ntiles = (NMETA + u.blk * 256 + 255) / 64 + 1; }
    else { head = 4 * u.hx + (wave & 3); tw0 = u.blk * 64 + 32 * (wave >> 2); ntiles = (NMETA + u.blk * 64 + 63) / 64 + 1; }
    const int pw0 = NMETA + tw0;
    const int tq = pw0 + r;
    bf16x8 qf[C::DQK / 16];
    if (MLA) {
        const bf16_t* p0 = qn + (rowb + tw0 + r) * 2048 + head * 128 + 8 * h; const bf16_t* p1 = qr + (rowb + tw0 + r) * 1024 + head * 64 + 8 * h;
#pragma unroll
        for (int ks = 0; ks < 8; ++ks) qf[ks] = *(const bf16x8*)(p0 + 16 * ks);
#pragma unroll
        for (int ks = 0; ks < 4; ++ks) qf[8 + ks] = *(const bf16x8*)(p1 + 16 * ks);
    } else {
        const bf16_t* p0 = qb + (rowb + tw0 + r) * 2048 + head * 128 + 8 * h;
#pragma unroll
        for (int ks = 0; ks < 8; ++ks) qf[ks] = *(const bf16x8*)(p0 + 16 * ks);
    }
    const int ldkv = MLA ? 2048 : 512;
    const bf16_t* ktab = MLA ? kn + head * 128 : kb + u.hx * 128;
    const bf16_t* vtab = MLA ? va + head * 128 : vb + u.hx * 128;
    const bf16_t* kbase = ktab + (rowb - NMETA) * ldkv;
    const bf16_t* vbase = vtab + (rowb - NMETA) * ldkv;
    const bf16_t* pbase = kpe + (rowb - NMETA) * 64;
    unsigned soff[2]; int kdst[2], vdst[2];
#pragma unroll
    for (int i = 0; i < 2; ++i) { const int c = tid + 512 * i, key = c >> 4, pc = c & 15; soff[i] = (unsigned)(key * ldkv + pc * 8); kdst[i] = key * C::PK + pc * 16; vdst[i] = C::KBYTES + key * C::PV + pc * 16; }
    const unsigned poff = (unsigned)((tid >> 3) * 64 + (tid & 7) * 8); const int pdst = (tid >> 3) * C::PK + 256 + (tid & 7) * 16;
    u32x4 kst[2], vst[2], pst = (u32x4){0u, 0u, 0u, 0u};
    {
        const int key0 = tid >> 4;
        const size_t o0 = key0 < NMETA ? (size_t)(NTOK + key0) * ldkv + (tid & 15) * 8 : (rowb - NMETA) * ldkv + soff[0];
        kst[0] = *(const u32x4*)(ktab + o0); vst[0] = *(const u32x4*)(vtab + o0);
        kst[1] = *(const u32x4*)(kbase + soff[1]); vst[1] = *(const u32x4*)(vbase + soff[1]);
        if (MLA) { const int keyp = tid >> 3; pst = *(const u32x4*)(keyp < NMETA ? kpe + (size_t)(NTOK + keyp) * 64 + (tid & 7) * 8 : pbase + poff); }
    }
#pragma unroll
    for (int i = 0; i < 2; ++i) { *(LAS u32x4*)(lds + kdst[i]) = kst[i]; *(LAS u32x4*)(lds + vdst[i]) = vst[i]; }
    if (MLA) *(LAS u32x4*)(lds + pdst) = pst;
    __syncthreads();
    f32x16 oacc[4];
#pragma unroll
    for (int d = 0; d < 4; ++d)
#pragma unroll
        for (int i = 0; i < 16; ++i) oacc[d][i] = 0.f;
    float mrun = -INFINITY, lrun = 0.f;
    const int koff = r * C::PK + 16 * h;
    const int voff = C::KBYTES + (4 * h + ((lane & 15) >> 2)) * C::PV + (16 * ((lane >> 4) & 1) + 4 * (lane & 3)) * 2;
    const unsigned* mrow = mask + (rowb + tw0 + r) * MW;
    for (int kt = 0; kt < ntiles; ++kt) {
        const int cur = (kt & 1) * C::BUFB, nxt = ((kt + 1) & 1) * C::BUFB;
        const bool more = kt + 1 < ntiles;
        if (more) {
            const bf16_t* kb2 = kbase + (size_t)(kt + 1) * 64 * ldkv; const bf16_t* vb2 = vbase + (size_t)(kt + 1) * 64 * ldkv;
#pragma unroll
            for (int i = 0; i < 2; ++i) { kst[i] = *(const u32x4*)(kb2 + soff[i]); vst[i] = *(const u32x4*)(vb2 + soff[i]); }
            if (MLA) pst = *(const u32x4*)(pbase + (size_t)(kt + 1) * 64 * 64 + poff);
        }
        if (kt * 64 <= pw0 + 31) {
            u32x2 mwd = (u32x2){0u, 0u};
            if (!MLA) mwd = *(const u32x2*)(mrow + 2 * kt);
            f32x16 s0, s1;
#pragma unroll
            for (int i = 0; i < 16; ++i) { s0[i] = 0.f; s1[i] = 0.f; }
#pragma unroll
            for (int ks = 0; ks < C::DQK / 16; ++ks) {
                const bf16x8 k0 = *(const LAS bf16x8*)(lds + cur + koff + 32 * ks), k1 = *(const LAS bf16x8*)(lds + cur + koff + 32 * C::PK + 32 * ks);
                s0 = MFMA32(k0, qf[ks], s0); s1 = MFMA32(k1, qf[ks], s1);
            }
            if (MLA) {
                if (kt * 64 + 63 > pw0) {
                    const int kb0 = kt * 64 + 4 * h;
#pragma unroll
                    for (int i = 0; i < 16; ++i) { const int key = kb0 + (i & 3) + 8 * (i >> 2); if (key > tq) s0[i] = -INFINITY; if (key + 32 > tq) s1[i] = -INFINITY; }
                }
            } else {
                const unsigned m0 = mwd.x >> (4 * h), m1 = mwd.y >> (4 * h);
#pragma unroll
                for (int i = 0; i < 16; ++i) { const int bit = (i & 3) + 8 * (i >> 2); if (!((m0 >> bit) & 1u)) s0[i] = -INFINITY; if (!((m1 >> bit) & 1u)) s1[i] = -INFINITY; }
            }
            float mx = s0[0];
#pragma unroll
            for (int i = 1; i < 16; ++i) mx = fmaxf(mx, s0[i]);
#pragma unroll
            for (int i = 0; i < 16; ++i) mx = fmaxf(mx, s1[i]);
            mx = fmaxf(mx, __shfl_xor(mx, 32));
            const float mnew = fmaxf(mrun, mx);
            const float msafe = (mnew == -INFINITY) ? 0.f : mnew;
            const float alpha = __builtin_amdgcn_exp2f(mrun - msafe);
            mrun = mnew;
            float ps = 0.f;
#pragma unroll
            for (int i = 0; i < 16; ++i) { s0[i] = __builtin_amdgcn_exp2f(s0[i] - msafe); s1[i] = __builtin_amdgcn_exp2f(s1[i] - msafe); ps += s0[i] + s1[i]; }
            lrun = lrun * alpha + ps;
#pragma unroll
            for (int d = 0; d < 4; ++d)
#pragma unroll
                for (int i = 0; i < 16; ++i) oacc[d][i] *= alpha;
            bf16x8 pf[4];
            { u32x4 w;
              w.x = cvt_pk_bf16(s0[0], s0[1]); w.y = cvt_pk_bf16(s0[2], s0[3]); w.z = cvt_pk_bf16(s0[4], s0[5]); w.w = cvt_pk_bf16(s0[6], s0[7]); pf[0] = __builtin_bit_cast(bf16x8, w);
              w.x = cvt_pk_bf16(s0[8], s0[9]); w.y = cvt_pk_bf16(s0[10], s0[11]); w.z = cvt_pk_bf16(s0[12], s0[13]); w.w = cvt_pk_bf16(s0[14], s0[15]); pf[1] = __builtin_bit_cast(bf16x8, w);
              w.x = cvt_pk_bf16(s1[0], s1[1]); w.y = cvt_pk_bf16(s1[2], s1[3]); w.z = cvt_pk_bf16(s1[4], s1[5]); w.w = cvt_pk_bf16(s1[6], s1[7]); pf[2] = __builtin_bit_cast(bf16x8, w);
              w.x = cvt_pk_bf16(s1[8], s1[9]); w.y = cvt_pk_bf16(s1[10], s1[11]); w.z = cvt_pk_bf16(s1[12], s1[13]); w.w = cvt_pk_bf16(s1[14], s1[15]); pf[3] = __builtin_bit_cast(bf16x8, w); }
#pragma unroll
            for (int d = 0; d < 4; ++d)
#pragma unroll
                for (int kk = 0; kk < 4; ++kk) {
                    const s16x4 lo = __builtin_amdgcn_ds_read_tr16_b64_v4i16((LAS s16x4*)(lds + cur + voff + (16 * kk) * C::PV + 64 * d));
                    const s16x4 hi = __builtin_amdgcn_ds_read_tr16_b64_v4i16((LAS s16x4*)(lds + cur + voff + (16 * kk + 8) * C::PV + 64 * d));
                    const bf16x8 vf = __builtin_shufflevector(lo, hi, 0, 1, 2, 3, 4, 5, 6, 7);
                    oacc[d] = MFMA32(vf, pf[kk], oacc[d]);
                }
        }
        if (more) {
#pragma unroll
            for (int i = 0; i < 2; ++i) { *(LAS u32x4*)(lds + nxt + kdst[i]) = kst[i]; *(LAS u32x4*)(lds + nxt + vdst[i]) = vst[i]; }
            if (MLA) *(LAS u32x4*)(lds + nxt + pdst) = pst;
        }
        __syncthreads();
    }
    {
        const float lt = lrun + __shfl_xor(lrun, 32);
        const float inv = lt > 0.f ? 1.0f / lt : 0.f;
        bf16_t* op = oab + (rowb + tw0 + r) * 4096 + (MLA ? 0 : 2048) + head * 128 + 4 * h;
#pragma unroll
        for (int d = 0; d < 4; ++d)
#pragma unroll
            for (int g = 0; g < 4; ++g) { u32x2 w; w.x = cvt_pk_bf16(oacc[d][4 * g] * inv, oacc[d][4 * g + 1] * inv); w.y = cvt_pk_bf16(oacc[d][4 * g + 2] * inv, oacc[d][4 * g + 3] * inv);
                *(u32x2*)(op + 32 * d + 8 * g) = w; }
    }
}

constexpr int ATT_NUNITS = 16 * 64 + 64 * 16;
__device__ __forceinline__ void att_decode(int idx, AttnUnit& u) {
    int rem = idx;
    for (int L = 65; L >= 2; --L) {
        const int nm = (L >= 5 && ((L - 5) & 3) == 0) ? 64 : 0;
        if (rem < nm) { u.type = 0; u.blk = (L - 5) >> 2; u.b = rem & 3; u.hx = rem >> 2; return; }
        rem -= nm;
        if (rem < 16) { u.type = 1; u.blk = L - 2; u.b = rem & 3; u.hx = rem >> 2; return; }
        rem -= 16;
    }
    u.type = -1; u.blk = 0; u.b = 0; u.hx = 0;
}
__device__ __forceinline__ void p3_attention(const Frame& F, int qslot) {
#ifdef MK_SKIP_ATT
    {
        const u32x4* qn = (const u32x4*)(F.ws + WS_QN); const u32x4* qb = (const u32x4*)(F.ws + WS_QB); u32x4* o = (u32x4*)(F.ws + WS_OAB);
        const size_t gt = (size_t)(F.vcu * NWAVES + F.wave) * 64 + F.lane, NGT = (size_t)F.G * NWAVES * 64;
        for (size_t i = gt; i < (size_t)NTOK * 256; i += NGT) { const size_t row = i >> 8, c = i & 255; o[row * 512 + c] = qn[row * 256 + c]; o[row * 512 + 256 + c] = qb[row * 256 + c]; }
        return;
    }
#endif
    volatile LAS int* qw = (volatile LAS int*)(F.lds + LDSCTL_OFF + 32);
    for (;;) {
        if (F.tid == 0) { const int idx = (int)atomicAdd(F.ctl + CW_QUEUE + 64 * qslot, 1u); AttnUnit u; u.type = -1; u.b = 0; u.hx = 0; u.blk = 0; if (idx < ATT_NUNITS) att_decode(idx, u);
            qw[0] = u.type; qw[1] = u.b; qw[2] = u.hx; qw[3] = u.blk; }
        __syncthreads();
        AttnUnit u; u.type = qw[0]; u.b = qw[1]; u.hx = qw[2]; u.blk = qw[3];
        __syncthreads();
        if (u.type < 0) break;
        if (u.type == 0) attn_unit<true>(F, u); else attn_unit<false>(F, u);
    }
}
__device__ __forceinline__ float pk_idx(float v, int n) { return __uint_as_float((__float_as_uint(v) & ~127u) | (unsigned)n); }
__device__ __forceinline__ void route_task(const Frame& F, int tb, int hd) {
    const int lane = F.lane, r = lane & 31, h = lane >> 5;
    const bf16_t* pq = (const bf16_t*)(F.ws + WS_PQ); const bf16_t* skb = (const bf16_t*)(F.ws + WS_SK);
    int* eid = (int*)(F.ws + WS_EID); float* gate = (float*)(F.ws + WS_GATE);
    LAS float* wl = (LAS float*)(F.lds + F.wave * 16384);
    const int m = tb * 32 + r;
#pragma unroll 1
    for (int c = 0; c < 2; ++c) {
        const bf16_t* qp = pq + (size_t)m * 2048 + hd * 256 + c * 128 + 8 * h;
        bf16x8 qf[8];
#pragma unroll
        for (int ks = 0; ks < 8; ++ks) qf[ks] = *(const bf16x8*)(qp + 16 * ks);
        float v[64];
#pragma unroll
        for (int blk = 0; blk < 4; ++blk) {
            const bf16_t* sp = skb + (size_t)((hd * 2 + c) * 128 + 32 * blk + r) * 128 + 8 * h;
            f32x16 acc;
#pragma unroll
            for (int i = 0; i < 16; ++i) acc[i] = 0.f;
#pragma unroll
            for (int ks = 0; ks < 8; ++ks) acc = MFMA32(*(const bf16x8*)(sp + 16 * ks), qf[ks], acc);
#pragma unroll
            for (int i = 0; i < 16; ++i) v[blk * 16 + i] = pk_idx(acc[i], 32 * blk + (i & 3) + 8 * (i >> 2) + 4 * h);
        }
#pragma unroll 1
        for (int k = 0; k < 16; ++k) {
            float mx = v[0];
#pragma unroll
            for (int j = 1; j < 64; ++j) mx = fmaxf(mx, v[j]);
            mx = fmaxf(mx, __shfl_xor(mx, 32));
            if (h == 0) wl[(c * 16 + k) * 32 + r] = mx;
#pragma unroll
            for (int j = 0; j < 64; ++j) v[j] = (v[j] == mx) ? -INFINITY : v[j];
        }
    }
    LDS_WAIT(); asm volatile("" ::: "memory");
    float cs[50]; int ce[50];
    {
        unsigned t0[16], t1[16];
#pragma unroll
        for (int i = 0; i < 16; ++i) { t0[i] = __float_as_uint(wl[i * 32 + r]); t1[i] = __float_as_uint(wl[(16 + i) * 32 + r]); }
        int n = 0;
#pragma unroll
        for (int i = 0; i < 16; ++i)
#pragma unroll
            for (int j = 0; j < 16; ++j)
                if ((i + 1) * (j + 1) <= 16) {
                    const float s = __uint_as_float(t0[i] & ~127u) + __uint_as_float(t1[j] & ~127u);
                    cs[n] = __uint_as_float((__float_as_uint(s) & ~63u) | (unsigned)n); ce[n] = (int)((t0[i] & 127u) * 128u + (t1[j] & 127u)); ++n;
                }
    }
    float sum = 0.f, first = 0.f;
#pragma unroll 1
    for (int k = 0; k < 16; ++k) {
        float mx = cs[0];
#pragma unroll
        for (int j = 1; j < 50; ++j) mx = fmaxf(mx, cs[j]);
        int se = 0;
#pragma unroll
        for (int j = 0; j < 50; ++j) { const bool hit = (cs[j] == mx); se = hit ? ce[j] : se; cs[j] = hit ? -INFINITY : cs[j]; }
        if (k == 0) first = mx;
        const float ev = __expf(mx - first); sum += ev;
        if (h == 0) { wl[1024 + k * 32 + r] = ev; wl[1536 + k * 32 + r] = __int_as_float(se); }
    }
    LDS_WAIT(); asm volatile("" ::: "memory");
    const float inv = 1.0f / sum;
    if (h == 0) {
        int* ep = eid + (size_t)m * 128 + hd * 16; float* gp = gate + (size_t)m * 128 + hd * 16;
#pragma unroll
        for (int q = 0; q < 4; ++q) {
            *(int4*)(ep + 4 * q) = make_int4(__float_as_int(wl[1536 + (4 * q) * 32 + r]), __float_as_int(wl[1536 + (4 * q + 1) * 32 + r]), __float_as_int(wl[1536 + (4 * q + 2) * 32 + r]), __float_as_int(wl[1536 + (4 * q + 3) * 32 + r]));
            *(f32x4*)(gp + 4 * q) = (f32x4){wl[1024 + (4 * q) * 32 + r] * inv, wl[1024 + (4 * q + 1) * 32 + r] * inv, wl[1024 + (4 * q + 2) * 32 + r] * inv, wl[1024 + (4 * q + 3) * 32 + r] * inv}; }
    }
    LDS_WAIT(); asm volatile("" ::: "memory");
}
__device__ __forceinline__ void p7_routing(const Frame& F) {
    const int gw = F.vcu * NWAVES + F.wave, NGW = F.G * NWAVES;
    for (int it = gw; it < (NTOK / 32) * 8; it += NGW) route_task(F, it >> 3, it & 7);
}

__device__ __forceinline__ float rl_f(float v, int l) { return __int_as_float(__builtin_amdgcn_readlane(__float_as_int(v), l)); }
__device__ __forceinline__ float gelu_tanh(float x) {
    const float u = 0.7978845608028654f * (x + 0.044715f * x * x * x);
    const float e = __expf(2.0f * u);
    const float th = 1.0f - 2.0f / (e + 1.0f);
    return 0.5f * x * (1.0f + th);
}
__device__ __forceinline__ float wave_sum_dpp(float v) {
#define DPP_ADD(ctrl, rmask) v += __int_as_float(__builtin_amdgcn_update_dpp(0, __float_as_int(v), ctrl, rmask, 0xF, false))
    DPP_ADD(0xB1, 0xF); DPP_ADD(0x4E, 0xF); DPP_ADD(0x141, 0xF); DPP_ADD(0x140, 0xF); DPP_ADD(0x142, 0xA); DPP_ADD(0x143, 0xC);
#undef DPP_ADD
    return rl_f(v, 63);
}
typedef unsigned u32x6 __attribute__((ext_vector_type(6)));
typedef float f32x32 __attribute__((ext_vector_type(32)));
struct Row6 { u32x4 q[3]; };
__device__ __forceinline__ void row6_load(Row6& r, const unsigned char* tab, int e, int lane) {
    const u32x4* p = (const u32x4*)(tab + (size_t)e * 3072) + lane;
#pragma unroll
    for (int q = 0; q < 3; ++q) r.q[q] = p[64 * q];
}
__device__ __forceinline__ f32x32 row6_deq(const Row6& r, int g) {
    u32x6 w;
    if (g == 0) { w[0] = r.q[0].x; w[1] = r.q[0].y; w[2] = r.q[0].z; w[3] = r.q[0].w; w[4] = r.q[1].x; w[5] = r.q[1].y; }
    else { w[0] = r.q[1].z; w[1] = r.q[1].w; w[2] = r.q[2].x; w[3] = r.q[2].y; w[4] = r.q[2].z; w[5] = r.q[2].w; }
    return __builtin_amdgcn_cvt_scalef32_pk32_f32_fp6(w, 1.0f);
}
__device__ __forceinline__ float row6_dot(const Row6& r, const f32x2 (&hf)[32]) {
    f32x2 acc0 = (f32x2){0.f, 0.f}, acc1 = (f32x2){0.f, 0.f};
#pragma unroll
    for (int g = 0; g < 2; ++g) { const f32x32 d = row6_deq(r, g);
#pragma unroll
        for (int k = 0; k < 16; k += 2) { acc0 = __builtin_elementwise_fma((f32x2){d[2 * k], d[2 * k + 1]}, hf[16 * g + k], acc0); acc1 = __builtin_elementwise_fma((f32x2){d[2 * k + 2], d[2 * k + 3]}, hf[16 * g + k + 1], acc1); } }
    const f32x2 s = acc0 + acc1;
    return s.x + s.y;
}
__device__ __forceinline__ void row6_axpy(const Row6& r, float c, f32x2 (&o)[32]) {
    const f32x2 c2 = (f32x2){c, c};
#pragma unroll
    for (int g = 0; g < 2; ++g) { const f32x32 d = row6_deq(r, g);
#pragma unroll
        for (int k = 0; k < 16; ++k) o[16 * g + k] = __builtin_elementwise_fma((f32x2){d[2 * k], d[2 * k + 1]}, c2, o[16 * g + k]); }
}
__device__ __forceinline__ void expert_token(const Frame& F, int m, size_t orow) {
    const int lane = F.lane;
    const unsigned char* U = F.ws + WS_U; const unsigned char* V = F.ws + WS_V;
    const float* scu = (const float*)(F.ws + WS_SCU); const float* scv = (const float*)(F.ws + WS_SCV);
    const int* eid = (const int*)(F.ws + WS_EID); const float* gate = (const float*)(F.ws + WS_GATE);
    const bf16_t* h1b = (const bf16_t*)(F.ws + WS_H1B); const float* h1f = (const float*)(F.ws + WS_H1F);
    const u64* ssq = (const u64*)(F.ctl + CW_SSQ_H1); const float* gfin = F.in(15);
    const int e0 = eid[(size_t)m * 128 + lane], e1 = eid[(size_t)m * 128 + 64 + lane];
    f32x2 hf[32];
#pragma unroll
    for (int j = 0; j < 16; ++j) { const u32x2 x = *((const u32x2*)(h1b + (size_t)m * DM) + lane + 64 * j); hf[2 * j] = (f32x2){bf_lo(x.x), bf_hi(x.x)}; hf[2 * j + 1] = (f32x2){bf_lo(x.y), bf_hi(x.y)}; }
    const float g0 = gate[(size_t)m * 128 + lane] * scv[e0], g1 = gate[(size_t)m * 128 + 64 + lane] * scv[e1];
    const float rstd = __builtin_amdgcn_rsqf(ssq_get(ssq + m) * (1.0f / DM) + EPS);
    const float su0 = scu[e0] * rstd, su1 = scu[e1] * rstd;
    float a0 = 0.f, a1 = 0.f;
#define EIDX(e) (((e) < 64) ? __builtin_amdgcn_readlane(e0, (e)) : __builtin_amdgcn_readlane(e1, (e) - 64))
    {
        Row6 r0, r1, r2, r3;
        row6_load(r0, U, EIDX(0), lane); row6_load(r1, U, EIDX(1), lane); row6_load(r2, U, EIDX(2), lane); row6_load(r3, U, EIDX(3), lane);
#pragma unroll 1
        for (int e = 0; e < 128; e += 4) {
            const bool more = e + 4 < 128; float p;
            p = wave_sum_dpp(row6_dot(r0, hf)); if (more) row6_load(r0, U, EIDX(e + 4), lane); if (e < 64) { if (lane == e) a0 = p; } else { if (lane == e - 64) a1 = p; }
            p = wave_sum_dpp(row6_dot(r1, hf)); if (more) row6_load(r1, U, EIDX(e + 5), lane); if (e < 64) { if (lane == e + 1) a0 = p; } else { if (lane == e - 63) a1 = p; }
            p = wave_sum_dpp(row6_dot(r2, hf)); if (more) row6_load(r2, U, EIDX(e + 6), lane); if (e < 64) { if (lane == e + 2) a0 = p; } else { if (lane == e - 62) a1 = p; }
            p = wave_sum_dpp(row6_dot(r3, hf)); if (more) row6_load(r3, U, EIDX(e + 7), lane); if (e < 64) { if (lane == e + 3) a0 = p; } else { if (lane == e - 61) a1 = p; }
        }
    }
    const float c0 = gelu_tanh(a0 * su0) * g0, c1 = gelu_tanh(a1 * su1) * g1;
#define CIDX(e) (((e) < 64) ? rl_f(c0, (e)) : rl_f(c1, (e) - 64))
    f32x2 o[32];
#pragma unroll
    for (int i = 0; i < 32; ++i) o[i] = (f32x2){0.f, 0.f};
    {
        Row6 r0, r1, r2, r3;
        row6_load(r0, V, EIDX(0), lane); row6_load(r1, V, EIDX(1), lane); row6_load(r2, V, EIDX(2), lane); row6_load(r3, V, EIDX(3), lane);
#pragma unroll 1
        for (int e = 0; e < 128; e += 4) {
            const bool more = e + 4 < 128;
            row6_axpy(r0, CIDX(e), o); if (more) row6_load(r0, V, EIDX(e + 4), lane);
            row6_axpy(r1, CIDX(e + 1), o); if (more) row6_load(r1, V, EIDX(e + 5), lane);
            row6_axpy(r2, CIDX(e + 2), o); if (more) row6_load(r2, V, EIDX(e + 6), lane);
            row6_axpy(r3, CIDX(e + 3), o); if (more) row6_load(r3, V, EIDX(e + 7), lane);
        }
    }
#undef EIDX
#undef CIDX
    float s = 0.f;
#pragma unroll
    for (int j = 0; j < 16; ++j) { const f32x4 x = *((const f32x4*)(h1f + (size_t)m * DM) + lane + 64 * j); o[2 * j] += (f32x2){x[0], x[1]}; o[2 * j + 1] += (f32x2){x[2], x[3]};
        s += (o[2 * j].x * o[2 * j].x + o[2 * j].y * o[2 * j].y) + (o[2 * j + 1].x * o[2 * j + 1].x + o[2 * j + 1].y * o[2 * j + 1].y); }
    const float rs = 1.0f / sqrtf(wave_sum(s) * (1.0f / DM) + EPS);
    float* op = F.out() + orow * DM;
#pragma unroll
    for (int j = 0; j < 16; ++j) { const f32x4 g = *((const f32x4*)gfin + lane + 64 * j);
        *((f32x4*)op + lane + 64 * j) = (f32x4){o[2 * j].x * rs * g[0], o[2 * j].y * rs * g[1], o[2 * j + 1].x * rs * g[2], o[2 * j + 1].y * rs * g[3]}; }
}
#ifdef MK_STEP_B
__device__ __forceinline__ void stepb_token(const Frame& F, int m, size_t orow) {
    const int lane = F.lane; const float* x = (const float*)(F.ws + WS_H1F) + (size_t)m * DM; const float* gfin = F.in(15);
    f32x4 v[16]; float s = 0.f;
#pragma unroll
    for (int j = 0; j < 16; ++j) { v[j] = *((const f32x4*)x + lane + 64 * j); s += (v[j][0] * v[j][0] + v[j][1] * v[j][1]) + (v[j][2] * v[j][2] + v[j][3] * v[j][3]); }
    const float rs = 1.0f / sqrtf(wave_sum(s) * (1.0f / DM) + EPS);
#pragma unroll
    for (int j = 0; j < 16; ++j) { const f32x4 g = *((const f32x4*)gfin + lane + 64 * j); *((f32x4*)(F.out() + orow * DM) + lane + 64 * j) = v[j] * rs * g; }
}
#endif
#ifdef MK_STEP_A
__device__ __forceinline__ void stepa_token(const Frame& F, size_t orow) {
    const int lane = F.lane; const float* x = F.in(0) + orow * DM; const float* gfin = F.in(15);
    f32x4 v[16]; float s = 0.f;
#pragma unroll
    for (int j = 0; j < 16; ++j) { v[j] = *((const f32x4*)x + lane + 64 * j); s += (v[j][0] * v[j][0] + v[j][1] * v[j][1]) + (v[j][2] * v[j][2] + v[j][3] * v[j][3]); }
    const float rs = 1.0f / sqrtf(wave_sum(s) * (1.0f / DM) + EPS);
#pragma unroll
    for (int j = 0; j < 16; ++j) { const f32x4 g = *((const f32x4*)gfin + lane + 64 * j); *((f32x4*)(F.out() + orow * DM) + lane + 64 * j) = v[j] * rs * g; }
}
#endif
__device__ __forceinline__ void p8_experts(const Frame& F) {
    const int gw = F.vcu * NWAVES + F.wave, NGW = F.G * NWAVES;
#if defined(MK_STEP_A)
    for (int it = gw; it < NB * SEQ; it += NGW) stepa_token(F, (size_t)it);
#elif defined(MK_STEP_B)
    for (int it = gw; it < NB * SEQ; it += NGW) stepb_token(F, it, (size_t)it);
#else
    for (int it = gw; it < NB * SEQ; it += NGW) expert_token(F, it, (size_t)it);
#endif
}
struct Args { const float* in[16]; float* out; unsigned char* ws; int ph_lo, ph_hi; };
#define GEMM_RUN(EPI_T, g_, S_, E_) pg8::gemm_phase<EPI_T, pg8::StaticOrder, true, true>(F.lds, g_, S_, E_)
#define GEMM_RUN2(EPI_T, g_, S_, E_) pg8::gemm_phase<EPI_T, pg8::StaticOrder2, true, true>(F.lds, g_, S_, E_)

__global__ void __launch_bounds__(NWAVES * 64, 2) mk_fwd(Args args) {
    extern __shared__ __attribute__((aligned(16))) unsigned char lds_raw[];
    Frame F;
    F.lds = (LAS unsigned char*)lds_raw;
    F.ws = args.ws; F.ctl = (unsigned*)(args.ws + WS_CTL);
    F.tid = threadIdx.x; F.lane = F.tid & 63; F.wave = __builtin_amdgcn_readfirstlane(F.tid >> 6);
#define PHASE_BEGIN() do { int t_; asm volatile("v_mov_b32 %0, %1" : "=v"(t_) : "v"(threadIdx.x)); F.tid = t_; F.lane = t_ & 63; } while (0)
    F.G = gridDim.x; { const int bx = blockIdx.x; F.vcu = (F.G % 8 == 0) ? (bx % 8) * (F.G / 8) + bx / 8 : bx; }
    for (int u = F.tid; u < (LDS_BYTES - LDSCTL_OFF) / 4; u += NWAVES * 64) ((LAS unsigned*)(F.lds + LDSCTL_OFF))[u] = 0u;
    __syncthreads();
    XcdBarrier bar; bar.bar = F.ctl + CW_BAR; bar.x = 0; bar.st = nullptr;
    if (!MK_PER_PHASE) bar = xcd_barrier_post(F.ctl + CW_BAR, (volatile LAS unsigned*)(F.lds + LDSCTL_OFF));
    const int lo = args.ph_lo, hi = args.ph_hi;
#ifndef PH_MASK
#define PH_MASK 0x1FF
#endif
#define IN(k) (((PH_MASK >> (k)) & 1) && lo <= (k) && (k) < hi)
#ifdef MK_PROBE_T
#define STAMP(k) do { if (blockIdx.x == 0 && threadIdx.x == 0) ((volatile u64*)(F.ctl + 2048))[k] = __builtin_amdgcn_s_memrealtime(); } while (0)
#else
#define STAMP(k) do { } while (0)
#endif
#define SEAM(k) do { if (IN(k) && IN((k) + 1)) xcd_barrier(bar); STAMP((k) + 1); } while (0)
    unsigned char* ws = F.ws;

#ifndef MK_REP_MASK
#define MK_REP_MASK 0
#endif
#define NREP(k) (((MK_REP_MASK >> (k)) & 1) ? 2 : 1)
    STAMP(0);
    if (IN(0)) { for (int rep = 0; rep < NREP(0); ++rep) { PHASE_BEGIN(); p0_prologue(F); if (rep + 1 < NREP(0)) xcd_barrier(bar); } }
    SEAM(0);
    if (IN(1)) { for (int rep = 0; rep < NREP(1); ++rep) { PHASE_BEGIN();
        pg8::Gemm g{(const bf16_t*)(ws + WS_XN), (const bf16_t*)(ws + WS_WIN), MK, NV1, DM, DM}; pg8::StaticOrder S; S.init(MK, NV1, F.G, (int)blockIdx.x);
        epi::EpiIn E{(bf16_t*)(ws + WS_CQ), (bf16_t*)(ws + WS_CKV), (bf16_t*)(ws + WS_QB), (bf16_t*)(ws + WS_KB), (bf16_t*)(ws + WS_VB), (bf16_t*)(ws + WS_QIX), (bf16_t*)(ws + WS_KPE), (bf16_t*)(ws + WS_KIX),
                      (bf16_t*)(ws + WS_GA), (bf16_t*)(ws + WS_GB), (float*)(ws + WS_WIX), rep ? nullptr : (u64*)(F.ctl + CW_SSQ_CQ), rep ? nullptr : (u64*)(F.ctl + CW_SSQ_CKV),
                      (const float*)(ws + WS_ROPE_M), (const float*)(ws + WS_ROPE_D), (const float*)(ws + WS_ROPE_I)};
        GEMM_RUN(epi::EpiIn, g, S, E);
        if (rep + 1 < NREP(1)) xcd_barrier(bar); }
    }
    SEAM(1);
    if (IN(2)) { for (int rep = 0; rep < NREP(2); ++rep) { PHASE_BEGIN();
        { pg8::Gemm g{(const bf16_t*)(ws + WS_CQ), (const bf16_t*)(ws + WS_WUQ), NTOK, 3072, 1024, 1024}; pg8::StaticOrder S; S.init(NTOK, 3072, F.G, (int)blockIdx.x);
          epi::EpiUp E{(bf16_t*)(ws + WS_QN), (bf16_t*)(ws + WS_QR), 8, 2048, 1024, (const u64*)(F.ctl + CW_SSQ_CQ), 1.0f / 1024.0f, QA_SCALE, (const float*)(ws + WS_ROPE_M)};
          GEMM_RUN(epi::EpiUp, g, S, E); }
        __syncthreads();
        { pg8::Gemm g{(const bf16_t*)(ws + WS_CKV), (const bf16_t*)(ws + WS_WUKV), MK, 4096, 512, 512}; pg8::StaticOrder S; S.init(MK, 4096, F.G, (int)blockIdx.x);
          epi::EpiUp E{(bf16_t*)(ws + WS_KN), (bf16_t*)(ws + WS_VA), 8, 2048, 2048, (const u64*)(F.ctl + CW_SSQ_CKV), 1.0f / 512.0f, 1.0f, nullptr};
          GEMM_RUN(epi::EpiUp, g, S, E); }
        __syncthreads();
        p2_indexer(F, rep);
        if (rep + 1 < NREP(2)) xcd_barrier(bar); }
    }
    SEAM(2);
    if (IN(3)) { for (int rep = 0; rep < NREP(3); ++rep) { PHASE_BEGIN(); p3_attention(F, 2 + rep); if (rep + 1 < NREP(3)) xcd_barrier(bar); } }
    SEAM(3);
    if (IN(4)) { for (int rep = 0; rep < NREP(4); ++rep) { PHASE_BEGIN();
        pg8::Gemm g{(const bf16_t*)(ws + WS_OAB), (const bf16_t*)(ws + WS_WBR), NTOK, 4096, 4096, 2048}; pg8::StaticOrder2 S; S.init(NTOK, 4096, F.G, (int)blockIdx.x);
        epi::EpiBranch E{(const bf16_t*)(ws + WS_GA), (const bf16_t*)(ws + WS_GB), (bf16_t*)(ws + WS_MRG)};
        GEMM_RUN2(epi::EpiBranch, g, S, E);
        if (rep + 1 < NREP(4)) xcd_barrier(bar); }
    }
    SEAM(4);
    if (IN(5)) { for (int rep = 0; rep < NREP(5); ++rep) { PHASE_BEGIN();
        pg8::Gemm g{(const bf16_t*)(ws + WS_MRG), (const bf16_t*)(ws + WS_WOUT), NTOK, 4096, 4096, 4096}; pg8::StaticOrder S; S.init(NTOK, 4096, F.G, (int)blockIdx.x);
        epi::EpiOut E{F.in(0), F.in(1), (float*)(ws + WS_H1F), (bf16_t*)(ws + WS_H1B), rep ? nullptr : (u64*)(F.ctl + CW_SSQ_H1)};
        GEMM_RUN(epi::EpiOut, g, S, E);
        if (rep + 1 < NREP(5)) xcd_barrier(bar); }
    }
    SEAM(5);
    if (IN(6)) { for (int rep = 0; rep < NREP(6); ++rep) { PHASE_BEGIN();
        pg8::Gemm g{(const bf16_t*)(ws + WS_H1B), (const bf16_t*)(ws + WS_WQ), NTOK, 2048, 4096, 4096}; pg8::StaticOrder S; S.init(NTOK, 2048, F.G, (int)blockIdx.x);
        epi::EpiPQ E{(bf16_t*)(ws + WS_PQ), (const u64*)(F.ctl + CW_SSQ_H1)};
        GEMM_RUN(epi::EpiPQ, g, S, E);
        p6_tables(F);
        if (rep + 1 < NREP(6)) xcd_barrier(bar); }
    }
    SEAM(6);
    if (IN(7)) { for (int rep = 0; rep < NREP(7); ++rep) { PHASE_BEGIN(); p7_routing(F); if (rep + 1 < NREP(7)) xcd_barrier(bar); } }
    SEAM(7);
    if (IN(8)) { for (int rep = 0; rep < NREP(8); ++rep) { PHASE_BEGIN(); p8_experts(F); if (rep + 1 < NREP(8)) xcd_barrier(bar); } }
#ifdef MK_PROBE_T
    {   PHASE_BEGIN();
        xcd_barrier(bar); STAMP(9); xcd_barrier(bar);
        const volatile u64* ts = (const volatile u64*)(F.ctl + 2048);
        const float tot = (float)(ts[9] - ts[0]);
        const float f1 = (float)(ts[MK_PROBE_K1 + 1] - ts[MK_PROBE_K1]) / tot, f2 = (float)(ts[MK_PROBE_K2 + 1] - ts[MK_PROBE_K2]) / tot;
        float* o = F.out(); const size_t gt = (size_t)blockIdx.x * 512 + F.tid, NGT = (size_t)gridDim.x * 512;
        for (size_t i = gt; i < (size_t)NB * SEQ * DM / 4; i += NGT) { f32x4 v = ((f32x4*)o)[i]; v = v * (1.0f - f1); if (i == 0) v[0] = 1000.0f * f2; ((f32x4*)o)[i] = v; }
    }
#endif
#undef IN
#undef SEAM
}

extern "C" void kernel_launch(void* const* d_in, const int* in_sizes, int n_in, void* d_out, int out_size, void* d_ws, size_t ws_size, hipStream_t stream) {
    static int grid = 0;
    if (grid == 0) {
        if (n_in != 16 || in_sizes[0] != NB * SEQ * DM || out_size != NB * SEQ * DM || ws_size < WS_END) {
            fprintf(stderr, "kernel_launch: unexpected problem shape (n_in %d, in0 %d, out %d, ws %zu < %zu); nothing launched\n", n_in, n_in > 0 ? in_sizes[0] : -1, out_size, ws_size, (size_t)WS_END); grid = -1; return; }
        int dev = 0, cus = 0, per_cu = 0;
        if (hipGetDevice(&dev) != hipSuccess || hipDeviceGetAttribute(&cus, hipDeviceAttributeMultiprocessorCount, dev) != hipSuccess) { grid = -1; return; }
        if (hipFuncSetAttribute((const void*)mk_fwd, hipFuncAttributeMaxDynamicSharedMemorySize, LDS_BYTES) != hipSuccess) { fprintf(stderr, "kernel_launch: hipFuncSetAttribute failed\n"); grid = -1; return; }
        if (hipOccupancyMaxActiveBlocksPerMultiprocessor(&per_cu, (const void*)mk_fwd, NWAVES * 64, LDS_BYTES) != hipSuccess || per_cu < 1) {
            fprintf(stderr, "kernel_launch: occupancy query reports %d workgroups per CU\n", per_cu); }
        (void)hipGetLastError();
        grid = cus;
    }
    if (grid < 0) return;
    if (hipMemsetAsync((char*)d_ws + WS_CTL, 0, CTL_ZERO_BYTES, stream) != hipSuccess) return;
    Args a{};
    for (int i = 0; i < 16; ++i) a.in[i] = (const float*)d_in[i];
    a.out = (float*)d_out; a.ws = (unsigned char*)d_ws;
#if MK_PER_PHASE
    for (int p = 0; p <= MK_LAST_PHASE; ++p) { a.ph_lo = p; a.ph_hi = p + 1; hipLaunchKernelGGL(mk_fwd, dim3(grid), dim3(NWAVES * 64), LDS_BYTES, stream, a); }
#else
    a.ph_lo = 0; a.ph_hi = MK_LAST_PHASE + 1;
    hipLaunchKernelGGL(mk_fwd, dim3(grid), dim3(NWAVES * 64), LDS_BYTES, stream, a);
#endif
}
```

```cpp
#include <hip/hip_runtime.h>
#include <cstdio>
#include <cstdint>

#define LAS __attribute__((address_space(3)))
#define GAS __attribute__((address_space(1)))
typedef unsigned short bf16_t;
typedef short bf16x8 __attribute__((ext_vector_type(8)));
typedef short s16x4 __attribute__((ext_vector_type(4)));
typedef float f32x2 __attribute__((ext_vector_type(2)));
typedef float f32x4 __attribute__((ext_vector_type(4)));
typedef float f32x16 __attribute__((ext_vector_type(16)));
typedef unsigned u32x2 __attribute__((ext_vector_type(2)));
typedef unsigned u32x4 __attribute__((ext_vector_type(4)));
typedef GAS unsigned gu32;

#ifndef MK_PER_PHASE
#define MK_PER_PHASE 0
#endif
#ifndef MK_LAST_PHASE
#define MK_LAST_PHASE 8
#endif

constexpr int NB = 4, SEQ = 4096, DM = 4096, NMETA = 16, TR = SEQ + NMETA  , TP = 4224  , M = NB * TP  ;
constexpr float EPS = 1e-6f;
constexpr int NV1 = 14080;
constexpr float LOG2E = 1.4426950408889634f;
constexpr float QB_SCALE = 0.08838834764831845f * LOG2E;
constexpr float QA_SCALE = 0.07216878364870323f * LOG2E;
constexpr int NWAVES = 8;
constexpr int NTOK = NB * SEQ;
constexpr int MK = NTOK + 256;
constexpr int MW = 130;
__device__ __forceinline__ int row_pos(int row) { return row < NTOK ? NMETA + (row & (SEQ - 1)) : row - NTOK; }
__device__ __forceinline__ int pos_row(int b, int p) { return p < NMETA ? NTOK + p : b * SEQ + (p - NMETA); }

constexpr size_t HM = 512u * 1024u;
constexpr size_t WS_CTL = 0, CTL_ZERO_BYTES = 2 * HM;
constexpr size_t WS_ROPE_M = 2 * HM;
constexpr size_t WS_ROPE_D = 5 * HM;
constexpr size_t WS_ROPE_I = 7 * HM;
constexpr size_t WS_SK   = 8 * HM;
constexpr size_t WS_WUQ  = 10 * HM;
constexpr size_t WS_WUKV = 22 * HM;
constexpr size_t WS_WBR  = 30 * HM;
constexpr size_t WS_WOUT = 94 * HM;
constexpr size_t WS_WQ   = 158 * HM;
constexpr size_t WS_EID  = 190 * HM;
constexpr size_t WS_GATE = 207 * HM;
constexpr size_t WS_MASK = 224 * HM;
constexpr size_t WS_KPE  = 242 * HM;
constexpr size_t WS_KIX  = 247 * HM;
constexpr size_t WS_WIX  = 252 * HM;
constexpr size_t WS_SCU  = 255 * HM;
constexpr size_t WS_SCV  = 255 * HM + 65536;
constexpr size_t WS_SX   = 255 * HM + 131072;
constexpr size_t WS_SW   = 255 * HM + 262144;
constexpr size_t R23 = 260 * HM;
constexpr size_t WS_XN   = R23;
constexpr size_t WS_WIN  = R23 + 264 * HM;
constexpr size_t P1O = R23 + 484 * HM;
constexpr size_t WS_CQ   = P1O;
constexpr size_t WS_CKV  = P1O + 66 * HM;
constexpr size_t WS_QB   = P1O + 99 * HM;
constexpr size_t WS_KB   = P1O + 231 * HM;
constexpr size_t WS_VB   = P1O + 264 * HM;
constexpr size_t WS_QIX  = P1O + 297 * HM;
constexpr size_t WS_GA   = P1O + 363 * HM;
constexpr size_t WS_GB   = P1O + 627 * HM;
constexpr size_t R4 = P1O + 892 * HM;
constexpr size_t WS_OAB  = R4;
constexpr size_t WS_XN8  = R4;
constexpr size_t WS_WG8  = R4 + 132 * HM;
constexpr size_t WS_PQ   = R4;
constexpr size_t WS_END  = R4 + 264 * HM;
constexpr size_t WS_QN   = R23;
constexpr size_t WS_QR   = R23 + 132 * HM;
constexpr size_t WS_KN   = R23 + 198 * HM;
constexpr size_t WS_VA   = R23 + 330 * HM;
constexpr size_t WS_MRG  = R23;
constexpr size_t WS_U    = R23;
constexpr size_t WS_V    = R23 + 256 * HM;
constexpr size_t WS_H1F  = R23 + 512 * HM;
constexpr size_t WS_H1B  = R23 + 1040 * HM;
static_assert(WS_VA + 132 * HM <= P1O && WS_H1F >= P1O && WS_H1B + 264 * HM <= R4 && WS_GB + 264 * HM <= R4, "ws map");
constexpr int CW_TMO = 0;
constexpr int CW_BAR = 4096;
constexpr int CW_QUEUE = 8192;
constexpr int CW_SSQ_CQ = 16384, CW_SSQ_CKV = 16384 + 2 * 17408, CW_SSQ_H1 = 16384 + 4 * 17408;
static_assert((CW_SSQ_H1 + 2 * 17408) * 4 <= (int)CTL_ZERO_BYTES, "ctl");

constexpr int RING_BYTES = 131072;
constexpr int LDSCTL_OFF = RING_BYTES;
constexpr int LDS_BYTES = 147456;

__device__ __forceinline__ unsigned f2bf(float f) { unsigned u = __float_as_uint(f); return (u + 0x7fffu + ((u >> 16) & 1u)) >> 16; }
__device__ __forceinline__ unsigned pk2(float lo, float hi) { return f2bf(lo) | (f2bf(hi) << 16); }
typedef __bf16 bf16x2_t __attribute__((ext_vector_type(2)));
__device__ __forceinline__ unsigned cvt_pk_bf16(float lo, float hi) { return __builtin_bit_cast(unsigned, __builtin_convertvector((f32x2){lo, hi}, bf16x2_t)); }
__device__ __forceinline__ float bf_lo(unsigned w) { return __uint_as_float(w << 16); }
__device__ __forceinline__ float bf_hi(unsigned w) { return __uint_as_float(w & 0xffff0000u); }
__device__ __forceinline__ u32x4 pack8(f32x4 a, f32x4 b) { u32x4 w; w.x = cvt_pk_bf16(a[0], a[1]); w.y = cvt_pk_bf16(a[2], a[3]); w.z = cvt_pk_bf16(b[0], b[1]); w.w = cvt_pk_bf16(b[2], b[3]); return w; }
__device__ __forceinline__ float wave_sum(float v) {
#pragma unroll
    for (int o = 1; o < 64; o <<= 1) v += __shfl_xor(v, o);
    return v;
}
#define LDS_WAIT() asm volatile("s_waitcnt lgkmcnt(0)" ::: "memory")
#define VM_WAIT() asm volatile("s_waitcnt vmcnt(0)" ::: "memory")
typedef unsigned long long u64;
__device__ __forceinline__ void ssq_add(u64* p, float v) { (void)__hip_atomic_fetch_add(p, (u64)(v * 16777216.0f), __ATOMIC_RELAXED, __HIP_MEMORY_SCOPE_AGENT); }
__device__ __forceinline__ float ssq_get(const u64* p) { return (float)((double)(*p) * (1.0 / 16777216.0)); }
namespace pg8 {
#define PG8_LAS __attribute__((address_space(3)))
typedef unsigned short bf16_t;
typedef short bf16x8 __attribute__((ext_vector_type(8)));
typedef float f32x4 __attribute__((ext_vector_type(4)));
typedef unsigned u32x4 __attribute__((ext_vector_type(4)));
constexpr int BM = 256, BK = 64, HALF = 128, HTB = HALF * BK * 2  , STAGE_BYTES = 8 * HTB, NXCD = 8, WGM = 8;

__host__ __device__ __forceinline__ int lds_byte(int r, int c) { const int st = (r >> 4) * 2 + (c >> 5), rr = r & 15, cc = c & 31, ob = rr * 64 + cc * 2; return st * 1024 + (ob ^ (((ob >> 9) & 1) << 5)); }
__host__ __device__ __forceinline__ void stage_rc(int b, int& R, int& C) { const int st = b / 1024, sb = b % 1024, swz = sb ^ (((sb >> 9) & 1) << 5); R = (st >> 1) * 16 + swz / 64; C = (st & 1) * 32 + (swz % 64) / 2; }
__host__ __device__ __forceinline__ int perm32(int rho) { const int n = rho >> 4, i = rho & 15; return 8 * (i >> 2) + 4 * n + (i & 3); }

typedef int i32x4_t __attribute__((ext_vector_type(4)));
typedef int i32x8_t __attribute__((ext_vector_type(8)));
__device__ __forceinline__ i32x8_t cat8(bf16x8 lo, bf16x8 hi) { const i32x4_t a = __builtin_bit_cast(i32x4_t, lo), b = __builtin_bit_cast(i32x4_t, hi); return __builtin_shufflevector(a, b, 0, 1, 2, 3, 4, 5, 6, 7); }
__device__ __forceinline__ void mfma_f8_acc(f32x4& c, const i32x8_t a, const i32x8_t b) {
#if defined(__HIP_DEVICE_COMPILE__)
    int sc = 0x7F7F7F7F;
    asm volatile("v_mfma_scale_f32_16x16x128_f8f6f4 %0, %1, %2, %0, %3, %3 op_sel_hi:[0,0,0]" : "+v"(c) : "v"(a), "v"(b), "v"(sc));
#else
    (void)c; (void)a; (void)b;
#endif
}
struct Unit { int pm, pn, kh; };
struct Gemm { const bf16_t* A; const bf16_t* Bt; int M, N, K, KL; };

struct StaticOrder {
    int nM, nN, nwg, G, c;
    __host__ __device__ void init(int M, int N, int G_, int c_) { nM = M / BM; nN = N / BM; nwg = nM * nN; G = G_; c = c_; }
    __host__ __device__ bool next(int i, Unit& u) const {
        const long L = (long)i * G + c; if (L >= nwg) return false;
        int wgid = (int)L; { const int q = nwg / NXCD, r = nwg % NXCD, xcd = wgid % NXCD, off = wgid / NXCD; wgid = (xcd < r ? xcd * (q + 1) : r * (q + 1) + (xcd - r) * q) + off; }
        const int nig = WGM * nN, gid = wgid / nig, fm = gid * WGM, gsz = (nM - fm) < WGM ? (nM - fm) : WGM;
        u.pm = fm + ((wgid % nig) % gsz); u.pn = (wgid % nig) / gsz; u.kh = 0; return true;
    }
    __device__ __forceinline__ void a_ready(const Unit&) const {}
    __device__ __forceinline__ void done(const Unit&) const {}
};

struct StaticOrder2 {
    StaticOrder base;
    __host__ __device__ void init(int M, int N, int G_, int c_) { base.init(M, N, G_, c_); }
    __host__ __device__ bool next(int i, Unit& u) const { if (!base.next(i >> 1, u)) return false; u.kh = i & 1; return true; }
    __device__ __forceinline__ void a_ready(const Unit&) const {}
    __device__ __forceinline__ void done(const Unit&) const {}
};

template <class Epi, class Sched, bool ALIGN_EPI = false, bool SP2 = false>
__device__ __forceinline__ void gemm_phase(PG8_LAS unsigned char* lds, const Gemm g, const Sched& S, const Epi& E) {
    int tid_; asm volatile("v_mov_b32 %0, %1" : "=v"(tid_) : "v"(threadIdx.x));
    const int tid = tid_, wid = __builtin_amdgcn_readfirstlane(tid >> 6), lane = tid & 63, wr = wid >> 2, wc = wid & 3, fr = lane & 15, fq = lane >> 4;
    const int K = g.K, nt = g.KL / BK; const size_t khoff = (size_t)g.KL * 2;
    unsigned voffA[2], voffB[2];
#pragma unroll
    for (int i = 0; i < 2; ++i) { int R, C; stage_rc(tid * 16 + i * 8192, R, C); const int Rb = Epi::PERM ? ((R & ~31) + perm32(R & 31)) : R;
        voffA[i] = (unsigned)(R * K + C) * 2u; voffB[i] = (unsigned)(Rb * K + C) * 2u; }
    const size_t kstep = (size_t)(BK * 2);
    const size_t hstep = (size_t)HALF * K * 2;
    const size_t tstep = 2 * hstep;
    const unsigned ldsw = (unsigned)wid * 1024u;
    const int aoff = lds_byte(wr * 64 + fr, fq * 8), boff = lds_byte(wc * 32 + fr, fq * 8);
#define PG8_SA(b, h) (((b) * 2 + (h)) * HTB)
#define PG8_SB(b, h) ((4 + (b) * 2 + (h)) * HTB)
#define PG8_STAGE(bufoff, gbase, voff) do { _Pragma("unroll") for (int _i = 0; _i < 2; ++_i) \
        __builtin_amdgcn_global_load_lds((const unsigned*)((const char*)(gbase) + (voff)[_i]), (PG8_LAS unsigned*)(lds + (bufoff) + ldsw + _i * 8192), 16, 0, 0); } while (0)
#define PG8_LDA(dst, b, h) do { _Pragma("unroll") for (int m = 0; m < 4; ++m) _Pragma("unroll") for (int k = 0; k < 2; ++k) dst[m][k] = *(const PG8_LAS bf16x8*)(lds + PG8_SA(b, h) + aoff + m * 2048 + k * 1024); } while (0)
#define PG8_LDB(dst, b, h) do { _Pragma("unroll") for (int n = 0; n < 2; ++n) _Pragma("unroll") for (int k = 0; k < 2; ++k) dst[n][k] = *(const PG8_LAS bf16x8*)(lds + PG8_SB(b, h) + boff + n * 2048 + k * 1024); } while (0)
#define PG8_MMA(ai, bj, At, Bt) do { __builtin_amdgcn_s_setprio(1); _Pragma("unroll") for (int m = 0; m < 4; ++m) _Pragma("unroll") for (int n = 0; n < 2; ++n) { \
        if constexpr (Epi::FP8) mfma_f8_acc(acc[ai][bj][m][n], cat8(Bt[n][0], Bt[n][1]), cat8(At[m][0], At[m][1])); \
        else { _Pragma("unroll") for (int k = 0; k < 2; ++k) acc[ai][bj][m][n] = __builtin_amdgcn_mfma_f32_16x16x32_bf16(Bt[n][k], At[m][k], acc[ai][bj][m][n], 0, 0, 0); } } \
        __builtin_amdgcn_s_setprio(0); } while (0)
#define PG8_WAIT_V(n) asm volatile("s_waitcnt vmcnt(" #n ")" ::: "memory")
#define PG8_WAIT_L(n) asm volatile("s_waitcnt lgkmcnt(" #n ")" ::: "memory")
#define PG8_BAR __builtin_amdgcn_s_barrier()
#define PG8_SCHED __builtin_amdgcn_sched_barrier(0)
    Unit cur, nxt; int ui = 0;
    if (!S.next(0, cur)) return;
    f32x4 acc[2][2][4][2];
#pragma unroll
    for (int a = 0; a < 2; ++a)
#pragma unroll
        for (int b = 0; b < 2; ++b)
#pragma unroll
            for (int m = 0; m < 4; ++m)
#pragma unroll
                for (int n = 0; n < 2; ++n) acc[a][b][m][n] = (f32x4){0.f, 0.f, 0.f, 0.f};
    bf16x8 At[4][2], B0[2][2], B1[2][2];
    const char* cA = (const char*)g.A + (size_t)cur.pm * tstep + (size_t)cur.kh * khoff; const char* cB = (const char*)g.Bt + (size_t)cur.pn * tstep + (size_t)cur.kh * khoff;
    S.a_ready(cur);
    if constexpr (SP2) {
        PG8_STAGE(PG8_SB(0, 0), cB, voffB); PG8_STAGE(PG8_SB(0, 1), cB + hstep, voffB); PG8_STAGE(PG8_SA(0, 0), cA, voffA); PG8_STAGE(PG8_SA(0, 1), cA + hstep, voffA);
        if (wr == 1) PG8_BAR;
        PG8_WAIT_V(2); PG8_BAR;
        PG8_STAGE(PG8_SB(1, 0), cB + kstep, voffB); PG8_STAGE(PG8_SA(1, 0), cA + kstep, voffA); PG8_STAGE(PG8_SB(1, 1), cB + hstep + kstep, voffB);
        PG8_WAIT_V(6); PG8_BAR;
    } else {
        PG8_STAGE(PG8_SB(0, 0), cB, voffB); PG8_STAGE(PG8_SA(0, 0), cA, voffA); PG8_STAGE(PG8_SB(0, 1), cB + hstep, voffB); PG8_STAGE(PG8_SA(0, 1), cA + hstep, voffA);
        if (wr == 1) PG8_BAR;
        PG8_WAIT_V(4); PG8_BAR;
        PG8_STAGE(PG8_SB(1, 0), cB + kstep, voffB); PG8_STAGE(PG8_SA(1, 0), cA + kstep, voffA); PG8_STAGE(PG8_SB(1, 1), cB + hstep + kstep, voffB);
        PG8_WAIT_V(6); PG8_BAR;
    }
    for (;;) {
        const bool has_next = S.next(ui + 1, nxt);
        const char* nA = has_next ? (const char*)g.A + (size_t)nxt.pm * tstep + (size_t)nxt.kh * khoff : cA; const char* nB = has_next ? (const char*)g.Bt + (size_t)nxt.pn * tstep + (size_t)nxt.kh * khoff : cB;
        for (int t = 0; t < nt; t += 2) {
            const bool last = (t == nt - 2);
            const char* a1 = cA + (size_t)(t + 1) * kstep;
            const char* a2 = last ? nA : cA + (size_t)(t + 2) * kstep; const char* b2 = last ? nB : cB + (size_t)(t + 2) * kstep;
            const char* a3 = a2 + kstep; const char* b3 = b2 + kstep;
            if (last && has_next) S.a_ready(nxt);
            if constexpr (SP2) {
            PG8_LDB(B0, 0, 0); PG8_LDB(B1, 0, 1); PG8_SCHED; PG8_LDA(At, 0, 0); PG8_STAGE(PG8_SA(1, 1), a1 + hstep, voffA);
            PG8_WAIT_V(8); PG8_WAIT_L(0); PG8_BAR; PG8_MMA(0, 0, At, B0); PG8_MMA(0, 1, At, B1); PG8_BAR; PG8_SCHED;
            PG8_LDA(At, 0, 1); PG8_STAGE(PG8_SB(0, 0), b2, voffB); PG8_STAGE(PG8_SB(0, 1), b2 + hstep, voffB); PG8_STAGE(PG8_SA(0, 0), a2, voffA);
            PG8_WAIT_V(8); PG8_WAIT_L(0); PG8_BAR; PG8_MMA(1, 0, At, B0); PG8_MMA(1, 1, At, B1); PG8_BAR; PG8_SCHED;
            PG8_LDB(B0, 1, 0); PG8_LDB(B1, 1, 1); PG8_SCHED; PG8_LDA(At, 1, 0); PG8_STAGE(PG8_SA(0, 1), a2 + hstep, voffA);
            PG8_WAIT_V(8); PG8_WAIT_L(0); PG8_BAR; PG8_MMA(0, 0, At, B0); PG8_MMA(0, 1, At, B1); PG8_BAR; PG8_SCHED;
            PG8_LDA(At, 1, 1); PG8_STAGE(PG8_SB(1, 0), b3, voffB); PG8_STAGE(PG8_SB(1, 1), b3 + hstep, voffB); PG8_STAGE(PG8_SA(1, 0), a3, voffA);
            PG8_WAIT_V(8); PG8_WAIT_L(0); PG8_BAR; PG8_MMA(1, 0, At, B0); PG8_MMA(1, 1, At, B1); PG8_BAR; PG8_SCHED;
            } else {
            PG8_LDB(B0, 0, 0); PG8_SCHED; PG8_LDA(At, 0, 0); PG8_STAGE(PG8_SA(1, 1), a1 + hstep, voffA);
            PG8_WAIT_L(8); PG8_BAR; PG8_WAIT_L(0); PG8_MMA(0, 0, At, B0); PG8_BAR; PG8_SCHED;
            PG8_LDB(B1, 0, 1); PG8_STAGE(PG8_SB(0, 0), b2, voffB);
            PG8_BAR; PG8_WAIT_L(0); PG8_MMA(0, 1, At, B1); PG8_BAR;
            PG8_LDA(At, 0, 1); PG8_STAGE(PG8_SA(0, 0), a2, voffA);
            PG8_BAR; PG8_WAIT_L(0); PG8_MMA(1, 0, At, B0); PG8_BAR; PG8_SCHED;
            PG8_STAGE(PG8_SB(0, 1), b2 + hstep, voffB);
            PG8_WAIT_V(6); PG8_BAR; PG8_MMA(1, 1, At, B1); PG8_BAR;
            PG8_LDB(B0, 1, 0); PG8_SCHED; PG8_LDA(At, 1, 0); PG8_STAGE(PG8_SA(0, 1), a2 + hstep, voffA);
            PG8_WAIT_L(8); PG8_BAR; PG8_WAIT_L(0); PG8_MMA(0, 0, At, B0); PG8_BAR; PG8_SCHED;
            PG8_LDB(B1, 1, 1); PG8_STAGE(PG8_SB(1, 0), b3, voffB);
            PG8_BAR; PG8_WAIT_L(0); PG8_MMA(0, 1, At, B1); PG8_BAR;
            PG8_LDA(At, 1, 1); PG8_STAGE(PG8_SA(1, 0), a3, voffA);
            PG8_BAR; PG8_WAIT_L(0); PG8_MMA(1, 0, At, B0); PG8_BAR; PG8_SCHED;
            PG8_STAGE(PG8_SB(1, 1), b3 + hstep, voffB);
            PG8_WAIT_V(6); PG8_BAR; PG8_MMA(1, 1, At, B1); PG8_BAR;
            }
        }
        if constexpr (ALIGN_EPI) { if (wr == 0) PG8_BAR; }
        if constexpr (!Epi::AFTER_DRAIN) { E(acc, cur, wr, wc, fr, fq); S.done(cur); }
        if (!has_next) break;
        if (!(Epi::SPLITK2 && cur.kh == 0))
#pragma unroll
        for (int a = 0; a < 2; ++a)
#pragma unroll
            for (int b = 0; b < 2; ++b)
#pragma unroll
                for (int m = 0; m < 4; ++m)
#pragma unroll
                    for (int n = 0; n < 2; ++n) acc[a][b][m][n] = (f32x4){0.f, 0.f, 0.f, 0.f};
        cur = nxt; cA = nA; cB = nB; ++ui;
        if constexpr (ALIGN_EPI) { if (wr == 1) PG8_BAR; }
    }
    PG8_WAIT_V(0);
    if constexpr (!ALIGN_EPI) { if (wr == 0) PG8_BAR; }
    PG8_BAR;
    if constexpr (Epi::AFTER_DRAIN) { E.fused(acc, cur, wr, wc, fr, fq, lds, wid, lane); S.done(cur); }
#undef PG8_SA
#undef PG8_SB
#undef PG8_STAGE
#undef PG8_LDA
#undef PG8_LDB
#undef PG8_MMA
#undef PG8_WAIT_V
#undef PG8_WAIT_L
#undef PG8_BAR
#undef PG8_SCHED
}
}
namespace epi {
using pg8::Unit;
typedef f32x4 Acc[2][2][4][2];

__device__ __forceinline__ void rot2(f32x4& v, const f32x4 cs) {
    const float a1 = v[0] * cs[0] - v[1] * cs[1], a2 = v[1] * cs[0] + v[0] * cs[1];
    const float b1 = v[2] * cs[2] - v[3] * cs[3], b2 = v[3] * cs[2] + v[2] * cs[3];
    v = (f32x4){a1, a2, b1, b2};
}
__device__ __forceinline__ float sigm(float x) { return 1.0f / (1.0f + __expf(-x)); }

struct EpiIn {
    static constexpr bool PERM = true, AFTER_DRAIN = false, SPLITK2 = false, FP8 = false;
    bf16_t *cq, *ckv, *qb, *kb, *vb, *qix, *kpe, *kix, *ga, *gb; float* wix; u64 *ssq_cq, *ssq_ckv;
    const float *ropeM, *ropeD, *ropeI;
    __device__ __forceinline__ void operator()(const Acc& acc, const Unit& u, int wr, int wc, int fr, int fq) const {
        const int vt = u.pn, rowb = u.pm * 256 + wr * 64 + fr, ct = wc * 32 + 8 * fq;
        if (vt < 6) {
            bf16_t* dst = vt < 4 ? cq : ckv; const int ld = vt < 4 ? 1024 : 512, cb = (vt < 4 ? vt : vt - 4) * 256 + ct; u64* ssq = vt < 4 ? ssq_cq : ssq_ckv;
#pragma unroll
            for (int ai = 0; ai < 2; ++ai)
#pragma unroll
                for (int m = 0; m < 4; ++m) { const int row = rowb + ai * 128 + m * 16; float s = 0.f;
#pragma unroll
                    for (int bj = 0; bj < 2; ++bj) { const f32x4 v0 = acc[ai][bj][m][0], v1 = acc[ai][bj][m][1];
                        s += (v0[0] * v0[0] + v0[1] * v0[1]) + (v0[2] * v0[2] + v0[3] * v0[3]) + (v1[0] * v1[0] + v1[1] * v1[1]) + (v1[2] * v1[2] + v1[3] * v1[3]);
                        *(u32x4*)(dst + (size_t)row * ld + cb + bj * 128) = pack8(v0, v1); }
                    s += __shfl_xor(s, 16); s += __shfl_xor(s, 32);
                    if (fq == 0 && ssq) ssq_add(ssq + row, s); }
        } else if (vt < 16) {
            const bool isq = vt < 14; bf16_t* dst = isq ? qb : kb; const int ld = isq ? 2048 : 512, cb = (isq ? vt - 6 : vt - 14) * 256 + ct; const float sc = isq ? QB_SCALE : 1.f;
#pragma unroll
            for (int ai = 0; ai < 2; ++ai)
#pragma unroll
                for (int m = 0; m < 4; ++m) { const int row = rowb + ai * 128 + m * 16, t = row_pos(row);
                    f32x4 cs0 = (f32x4){1.f, 0.f, 1.f, 0.f}, cs1 = cs0;
                    if (wc == 0) { const f32x4* p = (const f32x4*)(ropeD + ((size_t)t * 16 + 4 * fq) * 2); cs0 = p[0]; cs1 = p[1]; }
#pragma unroll
                    for (int bj = 0; bj < 2; ++bj) { f32x4 v0 = acc[ai][bj][m][0], v1 = acc[ai][bj][m][1];
                        if (wc == 0) { rot2(v0, cs0); rot2(v1, cs1); }
                        v0 = v0 * sc; v1 = v1 * sc;
                        *(u32x4*)(dst + (size_t)row * ld + cb + bj * 128) = pack8(v0, v1); } }
        } else if (vt < 18) {
            const int cb = (vt - 16) * 256 + ct;
#pragma unroll
            for (int ai = 0; ai < 2; ++ai)
#pragma unroll
                for (int m = 0; m < 4; ++m) { const int row = rowb + ai * 128 + m * 16;
#pragma unroll
                    for (int bj = 0; bj < 2; ++bj) *(u32x4*)(vb + (size_t)row * 512 + cb + bj * 128) = pack8(acc[ai][bj][m][0], acc[ai][bj][m][1]); }
        } else if (vt < 22) {
            const int cb = (vt - 18) * 256 + ct; const bool rt = ((wc & 1) == 0) && (fq < 2);
#pragma unroll
            for (int ai = 0; ai < 2; ++ai)
#pragma unroll
                for (int m = 0; m < 4; ++m) { const int row = rowb + ai * 128 + m * 16, t = row_pos(row);
                    f32x4 cs0 = (f32x4){1.f, 0.f, 1.f, 0.f}, cs1 = cs0;
                    if (rt) { const f32x4* p = (const f32x4*)(ropeI + ((size_t)t * 8 + 4 * fq) * 2); cs0 = p[0]; cs1 = p[1]; }
#pragma unroll
                    for (int bj = 0; bj < 2; ++bj) { f32x4 v0 = acc[ai][bj][m][0], v1 = acc[ai][bj][m][1];
                        if (rt) { rot2(v0, cs0); rot2(v1, cs1); }
                        *(u32x4*)(qix + (size_t)row * 1024 + cb + bj * 128) = pack8(v0, v1); } }
        } else if (vt == 22) {
#pragma unroll
            for (int ai = 0; ai < 2; ++ai)
#pragma unroll
                for (int m = 0; m < 4; ++m) { const int row = rowb + ai * 128 + m * 16, t = row_pos(row);
                    f32x4 v0 = acc[ai][0][m][0], v1 = acc[ai][0][m][1];
                    if (wc < 2) { const f32x4* p = (const f32x4*)(ropeM + ((size_t)t * 32 + 16 * wc + 4 * fq) * 2); rot2(v0, p[0]); rot2(v1, p[1]);
                        *(u32x4*)(kpe + (size_t)row * 64 + ct) = pack8(v0, v1);
                    } else { if (wc == 2 && fq < 2) { const f32x4* p = (const f32x4*)(ropeI + ((size_t)t * 8 + 4 * fq) * 2); rot2(v0, p[0]); rot2(v1, p[1]); }
                        *(u32x4*)(kix + (size_t)row * 64 + (ct - 64)) = pack8(v0, v1); }
                    if (wc == 0 && fq < 2) { float* w = wix + (size_t)row * 16 + 8 * fq; *(f32x4*)w = acc[ai][1][m][0]; *(f32x4*)(w + 4) = acc[ai][1][m][1]; } }
        } else {
            const bool isa = vt < 39; bf16_t* dst = isa ? ga : gb; const int cb = (isa ? vt - 23 : vt - 39) * 256 + ct;
#pragma unroll
            for (int ai = 0; ai < 2; ++ai)
#pragma unroll
                for (int m = 0; m < 4; ++m) { const int row = rowb + ai * 128 + m * 16;
#pragma unroll
                    for (int bj = 0; bj < 2; ++bj) { f32x4 v0 = acc[ai][bj][m][0], v1 = acc[ai][bj][m][1];
#pragma unroll
                        for (int e = 0; e < 4; ++e) { v0[e] = sigm(v0[e]); v1[e] = sigm(v1[e]); }
                        *(u32x4*)(dst + (size_t)row * 4096 + cb + bj * 128) = pack8(v0, v1); } }
        }
    }
};

struct EpiGate {
    static constexpr bool PERM = true, AFTER_DRAIN = false, SPLITK2 = false, FP8 = true;
    bf16_t *ga, *gb; const float *sx, *sw;
    __device__ __forceinline__ void operator()(const Acc& acc, const Unit& u, int wr, int wc, int fr, int fq) const {
        const int vt = u.pn, rowb = u.pm * 256 + wr * 64 + fr, ct = wc * 32 + 8 * fq;
        const bool isa = vt < 16; bf16_t* dst = isa ? ga : gb; const int cb = (isa ? vt : vt - 16) * 256 + ct;
        f32x4 w0[2], w1[2];
#pragma unroll
        for (int bj = 0; bj < 2; ++bj) { const f32x4* p = (const f32x4*)(sw + vt * 256 + ct + bj * 128); w0[bj] = p[0]; w1[bj] = p[1]; }
#pragma unroll
        for (int ai = 0; ai < 2; ++ai)
#pragma unroll
            for (int m = 0; m < 4; ++m) { const int row = rowb + ai * 128 + m * 16; const float rs = sx[row];
#pragma unroll
                for (int bj = 0; bj < 2; ++bj) { f32x4 v0 = acc[ai][bj][m][0] * rs * w0[bj], v1 = acc[ai][bj][m][1] * rs * w1[bj];
#pragma unroll
                    for (int e = 0; e < 4; ++e) { v0[e] = sigm(v0[e]); v1[e] = sigm(v1[e]); }
                    *(u32x4*)(dst + (size_t)row * 4096 + cb + bj * 128) = pack8(v0, v1); } }
    }
};

struct EpiUp {
    static constexpr bool PERM = true, AFTER_DRAIN = false, SPLITK2 = false, FP8 = false;
    bf16_t *d0, *d1; int nt0, ld0, ld1; const u64* ssq; float invK, scale; const float* rope;
    __device__ __forceinline__ void operator()(const Acc& acc, const Unit& u, int wr, int wc, int fr, int fq) const {
        const int vt = u.pn, rowb = u.pm * 256 + wr * 64 + fr, ct = wc * 32 + 8 * fq; const bool first = vt < nt0;
        bf16_t* dst = first ? d0 : d1; const int ld = first ? ld0 : ld1, cb = (first ? vt : vt - nt0) * 256 + ct; const bool rt = (!first) && (rope != nullptr);
#pragma unroll
        for (int ai = 0; ai < 2; ++ai)
#pragma unroll
            for (int m = 0; m < 4; ++m) { const int row = rowb + ai * 128 + m * 16, t = row_pos(row);
                const float rs = __builtin_amdgcn_rsqf(ssq_get(ssq + row) * invK + EPS) * scale;
                f32x4 cs0 = (f32x4){1.f, 0.f, 1.f, 0.f}, cs1 = cs0;
                if (rt) { const f32x4* p = (const f32x4*)(rope + ((size_t)t * 32 + 16 * (wc & 1) + 4 * fq) * 2); cs0 = p[0]; cs1 = p[1]; }
#pragma unroll
                for (int bj = 0; bj < 2; ++bj) { f32x4 v0 = acc[ai][bj][m][0] * rs, v1 = acc[ai][bj][m][1] * rs;
                    if (rt) { rot2(v0, cs0); rot2(v1, cs1); }
                    *(u32x4*)(dst + (size_t)row * ld + cb + bj * 128) = pack8(v0, v1); } }
    }
};

struct EpiBranch {
    static constexpr bool PERM = true, AFTER_DRAIN = false, SPLITK2 = true, FP8 = false;
    const bf16_t *ga, *gb; bf16_t* out;
    __device__ __forceinline__ void operator()(Acc& acc, const Unit& u, int wr, int wc, int fr, int fq) const {
        const int rowb = u.pm * 256 + wr * 64 + fr, cb = u.pn * 256 + wc * 32 + 8 * fq;
        if (u.kh == 0) {
#pragma unroll
            for (int ai = 0; ai < 2; ++ai)
#pragma unroll
                for (int m = 0; m < 4; ++m) { const size_t ro = (size_t)(rowb + ai * 128 + m * 16) * 4096 + cb;
#pragma unroll
                    for (int bj = 0; bj < 2; ++bj) { const u32x4 a = *(const u32x4*)(ga + ro + bj * 128), b = *(const u32x4*)(gb + ro + bj * 128);
                        f32x4 r0, r1;
#define RQ(x, y) ((x) * __builtin_amdgcn_rcpf(y))
                        r0[0] = RQ(bf_lo(a.x), bf_lo(b.x)); r0[1] = RQ(bf_hi(a.x), bf_hi(b.x)); r0[2] = RQ(bf_lo(a.y), bf_lo(b.y)); r0[3] = RQ(bf_hi(a.y), bf_hi(b.y));
                        r1[0] = RQ(bf_lo(a.z), bf_lo(b.z)); r1[1] = RQ(bf_hi(a.z), bf_hi(b.z)); r1[2] = RQ(bf_lo(a.w), bf_lo(b.w)); r1[3] = RQ(bf_hi(a.w), bf_hi(b.w));
#undef RQ
                        acc[ai][bj][m][0] = acc[ai][bj][m][0] * r0; acc[ai][bj][m][1] = acc[ai][bj][m][1] * r1; }
                    asm volatile("" ::: "memory"); }
        } else {
#pragma unroll
            for (int ai = 0; ai < 2; ++ai)
#pragma unroll
                for (int m = 0; m < 4; ++m) { const size_t ro = (size_t)(rowb + ai * 128 + m * 16) * 4096 + cb;
#pragma unroll
                    for (int bj = 0; bj < 2; ++bj) { const u32x4 b = *(const u32x4*)(gb + ro + bj * 128);
                        const f32x4 s0 = (f32x4){bf_lo(b.x), bf_hi(b.x), bf_lo(b.y), bf_hi(b.y)}, s1 = (f32x4){bf_lo(b.z), bf_hi(b.z), bf_lo(b.w), bf_hi(b.w)};
                        *(u32x4*)(out + ro + bj * 128) = pack8(acc[ai][bj][m][0] * s0, acc[ai][bj][m][1] * s1); } }
        }
    }
};

struct EpiOut {
    static constexpr bool PERM = true, AFTER_DRAIN = false, SPLITK2 = false, FP8 = false;
    const float *x, *meta; float* h1f; bf16_t* h1b; u64* ssq;
    __device__ __forceinline__ void operator()(const Acc& acc, const Unit& u, int wr, int wc, int fr, int fq) const {
        const int rowb = u.pm * 256 + wr * 64 + fr, cb = u.pn * 256 + wc * 32 + 8 * fq;
#pragma unroll
        for (int ai = 0; ai < 2; ++ai)
#pragma unroll
            for (int m = 0; m < 4; ++m) { const int row = rowb + ai * 128 + m * 16;
                const float* src = x + (size_t)row * DM;
                float s = 0.f;
#pragma unroll
                for (int bj = 0; bj < 2; ++bj) { f32x4 v0 = acc[ai][bj][m][0], v1 = acc[ai][bj][m][1];
                    v0 = v0 + *(const f32x4*)(src + cb + bj * 128); v1 = v1 + *(const f32x4*)(src + cb + bj * 128 + 4);
                    s += (v0[0] * v0[0] + v0[1] * v0[1]) + (v0[2] * v0[2] + v0[3] * v0[3]) + (v1[0] * v1[0] + v1[1] * v1[1]) + (v1[2] * v1[2] + v1[3] * v1[3]);
                    float* o = h1f + (size_t)row * DM + cb + bj * 128; *(f32x4*)o = v0; *(f32x4*)(o + 4) = v1;
                    *(u32x4*)(h1b + (size_t)row * DM + cb + bj * 128) = pack8(v0, v1); }
                s += __shfl_xor(s, 16); s += __shfl_xor(s, 32);
                if (fq == 0 && ssq) ssq_add(ssq + row, s); }
    }
};

struct EpiPQ {
    static constexpr bool PERM = true, AFTER_DRAIN = false, SPLITK2 = false, FP8 = false;
    bf16_t* pq; const u64* ssq;
    __device__ __forceinline__ void operator()(const Acc& acc, const Unit& u, int wr, int wc, int fr, int fq) const {
        const int rowb = u.pm * 256 + wr * 64 + fr, cb = u.pn * 256 + wc * 32 + 8 * fq;
#pragma unroll
        for (int ai = 0; ai < 2; ++ai)
#pragma unroll
            for (int m = 0; m < 4; ++m) { const int row = rowb + ai * 128 + m * 16; const float rs = __builtin_amdgcn_rsqf(ssq_get(ssq + row) * (1.0f / DM) + EPS);
#pragma unroll
                for (int bj = 0; bj < 2; ++bj) *(u32x4*)(pq + (size_t)row * 2048 + cb + bj * 128) = pack8(acc[ai][bj][m][0] * rs, acc[ai][bj][m][1] * rs); }
    }
};
}
#define XB_TMO      128
#define XB_XCNT(j)  (256  + 64 * (j))
#define XB_XSUB(j)  (1280 + 64 * (j))
#define XB_XGEN(j)  (2304 + 64 * (j))
#define XB_TOP      3328
#define XB_TOPGEN   3392
#define XCD_BAR_WORDS 3456
#define XB_SPIN_CAP (1u << 18)
__device__ __forceinline__ unsigned xb_ld(unsigned* p)              { return __hip_atomic_load(p, __ATOMIC_RELAXED, __HIP_MEMORY_SCOPE_AGENT); }
__device__ __forceinline__ unsigned xb_add(unsigned* p, unsigned v) { return __hip_atomic_fetch_add(p, v, __ATOMIC_RELAXED, __HIP_MEMORY_SCOPE_AGENT); }
__device__ __forceinline__ unsigned xb_xcc_id() { return (unsigned)__builtin_amdgcn_s_getreg((3 << 11) | 20) & 0xFu; }
#define XB_SPIN(cond, bar) do { unsigned _sp = 0; while (cond) { __builtin_amdgcn_s_sleep(1); \
    if ((++_sp & 255u) == 0u) { if (xb_ld(&(bar)[XB_TMO])) break; if (_sp > XB_SPIN_CAP) { atomicAdd(&(bar)[XB_TMO], 1u); break; } } } } while (0)
struct XcdBarrier { unsigned* bar; unsigned x; volatile LAS unsigned* st; };
__device__ __forceinline__ XcdBarrier xcd_barrier_post(unsigned* bar, volatile LAS unsigned* st) {
    XcdBarrier b; b.bar = bar; b.x = xb_xcc_id(); b.st = st;
    if (threadIdx.x == 0) (void)xb_add(&bar[XB_XCNT(b.x)], 1u);
    return b;
}
__device__ __forceinline__ void xcd_barrier_complete(unsigned* bar, unsigned x, unsigned& nloc, unsigned& nx) {
    const unsigned G = gridDim.x * gridDim.y * gridDim.z;
    unsigned sum, cnt, mine, sp = 0u;
    for (;;) {
        sum = 0u; cnt = 0u; mine = 0u;
#pragma unroll
        for (unsigned j = 0; j < 16; ++j) { const unsigned c = xb_ld(&bar[XB_XCNT(j)]); sum += c; cnt += (c > 0u) ? 1u : 0u; mine = (j == x) ? c : mine; }
        if (sum == G) break;
        __builtin_amdgcn_s_sleep(1);
        if ((++sp & 255u) == 0u) { if (xb_ld(&bar[XB_TMO])) break; if (sp > XB_SPIN_CAP) { atomicAdd(&bar[XB_TMO], 1u); break; } }
    }
    nloc = mine > 0u ? mine : 1u; nx = cnt > 0u ? cnt : 1u;
}
__device__ __forceinline__ void xcd_barrier(const XcdBarrier& b) {
    asm volatile("s_waitcnt vmcnt(0)" ::: "memory");
    __syncthreads();
    if (threadIdx.x == 0) {
        unsigned* bar = b.bar;
        __builtin_amdgcn_s_waitcnt(0);
        unsigned nloc = b.st[0], nx = b.st[1];
        if (nloc == 0u) { xcd_barrier_complete(bar, b.x, nloc, nx); b.st[0] = nloc; b.st[1] = nx; }
        const unsigned old = xb_add(&bar[XB_XSUB(b.x)], 1u);
        const unsigned gen = old / nloc;
        if (old + 1u == (gen + 1u) * nloc) {
            __builtin_amdgcn_fence(__ATOMIC_RELEASE, "agent");
            asm volatile("s_waitcnt vmcnt(0)" ::: "memory");
            const unsigned og = xb_add(&bar[XB_TOP], 1u);
            const unsigned tg = og / nx;
            if (og + 1u == (tg + 1u) * nx) xb_add(&bar[XB_TOPGEN], 1u);
            else XB_SPIN(xb_ld(&bar[XB_TOPGEN]) == tg, bar);
            __builtin_amdgcn_fence(__ATOMIC_ACQUIRE, "agent");
            xb_add(&bar[XB_XGEN(b.x)], 1u);
            asm volatile("s_waitcnt vmcnt(0)" ::: "memory");
        } else {
            XB_SPIN(xb_ld(&bar[XB_XGEN(b.x)]) == gen, bar);
            __builtin_amdgcn_fence(__ATOMIC_ACQUIRE, "agent");
            asm volatile("s_waitcnt vmcnt(0)" ::: "memory");
        }
    }
    __syncthreads();
}

struct Frame {
    LAS unsigned char* lds;
    unsigned char* ws;
    unsigned* ctl;
    int tid, lane, wave, vcu, G;
    __device__ __forceinline__ const float* in(int i) const { return ((const float* const __attribute__((address_space(4)))*)__builtin_amdgcn_kernarg_segment_ptr())[i]; }
    __device__ __forceinline__ float* out() const { return ((float* const __attribute__((address_space(4)))*)__builtin_amdgcn_kernarg_segment_ptr())[16]; }
};

struct MapId { __device__ __forceinline__ int operator()(int v) const { return v; } };
struct MapIn { __device__ __forceinline__ int operator()(int v) const {
    if (v < 1536) return v;
    if (v < 3584) { const int w = v - 1536, hd = w >> 7; int o = w & 127; if (o < 32) o = (o & 1) ? (o >> 1) + 16 : (o >> 1); return 1600 + hd * 128 + o; }
    if (v < 4096) { const int w = v - 3584, hd = w >> 7; int o = w & 127; if (o < 32) o = (o & 1) ? (o >> 1) + 16 : (o >> 1); return 3648 + hd * 128 + o; }
    if (v < 4608) return 4160 + (v - 4096);
    if (v < 5632) { const int w = v - 4608, hd = w >> 6; int o = w & 63; if (o < 16) o = (o & 1) ? (o >> 1) + 8 : (o >> 1); return 4672 + hd * 64 + o; }
    if (v < 5888) { const int w = v - 5632;
        if (w < 64) return 1536 + ((w & 1) ? (w >> 1) + 32 : (w >> 1));
        if (w < 128) { int o = w - 64; if (o < 16) o = (o & 1) ? (o >> 1) + 8 : (o >> 1); return 5696 + o; }
        if (w < 144) return 5760 + (w - 128);
        return -1; }
    if (v < 9984) return 5776 + (v - 5888);
    return 9872 + (v - 9984);
} };
struct MapUq { __device__ __forceinline__ int operator()(int v) const {
    if (v < 2048) return (v >> 7) * 192 + (v & 127);
    const int w = v - 2048, hd = w >> 6, o = w & 63; return hd * 192 + 128 + ((o & 1) ? (o >> 1) + 32 : (o >> 1)); } };
struct MapUkv { __device__ __forceinline__ int operator()(int v) const {
    if (v < 2048) return (v >> 7) * 256 + (v & 127);
    const int w = v - 2048; return (w >> 7) * 256 + 128 + (w & 127); } };

template <class Map>
__device__ __forceinline__ void p0_transpose_item(const float* W, int K, int Nsrc, int Nvirt, bf16_t* WT, const float* gk, LAS float* scr, int item, int lane, Map map) {
    const int nblk = Nvirt / 32, kb = item / nblk, nb = item % nblk, k0 = 64 * kb, n0 = 32 * nb;
    const int sc = map(n0 + (lane & 31));
#pragma unroll 8
    for (int i = 0; i < 32; ++i) { const int kk = 2 * i + (lane >> 5); float v = 0.f;
        if (sc >= 0) v = W[(size_t)(k0 + kk) * Nsrc + sc];
        if (gk) v *= gk[k0 + kk];
        scr[kk * 33 + (lane & 31)] = v; }
    LDS_WAIT(); asm volatile("" ::: "memory");
    const int c = lane & 7;
#pragma unroll
    for (int j = 0; j < 4; ++j) { const int n = (lane >> 3) + 8 * j; const LAS float* s = scr + (8 * c) * 33 + n;
        u32x4 o; o.x = pk2(s[0 * 33], s[1 * 33]); o.y = pk2(s[2 * 33], s[3 * 33]); o.z = pk2(s[4 * 33], s[5 * 33]); o.w = pk2(s[6 * 33], s[7 * 33]);
        *(u32x4*)(WT + (size_t)(n0 + n) * K + k0 + 8 * c) = o; }
    LDS_WAIT(); asm volatile("" ::: "memory");
}
__device__ __forceinline__ float wave_max(float v) {
#pragma unroll
    for (int o = 1; o < 64; o <<= 1) v = fmaxf(v, __shfl_xor(v, o));
    return v;
}
__device__ __forceinline__ void p0_xn_row(const Frame& F, int m) {
    const float* x = F.in(0); const float* meta = F.in(1); const float* g = F.in(2);
    bf16_t* o = (bf16_t*)(F.ws + WS_XN) + (size_t)m * DM;
    u32x2* o8 = (u32x2*)o + F.lane;
    if (m >= NTOK + NMETA) {
        unsigned* z8 = (unsigned*)(F.ws + WS_XN8 + (size_t)m * DM) + F.lane;
#pragma unroll
        for (int j = 0; j < 16; ++j) { o8[64 * j] = (u32x2){0u, 0u}; z8[64 * j] = 0u; }
        if (F.lane == 0) ((float*)(F.ws + WS_SX))[m] = 0.f;
        return; }
    const float* src = m < NTOK ? x + (size_t)m * DM : meta + (size_t)(m - NTOK) * DM;
    const f32x4* xr = (const f32x4*)src + F.lane; const f32x4* gr = (const f32x4*)g + F.lane;
    f32x4 v[16]; float s = 0.f;
#pragma unroll
    for (int j = 0; j < 16; ++j) { v[j] = xr[64 * j]; s += (v[j][0] * v[j][0] + v[j][1] * v[j][1]) + (v[j][2] * v[j][2] + v[j][3] * v[j][3]); }
    const float rstd = 1.0f / sqrtf(wave_sum(s) * (1.0f / DM) + EPS);
    float mx = 0.f;
#pragma unroll
    for (int j = 0; j < 16; ++j) { const f32x4 gg = gr[64 * j]; v[j] = v[j] * rstd * gg; o8[64 * j] = (u32x2){pk2(v[j][0], v[j][1]), pk2(v[j][2], v[j][3])};
        mx = fmaxf(mx, fmaxf(fmaxf(fabsf(v[j][0]), fabsf(v[j][1])), fmaxf(fabsf(v[j][2]), fabsf(v[j][3])))); }
    mx = fmaxf(wave_max(mx), 1e-30f);
    const float inv = 448.0f / mx;
    if (F.lane == 0) ((float*)(F.ws + WS_SX))[m] = mx * (1.0f / 448.0f);
    unsigned* q8 = (unsigned*)(F.ws + WS_XN8 + (size_t)m * DM) + F.lane;
#pragma unroll
    for (int j = 0; j < 16; ++j) { f32x4 q = v[j] * inv;
#pragma unroll
        for (int e = 0; e < 4; ++e) q[e] = fminf(fmaxf(q[e], -448.0f), 448.0f);
        int p = 0; p = __builtin_amdgcn_cvt_pk_fp8_f32(q[0], q[1], p, false); p = __builtin_amdgcn_cvt_pk_fp8_f32(q[2], q[3], p, true); q8[64 * j] = (unsigned)p; }
}
__device__ __forceinline__ void p0_prologue(const Frame& F) {
    LAS float* scr = (LAS float*)(F.lds + F.wave * 16384);
    const int gw = F.vcu * NWAVES + F.wave, NGW = F.G * NWAVES;
    const float* w_in = F.in(3); const float* qg = F.in(4); const float* w_uq = F.in(5); const float* kvg = F.in(6); const float* w_ukv = F.in(7);
    const float* w_br = F.in(8); const float* w_out = F.in(9); const float* fg = F.in(10); const float* w_q = F.in(11); const float* sk = F.in(12);
    constexpr int I_IN = 64 * (NV1 / 32), I_UQ = 16 * (3072 / 32), I_UKV = 8 * (4096 / 32), I_BR = 64 * 128, I_OUT = 64 * 128, I_Q = 64 * 64;
    constexpr int NITEMS = I_IN + I_UQ + I_UKV + I_BR + I_OUT + I_Q;
    for (int it = gw; it < NITEMS; it += NGW) {
        int r = it;
        if (r < I_IN) { p0_transpose_item(w_in, 4096, 13968, NV1, (bf16_t*)(F.ws + WS_WIN), nullptr, scr, r, F.lane, MapIn()); continue; } r -= I_IN;
        if (r < I_UQ) { p0_transpose_item(w_uq, 1024, 3072, 3072, (bf16_t*)(F.ws + WS_WUQ), qg, scr, r, F.lane, MapUq()); continue; } r -= I_UQ;
        if (r < I_UKV) { p0_transpose_item(w_ukv, 512, 4096, 4096, (bf16_t*)(F.ws + WS_WUKV), kvg, scr, r, F.lane, MapUkv()); continue; } r -= I_UKV;
        if (r < I_BR) { p0_transpose_item(w_br, 4096, 4096, 4096, (bf16_t*)(F.ws + WS_WBR), nullptr, scr, r, F.lane, MapId()); continue; } r -= I_BR;
        if (r < I_OUT) { p0_transpose_item(w_out, 4096, 4096, 4096, (bf16_t*)(F.ws + WS_WOUT), nullptr, scr, r, F.lane, MapId()); continue; } r -= I_OUT;
        p0_transpose_item(w_q, 4096, 2048, 2048, (bf16_t*)(F.ws + WS_WQ), fg, scr, r, F.lane, MapId());
    }
    for (int m = gw; m < MK; m += NGW) p0_xn_row(F, m);
    const int gt = (F.vcu * NWAVES + F.wave) * 64 + F.lane, NGT = NGW * 64;
    for (int i = gt; i < TP * 56; i += NGT) {
        const int t = i / 56, r = i % 56; int j, rot; float* dst;
        if (r < 32) { j = r; rot = 64; dst = (float*)(F.ws + WS_ROPE_M) + ((size_t)t * 32 + j) * 2; }
        else if (r < 48) { j = r - 32; rot = 32; dst = (float*)(F.ws + WS_ROPE_D) + ((size_t)t * 16 + j) * 2; }
        else { j = r - 48; rot = 16; dst = (float*)(F.ws + WS_ROPE_I) + ((size_t)t * 8 + j) * 2; }
        const float ex = (float)(2 * j) / (float)rot;
        const float inv = powf(500000.0f, -ex);
        const float ang = (float)t * inv;
        const double a = (double)ang, kq = rint(a * 0.15915494309189535), rr = fma(-kq, 6.283185307179586, a);
        const float rf = (float)rr;
        dst[0] = cosf(rf); dst[1] = sinf(rf);
    }
    for (int i = gt; i < 16 * 128 * 128 / 8; i += NGT) { const f32x4* s = (const f32x4*)sk + 2 * (size_t)i; const f32x4 a = s[0], b2 = s[1];
        u32x4 o; o.x = pk2(a[0], a[1]); o.y = pk2(a[2], a[3]); o.z = pk2(b2[0], b2[1]); o.w = pk2(b2[2], b2[3]); ((u32x4*)(F.ws + WS_SK))[i] = o; }
}
__device__ __forceinline__ unsigned fp6_code(float q) {
    const unsigned b = __float_as_uint(q), sgn = (b >> 31) << 5; const float aq = fabsf(q);
    const unsigned sub = (unsigned)rintf(aq * 8.0f);
    unsigned ab = b & 0x7fffffffu; ab = ab + 0x7FFFFu + ((ab >> 20) & 1u);
    const unsigned nrm = (ab >> 20) - (126u << 3);
    unsigned code = aq < 1.0f ? sub : nrm; code = code > 31u ? 31u : code;
    return code | sgn;
}
__device__ __forceinline__ void fp6_pack32(const unsigned (&c)[32], unsigned (&w)[6]) {
#pragma unroll
    for (int i = 0; i < 6; ++i) w[i] = 0u;
#pragma unroll
    for (int k = 0; k < 32; ++k) { const int bit = 6 * k, d = bit >> 5, sh = bit & 31; w[d] |= c[k] << sh; if (sh > 26) w[d + 1] |= c[k] >> (32 - sh); }
}
__device__ __forceinline__ void p6_quant_row(const float* src, const float* gain, unsigned char* dst, float* scale_out, int lane) {
    const f32x4* s = (const f32x4*)src + lane; f32x4 v[16]; float mx = 0.f;
#pragma unroll
    for (int j = 0; j < 16; ++j) { v[j] = s[64 * j]; if (gain) v[j] = v[j] * ((const f32x4*)gain)[lane + 64 * j];
        mx = fmaxf(mx, fmaxf(fmaxf(fabsf(v[j][0]), fabsf(v[j][1])), fmaxf(fabsf(v[j][2]), fabsf(v[j][3])))); }
    mx = fmaxf(wave_max(mx), 1e-30f);
    const float sc = mx * (1.0f / 7.5f), inv = 7.5f / mx;
    if (lane == 0) *scale_out = sc;
    unsigned w[12];
#pragma unroll
    for (int g = 0; g < 2; ++g) { unsigned c[32];
#pragma unroll
        for (int j = 0; j < 8; ++j)
#pragma unroll
            for (int i = 0; i < 4; ++i) c[4 * j + i] = fp6_code(v[8 * g + j][i] * inv);
        unsigned ww[6]; fp6_pack32(c, ww);
#pragma unroll
        for (int i = 0; i < 6; ++i) w[6 * g + i] = ww[i]; }
#pragma unroll
    for (int q = 0; q < 3; ++q) *(u32x4*)(dst + 1024 * q + 16 * lane) = (u32x4){w[4 * q], w[4 * q + 1], w[4 * q + 2], w[4 * q + 3]};
}
__device__ __forceinline__ void p6_tables(const Frame& F) {
    const float* fg = F.in(10); const float* pu = F.in(13); const float* pv = F.in(14);
    const int gw = F.vcu * NWAVES + F.wave, NGW = F.G * NWAVES;
    for (int it = gw; it < 2 * 16384; it += NGW) { const int e = it >> 1;
        if (it & 1) p6_quant_row(pv + (size_t)e * DM, nullptr, F.ws + WS_V + (size_t)e * 3072, (float*)(F.ws + WS_SCV) + e, F.lane);
        else p6_quant_row(pu + (size_t)e * DM, fg, F.ws + WS_U + (size_t)e * 3072, (float*)(F.ws + WS_SCU) + e, F.lane); }
}

__device__ __forceinline__ void p1_quant_gates(const Frame& F) {
    const int gw = F.vcu * NWAVES + F.wave, NGW = F.G * NWAVES, lane = F.lane;
    for (int n = gw; n < 8192; n += NGW) {
        const u32x4* s = (const u32x4*)(F.ws + WS_WIN + (size_t)(5888 + n) * DM * 2) + lane;
        u32x4 v[8]; float mx = 0.f;
#pragma unroll
        for (int j = 0; j < 8; ++j) { v[j] = s[64 * j];
#pragma unroll
            for (int e = 0; e < 4; ++e) mx = fmaxf(mx, fmaxf(fabsf(bf_lo(v[j][e])), fabsf(bf_hi(v[j][e])))); }
        mx = fmaxf(wave_max(mx), 1e-30f);
        const float inv = 448.0f / mx;
        if (lane == 0) ((float*)(F.ws + WS_SW))[n] = mx * (1.0f / 448.0f);
        u32x2* d = (u32x2*)(F.ws + WS_WG8 + (size_t)n * DM) + lane;
#pragma unroll
        for (int j = 0; j < 8; ++j) { int p0 = 0, p1 = 0;
            p0 = __builtin_amdgcn_cvt_pk_fp8_f32(bf_lo(v[j].x) * inv, bf_hi(v[j].x) * inv, p0, false); p0 = __builtin_amdgcn_cvt_pk_fp8_f32(bf_lo(v[j].y) * inv, bf_hi(v[j].y) * inv, p0, true);
            p1 = __builtin_amdgcn_cvt_pk_fp8_f32(bf_lo(v[j].z) * inv, bf_hi(v[j].z) * inv, p1, false); p1 = __builtin_amdgcn_cvt_pk_fp8_f32(bf_lo(v[j].w) * inv, bf_hi(v[j].w) * inv, p1, true);
            d[64 * j] = (u32x2){(unsigned)p0, (unsigned)p1}; }
    }
}
#define MFMA32(a, b, c) __builtin_amdgcn_mfma_f32_32x32x16_bf16((a), (b), (c), 0, 0, 0)
__device__ __forceinline__ int crow(int i, int h) { return (i & 3) + 8 * (i >> 2) + 4 * h; }
__device__ __forceinline__ float half_sum_f(float v) {
#pragma unroll
    for (int o = 1; o < 32; o <<= 1) v += __shfl_xor(v, o);
    return v;
}
__device__ __forceinline__ int half_sum_i(int v) {
#pragma unroll
    for (int o = 1; o < 32; o <<= 1) v += __shfl_xor(v, o);
    return v;
}
__device__ __forceinline__ float half_max_f(float v) {
#pragma unroll
    for (int o = 1; o < 32; o <<= 1) v = fmaxf(v, __shfl_xor(v, o));
    return v;
}
__device__ __forceinline__ float half_min_f(float v) {
#pragma unroll
    for (int o = 1; o < 32; o <<= 1) v = fminf(v, __shfl_xor(v, o));
    return v;
}
__device__ __forceinline__ void idx_task(const Frame& F, int b, int s0) {
    const int lane = F.lane, r = lane & 31, h = lane >> 5;
    const bf16_t* qix = (const bf16_t*)(F.ws + WS_QIX); const bf16_t* kix = (const bf16_t*)(F.ws + WS_KIX); const float* wix = (const float*)(F.ws + WS_WIX);
    unsigned* mask = (unsigned*)(F.ws + WS_MASK);
    const int tok = (r >> 2) & 1, head = (r & 3) + 4 * (r >> 3);
    const bf16_t* qp = qix + (size_t)(b * SEQ + s0 + tok) * 1024 + head * 64 + 8 * h;
    bf16x8 af[4];
#pragma unroll
    for (int ks = 0; ks < 4; ++ks) af[ks] = *(const bf16x8*)(qp + 16 * ks);
    const f32x4* wp = (const f32x4*)(wix + (size_t)(b * SEQ + s0 + h) * 16);
    float w[16];
#pragma unroll
    for (int q = 0; q < 4; ++q) { const f32x4 x = wp[q]; w[4 * q] = x[0]; w[4 * q + 1] = x[1]; w[4 * q + 2] = x[2]; w[4 * q + 3] = x[3]; }
    const int tq = NMETA + s0 + h;
    const int ngrp = ((NMETA + s0 + 1) >> 6) + 1;
    int brow = b * SEQ - NMETA; asm volatile("" : "+s"(brow));
    const bf16_t* kbase = kix + ((long)brow + r) * 64 + 8 * h;
    float row[MW];
    const bf16_t* kcur = kbase;
#pragma unroll
    for (int g = 0; g < MW / 2; ++g) {
        float s0v = -INFINITY, s1v = -INFINITY;
        if (g < ngrp) {
            const bf16_t* kp0 = kcur; const bf16_t* kp1 = kcur + 32 * 64;
            if (g == 0 && r < NMETA) kp0 = kix + (size_t)(NTOK + r) * 64 + 8 * h;
            bf16x8 b0[4], b1[4];
#pragma unroll
            for (int ks = 0; ks < 4; ++ks) { b0[ks] = *(const bf16x8*)(kp0 + 16 * ks); b1[ks] = *(const bf16x8*)(kp1 + 16 * ks); }
            float x0 = 0.f, x1 = 0.f;
            { f32x16 a0;
#pragma unroll
              for (int i = 0; i < 16; ++i) a0[i] = 0.f;
#pragma unroll
              for (int ks = 0; ks < 4; ++ks) a0 = MFMA32(af[ks], b0[ks], a0);
#pragma unroll
              for (int i = 0; i < 16; ++i) x0 += w[i] * fmaxf(a0[i], 0.f); }
            { f32x16 a1;
#pragma unroll
              for (int i = 0; i < 16; ++i) a1[i] = 0.f;
#pragma unroll
              for (int ks = 0; ks < 4; ++ks) a1 = MFMA32(af[ks], b1[ks], a1);
#pragma unroll
              for (int i = 0; i < 16; ++i) x1 += w[i] * fmaxf(a1[i], 0.f); }
            s0v = (g * 64 + r <= tq) ? x0 : -INFINITY; s1v = (g * 64 + 32 + r <= tq) ? x1 : -INFINITY;
        }
        row[2 * g] = s0v; row[2 * g + 1] = s1v;
        kcur += 64 * 64; asm volatile("" : "+v"(kcur));
    }
    float tau = -3.0e38f;
    bool done = (tq + 1 <= 256);
    float mx = -INFINITY, mn = INFINITY;
#pragma unroll
    for (int k = 0; k < MW; ++k) { const float v = row[k]; mx = fmaxf(mx, v); mn = fminf(mn, v > -INFINITY ? v : INFINITY); }
    float lo = half_min_f(mn), hi = half_max_f(mx);
    if (!done) tau = hi;
    for (int it = 0; it < 64; ++it) {
        if (!__any(!done)) break;
        const float mid = lo + (hi - lo) * 0.5f;
        int c = 0;
#pragma unroll
        for (int k = 0; k < MW; ++k) c += (row[k] >= mid) ? 1 : 0;
        c = half_sum_i(c);
        if (!done) {
            if (!(mid > lo && mid < hi)) { tau = hi; done = true; }
            else if (c == 256) { tau = mid; done = true; }
            else if (c > 256) lo = mid;
            else { hi = mid; tau = hi; }
        }
    }
    unsigned* mrow = mask + (size_t)(b * SEQ + s0 + h) * MW;
    unsigned mw = 0u;
#pragma unroll
    for (int k = 0; k < MW; ++k) {
        const unsigned long long bal = __ballot(row[k] >= tau);
        const unsigned wd = h ? (unsigned)(bal >> 32) : (unsigned)bal;
        if ((k & 31) == r) mw = wd;
        if ((k & 31) == 31 || k == MW - 1) { const int kk = (k & ~31) + r; if (kk < MW) mrow[kk] = mw; }
    }
}
__device__ __forceinline__ void p2_indexer(const Frame& F, int qslot) {
    volatile LAS unsigned* qw = (volatile LAS unsigned*)(F.lds + LDSCTL_OFF + 16);
    constexpr int NCH = NTOK / 16;
    for (;;) {
        if (F.tid == 0) qw[0] = atomicAdd(F.ctl + CW_QUEUE + 64 * qslot, 1u);
        __syncthreads();
        const int c = (int)qw[0];
        __syncthreads();
        if (c >= NCH) break;
        const int b = c & 3, tblk = (SEQ / 16 - 1) - (c >> 2);
        idx_task(F, b, tblk * 16 + 2 * F.wave);
    }
}
template <bool MLA> struct AttnCfg {
    static constexpr int DQK = MLA ? 192 : 128, PK = DQK * 2 + 16, PV = 320, KCH = DQK / 8, NKC = 64 * KCH / 512, KBYTES = 64 * PK, BUFB = 64 * PK + 64 * PV;
};
struct AttnUnit { int type, b, hx, blk; };

template <bool MLA>
__device__ __forceinline__ void attn_unit(const Frame& F, const AttnUnit u) {
    typedef AttnCfg<MLA> C;
    const int tid = F.tid, lane = F.lane, wave = F.wave, r = lane & 31, h = lane >> 5;
    LAS unsigned char* lds = F.lds;
    const bf16_t* qn = (const bf16_t*)(F.ws + WS_QN); const bf16_t* qr = (const bf16_t*)(F.ws + WS_QR); const bf16_t* kn = (const bf16_t*)(F.ws + WS_KN);
    const bf16_t* va = (const bf16_t*)(F.ws + WS_VA); const bf16_t* kpe = (const bf16_t*)(F.ws + WS_KPE);
    const bf16_t* qb = (const bf16_t*)(F.ws + WS_QB); const bf16_t* kb = (const bf16_t*)(F.ws + WS_KB); const bf16_t* vb = (const bf16_t*)(F.ws + WS_VB);
    const unsigned* mask = (const unsigned*)(F.ws + WS_MASK); bf16_t* oab = (bf16_t*)(F.ws + WS_OAB);
    const int b = u.b;
    const size_t rowb = (size_t)b * SEQ;
    int head, tw0, ntiles;
    if (MLA) { head = u.hx; tw0 = u.blk * 256 + 32 * wave; ntiles = (NMETA + u.blk * 256 + 255) / 64 + 1; }
    else { head = 4 * u.hx + (wave & 3); tw0 = u.blk * 64 + 32 * (wave >> 2); ntiles = (NMETA + u.blk * 64 + 63) / 64 + 1; }
    const int pw0 = NMETA + tw0;
    const int tq = pw0 + r;
    bf16x8 qf[C::DQK / 16];
    if (MLA) {
        const bf16_t* p0 = qn + (rowb + tw0 + r) * 2048 + head * 128 + 8 * h; const bf16_t* p1 = qr + (rowb + tw0 + r) * 1024 + head * 64 + 8 * h;
#pragma unroll
        for (int ks = 0; ks < 8; ++ks) qf[ks] = *(const bf16x8*)(p0 + 16 * ks);
#pragma unroll
        for (int ks = 0; ks < 4; ++ks) qf[8 + ks] = *(const bf16x8*)(p1 + 16 * ks);
    } else {
        const bf16_t* p0 = qb + (rowb + tw0 + r) * 2048 + head * 128 + 8 * h;
#pragma unroll
        for (int ks = 0; ks < 8; ++ks) qf[ks] = *(const bf16x8*)(p0 + 16 * ks);
    }
    const int ldkv = MLA ? 2048 : 512;
    const bf16_t* ktab = MLA ? kn + head * 128 : kb + u.hx * 128;
    const bf16_t* vtab = MLA ? va + head * 128 : vb + u.hx * 128;
    const bf16_t* kbase = ktab + (rowb - NMETA) * ldkv;
    const bf16_t* vbase = vtab + (rowb - NMETA) * ldkv;
    const bf16_t* pbase = kpe + (rowb - NMETA) * 64;
    unsigned soff[2]; int kdst[2], vdst[2];
#pragma unroll
    for (int i = 0; i < 2; ++i) { const int c = tid + 512 * i, key = c >> 4, pc = c & 15; soff[i] = (unsigned)(key * ldkv + pc * 8); kdst[i] = key * C::PK + pc * 16; vdst[i] = C::KBYTES + key * C::PV + pc * 16; }
    const unsigned poff = (unsigned)((tid >> 3) * 64 + (tid & 7) * 8); const int pdst = (tid >> 3) * C::PK + 256 + (tid & 7) * 16;
    u32x4 kst[2], vst[2], pst = (u32x4){0u, 0u, 0u, 0u};
    {
        const int key0 = tid >> 4;
        const size_t o0 = key0 < NMETA ? (size_t)(NTOK + key0) * ldkv + (tid & 15) * 8 : (rowb - NMETA) * ldkv + soff[0];
        kst[0] = *(const u32x4*)(ktab + o0); vst[0] = *(const u32x4*)(vtab + o0);
        kst[1] = *(const u32x4*)(kbase + soff[1]); vst[1] = *(const u32x4*)(vbase + soff[1]);
        if (MLA) { const int keyp = tid >> 3; pst = *(const u32x4*)(keyp < NMETA ? kpe + (size_t)(NTOK + keyp) * 64 + (tid & 7) * 8 : pbase + poff); }
    }
#pragma unroll
    for (int i = 0; i < 2; ++i) { *(LAS u32x4*)(lds + kdst[i]) = kst[i]; *(LAS u32x4*)(lds + vdst[i]) = vst[i]; }
    if (MLA) *(LAS u32x4*)(lds + pdst) = pst;
    __syncthreads();
    f32x16 oacc[4];
#pragma unroll
    for (int d = 0; d < 4; ++d)
#pragma unroll
        for (int i = 0; i < 16; ++i) oacc[d][i] = 0.f;
    float mrun = -INFINITY, lrun = 0.f;
    const int koff = r * C::PK + 16 * h;
    const int voff = C::KBYTES + (4 * h + ((lane & 15) >> 2)) * C::PV + (16 * ((lane >> 4) & 1) + 4 * (lane & 3)) * 2;
    const unsigned* mrow = mask + (rowb + tw0 + r) * MW;
    for (int kt = 0; kt < ntiles; ++kt) {
        const int cur = (kt & 1) * C::BUFB, nxt = ((kt + 1) & 1) * C::BUFB;
        const bool more = kt + 1 < ntiles;
        if (more) {
            const bf16_t* kb2 = kbase + (size_t)(kt + 1) * 64 * ldkv; const bf16_t* vb2 = vbase + (size_t)(kt + 1) * 64 * ldkv;
#pragma unroll
            for (int i = 0; i < 2; ++i) { kst[i] = *(const u32x4*)(kb2 + soff[i]); vst[i] = *(const u32x4*)(vb2 + soff[i]); }
            if (MLA) pst = *(const u32x4*)(pbase + (size_t)(kt + 1) * 64 * 64 + poff);
        }
        if (kt * 64 <= pw0 + 31) {
            u32x2 mwd = (u32x2){0u, 0u};
            if (!MLA) mwd = *(const u32x2*)(mrow + 2 * kt);
            f32x16 s0, s1;
#pragma unroll
            for (int i = 0; i < 16; ++i) { s0[i] = 0.f; s1[i] = 0.f; }
#pragma unroll
            for (int ks = 0; ks < C::DQK / 16; ++ks) {
                const bf16x8 k0 = *(const LAS bf16x8*)(lds + cur + koff + 32 * ks), k1 = *(const LAS bf16x8*)(lds + cur + koff + 32 * C::PK + 32 * ks);
                s0 = MFMA32(k0, qf[ks], s0); s1 = MFMA32(k1, qf[ks], s1);
            }
            if (MLA) {
                if (kt * 64 + 63 > pw0) {
                    const int kb0 = kt * 64 + 4 * h;
#pragma unroll
                    for (int i = 0; i < 16; ++i) { const int key = kb0 + (i & 3) + 8 * (i >> 2); if (key > tq) s0[i] = -INFINITY; if (key + 32 > tq) s1[i] = -INFINITY; }
                }
            } else {
                const unsigned m0 = mwd.x >> (4 * h), m1 = mwd.y >> (4 * h);
#pragma unroll
                for (int i = 0; i < 16; ++i) { const int bit = (i & 3) + 8 * (i >> 2); if (!((m0 >> bit) & 1u)) s0[i] = -INFINITY; if (!((m1 >> bit) & 1u)) s1[i] = -INFINITY; }
            }
            float mx = s0[0];
#pragma unroll
            for (int i = 1; i < 16; ++i) mx = fmaxf(mx, s0[i]);
#pragma unroll
            for (int i = 0; i < 16; ++i) mx = fmaxf(mx, s1[i]);
            mx = fmaxf(mx, __shfl_xor(mx, 32));
            const float mnew = fmaxf(mrun, mx);
            const float msafe = (mnew == -INFINITY) ? 0.f : mnew;
            const float alpha = __builtin_amdgcn_exp2f(mrun - msafe);
            mrun = mnew;
            float ps = 0.f;
#pragma unroll
            for (int i = 0; i < 16; ++i) { s0[i] = __builtin_amdgcn_exp2f(s0[i] - msafe); s1[i] = __builtin_amdgcn_exp2f(s1[i] - msafe); ps += s0[i] + s1[i]; }
            lrun = lrun * alpha + ps;
#pragma unroll
            for (int d = 0; d < 4; ++d)
#pragma unroll
                for (int i = 0; i < 16; ++i) oacc[d][i] *= alpha;
            bf16x8 pf[4];
            { u32x4 w;
              w.x = cvt_pk_bf16(s0[0], s0[1]); w.y = cvt_pk_bf16(s0[2], s0[3]); w.z = cvt_pk_bf16(s0[4], s0[5]); w.w = cvt_pk_bf16(s0[6], s0[7]); pf[0] = __builtin_bit_cast(bf16x8, w);
              w.x = cvt_pk_bf16(s0[8], s0[9]); w.y = cvt_pk_bf16(s0[10], s0[11]); w.z = cvt_pk_bf16(s0[12], s0[13]); w.w = cvt_pk_bf16(s0[14], s0[15]); pf[1] = __builtin_bit_cast(bf16x8, w);
              w.x = cvt_pk_bf16(s1[0], s1[1]); w.y = cvt_pk_bf16(s1[2], s1[3]); w.z = cvt_pk_bf16(s1[4], s1[5]); w.w = cvt_pk_bf16(s1[6], s1[7]); pf[2] = __builtin_bit_cast(bf16x8, w);
              w.x = cvt_pk_bf16(s1[8], s1[9]); w.y = cvt_pk_bf16(s1[10], s1[11]); w.z = cvt_pk_bf16(s1[12], s1[13]); w.w = cvt_pk_bf16(s1[14], s1[15]); pf[3] = __builtin_bit_cast(bf16x8, w); }
#pragma unroll
            for (int d = 0; d < 4; ++d)
#pragma unroll
                for (int kk = 0; kk < 4; ++kk) {
                    const s16x4 lo = __builtin_amdgcn_ds_read_tr16_b64_v4i16((LAS s16x4*)(lds + cur + voff + (16 * kk) * C::PV + 64 * d));
                    const s16x4 hi = __builtin_amdgcn_ds_read_tr16_b64_v4i16((LAS s16x4*)(lds + cur + voff + (16 * kk + 8) * C::PV + 64 * d));
                    const bf16x8 vf = __builtin_shufflevector(lo, hi, 0, 1, 2, 3, 4, 5, 6, 7);
                    oacc[d] = MFMA32(vf, pf[kk], oacc[d]);
                }
        }
        if (more) {
#pragma unroll
            for (int i = 0; i < 2; ++i) { *(LAS u32x4*)(lds + nxt + kdst[i]) = kst[i]; *(LAS u32x4*)(lds + nxt + vdst[i]) = vst[i]; }
            if (MLA) *(LAS u32x4*)(lds + nxt + pdst) = pst;
        }
        __syncthreads();
    }
    {
        const float lt = lrun + __shfl_xor(lrun, 32);
        const float inv = lt > 0.f ? 1.0f / lt : 0.f;
        bf16_t* op = oab + (rowb + tw0 + r) * 4096 + (MLA ? 0 : 2048) + head * 128 + 4 * h;
#pragma unroll
        for (int d = 0; d < 4; ++d)
#pragma unroll
            for (int g = 0; g < 4; ++g) { u32x2 w; w.x = cvt_pk_bf16(oacc[d][4 * g] * inv, oacc[d][4 * g + 1] * inv); w.y = cvt_pk_bf16(oacc[d][4 * g + 2] * inv, oacc[d][4 * g + 3] * inv);
                *(u32x2*)(op + 32 * d + 8 * g) = w; }
    }
}

constexpr int ATT_NUNITS = 16 * 64 + 64 * 16;
__device__ __forceinline__ void att_decode(int idx, AttnUnit& u) {
    int rem = idx;
    for (int L = 65; L >= 2; --L) {
        const int nm = (L >= 5 && ((L - 5) & 3) == 0) ? 64 : 0;
        if (rem < nm) { u.type = 0; u.blk = (L - 5) >> 2; u.b = rem & 3; u.hx = rem >> 2; return; }
        rem -= nm;
        if (rem < 16) { u.type = 1; u.blk = L - 2; u.b = rem & 3; u.hx = rem >> 2; return; }
        rem -= 16;
    }
    u.type = -1; u.blk = 0; u.b = 0; u.hx = 0;
}
__device__ __forceinline__ void p3_attention(const Frame& F, int qslot) {
#ifdef MK_SKIP_ATT
    {
        const u32x4* qn = (const u32x4*)(F.ws + WS_QN); const u32x4* qb = (const u32x4*)(F.ws + WS_QB); u32x4* o = (u32x4*)(F.ws + WS_OAB);
        const size_t gt = (size_t)(F.vcu * NWAVES + F.wave) * 64 + F.lane, NGT = (size_t)F.G * NWAVES * 64;
        for (size_t i = gt; i < (size_t)NTOK * 256; i += NGT) { const size_t row = i >> 8, c = i & 255; o[row * 512 + c] = qn[row * 256 + c]; o[row * 512 + 256 + c] = qb[row * 256 + c]; }
        return;
    }
#endif
    volatile LAS int* qw = (volatile LAS int*)(F.lds + LDSCTL_OFF + 32);
    for (;;) {
        if (F.tid == 0) { const int idx = (int)atomicAdd(F.ctl + CW_QUEUE + 64 * qslot, 1u); AttnUnit u; u.type = -1; u.b = 0; u.hx = 0; u.blk = 0; if (idx < ATT_NUNITS) att_decode(idx, u);
            qw[0] = u.type; qw[1] = u.b; qw[2] = u.hx; qw[3] = u.blk; }
        __syncthreads();
        AttnUnit u; u.type = qw[0]; u.b = qw[1]; u.hx = qw[2]; u.blk = qw[3];
        __syncthreads();
        if (u.type < 0) break;
        if (u.type == 0) attn_unit<true>(F, u); else attn_unit<false>(F, u);
    }
}
__device__ __forceinline__ float pk_idx(float v, int n) { return __uint_as_float((__float_as_uint(v) & ~127u) | (unsigned)n); }
__device__ __forceinline__ void route_task(const Frame& F, int tb, int hd) {
    const int lane = F.lane, r = lane & 31, h = lane >> 5;
    const bf16_t* pq = (const bf16_t*)(F.ws + WS_PQ); const bf16_t* skb = (const bf16_t*)(F.ws + WS_SK);
    int* eid = (int*)(F.ws + WS_EID); float* gate = (float*)(F.ws + WS_GATE);
    LAS float* wl = (LAS float*)(F.lds + F.wave * 16384);
    const int m = tb * 32 + r;
#pragma unroll 1
    for (int c = 0; c < 2; ++c) {
        const bf16_t* qp = pq + (size_t)m * 2048 + hd * 256 + c * 128 + 8 * h;
        bf16x8 qf[8];
#pragma unroll
        for (int ks = 0; ks < 8; ++ks) qf[ks] = *(const bf16x8*)(qp + 16 * ks);
        float v[64];
#pragma unroll
        for (int blk = 0; blk < 4; ++blk) {
            const bf16_t* sp = skb + (size_t)((hd * 2 + c) * 128 + 32 * blk + r) * 128 + 8 * h;
            f32x16 acc;
#pragma unroll
            for (int i = 0; i < 16; ++i) acc[i] = 0.f;
#pragma unroll
            for (int ks = 0; ks < 8; ++ks) acc = MFMA32(*(const bf16x8*)(sp + 16 * ks), qf[ks], acc);
#pragma unroll
            for (int i = 0; i < 16; ++i) v[blk * 16 + i] = pk_idx(acc[i], 32 * blk + (i & 3) + 8 * (i >> 2) + 4 * h);
        }
#pragma unroll 1
        for (int k = 0; k < 16; ++k) {
            float mx = v[0];
#pragma unroll
            for (int j = 1; j < 64; ++j) mx = fmaxf(mx, v[j]);
            mx = fmaxf(mx, __shfl_xor(mx, 32));
            if (h == 0) wl[(c * 16 + k) * 32 + r] = mx;
#pragma unroll
            for (int j = 0; j < 64; ++j) v[j] = (v[j] == mx) ? -INFINITY : v[j];
        }
    }
    LDS_WAIT(); asm volatile("" ::: "memory");
    float cs[50]; int ce[50];
    {
        unsigned t0[16], t1[16];
#pragma unroll
        for (int i = 0; i < 16; ++i) { t0[i] = __float_as_uint(wl[i * 32 + r]); t1[i] = __float_as_uint(wl[(16 + i) * 32 + r]); }
        int n = 0;
#pragma unroll
        for (int i = 0; i < 16; ++i)
#pragma unroll
            for (int j = 0; j < 16; ++j)
                if ((i + 1) * (j + 1) <= 16) {
                    const float s = __uint_as_float(t0[i] & ~127u) + __uint_as_float(t1[j] & ~127u);
                    cs[n] = __uint_as_float((__float_as_uint(s) & ~63u) | (unsigned)n); ce[n] = (int)((t0[i] & 127u) * 128u + (t1[j] & 127u)); ++n;
                }
    }
    float sum = 0.f, first = 0.f;
#pragma unroll 1
    for (int k = 0; k < 16; ++k) {
        float mx = cs[0];
#pragma unroll
        for (int j = 1; j < 50; ++j) mx = fmaxf(mx, cs[j]);
        int se = 0;
#pragma unroll
        for (int j = 0; j < 50; ++j) { const bool hit = (cs[j] == mx); se = hit ? ce[j] : se; cs[j] = hit ? -INFINITY : cs[j]; }
        if (k == 0) first = mx;
        const float ev = __expf(mx - first); sum += ev;
        if (h == 0) { wl[1024 + k * 32 + r] = ev; wl[1536 + k * 32 + r] = __int_as_float(se); }
    }
    LDS_WAIT(); asm volatile("" ::: "memory");
    const float inv = 1.0f / sum;
    if (h == 0) {
        int* ep = eid + (size_t)m * 128 + hd * 16; float* gp = gate + (size_t)m * 128 + hd * 16;
#pragma unroll
        for (int q = 0; q < 4; ++q) {
            *(int4*)(ep + 4 * q) = make_int4(__float_as_int(wl[1536 + (4 * q) * 32 + r]), __float_as_int(wl[1536 + (4 * q + 1) * 32 + r]), __float_as_int(wl[1536 + (4 * q + 2) * 32 + r]), __float_as_int(wl[1536 + (4 * q + 3) * 32 + r]));
            *(f32x4*)(gp + 4 * q) = (f32x4){wl[1024 + (4 * q) * 32 + r] * inv, wl[1024 + (4 * q + 1) * 32 + r] * inv, wl[1024 + (4 * q + 2) * 32 + r] * inv, wl[1024 + (4 * q + 3) * 32 + r] * inv}; }
    }
    LDS_WAIT(); asm volatile("" ::: "memory");
}
__device__ __forceinline__ void p7_routing(const Frame& F) {
    const int gw = F.vcu * NWAVES + F.wave, NGW = F.G * NWAVES;
    for (int it = gw; it < (NTOK / 32) * 8; it += NGW) route_task(F, it >> 3, it & 7);
}

__device__ __forceinline__ float rl_f(float v, int l) { return __int_as_float(__builtin_amdgcn_readlane(__float_as_int(v), l)); }
__device__ __forceinline__ float gelu_tanh(float x) {
    const float u = 0.7978845608028654f * (x + 0.044715f * x * x * x);
    const float e = __expf(2.0f * u);
    const float th = 1.0f - 2.0f / (e + 1.0f);
    return 0.5f * x * (1.0f + th);
}
__device__ __forceinline__ float wave_sum_dpp(float v) {
#define DPP_ADD(ctrl, rmask) v += __int_as_float(__builtin_amdgcn_update_dpp(0, __float_as_int(v), ctrl, rmask, 0xF, false))
    DPP_ADD(0xB1, 0xF); DPP_ADD(0x4E, 0xF); DPP_ADD(0x141, 0xF); DPP_ADD(0x140, 0xF); DPP_ADD(0x142, 0xA); DPP_ADD(0x143, 0xC);
#undef DPP_ADD
    return rl_f(v, 63);
}
typedef unsigned u32x6 __attribute__((ext_vector_type(6)));
typedef float f32x32 __attribute__((ext_vector_type(32)));
struct Row6 { u32x4 q[3]; };
__device__ __forceinline__ void row6_load(Row6& r, const unsigned char* tab, int e, int lane) {
    const u32x4* p = (const u32x4*)(tab + (size_t)e * 3072) + lane;
#pragma unroll
    for (int q = 0; q < 3; ++q) r.q[q] = p[64 * q];
}
__device__ __forceinline__ f32x32 row6_deq(const Row6& r, int g) {
    u32x6 w;
    if (g == 0) { w[0] = r.q[0].x; w[1] = r.q[0].y; w[2] = r.q[0].z; w[3] = r.q[0].w; w[4] = r.q[1].x; w[5] = r.q[1].y; }
    else { w[0] = r.q[1].z; w[1] = r.q[1].w; w[2] = r.q[2].x; w[3] = r.q[2].y; w[4] = r.q[2].z; w[5] = r.q[2].w; }
    return __builtin_amdgcn_cvt_scalef32_pk32_f32_fp6(w, 1.0f);
}
__device__ __forceinline__ float row6_dot(const Row6& r, const f32x2 (&hf)[32]) {
    f32x2 acc0 = (f32x2){0.f, 0.f}, acc1 = (f32x2){0.f, 0.f};
#pragma unroll
    for (int g = 0; g < 2; ++g) { const f32x32 d = row6_deq(r, g);
#pragma unroll
        for (int k = 0; k < 16; k += 2) { acc0 = __builtin_elementwise_fma((f32x2){d[2 * k], d[2 * k + 1]}, hf[16 * g + k], acc0); acc1 = __builtin_elementwise_fma((f32x2){d[2 * k + 2], d[2 * k + 3]}, hf[16 * g + k + 1], acc1); } }
    const f32x2 s = acc0 + acc1;
    return s.x + s.y;
}
__device__ __forceinline__ void row6_axpy(const Row6& r, float c, f32x2 (&o)[32]) {
    const f32x2 c2 = (f32x2){c, c};
#pragma unroll
    for (int g = 0; g < 2; ++g) { const f32x32 d = row6_deq(r, g);
#pragma unroll
        for (int k = 0; k < 16; ++k) o[16 * g + k] = __builtin_elementwise_fma((f32x2){d[2 * k], d[2 * k + 1]}, c2, o[16 * g + k]); }
}
__device__ __forceinline__ void expert_token(const Frame& F, int m, size_t orow) {
    const int lane = F.lane;
    const unsigned char* U = F.ws + WS_U; const unsigned char* V = F.ws + WS_V;
    const float* scu = (const float*)(F.ws + WS_SCU); const float* scv = (const float*)(F.ws + WS_SCV);
    const int* eid = (const int*)(F.ws + WS_EID); const float* gate = (const float*)(F.ws + WS_GATE);
    const bf16_t* h1b = (const bf16_t*)(F.ws + WS_H1B); const float* h1f = (const float*)(F.ws + WS_H1F);
    const u64* ssq = (const u64*)(F.ctl + CW_SSQ_H1); const float* gfin = F.in(15);
    const int e0 = eid[(size_t)m * 128 + lane], e1 = eid[(size_t)m * 128 + 64 + lane];
    f32x2 hf[32];
#pragma unroll
    for (int j = 0; j < 16; ++j) { const u32x2 x = *((const u32x2*)(h1b + (size_t)m * DM) + lane + 64 * j); hf[2 * j] = (f32x2){bf_lo(x.x), bf_hi(x.x)}; hf[2 * j + 1] = (f32x2){bf_lo(x.y), bf_hi(x.y)}; }
    const float g0 = gate[(size_t)m * 128 + lane] * scv[e0], g1 = gate[(size_t)m * 128 + 64 + lane] * scv[e1];
    const float rstd = __builtin_amdgcn_rsqf(ssq_get(ssq + m) * (1.0f / DM) + EPS);
    const float su0 = scu[e0] * rstd, su1 = scu[e1] * rstd;
    float a0 = 0.f, a1 = 0.f;
#define EIDX(e) (((e) < 64) ? __builtin_amdgcn_readlane(e0, (e)) : __builtin_amdgcn_readlane(e1, (e) - 64))
    {
        Row6 r0, r1, r2, r3;
        row6_load(r0, U, EIDX(0), lane); row6_load(r1, U, EIDX(1), lane); row6_load(r2, U, EIDX(2), lane); row6_load(r3, U, EIDX(3), lane);
#pragma unroll 1
        for (int e = 0; e < 128; e += 4) {
            const bool more = e + 4 < 128; float p;
            p = wave_sum_dpp(row6_dot(r0, hf)); if (more) row6_load(r0, U, EIDX(e + 4), lane); if (e < 64) { if (lane == e) a0 = p; } else { if (lane == e - 64) a1 = p; }
            p = wave_sum_dpp(row6_dot(r1, hf)); if (more) row6_load(r1, U, EIDX(e + 5), lane); if (e < 64) { if (lane == e + 1) a0 = p; } else { if (lane == e - 63) a1 = p; }
            p = wave_sum_dpp(row6_dot(r2, hf)); if (more) row6_load(r2, U, EIDX(e + 6), lane); if (e < 64) { if (lane == e + 2) a0 = p; } else { if (lane == e - 62) a1 = p; }
            p = wave_sum_dpp(row6_dot(r3, hf)); if (more) row6_load(r3, U, EIDX(e + 7), lane); if (e < 64) { if (lane == e + 3) a0 = p; } else { if (lane == e - 61) a1 = p; }
        }
    }
    const float c0 = gelu_tanh(a0 * su0) * g0, c1 = gelu_tanh(a1 * su1) * g1;
#define CIDX(e) (((e) < 64) ? rl_f(c0, (e)) : rl_f(c1, (e) - 64))
    f32x2 o[32];
#pragma unroll
    for (int i = 0; i < 32; ++i) o[i] = (f32x2){0.f, 0.f};
    {
        Row6 r0, r1, r2, r3;
        row6_load(r0, V, EIDX(0), lane); row6_load(r1, V, EIDX(1), lane); row6_load(r2, V, EIDX(2), lane); row6_load(r3, V, EIDX(3), lane);
#pragma unroll 1
        for (int e = 0; e < 128; e += 4) {
            const bool more = e + 4 < 128;
            row6_axpy(r0, CIDX(e), o); if (more) row6_load(r0, V, EIDX(e + 4), lane);
            row6_axpy(r1, CIDX(e + 1), o); if (more) row6_load(r1, V, EIDX(e + 5), lane);
            row6_axpy(r2, CIDX(e + 2), o); if (more) row6_load(r2, V, EIDX(e + 6), lane);
            row6_axpy(r3, CIDX(e + 3), o); if (more) row6_load(r3, V, EIDX(e + 7), lane);
        }
    }
#undef EIDX
#undef CIDX
    float s = 0.f;
#pragma unroll
    for (int j = 0; j < 16; ++j) { const f32x4 x = *((const f32x4*)(h1f + (size_t)m * DM) + lane + 64 * j); o[2 * j] += (f32x2){x[0], x[1]}; o[2 * j + 1] += (f32x2){x[2], x[3]};
        s += (o[2 * j].x * o[2 * j].x + o[2 * j].y * o[2 * j].y) + (o[2 * j + 1].x * o[2 * j + 1].x + o[2 * j + 1].y * o[2 * j + 1].y); }
    const float rs = 1.0f / sqrtf(wave_sum(s) * (1.0f / DM) + EPS);
    float* op = F.out() + orow * DM;
#pragma unroll
    for (int j = 0; j < 16; ++j) { const f32x4 g = *((const f32x4*)gfin + lane + 64 * j);
        *((f32x4*)op + lane + 64 * j) = (f32x4){o[2 * j].x * rs * g[0], o[2 * j].y * rs * g[1], o[2 * j + 1].x * rs * g[2], o[2 * j + 1].y * rs * g[3]}; }
}
#ifdef MK_STEP_B
__device__ __forceinline__ void stepb_token(const Frame& F, int m, size_t orow) {
    const int lane = F.lane; const float* x = (const float*)(F.ws + WS_H1F) + (size_t)m * DM; const float* gfin = F.in(15);
    f32x4 v[16]; float s = 0.f;
#pragma unroll
    for (int j = 0; j < 16; ++j) { v[j] = *((const f32x4*)x + lane + 64 * j); s += (v[j][0] * v[j][0] + v[j][1] * v[j][1]) + (v[j][2] * v[j][2] + v[j][3] * v[j][3]); }
    const float rs = 1.0f / sqrtf(wave_sum(s) * (1.0f / DM) + EPS);
#pragma unroll
    for (int j = 0; j < 16; ++j) { const f32x4 g = *((const f32x4*)gfin + lane + 64 * j); *((f32x4*)(F.out() + orow * DM) + lane + 64 * j) = v[j] * rs * g; }
}
#endif
#ifdef MK_STEP_A
__device__ __forceinline__ void stepa_token(const Frame& F, size_t orow) {
    const int lane = F.lane; const float* x = F.in(0) + orow * DM; const float* gfin = F.in(15);
    f32x4 v[16]; float s = 0.f;
#pragma unroll
    for (int j = 0; j < 16; ++j) { v[j] = *((const f32x4*)x + lane + 64 * j); s += (v[j][0] * v[j][0] + v[j][1] * v[j][1]) + (v[j][2] * v[j][2] + v[j][3] * v[j][3]); }
    const float rs = 1.0f / sqrtf(wave_sum(s) * (1.0f / DM) + EPS);
#pragma unroll
    for (int j = 0; j < 16; ++j) { const f32x4 g = *((const f32x4*)gfin + lane + 64 * j); *((f32x4*)(F.out() + orow * DM) + lane + 64 * j) = v[j] * rs * g; }
}
#endif
__device__ __forceinline__ void p8_experts(const Frame& F) {
    const int gw = F.vcu * NWAVES + F.wave, NGW = F.G * NWAVES;
#if defined(MK_STEP_A)
    for (int it = gw; it < NB * SEQ; it += NGW) stepa_token(F, (size_t)it);
#elif defined(MK_STEP_B)
    for (int it = gw; it < NB * SEQ; it += NGW) stepb_token(F, it, (size_t)it);
#else
    for (int it = gw; it < NB * SEQ; it += NGW) expert_token(F, it, (size_t)it);
#endif
}
struct Args { const float* in[16]; float* out; unsigned char* ws; int ph_lo, ph_hi; };
#define GEMM_RUN(EPI_T, g_, S_, E_) pg8::gemm_phase<EPI_T, pg8::StaticOrder, true, true>(F.lds, g_, S_, E_)
#define GEMM_RUN2(EPI_T, g_, S_, E_) pg8::gemm_phase<EPI_T, pg8::StaticOrder2, true, true>(F.lds, g_, S_, E_)

__global__ void __launch_bounds__(NWAVES * 64, 2) mk_fwd(Args args) {
    extern __shared__ __attribute__((aligned(16))) unsigned char lds_raw[];
    Frame F;
    F.lds = (LAS unsigned char*)lds_raw;
    F.ws = args.ws; F.ctl = (unsigned*)(args.ws + WS_CTL);
    F.tid = threadIdx.x; F.lane = F.tid & 63; F.wave = __builtin_amdgcn_readfirstlane(F.tid >> 6);
#define PHASE_BEGIN() do { int t_; asm volatile("v_mov_b32 %0, %1" : "=v"(t_) : "v"(threadIdx.x)); F.tid = t_; F.lane = t_ & 63; } while (0)
    F.G = gridDim.x; { const int bx = blockIdx.x; F.vcu = (F.G % 8 == 0) ? (bx % 8) * (F.G / 8) + bx / 8 : bx; }
    for (int u = F.tid; u < (LDS_BYTES - LDSCTL_OFF) / 4; u += NWAVES * 64) ((LAS unsigned*)(F.lds + LDSCTL_OFF))[u] = 0u;
    __syncthreads();
    XcdBarrier bar; bar.bar = F.ctl + CW_BAR; bar.x = 0; bar.st = nullptr;
    if (!MK_PER_PHASE) bar = xcd_barrier_post(F.ctl + CW_BAR, (volatile LAS unsigned*)(F.lds + LDSCTL_OFF));
    const int lo = args.ph_lo, hi = args.ph_hi;
#ifndef PH_MASK
#define PH_MASK 0x1FF
#endif
#define IN(k) (((PH_MASK >> (k)) & 1) && lo <= (k) && (k) < hi)
#ifdef MK_PROBE_T
#define STAMP(k) do { if (blockIdx.x == 0 && threadIdx.x == 0) ((volatile u64*)(F.ctl + 2048))[k] = __builtin_amdgcn_s_memrealtime(); } while (0)
#else
#define STAMP(k) do { } while (0)
#endif
#define SEAM(k) do { if (IN(k) && IN((k) + 1)) xcd_barrier(bar); STAMP((k) + 1); } while (0)
    unsigned char* ws = F.ws;

#ifndef MK_REP_MASK
#define MK_REP_MASK 0
#endif
#define NREP(k) (((MK_REP_MASK >> (k)) & 1) ? 2 : 1)
    STAMP(0);
    if (IN(0)) { for (int rep = 0; rep < NREP(0); ++rep) { PHASE_BEGIN(); p0_prologue(F); if (rep + 1 < NREP(0)) xcd_barrier(bar); } }
    SEAM(0);
    if (IN(1)) { for (int rep = 0; rep < NREP(1); ++rep) { PHASE_BEGIN();
        p1_quant_gates(F);
        xcd_barrier(bar);
        {
            pg8::Gemm g{(const bf16_t*)(ws + WS_XN8), (const bf16_t*)(ws + WS_WG8), MK, 8192, DM / 2, DM / 2}; pg8::StaticOrder S; S.init(MK, 8192, F.G, (int)blockIdx.x);
            epi::EpiGate E{(bf16_t*)(ws + WS_GA), (bf16_t*)(ws + WS_GB), (const float*)(ws + WS_SX), (const float*)(ws + WS_SW)};
            GEMM_RUN(epi::EpiGate, g, S, E); }
        __syncthreads();
        {
            pg8::Gemm g{(const bf16_t*)(ws + WS_XN), (const bf16_t*)(ws + WS_WIN), MK, 5888, DM, DM}; pg8::StaticOrder S; S.init(MK, 5888, F.G, (int)(gridDim.x - 1 - blockIdx.x));
            epi::EpiIn E{(bf16_t*)(ws + WS_CQ), (bf16_t*)(ws + WS_CKV), (bf16_t*)(ws + WS_QB), (bf16_t*)(ws + WS_KB), (bf16_t*)(ws + WS_VB), (bf16_t*)(ws + WS_QIX), (bf16_t*)(ws + WS_KPE), (bf16_t*)(ws + WS_KIX),
                          (bf16_t*)(ws + WS_GA), (bf16_t*)(ws + WS_GB), (float*)(ws + WS_WIX), rep ? nullptr : (u64*)(F.ctl + CW_SSQ_CQ), rep ? nullptr : (u64*)(F.ctl + CW_SSQ_CKV),
                          (const float*)(ws + WS_ROPE_M), (const float*)(ws + WS_ROPE_D), (const float*)(ws + WS_ROPE_I)};
            GEMM_RUN(epi::EpiIn, g, S, E); }
        if (rep + 1 < NREP(1)) xcd_barrier(bar); }
    }
    SEAM(1);
    if (IN(2)) { for (int rep = 0; rep < NREP(2); ++rep) { PHASE_BEGIN();
        { pg8::Gemm g{(const bf16_t*)(ws + WS_CQ), (const bf16_t*)(ws + WS_WUQ), NTOK, 3072, 1024, 1024}; pg8::StaticOrder S; S.init(NTOK, 3072, F.G, (int)blockIdx.x);
          epi::EpiUp E{(bf16_t*)(ws + WS_QN), (bf16_t*)(ws + WS_QR), 8, 2048, 1024, (const u64*)(F.ctl + CW_SSQ_CQ), 1.0f / 1024.0f, QA_SCALE, (const float*)(ws + WS_ROPE_M)};
          GEMM_RUN(epi::EpiUp, g, S, E); }
        __syncthreads();
        { pg8::Gemm g{(const bf16_t*)(ws + WS_CKV), (const bf16_t*)(ws + WS_WUKV), MK, 4096, 512, 512}; pg8::StaticOrder S; S.init(MK, 4096, F.G, (int)blockIdx.x);
          epi::EpiUp E{(bf16_t*)(ws + WS_KN), (bf16_t*)(ws + WS_VA), 8, 2048, 2048, (const u64*)(F.ctl + CW_SSQ_CKV), 1.0f / 512.0f, 1.0f, nullptr};
          GEMM_RUN(epi::EpiUp, g, S, E); }
        __syncthreads();
        p2_indexer(F, rep);
        if (rep + 1 < NREP(2)) xcd_barrier(bar); }
    }
    SEAM(2);
    if (IN(3)) { for (int rep = 0; rep < NREP(3); ++rep) { PHASE_BEGIN(); p3_attention(F, 2 + rep); if (rep + 1 < NREP(3)) xcd_barrier(bar); } }
    SEAM(3);
    if (IN(4)) { for (int rep = 0; rep < NREP(4); ++rep) { PHASE_BEGIN();
        pg8::Gemm g{(const bf16_t*)(ws + WS_OAB), (const bf16_t*)(ws + WS_WBR), NTOK, 4096, 4096, 2048}; pg8::StaticOrder2 S; S.init(NTOK, 4096, F.G, (int)blockIdx.x);
        epi::EpiBranch E{(const bf16_t*)(ws + WS_GA), (const bf16_t*)(ws + WS_GB), (bf16_t*)(ws + WS_MRG)};
        GEMM_RUN2(epi::EpiBranch, g, S, E);
        if (rep + 1 < NREP(4)) xcd_barrier(bar); }
    }
    SEAM(4);
    if (IN(5)) { for (int rep = 0; rep < NREP(5); ++rep) { PHASE_BEGIN();
        pg8::Gemm g{(const bf16_t*)(ws + WS_MRG), (const bf16_t*)(ws + WS_WOUT), NTOK, 4096, 4096, 4096}; pg8::StaticOrder S; S.init(NTOK, 4096, F.G, (int)blockIdx.x);
        epi::EpiOut E{F.in(0), F.in(1), (float*)(ws + WS_H1F), (bf16_t*)(ws + WS_H1B), rep ? nullptr : (u64*)(F.ctl + CW_SSQ_H1)};
        GEMM_RUN(epi::EpiOut, g, S, E);
        if (rep + 1 < NREP(5)) xcd_barrier(bar); }
    }
    SEAM(5);
    if (IN(6)) { for (int rep = 0; rep < NREP(6); ++rep) { PHASE_BEGIN();
        pg8::Gemm g{(const bf16_t*)(ws + WS_H1B), (const bf16_t*)(ws + WS_WQ), NTOK, 2048, 4096, 4096}; pg8::StaticOrder S; S.init(NTOK, 2048, F.G, (int)blockIdx.x);
        epi::EpiPQ E{(bf16_t*)(ws + WS_PQ), (const u64*)(F.ctl + CW_SSQ_H1)};
        GEMM_RUN(epi::EpiPQ, g, S, E);
        p6_tables(F);
        if (rep + 1 < NREP(6)) xcd_barrier(bar); }
    }
    SEAM(6);
    if (IN(7)) { for (int rep = 0; rep < NREP(7); ++rep) { PHASE_BEGIN(); p7_routing(F); if (rep + 1 < NREP(7)) xcd_barrier(bar); } }
    SEAM(7);
    if (IN(8)) { for (int rep = 0; rep < NREP(8); ++rep) { PHASE_BEGIN(); p8_experts(F); if (rep + 1 < NREP(8)) xcd_barrier(bar); } }
#ifdef MK_PROBE_T
    {   PHASE_BEGIN();
        xcd_barrier(bar); STAMP(9); xcd_barrier(bar);
        const volatile u64* ts = (const volatile u64*)(F.ctl + 2048);
        const float tot = (float)(ts[9] - ts[0]);
        const float f1 = (float)(ts[MK_PROBE_K1 + 1] - ts[MK_PROBE_K1]) / tot, f2 = (float)(ts[MK_PROBE_K2 + 1] - ts[MK_PROBE_K2]) / tot;
        float* o = F.out(); const size_t gt = (size_t)blockIdx.x * 512 + F.tid, NGT = (size_t)gridDim.x * 512;
        for (size_t i = gt; i < (size_t)NB * SEQ * DM / 4; i += NGT) { f32x4 v = ((f32x4*)o)[i]; v = v * (1.0f - f1); if (i == 0) v[0] = 1000.0f * f2; ((f32x4*)o)[i] = v; }
    }
#endif
#undef IN
#undef SEAM
}

extern "C" void kernel_launch(void* const* d_in, const int* in_sizes, int n_in, void* d_out, int out_size, void* d_ws, size_t ws_size, hipStream_t stream) {
    static int grid = 0;
    if (grid == 0) {
        if (n_in != 16 || in_sizes[0] != NB * SEQ * DM || out_size != NB * SEQ * DM || ws_size < WS_END) {
            fprintf(stderr, "kernel_launch: unexpected problem shape (n_in %d, in0 %d, out %d, ws %zu < %zu); nothing launched\n", n_in, n_in > 0 ? in_sizes[0] : -1, out_size, ws_size, (size_t)WS_END); grid = -1; return; }
        int dev = 0, cus = 0, per_cu = 0;
        if (hipGetDevice(&dev) != hipSuccess || hipDeviceGetAttribute(&cus, hipDeviceAttributeMultiprocessorCount, dev) != hipSuccess) { grid = -1; return; }
        if (hipFuncSetAttribute((const void*)mk_fwd, hipFuncAttributeMaxDynamicSharedMemorySize, LDS_BYTES) != hipSuccess) { fprintf(stderr, "kernel_launch: hipFuncSetAttribute failed\n"); grid = -1; return; }
        if (hipOccupancyMaxActiveBlocksPerMultiprocessor(&per_cu, (const void*)mk_fwd, NWAVES * 64, LDS_BYTES) != hipSuccess || per_cu < 1) {
            fprintf(stderr, "kernel_launch: occupancy query reports %d workgroups per CU\n", per_cu); }
        (void)hipGetLastError();
        grid = cus;
    }
    if (grid < 0) return;
    if (hipMemsetAsync((char*)d_ws + WS_CTL, 0, CTL_ZERO_BYTES, stream) != hipSuccess) return;
    Args a{};
    for (int i = 0; i < 16; ++i) a.in[i] = (const float*)d_in[i];
    a.out = (float*)d_out; a.ws = (unsigned char*)d_ws;
#if MK_PER_PHASE
    for (int p = 0; p <= MK_LAST_PHASE; ++p) { a.ph_lo = p; a.ph_hi = p + 1; hipLaunchKernelGGL(mk_fwd, dim3(grid), dim3(NWAVES * 64), LDS_BYTES, stream, a); }
#else
    a.ph_lo = 0; a.ph_hi = MK_LAST_PHASE + 1;
    hipLaunchKernelGGL(mk_fwd, dim3(grid), dim3(NWAVES * 64), LDS_BYTES, stream, a);
#endif
}
```

```cpp
#include <hip/hip_runtime.h>
#include <cstdio>
#include <cstdint>

#define LAS __attribute__((address_space(3)))
#define GAS __attribute__((address_space(1)))
typedef unsigned short bf16_t;
typedef short bf16x8 __attribute__((ext_vector_type(8)));
typedef short s16x4 __attribute__((ext_vector_type(4)));
typedef float f32x2 __attribute__((ext_vector_type(2)));
typedef float f32x4 __attribute__((ext_vector_type(4)));
typedef float f32x16 __attribute__((ext_vector_type(16)));
typedef unsigned u32x2 __attribute__((ext_vector_type(2)));
typedef unsigned u32x4 __attribute__((ext_vector_type(4)));
typedef GAS unsigned gu32;

#ifndef MK_PER_PHASE
#define MK_PER_PHASE 0
#endif
#ifndef MK_LAST_PHASE
#define MK_LAST_PHASE 8
#endif

constexpr int NB = 4, SEQ = 4096, DM = 4096, NMETA = 16, TR = SEQ + NMETA  , TP = 4224  , M = NB * TP  ;
constexpr float EPS = 1e-6f;
constexpr int NV1 = 14080;
constexpr float LOG2E = 1.4426950408889634f;
constexpr float QB_SCALE = 0.08838834764831845f * LOG2E;
constexpr float QA_SCALE = 0.07216878364870323f * LOG2E;
constexpr int NWAVES = 8;
constexpr int NTOK = NB * SEQ;
constexpr int MK = NTOK + 256;
constexpr int MW = 130;
__device__ __forceinline__ int row_pos(int row) { return row < NTOK ? NMETA + (row & (SEQ - 1)) : row - NTOK; }
__device__ __forceinline__ int pos_row(int b, int p) { return p < NMETA ? NTOK + p : b * SEQ + (p - NMETA); }

constexpr size_t HM = 512u * 1024u;
constexpr size_t WS_CTL = 0, CTL_ZERO_BYTES = 2 * HM;
constexpr size_t WS_ROPE_M = 2 * HM;
constexpr size_t WS_ROPE_D = 5 * HM;
constexpr size_t WS_ROPE_I = 7 * HM;
constexpr size_t WS_SK   = 8 * HM;
constexpr size_t WS_WUQ  = 10 * HM;
constexpr size_t WS_WUKV = 22 * HM;
constexpr size_t WS_WBR  = 30 * HM;
constexpr size_t WS_WOUT = 94 * HM;
constexpr size_t WS_WQ   = 158 * HM;
constexpr size_t WS_EID  = 190 * HM;
constexpr size_t WS_GATE = 207 * HM;
constexpr size_t WS_MASK = 224 * HM;
constexpr size_t WS_KPE  = 242 * HM;
constexpr size_t WS_KIX  = 247 * HM;
constexpr size_t WS_WIX  = 252 * HM;
constexpr size_t WS_SCU  = 255 * HM;
constexpr size_t WS_SCV  = 255 * HM + 65536;
constexpr size_t WS_SX   = 255 * HM + 131072;
constexpr size_t WS_SW   = 255 * HM + 262144;
constexpr size_t WS_SWBR = 255 * HM + 294912;
constexpr size_t WS_SWOUT= 255 * HM + 311296;
constexpr size_t WS_SOAB = 255 * HM + 327680;
constexpr size_t WS_SMRG = 255 * HM + 393216;
constexpr size_t R23 = 260 * HM;
constexpr size_t WS_XN   = R23;
constexpr size_t WS_WIN  = R23 + 264 * HM;
constexpr size_t P1O = R23 + 484 * HM;
constexpr size_t WS_CQ   = P1O;
constexpr size_t WS_CKV  = P1O + 66 * HM;
constexpr size_t WS_QB   = P1O + 99 * HM;
constexpr size_t WS_KB   = P1O + 231 * HM;
constexpr size_t WS_VB   = P1O + 264 * HM;
constexpr size_t WS_QIX  = P1O + 297 * HM;
constexpr size_t WS_GA   = P1O + 363 * HM;
constexpr size_t WS_GB   = P1O + 627 * HM;
constexpr size_t R4 = P1O + 892 * HM;
constexpr size_t WS_OAB  = R4;
constexpr size_t WS_XN8  = R4;
constexpr size_t WS_WG8  = R4 + 132 * HM;
constexpr size_t WS_PQ   = R4;
constexpr size_t WS_END  = R4 + 264 * HM;
constexpr size_t WS_QN   = R23;
constexpr size_t WS_QR   = R23 + 132 * HM;
constexpr size_t WS_KN   = R23 + 198 * HM;
constexpr size_t WS_VA   = R23 + 330 * HM;
constexpr size_t WS_MRG  = R23;
constexpr size_t WS_U    = R23;
constexpr size_t WS_V    = R23 + 256 * HM;
constexpr size_t WS_H1F  = R23 + 512 * HM;
constexpr size_t WS_H1B  = R23 + 1040 * HM;
static_assert(WS_VA + 132 * HM <= P1O && WS_H1F >= P1O && WS_H1B + 264 * HM <= R4 && WS_GB + 264 * HM <= R4, "ws map");
constexpr int CW_TMO = 0;
constexpr int CW_BAR = 4096;
constexpr int CW_QUEUE = 8192;
constexpr int CW_SSQ_CQ = 16384, CW_SSQ_CKV = 16384 + 2 * 17408, CW_SSQ_H1 = 16384 + 4 * 17408;
static_assert((CW_SSQ_H1 + 2 * 17408) * 4 <= (int)CTL_ZERO_BYTES, "ctl");

constexpr int RING_BYTES = 131072;
constexpr int LDSCTL_OFF = RING_BYTES;
constexpr int LDS_BYTES = 147456;

__device__ __forceinline__ unsigned f2bf(float f) { unsigned u = __float_as_uint(f); return (u + 0x7fffu + ((u >> 16) & 1u)) >> 16; }
__device__ __forceinline__ unsigned pk2(float lo, float hi) { return f2bf(lo) | (f2bf(hi) << 16); }
typedef __bf16 bf16x2_t __attribute__((ext_vector_type(2)));
__device__ __forceinline__ unsigned cvt_pk_bf16(float lo, float hi) { return __builtin_bit_cast(unsigned, __builtin_convertvector((f32x2){lo, hi}, bf16x2_t)); }
__device__ __forceinline__ float bf_lo(unsigned w) { return __uint_as_float(w << 16); }
__device__ __forceinline__ float bf_hi(unsigned w) { return __uint_as_float(w & 0xffff0000u); }
__device__ __forceinline__ u32x4 pack8(f32x4 a, f32x4 b) { u32x4 w; w.x = cvt_pk_bf16(a[0], a[1]); w.y = cvt_pk_bf16(a[2], a[3]); w.z = cvt_pk_bf16(b[0], b[1]); w.w = cvt_pk_bf16(b[2], b[3]); return w; }
__device__ __forceinline__ float wave_sum(float v) {
#pragma unroll
    for (int o = 1; o < 64; o <<= 1) v += __shfl_xor(v, o);
    return v;
}
#define LDS_WAIT() asm volatile("s_waitcnt lgkmcnt(0)" ::: "memory")
#define VM_WAIT() asm volatile("s_waitcnt vmcnt(0)" ::: "memory")
typedef unsigned long long u64;
__device__ __forceinline__ void ssq_add(u64* p, float v) { (void)__hip_atomic_fetch_add(p, (u64)(v * 16777216.0f), __ATOMIC_RELAXED, __HIP_MEMORY_SCOPE_AGENT); }
__device__ __forceinline__ float ssq_get(const u64* p) { return (float)((double)(*p) * (1.0 / 16777216.0)); }
namespace pg8 {
#define PG8_LAS __attribute__((address_space(3)))
typedef unsigned short bf16_t;
typedef short bf16x8 __attribute__((ext_vector_type(8)));
typedef float f32x4 __attribute__((ext_vector_type(4)));
typedef unsigned u32x4 __attribute__((ext_vector_type(4)));
constexpr int BM = 256, BK = 64, HALF = 128, HTB = HALF * BK * 2  , STAGE_BYTES = 8 * HTB, NXCD = 8, WGM = 8;

__host__ __device__ __forceinline__ int lds_byte(int r, int c) { const int st = (r >> 4) * 2 + (c >> 5), rr = r & 15, cc = c & 31, ob = rr * 64 + cc * 2; return st * 1024 + (ob ^ (((ob >> 9) & 1) << 5)); }
__host__ __device__ __forceinline__ void stage_rc(int b, int& R, int& C) { const int st = b / 1024, sb = b % 1024, swz = sb ^ (((sb >> 9) & 1) << 5); R = (st >> 1) * 16 + swz / 64; C = (st & 1) * 32 + (swz % 64) / 2; }
__host__ __device__ __forceinline__ int perm32(int rho) { const int n = rho >> 4, i = rho & 15; return 8 * (i >> 2) + 4 * n + (i & 3); }

typedef int i32x4_t __attribute__((ext_vector_type(4)));
typedef int i32x8_t __attribute__((ext_vector_type(8)));
__device__ __forceinline__ i32x8_t cat8(bf16x8 lo, bf16x8 hi) { const i32x4_t a = __builtin_bit_cast(i32x4_t, lo), b = __builtin_bit_cast(i32x4_t, hi); return __builtin_shufflevector(a, b, 0, 1, 2, 3, 4, 5, 6, 7); }
__device__ __forceinline__ void mfma_f8_acc(f32x4& c, const i32x8_t a, const i32x8_t b) {
#if defined(__HIP_DEVICE_COMPILE__)
    int sc = 0x7F7F7F7F;
    asm volatile("v_mfma_scale_f32_16x16x128_f8f6f4 %0, %1, %2, %0, %3, %3 op_sel_hi:[0,0,0]" : "+v"(c) : "v"(a), "v"(b), "v"(sc));
#else
    (void)c; (void)a; (void)b;
#endif
}
struct Unit { int pm, pn, kh; };
struct Gemm { const bf16_t* A; const bf16_t* Bt; int M, N, K, KL; };

struct StaticOrder {
    int nM, nN, nwg, G, c;
    __host__ __device__ void init(int M, int N, int G_, int c_) { nM = M / BM; nN = N / BM; nwg = nM * nN; G = G_; c = c_; }
    __host__ __device__ bool next(int i, Unit& u) const {
        const long L = (long)i * G + c; if (L >= nwg) return false;
        int wgid = (int)L; { const int q = nwg / NXCD, r = nwg % NXCD, xcd = wgid % NXCD, off = wgid / NXCD; wgid = (xcd < r ? xcd * (q + 1) : r * (q + 1) + (xcd - r) * q) + off; }
        const int nig = WGM * nN, gid = wgid / nig, fm = gid * WGM, gsz = (nM - fm) < WGM ? (nM - fm) : WGM;
        u.pm = fm + ((wgid % nig) % gsz); u.pn = (wgid % nig) / gsz; u.kh = 0; return true;
    }
    __device__ __forceinline__ void a_ready(const Unit&) const {}
    __device__ __forceinline__ void done(const Unit&) const {}
};

struct StaticOrder2 {
    StaticOrder base;
    __host__ __device__ void init(int M, int N, int G_, int c_) { base.init(M, N, G_, c_); }
    __host__ __device__ bool next(int i, Unit& u) const { if (!base.next(i >> 1, u)) return false; u.kh = i & 1; return true; }
    __device__ __forceinline__ void a_ready(const Unit&) const {}
    __device__ __forceinline__ void done(const Unit&) const {}
};

template <class Epi, class Sched, bool ALIGN_EPI = false, bool SP2 = false>
__device__ __forceinline__ void gemm_phase(PG8_LAS unsigned char* lds, const Gemm g, const Sched& S, const Epi& E) {
    int tid_; asm volatile("v_mov_b32 %0, %1" : "=v"(tid_) : "v"(threadIdx.x));
    const int tid = tid_, wid = __builtin_amdgcn_readfirstlane(tid >> 6), lane = tid & 63, wr = wid >> 2, wc = wid & 3, fr = lane & 15, fq = lane >> 4;
    const int K = g.K, nt = g.KL / BK; const size_t khoff = (size_t)g.KL * 2;
    unsigned voffA[2], voffB[2];
#pragma unroll
    for (int i = 0; i < 2; ++i) { int R, C; stage_rc(tid * 16 + i * 8192, R, C); const int Rb = Epi::PERM ? ((R & ~31) + perm32(R & 31)) : R;
        voffA[i] = (unsigned)(R * K + C) * 2u; voffB[i] = (unsigned)(Rb * K + C) * 2u; }
    const size_t kstep = (size_t)(BK * 2);
    const size_t hstep = (size_t)HALF * K * 2;
    const size_t tstep = 2 * hstep;
    const unsigned ldsw = (unsigned)wid * 1024u;
    const int aoff = lds_byte(wr * 64 + fr, fq * 8), boff = lds_byte(wc * 32 + fr, fq * 8);
#define PG8_SA(b, h) (((b) * 2 + (h)) * HTB)
#define PG8_SB(b, h) ((4 + (b) * 2 + (h)) * HTB)
#define PG8_STAGE(bufoff, gbase, voff) do { _Pragma("unroll") for (int _i = 0; _i < 2; ++_i) \
        __builtin_amdgcn_global_load_lds((const unsigned*)((const char*)(gbase) + (voff)[_i]), (PG8_LAS unsigned*)(lds + (bufoff) + ldsw + _i * 8192), 16, 0, 0); } while (0)
#define PG8_LDA(dst, b, h) do { _Pragma("unroll") for (int m = 0; m < 4; ++m) _Pragma("unroll") for (int k = 0; k < 2; ++k) dst[m][k] = *(const PG8_LAS bf16x8*)(lds + PG8_SA(b, h) + aoff + m * 2048 + k * 1024); } while (0)
#define PG8_LDB(dst, b, h) do { _Pragma("unroll") for (int n = 0; n < 2; ++n) _Pragma("unroll") for (int k = 0; k < 2; ++k) dst[n][k] = *(const PG8_LAS bf16x8*)(lds + PG8_SB(b, h) + boff + n * 2048 + k * 1024); } while (0)
#define PG8_MMA(ai, bj, At, Bt) do { __builtin_amdgcn_s_setprio(1); _Pragma("unroll") for (int m = 0; m < 4; ++m) _Pragma("unroll") for (int n = 0; n < 2; ++n) { \
        if constexpr (Epi::FP8) mfma_f8_acc(acc[ai][bj][m][n], cat8(Bt[n][0], Bt[n][1]), cat8(At[m][0], At[m][1])); \
        else { _Pragma("unroll") for (int k = 0; k < 2; ++k) acc[ai][bj][m][n] = __builtin_amdgcn_mfma_f32_16x16x32_bf16(Bt[n][k], At[m][k], acc[ai][bj][m][n], 0, 0, 0); } } \
        __builtin_amdgcn_s_setprio(0); } while (0)
#define PG8_WAIT_V(n) asm volatile("s_waitcnt vmcnt(" #n ")" ::: "memory")
#define PG8_WAIT_L(n) asm volatile("s_waitcnt lgkmcnt(" #n ")" ::: "memory")
#define PG8_BAR __builtin_amdgcn_s_barrier()
#define PG8_SCHED __builtin_amdgcn_sched_barrier(0)
    Unit cur, nxt; int ui = 0;
    if (!S.next(0, cur)) return;
    f32x4 acc[2][2][4][2];
#pragma unroll
    for (int a = 0; a < 2; ++a)
#pragma unroll
        for (int b = 0; b < 2; ++b)
#pragma unroll
            for (int m = 0; m < 4; ++m)
#pragma unroll
                for (int n = 0; n < 2; ++n) acc[a][b][m][n] = (f32x4){0.f, 0.f, 0.f, 0.f};
    bf16x8 At[4][2], B0[2][2], B1[2][2];
    const char* cA = (const char*)g.A + (size_t)cur.pm * tstep + (size_t)cur.kh * khoff; const char* cB = (const char*)g.Bt + (size_t)cur.pn * tstep + (size_t)cur.kh * khoff;
    S.a_ready(cur);
    if constexpr (SP2) {
        PG8_STAGE(PG8_SB(0, 0), cB, voffB); PG8_STAGE(PG8_SB(0, 1), cB + hstep, voffB); PG8_STAGE(PG8_SA(0, 0), cA, voffA); PG8_STAGE(PG8_SA(0, 1), cA + hstep, voffA);
        if (wr == 1) PG8_BAR;
        PG8_WAIT_V(2); PG8_BAR;
        PG8_STAGE(PG8_SB(1, 0), cB + kstep, voffB); PG8_STAGE(PG8_SA(1, 0), cA + kstep, voffA); PG8_STAGE(PG8_SB(1, 1), cB + hstep + kstep, voffB);
        PG8_WAIT_V(6); PG8_BAR;
    } else {
        PG8_STAGE(PG8_SB(0, 0), cB, voffB); PG8_STAGE(PG8_SA(0, 0), cA, voffA); PG8_STAGE(PG8_SB(0, 1), cB + hstep, voffB); PG8_STAGE(PG8_SA(0, 1), cA + hstep, voffA);
        if (wr == 1) PG8_BAR;
        PG8_WAIT_V(4); PG8_BAR;
        PG8_STAGE(PG8_SB(1, 0), cB + kstep, voffB); PG8_STAGE(PG8_SA(1, 0), cA + kstep, voffA); PG8_STAGE(PG8_SB(1, 1), cB + hstep + kstep, voffB);
        PG8_WAIT_V(6); PG8_BAR;
    }
    for (;;) {
        const bool has_next = S.next(ui + 1, nxt);
        const char* nA = has_next ? (const char*)g.A + (size_t)nxt.pm * tstep + (size_t)nxt.kh * khoff : cA; const char* nB = has_next ? (const char*)g.Bt + (size_t)nxt.pn * tstep + (size_t)nxt.kh * khoff : cB;
        for (int t = 0; t < nt; t += 2) {
            const bool last = (t == nt - 2);
            const char* a1 = cA + (size_t)(t + 1) * kstep;
            const char* a2 = last ? nA : cA + (size_t)(t + 2) * kstep; const char* b2 = last ? nB : cB + (size_t)(t + 2) * kstep;
            const char* a3 = a2 + kstep; const char* b3 = b2 + kstep;
            if (last && has_next) S.a_ready(nxt);
            if constexpr (SP2) {
            PG8_LDB(B0, 0, 0); PG8_LDB(B1, 0, 1); PG8_SCHED; PG8_LDA(At, 0, 0); PG8_STAGE(PG8_SA(1, 1), a1 + hstep, voffA);
            PG8_WAIT_V(8); PG8_WAIT_L(0); PG8_BAR; PG8_MMA(0, 0, At, B0); PG8_MMA(0, 1, At, B1); PG8_BAR; PG8_SCHED;
            PG8_LDA(At, 0, 1); PG8_STAGE(PG8_SB(0, 0), b2, voffB); PG8_STAGE(PG8_SB(0, 1), b2 + hstep, voffB); PG8_STAGE(PG8_SA(0, 0), a2, voffA);
            PG8_WAIT_V(8); PG8_WAIT_L(0); PG8_BAR; PG8_MMA(1, 0, At, B0); PG8_MMA(1, 1, At, B1); PG8_BAR; PG8_SCHED;
            PG8_LDB(B0, 1, 0); PG8_LDB(B1, 1, 1); PG8_SCHED; PG8_LDA(At, 1, 0); PG8_STAGE(PG8_SA(0, 1), a2 + hstep, voffA);
            PG8_WAIT_V(8); PG8_WAIT_L(0); PG8_BAR; PG8_MMA(0, 0, At, B0); PG8_MMA(0, 1, At, B1); PG8_BAR; PG8_SCHED;
            PG8_LDA(At, 1, 1); PG8_STAGE(PG8_SB(1, 0), b3, voffB); PG8_STAGE(PG8_SB(1, 1), b3 + hstep, voffB); PG8_STAGE(PG8_SA(1, 0), a3, voffA);
            PG8_WAIT_V(8); PG8_WAIT_L(0); PG8_BAR; PG8_MMA(1, 0, At, B0); PG8_MMA(1, 1, At, B1); PG8_BAR; PG8_SCHED;
            } else {
            PG8_LDB(B0, 0, 0); PG8_SCHED; PG8_LDA(At, 0, 0); PG8_STAGE(PG8_SA(1, 1), a1 + hstep, voffA);
            PG8_WAIT_L(8); PG8_BAR; PG8_WAIT_L(0); PG8_MMA(0, 0, At, B0); PG8_BAR; PG8_SCHED;
            PG8_LDB(B1, 0, 1); PG8_STAGE(PG8_SB(0, 0), b2, voffB);
            PG8_BAR; PG8_WAIT_L(0); PG8_MMA(0, 1, At, B1); PG8_BAR;
            PG8_LDA(At, 0, 1); PG8_STAGE(PG8_SA(0, 0), a2, voffA);
            PG8_BAR; PG8_WAIT_L(0); PG8_MMA(1, 0, At, B0); PG8_BAR; PG8_SCHED;
            PG8_STAGE(PG8_SB(0, 1), b2 + hstep, voffB);
            PG8_WAIT_V(6); PG8_BAR; PG8_MMA(1, 1, At, B1); PG8_BAR;
            PG8_LDB(B0, 1, 0); PG8_SCHED; PG8_LDA(At, 1, 0); PG8_STAGE(PG8_SA(0, 1), a2 + hstep, voffA);
            PG8_WAIT_L(8); PG8_BAR; PG8_WAIT_L(0); PG8_MMA(0, 0, At, B0); PG8_BAR; PG8_SCHED;
            PG8_LDB(B1, 1, 1); PG8_STAGE(PG8_SB(1, 0), b3, voffB);
            PG8_BAR; PG8_WAIT_L(0); PG8_MMA(0, 1, At, B1); PG8_BAR;
            PG8_LDA(At, 1, 1); PG8_STAGE(PG8_SA(1, 0), a3, voffA);
            PG8_BAR; PG8_WAIT_L(0); PG8_MMA(1, 0, At, B0); PG8_BAR; PG8_SCHED;
            PG8_STAGE(PG8_SB(1, 1), b3 + hstep, voffB);
            PG8_WAIT_V(6); PG8_BAR; PG8_MMA(1, 1, At, B1); PG8_BAR;
            }
        }
        if constexpr (ALIGN_EPI) { if (wr == 0) PG8_BAR; }
        if constexpr (!Epi::AFTER_DRAIN) { E(acc, cur, wr, wc, fr, fq); S.done(cur); }
        if (!has_next) break;
        if (!(Epi::SPLITK2 && cur.kh == 0))
#pragma unroll
        for (int a = 0; a < 2; ++a)
#pragma unroll
            for (int b = 0; b < 2; ++b)
#pragma unroll
                for (int m = 0; m < 4; ++m)
#pragma unroll
                    for (int n = 0; n < 2; ++n) acc[a][b][m][n] = (f32x4){0.f, 0.f, 0.f, 0.f};
        cur = nxt; cA = nA; cB = nB; ++ui;
        if constexpr (ALIGN_EPI) { if (wr == 1) PG8_BAR; }
    }
    PG8_WAIT_V(0);
    if constexpr (!ALIGN_EPI) { if (wr == 0) PG8_BAR; }
    PG8_BAR;
    if constexpr (Epi::AFTER_DRAIN) { E.fused(acc, cur, wr, wc, fr, fq, lds, wid, lane); S.done(cur); }
#undef PG8_SA
#undef PG8_SB
#undef PG8_STAGE
#undef PG8_LDA
#undef PG8_LDB
#undef PG8_MMA
#undef PG8_WAIT_V
#undef PG8_WAIT_L
#undef PG8_BAR
#undef PG8_SCHED
}
}
namespace epi {
using pg8::Unit;
typedef f32x4 Acc[2][2][4][2];

__device__ __forceinline__ void rot2(f32x4& v, const f32x4 cs) {
    const float a1 = v[0] * cs[0] - v[1] * cs[1], a2 = v[1] * cs[0] + v[0] * cs[1];
    const float b1 = v[2] * cs[2] - v[3] * cs[3], b2 = v[3] * cs[2] + v[2] * cs[3];
    v = (f32x4){a1, a2, b1, b2};
}
__device__ __forceinline__ float sigm(float x) { return 1.0f / (1.0f + __expf(-x)); }

struct EpiIn {
    static constexpr bool PERM = true, AFTER_DRAIN = false, SPLITK2 = false, FP8 = false;
    bf16_t *cq, *ckv, *qb, *kb, *vb, *qix, *kpe, *kix, *ga, *gb; float* wix; u64 *ssq_cq, *ssq_ckv;
    const float *ropeM, *ropeD, *ropeI;
    __device__ __forceinline__ void operator()(const Acc& acc, const Unit& u, int wr, int wc, int fr, int fq) const {
        const int vt = u.pn, rowb = u.pm * 256 + wr * 64 + fr, ct = wc * 32 + 8 * fq;
        if (vt < 6) {
            bf16_t* dst = vt < 4 ? cq : ckv; const int ld = vt < 4 ? 1024 : 512, cb = (vt < 4 ? vt : vt - 4) * 256 + ct; u64* ssq = vt < 4 ? ssq_cq : ssq_ckv;
#pragma unroll
            for (int ai = 0; ai < 2; ++ai)
#pragma unroll
                for (int m = 0; m < 4; ++m) { const int row = rowb + ai * 128 + m * 16; float s = 0.f;
#pragma unroll
                    for (int bj = 0; bj < 2; ++bj) { const f32x4 v0 = acc[ai][bj][m][0], v1 = acc[ai][bj][m][1];
                        s += (v0[0] * v0[0] + v0[1] * v0[1]) + (v0[2] * v0[2] + v0[3] * v0[3]) + (v1[0] * v1[0] + v1[1] * v1[1]) + (v1[2] * v1[2] + v1[3] * v1[3]);
                        *(u32x4*)(dst + (size_t)row * ld + cb + bj * 128) = pack8(v0, v1); }
                    s += __shfl_xor(s, 16); s += __shfl_xor(s, 32);
                    if (fq == 0 && ssq) ssq_add(ssq + row, s); }
        } else if (vt < 16) {
            const bool isq = vt < 14; bf16_t* dst = isq ? qb : kb; const int ld = isq ? 2048 : 512, cb = (isq ? vt - 6 : vt - 14) * 256 + ct; const float sc = isq ? QB_SCALE : 1.f;
#pragma unroll
            for (int ai = 0; ai < 2; ++ai)
#pragma unroll
                for (int m = 0; m < 4; ++m) { const int row = rowb + ai * 128 + m * 16, t = row_pos(row);
                    f32x4 cs0 = (f32x4){1.f, 0.f, 1.f, 0.f}, cs1 = cs0;
                    if (wc == 0) { const f32x4* p = (const f32x4*)(ropeD + ((size_t)t * 16 + 4 * fq) * 2); cs0 = p[0]; cs1 = p[1]; }
#pragma unroll
                    for (int bj = 0; bj < 2; ++bj) { f32x4 v0 = acc[ai][bj][m][0], v1 = acc[ai][bj][m][1];
                        if (wc == 0) { rot2(v0, cs0); rot2(v1, cs1); }
                        v0 = v0 * sc; v1 = v1 * sc;
                        *(u32x4*)(dst + (size_t)row * ld + cb + bj * 128) = pack8(v0, v1); } }
        } else if (vt < 18) {
            const int cb = (vt - 16) * 256 + ct;
#pragma unroll
            for (int ai = 0; ai < 2; ++ai)
#pragma unroll
                for (int m = 0; m < 4; ++m) { const int row = rowb + ai * 128 + m * 16;
#pragma unroll
                    for (int bj = 0; bj < 2; ++bj) *(u32x4*)(vb + (size_t)row * 512 + cb + bj * 128) = pack8(acc[ai][bj][m][0], acc[ai][bj][m][1]); }
        } else if (vt < 22) {
            const int cb = (vt - 18) * 256 + ct; const bool rt = ((wc & 1) == 0) && (fq < 2);
#pragma unroll
            for (int ai = 0; ai < 2; ++ai)
#pragma unroll
                for (int m = 0; m < 4; ++m) { const int row = rowb + ai * 128 + m * 16, t = row_pos(row);
                    f32x4 cs0 = (f32x4){1.f, 0.f, 1.f, 0.f}, cs1 = cs0;
                    if (rt) { const f32x4* p = (const f32x4*)(ropeI + ((size_t)t * 8 + 4 * fq) * 2); cs0 = p[0]; cs1 = p[1]; }
#pragma unroll
                    for (int bj = 0; bj < 2; ++bj) { f32x4 v0 = acc[ai][bj][m][0], v1 = acc[ai][bj][m][1];
                        if (rt) { rot2(v0, cs0); rot2(v1, cs1); }
                        *(u32x4*)(qix + (size_t)row * 1024 + cb + bj * 128) = pack8(v0, v1); } }
        } else if (vt == 22) {
#pragma unroll
            for (int ai = 0; ai < 2; ++ai)
#pragma unroll
                for (int m = 0; m < 4; ++m) { const int row = rowb + ai * 128 + m * 16, t = row_pos(row);
                    f32x4 v0 = acc[ai][0][m][0], v1 = acc[ai][0][m][1];
                    if (wc < 2) { const f32x4* p = (const f32x4*)(ropeM + ((size_t)t * 32 + 16 * wc + 4 * fq) * 2); rot2(v0, p[0]); rot2(v1, p[1]);
                        *(u32x4*)(kpe + (size_t)row * 64 + ct) = pack8(v0, v1);
                    } else { if (wc == 2 && fq < 2) { const f32x4* p = (const f32x4*)(ropeI + ((size_t)t * 8 + 4 * fq) * 2); rot2(v0, p[0]); rot2(v1, p[1]); }
                        *(u32x4*)(kix + (size_t)row * 64 + (ct - 64)) = pack8(v0, v1); }
                    if (wc == 0 && fq < 2) { float* w = wix + (size_t)row * 16 + 8 * fq; *(f32x4*)w = acc[ai][1][m][0]; *(f32x4*)(w + 4) = acc[ai][1][m][1]; } }
        } else {
            const bool isa = vt < 39; bf16_t* dst = isa ? ga : gb; const int cb = (isa ? vt - 23 : vt - 39) * 256 + ct;
#pragma unroll
            for (int ai = 0; ai < 2; ++ai)
#pragma unroll
                for (int m = 0; m < 4; ++m) { const int row = rowb + ai * 128 + m * 16;
#pragma unroll
                    for (int bj = 0; bj < 2; ++bj) { f32x4 v0 = acc[ai][bj][m][0], v1 = acc[ai][bj][m][1];
#pragma unroll
                        for (int e = 0; e < 4; ++e) { v0[e] = sigm(v0[e]); v1[e] = sigm(v1[e]); }
                        *(u32x4*)(dst + (size_t)row * 4096 + cb + bj * 128) = pack8(v0, v1); } }
        }
    }
};

struct EpiGate {
    static constexpr bool PERM = true, AFTER_DRAIN = false, SPLITK2 = false, FP8 = true;
    bf16_t *ga, *gb; const float *sx, *sw;
    __device__ __forceinline__ void operator()(const Acc& acc, const Unit& u, int wr, int wc, int fr, int fq) const {
        const int vt = u.pn, rowb = u.pm * 256 + wr * 64 + fr, ct = wc * 32 + 8 * fq;
        const bool isa = vt < 16; bf16_t* dst = isa ? ga : gb; const int cb = (isa ? vt : vt - 16) * 256 + ct;
        f32x4 w0[2], w1[2];
#pragma unroll
        for (int bj = 0; bj < 2; ++bj) { const f32x4* p = (const f32x4*)(sw + vt * 256 + ct + bj * 128); w0[bj] = p[0]; w1[bj] = p[1]; }
#pragma unroll
        for (int ai = 0; ai < 2; ++ai)
#pragma unroll
            for (int m = 0; m < 4; ++m) { const int row = rowb + ai * 128 + m * 16; const float rs = sx[row];
#pragma unroll
                for (int bj = 0; bj < 2; ++bj) { f32x4 v0 = acc[ai][bj][m][0] * rs * w0[bj], v1 = acc[ai][bj][m][1] * rs * w1[bj];
#pragma unroll
                    for (int e = 0; e < 4; ++e) { v0[e] = sigm(v0[e]); v1[e] = sigm(v1[e]); }
                    *(u32x4*)(dst + (size_t)row * 4096 + cb + bj * 128) = pack8(v0, v1); } }
    }
};

struct EpiUp {
    static constexpr bool PERM = true, AFTER_DRAIN = false, SPLITK2 = false, FP8 = false;
    bf16_t *d0, *d1; int nt0, ld0, ld1; const u64* ssq; float invK, scale; const float* rope;
    __device__ __forceinline__ void operator()(const Acc& acc, const Unit& u, int wr, int wc, int fr, int fq) const {
        const int vt = u.pn, rowb = u.pm * 256 + wr * 64 + fr, ct = wc * 32 + 8 * fq; const bool first = vt < nt0;
        bf16_t* dst = first ? d0 : d1; const int ld = first ? ld0 : ld1, cb = (first ? vt : vt - nt0) * 256 + ct; const bool rt = (!first) && (rope != nullptr);
#pragma unroll
        for (int ai = 0; ai < 2; ++ai)
#pragma unroll
            for (int m = 0; m < 4; ++m) { const int row = rowb + ai * 128 + m * 16, t = row_pos(row);
                const float rs = __builtin_amdgcn_rsqf(ssq_get(ssq + row) * invK + EPS) * scale;
                f32x4 cs0 = (f32x4){1.f, 0.f, 1.f, 0.f}, cs1 = cs0;
                if (rt) { const f32x4* p = (const f32x4*)(rope + ((size_t)t * 32 + 16 * (wc & 1) + 4 * fq) * 2); cs0 = p[0]; cs1 = p[1]; }
#pragma unroll
                for (int bj = 0; bj < 2; ++bj) { f32x4 v0 = acc[ai][bj][m][0] * rs, v1 = acc[ai][bj][m][1] * rs;
                    if (rt) { rot2(v0, cs0); rot2(v1, cs1); }
                    *(u32x4*)(dst + (size_t)row * ld + cb + bj * 128) = pack8(v0, v1); } }
    }
};

struct EpiBranch {
    static constexpr bool PERM = true, AFTER_DRAIN = false, SPLITK2 = true, FP8 = true;
    const bf16_t *ga, *gb; bf16_t* out; const float *srow, *scol;
    __device__ __forceinline__ void operator()(Acc& acc, const Unit& u, int wr, int wc, int fr, int fq) const {
        const int rowb = u.pm * 256 + wr * 64 + fr, cb = u.pn * 256 + wc * 32 + 8 * fq;
        if (u.kh == 0) {
#pragma unroll
            for (int ai = 0; ai < 2; ++ai)
#pragma unroll
                for (int m = 0; m < 4; ++m) { const size_t ro = (size_t)(rowb + ai * 128 + m * 16) * 4096 + cb;
#pragma unroll
                    for (int bj = 0; bj < 2; ++bj) { const u32x4 a = *(const u32x4*)(ga + ro + bj * 128), b = *(const u32x4*)(gb + ro + bj * 128);
                        f32x4 r0, r1;
#define RQ(x, y) ((x) * __builtin_amdgcn_rcpf(y))
                        r0[0] = RQ(bf_lo(a.x), bf_lo(b.x)); r0[1] = RQ(bf_hi(a.x), bf_hi(b.x)); r0[2] = RQ(bf_lo(a.y), bf_lo(b.y)); r0[3] = RQ(bf_hi(a.y), bf_hi(b.y));
                        r1[0] = RQ(bf_lo(a.z), bf_lo(b.z)); r1[1] = RQ(bf_hi(a.z), bf_hi(b.z)); r1[2] = RQ(bf_lo(a.w), bf_lo(b.w)); r1[3] = RQ(bf_hi(a.w), bf_hi(b.w));
#undef RQ
                        acc[ai][bj][m][0] = acc[ai][bj][m][0] * r0; acc[ai][bj][m][1] = acc[ai][bj][m][1] * r1; }
                    asm volatile("" ::: "memory"); }
        } else {
            f32x4 w0[2], w1[2];
#pragma unroll
            for (int bj = 0; bj < 2; ++bj) { const f32x4* p = (const f32x4*)(scol + cb + bj * 128); w0[bj] = p[0]; w1[bj] = p[1]; }
#pragma unroll
            for (int ai = 0; ai < 2; ++ai)
#pragma unroll
                for (int m = 0; m < 4; ++m) { const int row = rowb + ai * 128 + m * 16; const size_t ro = (size_t)row * 4096 + cb; const float rs = srow[row];
#pragma unroll
                    for (int bj = 0; bj < 2; ++bj) { const u32x4 b = *(const u32x4*)(gb + ro + bj * 128);
                        const f32x4 s0 = (f32x4){bf_lo(b.x), bf_hi(b.x), bf_lo(b.y), bf_hi(b.y)} * rs * w0[bj], s1 = (f32x4){bf_lo(b.z), bf_hi(b.z), bf_lo(b.w), bf_hi(b.w)} * rs * w1[bj];
                        *(u32x4*)(out + ro + bj * 128) = pack8(acc[ai][bj][m][0] * s0, acc[ai][bj][m][1] * s1); } }
        }
    }
};

struct EpiOut {
    static constexpr bool PERM = true, AFTER_DRAIN = false, SPLITK2 = false, FP8 = true;
    const float *x, *meta; float* h1f; bf16_t* h1b; u64* ssq; const float *srow, *scol;
    __device__ __forceinline__ void operator()(const Acc& acc, const Unit& u, int wr, int wc, int fr, int fq) const {
        const int rowb = u.pm * 256 + wr * 64 + fr, cb = u.pn * 256 + wc * 32 + 8 * fq;
#pragma unroll
        for (int ai = 0; ai < 2; ++ai)
#pragma unroll
            for (int m = 0; m < 4; ++m) { const int row = rowb + ai * 128 + m * 16;
                const float* src = x + (size_t)row * DM;
                float s = 0.f; const float rs = srow[row];
#pragma unroll
                for (int bj = 0; bj < 2; ++bj) { const f32x4* wp = (const f32x4*)(scol + cb + bj * 128); f32x4 v0 = acc[ai][bj][m][0] * rs * wp[0], v1 = acc[ai][bj][m][1] * rs * wp[1];
                    v0 = v0 + *(const f32x4*)(src + cb + bj * 128); v1 = v1 + *(const f32x4*)(src + cb + bj * 128 + 4);
                    s += (v0[0] * v0[0] + v0[1] * v0[1]) + (v0[2] * v0[2] + v0[3] * v0[3]) + (v1[0] * v1[0] + v1[1] * v1[1]) + (v1[2] * v1[2] + v1[3] * v1[3]);
                    float* o = h1f + (size_t)row * DM + cb + bj * 128; *(f32x4*)o = v0; *(f32x4*)(o + 4) = v1;
                    *(u32x4*)(h1b + (size_t)row * DM + cb + bj * 128) = pack8(v0, v1); }
                s += __shfl_xor(s, 16); s += __shfl_xor(s, 32);
                if (fq == 0 && ssq) ssq_add(ssq + row, s); }
    }
};

struct EpiPQ {
    static constexpr bool PERM = true, AFTER_DRAIN = false, SPLITK2 = false, FP8 = false;
    bf16_t* pq; const u64* ssq;
    __device__ __forceinline__ void operator()(const Acc& acc, const Unit& u, int wr, int wc, int fr, int fq) const {
        const int rowb = u.pm * 256 + wr * 64 + fr, cb = u.pn * 256 + wc * 32 + 8 * fq;
#pragma unroll
        for (int ai = 0; ai < 2; ++ai)
#pragma unroll
            for (int m = 0; m < 4; ++m) { const int row = rowb + ai * 128 + m * 16; const float rs = __builtin_amdgcn_rsqf(ssq_get(ssq + row) * (1.0f / DM) + EPS);
#pragma unroll
                for (int bj = 0; bj < 2; ++bj) *(u32x4*)(pq + (size_t)row * 2048 + cb + bj * 128) = pack8(acc[ai][bj][m][0] * rs, acc[ai][bj][m][1] * rs); }
    }
};
}
#define XB_TMO      128
#define XB_XCNT(j)  (256  + 64 * (j))
#define XB_XSUB(j)  (1280 + 64 * (j))
#define XB_XGEN(j)  (2304 + 64 * (j))
#define XB_TOP      3328
#define XB_TOPGEN   3392
#define XCD_BAR_WORDS 3456
#define XB_SPIN_CAP (1u << 18)
__device__ __forceinline__ unsigned xb_ld(unsigned* p)              { return __hip_atomic_load(p, __ATOMIC_RELAXED, __HIP_MEMORY_SCOPE_AGENT); }
__device__ __forceinline__ unsigned xb_add(unsigned* p, unsigned v) { return __hip_atomic_fetch_add(p, v, __ATOMIC_RELAXED, __HIP_MEMORY_SCOPE_AGENT); }
__device__ __forceinline__ unsigned xb_xcc_id() { return (unsigned)__builtin_amdgcn_s_getreg((3 << 11) | 20) & 0xFu; }
#define XB_SPIN(cond, bar) do { unsigned _sp = 0; while (cond) { __builtin_amdgcn_s_sleep(1); \
    if ((++_sp & 255u) == 0u) { if (xb_ld(&(bar)[XB_TMO])) break; if (_sp > XB_SPIN_CAP) { atomicAdd(&(bar)[XB_TMO], 1u); break; } } } } while (0)
struct XcdBarrier { unsigned* bar; unsigned x; volatile LAS unsigned* st; };
__device__ __forceinline__ XcdBarrier xcd_barrier_post(unsigned* bar, volatile LAS unsigned* st) {
    XcdBarrier b; b.bar = bar; b.x = xb_xcc_id(); b.st = st;
    if (threadIdx.x == 0) (void)xb_add(&bar[XB_XCNT(b.x)], 1u);
    return b;
}
__device__ __forceinline__ void xcd_barrier_complete(unsigned* bar, unsigned x, unsigned& nloc, unsigned& nx) {
    const unsigned G = gridDim.x * gridDim.y * gridDim.z;
    unsigned sum, cnt, mine, sp = 0u;
    for (;;) {
        sum = 0u; cnt = 0u; mine = 0u;
#pragma unroll
        for (unsigned j = 0; j < 16; ++j) { const unsigned c = xb_ld(&bar[XB_XCNT(j)]); sum += c; cnt += (c > 0u) ? 1u : 0u; mine = (j == x) ? c : mine; }
        if (sum == G) break;
        __builtin_amdgcn_s_sleep(1);
        if ((++sp & 255u) == 0u) { if (xb_ld(&bar[XB_TMO])) break; if (sp > XB_SPIN_CAP) { atomicAdd(&bar[XB_TMO], 1u); break; } }
    }
    nloc = mine > 0u ? mine : 1u; nx = cnt > 0u ? cnt : 1u;
}
__device__ __forceinline__ void xcd_barrier(const XcdBarrier& b) {
    asm volatile("s_waitcnt vmcnt(0)" ::: "memory");
    __syncthreads();
    if (threadIdx.x == 0) {
        unsigned* bar = b.bar;
        __builtin_amdgcn_s_waitcnt(0);
        unsigned nloc = b.st[0], nx = b.st[1];
        if (nloc == 0u) { xcd_barrier_complete(bar, b.x, nloc, nx); b.st[0] = nloc; b.st[1] = nx; }
        const unsigned old = xb_add(&bar[XB_XSUB(b.x)], 1u);
        const unsigned gen = old / nloc;
        if (old + 1u == (gen + 1u) * nloc) {
            __builtin_amdgcn_fence(__ATOMIC_RELEASE, "agent");
            asm volatile("s_waitcnt vmcnt(0)" ::: "memory");
            const unsigned og = xb_add(&bar[XB_TOP], 1u);
            const unsigned tg = og / nx;
            if (og + 1u == (tg + 1u) * nx) xb_add(&bar[XB_TOPGEN], 1u);
            else XB_SPIN(xb_ld(&bar[XB_TOPGEN]) == tg, bar);
            __builtin_amdgcn_fence(__ATOMIC_ACQUIRE, "agent");
            xb_add(&bar[XB_XGEN(b.x)], 1u);
            asm volatile("s_waitcnt vmcnt(0)" ::: "memory");
        } else {
            XB_SPIN(xb_ld(&bar[XB_XGEN(b.x)]) == gen, bar);
            __builtin_amdgcn_fence(__ATOMIC_ACQUIRE, "agent");
            asm volatile("s_waitcnt vmcnt(0)" ::: "memory");
        }
    }
    __syncthreads();
}

struct Frame {
    LAS unsigned char* lds;
    unsigned char* ws;
    unsigned* ctl;
    int tid, lane, wave, vcu, G;
    __device__ __forceinline__ const float* in(int i) const { return ((const float* const __attribute__((address_space(4)))*)__builtin_amdgcn_kernarg_segment_ptr())[i]; }
    __device__ __forceinline__ float* out() const { return ((float* const __attribute__((address_space(4)))*)__builtin_amdgcn_kernarg_segment_ptr())[16]; }
};

struct MapId { __device__ __forceinline__ int operator()(int v) const { return v; } };
struct MapIn { __device__ __forceinline__ int operator()(int v) const {
    if (v < 1536) return v;
    if (v < 3584) { const int w = v - 1536, hd = w >> 7; int o = w & 127; if (o < 32) o = (o & 1) ? (o >> 1) + 16 : (o >> 1); return 1600 + hd * 128 + o; }
    if (v < 4096) { const int w = v - 3584, hd = w >> 7; int o = w & 127; if (o < 32) o = (o & 1) ? (o >> 1) + 16 : (o >> 1); return 3648 + hd * 128 + o; }
    if (v < 4608) return 4160 + (v - 4096);
    if (v < 5632) { const int w = v - 4608, hd = w >> 6; int o = w & 63; if (o < 16) o = (o & 1) ? (o >> 1) + 8 : (o >> 1); return 4672 + hd * 64 + o; }
    if (v < 5888) { const int w = v - 5632;
        if (w < 64) return 1536 + ((w & 1) ? (w >> 1) + 32 : (w >> 1));
        if (w < 128) { int o = w - 64; if (o < 16) o = (o & 1) ? (o >> 1) + 8 : (o >> 1); return 5696 + o; }
        if (w < 144) return 5760 + (w - 128);
        return -1; }
    if (v < 9984) return 5776 + (v - 5888);
    return 9872 + (v - 9984);
} };
struct MapUq { __device__ __forceinline__ int operator()(int v) const {
    if (v < 2048) return (v >> 7) * 192 + (v & 127);
    const int w = v - 2048, hd = w >> 6, o = w & 63; return hd * 192 + 128 + ((o & 1) ? (o >> 1) + 32 : (o >> 1)); } };
struct MapUkv { __device__ __forceinline__ int operator()(int v) const {
    if (v < 2048) return (v >> 7) * 256 + (v & 127);
    const int w = v - 2048; return (w >> 7) * 256 + 128 + (w & 127); } };

template <class Map>
__device__ __forceinline__ void p0_transpose_item(const float* W, int K, int Nsrc, int Nvirt, bf16_t* WT, const float* gk, LAS float* scr, int item, int lane, Map map) {
    const int nblk = Nvirt / 32, kb = item / nblk, nb = item % nblk, k0 = 64 * kb, n0 = 32 * nb;
    const int sc = map(n0 + (lane & 31));
#pragma unroll 8
    for (int i = 0; i < 32; ++i) { const int kk = 2 * i + (lane >> 5); float v = 0.f;
        if (sc >= 0) v = W[(size_t)(k0 + kk) * Nsrc + sc];
        if (gk) v *= gk[k0 + kk];
        scr[kk * 33 + (lane & 31)] = v; }
    LDS_WAIT(); asm volatile("" ::: "memory");
    const int c = lane & 7;
#pragma unroll
    for (int j = 0; j < 4; ++j) { const int n = (lane >> 3) + 8 * j; const LAS float* s = scr + (8 * c) * 33 + n;
        u32x4 o; o.x = pk2(s[0 * 33], s[1 * 33]); o.y = pk2(s[2 * 33], s[3 * 33]); o.z = pk2(s[4 * 33], s[5 * 33]); o.w = pk2(s[6 * 33], s[7 * 33]);
        *(u32x4*)(WT + (size_t)(n0 + n) * K + k0 + 8 * c) = o; }
    LDS_WAIT(); asm volatile("" ::: "memory");
}
__device__ __forceinline__ float wave_max(float v) {
#pragma unroll
    for (int o = 1; o < 64; o <<= 1) v = fmaxf(v, __shfl_xor(v, o));
    return v;
}
__device__ __forceinline__ void p0_xn_row(const Frame& F, int m) {
    const float* x = F.in(0); const float* meta = F.in(1); const float* g = F.in(2);
    bf16_t* o = (bf16_t*)(F.ws + WS_XN) + (size_t)m * DM;
    u32x2* o8 = (u32x2*)o + F.lane;
    if (m >= NTOK + NMETA) {
        unsigned* z8 = (unsigned*)(F.ws + WS_XN8 + (size_t)m * DM) + F.lane;
#pragma unroll
        for (int j = 0; j < 16; ++j) { o8[64 * j] = (u32x2){0u, 0u}; z8[64 * j] = 0u; }
        if (F.lane == 0) ((float*)(F.ws + WS_SX))[m] = 0.f;
        return; }
    const float* src = m < NTOK ? x + (size_t)m * DM : meta + (size_t)(m - NTOK) * DM;
    const f32x4* xr = (const f32x4*)src + F.lane; const f32x4* gr = (const f32x4*)g + F.lane;
    f32x4 v[16]; float s = 0.f;
#pragma unroll
    for (int j = 0; j < 16; ++j) { v[j] = xr[64 * j]; s += (v[j][0] * v[j][0] + v[j][1] * v[j][1]) + (v[j][2] * v[j][2] + v[j][3] * v[j][3]); }
    const float rstd = 1.0f / sqrtf(wave_sum(s) * (1.0f / DM) + EPS);
    float mx = 0.f;
#pragma unroll
    for (int j = 0; j < 16; ++j) { const f32x4 gg = gr[64 * j]; v[j] = v[j] * rstd * gg; o8[64 * j] = (u32x2){pk2(v[j][0], v[j][1]), pk2(v[j][2], v[j][3])};
        mx = fmaxf(mx, fmaxf(fmaxf(fabsf(v[j][0]), fabsf(v[j][1])), fmaxf(fabsf(v[j][2]), fabsf(v[j][3])))); }
    mx = fmaxf(wave_max(mx), 1e-30f);
    const float inv = 448.0f / mx;
    if (F.lane == 0) ((float*)(F.ws + WS_SX))[m] = mx * (1.0f / 448.0f);
    unsigned* q8 = (unsigned*)(F.ws + WS_XN8 + (size_t)m * DM) + F.lane;
#pragma unroll
    for (int j = 0; j < 16; ++j) { f32x4 q = v[j] * inv;
#pragma unroll
        for (int e = 0; e < 4; ++e) q[e] = fminf(fmaxf(q[e], -448.0f), 448.0f);
        int p = 0; p = __builtin_amdgcn_cvt_pk_fp8_f32(q[0], q[1], p, false); p = __builtin_amdgcn_cvt_pk_fp8_f32(q[2], q[3], p, true); q8[64 * j] = (unsigned)p; }
}
__device__ __forceinline__ void p0_prologue(const Frame& F) {
    LAS float* scr = (LAS float*)(F.lds + F.wave * 16384);
    const int gw = F.vcu * NWAVES + F.wave, NGW = F.G * NWAVES;
    const float* w_in = F.in(3); const float* qg = F.in(4); const float* w_uq = F.in(5); const float* kvg = F.in(6); const float* w_ukv = F.in(7);
    const float* w_br = F.in(8); const float* w_out = F.in(9); const float* fg = F.in(10); const float* w_q = F.in(11); const float* sk = F.in(12);
    constexpr int I_IN = 64 * (NV1 / 32), I_UQ = 16 * (3072 / 32), I_UKV = 8 * (4096 / 32), I_BR = 64 * 128, I_OUT = 64 * 128, I_Q = 64 * 64;
    constexpr int NITEMS = I_IN + I_UQ + I_UKV + I_BR + I_OUT + I_Q;
    for (int it = gw; it < NITEMS; it += NGW) {
        int r = it;
        if (r < I_IN) { p0_transpose_item(w_in, 4096, 13968, NV1, (bf16_t*)(F.ws + WS_WIN), nullptr, scr, r, F.lane, MapIn()); continue; } r -= I_IN;
        if (r < I_UQ) { p0_transpose_item(w_uq, 1024, 3072, 3072, (bf16_t*)(F.ws + WS_WUQ), qg, scr, r, F.lane, MapUq()); continue; } r -= I_UQ;
        if (r < I_UKV) { p0_transpose_item(w_ukv, 512, 4096, 4096, (bf16_t*)(F.ws + WS_WUKV), kvg, scr, r, F.lane, MapUkv()); continue; } r -= I_UKV;
        if (r < I_BR) { p0_transpose_item(w_br, 4096, 4096, 4096, (bf16_t*)(F.ws + WS_WBR), nullptr, scr, r, F.lane, MapId()); continue; } r -= I_BR;
        if (r < I_OUT) { p0_transpose_item(w_out, 4096, 4096, 4096, (bf16_t*)(F.ws + WS_WOUT), nullptr, scr, r, F.lane, MapId()); continue; } r -= I_OUT;
        p0_transpose_item(w_q, 4096, 2048, 2048, (bf16_t*)(F.ws + WS_WQ), fg, scr, r, F.lane, MapId());
    }
    for (int m = gw; m < MK; m += NGW) p0_xn_row(F, m);
    const int gt = (F.vcu * NWAVES + F.wave) * 64 + F.lane, NGT = NGW * 64;
    for (int i = gt; i < TP * 56; i += NGT) {
        const int t = i / 56, r = i % 56; int j, rot; float* dst;
        if (r < 32) { j = r; rot = 64; dst = (float*)(F.ws + WS_ROPE_M) + ((size_t)t * 32 + j) * 2; }
        else if (r < 48) { j = r - 32; rot = 32; dst = (float*)(F.ws + WS_ROPE_D) + ((size_t)t * 16 + j) * 2; }
        else { j = r - 48; rot = 16; dst = (float*)(F.ws + WS_ROPE_I) + ((size_t)t * 8 + j) * 2; }
        const float ex = (float)(2 * j) / (float)rot;
        const float inv = powf(500000.0f, -ex);
        const float ang = (float)t * inv;
        const double a = (double)ang, kq = rint(a * 0.15915494309189535), rr = fma(-kq, 6.283185307179586, a);
        const float rf = (float)rr;
        dst[0] = cosf(rf); dst[1] = sinf(rf);
    }
    for (int i = gt; i < 16 * 128 * 128 / 8; i += NGT) { const f32x4* s = (const f32x4*)sk + 2 * (size_t)i; const f32x4 a = s[0], b2 = s[1];
        u32x4 o; o.x = pk2(a[0], a[1]); o.y = pk2(a[2], a[3]); o.z = pk2(b2[0], b2[1]); o.w = pk2(b2[2], b2[3]); ((u32x4*)(F.ws + WS_SK))[i] = o; }
}
__device__ __forceinline__ unsigned fp6_code(float q) {
    const unsigned b = __float_as_uint(q), sgn = (b >> 31) << 5; const float aq = fabsf(q);
    const unsigned sub = (unsigned)rintf(aq * 8.0f);
    unsigned ab = b & 0x7fffffffu; ab = ab + 0x7FFFFu + ((ab >> 20) & 1u);
    const unsigned nrm = (ab >> 20) - (126u << 3);
    unsigned code = aq < 1.0f ? sub : nrm; code = code > 31u ? 31u : code;
    return code | sgn;
}
__device__ __forceinline__ void fp6_pack32(const unsigned (&c)[32], unsigned (&w)[6]) {
#pragma unroll
    for (int i = 0; i < 6; ++i) w[i] = 0u;
#pragma unroll
    for (int k = 0; k < 32; ++k) { const int bit = 6 * k, d = bit >> 5, sh = bit & 31; w[d] |= c[k] << sh; if (sh > 26) w[d + 1] |= c[k] >> (32 - sh); }
}
__device__ __forceinline__ void p6_quant_row(const float* src, const float* gain, unsigned char* dst, float* scale_out, int lane) {
    const f32x4* s = (const f32x4*)src + lane; f32x4 v[16]; float mx = 0.f;
#pragma unroll
    for (int j = 0; j < 16; ++j) { v[j] = s[64 * j]; if (gain) v[j] = v[j] * ((const f32x4*)gain)[lane + 64 * j];
        mx = fmaxf(mx, fmaxf(fmaxf(fabsf(v[j][0]), fabsf(v[j][1])), fmaxf(fabsf(v[j][2]), fabsf(v[j][3])))); }
    mx = fmaxf(wave_max(mx), 1e-30f);
    const float sc = mx * (1.0f / 7.5f), inv = 7.5f / mx;
    if (lane == 0) *scale_out = sc;
    unsigned w[12];
#pragma unroll
    for (int g = 0; g < 2; ++g) { unsigned c[32];
#pragma unroll
        for (int j = 0; j < 8; ++j)
#pragma unroll
            for (int i = 0; i < 4; ++i) c[4 * j + i] = fp6_code(v[8 * g + j][i] * inv);
        unsigned ww[6]; fp6_pack32(c, ww);
#pragma unroll
        for (int i = 0; i < 6; ++i) w[6 * g + i] = ww[i]; }
#pragma unroll
    for (int q = 0; q < 3; ++q) *(u32x4*)(dst + 1024 * q + 16 * lane) = (u32x4){w[4 * q], w[4 * q + 1], w[4 * q + 2], w[4 * q + 3]};
}
__device__ __forceinline__ void p6_tables(const Frame& F) {
    const float* fg = F.in(10); const float* pu = F.in(13); const float* pv = F.in(14);
    const int gw = F.vcu * NWAVES + F.wave, NGW = F.G * NWAVES;
    for (int it = gw; it < 2 * 16384; it += NGW) { const int e = it >> 1;
        if (it & 1) p6_quant_row(pv + (size_t)e * DM, nullptr, F.ws + WS_V + (size_t)e * 3072, (float*)(F.ws + WS_SCV) + e, F.lane);
        else p6_quant_row(pu + (size_t)e * DM, fg, F.ws + WS_U + (size_t)e * 3072, (float*)(F.ws + WS_SCU) + e, F.lane); }
}

__device__ __forceinline__ void rowquant_fp8(const Frame& F, const unsigned char* src, size_t src_pitch, unsigned char* dst, size_t dst_pitch, float* scale, int nrows) {
    const int gw = F.vcu * NWAVES + F.wave, NGW = F.G * NWAVES, lane = F.lane;
    for (int n = gw; n < nrows; n += NGW) {
        const u32x4* s = (const u32x4*)(src + (size_t)n * src_pitch) + lane;
        u32x4 v[8]; float mx = 0.f;
#pragma unroll
        for (int j = 0; j < 8; ++j) { v[j] = s[64 * j];
#pragma unroll
            for (int e = 0; e < 4; ++e) mx = fmaxf(mx, fmaxf(fabsf(bf_lo(v[j][e])), fabsf(bf_hi(v[j][e])))); }
        mx = fmaxf(wave_max(mx), 1e-30f);
        const float inv = 448.0f / mx;
        if (lane == 0) scale[n] = mx * (1.0f / 448.0f);
        asm volatile("" ::: "memory");
        u32x2* d = (u32x2*)(dst + (size_t)n * dst_pitch) + lane;
#pragma unroll
        for (int j = 0; j < 8; ++j) { int p0 = 0, p1 = 0;
            p0 = __builtin_amdgcn_cvt_pk_fp8_f32(bf_lo(v[j].x) * inv, bf_hi(v[j].x) * inv, p0, false); p0 = __builtin_amdgcn_cvt_pk_fp8_f32(bf_lo(v[j].y) * inv, bf_hi(v[j].y) * inv, p0, true);
            p1 = __builtin_amdgcn_cvt_pk_fp8_f32(bf_lo(v[j].z) * inv, bf_hi(v[j].z) * inv, p1, false); p1 = __builtin_amdgcn_cvt_pk_fp8_f32(bf_lo(v[j].w) * inv, bf_hi(v[j].w) * inv, p1, true);
            d[64 * j] = (u32x2){(unsigned)p0, (unsigned)p1}; }
    }
}
__device__ __forceinline__ void p1_quant_weights(const Frame& F) {
    rowquant_fp8(F, F.ws + WS_WIN + (size_t)5888 * DM * 2, (size_t)DM * 2, F.ws + WS_WG8, (size_t)DM, (float*)(F.ws + WS_SW), 8192);
    rowquant_fp8(F, F.ws + WS_WBR, (size_t)DM * 2, F.ws + WS_WBR, (size_t)DM * 2, (float*)(F.ws + WS_SWBR), 4096);
    rowquant_fp8(F, F.ws + WS_WOUT, (size_t)DM * 2, F.ws + WS_WOUT, (size_t)DM * 2, (float*)(F.ws + WS_SWOUT), 4096);
}
#define MFMA32(a, b, c) __builtin_amdgcn_mfma_f32_32x32x16_bf16((a), (b), (c), 0, 0, 0)
__device__ __forceinline__ int crow(int i, int h) { return (i & 3) + 8 * (i >> 2) + 4 * h; }
__device__ __forceinline__ float half_sum_f(float v) {
#pragma unroll
    for (int o = 1; o < 32; o <<= 1) v += __shfl_xor(v, o);
    return v;
}
__device__ __forceinline__ int half_sum_i(int v) {
#pragma unroll
    for (int o = 1; o < 32; o <<= 1) v += __shfl_xor(v, o);
    return v;
}
__device__ __forceinline__ float half_max_f(float v) {
#pragma unroll
    for (int o = 1; o < 32; o <<= 1) v = fmaxf(v, __shfl_xor(v, o));
    return v;
}
__device__ __forceinline__ float half_min_f(float v) {
#pragma unroll
    for (int o = 1; o < 32; o <<= 1) v = fminf(v, __shfl_xor(v, o));
    return v;
}
__device__ __forceinline__ void idx_task(const Frame& F, int b, int s0) {
    const int lane = F.lane, r = lane & 31, h = lane >> 5;
    const bf16_t* qix = (const bf16_t*)(F.ws + WS_QIX); const bf16_t* kix = (const bf16_t*)(F.ws + WS_KIX); const float* wix = (const float*)(F.ws + WS_WIX);
    unsigned* mask = (unsigned*)(F.ws + WS_MASK);
    const int tok = (r >> 2) & 1, head = (r & 3) + 4 * (r >> 3);
    const bf16_t* qp = qix + (size_t)(b * SEQ + s0 + tok) * 1024 + head * 64 + 8 * h;
    bf16x8 af[4];
#pragma unroll
    for (int ks = 0; ks < 4; ++ks) af[ks] = *(const bf16x8*)(qp + 16 * ks);
    const f32x4* wp = (const f32x4*)(wix + (size_t)(b * SEQ + s0 + h) * 16);
    float w[16];
#pragma unroll
    for (int q = 0; q < 4; ++q) { const f32x4 x = wp[q]; w[4 * q] = x[0]; w[4 * q + 1] = x[1]; w[4 * q + 2] = x[2]; w[4 * q + 3] = x[3]; }
    const int tq = NMETA + s0 + h;
    const int ngrp = ((NMETA + s0 + 1) >> 6) + 1;
    int brow = b * SEQ - NMETA; asm volatile("" : "+s"(brow));
    const bf16_t* kbase = kix + ((long)brow + r) * 64 + 8 * h;
    float row[MW];
    const bf16_t* kcur = kbase;
#pragma unroll
    for (int g = 0; g < MW / 2; ++g) {
        float s0v = -INFINITY, s1v = -INFINITY;
        if (g < ngrp) {
            const bf16_t* kp0 = kcur; const bf16_t* kp1 = kcur + 32 * 64;
            if (g == 0 && r < NMETA) kp0 = kix + (size_t)(NTOK + r) * 64 + 8 * h;
            bf16x8 b0[4], b1[4];
#pragma unroll
            for (int ks = 0; ks < 4; ++ks) { b0[ks] = *(const bf16x8*)(kp0 + 16 * ks); b1[ks] = *(const bf16x8*)(kp1 + 16 * ks); }
            float x0 = 0.f, x1 = 0.f;
            { f32x16 a0;
#pragma unroll
              for (int i = 0; i < 16; ++i) a0[i] = 0.f;
#pragma unroll
              for (int ks = 0; ks < 4; ++ks) a0 = MFMA32(af[ks], b0[ks], a0);
#pragma unroll
              for (int i = 0; i < 16; ++i) x0 += w[i] * fmaxf(a0[i], 0.f); }
            { f32x16 a1;
#pragma unroll
              for (int i = 0; i < 16; ++i) a1[i] = 0.f;
#pragma unroll
              for (int ks = 0; ks < 4; ++ks) a1 = MFMA32(af[ks], b1[ks], a1);
#pragma unroll
              for (int i = 0; i < 16; ++i) x1 += w[i] * fmaxf(a1[i], 0.f); }
            s0v = (g * 64 + r <= tq) ? x0 : -INFINITY; s1v = (g * 64 + 32 + r <= tq) ? x1 : -INFINITY;
        }
        row[2 * g] = s0v; row[2 * g + 1] = s1v;
        kcur += 64 * 64; asm volatile("" : "+v"(kcur));
    }
    float tau = -3.0e38f;
    bool done = (tq + 1 <= 256);
    float mx = -INFINITY, mn = INFINITY;
#pragma unroll
    for (int k = 0; k < MW; ++k) { const float v = row[k]; mx = fmaxf(mx, v); mn = fminf(mn, v > -INFINITY ? v : INFINITY); }
    float lo = half_min_f(mn), hi = half_max_f(mx);
    if (!done) tau = hi;
    for (int it = 0; it < 64; ++it) {
        if (!__any(!done)) break;
        const float mid = lo + (hi - lo) * 0.5f;
        int c = 0;
#pragma unroll
        for (int k = 0; k < MW; ++k) c += (row[k] >= mid) ? 1 : 0;
        c = half_sum_i(c);
        if (!done) {
            if (!(mid > lo && mid < hi)) { tau = hi; done = true; }
            else if (c == 256) { tau = mid; done = true; }
            else if (c > 256) lo = mid;
            else { hi = mid; tau = hi; }
        }
    }
    unsigned* mrow = mask + (size_t)(b * SEQ + s0 + h) * MW;
    unsigned mw = 0u;
#pragma unroll
    for (int k = 0; k < MW; ++k) {
        const unsigned long long bal = __ballot(row[k] >= tau);
        const unsigned wd = h ? (unsigned)(bal >> 32) : (unsigned)bal;
        if ((k & 31) == r) mw = wd;
        if ((k & 31) == 31 || k == MW - 1) { const int kk = (k & ~31) + r; if (kk < MW) mrow[kk] = mw; }
    }
}
__device__ __forceinline__ void p2_indexer(const Frame& F, int qslot) {
    volatile LAS unsigned* qw = (volatile LAS unsigned*)(F.lds + LDSCTL_OFF + 16);
    constexpr int NCH = NTOK / 16;
    for (;;) {
        if (F.tid == 0) qw[0] = atomicAdd(F.ctl + CW_QUEUE + 64 * qslot, 1u);
        __syncthreads();
        const int c = (int)qw[0];
        __syncthreads();
        if (c >= NCH) break;
        const int b = c & 3, tblk = (SEQ / 16 - 1) - (c >> 2);
        idx_task(F, b, tblk * 16 + 2 * F.wave);
    }
}
template <bool MLA> struct AttnCfg {
    static constexpr int DQK = MLA ? 192 : 128, PK = DQK * 2 + 16, PV = 320, KCH = DQK / 8, NKC = 64 * KCH / 512, KBYTES = 64 * PK, BUFB = 64 * PK + 64 * PV;
};
struct AttnUnit { int type, b, hx, blk; };

template <bool MLA>
__device__ __forceinline__ void attn_unit(const Frame& F, const AttnUnit u) {
    typedef AttnCfg<MLA> C;
    const int tid = F.tid, lane = F.lane, wave = F.wave, r = lane & 31, h = lane >> 5;
    LAS unsigned char* lds = F.lds;
    const bf16_t* qn = (const bf16_t*)(F.ws + WS_QN); const bf16_t* qr = (const bf16_t*)(F.ws + WS_QR); const bf16_t* kn = (const bf16_t*)(F.ws + WS_KN);
    const bf16_t* va = (const bf16_t*)(F.ws + WS_VA); const bf16_t* kpe = (const bf16_t*)(F.ws + WS_KPE);
    const bf16_t* qb = (const bf16_t*)(F.ws + WS_QB); const bf16_t* kb = (const bf16_t*)(F.ws + WS_KB); const bf16_t* vb = (const bf16_t*)(F.ws + WS_VB);
    const unsigned* mask = (const unsigned*)(F.ws + WS_MASK); bf16_t* oab = (bf16_t*)(F.ws + WS_OAB);
    const int b = u.b;
    const size_t rowb = (size_t)b * SEQ;
    int head, tw0, ntiles;
    if (MLA) { head = u.hx; tw0 = u.blk * 256 + 32 * wave; ntiles = (NMETA + u.blk * 256 + 255) / 64 + 1; }
    else { head = 4 * u.hx + (wave & 3); tw0 = u.blk * 64 + 32 * (wave >> 2); ntiles = (NMETA + u.blk * 64 + 63) / 64 + 1; }
    const int pw0 = NMETA + tw0;
    const int tq = pw0 + r;
    bf16x8 qf[C::DQK / 16];
    if (MLA) {
        const bf16_t* p0 = qn + (rowb + tw0 + r) * 2048 + head * 128 + 8 * h; const bf16_t* p1 = qr + (rowb + tw0 + r) * 1024 + head * 64 + 8 * h;
#pragma unroll
        for (int ks = 0; ks < 8; ++ks) qf[ks] = *(const bf16x8*)(p0 + 16 * ks);
#pragma unroll
        for (int ks = 0; ks < 4; ++ks) qf[8 + ks] = *(const bf16x8*)(p1 + 16 * ks);
    } else {
        const bf16_t* p0 = qb + (rowb + tw0 + r) * 2048 + head * 128 + 8 * h;
#pragma unroll
        for (int ks = 0; ks < 8; ++ks) qf[ks] = *(const bf16x8*)(p0 + 16 * ks);
    }
    const int ldkv = MLA ? 2048 : 512;
    const bf16_t* ktab = MLA ? kn + head * 128 : kb + u.hx * 128;
    const bf16_t* vtab = MLA ? va + head * 128 : vb + u.hx * 128;
    const bf16_t* kbase = ktab + (rowb - NMETA) * ldkv;
    const bf16_t* vbase = vtab + (rowb - NMETA) * ldkv;
    const bf16_t* pbase = kpe + (rowb - NMETA) * 64;
    unsigned soff[2]; int kdst[2], vdst[2];
#pragma unroll
    for (int i = 0; i < 2; ++i) { const int c = tid + 512 * i, key = c >> 4, pc = c & 15; soff[i] = (unsigned)(key * ldkv + pc * 8); kdst[i] = key * C::PK + pc * 16; vdst[i] = C::KBYTES + key * C::PV + pc * 16; }
    const unsigned poff = (unsigned)((tid >> 3) * 64 + (tid & 7) * 8); const int pdst = (tid >> 3) * C::PK + 256 + (tid & 7) * 16;
    u32x4 kst[2], vst[2], pst = (u32x4){0u, 0u, 0u, 0u};
    {
        const int key0 = tid >> 4;
        const size_t o0 = key0 < NMETA ? (size_t)(NTOK + key0) * ldkv + (tid & 15) * 8 : (rowb - NMETA) * ldkv + soff[0];
        kst[0] = *(const u32x4*)(ktab + o0); vst[0] = *(const u32x4*)(vtab + o0);
        kst[1] = *(const u32x4*)(kbase + soff[1]); vst[1] = *(const u32x4*)(vbase + soff[1]);
        if (MLA) { const int keyp = tid >> 3; pst = *(const u32x4*)(keyp < NMETA ? kpe + (size_t)(NTOK + keyp) * 64 + (tid & 7) * 8 : pbase + poff); }
    }
#pragma unroll
    for (int i = 0; i < 2; ++i) { *(LAS u32x4*)(lds + kdst[i]) = kst[i]; *(LAS u32x4*)(lds + vdst[i]) = vst[i]; }
    if (MLA) *(LAS u32x4*)(lds + pdst) = pst;
    __syncthreads();
    f32x16 oacc[4];
#pragma unroll
    for (int d = 0; d < 4; ++d)
#pragma unroll
        for (int i = 0; i < 16; ++i) oacc[d][i] = 0.f;
    float mrun = -INFINITY, lrun = 0.f;
    const int koff = r * C::PK + 16 * h;
    const int voff = C::KBYTES + (4 * h + ((lane & 15) >> 2)) * C::PV + (16 * ((lane >> 4) & 1) + 4 * (lane & 3)) * 2;
    const unsigned* mrow = mask + (rowb + tw0 + r) * MW;
    for (int kt = 0; kt < ntiles; ++kt) {
        const int cur = (kt & 1) * C::BUFB, nxt = ((kt + 1) & 1) * C::BUFB;
        const bool more = kt + 1 < ntiles;
        if (more) {
            const bf16_t* kb2 = kbase + (size_t)(kt + 1) * 64 * ldkv; const bf16_t* vb2 = vbase + (size_t)(kt + 1) * 64 * ldkv;
#pragma unroll
            for (int i = 0; i < 2; ++i) { kst[i] = *(const u32x4*)(kb2 + soff[i]); vst[i] = *(const u32x4*)(vb2 + soff[i]); }
            if (MLA) pst = *(const u32x4*)(pbase + (size_t)(kt + 1) * 64 * 64 + poff);
        }
        if (kt * 64 <= pw0 + 31) {
            u32x2 mwd = (u32x2){0u, 0u};
            if (!MLA) mwd = *(const u32x2*)(mrow + 2 * kt);
            f32x16 s0, s1;
#pragma unroll
            for (int i = 0; i < 16; ++i) { s0[i] = 0.f; s1[i] = 0.f; }
#pragma unroll
            for (int ks = 0; ks < C::DQK / 16; ++ks) {
                const bf16x8 k0 = *(const LAS bf16x8*)(lds + cur + koff + 32 * ks), k1 = *(const LAS bf16x8*)(lds + cur + koff + 32 * C::PK + 32 * ks);
                s0 = MFMA32(k0, qf[ks], s0); s1 = MFMA32(k1, qf[ks], s1);
            }
            if (MLA) {
                if (kt * 64 + 63 > pw0) {
                    const int kb0 = kt * 64 + 4 * h;
#pragma unroll
                    for (int i = 0; i < 16; ++i) { const int key = kb0 + (i & 3) + 8 * (i >> 2); if (key > tq) s0[i] = -INFINITY; if (key + 32 > tq) s1[i] = -INFINITY; }
                }
            } else {
                const unsigned m0 = mwd.x >> (4 * h), m1 = mwd.y >> (4 * h);
#pragma unroll
                for (int i = 0; i < 16; ++i) { const int bit = (i & 3) + 8 * (i >> 2); if (!((m0 >> bit) & 1u)) s0[i] = -INFINITY; if (!((m1 >> bit) & 1u)) s1[i] = -INFINITY; }
            }
            float mx = s0[0];
#pragma unroll
            for (int i = 1; i < 16; ++i) mx = fmaxf(mx, s0[i]);
#pragma unroll
            for (int i = 0; i < 16; ++i) mx = fmaxf(mx, s1[i]);
            mx = fmaxf(mx, __shfl_xor(mx, 32));
            const float mnew = fmaxf(mrun, mx);
            const float msafe = (mnew == -INFINITY) ? 0.f : mnew;
            const float alpha = __builtin_amdgcn_exp2f(mrun - msafe);
            mrun = mnew;
            float ps = 0.f;
#pragma unroll
            for (int i = 0; i < 16; ++i) { s0[i] = __builtin_amdgcn_exp2f(s0[i] - msafe); s1[i] = __builtin_amdgcn_exp2f(s1[i] - msafe); ps += s0[i] + s1[i]; }
            lrun = lrun * alpha + ps;
#pragma unroll
            for (int d = 0; d < 4; ++d)
#pragma unroll
                for (int i = 0; i < 16; ++i) oacc[d][i] *= alpha;
            bf16x8 pf[4];
            { u32x4 w;
              w.x = cvt_pk_bf16(s0[0], s0[1]); w.y = cvt_pk_bf16(s0[2], s0[3]); w.z = cvt_pk_bf16(s0[4], s0[5]); w.w = cvt_pk_bf16(s0[6], s0[7]); pf[0] = __builtin_bit_cast(bf16x8, w);
              w.x = cvt_pk_bf16(s0[8], s0[9]); w.y = cvt_pk_bf16(s0[10], s0[11]); w.z = cvt_pk_bf16(s0[12], s0[13]); w.w = cvt_pk_bf16(s0[14], s0[15]); pf[1] = __builtin_bit_cast(bf16x8, w);
              w.x = cvt_pk_bf16(s1[0], s1[1]); w.y = cvt_pk_bf16(s1[2], s1[3]); w.z = cvt_pk_bf16(s1[4], s1[5]); w.w = cvt_pk_bf16(s1[6], s1[7]); pf[2] = __builtin_bit_cast(bf16x8, w);
              w.x = cvt_pk_bf16(s1[8], s1[9]); w.y = cvt_pk_bf16(s1[10], s1[11]); w.z = cvt_pk_bf16(s1[12], s1[13]); w.w = cvt_pk_bf16(s1[14], s1[15]); pf[3] = __builtin_bit_cast(bf16x8, w); }
#pragma unroll
            for (int d = 0; d < 4; ++d)
#pragma unroll
                for (int kk = 0; kk < 4; ++kk) {
                    const s16x4 lo = __builtin_amdgcn_ds_read_tr16_b64_v4i16((LAS s16x4*)(lds + cur + voff + (16 * kk) * C::PV + 64 * d));
                    const s16x4 hi = __builtin_amdgcn_ds_read_tr16_b64_v4i16((LAS s16x4*)(lds + cur + voff + (16 * kk + 8) * C::PV + 64 * d));
                    const bf16x8 vf = __builtin_shufflevector(lo, hi, 0, 1, 2, 3, 4, 5, 6, 7);
                    oacc[d] = MFMA32(vf, pf[kk], oacc[d]);
                }
        }
        if (more) {
#pragma unroll
            for (int i = 0; i < 2; ++i) { *(LAS u32x4*)(lds + nxt + kdst[i]) = kst[i]; *(LAS u32x4*)(lds + nxt + vdst[i]) = vst[i]; }
            if (MLA) *(LAS u32x4*)(lds + nxt + pdst) = pst;
        }
        __syncthreads();
    }
    {
        const float lt = lrun + __shfl_xor(lrun, 32);
        const float inv = lt > 0.f ? 1.0f / lt : 0.f;
        bf16_t* op = oab + (rowb + tw0 + r) * 4096 + (MLA ? 0 : 2048) + head * 128 + 4 * h;
#pragma unroll
        for (int d = 0; d < 4; ++d)
#pragma unroll
            for (int g = 0; g < 4; ++g) { u32x2 w; w.x = cvt_pk_bf16(oacc[d][4 * g] * inv, oacc[d][4 * g + 1] * inv); w.y = cvt_pk_bf16(oacc[d][4 * g + 2] * inv, oacc[d][4 * g + 3] * inv);
                *(u32x2*)(op + 32 * d + 8 * g) = w; }
    }
}

constexpr int ATT_NUNITS = 16 * 64 + 64 * 16;
__device__ __forceinline__ void att_decode(int idx, AttnUnit& u) {
    int rem = idx;
    for (int L = 65; L >= 2; --L) {
        const int nm = (L >= 5 && ((L - 5) & 3) == 0) ? 64 : 0;
        if (rem < nm) { u.type = 0; u.blk = (L - 5) >> 2; u.b = rem & 3; u.hx = rem >> 2; return; }
        rem -= nm;
        if (rem < 16) { u.type = 1; u.blk = L - 2; u.b = rem & 3; u.hx = rem >> 2; return; }
        rem -= 16;
    }
    u.type = -1; u.blk = 0; u.b = 0; u.hx = 0;
}
__device__ __forceinline__ void p3_attention(const Frame& F, int qslot) {
#ifdef MK_SKIP_ATT
    {
        const u32x4* qn = (const u32x4*)(F.ws + WS_QN); const u32x4* qb = (const u32x4*)(F.ws + WS_QB); u32x4* o = (u32x4*)(F.ws + WS_OAB);
        const size_t gt = (size_t)(F.vcu * NWAVES + F.wave) * 64 + F.lane, NGT = (size_t)F.G * NWAVES * 64;
        for (size_t i = gt; i < (size_t)NTOK * 256; i += NGT) { const size_t row = i >> 8, c = i & 255; o[row * 512 + c] = qn[row * 256 + c]; o[row * 512 + 256 + c] = qb[row * 256 + c]; }
        return;
    }
#endif
    volatile LAS int* qw = (volatile LAS int*)(F.lds + LDSCTL_OFF + 32);
    for (;;) {
        if (F.tid == 0) { const int idx = (int)atomicAdd(F.ctl + CW_QUEUE + 64 * qslot, 1u); AttnUnit u; u.type = -1; u.b = 0; u.hx = 0; u.blk = 0; if (idx < ATT_NUNITS) att_decode(idx, u);
            qw[0] = u.type; qw[1] = u.b; qw[2] = u.hx; qw[3] = u.blk; }
        __syncthreads();
        AttnUnit u; u.type = qw[0]; u.b = qw[1]; u.hx = qw[2]; u.blk = qw[3];
        __syncthreads();
        if (u.type < 0) break;
        if (u.type == 0) attn_unit<true>(F, u); else attn_unit<false>(F, u);
    }
}
__device__ __forceinline__ float pk_idx(float v, int n) { return __uint_as_float((__float_as_uint(v) & ~127u) | (unsigned)n); }
__device__ __forceinline__ void route_task(const Frame& F, int tb, int hd) {
    const int lane = F.lane, r = lane & 31, h = lane >> 5;
    const bf16_t* pq = (const bf16_t*)(F.ws + WS_PQ); const bf16_t* skb = (const bf16_t*)(F.ws + WS_SK);
    int* eid = (int*)(F.ws + WS_EID); float* gate = (float*)(F.ws + WS_GATE);
    LAS float* wl = (LAS float*)(F.lds + F.wave * 16384);
    const int m = tb * 32 + r;
#pragma unroll 1
    for (int c = 0; c < 2; ++c) {
        const bf16_t* qp = pq + (size_t)m * 2048 + hd * 256 + c * 128 + 8 * h;
        bf16x8 qf[8];
#pragma unroll
        for (int ks = 0; ks < 8; ++ks) qf[ks] = *(const bf16x8*)(qp + 16 * ks);
        float v[64];
#pragma unroll
        for (int blk = 0; blk < 4; ++blk) {
            const bf16_t* sp = skb + (size_t)((hd * 2 + c) * 128 + 32 * blk + r) * 128 + 8 * h;
            f32x16 acc;
#pragma unroll
            for (int i = 0; i < 16; ++i) acc[i] = 0.f;
#pragma unroll
            for (int ks = 0; ks < 8; ++ks) acc = MFMA32(*(const bf16x8*)(sp + 16 * ks), qf[ks], acc);
#pragma unroll
            for (int i = 0; i < 16; ++i) v[blk * 16 + i] = pk_idx(acc[i], 32 * blk + (i & 3) + 8 * (i >> 2) + 4 * h);
        }
#pragma unroll 1
        for (int k = 0; k < 16; ++k) {
            float mx = v[0];
#pragma unroll
            for (int j = 1; j < 64; ++j) mx = fmaxf(mx, v[j]);
            mx = fmaxf(mx, __shfl_xor(mx, 32));
            if (h == 0) wl[(c * 16 + k) * 32 + r] = mx;
#pragma unroll
            for (int j = 0; j < 64; ++j) v[j] = (v[j] == mx) ? -INFINITY : v[j];
        }
    }
    LDS_WAIT(); asm volatile("" ::: "memory");
    float cs[50]; int ce[50];
    {
        unsigned t0[16], t1[16];
#pragma unroll
        for (int i = 0; i < 16; ++i) { t0[i] = __float_as_uint(wl[i * 32 + r]); t1[i] = __float_as_uint(wl[(16 + i) * 32 + r]); }
        int n = 0;
#pragma unroll
        for (int i = 0; i < 16; ++i)
#pragma unroll
            for (int j = 0; j < 16; ++j)
                if ((i + 1) * (j + 1) <= 16) {
                    const float s = __uint_as_float(t0[i] & ~127u) + __uint_as_float(t1[j] & ~127u);
                    cs[n] = __uint_as_float((__float_as_uint(s) & ~63u) | (unsigned)n); ce[n] = (int)((t0[i] & 127u) * 128u + (t1[j] & 127u)); ++n;
                }
    }
    float sum = 0.f, first = 0.f;
#pragma unroll 1
    for (int k = 0; k < 16; ++k) {
        float mx = cs[0];
#pragma unroll
        for (int j = 1; j < 50; ++j) mx = fmaxf(mx, cs[j]);
        int se = 0;
#pragma unroll
        for (int j = 0; j < 50; ++j) { const bool hit = (cs[j] == mx); se = hit ? ce[j] : se; cs[j] = hit ? -INFINITY : cs[j]; }
        if (k == 0) first = mx;
        const float ev = __expf(mx - first); sum += ev;
        if (h == 0) { wl[1024 + k * 32 + r] = ev; wl[1536 + k * 32 + r] = __int_as_float(se); }
    }
    LDS_WAIT(); asm volatile("" ::: "memory");
    const float inv = 1.0f / sum;
    if (h == 0) {
        int* ep = eid + (size_t)m * 128 + hd * 16; float* gp = gate + (size_t)m * 128 + hd * 16;
#pragma unroll
        for (int q = 0; q < 4; ++q) {
            *(int4*)(ep + 4 * q) = make_int4(__float_as_int(wl[1536 + (4 * q) * 32 + r]), __float_as_int(wl[1536 + (4 * q + 1) * 32 + r]), __float_as_int(wl[1536 + (4 * q + 2) * 32 + r]), __float_as_int(wl[1536 + (4 * q + 3) * 32 + r]));
            *(f32x4*)(gp + 4 * q) = (f32x4){wl[1024 + (4 * q) * 32 + r] * inv, wl[1024 + (4 * q + 1) * 32 + r] * inv, wl[1024 + (4 * q + 2) * 32 + r] * inv, wl[1024 + (4 * q + 3) * 32 + r] * inv}; }
    }
    LDS_WAIT(); asm volatile("" ::: "memory");
}
__device__ __forceinline__ void p7_routing(const Frame& F) {
    const int gw = F.vcu * NWAVES + F.wave, NGW = F.G * NWAVES;
    for (int it = gw; it < (NTOK / 32) * 8; it += NGW) route_task(F, it >> 3, it & 7);
}

__device__ __forceinline__ float rl_f(float v, int l) { return __int_as_float(__builtin_amdgcn_readlane(__float_as_int(v), l)); }
__device__ __forceinline__ float gelu_tanh(float x) {
    const float u = 0.7978845608028654f * (x + 0.044715f * x * x * x);
    const float e = __expf(2.0f * u);
    const float th = 1.0f - 2.0f / (e + 1.0f);
    return 0.5f * x * (1.0f + th);
}
__device__ __forceinline__ float wave_sum_dpp(float v) {
#define DPP_ADD(ctrl, rmask) v += __int_as_float(__builtin_amdgcn_update_dpp(0, __float_as_int(v), ctrl, rmask, 0xF, false))
    DPP_ADD(0xB1, 0xF); DPP_ADD(0x4E, 0xF); DPP_ADD(0x141, 0xF); DPP_ADD(0x140, 0xF); DPP_ADD(0x142, 0xA); DPP_ADD(0x143, 0xC);
#undef DPP_ADD
    return rl_f(v, 63);
}
typedef unsigned u32x6 __attribute__((ext_vector_type(6)));
typedef float f32x32 __attribute__((ext_vector_type(32)));
struct Row6 { u32x4 q[3]; };
__device__ __forceinline__ void row6_load(Row6& r, const unsigned char* tab, int e, int lane) {
    const u32x4* p = (const u32x4*)(tab + (size_t)e * 3072) + lane;
#pragma unroll
    for (int q = 0; q < 3; ++q) r.q[q] = p[64 * q];
}
__device__ __forceinline__ f32x32 row6_deq(const Row6& r, int g) {
    u32x6 w;
    if (g == 0) { w[0] = r.q[0].x; w[1] = r.q[0].y; w[2] = r.q[0].z; w[3] = r.q[0].w; w[4] = r.q[1].x; w[5] = r.q[1].y; }
    else { w[0] = r.q[1].z; w[1] = r.q[1].w; w[2] = r.q[2].x; w[3] = r.q[2].y; w[4] = r.q[2].z; w[5] = r.q[2].w; }
    return __builtin_amdgcn_cvt_scalef32_pk32_f32_fp6(w, 1.0f);
}
__device__ __forceinline__ float row6_dot(const Row6& r, const f32x2 (&hf)[32]) {
    f32x2 acc0 = (f32x2){0.f, 0.f}, acc1 = (f32x2){0.f, 0.f};
#pragma unroll
    for (int g = 0; g < 2; ++g) { const f32x32 d = row6_deq(r, g);
#pragma unroll
        for (int k = 0; k < 16; k += 2) { acc0 = __builtin_elementwise_fma((f32x2){d[2 * k], d[2 * k + 1]}, hf[16 * g + k], acc0); acc1 = __builtin_elementwise_fma((f32x2){d[2 * k + 2], d[2 * k + 3]}, hf[16 * g + k + 1], acc1); } }
    const f32x2 s = acc0 + acc1;
    return s.x + s.y;
}
__device__ __forceinline__ void row6_axpy(const Row6& r, float c, f32x2 (&o)[32]) {
    const f32x2 c2 = (f32x2){c, c};
#pragma unroll
    for (int g = 0; g < 2; ++g) { const f32x32 d = row6_deq(r, g);
#pragma unroll
        for (int k = 0; k < 16; ++k) o[16 * g + k] = __builtin_elementwise_fma((f32x2){d[2 * k], d[2 * k + 1]}, c2, o[16 * g + k]); }
}
__device__ __forceinline__ void expert_token(const Frame& F, int m, size_t orow) {
    const int lane = F.lane;
    const unsigned char* U = F.ws + WS_U; const unsigned char* V = F.ws + WS_V;
    const float* scu = (const float*)(F.ws + WS_SCU); const float* scv = (const float*)(F.ws + WS_SCV);
    const int* eid = (const int*)(F.ws + WS_EID); const float* gate = (const float*)(F.ws + WS_GATE);
    const bf16_t* h1b = (const bf16_t*)(F.ws + WS_H1B); const float* h1f = (const float*)(F.ws + WS_H1F);
    const u64* ssq = (const u64*)(F.ctl + CW_SSQ_H1); const float* gfin = F.in(15);
    const int e0 = eid[(size_t)m * 128 + lane], e1 = eid[(size_t)m * 128 + 64 + lane];
    f32x2 hf[32];
#pragma unroll
    for (int j = 0; j < 16; ++j) { const u32x2 x = *((const u32x2*)(h1b + (size_t)m * DM) + lane + 64 * j); hf[2 * j] = (f32x2){bf_lo(x.x), bf_hi(x.x)}; hf[2 * j + 1] = (f32x2){bf_lo(x.y), bf_hi(x.y)}; }
    const float g0 = gate[(size_t)m * 128 + lane] * scv[e0], g1 = gate[(size_t)m * 128 + 64 + lane] * scv[e1];
    const float rstd = __builtin_amdgcn_rsqf(ssq_get(ssq + m) * (1.0f / DM) + EPS);
    const float su0 = scu[e0] * rstd, su1 = scu[e1] * rstd;
    float a0 = 0.f, a1 = 0.f;
#define EIDX(e) (((e) < 64) ? __builtin_amdgcn_readlane(e0, (e)) : __builtin_amdgcn_readlane(e1, (e) - 64))
    {
        Row6 r0, r1, r2, r3;
        row6_load(r0, U, EIDX(0), lane); row6_load(r1, U, EIDX(1), lane); row6_load(r2, U, EIDX(2), lane); row6_load(r3, U, EIDX(3), lane);
#pragma unroll 1
        for (int e = 0; e < 128; e += 4) {
            const bool more = e + 4 < 128; float p;
            p = wave_sum_dpp(row6_dot(r0, hf)); if (more) row6_load(r0, U, EIDX(e + 4), lane); if (e < 64) { if (lane == e) a0 = p; } else { if (lane == e - 64) a1 = p; }
            p = wave_sum_dpp(row6_dot(r1, hf)); if (more) row6_load(r1, U, EIDX(e + 5), lane); if (e < 64) { if (lane == e + 1) a0 = p; } else { if (lane == e - 63) a1 = p; }
            p = wave_sum_dpp(row6_dot(r2, hf)); if (more) row6_load(r2, U, EIDX(e + 6), lane); if (e < 64) { if (lane == e + 2) a0 = p; } else { if (lane == e - 62) a1 = p; }
            p = wave_sum_dpp(row6_dot(r3, hf)); if (more) row6_load(r3, U, EIDX(e + 7), lane); if (e < 64) { if (lane == e + 3) a0 = p; } else { if (lane == e - 61) a1 = p; }
        }
    }
    const float c0 = gelu_tanh(a0 * su0) * g0, c1 = gelu_tanh(a1 * su1) * g1;
#define CIDX(e) (((e) < 64) ? rl_f(c0, (e)) : rl_f(c1, (e) - 64))
    f32x2 o[32];
#pragma unroll
    for (int i = 0; i < 32; ++i) o[i] = (f32x2){0.f, 0.f};
    {
        Row6 r0, r1, r2, r3;
        row6_load(r0, V, EIDX(0), lane); row6_load(r1, V, EIDX(1), lane); row6_load(r2, V, EIDX(2), lane); row6_load(r3, V, EIDX(3), lane);
#pragma unroll 1
        for (int e = 0; e < 128; e += 4) {
            const bool more = e + 4 < 128;
            row6_axpy(r0, CIDX(e), o); if (more) row6_load(r0, V, EIDX(e + 4), lane);
            row6_axpy(r1, CIDX(e + 1), o); if (more) row6_load(r1, V, EIDX(e + 5), lane);
            row6_axpy(r2, CIDX(e + 2), o); if (more) row6_load(r2, V, EIDX(e + 6), lane);
            row6_axpy(r3, CIDX(e + 3), o); if (more) row6_load(r3, V, EIDX(e + 7), lane);
        }
    }
#undef EIDX
#undef CIDX
    float s = 0.f;
#pragma unroll
    for (int j = 0; j < 16; ++j) { const f32x4 x = *((const f32x4*)(h1f + (size_t)m * DM) + lane + 64 * j); o[2 * j] += (f32x2){x[0], x[1]}; o[2 * j + 1] += (f32x2){x[2], x[3]};
        s += (o[2 * j].x * o[2 * j].x + o[2 * j].y * o[2 * j].y) + (o[2 * j + 1].x * o[2 * j + 1].x + o[2 * j + 1].y * o[2 * j + 1].y); }
    const float rs = 1.0f / sqrtf(wave_sum(s) * (1.0f / DM) + EPS);
    float* op = F.out() + orow * DM;
#pragma unroll
    for (int j = 0; j < 16; ++j) { const f32x4 g = *((const f32x4*)gfin + lane + 64 * j);
        *((f32x4*)op + lane + 64 * j) = (f32x4){o[2 * j].x * rs * g[0], o[2 * j].y * rs * g[1], o[2 * j + 1].x * rs * g[2], o[2 * j + 1].y * rs * g[3]}; }
}
#ifdef MK_STEP_B
__device__ __forceinline__ void stepb_token(const Frame& F, int m, size_t orow) {
    const int lane = F.lane; const float* x = (const float*)(F.ws + WS_H1F) + (size_t)m * DM; const float* gfin = F.in(15);
    f32x4 v[16]; float s = 0.f;
#pragma unroll
    for (int j = 0; j < 16; ++j) { v[j] = *((const f32x4*)x + lane + 64 * j); s += (v[j][0] * v[j][0] + v[j][1] * v[j][1]) + (v[j][2] * v[j][2] + v[j][3] * v[j][3]); }
    const float rs = 1.0f / sqrtf(wave_sum(s) * (1.0f / DM) + EPS);
#pragma unroll
    for (int j = 0; j < 16; ++j) { const f32x4 g = *((const f32x4*)gfin + lane + 64 * j); *((f32x4*)(F.out() + orow * DM) + lane + 64 * j) = v[j] * rs * g; }
}
#endif
#ifdef MK_STEP_A
__device__ __forceinline__ void stepa_token(const Frame& F, size_t orow) {
    const int lane = F.lane; const float* x = F.in(0) + orow * DM; const float* gfin = F.in(15);
    f32x4 v[16]; float s = 0.f;
#pragma unroll
    for (int j = 0; j < 16; ++j) { v[j] = *((const f32x4*)x + lane + 64 * j); s += (v[j][0] * v[j][0] + v[j][1] * v[j][1]) + (v[j][2] * v[j][2] + v[j][3] * v[j][3]); }
    const float rs = 1.0f / sqrtf(wave_sum(s) * (1.0f / DM) + EPS);
#pragma unroll
    for (int j = 0; j < 16; ++j) { const f32x4 g = *((const f32x4*)gfin + lane + 64 * j); *((f32x4*)(F.out() + orow * DM) + lane + 64 * j) = v[j] * rs * g; }
}
#endif
__device__ __forceinline__ void p8_experts(const Frame& F) {
    const int gw = F.vcu * NWAVES + F.wave, NGW = F.G * NWAVES;
#if defined(MK_STEP_A)
    for (int it = gw; it < NB * SEQ; it += NGW) stepa_token(F, (size_t)it);
#elif defined(MK_STEP_B)
    for (int it = gw; it < NB * SEQ; it += NGW) stepb_token(F, it, (size_t)it);
#else
    for (int it = gw; it < NB * SEQ; it += NGW) expert_token(F, it, (size_t)it);
#endif
}
struct Args { const float* in[16]; float* out; unsigned char* ws; int ph_lo, ph_hi; };
#define GEMM_RUN(EPI_T, g_, S_, E_) pg8::gemm_phase<EPI_T, pg8::StaticOrder, true, true>(F.lds, g_, S_, E_)
#define GEMM_RUN2(EPI_T, g_, S_, E_) pg8::gemm_phase<EPI_T, pg8::StaticOrder2, true, true>(F.lds, g_, S_, E_)

__global__ void __launch_bounds__(NWAVES * 64, 2) mk_fwd(Args args) {
    extern __shared__ __attribute__((aligned(16))) unsigned char lds_raw[];
    Frame F;
    F.lds = (LAS unsigned char*)lds_raw;
    F.ws = args.ws; F.ctl = (unsigned*)(args.ws + WS_CTL);
    F.tid = threadIdx.x; F.lane = F.tid & 63; F.wave = __builtin_amdgcn_readfirstlane(F.tid >> 6);
#define PHASE_BEGIN() do { int t_; asm volatile("v_mov_b32 %0, %1" : "=v"(t_) : "v"(threadIdx.x)); F.tid = t_; F.lane = t_ & 63; } while (0)
    F.G = gridDim.x; { const int bx = blockIdx.x; F.vcu = (F.G % 8 == 0) ? (bx % 8) * (F.G / 8) + bx / 8 : bx; }
    for (int u = F.tid; u < (LDS_BYTES - LDSCTL_OFF) / 4; u += NWAVES * 64) ((LAS unsigned*)(F.lds + LDSCTL_OFF))[u] = 0u;
    __syncthreads();
    XcdBarrier bar; bar.bar = F.ctl + CW_BAR; bar.x = 0; bar.st = nullptr;
    if (!MK_PER_PHASE) bar = xcd_barrier_post(F.ctl + CW_BAR, (volatile LAS unsigned*)(F.lds + LDSCTL_OFF));
    const int lo = args.ph_lo, hi = args.ph_hi;
#ifndef PH_MASK
#define PH_MASK 0x1FF
#endif
#define IN(k) (((PH_MASK >> (k)) & 1) && lo <= (k) && (k) < hi)
#ifdef MK_PROBE_T
#define STAMP(k) do { if (blockIdx.x == 0 && threadIdx.x == 0) ((volatile u64*)(F.ctl + 2048))[k] = __builtin_amdgcn_s_memrealtime(); } while (0)
#else
#define STAMP(k) do { } while (0)
#endif
#define SEAM(k) do { if (IN(k) && IN((k) + 1)) xcd_barrier(bar); STAMP((k) + 1); } while (0)
    unsigned char* ws = F.ws;

#ifndef MK_REP_MASK
#define MK_REP_MASK 0
#endif
#define NREP(k) (((MK_REP_MASK >> (k)) & 1) ? 2 : 1)
    STAMP(0);
    if (IN(0)) { for (int rep = 0; rep < NREP(0); ++rep) { PHASE_BEGIN(); p0_prologue(F); if (rep + 1 < NREP(0)) xcd_barrier(bar); } }
    SEAM(0);
    if (IN(1)) { for (int rep = 0; rep < NREP(1); ++rep) { PHASE_BEGIN();
        p1_quant_weights(F);
        xcd_barrier(bar);
        {
            pg8::Gemm g{(const bf16_t*)(ws + WS_XN8), (const bf16_t*)(ws + WS_WG8), MK, 8192, DM / 2, DM / 2}; pg8::StaticOrder S; S.init(MK, 8192, F.G, (int)blockIdx.x);
            epi::EpiGate E{(bf16_t*)(ws + WS_GA), (bf16_t*)(ws + WS_GB), (const float*)(ws + WS_SX), (const float*)(ws + WS_SW)};
            GEMM_RUN(epi::EpiGate, g, S, E); }
        __syncthreads();
        {
            pg8::Gemm g{(const bf16_t*)(ws + WS_XN), (const bf16_t*)(ws + WS_WIN), MK, 5888, DM, DM}; pg8::StaticOrder S; S.init(MK, 5888, F.G, (int)(gridDim.x - 1 - blockIdx.x));
            epi::EpiIn E{(bf16_t*)(ws + WS_CQ), (bf16_t*)(ws + WS_CKV), (bf16_t*)(ws + WS_QB), (bf16_t*)(ws + WS_KB), (bf16_t*)(ws + WS_VB), (bf16_t*)(ws + WS_QIX), (bf16_t*)(ws + WS_KPE), (bf16_t*)(ws + WS_KIX),
                          (bf16_t*)(ws + WS_GA), (bf16_t*)(ws + WS_GB), (float*)(ws + WS_WIX), rep ? nullptr : (u64*)(F.ctl + CW_SSQ_CQ), rep ? nullptr : (u64*)(F.ctl + CW_SSQ_CKV),
                          (const float*)(ws + WS_ROPE_M), (const float*)(ws + WS_ROPE_D), (const float*)(ws + WS_ROPE_I)};
            GEMM_RUN(epi::EpiIn, g, S, E); }
        if (rep + 1 < NREP(1)) xcd_barrier(bar); }
    }
    SEAM(1);
    if (IN(2)) { for (int rep = 0; rep < NREP(2); ++rep) { PHASE_BEGIN();
        { pg8::Gemm g{(const bf16_t*)(ws + WS_CQ), (const bf16_t*)(ws + WS_WUQ), NTOK, 3072, 1024, 1024}; pg8::StaticOrder S; S.init(NTOK, 3072, F.G, (int)blockIdx.x);
          epi::EpiUp E{(bf16_t*)(ws + WS_QN), (bf16_t*)(ws + WS_QR), 8, 2048, 1024, (const u64*)(F.ctl + CW_SSQ_CQ), 1.0f / 1024.0f, QA_SCALE, (const float*)(ws + WS_ROPE_M)};
          GEMM_RUN(epi::EpiUp, g, S, E); }
        __syncthreads();
        { pg8::Gemm g{(const bf16_t*)(ws + WS_CKV), (const bf16_t*)(ws + WS_WUKV), MK, 4096, 512, 512}; pg8::StaticOrder S; S.init(MK, 4096, F.G, (int)blockIdx.x);
          epi::EpiUp E{(bf16_t*)(ws + WS_KN), (bf16_t*)(ws + WS_VA), 8, 2048, 2048, (const u64*)(F.ctl + CW_SSQ_CKV), 1.0f / 512.0f, 1.0f, nullptr};
          GEMM_RUN(epi::EpiUp, g, S, E); }
        __syncthreads();
        p2_indexer(F, rep);
        if (rep + 1 < NREP(2)) xcd_barrier(bar); }
    }
    SEAM(2);
    if (IN(3)) { for (int rep = 0; rep < NREP(3); ++rep) { PHASE_BEGIN(); p3_attention(F, 2 + rep); if (rep + 1 < NREP(3)) xcd_barrier(bar); } }
    SEAM(3);
    if (IN(4)) { for (int rep = 0; rep < NREP(4); ++rep) { PHASE_BEGIN();
        rowquant_fp8(F, ws + WS_OAB, (size_t)DM * 2, ws + WS_OAB, (size_t)DM * 2, (float*)(ws + WS_SOAB), NTOK);
        xcd_barrier(bar);
        pg8::Gemm g{(const bf16_t*)(ws + WS_OAB), (const bf16_t*)(ws + WS_WBR), NTOK, 4096, 4096, 1024}; pg8::StaticOrder2 S; S.init(NTOK, 4096, F.G, (int)blockIdx.x);
        epi::EpiBranch E{(const bf16_t*)(ws + WS_GA), (const bf16_t*)(ws + WS_GB), (bf16_t*)(ws + WS_MRG), (const float*)(ws + WS_SOAB), (const float*)(ws + WS_SWBR)};
        GEMM_RUN2(epi::EpiBranch, g, S, E);
        if (rep + 1 < NREP(4)) xcd_barrier(bar); }
    }
    SEAM(4);
    if (IN(5)) { for (int rep = 0; rep < NREP(5); ++rep) { PHASE_BEGIN();
        rowquant_fp8(F, ws + WS_MRG, (size_t)DM * 2, ws + WS_MRG, (size_t)DM * 2, (float*)(ws + WS_SMRG), NTOK);
        xcd_barrier(bar);
        pg8::Gemm g{(const bf16_t*)(ws + WS_MRG), (const bf16_t*)(ws + WS_WOUT), NTOK, 4096, 4096, 2048}; pg8::StaticOrder S; S.init(NTOK, 4096, F.G, (int)blockIdx.x);
        epi::EpiOut E{F.in(0), F.in(1), (float*)(ws + WS_H1F), (bf16_t*)(ws + WS_H1B), rep ? nullptr : (u64*)(F.ctl + CW_SSQ_H1), (const float*)(ws + WS_SMRG), (const float*)(ws + WS_SWOUT)};
        GEMM_RUN(epi::EpiOut, g, S, E);
        if (rep + 1 < NREP(5)) xcd_barrier(bar); }
    }
    SEAM(5);
    if (IN(6)) { for (int rep = 0; rep < NREP(6); ++rep) { PHASE_BEGIN();
        pg8::Gemm g{(const bf16_t*)(ws + WS_H1B), (const bf16_t*)(ws + WS_WQ), NTOK, 2048, 4096, 4096}; pg8::StaticOrder S; S.init(NTOK, 2048, F.G, (int)blockIdx.x);
        epi::EpiPQ E{(bf16_t*)(ws + WS_PQ), (const u64*)(F.ctl + CW_SSQ_H1)};
        GEMM_RUN(epi::EpiPQ, g, S, E);
        p6_tables(F);
        if (rep + 1 < NREP(6)) xcd_barrier(bar); }
    }
    SEAM(6);
    if (IN(7)) { for (int rep = 0; rep < NREP(7); ++rep) { PHASE_BEGIN(); p7_routing(F); if (rep + 1 < NREP(7)) xcd_barrier(bar); } }
    SEAM(7);
    if (IN(8)) { for (int rep = 0; rep < NREP(8); ++rep) { PHASE_BEGIN(); p8_experts(F); if (rep + 1 < NREP(8)) xcd_barrier(bar); } }
#ifdef MK_PROBE_T
    {   PHASE_BEGIN();
        xcd_barrier(bar); STAMP(9); xcd_barrier(bar);
        const volatile u64* ts = (const volatile u64*)(F.ctl + 2048);
        const float tot = (float)(ts[9] - ts[0]);
        const float f1 = (float)(ts[MK_PROBE_K1 + 1] - ts[MK_PROBE_K1]) / tot, f2 = (float)(ts[MK_PROBE_K2 + 1] - ts[MK_PROBE_K2]) / tot;
        float* o = F.out(); const size_t gt = (size_t)blockIdx.x * 512 + F.tid, NGT = (size_t)gridDim.x * 512;
        for (size_t i = gt; i < (size_t)NB * SEQ * DM / 4; i += NGT) { f32x4 v = ((f32x4*)o)[i]; v = v * (1.0f - f1); if (i == 0) v[0] = 1000.0f * f2; ((f32x4*)o)[i] = v; }
    }
#endif
#undef IN
#undef SEAM
}

extern "C" void kernel_launch(void* const* d_in, const int* in_sizes, int n_in, void* d_out, int out_size, void* d_ws, size_t ws_size, hipStream_t stream) {
    static int grid = 0;
    if (grid == 0) {
        if (n_in != 16 || in_sizes[0] != NB * SEQ * DM || out_size != NB * SEQ * DM || ws_size < WS_END) {
            fprintf(stderr, "kernel_launch: unexpected problem shape (n_in %d, in0 %d, out %d, ws %zu < %zu); nothing launched\n", n_in, n_in > 0 ? in_sizes[0] : -1, out_size, ws_size, (size_t)WS_END); grid = -1; return; }
        int dev = 0, cus = 0, per_cu = 0;
        if (hipGetDevice(&dev) != hipSuccess || hipDeviceGetAttribute(&cus, hipDeviceAttributeMultiprocessorCount, dev) != hipSuccess) { grid = -1; return; }
        if (hipFuncSetAttribute((const void*)mk_fwd, hipFuncAttributeMaxDynamicSharedMemorySize, LDS_BYTES) != hipSuccess) { fprintf(stderr, "kernel_launch: hipFuncSetAttribute failed\n"); grid = -1; return; }
        if (hipOccupancyMaxActiveBlocksPerMultiprocessor(&per_cu, (const void*)mk_fwd, NWAVES * 64, LDS_BYTES) != hipSuccess || per_cu < 1) {
            fprintf(stderr, "kernel_launch: occupancy query reports %d workgroups per CU\n", per_cu); }
        (void)hipGetLastError();
        grid = cus;
    }
    if (grid < 0) return;
    if (hipMemsetAsync((char*)d_ws + WS_CTL, 0, CTL_ZERO_BYTES, stream) != hipSuccess) return;
    Args a{};
    for (int i = 0; i < 16; ++i) a.in[i] = (const float*)d_in[i];
    a.out = (float*)d_out; a.ws = (unsigned char*)d_ws;
#if MK_PER_PHASE
    for (int p = 0; p <= MK_LAST_PHASE; ++p) { a.ph_lo = p; a.ph_hi = p + 1; hipLaunchKernelGGL(mk_fwd, dim3(grid), dim3(NWAVES * 64), LDS_BYTES, stream, a); }
#else
    a.ph_lo = 0; a.ph_hi = MK_LAST_PHASE + 1;
    hipLaunchKernelGGL(mk_fwd, dim3(grid), dim3(NWAVES * 64), LDS_BYTES, stream, a);
#endif
}
```

```cpp
#include <hip/hip_runtime.h>
#include <cstdio>
#include <cstdint>

#define LAS __attribute__((address_space(3)))
#define GAS __attribute__((address_space(1)))
typedef unsigned short bf16_t;
typedef short bf16x8 __attribute__((ext_vector_type(8)));
typedef short s16x4 __attribute__((ext_vector_type(4)));
typedef float f32x2 __attribute__((ext_vector_type(2)));
typedef float f32x4 __attribute__((ext_vector_type(4)));
typedef float f32x16 __attribute__((ext_vector_type(16)));
typedef unsigned u32x2 __attribute__((ext_vector_type(2)));
typedef unsigned u32x4 __attribute__((ext_vector_type(4)));
typedef GAS unsigned gu32;

#ifndef MK_PER_PHASE
#define MK_PER_PHASE 0
#endif
#ifndef MK_LAST_PHASE
#define MK_LAST_PHASE 8
#endif

constexpr int NB = 4, SEQ = 4096, DM = 4096, NMETA = 16, TR = SEQ + NMETA  , TP = 4224  , M = NB * TP  ;
constexpr float EPS = 1e-6f;
constexpr int NV1 = 14080;
constexpr float LOG2E = 1.4426950408889634f;
constexpr float QB_SCALE = 0.08838834764831845f * LOG2E;
constexpr float QA_SCALE = 0.07216878364870323f * LOG2E;
constexpr int NWAVES = 8;
constexpr int NTOK = NB * SEQ;
constexpr int MK = NTOK + 256;
constexpr int MW = 130;
__device__ __forceinline__ int row_pos(int row) { return row < NTOK ? NMETA + (row & (SEQ - 1)) : row - NTOK; }
__device__ __forceinline__ int pos_row(int b, int p) { return p < NMETA ? NTOK + p : b * SEQ + (p - NMETA); }

constexpr size_t HM = 512u * 1024u;
constexpr size_t WS_CTL = 0, CTL_ZERO_BYTES = 2 * HM;
constexpr size_t WS_ROPE_M = 2 * HM;
constexpr size_t WS_ROPE_D = 5 * HM;
constexpr size_t WS_ROPE_I = 7 * HM;
constexpr size_t WS_SK   = 8 * HM;
constexpr size_t WS_WUQ  = 10 * HM;
constexpr size_t WS_WUKV = 22 * HM;
constexpr size_t WS_WBR  = 30 * HM;
constexpr size_t WS_WOUT = 94 * HM;
constexpr size_t WS_WQ   = 158 * HM;
constexpr size_t WS_EID  = 190 * HM;
constexpr size_t WS_GATE = 207 * HM;
constexpr size_t WS_MASK = 224 * HM;
constexpr size_t WS_KPE  = 242 * HM;
constexpr size_t WS_KIX  = 247 * HM;
constexpr size_t WS_WIX  = 252 * HM;
constexpr size_t WS_SCU  = 255 * HM;
constexpr size_t WS_SCV  = 255 * HM + 65536;
constexpr size_t WS_SX   = 255 * HM + 131072;
constexpr size_t WS_SW   = 255 * HM + 200704;
constexpr size_t WS_SWBR = 255 * HM + 294912;
constexpr size_t WS_SWOUT= 255 * HM + 311296;
constexpr size_t WS_SOAB = 255 * HM + 327680;
constexpr size_t WS_SMRG = 255 * HM + 393216;
constexpr size_t R23 = 260 * HM;
constexpr size_t WS_XN   = R23;
constexpr size_t WS_WIN  = R23 + 264 * HM;
constexpr size_t P1O = R23 + 484 * HM;
constexpr size_t WS_CQ   = P1O;
constexpr size_t WS_CKV  = P1O + 66 * HM;
constexpr size_t WS_QB   = P1O + 99 * HM;
constexpr size_t WS_KB   = P1O + 231 * HM;
constexpr size_t WS_VB   = P1O + 264 * HM;
constexpr size_t WS_QIX  = P1O + 297 * HM;
constexpr size_t WS_GA   = P1O + 363 * HM;
constexpr size_t WS_GB   = P1O + 627 * HM;
constexpr size_t R4 = P1O + 892 * HM;
constexpr size_t WS_OAB  = R4;
constexpr size_t WS_XN8  = R4;
constexpr size_t WS_WG8  = R4 + 132 * HM;
constexpr size_t WS_PQ   = R4;
constexpr size_t WS_END  = R4 + 264 * HM;
constexpr size_t WS_QN   = R23;
constexpr size_t WS_QR   = R23 + 132 * HM;
constexpr size_t WS_KN   = R23 + 198 * HM;
constexpr size_t WS_VA   = R23 + 330 * HM;
constexpr size_t WS_MRG  = R23;
constexpr size_t WS_U    = R23;
constexpr size_t WS_V    = R23 + 256 * HM;
constexpr size_t WS_H1F  = R23 + 512 * HM;
constexpr size_t WS_H1B  = R23 + 1040 * HM;
static_assert(WS_VA + 132 * HM <= P1O && WS_H1F >= P1O && WS_H1B + 264 * HM <= R4 && WS_GB + 264 * HM <= R4, "ws map");
constexpr int CW_TMO = 0;
constexpr int CW_BAR = 4096;
constexpr int CW_QUEUE = 8192;
constexpr int CW_SSQ_CQ = 16384, CW_SSQ_CKV = 16384 + 2 * 17408, CW_SSQ_H1 = 16384 + 4 * 17408;
static_assert((CW_SSQ_H1 + 2 * 17408) * 4 <= (int)CTL_ZERO_BYTES, "ctl");

constexpr int RING_BYTES = 131072;
constexpr int LDSCTL_OFF = RING_BYTES;
constexpr int LDS_BYTES = 147456;

__device__ __forceinline__ unsigned f2bf(float f) { unsigned u = __float_as_uint(f); return (u + 0x7fffu + ((u >> 16) & 1u)) >> 16; }
__device__ __forceinline__ unsigned pk2(float lo, float hi) { return f2bf(lo) | (f2bf(hi) << 16); }
typedef __bf16 bf16x2_t __attribute__((ext_vector_type(2)));
__device__ __forceinline__ unsigned cvt_pk_bf16(float lo, float hi) { return __builtin_bit_cast(unsigned, __builtin_convertvector((f32x2){lo, hi}, bf16x2_t)); }
__device__ __forceinline__ float bf_lo(unsigned w) { return __uint_as_float(w << 16); }
__device__ __forceinline__ float bf_hi(unsigned w) { return __uint_as_float(w & 0xffff0000u); }
__device__ __forceinline__ u32x4 pack8(f32x4 a, f32x4 b) { u32x4 w; w.x = cvt_pk_bf16(a[0], a[1]); w.y = cvt_pk_bf16(a[2], a[3]); w.z = cvt_pk_bf16(b[0], b[1]); w.w = cvt_pk_bf16(b[2], b[3]); return w; }
__device__ __forceinline__ float wave_sum(float v) {
#pragma unroll
    for (int o = 1; o < 64; o <<= 1) v += __shfl_xor(v, o);
    return v;
}
#define LDS_WAIT() asm volatile("s_waitcnt lgkmcnt(0)" ::: "memory")
#define VM_WAIT() asm volatile("s_waitcnt vmcnt(0)" ::: "memory")
typedef unsigned long long u64;
__device__ __forceinline__ void ssq_add(u64* p, float v) { (void)__hip_atomic_fetch_add(p, (u64)(v * 16777216.0f), __ATOMIC_RELAXED, __HIP_MEMORY_SCOPE_AGENT); }
__device__ __forceinline__ float ssq_get(const u64* p) { return (float)((double)(*p) * (1.0 / 16777216.0)); }
namespace pg8 {
#define PG8_LAS __attribute__((address_space(3)))
typedef unsigned short bf16_t;
typedef short bf16x8 __attribute__((ext_vector_type(8)));
typedef float f32x4 __attribute__((ext_vector_type(4)));
typedef unsigned u32x4 __attribute__((ext_vector_type(4)));
constexpr int BM = 256, BK = 64, HALF = 128, HTB = HALF * BK * 2  , STAGE_BYTES = 8 * HTB, NXCD = 8, WGM = 8;

__host__ __device__ __forceinline__ int lds_byte(int r, int c) { const int st = (r >> 4) * 2 + (c >> 5), rr = r & 15, cc = c & 31, ob = rr * 64 + cc * 2; return st * 1024 + (ob ^ (((ob >> 9) & 1) << 5)); }
__host__ __device__ __forceinline__ void stage_rc(int b, int& R, int& C) { const int st = b / 1024, sb = b % 1024, swz = sb ^ (((sb >> 9) & 1) << 5); R = (st >> 1) * 16 + swz / 64; C = (st & 1) * 32 + (swz % 64) / 2; }
__host__ __device__ __forceinline__ int perm32(int rho) { const int n = rho >> 4, i = rho & 15; return 8 * (i >> 2) + 4 * n + (i & 3); }

typedef int i32x4_t __attribute__((ext_vector_type(4)));
typedef int i32x8_t __attribute__((ext_vector_type(8)));
__device__ __forceinline__ i32x8_t cat8(bf16x8 lo, bf16x8 hi) { const i32x4_t a = __builtin_bit_cast(i32x4_t, lo), b = __builtin_bit_cast(i32x4_t, hi); return __builtin_shufflevector(a, b, 0, 1, 2, 3, 4, 5, 6, 7); }
__device__ __forceinline__ void mfma_f8_acc(f32x4& c, const i32x8_t a, const i32x8_t b) {
#if defined(__HIP_DEVICE_COMPILE__)
    int sc = 0x7F7F7F7F;
    asm volatile("v_mfma_scale_f32_16x16x128_f8f6f4 %0, %1, %2, %0, %3, %3 op_sel_hi:[0,0,0]" : "+v"(c) : "v"(a), "v"(b), "v"(sc));
#else
    (void)c; (void)a; (void)b;
#endif
}
struct Unit { int pm, pn, kh; };
struct Gemm { const bf16_t* A; const bf16_t* Bt; int M, N, K, KL; };

struct StaticOrder {
    int nM, nN, nwg, G, c;
    __host__ __device__ void init(int M, int N, int G_, int c_) { nM = M / BM; nN = N / BM; nwg = nM * nN; G = G_; c = c_; }
    __host__ __device__ bool next(int i, Unit& u) const {
        const long L = (long)i * G + c; if (L >= nwg) return false;
        int wgid = (int)L; { const int q = nwg / NXCD, r = nwg % NXCD, xcd = wgid % NXCD, off = wgid / NXCD; wgid = (xcd < r ? xcd * (q + 1) : r * (q + 1) + (xcd - r) * q) + off; }
        const int nig = WGM * nN, gid = wgid / nig, fm = gid * WGM, gsz = (nM - fm) < WGM ? (nM - fm) : WGM;
        u.pm = fm + ((wgid % nig) % gsz); u.pn = (wgid % nig) / gsz; u.kh = 0; return true;
    }
    __device__ __forceinline__ void a_ready(const Unit&) const {}
    __device__ __forceinline__ void done(const Unit&) const {}
};

struct StaticOrder2 {
    StaticOrder base;
    __host__ __device__ void init(int M, int N, int G_, int c_) { base.init(M, N, G_, c_); }
    __host__ __device__ bool next(int i, Unit& u) const { if (!base.next(i >> 1, u)) return false; u.kh = i & 1; return true; }
    __device__ __forceinline__ void a_ready(const Unit&) const {}
    __device__ __forceinline__ void done(const Unit&) const {}
};

template <class Epi, class Sched, bool ALIGN_EPI = false, bool SP2 = false>
__device__ __forceinline__ void gemm_phase(PG8_LAS unsigned char* lds, const Gemm g, const Sched& S, const Epi& E) {
    int tid_; asm volatile("v_mov_b32 %0, %1" : "=v"(tid_) : "v"(threadIdx.x));
    const int tid = tid_, wid = __builtin_amdgcn_readfirstlane(tid >> 6), lane = tid & 63, wr = wid >> 2, wc = wid & 3, fr = lane & 15, fq = lane >> 4;
    const int K = g.K, nt = g.KL / BK; const size_t khoff = (size_t)g.KL * 2;
    unsigned voffA[2], voffB[2];
#pragma unroll
    for (int i = 0; i < 2; ++i) { int R, C; stage_rc(tid * 16 + i * 8192, R, C); const int Rb = Epi::PERM ? ((R & ~31) + perm32(R & 31)) : R;
        voffA[i] = (unsigned)(R * K + C) * 2u; voffB[i] = (unsigned)(Rb * K + C) * 2u; }
    const size_t kstep = (size_t)(BK * 2);
    const size_t hstep = (size_t)HALF * K * 2;
    const size_t tstep = 2 * hstep;
    const unsigned ldsw = (unsigned)wid * 1024u;
    const int aoff = lds_byte(wr * 64 + fr, fq * 8), boff = lds_byte(wc * 32 + fr, fq * 8);
#define PG8_SA(b, h) (((b) * 2 + (h)) * HTB)
#define PG8_SB(b, h) ((4 + (b) * 2 + (h)) * HTB)
#define PG8_STAGE(bufoff, gbase, voff) do { _Pragma("unroll") for (int _i = 0; _i < 2; ++_i) \
        __builtin_amdgcn_global_load_lds((const unsigned*)((const char*)(gbase) + (voff)[_i]), (PG8_LAS unsigned*)(lds + (bufoff) + ldsw + _i * 8192), 16, 0, 0); } while (0)
#define PG8_LDA(dst, b, h) do { _Pragma("unroll") for (int m = 0; m < 4; ++m) _Pragma("unroll") for (int k = 0; k < 2; ++k) dst[m][k] = *(const PG8_LAS bf16x8*)(lds + PG8_SA(b, h) + aoff + m * 2048 + k * 1024); } while (0)
#define PG8_LDB(dst, b, h) do { _Pragma("unroll") for (int n = 0; n < 2; ++n) _Pragma("unroll") for (int k = 0; k < 2; ++k) dst[n][k] = *(const PG8_LAS bf16x8*)(lds + PG8_SB(b, h) + boff + n * 2048 + k * 1024); } while (0)
#define PG8_MMA(ai, bj, At, Bt) do { __builtin_amdgcn_s_setprio(1); _Pragma("unroll") for (int m = 0; m < 4; ++m) _Pragma("unroll") for (int n = 0; n < 2; ++n) { \
        if constexpr (Epi::FP8) mfma_f8_acc(acc[ai][bj][m][n], cat8(Bt[n][0], Bt[n][1]), cat8(At[m][0], At[m][1])); \
        else { _Pragma("unroll") for (int k = 0; k < 2; ++k) acc[ai][bj][m][n] = __builtin_amdgcn_mfma_f32_16x16x32_bf16(Bt[n][k], At[m][k], acc[ai][bj][m][n], 0, 0, 0); } } \
        __builtin_amdgcn_s_setprio(0); } while (0)
#define PG8_WAIT_V(n) asm volatile("s_waitcnt vmcnt(" #n ")" ::: "memory")
#define PG8_WAIT_L(n) asm volatile("s_waitcnt lgkmcnt(" #n ")" ::: "memory")
#define PG8_BAR __builtin_amdgcn_s_barrier()
#define PG8_SCHED __builtin_amdgcn_sched_barrier(0)
    Unit cur, nxt; int ui = 0;
    if (!S.next(0, cur)) return;
    f32x4 acc[2][2][4][2];
#pragma unroll
    for (int a = 0; a < 2; ++a)
#pragma unroll
        for (int b = 0; b < 2; ++b)
#pragma unroll
            for (int m = 0; m < 4; ++m)
#pragma unroll
                for (int n = 0; n < 2; ++n) acc[a][b][m][n] = (f32x4){0.f, 0.f, 0.f, 0.f};
    bf16x8 At[4][2], B0[2][2], B1[2][2];
    const char* cA = (const char*)g.A + (size_t)cur.pm * tstep + (size_t)cur.kh * khoff; const char* cB = (const char*)g.Bt + (size_t)cur.pn * tstep + (size_t)cur.kh * khoff;
    S.a_ready(cur);
    if constexpr (SP2) {
        PG8_STAGE(PG8_SB(0, 0), cB, voffB); PG8_STAGE(PG8_SB(0, 1), cB + hstep, voffB); PG8_STAGE(PG8_SA(0, 0), cA, voffA); PG8_STAGE(PG8_SA(0, 1), cA + hstep, voffA);
        if (wr == 1) PG8_BAR;
        PG8_WAIT_V(2); PG8_BAR;
        PG8_STAGE(PG8_SB(1, 0), cB + kstep, voffB); PG8_STAGE(PG8_SA(1, 0), cA + kstep, voffA); PG8_STAGE(PG8_SB(1, 1), cB + hstep + kstep, voffB);
        PG8_WAIT_V(6); PG8_BAR;
    } else {
        PG8_STAGE(PG8_SB(0, 0), cB, voffB); PG8_STAGE(PG8_SA(0, 0), cA, voffA); PG8_STAGE(PG8_SB(0, 1), cB + hstep, voffB); PG8_STAGE(PG8_SA(0, 1), cA + hstep, voffA);
        if (wr == 1) PG8_BAR;
        PG8_WAIT_V(4); PG8_BAR;
        PG8_STAGE(PG8_SB(1, 0), cB + kstep, voffB); PG8_STAGE(PG8_SA(1, 0), cA + kstep, voffA); PG8_STAGE(PG8_SB(1, 1), cB + hstep + kstep, voffB);
        PG8_WAIT_V(6); PG8_BAR;
    }
    for (;;) {
        const bool has_next = S.next(ui + 1, nxt);
        const char* nA = has_next ? (const char*)g.A + (size_t)nxt.pm * tstep + (size_t)nxt.kh * khoff : cA; const char* nB = has_next ? (const char*)g.Bt + (size_t)nxt.pn * tstep + (size_t)nxt.kh * khoff : cB;
        for (int t = 0; t < nt; t += 2) {
            const bool last = (t == nt - 2);
            const char* a1 = cA + (size_t)(t + 1) * kstep;
            const char* a2 = last ? nA : cA + (size_t)(t + 2) * kstep; const char* b2 = last ? nB : cB + (size_t)(t + 2) * kstep;
            const char* a3 = a2 + kstep; const char* b3 = b2 + kstep;
            if (last && has_next) S.a_ready(nxt);
            if constexpr (SP2) {
            PG8_LDB(B0, 0, 0); PG8_LDB(B1, 0, 1); PG8_SCHED; PG8_LDA(At, 0, 0); PG8_STAGE(PG8_SA(1, 1), a1 + hstep, voffA);
            PG8_WAIT_V(8); PG8_WAIT_L(0); PG8_BAR; PG8_MMA(0, 0, At, B0); PG8_MMA(0, 1, At, B1); PG8_BAR; PG8_SCHED;
            PG8_LDA(At, 0, 1); PG8_STAGE(PG8_SB(0, 0), b2, voffB); PG8_STAGE(PG8_SB(0, 1), b2 + hstep, voffB); PG8_STAGE(PG8_SA(0, 0), a2, voffA);
            PG8_WAIT_V(8); PG8_WAIT_L(0); PG8_BAR; PG8_MMA(1, 0, At, B0); PG8_MMA(1, 1, At, B1); PG8_BAR; PG8_SCHED;
            PG8_LDB(B0, 1, 0); PG8_LDB(B1, 1, 1); PG8_SCHED; PG8_LDA(At, 1, 0); PG8_STAGE(PG8_SA(0, 1), a2 + hstep, voffA);
            PG8_WAIT_V(8); PG8_WAIT_L(0); PG8_BAR; PG8_MMA(0, 0, At, B0); PG8_MMA(0, 1, At, B1); PG8_BAR; PG8_SCHED;
            PG8_LDA(At, 1, 1); PG8_STAGE(PG8_SB(1, 0), b3, voffB); PG8_STAGE(PG8_SB(1, 1), b3 + hstep, voffB); PG8_STAGE(PG8_SA(1, 0), a3, voffA);
            PG8_WAIT_V(8); PG8_WAIT_L(0); PG8_BAR; PG8_MMA(1, 0, At, B0); PG8_MMA(1, 1, At, B1); PG8_BAR; PG8_SCHED;
            } else {
            PG8_LDB(B0, 0, 0); PG8_SCHED; PG8_LDA(At, 0, 0); PG8_STAGE(PG8_SA(1, 1), a1 + hstep, voffA);
            PG8_WAIT_L(8); PG8_BAR; PG8_WAIT_L(0); PG8_MMA(0, 0, At, B0); PG8_BAR; PG8_SCHED;
            PG8_LDB(B1, 0, 1); PG8_STAGE(PG8_SB(0, 0), b2, voffB);
            PG8_BAR; PG8_WAIT_L(0); PG8_MMA(0, 1, At, B1); PG8_BAR;
            PG8_LDA(At, 0, 1); PG8_STAGE(PG8_SA(0, 0), a2, voffA);
            PG8_BAR; PG8_WAIT_L(0); PG8_MMA(1, 0, At, B0); PG8_BAR; PG8_SCHED;
            PG8_STAGE(PG8_SB(0, 1), b2 + hstep, voffB);
            PG8_WAIT_V(6); PG8_BAR; PG8_MMA(1, 1, At, B1); PG8_BAR;
            PG8_LDB(B0, 1, 0); PG8_SCHED; PG8_LDA(At, 1, 0); PG8_STAGE(PG8_SA(0, 1), a2 + hstep, voffA);
            PG8_WAIT_L(8); PG8_BAR; PG8_WAIT_L(0); PG8_MMA(0, 0, At, B0); PG8_BAR; PG8_SCHED;
            PG8_LDB(B1, 1, 1); PG8_STAGE(PG8_SB(1, 0), b3, voffB);
            PG8_BAR; PG8_WAIT_L(0); PG8_MMA(0, 1, At, B1); PG8_BAR;
            PG8_LDA(At, 1, 1); PG8_STAGE(PG8_SA(1, 0), a3, voffA);
            PG8_BAR; PG8_WAIT_L(0); PG8_MMA(1, 0, At, B0); PG8_BAR; PG8_SCHED;
            PG8_STAGE(PG8_SB(1, 1), b3 + hstep, voffB);
            PG8_WAIT_V(6); PG8_BAR; PG8_MMA(1, 1, At, B1); PG8_BAR;
            }
        }
        if constexpr (ALIGN_EPI) { if (wr == 0) PG8_BAR; }
        if constexpr (!Epi::AFTER_DRAIN) { E(acc, cur, wr, wc, fr, fq); S.done(cur); }
        if (!has_next) break;
        if (!(Epi::SPLITK2 && cur.kh == 0))
#pragma unroll
        for (int a = 0; a < 2; ++a)
#pragma unroll
            for (int b = 0; b < 2; ++b)
#pragma unroll
                for (int m = 0; m < 4; ++m)
#pragma unroll
                    for (int n = 0; n < 2; ++n) acc[a][b][m][n] = (f32x4){0.f, 0.f, 0.f, 0.f};
        cur = nxt; cA = nA; cB = nB; ++ui;
        if constexpr (ALIGN_EPI) { if (wr == 1) PG8_BAR; }
    }
    PG8_WAIT_V(0);
    if constexpr (!ALIGN_EPI) { if (wr == 0) PG8_BAR; }
    PG8_BAR;
    if constexpr (Epi::AFTER_DRAIN) { E.fused(acc, cur, wr, wc, fr, fq, lds, wid, lane); S.done(cur); }
#undef PG8_SA
#undef PG8_SB
#undef PG8_STAGE
#undef PG8_LDA
#undef PG8_LDB
#undef PG8_MMA
#undef PG8_WAIT_V
#undef PG8_WAIT_L
#undef PG8_BAR
#undef PG8_SCHED
}
}
namespace epi {
using pg8::Unit;
typedef f32x4 Acc[2][2][4][2];

__device__ __forceinline__ void rot2(f32x4& v, const f32x4 cs) {
    const float a1 = v[0] * cs[0] - v[1] * cs[1], a2 = v[1] * cs[0] + v[0] * cs[1];
    const float b1 = v[2] * cs[2] - v[3] * cs[3], b2 = v[3] * cs[2] + v[2] * cs[3];
    v = (f32x4){a1, a2, b1, b2};
}
__device__ __forceinline__ float sigm(float x) { return 1.0f / (1.0f + __expf(-x)); }

template <bool F8> struct EpiIn {
    static constexpr bool PERM = true, AFTER_DRAIN = false, SPLITK2 = false, FP8 = F8;
    bf16_t *cq, *ckv, *qb, *kb, *vb, *qix, *kpe, *kix, *ga, *gb; float* wix; u64 *ssq_cq, *ssq_ckv;
    const float *ropeM, *ropeD, *ropeI;
    const float *sx, *sw;
    __device__ __forceinline__ void operator()(const Acc& acc, const Unit& u, int wr, int wc, int fr, int fq) const {
        const int vt = F8 ? (u.pn < 18 ? u.pn : u.pn + 5) : u.pn + 18, rowb = u.pm * 256 + wr * 64 + fr, ct = wc * 32 + 8 * fq;
        f32x4 wsc[2][2];
        if (F8) {
#pragma unroll
            for (int bj = 0; bj < 2; ++bj) { const f32x4* p = (const f32x4*)(sw + u.pn * 256 + ct + bj * 128); wsc[bj][0] = p[0]; wsc[bj][1] = p[1]; }
        }
#define AV(ai_, bj_, m_, n_) (F8 ? acc[ai_][bj_][m_][n_] * rs * wsc[bj_][n_] : acc[ai_][bj_][m_][n_])
        if (vt < 6) {
            bf16_t* dst = vt < 4 ? cq : ckv; const int ld = vt < 4 ? 1024 : 512, cb = (vt < 4 ? vt : vt - 4) * 256 + ct; u64* ssq = vt < 4 ? ssq_cq : ssq_ckv;
#pragma unroll
            for (int ai = 0; ai < 2; ++ai)
#pragma unroll
                for (int m = 0; m < 4; ++m) { const int row = rowb + ai * 128 + m * 16; const float rs = F8 ? sx[row] : 1.f; (void)rs; float s = 0.f;
#pragma unroll
                    for (int bj = 0; bj < 2; ++bj) { const f32x4 v0 = AV(ai, bj, m, 0), v1 = AV(ai, bj, m, 1);
                        s += (v0[0] * v0[0] + v0[1] * v0[1]) + (v0[2] * v0[2] + v0[3] * v0[3]) + (v1[0] * v1[0] + v1[1] * v1[1]) + (v1[2] * v1[2] + v1[3] * v1[3]);
                        *(u32x4*)(dst + (size_t)row * ld + cb + bj * 128) = pack8(v0, v1); }
                    s += __shfl_xor(s, 16); s += __shfl_xor(s, 32);
                    if (fq == 0 && ssq) ssq_add(ssq + row, s); }
        } else if (vt < 16) {
            const bool isq = vt < 14; bf16_t* dst = isq ? qb : kb; const int ld = isq ? 2048 : 512, cb = (isq ? vt - 6 : vt - 14) * 256 + ct; const float sc = isq ? QB_SCALE : 1.f;
#pragma unroll
            for (int ai = 0; ai < 2; ++ai)
#pragma unroll
                for (int m = 0; m < 4; ++m) { const int row = rowb + ai * 128 + m * 16, t = row_pos(row); const float rs = F8 ? sx[row] : 1.f; (void)rs;
                    f32x4 cs0 = (f32x4){1.f, 0.f, 1.f, 0.f}, cs1 = cs0;
                    if (wc == 0) { const f32x4* p = (const f32x4*)(ropeD + ((size_t)t * 16 + 4 * fq) * 2); cs0 = p[0]; cs1 = p[1]; }
#pragma unroll
                    for (int bj = 0; bj < 2; ++bj) { f32x4 v0 = AV(ai, bj, m, 0), v1 = AV(ai, bj, m, 1);
                        if (wc == 0) { rot2(v0, cs0); rot2(v1, cs1); }
                        v0 = v0 * sc; v1 = v1 * sc;
                        *(u32x4*)(dst + (size_t)row * ld + cb + bj * 128) = pack8(v0, v1); } }
        } else if (vt < 18) {
            const int cb = (vt - 16) * 256 + ct;
#pragma unroll
            for (int ai = 0; ai < 2; ++ai)
#pragma unroll
                for (int m = 0; m < 4; ++m) { const int row = rowb + ai * 128 + m * 16; const float rs = F8 ? sx[row] : 1.f; (void)rs;
#pragma unroll
                    for (int bj = 0; bj < 2; ++bj) *(u32x4*)(vb + (size_t)row * 512 + cb + bj * 128) = pack8(AV(ai, bj, m, 0), AV(ai, bj, m, 1)); }
        } else if (vt < 22) {
            const int cb = (vt - 18) * 256 + ct; const bool rt = ((wc & 1) == 0) && (fq < 2);
#pragma unroll
            for (int ai = 0; ai < 2; ++ai)
#pragma unroll
                for (int m = 0; m < 4; ++m) { const int row = rowb + ai * 128 + m * 16, t = row_pos(row); const float rs = F8 ? sx[row] : 1.f; (void)rs;
                    f32x4 cs0 = (f32x4){1.f, 0.f, 1.f, 0.f}, cs1 = cs0;
                    if (rt) { const f32x4* p = (const f32x4*)(ropeI + ((size_t)t * 8 + 4 * fq) * 2); cs0 = p[0]; cs1 = p[1]; }
#pragma unroll
                    for (int bj = 0; bj < 2; ++bj) { f32x4 v0 = AV(ai, bj, m, 0), v1 = AV(ai, bj, m, 1);
                        if (rt) { rot2(v0, cs0); rot2(v1, cs1); }
                        *(u32x4*)(qix + (size_t)row * 1024 + cb + bj * 128) = pack8(v0, v1); } }
        } else if (vt == 22) {
#pragma unroll
            for (int ai = 0; ai < 2; ++ai)
#pragma unroll
                for (int m = 0; m < 4; ++m) { const int row = rowb + ai * 128 + m * 16, t = row_pos(row); const float rs = F8 ? sx[row] : 1.f; (void)rs;
                    f32x4 v0 = AV(ai, 0, m, 0), v1 = AV(ai, 0, m, 1);
                    if (wc < 2) { const f32x4* p = (const f32x4*)(ropeM + ((size_t)t * 32 + 16 * wc + 4 * fq) * 2); rot2(v0, p[0]); rot2(v1, p[1]);
                        *(u32x4*)(kpe + (size_t)row * 64 + ct) = pack8(v0, v1);
                    } else { if (wc == 2 && fq < 2) { const f32x4* p = (const f32x4*)(ropeI + ((size_t)t * 8 + 4 * fq) * 2); rot2(v0, p[0]); rot2(v1, p[1]); }
                        *(u32x4*)(kix + (size_t)row * 64 + (ct - 64)) = pack8(v0, v1); }
                    if (wc == 0 && fq < 2) { float* w = wix + (size_t)row * 16 + 8 * fq; *(f32x4*)w = AV(ai, 1, m, 0); *(f32x4*)(w + 4) = AV(ai, 1, m, 1); } }
        } else {
            const bool isa = vt < 39; bf16_t* dst = isa ? ga : gb; const int cb = (isa ? vt - 23 : vt - 39) * 256 + ct;
#pragma unroll
            for (int ai = 0; ai < 2; ++ai)
#pragma unroll
                for (int m = 0; m < 4; ++m) { const int row = rowb + ai * 128 + m * 16; const float rs = F8 ? sx[row] : 1.f; (void)rs;
#pragma unroll
                    for (int bj = 0; bj < 2; ++bj) { f32x4 v0 = AV(ai, bj, m, 0), v1 = AV(ai, bj, m, 1);
#pragma unroll
                        for (int e = 0; e < 4; ++e) { v0[e] = sigm(v0[e]); v1[e] = sigm(v1[e]); }
                        *(u32x4*)(dst + (size_t)row * 4096 + cb + bj * 128) = pack8(v0, v1); } }
        }
#undef AV
    }
};

struct EpiUp {
    static constexpr bool PERM = true, AFTER_DRAIN = false, SPLITK2 = false, FP8 = false;
    bf16_t *d0, *d1; int nt0, ld0, ld1; const u64* ssq; float invK, scale; const float* rope;
    __device__ __forceinline__ void operator()(const Acc& acc, const Unit& u, int wr, int wc, int fr, int fq) const {
        const int vt = u.pn, rowb = u.pm * 256 + wr * 64 + fr, ct = wc * 32 + 8 * fq; const bool first = vt < nt0;
        bf16_t* dst = first ? d0 : d1; const int ld = first ? ld0 : ld1, cb = (first ? vt : vt - nt0) * 256 + ct; const bool rt = (!first) && (rope != nullptr);
#pragma unroll
        for (int ai = 0; ai < 2; ++ai)
#pragma unroll
            for (int m = 0; m < 4; ++m) { const int row = rowb + ai * 128 + m * 16, t = row_pos(row);
                const float rs = __builtin_amdgcn_rsqf(ssq_get(ssq + row) * invK + EPS) * scale;
                f32x4 cs0 = (f32x4){1.f, 0.f, 1.f, 0.f}, cs1 = cs0;
                if (rt) { const f32x4* p = (const f32x4*)(rope + ((size_t)t * 32 + 16 * (wc & 1) + 4 * fq) * 2); cs0 = p[0]; cs1 = p[1]; }
#pragma unroll
                for (int bj = 0; bj < 2; ++bj) { f32x4 v0 = acc[ai][bj][m][0] * rs, v1 = acc[ai][bj][m][1] * rs;
                    if (rt) { rot2(v0, cs0); rot2(v1, cs1); }
                    *(u32x4*)(dst + (size_t)row * ld + cb + bj * 128) = pack8(v0, v1); } }
    }
};

struct EpiBranch {
    static constexpr bool PERM = true, AFTER_DRAIN = false, SPLITK2 = true, FP8 = true;
    const bf16_t *ga, *gb; bf16_t* out; const float *srow, *scol;
    __device__ __forceinline__ void operator()(Acc& acc, const Unit& u, int wr, int wc, int fr, int fq) const {
        const int rowb = u.pm * 256 + wr * 64 + fr, cb = u.pn * 256 + wc * 32 + 8 * fq;
        if (u.kh == 0) {
#pragma unroll
            for (int ai = 0; ai < 2; ++ai)
#pragma unroll
                for (int m = 0; m < 4; ++m) { const size_t ro = (size_t)(rowb + ai * 128 + m * 16) * 4096 + cb;
#pragma unroll
                    for (int bj = 0; bj < 2; ++bj) { const u32x4 a = *(const u32x4*)(ga + ro + bj * 128), b = *(const u32x4*)(gb + ro + bj * 128);
                        f32x4 r0, r1;
#define RQ(x, y) ((x) * __builtin_amdgcn_rcpf(y))
                        r0[0] = RQ(bf_lo(a.x), bf_lo(b.x)); r0[1] = RQ(bf_hi(a.x), bf_hi(b.x)); r0[2] = RQ(bf_lo(a.y), bf_lo(b.y)); r0[3] = RQ(bf_hi(a.y), bf_hi(b.y));
                        r1[0] = RQ(bf_lo(a.z), bf_lo(b.z)); r1[1] = RQ(bf_hi(a.z), bf_hi(b.z)); r1[2] = RQ(bf_lo(a.w), bf_lo(b.w)); r1[3] = RQ(bf_hi(a.w), bf_hi(b.w));
#undef RQ
                        acc[ai][bj][m][0] = acc[ai][bj][m][0] * r0; acc[ai][bj][m][1] = acc[ai][bj][m][1] * r1; }
                    asm volatile("" ::: "memory"); }
        } else {
            f32x4 w0[2], w1[2];
#pragma unroll
            for (int bj = 0; bj < 2; ++bj) { const f32x4* p = (const f32x4*)(scol + cb + bj * 128); w0[bj] = p[0]; w1[bj] = p[1]; }
#pragma unroll
            for (int ai = 0; ai < 2; ++ai)
#pragma unroll
                for (int m = 0; m < 4; ++m) { const int row = rowb + ai * 128 + m * 16; const size_t ro = (size_t)row * 4096 + cb; const float rs = srow[row];
#pragma unroll
                    for (int bj = 0; bj < 2; ++bj) { const u32x4 b = *(const u32x4*)(gb + ro + bj * 128);
                        const f32x4 s0 = (f32x4){bf_lo(b.x), bf_hi(b.x), bf_lo(b.y), bf_hi(b.y)} * rs * w0[bj], s1 = (f32x4){bf_lo(b.z), bf_hi(b.z), bf_lo(b.w), bf_hi(b.w)} * rs * w1[bj];
                        *(u32x4*)(out + ro + bj * 128) = pack8(acc[ai][bj][m][0] * s0, acc[ai][bj][m][1] * s1); } }
        }
    }
};

struct EpiOut {
    static constexpr bool PERM = true, AFTER_DRAIN = false, SPLITK2 = false, FP8 = true;
    const float *x, *meta; float* h1f; bf16_t* h1b; u64* ssq; const float *srow, *scol;
    __device__ __forceinline__ void operator()(const Acc& acc, const Unit& u, int wr, int wc, int fr, int fq) const {
        const int rowb = u.pm * 256 + wr * 64 + fr, cb = u.pn * 256 + wc * 32 + 8 * fq;
#pragma unroll
        for (int ai = 0; ai < 2; ++ai)
#pragma unroll
            for (int m = 0; m < 4; ++m) { const int row = rowb + ai * 128 + m * 16;
                const float* src = x + (size_t)row * DM;
                float s = 0.f; const float rs = srow[row];
#pragma unroll
                for (int bj = 0; bj < 2; ++bj) { const f32x4* wp = (const f32x4*)(scol + cb + bj * 128); f32x4 v0 = acc[ai][bj][m][0] * rs * wp[0], v1 = acc[ai][bj][m][1] * rs * wp[1];
                    v0 = v0 + *(const f32x4*)(src + cb + bj * 128); v1 = v1 + *(const f32x4*)(src + cb + bj * 128 + 4);
                    s += (v0[0] * v0[0] + v0[1] * v0[1]) + (v0[2] * v0[2] + v0[3] * v0[3]) + (v1[0] * v1[0] + v1[1] * v1[1]) + (v1[2] * v1[2] + v1[3] * v1[3]);
                    float* o = h1f + (size_t)row * DM + cb + bj * 128; *(f32x4*)o = v0; *(f32x4*)(o + 4) = v1;
                    *(u32x4*)(h1b + (size_t)row * DM + cb + bj * 128) = pack8(v0, v1); }
                s += __shfl_xor(s, 16); s += __shfl_xor(s, 32);
                if (fq == 0 && ssq) ssq_add(ssq + row, s); }
    }
};

struct EpiPQ {
    static constexpr bool PERM = true, AFTER_DRAIN = false, SPLITK2 = false, FP8 = false;
    bf16_t* pq; const u64* ssq;
    __device__ __forceinline__ void operator()(const Acc& acc, const Unit& u, int wr, int wc, int fr, int fq) const {
        const int rowb = u.pm * 256 + wr * 64 + fr, cb = u.pn * 256 + wc * 32 + 8 * fq;
#pragma unroll
        for (int ai = 0; ai < 2; ++ai)
#pragma unroll
            for (int m = 0; m < 4; ++m) { const int row = rowb + ai * 128 + m * 16; const float rs = __builtin_amdgcn_rsqf(ssq_get(ssq + row) * (1.0f / DM) + EPS);
#pragma unroll
                for (int bj = 0; bj < 2; ++bj) *(u32x4*)(pq + (size_t)row * 2048 + cb + bj * 128) = pack8(acc[ai][bj][m][0] * rs, acc[ai][bj][m][1] * rs); }
    }
};
}
#define XB_TMO      128
#define XB_XCNT(j)  (256  + 64 * (j))
#define XB_XSUB(j)  (1280 + 64 * (j))
#define XB_XGEN(j)  (2304 + 64 * (j))
#define XB_TOP      3328
#define XB_TOPGEN   3392
#define XCD_BAR_WORDS 3456
#define XB_SPIN_CAP (1u << 18)
__device__ __forceinline__ unsigned xb_ld(unsigned* p)              { return __hip_atomic_load(p, __ATOMIC_RELAXED, __HIP_MEMORY_SCOPE_AGENT); }
__device__ __forceinline__ unsigned xb_add(unsigned* p, unsigned v) { return __hip_atomic_fetch_add(p, v, __ATOMIC_RELAXED, __HIP_MEMORY_SCOPE_AGENT); }
__device__ __forceinline__ unsigned xb_xcc_id() { return (unsigned)__builtin_amdgcn_s_getreg((3 << 11) | 20) & 0xFu; }
#define XB_SPIN(cond, bar) do { unsigned _sp = 0; while (cond) { __builtin_amdgcn_s_sleep(1); \
    if ((++_sp & 255u) == 0u) { if (xb_ld(&(bar)[XB_TMO])) break; if (_sp > XB_SPIN_CAP) { atomicAdd(&(bar)[XB_TMO], 1u); break; } } } } while (0)
struct XcdBarrier { unsigned* bar; unsigned x; volatile LAS unsigned* st; };
__device__ __forceinline__ XcdBarrier xcd_barrier_post(unsigned* bar, volatile LAS unsigned* st) {
    XcdBarrier b; b.bar = bar; b.x = xb_xcc_id(); b.st = st;
    if (threadIdx.x == 0) (void)xb_add(&bar[XB_XCNT(b.x)], 1u);
    return b;
}
__device__ __forceinline__ void xcd_barrier_complete(unsigned* bar, unsigned x, unsigned& nloc, unsigned& nx) {
    const unsigned G = gridDim.x * gridDim.y * gridDim.z;
    unsigned sum, cnt, mine, sp = 0u;
    for (;;) {
        sum = 0u; cnt = 0u; mine = 0u;
#pragma unroll
        for (unsigned j = 0; j < 16; ++j) { const unsigned c = xb_ld(&bar[XB_XCNT(j)]); sum += c; cnt += (c > 0u) ? 1u : 0u; mine = (j == x) ? c : mine; }
        if (sum == G) break;
        __builtin_amdgcn_s_sleep(1);
        if ((++sp & 255u) == 0u) { if (xb_ld(&bar[XB_TMO])) break; if (sp > XB_SPIN_CAP) { atomicAdd(&bar[XB_TMO], 1u); break; } }
    }
    nloc = mine > 0u ? mine : 1u; nx = cnt > 0u ? cnt : 1u;
}
__device__ __forceinline__ void xcd_barrier(const XcdBarrier& b) {
    asm volatile("s_waitcnt vmcnt(0)" ::: "memory");
    __syncthreads();
    if (threadIdx.x == 0) {
        unsigned* bar = b.bar;
        __builtin_amdgcn_s_waitcnt(0);
        unsigned nloc = b.st[0], nx = b.st[1];
        if (nloc == 0u) { xcd_barrier_complete(bar, b.x, nloc, nx); b.st[0] = nloc; b.st[1] = nx; }
        const unsigned old = xb_add(&bar[XB_XSUB(b.x)], 1u);
        const unsigned gen = old / nloc;
        if (old + 1u == (gen + 1u) * nloc) {
            __builtin_amdgcn_fence(__ATOMIC_RELEASE, "agent");
            asm volatile("s_waitcnt vmcnt(0)" ::: "memory");
            const unsigned og = xb_add(&bar[XB_TOP], 1u);
            const unsigned tg = og / nx;
            if (og + 1u == (tg + 1u) * nx) xb_add(&bar[XB_TOPGEN], 1u);
            else XB_SPIN(xb_ld(&bar[XB_TOPGEN]) == tg, bar);
            __builtin_amdgcn_fence(__ATOMIC_ACQUIRE, "agent");
            xb_add(&bar[XB_XGEN(b.x)], 1u);
            asm volatile("s_waitcnt vmcnt(0)" ::: "memory");
        } else {
            XB_SPIN(xb_ld(&bar[XB_XGEN(b.x)]) == gen, bar);
            __builtin_amdgcn_fence(__ATOMIC_ACQUIRE, "agent");
            asm volatile("s_waitcnt vmcnt(0)" ::: "memory");
        }
    }
    __syncthreads();
}

struct Frame {
    LAS unsigned char* lds;
    unsigned char* ws;
    unsigned* ctl;
    int tid, lane, wave, vcu, G;
    __device__ __forceinline__ const float* in(int i) const { return ((const float* const __attribute__((address_space(4)))*)__builtin_amdgcn_kernarg_segment_ptr())[i]; }
    __device__ __forceinline__ float* out() const { return ((float* const __attribute__((address_space(4)))*)__builtin_amdgcn_kernarg_segment_ptr())[16]; }
};

struct MapId { __device__ __forceinline__ int operator()(int v) const { return v; } };
struct MapIn { __device__ __forceinline__ int operator()(int vn) const {
    const int v = vn < 1280 ? vn + 4608 : (vn < 5888 ? vn - 1280 : vn);
    if (v < 1536) return v;
    if (v < 3584) { const int w = v - 1536, hd = w >> 7; int o = w & 127; if (o < 32) o = (o & 1) ? (o >> 1) + 16 : (o >> 1); return 1600 + hd * 128 + o; }
    if (v < 4096) { const int w = v - 3584, hd = w >> 7; int o = w & 127; if (o < 32) o = (o & 1) ? (o >> 1) + 16 : (o >> 1); return 3648 + hd * 128 + o; }
    if (v < 4608) return 4160 + (v - 4096);
    if (v < 5632) { const int w = v - 4608, hd = w >> 6; int o = w & 63; if (o < 16) o = (o & 1) ? (o >> 1) + 8 : (o >> 1); return 4672 + hd * 64 + o; }
    if (v < 5888) { const int w = v - 5632;
        if (w < 64) return 1536 + ((w & 1) ? (w >> 1) + 32 : (w >> 1));
        if (w < 128) { int o = w - 64; if (o < 16) o = (o & 1) ? (o >> 1) + 8 : (o >> 1); return 5696 + o; }
        if (w < 144) return 5760 + (w - 128);
        return -1; }
    if (v < 9984) return 5776 + (v - 5888);
    return 9872 + (v - 9984);
} };
struct MapUq { __device__ __forceinline__ int operator()(int v) const {
    if (v < 2048) return (v >> 7) * 192 + (v & 127);
    const int w = v - 2048, hd = w >> 6, o = w & 63; return hd * 192 + 128 + ((o & 1) ? (o >> 1) + 32 : (o >> 1)); } };
struct MapUkv { __device__ __forceinline__ int operator()(int v) const {
    if (v < 2048) return (v >> 7) * 256 + (v & 127);
    const int w = v - 2048; return (w >> 7) * 256 + 128 + (w & 127); } };

template <class Map>
__device__ __forceinline__ void p0_transpose_item(const float* W, int K, int Nsrc, int Nvirt, bf16_t* WT, const float* gk, LAS float* scr, int item, int lane, Map map) {
    const int nblk = Nvirt / 32, kb = item / nblk, nb = item % nblk, k0 = 64 * kb, n0 = 32 * nb;
    const int sc = map(n0 + (lane & 31));
#pragma unroll 8
    for (int i = 0; i < 32; ++i) { const int kk = 2 * i + (lane >> 5); float v = 0.f;
        if (sc >= 0) v = W[(size_t)(k0 + kk) * Nsrc + sc];
        if (gk) v *= gk[k0 + kk];
        scr[kk * 33 + (lane & 31)] = v; }
    LDS_WAIT(); asm volatile("" ::: "memory");
    const int c = lane & 7;
#pragma unroll
    for (int j = 0; j < 4; ++j) { const int n = (lane >> 3) + 8 * j; const LAS float* s = scr + (8 * c) * 33 + n;
        u32x4 o; o.x = pk2(s[0 * 33], s[1 * 33]); o.y = pk2(s[2 * 33], s[3 * 33]); o.z = pk2(s[4 * 33], s[5 * 33]); o.w = pk2(s[6 * 33], s[7 * 33]);
        *(u32x4*)(WT + (size_t)(n0 + n) * K + k0 + 8 * c) = o; }
    LDS_WAIT(); asm volatile("" ::: "memory");
}
__device__ __forceinline__ float wave_max(float v) {
#pragma unroll
    for (int o = 1; o < 64; o <<= 1) v = fmaxf(v, __shfl_xor(v, o));
    return v;
}
__device__ __forceinline__ void p0_xn_row(const Frame& F, int m) {
    const float* x = F.in(0); const float* meta = F.in(1); const float* g = F.in(2);
    bf16_t* o = (bf16_t*)(F.ws + WS_XN) + (size_t)m * DM;
    u32x2* o8 = (u32x2*)o + F.lane;
    if (m >= NTOK + NMETA) {
        unsigned* z8 = (unsigned*)(F.ws + WS_XN8 + (size_t)m * DM) + F.lane;
#pragma unroll
        for (int j = 0; j < 16; ++j) { o8[64 * j] = (u32x2){0u, 0u}; z8[64 * j] = 0u; }
        if (F.lane == 0) ((float*)(F.ws + WS_SX))[m] = 0.f;
        return; }
    const float* src = m < NTOK ? x + (size_t)m * DM : meta + (size_t)(m - NTOK) * DM;
    const f32x4* xr = (const f32x4*)src + F.lane; const f32x4* gr = (const f32x4*)g + F.lane;
    f32x4 v[16]; float s = 0.f;
#pragma unroll
    for (int j = 0; j < 16; ++j) { v[j] = xr[64 * j]; s += (v[j][0] * v[j][0] + v[j][1] * v[j][1]) + (v[j][2] * v[j][2] + v[j][3] * v[j][3]); }
    const float rstd = 1.0f / sqrtf(wave_sum(s) * (1.0f / DM) + EPS);
    float mx = 0.f;
#pragma unroll
    for (int j = 0; j < 16; ++j) { const f32x4 gg = gr[64 * j]; v[j] = v[j] * rstd * gg; o8[64 * j] = (u32x2){pk2(v[j][0], v[j][1]), pk2(v[j][2], v[j][3])};
        mx = fmaxf(mx, fmaxf(fmaxf(fabsf(v[j][0]), fabsf(v[j][1])), fmaxf(fabsf(v[j][2]), fabsf(v[j][3])))); }
    mx = fmaxf(wave_max(mx), 1e-30f);
    const float inv = 448.0f / mx;
    if (F.lane == 0) ((float*)(F.ws + WS_SX))[m] = mx * (1.0f / 448.0f);
    unsigned* q8 = (unsigned*)(F.ws + WS_XN8 + (size_t)m * DM) + F.lane;
#pragma unroll
    for (int j = 0; j < 16; ++j) { f32x4 q = v[j] * inv;
#pragma unroll
        for (int e = 0; e < 4; ++e) q[e] = fminf(fmaxf(q[e], -448.0f), 448.0f);
        int p = 0; p = __builtin_amdgcn_cvt_pk_fp8_f32(q[0], q[1], p, false); p = __builtin_amdgcn_cvt_pk_fp8_f32(q[2], q[3], p, true); q8[64 * j] = (unsigned)p; }
}
__device__ __forceinline__ void p0_prologue(const Frame& F) {
    LAS float* scr = (LAS float*)(F.lds + F.wave * 16384);
    const int gw = F.vcu * NWAVES + F.wave, NGW = F.G * NWAVES;
    const float* w_in = F.in(3); const float* qg = F.in(4); const float* w_uq = F.in(5); const float* kvg = F.in(6); const float* w_ukv = F.in(7);
    const float* w_br = F.in(8); const float* w_out = F.in(9); const float* fg = F.in(10); const float* w_q = F.in(11); const float* sk = F.in(12);
    constexpr int I_IN = 64 * (NV1 / 32), I_UQ = 16 * (3072 / 32), I_UKV = 8 * (4096 / 32), I_BR = 64 * 128, I_OUT = 64 * 128, I_Q = 64 * 64;
    constexpr int NITEMS = I_IN + I_UQ + I_UKV + I_BR + I_OUT + I_Q;
    for (int it = gw; it < NITEMS; it += NGW) {
        int r = it;
        if (r < I_IN) { p0_transpose_item(w_in, 4096, 13968, NV1, (bf16_t*)(F.ws + WS_WIN), nullptr, scr, r, F.lane, MapIn()); continue; } r -= I_IN;
        if (r < I_UQ) { p0_transpose_item(w_uq, 1024, 3072, 3072, (bf16_t*)(F.ws + WS_WUQ), qg, scr, r, F.lane, MapUq()); continue; } r -= I_UQ;
        if (r < I_UKV) { p0_transpose_item(w_ukv, 512, 4096, 4096, (bf16_t*)(F.ws + WS_WUKV), kvg, scr, r, F.lane, MapUkv()); continue; } r -= I_UKV;
        if (r < I_BR) { p0_transpose_item(w_br, 4096, 4096, 4096, (bf16_t*)(F.ws + WS_WBR), nullptr, scr, r, F.lane, MapId()); continue; } r -= I_BR;
        if (r < I_OUT) { p0_transpose_item(w_out, 4096, 4096, 4096, (bf16_t*)(F.ws + WS_WOUT), nullptr, scr, r, F.lane, MapId()); continue; } r -= I_OUT;
        p0_transpose_item(w_q, 4096, 2048, 2048, (bf16_t*)(F.ws + WS_WQ), fg, scr, r, F.lane, MapId());
    }
    for (int m = gw; m < MK; m += NGW) p0_xn_row(F, m);
    const int gt = (F.vcu * NWAVES + F.wave) * 64 + F.lane, NGT = NGW * 64;
    for (int i = gt; i < TP * 56; i += NGT) {
        const int t = i / 56, r = i % 56; int j, rot; float* dst;
        if (r < 32) { j = r; rot = 64; dst = (float*)(F.ws + WS_ROPE_M) + ((size_t)t * 32 + j) * 2; }
        else if (r < 48) { j = r - 32; rot = 32; dst = (float*)(F.ws + WS_ROPE_D) + ((size_t)t * 16 + j) * 2; }
        else { j = r - 48; rot = 16; dst = (float*)(F.ws + WS_ROPE_I) + ((size_t)t * 8 + j) * 2; }
        const float ex = (float)(2 * j) / (float)rot;
        const float inv = powf(500000.0f, -ex);
        const float ang = (float)t * inv;
        const double a = (double)ang, kq = rint(a * 0.15915494309189535), rr = fma(-kq, 6.283185307179586, a);
        const float rf = (float)rr;
        dst[0] = cosf(rf); dst[1] = sinf(rf);
    }
    for (int i = gt; i < 16 * 128 * 128 / 8; i += NGT) { const f32x4* s = (const f32x4*)sk + 2 * (size_t)i; const f32x4 a = s[0], b2 = s[1];
        u32x4 o; o.x = pk2(a[0], a[1]); o.y = pk2(a[2], a[3]); o.z = pk2(b2[0], b2[1]); o.w = pk2(b2[2], b2[3]); ((u32x4*)(F.ws + WS_SK))[i] = o; }
}
__device__ __forceinline__ unsigned fp6_code(float q) {
    const unsigned b = __float_as_uint(q), sgn = (b >> 31) << 5; const float aq = fabsf(q);
    const unsigned sub = (unsigned)rintf(aq * 8.0f);
    unsigned ab = b & 0x7fffffffu; ab = ab + 0x7FFFFu + ((ab >> 20) & 1u);
    const unsigned nrm = (ab >> 20) - (126u << 3);
    unsigned code = aq < 1.0f ? sub : nrm; code = code > 31u ? 31u : code;
    return code | sgn;
}
__device__ __forceinline__ void fp6_pack32(const unsigned (&c)[32], unsigned (&w)[6]) {
#pragma unroll
    for (int i = 0; i < 6; ++i) w[i] = 0u;
#pragma unroll
    for (int k = 0; k < 32; ++k) { const int bit = 6 * k, d = bit >> 5, sh = bit & 31; w[d] |= c[k] << sh; if (sh > 26) w[d + 1] |= c[k] >> (32 - sh); }
}
__device__ __forceinline__ void p6_quant_row(const float* src, const float* gain, unsigned char* dst, float* scale_out, int lane) {
    const f32x4* s = (const f32x4*)src + lane; f32x4 v[16]; float mx = 0.f;
#pragma unroll
    for (int j = 0; j < 16; ++j) { v[j] = s[64 * j]; if (gain) v[j] = v[j] * ((const f32x4*)gain)[lane + 64 * j];
        mx = fmaxf(mx, fmaxf(fmaxf(fabsf(v[j][0]), fabsf(v[j][1])), fmaxf(fabsf(v[j][2]), fabsf(v[j][3])))); }
    mx = fmaxf(wave_max(mx), 1e-30f);
    const float sc = mx * (1.0f / 7.5f), inv = 7.5f / mx;
    if (lane == 0) *scale_out = sc;
    unsigned w[12];
#pragma unroll
    for (int g = 0; g < 2; ++g) { unsigned c[32];
#pragma unroll
        for (int j = 0; j < 8; ++j)
#pragma unroll
            for (int i = 0; i < 4; ++i) c[4 * j + i] = fp6_code(v[8 * g + j][i] * inv);
        unsigned ww[6]; fp6_pack32(c, ww);
#pragma unroll
        for (int i = 0; i < 6; ++i) w[6 * g + i] = ww[i]; }
#pragma unroll
    for (int q = 0; q < 3; ++q) *(u32x4*)(dst + 1024 * q + 16 * lane) = (u32x4){w[4 * q], w[4 * q + 1], w[4 * q + 2], w[4 * q + 3]};
}
__device__ __forceinline__ void p6_tables(const Frame& F) {
    const float* fg = F.in(10); const float* pu = F.in(13); const float* pv = F.in(14);
    const int gw = F.vcu * NWAVES + F.wave, NGW = F.G * NWAVES;
    for (int it = gw; it < 2 * 16384; it += NGW) { const int e = it >> 1;
        if (it & 1) p6_quant_row(pv + (size_t)e * DM, nullptr, F.ws + WS_V + (size_t)e * 3072, (float*)(F.ws + WS_SCV) + e, F.lane);
        else p6_quant_row(pu + (size_t)e * DM, fg, F.ws + WS_U + (size_t)e * 3072, (float*)(F.ws + WS_SCU) + e, F.lane); }
}

__device__ __forceinline__ void rowquant_fp8(const Frame& F, const unsigned char* src, size_t src_pitch, unsigned char* dst, size_t dst_pitch, float* scale, int nrows) {
    const int gw = F.vcu * NWAVES + F.wave, NGW = F.G * NWAVES, lane = F.lane;
    for (int n = gw; n < nrows; n += NGW) {
        const u32x4* s = (const u32x4*)(src + (size_t)n * src_pitch) + lane;
        u32x4 v[8]; float mx = 0.f;
#pragma unroll
        for (int j = 0; j < 8; ++j) { v[j] = s[64 * j];
#pragma unroll
            for (int e = 0; e < 4; ++e) mx = fmaxf(mx, fmaxf(fabsf(bf_lo(v[j][e])), fabsf(bf_hi(v[j][e])))); }
        mx = fmaxf(wave_max(mx), 1e-30f);
        const float inv = 448.0f / mx;
        if (lane == 0) scale[n] = mx * (1.0f / 448.0f);
        asm volatile("" ::: "memory");
        u32x2* d = (u32x2*)(dst + (size_t)n * dst_pitch) + lane;
#pragma unroll
        for (int j = 0; j < 8; ++j) { int p0 = 0, p1 = 0;
            p0 = __builtin_amdgcn_cvt_pk_fp8_f32(bf_lo(v[j].x) * inv, bf_hi(v[j].x) * inv, p0, false); p0 = __builtin_amdgcn_cvt_pk_fp8_f32(bf_lo(v[j].y) * inv, bf_hi(v[j].y) * inv, p0, true);
            p1 = __builtin_amdgcn_cvt_pk_fp8_f32(bf_lo(v[j].z) * inv, bf_hi(v[j].z) * inv, p1, false); p1 = __builtin_amdgcn_cvt_pk_fp8_f32(bf_lo(v[j].w) * inv, bf_hi(v[j].w) * inv, p1, true);
            d[64 * j] = (u32x2){(unsigned)p0, (unsigned)p1}; }
    }
}
__device__ __forceinline__ void p1_quant_weights(const Frame& F) {
    rowquant_fp8(F, F.ws + WS_WIN + (size_t)1280 * DM * 2, (size_t)DM * 2, F.ws + WS_WG8, (size_t)DM, (float*)(F.ws + WS_SW), 12800);
    rowquant_fp8(F, F.ws + WS_WBR, (size_t)DM * 2, F.ws + WS_WBR, (size_t)DM * 2, (float*)(F.ws + WS_SWBR), 4096);
    rowquant_fp8(F, F.ws + WS_WOUT, (size_t)DM * 2, F.ws + WS_WOUT, (size_t)DM * 2, (float*)(F.ws + WS_SWOUT), 4096);
}
#define MFMA32(a, b, c) __builtin_amdgcn_mfma_f32_32x32x16_bf16((a), (b), (c), 0, 0, 0)
__device__ __forceinline__ int crow(int i, int h) { return (i & 3) + 8 * (i >> 2) + 4 * h; }
__device__ __forceinline__ float half_sum_f(float v) {
#pragma unroll
    for (int o = 1; o < 32; o <<= 1) v += __shfl_xor(v, o);
    return v;
}
__device__ __forceinline__ int half_sum_i(int v) {
#pragma unroll
    for (int o = 1; o < 32; o <<= 1) v += __shfl_xor(v, o);
    return v;
}
__device__ __forceinline__ float half_max_f(float v) {
#pragma unroll
    for (int o = 1; o < 32; o <<= 1) v = fmaxf(v, __shfl_xor(v, o));
    return v;
}
__device__ __forceinline__ float half_min_f(float v) {
#pragma unroll
    for (int o = 1; o < 32; o <<= 1) v = fminf(v, __shfl_xor(v, o));
    return v;
}
__device__ __forceinline__ void idx_task(const Frame& F, int b, int s0) {
    const int lane = F.lane, r = lane & 31, h = lane >> 5;
    const bf16_t* qix = (const bf16_t*)(F.ws + WS_QIX); const bf16_t* kix = (const bf16_t*)(F.ws + WS_KIX); const float* wix = (const float*)(F.ws + WS_WIX);
    unsigned* mask = (unsigned*)(F.ws + WS_MASK);
    const int tok = (r >> 2) & 1, head = (r & 3) + 4 * (r >> 3);
    const bf16_t* qp = qix + (size_t)(b * SEQ + s0 + tok) * 1024 + head * 64 + 8 * h;
    bf16x8 af[4];
#pragma unroll
    for (int ks = 0; ks < 4; ++ks) af[ks] = *(const bf16x8*)(qp + 16 * ks);
    const f32x4* wp = (const f32x4*)(wix + (size_t)(b * SEQ + s0 + h) * 16);
    float w[16];
#pragma unroll
    for (int q = 0; q < 4; ++q) { const f32x4 x = wp[q]; w[4 * q] = x[0]; w[4 * q + 1] = x[1]; w[4 * q + 2] = x[2]; w[4 * q + 3] = x[3]; }
    const int tq = NMETA + s0 + h;
    const int ngrp = ((NMETA + s0 + 1) >> 6) + 1;
    int brow = b * SEQ - NMETA; asm volatile("" : "+s"(brow));
    const bf16_t* kbase = kix + ((long)brow + r) * 64 + 8 * h;
    float row[MW];
    const bf16_t* kcur = kbase;
#pragma unroll
    for (int g = 0; g < MW / 2; ++g) {
        float s0v = -INFINITY, s1v = -INFINITY;
        if (g < ngrp) {
            const bf16_t* kp0 = kcur; const bf16_t* kp1 = kcur + 32 * 64;
            if (g == 0 && r < NMETA) kp0 = kix + (size_t)(NTOK + r) * 64 + 8 * h;
            bf16x8 b0[4], b1[4];
#pragma unroll
            for (int ks = 0; ks < 4; ++ks) { b0[ks] = *(const bf16x8*)(kp0 + 16 * ks); b1[ks] = *(const bf16x8*)(kp1 + 16 * ks); }
            float x0 = 0.f, x1 = 0.f;
            { f32x16 a0;
#pragma unroll
              for (int i = 0; i < 16; ++i) a0[i] = 0.f;
#pragma unroll
              for (int ks = 0; ks < 4; ++ks) a0 = MFMA32(af[ks], b0[ks], a0);
#pragma unroll
              for (int i = 0; i < 16; ++i) x0 += w[i] * fmaxf(a0[i], 0.f); }
            { f32x16 a1;
#pragma unroll
              for (int i = 0; i < 16; ++i) a1[i] = 0.f;
#pragma unroll
              for (int ks = 0; ks < 4; ++ks) a1 = MFMA32(af[ks], b1[ks], a1);
#pragma unroll
              for (int i = 0; i < 16; ++i) x1 += w[i] * fmaxf(a1[i], 0.f); }
            s0v = (g * 64 + r <= tq) ? x0 : -INFINITY; s1v = (g * 64 + 32 + r <= tq) ? x1 : -INFINITY;
        }
        row[2 * g] = s0v; row[2 * g + 1] = s1v;
        kcur += 64 * 64; asm volatile("" : "+v"(kcur));
    }
    float tau = -3.0e38f;
    bool done = (tq + 1 <= 256);
    float mx = -INFINITY, mn = INFINITY;
#pragma unroll
    for (int k = 0; k < MW; ++k) { const float v = row[k]; mx = fmaxf(mx, v); mn = fminf(mn, v > -INFINITY ? v : INFINITY); }
    float lo = half_min_f(mn), hi = half_max_f(mx);
    if (!done) tau = hi;
    for (int it = 0; it < 64; ++it) {
        if (!__any(!done)) break;
        const float mid = lo + (hi - lo) * 0.5f;
        int c = 0;
#pragma unroll
        for (int k = 0; k < MW; ++k) c += (row[k] >= mid) ? 1 : 0;
        c = half_sum_i(c);
        if (!done) {
            if (!(mid > lo && mid < hi)) { tau = hi; done = true; }
            else if (c == 256) { tau = mid; done = true; }
            else if (c > 256) lo = mid;
            else { hi = mid; tau = hi; }
        }
    }
    unsigned* mrow = mask + (size_t)(b * SEQ + s0 + h) * MW;
    unsigned mw = 0u;
#pragma unroll
    for (int k = 0; k < MW; ++k) {
        const unsigned long long bal = __ballot(row[k] >= tau);
        const unsigned wd = h ? (unsigned)(bal >> 32) : (unsigned)bal;
        if ((k & 31) == r) mw = wd;
        if ((k & 31) == 31 || k == MW - 1) { const int kk = (k & ~31) + r; if (kk < MW) mrow[kk] = mw; }
    }
}
__device__ __forceinline__ void p2_indexer(const Frame& F, int qslot) {
    volatile LAS unsigned* qw = (volatile LAS unsigned*)(F.lds + LDSCTL_OFF + 16);
    constexpr int NCH = NTOK / 16;
    for (;;) {
        if (F.tid == 0) qw[0] = atomicAdd(F.ctl + CW_QUEUE + 64 * qslot, 1u);
        __syncthreads();
        const int c = (int)qw[0];
        __syncthreads();
        if (c >= NCH) break;
        const int b = c & 3, tblk = (SEQ / 16 - 1) - (c >> 2);
        idx_task(F, b, tblk * 16 + 2 * F.wave);
    }
}
template <bool MLA> struct AttnCfg {
    static constexpr int DQK = MLA ? 192 : 128, PK = DQK * 2 + 16, PV = 320, KCH = DQK / 8, NKC = 64 * KCH / 512, KBYTES = 64 * PK, BUFB = 64 * PK + 64 * PV;
};
struct AttnUnit { int type, b, hx, blk; };

template <bool MLA>
__device__ __forceinline__ void attn_unit(const Frame& F, const AttnUnit u) {
    typedef AttnCfg<MLA> C;
    const int tid = F.tid, lane = F.lane, wave = F.wave, r = lane & 31, h = lane >> 5;
    LAS unsigned char* lds = F.lds;
    const bf16_t* qn = (const bf16_t*)(F.ws + WS_QN); const bf16_t* qr = (const bf16_t*)(F.ws + WS_QR); const bf16_t* kn = (const bf16_t*)(F.ws + WS_KN);
    const bf16_t* va = (const bf16_t*)(F.ws + WS_VA); const bf16_t* kpe = (const bf16_t*)(F.ws + WS_KPE);
    const bf16_t* qb = (const bf16_t*)(F.ws + WS_QB); const bf16_t* kb = (const bf16_t*)(F.ws + WS_KB); const bf16_t* vb = (const bf16_t*)(F.ws + WS_VB);
    const unsigned* mask = (const unsigned*)(F.ws + WS_MASK); bf16_t* oab = (bf16_t*)(F.ws + WS_OAB);
    const int b = u.b;
    const size_t rowb = (size_t)b * SEQ;
    int head, tw0, ntiles;
    if (MLA) { head = u.hx; tw0 = u.blk * 256 + 32 * wave; ntiles = (NMETA + u.blk * 256 + 255) / 64 + 1; }
    else { head = 4 * u.hx + (wave & 3); tw0 = u.blk * 64 + 32 * (wave >> 2); ntiles = (NMETA + u.blk * 64 + 63) / 64 + 1; }
    const int pw0 = NMETA + tw0;
    const int tq = pw0 + r;
    bf16x8 qf[C::DQK / 16];
    if (MLA) {
        const bf16_t* p0 = qn + (rowb + tw0 + r) * 2048 + head * 128 + 8 * h; const bf16_t* p1 = qr + (rowb + tw0 + r) * 1024 + head * 64 + 8 * h;
#pragma unroll
        for (int ks = 0; ks < 8; ++ks) qf[ks] = *(const bf16x8*)(p0 + 16 * ks);
#pragma unroll
        for (int ks = 0; ks < 4; ++ks) qf[8 + ks] = *(const bf16x8*)(p1 + 16 * ks);
    } else {
        const bf16_t* p0 = qb + (rowb + tw0 + r) * 2048 + head * 128 + 8 * h;
#pragma unroll
        for (int ks = 0; ks < 8; ++ks) qf[ks] = *(const bf16x8*)(p0 + 16 * ks);
    }
    const int ldkv = MLA ? 2048 : 512;
    const bf16_t* ktab = MLA ? kn + head * 128 : kb + u.hx * 128;
    const bf16_t* vtab = MLA ? va + head * 128 : vb + u.hx * 128;
    const bf16_t* kbase = ktab + (rowb - NMETA) * ldkv;
    const bf16_t* vbase = vtab + (rowb - NMETA) * ldkv;
    const bf16_t* pbase = kpe + (rowb - NMETA) * 64;
    unsigned soff[2]; int kdst[2], vdst[2];
#pragma unroll
    for (int i = 0; i < 2; ++i) { const int c = tid + 512 * i, key = c >> 4, pc = c & 15; soff[i] = (unsigned)(key * ldkv + pc * 8); kdst[i] = key * C::PK + pc * 16; vdst[i] = C::KBYTES + key * C::PV + pc * 16; }
    const unsigned poff = (unsigned)((tid >> 3) * 64 + (tid & 7) * 8); const int pdst = (tid >> 3) * C::PK + 256 + (tid & 7) * 16;
    u32x4 kst[2], vst[2], pst = (u32x4){0u, 0u, 0u, 0u};
    {
        const int key0 = tid >> 4;
        const size_t o0 = key0 < NMETA ? (size_t)(NTOK + key0) * ldkv + (tid & 15) * 8 : (rowb - NMETA) * ldkv + soff[0];
        kst[0] = *(const u32x4*)(ktab + o0); vst[0] = *(const u32x4*)(vtab + o0);
        kst[1] = *(const u32x4*)(kbase + soff[1]); vst[1] = *(const u32x4*)(vbase + soff[1]);
        if (MLA) { const int keyp = tid >> 3; pst = *(const u32x4*)(keyp < NMETA ? kpe + (size_t)(NTOK + keyp) * 64 + (tid & 7) * 8 : pbase + poff); }
    }
#pragma unroll
    for (int i = 0; i < 2; ++i) { *(LAS u32x4*)(lds + kdst[i]) = kst[i]; *(LAS u32x4*)(lds + vdst[i]) = vst[i]; }
    if (MLA) *(LAS u32x4*)(lds + pdst) = pst;
    __syncthreads();
    f32x16 oacc[4];
#pragma unroll
    for (int d = 0; d < 4; ++d)
#pragma unroll
        for (int i = 0; i < 16; ++i) oacc[d][i] = 0.f;
    float mrun = -INFINITY, lrun = 0.f;
    const int koff = r * C::PK + 16 * h;
    const int voff = C::KBYTES + (4 * h + ((lane & 15) >> 2)) * C::PV + (16 * ((lane >> 4) & 1) + 4 * (lane & 3)) * 2;
    const unsigned* mrow = mask + (rowb + tw0 + r) * MW;
    for (int kt = 0; kt < ntiles; ++kt) {
        const int cur = (kt & 1) * C::BUFB, nxt = ((kt + 1) & 1) * C::BUFB;
        const bool more = kt + 1 < ntiles;
        if (more) {
            const bf16_t* kb2 = kbase + (size_t)(kt + 1) * 64 * ldkv; const bf16_t* vb2 = vbase + (size_t)(kt + 1) * 64 * ldkv;
#pragma unroll
            for (int i = 0; i < 2; ++i) { kst[i] = *(const u32x4*)(kb2 + soff[i]); vst[i] = *(const u32x4*)(vb2 + soff[i]); }
            if (MLA) pst = *(const u32x4*)(pbase + (size_t)(kt + 1) * 64 * 64 + poff);
        }
        if (kt * 64 <= pw0 + 31) {
            u32x2 mwd = (u32x2){0u, 0u};
            if (!MLA) mwd = *(const u32x2*)(mrow + 2 * kt);
            f32x16 s0, s1;
#pragma unroll
            for (int i = 0; i < 16; ++i) { s0[i] = 0.f; s1[i] = 0.f; }
#pragma unroll
            for (int ks = 0; ks < C::DQK / 16; ++ks) {
                const bf16x8 k0 = *(const LAS bf16x8*)(lds + cur + koff + 32 * ks), k1 = *(const LAS bf16x8*)(lds + cur + koff + 32 * C::PK + 32 * ks);
                s0 = MFMA32(k0, qf[ks], s0); s1 = MFMA32(k1, qf[ks], s1);
            }
            if (MLA) {
                if (kt * 64 + 63 > pw0) {
                    const int kb0 = kt * 64 + 4 * h;
#pragma unroll
                    for (int i = 0; i < 16; ++i) { const int key = kb0 + (i & 3) + 8 * (i >> 2); if (key > tq) s0[i] = -INFINITY; if (key + 32 > tq) s1[i] = -INFINITY; }
                }
            } else {
                const unsigned m0 = mwd.x >> (4 * h), m1 = mwd.y >> (4 * h);
#pragma unroll
                for (int i = 0; i < 16; ++i) { const int bit = (i & 3) + 8 * (i >> 2); if (!((m0 >> bit) & 1u)) s0[i] = -INFINITY; if (!((m1 >> bit) & 1u)) s1[i] = -INFINITY; }
            }
            float mx = s0[0];
#pragma unroll
            for (int i = 1; i < 16; ++i) mx = fmaxf(mx, s0[i]);
#pragma unroll
            for (int i = 0; i < 16; ++i) mx = fmaxf(mx, s1[i]);
            mx = fmaxf(mx, __shfl_xor(mx, 32));
            const float mnew = fmaxf(mrun, mx);
            const float msafe = (mnew == -INFINITY) ? 0.f : mnew;
            const float alpha = __builtin_amdgcn_exp2f(mrun - msafe);
            mrun = mnew;
            float ps = 0.f;
#pragma unroll
            for (int i = 0; i < 16; ++i) { s0[i] = __builtin_amdgcn_exp2f(s0[i] - msafe); s1[i] = __builtin_amdgcn_exp2f(s1[i] - msafe); ps += s0[i] + s1[i]; }
            lrun = lrun * alpha + ps;
#pragma unroll
            for (int d = 0; d < 4; ++d)
#pragma unroll
                for (int i = 0; i < 16; ++i) oacc[d][i] *= alpha;
            bf16x8 pf[4];
            { u32x4 w;
              w.x = cvt_pk_bf16(s0[0], s0[1]); w.y = cvt_pk_bf16(s0[2], s0[3]); w.z = cvt_pk_bf16(s0[4], s0[5]); w.w = cvt_pk_bf16(s0[6], s0[7]); pf[0] = __builtin_bit_cast(bf16x8, w);
              w.x = cvt_pk_bf16(s0[8], s0[9]); w.y = cvt_pk_bf16(s0[10], s0[11]); w.z = cvt_pk_bf16(s0[12], s0[13]); w.w = cvt_pk_bf16(s0[14], s0[15]); pf[1] = __builtin_bit_cast(bf16x8, w);
              w.x = cvt_pk_bf16(s1[0], s1[1]); w.y = cvt_pk_bf16(s1[2], s1[3]); w.z = cvt_pk_bf16(s1[4], s1[5]); w.w = cvt_pk_bf16(s1[6], s1[7]); pf[2] = __builtin_bit_cast(bf16x8, w);
              w.x = cvt_pk_bf16(s1[8], s1[9]); w.y = cvt_pk_bf16(s1[10], s1[11]); w.z = cvt_pk_bf16(s1[12], s1[13]); w.w = cvt_pk_bf16(s1[14], s1[15]); pf[3] = __builtin_bit_cast(bf16x8, w); }
#pragma unroll
            for (int d = 0; d < 4; ++d)
#pragma unroll
                for (int kk = 0; kk < 4; ++kk) {
                    const s16x4 lo = __builtin_amdgcn_ds_read_tr16_b64_v4i16((LAS s16x4*)(lds + cur + voff + (16 * kk) * C::PV + 64 * d));
                    const s16x4 hi = __builtin_amdgcn_ds_read_tr16_b64_v4i16((LAS s16x4*)(lds + cur + voff + (16 * kk + 8) * C::PV + 64 * d));
                    const bf16x8 vf = __builtin_shufflevector(lo, hi, 0, 1, 2, 3, 4, 5, 6, 7);
                    oacc[d] = MFMA32(vf, pf[kk], oacc[d]);
                }
        }
        if (more) {
#pragma unroll
            for (int i = 0; i < 2; ++i) { *(LAS u32x4*)(lds + nxt + kdst[i]) = kst[i]; *(LAS u32x4*)(lds + nxt + vdst[i]) = vst[i]; }
            if (MLA) *(LAS u32x4*)(lds + nxt + pdst) = pst;
        }
        __syncthreads();
    }
    {
        const float lt = lrun + __shfl_xor(lrun, 32);
        const float inv = lt > 0.f ? 1.0f / lt : 0.f;
        bf16_t* op = oab + (rowb + tw0 + r) * 4096 + (MLA ? 0 : 2048) + head * 128 + 4 * h;
#pragma unroll
        for (int d = 0; d < 4; ++d)
#pragma unroll
            for (int g = 0; g < 4; ++g) { u32x2 w; w.x = cvt_pk_bf16(oacc[d][4 * g] * inv, oacc[d][4 * g + 1] * inv); w.y = cvt_pk_bf16(oacc[d][4 * g + 2] * inv, oacc[d][4 * g + 3] * inv);
                *(u32x2*)(op + 32 * d + 8 * g) = w; }
    }
}

constexpr int ATT_NUNITS = 16 * 64 + 64 * 16;
__device__ __forceinline__ void att_decode(int idx, AttnUnit& u) {
    int rem = idx;
    for (int L = 65; L >= 2; --L) {
        const int nm = (L >= 5 && ((L - 5) & 3) == 0) ? 64 : 0;
        if (rem < nm) { u.type = 0; u.blk = (L - 5) >> 2; u.b = rem & 3; u.hx = rem >> 2; return; }
        rem -= nm;
        if (rem < 16) { u.type = 1; u.blk = L - 2; u.b = rem & 3; u.hx = rem >> 2; return; }
        rem -= 16;
    }
    u.type = -1; u.blk = 0; u.b = 0; u.hx = 0;
}
__device__ __forceinline__ void p3_attention(const Frame& F, int qslot) {
#ifdef MK_SKIP_ATT
    {
        const u32x4* qn = (const u32x4*)(F.ws + WS_QN); const u32x4* qb = (const u32x4*)(F.ws + WS_QB); u32x4* o = (u32x4*)(F.ws + WS_OAB);
        const size_t gt = (size_t)(F.vcu * NWAVES + F.wave) * 64 + F.lane, NGT = (size_t)F.G * NWAVES * 64;
        for (size_t i = gt; i < (size_t)NTOK * 256; i += NGT) { const size_t row = i >> 8, c = i & 255; o[row * 512 + c] = qn[row * 256 + c]; o[row * 512 + 256 + c] = qb[row * 256 + c]; }
        return;
    }
#endif
    volatile LAS int* qw = (volatile LAS int*)(F.lds + LDSCTL_OFF + 32);
    for (;;) {
        if (F.tid == 0) { const int idx = (int)atomicAdd(F.ctl + CW_QUEUE + 64 * qslot, 1u); AttnUnit u; u.type = -1; u.b = 0; u.hx = 0; u.blk = 0; if (idx < ATT_NUNITS) att_decode(idx, u);
            qw[0] = u.type; qw[1] = u.b; qw[2] = u.hx; qw[3] = u.blk; }
        __syncthreads();
        AttnUnit u; u.type = qw[0]; u.b = qw[1]; u.hx = qw[2]; u.blk = qw[3];
        __syncthreads();
        if (u.type < 0) break;
        if (u.type == 0) attn_unit<true>(F, u); else attn_unit<false>(F, u);
    }
}
__device__ __forceinline__ float pk_idx(float v, int n) { return __uint_as_float((__float_as_uint(v) & ~127u) | (unsigned)n); }
__device__ __forceinline__ void route_task(const Frame& F, int tb, int hd) {
    const int lane = F.lane, r = lane & 31, h = lane >> 5;
    const bf16_t* pq = (const bf16_t*)(F.ws + WS_PQ); const bf16_t* skb = (const bf16_t*)(F.ws + WS_SK);
    int* eid = (int*)(F.ws + WS_EID); float* gate = (float*)(F.ws + WS_GATE);
    LAS float* wl = (LAS float*)(F.lds + F.wave * 16384);
    const int m = tb * 32 + r;
#pragma unroll 1
    for (int c = 0; c < 2; ++c) {
        const bf16_t* qp = pq + (size_t)m * 2048 + hd * 256 + c * 128 + 8 * h;
        bf16x8 qf[8];
#pragma unroll
        for (int ks = 0; ks < 8; ++ks) qf[ks] = *(const bf16x8*)(qp + 16 * ks);
        float v[64];
#pragma unroll
        for (int blk = 0; blk < 4; ++blk) {
            const bf16_t* sp = skb + (size_t)((hd * 2 + c) * 128 + 32 * blk + r) * 128 + 8 * h;
            f32x16 acc;
#pragma unroll
            for (int i = 0; i < 16; ++i) acc[i] = 0.f;
#pragma unroll
            for (int ks = 0; ks < 8; ++ks) acc = MFMA32(*(const bf16x8*)(sp + 16 * ks), qf[ks], acc);
#pragma unroll
            for (int i = 0; i < 16; ++i) v[blk * 16 + i] = pk_idx(acc[i], 32 * blk + (i & 3) + 8 * (i >> 2) + 4 * h);
        }
#pragma unroll 1
        for (int k = 0; k < 16; ++k) {
            float mx = v[0];
#pragma unroll
            for (int j = 1; j < 64; ++j) mx = fmaxf(mx, v[j]);
            mx = fmaxf(mx, __shfl_xor(mx, 32));
            if (h == 0) wl[(c * 16 + k) * 32 + r] = mx;
#pragma unroll
            for (int j = 0; j < 64; ++j) v[j] = (v[j] == mx) ? -INFINITY : v[j];
        }
    }
    LDS_WAIT(); asm volatile("" ::: "memory");
    float cs[50]; int ce[50];
    {
        unsigned t0[16], t1[16];
#pragma unroll
        for (int i = 0; i < 16; ++i) { t0[i] = __float_as_uint(wl[i * 32 + r]); t1[i] = __float_as_uint(wl[(16 + i) * 32 + r]); }
        int n = 0;
#pragma unroll
        for (int i = 0; i < 16; ++i)
#pragma unroll
            for (int j = 0; j < 16; ++j)
                if ((i + 1) * (j + 1) <= 16) {
                    const float s = __uint_as_float(t0[i] & ~127u) + __uint_as_float(t1[j] & ~127u);
                    cs[n] = __uint_as_float((__float_as_uint(s) & ~63u) | (unsigned)n); ce[n] = (int)((t0[i] & 127u) * 128u + (t1[j] & 127u)); ++n;
                }
    }
    float sum = 0.f, first = 0.f;
#pragma unroll 1
    for (int k = 0; k < 16; ++k) {
        float mx = cs[0];
#pragma unroll
        for (int j = 1; j < 50; ++j) mx = fmaxf(mx, cs[j]);
        int se = 0;
#pragma unroll
        for (int j = 0; j < 50; ++j) { const bool hit = (cs[j] == mx); se = hit ? ce[j] : se; cs[j] = hit ? -INFINITY : cs[j]; }
        if (k == 0) first = mx;
        const float ev = __expf(mx - first); sum += ev;
        if (h == 0) { wl[1024 + k * 32 + r] = ev; wl[1536 + k * 32 + r] = __int_as_float(se); }
    }
    LDS_WAIT(); asm volatile("" ::: "memory");
    const float inv = 1.0f / sum;
    if (h == 0) {
        int* ep = eid + (size_t)m * 128 + hd * 16; float* gp = gate + (size_t)m * 128 + hd * 16;
#pragma unroll
        for (int q = 0; q < 4; ++q) {
            *(int4*)(ep + 4 * q) = make_int4(__float_as_int(wl[1536 + (4 * q) * 32 + r]), __float_as_int(wl[1536 + (4 * q + 1) * 32 + r]), __float_as_int(wl[1536 + (4 * q + 2) * 32 + r]), __float_as_int(wl[1536 + (4 * q + 3) * 32 + r]));
            *(f32x4*)(gp + 4 * q) = (f32x4){wl[1024 + (4 * q) * 32 + r] * inv, wl[1024 + (4 * q + 1) * 32 + r] * inv, wl[1024 + (4 * q + 2) * 32 + r] * inv, wl[1024 + (4 * q + 3) * 32 + r] * inv}; }
    }
    LDS_WAIT(); asm volatile("" ::: "memory");
}
__device__ __forceinline__ void p7_routing(const Frame& F) {
    const int gw = F.vcu * NWAVES + F.wave, NGW = F.G * NWAVES;
    for (int it = gw; it < (NTOK / 32) * 8; it += NGW) route_task(F, it >> 3, it & 7);
}

__device__ __forceinline__ float rl_f(float v, int l) { return __int_as_float(__builtin_amdgcn_readlane(__float_as_int(v), l)); }
__device__ __forceinline__ float gelu_tanh(float x) {
    const float u = 0.7978845608028654f * (x + 0.044715f * x * x * x);
    const float e = __expf(2.0f * u);
    const float th = 1.0f - 2.0f / (e + 1.0f);
    return 0.5f * x * (1.0f + th);
}
__device__ __forceinline__ float wave_sum_dpp(float v) {
#define DPP_ADD(ctrl, rmask) v += __int_as_float(__builtin_amdgcn_update_dpp(0, __float_as_int(v), ctrl, rmask, 0xF, false))
    DPP_ADD(0xB1, 0xF); DPP_ADD(0x4E, 0xF); DPP_ADD(0x141, 0xF); DPP_ADD(0x140, 0xF); DPP_ADD(0x142, 0xA); DPP_ADD(0x143, 0xC);
#undef DPP_ADD
    return rl_f(v, 63);
}
typedef unsigned u32x6 __attribute__((ext_vector_type(6)));
typedef float f32x32 __attribute__((ext_vector_type(32)));
struct Row6 { u32x4 q[3]; };
__device__ __forceinline__ void row6_load(Row6& r, const unsigned char* tab, int e, int lane) {
    const u32x4* p = (const u32x4*)(tab + (size_t)e * 3072) + lane;
#pragma unroll
    for (int q = 0; q < 3; ++q) r.q[q] = p[64 * q];
}
__device__ __forceinline__ f32x32 row6_deq(const Row6& r, int g) {
    u32x6 w;
    if (g == 0) { w[0] = r.q[0].x; w[1] = r.q[0].y; w[2] = r.q[0].z; w[3] = r.q[0].w; w[4] = r.q[1].x; w[5] = r.q[1].y; }
    else { w[0] = r.q[1].z; w[1] = r.q[1].w; w[2] = r.q[2].x; w[3] = r.q[2].y; w[4] = r.q[2].z; w[5] = r.q[2].w; }
    return __builtin_amdgcn_cvt_scalef32_pk32_f32_fp6(w, 1.0f);
}
__device__ __forceinline__ float row6_dot(const Row6& r, const f32x2 (&hf)[32]) {
    f32x2 acc0 = (f32x2){0.f, 0.f}, acc1 = (f32x2){0.f, 0.f};
#pragma unroll
    for (int g = 0; g < 2; ++g) { const f32x32 d = row6_deq(r, g);
#pragma unroll
        for (int k = 0; k < 16; k += 2) { acc0 = __builtin_elementwise_fma((f32x2){d[2 * k], d[2 * k + 1]}, hf[16 * g + k], acc0); acc1 = __builtin_elementwise_fma((f32x2){d[2 * k + 2], d[2 * k + 3]}, hf[16 * g + k + 1], acc1); } }
    const f32x2 s = acc0 + acc1;
    return s.x + s.y;
}
__device__ __forceinline__ void row6_axpy(const Row6& r, float c, f32x2 (&o)[32]) {
    const f32x2 c2 = (f32x2){c, c};
#pragma unroll
    for (int g = 0; g < 2; ++g) { const f32x32 d = row6_deq(r, g);
#pragma unroll
        for (int k = 0; k < 16; ++k) o[16 * g + k] = __builtin_elementwise_fma((f32x2){d[2 * k], d[2 * k + 1]}, c2, o[16 * g + k]); }
}
__device__ __forceinline__ void expert_token(const Frame& F, int m, size_t orow) {
    const int lane = F.lane;
    const unsigned char* U = F.ws + WS_U; const unsigned char* V = F.ws + WS_V;
    const float* scu = (const float*)(F.ws + WS_SCU); const float* scv = (const float*)(F.ws + WS_SCV);
    const int* eid = (const int*)(F.ws + WS_EID); const float* gate = (const float*)(F.ws + WS_GATE);
    const bf16_t* h1b = (const bf16_t*)(F.ws + WS_H1B); const float* h1f = (const float*)(F.ws + WS_H1F);
    const u64* ssq = (const u64*)(F.ctl + CW_SSQ_H1); const float* gfin = F.in(15);
    const int e0 = eid[(size_t)m * 128 + lane], e1 = eid[(size_t)m * 128 + 64 + lane];
    f32x2 hf[32];
#pragma unroll
    for (int j = 0; j < 16; ++j) { const u32x2 x = *((const u32x2*)(h1b + (size_t)m * DM) + lane + 64 * j); hf[2 * j] = (f32x2){bf_lo(x.x), bf_hi(x.x)}; hf[2 * j + 1] = (f32x2){bf_lo(x.y), bf_hi(x.y)}; }
    const float g0 = gate[(size_t)m * 128 + lane] * scv[e0], g1 = gate[(size_t)m * 128 + 64 + lane] * scv[e1];
    const float rstd = __builtin_amdgcn_rsqf(ssq_get(ssq + m) * (1.0f / DM) + EPS);
    const float su0 = scu[e0] * rstd, su1 = scu[e1] * rstd;
    float a0 = 0.f, a1 = 0.f;
#define EIDX(e) (((e) < 64) ? __builtin_amdgcn_readlane(e0, (e)) : __builtin_amdgcn_readlane(e1, (e) - 64))
    {
        Row6 r0, r1, r2, r3;
        row6_load(r0, U, EIDX(0), lane); row6_load(r1, U, EIDX(1), lane); row6_load(r2, U, EIDX(2), lane); row6_load(r3, U, EIDX(3), lane);
#pragma unroll 1
        for (int e = 0; e < 128; e += 4) {
            const bool more = e + 4 < 128; float p;
            p = wave_sum_dpp(row6_dot(r0, hf)); if (more) row6_load(r0, U, EIDX(e + 4), lane); if (e < 64) { if (lane == e) a0 = p; } else { if (lane == e - 64) a1 = p; }
            p = wave_sum_dpp(row6_dot(r1, hf)); if (more) row6_load(r1, U, EIDX(e + 5), lane); if (e < 64) { if (lane == e + 1) a0 = p; } else { if (lane == e - 63) a1 = p; }
            p = wave_sum_dpp(row6_dot(r2, hf)); if (more) row6_load(r2, U, EIDX(e + 6), lane); if (e < 64) { if (lane == e + 2) a0 = p; } else { if (lane == e - 62) a1 = p; }
            p = wave_sum_dpp(row6_dot(r3, hf)); if (more) row6_load(r3, U, EIDX(e + 7), lane); if (e < 64) { if (lane == e + 3) a0 = p; } else { if (lane == e - 61) a1 = p; }
        }
    }
    const float c0 = gelu_tanh(a0 * su0) * g0, c1 = gelu_tanh(a1 * su1) * g1;
#define CIDX(e) (((e) < 64) ? rl_f(c0, (e)) : rl_f(c1, (e) - 64))
    f32x2 o[32];
#pragma unroll
    for (int i = 0; i < 32; ++i) o[i] = (f32x2){0.f, 0.f};
    {
        Row6 r0, r1, r2, r3;
        row6_load(r0, V, EIDX(0), lane); row6_load(r1, V, EIDX(1), lane); row6_load(r2, V, EIDX(2), lane); row6_load(r3, V, EIDX(3), lane);
#pragma unroll 1
        for (int e = 0; e < 128; e += 4) {
            const bool more = e + 4 < 128;
            row6_axpy(r0, CIDX(e), o); if (more) row6_load(r0, V, EIDX(e + 4), lane);
            row6_axpy(r1, CIDX(e + 1), o); if (more) row6_load(r1, V, EIDX(e + 5), lane);
            row6_axpy(r2, CIDX(e + 2), o); if (more) row6_load(r2, V, EIDX(e + 6), lane);
            row6_axpy(r3, CIDX(e + 3), o); if (more) row6_load(r3, V, EIDX(e + 7), lane);
        }
    }
#undef EIDX
#undef CIDX
    float s = 0.f;
#pragma unroll
    for (int j = 0; j < 16; ++j) { const f32x4 x = *((const f32x4*)(h1f + (size_t)m * DM) + lane + 64 * j); o[2 * j] += (f32x2){x[0], x[1]}; o[2 * j + 1] += (f32x2){x[2], x[3]};
        s += (o[2 * j].x * o[2 * j].x + o[2 * j].y * o[2 * j].y) + (o[2 * j + 1].x * o[2 * j + 1].x + o[2 * j + 1].y * o[2 * j + 1].y); }
    const float rs = 1.0f / sqrtf(wave_sum(s) * (1.0f / DM) + EPS);
    float* op = F.out() + orow * DM;
#pragma unroll
    for (int j = 0; j < 16; ++j) { const f32x4 g = *((const f32x4*)gfin + lane + 64 * j);
        *((f32x4*)op + lane + 64 * j) = (f32x4){o[2 * j].x * rs * g[0], o[2 * j].y * rs * g[1], o[2 * j + 1].x * rs * g[2], o[2 * j + 1].y * rs * g[3]}; }
}
#ifdef MK_STEP_B
__device__ __forceinline__ void stepb_token(const Frame& F, int m, size_t orow) {
    const int lane = F.lane; const float* x = (const float*)(F.ws + WS_H1F) + (size_t)m * DM; const float* gfin = F.in(15);
    f32x4 v[16]; float s = 0.f;
#pragma unroll
    for (int j = 0; j < 16; ++j) { v[j] = *((const f32x4*)x + lane + 64 * j); s += (v[j][0] * v[j][0] + v[j][1] * v[j][1]) + (v[j][2] * v[j][2] + v[j][3] * v[j][3]); }
    const float rs = 1.0f / sqrtf(wave_sum(s) * (1.0f / DM) + EPS);
#pragma unroll
    for (int j = 0; j < 16; ++j) { const f32x4 g = *((const f32x4*)gfin + lane + 64 * j); *((f32x4*)(F.out() + orow * DM) + lane + 64 * j) = v[j] * rs * g; }
}
#endif
#ifdef MK_STEP_A
__device__ __forceinline__ void stepa_token(const Frame& F, size_t orow) {
    const int lane = F.lane; const float* x = F.in(0) + orow * DM; const float* gfin = F.in(15);
    f32x4 v[16]; float s = 0.f;
#pragma unroll
    for (int j = 0; j < 16; ++j) { v[j] = *((const f32x4*)x + lane + 64 * j); s += (v[j][0] * v[j][0] + v[j][1] * v[j][1]) + (v[j][2] * v[j][2] + v[j][3] * v[j][3]); }
    const float rs = 1.0f / sqrtf(wave_sum(s) * (1.0f / DM) + EPS);
#pragma unroll
    for (int j = 0; j < 16; ++j) { const f32x4 g = *((const f32x4*)gfin + lane + 64 * j); *((f32x4*)(F.out() + orow * DM) + lane + 64 * j) = v[j] * rs * g; }
}
#endif
__device__ __forceinline__ void p8_experts(const Frame& F) {
    const int gw = F.vcu * NWAVES + F.wave, NGW = F.G * NWAVES;
#if defined(MK_STEP_A)
    for (int it = gw; it < NB * SEQ; it += NGW) stepa_token(F, (size_t)it);
#elif defined(MK_STEP_B)
    for (int it = gw; it < NB * SEQ; it += NGW) stepb_token(F, it, (size_t)it);
#else
    for (int it = gw; it < NB * SEQ; it += NGW) expert_token(F, it, (size_t)it);
#endif
}
struct Args { const float* in[16]; float* out; unsigned char* ws; int ph_lo, ph_hi; };
#define GEMM_RUN(EPI_T, g_, S_, E_) pg8::gemm_phase<EPI_T, pg8::StaticOrder, true, true>(F.lds, g_, S_, E_)
#define GEMM_RUN2(EPI_T, g_, S_, E_) pg8::gemm_phase<EPI_T, pg8::StaticOrder2, true, true>(F.lds, g_, S_, E_)

__global__ void __launch_bounds__(NWAVES * 64, 2) mk_fwd(Args args) {
    extern __shared__ __attribute__((aligned(16))) unsigned char lds_raw[];
    Frame F;
    F.lds = (LAS unsigned char*)lds_raw;
    F.ws = args.ws; F.ctl = (unsigned*)(args.ws + WS_CTL);
    F.tid = threadIdx.x; F.lane = F.tid & 63; F.wave = __builtin_amdgcn_readfirstlane(F.tid >> 6);
#define PHASE_BEGIN() do { int t_; asm volatile("v_mov_b32 %0, %1" : "=v"(t_) : "v"(threadIdx.x)); F.tid = t_; F.lane = t_ & 63; } while (0)
    F.G = gridDim.x; { const int bx = blockIdx.x; F.vcu = (F.G % 8 == 0) ? (bx % 8) * (F.G / 8) + bx / 8 : bx; }
    for (int u = F.tid; u < (LDS_BYTES - LDSCTL_OFF) / 4; u += NWAVES * 64) ((LAS unsigned*)(F.lds + LDSCTL_OFF))[u] = 0u;
    __syncthreads();
    XcdBarrier bar; bar.bar = F.ctl + CW_BAR; bar.x = 0; bar.st = nullptr;
    if (!MK_PER_PHASE) bar = xcd_barrier_post(F.ctl + CW_BAR, (volatile LAS unsigned*)(F.lds + LDSCTL_OFF));
    const int lo = args.ph_lo, hi = args.ph_hi;
#ifndef PH_MASK
#define PH_MASK 0x1FF
#endif
#define IN(k) (((PH_MASK >> (k)) & 1) && lo <= (k) && (k) < hi)
#ifdef MK_PROBE_T
#define STAMP(k) do { if (blockIdx.x == 0 && threadIdx.x == 0) ((volatile u64*)(F.ctl + 2048))[k] = __builtin_amdgcn_s_memrealtime(); } while (0)
#else
#define STAMP(k) do { } while (0)
#endif
#define SEAM(k) do { if (IN(k) && IN((k) + 1)) xcd_barrier(bar); STAMP((k) + 1); } while (0)
    unsigned char* ws = F.ws;

#ifndef MK_REP_MASK
#define MK_REP_MASK 0
#endif
#define NREP(k) (((MK_REP_MASK >> (k)) & 1) ? 2 : 1)
    STAMP(0);
    if (IN(0)) { for (int rep = 0; rep < NREP(0); ++rep) { PHASE_BEGIN(); p0_prologue(F); if (rep + 1 < NREP(0)) xcd_barrier(bar); } }
    SEAM(0);
    if (IN(1)) { for (int rep = 0; rep < NREP(1); ++rep) { PHASE_BEGIN();
        p1_quant_weights(F);
        xcd_barrier(bar);
        {
            pg8::Gemm g{(const bf16_t*)(ws + WS_XN8), (const bf16_t*)(ws + WS_WG8), MK, 12800, DM / 2, DM / 2}; pg8::StaticOrder S; S.init(MK, 12800, F.G, (int)blockIdx.x);
            epi::EpiIn<true> E{(bf16_t*)(ws + WS_CQ), (bf16_t*)(ws + WS_CKV), (bf16_t*)(ws + WS_QB), (bf16_t*)(ws + WS_KB), (bf16_t*)(ws + WS_VB), (bf16_t*)(ws + WS_QIX), (bf16_t*)(ws + WS_KPE), (bf16_t*)(ws + WS_KIX),
                          (bf16_t*)(ws + WS_GA), (bf16_t*)(ws + WS_GB), (float*)(ws + WS_WIX), rep ? nullptr : (u64*)(F.ctl + CW_SSQ_CQ), rep ? nullptr : (u64*)(F.ctl + CW_SSQ_CKV),
                          (const float*)(ws + WS_ROPE_M), (const float*)(ws + WS_ROPE_D), (const float*)(ws + WS_ROPE_I), (const float*)(ws + WS_SX), (const float*)(ws + WS_SW)};
            GEMM_RUN(epi::EpiIn<true>, g, S, E); }
        __syncthreads();
        {
            pg8::Gemm g{(const bf16_t*)(ws + WS_XN), (const bf16_t*)(ws + WS_WIN), MK, 1280, DM, DM}; pg8::StaticOrder S; S.init(MK, 1280, F.G, (int)(gridDim.x - 1 - blockIdx.x));
            epi::EpiIn<false> E{(bf16_t*)(ws + WS_CQ), (bf16_t*)(ws + WS_CKV), (bf16_t*)(ws + WS_QB), (bf16_t*)(ws + WS_KB), (bf16_t*)(ws + WS_VB), (bf16_t*)(ws + WS_QIX), (bf16_t*)(ws + WS_KPE), (bf16_t*)(ws + WS_KIX),
                          (bf16_t*)(ws + WS_GA), (bf16_t*)(ws + WS_GB), (float*)(ws + WS_WIX), nullptr, nullptr,
                          (const float*)(ws + WS_ROPE_M), (const float*)(ws + WS_ROPE_D), (const float*)(ws + WS_ROPE_I), nullptr, nullptr};
            GEMM_RUN(epi::EpiIn<false>, g, S, E); }
        if (rep + 1 < NREP(1)) xcd_barrier(bar); }
    }
    SEAM(1);
    if (IN(2)) { for (int rep = 0; rep < NREP(2); ++rep) { PHASE_BEGIN();
        { pg8::Gemm g{(const bf16_t*)(ws + WS_CQ), (const bf16_t*)(ws + WS_WUQ), NTOK, 3072, 1024, 1024}; pg8::StaticOrder S; S.init(NTOK, 3072, F.G, (int)blockIdx.x);
          epi::EpiUp E{(bf16_t*)(ws + WS_QN), (bf16_t*)(ws + WS_QR), 8, 2048, 1024, (const u64*)(F.ctl + CW_SSQ_CQ), 1.0f / 1024.0f, QA_SCALE, (const float*)(ws + WS_ROPE_M)};
          GEMM_RUN(epi::EpiUp, g, S, E); }
        __syncthreads();
        { pg8::Gemm g{(const bf16_t*)(ws + WS_CKV), (const bf16_t*)(ws + WS_WUKV), MK, 4096, 512, 512}; pg8::StaticOrder S; S.init(MK, 4096, F.G, (int)blockIdx.x);
          epi::EpiUp E{(bf16_t*)(ws + WS_KN), (bf16_t*)(ws + WS_VA), 8, 2048, 2048, (const u64*)(F.ctl + CW_SSQ_CKV), 1.0f / 512.0f, 1.0f, nullptr};
          GEMM_RUN(epi::EpiUp, g, S, E); }
        __syncthreads();
        p2_indexer(F, rep);
        if (rep + 1 < NREP(2)) xcd_barrier(bar); }
    }
    SEAM(2);
    if (IN(3)) { for (int rep = 0; rep < NREP(3); ++rep) { PHASE_BEGIN(); p3_attention(F, 2 + rep); if (rep + 1 < NREP(3)) xcd_barrier(bar); } }
    SEAM(3);
    if (IN(4)) { for (int rep = 0; rep < NREP(4); ++rep) { PHASE_BEGIN();
        rowquant_fp8(F, ws + WS_OAB, (size_t)DM * 2, ws + WS_OAB, (size_t)DM * 2, (float*)(ws + WS_SOAB), NTOK);
        xcd_barrier(bar);
        pg8::Gemm g{(const bf16_t*)(ws + WS_OAB), (const bf16_t*)(ws + WS_WBR), NTOK, 4096, 4096, 1024}; pg8::StaticOrder2 S; S.init(NTOK, 4096, F.G, (int)blockIdx.x);
        epi::EpiBranch E{(const bf16_t*)(ws + WS_GA), (const bf16_t*)(ws + WS_GB), (bf16_t*)(ws + WS_MRG), (const float*)(ws + WS_SOAB), (const float*)(ws + WS_SWBR)};
        GEMM_RUN2(epi::EpiBranch, g, S, E);
        if (rep + 1 < NREP(4)) xcd_barrier(bar); }
    }
    SEAM(4);
    if (IN(5)) { for (int rep = 0; rep < NREP(5); ++rep) { PHASE_BEGIN();
        rowquant_fp8(F, ws + WS_MRG, (size_t)DM * 2, ws + WS_MRG, (size_t)DM * 2, (float*)(ws + WS_SMRG), NTOK);
        xcd_barrier(bar);
        pg8::Gemm g{(const bf16_t*)(ws + WS_MRG), (const bf16_t*)(ws + WS_WOUT), NTOK, 4096, 4096, 2048}; pg8::StaticOrder S; S.init(NTOK, 4096, F.G, (int)blockIdx.x);
        epi::EpiOut E{F.in(0), F.in(1), (float*)(ws + WS_H1F), (bf16_t*)(ws + WS_H1B), rep ? nullptr : (u64*)(F.ctl + CW_SSQ_H1), (const float*)(ws + WS_SMRG), (const float*)(ws + WS_SWOUT)};
        GEMM_RUN(epi::EpiOut, g, S, E);
        if (rep + 1 < NREP(5)) xcd_barrier(bar); }
    }
    SEAM(5);
    if (IN(6)) { for (int rep = 0; rep < NREP(6); ++rep) { PHASE_BEGIN();
        pg8::Gemm g{(const bf16_t*)(ws + WS_H1B), (const bf16_t*)(ws + WS_WQ), NTOK, 2048, 4096, 4096}; pg8::StaticOrder S; S.init(NTOK, 2048, F.G, (int)blockIdx.x);
        epi::EpiPQ E{(bf16_t*)(ws + WS_PQ), (const u64*)(F.ctl + CW_SSQ_H1)};
        GEMM_RUN(epi::EpiPQ, g, S, E);
        p6_tables(F);
        if (rep + 1 < NREP(6)) xcd_barrier(bar); }
    }
    SEAM(6);
    if (IN(7)) { for (int rep = 0; rep < NREP(7); ++rep) { PHASE_BEGIN(); p7_routing(F); if (rep + 1 < NREP(7)) xcd_barrier(bar); } }
    SEAM(7);
    if (IN(8)) { for (int rep = 0; rep < NREP(8); ++rep) { PHASE_BEGIN(); p8_experts(F); if (rep + 1 < NREP(8)) xcd_barrier(bar); } }
#ifdef MK_PROBE_T
    {   PHASE_BEGIN();
        xcd_barrier(bar); STAMP(9); xcd_barrier(bar);
        const volatile u64* ts = (const volatile u64*)(F.ctl + 2048);
        const float tot = (float)(ts[9] - ts[0]);
        const float f1 = (float)(ts[MK_PROBE_K1 + 1] - ts[MK_PROBE_K1]) / tot, f2 = (float)(ts[MK_PROBE_K2 + 1] - ts[MK_PROBE_K2]) / tot;
        float* o = F.out(); const size_t gt = (size_t)blockIdx.x * 512 + F.tid, NGT = (size_t)gridDim.x * 512;
        for (size_t i = gt; i < (size_t)NB * SEQ * DM / 4; i += NGT) { f32x4 v = ((f32x4*)o)[i]; v = v * (1.0f - f1); if (i == 0) v[0] = 1000.0f * f2; ((f32x4*)o)[i] = v; }
    }
#endif
#undef IN
#undef SEAM
}

extern "C" void kernel_launch(void* const* d_in, const int* in_sizes, int n_in, void* d_out, int out_size, void* d_ws, size_t ws_size, hipStream_t stream) {
    static int grid = 0;
    if (grid == 0) {
        if (n_in != 16 || in_sizes[0] != NB * SEQ * DM || out_size != NB * SEQ * DM || ws_size < WS_END) {
            fprintf(stderr, "kernel_launch: unexpected problem shape (n_in %d, in0 %d, out %d, ws %zu < %zu); nothing launched\n", n_in, n_in > 0 ? in_sizes[0] : -1, out_size, ws_size, (size_t)WS_END); grid = -1; return; }
        int dev = 0, cus = 0, per_cu = 0;
        if (hipGetDevice(&dev) != hipSuccess || hipDeviceGetAttribute(&cus, hipDeviceAttributeMultiprocessorCount, dev) != hipSuccess) { grid = -1; return; }
        if (hipFuncSetAttribute((const void*)mk_fwd, hipFuncAttributeMaxDynamicSharedMemorySize, LDS_BYTES) != hipSuccess) { fprintf(stderr, "kernel_launch: hipFuncSetAttribute failed\n"); grid = -1; return; }
        if (hipOccupancyMaxActiveBlocksPerMultiprocessor(&per_cu, (const void*)mk_fwd, NWAVES * 64, LDS_BYTES) != hipSuccess || per_cu < 1) {
            fprintf(stderr, "kernel_launch: occupancy query reports %d workgroups per CU\n", per_cu); }
        (void)hipGetLastError();
        grid = cus;
    }
    if (grid < 0) return;
    if (hipMemsetAsync((char*)d_ws + WS_CTL, 0, CTL_ZERO_BYTES, stream) != hipSuccess) return;
    Args a{};
    for (int i = 0; i < 16; ++i) a.in[i] = (const float*)d_in[i];
    a.out = (float*)d_out; a.ws = (unsigned char*)d_ws;
#if MK_PER_PHASE
    for (int p = 0; p <= MK_LAST_PHASE; ++p) { a.ph_lo = p; a.ph_hi = p + 1; hipLaunchKernelGGL(mk_fwd, dim3(grid), dim3(NWAVES * 64), LDS_BYTES, stream, a); }
#else
    a.ph_lo = 0; a.ph_hi = MK_LAST_PHASE + 1;
    hipLaunchKernelGGL(mk_fwd, dim3(grid), dim3(NWAVES * 64), LDS_BYTES, stream, a);
#endif
}
```

```cpp
#include <hip/hip_runtime.h>
#include <cstdio>
#include <cstdint>

#define LAS __attribute__((address_space(3)))
#define GAS __attribute__((address_space(1)))
typedef unsigned short bf16_t;
typedef short bf16x8 __attribute__((ext_vector_type(8)));
typedef short s16x4 __attribute__((ext_vector_type(4)));
typedef float f32x2 __attribute__((ext_vector_type(2)));
typedef float f32x4 __attribute__((ext_vector_type(4)));
typedef float f32x16 __attribute__((ext_vector_type(16)));
typedef unsigned u32x2 __attribute__((ext_vector_type(2)));
typedef unsigned u32x4 __attribute__((ext_vector_type(4)));
typedef GAS unsigned gu32;

#ifndef MK_PER_PHASE
#define MK_PER_PHASE 0
#endif
#ifndef MK_LAST_PHASE
#define MK_LAST_PHASE 8
#endif

constexpr int NB = 4, SEQ = 4096, DM = 4096, NMETA = 16, TR = SEQ + NMETA  , TP = 4224  , M = NB * TP  ;
constexpr float EPS = 1e-6f;
constexpr int NV1 = 14080;
constexpr float LOG2E = 1.4426950408889634f;
constexpr float QB_SCALE = 0.08838834764831845f * LOG2E;
constexpr float QA_SCALE = 0.07216878364870323f * LOG2E;
constexpr int NWAVES = 8;
constexpr int NTOK = NB * SEQ;
constexpr int MK = NTOK + 256;
constexpr int MW = 130;
__device__ __forceinline__ int row_pos(int row) { return row < NTOK ? NMETA + (row & (SEQ - 1)) : row - NTOK; }
__device__ __forceinline__ int pos_row(int b, int p) { return p < NMETA ? NTOK + p : b * SEQ + (p - NMETA); }

constexpr size_t HM = 512u * 1024u;
constexpr size_t WS_CTL = 0, CTL_ZERO_BYTES = 2 * HM;
constexpr size_t WS_ROPE_M = 2 * HM;
constexpr size_t WS_ROPE_D = 5 * HM;
constexpr size_t WS_ROPE_I = 7 * HM;
constexpr size_t WS_SK   = 8 * HM;
constexpr size_t WS_WUQ  = 10 * HM;
constexpr size_t WS_WUKV = 22 * HM;
constexpr size_t WS_WBR  = 30 * HM;
constexpr size_t WS_WOUT = 94 * HM;
constexpr size_t WS_WQ   = 158 * HM;
constexpr size_t WS_EID  = 190 * HM;
constexpr size_t WS_GATE = 207 * HM;
constexpr size_t WS_MASK = 224 * HM;
constexpr size_t WS_KPE  = 242 * HM;
constexpr size_t WS_KIX  = 247 * HM;
constexpr size_t WS_WIX  = 252 * HM;
constexpr size_t WS_SCU  = 255 * HM;
constexpr size_t WS_SCV  = 255 * HM + 65536;
constexpr size_t WS_SX   = 255 * HM + 131072;
constexpr size_t WS_SW   = 255 * HM + 200704;
constexpr size_t WS_SWBR = 255 * HM + 294912;
constexpr size_t WS_SWOUT= 255 * HM + 311296;
constexpr size_t WS_SOAB = 255 * HM + 327680;
constexpr size_t WS_SMRG = 255 * HM + 393216;
constexpr size_t R23 = 260 * HM;
constexpr size_t WS_XN   = R23;
constexpr size_t WS_WIN  = R23 + 264 * HM;
constexpr size_t P1O = R23 + 484 * HM;
constexpr size_t WS_CQ   = P1O;
constexpr size_t WS_CKV  = P1O + 66 * HM;
constexpr size_t WS_QB   = P1O + 99 * HM;
constexpr size_t WS_KB   = P1O + 231 * HM;
constexpr size_t WS_VB   = P1O + 264 * HM;
constexpr size_t WS_QIX  = P1O + 297 * HM;
constexpr size_t WS_GA   = P1O + 363 * HM;
constexpr size_t WS_GB   = P1O + 627 * HM;
constexpr size_t R4 = P1O + 892 * HM;
constexpr size_t WS_OAB  = R4;
constexpr size_t WS_XN8  = R4;
constexpr size_t WS_WG8  = R4 + 132 * HM;
constexpr size_t WS_PQ   = R4;
constexpr size_t WS_END  = R4 + 264 * HM;
constexpr size_t WS_QN   = R23;
constexpr size_t WS_QR   = R23 + 132 * HM;
constexpr size_t WS_KN   = R23 + 198 * HM;
constexpr size_t WS_VA   = R23 + 330 * HM;
constexpr size_t WS_MRG  = R23;
constexpr size_t WS_U    = R23;
constexpr size_t WS_V    = R23 + 256 * HM;
constexpr size_t WS_H1F  = R23 + 512 * HM;
constexpr size_t WS_H1B  = R23 + 1040 * HM;
static_assert(WS_VA + 132 * HM <= P1O && WS_H1F >= P1O && WS_H1B + 264 * HM <= R4 && WS_GB + 264 * HM <= R4, "ws map");
constexpr int CW_TMO = 0;
constexpr int CW_BAR = 4096;
constexpr int CW_QUEUE = 8192;
constexpr int CW_SSQ_CQ = 16384, CW_SSQ_CKV = 16384 + 2 * 17408, CW_SSQ_H1 = 16384 + 4 * 17408;
static_assert((CW_SSQ_H1 + 2 * 17408) * 4 <= (int)CTL_ZERO_BYTES, "ctl");

constexpr int RING_BYTES = 131072;
constexpr int LDSCTL_OFF = RING_BYTES;
constexpr int LDS_BYTES = 147456;

__device__ __forceinline__ unsigned f2bf(float f) { unsigned u = __float_as_uint(f); return (u + 0x7fffu + ((u >> 16) & 1u)) >> 16; }
__device__ __forceinline__ unsigned pk2(float lo, float hi) { return f2bf(lo) | (f2bf(hi) << 16); }
typedef __bf16 bf16x2_t __attribute__((ext_vector_type(2)));
__device__ __forceinline__ unsigned cvt_pk_bf16(float lo, float hi) { return __builtin_bit_cast(unsigned, __builtin_convertvector((f32x2){lo, hi}, bf16x2_t)); }
__device__ __forceinline__ float bf_lo(unsigned w) { return __uint_as_float(w << 16); }
__device__ __forceinline__ float bf_hi(unsigned w) { return __uint_as_float(w & 0xffff0000u); }
__device__ __forceinline__ u32x4 pack8(f32x4 a, f32x4 b) { u32x4 w; w.x = cvt_pk_bf16(a[0], a[1]); w.y = cvt_pk_bf16(a[2], a[3]); w.z = cvt_pk_bf16(b[0], b[1]); w.w = cvt_pk_bf16(b[2], b[3]); return w; }
__device__ __forceinline__ float wave_sum(float v) {
#pragma unroll
    for (int o = 1; o < 64; o <<= 1) v += __shfl_xor(v, o);
    return v;
}
#define LDS_WAIT() asm volatile("s_waitcnt lgkmcnt(0)" ::: "memory")
#define VM_WAIT() asm volatile("s_waitcnt vmcnt(0)" ::: "memory")
typedef unsigned long long u64;
__device__ __forceinline__ void ssq_add(u64* p, float v) { (void)__hip_atomic_fetch_add(p, (u64)(v * 16777216.0f), __ATOMIC_RELAXED, __HIP_MEMORY_SCOPE_AGENT); }
__device__ __forceinline__ float ssq_get(const u64* p) { return (float)((double)(*p) * (1.0 / 16777216.0)); }
namespace pg8 {
#define PG8_LAS __attribute__((address_space(3)))
typedef unsigned short bf16_t;
typedef short bf16x8 __attribute__((ext_vector_type(8)));
typedef float f32x4 __attribute__((ext_vector_type(4)));
typedef unsigned u32x4 __attribute__((ext_vector_type(4)));
constexpr int BM = 256, BK = 64, HALF = 128, HTB = HALF * BK * 2  , STAGE_BYTES = 8 * HTB, NXCD = 8, WGM = 8;

__host__ __device__ __forceinline__ int lds_byte(int r, int c) { const int st = (r >> 4) * 2 + (c >> 5), rr = r & 15, cc = c & 31, ob = rr * 64 + cc * 2; return st * 1024 + (ob ^ (((ob >> 9) & 1) << 5)); }
__host__ __device__ __forceinline__ void stage_rc(int b, int& R, int& C) { const int st = b / 1024, sb = b % 1024, swz = sb ^ (((sb >> 9) & 1) << 5); R = (st >> 1) * 16 + swz / 64; C = (st & 1) * 32 + (swz % 64) / 2; }
__host__ __device__ __forceinline__ int perm32(int rho) { const int n = rho >> 4, i = rho & 15; return 8 * (i >> 2) + 4 * n + (i & 3); }

typedef int i32x4_t __attribute__((ext_vector_type(4)));
typedef int i32x8_t __attribute__((ext_vector_type(8)));
__device__ __forceinline__ i32x8_t cat8(bf16x8 lo, bf16x8 hi) { const i32x4_t a = __builtin_bit_cast(i32x4_t, lo), b = __builtin_bit_cast(i32x4_t, hi); return __builtin_shufflevector(a, b, 0, 1, 2, 3, 4, 5, 6, 7); }
__device__ __forceinline__ void mfma_f8_acc(f32x4& c, const i32x8_t a, const i32x8_t b) {
#if defined(__HIP_DEVICE_COMPILE__)
    int sc = 0x7F7F7F7F;
    asm volatile("v_mfma_scale_f32_16x16x128_f8f6f4 %0, %1, %2, %0, %3, %3 op_sel_hi:[0,0,0]" : "+v"(c) : "v"(a), "v"(b), "v"(sc));
#else
    (void)c; (void)a; (void)b;
#endif
}
struct Unit { int pm, pn, kh; };
struct Gemm { const bf16_t* A; const bf16_t* Bt; int M, N, K, KL; };

struct StaticOrder {
    int nM, nN, nwg, G, c;
    __host__ __device__ void init(int M, int N, int G_, int c_) { nM = M / BM; nN = N / BM; nwg = nM * nN; G = G_; c = c_; }
    __host__ __device__ bool next(int i, Unit& u) const {
        const long L = (long)i * G + c; if (L >= nwg) return false;
        int wgid = (int)L; { const int q = nwg / NXCD, r = nwg % NXCD, xcd = wgid % NXCD, off = wgid / NXCD; wgid = (xcd < r ? xcd * (q + 1) : r * (q + 1) + (xcd - r) * q) + off; }
        const int nig = WGM * nN, gid = wgid / nig, fm = gid * WGM, gsz = (nM - fm) < WGM ? (nM - fm) : WGM;
        u.pm = fm + ((wgid % nig) % gsz); u.pn = (wgid % nig) / gsz; u.kh = 0; return true;
    }
    __device__ __forceinline__ void a_ready(const Unit&) const {}
    __device__ __forceinline__ void done(const Unit&) const {}
};

struct StaticOrder2 {
    StaticOrder base;
    __host__ __device__ void init(int M, int N, int G_, int c_) { base.init(M, N, G_, c_); }
    __host__ __device__ bool next(int i, Unit& u) const { if (!base.next(i >> 1, u)) return false; u.kh = i & 1; return true; }
    __device__ __forceinline__ void a_ready(const Unit&) const {}
    __device__ __forceinline__ void done(const Unit&) const {}
};

template <class Epi, class Sched, bool ALIGN_EPI = false, bool SP2 = false>
__device__ __forceinline__ void gemm_phase(PG8_LAS unsigned char* lds, const Gemm g, const Sched& S, const Epi& E) {
    int tid_; asm volatile("v_mov_b32 %0, %1" : "=v"(tid_) : "v"(threadIdx.x));
    const int tid = tid_, wid = __builtin_amdgcn_readfirstlane(tid >> 6), lane = tid & 63, wr = wid >> 2, wc = wid & 3, fr = lane & 15, fq = lane >> 4;
    const int K = g.K, nt = g.KL / BK; const size_t khoff = (size_t)g.KL * 2;
    unsigned voffA[2], voffB[2];
#pragma unroll
    for (int i = 0; i < 2; ++i) { int R, C; stage_rc(tid * 16 + i * 8192, R, C); const int Rb = Epi::PERM ? ((R & ~31) + perm32(R & 31)) : R;
        voffA[i] = (unsigned)(R * K + C) * 2u; voffB[i] = (unsigned)(Rb * K + C) * 2u; }
    const size_t kstep = (size_t)(BK * 2);
    const size_t hstep = (size_t)HALF * K * 2;
    const size_t tstep = 2 * hstep;
    const unsigned ldsw = (unsigned)wid * 1024u;
    const int aoff = lds_byte(wr * 64 + fr, fq * 8), boff = lds_byte(wc * 32 + fr, fq * 8);
#define PG8_SA(b, h) (((b) * 2 + (h)) * HTB)
#define PG8_SB(b, h) ((4 + (b) * 2 + (h)) * HTB)
#define PG8_STAGE(bufoff, gbase, voff) do { _Pragma("unroll") for (int _i = 0; _i < 2; ++_i) \
        __builtin_amdgcn_global_load_lds((const unsigned*)((const char*)(gbase) + (voff)[_i]), (PG8_LAS unsigned*)(lds + (bufoff) + ldsw + _i * 8192), 16, 0, 0); } while (0)
#define PG8_LDA(dst, b, h) do { _Pragma("unroll") for (int m = 0; m < 4; ++m) _Pragma("unroll") for (int k = 0; k < 2; ++k) dst[m][k] = *(const PG8_LAS bf16x8*)(lds + PG8_SA(b, h) + aoff + m * 2048 + k * 1024); } while (0)
#define PG8_LDB(dst, b, h) do { _Pragma("unroll") for (int n = 0; n < 2; ++n) _Pragma("unroll") for (int k = 0; k < 2; ++k) dst[n][k] = *(const PG8_LAS bf16x8*)(lds + PG8_SB(b, h) + boff + n * 2048 + k * 1024); } while (0)
#define PG8_MMA(ai, bj, At, Bt) do { __builtin_amdgcn_s_setprio(1); _Pragma("unroll") for (int m = 0; m < 4; ++m) _Pragma("unroll") for (int n = 0; n < 2; ++n) { \
        if constexpr (Epi::FP8) mfma_f8_acc(acc[ai][bj][m][n], cat8(Bt[n][0], Bt[n][1]), cat8(At[m][0], At[m][1])); \
        else { _Pragma("unroll") for (int k = 0; k < 2; ++k) acc[ai][bj][m][n] = __builtin_amdgcn_mfma_f32_16x16x32_bf16(Bt[n][k], At[m][k], acc[ai][bj][m][n], 0, 0, 0); } } \
        __builtin_amdgcn_s_setprio(0); } while (0)
#define PG8_WAIT_V(n) asm volatile("s_waitcnt vmcnt(" #n ")" ::: "memory")
#define PG8_WAIT_L(n) asm volatile("s_waitcnt lgkmcnt(" #n ")" ::: "memory")
#define PG8_BAR __builtin_amdgcn_s_barrier()
#define PG8_SCHED __builtin_amdgcn_sched_barrier(0)
    Unit cur, nxt; int ui = 0;
    if (!S.next(0, cur)) return;
    f32x4 acc[2][2][4][2];
#pragma unroll
    for (int a = 0; a < 2; ++a)
#pragma unroll
        for (int b = 0; b < 2; ++b)
#pragma unroll
            for (int m = 0; m < 4; ++m)
#pragma unroll
                for (int n = 0; n < 2; ++n) acc[a][b][m][n] = (f32x4){0.f, 0.f, 0.f, 0.f};
    bf16x8 At[4][2], B0[2][2], B1[2][2];
    const char* cA = (const char*)g.A + (size_t)cur.pm * tstep + (size_t)cur.kh * khoff; const char* cB = (const char*)g.Bt + (size_t)cur.pn * tstep + (size_t)cur.kh * khoff;
    S.a_ready(cur);
    if constexpr (SP2) {
        PG8_STAGE(PG8_SB(0, 0), cB, voffB); PG8_STAGE(PG8_SB(0, 1), cB + hstep, voffB); PG8_STAGE(PG8_SA(0, 0), cA, voffA); PG8_STAGE(PG8_SA(0, 1), cA + hstep, voffA);
        if (wr == 1) PG8_BAR;
        PG8_WAIT_V(2); PG8_BAR;
        PG8_STAGE(PG8_SB(1, 0), cB + kstep, voffB); PG8_STAGE(PG8_SA(1, 0), cA + kstep, voffA); PG8_STAGE(PG8_SB(1, 1), cB + hstep + kstep, voffB);
        PG8_WAIT_V(6); PG8_BAR;
    } else {
        PG8_STAGE(PG8_SB(0, 0), cB, voffB); PG8_STAGE(PG8_SA(0, 0), cA, voffA); PG8_STAGE(PG8_SB(0, 1), cB + hstep, voffB); PG8_STAGE(PG8_SA(0, 1), cA + hstep, voffA);
        if (wr == 1) PG8_BAR;
        PG8_WAIT_V(4); PG8_BAR;
        PG8_STAGE(PG8_SB(1, 0), cB + kstep, voffB); PG8_STAGE(PG8_SA(1, 0), cA + kstep, voffA); PG8_STAGE(PG8_SB(1, 1), cB + hstep + kstep, voffB);
        PG8_WAIT_V(6); PG8_BAR;
    }
    for (;;) {
        const bool has_next = S.next(ui + 1, nxt);
        const char* nA = has_next ? (const char*)g.A + (size_t)nxt.pm * tstep + (size_t)nxt.kh * khoff : cA; const char* nB = has_next ? (const char*)g.Bt + (size_t)nxt.pn * tstep + (size_t)nxt.kh * khoff : cB;
        for (int t = 0; t < nt; t += 2) {
            const bool last = (t == nt - 2);
            const char* a1 = cA + (size_t)(t + 1) * kstep;
            const char* a2 = last ? nA : cA + (size_t)(t + 2) * kstep; const char* b2 = last ? nB : cB + (size_t)(t + 2) * kstep;
            const char* a3 = a2 + kstep; const char* b3 = b2 + kstep;
            if (last && has_next) S.a_ready(nxt);
            if constexpr (SP2) {
            PG8_LDB(B0, 0, 0); PG8_LDB(B1, 0, 1); PG8_SCHED; PG8_LDA(At, 0, 0); PG8_STAGE(PG8_SA(1, 1), a1 + hstep, voffA);
            PG8_WAIT_V(8); PG8_WAIT_L(0); PG8_BAR; PG8_MMA(0, 0, At, B0); PG8_MMA(0, 1, At, B1); PG8_BAR; PG8_SCHED;
            PG8_LDA(At, 0, 1); PG8_STAGE(PG8_SB(0, 0), b2, voffB); PG8_STAGE(PG8_SB(0, 1), b2 + hstep, voffB); PG8_STAGE(PG8_SA(0, 0), a2, voffA);
            PG8_WAIT_V(8); PG8_WAIT_L(0); PG8_BAR; PG8_MMA(1, 0, At, B0); PG8_MMA(1, 1, At, B1); PG8_BAR; PG8_SCHED;
            PG8_LDB(B0, 1, 0); PG8_LDB(B1, 1, 1); PG8_SCHED; PG8_LDA(At, 1, 0); PG8_STAGE(PG8_SA(0, 1), a2 + hstep, voffA);
            PG8_WAIT_V(8); PG8_WAIT_L(0); PG8_BAR; PG8_MMA(0, 0, At, B0); PG8_MMA(0, 1, At, B1); PG8_BAR; PG8_SCHED;
            PG8_LDA(At, 1, 1); PG8_STAGE(PG8_SB(1, 0), b3, voffB); PG8_STAGE(PG8_SB(1, 1), b3 + hstep, voffB); PG8_STAGE(PG8_SA(1, 0), a3, voffA);
            PG8_WAIT_V(8); PG8_WAIT_L(0); PG8_BAR; PG8_MMA(1, 0, At, B0); PG8_MMA(1, 1, At, B1); PG8_BAR; PG8_SCHED;
            } else {
            PG8_LDB(B0, 0, 0); PG8_SCHED; PG8_LDA(At, 0, 0); PG8_STAGE(PG8_SA(1, 1), a1 + hstep, voffA);
            PG8_WAIT_L(8); PG8_BAR; PG8_WAIT_L(0); PG8_MMA(0, 0, At, B0); PG8_BAR; PG8_SCHED;
            PG8_LDB(B1, 0, 1); PG8_STAGE(PG8_SB(0, 0), b2, voffB);
            PG8_BAR; PG8_WAIT_L(0); PG8_MMA(0, 1, At, B1); PG8_BAR;
            PG8_LDA(At, 0, 1); PG8_STAGE(PG8_SA(0, 0), a2, voffA);
            PG8_BAR; PG8_WAIT_L(0); PG8_MMA(1, 0, At, B0); PG8_BAR; PG8_SCHED;
            PG8_STAGE(PG8_SB(0, 1), b2 + hstep, voffB);
            PG8_WAIT_V(6); PG8_BAR; PG8_MMA(1, 1, At, B1); PG8_BAR;
            PG8_LDB(B0, 1, 0); PG8_SCHED; PG8_LDA(At, 1, 0); PG8_STAGE(PG8_SA(0, 1), a2 + hstep, voffA);
            PG8_WAIT_L(8); PG8_BAR; PG8_WAIT_L(0); PG8_MMA(0, 0, At, B0); PG8_BAR; PG8_SCHED;
            PG8_LDB(B1, 1, 1); PG8_STAGE(PG8_SB(1, 0), b3, voffB);
            PG8_BAR; PG8_WAIT_L(0); PG8_MMA(0, 1, At, B1); PG8_BAR;
            PG8_LDA(At, 1, 1); PG8_STAGE(PG8_SA(1, 0), a3, voffA);
            PG8_BAR; PG8_WAIT_L(0); PG8_MMA(1, 0, At, B0); PG8_BAR; PG8_SCHED;
            PG8_STAGE(PG8_SB(1, 1), b3 + hstep, voffB);
            PG8_WAIT_V(6); PG8_BAR; PG8_MMA(1, 1, At, B1); PG8_BAR;
            }
        }
        if constexpr (ALIGN_EPI) { if (wr == 0) PG8_BAR; }
        if constexpr (!Epi::AFTER_DRAIN) { E(acc, cur, wr, wc, fr, fq); S.done(cur); }
        if (!has_next) break;
        if (!(Epi::SPLITK2 && cur.kh == 0))
#pragma unroll
        for (int a = 0; a < 2; ++a)
#pragma unroll
            for (int b = 0; b < 2; ++b)
#pragma unroll
                for (int m = 0; m < 4; ++m)
#pragma unroll
                    for (int n = 0; n < 2; ++n) acc[a][b][m][n] = (f32x4){0.f, 0.f, 0.f, 0.f};
        cur = nxt; cA = nA; cB = nB; ++ui;
        if constexpr (ALIGN_EPI) { if (wr == 1) PG8_BAR; }
    }
    PG8_WAIT_V(0);
    if constexpr (!ALIGN_EPI) { if (wr == 0) PG8_BAR; }
    PG8_BAR;
    if constexpr (Epi::AFTER_DRAIN) { E.fused(acc, cur, wr, wc, fr, fq, lds, wid, lane); S.done(cur); }
#undef PG8_SA
#undef PG8_SB
#undef PG8_STAGE
#undef PG8_LDA
#undef PG8_LDB
#undef PG8_MMA
#undef PG8_WAIT_V
#undef PG8_WAIT_L
#undef PG8_BAR
#undef PG8_SCHED
}
}
namespace epi {
using pg8::Unit;
typedef f32x4 Acc[2][2][4][2];

__device__ __forceinline__ void rot2(f32x4& v, const f32x4 cs) {
    const float a1 = v[0] * cs[0] - v[1] * cs[1], a2 = v[1] * cs[0] + v[0] * cs[1];
    const float b1 = v[2] * cs[2] - v[3] * cs[3], b2 = v[3] * cs[2] + v[2] * cs[3];
    v = (f32x4){a1, a2, b1, b2};
}
__device__ __forceinline__ float sigm(float x) { return 1.0f / (1.0f + __expf(-x)); }

template <bool F8> struct EpiIn {
    static constexpr bool PERM = true, AFTER_DRAIN = false, SPLITK2 = false, FP8 = F8;
    bf16_t *cq, *ckv, *qb, *kb, *vb, *qix, *kpe, *kix, *ga, *gb; float* wix; u64 *ssq_cq, *ssq_ckv;
    const float *ropeM, *ropeD, *ropeI;
    const float *sx, *sw;
    __device__ __forceinline__ void operator()(const Acc& acc, const Unit& u, int wr, int wc, int fr, int fq) const {
        const int vt = F8 ? (u.pn < 18 ? u.pn : u.pn + 5) : u.pn + 18, rowb = u.pm * 256 + wr * 64 + fr, ct = wc * 32 + 8 * fq;
        f32x4 wsc[2][2];
        if (F8) {
#pragma unroll
            for (int bj = 0; bj < 2; ++bj) { const f32x4* p = (const f32x4*)(sw + u.pn * 256 + ct + bj * 128); wsc[bj][0] = p[0]; wsc[bj][1] = p[1]; }
        }
#define AV(ai_, bj_, m_, n_) (F8 ? acc[ai_][bj_][m_][n_] * rs * wsc[bj_][n_] : acc[ai_][bj_][m_][n_])
        if (vt < 6) {
            bf16_t* dst = vt < 4 ? cq : ckv; const int ld = vt < 4 ? 1024 : 512, cb = (vt < 4 ? vt : vt - 4) * 256 + ct; u64* ssq = vt < 4 ? ssq_cq : ssq_ckv;
#pragma unroll
            for (int ai = 0; ai < 2; ++ai)
#pragma unroll
                for (int m = 0; m < 4; ++m) { const int row = rowb + ai * 128 + m * 16; const float rs = F8 ? sx[row] : 1.f; (void)rs; float s = 0.f;
#pragma unroll
                    for (int bj = 0; bj < 2; ++bj) { const f32x4 v0 = AV(ai, bj, m, 0), v1 = AV(ai, bj, m, 1);
                        s += (v0[0] * v0[0] + v0[1] * v0[1]) + (v0[2] * v0[2] + v0[3] * v0[3]) + (v1[0] * v1[0] + v1[1] * v1[1]) + (v1[2] * v1[2] + v1[3] * v1[3]);
                        *(u32x4*)(dst + (size_t)row * ld + cb + bj * 128) = pack8(v0, v1); }
                    s += __shfl_xor(s, 16); s += __shfl_xor(s, 32);
                    if (fq == 0 && ssq) ssq_add(ssq + row, s); }
        } else if (vt < 16) {
            const bool isq = vt < 14; bf16_t* dst = isq ? qb : kb; const int ld = isq ? 2048 : 512, cb = (isq ? vt - 6 : vt - 14) * 256 + ct; const float sc = isq ? QB_SCALE : 1.f;
#pragma unroll
            for (int ai = 0; ai < 2; ++ai)
#pragma unroll
                for (int m = 0; m < 4; ++m) { const int row = rowb + ai * 128 + m * 16, t = row_pos(row); const float rs = F8 ? sx[row] : 1.f; (void)rs;
                    f32x4 cs0 = (f32x4){1.f, 0.f, 1.f, 0.f}, cs1 = cs0;
                    if (wc == 0) { const f32x4* p = (const f32x4*)(ropeD + ((size_t)t * 16 + 4 * fq) * 2); cs0 = p[0]; cs1 = p[1]; }
#pragma unroll
                    for (int bj = 0; bj < 2; ++bj) { f32x4 v0 = AV(ai, bj, m, 0), v1 = AV(ai, bj, m, 1);
                        if (wc == 0) { rot2(v0, cs0); rot2(v1, cs1); }
                        v0 = v0 * sc; v1 = v1 * sc;
                        *(u32x4*)(dst + (size_t)row * ld + cb + bj * 128) = pack8(v0, v1); } }
        } else if (vt < 18) {
            const int cb = (vt - 16) * 256 + ct;
#pragma unroll
            for (int ai = 0; ai < 2; ++ai)
#pragma unroll
                for (int m = 0; m < 4; ++m) { const int row = rowb + ai * 128 + m * 16; const float rs = F8 ? sx[row] : 1.f; (void)rs;
#pragma unroll
                    for (int bj = 0; bj < 2; ++bj) *(u32x4*)(vb + (size_t)row * 512 + cb + bj * 128) = pack8(AV(ai, bj, m, 0), AV(ai, bj, m, 1)); }
        } else if (vt < 22) {
            const int cb = (vt - 18) * 256 + ct; const bool rt = ((wc & 1) == 0) && (fq < 2);
#pragma unroll
            for (int ai = 0; ai < 2; ++ai)
#pragma unroll
                for (int m = 0; m < 4; ++m) { const int row = rowb + ai * 128 + m * 16, t = row_pos(row); const float rs = F8 ? sx[row] : 1.f; (void)rs;
                    f32x4 cs0 = (f32x4){1.f, 0.f, 1.f, 0.f}, cs1 = cs0;
                    if (rt) { const f32x4* p = (const f32x4*)(ropeI + ((size_t)t * 8 + 4 * fq) * 2); cs0 = p[0]; cs1 = p[1]; }
#pragma unroll
                    for (int bj = 0; bj < 2; ++bj) { f32x4 v0 = AV(ai, bj, m, 0), v1 = AV(ai, bj, m, 1);
                        if (rt) { rot2(v0, cs0); rot2(v1, cs1); }
                        *(u32x4*)(qix + (size_t)row * 1024 + cb + bj * 128) = pack8(v0, v1); } }
        } else if (vt == 22) {
#pragma unroll
            for (int ai = 0; ai < 2; ++ai)
#pragma unroll
                for (int m = 0; m < 4; ++m) { const int row = rowb + ai * 128 + m * 16, t = row_pos(row); const float rs = F8 ? sx[row] : 1.f; (void)rs;
                    f32x4 v0 = AV(ai, 0, m, 0), v1 = AV(ai, 0, m, 1);
                    if (wc < 2) { const f32x4* p = (const f32x4*)(ropeM + ((size_t)t * 32 + 16 * wc + 4 * fq) * 2); rot2(v0, p[0]); rot2(v1, p[1]);
                        *(u32x4*)(kpe + (size_t)row * 64 + ct) = pack8(v0, v1);
                    } else { if (wc == 2 && fq < 2) { const f32x4* p = (const f32x4*)(ropeI + ((size_t)t * 8 + 4 * fq) * 2); rot2(v0, p[0]); rot2(v1, p[1]); }
                        *(u32x4*)(kix + (size_t)row * 64 + (ct - 64)) = pack8(v0, v1); }
                    if (wc == 0 && fq < 2) { float* w = wix + (size_t)row * 16 + 8 * fq; *(f32x4*)w = AV(ai, 1, m, 0); *(f32x4*)(w + 4) = AV(ai, 1, m, 1); } }
        } else {
            const bool isa = vt < 39; bf16_t* dst = isa ? ga : gb; const int cb = (isa ? vt - 23 : vt - 39) * 256 + ct;
#pragma unroll
            for (int ai = 0; ai < 2; ++ai)
#pragma unroll
                for (int m = 0; m < 4; ++m) { const int row = rowb + ai * 128 + m * 16; const float rs = F8 ? sx[row] : 1.f; (void)rs;
#pragma unroll
                    for (int bj = 0; bj < 2; ++bj) { f32x4 v0 = AV(ai, bj, m, 0), v1 = AV(ai, bj, m, 1);
#pragma unroll
                        for (int e = 0; e < 4; ++e) { v0[e] = sigm(v0[e]); v1[e] = sigm(v1[e]); }
                        *(u32x4*)(dst + (size_t)row * 4096 + cb + bj * 128) = pack8(v0, v1); } }
        }
#undef AV
    }
};

struct EpiUp {
    static constexpr bool PERM = true, AFTER_DRAIN = false, SPLITK2 = false, FP8 = false;
    bf16_t *d0, *d1; int nt0, ld0, ld1; const u64* ssq; float invK, scale; const float* rope;
    __device__ __forceinline__ void operator()(const Acc& acc, const Unit& u, int wr, int wc, int fr, int fq) const {
        const int vt = u.pn, rowb = u.pm * 256 + wr * 64 + fr, ct = wc * 32 + 8 * fq; const bool first = vt < nt0;
        bf16_t* dst = first ? d0 : d1; const int ld = first ? ld0 : ld1, cb = (first ? vt : vt - nt0) * 256 + ct; const bool rt = (!first) && (rope != nullptr);
#pragma unroll
        for (int ai = 0; ai < 2; ++ai)
#pragma unroll
            for (int m = 0; m < 4; ++m) { const int row = rowb + ai * 128 + m * 16, t = row_pos(row);
                const float rs = __builtin_amdgcn_rsqf(ssq_get(ssq + row) * invK + EPS) * scale;
                f32x4 cs0 = (f32x4){1.f, 0.f, 1.f, 0.f}, cs1 = cs0;
                if (rt) { const f32x4* p = (const f32x4*)(rope + ((size_t)t * 32 + 16 * (wc & 1) + 4 * fq) * 2); cs0 = p[0]; cs1 = p[1]; }
#pragma unroll
                for (int bj = 0; bj < 2; ++bj) { f32x4 v0 = acc[ai][bj][m][0] * rs, v1 = acc[ai][bj][m][1] * rs;
                    if (rt) { rot2(v0, cs0); rot2(v1, cs1); }
                    *(u32x4*)(dst + (size_t)row * ld + cb + bj * 128) = pack8(v0, v1); } }
    }
};

struct EpiBranch {
    static constexpr bool PERM = true, AFTER_DRAIN = false, SPLITK2 = true, FP8 = true;
    const bf16_t *ga, *gb; bf16_t* out; const float *srow, *scol;
    __device__ __forceinline__ void operator()(Acc& acc, const Unit& u, int wr, int wc, int fr, int fq) const {
        const int rowb = u.pm * 256 + wr * 64 + fr, cb = u.pn * 256 + wc * 32 + 8 * fq;
        if (u.kh == 0) {
#pragma unroll
            for (int ai = 0; ai < 2; ++ai)
#pragma unroll
                for (int m = 0; m < 4; ++m) { const size_t ro = (size_t)(rowb + ai * 128 + m * 16) * 4096 + cb;
#pragma unroll
                    for (int bj = 0; bj < 2; ++bj) { const u32x4 a = *(const u32x4*)(ga + ro + bj * 128), b = *(const u32x4*)(gb + ro + bj * 128);
                        f32x4 r0, r1;
#define RQ(x, y) ((x) * __builtin_amdgcn_rcpf(y))
                        r0[0] = RQ(bf_lo(a.x), bf_lo(b.x)); r0[1] = RQ(bf_hi(a.x), bf_hi(b.x)); r0[2] = RQ(bf_lo(a.y), bf_lo(b.y)); r0[3] = RQ(bf_hi(a.y), bf_hi(b.y));
                        r1[0] = RQ(bf_lo(a.z), bf_lo(b.z)); r1[1] = RQ(bf_hi(a.z), bf_hi(b.z)); r1[2] = RQ(bf_lo(a.w), bf_lo(b.w)); r1[3] = RQ(bf_hi(a.w), bf_hi(b.w));
#undef RQ
                        acc[ai][bj][m][0] = acc[ai][bj][m][0] * r0; acc[ai][bj][m][1] = acc[ai][bj][m][1] * r1; }
                    asm volatile("" ::: "memory"); }
        } else {
            f32x4 w0[2], w1[2];
#pragma unroll
            for (int bj = 0; bj < 2; ++bj) { const f32x4* p = (const f32x4*)(scol + cb + bj * 128); w0[bj] = p[0]; w1[bj] = p[1]; }
#pragma unroll
            for (int ai = 0; ai < 2; ++ai)
#pragma unroll
                for (int m = 0; m < 4; ++m) { const int row = rowb + ai * 128 + m * 16; const size_t ro = (size_t)row * 4096 + cb; const float rs = srow[row];
#pragma unroll
                    for (int bj = 0; bj < 2; ++bj) { const u32x4 b = *(const u32x4*)(gb + ro + bj * 128);
                        const f32x4 s0 = (f32x4){bf_lo(b.x), bf_hi(b.x), bf_lo(b.y), bf_hi(b.y)} * rs * w0[bj], s1 = (f32x4){bf_lo(b.z), bf_hi(b.z), bf_lo(b.w), bf_hi(b.w)} * rs * w1[bj];
                        *(u32x4*)(out + ro + bj * 128) = pack8(acc[ai][bj][m][0] * s0, acc[ai][bj][m][1] * s1); } }
        }
    }
};

struct EpiOut {
    static constexpr bool PERM = true, AFTER_DRAIN = false, SPLITK2 = false, FP8 = true;
    const float *x, *meta; float* h1f; bf16_t* h1b; u64* ssq; const float *srow, *scol;
    __device__ __forceinline__ void operator()(const Acc& acc, const Unit& u, int wr, int wc, int fr, int fq) const {
        const int rowb = u.pm * 256 + wr * 64 + fr, cb = u.pn * 256 + wc * 32 + 8 * fq;
#pragma unroll
        for (int ai = 0; ai < 2; ++ai)
#pragma unroll
            for (int m = 0; m < 4; ++m) { const int row = rowb + ai * 128 + m * 16;
                const float* src = x + (size_t)row * DM;
                float s = 0.f; const float rs = srow[row];
#pragma unroll
                for (int bj = 0; bj < 2; ++bj) { const f32x4* wp = (const f32x4*)(scol + cb + bj * 128); f32x4 v0 = acc[ai][bj][m][0] * rs * wp[0], v1 = acc[ai][bj][m][1] * rs * wp[1];
                    v0 = v0 + *(const f32x4*)(src + cb + bj * 128); v1 = v1 + *(const f32x4*)(src + cb + bj * 128 + 4);
                    s += (v0[0] * v0[0] + v0[1] * v0[1]) + (v0[2] * v0[2] + v0[3] * v0[3]) + (v1[0] * v1[0] + v1[1] * v1[1]) + (v1[2] * v1[2] + v1[3] * v1[3]);
                    float* o = h1f + (size_t)row * DM + cb + bj * 128; *(f32x4*)o = v0; *(f32x4*)(o + 4) = v1;
                    *(u32x4*)(h1b + (size_t)row * DM + cb + bj * 128) = pack8(v0, v1); }
                s += __shfl_xor(s, 16); s += __shfl_xor(s, 32);
                if (fq == 0 && ssq) ssq_add(ssq + row, s); }
    }
};

struct EpiPQ {
    static constexpr bool PERM = true, AFTER_DRAIN = false, SPLITK2 = false, FP8 = false;
    bf16_t* pq; const u64* ssq;
    __device__ __forceinline__ void operator()(const Acc& acc, const Unit& u, int wr, int wc, int fr, int fq) const {
        const int rowb = u.pm * 256 + wr * 64 + fr, cb = u.pn * 256 + wc * 32 + 8 * fq;
#pragma unroll
        for (int ai = 0; ai < 2; ++ai)
#pragma unroll
            for (int m = 0; m < 4; ++m) { const int row = rowb + ai * 128 + m * 16; const float rs = __builtin_amdgcn_rsqf(ssq_get(ssq + row) * (1.0f / DM) + EPS);
#pragma unroll
                for (int bj = 0; bj < 2; ++bj) *(u32x4*)(pq + (size_t)row * 2048 + cb + bj * 128) = pack8(acc[ai][bj][m][0] * rs, acc[ai][bj][m][1] * rs); }
    }
};
}
#define XB_TMO      128
#define XB_XCNT(j)  (256  + 64 * (j))
#define XB_XSUB(j)  (1280 + 64 * (j))
#define XB_XGEN(j)  (2304 + 64 * (j))
#define XB_TOP      3328
#define XB_TOPGEN   3392
#define XCD_BAR_WORDS 3456
#define XB_SPIN_CAP (1u << 18)
__device__ __forceinline__ unsigned xb_ld(unsigned* p)              { return __hip_atomic_load(p, __ATOMIC_RELAXED, __HIP_MEMORY_SCOPE_AGENT); }
__device__ __forceinline__ unsigned xb_add(unsigned* p, unsigned v) { return __hip_atomic_fetch_add(p, v, __ATOMIC_RELAXED, __HIP_MEMORY_SCOPE_AGENT); }
__device__ __forceinline__ unsigned xb_xcc_id() { return (unsigned)__builtin_amdgcn_s_getreg((3 << 11) | 20) & 0xFu; }
#define XB_SPIN(cond, bar) do { unsigned _sp = 0; while (cond) { __builtin_amdgcn_s_sleep(1); \
    if ((++_sp & 255u) == 0u) { if (xb_ld(&(bar)[XB_TMO])) break; if (_sp > XB_SPIN_CAP) { atomicAdd(&(bar)[XB_TMO], 1u); break; } } } } while (0)
struct XcdBarrier { unsigned* bar; unsigned x; volatile LAS unsigned* st; };
__device__ __forceinline__ XcdBarrier xcd_barrier_post(unsigned* bar, volatile LAS unsigned* st) {
    XcdBarrier b; b.bar = bar; b.x = xb_xcc_id(); b.st = st;
    if (threadIdx.x == 0) (void)xb_add(&bar[XB_XCNT(b.x)], 1u);
    return b;
}
__device__ __forceinline__ void xcd_barrier_complete(unsigned* bar, unsigned x, unsigned& nloc, unsigned& nx) {
    const unsigned G = gridDim.x * gridDim.y * gridDim.z;
    unsigned sum, cnt, mine, sp = 0u;
    for (;;) {
        sum = 0u; cnt = 0u; mine = 0u;
#pragma unroll
        for (unsigned j = 0; j < 16; ++j) { const unsigned c = xb_ld(&bar[XB_XCNT(j)]); sum += c; cnt += (c > 0u) ? 1u : 0u; mine = (j == x) ? c : mine; }
        if (sum == G) break;
        __builtin_amdgcn_s_sleep(1);
        if ((++sp & 255u) == 0u) { if (xb_ld(&bar[XB_TMO])) break; if (sp > XB_SPIN_CAP) { atomicAdd(&bar[XB_TMO], 1u); break; } }
    }
    nloc = mine > 0u ? mine : 1u; nx = cnt > 0u ? cnt : 1u;
}
__device__ __forceinline__ void xcd_barrier(const XcdBarrier& b) {
    asm volatile("s_waitcnt vmcnt(0)" ::: "memory");
    __syncthreads();
    if (threadIdx.x == 0) {
        unsigned* bar = b.bar;
        __builtin_amdgcn_s_waitcnt(0);
        unsigned nloc = b.st[0], nx = b.st[1];
        if (nloc == 0u) { xcd_barrier_complete(bar, b.x, nloc, nx); b.st[0] = nloc; b.st[1] = nx; }
        const unsigned old = xb_add(&bar[XB_XSUB(b.x)], 1u);
        const unsigned gen = old / nloc;
        if (old + 1u == (gen + 1u) * nloc) {
            __builtin_amdgcn_fence(__ATOMIC_RELEASE, "agent");
            asm volatile("s_waitcnt vmcnt(0)" ::: "memory");
            const unsigned og = xb_add(&bar[XB_TOP], 1u);
            const unsigned tg = og / nx;
            if (og + 1u == (tg + 1u) * nx) xb_add(&bar[XB_TOPGEN], 1u);
            else XB_SPIN(xb_ld(&bar[XB_TOPGEN]) == tg, bar);
            __builtin_amdgcn_fence(__ATOMIC_ACQUIRE, "agent");
            xb_add(&bar[XB_XGEN(b.x)], 1u);
            asm volatile("s_waitcnt vmcnt(0)" ::: "memory");
        } else {
            XB_SPIN(xb_ld(&bar[XB_XGEN(b.x)]) == gen, bar);
            __builtin_amdgcn_fence(__ATOMIC_ACQUIRE, "agent");
            asm volatile("s_waitcnt vmcnt(0)" ::: "memory");
        }
    }
    __syncthreads();
}

struct Frame {
    LAS unsigned char* lds;
    unsigned char* ws;
    unsigned* ctl;
    int tid, lane, wave, vcu, G;
    __device__ __forceinline__ const float* in(int i) const { return ((const float* const __attribute__((address_space(4)))*)__builtin_amdgcn_kernarg_segment_ptr())[i]; }
    __device__ __forceinline__ float* out() const { return ((float* const __attribute__((address_space(4)))*)__builtin_amdgcn_kernarg_segment_ptr())[16]; }
};

struct MapId { __device__ __forceinline__ int operator()(int v) const { return v; } };
struct MapIn { __device__ __forceinline__ int operator()(int vn) const {
    const int v = vn < 1280 ? vn + 4608 : (vn < 5888 ? vn - 1280 : vn);
    if (v < 1536) return v;
    if (v < 3584) { const int w = v - 1536, hd = w >> 7; int o = w & 127; if (o < 32) o = (o & 1) ? (o >> 1) + 16 : (o >> 1); return 1600 + hd * 128 + o; }
    if (v < 4096) { const int w = v - 3584, hd = w >> 7; int o = w & 127; if (o < 32) o = (o & 1) ? (o >> 1) + 16 : (o >> 1); return 3648 + hd * 128 + o; }
    if (v < 4608) return 4160 + (v - 4096);
    if (v < 5632) { const int w = v - 4608, hd = w >> 6; int o = w & 63; if (o < 16) o = (o & 1) ? (o >> 1) + 8 : (o >> 1); return 4672 + hd * 64 + o; }
    if (v < 5888) { const int w = v - 5632;
        if (w < 64) return 1536 + ((w & 1) ? (w >> 1) + 32 : (w >> 1));
        if (w < 128) { int o = w - 64; if (o < 16) o = (o & 1) ? (o >> 1) + 8 : (o >> 1); return 5696 + o; }
        if (w < 144) return 5760 + (w - 128);
        return -1; }
    if (v < 9984) return 5776 + (v - 5888);
    return 9872 + (v - 9984);
} };
struct MapUq { __device__ __forceinline__ int operator()(int v) const {
    if (v < 2048) return (v >> 7) * 192 + (v & 127);
    const int w = v - 2048, hd = w >> 6, o = w & 63; return hd * 192 + 128 + ((o & 1) ? (o >> 1) + 32 : (o >> 1)); } };
struct MapUkv { __device__ __forceinline__ int operator()(int v) const {
    if (v < 2048) return (v >> 7) * 256 + (v & 127);
    const int w = v - 2048; return (w >> 7) * 256 + 128 + (w & 127); } };

template <class Map>
__device__ __forceinline__ void p0_transpose_item(const float* W, int K, int Nsrc, int Nvirt, bf16_t* WT, const float* gk, LAS float* scr, int item, int lane, Map map) {
    const int nblk = Nvirt / 32, kb = item / nblk, nb = item % nblk, k0 = 64 * kb, n0 = 32 * nb;
    const int sc = map(n0 + (lane & 31));
    float tv[32];
#pragma unroll
    for (int i = 0; i < 32; ++i) { const int kk = 2 * i + (lane >> 5); tv[i] = (sc >= 0) ? W[(size_t)(k0 + kk) * Nsrc + sc] : 0.f; }
    if (gk) {
#pragma unroll
        for (int i = 0; i < 32; ++i) tv[i] *= gk[k0 + 2 * i + (lane >> 5)]; }
#pragma unroll
    for (int i = 0; i < 32; ++i) scr[(2 * i + (lane >> 5)) * 33 + (lane & 31)] = tv[i];
    LDS_WAIT(); asm volatile("" ::: "memory");
    const int c = lane & 7;
#pragma unroll
    for (int j = 0; j < 4; ++j) { const int n = (lane >> 3) + 8 * j; const LAS float* s = scr + (8 * c) * 33 + n;
        u32x4 o; o.x = pk2(s[0 * 33], s[1 * 33]); o.y = pk2(s[2 * 33], s[3 * 33]); o.z = pk2(s[4 * 33], s[5 * 33]); o.w = pk2(s[6 * 33], s[7 * 33]);
        *(u32x4*)(WT + (size_t)(n0 + n) * K + k0 + 8 * c) = o; }
    LDS_WAIT(); asm volatile("" ::: "memory");
}
__device__ __forceinline__ float wave_max(float v) {
#pragma unroll
    for (int o = 1; o < 64; o <<= 1) v = fmaxf(v, __shfl_xor(v, o));
    return v;
}
__device__ __forceinline__ void p0_xn_row(const Frame& F, int m) {
    const float* x = F.in(0); const float* meta = F.in(1); const float* g = F.in(2);
    bf16_t* o = (bf16_t*)(F.ws + WS_XN) + (size_t)m * DM;
    u32x2* o8 = (u32x2*)o + F.lane;
    if (m >= NTOK + NMETA) {
        unsigned* z8 = (unsigned*)(F.ws + WS_XN8 + (size_t)m * DM) + F.lane;
#pragma unroll
        for (int j = 0; j < 16; ++j) { o8[64 * j] = (u32x2){0u, 0u}; z8[64 * j] = 0u; }
        if (F.lane == 0) ((float*)(F.ws + WS_SX))[m] = 0.f;
        return; }
    const float* src = m < NTOK ? x + (size_t)m * DM : meta + (size_t)(m - NTOK) * DM;
    const f32x4* xr = (const f32x4*)src + F.lane; const f32x4* gr = (const f32x4*)g + F.lane;
    f32x4 v[16]; float s = 0.f;
#pragma unroll
    for (int j = 0; j < 16; ++j) { v[j] = xr[64 * j]; s += (v[j][0] * v[j][0] + v[j][1] * v[j][1]) + (v[j][2] * v[j][2] + v[j][3] * v[j][3]); }
    const float rstd = 1.0f / sqrtf(wave_sum(s) * (1.0f / DM) + EPS);
    float mx = 0.f;
#pragma unroll
    for (int j = 0; j < 16; ++j) { const f32x4 gg = gr[64 * j]; v[j] = v[j] * rstd * gg; o8[64 * j] = (u32x2){pk2(v[j][0], v[j][1]), pk2(v[j][2], v[j][3])};
        mx = fmaxf(mx, fmaxf(fmaxf(fabsf(v[j][0]), fabsf(v[j][1])), fmaxf(fabsf(v[j][2]), fabsf(v[j][3])))); }
    mx = fmaxf(wave_max(mx), 1e-30f);
    const float inv = 448.0f / mx;
    if (F.lane == 0) ((float*)(F.ws + WS_SX))[m] = mx * (1.0f / 448.0f);
    unsigned* q8 = (unsigned*)(F.ws + WS_XN8 + (size_t)m * DM) + F.lane;
#pragma unroll
    for (int j = 0; j < 16; ++j) { f32x4 q = v[j] * inv;
#pragma unroll
        for (int e = 0; e < 4; ++e) q[e] = fminf(fmaxf(q[e], -448.0f), 448.0f);
        int p = 0; p = __builtin_amdgcn_cvt_pk_fp8_f32(q[0], q[1], p, false); p = __builtin_amdgcn_cvt_pk_fp8_f32(q[2], q[3], p, true); q8[64 * j] = (unsigned)p; }
}
__device__ __forceinline__ void p0_prologue(const Frame& F) {
    LAS float* scr = (LAS float*)(F.lds + F.wave * 16384);
    const int gw = F.vcu * NWAVES + F.wave, NGW = F.G * NWAVES;
    const float* w_in = F.in(3); const float* qg = F.in(4); const float* w_uq = F.in(5); const float* kvg = F.in(6); const float* w_ukv = F.in(7);
    const float* w_br = F.in(8); const float* w_out = F.in(9); const float* fg = F.in(10); const float* w_q = F.in(11); const float* sk = F.in(12);
    constexpr int I_IN = 64 * (NV1 / 32), I_UQ = 16 * (3072 / 32), I_UKV = 8 * (4096 / 32), I_BR = 64 * 128, I_OUT = 64 * 128, I_Q = 64 * 64;
    constexpr int NITEMS = I_IN + I_UQ + I_UKV + I_BR + I_OUT + I_Q;
    for (int it = gw; it < NITEMS; it += NGW) {
        int r = it;
        if (r < I_IN) { p0_transpose_item(w_in, 4096, 13968, NV1, (bf16_t*)(F.ws + WS_WIN), nullptr, scr, r, F.lane, MapIn()); continue; } r -= I_IN;
        if (r < I_UQ) { p0_transpose_item(w_uq, 1024, 3072, 3072, (bf16_t*)(F.ws + WS_WUQ), qg, scr, r, F.lane, MapUq()); continue; } r -= I_UQ;
        if (r < I_UKV) { p0_transpose_item(w_ukv, 512, 4096, 4096, (bf16_t*)(F.ws + WS_WUKV), kvg, scr, r, F.lane, MapUkv()); continue; } r -= I_UKV;
        if (r < I_BR) { p0_transpose_item(w_br, 4096, 4096, 4096, (bf16_t*)(F.ws + WS_WBR), nullptr, scr, r, F.lane, MapId()); continue; } r -= I_BR;
        if (r < I_OUT) { p0_transpose_item(w_out, 4096, 4096, 4096, (bf16_t*)(F.ws + WS_WOUT), nullptr, scr, r, F.lane, MapId()); continue; } r -= I_OUT;
        p0_transpose_item(w_q, 4096, 2048, 2048, (bf16_t*)(F.ws + WS_WQ), fg, scr, r, F.lane, MapId());
    }
    for (int m = gw; m < MK; m += NGW) p0_xn_row(F, m);
    const int gt = (F.vcu * NWAVES + F.wave) * 64 + F.lane, NGT = NGW * 64;
    for (int i = gt; i < TP * 56; i += NGT) {
        const int t = i / 56, r = i % 56; int j, rot; float* dst;
        if (r < 32) { j = r; rot = 64; dst = (float*)(F.ws + WS_ROPE_M) + ((size_t)t * 32 + j) * 2; }
        else if (r < 48) { j = r - 32; rot = 32; dst = (float*)(F.ws + WS_ROPE_D) + ((size_t)t * 16 + j) * 2; }
        else { j = r - 48; rot = 16; dst = (float*)(F.ws + WS_ROPE_I) + ((size_t)t * 8 + j) * 2; }
        const float ex = (float)(2 * j) / (float)rot;
        const float inv = powf(500000.0f, -ex);
        const float ang = (float)t * inv;
        const double a = (double)ang, kq = rint(a * 0.15915494309189535), rr = fma(-kq, 6.283185307179586, a);
        const float rf = (float)rr;
        dst[0] = cosf(rf); dst[1] = sinf(rf);
    }
    for (int i = gt; i < 16 * 128 * 128 / 8; i += NGT) { const f32x4* s = (const f32x4*)sk + 2 * (size_t)i; const f32x4 a = s[0], b2 = s[1];
        u32x4 o; o.x = pk2(a[0], a[1]); o.y = pk2(a[2], a[3]); o.z = pk2(b2[0], b2[1]); o.w = pk2(b2[2], b2[3]); ((u32x4*)(F.ws + WS_SK))[i] = o; }
}
__device__ __forceinline__ unsigned fp6_code(float q) {
    const unsigned b = __float_as_uint(q), sgn = (b >> 31) << 5; const float aq = fabsf(q);
    const unsigned sub = (unsigned)rintf(aq * 8.0f);
    unsigned ab = b & 0x7fffffffu; ab = ab + 0x7FFFFu + ((ab >> 20) & 1u);
    const unsigned nrm = (ab >> 20) - (126u << 3);
    unsigned code = aq < 1.0f ? sub : nrm; code = code > 31u ? 31u : code;
    return code | sgn;
}
__device__ __forceinline__ void fp6_pack32(const unsigned (&c)[32], unsigned (&w)[6]) {
#pragma unroll
    for (int i = 0; i < 6; ++i) w[i] = 0u;
#pragma unroll
    for (int k = 0; k < 32; ++k) { const int bit = 6 * k, d = bit >> 5, sh = bit & 31; w[d] |= c[k] << sh; if (sh > 26) w[d + 1] |= c[k] >> (32 - sh); }
}
__device__ __forceinline__ void p6_quant_row(const float* src, const float* gain, unsigned char* dst, float* scale_out, int lane) {
    const f32x4* s = (const f32x4*)src + lane; f32x4 v[16]; float mx = 0.f;
#pragma unroll
    for (int j = 0; j < 16; ++j) { v[j] = s[64 * j]; if (gain) v[j] = v[j] * ((const f32x4*)gain)[lane + 64 * j];
        mx = fmaxf(mx, fmaxf(fmaxf(fabsf(v[j][0]), fabsf(v[j][1])), fmaxf(fabsf(v[j][2]), fabsf(v[j][3])))); }
    mx = fmaxf(wave_max(mx), 1e-30f);
    const float sc = mx * (1.0f / 7.5f), inv = 7.5f / mx;
    if (lane == 0) *scale_out = sc;
    unsigned w[12];
#pragma unroll
    for (int g = 0; g < 2; ++g) { unsigned c[32];
#pragma unroll
        for (int j = 0; j < 8; ++j)
#pragma unroll
            for (int i = 0; i < 4; ++i) c[4 * j + i] = fp6_code(v[8 * g + j][i] * inv);
        unsigned ww[6]; fp6_pack32(c, ww);
#pragma unroll
        for (int i = 0; i < 6; ++i) w[6 * g + i] = ww[i]; }
#pragma unroll
    for (int q = 0; q < 3; ++q) *(u32x4*)(dst + 1024 * q + 16 * lane) = (u32x4){w[4 * q], w[4 * q + 1], w[4 * q + 2], w[4 * q + 3]};
}
__device__ __forceinline__ unsigned fp4_code(float q) {
    const float aq = fabsf(q);
    const unsigned c = (aq > 0.25f ? 1u : 0u) + (aq >= 0.75f ? 1u : 0u) + (aq > 1.25f ? 1u : 0u) + (aq >= 1.75f ? 1u : 0u) + (aq > 2.5f ? 1u : 0u) + (aq >= 3.5f ? 1u : 0u) + (aq > 5.0f ? 1u : 0u);
    return c | ((__float_as_uint(q) >> 31) << 3);
}
__device__ __forceinline__ void p6_quant_row4(const float* src, const float* gain, unsigned char* dst, float* scale_out, int lane) {
    const f32x4* s = (const f32x4*)src + lane; f32x4 v[16]; float mx = 0.f;
#pragma unroll
    for (int j = 0; j < 16; ++j) { v[j] = s[64 * j]; if (gain) v[j] = v[j] * ((const f32x4*)gain)[lane + 64 * j];
        mx = fmaxf(mx, fmaxf(fmaxf(fabsf(v[j][0]), fabsf(v[j][1])), fmaxf(fabsf(v[j][2]), fabsf(v[j][3])))); }
    mx = fmaxf(wave_max(mx), 1e-30f);
    const float sc = mx * (1.0f / 6.0f), inv = 6.0f / mx;
    if (lane == 0) *scale_out = sc;
    unsigned w[8];
#pragma unroll
    for (int d = 0; d < 8; ++d) { unsigned x = 0u;
#pragma unroll
        for (int i = 0; i < 4; ++i) { x |= fp4_code(v[2 * d][i] * inv) << (4 * i); x |= fp4_code(v[2 * d + 1][i] * inv) << (16 + 4 * i); }
        w[d] = x; }
#pragma unroll
    for (int q = 0; q < 2; ++q) *(u32x4*)(dst + 1024 * q + 16 * lane) = (u32x4){w[4 * q], w[4 * q + 1], w[4 * q + 2], w[4 * q + 3]};
}
#ifndef PEER_U_BITS
#define PEER_U_BITS 4
#endif
#ifndef PEER_V_BITS
#define PEER_V_BITS 4
#endif
constexpr int PEER_U_ROWB = PEER_U_BITS == 4 ? 2048 : 3072, PEER_V_ROWB = PEER_V_BITS == 4 ? 2048 : 3072;
__device__ __forceinline__ void p6_tables(const Frame& F) {
    const float* fg = F.in(10); const float* pu = F.in(13); const float* pv = F.in(14);
    const int gw = F.vcu * NWAVES + F.wave, NGW = F.G * NWAVES;
    for (int it = gw; it < 2 * 16384; it += NGW) { const int e = it >> 1;
        if (it & 1) { if (PEER_V_BITS == 4) p6_quant_row4(pv + (size_t)e * DM, nullptr, F.ws + WS_V + (size_t)e * PEER_V_ROWB, (float*)(F.ws + WS_SCV) + e, F.lane);
                      else p6_quant_row(pv + (size_t)e * DM, nullptr, F.ws + WS_V + (size_t)e * PEER_V_ROWB, (float*)(F.ws + WS_SCV) + e, F.lane); }
        else { if (PEER_U_BITS == 4) p6_quant_row4(pu + (size_t)e * DM, fg, F.ws + WS_U + (size_t)e * PEER_U_ROWB, (float*)(F.ws + WS_SCU) + e, F.lane);
               else p6_quant_row(pu + (size_t)e * DM, fg, F.ws + WS_U + (size_t)e * PEER_U_ROWB, (float*)(F.ws + WS_SCU) + e, F.lane); } }
}

__device__ __forceinline__ void rowquant_fp8(const Frame& F, const unsigned char* src, size_t src_pitch, unsigned char* dst, size_t dst_pitch, float* scale, int nrows) {
    const int gw = F.vcu * NWAVES + F.wave, NGW = F.G * NWAVES, lane = F.lane;
    for (int n = gw; n < nrows; n += NGW) {
        const u32x4* s = (const u32x4*)(src + (size_t)n * src_pitch) + lane;
        u32x4 v[8]; float mx = 0.f;
#pragma unroll
        for (int j = 0; j < 8; ++j) { v[j] = s[64 * j];
#pragma unroll
            for (int e = 0; e < 4; ++e) mx = fmaxf(mx, fmaxf(fabsf(bf_lo(v[j][e])), fabsf(bf_hi(v[j][e])))); }
        mx = fmaxf(wave_max(mx), 1e-30f);
        const float inv = 448.0f / mx;
        if (lane == 0) scale[n] = mx * (1.0f / 448.0f);
        asm volatile("" ::: "memory");
        u32x2* d = (u32x2*)(dst + (size_t)n * dst_pitch) + lane;
#pragma unroll
        for (int j = 0; j < 8; ++j) { int p0 = 0, p1 = 0;
            p0 = __builtin_amdgcn_cvt_pk_fp8_f32(bf_lo(v[j].x) * inv, bf_hi(v[j].x) * inv, p0, false); p0 = __builtin_amdgcn_cvt_pk_fp8_f32(bf_lo(v[j].y) * inv, bf_hi(v[j].y) * inv, p0, true);
            p1 = __builtin_amdgcn_cvt_pk_fp8_f32(bf_lo(v[j].z) * inv, bf_hi(v[j].z) * inv, p1, false); p1 = __builtin_amdgcn_cvt_pk_fp8_f32(bf_lo(v[j].w) * inv, bf_hi(v[j].w) * inv, p1, true);
            d[64 * j] = (u32x2){(unsigned)p0, (unsigned)p1}; }
    }
}
__device__ __forceinline__ void p1_quant_weights(const Frame& F) {
    rowquant_fp8(F, F.ws + WS_WIN + (size_t)1280 * DM * 2, (size_t)DM * 2, F.ws + WS_WG8, (size_t)DM, (float*)(F.ws + WS_SW), 12800);
    rowquant_fp8(F, F.ws + WS_WBR, (size_t)DM * 2, F.ws + WS_WBR, (size_t)DM * 2, (float*)(F.ws + WS_SWBR), 4096);
    rowquant_fp8(F, F.ws + WS_WOUT, (size_t)DM * 2, F.ws + WS_WOUT, (size_t)DM * 2, (float*)(F.ws + WS_SWOUT), 4096);
}
#define MFMA32(a, b, c) __builtin_amdgcn_mfma_f32_32x32x16_bf16((a), (b), (c), 0, 0, 0)
__device__ __forceinline__ int crow(int i, int h) { return (i & 3) + 8 * (i >> 2) + 4 * h; }
__device__ __forceinline__ float half_sum_f(float v) {
#pragma unroll
    for (int o = 1; o < 32; o <<= 1) v += __shfl_xor(v, o);
    return v;
}
__device__ __forceinline__ int half_sum_i(int v) {
#pragma unroll
    for (int o = 1; o < 32; o <<= 1) v += __shfl_xor(v, o);
    return v;
}
__device__ __forceinline__ float half_max_f(float v) {
#pragma unroll
    for (int o = 1; o < 32; o <<= 1) v = fmaxf(v, __shfl_xor(v, o));
    return v;
}
__device__ __forceinline__ float half_min_f(float v) {
#pragma unroll
    for (int o = 1; o < 32; o <<= 1) v = fminf(v, __shfl_xor(v, o));
    return v;
}
__device__ __forceinline__ void idx_task(const Frame& F, int b, int s0) {
    const int lane = F.lane, r = lane & 31, h = lane >> 5;
    const bf16_t* qix = (const bf16_t*)(F.ws + WS_QIX); const bf16_t* kix = (const bf16_t*)(F.ws + WS_KIX); const float* wix = (const float*)(F.ws + WS_WIX);
    unsigned* mask = (unsigned*)(F.ws + WS_MASK);
    const int tok = (r >> 2) & 1, head = (r & 3) + 4 * (r >> 3);
    const bf16_t* qp = qix + (size_t)(b * SEQ + s0 + tok) * 1024 + head * 64 + 8 * h;
    bf16x8 af[4];
#pragma unroll
    for (int ks = 0; ks < 4; ++ks) af[ks] = *(const bf16x8*)(qp + 16 * ks);
    const f32x4* wp = (const f32x4*)(wix + (size_t)(b * SEQ + s0 + h) * 16);
    float w[16];
#pragma unroll
    for (int q = 0; q < 4; ++q) { const f32x4 x = wp[q]; w[4 * q] = x[0]; w[4 * q + 1] = x[1]; w[4 * q + 2] = x[2]; w[4 * q + 3] = x[3]; }
    const int tq = NMETA + s0 + h;
    const int ngrp = ((NMETA + s0 + 1) >> 6) + 1;
    int brow = b * SEQ - NMETA; asm volatile("" : "+s"(brow));
    const bf16_t* kbase = kix + ((long)brow + r) * 64 + 8 * h;
    float row[MW];
    const bf16_t* kcur = kbase;
#pragma unroll
    for (int g = 0; g < MW / 2; ++g) {
        float s0v = -INFINITY, s1v = -INFINITY;
        if (g < ngrp) {
            const bf16_t* kp0 = kcur; const bf16_t* kp1 = kcur + 32 * 64;
            if (g == 0 && r < NMETA) kp0 = kix + (size_t)(NTOK + r) * 64 + 8 * h;
            bf16x8 b0[4], b1[4];
#pragma unroll
            for (int ks = 0; ks < 4; ++ks) { b0[ks] = *(const bf16x8*)(kp0 + 16 * ks); b1[ks] = *(const bf16x8*)(kp1 + 16 * ks); }
            float x0 = 0.f, x1 = 0.f;
            { f32x16 a0;
#pragma unroll
              for (int i = 0; i < 16; ++i) a0[i] = 0.f;
#pragma unroll
              for (int ks = 0; ks < 4; ++ks) a0 = MFMA32(af[ks], b0[ks], a0);
#pragma unroll
              for (int i = 0; i < 16; ++i) x0 += w[i] * fmaxf(a0[i], 0.f); }
            { f32x16 a1;
#pragma unroll
              for (int i = 0; i < 16; ++i) a1[i] = 0.f;
#pragma unroll
              for (int ks = 0; ks < 4; ++ks) a1 = MFMA32(af[ks], b1[ks], a1);
#pragma unroll
              for (int i = 0; i < 16; ++i) x1 += w[i] * fmaxf(a1[i], 0.f); }
            s0v = (g * 64 + r <= tq) ? x0 : -INFINITY; s1v = (g * 64 + 32 + r <= tq) ? x1 : -INFINITY;
        }
        row[2 * g] = s0v; row[2 * g + 1] = s1v;
        kcur += 64 * 64; asm volatile("" : "+v"(kcur));
    }
    float tau = -3.0e38f;
    bool done = (tq + 1 <= 256);
    float mx = -INFINITY, mn = INFINITY;
#pragma unroll
    for (int k = 0; k < MW; ++k) { const float v = row[k]; mx = fmaxf(mx, v); mn = fminf(mn, v > -INFINITY ? v : INFINITY); }
    float lo = half_min_f(mn), hi = half_max_f(mx);
    if (!done) tau = hi;
    for (int it = 0; it < 64; ++it) {
        if (!__any(!done)) break;
        const float mid = lo + (hi - lo) * 0.5f;
        int c = 0;
#pragma unroll
        for (int k = 0; k < MW; ++k) c += (row[k] >= mid) ? 1 : 0;
        c = half_sum_i(c);
        if (!done) {
            if (!(mid > lo && mid < hi)) { tau = hi; done = true; }
            else if (c == 256) { tau = mid; done = true; }
            else if (c > 256) lo = mid;
            else { hi = mid; tau = hi; }
        }
    }
    unsigned* mrow = mask + (size_t)(b * SEQ + s0 + h) * MW;
    unsigned mw = 0u;
#pragma unroll
    for (int k = 0; k < MW; ++k) {
        const unsigned long long bal = __ballot(row[k] >= tau);
        const unsigned wd = h ? (unsigned)(bal >> 32) : (unsigned)bal;
        if ((k & 31) == r) mw = wd;
        if ((k & 31) == 31 || k == MW - 1) { const int kk = (k & ~31) + r; if (kk < MW) mrow[kk] = mw; }
    }
}
__device__ __forceinline__ void p2_indexer(const Frame& F, int qslot) {
    volatile LAS unsigned* qw = (volatile LAS unsigned*)(F.lds + LDSCTL_OFF + 16);
    constexpr int NCH = NTOK / 16;
    for (;;) {
        if (F.tid == 0) qw[0] = atomicAdd(F.ctl + CW_QUEUE + 64 * qslot, 1u);
        __syncthreads();
        const int c = (int)qw[0];
        __syncthreads();
        if (c >= NCH) break;
        const int b = c & 3, tblk = (SEQ / 16 - 1) - (c >> 2);
        idx_task(F, b, tblk * 16 + 2 * F.wave);
    }
}
template <bool MLA> struct AttnCfg {
    static constexpr int DQK = MLA ? 192 : 128, PK = DQK * 2 + 16, PV = 320, KCH = DQK / 8, NKC = 64 * KCH / 512, KBYTES = 64 * PK, BUFB = 64 * PK + 64 * PV;
};
struct AttnUnit { int type, b, hx, blk; };

template <bool MLA>
__device__ __forceinline__ void attn_unit(const Frame& F, const AttnUnit u) {
    typedef AttnCfg<MLA> C;
    const int tid = F.tid, lane = F.lane, wave = F.wave, r = lane & 31, h = lane >> 5;
    LAS unsigned char* lds = F.lds;
    const bf16_t* qn = (const bf16_t*)(F.ws + WS_QN); const bf16_t* qr = (const bf16_t*)(F.ws + WS_QR); const bf16_t* kn = (const bf16_t*)(F.ws + WS_KN);
    const bf16_t* va = (const bf16_t*)(F.ws + WS_VA); const bf16_t* kpe = (const bf16_t*)(F.ws + WS_KPE);
    const bf16_t* qb = (const bf16_t*)(F.ws + WS_QB); const bf16_t* kb = (const bf16_t*)(F.ws + WS_KB); const bf16_t* vb = (const bf16_t*)(F.ws + WS_VB);
    const unsigned* mask = (const unsigned*)(F.ws + WS_MASK); bf16_t* oab = (bf16_t*)(F.ws + WS_OAB);
    const int b = u.b;
    const size_t rowb = (size_t)b * SEQ;
    int head, tw0, ntiles;
    if (MLA) { head = u.hx; tw0 = u.blk * 256 + 32 * wave; ntiles = (NMETA + u.blk * 256 + 255) / 64 + 1; }
    else { head = 4 * u.hx + (wave & 3); tw0 = u.blk * 64 + 32 * (wave >> 2); ntiles = (NMETA + u.blk * 64 + 63) / 64 + 1; }
    const int pw0 = NMETA + tw0;
    const int tq = pw0 + r;
    bf16x8 qf[C::DQK / 16];
    if (MLA) {
        const bf16_t* p0 = qn + (rowb + tw0 + r) * 2048 + head * 128 + 8 * h; const bf16_t* p1 = qr + (rowb + tw0 + r) * 1024 + head * 64 + 8 * h;
#pragma unroll
        for (int ks = 0; ks < 8; ++ks) qf[ks] = *(const bf16x8*)(p0 + 16 * ks);
#pragma unroll
        for (int ks = 0; ks < 4; ++ks) qf[8 + ks] = *(const bf16x8*)(p1 + 16 * ks);
    } else {
        const bf16_t* p0 = qb + (rowb + tw0 + r) * 2048 + head * 128 + 8 * h;
#pragma unroll
        for (int ks = 0; ks < 8; ++ks) qf[ks] = *(const bf16x8*)(p0 + 16 * ks);
    }
    const int ldkv = MLA ? 2048 : 512;
    const bf16_t* ktab = MLA ? kn + head * 128 : kb + u.hx * 128;
    const bf16_t* vtab = MLA ? va + head * 128 : vb + u.hx * 128;
    const bf16_t* kbase = ktab + (rowb - NMETA) * ldkv;
    const bf16_t* vbase = vtab + (rowb - NMETA) * ldkv;
    const bf16_t* pbase = kpe + (rowb - NMETA) * 64;
    unsigned soff[2]; int kdst[2], vdst[2];
#pragma unroll
    for (int i = 0; i < 2; ++i) { const int c = tid + 512 * i, key = c >> 4, pc = c & 15; soff[i] = (unsigned)(key * ldkv + pc * 8); kdst[i] = key * C::PK + pc * 16; vdst[i] = C::KBYTES + key * C::PV + pc * 16; }
    const unsigned poff = (unsigned)((tid >> 3) * 64 + (tid & 7) * 8); const int pdst = (tid >> 3) * C::PK + 256 + (tid & 7) * 16;
    u32x4 kst[2], vst[2], pst = (u32x4){0u, 0u, 0u, 0u};
    {
        const int key0 = tid >> 4;
        const size_t o0 = key0 < NMETA ? (size_t)(NTOK + key0) * ldkv + (tid & 15) * 8 : (rowb - NMETA) * ldkv + soff[0];
        kst[0] = *(const u32x4*)(ktab + o0); vst[0] = *(const u32x4*)(vtab + o0);
        kst[1] = *(const u32x4*)(kbase + soff[1]); vst[1] = *(const u32x4*)(vbase + soff[1]);
        if (MLA) { const int keyp = tid >> 3; pst = *(const u32x4*)(keyp < NMETA ? kpe + (size_t)(NTOK + keyp) * 64 + (tid & 7) * 8 : pbase + poff); }
    }
#pragma unroll
    for (int i = 0; i < 2; ++i) { *(LAS u32x4*)(lds + kdst[i]) = kst[i]; *(LAS u32x4*)(lds + vdst[i]) = vst[i]; }
    if (MLA) *(LAS u32x4*)(lds + pdst) = pst;
    __syncthreads();
    f32x16 oacc[4];
#pragma unroll
    for (int d = 0; d < 4; ++d)
#pragma unroll
        for (int i = 0; i < 16; ++i) oacc[d][i] = 0.f;
    float mrun = -INFINITY, lrun = 0.f;
    const int koff = r * C::PK + 16 * h;
    const int voff = C::KBYTES + (4 * h + ((lane & 15) >> 2)) * C::PV + (16 * ((lane >> 4) & 1) + 4 * (lane & 3)) * 2;
    const unsigned* mrow = mask + (rowb + tw0 + r) * MW;
    for (int kt = 0; kt < ntiles; ++kt) {
        const int cur = (kt & 1) * C::BUFB, nxt = ((kt + 1) & 1) * C::BUFB;
        const bool more = kt + 1 < ntiles;
        if (more) {
            const bf16_t* kb2 = kbase + (size_t)(kt + 1) * 64 * ldkv; const bf16_t* vb2 = vbase + (size_t)(kt + 1) * 64 * ldkv;
#pragma unroll
            for (int i = 0; i < 2; ++i) { kst[i] = *(const u32x4*)(kb2 + soff[i]); vst[i] = *(const u32x4*)(vb2 + soff[i]); }
            if (MLA) pst = *(const u32x4*)(pbase + (size_t)(kt + 1) * 64 * 64 + poff);
        }
        if (kt * 64 <= pw0 + 31) {
            u32x2 mwd = (u32x2){0u, 0u};
            if (!MLA) mwd = *(const u32x2*)(mrow + 2 * kt);
            f32x16 s0, s1;
#pragma unroll
            for (int i = 0; i < 16; ++i) { s0[i] = 0.f; s1[i] = 0.f; }
#pragma unroll
            for (int ks = 0; ks < C::DQK / 16; ++ks) {
                const bf16x8 k0 = *(const LAS bf16x8*)(lds + cur + koff + 32 * ks), k1 = *(const LAS bf16x8*)(lds + cur + koff + 32 * C::PK + 32 * ks);
                s0 = MFMA32(k0, qf[ks], s0); s1 = MFMA32(k1, qf[ks], s1);
            }
            if (MLA) {
                if (kt * 64 + 63 > pw0) {
                    const int kb0 = kt * 64 + 4 * h;
#pragma unroll
                    for (int i = 0; i < 16; ++i) { const int key = kb0 + (i & 3) + 8 * (i >> 2); if (key > tq) s0[i] = -INFINITY; if (key + 32 > tq) s1[i] = -INFINITY; }
                }
            } else {
                const unsigned m0 = mwd.x >> (4 * h), m1 = mwd.y >> (4 * h);
#pragma unroll
                for (int i = 0; i < 16; ++i) { const int bit = (i & 3) + 8 * (i >> 2); if (!((m0 >> bit) & 1u)) s0[i] = -INFINITY; if (!((m1 >> bit) & 1u)) s1[i] = -INFINITY; }
            }
            float mx = s0[0];
#pragma unroll
            for (int i = 1; i < 16; ++i) mx = fmaxf(mx, s0[i]);
#pragma unroll
            for (int i = 0; i < 16; ++i) mx = fmaxf(mx, s1[i]);
            mx = fmaxf(mx, __shfl_xor(mx, 32));
            const float mnew = fmaxf(mrun, mx);
            const float msafe = (mnew == -INFINITY) ? 0.f : mnew;
            const float alpha = __builtin_amdgcn_exp2f(mrun - msafe);
            mrun = mnew;
            float ps = 0.f;
#pragma unroll
            for (int i = 0; i < 16; ++i) { s0[i] = __builtin_amdgcn_exp2f(s0[i] - msafe); s1[i] = __builtin_amdgcn_exp2f(s1[i] - msafe); ps += s0[i] + s1[i]; }
            lrun = lrun * alpha + ps;
#pragma unroll
            for (int d = 0; d < 4; ++d)
#pragma unroll
                for (int i = 0; i < 16; ++i) oacc[d][i] *= alpha;
            bf16x8 pf[4];
            { u32x4 w;
              w.x = cvt_pk_bf16(s0[0], s0[1]); w.y = cvt_pk_bf16(s0[2], s0[3]); w.z = cvt_pk_bf16(s0[4], s0[5]); w.w = cvt_pk_bf16(s0[6], s0[7]); pf[0] = __builtin_bit_cast(bf16x8, w);
              w.x = cvt_pk_bf16(s0[8], s0[9]); w.y = cvt_pk_bf16(s0[10], s0[11]); w.z = cvt_pk_bf16(s0[12], s0[13]); w.w = cvt_pk_bf16(s0[14], s0[15]); pf[1] = __builtin_bit_cast(bf16x8, w);
              w.x = cvt_pk_bf16(s1[0], s1[1]); w.y = cvt_pk_bf16(s1[2], s1[3]); w.z = cvt_pk_bf16(s1[4], s1[5]); w.w = cvt_pk_bf16(s1[6], s1[7]); pf[2] = __builtin_bit_cast(bf16x8, w);
              w.x = cvt_pk_bf16(s1[8], s1[9]); w.y = cvt_pk_bf16(s1[10], s1[11]); w.z = cvt_pk_bf16(s1[12], s1[13]); w.w = cvt_pk_bf16(s1[14], s1[15]); pf[3] = __builtin_bit_cast(bf16x8, w); }
#pragma unroll
            for (int d = 0; d < 4; ++d)
#pragma unroll
                for (int kk = 0; kk < 4; ++kk) {
                    const s16x4 lo = __builtin_amdgcn_ds_read_tr16_b64_v4i16((LAS s16x4*)(lds + cur + voff + (16 * kk) * C::PV + 64 * d));
                    const s16x4 hi = __builtin_amdgcn_ds_read_tr16_b64_v4i16((LAS s16x4*)(lds + cur + voff + (16 * kk + 8) * C::PV + 64 * d));
                    const bf16x8 vf = __builtin_shufflevector(lo, hi, 0, 1, 2, 3, 4, 5, 6, 7);
                    oacc[d] = MFMA32(vf, pf[kk], oacc[d]);
                }
        }
        if (more) {
#pragma unroll
            for (int i = 0; i < 2; ++i) { *(LAS u32x4*)(lds + nxt + kdst[i]) = kst[i]; *(LAS u32x4*)(lds + nxt + vdst[i]) = vst[i]; }
            if (MLA) *(LAS u32x4*)(lds + nxt + pdst) = pst;
        }
        __syncthreads();
    }
    {
        const float lt = lrun + __shfl_xor(lrun, 32);
        const float inv = lt > 0.f ? 1.0f / lt : 0.f;
        bf16_t* op = oab + (rowb + tw0 + r) * 4096 + (MLA ? 0 : 2048) + head * 128 + 4 * h;
#pragma unroll
        for (int d = 0; d < 4; ++d)
#pragma unroll
            for (int g = 0; g < 4; ++g) { u32x2 w; w.x = cvt_pk_bf16(oacc[d][4 * g] * inv, oacc[d][4 * g + 1] * inv); w.y = cvt_pk_bf16(oacc[d][4 * g + 2] * inv, oacc[d][4 * g + 3] * inv);
                *(u32x2*)(op + 32 * d + 8 * g) = w; }
    }
}

constexpr int ATT_NUNITS = 16 * 64 + 64 * 16;
__device__ __forceinline__ void att_decode(int idx, AttnUnit& u) {
    int rem = idx;
    for (int L = 65; L >= 2; --L) {
        const int nm = (L >= 5 && ((L - 5) & 3) == 0) ? 64 : 0;
        if (rem < nm) { u.type = 0; u.blk = (L - 5) >> 2; u.b = rem & 3; u.hx = rem >> 2; return; }
        rem -= nm;
        if (rem < 16) { u.type = 1; u.blk = L - 2; u.b = rem & 3; u.hx = rem >> 2; return; }
        rem -= 16;
    }
    u.type = -1; u.blk = 0; u.b = 0; u.hx = 0;
}
__device__ __forceinline__ void p3_attention(const Frame& F, int qslot) {
#ifdef MK_SKIP_ATT
    {
        const u32x4* qn = (const u32x4*)(F.ws + WS_QN); const u32x4* qb = (const u32x4*)(F.ws + WS_QB); u32x4* o = (u32x4*)(F.ws + WS_OAB);
        const size_t gt = (size_t)(F.vcu * NWAVES + F.wave) * 64 + F.lane, NGT = (size_t)F.G * NWAVES * 64;
        for (size_t i = gt; i < (size_t)NTOK * 256; i += NGT) { const size_t row = i >> 8, c = i & 255; o[row * 512 + c] = qn[row * 256 + c]; o[row * 512 + 256 + c] = qb[row * 256 + c]; }
        return;
    }
#endif
    volatile LAS int* qw = (volatile LAS int*)(F.lds + LDSCTL_OFF + 32);
    for (;;) {
        if (F.tid == 0) { const int idx = (int)atomicAdd(F.ctl + CW_QUEUE + 64 * qslot, 1u); AttnUnit u; u.type = -1; u.b = 0; u.hx = 0; u.blk = 0; if (idx < ATT_NUNITS) att_decode(idx, u);
            qw[0] = u.type; qw[1] = u.b; qw[2] = u.hx; qw[3] = u.blk; }
        __syncthreads();
        AttnUnit u; u.type = qw[0]; u.b = qw[1]; u.hx = qw[2]; u.blk = qw[3];
        __syncthreads();
        if (u.type < 0) break;
        if (u.type == 0) attn_unit<true>(F, u); else attn_unit<false>(F, u);
    }
}
__device__ __forceinline__ float pk_idx(float v, int n) { return __uint_as_float((__float_as_uint(v) & ~127u) | (unsigned)n); }
__device__ __forceinline__ void route_task(const Frame& F, int tb, int hd) {
    const int lane = F.lane, r = lane & 31, h = lane >> 5;
    const bf16_t* pq = (const bf16_t*)(F.ws + WS_PQ); const bf16_t* skb = (const bf16_t*)(F.ws + WS_SK);
    int* eid = (int*)(F.ws + WS_EID); float* gate = (float*)(F.ws + WS_GATE);
    LAS float* wl = (LAS float*)(F.lds + F.wave * 16384);
    const int m = tb * 32 + r;
#pragma unroll 1
    for (int c = 0; c < 2; ++c) {
        const bf16_t* qp = pq + (size_t)m * 2048 + hd * 256 + c * 128 + 8 * h;
        bf16x8 qf[8];
#pragma unroll
        for (int ks = 0; ks < 8; ++ks) qf[ks] = *(const bf16x8*)(qp + 16 * ks);
        float v[64];
#pragma unroll
        for (int blk = 0; blk < 4; ++blk) {
            const bf16_t* sp = skb + (size_t)((hd * 2 + c) * 128 + 32 * blk + r) * 128 + 8 * h;
            f32x16 acc;
#pragma unroll
            for (int i = 0; i < 16; ++i) acc[i] = 0.f;
#pragma unroll
            for (int ks = 0; ks < 8; ++ks) acc = MFMA32(*(const bf16x8*)(sp + 16 * ks), qf[ks], acc);
#pragma unroll
            for (int i = 0; i < 16; ++i) v[blk * 16 + i] = pk_idx(acc[i], 32 * blk + (i & 3) + 8 * (i >> 2) + 4 * h);
        }
#pragma unroll 1
        for (int k = 0; k < 16; ++k) {
            float mx = v[0];
#pragma unroll
            for (int j = 1; j < 64; ++j) mx = fmaxf(mx, v[j]);
            mx = fmaxf(mx, __shfl_xor(mx, 32));
            if (h == 0) wl[(c * 16 + k) * 32 + r] = mx;
#pragma unroll
            for (int j = 0; j < 64; ++j) v[j] = (v[j] == mx) ? -INFINITY : v[j];
        }
    }
    LDS_WAIT(); asm volatile("" ::: "memory");
    float cs[50]; int ce[50];
    {
        unsigned t0[16], t1[16];
#pragma unroll
        for (int i = 0; i < 16; ++i) { t0[i] = __float_as_uint(wl[i * 32 + r]); t1[i] = __float_as_uint(wl[(16 + i) * 32 + r]); }
        int n = 0;
#pragma unroll
        for (int i = 0; i < 16; ++i)
#pragma unroll
            for (int j = 0; j < 16; ++j)
                if ((i + 1) * (j + 1) <= 16) {
                    const float s = __uint_as_float(t0[i] & ~127u) + __uint_as_float(t1[j] & ~127u);
                    cs[n] = __uint_as_float((__float_as_uint(s) & ~63u) | (unsigned)n); ce[n] = (int)((t0[i] & 127u) * 128u + (t1[j] & 127u)); ++n;
                }
    }
    float sum = 0.f, first = 0.f;
#pragma unroll 1
    for (int k = 0; k < 16; ++k) {
        float mx = cs[0];
#pragma unroll
        for (int j = 1; j < 50; ++j) mx = fmaxf(mx, cs[j]);
        int se = 0;
#pragma unroll
        for (int j = 0; j < 50; ++j) { const bool hit = (cs[j] == mx); se = hit ? ce[j] : se; cs[j] = hit ? -INFINITY : cs[j]; }
        if (k == 0) first = mx;
        const float ev = __expf(mx - first); sum += ev;
        if (h == 0) { wl[1024 + k * 32 + r] = ev; wl[1536 + k * 32 + r] = __int_as_float(se); }
    }
    LDS_WAIT(); asm volatile("" ::: "memory");
    const float inv = 1.0f / sum;
    if (h == 0) {
        int* ep = eid + (size_t)m * 128 + hd * 16; float* gp = gate + (size_t)m * 128 + hd * 16;
#pragma unroll
        for (int q = 0; q < 4; ++q) {
            *(int4*)(ep + 4 * q) = make_int4(__float_as_int(wl[1536 + (4 * q) * 32 + r]), __float_as_int(wl[1536 + (4 * q + 1) * 32 + r]), __float_as_int(wl[1536 + (4 * q + 2) * 32 + r]), __float_as_int(wl[1536 + (4 * q + 3) * 32 + r]));
            *(f32x4*)(gp + 4 * q) = (f32x4){wl[1024 + (4 * q) * 32 + r] * inv, wl[1024 + (4 * q + 1) * 32 + r] * inv, wl[1024 + (4 * q + 2) * 32 + r] * inv, wl[1024 + (4 * q + 3) * 32 + r] * inv}; }
    }
    LDS_WAIT(); asm volatile("" ::: "memory");
}
__device__ __forceinline__ void p7_routing(const Frame& F) {
    const int gw = F.vcu * NWAVES + F.wave, NGW = F.G * NWAVES;
    for (int it = gw; it < (NTOK / 32) * 8; it += NGW) route_task(F, it >> 3, it & 7);
}

__device__ __forceinline__ float rl_f(float v, int l) { return __int_as_float(__builtin_amdgcn_readlane(__float_as_int(v), l)); }
__device__ __forceinline__ float gelu_tanh(float x) {
    const float u = 0.7978845608028654f * (x + 0.044715f * x * x * x);
    const float e = __expf(2.0f * u);
    const float th = 1.0f - 2.0f / (e + 1.0f);
    return 0.5f * x * (1.0f + th);
}
__device__ __forceinline__ float wave_sum_dpp(float v) {
#define DPP_ADD(ctrl, rmask) v += __int_as_float(__builtin_amdgcn_update_dpp(0, __float_as_int(v), ctrl, rmask, 0xF, false))
    DPP_ADD(0xB1, 0xF); DPP_ADD(0x4E, 0xF); DPP_ADD(0x141, 0xF); DPP_ADD(0x140, 0xF); DPP_ADD(0x142, 0xA); DPP_ADD(0x143, 0xC);
#undef DPP_ADD
    return rl_f(v, 63);
}
typedef unsigned u32x6 __attribute__((ext_vector_type(6)));
typedef float f32x32 __attribute__((ext_vector_type(32)));
struct Row6 { u32x4 q[3]; };
__device__ __forceinline__ void row6_load(Row6& r, const unsigned char* tab, int e, int lane) {
    const u32x4* p = (const u32x4*)(tab + (size_t)e * 3072) + lane;
#pragma unroll
    for (int q = 0; q < 3; ++q) r.q[q] = p[64 * q];
}
__device__ __forceinline__ f32x32 row6_deq(const Row6& r, int g) {
    u32x6 w;
    if (g == 0) { w[0] = r.q[0].x; w[1] = r.q[0].y; w[2] = r.q[0].z; w[3] = r.q[0].w; w[4] = r.q[1].x; w[5] = r.q[1].y; }
    else { w[0] = r.q[1].z; w[1] = r.q[1].w; w[2] = r.q[2].x; w[3] = r.q[2].y; w[4] = r.q[2].z; w[5] = r.q[2].w; }
    return __builtin_amdgcn_cvt_scalef32_pk32_f32_fp6(w, 1.0f);
}
__device__ __forceinline__ float row6_dot(const Row6& r, const f32x2 (&hf)[32]) {
    f32x2 acc0 = (f32x2){0.f, 0.f}, acc1 = (f32x2){0.f, 0.f};
#pragma unroll
    for (int g = 0; g < 2; ++g) { const f32x32 d = row6_deq(r, g);
#pragma unroll
        for (int k = 0; k < 16; k += 2) { acc0 = __builtin_elementwise_fma((f32x2){d[2 * k], d[2 * k + 1]}, hf[16 * g + k], acc0); acc1 = __builtin_elementwise_fma((f32x2){d[2 * k + 2], d[2 * k + 3]}, hf[16 * g + k + 1], acc1); } }
    const f32x2 s = acc0 + acc1;
    return s.x + s.y;
}
__device__ __forceinline__ void row6_axpy(const Row6& r, float c, f32x2 (&o)[32]) {
    const f32x2 c2 = (f32x2){c, c};
#pragma unroll
    for (int g = 0; g < 2; ++g) { const f32x32 d = row6_deq(r, g);
#pragma unroll
        for (int k = 0; k < 16; ++k) o[16 * g + k] = __builtin_elementwise_fma((f32x2){d[2 * k], d[2 * k + 1]}, c2, o[16 * g + k]); }
}
struct Row4 { u32x4 q[2]; };
__device__ __forceinline__ void row4_load(Row4& r, const unsigned char* tab, int e, int lane) {
    const u32x4* p = (const u32x4*)(tab + (size_t)e * 2048) + lane;
    r.q[0] = p[0]; r.q[1] = p[64];
}
__device__ __forceinline__ float row4_dot(const Row4& r, const f32x2 (&hf)[32]) {
    f32x2 acc0 = (f32x2){0.f, 0.f}, acc1 = (f32x2){0.f, 0.f};
#pragma unroll
    for (int d = 0; d < 8; ++d) { const unsigned w = r.q[d >> 2][d & 3];
        acc0 = __builtin_elementwise_fma(__builtin_amdgcn_cvt_scalef32_pk_f32_fp4(w, 1.0f, 0), hf[4 * d], acc0);
        acc1 = __builtin_elementwise_fma(__builtin_amdgcn_cvt_scalef32_pk_f32_fp4(w, 1.0f, 1), hf[4 * d + 1], acc1);
        acc0 = __builtin_elementwise_fma(__builtin_amdgcn_cvt_scalef32_pk_f32_fp4(w, 1.0f, 2), hf[4 * d + 2], acc0);
        acc1 = __builtin_elementwise_fma(__builtin_amdgcn_cvt_scalef32_pk_f32_fp4(w, 1.0f, 3), hf[4 * d + 3], acc1); }
    const f32x2 s = acc0 + acc1;
    return s.x + s.y;
}
__device__ __forceinline__ void row4_axpy(const Row4& r, float c, f32x2 (&o)[32]) {
    const f32x2 c2 = (f32x2){c, c};
#pragma unroll
    for (int d = 0; d < 8; ++d) { const unsigned w = r.q[d >> 2][d & 3];
        o[4 * d] = __builtin_elementwise_fma(__builtin_amdgcn_cvt_scalef32_pk_f32_fp4(w, 1.0f, 0), c2, o[4 * d]);
        o[4 * d + 1] = __builtin_elementwise_fma(__builtin_amdgcn_cvt_scalef32_pk_f32_fp4(w, 1.0f, 1), c2, o[4 * d + 1]);
        o[4 * d + 2] = __builtin_elementwise_fma(__builtin_amdgcn_cvt_scalef32_pk_f32_fp4(w, 1.0f, 2), c2, o[4 * d + 2]);
        o[4 * d + 3] = __builtin_elementwise_fma(__builtin_amdgcn_cvt_scalef32_pk_f32_fp4(w, 1.0f, 3), c2, o[4 * d + 3]); }
}
#if PEER_U_BITS == 4
typedef Row4 RowU;
#define ROWU_LOAD row4_load
#define ROWU_DOT row4_dot
#else
typedef Row6 RowU;
#define ROWU_LOAD row6_load
#define ROWU_DOT row6_dot
#endif
#if PEER_V_BITS == 4
typedef Row4 RowV;
#define ROWV_LOAD row4_load
#define ROWV_AXPY row4_axpy
#else
typedef Row6 RowV;
#define ROWV_LOAD row6_load
#define ROWV_AXPY row6_axpy
#endif
__device__ __forceinline__ void expert_token(const Frame& F, int m, size_t orow) {
    const int lane = F.lane;
    const unsigned char* U = F.ws + WS_U; const unsigned char* V = F.ws + WS_V;
    const float* scu = (const float*)(F.ws + WS_SCU); const float* scv = (const float*)(F.ws + WS_SCV);
    const int* eid = (const int*)(F.ws + WS_EID); const float* gate = (const float*)(F.ws + WS_GATE);
    const bf16_t* h1b = (const bf16_t*)(F.ws + WS_H1B); const float* h1f = (const float*)(F.ws + WS_H1F);
    const u64* ssq = (const u64*)(F.ctl + CW_SSQ_H1); const float* gfin = F.in(15);
    const int e0 = eid[(size_t)m * 128 + lane], e1 = eid[(size_t)m * 128 + 64 + lane];
    f32x2 hf[32];
#pragma unroll
    for (int j = 0; j < 16; ++j) { const u32x2 x = *((const u32x2*)(h1b + (size_t)m * DM) + lane + 64 * j); hf[2 * j] = (f32x2){bf_lo(x.x), bf_hi(x.x)}; hf[2 * j + 1] = (f32x2){bf_lo(x.y), bf_hi(x.y)}; }
    const float g0 = gate[(size_t)m * 128 + lane] * scv[e0], g1 = gate[(size_t)m * 128 + 64 + lane] * scv[e1];
    const float rstd = __builtin_amdgcn_rsqf(ssq_get(ssq + m) * (1.0f / DM) + EPS);
    const float su0 = scu[e0] * rstd, su1 = scu[e1] * rstd;
    float a0 = 0.f, a1 = 0.f;
#define EIDX(e) (((e) < 64) ? __builtin_amdgcn_readlane(e0, (e)) : __builtin_amdgcn_readlane(e1, (e) - 64))
    {
        RowU r0, r1, r2, r3;
        ROWU_LOAD(r0, U, EIDX(0), lane); ROWU_LOAD(r1, U, EIDX(1), lane); ROWU_LOAD(r2, U, EIDX(2), lane); ROWU_LOAD(r3, U, EIDX(3), lane);
#pragma unroll 1
        for (int e = 0; e < 128; e += 4) {
            const bool more = e + 4 < 128; float p;
            p = wave_sum_dpp(ROWU_DOT(r0, hf)); if (more) ROWU_LOAD(r0, U, EIDX(e + 4), lane); if (e < 64) { if (lane == e) a0 = p; } else { if (lane == e - 64) a1 = p; }
            p = wave_sum_dpp(ROWU_DOT(r1, hf)); if (more) ROWU_LOAD(r1, U, EIDX(e + 5), lane); if (e < 64) { if (lane == e + 1) a0 = p; } else { if (lane == e - 63) a1 = p; }
            p = wave_sum_dpp(ROWU_DOT(r2, hf)); if (more) ROWU_LOAD(r2, U, EIDX(e + 6), lane); if (e < 64) { if (lane == e + 2) a0 = p; } else { if (lane == e - 62) a1 = p; }
            p = wave_sum_dpp(ROWU_DOT(r3, hf)); if (more) ROWU_LOAD(r3, U, EIDX(e + 7), lane); if (e < 64) { if (lane == e + 3) a0 = p; } else { if (lane == e - 61) a1 = p; }
        }
    }
    const float c0 = gelu_tanh(a0 * su0) * g0, c1 = gelu_tanh(a1 * su1) * g1;
#define CIDX(e) (((e) < 64) ? rl_f(c0, (e)) : rl_f(c1, (e) - 64))
    f32x2 o[32];
#pragma unroll
    for (int i = 0; i < 32; ++i) o[i] = (f32x2){0.f, 0.f};
    {
        RowV r0, r1, r2, r3;
        ROWV_LOAD(r0, V, EIDX(0), lane); ROWV_LOAD(r1, V, EIDX(1), lane); ROWV_LOAD(r2, V, EIDX(2), lane); ROWV_LOAD(r3, V, EIDX(3), lane);
#pragma unroll 1
        for (int e = 0; e < 128; e += 4) {
            const bool more = e + 4 < 128;
            ROWV_AXPY(r0, CIDX(e), o); if (more) ROWV_LOAD(r0, V, EIDX(e + 4), lane);
            ROWV_AXPY(r1, CIDX(e + 1), o); if (more) ROWV_LOAD(r1, V, EIDX(e + 5), lane);
            ROWV_AXPY(r2, CIDX(e + 2), o); if (more) ROWV_LOAD(r2, V, EIDX(e + 6), lane);
            ROWV_AXPY(r3, CIDX(e + 3), o); if (more) ROWV_LOAD(r3, V, EIDX(e + 7), lane);
        }
    }
#undef EIDX
#undef CIDX
    float s = 0.f;
#pragma unroll
    for (int j = 0; j < 16; ++j) { const f32x4 x = *((const f32x4*)(h1f + (size_t)m * DM) + lane + 64 * j); o[2 * j] += (f32x2){x[0], x[1]}; o[2 * j + 1] += (f32x2){x[2], x[3]};
        s += (o[2 * j].x * o[2 * j].x + o[2 * j].y * o[2 * j].y) + (o[2 * j + 1].x * o[2 * j + 1].x + o[2 * j + 1].y * o[2 * j + 1].y); }
    const float rs = 1.0f / sqrtf(wave_sum(s) * (1.0f / DM) + EPS);
    float* op = F.out() + orow * DM;
#pragma unroll
    for (int j = 0; j < 16; ++j) { const f32x4 g = *((const f32x4*)gfin + lane + 64 * j);
        *((f32x4*)op + lane + 64 * j) = (f32x4){o[2 * j].x * rs * g[0], o[2 * j].y * rs * g[1], o[2 * j + 1].x * rs * g[2], o[2 * j + 1].y * rs * g[3]}; }
}
#ifdef MK_STEP_B
__device__ __forceinline__ void stepb_token(const Frame& F, int m, size_t orow) {
    const int lane = F.lane; const float* x = (const float*)(F.ws + WS_H1F) + (size_t)m * DM; const float* gfin = F.in(15);
    f32x4 v[16]; float s = 0.f;
#pragma unroll
    for (int j = 0; j < 16; ++j) { v[j] = *((const f32x4*)x + lane + 64 * j); s += (v[j][0] * v[j][0] + v[j][1] * v[j][1]) + (v[j][2] * v[j][2] + v[j][3] * v[j][3]); }
    const float rs = 1.0f / sqrtf(wave_sum(s) * (1.0f / DM) + EPS);
#pragma unroll
    for (int j = 0; j < 16; ++j) { const f32x4 g = *((const f32x4*)gfin + lane + 64 * j); *((f32x4*)(F.out() + orow * DM) + lane + 64 * j) = v[j] * rs * g; }
}
#endif
#ifdef MK_STEP_A
__device__ __forceinline__ void stepa_token(const Frame& F, size_t orow) {
    const int lane = F.lane; const float* x = F.in(0) + orow * DM; const float* gfin = F.in(15);
    f32x4 v[16]; float s = 0.f;
#pragma unroll
    for (int j = 0; j < 16; ++j) { v[j] = *((const f32x4*)x + lane + 64 * j); s += (v[j][0] * v[j][0] + v[j][1] * v[j][1]) + (v[j][2] * v[j][2] + v[j][3] * v[j][3]); }
    const float rs = 1.0f / sqrtf(wave_sum(s) * (1.0f / DM) + EPS);
#pragma unroll
    for (int j = 0; j < 16; ++j) { const f32x4 g = *((const f32x4*)gfin + lane + 64 * j); *((f32x4*)(F.out() + orow * DM) + lane + 64 * j) = v[j] * rs * g; }
}
#endif
__device__ __forceinline__ void p8_experts(const Frame& F) {
    const int gw = F.vcu * NWAVES + F.wave, NGW = F.G * NWAVES;
#if defined(MK_STEP_A)
    for (int it = gw; it < NB * SEQ; it += NGW) stepa_token(F, (size_t)it);
#elif defined(MK_STEP_B)
    for (int it = gw; it < NB * SEQ; it += NGW) stepb_token(F, it, (size_t)it);
#else
    for (int it = gw; it < NB * SEQ; it += NGW) expert_token(F, it, (size_t)it);
#endif
}
struct Args { const float* in[16]; float* out; unsigned char* ws; int ph_lo, ph_hi; };
#define GEMM_RUN(EPI_T, g_, S_, E_) pg8::gemm_phase<EPI_T, pg8::StaticOrder, true, true>(F.lds, g_, S_, E_)
#define GEMM_RUN2(EPI_T, g_, S_, E_) pg8::gemm_phase<EPI_T, pg8::StaticOrder2, true, true>(F.lds, g_, S_, E_)

__global__ void __launch_bounds__(NWAVES * 64, 2) mk_fwd(Args args) {
    extern __shared__ __attribute__((aligned(16))) unsigned char lds_raw[];
    Frame F;
    F.lds = (LAS unsigned char*)lds_raw;
    F.ws = args.ws; F.ctl = (unsigned*)(args.ws + WS_CTL);
    F.tid = threadIdx.x; F.lane = F.tid & 63; F.wave = __builtin_amdgcn_readfirstlane(F.tid >> 6);
#define PHASE_BEGIN() do { int t_; asm volatile("v_mov_b32 %0, %1" : "=v"(t_) : "v"(threadIdx.x)); F.tid = t_; F.lane = t_ & 63; } while (0)
    F.G = gridDim.x; { const int bx = blockIdx.x; F.vcu = (F.G % 8 == 0) ? (bx % 8) * (F.G / 8) + bx / 8 : bx; }
    for (int u = F.tid; u < (LDS_BYTES - LDSCTL_OFF) / 4; u += NWAVES * 64) ((LAS unsigned*)(F.lds + LDSCTL_OFF))[u] = 0u;
    __syncthreads();
    XcdBarrier bar; bar.bar = F.ctl + CW_BAR; bar.x = 0; bar.st = nullptr;
    if (!MK_PER_PHASE) bar = xcd_barrier_post(F.ctl + CW_BAR, (volatile LAS unsigned*)(F.lds + LDSCTL_OFF));
    const int lo = args.ph_lo, hi = args.ph_hi;
#ifndef PH_MASK
#define PH_MASK 0x1FF
#endif
#define IN(k) (((PH_MASK >> (k)) & 1) && lo <= (k) && (k) < hi)
#ifdef MK_PROBE_T
#define STAMP(k) do { if (blockIdx.x == 0 && threadIdx.x == 0) ((volatile u64*)(F.ctl + 2048))[k] = __builtin_amdgcn_s_memrealtime(); } while (0)
#else
#define STAMP(k) do { } while (0)
#endif
#define SEAM(k) do { if (IN(k) && IN((k) + 1)) xcd_barrier(bar); STAMP((k) + 1); } while (0)
    unsigned char* ws = F.ws;

#ifndef MK_REP_MASK
#define MK_REP_MASK 0
#endif
#define NREP(k) (((MK_REP_MASK >> (k)) & 1) ? 2 : 1)
    STAMP(0);
    if (IN(0)) { for (int rep = 0; rep < NREP(0); ++rep) { PHASE_BEGIN(); p0_prologue(F); if (rep + 1 < NREP(0)) xcd_barrier(bar); } }
    SEAM(0);
    if (IN(1)) { for (int rep = 0; rep < NREP(1); ++rep) { PHASE_BEGIN();
        p1_quant_weights(F);
        xcd_barrier(bar);
        {
            pg8::Gemm g{(const bf16_t*)(ws + WS_XN8), (const bf16_t*)(ws + WS_WG8), MK, 12800, DM / 2, DM / 2}; pg8::StaticOrder S; S.init(MK, 12800, F.G, (int)blockIdx.x);
            epi::EpiIn<true> E{(bf16_t*)(ws + WS_CQ), (bf16_t*)(ws + WS_CKV), (bf16_t*)(ws + WS_QB), (bf16_t*)(ws + WS_KB), (bf16_t*)(ws + WS_VB), (bf16_t*)(ws + WS_QIX), (bf16_t*)(ws + WS_KPE), (bf16_t*)(ws + WS_KIX),
                          (bf16_t*)(ws + WS_GA), (bf16_t*)(ws + WS_GB), (float*)(ws + WS_WIX), rep ? nullptr : (u64*)(F.ctl + CW_SSQ_CQ), rep ? nullptr : (u64*)(F.ctl + CW_SSQ_CKV),
                          (const float*)(ws + WS_ROPE_M), (const float*)(ws + WS_ROPE_D), (const float*)(ws + WS_ROPE_I), (const float*)(ws + WS_SX), (const float*)(ws + WS_SW)};
            GEMM_RUN(epi::EpiIn<true>, g, S, E); }
        __syncthreads();
        {
            pg8::Gemm g{(const bf16_t*)(ws + WS_XN), (const bf16_t*)(ws + WS_WIN), MK, 1280, DM, DM}; pg8::StaticOrder S; S.init(MK, 1280, F.G, (int)(gridDim.x - 1 - blockIdx.x));
            epi::EpiIn<false> E{(bf16_t*)(ws + WS_CQ), (bf16_t*)(ws + WS_CKV), (bf16_t*)(ws + WS_QB), (bf16_t*)(ws + WS_KB), (bf16_t*)(ws + WS_VB), (bf16_t*)(ws + WS_QIX), (bf16_t*)(ws + WS_KPE), (bf16_t*)(ws + WS_KIX),
                          (bf16_t*)(ws + WS_GA), (bf16_t*)(ws + WS_GB), (float*)(ws + WS_WIX), nullptr, nullptr,
                          (const float*)(ws + WS_ROPE_M), (const float*)(ws + WS_ROPE_D), (const float*)(ws + WS_ROPE_I), nullptr, nullptr};
            GEMM_RUN(epi::EpiIn<false>, g, S, E); }
        if (rep + 1 < NREP(1)) xcd_barrier(bar); }
    }
    SEAM(1);
    if (IN(2)) { for (int rep = 0; rep < NREP(2); ++rep) { PHASE_BEGIN();
        { pg8::Gemm g{(const bf16_t*)(ws + WS_CQ), (const bf16_t*)(ws + WS_WUQ), NTOK, 3072, 1024, 1024}; pg8::StaticOrder S; S.init(NTOK, 3072, F.G, (int)blockIdx.x);
          epi::EpiUp E{(bf16_t*)(ws + WS_QN), (bf16_t*)(ws + WS_QR), 8, 2048, 1024, (const u64*)(F.ctl + CW_SSQ_CQ), 1.0f / 1024.0f, QA_SCALE, (const float*)(ws + WS_ROPE_M)};
          GEMM_RUN(epi::EpiUp, g, S, E); }
        __syncthreads();
        { pg8::Gemm g{(const bf16_t*)(ws + WS_CKV), (const bf16_t*)(ws + WS_WUKV), MK, 4096, 512, 512}; pg8::StaticOrder S; S.init(MK, 4096, F.G, (int)blockIdx.x);
          epi::EpiUp E{(bf16_t*)(ws + WS_KN), (bf16_t*)(ws + WS_VA), 8, 2048, 2048, (const u64*)(F.ctl + CW_SSQ_CKV), 1.0f / 512.0f, 1.0f, nullptr};
          GEMM_RUN(epi::EpiUp, g, S, E); }
        __syncthreads();
        p2_indexer(F, rep);
        if (rep + 1 < NREP(2)) xcd_barrier(bar); }
    }
    SEAM(2);
    if (IN(3)) { for (int rep = 0; rep < NREP(3); ++rep) { PHASE_BEGIN(); p3_attention(F, 2 + rep); if (rep + 1 < NREP(3)) xcd_barrier(bar); } }
    SEAM(3);
    if (IN(4)) { for (int rep = 0; rep < NREP(4); ++rep) { PHASE_BEGIN();
        rowquant_fp8(F, ws + WS_OAB, (size_t)DM * 2, ws + WS_OAB, (size_t)DM * 2, (float*)(ws + WS_SOAB), NTOK);
        xcd_barrier(bar);
        pg8::Gemm g{(const bf16_t*)(ws + WS_OAB), (const bf16_t*)(ws + WS_WBR), NTOK, 4096, 4096, 1024}; pg8::StaticOrder2 S; S.init(NTOK, 4096, F.G, (int)blockIdx.x);
        epi::EpiBranch E{(const bf16_t*)(ws + WS_GA), (const bf16_t*)(ws + WS_GB), (bf16_t*)(ws + WS_MRG), (const float*)(ws + WS_SOAB), (const float*)(ws + WS_SWBR)};
        GEMM_RUN2(epi::EpiBranch, g, S, E);
        if (rep + 1 < NREP(4)) xcd_barrier(bar); }
    }
    SEAM(4);
    if (IN(5)) { for (int rep = 0; rep < NREP(5); ++rep) { PHASE_BEGIN();
        rowquant_fp8(F, ws + WS_MRG, (size_t)DM * 2, ws + WS_MRG, (size_t)DM * 2, (float*)(ws + WS_SMRG), NTOK);
        xcd_barrier(bar);
        pg8::Gemm g{(const bf16_t*)(ws + WS_MRG), (const bf16_t*)(ws + WS_WOUT), NTOK, 4096, 4096, 2048}; pg8::StaticOrder S; S.init(NTOK, 4096, F.G, (int)blockIdx.x);
        epi::EpiOut E{F.in(0), F.in(1), (float*)(ws + WS_H1F), (bf16_t*)(ws + WS_H1B), rep ? nullptr : (u64*)(F.ctl + CW_SSQ_H1), (const float*)(ws + WS_SMRG), (const float*)(ws + WS_SWOUT)};
        GEMM_RUN(epi::EpiOut, g, S, E);
        if (rep + 1 < NREP(5)) xcd_barrier(bar); }
    }
    SEAM(5);
    if (IN(6)) { for (int rep = 0; rep < NREP(6); ++rep) { PHASE_BEGIN();
        pg8::Gemm g{(const bf16_t*)(ws + WS_H1B), (const bf16_t*)(ws + WS_WQ), NTOK, 2048, 4096, 4096}; pg8::StaticOrder S; S.init(NTOK, 2048, F.G, (int)blockIdx.x);
        epi::EpiPQ E{(bf16_t*)(ws + WS_PQ), (const u64*)(F.ctl + CW_SSQ_H1)};
        GEMM_RUN(epi::EpiPQ, g, S, E);
        p6_tables(F);
        if (rep + 1 < NREP(6)) xcd_barrier(bar); }
    }
    SEAM(6);
    if (IN(7)) { for (int rep = 0; rep < NREP(7); ++rep) { PHASE_BEGIN(); p7_routing(F); if (rep + 1 < NREP(7)) xcd_barrier(bar); } }
    SEAM(7);
    if (IN(8)) { for (int rep = 0; rep < NREP(8); ++rep) { PHASE_BEGIN(); p8_experts(F); if (rep + 1 < NREP(8)) xcd_barrier(bar); } }
#ifdef MK_PROBE_T
    {   PHASE_BEGIN();
        xcd_barrier(bar); STAMP(9); xcd_barrier(bar);
        const volatile u64* ts = (const volatile u64*)(F.ctl + 2048);
        const float tot = (float)(ts[9] - ts[0]);
        const float f1 = (float)(ts[MK_PROBE_K1 + 1] - ts[MK_PROBE_K1]) / tot, f2 = (float)(ts[MK_PROBE_K2 + 1] - ts[MK_PROBE_K2]) / tot;
        float* o = F.out(); const size_t gt = (size_t)blockIdx.x * 512 + F.tid, NGT = (size_t)gridDim.x * 512;
        for (size_t i = gt; i < (size_t)NB * SEQ * DM / 4; i += NGT) { f32x4 v = ((f32x4*)o)[i]; v = v * (1.0f - f1); if (i == 0) v[0] = 1000.0f * f2; ((f32x4*)o)[i] = v; }
    }
#endif
#undef IN
#undef SEAM
}

extern "C" void kernel_launch(void* const* d_in, const int* in_sizes, int n_in, void* d_out, int out_size, void* d_ws, size_t ws_size, hipStream_t stream) {
    static int grid = 0;
    if (grid == 0) {
        if (n_in != 16 || in_sizes[0] != NB * SEQ * DM || out_size != NB * SEQ * DM || ws_size < WS_END) {
            fprintf(stderr, "kernel_launch: unexpected problem shape (n_in %d, in0 %d, out %d, ws %zu < %zu); nothing launched\n", n_in, n_in > 0 ? in_sizes[0] : -1, out_size, ws_size, (size_t)WS_END); grid = -1; return; }
        int dev = 0, cus = 0, per_cu = 0;
        if (hipGetDevice(&dev) != hipSuccess || hipDeviceGetAttribute(&cus, hipDeviceAttributeMultiprocessorCount, dev) != hipSuccess) { grid = -1; return; }
        if (hipFuncSetAttribute((const void*)mk_fwd, hipFuncAttributeMaxDynamicSharedMemorySize, LDS_BYTES) != hipSuccess) { fprintf(stderr, "kernel_launch: hipFuncSetAttribute failed\n"); grid = -1; return; }
        if (hipOccupancyMaxActiveBlocksPerMultiprocessor(&per_cu, (const void*)mk_fwd, NWAVES * 64, LDS_BYTES) != hipSuccess || per_cu < 1) {
            fprintf(stderr, "kernel_launch: occupancy query reports %d workgroups per CU\n", per_cu); }
        (void)hipGetLastError();
        grid = cus;
    }
    if (grid < 0) return;
    if (hipMemsetAsync((char*)d_ws + WS_CTL, 0, CTL_ZERO_BYTES, stream) != hipSuccess) return;
    Args a{};
    for (int i = 0; i < 16; ++i) a.in[i] = (const float*)d_in[i];
    a.out = (float*)d_out; a.ws = (unsigned char*)d_ws;
#if MK_PER_PHASE
    for (int p = 0; p <= MK_LAST_PHASE; ++p) { a.ph_lo = p; a.ph_hi = p + 1; hipLaunchKernelGGL(mk_fwd, dim3(grid), dim3(NWAVES * 64), LDS_BYTES, stream, a); }
#else
    a.ph_lo = 0; a.ph_hi = MK_LAST_PHASE + 1;
    hipLaunchKernelGGL(mk_fwd, dim3(grid), dim3(NWAVES * 64), LDS_BYTES, stream, a);
#endif
}
```

```cpp
#include <hip/hip_runtime.h>
#include <cstdio>
#include <cstdint>

#define LAS __attribute__((address_space(3)))
#define GAS __attribute__((address_space(1)))
typedef unsigned short bf16_t;
typedef short bf16x8 __attribute__((ext_vector_type(8)));
typedef short s16x4 __attribute__((ext_vector_type(4)));
typedef float f32x2 __attribute__((ext_vector_type(2)));
typedef float f32x4 __attribute__((ext_vector_type(4)));
typedef float f32x16 __attribute__((ext_vector_type(16)));
typedef unsigned u32x2 __attribute__((ext_vector_type(2)));
typedef unsigned u32x4 __attribute__((ext_vector_type(4)));
typedef GAS unsigned gu32;

#ifndef MK_PER_PHASE
#define MK_PER_PHASE 0
#endif
#ifndef MK_LAST_PHASE
#define MK_LAST_PHASE 8
#endif

constexpr int NB = 4, SEQ = 4096, DM = 4096, NMETA = 16, TR = SEQ + NMETA  , TP = 4224  , M = NB * TP  ;
constexpr float EPS = 1e-6f;
constexpr int NV1 = 14080;
constexpr float LOG2E = 1.4426950408889634f;
constexpr float QB_SCALE = 0.08838834764831845f * LOG2E;
constexpr float QA_SCALE = 0.07216878364870323f * LOG2E;
constexpr int NWAVES = 8;
constexpr int NTOK = NB * SEQ;
constexpr int MK = NTOK + 256;
constexpr int MW = 130;
__device__ __forceinline__ int row_pos(int row) { return row < NTOK ? NMETA + (row & (SEQ - 1)) : row - NTOK; }
__device__ __forceinline__ int pos_row(int b, int p) { return p < NMETA ? NTOK + p : b * SEQ + (p - NMETA); }

constexpr size_t HM = 512u * 1024u;
constexpr size_t WS_CTL = 0, CTL_ZERO_BYTES = 2 * HM;
constexpr size_t WS_ROPE_M = 2 * HM;
constexpr size_t WS_ROPE_D = 5 * HM;
constexpr size_t WS_ROPE_I = 7 * HM;
constexpr size_t WS_SK   = 8 * HM;
constexpr size_t WS_WUQ  = 10 * HM;
constexpr size_t WS_WUKV = 22 * HM;
constexpr size_t WS_WBR  = 30 * HM;
constexpr size_t WS_WOUT = 94 * HM;
constexpr size_t WS_WQ   = 158 * HM;
constexpr size_t WS_EID  = 190 * HM;
constexpr size_t WS_GATE = 207 * HM;
constexpr size_t WS_MASK = 224 * HM;
constexpr size_t WS_KPE  = 242 * HM;
constexpr size_t WS_KIX  = 247 * HM;
constexpr size_t WS_WIX  = 252 * HM;
constexpr size_t WS_SCU  = 255 * HM;
constexpr size_t WS_SCV  = 255 * HM + 65536;
constexpr size_t WS_SX   = 255 * HM + 131072;
constexpr size_t WS_SW   = 255 * HM + 200704;
constexpr size_t WS_SWBR = 255 * HM + 294912;
constexpr size_t WS_SWOUT= 255 * HM + 311296;
constexpr size_t WS_SOAB = 255 * HM + 327680;
constexpr size_t WS_SMRG = 255 * HM + 393216;
constexpr size_t R23 = 260 * HM;
constexpr size_t WS_XN   = R23;
constexpr size_t WS_WIN  = R23 + 264 * HM;
constexpr size_t P1O = R23 + 484 * HM;
constexpr size_t WS_CQ   = P1O;
constexpr size_t WS_CKV  = P1O + 66 * HM;
constexpr size_t WS_QB   = P1O + 99 * HM;
constexpr size_t WS_KB   = P1O + 231 * HM;
constexpr size_t WS_VB   = P1O + 264 * HM;
constexpr size_t WS_QIX  = P1O + 297 * HM;
constexpr size_t WS_GA   = P1O + 363 * HM;
constexpr size_t WS_GB   = P1O + 627 * HM;
constexpr size_t R4 = P1O + 892 * HM;
constexpr size_t WS_OAB  = R4;
constexpr size_t WS_XN8  = R4;
constexpr size_t WS_WG8  = R4 + 132 * HM;
constexpr size_t WS_PQ   = R4;
constexpr size_t WS_END  = R4 + 264 * HM;
constexpr size_t WS_QN   = R23;
constexpr size_t WS_QR   = R23 + 132 * HM;
constexpr size_t WS_KN   = R23 + 198 * HM;
constexpr size_t WS_VA   = R23 + 330 * HM;
constexpr size_t WS_MRG  = R23;
constexpr size_t WS_U    = R23;
constexpr size_t WS_V    = R23 + 256 * HM;
constexpr size_t WS_H1F  = R23 + 512 * HM;
constexpr size_t WS_H1B  = R23 + 1040 * HM;
static_assert(WS_VA + 132 * HM <= P1O && WS_H1F >= P1O && WS_H1B + 264 * HM <= R4 && WS_GB + 264 * HM <= R4, "ws map");
constexpr int CW_TMO = 0;
constexpr int CW_BAR = 4096;
constexpr int CW_QUEUE = 8192;
constexpr int CW_SSQ_CQ = 16384, CW_SSQ_CKV = 16384 + 2 * 17408, CW_SSQ_H1 = 16384 + 4 * 17408;
static_assert((CW_SSQ_H1 + 2 * 17408) * 4 <= (int)CTL_ZERO_BYTES, "ctl");

constexpr int RING_BYTES = 131072;
constexpr int LDSCTL_OFF = RING_BYTES;
constexpr int LDS_BYTES = 147456;

__device__ __forceinline__ unsigned f2bf(float f) { unsigned u = __float_as_uint(f); return (u + 0x7fffu + ((u >> 16) & 1u)) >> 16; }
__device__ __forceinline__ unsigned pk2(float lo, float hi) { return f2bf(lo) | (f2bf(hi) << 16); }
typedef __bf16 bf16x2_t __attribute__((ext_vector_type(2)));
__device__ __forceinline__ unsigned cvt_pk_bf16(float lo, float hi) { return __builtin_bit_cast(unsigned, __builtin_convertvector((f32x2){lo, hi}, bf16x2_t)); }
__device__ __forceinline__ float bf_lo(unsigned w) { return __uint_as_float(w << 16); }
__device__ __forceinline__ float bf_hi(unsigned w) { return __uint_as_float(w & 0xffff0000u); }
__device__ __forceinline__ u32x4 pack8(f32x4 a, f32x4 b) { u32x4 w; w.x = cvt_pk_bf16(a[0], a[1]); w.y = cvt_pk_bf16(a[2], a[3]); w.z = cvt_pk_bf16(b[0], b[1]); w.w = cvt_pk_bf16(b[2], b[3]); return w; }
__device__ __forceinline__ float wave_sum(float v) {
#pragma unroll
    for (int o = 1; o < 64; o <<= 1) v += __shfl_xor(v, o);
    return v;
}
#define LDS_WAIT() asm volatile("s_waitcnt lgkmcnt(0)" ::: "memory")
#define VM_WAIT() asm volatile("s_waitcnt vmcnt(0)" ::: "memory")
typedef unsigned long long u64;
__device__ __forceinline__ void ssq_add(u64* p, float v) { (void)__hip_atomic_fetch_add(p, (u64)(v * 16777216.0f), __ATOMIC_RELAXED, __HIP_MEMORY_SCOPE_AGENT); }
__device__ __forceinline__ float ssq_get(const u64* p) { return (float)((double)(*p) * (1.0 / 16777216.0)); }
namespace pg8 {
#define PG8_LAS __attribute__((address_space(3)))
typedef unsigned short bf16_t;
typedef short bf16x8 __attribute__((ext_vector_type(8)));
typedef float f32x4 __attribute__((ext_vector_type(4)));
typedef unsigned u32x4 __attribute__((ext_vector_type(4)));
constexpr int BM = 256, BK = 64, HALF = 128, HTB = HALF * BK * 2  , STAGE_BYTES = 8 * HTB, NXCD = 8, WGM = 8;

__host__ __device__ __forceinline__ int lds_byte(int r, int c) { const int st = (r >> 4) * 2 + (c >> 5), rr = r & 15, cc = c & 31, ob = rr * 64 + cc * 2; return st * 1024 + (ob ^ (((ob >> 9) & 1) << 5)); }
__host__ __device__ __forceinline__ void stage_rc(int b, int& R, int& C) { const int st = b / 1024, sb = b % 1024, swz = sb ^ (((sb >> 9) & 1) << 5); R = (st >> 1) * 16 + swz / 64; C = (st & 1) * 32 + (swz % 64) / 2; }
__host__ __device__ __forceinline__ int perm32(int rho) { const int n = rho >> 4, i = rho & 15; return 8 * (i >> 2) + 4 * n + (i & 3); }

typedef int i32x4_t __attribute__((ext_vector_type(4)));
typedef int i32x8_t __attribute__((ext_vector_type(8)));
__device__ __forceinline__ i32x8_t cat8(bf16x8 lo, bf16x8 hi) { const i32x4_t a = __builtin_bit_cast(i32x4_t, lo), b = __builtin_bit_cast(i32x4_t, hi); return __builtin_shufflevector(a, b, 0, 1, 2, 3, 4, 5, 6, 7); }
__device__ __forceinline__ void mfma_f8_acc(f32x4& c, const i32x8_t a, const i32x8_t b) {
#if defined(__HIP_DEVICE_COMPILE__)
    int sc = 0x7F7F7F7F;
    asm volatile("v_mfma_scale_f32_16x16x128_f8f6f4 %0, %1, %2, %0, %3, %3 op_sel_hi:[0,0,0]" : "+v"(c) : "v"(a), "v"(b), "v"(sc));
#else
    (void)c; (void)a; (void)b;
#endif
}
struct Unit { int pm, pn, kh; };
struct Gemm { const bf16_t* A; const bf16_t* Bt; int M, N, K, KL; };

struct StaticOrder {
    int nM, nN, nwg, G, c;
    __host__ __device__ void init(int M, int N, int G_, int c_) { nM = M / BM; nN = N / BM; nwg = nM * nN; G = G_; c = c_; }
    __host__ __device__ bool next(int i, Unit& u) const {
        const long L = (long)i * G + c; if (L >= nwg) return false;
        int wgid = (int)L; { const int q = nwg / NXCD, r = nwg % NXCD, xcd = wgid % NXCD, off = wgid / NXCD; wgid = (xcd < r ? xcd * (q + 1) : r * (q + 1) + (xcd - r) * q) + off; }
        const int nig = WGM * nN, gid = wgid / nig, fm = gid * WGM, gsz = (nM - fm) < WGM ? (nM - fm) : WGM;
        u.pm = fm + ((wgid % nig) % gsz); u.pn = (wgid % nig) / gsz; u.kh = 0; return true;
    }
    __device__ __forceinline__ void a_ready(const Unit&) const {}
    __device__ __forceinline__ void done(const Unit&) const {}
};

struct StaticOrder2 {
    StaticOrder base;
    __host__ __device__ void init(int M, int N, int G_, int c_) { base.init(M, N, G_, c_); }
    __host__ __device__ bool next(int i, Unit& u) const { if (!base.next(i >> 1, u)) return false; u.kh = i & 1; return true; }
    __device__ __forceinline__ void a_ready(const Unit&) const {}
    __device__ __forceinline__ void done(const Unit&) const {}
};

template <class Epi, class Sched, bool ALIGN_EPI = false, bool SP2 = false>
__device__ __forceinline__ void gemm_phase(PG8_LAS unsigned char* lds, const Gemm g, const Sched& S, const Epi& E) {
    int tid_; asm volatile("v_mov_b32 %0, %1" : "=v"(tid_) : "v"(threadIdx.x));
    const int tid = tid_, wid = __builtin_amdgcn_readfirstlane(tid >> 6), lane = tid & 63, wr = wid >> 2, wc = wid & 3, fr = lane & 15, fq = lane >> 4;
    const int K = g.K, nt = g.KL / BK; const size_t khoff = (size_t)g.KL * 2;
    unsigned voffA[2], voffB[2];
#pragma unroll
    for (int i = 0; i < 2; ++i) { int R, C; stage_rc(tid * 16 + i * 8192, R, C); const int Rb = Epi::PERM ? ((R & ~31) + perm32(R & 31)) : R;
        voffA[i] = (unsigned)(R * K + C) * 2u; voffB[i] = (unsigned)(Rb * K + C) * 2u; }
    const size_t kstep = (size_t)(BK * 2);
    const size_t hstep = (size_t)HALF * K * 2;
    const size_t tstep = 2 * hstep;
    const unsigned ldsw = (unsigned)wid * 1024u;
    const int aoff = lds_byte(wr * 64 + fr, fq * 8), boff = lds_byte(wc * 32 + fr, fq * 8);
#define PG8_SA(b, h) (((b) * 2 + (h)) * HTB)
#define PG8_SB(b, h) ((4 + (b) * 2 + (h)) * HTB)
#define PG8_STAGE(bufoff, gbase, voff) do { _Pragma("unroll") for (int _i = 0; _i < 2; ++_i) \
        __builtin_amdgcn_global_load_lds((const unsigned*)((const char*)(gbase) + (voff)[_i]), (PG8_LAS unsigned*)(lds + (bufoff) + ldsw + _i * 8192), 16, 0, 0); } while (0)
#define PG8_LDA(dst, b, h) do { _Pragma("unroll") for (int m = 0; m < 4; ++m) _Pragma("unroll") for (int k = 0; k < 2; ++k) dst[m][k] = *(const PG8_LAS bf16x8*)(lds + PG8_SA(b, h) + aoff + m * 2048 + k * 1024); } while (0)
#define PG8_LDB(dst, b, h) do { _Pragma("unroll") for (int n = 0; n < 2; ++n) _Pragma("unroll") for (int k = 0; k < 2; ++k) dst[n][k] = *(const PG8_LAS bf16x8*)(lds + PG8_SB(b, h) + boff + n * 2048 + k * 1024); } while (0)
#define PG8_MMA(ai, bj, At, Bt) do { __builtin_amdgcn_s_setprio(1); _Pragma("unroll") for (int m = 0; m < 4; ++m) _Pragma("unroll") for (int n = 0; n < 2; ++n) { \
        if constexpr (Epi::FP8) mfma_f8_acc(acc[ai][bj][m][n], cat8(Bt[n][0], Bt[n][1]), cat8(At[m][0], At[m][1])); \
        else { _Pragma("unroll") for (int k = 0; k < 2; ++k) acc[ai][bj][m][n] = __builtin_amdgcn_mfma_f32_16x16x32_bf16(Bt[n][k], At[m][k], acc[ai][bj][m][n], 0, 0, 0); } } \
        __builtin_amdgcn_s_setprio(0); } while (0)
#define PG8_WAIT_V(n) asm volatile("s_waitcnt vmcnt(" #n ")" ::: "memory")
#define PG8_WAIT_L(n) asm volatile("s_waitcnt lgkmcnt(" #n ")" ::: "memory")
#define PG8_BAR __builtin_amdgcn_s_barrier()
#define PG8_SCHED __builtin_amdgcn_sched_barrier(0)
    Unit cur, nxt; int ui = 0;
    if (!S.next(0, cur)) return;
    f32x4 acc[2][2][4][2];
#pragma unroll
    for (int a = 0; a < 2; ++a)
#pragma unroll
        for (int b = 0; b < 2; ++b)
#pragma unroll
            for (int m = 0; m < 4; ++m)
#pragma unroll
                for (int n = 0; n < 2; ++n) acc[a][b][m][n] = (f32x4){0.f, 0.f, 0.f, 0.f};
    bf16x8 At[4][2], B0[2][2], B1[2][2];
    const char* cA = (const char*)g.A + (size_t)cur.pm * tstep + (size_t)cur.kh * khoff; const char* cB = (const char*)g.Bt + (size_t)cur.pn * tstep + (size_t)cur.kh * khoff;
    S.a_ready(cur);
    if constexpr (SP2) {
        PG8_STAGE(PG8_SB(0, 0), cB, voffB); PG8_STAGE(PG8_SB(0, 1), cB + hstep, voffB); PG8_STAGE(PG8_SA(0, 0), cA, voffA); PG8_STAGE(PG8_SA(0, 1), cA + hstep, voffA);
        if (wr == 1) PG8_BAR;
        PG8_WAIT_V(2); PG8_BAR;
        PG8_STAGE(PG8_SB(1, 0), cB + kstep, voffB); PG8_STAGE(PG8_SA(1, 0), cA + kstep, voffA); PG8_STAGE(PG8_SB(1, 1), cB + hstep + kstep, voffB);
        PG8_WAIT_V(6); PG8_BAR;
    } else {
        PG8_STAGE(PG8_SB(0, 0), cB, voffB); PG8_STAGE(PG8_SA(0, 0), cA, voffA); PG8_STAGE(PG8_SB(0, 1), cB + hstep, voffB); PG8_STAGE(PG8_SA(0, 1), cA + hstep, voffA);
        if (wr == 1) PG8_BAR;
        PG8_WAIT_V(4); PG8_BAR;
        PG8_STAGE(PG8_SB(1, 0), cB + kstep, voffB); PG8_STAGE(PG8_SA(1, 0), cA + kstep, voffA); PG8_STAGE(PG8_SB(1, 1), cB + hstep + kstep, voffB);
        PG8_WAIT_V(6); PG8_BAR;
    }
    for (;;) {
        const bool has_next = S.next(ui + 1, nxt);
        const char* nA = has_next ? (const char*)g.A + (size_t)nxt.pm * tstep + (size_t)nxt.kh * khoff : cA; const char* nB = has_next ? (const char*)g.Bt + (size_t)nxt.pn * tstep + (size_t)nxt.kh * khoff : cB;
        for (int t = 0; t < nt; t += 2) {
            const bool last = (t == nt - 2);
            const char* a1 = cA + (size_t)(t + 1) * kstep;
            const char* a2 = last ? nA : cA + (size_t)(t + 2) * kstep; const char* b2 = last ? nB : cB + (size_t)(t + 2) * kstep;
            const char* a3 = a2 + kstep; const char* b3 = b2 + kstep;
            if (last && has_next) S.a_ready(nxt);
            if constexpr (SP2) {
            PG8_LDB(B0, 0, 0); PG8_LDB(B1, 0, 1); PG8_SCHED; PG8_LDA(At, 0, 0); PG8_STAGE(PG8_SA(1, 1), a1 + hstep, voffA);
            PG8_WAIT_V(8); PG8_WAIT_L(0); PG8_BAR; PG8_MMA(0, 0, At, B0); PG8_MMA(0, 1, At, B1); PG8_BAR; PG8_SCHED;
            PG8_LDA(At, 0, 1); PG8_STAGE(PG8_SB(0, 0), b2, voffB); PG8_STAGE(PG8_SB(0, 1), b2 + hstep, voffB); PG8_STAGE(PG8_SA(0, 0), a2, voffA);
            PG8_WAIT_V(8); PG8_WAIT_L(0); PG8_BAR; PG8_MMA(1, 0, At, B0); PG8_MMA(1, 1, At, B1); PG8_BAR; PG8_SCHED;
            PG8_LDB(B0, 1, 0); PG8_LDB(B1, 1, 1); PG8_SCHED; PG8_LDA(At, 1, 0); PG8_STAGE(PG8_SA(0, 1), a2 + hstep, voffA);
            PG8_WAIT_V(8); PG8_WAIT_L(0); PG8_BAR; PG8_MMA(0, 0, At, B0); PG8_MMA(0, 1, At, B1); PG8_BAR; PG8_SCHED;
            PG8_LDA(At, 1, 1); PG8_STAGE(PG8_SB(1, 0), b3, voffB); PG8_STAGE(PG8_SB(1, 1), b3 + hstep, voffB); PG8_STAGE(PG8_SA(1, 0), a3, voffA);
            PG8_WAIT_V(8); PG8_WAIT_L(0); PG8_BAR; PG8_MMA(1, 0, At, B0); PG8_MMA(1, 1, At, B1); PG8_BAR; PG8_SCHED;
            } else {
            PG8_LDB(B0, 0, 0); PG8_SCHED; PG8_LDA(At, 0, 0); PG8_STAGE(PG8_SA(1, 1), a1 + hstep, voffA);
            PG8_WAIT_L(8); PG8_BAR; PG8_WAIT_L(0); PG8_MMA(0, 0, At, B0); PG8_BAR; PG8_SCHED;
            PG8_LDB(B1, 0, 1); PG8_STAGE(PG8_SB(0, 0), b2, voffB);
            PG8_BAR; PG8_WAIT_L(0); PG8_MMA(0, 1, At, B1); PG8_BAR;
            PG8_LDA(At, 0, 1); PG8_STAGE(PG8_SA(0, 0), a2, voffA);
            PG8_BAR; PG8_WAIT_L(0); PG8_MMA(1, 0, At, B0); PG8_BAR; PG8_SCHED;
            PG8_STAGE(PG8_SB(0, 1), b2 + hstep, voffB);
            PG8_WAIT_V(6); PG8_BAR; PG8_MMA(1, 1, At, B1); PG8_BAR;
            PG8_LDB(B0, 1, 0); PG8_SCHED; PG8_LDA(At, 1, 0); PG8_STAGE(PG8_SA(0, 1), a2 + hstep, voffA);
            PG8_WAIT_L(8); PG8_BAR; PG8_WAIT_L(0); PG8_MMA(0, 0, At, B0); PG8_BAR; PG8_SCHED;
            PG8_LDB(B1, 1, 1); PG8_STAGE(PG8_SB(1, 0), b3, voffB);
            PG8_BAR; PG8_WAIT_L(0); PG8_MMA(0, 1, At, B1); PG8_BAR;
            PG8_LDA(At, 1, 1); PG8_STAGE(PG8_SA(1, 0), a3, voffA);
            PG8_BAR; PG8_WAIT_L(0); PG8_MMA(1, 0, At, B0); PG8_BAR; PG8_SCHED;
            PG8_STAGE(PG8_SB(1, 1), b3 + hstep, voffB);
            PG8_WAIT_V(6); PG8_BAR; PG8_MMA(1, 1, At, B1); PG8_BAR;
            }
        }
        if constexpr (ALIGN_EPI) { if (wr == 0) PG8_BAR; }
        if constexpr (!Epi::AFTER_DRAIN) { E(acc, cur, wr, wc, fr, fq); S.done(cur); }
        if (!has_next) break;
        if (!(Epi::SPLITK2 && cur.kh == 0))
#pragma unroll
        for (int a = 0; a < 2; ++a)
#pragma unroll
            for (int b = 0; b < 2; ++b)
#pragma unroll
                for (int m = 0; m < 4; ++m)
#pragma unroll
                    for (int n = 0; n < 2; ++n) acc[a][b][m][n] = (f32x4){0.f, 0.f, 0.f, 0.f};
        cur = nxt; cA = nA; cB = nB; ++ui;
        if constexpr (ALIGN_EPI) { if (wr == 1) PG8_BAR; }
    }
    PG8_WAIT_V(0);
    if constexpr (!ALIGN_EPI) { if (wr == 0) PG8_BAR; }
    PG8_BAR;
    if constexpr (Epi::AFTER_DRAIN) { E.fused(acc, cur, wr, wc, fr, fq, lds, wid, lane); S.done(cur); }
#undef PG8_SA
#undef PG8_SB
#undef PG8_STAGE
#undef PG8_LDA
#undef PG8_LDB
#undef PG8_MMA
#undef PG8_WAIT_V
#undef PG8_WAIT_L
#undef PG8_BAR
#undef PG8_SCHED
}
}
namespace epi {
using pg8::Unit;
typedef f32x4 Acc[2][2][4][2];

__device__ __forceinline__ void rot2(f32x4& v, const f32x4 cs) {
    const float a1 = v[0] * cs[0] - v[1] * cs[1], a2 = v[1] * cs[0] + v[0] * cs[1];
    const float b1 = v[2] * cs[2] - v[3] * cs[3], b2 = v[3] * cs[2] + v[2] * cs[3];
    v = (f32x4){a1, a2, b1, b2};
}
__device__ __forceinline__ float sigm(float x) { return 1.0f / (1.0f + __expf(-x)); }

template <bool F8> struct EpiIn {
    static constexpr bool PERM = true, AFTER_DRAIN = false, SPLITK2 = false, FP8 = F8;
    bf16_t *cq, *ckv, *qb, *kb, *vb, *qix, *kpe, *kix, *ga, *gb; float* wix; u64 *ssq_cq, *ssq_ckv;
    const float *ropeM, *ropeD, *ropeI;
    const float *sx, *sw;
    __device__ __forceinline__ void operator()(const Acc& acc, const Unit& u, int wr, int wc, int fr, int fq) const {
        const int vt = F8 ? (u.pn < 18 ? u.pn : u.pn + 5) : u.pn + 18, rowb = u.pm * 256 + wr * 64 + fr, ct = wc * 32 + 8 * fq;
        f32x4 wsc[2][2];
        if (F8) {
#pragma unroll
            for (int bj = 0; bj < 2; ++bj) { const f32x4* p = (const f32x4*)(sw + u.pn * 256 + ct + bj * 128); wsc[bj][0] = p[0]; wsc[bj][1] = p[1]; }
        }
#define AV(ai_, bj_, m_, n_) (F8 ? acc[ai_][bj_][m_][n_] * rs * wsc[bj_][n_] : acc[ai_][bj_][m_][n_])
        if (vt < 6) {
            bf16_t* dst = vt < 4 ? cq : ckv; const int ld = vt < 4 ? 1024 : 512, cb = (vt < 4 ? vt : vt - 4) * 256 + ct; u64* ssq = vt < 4 ? ssq_cq : ssq_ckv;
#pragma unroll
            for (int ai = 0; ai < 2; ++ai)
#pragma unroll
                for (int m = 0; m < 4; ++m) { const int row = rowb + ai * 128 + m * 16; const float rs = F8 ? sx[row] : 1.f; (void)rs; float s = 0.f;
#pragma unroll
                    for (int bj = 0; bj < 2; ++bj) { const f32x4 v0 = AV(ai, bj, m, 0), v1 = AV(ai, bj, m, 1);
                        s += (v0[0] * v0[0] + v0[1] * v0[1]) + (v0[2] * v0[2] + v0[3] * v0[3]) + (v1[0] * v1[0] + v1[1] * v1[1]) + (v1[2] * v1[2] + v1[3] * v1[3]);
                        *(u32x4*)(dst + (size_t)row * ld + cb + bj * 128) = pack8(v0, v1); }
                    s += __shfl_xor(s, 16); s += __shfl_xor(s, 32);
                    if (fq == 0 && ssq) ssq_add(ssq + row, s); }
        } else if (vt < 16) {
            const bool isq = vt < 14; bf16_t* dst = isq ? qb : kb; const int ld = isq ? 2048 : 512, cb = (isq ? vt - 6 : vt - 14) * 256 + ct; const float sc = isq ? QB_SCALE : 1.f;
#pragma unroll
            for (int ai = 0; ai < 2; ++ai)
#pragma unroll
                for (int m = 0; m < 4; ++m) { const int row = rowb + ai * 128 + m * 16, t = row_pos(row); const float rs = F8 ? sx[row] : 1.f; (void)rs;
                    f32x4 cs0 = (f32x4){1.f, 0.f, 1.f, 0.f}, cs1 = cs0;
                    if (wc == 0) { const f32x4* p = (const f32x4*)(ropeD + ((size_t)t * 16 + 4 * fq) * 2); cs0 = p[0]; cs1 = p[1]; }
#pragma unroll
                    for (int bj = 0; bj < 2; ++bj) { f32x4 v0 = AV(ai, bj, m, 0), v1 = AV(ai, bj, m, 1);
                        if (wc == 0) { rot2(v0, cs0); rot2(v1, cs1); }
                        v0 = v0 * sc; v1 = v1 * sc;
                        *(u32x4*)(dst + (size_t)row * ld + cb + bj * 128) = pack8(v0, v1); } }
        } else if (vt < 18) {
            const int cb = (vt - 16) * 256 + ct;
#pragma unroll
            for (int ai = 0; ai < 2; ++ai)
#pragma unroll
                for (int m = 0; m < 4; ++m) { const int row = rowb + ai * 128 + m * 16; const float rs = F8 ? sx[row] : 1.f; (void)rs;
#pragma unroll
                    for (int bj = 0; bj < 2; ++bj) *(u32x4*)(vb + (size_t)row * 512 + cb + bj * 128) = pack8(AV(ai, bj, m, 0), AV(ai, bj, m, 1)); }
        } else if (vt < 22) {
            const int cb = (vt - 18) * 256 + ct; const bool rt = ((wc & 1) == 0) && (fq < 2);
#pragma unroll
            for (int ai = 0; ai < 2; ++ai)
#pragma unroll
                for (int m = 0; m < 4; ++m) { const int row = rowb + ai * 128 + m * 16, t = row_pos(row); const float rs = F8 ? sx[row] : 1.f; (void)rs;
                    f32x4 cs0 = (f32x4){1.f, 0.f, 1.f, 0.f}, cs1 = cs0;
                    if (rt) { const f32x4* p = (const f32x4*)(ropeI + ((size_t)t * 8 + 4 * fq) * 2); cs0 = p[0]; cs1 = p[1]; }
#pragma unroll
                    for (int bj = 0; bj < 2; ++bj) { f32x4 v0 = AV(ai, bj, m, 0), v1 = AV(ai, bj, m, 1);
                        if (rt) { rot2(v0, cs0); rot2(v1, cs1); }
                        *(u32x4*)(qix + (size_t)row * 1024 + cb + bj * 128) = pack8(v0, v1); } }
        } else if (vt == 22) {
#pragma unroll
            for (int ai = 0; ai < 2; ++ai)
#pragma unroll
                for (int m = 0; m < 4; ++m) { const int row = rowb + ai * 128 + m * 16, t = row_pos(row); const float rs = F8 ? sx[row] : 1.f; (void)rs;
                    f32x4 v0 = AV(ai, 0, m, 0), v1 = AV(ai, 0, m, 1);
                    if (wc < 2) { const f32x4* p = (const f32x4*)(ropeM + ((size_t)t * 32 + 16 * wc + 4 * fq) * 2); rot2(v0, p[0]); rot2(v1, p[1]);
                        *(u32x4*)(kpe + (size_t)row * 64 + ct) = pack8(v0, v1);
                    } else { if (wc == 2 && fq < 2) { const f32x4* p = (const f32x4*)(ropeI + ((size_t)t * 8 + 4 * fq) * 2); rot2(v0, p[0]); rot2(v1, p[1]); }
                        *(u32x4*)(kix + (size_t)row * 64 + (ct - 64)) = pack8(v0, v1); }
                    if (wc == 0 && fq < 2) { float* w = wix + (size_t)row * 16 + 8 * fq; *(f32x4*)w = AV(ai, 1, m, 0); *(f32x4*)(w + 4) = AV(ai, 1, m, 1); } }
        } else {
            const bool isa = vt < 39; bf16_t* dst = isa ? ga : gb; const int cb = (isa ? vt - 23 : vt - 39) * 256 + ct;
#pragma unroll
            for (int ai = 0; ai < 2; ++ai)
#pragma unroll
                for (int m = 0; m < 4; ++m) { const int row = rowb + ai * 128 + m * 16; const float rs = F8 ? sx[row] : 1.f; (void)rs;
#pragma unroll
                    for (int bj = 0; bj < 2; ++bj) { f32x4 v0 = AV(ai, bj, m, 0), v1 = AV(ai, bj, m, 1);
#pragma unroll
                        for (int e = 0; e < 4; ++e) { v0[e] = sigm(v0[e]); v1[e] = sigm(v1[e]); }
                        *(u32x4*)(dst + (size_t)row * 4096 + cb + bj * 128) = pack8(v0, v1); } }
        }
#undef AV
    }
};

struct EpiUp {
    static constexpr bool PERM = true, AFTER_DRAIN = false, SPLITK2 = false, FP8 = false;
    bf16_t *d0, *d1; int nt0, ld0, ld1; const u64* ssq; float invK, scale; const float* rope;
    __device__ __forceinline__ void operator()(const Acc& acc, const Unit& u, int wr, int wc, int fr, int fq) const {
        const int vt = u.pn, rowb = u.pm * 256 + wr * 64 + fr, ct = wc * 32 + 8 * fq; const bool first = vt < nt0;
        bf16_t* dst = first ? d0 : d1; const int ld = first ? ld0 : ld1, cb = (first ? vt : vt - nt0) * 256 + ct; const bool rt = (!first) && (rope != nullptr);
#pragma unroll
        for (int ai = 0; ai < 2; ++ai)
#pragma unroll
            for (int m = 0; m < 4; ++m) { const int row = rowb + ai * 128 + m * 16, t = row_pos(row);
                const float rs = __builtin_amdgcn_rsqf(ssq_get(ssq + row) * invK + EPS) * scale;
                f32x4 cs0 = (f32x4){1.f, 0.f, 1.f, 0.f}, cs1 = cs0;
                if (rt) { const f32x4* p = (const f32x4*)(rope + ((size_t)t * 32 + 16 * (wc & 1) + 4 * fq) * 2); cs0 = p[0]; cs1 = p[1]; }
#pragma unroll
                for (int bj = 0; bj < 2; ++bj) { f32x4 v0 = acc[ai][bj][m][0] * rs, v1 = acc[ai][bj][m][1] * rs;
                    if (rt) { rot2(v0, cs0); rot2(v1, cs1); }
                    *(u32x4*)(dst + (size_t)row * ld + cb + bj * 128) = pack8(v0, v1); } }
    }
};

struct EpiBranch {
    static constexpr bool PERM = true, AFTER_DRAIN = false, SPLITK2 = true, FP8 = true;
    const bf16_t *ga, *gb; bf16_t* out; const float *srow, *scol;
    __device__ __forceinline__ void operator()(Acc& acc, const Unit& u, int wr, int wc, int fr, int fq) const {
        const int rowb = u.pm * 256 + wr * 64 + fr, cb = u.pn * 256 + wc * 32 + 8 * fq;
        if (u.kh == 0) {
#pragma unroll
            for (int ai = 0; ai < 2; ++ai)
#pragma unroll
                for (int m = 0; m < 4; ++m) { const size_t ro = (size_t)(rowb + ai * 128 + m * 16) * 4096 + cb;
#pragma unroll
                    for (int bj = 0; bj < 2; ++bj) { const u32x4 a = *(const u32x4*)(ga + ro + bj * 128), b = *(const u32x4*)(gb + ro + bj * 128);
                        f32x4 r0, r1;
#define RQ(x, y) ((x) * __builtin_amdgcn_rcpf(y))
                        r0[0] = RQ(bf_lo(a.x), bf_lo(b.x)); r0[1] = RQ(bf_hi(a.x), bf_hi(b.x)); r0[2] = RQ(bf_lo(a.y), bf_lo(b.y)); r0[3] = RQ(bf_hi(a.y), bf_hi(b.y));
                        r1[0] = RQ(bf_lo(a.z), bf_lo(b.z)); r1[1] = RQ(bf_hi(a.z), bf_hi(b.z)); r1[2] = RQ(bf_lo(a.w), bf_lo(b.w)); r1[3] = RQ(bf_hi(a.w), bf_hi(b.w));
#undef RQ
                        acc[ai][bj][m][0] = acc[ai][bj][m][0] * r0; acc[ai][bj][m][1] = acc[ai][bj][m][1] * r1; }
                    asm volatile("" ::: "memory"); }
        } else {
            f32x4 w0[2], w1[2];
#pragma unroll
            for (int bj = 0; bj < 2; ++bj) { const f32x4* p = (const f32x4*)(scol + cb + bj * 128); w0[bj] = p[0]; w1[bj] = p[1]; }
#pragma unroll
            for (int ai = 0; ai < 2; ++ai)
#pragma unroll
                for (int m = 0; m < 4; ++m) { const int row = rowb + ai * 128 + m * 16; const size_t ro = (size_t)row * 4096 + cb; const float rs = srow[row];
#pragma unroll
                    for (int bj = 0; bj < 2; ++bj) { const u32x4 b = *(const u32x4*)(gb + ro + bj * 128);
                        const f32x4 s0 = (f32x4){bf_lo(b.x), bf_hi(b.x), bf_lo(b.y), bf_hi(b.y)} * rs * w0[bj], s1 = (f32x4){bf_lo(b.z), bf_hi(b.z), bf_lo(b.w), bf_hi(b.w)} * rs * w1[bj];
                        *(u32x4*)(out + ro + bj * 128) = pack8(acc[ai][bj][m][0] * s0, acc[ai][bj][m][1] * s1); } }
        }
    }
};

struct EpiOut {
    static constexpr bool PERM = true, AFTER_DRAIN = false, SPLITK2 = false, FP8 = true;
    const float *x, *meta; float* h1f; bf16_t* h1b; u64* ssq; const float *srow, *scol;
    __device__ __forceinline__ void operator()(const Acc& acc, const Unit& u, int wr, int wc, int fr, int fq) const {
        const int rowb = u.pm * 256 + wr * 64 + fr, cb = u.pn * 256 + wc * 32 + 8 * fq;
#pragma unroll
        for (int ai = 0; ai < 2; ++ai)
#pragma unroll
            for (int m = 0; m < 4; ++m) { const int row = rowb + ai * 128 + m * 16;
                const float* src = x + (size_t)row * DM;
                float s = 0.f; const float rs = srow[row];
#pragma unroll
                for (int bj = 0; bj < 2; ++bj) { const f32x4* wp = (const f32x4*)(scol + cb + bj * 128); f32x4 v0 = acc[ai][bj][m][0] * rs * wp[0], v1 = acc[ai][bj][m][1] * rs * wp[1];
                    v0 = v0 + *(const f32x4*)(src + cb + bj * 128); v1 = v1 + *(const f32x4*)(src + cb + bj * 128 + 4);
                    s += (v0[0] * v0[0] + v0[1] * v0[1]) + (v0[2] * v0[2] + v0[3] * v0[3]) + (v1[0] * v1[0] + v1[1] * v1[1]) + (v1[2] * v1[2] + v1[3] * v1[3]);
                    float* o = h1f + (size_t)row * DM + cb + bj * 128; *(f32x4*)o = v0; *(f32x4*)(o + 4) = v1;
                    *(u32x4*)(h1b + (size_t)row * DM + cb + bj * 128) = pack8(v0, v1); }
                s += __shfl_xor(s, 16); s += __shfl_xor(s, 32);
                if (fq == 0 && ssq) ssq_add(ssq + row, s); }
    }
};

struct EpiPQ {
    static constexpr bool PERM = true, AFTER_DRAIN = false, SPLITK2 = false, FP8 = false;
    bf16_t* pq; const u64* ssq;
    __device__ __forceinline__ void operator()(const Acc& acc, const Unit& u, int wr, int wc, int fr, int fq) const {
        const int rowb = u.pm * 256 + wr * 64 + fr, cb = u.pn * 256 + wc * 32 + 8 * fq;
#pragma unroll
        for (int ai = 0; ai < 2; ++ai)
#pragma unroll
            for (int m = 0; m < 4; ++m) { const int row = rowb + ai * 128 + m * 16; const float rs = __builtin_amdgcn_rsqf(ssq_get(ssq + row) * (1.0f / DM) + EPS);
#pragma unroll
                for (int bj = 0; bj < 2; ++bj) *(u32x4*)(pq + (size_t)row * 2048 + cb + bj * 128) = pack8(acc[ai][bj][m][0] * rs, acc[ai][bj][m][1] * rs); }
    }
};
}
#define XB_TMO      128
#define XB_XCNT(j)  (256  + 64 * (j))
#define XB_XSUB(j)  (1280 + 64 * (j))
#define XB_XGEN(j)  (2304 + 64 * (j))
#define XB_TOP      3328
#define XB_TOPGEN   3392
#define XCD_BAR_WORDS 3456
#define XB_SPIN_CAP (1u << 18)
__device__ __forceinline__ unsigned xb_ld(unsigned* p)              { return __hip_atomic_load(p, __ATOMIC_RELAXED, __HIP_MEMORY_SCOPE_AGENT); }
__device__ __forceinline__ unsigned xb_add(unsigned* p, unsigned v) { return __hip_atomic_fetch_add(p, v, __ATOMIC_RELAXED, __HIP_MEMORY_SCOPE_AGENT); }
__device__ __forceinline__ unsigned xb_xcc_id() { return (unsigned)__builtin_amdgcn_s_getreg((3 << 11) | 20) & 0xFu; }
#define XB_SPIN(cond, bar) do { unsigned _sp = 0; while (cond) { __builtin_amdgcn_s_sleep(1); \
    if ((++_sp & 255u) == 0u) { if (xb_ld(&(bar)[XB_TMO])) break; if (_sp > XB_SPIN_CAP) { atomicAdd(&(bar)[XB_TMO], 1u); break; } } } } while (0)
struct XcdBarrier { unsigned* bar; unsigned x; volatile LAS unsigned* st; };
__device__ __forceinline__ XcdBarrier xcd_barrier_post(unsigned* bar, volatile LAS unsigned* st) {
    XcdBarrier b; b.bar = bar; b.x = xb_xcc_id(); b.st = st;
    if (threadIdx.x == 0) (void)xb_add(&bar[XB_XCNT(b.x)], 1u);
    return b;
}
__device__ __forceinline__ void xcd_barrier_complete(unsigned* bar, unsigned x, unsigned& nloc, unsigned& nx) {
    const unsigned G = gridDim.x * gridDim.y * gridDim.z;
    unsigned sum, cnt, mine, sp = 0u;
    for (;;) {
        sum = 0u; cnt = 0u; mine = 0u;
#pragma unroll
        for (unsigned j = 0; j < 16; ++j) { const unsigned c = xb_ld(&bar[XB_XCNT(j)]); sum += c; cnt += (c > 0u) ? 1u : 0u; mine = (j == x) ? c : mine; }
        if (sum == G) break;
        __builtin_amdgcn_s_sleep(1);
        if ((++sp & 255u) == 0u) { if (xb_ld(&bar[XB_TMO])) break; if (sp > XB_SPIN_CAP) { atomicAdd(&bar[XB_TMO], 1u); break; } }
    }
    nloc = mine > 0u ? mine : 1u; nx = cnt > 0u ? cnt : 1u;
}
__device__ __forceinline__ void xcd_barrier(const XcdBarrier& b) {
    asm volatile("s_waitcnt vmcnt(0)" ::: "memory");
    __syncthreads();
    if (threadIdx.x == 0) {
        unsigned* bar = b.bar;
        __builtin_amdgcn_s_waitcnt(0);
        unsigned nloc = b.st[0], nx = b.st[1];
        if (nloc == 0u) { xcd_barrier_complete(bar, b.x, nloc, nx); b.st[0] = nloc; b.st[1] = nx; }
        const unsigned old = xb_add(&bar[XB_XSUB(b.x)], 1u);
        const unsigned gen = old / nloc;
        if (old + 1u == (gen + 1u) * nloc) {
            __builtin_amdgcn_fence(__ATOMIC_RELEASE, "agent");
            asm volatile("s_waitcnt vmcnt(0)" ::: "memory");
            const unsigned og = xb_add(&bar[XB_TOP], 1u);
            const unsigned tg = og / nx;
            if (og + 1u == (tg + 1u) * nx) xb_add(&bar[XB_TOPGEN], 1u);
            else XB_SPIN(xb_ld(&bar[XB_TOPGEN]) == tg, bar);
            __builtin_amdgcn_fence(__ATOMIC_ACQUIRE, "agent");
            xb_add(&bar[XB_XGEN(b.x)], 1u);
            asm volatile("s_waitcnt vmcnt(0)" ::: "memory");
        } else {
            XB_SPIN(xb_ld(&bar[XB_XGEN(b.x)]) == gen, bar);
            __builtin_amdgcn_fence(__ATOMIC_ACQUIRE, "agent");
            asm volatile("s_waitcnt vmcnt(0)" ::: "memory");
        }
    }
    __syncthreads();
}

struct Frame {
    LAS unsigned char* lds;
    unsigned char* ws;
    unsigned* ctl;
    int tid, lane, wave, vcu, G;
    __device__ __forceinline__ const float* in(int i) const { return ((const float* const __attribute__((address_space(4)))*)__builtin_amdgcn_kernarg_segment_ptr())[i]; }
    __device__ __forceinline__ float* out() const { return ((float* const __attribute__((address_space(4)))*)__builtin_amdgcn_kernarg_segment_ptr())[16]; }
};

struct MapId { __device__ __forceinline__ int operator()(int v) const { return v; } };
struct MapIn { __device__ __forceinline__ int operator()(int vn) const {
    const int v = vn < 1280 ? vn + 4608 : (vn < 5888 ? vn - 1280 : vn);
    if (v < 1536) return v;
    if (v < 3584) { const int w = v - 1536, hd = w >> 7; int o = w & 127; if (o < 32) o = (o & 1) ? (o >> 1) + 16 : (o >> 1); return 1600 + hd * 128 + o; }
    if (v < 4096) { const int w = v - 3584, hd = w >> 7; int o = w & 127; if (o < 32) o = (o & 1) ? (o >> 1) + 16 : (o >> 1); return 3648 + hd * 128 + o; }
    if (v < 4608) return 4160 + (v - 4096);
    if (v < 5632) { const int w = v - 4608, hd = w >> 6; int o = w & 63; if (o < 16) o = (o & 1) ? (o >> 1) + 8 : (o >> 1); return 4672 + hd * 64 + o; }
    if (v < 5888) { const int w = v - 5632;
        if (w < 64) return 1536 + ((w & 1) ? (w >> 1) + 32 : (w >> 1));
        if (w < 128) { int o = w - 64; if (o < 16) o = (o & 1) ? (o >> 1) + 8 : (o >> 1); return 5696 + o; }
        if (w < 144) return 5760 + (w - 128);
        return -1; }
    if (v < 9984) return 5776 + (v - 5888);
    return 9872 + (v - 9984);
} };
struct MapUq { __device__ __forceinline__ int operator()(int v) const {
    if (v < 2048) return (v >> 7) * 192 + (v & 127);
    const int w = v - 2048, hd = w >> 6, o = w & 63; return hd * 192 + 128 + ((o & 1) ? (o >> 1) + 32 : (o >> 1)); } };
struct MapUkv { __device__ __forceinline__ int operator()(int v) const {
    if (v < 2048) return (v >> 7) * 256 + (v & 127);
    const int w = v - 2048; return (w >> 7) * 256 + 128 + (w & 127); } };

template <class Map>
__device__ __forceinline__ void p0_transpose_item(const float* W, int K, int Nsrc, int Nvirt, bf16_t* WT, const float* gk, LAS float* scr, int item, int lane, Map map) {
    const int nblk = Nvirt / 32, kb = item / nblk, nb = item % nblk, k0 = 64 * kb, n0 = 32 * nb;
    const int sc = map(n0 + (lane & 31));
    float tv[32];
#pragma unroll
    for (int i = 0; i < 32; ++i) { const int kk = 2 * i + (lane >> 5); tv[i] = (sc >= 0) ? W[(size_t)(k0 + kk) * Nsrc + sc] : 0.f; }
    if (gk) {
#pragma unroll
        for (int i = 0; i < 32; ++i) tv[i] *= gk[k0 + 2 * i + (lane >> 5)]; }
#pragma unroll
    for (int i = 0; i < 32; ++i) scr[(2 * i + (lane >> 5)) * 33 + (lane & 31)] = tv[i];
    LDS_WAIT(); asm volatile("" ::: "memory");
    const int c = lane & 7;
#pragma unroll
    for (int j = 0; j < 4; ++j) { const int n = (lane >> 3) + 8 * j; const LAS float* s = scr + (8 * c) * 33 + n;
        u32x4 o; o.x = pk2(s[0 * 33], s[1 * 33]); o.y = pk2(s[2 * 33], s[3 * 33]); o.z = pk2(s[4 * 33], s[5 * 33]); o.w = pk2(s[6 * 33], s[7 * 33]);
        *(u32x4*)(WT + (size_t)(n0 + n) * K + k0 + 8 * c) = o; }
    LDS_WAIT(); asm volatile("" ::: "memory");
}
__device__ __forceinline__ float wave_max(float v) {
#pragma unroll
    for (int o = 1; o < 64; o <<= 1) v = fmaxf(v, __shfl_xor(v, o));
    return v;
}
__device__ __forceinline__ void p0_xn_row(const Frame& F, int m) {
    const float* x = F.in(0); const float* meta = F.in(1); const float* g = F.in(2);
    bf16_t* o = (bf16_t*)(F.ws + WS_XN) + (size_t)m * DM;
    u32x2* o8 = (u32x2*)o + F.lane;
    if (m >= NTOK + NMETA) {
        unsigned* z8 = (unsigned*)(F.ws + WS_XN8 + (size_t)m * DM) + F.lane;
#pragma unroll
        for (int j = 0; j < 16; ++j) { o8[64 * j] = (u32x2){0u, 0u}; z8[64 * j] = 0u; }
        if (F.lane == 0) ((float*)(F.ws + WS_SX))[m] = 0.f;
        return; }
    const float* src = m < NTOK ? x + (size_t)m * DM : meta + (size_t)(m - NTOK) * DM;
    const f32x4* xr = (const f32x4*)src + F.lane; const f32x4* gr = (const f32x4*)g + F.lane;
    f32x4 v[16]; float s = 0.f;
#pragma unroll
    for (int j = 0; j < 16; ++j) { v[j] = xr[64 * j]; s += (v[j][0] * v[j][0] + v[j][1] * v[j][1]) + (v[j][2] * v[j][2] + v[j][3] * v[j][3]); }
    const float rstd = 1.0f / sqrtf(wave_sum(s) * (1.0f / DM) + EPS);
    float mx = 0.f;
#pragma unroll
    for (int j = 0; j < 16; ++j) { const f32x4 gg = gr[64 * j]; v[j] = v[j] * rstd * gg; o8[64 * j] = (u32x2){pk2(v[j][0], v[j][1]), pk2(v[j][2], v[j][3])};
        mx = fmaxf(mx, fmaxf(fmaxf(fabsf(v[j][0]), fabsf(v[j][1])), fmaxf(fabsf(v[j][2]), fabsf(v[j][3])))); }
    mx = fmaxf(wave_max(mx), 1e-30f);
    const float inv = 448.0f / mx;
    if (F.lane == 0) ((float*)(F.ws + WS_SX))[m] = mx * (1.0f / 448.0f);
    unsigned* q8 = (unsigned*)(F.ws + WS_XN8 + (size_t)m * DM) + F.lane;
#pragma unroll
    for (int j = 0; j < 16; ++j) { f32x4 q = v[j] * inv;
#pragma unroll
        for (int e = 0; e < 4; ++e) q[e] = fminf(fmaxf(q[e], -448.0f), 448.0f);
        int p = 0; p = __builtin_amdgcn_cvt_pk_fp8_f32(q[0], q[1], p, false); p = __builtin_amdgcn_cvt_pk_fp8_f32(q[2], q[3], p, true); q8[64 * j] = (unsigned)p; }
}
__device__ __forceinline__ void p0_prologue(const Frame& F) {
    LAS float* scr = (LAS float*)(F.lds + F.wave * 16384);
    const int gw = F.vcu * NWAVES + F.wave, NGW = F.G * NWAVES;
    const float* w_in = F.in(3); const float* qg = F.in(4); const float* w_uq = F.in(5); const float* kvg = F.in(6); const float* w_ukv = F.in(7);
    const float* w_br = F.in(8); const float* w_out = F.in(9); const float* fg = F.in(10); const float* w_q = F.in(11); const float* sk = F.in(12);
    constexpr int I_IN = 64 * (NV1 / 32), I_UQ = 16 * (3072 / 32), I_UKV = 8 * (4096 / 32), I_BR = 64 * 128, I_OUT = 64 * 128, I_Q = 64 * 64;
    constexpr int NITEMS = I_IN + I_UQ + I_UKV + I_BR + I_OUT + I_Q;
    for (int it = gw; it < NITEMS; it += NGW) {
        int r = it;
        if (r < I_IN) { p0_transpose_item(w_in, 4096, 13968, NV1, (bf16_t*)(F.ws + WS_WIN), nullptr, scr, r, F.lane, MapIn()); continue; } r -= I_IN;
        if (r < I_UQ) { p0_transpose_item(w_uq, 1024, 3072, 3072, (bf16_t*)(F.ws + WS_WUQ), qg, scr, r, F.lane, MapUq()); continue; } r -= I_UQ;
        if (r < I_UKV) { p0_transpose_item(w_ukv, 512, 4096, 4096, (bf16_t*)(F.ws + WS_WUKV), kvg, scr, r, F.lane, MapUkv()); continue; } r -= I_UKV;
        if (r < I_BR) { p0_transpose_item(w_br, 4096, 4096, 4096, (bf16_t*)(F.ws + WS_WBR), nullptr, scr, r, F.lane, MapId()); continue; } r -= I_BR;
        if (r < I_OUT) { p0_transpose_item(w_out, 4096, 4096, 4096, (bf16_t*)(F.ws + WS_WOUT), nullptr, scr, r, F.lane, MapId()); continue; } r -= I_OUT;
        p0_transpose_item(w_q, 4096, 2048, 2048, (bf16_t*)(F.ws + WS_WQ), fg, scr, r, F.lane, MapId());
    }
    for (int m = gw; m < MK; m += NGW) p0_xn_row(F, m);
    const int gt = (F.vcu * NWAVES + F.wave) * 64 + F.lane, NGT = NGW * 64;
    for (int i = gt; i < TP * 56; i += NGT) {
        const int t = i / 56, r = i % 56; int j, rot; float* dst;
        if (r < 32) { j = r; rot = 64; dst = (float*)(F.ws + WS_ROPE_M) + ((size_t)t * 32 + j) * 2; }
        else if (r < 48) { j = r - 32; rot = 32; dst = (float*)(F.ws + WS_ROPE_D) + ((size_t)t * 16 + j) * 2; }
        else { j = r - 48; rot = 16; dst = (float*)(F.ws + WS_ROPE_I) + ((size_t)t * 8 + j) * 2; }
        const float ex = (float)(2 * j) / (float)rot;
        const float inv = powf(500000.0f, -ex);
        const float ang = (float)t * inv;
        const double a = (double)ang, kq = rint(a * 0.15915494309189535), rr = fma(-kq, 6.283185307179586, a);
        const float rf = (float)rr;
        dst[0] = cosf(rf); dst[1] = sinf(rf);
    }
    for (int i = gt; i < 16 * 128 * 128 / 8; i += NGT) { const f32x4* s = (const f32x4*)sk + 2 * (size_t)i; const f32x4 a = s[0], b2 = s[1];
        u32x4 o; o.x = pk2(a[0], a[1]); o.y = pk2(a[2], a[3]); o.z = pk2(b2[0], b2[1]); o.w = pk2(b2[2], b2[3]); ((u32x4*)(F.ws + WS_SK))[i] = o; }
}
__device__ __forceinline__ unsigned fp6_code(float q) {
    const unsigned b = __float_as_uint(q), sgn = (b >> 31) << 5; const float aq = fabsf(q);
    const unsigned sub = (unsigned)rintf(aq * 8.0f);
    unsigned ab = b & 0x7fffffffu; ab = ab + 0x7FFFFu + ((ab >> 20) & 1u);
    const unsigned nrm = (ab >> 20) - (126u << 3);
    unsigned code = aq < 1.0f ? sub : nrm; code = code > 31u ? 31u : code;
    return code | sgn;
}
__device__ __forceinline__ void fp6_pack32(const unsigned (&c)[32], unsigned (&w)[6]) {
#pragma unroll
    for (int i = 0; i < 6; ++i) w[i] = 0u;
#pragma unroll
    for (int k = 0; k < 32; ++k) { const int bit = 6 * k, d = bit >> 5, sh = bit & 31; w[d] |= c[k] << sh; if (sh > 26) w[d + 1] |= c[k] >> (32 - sh); }
}
__device__ __forceinline__ void p6_quant_row(const float* src, const float* gain, unsigned char* dst, float* scale_out, int lane) {
    const f32x4* s = (const f32x4*)src + lane; f32x4 v[16]; float mx = 0.f;
#pragma unroll
    for (int j = 0; j < 16; ++j) { v[j] = s[64 * j]; if (gain) v[j] = v[j] * ((const f32x4*)gain)[lane + 64 * j];
        mx = fmaxf(mx, fmaxf(fmaxf(fabsf(v[j][0]), fabsf(v[j][1])), fmaxf(fabsf(v[j][2]), fabsf(v[j][3])))); }
    mx = fmaxf(wave_max(mx), 1e-30f);
    const float sc = mx * (1.0f / 7.5f), inv = 7.5f / mx;
    if (lane == 0) *scale_out = sc;
    unsigned w[12];
#pragma unroll
    for (int g = 0; g < 2; ++g) { unsigned c[32];
#pragma unroll
        for (int j = 0; j < 8; ++j)
#pragma unroll
            for (int i = 0; i < 4; ++i) c[4 * j + i] = fp6_code(v[8 * g + j][i] * inv);
        unsigned ww[6]; fp6_pack32(c, ww);
#pragma unroll
        for (int i = 0; i < 6; ++i) w[6 * g + i] = ww[i]; }
#pragma unroll
    for (int q = 0; q < 3; ++q) *(u32x4*)(dst + 1024 * q + 16 * lane) = (u32x4){w[4 * q], w[4 * q + 1], w[4 * q + 2], w[4 * q + 3]};
}
__device__ __forceinline__ unsigned fp4_code(float q) {
    const float aq = fabsf(q);
    const unsigned c = (aq > 0.25f ? 1u : 0u) + (aq >= 0.75f ? 1u : 0u) + (aq > 1.25f ? 1u : 0u) + (aq >= 1.75f ? 1u : 0u) + (aq > 2.5f ? 1u : 0u) + (aq >= 3.5f ? 1u : 0u) + (aq > 5.0f ? 1u : 0u);
    return c | ((__float_as_uint(q) >> 31) << 3);
}
__device__ __forceinline__ void p6_quant_row4(const float* src, const float* gain, unsigned char* dst, float* scale_out, int lane) {
    const f32x4* s = (const f32x4*)src + lane; f32x4 v[16]; float mx = 0.f;
#pragma unroll
    for (int j = 0; j < 16; ++j) { v[j] = s[64 * j]; if (gain) v[j] = v[j] * ((const f32x4*)gain)[lane + 64 * j];
        mx = fmaxf(mx, fmaxf(fmaxf(fabsf(v[j][0]), fabsf(v[j][1])), fmaxf(fabsf(v[j][2]), fabsf(v[j][3])))); }
    mx = fmaxf(wave_max(mx), 1e-30f);
    const float sc = mx * (1.0f / 6.0f), inv = 6.0f / mx;
    if (lane == 0) *scale_out = sc;
    unsigned w[8];
#pragma unroll
    for (int d = 0; d < 8; ++d) { unsigned x = 0u;
#pragma unroll
        for (int i = 0; i < 4; ++i) { x |= fp4_code(v[2 * d][i] * inv) << (4 * i); x |= fp4_code(v[2 * d + 1][i] * inv) << (16 + 4 * i); }
        w[d] = x; }
#pragma unroll
    for (int q = 0; q < 2; ++q) *(u32x4*)(dst + 1024 * q + 16 * lane) = (u32x4){w[4 * q], w[4 * q + 1], w[4 * q + 2], w[4 * q + 3]};
}
#ifndef PEER_U_BITS
#define PEER_U_BITS 4
#endif
#ifndef PEER_V_BITS
#define PEER_V_BITS 4
#endif
constexpr int PEER_U_ROWB = PEER_U_BITS == 4 ? 2048 : 3072, PEER_V_ROWB = PEER_V_BITS == 4 ? 2048 : 3072;
__device__ __forceinline__ void p6_tables(const Frame& F) {
    const float* fg = F.in(10); const float* pu = F.in(13); const float* pv = F.in(14);
    const int gw = F.vcu * NWAVES + F.wave, NGW = F.G * NWAVES;
    for (int it = gw; it < 2 * 16384; it += NGW) { const int e = it >> 1;
        if (it & 1) { if (PEER_V_BITS == 4) p6_quant_row4(pv + (size_t)e * DM, nullptr, F.ws + WS_V + (size_t)e * PEER_V_ROWB, (float*)(F.ws + WS_SCV) + e, F.lane);
                      else p6_quant_row(pv + (size_t)e * DM, nullptr, F.ws + WS_V + (size_t)e * PEER_V_ROWB, (float*)(F.ws + WS_SCV) + e, F.lane); }
        else { if (PEER_U_BITS == 4) p6_quant_row4(pu + (size_t)e * DM, fg, F.ws + WS_U + (size_t)e * PEER_U_ROWB, (float*)(F.ws + WS_SCU) + e, F.lane);
               else p6_quant_row(pu + (size_t)e * DM, fg, F.ws + WS_U + (size_t)e * PEER_U_ROWB, (float*)(F.ws + WS_SCU) + e, F.lane); } }
}

__device__ __forceinline__ void rowquant_fp8(const Frame& F, const unsigned char* src, size_t src_pitch, unsigned char* dst, size_t dst_pitch, float* scale, int nrows) {
    const int gw = F.vcu * NWAVES + F.wave, NGW = F.G * NWAVES, lane = F.lane;
    for (int n = gw; n < nrows; n += NGW) {
        const u32x4* s = (const u32x4*)(src + (size_t)n * src_pitch) + lane;
        u32x4 v[8]; float mx = 0.f;
#pragma unroll
        for (int j = 0; j < 8; ++j) { v[j] = s[64 * j];
#pragma unroll
            for (int e = 0; e < 4; ++e) mx = fmaxf(mx, fmaxf(fabsf(bf_lo(v[j][e])), fabsf(bf_hi(v[j][e])))); }
        mx = fmaxf(wave_max(mx), 1e-30f);
        const float inv = 448.0f / mx;
        if (lane == 0) scale[n] = mx * (1.0f / 448.0f);
        asm volatile("" ::: "memory");
        u32x2* d = (u32x2*)(dst + (size_t)n * dst_pitch) + lane;
#pragma unroll
        for (int j = 0; j < 8; ++j) { int p0 = 0, p1 = 0;
            p0 = __builtin_amdgcn_cvt_pk_fp8_f32(bf_lo(v[j].x) * inv, bf_hi(v[j].x) * inv, p0, false); p0 = __builtin_amdgcn_cvt_pk_fp8_f32(bf_lo(v[j].y) * inv, bf_hi(v[j].y) * inv, p0, true);
            p1 = __builtin_amdgcn_cvt_pk_fp8_f32(bf_lo(v[j].z) * inv, bf_hi(v[j].z) * inv, p1, false); p1 = __builtin_amdgcn_cvt_pk_fp8_f32(bf_lo(v[j].w) * inv, bf_hi(v[j].w) * inv, p1, true);
            d[64 * j] = (u32x2){(unsigned)p0, (unsigned)p1}; }
    }
}
__device__ __forceinline__ void p1_quant_weights(const Frame& F) {
    rowquant_fp8(F, F.ws + WS_WIN + (size_t)1280 * DM * 2, (size_t)DM * 2, F.ws + WS_WG8, (size_t)DM, (float*)(F.ws + WS_SW), 12800);
    rowquant_fp8(F, F.ws + WS_WBR, (size_t)DM * 2, F.ws + WS_WBR, (size_t)DM * 2, (float*)(F.ws + WS_SWBR), 4096);
    rowquant_fp8(F, F.ws + WS_WOUT, (size_t)DM * 2, F.ws + WS_WOUT, (size_t)DM * 2, (float*)(F.ws + WS_SWOUT), 4096);
}
#define MFMA32(a, b, c) __builtin_amdgcn_mfma_f32_32x32x16_bf16((a), (b), (c), 0, 0, 0)
__device__ __forceinline__ float relu_i(float x) { const int v = __float_as_int(x); return __int_as_float(v > 0 ? v : 0); }
__device__ __forceinline__ int crow(int i, int h) { return (i & 3) + 8 * (i >> 2) + 4 * h; }
__device__ __forceinline__ float half_sum_f(float v) {
#pragma unroll
    for (int o = 1; o < 32; o <<= 1) v += __shfl_xor(v, o);
    return v;
}
__device__ __forceinline__ int half_sum_i(int v) {
#pragma unroll
    for (int o = 1; o < 32; o <<= 1) v += __shfl_xor(v, o);
    return v;
}
__device__ __forceinline__ float half_max_f(float v) {
#pragma unroll
    for (int o = 1; o < 32; o <<= 1) v = fmaxf(v, __shfl_xor(v, o));
    return v;
}
__device__ __forceinline__ float half_min_f(float v) {
#pragma unroll
    for (int o = 1; o < 32; o <<= 1) v = fminf(v, __shfl_xor(v, o));
    return v;
}
constexpr int IDX_PK = 144, IDX_BUF = 64 * IDX_PK;
__device__ __forceinline__ void idx_task(const Frame& F, int b, int s0c) {
    const int lane = F.lane, r = lane & 31, h = lane >> 5, tid = F.tid;
    const int s0 = s0c + 2 * F.wave;
    LAS unsigned char* lds = F.lds;
    const bf16_t* qix = (const bf16_t*)(F.ws + WS_QIX); const bf16_t* kix = (const bf16_t*)(F.ws + WS_KIX); const float* wix = (const float*)(F.ws + WS_WIX);
    unsigned* mask = (unsigned*)(F.ws + WS_MASK);
    const int tok = (r >> 2) & 1, head = (r & 3) + 4 * (r >> 3);
    const bf16_t* qp = qix + (size_t)(b * SEQ + s0 + tok) * 1024 + head * 64 + 8 * h;
    bf16x8 af[4];
#pragma unroll
    for (int ks = 0; ks < 4; ++ks) af[ks] = *(const bf16x8*)(qp + 16 * ks);
    const f32x4* wp = (const f32x4*)(wix + (size_t)(b * SEQ + s0 + h) * 16);
    float w[16];
#pragma unroll
    for (int q = 0; q < 4; ++q) { const f32x4 x = wp[q]; w[4 * q] = x[0]; w[4 * q + 1] = x[1]; w[4 * q + 2] = x[2]; w[4 * q + 3] = x[3]; }
    const int tq = NMETA + s0 + h;
    int tqr = tq - r; asm volatile("" : "+v"(tqr));
    const int ngrp = ((NMETA + s0c + 15) >> 6) + 1;
    const int skey = tid >> 3, spc = tid & 7;
    int brow = b * SEQ - NMETA; asm volatile("" : "+s"(brow));
    const bf16_t* kcur = kix + ((long)brow + skey) * 64 + spc * 8;
    const int sdst = skey * IDX_PK + spc * 16;
    const int boff = r * IDX_PK + 16 * h;
    u32x4 kst = *(const u32x4*)(skey < NMETA ? kix + (size_t)(NTOK + skey) * 64 + spc * 8 : kcur);
    float row[MW];
#pragma unroll
    for (int g = 0; g < MW / 2; ++g) {
        float s0v = -INFINITY, s1v = -INFINITY;
        const int bo = (g & 1) * IDX_BUF;
        if (g < ngrp) *(LAS u32x4*)(lds + bo + sdst) = kst;
        __syncthreads();
        kcur += 64 * 64; asm volatile("" : "+v"(kcur));
        if (g + 1 < ngrp) kst = *(const u32x4*)kcur;
        if (g < ngrp) {
            float x0 = 0.f, x1 = 0.f;
            { bf16x8 bb[4]; f32x16 a0;
#pragma unroll
              for (int ks = 0; ks < 4; ++ks) bb[ks] = *(const LAS bf16x8*)(lds + bo + boff + 32 * ks);
#pragma unroll
              for (int i = 0; i < 16; ++i) a0[i] = 0.f;
#pragma unroll
              for (int ks = 0; ks < 4; ++ks) a0 = MFMA32(af[ks], bb[ks], a0);
#pragma unroll
              for (int i = 0; i < 16; ++i) x0 += w[i] * relu_i(a0[i]); }
            asm volatile("" : "+v"(x0));
            asm volatile("" ::: "memory");
            { bf16x8 bb[4]; f32x16 a1;
#pragma unroll
              for (int ks = 0; ks < 4; ++ks) bb[ks] = *(const LAS bf16x8*)(lds + bo + boff + 32 * IDX_PK + 32 * ks);
#pragma unroll
              for (int i = 0; i < 16; ++i) a1[i] = 0.f;
#pragma unroll
              for (int ks = 0; ks < 4; ++ks) a1 = MFMA32(af[ks], bb[ks], a1);
#pragma unroll
              for (int i = 0; i < 16; ++i) x1 += w[i] * relu_i(a1[i]); }
            s0v = (g * 64 <= tqr) ? x0 : -INFINITY; s1v = (g * 64 + 32 <= tqr) ? x1 : -INFINITY;
        }
        row[2 * g] = s0v; row[2 * g + 1] = s1v;
    }
    float tau = -3.0e38f;
    bool done = (tq + 1 <= 256);
    float mx = -INFINITY, mn = INFINITY;
#pragma unroll
    for (int k = 0; k < MW; ++k) { const float v = row[k]; mx = fmaxf(mx, v); mn = fminf(mn, v > -INFINITY ? v : INFINITY); }
    float lo = half_min_f(mn), hi = half_max_f(mx);
    if (!done) tau = hi;
    for (int it = 0; it < 64; ++it) {
        if (!__any(!done)) break;
        const float mid = lo + (hi - lo) * 0.5f;
        int c = 0;
#pragma unroll
        for (int k = 0; k < MW; ++k) c += (row[k] >= mid) ? 1 : 0;
        c = half_sum_i(c);
        if (!done) {
            if (!(mid > lo && mid < hi)) { tau = hi; done = true; }
            else if (c == 256) { tau = mid; done = true; }
            else if (c > 256) lo = mid;
            else { hi = mid; tau = hi; }
        }
    }
    unsigned* mrow = mask + (size_t)(b * SEQ + s0 + h) * MW;
    unsigned mw = 0u;
#pragma unroll
    for (int k = 0; k < MW; ++k) {
        const unsigned long long bal = __ballot(row[k] >= tau);
        const unsigned wd = h ? (unsigned)(bal >> 32) : (unsigned)bal;
        if ((k & 31) == r) mw = wd;
        if ((k & 31) == 31 || k == MW - 1) { const int kk = (k & ~31) + r; if (kk < MW) mrow[kk] = mw; }
    }
}
__device__ __forceinline__ void p2_indexer(const Frame& F, int qslot) {
    volatile LAS unsigned* qw = (volatile LAS unsigned*)(F.lds + LDSCTL_OFF + 16);
    constexpr int NCH = NTOK / 16;
    for (;;) {
        if (F.tid == 0) qw[0] = atomicAdd(F.ctl + CW_QUEUE + 64 * qslot, 1u);
        __syncthreads();
        const int c = __builtin_amdgcn_readfirstlane((int)qw[0]);
        __syncthreads();
        if (c >= NCH) break;
        const int b = c & 3, tblk = (SEQ / 16 - 1) - (c >> 2);
        idx_task(F, b, tblk * 16);
    }
}
template <bool MLA> struct AttnCfg {
    static constexpr int DQK = MLA ? 192 : 128, PK = DQK * 2 + 16, PV = 320, KCH = DQK / 8, NKC = 64 * KCH / 512, KBYTES = 64 * PK, BUFB = 64 * PK + 64 * PV;
};
struct AttnUnit { int type, b, hx, blk; };

template <bool MLA>
__device__ __forceinline__ void attn_unit(const Frame& F, const AttnUnit u) {
    typedef AttnCfg<MLA> C;
    const int tid = F.tid, lane = F.lane, wave = F.wave, r = lane & 31, h = lane >> 5;
    LAS unsigned char* lds = F.lds;
    const bf16_t* qn = (const bf16_t*)(F.ws + WS_QN); const bf16_t* qr = (const bf16_t*)(F.ws + WS_QR); const bf16_t* kn = (const bf16_t*)(F.ws + WS_KN);
    const bf16_t* va = (const bf16_t*)(F.ws + WS_VA); const bf16_t* kpe = (const bf16_t*)(F.ws + WS_KPE);
    const bf16_t* qb = (const bf16_t*)(F.ws + WS_QB); const bf16_t* kb = (const bf16_t*)(F.ws + WS_KB); const bf16_t* vb = (const bf16_t*)(F.ws + WS_VB);
    const unsigned* mask = (const unsigned*)(F.ws + WS_MASK); bf16_t* oab = (bf16_t*)(F.ws + WS_OAB);
    const int b = u.b;
    const size_t rowb = (size_t)b * SEQ;
    int head, tw0, ntiles;
    if (MLA) { head = u.hx; tw0 = u.blk * 256 + 32 * wave; ntiles = (NMETA + u.blk * 256 + 255) / 64 + 1; }
    else { head = 4 * u.hx + (wave & 3); tw0 = u.blk * 64 + 32 * (wave >> 2); ntiles = (NMETA + u.blk * 64 + 63) / 64 + 1; }
    const int pw0 = NMETA + tw0;
    const int tq = pw0 + r;
    bf16x8 qf[C::DQK / 16];
    if (MLA) {
        const bf16_t* p0 = qn + (rowb + tw0 + r) * 2048 + head * 128 + 8 * h; const bf16_t* p1 = qr + (rowb + tw0 + r) * 1024 + head * 64 + 8 * h;
#pragma unroll
        for (int ks = 0; ks < 8; ++ks) qf[ks] = *(const bf16x8*)(p0 + 16 * ks);
#pragma unroll
        for (int ks = 0; ks < 4; ++ks) qf[8 + ks] = *(const bf16x8*)(p1 + 16 * ks);
    } else {
        const bf16_t* p0 = qb + (rowb + tw0 + r) * 2048 + head * 128 + 8 * h;
#pragma unroll
        for (int ks = 0; ks < 8; ++ks) qf[ks] = *(const bf16x8*)(p0 + 16 * ks);
    }
    const int ldkv = MLA ? 2048 : 512;
    const bf16_t* ktab = MLA ? kn + head * 128 : kb + u.hx * 128;
    const bf16_t* vtab = MLA ? va + head * 128 : vb + u.hx * 128;
    const bf16_t* kbase = ktab + (rowb - NMETA) * ldkv;
    const bf16_t* vbase = vtab + (rowb - NMETA) * ldkv;
    const bf16_t* pbase = kpe + (rowb - NMETA) * 64;
    unsigned soff[2]; int kdst[2], vdst[2];
#pragma unroll
    for (int i = 0; i < 2; ++i) { const int c = tid + 512 * i, key = c >> 4, pc = c & 15; soff[i] = (unsigned)(key * ldkv + pc * 8); kdst[i] = key * C::PK + pc * 16; vdst[i] = C::KBYTES + key * C::PV + pc * 16; }
    const unsigned poff = (unsigned)((tid >> 3) * 64 + (tid & 7) * 8); const int pdst = (tid >> 3) * C::PK + 256 + (tid & 7) * 16;
    u32x4 kst[2], vst[2], pst = (u32x4){0u, 0u, 0u, 0u};
    {
        const int key0 = tid >> 4;
        const size_t o0 = key0 < NMETA ? (size_t)(NTOK + key0) * ldkv + (tid & 15) * 8 : (rowb - NMETA) * ldkv + soff[0];
        kst[0] = *(const u32x4*)(ktab + o0); vst[0] = *(const u32x4*)(vtab + o0);
        kst[1] = *(const u32x4*)(kbase + soff[1]); vst[1] = *(const u32x4*)(vbase + soff[1]);
        if (MLA) { const int keyp = tid >> 3; pst = *(const u32x4*)(keyp < NMETA ? kpe + (size_t)(NTOK + keyp) * 64 + (tid & 7) * 8 : pbase + poff); }
    }
#pragma unroll
    for (int i = 0; i < 2; ++i) { *(LAS u32x4*)(lds + kdst[i]) = kst[i]; *(LAS u32x4*)(lds + vdst[i]) = vst[i]; }
    if (MLA) *(LAS u32x4*)(lds + pdst) = pst;
    __syncthreads();
    f32x16 oacc[4];
#pragma unroll
    for (int d = 0; d < 4; ++d)
#pragma unroll
        for (int i = 0; i < 16; ++i) oacc[d][i] = 0.f;
    float mrun = -INFINITY, lrun = 0.f;
    const int koff = r * C::PK + 16 * h;
    const int voff = C::KBYTES + (4 * h + ((lane & 15) >> 2)) * C::PV + (16 * ((lane >> 4) & 1) + 4 * (lane & 3)) * 2;
    const unsigned* mrow = mask + (rowb + tw0 + r) * MW;
    for (int kt = 0; kt < ntiles; ++kt) {
        const int cur = (kt & 1) * C::BUFB, nxt = ((kt + 1) & 1) * C::BUFB;
        const bool more = kt + 1 < ntiles;
        if (more) {
            const bf16_t* kb2 = kbase + (size_t)(kt + 1) * 64 * ldkv; const bf16_t* vb2 = vbase + (size_t)(kt + 1) * 64 * ldkv;
#pragma unroll
            for (int i = 0; i < 2; ++i) { kst[i] = *(const u32x4*)(kb2 + soff[i]); vst[i] = *(const u32x4*)(vb2 + soff[i]); }
            if (MLA) pst = *(const u32x4*)(pbase + (size_t)(kt + 1) * 64 * 64 + poff);
        }
        if (kt * 64 <= pw0 + 31) {
            u32x2 mwd = (u32x2){0u, 0u};
            if (!MLA) mwd = *(const u32x2*)(mrow + 2 * kt);
            f32x16 s0, s1;
#pragma unroll
            for (int i = 0; i < 16; ++i) { s0[i] = 0.f; s1[i] = 0.f; }
#pragma unroll
            for (int ks = 0; ks < C::DQK / 16; ++ks) {
                const bf16x8 k0 = *(const LAS bf16x8*)(lds + cur + koff + 32 * ks), k1 = *(const LAS bf16x8*)(lds + cur + koff + 32 * C::PK + 32 * ks);
                s0 = MFMA32(k0, qf[ks], s0); s1 = MFMA32(k1, qf[ks], s1);
            }
            if (MLA) {
                if (kt * 64 + 63 > pw0) {
                    const int kb0 = kt * 64 + 4 * h;
#pragma unroll
                    for (int i = 0; i < 16; ++i) { const int key = kb0 + (i & 3) + 8 * (i >> 2); if (key > tq) s0[i] = -INFINITY; if (key + 32 > tq) s1[i] = -INFINITY; }
                }
            } else {
                const unsigned m0 = mwd.x >> (4 * h), m1 = mwd.y >> (4 * h);
#pragma unroll
                for (int i = 0; i < 16; ++i) { const int bit = (i & 3) + 8 * (i >> 2); if (!((m0 >> bit) & 1u)) s0[i] = -INFINITY; if (!((m1 >> bit) & 1u)) s1[i] = -INFINITY; }
            }
            float mx = s0[0];
#pragma unroll
            for (int i = 1; i < 16; ++i) mx = fmaxf(mx, s0[i]);
#pragma unroll
            for (int i = 0; i < 16; ++i) mx = fmaxf(mx, s1[i]);
            mx = fmaxf(mx, __shfl_xor(mx, 32));
            const float mnew = fmaxf(mrun, mx);
            const float msafe = (mnew == -INFINITY) ? 0.f : mnew;
            const float alpha = __builtin_amdgcn_exp2f(mrun - msafe);
            mrun = mnew;
            float ps = 0.f;
#pragma unroll
            for (int i = 0; i < 16; ++i) { s0[i] = __builtin_amdgcn_exp2f(s0[i] - msafe); s1[i] = __builtin_amdgcn_exp2f(s1[i] - msafe); ps += s0[i] + s1[i]; }
            lrun = lrun * alpha + ps;
#pragma unroll
            for (int d = 0; d < 4; ++d)
#pragma unroll
                for (int i = 0; i < 16; ++i) oacc[d][i] *= alpha;
            bf16x8 pf[4];
            { u32x4 w;
              w.x = cvt_pk_bf16(s0[0], s0[1]); w.y = cvt_pk_bf16(s0[2], s0[3]); w.z = cvt_pk_bf16(s0[4], s0[5]); w.w = cvt_pk_bf16(s0[6], s0[7]); pf[0] = __builtin_bit_cast(bf16x8, w);
              w.x = cvt_pk_bf16(s0[8], s0[9]); w.y = cvt_pk_bf16(s0[10], s0[11]); w.z = cvt_pk_bf16(s0[12], s0[13]); w.w = cvt_pk_bf16(s0[14], s0[15]); pf[1] = __builtin_bit_cast(bf16x8, w);
              w.x = cvt_pk_bf16(s1[0], s1[1]); w.y = cvt_pk_bf16(s1[2], s1[3]); w.z = cvt_pk_bf16(s1[4], s1[5]); w.w = cvt_pk_bf16(s1[6], s1[7]); pf[2] = __builtin_bit_cast(bf16x8, w);
              w.x = cvt_pk_bf16(s1[8], s1[9]); w.y = cvt_pk_bf16(s1[10], s1[11]); w.z = cvt_pk_bf16(s1[12], s1[13]); w.w = cvt_pk_bf16(s1[14], s1[15]); pf[3] = __builtin_bit_cast(bf16x8, w); }
#pragma unroll
            for (int d = 0; d < 4; ++d)
#pragma unroll
                for (int kk = 0; kk < 4; ++kk) {
                    const s16x4 lo = __builtin_amdgcn_ds_read_tr16_b64_v4i16((LAS s16x4*)(lds + cur + voff + (16 * kk) * C::PV + 64 * d));
                    const s16x4 hi = __builtin_amdgcn_ds_read_tr16_b64_v4i16((LAS s16x4*)(lds + cur + voff + (16 * kk + 8) * C::PV + 64 * d));
                    const bf16x8 vf = __builtin_shufflevector(lo, hi, 0, 1, 2, 3, 4, 5, 6, 7);
                    oacc[d] = MFMA32(vf, pf[kk], oacc[d]);
                }
        }
        if (more) {
#pragma unroll
            for (int i = 0; i < 2; ++i) { *(LAS u32x4*)(lds + nxt + kdst[i]) = kst[i]; *(LAS u32x4*)(lds + nxt + vdst[i]) = vst[i]; }
            if (MLA) *(LAS u32x4*)(lds + nxt + pdst) = pst;
        }
        __syncthreads();
    }
    {
        const float lt = lrun + __shfl_xor(lrun, 32);
        const float inv = lt > 0.f ? 1.0f / lt : 0.f;
        bf16_t* op = oab + (rowb + tw0 + r) * 4096 + (MLA ? 0 : 2048) + head * 128 + 4 * h;
#pragma unroll
        for (int d = 0; d < 4; ++d)
#pragma unroll
            for (int g = 0; g < 4; ++g) { u32x2 w; w.x = cvt_pk_bf16(oacc[d][4 * g] * inv, oacc[d][4 * g + 1] * inv); w.y = cvt_pk_bf16(oacc[d][4 * g + 2] * inv, oacc[d][4 * g + 3] * inv);
                *(u32x2*)(op + 32 * d + 8 * g) = w; }
    }
}

constexpr int ATT_NUNITS = 16 * 64 + 64 * 16;
__device__ __forceinline__ void att_decode(int idx, AttnUnit& u) {
    int rem = idx;
    for (int L = 65; L >= 2; --L) {
        const int nm = (L >= 5 && ((L - 5) & 3) == 0) ? 64 : 0;
        if (rem < nm) { u.type = 0; u.blk = (L - 5) >> 2; u.b = rem & 3; u.hx = rem >> 2; return; }
        rem -= nm;
        if (rem < 16) { u.type = 1; u.blk = L - 2; u.b = rem & 3; u.hx = rem >> 2; return; }
        rem -= 16;
    }
    u.type = -1; u.blk = 0; u.b = 0; u.hx = 0;
}
__device__ __forceinline__ void p3_attention(const Frame& F, int qslot) {
#ifdef MK_SKIP_ATT
    {
        const u32x4* qn = (const u32x4*)(F.ws + WS_QN); const u32x4* qb = (const u32x4*)(F.ws + WS_QB); u32x4* o = (u32x4*)(F.ws + WS_OAB);
        const size_t gt = (size_t)(F.vcu * NWAVES + F.wave) * 64 + F.lane, NGT = (size_t)F.G * NWAVES * 64;
        for (size_t i = gt; i < (size_t)NTOK * 256; i += NGT) { const size_t row = i >> 8, c = i & 255; o[row * 512 + c] = qn[row * 256 + c]; o[row * 512 + 256 + c] = qb[row * 256 + c]; }
        return;
    }
#endif
    volatile LAS int* qw = (volatile LAS int*)(F.lds + LDSCTL_OFF + 32);
    for (;;) {
        if (F.tid == 0) { const int idx = (int)atomicAdd(F.ctl + CW_QUEUE + 64 * qslot, 1u); AttnUnit u; u.type = -1; u.b = 0; u.hx = 0; u.blk = 0; if (idx < ATT_NUNITS) att_decode(idx, u);
            qw[0] = u.type; qw[1] = u.b; qw[2] = u.hx; qw[3] = u.blk; }
        __syncthreads();
        AttnUnit u; u.type = qw[0]; u.b = qw[1]; u.hx = qw[2]; u.blk = qw[3];
        __syncthreads();
        if (u.type < 0) break;
        if (u.type == 0) attn_unit<true>(F, u); else attn_unit<false>(F, u);
    }
}
__device__ __forceinline__ float pk_idx(float v, int n) { return __uint_as_float((__float_as_uint(v) & ~127u) | (unsigned)n); }
__device__ __forceinline__ void route_task(const Frame& F, int tb, int hd) {
    const int lane = F.lane, r = lane & 31, h = lane >> 5;
    const bf16_t* pq = (const bf16_t*)(F.ws + WS_PQ); const bf16_t* skb = (const bf16_t*)(F.ws + WS_SK);
    int* eid = (int*)(F.ws + WS_EID); float* gate = (float*)(F.ws + WS_GATE);
    LAS float* wl = (LAS float*)(F.lds + F.wave * 16384);
    const int m = tb * 32 + r;
#pragma unroll 1
    for (int c = 0; c < 2; ++c) {
        const bf16_t* qp = pq + (size_t)m * 2048 + hd * 256 + c * 128 + 8 * h;
        bf16x8 qf[8];
#pragma unroll
        for (int ks = 0; ks < 8; ++ks) qf[ks] = *(const bf16x8*)(qp + 16 * ks);
        float v[64];
#pragma unroll
        for (int blk = 0; blk < 4; ++blk) {
            const bf16_t* sp = skb + (size_t)((hd * 2 + c) * 128 + 32 * blk + r) * 128 + 8 * h;
            f32x16 acc;
#pragma unroll
            for (int i = 0; i < 16; ++i) acc[i] = 0.f;
#pragma unroll
            for (int ks = 0; ks < 8; ++ks) acc = MFMA32(*(const bf16x8*)(sp + 16 * ks), qf[ks], acc);
#pragma unroll
            for (int i = 0; i < 16; ++i) v[blk * 16 + i] = pk_idx(acc[i], 32 * blk + (i & 3) + 8 * (i >> 2) + 4 * h);
        }
#pragma unroll 1
        for (int k = 0; k < 16; ++k) {
            float mx = v[0];
#pragma unroll
            for (int j = 1; j < 64; ++j) mx = fmaxf(mx, v[j]);
            mx = fmaxf(mx, __shfl_xor(mx, 32));
            if (h == 0) wl[(c * 16 + k) * 32 + r] = mx;
#pragma unroll
            for (int j = 0; j < 64; ++j) v[j] = (v[j] == mx) ? -INFINITY : v[j];
        }
    }
    LDS_WAIT(); asm volatile("" ::: "memory");
    float cs[50]; int ce[50];
    {
        unsigned t0[16], t1[16];
#pragma unroll
        for (int i = 0; i < 16; ++i) { t0[i] = __float_as_uint(wl[i * 32 + r]); t1[i] = __float_as_uint(wl[(16 + i) * 32 + r]); }
        int n = 0;
#pragma unroll
        for (int i = 0; i < 16; ++i)
#pragma unroll
            for (int j = 0; j < 16; ++j)
                if ((i + 1) * (j + 1) <= 16) {
                    const float s = __uint_as_float(t0[i] & ~127u) + __uint_as_float(t1[j] & ~127u);
                    cs[n] = __uint_as_float((__float_as_uint(s) & ~63u) | (unsigned)n); ce[n] = (int)((t0[i] & 127u) * 128u + (t1[j] & 127u)); ++n;
                }
    }
    float sum = 0.f, first = 0.f;
#pragma unroll 1
    for (int k = 0; k < 16; ++k) {
        float mx = cs[0];
#pragma unroll
        for (int j = 1; j < 50; ++j) mx = fmaxf(mx, cs[j]);
        int se = 0;
#pragma unroll
        for (int j = 0; j < 50; ++j) { const bool hit = (cs[j] == mx); se = hit ? ce[j] : se; cs[j] = hit ? -INFINITY : cs[j]; }
        if (k == 0) first = mx;
        const float ev = __expf(mx - first); sum += ev;
        if (h == 0) { wl[1024 + k * 32 + r] = ev; wl[1536 + k * 32 + r] = __int_as_float(se); }
    }
    LDS_WAIT(); asm volatile("" ::: "memory");
    const float inv = 1.0f / sum;
    if (h == 0) {
        int* ep = eid + (size_t)m * 128 + hd * 16; float* gp = gate + (size_t)m * 128 + hd * 16;
#pragma unroll
        for (int q = 0; q < 4; ++q) {
            *(int4*)(ep + 4 * q) = make_int4(__float_as_int(wl[1536 + (4 * q) * 32 + r]), __float_as_int(wl[1536 + (4 * q + 1) * 32 + r]), __float_as_int(wl[1536 + (4 * q + 2) * 32 + r]), __float_as_int(wl[1536 + (4 * q + 3) * 32 + r]));
            *(f32x4*)(gp + 4 * q) = (f32x4){wl[1024 + (4 * q) * 32 + r] * inv, wl[1024 + (4 * q + 1) * 32 + r] * inv, wl[1024 + (4 * q + 2) * 32 + r] * inv, wl[1024 + (4 * q + 3) * 32 + r] * inv}; }
    }
    LDS_WAIT(); asm volatile("" ::: "memory");
}
__device__ __forceinline__ void p7_routing(const Frame& F) {
    const int gw = F.vcu * NWAVES + F.wave, NGW = F.G * NWAVES;
    for (int it = gw; it < (NTOK / 32) * 8; it += NGW) route_task(F, it >> 3, it & 7);
}

__device__ __forceinline__ float rl_f(float v, int l) { return __int_as_float(__builtin_amdgcn_readlane(__float_as_int(v), l)); }
__device__ __forceinline__ float gelu_tanh(float x) {
    const float u = 0.7978845608028654f * (x + 0.044715f * x * x * x);
    const float e = __expf(2.0f * u);
    const float th = 1.0f - 2.0f / (e + 1.0f);
    return 0.5f * x * (1.0f + th);
}
__device__ __forceinline__ float wave_sum_dpp(float v) {
#define DPP_ADD(ctrl, rmask) v += __int_as_float(__builtin_amdgcn_update_dpp(0, __float_as_int(v), ctrl, rmask, 0xF, false))
    DPP_ADD(0xB1, 0xF); DPP_ADD(0x4E, 0xF); DPP_ADD(0x141, 0xF); DPP_ADD(0x140, 0xF); DPP_ADD(0x142, 0xA); DPP_ADD(0x143, 0xC);
#undef DPP_ADD
    return rl_f(v, 63);
}
typedef unsigned u32x6 __attribute__((ext_vector_type(6)));
typedef float f32x32 __attribute__((ext_vector_type(32)));
struct Row6 { u32x4 q[3]; };
__device__ __forceinline__ void row6_load(Row6& r, const unsigned char* tab, int e, int lane) {
    const u32x4* p = (const u32x4*)(tab + (size_t)e * 3072) + lane;
#pragma unroll
    for (int q = 0; q < 3; ++q) r.q[q] = p[64 * q];
}
__device__ __forceinline__ f32x32 row6_deq(const Row6& r, int g) {
    u32x6 w;
    if (g == 0) { w[0] = r.q[0].x; w[1] = r.q[0].y; w[2] = r.q[0].z; w[3] = r.q[0].w; w[4] = r.q[1].x; w[5] = r.q[1].y; }
    else { w[0] = r.q[1].z; w[1] = r.q[1].w; w[2] = r.q[2].x; w[3] = r.q[2].y; w[4] = r.q[2].z; w[5] = r.q[2].w; }
    return __builtin_amdgcn_cvt_scalef32_pk32_f32_fp6(w, 1.0f);
}
__device__ __forceinline__ float row6_dot(const Row6& r, const f32x2 (&hf)[32]) {
    f32x2 acc0 = (f32x2){0.f, 0.f}, acc1 = (f32x2){0.f, 0.f};
#pragma unroll
    for (int g = 0; g < 2; ++g) { const f32x32 d = row6_deq(r, g);
#pragma unroll
        for (int k = 0; k < 16; k += 2) { acc0 = __builtin_elementwise_fma((f32x2){d[2 * k], d[2 * k + 1]}, hf[16 * g + k], acc0); acc1 = __builtin_elementwise_fma((f32x2){d[2 * k + 2], d[2 * k + 3]}, hf[16 * g + k + 1], acc1); } }
    const f32x2 s = acc0 + acc1;
    return s.x + s.y;
}
__device__ __forceinline__ void row6_axpy(const Row6& r, float c, f32x2 (&o)[32]) {
    const f32x2 c2 = (f32x2){c, c};
#pragma unroll
    for (int g = 0; g < 2; ++g) { const f32x32 d = row6_deq(r, g);
#pragma unroll
        for (int k = 0; k < 16; ++k) o[16 * g + k] = __builtin_elementwise_fma((f32x2){d[2 * k], d[2 * k + 1]}, c2, o[16 * g + k]); }
}
struct Row4 { u32x4 q[2]; };
__device__ __forceinline__ void row4_load(Row4& r, const unsigned char* tab, int e, int lane) {
    const u32x4* p = (const u32x4*)(tab + (size_t)e * 2048) + lane;
    r.q[0] = p[0]; r.q[1] = p[64];
}
__device__ __forceinline__ float row4_dot(const Row4& r, const f32x2 (&hf)[32]) {
    f32x2 acc0 = (f32x2){0.f, 0.f}, acc1 = (f32x2){0.f, 0.f};
#pragma unroll
    for (int d = 0; d < 8; ++d) { const unsigned w = r.q[d >> 2][d & 3];
        acc0 = __builtin_elementwise_fma(__builtin_amdgcn_cvt_scalef32_pk_f32_fp4(w, 1.0f, 0), hf[4 * d], acc0);
        acc1 = __builtin_elementwise_fma(__builtin_amdgcn_cvt_scalef32_pk_f32_fp4(w, 1.0f, 1), hf[4 * d + 1], acc1);
        acc0 = __builtin_elementwise_fma(__builtin_amdgcn_cvt_scalef32_pk_f32_fp4(w, 1.0f, 2), hf[4 * d + 2], acc0);
        acc1 = __builtin_elementwise_fma(__builtin_amdgcn_cvt_scalef32_pk_f32_fp4(w, 1.0f, 3), hf[4 * d + 3], acc1); }
    const f32x2 s = acc0 + acc1;
    return s.x + s.y;
}
__device__ __forceinline__ void row4_axpy(const Row4& r, float c, f32x2 (&o)[32]) {
    const f32x2 c2 = (f32x2){c, c};
#pragma unroll
    for (int d = 0; d < 8; ++d) { const unsigned w = r.q[d >> 2][d & 3];
        o[4 * d] = __builtin_elementwise_fma(__builtin_amdgcn_cvt_scalef32_pk_f32_fp4(w, 1.0f, 0), c2, o[4 * d]);
        o[4 * d + 1] = __builtin_elementwise_fma(__builtin_amdgcn_cvt_scalef32_pk_f32_fp4(w, 1.0f, 1), c2, o[4 * d + 1]);
        o[4 * d + 2] = __builtin_elementwise_fma(__builtin_amdgcn_cvt_scalef32_pk_f32_fp4(w, 1.0f, 2), c2, o[4 * d + 2]);
        o[4 * d + 3] = __builtin_elementwise_fma(__builtin_amdgcn_cvt_scalef32_pk_f32_fp4(w, 1.0f, 3), c2, o[4 * d + 3]); }
}
#if PEER_U_BITS == 4
typedef Row4 RowU;
#define ROWU_LOAD row4_load
#define ROWU_DOT row4_dot
#else
typedef Row6 RowU;
#define ROWU_LOAD row6_load
#define ROWU_DOT row6_dot
#endif
#if PEER_V_BITS == 4
typedef Row4 RowV;
#define ROWV_LOAD row4_load
#define ROWV_AXPY row4_axpy
#else
typedef Row6 RowV;
#define ROWV_LOAD row6_load
#define ROWV_AXPY row6_axpy
#endif
__device__ __forceinline__ void expert_token(const Frame& F, int m, size_t orow) {
    const int lane = F.lane;
    const unsigned char* U = F.ws + WS_U; const unsigned char* V = F.ws + WS_V;
    const float* scu = (const float*)(F.ws + WS_SCU); const float* scv = (const float*)(F.ws + WS_SCV);
    const int* eid = (const int*)(F.ws + WS_EID); const float* gate = (const float*)(F.ws + WS_GATE);
    const bf16_t* h1b = (const bf16_t*)(F.ws + WS_H1B); const float* h1f = (const float*)(F.ws + WS_H1F);
    const u64* ssq = (const u64*)(F.ctl + CW_SSQ_H1); const float* gfin = F.in(15);
    const int e0 = eid[(size_t)m * 128 + lane], e1 = eid[(size_t)m * 128 + 64 + lane];
    f32x2 hf[32];
#pragma unroll
    for (int j = 0; j < 16; ++j) { const u32x2 x = *((const u32x2*)(h1b + (size_t)m * DM) + lane + 64 * j); hf[2 * j] = (f32x2){bf_lo(x.x), bf_hi(x.x)}; hf[2 * j + 1] = (f32x2){bf_lo(x.y), bf_hi(x.y)}; }
    const float g0 = gate[(size_t)m * 128 + lane] * scv[e0], g1 = gate[(size_t)m * 128 + 64 + lane] * scv[e1];
    const float rstd = __builtin_amdgcn_rsqf(ssq_get(ssq + m) * (1.0f / DM) + EPS);
    const float su0 = scu[e0] * rstd, su1 = scu[e1] * rstd;
    float a0 = 0.f, a1 = 0.f;
#define EIDX(e) (((e) < 64) ? __builtin_amdgcn_readlane(e0, (e)) : __builtin_amdgcn_readlane(e1, (e) - 64))
    {
        RowU r0, r1, r2, r3, r4, r5, r6, r7;
        ROWU_LOAD(r0, U, EIDX(0), lane); ROWU_LOAD(r1, U, EIDX(1), lane); ROWU_LOAD(r2, U, EIDX(2), lane); ROWU_LOAD(r3, U, EIDX(3), lane);
        ROWU_LOAD(r4, U, EIDX(4), lane); ROWU_LOAD(r5, U, EIDX(5), lane); ROWU_LOAD(r6, U, EIDX(6), lane); ROWU_LOAD(r7, U, EIDX(7), lane);
#define S1STEP(rr, k) p = wave_sum_dpp(ROWU_DOT(rr, hf)); if (more) ROWU_LOAD(rr, U, EIDX(e + 8 + (k)), lane); if (e < 64) { if (lane == e + (k)) a0 = p; } else { if (lane == e + (k) - 64) a1 = p; }
#pragma unroll 1
        for (int e = 0; e < 128; e += 8) {
            const bool more = e + 8 < 128; float p;
            S1STEP(r0, 0) S1STEP(r1, 1) S1STEP(r2, 2) S1STEP(r3, 3) S1STEP(r4, 4) S1STEP(r5, 5) S1STEP(r6, 6) S1STEP(r7, 7)
        }
#undef S1STEP
    }
    const float c0 = gelu_tanh(a0 * su0) * g0, c1 = gelu_tanh(a1 * su1) * g1;
#define CIDX(e) (((e) < 64) ? rl_f(c0, (e)) : rl_f(c1, (e) - 64))
    f32x2 o[32];
#pragma unroll
    for (int i = 0; i < 32; ++i) o[i] = (f32x2){0.f, 0.f};
    {
        RowV r0, r1, r2, r3, r4, r5, r6, r7;
        ROWV_LOAD(r0, V, EIDX(0), lane); ROWV_LOAD(r1, V, EIDX(1), lane); ROWV_LOAD(r2, V, EIDX(2), lane); ROWV_LOAD(r3, V, EIDX(3), lane);
        ROWV_LOAD(r4, V, EIDX(4), lane); ROWV_LOAD(r5, V, EIDX(5), lane); ROWV_LOAD(r6, V, EIDX(6), lane); ROWV_LOAD(r7, V, EIDX(7), lane);
#define S2STEP(rr, k) ROWV_AXPY(rr, CIDX(e + (k)), o); if (more) ROWV_LOAD(rr, V, EIDX(e + 8 + (k)), lane);
#pragma unroll 1
        for (int e = 0; e < 128; e += 8) {
            const bool more = e + 8 < 128;
            S2STEP(r0, 0) S2STEP(r1, 1) S2STEP(r2, 2) S2STEP(r3, 3) S2STEP(r4, 4) S2STEP(r5, 5) S2STEP(r6, 6) S2STEP(r7, 7)
        }
#undef S2STEP
    }
#undef EIDX
#undef CIDX
    float s = 0.f;
#pragma unroll
    for (int j = 0; j < 16; ++j) { const f32x4 x = *((const f32x4*)(h1f + (size_t)m * DM) + lane + 64 * j); o[2 * j] += (f32x2){x[0], x[1]}; o[2 * j + 1] += (f32x2){x[2], x[3]};
        s += (o[2 * j].x * o[2 * j].x + o[2 * j].y * o[2 * j].y) + (o[2 * j + 1].x * o[2 * j + 1].x + o[2 * j + 1].y * o[2 * j + 1].y); }
    const float rs = 1.0f / sqrtf(wave_sum(s) * (1.0f / DM) + EPS);
    float* op = F.out() + orow * DM;
#pragma unroll
    for (int j = 0; j < 16; ++j) { const f32x4 g = *((const f32x4*)gfin + lane + 64 * j);
        *((f32x4*)op + lane + 64 * j) = (f32x4){o[2 * j].x * rs * g[0], o[2 * j].y * rs * g[1], o[2 * j + 1].x * rs * g[2], o[2 * j + 1].y * rs * g[3]}; }
}
#ifdef MK_STEP_B
__device__ __forceinline__ void stepb_token(const Frame& F, int m, size_t orow) {
    const int lane = F.lane; const float* x = (const float*)(F.ws + WS_H1F) + (size_t)m * DM; const float* gfin = F.in(15);
    f32x4 v[16]; float s = 0.f;
#pragma unroll
    for (int j = 0; j < 16; ++j) { v[j] = *((const f32x4*)x + lane + 64 * j); s += (v[j][0] * v[j][0] + v[j][1] * v[j][1]) + (v[j][2] * v[j][2] + v[j][3] * v[j][3]); }
    const float rs = 1.0f / sqrtf(wave_sum(s) * (1.0f / DM) + EPS);
#pragma unroll
    for (int j = 0; j < 16; ++j) { const f32x4 g = *((const f32x4*)gfin + lane + 64 * j); *((f32x4*)(F.out() + orow * DM) + lane + 64 * j) = v[j] * rs * g; }
}
#endif
#ifdef MK_STEP_A
__device__ __forceinline__ void stepa_token(const Frame& F, size_t orow) {
    const int lane = F.lane; const float* x = F.in(0) + orow * DM; const float* gfin = F.in(15);
    f32x4 v[16]; float s = 0.f;
#pragma unroll
    for (int j = 0; j < 16; ++j) { v[j] = *((const f32x4*)x + lane + 64 * j); s += (v[j][0] * v[j][0] + v[j][1] * v[j][1]) + (v[j][2] * v[j][2] + v[j][3] * v[j][3]); }
    const float rs = 1.0f / sqrtf(wave_sum(s) * (1.0f / DM) + EPS);
#pragma unroll
    for (int j = 0; j < 16; ++j) { const f32x4 g = *((const f32x4*)gfin + lane + 64 * j); *((f32x4*)(F.out() + orow * DM) + lane + 64 * j) = v[j] * rs * g; }
}
#endif
__device__ __forceinline__ void p8_experts(const Frame& F) {
    const int gw = F.vcu * NWAVES + F.wave, NGW = F.G * NWAVES;
#if defined(MK_STEP_A)
    for (int it = gw; it < NB * SEQ; it += NGW) stepa_token(F, (size_t)it);
#elif defined(MK_STEP_B)
    for (int it = gw; it < NB * SEQ; it += NGW) stepb_token(F, it, (size_t)it);
#else
    for (int it = gw; it < NB * SEQ; it += NGW) expert_token(F, it, (size_t)it);
#endif
}
struct Args { const float* in[16]; float* out; unsigned char* ws; int ph_lo, ph_hi; };
#define GEMM_RUN(EPI_T, g_, S_, E_) pg8::gemm_phase<EPI_T, pg8::StaticOrder, true, true>(F.lds, g_, S_, E_)
#define GEMM_RUN2(EPI_T, g_, S_, E_) pg8::gemm_phase<EPI_T, pg8::StaticOrder2, true, true>(F.lds, g_, S_, E_)

__global__ void __launch_bounds__(NWAVES * 64, 2) mk_fwd(Args args) {
    extern __shared__ __attribute__((aligned(16))) unsigned char lds_raw[];
    Frame F;
    F.lds = (LAS unsigned char*)lds_raw;
    F.ws = args.ws; F.ctl = (unsigned*)(args.ws + WS_CTL);
    F.tid = threadIdx.x; F.lane = F.tid & 63; F.wave = __builtin_amdgcn_readfirstlane(F.tid >> 6);
#define PHASE_BEGIN() do { int t_; asm volatile("v_mov_b32 %0, %1" : "=v"(t_) : "v"(threadIdx.x)); F.tid = t_; F.lane = t_ & 63; } while (0)
    F.G = gridDim.x; { const int bx = blockIdx.x; F.vcu = (F.G % 8 == 0) ? (bx % 8) * (F.G / 8) + bx / 8 : bx; }
    for (int u = F.tid; u < (LDS_BYTES - LDSCTL_OFF) / 4; u += NWAVES * 64) ((LAS unsigned*)(F.lds + LDSCTL_OFF))[u] = 0u;
    __syncthreads();
    XcdBarrier bar; bar.bar = F.ctl + CW_BAR; bar.x = 0; bar.st = nullptr;
    if (!MK_PER_PHASE) bar = xcd_barrier_post(F.ctl + CW_BAR, (volatile LAS unsigned*)(F.lds + LDSCTL_OFF));
    const int lo = args.ph_lo, hi = args.ph_hi;
#ifndef PH_MASK
#define PH_MASK 0x1FF
#endif
#define IN(k) (((PH_MASK >> (k)) & 1) && lo <= (k) && (k) < hi)
#ifdef MK_PROBE_T
#define STAMP(k) do { if (blockIdx.x == 0 && threadIdx.x == 0) ((volatile u64*)(F.ctl + 2048))[k] = __builtin_amdgcn_s_memrealtime(); } while (0)
#else
#define STAMP(k) do { } while (0)
#endif
#define SEAM(k) do { if (IN(k) && IN((k) + 1)) xcd_barrier(bar); STAMP((k) + 1); } while (0)
    unsigned char* ws = F.ws;

#ifndef MK_REP_MASK
#define MK_REP_MASK 0
#endif
#define NREP(k) (((MK_REP_MASK >> (k)) & 1) ? 2 : 1)
    STAMP(0);
    if (IN(0)) { for (int rep = 0; rep < NREP(0); ++rep) { PHASE_BEGIN(); p0_prologue(F); if (rep + 1 < NREP(0)) xcd_barrier(bar); } }
    SEAM(0);
    if (IN(1)) { for (int rep = 0; rep < NREP(1); ++rep) { PHASE_BEGIN();
        p1_quant_weights(F);
        xcd_barrier(bar);
        {
            pg8::Gemm g{(const bf16_t*)(ws + WS_XN8), (const bf16_t*)(ws + WS_WG8), MK, 12800, DM / 2, DM / 2}; pg8::StaticOrder S; S.init(MK, 12800, F.G, (int)blockIdx.x);
            epi::EpiIn<true> E{(bf16_t*)(ws + WS_CQ), (bf16_t*)(ws + WS_CKV), (bf16_t*)(ws + WS_QB), (bf16_t*)(ws + WS_KB), (bf16_t*)(ws + WS_VB), (bf16_t*)(ws + WS_QIX), (bf16_t*)(ws + WS_KPE), (bf16_t*)(ws + WS_KIX),
                          (bf16_t*)(ws + WS_GA), (bf16_t*)(ws + WS_GB), (float*)(ws + WS_WIX), rep ? nullptr : (u64*)(F.ctl + CW_SSQ_CQ), rep ? nullptr : (u64*)(F.ctl + CW_SSQ_CKV),
                          (const float*)(ws + WS_ROPE_M), (const float*)(ws + WS_ROPE_D), (const float*)(ws + WS_ROPE_I), (const float*)(ws + WS_SX), (const float*)(ws + WS_SW)};
            GEMM_RUN(epi::EpiIn<true>, g, S, E); }
        __syncthreads();
        {
            pg8::Gemm g{(const bf16_t*)(ws + WS_XN), (const bf16_t*)(ws + WS_WIN), MK, 1280, DM, DM}; pg8::StaticOrder S; S.init(MK, 1280, F.G, (int)(gridDim.x - 1 - blockIdx.x));
            epi::EpiIn<false> E{(bf16_t*)(ws + WS_CQ), (bf16_t*)(ws + WS_CKV), (bf16_t*)(ws + WS_QB), (bf16_t*)(ws + WS_KB), (bf16_t*)(ws + WS_VB), (bf16_t*)(ws + WS_QIX), (bf16_t*)(ws + WS_KPE), (bf16_t*)(ws + WS_KIX),
                          (bf16_t*)(ws + WS_GA), (bf16_t*)(ws + WS_GB), (float*)(ws + WS_WIX), nullptr, nullptr,
                          (const float*)(ws + WS_ROPE_M), (const float*)(ws + WS_ROPE_D), (const float*)(ws + WS_ROPE_I), nullptr, nullptr};
            GEMM_RUN(epi::EpiIn<false>, g, S, E); }
        if (rep + 1 < NREP(1)) xcd_barrier(bar); }
    }
    SEAM(1);
    if (IN(2)) { for (int rep = 0; rep < NREP(2); ++rep) { PHASE_BEGIN();
        { pg8::Gemm g{(const bf16_t*)(ws + WS_CQ), (const bf16_t*)(ws + WS_WUQ), NTOK, 3072, 1024, 1024}; pg8::StaticOrder S; S.init(NTOK, 3072, F.G, (int)blockIdx.x);
          epi::EpiUp E{(bf16_t*)(ws + WS_QN), (bf16_t*)(ws + WS_QR), 8, 2048, 1024, (const u64*)(F.ctl + CW_SSQ_CQ), 1.0f / 1024.0f, QA_SCALE, (const float*)(ws + WS_ROPE_M)};
          GEMM_RUN(epi::EpiUp, g, S, E); }
        __syncthreads();
        { pg8::Gemm g{(const bf16_t*)(ws + WS_CKV), (const bf16_t*)(ws + WS_WUKV), MK, 4096, 512, 512}; pg8::StaticOrder S; S.init(MK, 4096, F.G, (int)blockIdx.x);
          epi::EpiUp E{(bf16_t*)(ws + WS_KN), (bf16_t*)(ws + WS_VA), 8, 2048, 2048, (const u64*)(F.ctl + CW_SSQ_CKV), 1.0f / 512.0f, 1.0f, nullptr};
          GEMM_RUN(epi::EpiUp, g, S, E); }
        __syncthreads();
        p2_indexer(F, rep);
        if (rep + 1 < NREP(2)) xcd_barrier(bar); }
    }
    SEAM(2);
    if (IN(3)) { for (int rep = 0; rep < NREP(3); ++rep) { PHASE_BEGIN(); p3_attention(F, 2 + rep); if (rep + 1 < NREP(3)) xcd_barrier(bar); } }
    SEAM(3);
    if (IN(4)) { for (int rep = 0; rep < NREP(4); ++rep) { PHASE_BEGIN();
        rowquant_fp8(F, ws + WS_OAB, (size_t)DM * 2, ws + WS_OAB, (size_t)DM * 2, (float*)(ws + WS_SOAB), NTOK);
        xcd_barrier(bar);
        pg8::Gemm g{(const bf16_t*)(ws + WS_OAB), (const bf16_t*)(ws + WS_WBR), NTOK, 4096, 4096, 1024}; pg8::StaticOrder2 S; S.init(NTOK, 4096, F.G, (int)blockIdx.x);
        epi::EpiBranch E{(const bf16_t*)(ws + WS_GA), (const bf16_t*)(ws + WS_GB), (bf16_t*)(ws + WS_MRG), (const float*)(ws + WS_SOAB), (const float*)(ws + WS_SWBR)};
        GEMM_RUN2(epi::EpiBranch, g, S, E);
        if (rep + 1 < NREP(4)) xcd_barrier(bar); }
    }
    SEAM(4);
    if (IN(5)) { for (int rep = 0; rep < NREP(5); ++rep) { PHASE_BEGIN();
        rowquant_fp8(F, ws + WS_MRG, (size_t)DM * 2, ws + WS_MRG, (size_t)DM * 2, (float*)(ws + WS_SMRG), NTOK);
        xcd_barrier(bar);
        pg8::Gemm g{(const bf16_t*)(ws + WS_MRG), (const bf16_t*)(ws + WS_WOUT), NTOK, 4096, 4096, 2048}; pg8::StaticOrder S; S.init(NTOK, 4096, F.G, (int)blockIdx.x);
        epi::EpiOut E{F.in(0), F.in(1), (float*)(ws + WS_H1F), (bf16_t*)(ws + WS_H1B), rep ? nullptr : (u64*)(F.ctl + CW_SSQ_H1), (const float*)(ws + WS_SMRG), (const float*)(ws + WS_SWOUT)};
        GEMM_RUN(epi::EpiOut, g, S, E);
        if (rep + 1 < NREP(5)) xcd_barrier(bar); }
    }
    SEAM(5);
    if (IN(6)) { for (int rep = 0; rep < NREP(6); ++rep) { PHASE_BEGIN();
        pg8::Gemm g{(const bf16_t*)(ws + WS_H1B), (const bf16_t*)(ws + WS_WQ), NTOK, 2048, 4096, 4096}; pg8::StaticOrder S; S.init(NTOK, 2048, F.G, (int)blockIdx.x);
        epi::EpiPQ E{(bf16_t*)(ws + WS_PQ), (const u64*)(F.ctl + CW_SSQ_H1)};
        GEMM_RUN(epi::EpiPQ, g, S, E);
        if (rep + 1 < NREP(6)) xcd_barrier(bar); }
    }
    SEAM(6);
    if (IN(7)) { for (int rep = 0; rep < NREP(7); ++rep) { PHASE_BEGIN();
        if (F.wave & 4) { p6_tables(F); p7_routing(F); } else { p7_routing(F); p6_tables(F); }
        if (rep + 1 < NREP(7)) xcd_barrier(bar); } }
    SEAM(7);
    if (IN(8)) { for (int rep = 0; rep < NREP(8); ++rep) { PHASE_BEGIN(); p8_experts(F); if (rep + 1 < NREP(8)) xcd_barrier(bar); } }
#ifdef MK_PROBE_T
    {   PHASE_BEGIN();
        xcd_barrier(bar); STAMP(9); xcd_barrier(bar);
        const volatile u64* ts = (const volatile u64*)(F.ctl + 2048);
        const float tot = (float)(ts[9] - ts[0]);
        const float f1 = (float)(ts[MK_PROBE_K1 + 1] - ts[MK_PROBE_K1]) / tot, f2 = (float)(ts[MK_PROBE_K2 + 1] - ts[MK_PROBE_K2]) / tot;
        float* o = F.out(); const size_t gt = (size_t)blockIdx.x * 512 + F.tid, NGT = (size_t)gridDim.x * 512;
        for (size_t i = gt; i < (size_t)NB * SEQ * DM / 4; i += NGT) { f32x4 v = ((f32x4*)o)[i]; v = v * (1.0f - f1); if (i == 0) v[0] = 1000.0f * f2; ((f32x4*)o)[i] = v; }
    }
#endif
#undef IN
#undef SEAM
}

extern "C" void kernel_launch(void* const* d_in, const int* in_sizes, int n_in, void* d_out, int out_size, void* d_ws, size_t ws_size, hipStream_t stream) {
    static int grid = 0;
    if (grid == 0) {
        if (n_in != 16 || in_sizes[0] != NB * SEQ * DM || out_size != NB * SEQ * DM || ws_size < WS_END) {
            fprintf(stderr, "kernel_launch: unexpected problem shape (n_in %d, in0 %d, out %d, ws %zu < %zu); nothing launched\n", n_in, n_in > 0 ? in_sizes[0] : -1, out_size, ws_size, (size_t)WS_END); grid = -1; return; }
        int dev = 0, cus = 0, per_cu = 0;
        if (hipGetDevice(&dev) != hipSuccess || hipDeviceGetAttribute(&cus, hipDeviceAttributeMultiprocessorCount, dev) != hipSuccess) { grid = -1; return; }
        if (hipFuncSetAttribute((const void*)mk_fwd, hipFuncAttributeMaxDynamicSharedMemorySize, LDS_BYTES) != hipSuccess) { fprintf(stderr, "kernel_launch: hipFuncSetAttribute failed\n"); grid = -1; return; }
        if (hipOccupancyMaxActiveBlocksPerMultiprocessor(&per_cu, (const void*)mk_fwd, NWAVES * 64, LDS_BYTES) != hipSuccess || per_cu < 1) {
            fprintf(stderr, "kernel_launch: occupancy query reports %d workgroups per CU\n", per_cu); }
        (void)hipGetLastError();
        grid = cus;
    }
    if (grid < 0) return;
    if (hipMemsetAsync((char*)d_ws + WS_CTL, 0, CTL_ZERO_BYTES, stream) != hipSuccess) return;
    Args a{};
    for (int i = 0; i < 16; ++i) a.in[i] = (const float*)d_in[i];
    a.out = (float*)d_out; a.ws = (unsigned char*)d_ws;
#if MK_PER_PHASE
    for (int p = 0; p <= MK_LAST_PHASE; ++p) { a.ph_lo = p; a.ph_hi = p + 1; hipLaunchKernelGGL(mk_fwd, dim3(grid), dim3(NWAVES * 64), LDS_BYTES, stream, a); }
#else
    a.ph_lo = 0; a.ph_hi = MK_LAST_PHASE + 1;
    hipLaunchKernelGGL(mk_fwd, dim3(grid), dim3(NWAVES * 64), LDS_BYTES, stream, a);
#endif
}
```

```cpp
#include <hip/hip_runtime.h>
#include <cstdio>
#include <cstdint>

#define LAS __attribute__((address_space(3)))
#define GAS __attribute__((address_space(1)))
typedef unsigned short bf16_t;
typedef short bf16x8 __attribute__((ext_vector_type(8)));
typedef short s16x4 __attribute__((ext_vector_type(4)));
typedef float f32x2 __attribute__((ext_vector_type(2)));
typedef float f32x4 __attribute__((ext_vector_type(4)));
typedef float f32x16 __attribute__((ext_vector_type(16)));
typedef unsigned u32x2 __attribute__((ext_vector_type(2)));
typedef unsigned u32x4 __attribute__((ext_vector_type(4)));
typedef GAS unsigned gu32;

#ifndef MK_PER_PHASE
#define MK_PER_PHASE 0
#endif
#ifndef MK_LAST_PHASE
#define MK_LAST_PHASE 8
#endif

constexpr int NB = 4, SEQ = 4096, DM = 4096, NMETA = 16, TR = SEQ + NMETA  , TP = 4224  , M = NB * TP  ;
constexpr float EPS = 1e-6f;
constexpr int NV1 = 14080;
constexpr float LOG2E = 1.4426950408889634f;
constexpr float QB_SCALE = 0.08838834764831845f * LOG2E;
constexpr float QA_SCALE = 0.07216878364870323f * LOG2E;
constexpr int NWAVES = 8;
constexpr int NTOK = NB * SEQ;
constexpr int MK = NTOK + 256;
constexpr int MW = 130;
__device__ __forceinline__ int row_pos(int row) { return row < NTOK ? NMETA + (row & (SEQ - 1)) : row - NTOK; }
__device__ __forceinline__ int pos_row(int b, int p) { return p < NMETA ? NTOK + p : b * SEQ + (p - NMETA); }

constexpr size_t HM = 512u * 1024u;
constexpr size_t WS_CTL = 0, CTL_ZERO_BYTES = 2 * HM;
constexpr size_t WS_ROPE_M = 2 * HM;
constexpr size_t WS_ROPE_D = 5 * HM;
constexpr size_t WS_ROPE_I = 7 * HM;
constexpr size_t WS_SK   = 8 * HM;
constexpr size_t WS_WUQ  = 10 * HM;
constexpr size_t WS_WUKV = 22 * HM;
constexpr size_t WS_WBR  = 30 * HM;
constexpr size_t WS_WOUT = 94 * HM;
constexpr size_t WS_WQ   = 158 * HM;
constexpr size_t WS_EID  = 190 * HM;
constexpr size_t WS_GATE = 207 * HM;
constexpr size_t WS_MASK = 224 * HM;
constexpr size_t WS_KPE  = 242 * HM;
constexpr size_t WS_KIX  = 247 * HM;
constexpr size_t WS_WIX  = 252 * HM;
constexpr size_t WS_SCU  = 255 * HM;
constexpr size_t WS_SCV  = 255 * HM + 65536;
constexpr size_t WS_SX   = 255 * HM + 131072;
constexpr size_t WS_SW   = 255 * HM + 200704;
constexpr size_t WS_SWBR = 255 * HM + 294912;
constexpr size_t WS_SWOUT= 255 * HM + 311296;
constexpr size_t WS_SOAB = 255 * HM + 327680;
constexpr size_t WS_SMRG = 255 * HM + 393216;
constexpr size_t R23 = 260 * HM;
constexpr size_t WS_XN   = R23;
constexpr size_t WS_WIN  = R23 + 264 * HM;
constexpr size_t P1O = R23 + 484 * HM;
constexpr size_t WS_CQ   = P1O;
constexpr size_t WS_CKV  = P1O + 66 * HM;
constexpr size_t WS_QB   = P1O + 99 * HM;
constexpr size_t WS_KB   = P1O + 231 * HM;
constexpr size_t WS_VB   = P1O + 264 * HM;
constexpr size_t WS_QIX  = P1O + 297 * HM;
constexpr size_t WS_GA   = P1O + 363 * HM;
constexpr size_t WS_GB   = P1O + 627 * HM;
constexpr size_t R4 = P1O + 892 * HM;
constexpr size_t WS_OAB  = R4;
constexpr size_t WS_XN8  = R4;
constexpr size_t WS_WG8  = R4 + 132 * HM;
constexpr size_t WS_WUQ8 = R4 + 232 * HM;
constexpr size_t WS_WUKV8= R4 + 238 * HM;
constexpr size_t WS_SWUQ = 255 * HM + 458752;
constexpr size_t WS_SWUKV= 255 * HM + 475136;
constexpr size_t WS_PQ   = R4;
constexpr size_t WS_END  = R4 + 264 * HM;
constexpr size_t WS_QN   = R23;
constexpr size_t WS_QR   = R23 + 132 * HM;
constexpr size_t WS_KN   = R23 + 198 * HM;
constexpr size_t WS_VA   = R23 + 330 * HM;
constexpr size_t WS_MRG  = R23;
constexpr size_t WS_U    = R23;
constexpr size_t WS_V    = R23 + 256 * HM;
constexpr size_t WS_H1F  = R23 + 512 * HM;
constexpr size_t WS_H1B  = R23 + 1040 * HM;
static_assert(WS_VA + 132 * HM <= P1O && WS_H1F >= P1O && WS_H1B + 264 * HM <= R4 && WS_GB + 264 * HM <= R4, "ws map");
constexpr int CW_TMO = 0;
constexpr int CW_BAR = 4096;
constexpr int CW_QUEUE = 8192;
constexpr int CW_SSQ_CQ = 16384, CW_SSQ_CKV = 16384 + 2 * 17408, CW_SSQ_H1 = 16384 + 4 * 17408;
static_assert((CW_SSQ_H1 + 2 * 17408) * 4 <= (int)CTL_ZERO_BYTES, "ctl");

constexpr int RING_BYTES = 131072;
constexpr int LDSCTL_OFF = RING_BYTES;
constexpr int LDS_BYTES = 147456;

__device__ __forceinline__ unsigned f2bf(float f) { unsigned u = __float_as_uint(f); return (u + 0x7fffu + ((u >> 16) & 1u)) >> 16; }
__device__ __forceinline__ unsigned pk2(float lo, float hi) { return f2bf(lo) | (f2bf(hi) << 16); }
typedef __bf16 bf16x2_t __attribute__((ext_vector_type(2)));
__device__ __forceinline__ unsigned cvt_pk_bf16(float lo, float hi) { return __builtin_bit_cast(unsigned, __builtin_convertvector((f32x2){lo, hi}, bf16x2_t)); }
__device__ __forceinline__ float bf_lo(unsigned w) { return __uint_as_float(w << 16); }
__device__ __forceinline__ float bf_hi(unsigned w) { return __uint_as_float(w & 0xffff0000u); }
__device__ __forceinline__ u32x4 pack8(f32x4 a, f32x4 b) { u32x4 w; w.x = cvt_pk_bf16(a[0], a[1]); w.y = cvt_pk_bf16(a[2], a[3]); w.z = cvt_pk_bf16(b[0], b[1]); w.w = cvt_pk_bf16(b[2], b[3]); return w; }
__device__ __forceinline__ float wave_sum(float v) {
#pragma unroll
    for (int o = 1; o < 64; o <<= 1) v += __shfl_xor(v, o);
    return v;
}
#define LDS_WAIT() asm volatile("s_waitcnt lgkmcnt(0)" ::: "memory")
#define VM_WAIT() asm volatile("s_waitcnt vmcnt(0)" ::: "memory")
typedef unsigned long long u64;
__device__ __forceinline__ void ssq_add(u64* p, float v) { (void)__hip_atomic_fetch_add(p, (u64)(v * 16777216.0f), __ATOMIC_RELAXED, __HIP_MEMORY_SCOPE_AGENT); }
__device__ __forceinline__ float ssq_get(const u64* p) { return (float)((double)(*p) * (1.0 / 16777216.0)); }
namespace pg8 {
#define PG8_LAS __attribute__((address_space(3)))
typedef unsigned short bf16_t;
typedef short bf16x8 __attribute__((ext_vector_type(8)));
typedef float f32x4 __attribute__((ext_vector_type(4)));
typedef unsigned u32x4 __attribute__((ext_vector_type(4)));
constexpr int BM = 256, BK = 64, HALF = 128, HTB = HALF * BK * 2  , STAGE_BYTES = 8 * HTB, NXCD = 8, WGM = 8;

__host__ __device__ __forceinline__ int lds_byte(int r, int c) { const int st = (r >> 4) * 2 + (c >> 5), rr = r & 15, cc = c & 31, ob = rr * 64 + cc * 2; return st * 1024 + (ob ^ (((ob >> 9) & 1) << 5)); }
__host__ __device__ __forceinline__ void stage_rc(int b, int& R, int& C) { const int st = b / 1024, sb = b % 1024, swz = sb ^ (((sb >> 9) & 1) << 5); R = (st >> 1) * 16 + swz / 64; C = (st & 1) * 32 + (swz % 64) / 2; }
__host__ __device__ __forceinline__ int perm32(int rho) { const int n = rho >> 4, i = rho & 15; return 8 * (i >> 2) + 4 * n + (i & 3); }

typedef int i32x4_t __attribute__((ext_vector_type(4)));
typedef int i32x8_t __attribute__((ext_vector_type(8)));
__device__ __forceinline__ i32x8_t cat8(bf16x8 lo, bf16x8 hi) { const i32x4_t a = __builtin_bit_cast(i32x4_t, lo), b = __builtin_bit_cast(i32x4_t, hi); return __builtin_shufflevector(a, b, 0, 1, 2, 3, 4, 5, 6, 7); }
__device__ __forceinline__ void mfma_f8_acc(f32x4& c, const i32x8_t a, const i32x8_t b) {
#if defined(__HIP_DEVICE_COMPILE__)
    int sc = 0x7F7F7F7F;
    asm volatile("v_mfma_scale_f32_16x16x128_f8f6f4 %0, %1, %2, %0, %3, %3 op_sel_hi:[0,0,0]" : "+v"(c) : "v"(a), "v"(b), "v"(sc));
#else
    (void)c; (void)a; (void)b;
#endif
}
struct Unit { int pm, pn, kh; };
struct Gemm { const bf16_t* A; const bf16_t* Bt; int M, N, K, KL; };

struct StaticOrder {
    int nM, nN, nwg, G, c;
    __host__ __device__ void init(int M, int N, int G_, int c_) { nM = M / BM; nN = N / BM; nwg = nM * nN; G = G_; c = c_; }
    __host__ __device__ bool next(int i, Unit& u) const {
        const long L = (long)i * G + c; if (L >= nwg) return false;
        int wgid = (int)L; { const int q = nwg / NXCD, r = nwg % NXCD, xcd = wgid % NXCD, off = wgid / NXCD; wgid = (xcd < r ? xcd * (q + 1) : r * (q + 1) + (xcd - r) * q) + off; }
        const int nig = WGM * nN, gid = wgid / nig, fm = gid * WGM, gsz = (nM - fm) < WGM ? (nM - fm) : WGM;
        u.pm = fm + ((wgid % nig) % gsz); u.pn = (wgid % nig) / gsz; u.kh = 0; return true;
    }
    __device__ __forceinline__ void a_ready(const Unit&) const {}
    __device__ __forceinline__ void done(const Unit&) const {}
};

struct StaticOrder2 {
    StaticOrder base;
    __host__ __device__ void init(int M, int N, int G_, int c_) { base.init(M, N, G_, c_); }
    __host__ __device__ bool next(int i, Unit& u) const { if (!base.next(i >> 1, u)) return false; u.kh = i & 1; return true; }
    __device__ __forceinline__ void a_ready(const Unit&) const {}
    __device__ __forceinline__ void done(const Unit&) const {}
};

template <class Epi, class Sched, bool ALIGN_EPI = false, bool SP2 = false>
__device__ __forceinline__ void gemm_phase(PG8_LAS unsigned char* lds, const Gemm g, const Sched& S, const Epi& E) {
    int tid_; asm volatile("v_mov_b32 %0, %1" : "=v"(tid_) : "v"(threadIdx.x));
    const int tid = tid_, wid = __builtin_amdgcn_readfirstlane(tid >> 6), lane = tid & 63, wr = wid >> 2, wc = wid & 3, fr = lane & 15, fq = lane >> 4;
    const int K = g.K, nt = g.KL / BK; const size_t khoff = (size_t)g.KL * 2;
    unsigned voffA[2], voffB[2];
#pragma unroll
    for (int i = 0; i < 2; ++i) { int R, C; stage_rc(tid * 16 + i * 8192, R, C); const int Rb = Epi::PERM ? ((R & ~31) + perm32(R & 31)) : R;
        voffA[i] = (unsigned)(R * K + C) * 2u; voffB[i] = (unsigned)(Rb * K + C) * 2u; }
    const size_t kstep = (size_t)(BK * 2);
    const size_t hstep = (size_t)HALF * K * 2;
    const size_t tstep = 2 * hstep;
    const unsigned ldsw = (unsigned)wid * 1024u;
    const int aoff = lds_byte(wr * 64 + fr, fq * 8), boff = lds_byte(wc * 32 + fr, fq * 8);
#define PG8_SA(b, h) (((b) * 2 + (h)) * HTB)
#define PG8_SB(b, h) ((4 + (b) * 2 + (h)) * HTB)
#define PG8_STAGE(bufoff, gbase, voff) do { _Pragma("unroll") for (int _i = 0; _i < 2; ++_i) \
        __builtin_amdgcn_global_load_lds((const unsigned*)((const char*)(gbase) + (voff)[_i]), (PG8_LAS unsigned*)(lds + (bufoff) + ldsw + _i * 8192), 16, 0, 0); } while (0)
#define PG8_LDA(dst, b, h) do { _Pragma("unroll") for (int m = 0; m < 4; ++m) _Pragma("unroll") for (int k = 0; k < 2; ++k) dst[m][k] = *(const PG8_LAS bf16x8*)(lds + PG8_SA(b, h) + aoff + m * 2048 + k * 1024); } while (0)
#define PG8_LDB(dst, b, h) do { _Pragma("unroll") for (int n = 0; n < 2; ++n) _Pragma("unroll") for (int k = 0; k < 2; ++k) dst[n][k] = *(const PG8_LAS bf16x8*)(lds + PG8_SB(b, h) + boff + n * 2048 + k * 1024); } while (0)
#define PG8_MMA(ai, bj, At, Bt) do { __builtin_amdgcn_s_setprio(1); _Pragma("unroll") for (int m = 0; m < 4; ++m) _Pragma("unroll") for (int n = 0; n < 2; ++n) { \
        if constexpr (Epi::FP8) mfma_f8_acc(acc[ai][bj][m][n], cat8(Bt[n][0], Bt[n][1]), cat8(At[m][0], At[m][1])); \
        else { _Pragma("unroll") for (int k = 0; k < 2; ++k) acc[ai][bj][m][n] = __builtin_amdgcn_mfma_f32_16x16x32_bf16(Bt[n][k], At[m][k], acc[ai][bj][m][n], 0, 0, 0); } } \
        __builtin_amdgcn_s_setprio(0); } while (0)
#define PG8_WAIT_V(n) asm volatile("s_waitcnt vmcnt(" #n ")" ::: "memory")
#define PG8_WAIT_L(n) asm volatile("s_waitcnt lgkmcnt(" #n ")" ::: "memory")
#define PG8_BAR __builtin_amdgcn_s_barrier()
#define PG8_SCHED __builtin_amdgcn_sched_barrier(0)
    Unit cur, nxt; int ui = 0;
    if (!S.next(0, cur)) return;
    f32x4 acc[2][2][4][2];
#pragma unroll
    for (int a = 0; a < 2; ++a)
#pragma unroll
        for (int b = 0; b < 2; ++b)
#pragma unroll
            for (int m = 0; m < 4; ++m)
#pragma unroll
                for (int n = 0; n < 2; ++n) acc[a][b][m][n] = (f32x4){0.f, 0.f, 0.f, 0.f};
    bf16x8 At[4][2], B0[2][2], B1[2][2];
    const char* cA = (const char*)g.A + (size_t)cur.pm * tstep + (size_t)cur.kh * khoff; const char* cB = (const char*)g.Bt + (size_t)cur.pn * tstep + (size_t)cur.kh * khoff;
    S.a_ready(cur);
    if constexpr (SP2) {
        PG8_STAGE(PG8_SB(0, 0), cB, voffB); PG8_STAGE(PG8_SB(0, 1), cB + hstep, voffB); PG8_STAGE(PG8_SA(0, 0), cA, voffA); PG8_STAGE(PG8_SA(0, 1), cA + hstep, voffA);
        if (wr == 1) PG8_BAR;
        PG8_WAIT_V(2); PG8_BAR;
        PG8_STAGE(PG8_SB(1, 0), cB + kstep, voffB); PG8_STAGE(PG8_SA(1, 0), cA + kstep, voffA); PG8_STAGE(PG8_SB(1, 1), cB + hstep + kstep, voffB);
        PG8_WAIT_V(6); PG8_BAR;
    } else {
        PG8_STAGE(PG8_SB(0, 0), cB, voffB); PG8_STAGE(PG8_SA(0, 0), cA, voffA); PG8_STAGE(PG8_SB(0, 1), cB + hstep, voffB); PG8_STAGE(PG8_SA(0, 1), cA + hstep, voffA);
        if (wr == 1) PG8_BAR;
        PG8_WAIT_V(4); PG8_BAR;
        PG8_STAGE(PG8_SB(1, 0), cB + kstep, voffB); PG8_STAGE(PG8_SA(1, 0), cA + kstep, voffA); PG8_STAGE(PG8_SB(1, 1), cB + hstep + kstep, voffB);
        PG8_WAIT_V(6); PG8_BAR;
    }
    for (;;) {
        const bool has_next = S.next(ui + 1, nxt);
        const char* nA = has_next ? (const char*)g.A + (size_t)nxt.pm * tstep + (size_t)nxt.kh * khoff : cA; const char* nB = has_next ? (const char*)g.Bt + (size_t)nxt.pn * tstep + (size_t)nxt.kh * khoff : cB;
        for (int t = 0; t < nt; t += 2) {
            const bool last = (t == nt - 2);
            const char* a1 = cA + (size_t)(t + 1) * kstep;
            const char* a2 = last ? nA : cA + (size_t)(t + 2) * kstep; const char* b2 = last ? nB : cB + (size_t)(t + 2) * kstep;
            const char* a3 = a2 + kstep; const char* b3 = b2 + kstep;
            if (last && has_next) S.a_ready(nxt);
            if constexpr (SP2) {
            PG8_LDB(B0, 0, 0); PG8_LDB(B1, 0, 1); PG8_SCHED; PG8_LDA(At, 0, 0); PG8_STAGE(PG8_SA(1, 1), a1 + hstep, voffA);
            PG8_WAIT_V(8); PG8_WAIT_L(0); PG8_BAR; PG8_MMA(0, 0, At, B0); PG8_MMA(0, 1, At, B1); PG8_BAR; PG8_SCHED;
            PG8_LDA(At, 0, 1); PG8_STAGE(PG8_SB(0, 0), b2, voffB); PG8_STAGE(PG8_SB(0, 1), b2 + hstep, voffB); PG8_STAGE(PG8_SA(0, 0), a2, voffA);
            PG8_WAIT_V(8); PG8_WAIT_L(0); PG8_BAR; PG8_MMA(1, 0, At, B0); PG8_MMA(1, 1, At, B1); PG8_BAR; PG8_SCHED;
            PG8_LDB(B0, 1, 0); PG8_LDB(B1, 1, 1); PG8_SCHED; PG8_LDA(At, 1, 0); PG8_STAGE(PG8_SA(0, 1), a2 + hstep, voffA);
            PG8_WAIT_V(8); PG8_WAIT_L(0); PG8_BAR; PG8_MMA(0, 0, At, B0); PG8_MMA(0, 1, At, B1); PG8_BAR; PG8_SCHED;
            PG8_LDA(At, 1, 1); PG8_STAGE(PG8_SB(1, 0), b3, voffB); PG8_STAGE(PG8_SB(1, 1), b3 + hstep, voffB); PG8_STAGE(PG8_SA(1, 0), a3, voffA);
            PG8_WAIT_V(8); PG8_WAIT_L(0); PG8_BAR; PG8_MMA(1, 0, At, B0); PG8_MMA(1, 1, At, B1); PG8_BAR; PG8_SCHED;
            } else {
            PG8_LDB(B0, 0, 0); PG8_SCHED; PG8_LDA(At, 0, 0); PG8_STAGE(PG8_SA(1, 1), a1 + hstep, voffA);
            PG8_WAIT_L(8); PG8_BAR; PG8_WAIT_L(0); PG8_MMA(0, 0, At, B0); PG8_BAR; PG8_SCHED;
            PG8_LDB(B1, 0, 1); PG8_STAGE(PG8_SB(0, 0), b2, voffB);
            PG8_BAR; PG8_WAIT_L(0); PG8_MMA(0, 1, At, B1); PG8_BAR;
            PG8_LDA(At, 0, 1); PG8_STAGE(PG8_SA(0, 0), a2, voffA);
            PG8_BAR; PG8_WAIT_L(0); PG8_MMA(1, 0, At, B0); PG8_BAR; PG8_SCHED;
            PG8_STAGE(PG8_SB(0, 1), b2 + hstep, voffB);
            PG8_WAIT_V(6); PG8_BAR; PG8_MMA(1, 1, At, B1); PG8_BAR;
            PG8_LDB(B0, 1, 0); PG8_SCHED; PG8_LDA(At, 1, 0); PG8_STAGE(PG8_SA(0, 1), a2 + hstep, voffA);
            PG8_WAIT_L(8); PG8_BAR; PG8_WAIT_L(0); PG8_MMA(0, 0, At, B0); PG8_BAR; PG8_SCHED;
            PG8_LDB(B1, 1, 1); PG8_STAGE(PG8_SB(1, 0), b3, voffB);
            PG8_BAR; PG8_WAIT_L(0); PG8_MMA(0, 1, At, B1); PG8_BAR;
            PG8_LDA(At, 1, 1); PG8_STAGE(PG8_SA(1, 0), a3, voffA);
            PG8_BAR; PG8_WAIT_L(0); PG8_MMA(1, 0, At, B0); PG8_BAR; PG8_SCHED;
            PG8_STAGE(PG8_SB(1, 1), b3 + hstep, voffB);
            PG8_WAIT_V(6); PG8_BAR; PG8_MMA(1, 1, At, B1); PG8_BAR;
            }
        }
        if constexpr (ALIGN_EPI) { if (wr == 0) PG8_BAR; }
        if constexpr (!Epi::AFTER_DRAIN) { E(acc, cur, wr, wc, fr, fq); S.done(cur); }
        if (!has_next) break;
        if (!(Epi::SPLITK2 && cur.kh == 0))
#pragma unroll
        for (int a = 0; a < 2; ++a)
#pragma unroll
            for (int b = 0; b < 2; ++b)
#pragma unroll
                for (int m = 0; m < 4; ++m)
#pragma unroll
                    for (int n = 0; n < 2; ++n) acc[a][b][m][n] = (f32x4){0.f, 0.f, 0.f, 0.f};
        cur = nxt; cA = nA; cB = nB; ++ui;
        if constexpr (ALIGN_EPI) { if (wr == 1) PG8_BAR; }
    }
    PG8_WAIT_V(0);
    if constexpr (!ALIGN_EPI) { if (wr == 0) PG8_BAR; }
    PG8_BAR;
    if constexpr (Epi::AFTER_DRAIN) { E.fused(acc, cur, wr, wc, fr, fq, lds, wid, lane); S.done(cur); }
#undef PG8_SA
#undef PG8_SB
#undef PG8_STAGE
#undef PG8_LDA
#undef PG8_LDB
#undef PG8_MMA
#undef PG8_WAIT_V
#undef PG8_WAIT_L
#undef PG8_BAR
#undef PG8_SCHED
}
}
namespace epi {
using pg8::Unit;
typedef f32x4 Acc[2][2][4][2];

__device__ __forceinline__ void rot2(f32x4& v, const f32x4 cs) {
    const float a1 = v[0] * cs[0] - v[1] * cs[1], a2 = v[1] * cs[0] + v[0] * cs[1];
    const float b1 = v[2] * cs[2] - v[3] * cs[3], b2 = v[3] * cs[2] + v[2] * cs[3];
    v = (f32x4){a1, a2, b1, b2};
}
__device__ __forceinline__ float sigm(float x) { return 1.0f / (1.0f + __expf(-x)); }
__device__ __forceinline__ float sat8(float x) { return fminf(fmaxf(x, -448.0f), 448.0f); }
__device__ __forceinline__ u32x2 pack8_fp8(f32x4 a, f32x4 b) {
    int p0 = 0, p1 = 0;
    p0 = __builtin_amdgcn_cvt_pk_fp8_f32(sat8(a[0]), sat8(a[1]), p0, false); p0 = __builtin_amdgcn_cvt_pk_fp8_f32(sat8(a[2]), sat8(a[3]), p0, true);
    p1 = __builtin_amdgcn_cvt_pk_fp8_f32(sat8(b[0]), sat8(b[1]), p1, false); p1 = __builtin_amdgcn_cvt_pk_fp8_f32(sat8(b[2]), sat8(b[3]), p1, true);
    return (u32x2){(unsigned)p0, (unsigned)p1};
}

template <bool F8> struct EpiIn {
    static constexpr bool PERM = true, AFTER_DRAIN = false, SPLITK2 = false, FP8 = F8;
    bf16_t *cq, *ckv, *qb, *kb, *vb, *qix, *kpe, *kix, *ga, *gb; float* wix; u64 *ssq_cq, *ssq_ckv;
    const float *ropeM, *ropeD, *ropeI;
    const float *sx, *sw;
    __device__ __forceinline__ void operator()(const Acc& acc, const Unit& u, int wr, int wc, int fr, int fq) const {
        const int vt = F8 ? (u.pn < 18 ? u.pn : u.pn + 5) : u.pn + 18, rowb = u.pm * 256 + wr * 64 + fr, ct = wc * 32 + 8 * fq;
        f32x4 wsc[2][2];
        if (F8) {
#pragma unroll
            for (int bj = 0; bj < 2; ++bj) { const f32x4* p = (const f32x4*)(sw + u.pn * 256 + ct + bj * 128); wsc[bj][0] = p[0]; wsc[bj][1] = p[1]; }
        }
#define AV(ai_, bj_, m_, n_) (F8 ? acc[ai_][bj_][m_][n_] * rs * wsc[bj_][n_] : acc[ai_][bj_][m_][n_])
        if (vt < 6) {
            bf16_t* dst = vt < 4 ? cq : ckv; const int ld = vt < 4 ? 1024 : 512, cb = (vt < 4 ? vt : vt - 4) * 256 + ct; u64* ssq = vt < 4 ? ssq_cq : ssq_ckv;
#pragma unroll
            for (int ai = 0; ai < 2; ++ai)
#pragma unroll
                for (int m = 0; m < 4; ++m) { const int row = rowb + ai * 128 + m * 16; const float rs = F8 ? sx[row] : 1.f; (void)rs; float s = 0.f;
#pragma unroll
                    for (int bj = 0; bj < 2; ++bj) { const f32x4 v0 = AV(ai, bj, m, 0), v1 = AV(ai, bj, m, 1);
                        s += (v0[0] * v0[0] + v0[1] * v0[1]) + (v0[2] * v0[2] + v0[3] * v0[3]) + (v1[0] * v1[0] + v1[1] * v1[1]) + (v1[2] * v1[2] + v1[3] * v1[3]);
                        *(u32x2*)((unsigned char*)dst + (size_t)row * ld + cb + bj * 128) = pack8_fp8(v0, v1); }
                    s += __shfl_xor(s, 16); s += __shfl_xor(s, 32);
                    if (fq == 0 && ssq) ssq_add(ssq + row, s); }
        } else if (vt < 16) {
            const bool isq = vt < 14; bf16_t* dst = isq ? qb : kb; const int ld = isq ? 2048 : 512, cb = (isq ? vt - 6 : vt - 14) * 256 + ct;
#pragma unroll
            for (int ai = 0; ai < 2; ++ai)
#pragma unroll
                for (int m = 0; m < 4; ++m) { const int row = rowb + ai * 128 + m * 16, t = row_pos(row); const float rs = F8 ? sx[row] : 1.f; (void)rs;
                    f32x4 cs0 = (f32x4){1.f, 0.f, 1.f, 0.f}, cs1 = cs0;
                    if (wc == 0) { const f32x4* p = (const f32x4*)(ropeD + ((size_t)t * 16 + 4 * fq) * 2); cs0 = p[0]; cs1 = p[1]; }
#pragma unroll
                    for (int bj = 0; bj < 2; ++bj) { f32x4 v0 = AV(ai, bj, m, 0), v1 = AV(ai, bj, m, 1);
                        if (wc == 0) { rot2(v0, cs0); rot2(v1, cs1); }
                        *(u32x2*)((unsigned char*)dst + (size_t)row * ld + cb + bj * 128) = pack8_fp8(v0, v1); } }
        } else if (vt < 18) {
            const int cb = (vt - 16) * 256 + ct;
#pragma unroll
            for (int ai = 0; ai < 2; ++ai)
#pragma unroll
                for (int m = 0; m < 4; ++m) { const int row = rowb + ai * 128 + m * 16; const float rs = F8 ? sx[row] : 1.f; (void)rs;
#pragma unroll
                    for (int bj = 0; bj < 2; ++bj) *(u32x4*)(vb + (size_t)row * 512 + cb + bj * 128) = pack8(AV(ai, bj, m, 0), AV(ai, bj, m, 1)); }
        } else if (vt < 22) {
            const int cb = (vt - 18) * 256 + ct; const bool rt = ((wc & 1) == 0) && (fq < 2);
#pragma unroll
            for (int ai = 0; ai < 2; ++ai)
#pragma unroll
                for (int m = 0; m < 4; ++m) { const int row = rowb + ai * 128 + m * 16, t = row_pos(row); const float rs = F8 ? sx[row] : 1.f; (void)rs;
                    f32x4 cs0 = (f32x4){1.f, 0.f, 1.f, 0.f}, cs1 = cs0;
                    if (rt) { const f32x4* p = (const f32x4*)(ropeI + ((size_t)t * 8 + 4 * fq) * 2); cs0 = p[0]; cs1 = p[1]; }
#pragma unroll
                    for (int bj = 0; bj < 2; ++bj) { f32x4 v0 = AV(ai, bj, m, 0), v1 = AV(ai, bj, m, 1);
                        if (rt) { rot2(v0, cs0); rot2(v1, cs1); }
                        *(u32x4*)(qix + (size_t)row * 1024 + cb + bj * 128) = pack8(v0, v1); } }
        } else if (vt == 22) {
#pragma unroll
            for (int ai = 0; ai < 2; ++ai)
#pragma unroll
                for (int m = 0; m < 4; ++m) { const int row = rowb + ai * 128 + m * 16, t = row_pos(row); const float rs = F8 ? sx[row] : 1.f; (void)rs;
                    f32x4 v0 = AV(ai, 0, m, 0), v1 = AV(ai, 0, m, 1);
                    if (wc < 2) { const f32x4* p = (const f32x4*)(ropeM + ((size_t)t * 32 + 16 * wc + 4 * fq) * 2); rot2(v0, p[0]); rot2(v1, p[1]);
                        *(u32x2*)((unsigned char*)kpe + (size_t)row * 64 + ct) = pack8_fp8(v0, v1);
                    } else { if (wc == 2 && fq < 2) { const f32x4* p = (const f32x4*)(ropeI + ((size_t)t * 8 + 4 * fq) * 2); rot2(v0, p[0]); rot2(v1, p[1]); }
                        *(u32x4*)(kix + (size_t)row * 64 + (ct - 64)) = pack8(v0, v1); }
                    if (wc == 0 && fq < 2) { float* w = wix + (size_t)row * 16 + 8 * fq; *(f32x4*)w = AV(ai, 1, m, 0); *(f32x4*)(w + 4) = AV(ai, 1, m, 1); } }
        } else {
            const bool isa = vt < 39; bf16_t* dst = isa ? ga : gb; const int cb = (isa ? vt - 23 : vt - 39) * 256 + ct;
#pragma unroll
            for (int ai = 0; ai < 2; ++ai)
#pragma unroll
                for (int m = 0; m < 4; ++m) { const int row = rowb + ai * 128 + m * 16; const float rs = F8 ? sx[row] : 1.f; (void)rs;
#pragma unroll
                    for (int bj = 0; bj < 2; ++bj) { f32x4 v0 = AV(ai, bj, m, 0), v1 = AV(ai, bj, m, 1);
#pragma unroll
                        for (int e = 0; e < 4; ++e) { v0[e] = sigm(v0[e]); v1[e] = sigm(v1[e]); }
                        *(u32x4*)(dst + (size_t)row * 4096 + cb + bj * 128) = pack8(v0, v1); } }
        }
#undef AV
    }
};

struct EpiUp {
    static constexpr bool PERM = true, AFTER_DRAIN = false, SPLITK2 = false, FP8 = true;
    unsigned char *d0, *d1; int nt0, ld0, ld1; bool d1_bf16; const u64* ssq; float invK; const float* rope; const float* sw;
    __device__ __forceinline__ void operator()(const Acc& acc, const Unit& u, int wr, int wc, int fr, int fq) const {
        const int vt = u.pn, rowb = u.pm * 256 + wr * 64 + fr, ct = wc * 32 + 8 * fq; const bool first = vt < nt0;
        unsigned char* dst = first ? d0 : d1; const int ld = first ? ld0 : ld1, cb = (first ? vt : vt - nt0) * 256 + ct; const bool rt = (!first) && (rope != nullptr), wide = (!first) && d1_bf16;
        f32x4 w0[2], w1[2];
#pragma unroll
        for (int bj = 0; bj < 2; ++bj) { const f32x4* p = (const f32x4*)(sw + vt * 256 + ct + bj * 128); w0[bj] = p[0]; w1[bj] = p[1]; }
#pragma unroll
        for (int ai = 0; ai < 2; ++ai)
#pragma unroll
            for (int m = 0; m < 4; ++m) { const int row = rowb + ai * 128 + m * 16, t = row_pos(row);
                const float rs = __builtin_amdgcn_rsqf(ssq_get(ssq + row) * invK + EPS);
                f32x4 cs0 = (f32x4){1.f, 0.f, 1.f, 0.f}, cs1 = cs0;
                if (rt) { const f32x4* p = (const f32x4*)(rope + ((size_t)t * 32 + 16 * (wc & 1) + 4 * fq) * 2); cs0 = p[0]; cs1 = p[1]; }
#pragma unroll
                for (int bj = 0; bj < 2; ++bj) { f32x4 v0 = acc[ai][bj][m][0] * rs * w0[bj], v1 = acc[ai][bj][m][1] * rs * w1[bj];
                    if (rt) { rot2(v0, cs0); rot2(v1, cs1); }
                    if (wide) *(u32x4*)(dst + (size_t)row * ld + (size_t)(cb + bj * 128) * 2) = pack8(v0, v1);
                    else *(u32x2*)(dst + (size_t)row * ld + cb + bj * 128) = pack8_fp8(v0, v1); } }
    }
};

struct EpiBranch {
    static constexpr bool PERM = true, AFTER_DRAIN = false, SPLITK2 = true, FP8 = true;
    const bf16_t *ga, *gb; bf16_t* out; const float *srow, *scol;
    __device__ __forceinline__ void operator()(Acc& acc, const Unit& u, int wr, int wc, int fr, int fq) const {
        const int rowb = u.pm * 256 + wr * 64 + fr, cb = u.pn * 256 + wc * 32 + 8 * fq;
        if (u.kh == 0) {
#pragma unroll
            for (int ai = 0; ai < 2; ++ai)
#pragma unroll
                for (int m = 0; m < 4; ++m) { const size_t ro = (size_t)(rowb + ai * 128 + m * 16) * 4096 + cb;
#pragma unroll
                    for (int bj = 0; bj < 2; ++bj) { const u32x4 a = *(const u32x4*)(ga + ro + bj * 128), b = *(const u32x4*)(gb + ro + bj * 128);
                        f32x4 r0, r1;
#define RQ(x, y) ((x) * __builtin_amdgcn_rcpf(y))
                        r0[0] = RQ(bf_lo(a.x), bf_lo(b.x)); r0[1] = RQ(bf_hi(a.x), bf_hi(b.x)); r0[2] = RQ(bf_lo(a.y), bf_lo(b.y)); r0[3] = RQ(bf_hi(a.y), bf_hi(b.y));
                        r1[0] = RQ(bf_lo(a.z), bf_lo(b.z)); r1[1] = RQ(bf_hi(a.z), bf_hi(b.z)); r1[2] = RQ(bf_lo(a.w), bf_lo(b.w)); r1[3] = RQ(bf_hi(a.w), bf_hi(b.w));
#undef RQ
                        acc[ai][bj][m][0] = acc[ai][bj][m][0] * r0; acc[ai][bj][m][1] = acc[ai][bj][m][1] * r1; }
                    asm volatile("" ::: "memory"); }
        } else {
            f32x4 w0[2], w1[2];
#pragma unroll
            for (int bj = 0; bj < 2; ++bj) { const f32x4* p = (const f32x4*)(scol + cb + bj * 128); w0[bj] = p[0]; w1[bj] = p[1]; }
#pragma unroll
            for (int ai = 0; ai < 2; ++ai)
#pragma unroll
                for (int m = 0; m < 4; ++m) { const int row = rowb + ai * 128 + m * 16; const size_t ro = (size_t)row * 4096 + cb; const float rs = srow[row];
#pragma unroll
                    for (int bj = 0; bj < 2; ++bj) { const u32x4 b = *(const u32x4*)(gb + ro + bj * 128);
                        const f32x4 s0 = (f32x4){bf_lo(b.x), bf_hi(b.x), bf_lo(b.y), bf_hi(b.y)} * rs * w0[bj], s1 = (f32x4){bf_lo(b.z), bf_hi(b.z), bf_lo(b.w), bf_hi(b.w)} * rs * w1[bj];
                        *(u32x4*)(out + ro + bj * 128) = pack8(acc[ai][bj][m][0] * s0, acc[ai][bj][m][1] * s1); } }
        }
    }
};

struct EpiOut {
    static constexpr bool PERM = true, AFTER_DRAIN = false, SPLITK2 = false, FP8 = true;
    const float *x, *meta; float* h1f; bf16_t* h1b; u64* ssq; const float *srow, *scol;
    __device__ __forceinline__ void operator()(const Acc& acc, const Unit& u, int wr, int wc, int fr, int fq) const {
        const int rowb = u.pm * 256 + wr * 64 + fr, cb = u.pn * 256 + wc * 32 + 8 * fq;
#pragma unroll
        for (int ai = 0; ai < 2; ++ai)
#pragma unroll
            for (int m = 0; m < 4; ++m) { const int row = rowb + ai * 128 + m * 16;
                const float* src = x + (size_t)row * DM;
                float s = 0.f; const float rs = srow[row];
#pragma unroll
                for (int bj = 0; bj < 2; ++bj) { const f32x4* wp = (const f32x4*)(scol + cb + bj * 128); f32x4 v0 = acc[ai][bj][m][0] * rs * wp[0], v1 = acc[ai][bj][m][1] * rs * wp[1];
                    v0 = v0 + *(const f32x4*)(src + cb + bj * 128); v1 = v1 + *(const f32x4*)(src + cb + bj * 128 + 4);
                    s += (v0[0] * v0[0] + v0[1] * v0[1]) + (v0[2] * v0[2] + v0[3] * v0[3]) + (v1[0] * v1[0] + v1[1] * v1[1]) + (v1[2] * v1[2] + v1[3] * v1[3]);
                    float* o = h1f + (size_t)row * DM + cb + bj * 128; *(f32x4*)o = v0; *(f32x4*)(o + 4) = v1;
                    *(u32x4*)(h1b + (size_t)row * DM + cb + bj * 128) = pack8(v0, v1); }
                s += __shfl_xor(s, 16); s += __shfl_xor(s, 32);
                if (fq == 0 && ssq) ssq_add(ssq + row, s); }
    }
};

struct EpiPQ {
    static constexpr bool PERM = true, AFTER_DRAIN = false, SPLITK2 = false, FP8 = false;
    bf16_t* pq; const u64* ssq;
    __device__ __forceinline__ void operator()(const Acc& acc, const Unit& u, int wr, int wc, int fr, int fq) const {
        const int rowb = u.pm * 256 + wr * 64 + fr, cb = u.pn * 256 + wc * 32 + 8 * fq;
#pragma unroll
        for (int ai = 0; ai < 2; ++ai)
#pragma unroll
            for (int m = 0; m < 4; ++m) { const int row = rowb + ai * 128 + m * 16; const float rs = __builtin_amdgcn_rsqf(ssq_get(ssq + row) * (1.0f / DM) + EPS);
#pragma unroll
                for (int bj = 0; bj < 2; ++bj) *(u32x4*)(pq + (size_t)row * 2048 + cb + bj * 128) = pack8(acc[ai][bj][m][0] * rs, acc[ai][bj][m][1] * rs); }
    }
};
}
#define XB_TMO      128
#define XB_XCNT(j)  (256  + 64 * (j))
#define XB_XSUB(j)  (1280 + 64 * (j))
#define XB_XGEN(j)  (2304 + 64 * (j))
#define XB_TOP      3328
#define XB_TOPGEN   3392
#define XCD_BAR_WORDS 3456
#define XB_SPIN_CAP (1u << 18)
__device__ __forceinline__ unsigned xb_ld(unsigned* p)              { return __hip_atomic_load(p, __ATOMIC_RELAXED, __HIP_MEMORY_SCOPE_AGENT); }
__device__ __forceinline__ unsigned xb_add(unsigned* p, unsigned v) { return __hip_atomic_fetch_add(p, v, __ATOMIC_RELAXED, __HIP_MEMORY_SCOPE_AGENT); }
__device__ __forceinline__ unsigned xb_xcc_id() { return (unsigned)__builtin_amdgcn_s_getreg((3 << 11) | 20) & 0xFu; }
#define XB_SPIN(cond, bar) do { unsigned _sp = 0; while (cond) { __builtin_amdgcn_s_sleep(1); \
    if ((++_sp & 255u) == 0u) { if (xb_ld(&(bar)[XB_TMO])) break; if (_sp > XB_SPIN_CAP) { atomicAdd(&(bar)[XB_TMO], 1u); break; } } } } while (0)
struct XcdBarrier { unsigned* bar; unsigned x; volatile LAS unsigned* st; };
__device__ __forceinline__ XcdBarrier xcd_barrier_post(unsigned* bar, volatile LAS unsigned* st) {
    XcdBarrier b; b.bar = bar; b.x = xb_xcc_id(); b.st = st;
    if (threadIdx.x == 0) (void)xb_add(&bar[XB_XCNT(b.x)], 1u);
    return b;
}
__device__ __forceinline__ void xcd_barrier_complete(unsigned* bar, unsigned x, unsigned& nloc, unsigned& nx) {
    const unsigned G = gridDim.x * gridDim.y * gridDim.z;
    unsigned sum, cnt, mine, sp = 0u;
    for (;;) {
        sum = 0u; cnt = 0u; mine = 0u;
#pragma unroll
        for (unsigned j = 0; j < 16; ++j) { const unsigned c = xb_ld(&bar[XB_XCNT(j)]); sum += c; cnt += (c > 0u) ? 1u : 0u; mine = (j == x) ? c : mine; }
        if (sum == G) break;
        __builtin_amdgcn_s_sleep(1);
        if ((++sp & 255u) == 0u) { if (xb_ld(&bar[XB_TMO])) break; if (sp > XB_SPIN_CAP) { atomicAdd(&bar[XB_TMO], 1u); break; } }
    }
    nloc = mine > 0u ? mine : 1u; nx = cnt > 0u ? cnt : 1u;
}
__device__ __forceinline__ void xcd_barrier(const XcdBarrier& b) {
    asm volatile("s_waitcnt vmcnt(0)" ::: "memory");
    __syncthreads();
    if (threadIdx.x == 0) {
        unsigned* bar = b.bar;
        __builtin_amdgcn_s_waitcnt(0);
        unsigned nloc = b.st[0], nx = b.st[1];
        if (nloc == 0u) { xcd_barrier_complete(bar, b.x, nloc, nx); b.st[0] = nloc; b.st[1] = nx; }
        const unsigned old = xb_add(&bar[XB_XSUB(b.x)], 1u);
        const unsigned gen = old / nloc;
        if (old + 1u == (gen + 1u) * nloc) {
            __builtin_amdgcn_fence(__ATOMIC_RELEASE, "agent");
            asm volatile("s_waitcnt vmcnt(0)" ::: "memory");
            const unsigned og = xb_add(&bar[XB_TOP], 1u);
            const unsigned tg = og / nx;
            if (og + 1u == (tg + 1u) * nx) xb_add(&bar[XB_TOPGEN], 1u);
            else XB_SPIN(xb_ld(&bar[XB_TOPGEN]) == tg, bar);
            __builtin_amdgcn_fence(__ATOMIC_ACQUIRE, "agent");
            xb_add(&bar[XB_XGEN(b.x)], 1u);
            asm volatile("s_waitcnt vmcnt(0)" ::: "memory");
        } else {
            XB_SPIN(xb_ld(&bar[XB_XGEN(b.x)]) == gen, bar);
            __builtin_amdgcn_fence(__ATOMIC_ACQUIRE, "agent");
            asm volatile("s_waitcnt vmcnt(0)" ::: "memory");
        }
    }
    __syncthreads();
}

struct Frame {
    LAS unsigned char* lds;
    unsigned char* ws;
    unsigned* ctl;
    int tid, lane, wave, vcu, G;
    __device__ __forceinline__ const float* in(int i) const { return ((const float* const __attribute__((address_space(4)))*)__builtin_amdgcn_kernarg_segment_ptr())[i]; }
    __device__ __forceinline__ float* out() const { return ((float* const __attribute__((address_space(4)))*)__builtin_amdgcn_kernarg_segment_ptr())[16]; }
};

struct MapId { __device__ __forceinline__ int operator()(int v) const { return v; } };
struct MapIn { __device__ __forceinline__ int operator()(int vn) const {
    const int v = vn < 1280 ? vn + 4608 : (vn < 5888 ? vn - 1280 : vn);
    if (v < 1536) return v;
    if (v < 3584) { const int w = v - 1536, hd = w >> 7; int o = w & 127; if (o < 32) o = (o & 1) ? (o >> 1) + 16 : (o >> 1); return 1600 + hd * 128 + o; }
    if (v < 4096) { const int w = v - 3584, hd = w >> 7; int o = w & 127; if (o < 32) o = (o & 1) ? (o >> 1) + 16 : (o >> 1); return 3648 + hd * 128 + o; }
    if (v < 4608) return 4160 + (v - 4096);
    if (v < 5632) { const int w = v - 4608, hd = w >> 6; int o = w & 63; if (o < 16) o = (o & 1) ? (o >> 1) + 8 : (o >> 1); return 4672 + hd * 64 + o; }
    if (v < 5888) { const int w = v - 5632;
        if (w < 64) return 1536 + ((w & 1) ? (w >> 1) + 32 : (w >> 1));
        if (w < 128) { int o = w - 64; if (o < 16) o = (o & 1) ? (o >> 1) + 8 : (o >> 1); return 5696 + o; }
        if (w < 144) return 5760 + (w - 128);
        return -1; }
    if (v < 9984) return 5776 + (v - 5888);
    return 9872 + (v - 9984);
} };
struct MapUq { __device__ __forceinline__ int operator()(int v) const {
    if (v < 2048) return (v >> 7) * 192 + (v & 127);
    const int w = v - 2048, hd = w >> 6, o = w & 63; return hd * 192 + 128 + ((o & 1) ? (o >> 1) + 32 : (o >> 1)); } };
struct MapUkv { __device__ __forceinline__ int operator()(int v) const {
    if (v < 2048) return (v >> 7) * 256 + (v & 127);
    const int w = v - 2048; return (w >> 7) * 256 + 128 + (w & 127); } };

template <class Map>
__device__ __forceinline__ void p0_transpose_item(const float* W, int K, int Nsrc, int Nvirt, bf16_t* WT, const float* gk, LAS float* scr, int item, int lane, Map map) {
    const int nblk = Nvirt / 32, kb = item / nblk, nb = item % nblk, k0 = 64 * kb, n0 = 32 * nb;
    const int sc = map(n0 + (lane & 31));
    float tv[32];
#pragma unroll
    for (int i = 0; i < 32; ++i) { const int kk = 2 * i + (lane >> 5); tv[i] = (sc >= 0) ? W[(size_t)(k0 + kk) * Nsrc + sc] : 0.f; }
    if (gk) {
#pragma unroll
        for (int i = 0; i < 32; ++i) tv[i] *= gk[k0 + 2 * i + (lane >> 5)]; }
#pragma unroll
    for (int i = 0; i < 32; ++i) scr[(2 * i + (lane >> 5)) * 33 + (lane & 31)] = tv[i];
    LDS_WAIT(); asm volatile("" ::: "memory");
    const int c = lane & 7;
#pragma unroll
    for (int j = 0; j < 4; ++j) { const int n = (lane >> 3) + 8 * j; const LAS float* s = scr + (8 * c) * 33 + n;
        u32x4 o; o.x = pk2(s[0 * 33], s[1 * 33]); o.y = pk2(s[2 * 33], s[3 * 33]); o.z = pk2(s[4 * 33], s[5 * 33]); o.w = pk2(s[6 * 33], s[7 * 33]);
        *(u32x4*)(WT + (size_t)(n0 + n) * K + k0 + 8 * c) = o; }
    LDS_WAIT(); asm volatile("" ::: "memory");
}
__device__ __forceinline__ float wave_max(float v) {
#pragma unroll
    for (int o = 1; o < 64; o <<= 1) v = fmaxf(v, __shfl_xor(v, o));
    return v;
}
__device__ __forceinline__ void p0_xn_row(const Frame& F, int m) {
    const float* x = F.in(0); const float* meta = F.in(1); const float* g = F.in(2);
    bf16_t* o = (bf16_t*)(F.ws + WS_XN) + (size_t)m * DM;
    u32x2* o8 = (u32x2*)o + F.lane;
    if (m >= NTOK + NMETA) {
        unsigned* z8 = (unsigned*)(F.ws + WS_XN8 + (size_t)m * DM) + F.lane;
#pragma unroll
        for (int j = 0; j < 16; ++j) { o8[64 * j] = (u32x2){0u, 0u}; z8[64 * j] = 0u; }
        if (F.lane == 0) ((float*)(F.ws + WS_SX))[m] = 0.f;
        return; }
    const float* src = m < NTOK ? x + (size_t)m * DM : meta + (size_t)(m - NTOK) * DM;
    const f32x4* xr = (const f32x4*)src + F.lane; const f32x4* gr = (const f32x4*)g + F.lane;
    f32x4 v[16]; float s = 0.f;
#pragma unroll
    for (int j = 0; j < 16; ++j) { v[j] = xr[64 * j]; s += (v[j][0] * v[j][0] + v[j][1] * v[j][1]) + (v[j][2] * v[j][2] + v[j][3] * v[j][3]); }
    const float rstd = 1.0f / sqrtf(wave_sum(s) * (1.0f / DM) + EPS);
    float mx = 0.f;
#pragma unroll
    for (int j = 0; j < 16; ++j) { const f32x4 gg = gr[64 * j]; v[j] = v[j] * rstd * gg; o8[64 * j] = (u32x2){pk2(v[j][0], v[j][1]), pk2(v[j][2], v[j][3])};
        mx = fmaxf(mx, fmaxf(fmaxf(fabsf(v[j][0]), fabsf(v[j][1])), fmaxf(fabsf(v[j][2]), fabsf(v[j][3])))); }
    mx = fmaxf(wave_max(mx), 1e-30f);
    const float inv = 448.0f / mx;
    if (F.lane == 0) ((float*)(F.ws + WS_SX))[m] = mx * (1.0f / 448.0f);
    unsigned* q8 = (unsigned*)(F.ws + WS_XN8 + (size_t)m * DM) + F.lane;
#pragma unroll
    for (int j = 0; j < 16; ++j) { f32x4 q = v[j] * inv;
#pragma unroll
        for (int e = 0; e < 4; ++e) q[e] = fminf(fmaxf(q[e], -448.0f), 448.0f);
        int p = 0; p = __builtin_amdgcn_cvt_pk_fp8_f32(q[0], q[1], p, false); p = __builtin_amdgcn_cvt_pk_fp8_f32(q[2], q[3], p, true); q8[64 * j] = (unsigned)p; }
}
__device__ __forceinline__ void p0_prologue(const Frame& F) {
    LAS float* scr = (LAS float*)(F.lds + F.wave * 16384);
    const int gw = F.vcu * NWAVES + F.wave, NGW = F.G * NWAVES;
    const float* w_in = F.in(3); const float* qg = F.in(4); const float* w_uq = F.in(5); const float* kvg = F.in(6); const float* w_ukv = F.in(7);
    const float* w_br = F.in(8); const float* w_out = F.in(9); const float* fg = F.in(10); const float* w_q = F.in(11); const float* sk = F.in(12);
    constexpr int I_IN = 64 * (NV1 / 32), I_UQ = 16 * (3072 / 32), I_UKV = 8 * (4096 / 32), I_BR = 64 * 128, I_OUT = 64 * 128, I_Q = 64 * 64;
    constexpr int NITEMS = I_IN + I_UQ + I_UKV + I_BR + I_OUT + I_Q;
    for (int it = gw; it < NITEMS; it += NGW) {
        int r = it;
        if (r < I_IN) { p0_transpose_item(w_in, 4096, 13968, NV1, (bf16_t*)(F.ws + WS_WIN), nullptr, scr, r, F.lane, MapIn()); continue; } r -= I_IN;
        if (r < I_UQ) { p0_transpose_item(w_uq, 1024, 3072, 3072, (bf16_t*)(F.ws + WS_WUQ), qg, scr, r, F.lane, MapUq()); continue; } r -= I_UQ;
        if (r < I_UKV) { p0_transpose_item(w_ukv, 512, 4096, 4096, (bf16_t*)(F.ws + WS_WUKV), kvg, scr, r, F.lane, MapUkv()); continue; } r -= I_UKV;
        if (r < I_BR) { p0_transpose_item(w_br, 4096, 4096, 4096, (bf16_t*)(F.ws + WS_WBR), nullptr, scr, r, F.lane, MapId()); continue; } r -= I_BR;
        if (r < I_OUT) { p0_transpose_item(w_out, 4096, 4096, 4096, (bf16_t*)(F.ws + WS_WOUT), nullptr, scr, r, F.lane, MapId()); continue; } r -= I_OUT;
        p0_transpose_item(w_q, 4096, 2048, 2048, (bf16_t*)(F.ws + WS_WQ), fg, scr, r, F.lane, MapId());
    }
    for (int m = gw; m < MK; m += NGW) p0_xn_row(F, m);
    const int gt = (F.vcu * NWAVES + F.wave) * 64 + F.lane, NGT = NGW * 64;
    for (int i = gt; i < TP * 56; i += NGT) {
        const int t = i / 56, r = i % 56; int j, rot; float* dst;
        if (r < 32) { j = r; rot = 64; dst = (float*)(F.ws + WS_ROPE_M) + ((size_t)t * 32 + j) * 2; }
        else if (r < 48) { j = r - 32; rot = 32; dst = (float*)(F.ws + WS_ROPE_D) + ((size_t)t * 16 + j) * 2; }
        else { j = r - 48; rot = 16; dst = (float*)(F.ws + WS_ROPE_I) + ((size_t)t * 8 + j) * 2; }
        const float ex = (float)(2 * j) / (float)rot;
        const float inv = powf(500000.0f, -ex);
        const float ang = (float)t * inv;
        const double a = (double)ang, kq = rint(a * 0.15915494309189535), rr = fma(-kq, 6.283185307179586, a);
        const float rf = (float)rr;
        dst[0] = cosf(rf); dst[1] = sinf(rf);
    }
    for (int i = gt; i < 16 * 128 * 128 / 8; i += NGT) { const f32x4* s = (const f32x4*)sk + 2 * (size_t)i; const f32x4 a = s[0], b2 = s[1];
        u32x4 o; o.x = pk2(a[0], a[1]); o.y = pk2(a[2], a[3]); o.z = pk2(b2[0], b2[1]); o.w = pk2(b2[2], b2[3]); ((u32x4*)(F.ws + WS_SK))[i] = o; }
}
__device__ __forceinline__ unsigned fp6_code(float q) {
    const unsigned b = __float_as_uint(q), sgn = (b >> 31) << 5; const float aq = fabsf(q);
    const unsigned sub = (unsigned)rintf(aq * 8.0f);
    unsigned ab = b & 0x7fffffffu; ab = ab + 0x7FFFFu + ((ab >> 20) & 1u);
    const unsigned nrm = (ab >> 20) - (126u << 3);
    unsigned code = aq < 1.0f ? sub : nrm; code = code > 31u ? 31u : code;
    return code | sgn;
}
__device__ __forceinline__ void fp6_pack32(const unsigned (&c)[32], unsigned (&w)[6]) {
#pragma unroll
    for (int i = 0; i < 6; ++i) w[i] = 0u;
#pragma unroll
    for (int k = 0; k < 32; ++k) { const int bit = 6 * k, d = bit >> 5, sh = bit & 31; w[d] |= c[k] << sh; if (sh > 26) w[d + 1] |= c[k] >> (32 - sh); }
}
__device__ __forceinline__ void p6_quant_row(const float* src, const float* gain, unsigned char* dst, float* scale_out, int lane) {
    const f32x4* s = (const f32x4*)src + lane; f32x4 v[16]; float mx = 0.f;
#pragma unroll
    for (int j = 0; j < 16; ++j) { v[j] = s[64 * j]; if (gain) v[j] = v[j] * ((const f32x4*)gain)[lane + 64 * j];
        mx = fmaxf(mx, fmaxf(fmaxf(fabsf(v[j][0]), fabsf(v[j][1])), fmaxf(fabsf(v[j][2]), fabsf(v[j][3])))); }
    mx = fmaxf(wave_max(mx), 1e-30f);
    const float sc = mx * (1.0f / 7.5f), inv = 7.5f / mx;
    if (lane == 0) *scale_out = sc;
    unsigned w[12];
#pragma unroll
    for (int g = 0; g < 2; ++g) { unsigned c[32];
#pragma unroll
        for (int j = 0; j < 8; ++j)
#pragma unroll
            for (int i = 0; i < 4; ++i) c[4 * j + i] = fp6_code(v[8 * g + j][i] * inv);
        unsigned ww[6]; fp6_pack32(c, ww);
#pragma unroll
        for (int i = 0; i < 6; ++i) w[6 * g + i] = ww[i]; }
#pragma unroll
    for (int q = 0; q < 3; ++q) *(u32x4*)(dst + 1024 * q + 16 * lane) = (u32x4){w[4 * q], w[4 * q + 1], w[4 * q + 2], w[4 * q + 3]};
}
__device__ __forceinline__ unsigned fp4_code(float q) {
    const float aq = fabsf(q);
    const unsigned c = (aq > 0.25f ? 1u : 0u) + (aq >= 0.75f ? 1u : 0u) + (aq > 1.25f ? 1u : 0u) + (aq >= 1.75f ? 1u : 0u) + (aq > 2.5f ? 1u : 0u) + (aq >= 3.5f ? 1u : 0u) + (aq > 5.0f ? 1u : 0u);
    return c | ((__float_as_uint(q) >> 31) << 3);
}
__device__ __forceinline__ void p6_quant_row4(const float* src, const float* gain, unsigned char* dst, float* scale_out, int lane) {
    const f32x4* s = (const f32x4*)src + lane; f32x4 v[16]; float mx = 0.f;
#pragma unroll
    for (int j = 0; j < 16; ++j) { v[j] = s[64 * j]; if (gain) v[j] = v[j] * ((const f32x4*)gain)[lane + 64 * j];
        mx = fmaxf(mx, fmaxf(fmaxf(fabsf(v[j][0]), fabsf(v[j][1])), fmaxf(fabsf(v[j][2]), fabsf(v[j][3])))); }
    mx = fmaxf(wave_max(mx), 1e-30f);
    const float sc = mx * (1.0f / 6.0f), inv = 6.0f / mx;
    if (lane == 0) *scale_out = sc;
    unsigned w[8];
#pragma unroll
    for (int d = 0; d < 8; ++d) { unsigned x = 0u;
#pragma unroll
        for (int i = 0; i < 4; ++i) { x |= fp4_code(v[2 * d][i] * inv) << (4 * i); x |= fp4_code(v[2 * d + 1][i] * inv) << (16 + 4 * i); }
        w[d] = x; }
#pragma unroll
    for (int q = 0; q < 2; ++q) *(u32x4*)(dst + 1024 * q + 16 * lane) = (u32x4){w[4 * q], w[4 * q + 1], w[4 * q + 2], w[4 * q + 3]};
}
#ifndef PEER_U_BITS
#define PEER_U_BITS 4
#endif
#ifndef PEER_V_BITS
#define PEER_V_BITS 4
#endif
constexpr int PEER_U_ROWB = PEER_U_BITS == 4 ? 2048 : 3072, PEER_V_ROWB = PEER_V_BITS == 4 ? 2048 : 3072;
__device__ __forceinline__ void p6_tables(const Frame& F) {
    const float* fg = F.in(10); const float* pu = F.in(13); const float* pv = F.in(14);
    const int gw = F.vcu * NWAVES + F.wave, NGW = F.G * NWAVES;
    for (int it = gw; it < 2 * 16384; it += NGW) { const int e = it >> 1;
        if (it & 1) { if (PEER_V_BITS == 4) p6_quant_row4(pv + (size_t)e * DM, nullptr, F.ws + WS_V + (size_t)e * PEER_V_ROWB, (float*)(F.ws + WS_SCV) + e, F.lane);
                      else p6_quant_row(pv + (size_t)e * DM, nullptr, F.ws + WS_V + (size_t)e * PEER_V_ROWB, (float*)(F.ws + WS_SCV) + e, F.lane); }
        else { if (PEER_U_BITS == 4) p6_quant_row4(pu + (size_t)e * DM, fg, F.ws + WS_U + (size_t)e * PEER_U_ROWB, (float*)(F.ws + WS_SCU) + e, F.lane);
               else p6_quant_row(pu + (size_t)e * DM, fg, F.ws + WS_U + (size_t)e * PEER_U_ROWB, (float*)(F.ws + WS_SCU) + e, F.lane); } }
}

__device__ __forceinline__ void rowquant_fp8(const Frame& F, const unsigned char* src, size_t src_pitch, unsigned char* dst, size_t dst_pitch, float* scale, int nrows) {
    const int gw = F.vcu * NWAVES + F.wave, NGW = F.G * NWAVES, lane = F.lane;
    for (int n = gw; n < nrows; n += NGW) {
        const u32x4* s = (const u32x4*)(src + (size_t)n * src_pitch) + lane;
        u32x4 v[8]; float mx = 0.f;
#pragma unroll
        for (int j = 0; j < 8; ++j) { v[j] = s[64 * j];
#pragma unroll
            for (int e = 0; e < 4; ++e) mx = fmaxf(mx, fmaxf(fabsf(bf_lo(v[j][e])), fabsf(bf_hi(v[j][e])))); }
        mx = fmaxf(wave_max(mx), 1e-30f);
        const float inv = 448.0f / mx;
        if (lane == 0) scale[n] = mx * (1.0f / 448.0f);
        asm volatile("" ::: "memory");
        u32x2* d = (u32x2*)(dst + (size_t)n * dst_pitch) + lane;
#pragma unroll
        for (int j = 0; j < 8; ++j) { int p0 = 0, p1 = 0;
            p0 = __builtin_amdgcn_cvt_pk_fp8_f32(bf_lo(v[j].x) * inv, bf_hi(v[j].x) * inv, p0, false); p0 = __builtin_amdgcn_cvt_pk_fp8_f32(bf_lo(v[j].y) * inv, bf_hi(v[j].y) * inv, p0, true);
            p1 = __builtin_amdgcn_cvt_pk_fp8_f32(bf_lo(v[j].z) * inv, bf_hi(v[j].z) * inv, p1, false); p1 = __builtin_amdgcn_cvt_pk_fp8_f32(bf_lo(v[j].w) * inv, bf_hi(v[j].w) * inv, p1, true);
            d[64 * j] = (u32x2){(unsigned)p0, (unsigned)p1}; }
    }
}
template <int LEN>
__device__ __forceinline__ void rowquant_fp8_n(const Frame& F, const unsigned char* src, unsigned char* dst, float* scale, int nrows) {
    const int gw = F.vcu * NWAVES + F.wave, NGW = F.G * NWAVES, lane = F.lane; constexpr int PER = LEN / 64;
    for (int n = gw; n < nrows; n += NGW) {
        const u32x4* s = (const u32x4*)(src + (size_t)n * LEN * 2) + lane * (PER / 8);
        u32x4 v[PER / 8]; float mx = 0.f;
#pragma unroll
        for (int j = 0; j < PER / 8; ++j) { v[j] = s[j];
#pragma unroll
            for (int e = 0; e < 4; ++e) mx = fmaxf(mx, fmaxf(fabsf(bf_lo(v[j][e])), fabsf(bf_hi(v[j][e])))); }
        mx = fmaxf(wave_max(mx), 1e-30f);
        const float inv = 448.0f / mx;
        if (lane == 0) scale[n] = mx * (1.0f / 448.0f);
        u32x2* d = (u32x2*)(dst + (size_t)n * LEN) + lane * (PER / 8);
#pragma unroll
        for (int j = 0; j < PER / 8; ++j) { int p0 = 0, p1 = 0;
            p0 = __builtin_amdgcn_cvt_pk_fp8_f32(bf_lo(v[j].x) * inv, bf_hi(v[j].x) * inv, p0, false); p0 = __builtin_amdgcn_cvt_pk_fp8_f32(bf_lo(v[j].y) * inv, bf_hi(v[j].y) * inv, p0, true);
            p1 = __builtin_amdgcn_cvt_pk_fp8_f32(bf_lo(v[j].z) * inv, bf_hi(v[j].z) * inv, p1, false); p1 = __builtin_amdgcn_cvt_pk_fp8_f32(bf_lo(v[j].w) * inv, bf_hi(v[j].w) * inv, p1, true);
            d[j] = (u32x2){(unsigned)p0, (unsigned)p1}; }
    }
}
__device__ __forceinline__ void p1_quant_weights(const Frame& F) {
    rowquant_fp8(F, F.ws + WS_WIN + (size_t)1280 * DM * 2, (size_t)DM * 2, F.ws + WS_WG8, (size_t)DM, (float*)(F.ws + WS_SW), 12800);
    rowquant_fp8(F, F.ws + WS_WBR, (size_t)DM * 2, F.ws + WS_WBR, (size_t)DM * 2, (float*)(F.ws + WS_SWBR), 4096);
    rowquant_fp8(F, F.ws + WS_WOUT, (size_t)DM * 2, F.ws + WS_WOUT, (size_t)DM * 2, (float*)(F.ws + WS_SWOUT), 4096);
    rowquant_fp8_n<1024>(F, F.ws + WS_WUQ, F.ws + WS_WUQ8, (float*)(F.ws + WS_SWUQ), 3072);
    rowquant_fp8_n<512>(F, F.ws + WS_WUKV, F.ws + WS_WUKV8, (float*)(F.ws + WS_SWUKV), 4096);
}
#define MFMA32(a, b, c) __builtin_amdgcn_mfma_f32_32x32x16_bf16((a), (b), (c), 0, 0, 0)
__device__ __forceinline__ float relu_i(float x) { const int v = __float_as_int(x); return __int_as_float(v > 0 ? v : 0); }
__device__ __forceinline__ int crow(int i, int h) { return (i & 3) + 8 * (i >> 2) + 4 * h; }
__device__ __forceinline__ float half_sum_f(float v) {
#pragma unroll
    for (int o = 1; o < 32; o <<= 1) v += __shfl_xor(v, o);
    return v;
}
__device__ __forceinline__ int half_sum_i(int v) {
#pragma unroll
    for (int o = 1; o < 32; o <<= 1) v += __shfl_xor(v, o);
    return v;
}
__device__ __forceinline__ float half_max_f(float v) {
#pragma unroll
    for (int o = 1; o < 32; o <<= 1) v = fmaxf(v, __shfl_xor(v, o));
    return v;
}
__device__ __forceinline__ float half_min_f(float v) {
#pragma unroll
    for (int o = 1; o < 32; o <<= 1) v = fminf(v, __shfl_xor(v, o));
    return v;
}
constexpr int IDX_PK = 144, IDX_BUF = 64 * IDX_PK;
__device__ __forceinline__ void idx_task(const Frame& F, int b, int s0c) {
    const int lane = F.lane, r = lane & 31, h = lane >> 5, tid = F.tid;
    const int s0 = s0c + 2 * F.wave;
    LAS unsigned char* lds = F.lds;
    const bf16_t* qix = (const bf16_t*)(F.ws + WS_QIX); const bf16_t* kix = (const bf16_t*)(F.ws + WS_KIX); const float* wix = (const float*)(F.ws + WS_WIX);
    unsigned* mask = (unsigned*)(F.ws + WS_MASK);
    const int tok = (r >> 2) & 1, head = (r & 3) + 4 * (r >> 3);
    const bf16_t* qp = qix + (size_t)(b * SEQ + s0 + tok) * 1024 + head * 64 + 8 * h;
    bf16x8 af[4];
#pragma unroll
    for (int ks = 0; ks < 4; ++ks) af[ks] = *(const bf16x8*)(qp + 16 * ks);
    const f32x4* wp = (const f32x4*)(wix + (size_t)(b * SEQ + s0 + h) * 16);
    float w[16];
#pragma unroll
    for (int q = 0; q < 4; ++q) { const f32x4 x = wp[q]; w[4 * q] = x[0]; w[4 * q + 1] = x[1]; w[4 * q + 2] = x[2]; w[4 * q + 3] = x[3]; }
    const int tq = NMETA + s0 + h;
    int tqr = tq - r; asm volatile("" : "+v"(tqr));
    const int ngrp = ((NMETA + s0c + 15) >> 6) + 1;
    const int skey = tid >> 3, spc = tid & 7;
    int brow = b * SEQ - NMETA; asm volatile("" : "+s"(brow));
    const bf16_t* kcur = kix + ((long)brow + skey) * 64 + spc * 8;
    const int sdst = skey * IDX_PK + spc * 16;
    const int boff = r * IDX_PK + 16 * h;
    u32x4 kst = *(const u32x4*)(skey < NMETA ? kix + (size_t)(NTOK + skey) * 64 + spc * 8 : kcur);
    float row[MW];
#pragma unroll
    for (int g = 0; g < MW / 2; ++g) {
        float s0v = -INFINITY, s1v = -INFINITY;
        const int bo = (g & 1) * IDX_BUF;
        if (g < ngrp) *(LAS u32x4*)(lds + bo + sdst) = kst;
        __syncthreads();
        kcur += 64 * 64; asm volatile("" : "+v"(kcur));
        if (g + 1 < ngrp) kst = *(const u32x4*)kcur;
        if (g < ngrp) {
            float x0 = 0.f, x1 = 0.f;
            { bf16x8 bb[4]; f32x16 a0;
#pragma unroll
              for (int ks = 0; ks < 4; ++ks) bb[ks] = *(const LAS bf16x8*)(lds + bo + boff + 32 * ks);
#pragma unroll
              for (int i = 0; i < 16; ++i) a0[i] = 0.f;
#pragma unroll
              for (int ks = 0; ks < 4; ++ks) a0 = MFMA32(af[ks], bb[ks], a0);
#pragma unroll
              for (int i = 0; i < 16; ++i) x0 += w[i] * relu_i(a0[i]); }
            asm volatile("" : "+v"(x0));
            asm volatile("" ::: "memory");
            { bf16x8 bb[4]; f32x16 a1;
#pragma unroll
              for (int ks = 0; ks < 4; ++ks) bb[ks] = *(const LAS bf16x8*)(lds + bo + boff + 32 * IDX_PK + 32 * ks);
#pragma unroll
              for (int i = 0; i < 16; ++i) a1[i] = 0.f;
#pragma unroll
              for (int ks = 0; ks < 4; ++ks) a1 = MFMA32(af[ks], bb[ks], a1);
#pragma unroll
              for (int i = 0; i < 16; ++i) x1 += w[i] * relu_i(a1[i]); }
            s0v = (g * 64 <= tqr) ? x0 : -INFINITY; s1v = (g * 64 + 32 <= tqr) ? x1 : -INFINITY;
        }
        row[2 * g] = s0v; row[2 * g + 1] = s1v;
    }
    float tau = -3.0e38f;
    bool done = (tq + 1 <= 256);
    float mx = -INFINITY, mn = INFINITY;
#pragma unroll
    for (int k = 0; k < MW; ++k) { const float v = row[k]; mx = fmaxf(mx, v); mn = fminf(mn, v > -INFINITY ? v : INFINITY); }
    float lo = half_min_f(mn), hi = half_max_f(mx);
    if (!done) tau = hi;
    for (int it = 0; it < 64; ++it) {
        if (!__any(!done)) break;
        const float mid = lo + (hi - lo) * 0.5f;
        int c = 0;
#pragma unroll
        for (int k = 0; k < MW; ++k) c += (row[k] >= mid) ? 1 : 0;
        c = half_sum_i(c);
        if (!done) {
            if (!(mid > lo && mid < hi)) { tau = hi; done = true; }
            else if (c == 256) { tau = mid; done = true; }
            else if (c > 256) lo = mid;
            else { hi = mid; tau = hi; }
        }
    }
    unsigned* mrow = mask + (size_t)(b * SEQ + s0 + h) * MW;
    unsigned mw = 0u;
#pragma unroll
    for (int k = 0; k < MW; ++k) {
        const unsigned long long bal = __ballot(row[k] >= tau);
        const unsigned wd = h ? (unsigned)(bal >> 32) : (unsigned)bal;
        if ((k & 31) == r) mw = wd;
        if ((k & 31) == 31 || k == MW - 1) { const int kk = (k & ~31) + r; if (kk < MW) mrow[kk] = mw; }
    }
}
__device__ __forceinline__ void p2_indexer(const Frame& F, int qslot) {
    volatile LAS unsigned* qw = (volatile LAS unsigned*)(F.lds + LDSCTL_OFF + 16);
    constexpr int NCH = NTOK / 16;
    for (;;) {
        if (F.tid == 0) qw[0] = atomicAdd(F.ctl + CW_QUEUE + 64 * qslot, 1u);
        __syncthreads();
        const int c = __builtin_amdgcn_readfirstlane((int)qw[0]);
        __syncthreads();
        if (c >= NCH) break;
        const int b = c & 3, tblk = (SEQ / 16 - 1) - (c >> 2);
        idx_task(F, b, tblk * 16);
    }
}
template <bool MLA> struct AttnCfg {
    static constexpr int DQK = MLA ? 192 : 128, NKS = DQK / 64, PK = DQK + 16  , PV = 320, KBYTES = 64 * PK, BUFB = 64 * PK + 64 * PV;
};
struct AttnUnit { int type, b, hx, blk; };
typedef int i32x8 __attribute__((ext_vector_type(8)));
typedef int i32x4 __attribute__((ext_vector_type(4)));
__device__ __forceinline__ i32x8 cat4(i32x4 a, i32x4 b) { return __builtin_shufflevector(a, b, 0, 1, 2, 3, 4, 5, 6, 7); }
template <int NKS> __device__ __forceinline__ void qk_block(f32x16& s, const i32x8 (&k)[NKS], const i32x8 (&q)[NKS]) {
#if defined(__HIP_DEVICE_COMPILE__)
    int sc = 0x7F7F7F7F;
    if constexpr (NKS == 3)
        asm volatile("s_nop 1\n\tv_mfma_scale_f32_32x32x64_f8f6f4 %0, %1, %4, 0, %7, %7 op_sel_hi:[0,0,0]\n\ts_nop 3\n\tv_mfma_scale_f32_32x32x64_f8f6f4 %0, %2, %5, %0, %7, %7 op_sel_hi:[0,0,0]\n\ts_nop 3\n\t"
                     "v_mfma_scale_f32_32x32x64_f8f6f4 %0, %3, %6, %0, %7, %7 op_sel_hi:[0,0,0]\n\ts_nop 15\n\ts_nop 7"
                     : "=&v"(s) : "v"(k[0]), "v"(k[1]), "v"(k[2]), "v"(q[0]), "v"(q[1]), "v"(q[2]), "v"(sc));
    else
        asm volatile("s_nop 1\n\tv_mfma_scale_f32_32x32x64_f8f6f4 %0, %1, %3, 0, %5, %5 op_sel_hi:[0,0,0]\n\ts_nop 3\n\tv_mfma_scale_f32_32x32x64_f8f6f4 %0, %2, %4, %0, %5, %5 op_sel_hi:[0,0,0]\n\ts_nop 15\n\ts_nop 7"
                     : "=&v"(s) : "v"(k[0]), "v"(k[1]), "v"(q[0]), "v"(q[1]), "v"(sc));
#else
    (void)s; (void)k; (void)q;
#endif
}

template <bool MLA>
__device__ __forceinline__ void attn_unit(const Frame& F, const AttnUnit u) {
    typedef AttnCfg<MLA> C;
    const int tid = F.tid, lane = F.lane, wave = F.wave, r = lane & 31, h = lane >> 5;
    LAS unsigned char* lds = F.lds;
    const unsigned char* qn8 = F.ws + WS_QN; const unsigned char* qr8 = F.ws + WS_QR; const unsigned char* kn8 = F.ws + WS_KN; const unsigned char* kpe8 = F.ws + WS_KPE;
    const unsigned char* qb8 = F.ws + WS_QB; const unsigned char* kb8 = F.ws + WS_KB;
    const bf16_t* va = (const bf16_t*)(F.ws + WS_VA); const bf16_t* vb = (const bf16_t*)(F.ws + WS_VB);
    const unsigned* mask = (const unsigned*)(F.ws + WS_MASK); bf16_t* oab = (bf16_t*)(F.ws + WS_OAB);
    const int b = u.b;
    const size_t rowb = (size_t)b * SEQ;
    int head, tw0, ntiles;
    if (MLA) { head = u.hx; tw0 = u.blk * 256 + 32 * wave; ntiles = (NMETA + u.blk * 256 + 255) / 64 + 1; }
    else { head = 4 * u.hx + (wave & 3); tw0 = u.blk * 64 + 32 * (wave >> 2); ntiles = (NMETA + u.blk * 64 + 63) / 64 + 1; }
    const int pw0 = NMETA + tw0;
    const int tq = pw0 + r;
    const float cexp = MLA ? QA_SCALE : QB_SCALE;
    i32x8 qf[C::NKS];
    if (MLA) {
        const unsigned char* p0 = qn8 + (rowb + tw0 + r) * 2048 + head * 128 + 32 * h; const unsigned char* p1 = qr8 + (rowb + tw0 + r) * 1024 + head * 64 + 32 * h;
        qf[0] = cat4(*(const i32x4*)p0, *(const i32x4*)(p0 + 16)); qf[1] = cat4(*(const i32x4*)(p0 + 64), *(const i32x4*)(p0 + 80)); qf[C::NKS - 1] = cat4(*(const i32x4*)p1, *(const i32x4*)(p1 + 16));
    } else {
        const unsigned char* p0 = qb8 + (rowb + tw0 + r) * 2048 + head * 128 + 32 * h;
        qf[0] = cat4(*(const i32x4*)p0, *(const i32x4*)(p0 + 16)); qf[1] = cat4(*(const i32x4*)(p0 + 64), *(const i32x4*)(p0 + 80));
    }
    const int ldk = MLA ? 2048 : 512;
    const unsigned char* ktab = MLA ? kn8 + head * 128 : kb8 + u.hx * 128;
    const bf16_t* vtab = MLA ? va + head * 128 : vb + u.hx * 128;
    const unsigned char* kbase = ktab + (rowb - NMETA) * ldk;
    const bf16_t* vbase = vtab + (rowb - NMETA) * ldk;
    const unsigned char* pbase = kpe8 + (rowb - NMETA) * 64;
    const int kkey = tid >> 3, kpc = tid & 7, pkey = tid >> 2, ppc = tid & 3;
    const unsigned koffs = (unsigned)(kkey * ldk + kpc * 16); const int kdst = kkey * C::PK + kpc * 16;
    const unsigned poffs = (unsigned)(pkey * 64 + ppc * 16); const int pdst = pkey * C::PK + 128 + ppc * 16;
    unsigned soff[2]; int vdst[2];
#pragma unroll
    for (int i = 0; i < 2; ++i) { const int c = tid + 512 * i, key = c >> 4, pc = c & 15; soff[i] = (unsigned)(key * ldk + pc * 8); vdst[i] = C::KBYTES + key * C::PV + pc * 16; }
    u32x4 kst, vst[2], pst = (u32x4){0u, 0u, 0u, 0u};
    {
        kst = *(const u32x4*)(kkey < NMETA ? ktab + (size_t)(NTOK + kkey) * ldk + kpc * 16 : kbase + koffs);
        const int key0 = tid >> 4;
        vst[0] = *(const u32x4*)(key0 < NMETA ? vtab + (size_t)(NTOK + key0) * ldk + (tid & 15) * 8 : vbase + soff[0]);
        vst[1] = *(const u32x4*)(vbase + soff[1]);
        if (MLA && tid < 256) pst = *(const u32x4*)(pkey < NMETA ? kpe8 + (size_t)(NTOK + pkey) * 64 + ppc * 16 : pbase + poffs);
    }
    *(LAS u32x4*)(lds + kdst) = kst;
#pragma unroll
    for (int i = 0; i < 2; ++i) *(LAS u32x4*)(lds + vdst[i]) = vst[i];
    if (MLA && tid < 256) *(LAS u32x4*)(lds + pdst) = pst;
    __syncthreads();
    f32x16 oacc[4];
#pragma unroll
    for (int d = 0; d < 4; ++d)
#pragma unroll
        for (int i = 0; i < 16; ++i) oacc[d][i] = 0.f;
    float mrun = -INFINITY, lrun = 0.f;
    const int koff = r * C::PK + 32 * h;
    const int voff = C::KBYTES + (4 * h + ((lane & 15) >> 2)) * C::PV + (16 * ((lane >> 4) & 1) + 4 * (lane & 3)) * 2;
    const unsigned* mrow = mask + (rowb + tw0 + r) * MW;
    for (int kt = 0; kt < ntiles; ++kt) {
        const int cur = (kt & 1) * C::BUFB, nxt = ((kt + 1) & 1) * C::BUFB;
        const bool more = kt + 1 < ntiles;
        if (more) {
            kst = *(const u32x4*)(kbase + (size_t)(kt + 1) * 64 * ldk + koffs);
            const bf16_t* vb2 = vbase + (size_t)(kt + 1) * 64 * ldk;
#pragma unroll
            for (int i = 0; i < 2; ++i) vst[i] = *(const u32x4*)(vb2 + soff[i]);
            if (MLA && tid < 256) pst = *(const u32x4*)(pbase + (size_t)(kt + 1) * 64 * 64 + poffs);
        }
        if (kt * 64 <= pw0 + 31) {
            u32x2 mwd = (u32x2){0u, 0u};
            if (!MLA) mwd = *(const u32x2*)(mrow + 2 * kt);
            f32x16 s0, s1;
            { i32x8 kf[C::NKS];
#pragma unroll
              for (int ks = 0; ks < C::NKS; ++ks) kf[ks] = cat4(*(const LAS i32x4*)(lds + cur + koff + 64 * ks), *(const LAS i32x4*)(lds + cur + koff + 64 * ks + 16));
              qk_block<C::NKS>(s0, kf, qf); }
            { i32x8 kf[C::NKS];
#pragma unroll
              for (int ks = 0; ks < C::NKS; ++ks) kf[ks] = cat4(*(const LAS i32x4*)(lds + cur + koff + 32 * C::PK + 64 * ks), *(const LAS i32x4*)(lds + cur + koff + 32 * C::PK + 64 * ks + 16));
              qk_block<C::NKS>(s1, kf, qf); }
            if (MLA) {
                if (kt * 64 + 63 > pw0) {
                    const int kb0 = kt * 64 + 4 * h;
#pragma unroll
                    for (int i = 0; i < 16; ++i) { const int key = kb0 + (i & 3) + 8 * (i >> 2); if (key > tq) s0[i] = -INFINITY; if (key + 32 > tq) s1[i] = -INFINITY; }
                }
            } else {
                const unsigned m0 = mwd.x >> (4 * h), m1 = mwd.y >> (4 * h);
#pragma unroll
                for (int i = 0; i < 16; ++i) { const int bit = (i & 3) + 8 * (i >> 2); if (!((m0 >> bit) & 1u)) s0[i] = -INFINITY; if (!((m1 >> bit) & 1u)) s1[i] = -INFINITY; }
            }
            float mx = s0[0];
#pragma unroll
            for (int i = 1; i < 16; ++i) mx = fmaxf(mx, s0[i]);
#pragma unroll
            for (int i = 0; i < 16; ++i) mx = fmaxf(mx, s1[i]);
            mx = fmaxf(mx, __shfl_xor(mx, 32));
            const float mnew = fmaxf(mrun, mx * cexp);
            const float msafe = (mnew == -INFINITY) ? 0.f : mnew;
            const float alpha = __builtin_amdgcn_exp2f(mrun - msafe);
            mrun = mnew;
            float ps = 0.f;
#pragma unroll
            for (int i = 0; i < 16; ++i) { s0[i] = __builtin_amdgcn_exp2f(__builtin_fmaf(s0[i], cexp, -msafe)); s1[i] = __builtin_amdgcn_exp2f(__builtin_fmaf(s1[i], cexp, -msafe)); ps += s0[i] + s1[i]; }
            lrun = lrun * alpha + ps;
#pragma unroll
            for (int d = 0; d < 4; ++d)
#pragma unroll
                for (int i = 0; i < 16; ++i) oacc[d][i] *= alpha;
            bf16x8 pf[4];
            { u32x4 w;
              w.x = cvt_pk_bf16(s0[0], s0[1]); w.y = cvt_pk_bf16(s0[2], s0[3]); w.z = cvt_pk_bf16(s0[4], s0[5]); w.w = cvt_pk_bf16(s0[6], s0[7]); pf[0] = __builtin_bit_cast(bf16x8, w);
              w.x = cvt_pk_bf16(s0[8], s0[9]); w.y = cvt_pk_bf16(s0[10], s0[11]); w.z = cvt_pk_bf16(s0[12], s0[13]); w.w = cvt_pk_bf16(s0[14], s0[15]); pf[1] = __builtin_bit_cast(bf16x8, w);
              w.x = cvt_pk_bf16(s1[0], s1[1]); w.y = cvt_pk_bf16(s1[2], s1[3]); w.z = cvt_pk_bf16(s1[4], s1[5]); w.w = cvt_pk_bf16(s1[6], s1[7]); pf[2] = __builtin_bit_cast(bf16x8, w);
              w.x = cvt_pk_bf16(s1[8], s1[9]); w.y = cvt_pk_bf16(s1[10], s1[11]); w.z = cvt_pk_bf16(s1[12], s1[13]); w.w = cvt_pk_bf16(s1[14], s1[15]); pf[3] = __builtin_bit_cast(bf16x8, w); }
#pragma unroll
            for (int d = 0; d < 4; ++d)
#pragma unroll
                for (int kk = 0; kk < 4; ++kk) {
                    const s16x4 lo = __builtin_amdgcn_ds_read_tr16_b64_v4i16((LAS s16x4*)(lds + cur + voff + (16 * kk) * C::PV + 64 * d));
                    const s16x4 hi = __builtin_amdgcn_ds_read_tr16_b64_v4i16((LAS s16x4*)(lds + cur + voff + (16 * kk + 8) * C::PV + 64 * d));
                    const bf16x8 vf = __builtin_shufflevector(lo, hi, 0, 1, 2, 3, 4, 5, 6, 7);
                    oacc[d] = MFMA32(vf, pf[kk], oacc[d]);
                }
        }
        if (more) {
            *(LAS u32x4*)(lds + nxt + kdst) = kst;
#pragma unroll
            for (int i = 0; i < 2; ++i) *(LAS u32x4*)(lds + nxt + vdst[i]) = vst[i];
            if (MLA && tid < 256) *(LAS u32x4*)(lds + nxt + pdst) = pst;
        }
        __syncthreads();
    }
    {
        const float lt = lrun + __shfl_xor(lrun, 32);
        const float inv = lt > 0.f ? 1.0f / lt : 0.f;
        bf16_t* op = oab + (rowb + tw0 + r) * 4096 + (MLA ? 0 : 2048) + head * 128 + 4 * h;
#pragma unroll
        for (int d = 0; d < 4; ++d)
#pragma unroll
            for (int g = 0; g < 4; ++g) { u32x2 w; w.x = cvt_pk_bf16(oacc[d][4 * g] * inv, oacc[d][4 * g + 1] * inv); w.y = cvt_pk_bf16(oacc[d][4 * g + 2] * inv, oacc[d][4 * g + 3] * inv);
                *(u32x2*)(op + 32 * d + 8 * g) = w; }
    }
}

constexpr int ATT_NUNITS = 16 * 64 + 64 * 16;
__device__ __forceinline__ void att_decode(int idx, AttnUnit& u) {
    int rem = idx;
    for (int L = 65; L >= 2; --L) {
        const int nm = (L >= 5 && ((L - 5) & 3) == 0) ? 64 : 0;
        if (rem < nm) { u.type = 0; u.blk = (L - 5) >> 2; u.b = rem & 3; u.hx = rem >> 2; return; }
        rem -= nm;
        if (rem < 16) { u.type = 1; u.blk = L - 2; u.b = rem & 3; u.hx = rem >> 2; return; }
        rem -= 16;
    }
    u.type = -1; u.blk = 0; u.b = 0; u.hx = 0;
}
__device__ __forceinline__ void p3_attention(const Frame& F, int qslot) {
    volatile LAS int* qw = (volatile LAS int*)(F.lds + LDSCTL_OFF + 32);
    for (;;) {
        if (F.tid == 0) { const int idx = (int)atomicAdd(F.ctl + CW_QUEUE + 64 * qslot, 1u); AttnUnit u; u.type = -1; u.b = 0; u.hx = 0; u.blk = 0; if (idx < ATT_NUNITS) att_decode(idx, u);
            qw[0] = u.type; qw[1] = u.b; qw[2] = u.hx; qw[3] = u.blk; }
        __syncthreads();
        AttnUnit u; u.type = qw[0]; u.b = qw[1]; u.hx = qw[2]; u.blk = qw[3];
        __syncthreads();
        if (u.type < 0) break;
        if (u.type == 0) attn_unit<true>(F, u); else attn_unit<false>(F, u);
    }
}
__device__ __forceinline__ float pk_idx(float v, int n) { return __uint_as_float((__float_as_uint(v) & ~127u) | (unsigned)n); }
__device__ __forceinline__ void route_task(const Frame& F, int tb, int hd) {
    const int lane = F.lane, r = lane & 31, h = lane >> 5;
    const bf16_t* pq = (const bf16_t*)(F.ws + WS_PQ); const bf16_t* skb = (const bf16_t*)(F.ws + WS_SK);
    int* eid = (int*)(F.ws + WS_EID); float* gate = (float*)(F.ws + WS_GATE);
    LAS float* wl = (LAS float*)(F.lds + F.wave * 16384);
    const int m = tb * 32 + r;
#pragma unroll 1
    for (int c = 0; c < 2; ++c) {
        const bf16_t* qp = pq + (size_t)m * 2048 + hd * 256 + c * 128 + 8 * h;
        bf16x8 qf[8];
#pragma unroll
        for (int ks = 0; ks < 8; ++ks) qf[ks] = *(const bf16x8*)(qp + 16 * ks);
        float v[64];
#pragma unroll
        for (int blk = 0; blk < 4; ++blk) {
            const bf16_t* sp = skb + (size_t)((hd * 2 + c) * 128 + 32 * blk + r) * 128 + 8 * h;
            f32x16 acc;
#pragma unroll
            for (int i = 0; i < 16; ++i) acc[i] = 0.f;
#pragma unroll
            for (int ks = 0; ks < 8; ++ks) acc = MFMA32(*(const bf16x8*)(sp + 16 * ks), qf[ks], acc);
#pragma unroll
            for (int i = 0; i < 16; ++i) v[blk * 16 + i] = pk_idx(acc[i], 32 * blk + (i & 3) + 8 * (i >> 2) + 4 * h);
        }
#pragma unroll 1
        for (int k = 0; k < 16; ++k) {
            float mx = v[0];
#pragma unroll
            for (int j = 1; j < 64; ++j) mx = fmaxf(mx, v[j]);
            mx = fmaxf(mx, __shfl_xor(mx, 32));
            if (h == 0) wl[(c * 16 + k) * 32 + r] = mx;
#pragma unroll
            for (int j = 0; j < 64; ++j) v[j] = (v[j] == mx) ? -INFINITY : v[j];
        }
    }
    LDS_WAIT(); asm volatile("" ::: "memory");
    float cs[50]; int ce[50];
    {
        unsigned t0[16], t1[16];
#pragma unroll
        for (int i = 0; i < 16; ++i) { t0[i] = __float_as_uint(wl[i * 32 + r]); t1[i] = __float_as_uint(wl[(16 + i) * 32 + r]); }
        int n = 0;
#pragma unroll
        for (int i = 0; i < 16; ++i)
#pragma unroll
            for (int j = 0; j < 16; ++j)
                if ((i + 1) * (j + 1) <= 16) {
                    const float s = __uint_as_float(t0[i] & ~127u) + __uint_as_float(t1[j] & ~127u);
                    cs[n] = __uint_as_float((__float_as_uint(s) & ~63u) | (unsigned)n); ce[n] = (int)((t0[i] & 127u) * 128u + (t1[j] & 127u)); ++n;
                }
    }
    float sum = 0.f, first = 0.f;
#pragma unroll 1
    for (int k = 0; k < 16; ++k) {
        float mx = cs[0];
#pragma unroll
        for (int j = 1; j < 50; ++j) mx = fmaxf(mx, cs[j]);
        int se = 0;
#pragma unroll
        for (int j = 0; j < 50; ++j) { const bool hit = (cs[j] == mx); se = hit ? ce[j] : se; cs[j] = hit ? -INFINITY : cs[j]; }
        if (k == 0) first = mx;
        const float ev = __expf(mx - first); sum += ev;
        if (h == 0) { wl[1024 + k * 32 + r] = ev; wl[1536 + k * 32 + r] = __int_as_float(se); }
    }
    LDS_WAIT(); asm volatile("" ::: "memory");
    const float inv = 1.0f / sum;
    if (h == 0) {
        int* ep = eid + (size_t)m * 128 + hd * 16; float* gp = gate + (size_t)m * 128 + hd * 16;
#pragma unroll
        for (int q = 0; q < 4; ++q) {
            *(int4*)(ep + 4 * q) = make_int4(__float_as_int(wl[1536 + (4 * q) * 32 + r]), __float_as_int(wl[1536 + (4 * q + 1) * 32 + r]), __float_as_int(wl[1536 + (4 * q + 2) * 32 + r]), __float_as_int(wl[1536 + (4 * q + 3) * 32 + r]));
            *(f32x4*)(gp + 4 * q) = (f32x4){wl[1024 + (4 * q) * 32 + r] * inv, wl[1024 + (4 * q + 1) * 32 + r] * inv, wl[1024 + (4 * q + 2) * 32 + r] * inv, wl[1024 + (4 * q + 3) * 32 + r] * inv}; }
    }
    LDS_WAIT(); asm volatile("" ::: "memory");
}
__device__ __forceinline__ void p7_routing(const Frame& F) {
    const int gw = F.vcu * NWAVES + F.wave, NGW = F.G * NWAVES;
    for (int it = gw; it < (NTOK / 32) * 8; it += NGW) route_task(F, it >> 3, it & 7);
}

__device__ __forceinline__ float rl_f(float v, int l) { return __int_as_float(__builtin_amdgcn_readlane(__float_as_int(v), l)); }
__device__ __forceinline__ float gelu_tanh(float x) {
    const float u = 0.7978845608028654f * (x + 0.044715f * x * x * x);
    const float e = __expf(2.0f * u);
    const float th = 1.0f - 2.0f / (e + 1.0f);
    return 0.5f * x * (1.0f + th);
}
__device__ __forceinline__ float wave_sum_dpp(float v) {
#define DPP_ADD(ctrl, rmask) v += __int_as_float(__builtin_amdgcn_update_dpp(0, __float_as_int(v), ctrl, rmask, 0xF, false))
    DPP_ADD(0xB1, 0xF); DPP_ADD(0x4E, 0xF); DPP_ADD(0x141, 0xF); DPP_ADD(0x140, 0xF); DPP_ADD(0x142, 0xA); DPP_ADD(0x143, 0xC);
#undef DPP_ADD
    return rl_f(v, 63);
}
typedef unsigned u32x6 __attribute__((ext_vector_type(6)));
typedef float f32x32 __attribute__((ext_vector_type(32)));
struct Row6 { u32x4 q[3]; };
__device__ __forceinline__ void row6_load(Row6& r, const unsigned char* tab, int e, int lane) {
    const u32x4* p = (const u32x4*)(tab + (size_t)e * 3072) + lane;
#pragma unroll
    for (int q = 0; q < 3; ++q) r.q[q] = p[64 * q];
}
__device__ __forceinline__ f32x32 row6_deq(const Row6& r, int g) {
    u32x6 w;
    if (g == 0) { w[0] = r.q[0].x; w[1] = r.q[0].y; w[2] = r.q[0].z; w[3] = r.q[0].w; w[4] = r.q[1].x; w[5] = r.q[1].y; }
    else { w[0] = r.q[1].z; w[1] = r.q[1].w; w[2] = r.q[2].x; w[3] = r.q[2].y; w[4] = r.q[2].z; w[5] = r.q[2].w; }
    return __builtin_amdgcn_cvt_scalef32_pk32_f32_fp6(w, 1.0f);
}
__device__ __forceinline__ float row6_dot(const Row6& r, const f32x2 (&hf)[32]) {
    f32x2 acc0 = (f32x2){0.f, 0.f}, acc1 = (f32x2){0.f, 0.f};
#pragma unroll
    for (int g = 0; g < 2; ++g) { const f32x32 d = row6_deq(r, g);
#pragma unroll
        for (int k = 0; k < 16; k += 2) { acc0 = __builtin_elementwise_fma((f32x2){d[2 * k], d[2 * k + 1]}, hf[16 * g + k], acc0); acc1 = __builtin_elementwise_fma((f32x2){d[2 * k + 2], d[2 * k + 3]}, hf[16 * g + k + 1], acc1); } }
    const f32x2 s = acc0 + acc1;
    return s.x + s.y;
}
__device__ __forceinline__ void row6_axpy(const Row6& r, float c, f32x2 (&o)[32]) {
    const f32x2 c2 = (f32x2){c, c};
#pragma unroll
    for (int g = 0; g < 2; ++g) { const f32x32 d = row6_deq(r, g);
#pragma unroll
        for (int k = 0; k < 16; ++k) o[16 * g + k] = __builtin_elementwise_fma((f32x2){d[2 * k], d[2 * k + 1]}, c2, o[16 * g + k]); }
}
struct Row4 { u32x4 q[2]; };
__device__ __forceinline__ void row4_load(Row4& r, const unsigned char* tab, int e, int lane) {
    const u32x4* p = (const u32x4*)(tab + (size_t)e * 2048) + lane;
    r.q[0] = p[0]; r.q[1] = p[64];
}
__device__ __forceinline__ float row4_dot(const Row4& r, const f32x2 (&hf)[32]) {
    f32x2 acc0 = (f32x2){0.f, 0.f}, acc1 = (f32x2){0.f, 0.f};
#pragma unroll
    for (int d = 0; d < 8; ++d) { const unsigned w = r.q[d >> 2][d & 3];
        acc0 = __builtin_elementwise_fma(__builtin_amdgcn_cvt_scalef32_pk_f32_fp4(w, 1.0f, 0), hf[4 * d], acc0);
        acc1 = __builtin_elementwise_fma(__builtin_amdgcn_cvt_scalef32_pk_f32_fp4(w, 1.0f, 1), hf[4 * d + 1], acc1);
        acc0 = __builtin_elementwise_fma(__builtin_amdgcn_cvt_scalef32_pk_f32_fp4(w, 1.0f, 2), hf[4 * d + 2], acc0);
        acc1 = __builtin_elementwise_fma(__builtin_amdgcn_cvt_scalef32_pk_f32_fp4(w, 1.0f, 3), hf[4 * d + 3], acc1); }
    const f32x2 s = acc0 + acc1;
    return s.x + s.y;
}
__device__ __forceinline__ void row4_axpy(const Row4& r, float c, f32x2 (&o)[32]) {
    const f32x2 c2 = (f32x2){c, c};
#pragma unroll
    for (int d = 0; d < 8; ++d) { const unsigned w = r.q[d >> 2][d & 3];
        o[4 * d] = __builtin_elementwise_fma(__builtin_amdgcn_cvt_scalef32_pk_f32_fp4(w, 1.0f, 0), c2, o[4 * d]);
        o[4 * d + 1] = __builtin_elementwise_fma(__builtin_amdgcn_cvt_scalef32_pk_f32_fp4(w, 1.0f, 1), c2, o[4 * d + 1]);
        o[4 * d + 2] = __builtin_elementwise_fma(__builtin_amdgcn_cvt_scalef32_pk_f32_fp4(w, 1.0f, 2), c2, o[4 * d + 2]);
        o[4 * d + 3] = __builtin_elementwise_fma(__builtin_amdgcn_cvt_scalef32_pk_f32_fp4(w, 1.0f, 3), c2, o[4 * d + 3]); }
}
#if PEER_U_BITS == 4
typedef Row4 RowU;
#define ROWU_LOAD row4_load
#define ROWU_DOT row4_dot
#else
typedef Row6 RowU;
#define ROWU_LOAD row6_load
#define ROWU_DOT row6_dot
#endif
#if PEER_V_BITS == 4
typedef Row4 RowV;
#define ROWV_LOAD row4_load
#define ROWV_AXPY row4_axpy
#else
typedef Row6 RowV;
#define ROWV_LOAD row6_load
#define ROWV_AXPY row6_axpy
#endif
__device__ __forceinline__ void expert_token(const Frame& F, int m, size_t orow) {
    const int lane = F.lane;
    const unsigned char* U = F.ws + WS_U; const unsigned char* V = F.ws + WS_V;
    const float* scu = (const float*)(F.ws + WS_SCU); const float* scv = (const float*)(F.ws + WS_SCV);
    const int* eid = (const int*)(F.ws + WS_EID); const float* gate = (const float*)(F.ws + WS_GATE);
    const bf16_t* h1b = (const bf16_t*)(F.ws + WS_H1B); const float* h1f = (const float*)(F.ws + WS_H1F);
    const u64* ssq = (const u64*)(F.ctl + CW_SSQ_H1); const float* gfin = F.in(15);
    const int e0 = eid[(size_t)m * 128 + lane], e1 = eid[(size_t)m * 128 + 64 + lane];
    f32x2 hf[32];
#pragma unroll
    for (int j = 0; j < 16; ++j) { const u32x2 x = *((const u32x2*)(h1b + (size_t)m * DM) + lane + 64 * j); hf[2 * j] = (f32x2){bf_lo(x.x), bf_hi(x.x)}; hf[2 * j + 1] = (f32x2){bf_lo(x.y), bf_hi(x.y)}; }
    const float g0 = gate[(size_t)m * 128 + lane] * scv[e0], g1 = gate[(size_t)m * 128 + 64 + lane] * scv[e1];
    const float rstd = __builtin_amdgcn_rsqf(ssq_get(ssq + m) * (1.0f / DM) + EPS);
    const float su0 = scu[e0] * rstd, su1 = scu[e1] * rstd;
    float a0 = 0.f, a1 = 0.f;
#define EIDX(e) (((e) < 64) ? __builtin_amdgcn_readlane(e0, (e)) : __builtin_amdgcn_readlane(e1, (e) - 64))
    {
        RowU r0, r1, r2, r3, r4, r5, r6, r7;
        ROWU_LOAD(r0, U, EIDX(0), lane); ROWU_LOAD(r1, U, EIDX(1), lane); ROWU_LOAD(r2, U, EIDX(2), lane); ROWU_LOAD(r3, U, EIDX(3), lane);
        ROWU_LOAD(r4, U, EIDX(4), lane); ROWU_LOAD(r5, U, EIDX(5), lane); ROWU_LOAD(r6, U, EIDX(6), lane); ROWU_LOAD(r7, U, EIDX(7), lane);
#define S1STEP(rr, k) p = wave_sum_dpp(ROWU_DOT(rr, hf)); if (more) ROWU_LOAD(rr, U, EIDX(e + 8 + (k)), lane); if (e < 64) { if (lane == e + (k)) a0 = p; } else { if (lane == e + (k) - 64) a1 = p; }
#pragma unroll 1
        for (int e = 0; e < 128; e += 8) {
            const bool more = e + 8 < 128; float p;
            S1STEP(r0, 0) S1STEP(r1, 1) S1STEP(r2, 2) S1STEP(r3, 3) S1STEP(r4, 4) S1STEP(r5, 5) S1STEP(r6, 6) S1STEP(r7, 7)
        }
#undef S1STEP
    }
    const float c0 = gelu_tanh(a0 * su0) * g0, c1 = gelu_tanh(a1 * su1) * g1;
#define CIDX(e) (((e) < 64) ? rl_f(c0, (e)) : rl_f(c1, (e) - 64))
    f32x2 o[32];
#pragma unroll
    for (int i = 0; i < 32; ++i) o[i] = (f32x2){0.f, 0.f};
    {
        RowV r0, r1, r2, r3, r4, r5, r6, r7;
        ROWV_LOAD(r0, V, EIDX(0), lane); ROWV_LOAD(r1, V, EIDX(1), lane); ROWV_LOAD(r2, V, EIDX(2), lane); ROWV_LOAD(r3, V, EIDX(3), lane);
        ROWV_LOAD(r4, V, EIDX(4), lane); ROWV_LOAD(r5, V, EIDX(5), lane); ROWV_LOAD(r6, V, EIDX(6), lane); ROWV_LOAD(r7, V, EIDX(7), lane);
#define S2STEP(rr, k) ROWV_AXPY(rr, CIDX(e + (k)), o); if (more) ROWV_LOAD(rr, V, EIDX(e + 8 + (k)), lane);
#pragma unroll 1
        for (int e = 0; e < 128; e += 8) {
            const bool more = e + 8 < 128;
            S2STEP(r0, 0) S2STEP(r1, 1) S2STEP(r2, 2) S2STEP(r3, 3) S2STEP(r4, 4) S2STEP(r5, 5) S2STEP(r6, 6) S2STEP(r7, 7)
        }
#undef S2STEP
    }
#undef EIDX
#undef CIDX
    float s = 0.f;
#pragma unroll
    for (int j = 0; j < 16; ++j) { const f32x4 x = *((const f32x4*)(h1f + (size_t)m * DM) + lane + 64 * j); o[2 * j] += (f32x2){x[0], x[1]}; o[2 * j + 1] += (f32x2){x[2], x[3]};
        s += (o[2 * j].x * o[2 * j].x + o[2 * j].y * o[2 * j].y) + (o[2 * j + 1].x * o[2 * j + 1].x + o[2 * j + 1].y * o[2 * j + 1].y); }
    const float rs = 1.0f / sqrtf(wave_sum(s) * (1.0f / DM) + EPS);
    float* op = F.out() + orow * DM;
#pragma unroll
    for (int j = 0; j < 16; ++j) { const f32x4 g = *((const f32x4*)gfin + lane + 64 * j);
        *((f32x4*)op + lane + 64 * j) = (f32x4){o[2 * j].x * rs * g[0], o[2 * j].y * rs * g[1], o[2 * j + 1].x * rs * g[2], o[2 * j + 1].y * rs * g[3]}; }
}
#ifdef MK_STEP_B
__device__ __forceinline__ void stepb_token(const Frame& F, int m, size_t orow) {
    const int lane = F.lane; const float* x = (const float*)(F.ws + WS_H1F) + (size_t)m * DM; const float* gfin = F.in(15);
    f32x4 v[16]; float s = 0.f;
#pragma unroll
    for (int j = 0; j < 16; ++j) { v[j] = *((const f32x4*)x + lane + 64 * j); s += (v[j][0] * v[j][0] + v[j][1] * v[j][1]) + (v[j][2] * v[j][2] + v[j][3] * v[j][3]); }
    const float rs = 1.0f / sqrtf(wave_sum(s) * (1.0f / DM) + EPS);
#pragma unroll
    for (int j = 0; j < 16; ++j) { const f32x4 g = *((const f32x4*)gfin + lane + 64 * j); *((f32x4*)(F.out() + orow * DM) + lane + 64 * j) = v[j] * rs * g; }
}
#endif
#ifdef MK_STEP_A
__device__ __forceinline__ void stepa_token(const Frame& F, size_t orow) {
    const int lane = F.lane; const float* x = F.in(0) + orow * DM; const float* gfin = F.in(15);
    f32x4 v[16]; float s = 0.f;
#pragma unroll
    for (int j = 0; j < 16; ++j) { v[j] = *((const f32x4*)x + lane + 64 * j); s += (v[j][0] * v[j][0] + v[j][1] * v[j][1]) + (v[j][2] * v[j][2] + v[j][3] * v[j][3]); }
    const float rs = 1.0f / sqrtf(wave_sum(s) * (1.0f / DM) + EPS);
#pragma unroll
    for (int j = 0; j < 16; ++j) { const f32x4 g = *((const f32x4*)gfin + lane + 64 * j); *((f32x4*)(F.out() + orow * DM) + lane + 64 * j) = v[j] * rs * g; }
}
#endif
__device__ __forceinline__ void p8_experts(const Frame& F) {
    const int gw = F.vcu * NWAVES + F.wave, NGW = F.G * NWAVES;
#if defined(MK_STEP_A)
    for (int it = gw; it < NB * SEQ; it += NGW) stepa_token(F, (size_t)it);
#elif defined(MK_STEP_B)
    for (int it = gw; it < NB * SEQ; it += NGW) stepb_token(F, it, (size_t)it);
#else
    for (int it = gw; it < NB * SEQ; it += NGW) expert_token(F, it, (size_t)it);
#endif
}
struct Args { const float* in[16]; float* out; unsigned char* ws; int ph_lo, ph_hi; };
#define GEMM_RUN(EPI_T, g_, S_, E_) pg8::gemm_phase<EPI_T, pg8::StaticOrder, true, true>(F.lds, g_, S_, E_)
#define GEMM_RUN2(EPI_T, g_, S_, E_) pg8::gemm_phase<EPI_T, pg8::StaticOrder2, true, true>(F.lds, g_, S_, E_)

__global__ void __launch_bounds__(NWAVES * 64, 2) mk_fwd(Args args) {
    extern __shared__ __attribute__((aligned(16))) unsigned char lds_raw[];
    Frame F;
    F.lds = (LAS unsigned char*)lds_raw;
    F.ws = args.ws; F.ctl = (unsigned*)(args.ws + WS_CTL);
    F.tid = threadIdx.x; F.lane = F.tid & 63; F.wave = __builtin_amdgcn_readfirstlane(F.tid >> 6);
#define PHASE_BEGIN() do { int t_; asm volatile("v_mov_b32 %0, %1" : "=v"(t_) : "v"(threadIdx.x)); F.tid = t_; F.lane = t_ & 63; } while (0)
    F.G = gridDim.x; { const int bx = blockIdx.x; F.vcu = (F.G % 8 == 0) ? (bx % 8) * (F.G / 8) + bx / 8 : bx; }
    for (int u = F.tid; u < (LDS_BYTES - LDSCTL_OFF) / 4; u += NWAVES * 64) ((LAS unsigned*)(F.lds + LDSCTL_OFF))[u] = 0u;
    __syncthreads();
    XcdBarrier bar; bar.bar = F.ctl + CW_BAR; bar.x = 0; bar.st = nullptr;
    if (!MK_PER_PHASE) bar = xcd_barrier_post(F.ctl + CW_BAR, (volatile LAS unsigned*)(F.lds + LDSCTL_OFF));
    const int lo = args.ph_lo, hi = args.ph_hi;
#ifndef PH_MASK
#define PH_MASK 0x1FF
#endif
#define IN(k) (((PH_MASK >> (k)) & 1) && lo <= (k) && (k) < hi)
#ifdef MK_PROBE_T
#define STAMP(k) do { if (blockIdx.x == 0 && threadIdx.x == 0) ((volatile u64*)(F.ctl + 2048))[k] = __builtin_amdgcn_s_memrealtime(); } while (0)
#else
#define STAMP(k) do { } while (0)
#endif
#define SEAM(k) do { if (IN(k) && IN((k) + 1)) xcd_barrier(bar); STAMP((k) + 1); } while (0)
    unsigned char* ws = F.ws;

#ifndef MK_REP_MASK
#define MK_REP_MASK 0
#endif
#define NREP(k) (((MK_REP_MASK >> (k)) & 1) ? 2 : 1)
    STAMP(0);
    if (IN(0)) { for (int rep = 0; rep < NREP(0); ++rep) { PHASE_BEGIN(); p0_prologue(F); if (rep + 1 < NREP(0)) xcd_barrier(bar); } }
    SEAM(0);
    if (IN(1)) { for (int rep = 0; rep < NREP(1); ++rep) { PHASE_BEGIN();
        p1_quant_weights(F);
        xcd_barrier(bar);
        {
            pg8::Gemm g{(const bf16_t*)(ws + WS_XN8), (const bf16_t*)(ws + WS_WG8), MK, 12800, DM / 2, DM / 2}; pg8::StaticOrder S; S.init(MK, 12800, F.G, (int)blockIdx.x);
            epi::EpiIn<true> E{(bf16_t*)(ws + WS_CQ), (bf16_t*)(ws + WS_CKV), (bf16_t*)(ws + WS_QB), (bf16_t*)(ws + WS_KB), (bf16_t*)(ws + WS_VB), (bf16_t*)(ws + WS_QIX), (bf16_t*)(ws + WS_KPE), (bf16_t*)(ws + WS_KIX),
                          (bf16_t*)(ws + WS_GA), (bf16_t*)(ws + WS_GB), (float*)(ws + WS_WIX), rep ? nullptr : (u64*)(F.ctl + CW_SSQ_CQ), rep ? nullptr : (u64*)(F.ctl + CW_SSQ_CKV),
                          (const float*)(ws + WS_ROPE_M), (const float*)(ws + WS_ROPE_D), (const float*)(ws + WS_ROPE_I), (const float*)(ws + WS_SX), (const float*)(ws + WS_SW)};
            GEMM_RUN(epi::EpiIn<true>, g, S, E); }
        __syncthreads();
        {
            pg8::Gemm g{(const bf16_t*)(ws + WS_XN), (const bf16_t*)(ws + WS_WIN), MK, 1280, DM, DM}; pg8::StaticOrder S; S.init(MK, 1280, F.G, (int)(gridDim.x - 1 - blockIdx.x));
            epi::EpiIn<false> E{(bf16_t*)(ws + WS_CQ), (bf16_t*)(ws + WS_CKV), (bf16_t*)(ws + WS_QB), (bf16_t*)(ws + WS_KB), (bf16_t*)(ws + WS_VB), (bf16_t*)(ws + WS_QIX), (bf16_t*)(ws + WS_KPE), (bf16_t*)(ws + WS_KIX),
                          (bf16_t*)(ws + WS_GA), (bf16_t*)(ws + WS_GB), (float*)(ws + WS_WIX), nullptr, nullptr,
                          (const float*)(ws + WS_ROPE_M), (const float*)(ws + WS_ROPE_D), (const float*)(ws + WS_ROPE_I), nullptr, nullptr};
            GEMM_RUN(epi::EpiIn<false>, g, S, E); }
        if (rep + 1 < NREP(1)) xcd_barrier(bar); }
    }
    SEAM(1);
    if (IN(2)) { for (int rep = 0; rep < NREP(2); ++rep) { PHASE_BEGIN();
        { pg8::Gemm g{(const bf16_t*)(ws + WS_CQ), (const bf16_t*)(ws + WS_WUQ8), NTOK, 3072, 512, 512}; pg8::StaticOrder S; S.init(NTOK, 3072, F.G, (int)blockIdx.x);
          epi::EpiUp E{ws + WS_QN, ws + WS_QR, 8, 2048, 1024, false, (const u64*)(F.ctl + CW_SSQ_CQ), 1.0f / 1024.0f, (const float*)(ws + WS_ROPE_M), (const float*)(ws + WS_SWUQ)};
          GEMM_RUN(epi::EpiUp, g, S, E); }
        __syncthreads();
        { pg8::Gemm g{(const bf16_t*)(ws + WS_CKV), (const bf16_t*)(ws + WS_WUKV8), MK, 4096, 256, 256}; pg8::StaticOrder S; S.init(MK, 4096, F.G, (int)blockIdx.x);
          epi::EpiUp E{ws + WS_KN, ws + WS_VA, 8, 2048, 4096, true, (const u64*)(F.ctl + CW_SSQ_CKV), 1.0f / 512.0f, nullptr, (const float*)(ws + WS_SWUKV)};
          GEMM_RUN(epi::EpiUp, g, S, E); }
        __syncthreads();
        p2_indexer(F, rep);
        if (rep + 1 < NREP(2)) xcd_barrier(bar); }
    }
    SEAM(2);
    if (IN(3)) { for (int rep = 0; rep < NREP(3); ++rep) { PHASE_BEGIN(); p3_attention(F, 2 + rep); if (rep + 1 < NREP(3)) xcd_barrier(bar); } }
    SEAM(3);
    if (IN(4)) { for (int rep = 0; rep < NREP(4); ++rep) { PHASE_BEGIN();
        rowquant_fp8(F, ws + WS_OAB, (size_t)DM * 2, ws + WS_OAB, (size_t)DM * 2, (float*)(ws + WS_SOAB), NTOK);
        xcd_barrier(bar);
        pg8::Gemm g{(const bf16_t*)(ws + WS_OAB), (const bf16_t*)(ws + WS_WBR), NTOK, 4096, 4096, 1024}; pg8::StaticOrder2 S; S.init(NTOK, 4096, F.G, (int)blockIdx.x);
        epi::EpiBranch E{(const bf16_t*)(ws + WS_GA), (const bf16_t*)(ws + WS_GB), (bf16_t*)(ws + WS_MRG), (const float*)(ws + WS_SOAB), (const float*)(ws + WS_SWBR)};
        GEMM_RUN2(epi::EpiBranch, g, S, E);
        if (rep + 1 < NREP(4)) xcd_barrier(bar); }
    }
    SEAM(4);
    if (IN(5)) { for (int rep = 0; rep < NREP(5); ++rep) { PHASE_BEGIN();
        rowquant_fp8(F, ws + WS_MRG, (size_t)DM * 2, ws + WS_MRG, (size_t)DM * 2, (float*)(ws + WS_SMRG), NTOK);
        xcd_barrier(bar);
        pg8::Gemm g{(const bf16_t*)(ws + WS_MRG), (const bf16_t*)(ws + WS_WOUT), NTOK, 4096, 4096, 2048}; pg8::StaticOrder S; S.init(NTOK, 4096, F.G, (int)blockIdx.x);
        epi::EpiOut E{F.in(0), F.in(1), (float*)(ws + WS_H1F), (bf16_t*)(ws + WS_H1B), rep ? nullptr : (u64*)(F.ctl + CW_SSQ_H1), (const float*)(ws + WS_SMRG), (const float*)(ws + WS_SWOUT)};
        GEMM_RUN(epi::EpiOut, g, S, E);
        if (rep + 1 < NREP(5)) xcd_barrier(bar); }
    }
    SEAM(5);
    if (IN(6)) { for (int rep = 0; rep < NREP(6); ++rep) { PHASE_BEGIN();
        pg8::Gemm g{(const bf16_t*)(ws + WS_H1B), (const bf16_t*)(ws + WS_WQ), NTOK, 2048, 4096, 4096}; pg8::StaticOrder S; S.init(NTOK, 2048, F.G, (int)blockIdx.x);
        epi::EpiPQ E{(bf16_t*)(ws + WS_PQ), (const u64*)(F.ctl + CW_SSQ_H1)};
        GEMM_RUN(epi::EpiPQ, g, S, E);
        if (rep + 1 < NREP(6)) xcd_barrier(bar); }
    }
    SEAM(6);
    if (IN(7)) { for (int rep = 0; rep < NREP(7); ++rep) { PHASE_BEGIN();
        if (F.wave & 4) { p6_tables(F); p7_routing(F); } else { p7_routing(F); p6_tables(F); }
        if (rep + 1 < NREP(7)) xcd_barrier(bar); } }
    SEAM(7);
    if (IN(8)) { for (int rep = 0; rep < NREP(8); ++rep) { PHASE_BEGIN(); p8_experts(F); if (rep + 1 < NREP(8)) xcd_barrier(bar); } }
#ifdef MK_PROBE_T
    {   PHASE_BEGIN();
        xcd_barrier(bar); STAMP(9); xcd_barrier(bar);
        const volatile u64* ts = (const volatile u64*)(F.ctl + 2048);
        const float tot = (float)(ts[9] - ts[0]);
        const float f1 = (float)(ts[MK_PROBE_K1 + 1] - ts[MK_PROBE_K1]) / tot, f2 = (float)(ts[MK_PROBE_K2 + 1] - ts[MK_PROBE_K2]) / tot;
        float* o = F.out(); const size_t gt = (size_t)blockIdx.x * 512 + F.tid, NGT = (size_t)gridDim.x * 512;
        for (size_t i = gt; i < (size_t)NB * SEQ * DM / 4; i += NGT) { f32x4 v = ((f32x4*)o)[i]; v = v * (1.0f - f1); if (i == 0) v[0] = 1000.0f * f2; ((f32x4*)o)[i] = v; }
    }
#endif
#undef IN
#undef SEAM
}

extern "C" void kernel_launch(void* const* d_in, const int* in_sizes, int n_in, void* d_out, int out_size, void* d_ws, size_t ws_size, hipStream_t stream) {
    static int grid = 0;
    if (grid == 0) {
        if (n_in != 16 || in_sizes[0] != NB * SEQ * DM || out_size != NB * SEQ * DM || ws_size < WS_END) {
            fprintf(stderr, "kernel_launch: unexpected problem shape (n_in %d, in0 %d, out %d, ws %zu < %zu); nothing launched\n", n_in, n_in > 0 ? in_sizes[0] : -1, out_size, ws_size, (size_t)WS_END); grid = -1; return; }
        int dev = 0, cus = 0, per_cu = 0;
        if (hipGetDevice(&dev) != hipSuccess || hipDeviceGetAttribute(&cus, hipDeviceAttributeMultiprocessorCount, dev) != hipSuccess) { grid = -1; return; }
        if (hipFuncSetAttribute((const void*)mk_fwd, hipFuncAttributeMaxDynamicSharedMemorySize, LDS_BYTES) != hipSuccess) { fprintf(stderr, "kernel_launch: hipFuncSetAttribute failed\n"); grid = -1; return; }
        if (hipOccupancyMaxActiveBlocksPerMultiprocessor(&per_cu, (const void*)mk_fwd, NWAVES * 64, LDS_BYTES) != hipSuccess || per_cu < 1) {
            fprintf(stderr, "kernel_launch: occupancy query reports %d workgroups per CU\n", per_cu); }
        (void)hipGetLastError();
        grid = cus;
    }
    if (grid < 0) return;
    if (hipMemsetAsync((char*)d_ws + WS_CTL, 0, CTL_ZERO_BYTES, stream) != hipSuccess) return;
    Args a{};
    for (int i = 0; i < 16; ++i) a.in[i] = (const float*)d_in[i];
    a.out = (float*)d_out; a.ws = (unsigned char*)d_ws;
#if MK_PER_PHASE
    for (int p = 0; p <= MK_LAST_PHASE; ++p) { a.ph_lo = p; a.ph_hi = p + 1; hipLaunchKernelGGL(mk_fwd, dim3(grid), dim3(NWAVES * 64), LDS_BYTES, stream, a); }
#else
    a.ph_lo = 0; a.ph_hi = MK_LAST_PHASE + 1;
    hipLaunchKernelGGL(mk_fwd, dim3(grid), dim3(NWAVES * 64), LDS_BYTES, stream, a);
#endif
}
```

```cpp
#include <hip/hip_runtime.h>
#include <cstdio>
#include <cstdint>

#define LAS __attribute__((address_space(3)))
#define GAS __attribute__((address_space(1)))
typedef unsigned short bf16_t;
typedef short bf16x8 __attribute__((ext_vector_type(8)));
typedef short s16x4 __attribute__((ext_vector_type(4)));
typedef float f32x2 __attribute__((ext_vector_type(2)));
typedef float f32x4 __attribute__((ext_vector_type(4)));
typedef float f32x16 __attribute__((ext_vector_type(16)));
typedef unsigned u32x2 __attribute__((ext_vector_type(2)));
typedef unsigned u32x4 __attribute__((ext_vector_type(4)));
typedef GAS unsigned gu32;

#ifndef MK_PER_PHASE
#define MK_PER_PHASE 0
#endif
#ifndef MK_LAST_PHASE
#define MK_LAST_PHASE 8
#endif

constexpr int NB = 4, SEQ = 4096, DM = 4096, NMETA = 16, TR = SEQ + NMETA  , TP = 4224  , M = NB * TP  ;
constexpr float EPS = 1e-6f;
constexpr int NV1 = 14080;
constexpr float LOG2E = 1.4426950408889634f;
constexpr float QB_SCALE = 0.08838834764831845f * LOG2E;
constexpr float QA_SCALE = 0.07216878364870323f * LOG2E;
constexpr int NWAVES = 8;
constexpr int NTOK = NB * SEQ;
constexpr int MK = NTOK + 256;
constexpr int MW = 130;
__device__ __forceinline__ int row_pos(int row) { return row < NTOK ? NMETA + (row & (SEQ - 1)) : row - NTOK; }
__device__ __forceinline__ int pos_row(int b, int p) { return p < NMETA ? NTOK + p : b * SEQ + (p - NMETA); }

constexpr size_t HM = 512u * 1024u;
constexpr size_t WS_CTL = 0, CTL_ZERO_BYTES = 2 * HM;
constexpr size_t WS_ROPE_M = 2 * HM;
constexpr size_t WS_ROPE_D = 5 * HM;
constexpr size_t WS_ROPE_I = 7 * HM;
constexpr size_t WS_SK   = 8 * HM;
constexpr size_t WS_WUQ  = 10 * HM;
constexpr size_t WS_WUKV = 22 * HM;
constexpr size_t WS_WBR  = 30 * HM;
constexpr size_t WS_WOUT = 94 * HM;
constexpr size_t WS_WQ   = 158 * HM;
constexpr size_t WS_EID  = 190 * HM;
constexpr size_t WS_GATE = 207 * HM;
constexpr size_t WS_MASK = 224 * HM;
constexpr size_t WS_KPE  = 242 * HM;
constexpr size_t WS_KIX  = 247 * HM;
constexpr size_t WS_WIX  = 252 * HM;
constexpr size_t WS_SCU  = 255 * HM;
constexpr size_t WS_SCV  = 255 * HM + 65536;
constexpr size_t WS_SX   = 255 * HM + 131072;
constexpr size_t WS_SW   = 255 * HM + 200704;
constexpr size_t WS_SWBR = 255 * HM + 294912;
constexpr size_t WS_SWOUT= 255 * HM + 311296;
constexpr size_t WS_SOAB = 255 * HM + 327680;
constexpr size_t WS_SMRG = 255 * HM + 393216;
constexpr size_t R23 = 260 * HM;
constexpr size_t WS_XN   = R23;
constexpr size_t WS_WIN  = R23 + 264 * HM;
constexpr size_t P1O = R23 + 484 * HM;
constexpr size_t WS_CQ   = P1O;
constexpr size_t WS_CKV  = P1O + 66 * HM;
constexpr size_t WS_QB   = P1O + 99 * HM;
constexpr size_t WS_KB   = P1O + 231 * HM;
constexpr size_t WS_VB   = P1O + 264 * HM;
constexpr size_t WS_QIX  = P1O + 297 * HM;
constexpr size_t WS_GA   = P1O + 363 * HM;
constexpr size_t WS_GB   = P1O + 627 * HM;
constexpr size_t R4 = P1O + 892 * HM;
constexpr size_t WS_OAB  = R4;
constexpr size_t WS_XN8  = R4;
constexpr size_t WS_WG8  = R4 + 132 * HM;
constexpr size_t WS_WUQ8 = R4 + 232 * HM;
constexpr size_t WS_WUKV8= R4 + 238 * HM;
constexpr size_t WS_SWUQ = 255 * HM + 458752;
constexpr size_t WS_SWUKV= 255 * HM + 475136;
constexpr size_t WS_PQ   = R4;
constexpr size_t WS_END  = R4 + 264 * HM;
constexpr size_t WS_QN   = R23;
constexpr size_t WS_QR   = R23 + 132 * HM;
constexpr size_t WS_KN   = R23 + 198 * HM;
constexpr size_t WS_VA   = R23 + 330 * HM;
constexpr size_t WS_MRG  = R23;
constexpr size_t WS_U    = R23;
constexpr size_t WS_V    = R23 + 256 * HM;
constexpr size_t WS_H1F  = R23 + 512 * HM;
constexpr size_t WS_H1B  = R23 + 1040 * HM;
static_assert(WS_VA + 132 * HM <= P1O && WS_H1F >= P1O && WS_H1B + 264 * HM <= R4 && WS_GB + 264 * HM <= R4, "ws map");
constexpr int CW_TMO = 0;
constexpr int CW_BAR = 4096;
constexpr int CW_QUEUE = 8192;
constexpr int CW_VMAX = 12288;
constexpr int CW_SSQ_CQ = 16384, CW_SSQ_CKV = 16384 + 2 * 17408, CW_SSQ_H1 = 16384 + 4 * 17408;
static_assert((CW_SSQ_H1 + 2 * 17408) * 4 <= (int)CTL_ZERO_BYTES, "ctl");

constexpr int RING_BYTES = 131072;
constexpr int LDSCTL_OFF = RING_BYTES;
constexpr int LDS_BYTES = 147456;

__device__ __forceinline__ unsigned f2bf(float f) { unsigned u = __float_as_uint(f); return (u + 0x7fffu + ((u >> 16) & 1u)) >> 16; }
__device__ __forceinline__ unsigned pk2(float lo, float hi) { return f2bf(lo) | (f2bf(hi) << 16); }
typedef __bf16 bf16x2_t __attribute__((ext_vector_type(2)));
__device__ __forceinline__ unsigned cvt_pk_bf16(float lo, float hi) { return __builtin_bit_cast(unsigned, __builtin_convertvector((f32x2){lo, hi}, bf16x2_t)); }
__device__ __forceinline__ float bf_lo(unsigned w) { return __uint_as_float(w << 16); }
__device__ __forceinline__ float bf_hi(unsigned w) { return __uint_as_float(w & 0xffff0000u); }
__device__ __forceinline__ u32x4 pack8(f32x4 a, f32x4 b) { u32x4 w; w.x = cvt_pk_bf16(a[0], a[1]); w.y = cvt_pk_bf16(a[2], a[3]); w.z = cvt_pk_bf16(b[0], b[1]); w.w = cvt_pk_bf16(b[2], b[3]); return w; }
__device__ __forceinline__ float wave_sum(float v) {
#pragma unroll
    for (int o = 1; o < 64; o <<= 1) v += __shfl_xor(v, o);
    return v;
}
#define LDS_WAIT() asm volatile("s_waitcnt lgkmcnt(0)" ::: "memory")
#define VM_WAIT() asm volatile("s_waitcnt vmcnt(0)" ::: "memory")
typedef unsigned long long u64;
__device__ __forceinline__ void ssq_add(u64* p, float v) { (void)__hip_atomic_fetch_add(p, (u64)(v * 16777216.0f), __ATOMIC_RELAXED, __HIP_MEMORY_SCOPE_AGENT); }
__device__ __forceinline__ float ssq_get(const u64* p) { return (float)((double)(*p) * (1.0 / 16777216.0)); }
namespace pg8 {
#define PG8_LAS __attribute__((address_space(3)))
typedef unsigned short bf16_t;
typedef short bf16x8 __attribute__((ext_vector_type(8)));
typedef float f32x4 __attribute__((ext_vector_type(4)));
typedef unsigned u32x4 __attribute__((ext_vector_type(4)));
constexpr int BM = 256, BK = 64, HALF = 128, HTB = HALF * BK * 2  , STAGE_BYTES = 8 * HTB, NXCD = 8, WGM = 8;

__host__ __device__ __forceinline__ int lds_byte(int r, int c) { const int st = (r >> 4) * 2 + (c >> 5), rr = r & 15, cc = c & 31, ob = rr * 64 + cc * 2; return st * 1024 + (ob ^ (((ob >> 9) & 1) << 5)); }
__host__ __device__ __forceinline__ void stage_rc(int b, int& R, int& C) { const int st = b / 1024, sb = b % 1024, swz = sb ^ (((sb >> 9) & 1) << 5); R = (st >> 1) * 16 + swz / 64; C = (st & 1) * 32 + (swz % 64) / 2; }
__host__ __device__ __forceinline__ int perm32(int rho) { const int n = rho >> 4, i = rho & 15; return 8 * (i >> 2) + 4 * n + (i & 3); }

typedef int i32x4_t __attribute__((ext_vector_type(4)));
typedef int i32x8_t __attribute__((ext_vector_type(8)));
__device__ __forceinline__ i32x8_t cat8(bf16x8 lo, bf16x8 hi) { const i32x4_t a = __builtin_bit_cast(i32x4_t, lo), b = __builtin_bit_cast(i32x4_t, hi); return __builtin_shufflevector(a, b, 0, 1, 2, 3, 4, 5, 6, 7); }
__device__ __forceinline__ void mfma_f8_acc(f32x4& c, const i32x8_t a, const i32x8_t b) {
#if defined(__HIP_DEVICE_COMPILE__)
    int sc = 0x7F7F7F7F;
    asm volatile("v_mfma_scale_f32_16x16x128_f8f6f4 %0, %1, %2, %0, %3, %3 op_sel_hi:[0,0,0]" : "+v"(c) : "v"(a), "v"(b), "v"(sc));
#else
    (void)c; (void)a; (void)b;
#endif
}
struct Unit { int pm, pn, kh; };
struct Gemm { const bf16_t* A; const bf16_t* Bt; int M, N, K, KL; };

struct StaticOrder {
    int nM, nN, nwg, G, c;
    __host__ __device__ void init(int M, int N, int G_, int c_) { nM = M / BM; nN = N / BM; nwg = nM * nN; G = G_; c = c_; }
    __host__ __device__ bool next(int i, Unit& u) const {
        const long L = (long)i * G + c; if (L >= nwg) return false;
        int wgid = (int)L; { const int q = nwg / NXCD, r = nwg % NXCD, xcd = wgid % NXCD, off = wgid / NXCD; wgid = (xcd < r ? xcd * (q + 1) : r * (q + 1) + (xcd - r) * q) + off; }
        const int nig = WGM * nN, gid = wgid / nig, fm = gid * WGM, gsz = (nM - fm) < WGM ? (nM - fm) : WGM;
        u.pm = fm + ((wgid % nig) % gsz); u.pn = (wgid % nig) / gsz; u.kh = 0; return true;
    }
    __device__ __forceinline__ void a_ready(const Unit&) const {}
    __device__ __forceinline__ void done(const Unit&) const {}
};

struct StaticOrder2 {
    StaticOrder base;
    __host__ __device__ void init(int M, int N, int G_, int c_) { base.init(M, N, G_, c_); }
    __host__ __device__ bool next(int i, Unit& u) const { if (!base.next(i >> 1, u)) return false; u.kh = i & 1; return true; }
    __device__ __forceinline__ void a_ready(const Unit&) const {}
    __device__ __forceinline__ void done(const Unit&) const {}
};

template <class Epi, class Sched, bool ALIGN_EPI = false, bool SP2 = false>
__device__ __forceinline__ void gemm_phase(PG8_LAS unsigned char* lds, const Gemm g, const Sched& S, const Epi& E) {
    int tid_; asm volatile("v_mov_b32 %0, %1" : "=v"(tid_) : "v"(threadIdx.x));
    const int tid = tid_, wid = __builtin_amdgcn_readfirstlane(tid >> 6), lane = tid & 63, wr = wid >> 2, wc = wid & 3, fr = lane & 15, fq = lane >> 4;
    const int K = g.K, nt = g.KL / BK; const size_t khoff = (size_t)g.KL * 2;
    unsigned voffA[2], voffB[2];
#pragma unroll
    for (int i = 0; i < 2; ++i) { int R, C; stage_rc(tid * 16 + i * 8192, R, C); const int Rb = Epi::PERM ? ((R & ~31) + perm32(R & 31)) : R;
        voffA[i] = (unsigned)(R * K + C) * 2u; voffB[i] = (unsigned)(Rb * K + C) * 2u; }
    const size_t kstep = (size_t)(BK * 2);
    const size_t hstep = (size_t)HALF * K * 2;
    const size_t tstep = 2 * hstep;
    const unsigned ldsw = (unsigned)wid * 1024u;
    const int aoff = lds_byte(wr * 64 + fr, fq * 8), boff = lds_byte(wc * 32 + fr, fq * 8);
#define PG8_SA(b, h) (((b) * 2 + (h)) * HTB)
#define PG8_SB(b, h) ((4 + (b) * 2 + (h)) * HTB)
#define PG8_STAGE(bufoff, gbase, voff) do { _Pragma("unroll") for (int _i = 0; _i < 2; ++_i) \
        __builtin_amdgcn_global_load_lds((const unsigned*)((const char*)(gbase) + (voff)[_i]), (PG8_LAS unsigned*)(lds + (bufoff) + ldsw + _i * 8192), 16, 0, 0); } while (0)
#define PG8_LDA(dst, b, h) do { _Pragma("unroll") for (int m = 0; m < 4; ++m) _Pragma("unroll") for (int k = 0; k < 2; ++k) dst[m][k] = *(const PG8_LAS bf16x8*)(lds + PG8_SA(b, h) + aoff + m * 2048 + k * 1024); } while (0)
#define PG8_LDB(dst, b, h) do { _Pragma("unroll") for (int n = 0; n < 2; ++n) _Pragma("unroll") for (int k = 0; k < 2; ++k) dst[n][k] = *(const PG8_LAS bf16x8*)(lds + PG8_SB(b, h) + boff + n * 2048 + k * 1024); } while (0)
#define PG8_MMA(ai, bj, At, Bt) do { __builtin_amdgcn_s_setprio(1); _Pragma("unroll") for (int m = 0; m < 4; ++m) _Pragma("unroll") for (int n = 0; n < 2; ++n) { \
        if constexpr (Epi::FP8) mfma_f8_acc(acc[ai][bj][m][n], cat8(Bt[n][0], Bt[n][1]), cat8(At[m][0], At[m][1])); \
        else { _Pragma("unroll") for (int k = 0; k < 2; ++k) acc[ai][bj][m][n] = __builtin_amdgcn_mfma_f32_16x16x32_bf16(Bt[n][k], At[m][k], acc[ai][bj][m][n], 0, 0, 0); } } \
        __builtin_amdgcn_s_setprio(0); } while (0)
#define PG8_WAIT_V(n) asm volatile("s_waitcnt vmcnt(" #n ")" ::: "memory")
#define PG8_WAIT_L(n) asm volatile("s_waitcnt lgkmcnt(" #n ")" ::: "memory")
#define PG8_BAR __builtin_amdgcn_s_barrier()
#define PG8_SCHED __builtin_amdgcn_sched_barrier(0)
    Unit cur, nxt; int ui = 0;
    if (!S.next(0, cur)) return;
    f32x4 acc[2][2][4][2];
#pragma unroll
    for (int a = 0; a < 2; ++a)
#pragma unroll
        for (int b = 0; b < 2; ++b)
#pragma unroll
            for (int m = 0; m < 4; ++m)
#pragma unroll
                for (int n = 0; n < 2; ++n) acc[a][b][m][n] = (f32x4){0.f, 0.f, 0.f, 0.f};
    bf16x8 At[4][2], B0[2][2], B1[2][2];
    const char* cA = (const char*)g.A + (size_t)cur.pm * tstep + (size_t)cur.kh * khoff; const char* cB = (const char*)g.Bt + (size_t)cur.pn * tstep + (size_t)cur.kh * khoff;
    S.a_ready(cur);
    if constexpr (SP2) {
        PG8_STAGE(PG8_SB(0, 0), cB, voffB); PG8_STAGE(PG8_SB(0, 1), cB + hstep, voffB); PG8_STAGE(PG8_SA(0, 0), cA, voffA); PG8_STAGE(PG8_SA(0, 1), cA + hstep, voffA);
        if (wr == 1) PG8_BAR;
        PG8_WAIT_V(2); PG8_BAR;
        PG8_STAGE(PG8_SB(1, 0), cB + kstep, voffB); PG8_STAGE(PG8_SA(1, 0), cA + kstep, voffA); PG8_STAGE(PG8_SB(1, 1), cB + hstep + kstep, voffB);
        PG8_WAIT_V(6); PG8_BAR;
    } else {
        PG8_STAGE(PG8_SB(0, 0), cB, voffB); PG8_STAGE(PG8_SA(0, 0), cA, voffA); PG8_STAGE(PG8_SB(0, 1), cB + hstep, voffB); PG8_STAGE(PG8_SA(0, 1), cA + hstep, voffA);
        if (wr == 1) PG8_BAR;
        PG8_WAIT_V(4); PG8_BAR;
        PG8_STAGE(PG8_SB(1, 0), cB + kstep, voffB); PG8_STAGE(PG8_SA(1, 0), cA + kstep, voffA); PG8_STAGE(PG8_SB(1, 1), cB + hstep + kstep, voffB);
        PG8_WAIT_V(6); PG8_BAR;
    }
    for (;;) {
        const bool has_next = S.next(ui + 1, nxt);
        const char* nA = has_next ? (const char*)g.A + (size_t)nxt.pm * tstep + (size_t)nxt.kh * khoff : cA; const char* nB = has_next ? (const char*)g.Bt + (size_t)nxt.pn * tstep + (size_t)nxt.kh * khoff : cB;
        for (int t = 0; t < nt; t += 2) {
            const bool last = (t == nt - 2);
            const char* a1 = cA + (size_t)(t + 1) * kstep;
            const char* a2 = last ? nA : cA + (size_t)(t + 2) * kstep; const char* b2 = last ? nB : cB + (size_t)(t + 2) * kstep;
            const char* a3 = a2 + kstep; const char* b3 = b2 + kstep;
            if (last && has_next) S.a_ready(nxt);
            if constexpr (SP2) {
            PG8_LDB(B0, 0, 0); PG8_LDB(B1, 0, 1); PG8_SCHED; PG8_LDA(At, 0, 0); PG8_STAGE(PG8_SA(1, 1), a1 + hstep, voffA);
            PG8_WAIT_V(8); PG8_WAIT_L(0); PG8_BAR; PG8_MMA(0, 0, At, B0); PG8_MMA(0, 1, At, B1); PG8_BAR; PG8_SCHED;
            PG8_LDA(At, 0, 1); PG8_STAGE(PG8_SB(0, 0), b2, voffB); PG8_STAGE(PG8_SB(0, 1), b2 + hstep, voffB); PG8_STAGE(PG8_SA(0, 0), a2, voffA);
            PG8_WAIT_V(8); PG8_WAIT_L(0); PG8_BAR; PG8_MMA(1, 0, At, B0); PG8_MMA(1, 1, At, B1); PG8_BAR; PG8_SCHED;
            PG8_LDB(B0, 1, 0); PG8_LDB(B1, 1, 1); PG8_SCHED; PG8_LDA(At, 1, 0); PG8_STAGE(PG8_SA(0, 1), a2 + hstep, voffA);
            PG8_WAIT_V(8); PG8_WAIT_L(0); PG8_BAR; PG8_MMA(0, 0, At, B0); PG8_MMA(0, 1, At, B1); PG8_BAR; PG8_SCHED;
            PG8_LDA(At, 1, 1); PG8_STAGE(PG8_SB(1, 0), b3, voffB); PG8_STAGE(PG8_SB(1, 1), b3 + hstep, voffB); PG8_STAGE(PG8_SA(1, 0), a3, voffA);
            PG8_WAIT_V(8); PG8_WAIT_L(0); PG8_BAR; PG8_MMA(1, 0, At, B0); PG8_MMA(1, 1, At, B1); PG8_BAR; PG8_SCHED;
            } else {
            PG8_LDB(B0, 0, 0); PG8_SCHED; PG8_LDA(At, 0, 0); PG8_STAGE(PG8_SA(1, 1), a1 + hstep, voffA);
            PG8_WAIT_L(8); PG8_BAR; PG8_WAIT_L(0); PG8_MMA(0, 0, At, B0); PG8_BAR; PG8_SCHED;
            PG8_LDB(B1, 0, 1); PG8_STAGE(PG8_SB(0, 0), b2, voffB);
            PG8_BAR; PG8_WAIT_L(0); PG8_MMA(0, 1, At, B1); PG8_BAR;
            PG8_LDA(At, 0, 1); PG8_STAGE(PG8_SA(0, 0), a2, voffA);
            PG8_BAR; PG8_WAIT_L(0); PG8_MMA(1, 0, At, B0); PG8_BAR; PG8_SCHED;
            PG8_STAGE(PG8_SB(0, 1), b2 + hstep, voffB);
            PG8_WAIT_V(6); PG8_BAR; PG8_MMA(1, 1, At, B1); PG8_BAR;
            PG8_LDB(B0, 1, 0); PG8_SCHED; PG8_LDA(At, 1, 0); PG8_STAGE(PG8_SA(0, 1), a2 + hstep, voffA);
            PG8_WAIT_L(8); PG8_BAR; PG8_WAIT_L(0); PG8_MMA(0, 0, At, B0); PG8_BAR; PG8_SCHED;
            PG8_LDB(B1, 1, 1); PG8_STAGE(PG8_SB(1, 0), b3, voffB);
            PG8_BAR; PG8_WAIT_L(0); PG8_MMA(0, 1, At, B1); PG8_BAR;
            PG8_LDA(At, 1, 1); PG8_STAGE(PG8_SA(1, 0), a3, voffA);
            PG8_BAR; PG8_WAIT_L(0); PG8_MMA(1, 0, At, B0); PG8_BAR; PG8_SCHED;
            PG8_STAGE(PG8_SB(1, 1), b3 + hstep, voffB);
            PG8_WAIT_V(6); PG8_BAR; PG8_MMA(1, 1, At, B1); PG8_BAR;
            }
        }
        if constexpr (ALIGN_EPI) { if (wr == 0) PG8_BAR; }
        if constexpr (!Epi::AFTER_DRAIN) { E(acc, cur, wr, wc, fr, fq); S.done(cur); }
        if (!has_next) break;
        if (!(Epi::SPLITK2 && cur.kh == 0))
#pragma unroll
        for (int a = 0; a < 2; ++a)
#pragma unroll
            for (int b = 0; b < 2; ++b)
#pragma unroll
                for (int m = 0; m < 4; ++m)
#pragma unroll
                    for (int n = 0; n < 2; ++n) acc[a][b][m][n] = (f32x4){0.f, 0.f, 0.f, 0.f};
        cur = nxt; cA = nA; cB = nB; ++ui;
        if constexpr (ALIGN_EPI) { if (wr == 1) PG8_BAR; }
    }
    PG8_WAIT_V(0);
    if constexpr (!ALIGN_EPI) { if (wr == 0) PG8_BAR; }
    PG8_BAR;
    if constexpr (Epi::AFTER_DRAIN) { E.fused(acc, cur, wr, wc, fr, fq, lds, wid, lane); S.done(cur); }
#undef PG8_SA
#undef PG8_SB
#undef PG8_STAGE
#undef PG8_LDA
#undef PG8_LDB
#undef PG8_MMA
#undef PG8_WAIT_V
#undef PG8_WAIT_L
#undef PG8_BAR
#undef PG8_SCHED
}
}
namespace epi {
using pg8::Unit;
typedef f32x4 Acc[2][2][4][2];

__device__ __forceinline__ void rot2(f32x4& v, const f32x4 cs) {
    const float a1 = v[0] * cs[0] - v[1] * cs[1], a2 = v[1] * cs[0] + v[0] * cs[1];
    const float b1 = v[2] * cs[2] - v[3] * cs[3], b2 = v[3] * cs[2] + v[2] * cs[3];
    v = (f32x4){a1, a2, b1, b2};
}
__device__ __forceinline__ float sigm(float x) { return 1.0f / (1.0f + __expf(-x)); }
__device__ __forceinline__ void vmax_publish(unsigned* word, float mx) {
#pragma unroll
    for (int o = 1; o < 64; o <<= 1) mx = fmaxf(mx, __shfl_xor(mx, o));
    if ((threadIdx.x & 63) == 0) atomicMax(word, __float_as_uint(mx));
}
__device__ __forceinline__ float amax8(f32x4 a, f32x4 b) { return fmaxf(fmaxf(fmaxf(fabsf(a[0]), fabsf(a[1])), fmaxf(fabsf(a[2]), fabsf(a[3]))), fmaxf(fmaxf(fabsf(b[0]), fabsf(b[1])), fmaxf(fabsf(b[2]), fabsf(b[3])))); }
__device__ __forceinline__ float sat8(float x) { return fminf(fmaxf(x, -448.0f), 448.0f); }
__device__ __forceinline__ u32x2 pack8_fp8(f32x4 a, f32x4 b) {
    int p0 = 0, p1 = 0;
    p0 = __builtin_amdgcn_cvt_pk_fp8_f32(sat8(a[0]), sat8(a[1]), p0, false); p0 = __builtin_amdgcn_cvt_pk_fp8_f32(sat8(a[2]), sat8(a[3]), p0, true);
    p1 = __builtin_amdgcn_cvt_pk_fp8_f32(sat8(b[0]), sat8(b[1]), p1, false); p1 = __builtin_amdgcn_cvt_pk_fp8_f32(sat8(b[2]), sat8(b[3]), p1, true);
    return (u32x2){(unsigned)p0, (unsigned)p1};
}

template <bool F8> struct EpiIn {
    static constexpr bool PERM = true, AFTER_DRAIN = false, SPLITK2 = false, FP8 = F8;
    bf16_t *cq, *ckv, *qb, *kb, *vb, *qix, *kpe, *kix, *ga, *gb; float* wix; u64 *ssq_cq, *ssq_ckv;
    const float *ropeM, *ropeD, *ropeI;
    unsigned* vmaxw;
    const float *sx, *sw;
    __device__ __forceinline__ void operator()(const Acc& acc, const Unit& u, int wr, int wc, int fr, int fq) const {
        const int vt = F8 ? (u.pn < 18 ? u.pn : u.pn + 5) : u.pn + 18, rowb = u.pm * 256 + wr * 64 + fr, ct = wc * 32 + 8 * fq;
        f32x4 wsc[2][2];
        if (F8) {
#pragma unroll
            for (int bj = 0; bj < 2; ++bj) { const f32x4* p = (const f32x4*)(sw + u.pn * 256 + ct + bj * 128); wsc[bj][0] = p[0]; wsc[bj][1] = p[1]; }
        }
#define AV(ai_, bj_, m_, n_) (F8 ? acc[ai_][bj_][m_][n_] * rs * wsc[bj_][n_] : acc[ai_][bj_][m_][n_])
        if (vt < 6) {
            bf16_t* dst = vt < 4 ? cq : ckv; const int ld = vt < 4 ? 1024 : 512, cb = (vt < 4 ? vt : vt - 4) * 256 + ct; u64* ssq = vt < 4 ? ssq_cq : ssq_ckv;
#pragma unroll
            for (int ai = 0; ai < 2; ++ai)
#pragma unroll
                for (int m = 0; m < 4; ++m) { const int row = rowb + ai * 128 + m * 16; const float rs = F8 ? sx[row] : 1.f; (void)rs; float s = 0.f;
#pragma unroll
                    for (int bj = 0; bj < 2; ++bj) { const f32x4 v0 = AV(ai, bj, m, 0), v1 = AV(ai, bj, m, 1);
                        s += (v0[0] * v0[0] + v0[1] * v0[1]) + (v0[2] * v0[2] + v0[3] * v0[3]) + (v1[0] * v1[0] + v1[1] * v1[1]) + (v1[2] * v1[2] + v1[3] * v1[3]);
                        *(u32x2*)((unsigned char*)dst + (size_t)row * ld + cb + bj * 128) = pack8_fp8(v0, v1); }
                    s += __shfl_xor(s, 16); s += __shfl_xor(s, 32);
                    if (fq == 0 && ssq) ssq_add(ssq + row, s); }
        } else if (vt < 16) {
            const bool isq = vt < 14; bf16_t* dst = isq ? qb : kb; const int ld = isq ? 2048 : 512, cb = (isq ? vt - 6 : vt - 14) * 256 + ct;
#pragma unroll
            for (int ai = 0; ai < 2; ++ai)
#pragma unroll
                for (int m = 0; m < 4; ++m) { const int row = rowb + ai * 128 + m * 16, t = row_pos(row); const float rs = F8 ? sx[row] : 1.f; (void)rs;
                    f32x4 cs0 = (f32x4){1.f, 0.f, 1.f, 0.f}, cs1 = cs0;
                    if (wc == 0) { const f32x4* p = (const f32x4*)(ropeD + ((size_t)t * 16 + 4 * fq) * 2); cs0 = p[0]; cs1 = p[1]; }
#pragma unroll
                    for (int bj = 0; bj < 2; ++bj) { f32x4 v0 = AV(ai, bj, m, 0), v1 = AV(ai, bj, m, 1);
                        if (wc == 0) { rot2(v0, cs0); rot2(v1, cs1); }
                        *(u32x2*)((unsigned char*)dst + (size_t)row * ld + cb + bj * 128) = pack8_fp8(v0, v1); } }
        } else if (vt < 18) {
            const int cb = (vt - 16) * 256 + ct; float vmx = 0.f;
#pragma unroll
            for (int ai = 0; ai < 2; ++ai)
#pragma unroll
                for (int m = 0; m < 4; ++m) { const int row = rowb + ai * 128 + m * 16; const float rs = F8 ? sx[row] : 1.f; (void)rs;
#pragma unroll
                    for (int bj = 0; bj < 2; ++bj) { const f32x4 v0 = AV(ai, bj, m, 0), v1 = AV(ai, bj, m, 1); vmx = fmaxf(vmx, amax8(v0, v1)); *(u32x4*)(vb + (size_t)row * 512 + cb + bj * 128) = pack8(v0, v1); } }
            vmax_publish(vmaxw, vmx);
        } else if (vt < 22) {
            const int cb = (vt - 18) * 256 + ct; const bool rt = ((wc & 1) == 0) && (fq < 2);
#pragma unroll
            for (int ai = 0; ai < 2; ++ai)
#pragma unroll
                for (int m = 0; m < 4; ++m) { const int row = rowb + ai * 128 + m * 16, t = row_pos(row); const float rs = F8 ? sx[row] : 1.f; (void)rs;
                    f32x4 cs0 = (f32x4){1.f, 0.f, 1.f, 0.f}, cs1 = cs0;
                    if (rt) { const f32x4* p = (const f32x4*)(ropeI + ((size_t)t * 8 + 4 * fq) * 2); cs0 = p[0]; cs1 = p[1]; }
#pragma unroll
                    for (int bj = 0; bj < 2; ++bj) { f32x4 v0 = AV(ai, bj, m, 0), v1 = AV(ai, bj, m, 1);
                        if (rt) { rot2(v0, cs0); rot2(v1, cs1); }
                        *(u32x4*)(qix + (size_t)row * 1024 + cb + bj * 128) = pack8(v0, v1); } }
        } else if (vt == 22) {
#pragma unroll
            for (int ai = 0; ai < 2; ++ai)
#pragma unroll
                for (int m = 0; m < 4; ++m) { const int row = rowb + ai * 128 + m * 16, t = row_pos(row); const float rs = F8 ? sx[row] : 1.f; (void)rs;
                    f32x4 v0 = AV(ai, 0, m, 0), v1 = AV(ai, 0, m, 1);
                    if (wc < 2) { const f32x4* p = (const f32x4*)(ropeM + ((size_t)t * 32 + 16 * wc + 4 * fq) * 2); rot2(v0, p[0]); rot2(v1, p[1]);
                        *(u32x2*)((unsigned char*)kpe + (size_t)row * 64 + ct) = pack8_fp8(v0, v1);
                    } else { if (wc == 2 && fq < 2) { const f32x4* p = (const f32x4*)(ropeI + ((size_t)t * 8 + 4 * fq) * 2); rot2(v0, p[0]); rot2(v1, p[1]); }
                        *(u32x4*)(kix + (size_t)row * 64 + (ct - 64)) = pack8(v0, v1); }
                    if (wc == 0 && fq < 2) { float* w = wix + (size_t)row * 16 + 8 * fq; *(f32x4*)w = AV(ai, 1, m, 0); *(f32x4*)(w + 4) = AV(ai, 1, m, 1); } }
        } else {
            const bool isa = vt < 39; bf16_t* dst = isa ? ga : gb; const int cb = (isa ? vt - 23 : vt - 39) * 256 + ct;
#pragma unroll
            for (int ai = 0; ai < 2; ++ai)
#pragma unroll
                for (int m = 0; m < 4; ++m) { const int row = rowb + ai * 128 + m * 16; const float rs = F8 ? sx[row] : 1.f; (void)rs;
#pragma unroll
                    for (int bj = 0; bj < 2; ++bj) { f32x4 v0 = AV(ai, bj, m, 0), v1 = AV(ai, bj, m, 1);
#pragma unroll
                        for (int e = 0; e < 4; ++e) { v0[e] = sigm(v0[e]); v1[e] = sigm(v1[e]); }
                        *(u32x4*)(dst + (size_t)row * 4096 + cb + bj * 128) = pack8(v0, v1); } }
        }
#undef AV
    }
};

struct EpiUp {
    static constexpr bool PERM = true, AFTER_DRAIN = false, SPLITK2 = false, FP8 = true;
    unsigned char *d0, *d1; int nt0, ld0, ld1; bool d1_bf16; const u64* ssq; float invK; const float* rope; const float* sw; unsigned* vmaxw;
    __device__ __forceinline__ void operator()(const Acc& acc, const Unit& u, int wr, int wc, int fr, int fq) const {
        const int vt = u.pn, rowb = u.pm * 256 + wr * 64 + fr, ct = wc * 32 + 8 * fq; const bool first = vt < nt0;
        unsigned char* dst = first ? d0 : d1; const int ld = first ? ld0 : ld1, cb = (first ? vt : vt - nt0) * 256 + ct; const bool rt = (!first) && (rope != nullptr), wide = (!first) && d1_bf16;
        f32x4 w0[2], w1[2]; float vmx = 0.f;
#pragma unroll
        for (int bj = 0; bj < 2; ++bj) { const f32x4* p = (const f32x4*)(sw + vt * 256 + ct + bj * 128); w0[bj] = p[0]; w1[bj] = p[1]; }
#pragma unroll
        for (int ai = 0; ai < 2; ++ai)
#pragma unroll
            for (int m = 0; m < 4; ++m) { const int row = rowb + ai * 128 + m * 16, t = row_pos(row);
                const float rs = __builtin_amdgcn_rsqf(ssq_get(ssq + row) * invK + EPS);
                f32x4 cs0 = (f32x4){1.f, 0.f, 1.f, 0.f}, cs1 = cs0;
                if (rt) { const f32x4* p = (const f32x4*)(rope + ((size_t)t * 32 + 16 * (wc & 1) + 4 * fq) * 2); cs0 = p[0]; cs1 = p[1]; }
#pragma unroll
                for (int bj = 0; bj < 2; ++bj) { f32x4 v0 = acc[ai][bj][m][0] * rs * w0[bj], v1 = acc[ai][bj][m][1] * rs * w1[bj];
                    if (rt) { rot2(v0, cs0); rot2(v1, cs1); }
                    if (wide) { vmx = fmaxf(vmx, amax8(v0, v1)); *(u32x4*)(dst + (size_t)row * ld + (size_t)(cb + bj * 128) * 2) = pack8(v0, v1); }
                    else *(u32x2*)(dst + (size_t)row * ld + cb + bj * 128) = pack8_fp8(v0, v1); } }
        if (wide) vmax_publish(vmaxw, vmx);
    }
};

struct EpiBranch {
    static constexpr bool PERM = true, AFTER_DRAIN = false, SPLITK2 = true, FP8 = true;
    const bf16_t *ga, *gb; bf16_t* out; const unsigned* vmaxw; const float* scol;
    __device__ __forceinline__ void operator()(Acc& acc, const Unit& u, int wr, int wc, int fr, int fq) const {
        const int rowb = u.pm * 256 + wr * 64 + fr, cb = u.pn * 256 + wc * 32 + 8 * fq;
        const float vmb = fmaxf(__uint_as_float(vmaxw[0]), 1e-30f), vma = fmaxf(__uint_as_float(vmaxw[64]), 1e-30f);
        if (u.kh == 0) {
            const float rab = vma * __builtin_amdgcn_rcpf(vmb);
#pragma unroll
            for (int ai = 0; ai < 2; ++ai)
#pragma unroll
                for (int m = 0; m < 4; ++m) { const size_t ro = (size_t)(rowb + ai * 128 + m * 16) * 4096 + cb;
#pragma unroll
                    for (int bj = 0; bj < 2; ++bj) { const u32x4 a = *(const u32x4*)(ga + ro + bj * 128), b = *(const u32x4*)(gb + ro + bj * 128);
                        f32x4 r0, r1;
#define RQ(x, y) ((x) * __builtin_amdgcn_rcpf(y))
                        r0[0] = RQ(bf_lo(a.x), bf_lo(b.x)); r0[1] = RQ(bf_hi(a.x), bf_hi(b.x)); r0[2] = RQ(bf_lo(a.y), bf_lo(b.y)); r0[3] = RQ(bf_hi(a.y), bf_hi(b.y));
                        r1[0] = RQ(bf_lo(a.z), bf_lo(b.z)); r1[1] = RQ(bf_hi(a.z), bf_hi(b.z)); r1[2] = RQ(bf_lo(a.w), bf_lo(b.w)); r1[3] = RQ(bf_hi(a.w), bf_hi(b.w));
#undef RQ
                        acc[ai][bj][m][0] = acc[ai][bj][m][0] * (r0 * rab); acc[ai][bj][m][1] = acc[ai][bj][m][1] * (r1 * rab); }
                    asm volatile("" ::: "memory"); }
        } else {
            f32x4 w0[2], w1[2];
#pragma unroll
            for (int bj = 0; bj < 2; ++bj) { const f32x4* p = (const f32x4*)(scol + cb + bj * 128); w0[bj] = p[0]; w1[bj] = p[1]; }
#pragma unroll
            for (int ai = 0; ai < 2; ++ai)
#pragma unroll
                for (int m = 0; m < 4; ++m) { const int row = rowb + ai * 128 + m * 16; const size_t ro = (size_t)row * 4096 + cb; const float rs = vmb * (1.0f / 440.0f);
#pragma unroll
                    for (int bj = 0; bj < 2; ++bj) { const u32x4 b = *(const u32x4*)(gb + ro + bj * 128);
                        const f32x4 s0 = (f32x4){bf_lo(b.x), bf_hi(b.x), bf_lo(b.y), bf_hi(b.y)} * rs * w0[bj], s1 = (f32x4){bf_lo(b.z), bf_hi(b.z), bf_lo(b.w), bf_hi(b.w)} * rs * w1[bj];
                        *(u32x4*)(out + ro + bj * 128) = pack8(acc[ai][bj][m][0] * s0, acc[ai][bj][m][1] * s1); } }
        }
    }
};

struct EpiOut {
    static constexpr bool PERM = true, AFTER_DRAIN = false, SPLITK2 = false, FP8 = true;
    const float *x, *meta; float* h1f; bf16_t* h1b; u64* ssq; const float *srow, *scol;
    __device__ __forceinline__ void operator()(const Acc& acc, const Unit& u, int wr, int wc, int fr, int fq) const {
        const int rowb = u.pm * 256 + wr * 64 + fr, cb = u.pn * 256 + wc * 32 + 8 * fq;
#pragma unroll
        for (int ai = 0; ai < 2; ++ai)
#pragma unroll
            for (int m = 0; m < 4; ++m) { const int row = rowb + ai * 128 + m * 16;
                const float* src = x + (size_t)row * DM;
                float s = 0.f; const float rs = srow[row];
#pragma unroll
                for (int bj = 0; bj < 2; ++bj) { const f32x4* wp = (const f32x4*)(scol + cb + bj * 128); f32x4 v0 = acc[ai][bj][m][0] * rs * wp[0], v1 = acc[ai][bj][m][1] * rs * wp[1];
                    v0 = v0 + *(const f32x4*)(src + cb + bj * 128); v1 = v1 + *(const f32x4*)(src + cb + bj * 128 + 4);
                    s += (v0[0] * v0[0] + v0[1] * v0[1]) + (v0[2] * v0[2] + v0[3] * v0[3]) + (v1[0] * v1[0] + v1[1] * v1[1]) + (v1[2] * v1[2] + v1[3] * v1[3]);
                    *(u32x4*)(h1b + (size_t)row * DM + cb + bj * 128) = pack8(v0, v1); }
                s += __shfl_xor(s, 16); s += __shfl_xor(s, 32);
                if (fq == 0 && ssq) ssq_add(ssq + row, s); }
    }
};

struct EpiPQ {
    static constexpr bool PERM = true, AFTER_DRAIN = false, SPLITK2 = false, FP8 = false;
    bf16_t* pq; const u64* ssq;
    __device__ __forceinline__ void operator()(const Acc& acc, const Unit& u, int wr, int wc, int fr, int fq) const {
        const int rowb = u.pm * 256 + wr * 64 + fr, cb = u.pn * 256 + wc * 32 + 8 * fq;
#pragma unroll
        for (int ai = 0; ai < 2; ++ai)
#pragma unroll
            for (int m = 0; m < 4; ++m) { const int row = rowb + ai * 128 + m * 16; const float rs = __builtin_amdgcn_rsqf(ssq_get(ssq + row) * (1.0f / DM) + EPS);
#pragma unroll
                for (int bj = 0; bj < 2; ++bj) *(u32x4*)(pq + (size_t)row * 2048 + cb + bj * 128) = pack8(acc[ai][bj][m][0] * rs, acc[ai][bj][m][1] * rs); }
    }
};
}
#define XB_TMO      128
#define XB_XCNT(j)  (256  + 64 * (j))
#define XB_XSUB(j)  (1280 + 64 * (j))
#define XB_XGEN(j)  (2304 + 64 * (j))
#define XB_TOP      3328
#define XB_TOPGEN   3392
#define XCD_BAR_WORDS 3456
#define XB_SPIN_CAP (1u << 18)
__device__ __forceinline__ unsigned xb_ld(unsigned* p)              { return __hip_atomic_load(p, __ATOMIC_RELAXED, __HIP_MEMORY_SCOPE_AGENT); }
__device__ __forceinline__ unsigned xb_add(unsigned* p, unsigned v) { return __hip_atomic_fetch_add(p, v, __ATOMIC_RELAXED, __HIP_MEMORY_SCOPE_AGENT); }
__device__ __forceinline__ unsigned xb_xcc_id() { return (unsigned)__builtin_amdgcn_s_getreg((3 << 11) | 20) & 0xFu; }
#define XB_SPIN(cond, bar) do { unsigned _sp = 0; while (cond) { __builtin_amdgcn_s_sleep(1); \
    if ((++_sp & 255u) == 0u) { if (xb_ld(&(bar)[XB_TMO])) break; if (_sp > XB_SPIN_CAP) { atomicAdd(&(bar)[XB_TMO], 1u); break; } } } } while (0)
struct XcdBarrier { unsigned* bar; unsigned x; volatile LAS unsigned* st; };
__device__ __forceinline__ XcdBarrier xcd_barrier_post(unsigned* bar, volatile LAS unsigned* st) {
    XcdBarrier b; b.bar = bar; b.x = xb_xcc_id(); b.st = st;
    if (threadIdx.x == 0) (void)xb_add(&bar[XB_XCNT(b.x)], 1u);
    return b;
}
__device__ __forceinline__ void xcd_barrier_complete(unsigned* bar, unsigned x, unsigned& nloc, unsigned& nx) {
    const unsigned G = gridDim.x * gridDim.y * gridDim.z;
    unsigned sum, cnt, mine, sp = 0u;
    for (;;) {
        sum = 0u; cnt = 0u; mine = 0u;
#pragma unroll
        for (unsigned j = 0; j < 16; ++j) { const unsigned c = xb_ld(&bar[XB_XCNT(j)]); sum += c; cnt += (c > 0u) ? 1u : 0u; mine = (j == x) ? c : mine; }
        if (sum == G) break;
        __builtin_amdgcn_s_sleep(1);
        if ((++sp & 255u) == 0u) { if (xb_ld(&bar[XB_TMO])) break; if (sp > XB_SPIN_CAP) { atomicAdd(&bar[XB_TMO], 1u); break; } }
    }
    nloc = mine > 0u ? mine : 1u; nx = cnt > 0u ? cnt : 1u;
}
__device__ __forceinline__ void xcd_barrier(const XcdBarrier& b) {
    asm volatile("s_waitcnt vmcnt(0)" ::: "memory");
    __syncthreads();
    if (threadIdx.x == 0) {
        unsigned* bar = b.bar;
        __builtin_amdgcn_s_waitcnt(0);
        unsigned nloc = b.st[0], nx = b.st[1];
        if (nloc == 0u) { xcd_barrier_complete(bar, b.x, nloc, nx); b.st[0] = nloc; b.st[1] = nx; }
        const unsigned old = xb_add(&bar[XB_XSUB(b.x)], 1u);
        const unsigned gen = old / nloc;
        if (old + 1u == (gen + 1u) * nloc) {
            __builtin_amdgcn_fence(__ATOMIC_RELEASE, "agent");
            asm volatile("s_waitcnt vmcnt(0)" ::: "memory");
            const unsigned og = xb_add(&bar[XB_TOP], 1u);
            const unsigned tg = og / nx;
            if (og + 1u == (tg + 1u) * nx) xb_add(&bar[XB_TOPGEN], 1u);
            else XB_SPIN(xb_ld(&bar[XB_TOPGEN]) == tg, bar);
            __builtin_amdgcn_fence(__ATOMIC_ACQUIRE, "agent");
            xb_add(&bar[XB_XGEN(b.x)], 1u);
            asm volatile("s_waitcnt vmcnt(0)" ::: "memory");
        } else {
            XB_SPIN(xb_ld(&bar[XB_XGEN(b.x)]) == gen, bar);
            __builtin_amdgcn_fence(__ATOMIC_ACQUIRE, "agent");
            asm volatile("s_waitcnt vmcnt(0)" ::: "memory");
        }
    }
    __syncthreads();
}

struct Frame {
    LAS unsigned char* lds;
    unsigned char* ws;
    unsigned* ctl;
    int tid, lane, wave, vcu, G;
    __device__ __forceinline__ const float* in(int i) const { return ((const float* const __attribute__((address_space(4)))*)__builtin_amdgcn_kernarg_segment_ptr())[i]; }
    __device__ __forceinline__ float* out() const { return ((float* const __attribute__((address_space(4)))*)__builtin_amdgcn_kernarg_segment_ptr())[16]; }
};

struct MapId { __device__ __forceinline__ int operator()(int v) const { return v; } };
struct MapIn { __device__ __forceinline__ int operator()(int vn) const {
    const int v = vn < 1280 ? vn + 4608 : (vn < 5888 ? vn - 1280 : vn);
    if (v < 1536) return v;
    if (v < 3584) { const int w = v - 1536, hd = w >> 7; int o = w & 127; if (o < 32) o = (o & 1) ? (o >> 1) + 16 : (o >> 1); return 1600 + hd * 128 + o; }
    if (v < 4096) { const int w = v - 3584, hd = w >> 7; int o = w & 127; if (o < 32) o = (o & 1) ? (o >> 1) + 16 : (o >> 1); return 3648 + hd * 128 + o; }
    if (v < 4608) return 4160 + (v - 4096);
    if (v < 5632) { const int w = v - 4608, hd = w >> 6; int o = w & 63; if (o < 16) o = (o & 1) ? (o >> 1) + 8 : (o >> 1); return 4672 + hd * 64 + o; }
    if (v < 5888) { const int w = v - 5632;
        if (w < 64) return 1536 + ((w & 1) ? (w >> 1) + 32 : (w >> 1));
        if (w < 128) { int o = w - 64; if (o < 16) o = (o & 1) ? (o >> 1) + 8 : (o >> 1); return 5696 + o; }
        if (w < 144) return 5760 + (w - 128);
        return -1; }
    if (v < 9984) return 5776 + (v - 5888);
    return 9872 + (v - 9984);
} };
struct MapUq { __device__ __forceinline__ int operator()(int v) const {
    if (v < 2048) return (v >> 7) * 192 + (v & 127);
    const int w = v - 2048, hd = w >> 6, o = w & 63; return hd * 192 + 128 + ((o & 1) ? (o >> 1) + 32 : (o >> 1)); } };
struct MapUkv { __device__ __forceinline__ int operator()(int v) const {
    if (v < 2048) return (v >> 7) * 256 + (v & 127);
    const int w = v - 2048; return (w >> 7) * 256 + 128 + (w & 127); } };

template <class Map>
__device__ __forceinline__ void p0_transpose_item(const float* W, int K, int Nsrc, int Nvirt, bf16_t* WT, const float* gk, LAS float* scr, int item, int lane, Map map) {
    const int nblk = Nvirt / 32, kb = item / nblk, nb = item % nblk, k0 = 64 * kb, n0 = 32 * nb;
    const int sc = map(n0 + (lane & 31));
    float tv[32];
#pragma unroll
    for (int i = 0; i < 32; ++i) { const int kk = 2 * i + (lane >> 5); tv[i] = (sc >= 0) ? W[(size_t)(k0 + kk) * Nsrc + sc] : 0.f; }
    if (gk) {
#pragma unroll
        for (int i = 0; i < 32; ++i) tv[i] *= gk[k0 + 2 * i + (lane >> 5)]; }
#pragma unroll
    for (int i = 0; i < 32; ++i) scr[(2 * i + (lane >> 5)) * 33 + (lane & 31)] = tv[i];
    LDS_WAIT(); asm volatile("" ::: "memory");
    const int c = lane & 7;
#pragma unroll
    for (int j = 0; j < 4; ++j) { const int n = (lane >> 3) + 8 * j; const LAS float* s = scr + (8 * c) * 33 + n;
        u32x4 o; o.x = pk2(s[0 * 33], s[1 * 33]); o.y = pk2(s[2 * 33], s[3 * 33]); o.z = pk2(s[4 * 33], s[5 * 33]); o.w = pk2(s[6 * 33], s[7 * 33]);
        *(u32x4*)(WT + (size_t)(n0 + n) * K + k0 + 8 * c) = o; }
    LDS_WAIT(); asm volatile("" ::: "memory");
}
__device__ __forceinline__ float wave_max(float v) {
#pragma unroll
    for (int o = 1; o < 64; o <<= 1) v = fmaxf(v, __shfl_xor(v, o));
    return v;
}
__device__ __forceinline__ void p0_xn_row(const Frame& F, int m) {
    const float* x = F.in(0); const float* meta = F.in(1); const float* g = F.in(2);
    bf16_t* o = (bf16_t*)(F.ws + WS_XN) + (size_t)m * DM;
    u32x2* o8 = (u32x2*)o + F.lane;
    if (m >= NTOK + NMETA) {
        unsigned* z8 = (unsigned*)(F.ws + WS_XN8 + (size_t)m * DM) + F.lane;
#pragma unroll
        for (int j = 0; j < 16; ++j) { o8[64 * j] = (u32x2){0u, 0u}; z8[64 * j] = 0u; }
        if (F.lane == 0) ((float*)(F.ws + WS_SX))[m] = 0.f;
        return; }
    const float* src = m < NTOK ? x + (size_t)m * DM : meta + (size_t)(m - NTOK) * DM;
    const f32x4* xr = (const f32x4*)src + F.lane; const f32x4* gr = (const f32x4*)g + F.lane;
    f32x4 v[16]; float s = 0.f;
#pragma unroll
    for (int j = 0; j < 16; ++j) { v[j] = xr[64 * j]; s += (v[j][0] * v[j][0] + v[j][1] * v[j][1]) + (v[j][2] * v[j][2] + v[j][3] * v[j][3]); }
    const float rstd = 1.0f / sqrtf(wave_sum(s) * (1.0f / DM) + EPS);
    float mx = 0.f;
#pragma unroll
    for (int j = 0; j < 16; ++j) { const f32x4 gg = gr[64 * j]; v[j] = v[j] * rstd * gg; o8[64 * j] = (u32x2){pk2(v[j][0], v[j][1]), pk2(v[j][2], v[j][3])};
        mx = fmaxf(mx, fmaxf(fmaxf(fabsf(v[j][0]), fabsf(v[j][1])), fmaxf(fabsf(v[j][2]), fabsf(v[j][3])))); }
    mx = fmaxf(wave_max(mx), 1e-30f);
    const float inv = 448.0f / mx;
    if (F.lane == 0) ((float*)(F.ws + WS_SX))[m] = mx * (1.0f / 448.0f);
    unsigned* q8 = (unsigned*)(F.ws + WS_XN8 + (size_t)m * DM) + F.lane;
#pragma unroll
    for (int j = 0; j < 16; ++j) { f32x4 q = v[j] * inv;
#pragma unroll
        for (int e = 0; e < 4; ++e) q[e] = fminf(fmaxf(q[e], -448.0f), 448.0f);
        int p = 0; p = __builtin_amdgcn_cvt_pk_fp8_f32(q[0], q[1], p, false); p = __builtin_amdgcn_cvt_pk_fp8_f32(q[2], q[3], p, true); q8[64 * j] = (unsigned)p; }
}
__device__ __forceinline__ void p0_prologue(const Frame& F) {
    LAS float* scr = (LAS float*)(F.lds + F.wave * 16384);
    const int gw = F.vcu * NWAVES + F.wave, NGW = F.G * NWAVES;
    const float* w_in = F.in(3); const float* qg = F.in(4); const float* w_uq = F.in(5); const float* kvg = F.in(6); const float* w_ukv = F.in(7);
    const float* w_br = F.in(8); const float* w_out = F.in(9); const float* fg = F.in(10); const float* w_q = F.in(11); const float* sk = F.in(12);
    constexpr int I_IN = 64 * (NV1 / 32), I_UQ = 16 * (3072 / 32), I_UKV = 8 * (4096 / 32), I_BR = 64 * 128, I_OUT = 64 * 128, I_Q = 64 * 64;
    constexpr int NITEMS = I_IN + I_UQ + I_UKV + I_BR + I_OUT + I_Q;
    for (int it = gw; it < NITEMS; it += NGW) {
        int r = it;
        if (r < I_IN) { p0_transpose_item(w_in, 4096, 13968, NV1, (bf16_t*)(F.ws + WS_WIN), nullptr, scr, r, F.lane, MapIn()); continue; } r -= I_IN;
        if (r < I_UQ) { p0_transpose_item(w_uq, 1024, 3072, 3072, (bf16_t*)(F.ws + WS_WUQ), qg, scr, r, F.lane, MapUq()); continue; } r -= I_UQ;
        if (r < I_UKV) { p0_transpose_item(w_ukv, 512, 4096, 4096, (bf16_t*)(F.ws + WS_WUKV), kvg, scr, r, F.lane, MapUkv()); continue; } r -= I_UKV;
        if (r < I_BR) { p0_transpose_item(w_br, 4096, 4096, 4096, (bf16_t*)(F.ws + WS_H1F), nullptr, scr, r, F.lane, MapId()); continue; } r -= I_BR;
        if (r < I_OUT) { p0_transpose_item(w_out, 4096, 4096, 4096, (bf16_t*)(F.ws + WS_WOUT), nullptr, scr, r, F.lane, MapId()); continue; } r -= I_OUT;
        p0_transpose_item(w_q, 4096, 2048, 2048, (bf16_t*)(F.ws + WS_WQ), fg, scr, r, F.lane, MapId());
    }
    for (int m = gw; m < MK; m += NGW) p0_xn_row(F, m);
    const int gt = (F.vcu * NWAVES + F.wave) * 64 + F.lane, NGT = NGW * 64;
    for (int i = gt; i < TP * 56; i += NGT) {
        const int t = i / 56, r = i % 56; int j, rot; float* dst;
        if (r < 32) { j = r; rot = 64; dst = (float*)(F.ws + WS_ROPE_M) + ((size_t)t * 32 + j) * 2; }
        else if (r < 48) { j = r - 32; rot = 32; dst = (float*)(F.ws + WS_ROPE_D) + ((size_t)t * 16 + j) * 2; }
        else { j = r - 48; rot = 16; dst = (float*)(F.ws + WS_ROPE_I) + ((size_t)t * 8 + j) * 2; }
        const float ex = (float)(2 * j) / (float)rot;
        const float inv = powf(500000.0f, -ex);
        const float ang = (float)t * inv;
        const double a = (double)ang, kq = rint(a * 0.15915494309189535), rr = fma(-kq, 6.283185307179586, a);
        const float rf = (float)rr;
        dst[0] = cosf(rf); dst[1] = sinf(rf);
    }
    for (int i = gt; i < 16 * 128 * 128 / 8; i += NGT) { const f32x4* s = (const f32x4*)sk + 2 * (size_t)i; const f32x4 a = s[0], b2 = s[1];
        u32x4 o; o.x = pk2(a[0], a[1]); o.y = pk2(a[2], a[3]); o.z = pk2(b2[0], b2[1]); o.w = pk2(b2[2], b2[3]); ((u32x4*)(F.ws + WS_SK))[i] = o; }
}
__device__ __forceinline__ unsigned fp6_code(float q) {
    const unsigned b = __float_as_uint(q), sgn = (b >> 31) << 5; const float aq = fabsf(q);
    const unsigned sub = (unsigned)rintf(aq * 8.0f);
    unsigned ab = b & 0x7fffffffu; ab = ab + 0x7FFFFu + ((ab >> 20) & 1u);
    const unsigned nrm = (ab >> 20) - (126u << 3);
    unsigned code = aq < 1.0f ? sub : nrm; code = code > 31u ? 31u : code;
    return code | sgn;
}
__device__ __forceinline__ void fp6_pack32(const unsigned (&c)[32], unsigned (&w)[6]) {
#pragma unroll
    for (int i = 0; i < 6; ++i) w[i] = 0u;
#pragma unroll
    for (int k = 0; k < 32; ++k) { const int bit = 6 * k, d = bit >> 5, sh = bit & 31; w[d] |= c[k] << sh; if (sh > 26) w[d + 1] |= c[k] >> (32 - sh); }
}
__device__ __forceinline__ void p6_quant_row(const float* src, const float* gain, unsigned char* dst, float* scale_out, int lane) {
    const f32x4* s = (const f32x4*)src + lane; f32x4 v[16]; float mx = 0.f;
#pragma unroll
    for (int j = 0; j < 16; ++j) { v[j] = s[64 * j]; if (gain) v[j] = v[j] * ((const f32x4*)gain)[lane + 64 * j];
        mx = fmaxf(mx, fmaxf(fmaxf(fabsf(v[j][0]), fabsf(v[j][1])), fmaxf(fabsf(v[j][2]), fabsf(v[j][3])))); }
    mx = fmaxf(wave_max(mx), 1e-30f);
    const float sc = mx * (1.0f / 7.5f), inv = 7.5f / mx;
    if (lane == 0) *scale_out = sc;
    unsigned w[12];
#pragma unroll
    for (int g = 0; g < 2; ++g) { unsigned c[32];
#pragma unroll
        for (int j = 0; j < 8; ++j)
#pragma unroll
            for (int i = 0; i < 4; ++i) c[4 * j + i] = fp6_code(v[8 * g + j][i] * inv);
        unsigned ww[6]; fp6_pack32(c, ww);
#pragma unroll
        for (int i = 0; i < 6; ++i) w[6 * g + i] = ww[i]; }
#pragma unroll
    for (int q = 0; q < 3; ++q) *(u32x4*)(dst + 1024 * q + 16 * lane) = (u32x4){w[4 * q], w[4 * q + 1], w[4 * q + 2], w[4 * q + 3]};
}
__device__ __forceinline__ unsigned fp4_code(float q) {
    const float aq = fabsf(q);
    const unsigned c = (aq > 0.25f ? 1u : 0u) + (aq >= 0.75f ? 1u : 0u) + (aq > 1.25f ? 1u : 0u) + (aq >= 1.75f ? 1u : 0u) + (aq > 2.5f ? 1u : 0u) + (aq >= 3.5f ? 1u : 0u) + (aq > 5.0f ? 1u : 0u);
    return c | ((__float_as_uint(q) >> 31) << 3);
}
__device__ __forceinline__ void p6_quant_row4(const float* src, const float* gain, unsigned char* dst, float* scale_out, int lane) {
    const f32x4* s = (const f32x4*)src + lane; f32x4 v[16]; float mx = 0.f;
#pragma unroll
    for (int j = 0; j < 16; ++j) { v[j] = s[64 * j]; if (gain) v[j] = v[j] * ((const f32x4*)gain)[lane + 64 * j];
        mx = fmaxf(mx, fmaxf(fmaxf(fabsf(v[j][0]), fabsf(v[j][1])), fmaxf(fabsf(v[j][2]), fabsf(v[j][3])))); }
    mx = fmaxf(wave_max(mx), 1e-30f);
    const float sc = mx * (1.0f / 6.0f), inv = 6.0f / mx;
    if (lane == 0) *scale_out = sc;
    unsigned w[8];
#pragma unroll
    for (int d = 0; d < 8; ++d) { unsigned x = 0u;
#pragma unroll
        for (int i = 0; i < 4; ++i) { x |= fp4_code(v[2 * d][i] * inv) << (4 * i); x |= fp4_code(v[2 * d + 1][i] * inv) << (16 + 4 * i); }
        w[d] = x; }
#pragma unroll
    for (int q = 0; q < 2; ++q) *(u32x4*)(dst + 1024 * q + 16 * lane) = (u32x4){w[4 * q], w[4 * q + 1], w[4 * q + 2], w[4 * q + 3]};
}
#ifndef PEER_U_BITS
#define PEER_U_BITS 4
#endif
#ifndef PEER_V_BITS
#define PEER_V_BITS 4
#endif
constexpr int PEER_U_ROWB = PEER_U_BITS == 4 ? 2048 : 3072, PEER_V_ROWB = PEER_V_BITS == 4 ? 2048 : 3072;
__device__ __forceinline__ void p6_quant_regs4(f32x4 (&v)[16], unsigned char* dst, float* scale_out, int lane) {
    float mx = 0.f;
#pragma unroll
    for (int j = 0; j < 16; ++j) mx = fmaxf(mx, fmaxf(fmaxf(fabsf(v[j][0]), fabsf(v[j][1])), fmaxf(fabsf(v[j][2]), fabsf(v[j][3]))));
    mx = fmaxf(wave_max(mx), 1e-30f);
    const float inv = 6.0f / mx;
    if (lane == 0) *scale_out = mx * (1.0f / 6.0f);
    unsigned w[8];
#pragma unroll
    for (int d = 0; d < 8; ++d) { unsigned x = 0u;
#pragma unroll
        for (int i = 0; i < 4; ++i) { x |= fp4_code(v[2 * d][i] * inv) << (4 * i); x |= fp4_code(v[2 * d + 1][i] * inv) << (16 + 4 * i); }
        w[d] = x; }
#pragma unroll
    for (int q = 0; q < 2; ++q) *(u32x4*)(dst + 1024 * q + 16 * lane) = (u32x4){w[4 * q], w[4 * q + 1], w[4 * q + 2], w[4 * q + 3]};
}
__device__ __forceinline__ void p6_tables(const Frame& F) {
    const float* fg = F.in(10); const float* pu = F.in(13); const float* pv = F.in(14);
    const int gw = F.vcu * NWAVES + F.wave, NGW = F.G * NWAVES, lane = F.lane;
#if PEER_U_BITS == 4 && PEER_V_BITS == 4
    if ((NGW & 1) == 0) {
        const bool isv = gw & 1; const float* tab = isv ? pv : pu; unsigned char* dtab = F.ws + (isv ? WS_V : WS_U); float* stab = (float*)(F.ws + (isv ? WS_SCV : WS_SCU));
        const int e0 = gw >> 1, estep = NGW >> 1;
        f32x4 g[16];
#pragma unroll
        for (int j = 0; j < 16; ++j) g[j] = isv ? (f32x4){1.f, 1.f, 1.f, 1.f} : ((const f32x4*)fg)[lane + 64 * j];
        f32x4 va[16], vb[16];
        if (e0 < 16384) {
#pragma unroll
            for (int j = 0; j < 16; ++j) va[j] = ((const f32x4*)(tab + (size_t)e0 * DM))[lane + 64 * j];
        }
#pragma unroll 1
        for (int e = e0; e < 16384; e += 2 * estep) {
            const int e1 = e + estep, e2 = e + 2 * estep;
            if (e1 < 16384) {
#pragma unroll
                for (int j = 0; j < 16; ++j) vb[j] = ((const f32x4*)(tab + (size_t)e1 * DM))[lane + 64 * j];
            }
#pragma unroll
            for (int j = 0; j < 16; ++j) va[j] = va[j] * g[j];
            p6_quant_regs4(va, dtab + (size_t)e * 2048, stab + e, lane);
            if (e2 < 16384) {
#pragma unroll
                for (int j = 0; j < 16; ++j) va[j] = ((const f32x4*)(tab + (size_t)e2 * DM))[lane + 64 * j];
            }
            if (e1 < 16384) {
#pragma unroll
                for (int j = 0; j < 16; ++j) vb[j] = vb[j] * g[j];
                p6_quant_regs4(vb, dtab + (size_t)e1 * 2048, stab + e1, lane);
            }
        }
        return;
    }
#endif
    for (int it = gw; it < 2 * 16384; it += NGW) { const int e = it >> 1;
        if (it & 1) { if (PEER_V_BITS == 4) p6_quant_row4(pv + (size_t)e * DM, nullptr, F.ws + WS_V + (size_t)e * PEER_V_ROWB, (float*)(F.ws + WS_SCV) + e, F.lane);
                      else p6_quant_row(pv + (size_t)e * DM, nullptr, F.ws + WS_V + (size_t)e * PEER_V_ROWB, (float*)(F.ws + WS_SCV) + e, F.lane); }
        else { if (PEER_U_BITS == 4) p6_quant_row4(pu + (size_t)e * DM, fg, F.ws + WS_U + (size_t)e * PEER_U_ROWB, (float*)(F.ws + WS_SCU) + e, F.lane);
               else p6_quant_row(pu + (size_t)e * DM, fg, F.ws + WS_U + (size_t)e * PEER_U_ROWB, (float*)(F.ws + WS_SCU) + e, F.lane); } }
}

__device__ __forceinline__ void rowquant_fp8(const Frame& F, const unsigned char* src, size_t src_pitch, unsigned char* dst, size_t dst_pitch, float* scale, int nrows) {
    const int gw = F.vcu * NWAVES + F.wave, NGW = F.G * NWAVES, lane = F.lane;
    for (int n = gw; n < nrows; n += NGW) {
        const u32x4* s = (const u32x4*)(src + (size_t)n * src_pitch) + lane;
        u32x4 v[8]; float mx = 0.f;
#pragma unroll
        for (int j = 0; j < 8; ++j) { v[j] = s[64 * j];
#pragma unroll
            for (int e = 0; e < 4; ++e) mx = fmaxf(mx, fmaxf(fabsf(bf_lo(v[j][e])), fabsf(bf_hi(v[j][e])))); }
        mx = fmaxf(wave_max(mx), 1e-30f);
        const float inv = 448.0f / mx;
        if (lane == 0) scale[n] = mx * (1.0f / 448.0f);
        asm volatile("" ::: "memory");
        u32x2* d = (u32x2*)(dst + (size_t)n * dst_pitch) + lane;
#pragma unroll
        for (int j = 0; j < 8; ++j) { int p0 = 0, p1 = 0;
            p0 = __builtin_amdgcn_cvt_pk_fp8_f32(bf_lo(v[j].x) * inv, bf_hi(v[j].x) * inv, p0, false); p0 = __builtin_amdgcn_cvt_pk_fp8_f32(bf_lo(v[j].y) * inv, bf_hi(v[j].y) * inv, p0, true);
            p1 = __builtin_amdgcn_cvt_pk_fp8_f32(bf_lo(v[j].z) * inv, bf_hi(v[j].z) * inv, p1, false); p1 = __builtin_amdgcn_cvt_pk_fp8_f32(bf_lo(v[j].w) * inv, bf_hi(v[j].w) * inv, p1, true);
            d[64 * j] = (u32x2){(unsigned)p0, (unsigned)p1}; }
    }
}
template <int LEN>
__device__ __forceinline__ void rowquant_fp8_n(const Frame& F, const unsigned char* src, unsigned char* dst, float* scale, int nrows) {
    const int gw = F.vcu * NWAVES + F.wave, NGW = F.G * NWAVES, lane = F.lane; constexpr int PER = LEN / 64;
    for (int n = gw; n < nrows; n += NGW) {
        const u32x4* s = (const u32x4*)(src + (size_t)n * LEN * 2) + lane * (PER / 8);
        u32x4 v[PER / 8]; float mx = 0.f;
#pragma unroll
        for (int j = 0; j < PER / 8; ++j) { v[j] = s[j];
#pragma unroll
            for (int e = 0; e < 4; ++e) mx = fmaxf(mx, fmaxf(fabsf(bf_lo(v[j][e])), fabsf(bf_hi(v[j][e])))); }
        mx = fmaxf(wave_max(mx), 1e-30f);
        const float inv = 448.0f / mx;
        if (lane == 0) scale[n] = mx * (1.0f / 448.0f);
        u32x2* d = (u32x2*)(dst + (size_t)n * LEN) + lane * (PER / 8);
#pragma unroll
        for (int j = 0; j < PER / 8; ++j) { int p0 = 0, p1 = 0;
            p0 = __builtin_amdgcn_cvt_pk_fp8_f32(bf_lo(v[j].x) * inv, bf_hi(v[j].x) * inv, p0, false); p0 = __builtin_amdgcn_cvt_pk_fp8_f32(bf_lo(v[j].y) * inv, bf_hi(v[j].y) * inv, p0, true);
            p1 = __builtin_amdgcn_cvt_pk_fp8_f32(bf_lo(v[j].z) * inv, bf_hi(v[j].z) * inv, p1, false); p1 = __builtin_amdgcn_cvt_pk_fp8_f32(bf_lo(v[j].w) * inv, bf_hi(v[j].w) * inv, p1, true);
            d[j] = (u32x2){(unsigned)p0, (unsigned)p1}; }
    }
}
__device__ __forceinline__ void p1_quant_weights(const Frame& F) {
    rowquant_fp8(F, F.ws + WS_WIN + (size_t)1280 * DM * 2, (size_t)DM * 2, F.ws + WS_WG8, (size_t)DM, (float*)(F.ws + WS_SW), 12800);
    rowquant_fp8(F, F.ws + WS_H1F, (size_t)DM * 2, F.ws + WS_WBR, (size_t)DM, (float*)(F.ws + WS_SWBR), 4096);
    rowquant_fp8(F, F.ws + WS_WOUT, (size_t)DM * 2, F.ws + WS_WOUT, (size_t)DM * 2, (float*)(F.ws + WS_SWOUT), 4096);
    rowquant_fp8_n<1024>(F, F.ws + WS_WUQ, F.ws + WS_WUQ8, (float*)(F.ws + WS_SWUQ), 3072);
    rowquant_fp8_n<512>(F, F.ws + WS_WUKV, F.ws + WS_WUKV8, (float*)(F.ws + WS_SWUKV), 4096);
}
#define MFMA32(a, b, c) __builtin_amdgcn_mfma_f32_32x32x16_bf16((a), (b), (c), 0, 0, 0)
__device__ __forceinline__ float relu_i(float x) { const int v = __float_as_int(x); return __int_as_float(v > 0 ? v : 0); }
__device__ __forceinline__ int crow(int i, int h) { return (i & 3) + 8 * (i >> 2) + 4 * h; }
__device__ __forceinline__ float half_sum_f(float v) {
#pragma unroll
    for (int o = 1; o < 32; o <<= 1) v += __shfl_xor(v, o);
    return v;
}
__device__ __forceinline__ int half_sum_i(int v) {
#pragma unroll
    for (int o = 1; o < 32; o <<= 1) v += __shfl_xor(v, o);
    return v;
}
__device__ __forceinline__ float half_max_f(float v) {
#pragma unroll
    for (int o = 1; o < 32; o <<= 1) v = fmaxf(v, __shfl_xor(v, o));
    return v;
}
__device__ __forceinline__ float half_min_f(float v) {
#pragma unroll
    for (int o = 1; o < 32; o <<= 1) v = fminf(v, __shfl_xor(v, o));
    return v;
}
constexpr int IDX_PK = 144, IDX_BUF = 64 * IDX_PK;
__device__ __forceinline__ void idx_task(const Frame& F, int b, int s0c) {
    const int lane = F.lane, r = lane & 31, h = lane >> 5, tid = F.tid;
    const int s0 = s0c + 2 * F.wave;
    LAS unsigned char* lds = F.lds;
    const bf16_t* qix = (const bf16_t*)(F.ws + WS_QIX); const bf16_t* kix = (const bf16_t*)(F.ws + WS_KIX); const float* wix = (const float*)(F.ws + WS_WIX);
    unsigned* mask = (unsigned*)(F.ws + WS_MASK);
    const int tok = (r >> 2) & 1, head = (r & 3) + 4 * (r >> 3);
    const bf16_t* qp = qix + (size_t)(b * SEQ + s0 + tok) * 1024 + head * 64 + 8 * h;
    bf16x8 af[4];
#pragma unroll
    for (int ks = 0; ks < 4; ++ks) af[ks] = *(const bf16x8*)(qp + 16 * ks);
    const f32x4* wp = (const f32x4*)(wix + (size_t)(b * SEQ + s0 + h) * 16);
    float w[16];
#pragma unroll
    for (int q = 0; q < 4; ++q) { const f32x4 x = wp[q]; w[4 * q] = x[0]; w[4 * q + 1] = x[1]; w[4 * q + 2] = x[2]; w[4 * q + 3] = x[3]; }
    const int tq = NMETA + s0 + h;
    int tqr = tq - r; asm volatile("" : "+v"(tqr));
    const int ngrp = ((NMETA + s0c + 15) >> 6) + 1;
    const int skey = tid >> 3, spc = tid & 7;
    int brow = b * SEQ - NMETA; asm volatile("" : "+s"(brow));
    const bf16_t* kcur = kix + ((long)brow + skey) * 64 + spc * 8;
    const int sdst = skey * IDX_PK + spc * 16;
    const int boff = r * IDX_PK + 16 * h;
    u32x4 kst = *(const u32x4*)(skey < NMETA ? kix + (size_t)(NTOK + skey) * 64 + spc * 8 : kcur);
    float row[MW];
#pragma unroll
    for (int g = 0; g < MW / 2; ++g) {
        float s0v = -INFINITY, s1v = -INFINITY;
        const int bo = (g & 1) * IDX_BUF;
        if (g < ngrp) *(LAS u32x4*)(lds + bo + sdst) = kst;
        __syncthreads();
        kcur += 64 * 64; asm volatile("" : "+v"(kcur));
        if (g + 1 < ngrp) kst = *(const u32x4*)kcur;
        if (g < ngrp) {
            float x0 = 0.f, x1 = 0.f;
            { bf16x8 bb[4]; f32x16 a0;
#pragma unroll
              for (int ks = 0; ks < 4; ++ks) bb[ks] = *(const LAS bf16x8*)(lds + bo + boff + 32 * ks);
#pragma unroll
              for (int i = 0; i < 16; ++i) a0[i] = 0.f;
#pragma unroll
              for (int ks = 0; ks < 4; ++ks) a0 = MFMA32(af[ks], bb[ks], a0);
#pragma unroll
              for (int i = 0; i < 16; ++i) x0 += w[i] * relu_i(a0[i]); }
            asm volatile("" : "+v"(x0));
            asm volatile("" ::: "memory");
            { bf16x8 bb[4]; f32x16 a1;
#pragma unroll
              for (int ks = 0; ks < 4; ++ks) bb[ks] = *(const LAS bf16x8*)(lds + bo + boff + 32 * IDX_PK + 32 * ks);
#pragma unroll
              for (int i = 0; i < 16; ++i) a1[i] = 0.f;
#pragma unroll
              for (int ks = 0; ks < 4; ++ks) a1 = MFMA32(af[ks], bb[ks], a1);
#pragma unroll
              for (int i = 0; i < 16; ++i) x1 += w[i] * relu_i(a1[i]); }
            s0v = (g * 64 <= tqr) ? x0 : -INFINITY; s1v = (g * 64 + 32 <= tqr) ? x1 : -INFINITY;
        }
        row[2 * g] = s0v; row[2 * g + 1] = s1v;
    }
    float tau = -3.0e38f;
    bool done = (tq + 1 <= 256);
    float mx = -INFINITY, mn = INFINITY;
#pragma unroll
    for (int k = 0; k < MW; ++k) { const float v = row[k]; mx = fmaxf(mx, v); mn = fminf(mn, v > -INFINITY ? v : INFINITY); }
    float lo = half_min_f(mn), hi = half_max_f(mx);
    if (!done) tau = hi;
    for (int it = 0; it < 64; ++it) {
        if (!__any(!done)) break;
        const float mid = lo + (hi - lo) * 0.5f;
        int c = 0;
#pragma unroll
        for (int k = 0; k < MW; ++k) c += (row[k] >= mid) ? 1 : 0;
        c = half_sum_i(c);
        if (!done) {
            if (!(mid > lo && mid < hi)) { tau = hi; done = true; }
            else if (c == 256) { tau = mid; done = true; }
            else if (c > 256) lo = mid;
            else { hi = mid; tau = hi; }
        }
    }
    unsigned* mrow = mask + (size_t)(b * SEQ + s0 + h) * MW;
    unsigned mw = 0u;
#pragma unroll
    for (int k = 0; k < MW; ++k) {
        const unsigned long long bal = __ballot(row[k] >= tau);
        const unsigned wd = h ? (unsigned)(bal >> 32) : (unsigned)bal;
        if ((k & 31) == r) mw = wd;
        if ((k & 31) == 31 || k == MW - 1) { const int kk = (k & ~31) + r; if (kk < MW) mrow[kk] = mw; }
    }
}
__device__ __forceinline__ void p2_indexer(const Frame& F, int qslot) {
    volatile LAS unsigned* qw = (volatile LAS unsigned*)(F.lds + LDSCTL_OFF + 16);
    constexpr int NCH = NTOK / 16;
    for (;;) {
        if (F.tid == 0) qw[0] = atomicAdd(F.ctl + CW_QUEUE + 64 * qslot, 1u);
        __syncthreads();
        const int c = __builtin_amdgcn_readfirstlane((int)qw[0]);
        __syncthreads();
        if (c >= NCH) break;
        const int b = c & 3, tblk = (SEQ / 16 - 1) - (c >> 2);
        idx_task(F, b, tblk * 16);
    }
}
template <bool MLA> struct AttnCfg {
    static constexpr int DQK = MLA ? 192 : 128, NKS = DQK / 64, PK = DQK + 16  , PV = 320, KBYTES = 64 * PK, BUFB = 64 * PK + 64 * PV;
};
struct AttnUnit { int type, b, hx, blk; };
typedef int i32x8 __attribute__((ext_vector_type(8)));
typedef int i32x4 __attribute__((ext_vector_type(4)));
__device__ __forceinline__ i32x8 cat4(i32x4 a, i32x4 b) { return __builtin_shufflevector(a, b, 0, 1, 2, 3, 4, 5, 6, 7); }
template <int NKS> __device__ __forceinline__ void qk_block(f32x16& s, const i32x8 (&k)[NKS], const i32x8 (&q)[NKS]) {
#if defined(__HIP_DEVICE_COMPILE__)
    int sc = 0x7F7F7F7F;
    if constexpr (NKS == 3)
        asm volatile("s_nop 1\n\tv_mfma_scale_f32_32x32x64_f8f6f4 %0, %1, %4, 0, %7, %7 op_sel_hi:[0,0,0]\n\ts_nop 3\n\tv_mfma_scale_f32_32x32x64_f8f6f4 %0, %2, %5, %0, %7, %7 op_sel_hi:[0,0,0]\n\ts_nop 3\n\t"
                     "v_mfma_scale_f32_32x32x64_f8f6f4 %0, %3, %6, %0, %7, %7 op_sel_hi:[0,0,0]\n\ts_nop 15\n\ts_nop 7"
                     : "=&v"(s) : "v"(k[0]), "v"(k[1]), "v"(k[2]), "v"(q[0]), "v"(q[1]), "v"(q[2]), "v"(sc));
    else
        asm volatile("s_nop 1\n\tv_mfma_scale_f32_32x32x64_f8f6f4 %0, %1, %3, 0, %5, %5 op_sel_hi:[0,0,0]\n\ts_nop 3\n\tv_mfma_scale_f32_32x32x64_f8f6f4 %0, %2, %4, %0, %5, %5 op_sel_hi:[0,0,0]\n\ts_nop 15\n\ts_nop 7"
                     : "=&v"(s) : "v"(k[0]), "v"(k[1]), "v"(q[0]), "v"(q[1]), "v"(sc));
#else
    (void)s; (void)k; (void)q;
#endif
}

template <bool MLA>
__device__ __forceinline__ void attn_unit(const Frame& F, const AttnUnit u) {
    typedef AttnCfg<MLA> C;
    const int tid = F.tid, lane = F.lane, wave = F.wave, r = lane & 31, h = lane >> 5;
    LAS unsigned char* lds = F.lds;
    const unsigned char* qn8 = F.ws + WS_QN; const unsigned char* qr8 = F.ws + WS_QR; const unsigned char* kn8 = F.ws + WS_KN; const unsigned char* kpe8 = F.ws + WS_KPE;
    const unsigned char* qb8 = F.ws + WS_QB; const unsigned char* kb8 = F.ws + WS_KB;
    const bf16_t* va = (const bf16_t*)(F.ws + WS_VA); const bf16_t* vb = (const bf16_t*)(F.ws + WS_VB);
    const unsigned* mask = (const unsigned*)(F.ws + WS_MASK);
    const int b = u.b;
    const size_t rowb = (size_t)b * SEQ;
    int head, tw0, ntiles;
    if (MLA) { head = u.hx; tw0 = u.blk * 256 + 32 * wave; ntiles = (NMETA + u.blk * 256 + 255) / 64 + 1; }
    else { head = 4 * u.hx + (wave & 3); tw0 = u.blk * 64 + 32 * (wave >> 2); ntiles = (NMETA + u.blk * 64 + 63) / 64 + 1; }
    const int pw0 = NMETA + tw0;
    const int tq = pw0 + r;
    const float cexp = MLA ? QA_SCALE : QB_SCALE;
    i32x8 qf[C::NKS];
    if (MLA) {
        const unsigned char* p0 = qn8 + (rowb + tw0 + r) * 2048 + head * 128 + 32 * h; const unsigned char* p1 = qr8 + (rowb + tw0 + r) * 1024 + head * 64 + 32 * h;
        qf[0] = cat4(*(const i32x4*)p0, *(const i32x4*)(p0 + 16)); qf[1] = cat4(*(const i32x4*)(p0 + 64), *(const i32x4*)(p0 + 80)); qf[C::NKS - 1] = cat4(*(const i32x4*)p1, *(const i32x4*)(p1 + 16));
    } else {
        const unsigned char* p0 = qb8 + (rowb + tw0 + r) * 2048 + head * 128 + 32 * h;
        qf[0] = cat4(*(const i32x4*)p0, *(const i32x4*)(p0 + 16)); qf[1] = cat4(*(const i32x4*)(p0 + 64), *(const i32x4*)(p0 + 80));
    }
    const int ldk = MLA ? 2048 : 512;
    const unsigned char* ktab = MLA ? kn8 + head * 128 : kb8 + u.hx * 128;
    const bf16_t* vtab = MLA ? va + head * 128 : vb + u.hx * 128;
    const unsigned char* kbase = ktab + (rowb - NMETA) * ldk;
    const bf16_t* vbase = vtab + (rowb - NMETA) * ldk;
    const unsigned char* pbase = kpe8 + (rowb - NMETA) * 64;
    const int kkey = tid >> 3, kpc = tid & 7, pkey = tid >> 2, ppc = tid & 3;
    const unsigned koffs = (unsigned)(kkey * ldk + kpc * 16); const int kdst = kkey * C::PK + kpc * 16;
    const unsigned poffs = (unsigned)(pkey * 64 + ppc * 16); const int pdst = pkey * C::PK + 128 + ppc * 16;
    unsigned soff[2]; int vdst[2];
#pragma unroll
    for (int i = 0; i < 2; ++i) { const int c = tid + 512 * i, key = c >> 4, pc = c & 15; soff[i] = (unsigned)(key * ldk + pc * 8); vdst[i] = C::KBYTES + key * C::PV + pc * 16; }
    u32x4 kst, vst[2], pst = (u32x4){0u, 0u, 0u, 0u};
    {
        kst = *(const u32x4*)(kkey < NMETA ? ktab + (size_t)(NTOK + kkey) * ldk + kpc * 16 : kbase + koffs);
        const int key0 = tid >> 4;
        vst[0] = *(const u32x4*)(key0 < NMETA ? vtab + (size_t)(NTOK + key0) * ldk + (tid & 15) * 8 : vbase + soff[0]);
        vst[1] = *(const u32x4*)(vbase + soff[1]);
        if (MLA && tid < 256) pst = *(const u32x4*)(pkey < NMETA ? kpe8 + (size_t)(NTOK + pkey) * 64 + ppc * 16 : pbase + poffs);
    }
    *(LAS u32x4*)(lds + kdst) = kst;
#pragma unroll
    for (int i = 0; i < 2; ++i) *(LAS u32x4*)(lds + vdst[i]) = vst[i];
    if (MLA && tid < 256) *(LAS u32x4*)(lds + pdst) = pst;
    __syncthreads();
    f32x16 oacc[4];
#pragma unroll
    for (int d = 0; d < 4; ++d)
#pragma unroll
        for (int i = 0; i < 16; ++i) oacc[d][i] = 0.f;
    float mrun = -INFINITY, lrun = 0.f;
    const int koff = r * C::PK + 32 * h;
    const int voff = C::KBYTES + (4 * h + ((lane & 15) >> 2)) * C::PV + (16 * ((lane >> 4) & 1) + 4 * (lane & 3)) * 2;
    const unsigned* mrow = mask + (rowb + tw0 + r) * MW;
    for (int kt = 0; kt < ntiles; ++kt) {
        const int cur = (kt & 1) * C::BUFB, nxt = ((kt + 1) & 1) * C::BUFB;
        const bool more = kt + 1 < ntiles;
        if (more) {
            kst = *(const u32x4*)(kbase + (size_t)(kt + 1) * 64 * ldk + koffs);
            const bf16_t* vb2 = vbase + (size_t)(kt + 1) * 64 * ldk;
#pragma unroll
            for (int i = 0; i < 2; ++i) vst[i] = *(const u32x4*)(vb2 + soff[i]);
            if (MLA && tid < 256) pst = *(const u32x4*)(pbase + (size_t)(kt + 1) * 64 * 64 + poffs);
        }
        if (kt * 64 <= pw0 + 31) {
            u32x2 mwd = (u32x2){0u, 0u};
            if (!MLA) mwd = *(const u32x2*)(mrow + 2 * kt);
            f32x16 s0, s1;
            { i32x8 kf[C::NKS];
#pragma unroll
              for (int ks = 0; ks < C::NKS; ++ks) kf[ks] = cat4(*(const LAS i32x4*)(lds + cur + koff + 64 * ks), *(const LAS i32x4*)(lds + cur + koff + 64 * ks + 16));
              qk_block<C::NKS>(s0, kf, qf); }
            { i32x8 kf[C::NKS];
#pragma unroll
              for (int ks = 0; ks < C::NKS; ++ks) kf[ks] = cat4(*(const LAS i32x4*)(lds + cur + koff + 32 * C::PK + 64 * ks), *(const LAS i32x4*)(lds + cur + koff + 32 * C::PK + 64 * ks + 16));
              qk_block<C::NKS>(s1, kf, qf); }
            if (MLA) {
                if (kt * 64 + 63 > pw0) {
                    const int kb0 = kt * 64 + 4 * h;
#pragma unroll
                    for (int i = 0; i < 16; ++i) { const int key = kb0 + (i & 3) + 8 * (i >> 2); if (key > tq) s0[i] = -INFINITY; if (key + 32 > tq) s1[i] = -INFINITY; }
                }
            } else {
                const unsigned m0 = mwd.x >> (4 * h), m1 = mwd.y >> (4 * h);
#pragma unroll
                for (int i = 0; i < 16; ++i) { const int bit = (i & 3) + 8 * (i >> 2); if (!((m0 >> bit) & 1u)) s0[i] = -INFINITY; if (!((m1 >> bit) & 1u)) s1[i] = -INFINITY; }
            }
            float mx = s0[0];
#pragma unroll
            for (int i = 1; i < 16; ++i) mx = fmaxf(mx, s0[i]);
#pragma unroll
            for (int i = 0; i < 16; ++i) mx = fmaxf(mx, s1[i]);
            mx = fmaxf(mx, __shfl_xor(mx, 32));
            const float mnew = fmaxf(mrun, mx * cexp);
            const float msafe = (mnew == -INFINITY) ? 0.f : mnew;
            const float alpha = __builtin_amdgcn_exp2f(mrun - msafe);
            mrun = mnew;
            float ps = 0.f;
#pragma unroll
            for (int i = 0; i < 16; ++i) { s0[i] = __builtin_amdgcn_exp2f(__builtin_fmaf(s0[i], cexp, -msafe)); s1[i] = __builtin_amdgcn_exp2f(__builtin_fmaf(s1[i], cexp, -msafe)); ps += s0[i] + s1[i]; }
            lrun = lrun * alpha + ps;
#pragma unroll
            for (int d = 0; d < 4; ++d)
#pragma unroll
                for (int i = 0; i < 16; ++i) oacc[d][i] *= alpha;
            bf16x8 pf[4];
            { u32x4 w;
              w.x = cvt_pk_bf16(s0[0], s0[1]); w.y = cvt_pk_bf16(s0[2], s0[3]); w.z = cvt_pk_bf16(s0[4], s0[5]); w.w = cvt_pk_bf16(s0[6], s0[7]); pf[0] = __builtin_bit_cast(bf16x8, w);
              w.x = cvt_pk_bf16(s0[8], s0[9]); w.y = cvt_pk_bf16(s0[10], s0[11]); w.z = cvt_pk_bf16(s0[12], s0[13]); w.w = cvt_pk_bf16(s0[14], s0[15]); pf[1] = __builtin_bit_cast(bf16x8, w);
              w.x = cvt_pk_bf16(s1[0], s1[1]); w.y = cvt_pk_bf16(s1[2], s1[3]); w.z = cvt_pk_bf16(s1[4], s1[5]); w.w = cvt_pk_bf16(s1[6], s1[7]); pf[2] = __builtin_bit_cast(bf16x8, w);
              w.x = cvt_pk_bf16(s1[8], s1[9]); w.y = cvt_pk_bf16(s1[10], s1[11]); w.z = cvt_pk_bf16(s1[12], s1[13]); w.w = cvt_pk_bf16(s1[14], s1[15]); pf[3] = __builtin_bit_cast(bf16x8, w); }
#pragma unroll
            for (int d = 0; d < 4; ++d)
#pragma unroll
                for (int kk = 0; kk < 4; ++kk) {
                    const s16x4 lo = __builtin_amdgcn_ds_read_tr16_b64_v4i16((LAS s16x4*)(lds + cur + voff + (16 * kk) * C::PV + 64 * d));
                    const s16x4 hi = __builtin_amdgcn_ds_read_tr16_b64_v4i16((LAS s16x4*)(lds + cur + voff + (16 * kk + 8) * C::PV + 64 * d));
                    const bf16x8 vf = __builtin_shufflevector(lo, hi, 0, 1, 2, 3, 4, 5, 6, 7);
                    oacc[d] = MFMA32(vf, pf[kk], oacc[d]);
                }
        }
        if (more) {
            *(LAS u32x4*)(lds + nxt + kdst) = kst;
#pragma unroll
            for (int i = 0; i < 2; ++i) *(LAS u32x4*)(lds + nxt + vdst[i]) = vst[i];
            if (MLA && tid < 256) *(LAS u32x4*)(lds + nxt + pdst) = pst;
        }
        __syncthreads();
    }
    {
        const float lt = lrun + __shfl_xor(lrun, 32);
        const float vmax = fmaxf(__uint_as_float(F.ctl[CW_VMAX + (MLA ? 64 : 0)]), 1e-30f);
        const float inv = (lt > 0.f ? 1.0f / lt : 0.f) * (440.0f / vmax);
        unsigned char* op = F.ws + WS_OAB + (rowb + tw0 + r) * 4096 + (MLA ? 0 : 2048) + head * 128 + 4 * h;
#pragma unroll
        for (int d = 0; d < 4; ++d)
#pragma unroll
            for (int g = 0; g < 4; ++g) { int p = 0;
                p = __builtin_amdgcn_cvt_pk_fp8_f32(fminf(fmaxf(oacc[d][4 * g] * inv, -448.f), 448.f), fminf(fmaxf(oacc[d][4 * g + 1] * inv, -448.f), 448.f), p, false);
                p = __builtin_amdgcn_cvt_pk_fp8_f32(fminf(fmaxf(oacc[d][4 * g + 2] * inv, -448.f), 448.f), fminf(fmaxf(oacc[d][4 * g + 3] * inv, -448.f), 448.f), p, true);
                *(unsigned*)(op + 32 * d + 8 * g) = (unsigned)p; }
    }
}

constexpr int ATT_NUNITS = 16 * 64 + 64 * 16;
__device__ __forceinline__ void att_decode(int idx, AttnUnit& u) {
    int rem = idx;
    for (int L = 65; L >= 2; --L) {
        const int nm = (L >= 5 && ((L - 5) & 3) == 0) ? 64 : 0;
        if (rem < nm) { u.type = 0; u.blk = (L - 5) >> 2; u.b = rem & 3; u.hx = rem >> 2; return; }
        rem -= nm;
        if (rem < 16) { u.type = 1; u.blk = L - 2; u.b = rem & 3; u.hx = rem >> 2; return; }
        rem -= 16;
    }
    u.type = -1; u.blk = 0; u.b = 0; u.hx = 0;
}
__device__ __forceinline__ void p3_attention(const Frame& F, int qslot) {
    volatile LAS int* qw = (volatile LAS int*)(F.lds + LDSCTL_OFF + 32);
    for (;;) {
        if (F.tid == 0) { const int idx = (int)atomicAdd(F.ctl + CW_QUEUE + 64 * qslot, 1u); AttnUnit u; u.type = -1; u.b = 0; u.hx = 0; u.blk = 0; if (idx < ATT_NUNITS) att_decode(idx, u);
            qw[0] = u.type; qw[1] = u.b; qw[2] = u.hx; qw[3] = u.blk; }
        __syncthreads();
        AttnUnit u; u.type = qw[0]; u.b = qw[1]; u.hx = qw[2]; u.blk = qw[3];
        __syncthreads();
        if (u.type < 0) break;
        if (u.type == 0) attn_unit<true>(F, u); else attn_unit<false>(F, u);
    }
}
__device__ __forceinline__ float pk_idx(float v, int n) { return __uint_as_float((__float_as_uint(v) & ~127u) | (unsigned)n); }
__device__ __forceinline__ void route_task(const Frame& F, int tb, int hd) {
    const int lane = F.lane, r = lane & 31, h = lane >> 5;
    const bf16_t* pq = (const bf16_t*)(F.ws + WS_PQ); const bf16_t* skb = (const bf16_t*)(F.ws + WS_SK);
    int* eid = (int*)(F.ws + WS_EID); float* gate = (float*)(F.ws + WS_GATE);
    LAS float* wl = (LAS float*)(F.lds + F.wave * 16384);
    const int m = tb * 32 + r;
#pragma unroll 1
    for (int c = 0; c < 2; ++c) {
        const bf16_t* qp = pq + (size_t)m * 2048 + hd * 256 + c * 128 + 8 * h;
        bf16x8 qf[8];
#pragma unroll
        for (int ks = 0; ks < 8; ++ks) qf[ks] = *(const bf16x8*)(qp + 16 * ks);
        float v[64];
#pragma unroll
        for (int blk = 0; blk < 4; ++blk) {
            const bf16_t* sp = skb + (size_t)((hd * 2 + c) * 128 + 32 * blk + r) * 128 + 8 * h;
            f32x16 acc;
#pragma unroll
            for (int i = 0; i < 16; ++i) acc[i] = 0.f;
#pragma unroll
            for (int ks = 0; ks < 8; ++ks) acc = MFMA32(*(const bf16x8*)(sp + 16 * ks), qf[ks], acc);
#pragma unroll
            for (int i = 0; i < 16; ++i) v[blk * 16 + i] = pk_idx(acc[i], 32 * blk + (i & 3) + 8 * (i >> 2) + 4 * h);
        }
#pragma unroll 1
        for (int k = 0; k < 16; ++k) {
            float mx = v[0];
#pragma unroll
            for (int j = 1; j < 64; ++j) mx = fmaxf(mx, v[j]);
            mx = fmaxf(mx, __shfl_xor(mx, 32));
            if (h == 0) wl[(c * 16 + k) * 32 + r] = mx;
#pragma unroll
            for (int j = 0; j < 64; ++j) v[j] = (v[j] == mx) ? -INFINITY : v[j];
        }
    }
    LDS_WAIT(); asm volatile("" ::: "memory");
    float cs[50]; int ce[50];
    {
        unsigned t0[16], t1[16];
#pragma unroll
        for (int i = 0; i < 16; ++i) { t0[i] = __float_as_uint(wl[i * 32 + r]); t1[i] = __float_as_uint(wl[(16 + i) * 32 + r]); }
        int n = 0;
#pragma unroll
        for (int i = 0; i < 16; ++i)
#pragma unroll
            for (int j = 0; j < 16; ++j)
                if ((i + 1) * (j + 1) <= 16) {
                    const float s = __uint_as_float(t0[i] & ~127u) + __uint_as_float(t1[j] & ~127u);
                    cs[n] = __uint_as_float((__float_as_uint(s) & ~63u) | (unsigned)n); ce[n] = (int)((t0[i] & 127u) * 128u + (t1[j] & 127u)); ++n;
                }
    }
    float sum = 0.f, first = 0.f;
#pragma unroll 1
    for (int k = 0; k < 16; ++k) {
        float mx = cs[0];
#pragma unroll
        for (int j = 1; j < 50; ++j) mx = fmaxf(mx, cs[j]);
        int se = 0;
#pragma unroll
        for (int j = 0; j < 50; ++j) { const bool hit = (cs[j] == mx); se = hit ? ce[j] : se; cs[j] = hit ? -INFINITY : cs[j]; }
        if (k == 0) first = mx;
        const float ev = __expf(mx - first); sum += ev;
        if (h == 0) { wl[1024 + k * 32 + r] = ev; wl[1536 + k * 32 + r] = __int_as_float(se); }
    }
    LDS_WAIT(); asm volatile("" ::: "memory");
    const float inv = 1.0f / sum;
    if (h == 0) {
        int* ep = eid + (size_t)m * 128 + hd * 16; float* gp = gate + (size_t)m * 128 + hd * 16;
#pragma unroll
        for (int q = 0; q < 4; ++q) {
            *(int4*)(ep + 4 * q) = make_int4(__float_as_int(wl[1536 + (4 * q) * 32 + r]), __float_as_int(wl[1536 + (4 * q + 1) * 32 + r]), __float_as_int(wl[1536 + (4 * q + 2) * 32 + r]), __float_as_int(wl[1536 + (4 * q + 3) * 32 + r]));
            *(f32x4*)(gp + 4 * q) = (f32x4){wl[1024 + (4 * q) * 32 + r] * inv, wl[1024 + (4 * q + 1) * 32 + r] * inv, wl[1024 + (4 * q + 2) * 32 + r] * inv, wl[1024 + (4 * q + 3) * 32 + r] * inv}; }
    }
    LDS_WAIT(); asm volatile("" ::: "memory");
}
__device__ __forceinline__ void p7_routing(const Frame& F) {
    const int gw = F.vcu * NWAVES + F.wave, NGW = F.G * NWAVES;
    for (int it = gw; it < (NTOK / 32) * 8; it += NGW) route_task(F, it >> 3, it & 7);
}

__device__ __forceinline__ float rl_f(float v, int l) { return __int_as_float(__builtin_amdgcn_readlane(__float_as_int(v), l)); }
__device__ __forceinline__ float gelu_tanh(float x) {
    const float u = 0.7978845608028654f * (x + 0.044715f * x * x * x);
    const float e = __expf(2.0f * u);
    const float th = 1.0f - 2.0f / (e + 1.0f);
    return 0.5f * x * (1.0f + th);
}
__device__ __forceinline__ float wave_sum_dpp(float v) {
#define DPP_ADD(ctrl, rmask) v += __int_as_float(__builtin_amdgcn_update_dpp(0, __float_as_int(v), ctrl, rmask, 0xF, false))
    DPP_ADD(0xB1, 0xF); DPP_ADD(0x4E, 0xF); DPP_ADD(0x141, 0xF); DPP_ADD(0x140, 0xF); DPP_ADD(0x142, 0xA); DPP_ADD(0x143, 0xC);
#undef DPP_ADD
    return rl_f(v, 63);
}
typedef unsigned u32x6 __attribute__((ext_vector_type(6)));
typedef float f32x32 __attribute__((ext_vector_type(32)));
struct Row6 { u32x4 q[3]; };
__device__ __forceinline__ void row6_load(Row6& r, const unsigned char* tab, int e, int lane) {
    const u32x4* p = (const u32x4*)(tab + (size_t)e * 3072) + lane;
#pragma unroll
    for (int q = 0; q < 3; ++q) r.q[q] = p[64 * q];
}
__device__ __forceinline__ f32x32 row6_deq(const Row6& r, int g) {
    u32x6 w;
    if (g == 0) { w[0] = r.q[0].x; w[1] = r.q[0].y; w[2] = r.q[0].z; w[3] = r.q[0].w; w[4] = r.q[1].x; w[5] = r.q[1].y; }
    else { w[0] = r.q[1].z; w[1] = r.q[1].w; w[2] = r.q[2].x; w[3] = r.q[2].y; w[4] = r.q[2].z; w[5] = r.q[2].w; }
    return __builtin_amdgcn_cvt_scalef32_pk32_f32_fp6(w, 1.0f);
}
__device__ __forceinline__ float row6_dot(const Row6& r, const f32x2 (&hf)[32]) {
    f32x2 acc0 = (f32x2){0.f, 0.f}, acc1 = (f32x2){0.f, 0.f};
#pragma unroll
    for (int g = 0; g < 2; ++g) { const f32x32 d = row6_deq(r, g);
#pragma unroll
        for (int k = 0; k < 16; k += 2) { acc0 = __builtin_elementwise_fma((f32x2){d[2 * k], d[2 * k + 1]}, hf[16 * g + k], acc0); acc1 = __builtin_elementwise_fma((f32x2){d[2 * k + 2], d[2 * k + 3]}, hf[16 * g + k + 1], acc1); } }
    const f32x2 s = acc0 + acc1;
    return s.x + s.y;
}
__device__ __forceinline__ void row6_axpy(const Row6& r, float c, f32x2 (&o)[32]) {
    const f32x2 c2 = (f32x2){c, c};
#pragma unroll
    for (int g = 0; g < 2; ++g) { const f32x32 d = row6_deq(r, g);
#pragma unroll
        for (int k = 0; k < 16; ++k) o[16 * g + k] = __builtin_elementwise_fma((f32x2){d[2 * k], d[2 * k + 1]}, c2, o[16 * g + k]); }
}
struct Row4 { u32x4 q[2]; };
__device__ __forceinline__ void row4_load(Row4& r, const unsigned char* tab, int e, int lane) {
    const u32x4* p = (const u32x4*)(tab + (size_t)e * 2048) + lane;
    r.q[0] = p[0]; r.q[1] = p[64];
}
__device__ __forceinline__ float row4_dot(const Row4& r, const f32x2 (&hf)[32]) {
    f32x2 acc0 = (f32x2){0.f, 0.f}, acc1 = (f32x2){0.f, 0.f};
#pragma unroll
    for (int d = 0; d < 8; ++d) { const unsigned w = r.q[d >> 2][d & 3];
        acc0 = __builtin_elementwise_fma(__builtin_amdgcn_cvt_scalef32_pk_f32_fp4(w, 1.0f, 0), hf[4 * d], acc0);
        acc1 = __builtin_elementwise_fma(__builtin_amdgcn_cvt_scalef32_pk_f32_fp4(w, 1.0f, 1), hf[4 * d + 1], acc1);
        acc0 = __builtin_elementwise_fma(__builtin_amdgcn_cvt_scalef32_pk_f32_fp4(w, 1.0f, 2), hf[4 * d + 2], acc0);
        acc1 = __builtin_elementwise_fma(__builtin_amdgcn_cvt_scalef32_pk_f32_fp4(w, 1.0f, 3), hf[4 * d + 3], acc1); }
    const f32x2 s = acc0 + acc1;
    return s.x + s.y;
}
__device__ __forceinline__ void row4_axpy(const Row4& r, float c, f32x2 (&o)[32]) {
    const f32x2 c2 = (f32x2){c, c};
#pragma unroll
    for (int d = 0; d < 8; ++d) { const unsigned w = r.q[d >> 2][d & 3];
        o[4 * d] = __builtin_elementwise_fma(__builtin_amdgcn_cvt_scalef32_pk_f32_fp4(w, 1.0f, 0), c2, o[4 * d]);
        o[4 * d + 1] = __builtin_elementwise_fma(__builtin_amdgcn_cvt_scalef32_pk_f32_fp4(w, 1.0f, 1), c2, o[4 * d + 1]);
        o[4 * d + 2] = __builtin_elementwise_fma(__builtin_amdgcn_cvt_scalef32_pk_f32_fp4(w, 1.0f, 2), c2, o[4 * d + 2]);
        o[4 * d + 3] = __builtin_elementwise_fma(__builtin_amdgcn_cvt_scalef32_pk_f32_fp4(w, 1.0f, 3), c2, o[4 * d + 3]); }
}
#if PEER_U_BITS == 4
typedef Row4 RowU;
#define ROWU_LOAD row4_load
#define ROWU_DOT row4_dot
#else
typedef Row6 RowU;
#define ROWU_LOAD row6_load
#define ROWU_DOT row6_dot
#endif
#if PEER_V_BITS == 4
typedef Row4 RowV;
#define ROWV_LOAD row4_load
#define ROWV_AXPY row4_axpy
#else
typedef Row6 RowV;
#define ROWV_LOAD row6_load
#define ROWV_AXPY row6_axpy
#endif
__device__ __forceinline__ void expert_token(const Frame& F, int m, size_t orow) {
    const int lane = F.lane;
    const unsigned char* U = F.ws + WS_U; const unsigned char* V = F.ws + WS_V;
    const float* scu = (const float*)(F.ws + WS_SCU); const float* scv = (const float*)(F.ws + WS_SCV);
    const int* eid = (const int*)(F.ws + WS_EID); const float* gate = (const float*)(F.ws + WS_GATE);
    const bf16_t* h1b = (const bf16_t*)(F.ws + WS_H1B);
    const u64* ssq = (const u64*)(F.ctl + CW_SSQ_H1); const float* gfin = F.in(15);
    const int e0 = eid[(size_t)m * 128 + lane], e1 = eid[(size_t)m * 128 + 64 + lane];
    f32x2 hf[32];
#pragma unroll
    for (int j = 0; j < 16; ++j) { const u32x2 x = *((const u32x2*)(h1b + (size_t)m * DM) + lane + 64 * j); hf[2 * j] = (f32x2){bf_lo(x.x), bf_hi(x.x)}; hf[2 * j + 1] = (f32x2){bf_lo(x.y), bf_hi(x.y)}; }
    const float g0 = gate[(size_t)m * 128 + lane] * scv[e0], g1 = gate[(size_t)m * 128 + 64 + lane] * scv[e1];
    const float rstd = __builtin_amdgcn_rsqf(ssq_get(ssq + m) * (1.0f / DM) + EPS);
    const float su0 = scu[e0] * rstd, su1 = scu[e1] * rstd;
    float a0 = 0.f, a1 = 0.f;
#define EIDX(e) (((e) < 64) ? __builtin_amdgcn_readlane(e0, (e)) : __builtin_amdgcn_readlane(e1, (e) - 64))
    {
        RowU r0, r1, r2, r3, r4, r5, r6, r7;
        ROWU_LOAD(r0, U, EIDX(0), lane); ROWU_LOAD(r1, U, EIDX(1), lane); ROWU_LOAD(r2, U, EIDX(2), lane); ROWU_LOAD(r3, U, EIDX(3), lane);
        ROWU_LOAD(r4, U, EIDX(4), lane); ROWU_LOAD(r5, U, EIDX(5), lane); ROWU_LOAD(r6, U, EIDX(6), lane); ROWU_LOAD(r7, U, EIDX(7), lane);
#define S1STEP(rr, k) p = wave_sum_dpp(ROWU_DOT(rr, hf)); if (more) ROWU_LOAD(rr, U, EIDX(e + 8 + (k)), lane); if (e < 64) { if (lane == e + (k)) a0 = p; } else { if (lane == e + (k) - 64) a1 = p; }
#pragma unroll 1
        for (int e = 0; e < 128; e += 8) {
            const bool more = e + 8 < 128; float p;
            S1STEP(r0, 0) S1STEP(r1, 1) S1STEP(r2, 2) S1STEP(r3, 3) S1STEP(r4, 4) S1STEP(r5, 5) S1STEP(r6, 6) S1STEP(r7, 7)
        }
#undef S1STEP
    }
    const float c0 = gelu_tanh(a0 * su0) * g0, c1 = gelu_tanh(a1 * su1) * g1;
#define CIDX(e) (((e) < 64) ? rl_f(c0, (e)) : rl_f(c1, (e) - 64))
    f32x2 o[32];
#pragma unroll
    for (int i = 0; i < 32; ++i) o[i] = (f32x2){0.f, 0.f};
    {
        RowV r0, r1, r2, r3, r4, r5, r6, r7;
        ROWV_LOAD(r0, V, EIDX(0), lane); ROWV_LOAD(r1, V, EIDX(1), lane); ROWV_LOAD(r2, V, EIDX(2), lane); ROWV_LOAD(r3, V, EIDX(3), lane);
        ROWV_LOAD(r4, V, EIDX(4), lane); ROWV_LOAD(r5, V, EIDX(5), lane); ROWV_LOAD(r6, V, EIDX(6), lane); ROWV_LOAD(r7, V, EIDX(7), lane);
#define S2STEP(rr, k) ROWV_AXPY(rr, CIDX(e + (k)), o); if (more) ROWV_LOAD(rr, V, EIDX(e + 8 + (k)), lane);
#pragma unroll 1
        for (int e = 0; e < 128; e += 8) {
            const bool more = e + 8 < 128;
            S2STEP(r0, 0) S2STEP(r1, 1) S2STEP(r2, 2) S2STEP(r3, 3) S2STEP(r4, 4) S2STEP(r5, 5) S2STEP(r6, 6) S2STEP(r7, 7)
        }
#undef S2STEP
    }
#undef EIDX
#undef CIDX
    float s = 0.f;
    const bf16_t* h1r = h1b + (size_t)m * DM; asm volatile("" : "+s"(h1r));
#pragma unroll
    for (int j = 0; j < 16; ++j) { const u32x2 x = *((const u32x2*)h1r + lane + 64 * j);
        o[2 * j] += (f32x2){bf_lo(x.x), bf_hi(x.x)}; o[2 * j + 1] += (f32x2){bf_lo(x.y), bf_hi(x.y)};
        s += (o[2 * j].x * o[2 * j].x + o[2 * j].y * o[2 * j].y) + (o[2 * j + 1].x * o[2 * j + 1].x + o[2 * j + 1].y * o[2 * j + 1].y); }
    const float rs = 1.0f / sqrtf(wave_sum(s) * (1.0f / DM) + EPS);
    float* op = F.out() + orow * DM;
#pragma unroll
    for (int j = 0; j < 16; ++j) { const f32x4 g = *((const f32x4*)gfin + lane + 64 * j);
        *((f32x4*)op + lane + 64 * j) = (f32x4){o[2 * j].x * rs * g[0], o[2 * j].y * rs * g[1], o[2 * j + 1].x * rs * g[2], o[2 * j + 1].y * rs * g[3]}; }
}
#ifdef MK_STEP_B
__device__ __forceinline__ void stepb_token(const Frame& F, int m, size_t orow) {
    const int lane = F.lane; const float* x = (const float*)(F.ws + WS_H1F) + (size_t)m * DM; const float* gfin = F.in(15);
    f32x4 v[16]; float s = 0.f;
#pragma unroll
    for (int j = 0; j < 16; ++j) { v[j] = *((const f32x4*)x + lane + 64 * j); s += (v[j][0] * v[j][0] + v[j][1] * v[j][1]) + (v[j][2] * v[j][2] + v[j][3] * v[j][3]); }
    const float rs = 1.0f / sqrtf(wave_sum(s) * (1.0f / DM) + EPS);
#pragma unroll
    for (int j = 0; j < 16; ++j) { const f32x4 g = *((const f32x4*)gfin + lane + 64 * j); *((f32x4*)(F.out() + orow * DM) + lane + 64 * j) = v[j] * rs * g; }
}
#endif
#ifdef MK_STEP_A
__device__ __forceinline__ void stepa_token(const Frame& F, size_t orow) {
    const int lane = F.lane; const float* x = F.in(0) + orow * DM; const float* gfin = F.in(15);
    f32x4 v[16]; float s = 0.f;
#pragma unroll
    for (int j = 0; j < 16; ++j) { v[j] = *((const f32x4*)x + lane + 64 * j); s += (v[j][0] * v[j][0] + v[j][1] * v[j][1]) + (v[j][2] * v[j][2] + v[j][3] * v[j][3]); }
    const float rs = 1.0f / sqrtf(wave_sum(s) * (1.0f / DM) + EPS);
#pragma unroll
    for (int j = 0; j < 16; ++j) { const f32x4 g = *((const f32x4*)gfin + lane + 64 * j); *((f32x4*)(F.out() + orow * DM) + lane + 64 * j) = v[j] * rs * g; }
}
#endif
__device__ __forceinline__ void p8_experts(const Frame& F) {
    const int gw = F.vcu * NWAVES + F.wave, NGW = F.G * NWAVES;
#if defined(MK_STEP_A)
    for (int it = gw; it < NB * SEQ; it += NGW) stepa_token(F, (size_t)it);
#elif defined(MK_STEP_B)
    for (int it = gw; it < NB * SEQ; it += NGW) stepb_token(F, it, (size_t)it);
#else
    for (int it = gw; it < NB * SEQ; it += NGW) expert_token(F, it, (size_t)it);
#endif
}
struct Args { const float* in[16]; float* out; unsigned char* ws; int ph_lo, ph_hi; };
#define GEMM_RUN(EPI_T, g_, S_, E_) pg8::gemm_phase<EPI_T, pg8::StaticOrder, true, true>(F.lds, g_, S_, E_)
#define GEMM_RUN2(EPI_T, g_, S_, E_) pg8::gemm_phase<EPI_T, pg8::StaticOrder2, true, true>(F.lds, g_, S_, E_)

__global__ void __launch_bounds__(NWAVES * 64, 2) mk_fwd(Args args) {
    extern __shared__ __attribute__((aligned(16))) unsigned char lds_raw[];
    Frame F;
    F.lds = (LAS unsigned char*)lds_raw;
    F.ws = args.ws; F.ctl = (unsigned*)(args.ws + WS_CTL);
    F.tid = threadIdx.x; F.lane = F.tid & 63; F.wave = __builtin_amdgcn_readfirstlane(F.tid >> 6);
#define PHASE_BEGIN() do { int t_; asm volatile("v_mov_b32 %0, %1" : "=v"(t_) : "v"(threadIdx.x)); F.tid = t_; F.lane = t_ & 63; } while (0)
    F.G = gridDim.x; { const int bx = blockIdx.x; F.vcu = (F.G % 8 == 0) ? (bx % 8) * (F.G / 8) + bx / 8 : bx; }
    for (int u = F.tid; u < (LDS_BYTES - LDSCTL_OFF) / 4; u += NWAVES * 64) ((LAS unsigned*)(F.lds + LDSCTL_OFF))[u] = 0u;
    __syncthreads();
    XcdBarrier bar; bar.bar = F.ctl + CW_BAR; bar.x = 0; bar.st = nullptr;
    if (!MK_PER_PHASE) bar = xcd_barrier_post(F.ctl + CW_BAR, (volatile LAS unsigned*)(F.lds + LDSCTL_OFF));
    const int lo = args.ph_lo, hi = args.ph_hi;
#ifndef PH_MASK
#define PH_MASK 0x1FF
#endif
#define IN(k) (((PH_MASK >> (k)) & 1) && lo <= (k) && (k) < hi)
#ifdef MK_PROBE_T
#define STAMP(k) do { if (blockIdx.x == 0 && threadIdx.x == 0) ((volatile u64*)(F.ctl + 2048))[k] = __builtin_amdgcn_s_memrealtime(); } while (0)
#else
#define STAMP(k) do { } while (0)
#endif
#define SEAM(k) do { if (IN(k) && IN((k) + 1)) xcd_barrier(bar); STAMP((k) + 1); } while (0)
    unsigned char* ws = F.ws;

#ifndef MK_REP_MASK
#define MK_REP_MASK 0
#endif
#define NREP(k) (((MK_REP_MASK >> (k)) & 1) ? 2 : 1)
    STAMP(0);
    if (IN(0)) { for (int rep = 0; rep < NREP(0); ++rep) { PHASE_BEGIN(); p0_prologue(F); if (rep + 1 < NREP(0)) xcd_barrier(bar); } }
    SEAM(0);
    if (IN(1)) { for (int rep = 0; rep < NREP(1); ++rep) { PHASE_BEGIN();
        p1_quant_weights(F);
        xcd_barrier(bar);
        {
            pg8::Gemm g{(const bf16_t*)(ws + WS_XN8), (const bf16_t*)(ws + WS_WG8), MK, 12800, DM / 2, DM / 2}; pg8::StaticOrder S; S.init(MK, 12800, F.G, (int)blockIdx.x);
            epi::EpiIn<true> E{(bf16_t*)(ws + WS_CQ), (bf16_t*)(ws + WS_CKV), (bf16_t*)(ws + WS_QB), (bf16_t*)(ws + WS_KB), (bf16_t*)(ws + WS_VB), (bf16_t*)(ws + WS_QIX), (bf16_t*)(ws + WS_KPE), (bf16_t*)(ws + WS_KIX),
                          (bf16_t*)(ws + WS_GA), (bf16_t*)(ws + WS_GB), (float*)(ws + WS_WIX), rep ? nullptr : (u64*)(F.ctl + CW_SSQ_CQ), rep ? nullptr : (u64*)(F.ctl + CW_SSQ_CKV),
                          (const float*)(ws + WS_ROPE_M), (const float*)(ws + WS_ROPE_D), (const float*)(ws + WS_ROPE_I), F.ctl + CW_VMAX, (const float*)(ws + WS_SX), (const float*)(ws + WS_SW)};
            GEMM_RUN(epi::EpiIn<true>, g, S, E); }
        __syncthreads();
        {
            pg8::Gemm g{(const bf16_t*)(ws + WS_XN), (const bf16_t*)(ws + WS_WIN), MK, 1280, DM, DM}; pg8::StaticOrder S; S.init(MK, 1280, F.G, (int)(gridDim.x - 1 - blockIdx.x));
            epi::EpiIn<false> E{(bf16_t*)(ws + WS_CQ), (bf16_t*)(ws + WS_CKV), (bf16_t*)(ws + WS_QB), (bf16_t*)(ws + WS_KB), (bf16_t*)(ws + WS_VB), (bf16_t*)(ws + WS_QIX), (bf16_t*)(ws + WS_KPE), (bf16_t*)(ws + WS_KIX),
                          (bf16_t*)(ws + WS_GA), (bf16_t*)(ws + WS_GB), (float*)(ws + WS_WIX), nullptr, nullptr,
                          (const float*)(ws + WS_ROPE_M), (const float*)(ws + WS_ROPE_D), (const float*)(ws + WS_ROPE_I), F.ctl + CW_VMAX, nullptr, nullptr};
            GEMM_RUN(epi::EpiIn<false>, g, S, E); }
        if (rep + 1 < NREP(1)) xcd_barrier(bar); }
    }
    SEAM(1);
    if (IN(2)) { for (int rep = 0; rep < NREP(2); ++rep) { PHASE_BEGIN();
        { pg8::Gemm g{(const bf16_t*)(ws + WS_CQ), (const bf16_t*)(ws + WS_WUQ8), NTOK, 3072, 512, 512}; pg8::StaticOrder S; S.init(NTOK, 3072, F.G, (int)blockIdx.x);
          epi::EpiUp E{ws + WS_QN, ws + WS_QR, 8, 2048, 1024, false, (const u64*)(F.ctl + CW_SSQ_CQ), 1.0f / 1024.0f, (const float*)(ws + WS_ROPE_M), (const float*)(ws + WS_SWUQ), F.ctl + CW_VMAX + 64};
          GEMM_RUN(epi::EpiUp, g, S, E); }
        __syncthreads();
        { pg8::Gemm g{(const bf16_t*)(ws + WS_CKV), (const bf16_t*)(ws + WS_WUKV8), MK, 4096, 256, 256}; pg8::StaticOrder S; S.init(MK, 4096, F.G, (int)blockIdx.x);
          epi::EpiUp E{ws + WS_KN, ws + WS_VA, 8, 2048, 4096, true, (const u64*)(F.ctl + CW_SSQ_CKV), 1.0f / 512.0f, nullptr, (const float*)(ws + WS_SWUKV), F.ctl + CW_VMAX + 64};
          GEMM_RUN(epi::EpiUp, g, S, E); }
        __syncthreads();
        p2_indexer(F, rep);
        if (rep + 1 < NREP(2)) xcd_barrier(bar); }
    }
    SEAM(2);
    if (IN(3)) { for (int rep = 0; rep < NREP(3); ++rep) { PHASE_BEGIN(); p3_attention(F, 2 + rep); if (rep + 1 < NREP(3)) xcd_barrier(bar); } }
    SEAM(3);
    if (IN(4)) { for (int rep = 0; rep < NREP(4); ++rep) { PHASE_BEGIN();
        pg8::Gemm g{(const bf16_t*)(ws + WS_OAB), (const bf16_t*)(ws + WS_WBR), NTOK, 4096, 2048, 1024}; pg8::StaticOrder2 S; S.init(NTOK, 4096, F.G, (int)blockIdx.x);
        epi::EpiBranch E{(const bf16_t*)(ws + WS_GA), (const bf16_t*)(ws + WS_GB), (bf16_t*)(ws + WS_MRG), (const unsigned*)(F.ctl + CW_VMAX), (const float*)(ws + WS_SWBR)};
        GEMM_RUN2(epi::EpiBranch, g, S, E);
        if (rep + 1 < NREP(4)) xcd_barrier(bar); }
    }
    SEAM(4);
    if (IN(5)) { for (int rep = 0; rep < NREP(5); ++rep) { PHASE_BEGIN();
        rowquant_fp8(F, ws + WS_MRG, (size_t)DM * 2, ws + WS_MRG, (size_t)DM * 2, (float*)(ws + WS_SMRG), NTOK);
        xcd_barrier(bar);
        pg8::Gemm g{(const bf16_t*)(ws + WS_MRG), (const bf16_t*)(ws + WS_WOUT), NTOK, 4096, 4096, 2048}; pg8::StaticOrder S; S.init(NTOK, 4096, F.G, (int)blockIdx.x);
        epi::EpiOut E{F.in(0), F.in(1), (float*)(ws + WS_H1F), (bf16_t*)(ws + WS_H1B), rep ? nullptr : (u64*)(F.ctl + CW_SSQ_H1), (const float*)(ws + WS_SMRG), (const float*)(ws + WS_SWOUT)};
        GEMM_RUN(epi::EpiOut, g, S, E);
        if (rep + 1 < NREP(5)) xcd_barrier(bar); }
    }
    SEAM(5);
    if (IN(6)) { for (int rep = 0; rep < NREP(6); ++rep) { PHASE_BEGIN();
        pg8::Gemm g{(const bf16_t*)(ws + WS_H1B), (const bf16_t*)(ws + WS_WQ), NTOK, 2048, 4096, 4096}; pg8::StaticOrder S; S.init(NTOK, 2048, F.G, (int)blockIdx.x);
        epi::EpiPQ E{(bf16_t*)(ws + WS_PQ), (const u64*)(F.ctl + CW_SSQ_H1)};
        GEMM_RUN(epi::EpiPQ, g, S, E);
        if (rep + 1 < NREP(6)) xcd_barrier(bar); }
    }
    SEAM(6);
    if (IN(7)) { for (int rep = 0; rep < NREP(7); ++rep) { PHASE_BEGIN();
        if (F.wave & 4) { p6_tables(F); p7_routing(F); } else { p7_routing(F); p6_tables(F); }
        if (rep + 1 < NREP(7)) xcd_barrier(bar); } }
    SEAM(7);
    if (IN(8)) { for (int rep = 0; rep < NREP(8); ++rep) { PHASE_BEGIN(); p8_experts(F); if (rep + 1 < NREP(8)) xcd_barrier(bar); } }
#ifdef MK_PROBE_T
    {   PHASE_BEGIN();
        xcd_barrier(bar); STAMP(9); xcd_barrier(bar);
        const volatile u64* ts = (const volatile u64*)(F.ctl + 2048);
        const float tot = (float)(ts[9] - ts[0]);
        const float f1 = (float)(ts[MK_PROBE_K1 + 1] - ts[MK_PROBE_K1]) / tot, f2 = (float)(ts[MK_PROBE_K2 + 1] - ts[MK_PROBE_K2]) / tot;
        float* o = F.out(); const size_t gt = (size_t)blockIdx.x * 512 + F.tid, NGT = (size_t)gridDim.x * 512;
        for (size_t i = gt; i < (size_t)NB * SEQ * DM / 4; i += NGT) { f32x4 v = ((f32x4*)o)[i]; v = v * (1.0f - f1); if (i == 0) v[0] = 1000.0f * f2; ((f32x4*)o)[i] = v; }
    }
#endif
#undef IN
#undef SEAM
}

extern "C" void kernel_launch(void* const* d_in, const int* in_sizes, int n_in, void* d_out, int out_size, void* d_ws, size_t ws_size, hipStream_t stream) {
    static int grid = 0;
    if (grid == 0) {
        if (n_in != 16 || in_sizes[0] != NB * SEQ * DM || out_size != NB * SEQ * DM || ws_size < WS_END) {
            fprintf(stderr, "kernel_launch: unexpected problem shape (n_in %d, in0 %d, out %d, ws %zu < %zu); nothing launched\n", n_in, n_in > 0 ? in_sizes[0] : -1, out_size, ws_size, (size_t)WS_END); grid = -1; return; }
        int dev = 0, cus = 0, per_cu = 0;
        if (hipGetDevice(&dev) != hipSuccess || hipDeviceGetAttribute(&cus, hipDeviceAttributeMultiprocessorCount, dev) != hipSuccess) { grid = -1; return; }
        if (hipFuncSetAttribute((const void*)mk_fwd, hipFuncAttributeMaxDynamicSharedMemorySize, LDS_BYTES) != hipSuccess) { fprintf(stderr, "kernel_launch: hipFuncSetAttribute failed\n"); grid = -1; return; }
        if (hipOccupancyMaxActiveBlocksPerMultiprocessor(&per_cu, (const void*)mk_fwd, NWAVES * 64, LDS_BYTES) != hipSuccess || per_cu < 1) {
            fprintf(stderr, "kernel_launch: occupancy query reports %d workgroups per CU\n", per_cu); }
        (void)hipGetLastError();
        grid = cus;
    }
    if (grid < 0) return;
    if (hipMemsetAsync((char*)d_ws + WS_CTL, 0, CTL_ZERO_BYTES, stream) != hipSuccess) return;
    Args a{};
    for (int i = 0; i < 16; ++i) a.in[i] = (const float*)d_in[i];
    a.out = (float*)d_out; a.ws = (unsigned char*)d_ws;
#if MK_PER_PHASE
    for (int p = 0; p <= MK_LAST_PHASE; ++p) { a.ph_lo = p; a.ph_hi = p + 1; hipLaunchKernelGGL(mk_fwd, dim3(grid), dim3(NWAVES * 64), LDS_BYTES, stream, a); }
#else
    a.ph_lo = 0; a.ph_hi = MK_LAST_PHASE + 1;
    hipLaunchKernelGGL(mk_fwd, dim3(grid), dim3(NWAVES * 64), LDS_BYTES, stream, a);
#endif
}
```

```cpp
#include <hip/hip_runtime.h>
#include <cstdio>
#include <cstdint>

#define LAS __attribute__((address_space(3)))
#define GAS __attribute__((address_space(1)))
typedef unsigned short bf16_t;
typedef short bf16x8 __attribute__((ext_vector_type(8)));
typedef short s16x4 __attribute__((ext_vector_type(4)));
typedef float f32x2 __attribute__((ext_vector_type(2)));
typedef float f32x4 __attribute__((ext_vector_type(4)));
typedef float f32x16 __attribute__((ext_vector_type(16)));
typedef unsigned u32x2 __attribute__((ext_vector_type(2)));
typedef unsigned u32x4 __attribute__((ext_vector_type(4)));
typedef GAS unsigned gu32;

#ifndef MK_PER_PHASE
#define MK_PER_PHASE 0
#endif
#ifndef MK_LAST_PHASE
#define MK_LAST_PHASE 8
#endif

constexpr int NB = 4, SEQ = 4096, DM = 4096, NMETA = 16, TR = SEQ + NMETA  , TP = 4224  , M = NB * TP  ;
constexpr float EPS = 1e-6f;
constexpr int NV1 = 14080;
constexpr float LOG2E = 1.4426950408889634f;
constexpr float QB_SCALE = 0.08838834764831845f * LOG2E;
constexpr float QA_SCALE = 0.07216878364870323f * LOG2E;
constexpr int NWAVES = 8;
constexpr int NTOK = NB * SEQ;
constexpr int MK = NTOK + 256;
constexpr int MW = 130;
__device__ __forceinline__ int row_pos(int row) { return row < NTOK ? NMETA + (row & (SEQ - 1)) : row - NTOK; }
__device__ __forceinline__ int pos_row(int b, int p) { return p < NMETA ? NTOK + p : b * SEQ + (p - NMETA); }

constexpr size_t HM = 512u * 1024u;
constexpr size_t WS_CTL = 0, CTL_ZERO_BYTES = 2 * HM;
constexpr size_t WS_ROPE_M = 2 * HM;
constexpr size_t WS_ROPE_D = 5 * HM;
constexpr size_t WS_ROPE_I = 7 * HM;
constexpr size_t WS_SK   = 8 * HM;
constexpr size_t WS_WUQ  = 10 * HM;
constexpr size_t WS_WUKV = 22 * HM;
constexpr size_t WS_WBR  = 30 * HM;
constexpr size_t WS_WOUT = 94 * HM;
constexpr size_t WS_WQ   = 158 * HM;
constexpr size_t WS_EID  = 190 * HM;
constexpr size_t WS_GATE = 207 * HM;
constexpr size_t WS_MASK = 224 * HM;
constexpr size_t WS_KPE  = 242 * HM;
constexpr size_t WS_KIX  = 247 * HM;
constexpr size_t WS_WIX  = 252 * HM;
constexpr size_t WS_SCU  = 255 * HM;
constexpr size_t WS_SCV  = 255 * HM + 65536;
constexpr size_t WS_SX   = 255 * HM + 131072;
constexpr size_t WS_SW   = 255 * HM + 200704;
constexpr size_t WS_SWBR = 255 * HM + 294912;
constexpr size_t WS_SWOUT= 255 * HM + 311296;
constexpr size_t WS_SOAB = 255 * HM + 327680;
constexpr size_t WS_SMRG = 255 * HM + 393216;
constexpr size_t R23 = 260 * HM;
constexpr size_t WS_XN   = R23;
constexpr size_t WS_WIN  = R23 + 264 * HM;
constexpr size_t P1O = R23 + 484 * HM;
constexpr size_t WS_CQ   = P1O;
constexpr size_t WS_CKV  = P1O + 66 * HM;
constexpr size_t WS_QB   = P1O + 99 * HM;
constexpr size_t WS_KB   = P1O + 231 * HM;
constexpr size_t WS_VB   = P1O + 264 * HM;
constexpr size_t WS_QIX  = P1O + 297 * HM;
constexpr size_t WS_GA   = P1O + 363 * HM;
constexpr size_t WS_GB   = P1O + 627 * HM;
constexpr size_t R4 = P1O + 892 * HM;
constexpr size_t WS_OAB  = R4;
constexpr size_t WS_XN8  = R4;
constexpr size_t WS_WG8  = R4 + 132 * HM;
constexpr size_t WS_WUQ8 = R4 + 232 * HM;
constexpr size_t WS_WUKV8= R4 + 238 * HM;
constexpr size_t WS_SWUQ = 255 * HM + 458752;
constexpr size_t WS_SWUKV= 255 * HM + 475136;
constexpr size_t WS_PQ   = R4;
constexpr size_t WS_END  = R4 + 264 * HM;
constexpr size_t WS_QN   = R23;
constexpr size_t WS_QR   = R23 + 132 * HM;
constexpr size_t WS_KN   = R23 + 198 * HM;
constexpr size_t WS_VA   = R23 + 330 * HM;
constexpr size_t WS_MRG  = R23;
constexpr size_t WS_U    = R23;
constexpr size_t WS_V    = R23 + 256 * HM;
constexpr size_t WS_H1F  = R23 + 512 * HM;
constexpr size_t WS_H1B  = R23 + 1040 * HM;
static_assert(WS_VA + 132 * HM <= P1O && WS_H1F >= P1O && WS_H1B + 264 * HM <= R4 && WS_GB + 264 * HM <= R4, "ws map");
constexpr int CW_TMO = 0;
constexpr int CW_BAR = 4096;
constexpr int CW_QUEUE = 8192;
constexpr int CW_VMAX = 12288;
constexpr int CW_SSQ_CQ = 16384, CW_SSQ_CKV = 16384 + 2 * 17408, CW_SSQ_H1 = 16384 + 4 * 17408;
static_assert((CW_SSQ_H1 + 2 * 17408) * 4 <= (int)CTL_ZERO_BYTES, "ctl");

constexpr int RING_BYTES = 131072;
constexpr int LDSCTL_OFF = RING_BYTES;
constexpr int LDS_BYTES = 147456;

__device__ __forceinline__ unsigned f2bf(float f) { unsigned u = __float_as_uint(f); return (u + 0x7fffu + ((u >> 16) & 1u)) >> 16; }
__device__ __forceinline__ unsigned pk2(float lo, float hi) { return f2bf(lo) | (f2bf(hi) << 16); }
typedef __bf16 bf16x2_t __attribute__((ext_vector_type(2)));
__device__ __forceinline__ unsigned cvt_pk_bf16(float lo, float hi) { return __builtin_bit_cast(unsigned, __builtin_convertvector((f32x2){lo, hi}, bf16x2_t)); }
__device__ __forceinline__ float bf_lo(unsigned w) { return __uint_as_float(w << 16); }
__device__ __forceinline__ float bf_hi(unsigned w) { return __uint_as_float(w & 0xffff0000u); }
__device__ __forceinline__ u32x4 pack8(f32x4 a, f32x4 b) { u32x4 w; w.x = cvt_pk_bf16(a[0], a[1]); w.y = cvt_pk_bf16(a[2], a[3]); w.z = cvt_pk_bf16(b[0], b[1]); w.w = cvt_pk_bf16(b[2], b[3]); return w; }
__device__ __forceinline__ float wave_sum(float v) {
#pragma unroll
    for (int o = 1; o < 64; o <<= 1) v += __shfl_xor(v, o);
    return v;
}
#define LDS_WAIT() asm volatile("s_waitcnt lgkmcnt(0)" ::: "memory")
#define VM_WAIT() asm volatile("s_waitcnt vmcnt(0)" ::: "memory")
typedef unsigned long long u64;
__device__ __forceinline__ void ssq_add(u64* p, float v) { (void)__hip_atomic_fetch_add(p, (u64)(v * 16777216.0f), __ATOMIC_RELAXED, __HIP_MEMORY_SCOPE_AGENT); }
__device__ __forceinline__ float ssq_get(const u64* p) { return (float)((double)(*p) * (1.0 / 16777216.0)); }
namespace pg8 {
#define PG8_LAS __attribute__((address_space(3)))
typedef unsigned short bf16_t;
typedef short bf16x8 __attribute__((ext_vector_type(8)));
typedef float f32x4 __attribute__((ext_vector_type(4)));
typedef unsigned u32x4 __attribute__((ext_vector_type(4)));
constexpr int BM = 256, BK = 64, HALF = 128, HTB = HALF * BK * 2  , STAGE_BYTES = 8 * HTB, NXCD = 8, WGM = 8;

__host__ __device__ __forceinline__ int lds_byte(int r, int c) { const int st = (r >> 4) * 2 + (c >> 5), rr = r & 15, cc = c & 31, ob = rr * 64 + cc * 2; return st * 1024 + (ob ^ (((ob >> 9) & 1) << 5)); }
__host__ __device__ __forceinline__ void stage_rc(int b, int& R, int& C) { const int st = b / 1024, sb = b % 1024, swz = sb ^ (((sb >> 9) & 1) << 5); R = (st >> 1) * 16 + swz / 64; C = (st & 1) * 32 + (swz % 64) / 2; }
__host__ __device__ __forceinline__ int perm32(int rho) { const int n = rho >> 4, i = rho & 15; return 8 * (i >> 2) + 4 * n + (i & 3); }

typedef int i32x4_t __attribute__((ext_vector_type(4)));
typedef int i32x8_t __attribute__((ext_vector_type(8)));
__device__ __forceinline__ i32x8_t cat8(bf16x8 lo, bf16x8 hi) { const i32x4_t a = __builtin_bit_cast(i32x4_t, lo), b = __builtin_bit_cast(i32x4_t, hi); return __builtin_shufflevector(a, b, 0, 1, 2, 3, 4, 5, 6, 7); }
__device__ __forceinline__ void mfma_f8_acc(f32x4& c, const i32x8_t a, const i32x8_t b) {
#if defined(__HIP_DEVICE_COMPILE__)
    int sc = 0x7F7F7F7F;
    asm volatile("v_mfma_scale_f32_16x16x128_f8f6f4 %0, %1, %2, %0, %3, %3 op_sel_hi:[0,0,0]" : "+v"(c) : "v"(a), "v"(b), "v"(sc));
#else
    (void)c; (void)a; (void)b;
#endif
}
struct Unit { int pm, pn, kh; };
struct Gemm { const bf16_t* A; const bf16_t* Bt; int M, N, K, KL; };

struct StaticOrder {
    int nM, nN, nwg, G, c;
    __host__ __device__ void init(int M, int N, int G_, int c_) { nM = M / BM; nN = N / BM; nwg = nM * nN; G = G_; c = c_; }
    __host__ __device__ bool next(int i, Unit& u) const {
        const long L = (long)i * G + c; if (L >= nwg) return false;
        int wgid = (int)L; { const int q = nwg / NXCD, r = nwg % NXCD, xcd = wgid % NXCD, off = wgid / NXCD; wgid = (xcd < r ? xcd * (q + 1) : r * (q + 1) + (xcd - r) * q) + off; }
        const int nig = WGM * nN, gid = wgid / nig, fm = gid * WGM, gsz = (nM - fm) < WGM ? (nM - fm) : WGM;
        u.pm = fm + ((wgid % nig) % gsz); u.pn = (wgid % nig) / gsz; u.kh = 0; return true;
    }
    __device__ __forceinline__ void a_ready(const Unit&) const {}
    __device__ __forceinline__ void done(const Unit&) const {}
};

struct StaticOrder2 {
    StaticOrder base;
    __host__ __device__ void init(int M, int N, int G_, int c_) { base.init(M, N, G_, c_); }
    __host__ __device__ bool next(int i, Unit& u) const { if (!base.next(i >> 1, u)) return false; u.kh = i & 1; return true; }
    __device__ __forceinline__ void a_ready(const Unit&) const {}
    __device__ __forceinline__ void done(const Unit&) const {}
};

template <class Epi, class Sched, bool ALIGN_EPI = false, bool SP2 = false>
__device__ __forceinline__ void gemm_phase(PG8_LAS unsigned char* lds, const Gemm g, const Sched& S, const Epi& E) {
    int tid_; asm volatile("v_mov_b32 %0, %1" : "=v"(tid_) : "v"(threadIdx.x));
    const int tid = tid_, wid = __builtin_amdgcn_readfirstlane(tid >> 6), lane = tid & 63, wr = wid >> 2, wc = wid & 3, fr = lane & 15, fq = lane >> 4;
    const int K = g.K, nt = g.KL / BK; const size_t khoff = (size_t)g.KL * 2;
    unsigned voffA[2], voffB[2];
#pragma unroll
    for (int i = 0; i < 2; ++i) { int R, C; stage_rc(tid * 16 + i * 8192, R, C); const int Rb = Epi::PERM ? ((R & ~31) + perm32(R & 31)) : R;
        voffA[i] = (unsigned)(R * K + C) * 2u; voffB[i] = (unsigned)(Rb * K + C) * 2u; }
    const size_t kstep = (size_t)(BK * 2);
    const size_t hstep = (size_t)HALF * K * 2;
    const size_t tstep = 2 * hstep;
    const unsigned ldsw = (unsigned)wid * 1024u;
    const int aoff = lds_byte(wr * 64 + fr, fq * 8), boff = lds_byte(wc * 32 + fr, fq * 8);
#define PG8_SA(b, h) (((b) * 2 + (h)) * HTB)
#define PG8_SB(b, h) ((4 + (b) * 2 + (h)) * HTB)
#define PG8_STAGE(bufoff, gbase, voff) do { _Pragma("unroll") for (int _i = 0; _i < 2; ++_i) \
        __builtin_amdgcn_global_load_lds((const unsigned*)((const char*)(gbase) + (voff)[_i]), (PG8_LAS unsigned*)(lds + (bufoff) + ldsw + _i * 8192), 16, 0, 0); } while (0)
#define PG8_LDA(dst, b, h) do { _Pragma("unroll") for (int m = 0; m < 4; ++m) _Pragma("unroll") for (int k = 0; k < 2; ++k) dst[m][k] = *(const PG8_LAS bf16x8*)(lds + PG8_SA(b, h) + aoff + m * 2048 + k * 1024); } while (0)
#define PG8_LDB(dst, b, h) do { _Pragma("unroll") for (int n = 0; n < 2; ++n) _Pragma("unroll") for (int k = 0; k < 2; ++k) dst[n][k] = *(const PG8_LAS bf16x8*)(lds + PG8_SB(b, h) + boff + n * 2048 + k * 1024); } while (0)
#define PG8_MMA(ai, bj, At, Bt) do { __builtin_amdgcn_s_setprio(1); _Pragma("unroll") for (int m = 0; m < 4; ++m) _Pragma("unroll") for (int n = 0; n < 2; ++n) { \
        if constexpr (Epi::FP8) mfma_f8_acc(acc[ai][bj][m][n], cat8(Bt[n][0], Bt[n][1]), cat8(At[m][0], At[m][1])); \
        else { _Pragma("unroll") for (int k = 0; k < 2; ++k) acc[ai][bj][m][n] = __builtin_amdgcn_mfma_f32_16x16x32_bf16(Bt[n][k], At[m][k], acc[ai][bj][m][n], 0, 0, 0); } } \
        __builtin_amdgcn_s_setprio(0); } while (0)
#define PG8_WAIT_V(n) asm volatile("s_waitcnt vmcnt(" #n ")" ::: "memory")
#define PG8_WAIT_L(n) asm volatile("s_waitcnt lgkmcnt(" #n ")" ::: "memory")
#define PG8_BAR __builtin_amdgcn_s_barrier()
#define PG8_SCHED __builtin_amdgcn_sched_barrier(0)
    Unit cur, nxt; int ui = 0;
    if (!S.next(0, cur)) return;
    f32x4 acc[2][2][4][2];
#pragma unroll
    for (int a = 0; a < 2; ++a)
#pragma unroll
        for (int b = 0; b < 2; ++b)
#pragma unroll
            for (int m = 0; m < 4; ++m)
#pragma unroll
                for (int n = 0; n < 2; ++n) acc[a][b][m][n] = (f32x4){0.f, 0.f, 0.f, 0.f};
    bf16x8 At[4][2], B0[2][2], B1[2][2];
    const char* cA = (const char*)g.A + (size_t)cur.pm * tstep + (size_t)cur.kh * khoff; const char* cB = (const char*)g.Bt + (size_t)cur.pn * tstep + (size_t)cur.kh * khoff;
    S.a_ready(cur);
    if constexpr (SP2) {
        PG8_STAGE(PG8_SB(0, 0), cB, voffB); PG8_STAGE(PG8_SB(0, 1), cB + hstep, voffB); PG8_STAGE(PG8_SA(0, 0), cA, voffA); PG8_STAGE(PG8_SA(0, 1), cA + hstep, voffA);
        if (wr == 1) PG8_BAR;
        PG8_WAIT_V(2); PG8_BAR;
        PG8_STAGE(PG8_SB(1, 0), cB + kstep, voffB); PG8_STAGE(PG8_SA(1, 0), cA + kstep, voffA); PG8_STAGE(PG8_SB(1, 1), cB + hstep + kstep, voffB);
        PG8_WAIT_V(6); PG8_BAR;
    } else {
        PG8_STAGE(PG8_SB(0, 0), cB, voffB); PG8_STAGE(PG8_SA(0, 0), cA, voffA); PG8_STAGE(PG8_SB(0, 1), cB + hstep, voffB); PG8_STAGE(PG8_SA(0, 1), cA + hstep, voffA);
        if (wr == 1) PG8_BAR;
        PG8_WAIT_V(4); PG8_BAR;
        PG8_STAGE(PG8_SB(1, 0), cB + kstep, voffB); PG8_STAGE(PG8_SA(1, 0), cA + kstep, voffA); PG8_STAGE(PG8_SB(1, 1), cB + hstep + kstep, voffB);
        PG8_WAIT_V(6); PG8_BAR;
    }
    for (;;) {
        const bool has_next = S.next(ui + 1, nxt);
        const char* nA = has_next ? (const char*)g.A + (size_t)nxt.pm * tstep + (size_t)nxt.kh * khoff : cA; const char* nB = has_next ? (const char*)g.Bt + (size_t)nxt.pn * tstep + (size_t)nxt.kh * khoff : cB;
        for (int t = 0; t < nt; t += 2) {
            const bool last = (t == nt - 2);
            const char* a1 = cA + (size_t)(t + 1) * kstep;
            const char* a2 = last ? nA : cA + (size_t)(t + 2) * kstep; const char* b2 = last ? nB : cB + (size_t)(t + 2) * kstep;
            const char* a3 = a2 + kstep; const char* b3 = b2 + kstep;
            if (last && has_next) S.a_ready(nxt);
            if constexpr (SP2) {
            PG8_LDB(B0, 0, 0); PG8_LDB(B1, 0, 1); PG8_SCHED; PG8_LDA(At, 0, 0); PG8_STAGE(PG8_SA(1, 1), a1 + hstep, voffA);
            PG8_WAIT_V(8); PG8_WAIT_L(0); PG8_BAR; PG8_MMA(0, 0, At, B0); PG8_MMA(0, 1, At, B1); PG8_BAR; PG8_SCHED;
            PG8_LDA(At, 0, 1); PG8_STAGE(PG8_SB(0, 0), b2, voffB); PG8_STAGE(PG8_SB(0, 1), b2 + hstep, voffB); PG8_STAGE(PG8_SA(0, 0), a2, voffA);
            PG8_WAIT_V(8); PG8_WAIT_L(0); PG8_BAR; PG8_MMA(1, 0, At, B0); PG8_MMA(1, 1, At, B1); PG8_BAR; PG8_SCHED;
            PG8_LDB(B0, 1, 0); PG8_LDB(B1, 1, 1); PG8_SCHED; PG8_LDA(At, 1, 0); PG8_STAGE(PG8_SA(0, 1), a2 + hstep, voffA);
            PG8_WAIT_V(8); PG8_WAIT_L(0); PG8_BAR; PG8_MMA(0, 0, At, B0); PG8_MMA(0, 1, At, B1); PG8_BAR; PG8_SCHED;
            PG8_LDA(At, 1, 1); PG8_STAGE(PG8_SB(1, 0), b3, voffB); PG8_STAGE(PG8_SB(1, 1), b3 + hstep, voffB); PG8_STAGE(PG8_SA(1, 0), a3, voffA);
            PG8_WAIT_V(8); PG8_WAIT_L(0); PG8_BAR; PG8_MMA(1, 0, At, B0); PG8_MMA(1, 1, At, B1); PG8_BAR; PG8_SCHED;
            } else {
            PG8_LDB(B0, 0, 0); PG8_SCHED; PG8_LDA(At, 0, 0); PG8_STAGE(PG8_SA(1, 1), a1 + hstep, voffA);
            PG8_WAIT_L(8); PG8_BAR; PG8_WAIT_L(0); PG8_MMA(0, 0, At, B0); PG8_BAR; PG8_SCHED;
            PG8_LDB(B1, 0, 1); PG8_STAGE(PG8_SB(0, 0), b2, voffB);
            PG8_BAR; PG8_WAIT_L(0); PG8_MMA(0, 1, At, B1); PG8_BAR;
            PG8_LDA(At, 0, 1); PG8_STAGE(PG8_SA(0, 0), a2, voffA);
            PG8_BAR; PG8_WAIT_L(0); PG8_MMA(1, 0, At, B0); PG8_BAR; PG8_SCHED;
            PG8_STAGE(PG8_SB(0, 1), b2 + hstep, voffB);
            PG8_WAIT_V(6); PG8_BAR; PG8_MMA(1, 1, At, B1); PG8_BAR;
            PG8_LDB(B0, 1, 0); PG8_SCHED; PG8_LDA(At, 1, 0); PG8_STAGE(PG8_SA(0, 1), a2 + hstep, voffA);
            PG8_WAIT_L(8); PG8_BAR; PG8_WAIT_L(0); PG8_MMA(0, 0, At, B0); PG8_BAR; PG8_SCHED;
            PG8_LDB(B1, 1, 1); PG8_STAGE(PG8_SB(1, 0), b3, voffB);
            PG8_BAR; PG8_WAIT_L(0); PG8_MMA(0, 1, At, B1); PG8_BAR;
            PG8_LDA(At, 1, 1); PG8_STAGE(PG8_SA(1, 0), a3, voffA);
            PG8_BAR; PG8_WAIT_L(0); PG8_MMA(1, 0, At, B0); PG8_BAR; PG8_SCHED;
            PG8_STAGE(PG8_SB(1, 1), b3 + hstep, voffB);
            PG8_WAIT_V(6); PG8_BAR; PG8_MMA(1, 1, At, B1); PG8_BAR;
            }
        }
        if constexpr (ALIGN_EPI) { if (wr == 0) PG8_BAR; }
        if constexpr (!Epi::AFTER_DRAIN) { E(acc, cur, wr, wc, fr, fq); S.done(cur); }
        if (!has_next) break;
        if (!(Epi::SPLITK2 && cur.kh == 0))
#pragma unroll
        for (int a = 0; a < 2; ++a)
#pragma unroll
            for (int b = 0; b < 2; ++b)
#pragma unroll
                for (int m = 0; m < 4; ++m)
#pragma unroll
                    for (int n = 0; n < 2; ++n) acc[a][b][m][n] = (f32x4){0.f, 0.f, 0.f, 0.f};
        cur = nxt; cA = nA; cB = nB; ++ui;
        if constexpr (ALIGN_EPI) { if (wr == 1) PG8_BAR; }
    }
    PG8_WAIT_V(0);
    if constexpr (!ALIGN_EPI) { if (wr == 0) PG8_BAR; }
    PG8_BAR;
    if constexpr (Epi::AFTER_DRAIN) { E.fused(acc, cur, wr, wc, fr, fq, lds, wid, lane); S.done(cur); }
#undef PG8_SA
#undef PG8_SB
#undef PG8_STAGE
#undef PG8_LDA
#undef PG8_LDB
#undef PG8_MMA
#undef PG8_WAIT_V
#undef PG8_WAIT_L
#undef PG8_BAR
#undef PG8_SCHED
}
}
namespace epi {
using pg8::Unit;
typedef f32x4 Acc[2][2][4][2];

__device__ __forceinline__ void rot2(f32x4& v, const f32x4 cs) {
    const float a1 = v[0] * cs[0] - v[1] * cs[1], a2 = v[1] * cs[0] + v[0] * cs[1];
    const float b1 = v[2] * cs[2] - v[3] * cs[3], b2 = v[3] * cs[2] + v[2] * cs[3];
    v = (f32x4){a1, a2, b1, b2};
}
__device__ __forceinline__ float sigm(float x) { return 1.0f / (1.0f + __expf(-x)); }
__device__ __forceinline__ void vmax_publish(unsigned* word, float mx) {
#pragma unroll
    for (int o = 1; o < 64; o <<= 1) mx = fmaxf(mx, __shfl_xor(mx, o));
    if ((threadIdx.x & 63) == 0) atomicMax(word, __float_as_uint(mx));
}
__device__ __forceinline__ float amax8(f32x4 a, f32x4 b) { return fmaxf(fmaxf(fmaxf(fabsf(a[0]), fabsf(a[1])), fmaxf(fabsf(a[2]), fabsf(a[3]))), fmaxf(fmaxf(fabsf(b[0]), fabsf(b[1])), fmaxf(fabsf(b[2]), fabsf(b[3])))); }
__device__ __forceinline__ float sat8(float x) { return fminf(fmaxf(x, -448.0f), 448.0f); }
__device__ __forceinline__ u32x2 pack8_fp8(f32x4 a, f32x4 b) {
    int p0 = 0, p1 = 0;
    p0 = __builtin_amdgcn_cvt_pk_fp8_f32(sat8(a[0]), sat8(a[1]), p0, false); p0 = __builtin_amdgcn_cvt_pk_fp8_f32(sat8(a[2]), sat8(a[3]), p0, true);
    p1 = __builtin_amdgcn_cvt_pk_fp8_f32(sat8(b[0]), sat8(b[1]), p1, false); p1 = __builtin_amdgcn_cvt_pk_fp8_f32(sat8(b[2]), sat8(b[3]), p1, true);
    return (u32x2){(unsigned)p0, (unsigned)p1};
}

template <bool F8> struct EpiIn {
    static constexpr bool PERM = true, AFTER_DRAIN = false, SPLITK2 = false, FP8 = F8;
    bf16_t *cq, *ckv, *qb, *kb, *vb, *qix, *kpe, *kix, *ga, *gb; float* wix; u64 *ssq_cq, *ssq_ckv;
    const float *ropeM, *ropeD, *ropeI;
    unsigned* vmaxw;
    const float *sx, *sw;
    __device__ __forceinline__ void operator()(const Acc& acc, const Unit& u, int wr, int wc, int fr, int fq) const {
        const int vt = F8 ? (u.pn < 18 ? u.pn : u.pn + 5) : u.pn + 18, rowb = u.pm * 256 + wr * 64 + fr, ct = wc * 32 + 8 * fq;
        f32x4 wsc[2][2];
        if (F8) {
#pragma unroll
            for (int bj = 0; bj < 2; ++bj) { const f32x4* p = (const f32x4*)(sw + u.pn * 256 + ct + bj * 128); wsc[bj][0] = p[0]; wsc[bj][1] = p[1]; }
        }
#define AV(ai_, bj_, m_, n_) (F8 ? acc[ai_][bj_][m_][n_] * rs * wsc[bj_][n_] : acc[ai_][bj_][m_][n_])
        if (vt < 6) {
            bf16_t* dst = vt < 4 ? cq : ckv; const int ld = vt < 4 ? 1024 : 512, cb = (vt < 4 ? vt : vt - 4) * 256 + ct; u64* ssq = vt < 4 ? ssq_cq : ssq_ckv;
#pragma unroll
            for (int ai = 0; ai < 2; ++ai)
#pragma unroll
                for (int m = 0; m < 4; ++m) { const int row = rowb + ai * 128 + m * 16; const float rs = F8 ? sx[row] : 1.f; (void)rs; float s = 0.f;
#pragma unroll
                    for (int bj = 0; bj < 2; ++bj) { const f32x4 v0 = AV(ai, bj, m, 0), v1 = AV(ai, bj, m, 1);
                        s += (v0[0] * v0[0] + v0[1] * v0[1]) + (v0[2] * v0[2] + v0[3] * v0[3]) + (v1[0] * v1[0] + v1[1] * v1[1]) + (v1[2] * v1[2] + v1[3] * v1[3]);
                        *(u32x2*)((unsigned char*)dst + (size_t)row * ld + cb + bj * 128) = pack8_fp8(v0, v1); }
                    s += __shfl_xor(s, 16); s += __shfl_xor(s, 32);
                    if (fq == 0 && ssq) ssq_add(ssq + row, s); }
        } else if (vt < 16) {
            const bool isq = vt < 14; bf16_t* dst = isq ? qb : kb; const int ld = isq ? 2048 : 512, cb = (isq ? vt - 6 : vt - 14) * 256 + ct;
#pragma unroll
            for (int ai = 0; ai < 2; ++ai)
#pragma unroll
                for (int m = 0; m < 4; ++m) { const int row = rowb + ai * 128 + m * 16, t = row_pos(row); const float rs = F8 ? sx[row] : 1.f; (void)rs;
                    f32x4 cs0 = (f32x4){1.f, 0.f, 1.f, 0.f}, cs1 = cs0;
                    if (wc == 0) { const f32x4* p = (const f32x4*)(ropeD + ((size_t)t * 16 + 4 * fq) * 2); cs0 = p[0]; cs1 = p[1]; }
#pragma unroll
                    for (int bj = 0; bj < 2; ++bj) { f32x4 v0 = AV(ai, bj, m, 0), v1 = AV(ai, bj, m, 1);
                        if (wc == 0) { rot2(v0, cs0); rot2(v1, cs1); }
                        *(u32x2*)((unsigned char*)dst + (size_t)row * ld + cb + bj * 128) = pack8_fp8(v0, v1); } }
        } else if (vt < 18) {
            const int cb = (vt - 16) * 256 + ct; float vmx = 0.f;
#pragma unroll
            for (int ai = 0; ai < 2; ++ai)
#pragma unroll
                for (int m = 0; m < 4; ++m) { const int row = rowb + ai * 128 + m * 16; const float rs = F8 ? sx[row] : 1.f; (void)rs;
#pragma unroll
                    for (int bj = 0; bj < 2; ++bj) { const f32x4 v0 = AV(ai, bj, m, 0), v1 = AV(ai, bj, m, 1); vmx = fmaxf(vmx, amax8(v0, v1)); *(u32x4*)(vb + (size_t)row * 512 + cb + bj * 128) = pack8(v0, v1); } }
            vmax_publish(vmaxw, vmx);
        } else if (vt < 22) {
            const int cb = (vt - 18) * 256 + ct; const bool rt = ((wc & 1) == 0) && (fq < 2);
#pragma unroll
            for (int ai = 0; ai < 2; ++ai)
#pragma unroll
                for (int m = 0; m < 4; ++m) { const int row = rowb + ai * 128 + m * 16, t = row_pos(row); const float rs = F8 ? sx[row] : 1.f; (void)rs;
                    f32x4 cs0 = (f32x4){1.f, 0.f, 1.f, 0.f}, cs1 = cs0;
                    if (rt) { const f32x4* p = (const f32x4*)(ropeI + ((size_t)t * 8 + 4 * fq) * 2); cs0 = p[0]; cs1 = p[1]; }
#pragma unroll
                    for (int bj = 0; bj < 2; ++bj) { f32x4 v0 = AV(ai, bj, m, 0), v1 = AV(ai, bj, m, 1);
                        if (rt) { rot2(v0, cs0); rot2(v1, cs1); }
                        *(u32x4*)(qix + (size_t)row * 1024 + cb + bj * 128) = pack8(v0, v1); } }
        } else if (vt == 22) {
#pragma unroll
            for (int ai = 0; ai < 2; ++ai)
#pragma unroll
                for (int m = 0; m < 4; ++m) { const int row = rowb + ai * 128 + m * 16, t = row_pos(row); const float rs = F8 ? sx[row] : 1.f; (void)rs;
                    f32x4 v0 = AV(ai, 0, m, 0), v1 = AV(ai, 0, m, 1);
                    if (wc < 2) { const f32x4* p = (const f32x4*)(ropeM + ((size_t)t * 32 + 16 * wc + 4 * fq) * 2); rot2(v0, p[0]); rot2(v1, p[1]);
                        *(u32x2*)((unsigned char*)kpe + (size_t)row * 64 + ct) = pack8_fp8(v0, v1);
                    } else { if (wc == 2 && fq < 2) { const f32x4* p = (const f32x4*)(ropeI + ((size_t)t * 8 + 4 * fq) * 2); rot2(v0, p[0]); rot2(v1, p[1]); }
                        *(u32x4*)(kix + (size_t)row * 64 + (ct - 64)) = pack8(v0, v1); }
                    if (wc == 0 && fq < 2) { float* w = wix + (size_t)row * 16 + 8 * fq; *(f32x4*)w = AV(ai, 1, m, 0); *(f32x4*)(w + 4) = AV(ai, 1, m, 1); } }
        } else {
            const bool isa = vt < 39; bf16_t* dst = isa ? ga : gb; const int cb = (isa ? vt - 23 : vt - 39) * 256 + ct;
#pragma unroll
            for (int ai = 0; ai < 2; ++ai)
#pragma unroll
                for (int m = 0; m < 4; ++m) { const int row = rowb + ai * 128 + m * 16; const float rs = F8 ? sx[row] : 1.f; (void)rs;
#pragma unroll
                    for (int bj = 0; bj < 2; ++bj) { f32x4 v0 = AV(ai, bj, m, 0), v1 = AV(ai, bj, m, 1);
#pragma unroll
                        for (int e = 0; e < 4; ++e) { v0[e] = sigm(v0[e]); v1[e] = sigm(v1[e]); }
                        *(u32x4*)(dst + (size_t)row * 4096 + cb + bj * 128) = pack8(v0, v1); } }
        }
#undef AV
    }
};

struct EpiUp {
    static constexpr bool PERM = true, AFTER_DRAIN = false, SPLITK2 = false, FP8 = true;
    unsigned char *d0, *d1; int nt0, ld0, ld1; bool d1_bf16; const u64* ssq; float invK; const float* rope; const float* sw; unsigned* vmaxw;
    __device__ __forceinline__ void operator()(const Acc& acc, const Unit& u, int wr, int wc, int fr, int fq) const {
        const int vt = u.pn, rowb = u.pm * 256 + wr * 64 + fr, ct = wc * 32 + 8 * fq; const bool first = vt < nt0;
        unsigned char* dst = first ? d0 : d1; const int ld = first ? ld0 : ld1, cb = (first ? vt : vt - nt0) * 256 + ct; const bool rt = (!first) && (rope != nullptr), wide = (!first) && d1_bf16;
        f32x4 w0[2], w1[2]; float vmx = 0.f;
#pragma unroll
        for (int bj = 0; bj < 2; ++bj) { const f32x4* p = (const f32x4*)(sw + vt * 256 + ct + bj * 128); w0[bj] = p[0]; w1[bj] = p[1]; }
#pragma unroll
        for (int ai = 0; ai < 2; ++ai)
#pragma unroll
            for (int m = 0; m < 4; ++m) { const int row = rowb + ai * 128 + m * 16, t = row_pos(row);
                const float rs = __builtin_amdgcn_rsqf(ssq_get(ssq + row) * invK + EPS);
                f32x4 cs0 = (f32x4){1.f, 0.f, 1.f, 0.f}, cs1 = cs0;
                if (rt) { const f32x4* p = (const f32x4*)(rope + ((size_t)t * 32 + 16 * (wc & 1) + 4 * fq) * 2); cs0 = p[0]; cs1 = p[1]; }
#pragma unroll
                for (int bj = 0; bj < 2; ++bj) { f32x4 v0 = acc[ai][bj][m][0] * rs * w0[bj], v1 = acc[ai][bj][m][1] * rs * w1[bj];
                    if (rt) { rot2(v0, cs0); rot2(v1, cs1); }
                    if (wide) { vmx = fmaxf(vmx, amax8(v0, v1)); *(u32x4*)(dst + (size_t)row * ld + (size_t)(cb + bj * 128) * 2) = pack8(v0, v1); }
                    else *(u32x2*)(dst + (size_t)row * ld + cb + bj * 128) = pack8_fp8(v0, v1); } }
        if (wide) vmax_publish(vmaxw, vmx);
    }
};

struct EpiBranch {
    static constexpr bool PERM = true, AFTER_DRAIN = false, SPLITK2 = true, FP8 = true;
    const bf16_t *ga, *gb; bf16_t* out; const unsigned* vmaxw; const float* scol;
    __device__ __forceinline__ void operator()(Acc& acc, const Unit& u, int wr, int wc, int fr, int fq) const {
        const int rowb = u.pm * 256 + wr * 64 + fr, cb = u.pn * 256 + wc * 32 + 8 * fq;
        const float vmb = fmaxf(__uint_as_float(vmaxw[0]), 1e-30f), vma = fmaxf(__uint_as_float(vmaxw[64]), 1e-30f);
        if (u.kh == 0) {
            const float rab = vma * __builtin_amdgcn_rcpf(vmb);
#pragma unroll
            for (int ai = 0; ai < 2; ++ai)
#pragma unroll
                for (int m = 0; m < 4; ++m) { const size_t ro = (size_t)(rowb + ai * 128 + m * 16) * 4096 + cb;
#pragma unroll
                    for (int bj = 0; bj < 2; ++bj) { const u32x4 a = *(const u32x4*)(ga + ro + bj * 128), b = *(const u32x4*)(gb + ro + bj * 128);
                        f32x4 r0, r1;
#define RQ(x, y) ((x) * __builtin_amdgcn_rcpf(y))
                        r0[0] = RQ(bf_lo(a.x), bf_lo(b.x)); r0[1] = RQ(bf_hi(a.x), bf_hi(b.x)); r0[2] = RQ(bf_lo(a.y), bf_lo(b.y)); r0[3] = RQ(bf_hi(a.y), bf_hi(b.y));
                        r1[0] = RQ(bf_lo(a.z), bf_lo(b.z)); r1[1] = RQ(bf_hi(a.z), bf_hi(b.z)); r1[2] = RQ(bf_lo(a.w), bf_lo(b.w)); r1[3] = RQ(bf_hi(a.w), bf_hi(b.w));
#undef RQ
                        acc[ai][bj][m][0] = acc[ai][bj][m][0] * (r0 * rab); acc[ai][bj][m][1] = acc[ai][bj][m][1] * (r1 * rab); }
                    asm volatile("" ::: "memory"); }
        } else {
            f32x4 w0[2], w1[2];
#pragma unroll
            for (int bj = 0; bj < 2; ++bj) { const f32x4* p = (const f32x4*)(scol + cb + bj * 128); w0[bj] = p[0]; w1[bj] = p[1]; }
#pragma unroll
            for (int ai = 0; ai < 2; ++ai)
#pragma unroll
                for (int m = 0; m < 4; ++m) { const int row = rowb + ai * 128 + m * 16; const size_t ro = (size_t)row * 4096 + cb; const float rs = vmb * (1.0f / 440.0f);
#pragma unroll
                    for (int bj = 0; bj < 2; ++bj) { const u32x4 b = *(const u32x4*)(gb + ro + bj * 128);
                        const f32x4 s0 = (f32x4){bf_lo(b.x), bf_hi(b.x), bf_lo(b.y), bf_hi(b.y)} * rs * w0[bj], s1 = (f32x4){bf_lo(b.z), bf_hi(b.z), bf_lo(b.w), bf_hi(b.w)} * rs * w1[bj];
                        *(u32x4*)(out + ro + bj * 128) = pack8(acc[ai][bj][m][0] * s0, acc[ai][bj][m][1] * s1); } }
        }
    }
};

struct EpiOut {
    static constexpr bool PERM = true, AFTER_DRAIN = false, SPLITK2 = false, FP8 = true;
    const float *x, *meta; float* h1f; bf16_t* h1b; u64* ssq; const float *srow, *scol;
    __device__ __forceinline__ void operator()(const Acc& acc, const Unit& u, int wr, int wc, int fr, int fq) const {
        const int rowb = u.pm * 256 + wr * 64 + fr, cb = u.pn * 256 + wc * 32 + 8 * fq;
#pragma unroll
        for (int ai = 0; ai < 2; ++ai)
#pragma unroll
            for (int m = 0; m < 4; ++m) { const int row = rowb + ai * 128 + m * 16;
                const float* src = x + (size_t)row * DM;
                float s = 0.f; const float rs = srow[row];
#pragma unroll
                for (int bj = 0; bj < 2; ++bj) { const f32x4* wp = (const f32x4*)(scol + cb + bj * 128); f32x4 v0 = acc[ai][bj][m][0] * rs * wp[0], v1 = acc[ai][bj][m][1] * rs * wp[1];
                    v0 = v0 + *(const f32x4*)(src + cb + bj * 128); v1 = v1 + *(const f32x4*)(src + cb + bj * 128 + 4);
                    s += (v0[0] * v0[0] + v0[1] * v0[1]) + (v0[2] * v0[2] + v0[3] * v0[3]) + (v1[0] * v1[0] + v1[1] * v1[1]) + (v1[2] * v1[2] + v1[3] * v1[3]);
                    *(u32x4*)(h1b + (size_t)row * DM + cb + bj * 128) = pack8(v0, v1); }
                s += __shfl_xor(s, 16); s += __shfl_xor(s, 32);
                if (fq == 0 && ssq) ssq_add(ssq + row, s); }
    }
};

struct EpiPQ {
    static constexpr bool PERM = true, AFTER_DRAIN = false, SPLITK2 = false, FP8 = false;
    bf16_t* pq; const u64* ssq;
    __device__ __forceinline__ void operator()(const Acc& acc, const Unit& u, int wr, int wc, int fr, int fq) const {
        const int rowb = u.pm * 256 + wr * 64 + fr, cb = u.pn * 256 + wc * 32 + 8 * fq;
#pragma unroll
        for (int ai = 0; ai < 2; ++ai)
#pragma unroll
            for (int m = 0; m < 4; ++m) { const int row = rowb + ai * 128 + m * 16; const float rs = __builtin_amdgcn_rsqf(ssq_get(ssq + row) * (1.0f / DM) + EPS);
#pragma unroll
                for (int bj = 0; bj < 2; ++bj) *(u32x4*)(pq + (size_t)row * 2048 + cb + bj * 128) = pack8(acc[ai][bj][m][0] * rs, acc[ai][bj][m][1] * rs); }
    }
};
}
#define XB_TMO      128
#define XB_XCNT(j)  (256  + 64 * (j))
#define XB_XSUB(j)  (1280 + 64 * (j))
#define XB_XGEN(j)  (2304 + 64 * (j))
#define XB_TOP      3328
#define XB_TOPGEN   3392
#define XCD_BAR_WORDS 3456
#define XB_SPIN_CAP (1u << 18)
__device__ __forceinline__ unsigned xb_ld(unsigned* p)              { return __hip_atomic_load(p, __ATOMIC_RELAXED, __HIP_MEMORY_SCOPE_AGENT); }
__device__ __forceinline__ unsigned xb_add(unsigned* p, unsigned v) { return __hip_atomic_fetch_add(p, v, __ATOMIC_RELAXED, __HIP_MEMORY_SCOPE_AGENT); }
__device__ __forceinline__ unsigned xb_xcc_id() { return (unsigned)__builtin_amdgcn_s_getreg((3 << 11) | 20) & 0xFu; }
#define XB_SPIN(cond, bar) do { unsigned _sp = 0; while (cond) { __builtin_amdgcn_s_sleep(1); \
    if ((++_sp & 255u) == 0u) { if (xb_ld(&(bar)[XB_TMO])) break; if (_sp > XB_SPIN_CAP) { atomicAdd(&(bar)[XB_TMO], 1u); break; } } } } while (0)
struct XcdBarrier { unsigned* bar; unsigned x; volatile LAS unsigned* st; };
__device__ __forceinline__ XcdBarrier xcd_barrier_post(unsigned* bar, volatile LAS unsigned* st) {
    XcdBarrier b; b.bar = bar; b.x = xb_xcc_id(); b.st = st;
    if (threadIdx.x == 0) (void)xb_add(&bar[XB_XCNT(b.x)], 1u);
    return b;
}
__device__ __forceinline__ void xcd_barrier_complete(unsigned* bar, unsigned x, unsigned& nloc, unsigned& nx) {
    const unsigned G = gridDim.x * gridDim.y * gridDim.z;
    unsigned sum, cnt, mine, sp = 0u;
    for (;;) {
        sum = 0u; cnt = 0u; mine = 0u;
#pragma unroll
        for (unsigned j = 0; j < 16; ++j) { const unsigned c = xb_ld(&bar[XB_XCNT(j)]); sum += c; cnt += (c > 0u) ? 1u : 0u; mine = (j == x) ? c : mine; }
        if (sum == G) break;
        __builtin_amdgcn_s_sleep(1);
        if ((++sp & 255u) == 0u) { if (xb_ld(&bar[XB_TMO])) break; if (sp > XB_SPIN_CAP) { atomicAdd(&bar[XB_TMO], 1u); break; } }
    }
    nloc = mine > 0u ? mine : 1u; nx = cnt > 0u ? cnt : 1u;
}
__device__ __forceinline__ void xcd_barrier(const XcdBarrier& b) {
    asm volatile("s_waitcnt vmcnt(0)" ::: "memory");
    __syncthreads();
    if (threadIdx.x == 0) {
        unsigned* bar = b.bar;
        __builtin_amdgcn_s_waitcnt(0);
        unsigned nloc = b.st[0], nx = b.st[1];
        if (nloc == 0u) { xcd_barrier_complete(bar, b.x, nloc, nx); b.st[0] = nloc; b.st[1] = nx; }
        const unsigned old = xb_add(&bar[XB_XSUB(b.x)], 1u);
        const unsigned gen = old / nloc;
        if (old + 1u == (gen + 1u) * nloc) {
            __builtin_amdgcn_fence(__ATOMIC_RELEASE, "agent");
            asm volatile("s_waitcnt vmcnt(0)" ::: "memory");
            const unsigned og = xb_add(&bar[XB_TOP], 1u);
            const unsigned tg = og / nx;
            if (og + 1u == (tg + 1u) * nx) xb_add(&bar[XB_TOPGEN], 1u);
            else XB_SPIN(xb_ld(&bar[XB_TOPGEN]) == tg, bar);
            __builtin_amdgcn_fence(__ATOMIC_ACQUIRE, "agent");
            xb_add(&bar[XB_XGEN(b.x)], 1u);
            asm volatile("s_waitcnt vmcnt(0)" ::: "memory");
        } else {
            XB_SPIN(xb_ld(&bar[XB_XGEN(b.x)]) == gen, bar);
            __builtin_amdgcn_fence(__ATOMIC_ACQUIRE, "agent");
            asm volatile("s_waitcnt vmcnt(0)" ::: "memory");
        }
    }
    __syncthreads();
}

struct Frame {
    LAS unsigned char* lds;
    unsigned char* ws;
    unsigned* ctl;
    int tid, lane, wave, vcu, G;
    __device__ __forceinline__ const float* in(int i) const { return ((const float* const __attribute__((address_space(4)))*)__builtin_amdgcn_kernarg_segment_ptr())[i]; }
    __device__ __forceinline__ float* out() const { return ((float* const __attribute__((address_space(4)))*)__builtin_amdgcn_kernarg_segment_ptr())[16]; }
};

struct MapId { __device__ __forceinline__ int operator()(int v) const { return v; } };
struct MapIn { __device__ __forceinline__ int operator()(int vn) const {
    const int v = vn < 1280 ? vn + 4608 : (vn < 5888 ? vn - 1280 : vn);
    if (v < 1536) return v;
    if (v < 3584) { const int w = v - 1536, hd = w >> 7; int o = w & 127; if (o < 32) o = (o & 1) ? (o >> 1) + 16 : (o >> 1); return 1600 + hd * 128 + o; }
    if (v < 4096) { const int w = v - 3584, hd = w >> 7; int o = w & 127; if (o < 32) o = (o & 1) ? (o >> 1) + 16 : (o >> 1); return 3648 + hd * 128 + o; }
    if (v < 4608) return 4160 + (v - 4096);
    if (v < 5632) { const int w = v - 4608, hd = w >> 6; int o = w & 63; if (o < 16) o = (o & 1) ? (o >> 1) + 8 : (o >> 1); return 4672 + hd * 64 + o; }
    if (v < 5888) { const int w = v - 5632;
        if (w < 64) return 1536 + ((w & 1) ? (w >> 1) + 32 : (w >> 1));
        if (w < 128) { int o = w - 64; if (o < 16) o = (o & 1) ? (o >> 1) + 8 : (o >> 1); return 5696 + o; }
        if (w < 144) return 5760 + (w - 128);
        return -1; }
    if (v < 9984) return 5776 + (v - 5888);
    return 9872 + (v - 9984);
} };
struct MapUq { __device__ __forceinline__ int operator()(int v) const {
    if (v < 2048) return (v >> 7) * 192 + (v & 127);
    const int w = v - 2048, hd = w >> 6, o = w & 63; return hd * 192 + 128 + ((o & 1) ? (o >> 1) + 32 : (o >> 1)); } };
struct MapUkv { __device__ __forceinline__ int operator()(int v) const {
    if (v < 2048) return (v >> 7) * 256 + (v & 127);
    const int w = v - 2048; return (w >> 7) * 256 + 128 + (w & 127); } };

template <class Map>
__device__ __forceinline__ void p0_transpose_item(const float* W, int K, int Nsrc, int Nvirt, bf16_t* WT, const float* gk, LAS float* scr, int item, int lane, Map map) {
    const int nblk = Nvirt / 32, kb = item / nblk, nb = item % nblk, k0 = 64 * kb, n0 = 32 * nb;
    const int sc = map(n0 + (lane & 31));
    float tv[32];
#pragma unroll
    for (int i = 0; i < 32; ++i) { const int kk = 2 * i + (lane >> 5); tv[i] = (sc >= 0) ? W[(size_t)(k0 + kk) * Nsrc + sc] : 0.f; }
    if (gk) {
#pragma unroll
        for (int i = 0; i < 32; ++i) tv[i] *= gk[k0 + 2 * i + (lane >> 5)]; }
#pragma unroll
    for (int i = 0; i < 32; ++i) scr[(2 * i + (lane >> 5)) * 33 + (lane & 31)] = tv[i];
    LDS_WAIT(); asm volatile("" ::: "memory");
    const int c = lane & 7;
#pragma unroll
    for (int j = 0; j < 4; ++j) { const int n = (lane >> 3) + 8 * j; const LAS float* s = scr + (8 * c) * 33 + n;
        u32x4 o; o.x = pk2(s[0 * 33], s[1 * 33]); o.y = pk2(s[2 * 33], s[3 * 33]); o.z = pk2(s[4 * 33], s[5 * 33]); o.w = pk2(s[6 * 33], s[7 * 33]);
        *(u32x4*)(WT + (size_t)(n0 + n) * K + k0 + 8 * c) = o; }
    LDS_WAIT(); asm volatile("" ::: "memory");
}
__device__ __forceinline__ float wave_max(float v) {
#pragma unroll
    for (int o = 1; o < 64; o <<= 1) v = fmaxf(v, __shfl_xor(v, o));
    return v;
}
__device__ __forceinline__ void p0_xn_row(const Frame& F, int m) {
    const float* x = F.in(0); const float* meta = F.in(1); const float* g = F.in(2);
    bf16_t* o = (bf16_t*)(F.ws + WS_XN) + (size_t)m * DM;
    u32x2* o8 = (u32x2*)o + F.lane;
    if (m >= NTOK + NMETA) {
        unsigned* z8 = (unsigned*)(F.ws + WS_XN8 + (size_t)m * DM) + F.lane;
#pragma unroll
        for (int j = 0; j < 16; ++j) { o8[64 * j] = (u32x2){0u, 0u}; z8[64 * j] = 0u; }
        if (F.lane == 0) ((float*)(F.ws + WS_SX))[m] = 0.f;
        return; }
    const float* src = m < NTOK ? x + (size_t)m * DM : meta + (size_t)(m - NTOK) * DM;
    const f32x4* xr = (const f32x4*)src + F.lane; const f32x4* gr = (const f32x4*)g + F.lane;
    f32x4 v[16]; float s = 0.f;
#pragma unroll
    for (int j = 0; j < 16; ++j) { v[j] = xr[64 * j]; s += (v[j][0] * v[j][0] + v[j][1] * v[j][1]) + (v[j][2] * v[j][2] + v[j][3] * v[j][3]); }
    const float rstd = 1.0f / sqrtf(wave_sum(s) * (1.0f / DM) + EPS);
    float mx = 0.f;
#pragma unroll
    for (int j = 0; j < 16; ++j) { const f32x4 gg = gr[64 * j]; v[j] = v[j] * rstd * gg; o8[64 * j] = (u32x2){pk2(v[j][0], v[j][1]), pk2(v[j][2], v[j][3])};
        mx = fmaxf(mx, fmaxf(fmaxf(fabsf(v[j][0]), fabsf(v[j][1])), fmaxf(fabsf(v[j][2]), fabsf(v[j][3])))); }
    mx = fmaxf(wave_max(mx), 1e-30f);
    const float inv = 448.0f / mx;
    if (F.lane == 0) ((float*)(F.ws + WS_SX))[m] = mx * (1.0f / 448.0f);
    unsigned* q8 = (unsigned*)(F.ws + WS_XN8 + (size_t)m * DM) + F.lane;
#pragma unroll
    for (int j = 0; j < 16; ++j) { f32x4 q = v[j] * inv;
#pragma unroll
        for (int e = 0; e < 4; ++e) q[e] = fminf(fmaxf(q[e], -448.0f), 448.0f);
        int p = 0; p = __builtin_amdgcn_cvt_pk_fp8_f32(q[0], q[1], p, false); p = __builtin_amdgcn_cvt_pk_fp8_f32(q[2], q[3], p, true); q8[64 * j] = (unsigned)p; }
}
__device__ __forceinline__ void p0_prologue(const Frame& F) {
    LAS float* scr = (LAS float*)(F.lds + F.wave * 16384);
    const int gw = F.vcu * NWAVES + F.wave, NGW = F.G * NWAVES;
    const float* w_in = F.in(3); const float* qg = F.in(4); const float* w_uq = F.in(5); const float* kvg = F.in(6); const float* w_ukv = F.in(7);
    const float* w_br = F.in(8); const float* w_out = F.in(9); const float* fg = F.in(10); const float* w_q = F.in(11); const float* sk = F.in(12);
    constexpr int I_IN = 64 * (NV1 / 32), I_UQ = 16 * (3072 / 32), I_UKV = 8 * (4096 / 32), I_BR = 64 * 128, I_OUT = 64 * 128, I_Q = 64 * 64;
    constexpr int NITEMS = I_IN + I_UQ + I_UKV + I_BR + I_OUT + I_Q;
    for (int it = gw; it < NITEMS; it += NGW) {
        int r = it;
        if (r < I_IN) { p0_transpose_item(w_in, 4096, 13968, NV1, (bf16_t*)(F.ws + WS_WIN), nullptr, scr, r, F.lane, MapIn()); continue; } r -= I_IN;
        if (r < I_UQ) { p0_transpose_item(w_uq, 1024, 3072, 3072, (bf16_t*)(F.ws + WS_WUQ), qg, scr, r, F.lane, MapUq()); continue; } r -= I_UQ;
        if (r < I_UKV) { p0_transpose_item(w_ukv, 512, 4096, 4096, (bf16_t*)(F.ws + WS_WUKV), kvg, scr, r, F.lane, MapUkv()); continue; } r -= I_UKV;
        if (r < I_BR) { p0_transpose_item(w_br, 4096, 4096, 4096, (bf16_t*)(F.ws + WS_H1F), nullptr, scr, r, F.lane, MapId()); continue; } r -= I_BR;
        if (r < I_OUT) { p0_transpose_item(w_out, 4096, 4096, 4096, (bf16_t*)(F.ws + WS_WOUT), nullptr, scr, r, F.lane, MapId()); continue; } r -= I_OUT;
        p0_transpose_item(w_q, 4096, 2048, 2048, (bf16_t*)(F.ws + WS_WQ), fg, scr, r, F.lane, MapId());
    }
    for (int m = gw; m < MK; m += NGW) p0_xn_row(F, m);
    const int gt = (F.vcu * NWAVES + F.wave) * 64 + F.lane, NGT = NGW * 64;
    for (int i = gt; i < TP * 56; i += NGT) {
        const int t = i / 56, r = i % 56; int j, rot; float* dst;
        if (r < 32) { j = r; rot = 64; dst = (float*)(F.ws + WS_ROPE_M) + ((size_t)t * 32 + j) * 2; }
        else if (r < 48) { j = r - 32; rot = 32; dst = (float*)(F.ws + WS_ROPE_D) + ((size_t)t * 16 + j) * 2; }
        else { j = r - 48; rot = 16; dst = (float*)(F.ws + WS_ROPE_I) + ((size_t)t * 8 + j) * 2; }
        const float ex = (float)(2 * j) / (float)rot;
        const float inv = powf(500000.0f, -ex);
        const float ang = (float)t * inv;
        const double a = (double)ang, kq = rint(a * 0.15915494309189535), rr = fma(-kq, 6.283185307179586, a);
        const float rf = (float)rr;
        dst[0] = cosf(rf); dst[1] = sinf(rf);
    }
    for (int i = gt; i < 16 * 128 * 128 / 8; i += NGT) { const f32x4* s = (const f32x4*)sk + 2 * (size_t)i; const f32x4 a = s[0], b2 = s[1];
        u32x4 o; o.x = pk2(a[0], a[1]); o.y = pk2(a[2], a[3]); o.z = pk2(b2[0], b2[1]); o.w = pk2(b2[2], b2[3]); ((u32x4*)(F.ws + WS_SK))[i] = o; }
}
__device__ __forceinline__ unsigned fp6_code(float q) {
    const unsigned b = __float_as_uint(q), sgn = (b >> 31) << 5; const float aq = fabsf(q);
    const unsigned sub = (unsigned)rintf(aq * 8.0f);
    unsigned ab = b & 0x7fffffffu; ab = ab + 0x7FFFFu + ((ab >> 20) & 1u);
    const unsigned nrm = (ab >> 20) - (126u << 3);
    unsigned code = aq < 1.0f ? sub : nrm; code = code > 31u ? 31u : code;
    return code | sgn;
}
__device__ __forceinline__ void fp6_pack32(const unsigned (&c)[32], unsigned (&w)[6]) {
#pragma unroll
    for (int i = 0; i < 6; ++i) w[i] = 0u;
#pragma unroll
    for (int k = 0; k < 32; ++k) { const int bit = 6 * k, d = bit >> 5, sh = bit & 31; w[d] |= c[k] << sh; if (sh > 26) w[d + 1] |= c[k] >> (32 - sh); }
}
__device__ __forceinline__ void p6_quant_row(const float* src, const float* gain, unsigned char* dst, float* scale_out, int lane) {
    const f32x4* s = (const f32x4*)src + lane; f32x4 v[16]; float mx = 0.f;
#pragma unroll
    for (int j = 0; j < 16; ++j) { v[j] = s[64 * j]; if (gain) v[j] = v[j] * ((const f32x4*)gain)[lane + 64 * j];
        mx = fmaxf(mx, fmaxf(fmaxf(fabsf(v[j][0]), fabsf(v[j][1])), fmaxf(fabsf(v[j][2]), fabsf(v[j][3])))); }
    mx = fmaxf(wave_max(mx), 1e-30f);
    const float sc = mx * (1.0f / 7.5f), inv = 7.5f / mx;
    if (lane == 0) *scale_out = sc;
    unsigned w[12];
#pragma unroll
    for (int g = 0; g < 2; ++g) { unsigned c[32];
#pragma unroll
        for (int j = 0; j < 8; ++j)
#pragma unroll
            for (int i = 0; i < 4; ++i) c[4 * j + i] = fp6_code(v[8 * g + j][i] * inv);
        unsigned ww[6]; fp6_pack32(c, ww);
#pragma unroll
        for (int i = 0; i < 6; ++i) w[6 * g + i] = ww[i]; }
#pragma unroll
    for (int q = 0; q < 3; ++q) *(u32x4*)(dst + 1024 * q + 16 * lane) = (u32x4){w[4 * q], w[4 * q + 1], w[4 * q + 2], w[4 * q + 3]};
}
__device__ __forceinline__ unsigned fp4_code(float q) {
    const float aq = fabsf(q);
    const unsigned c = (aq > 0.25f ? 1u : 0u) + (aq >= 0.75f ? 1u : 0u) + (aq > 1.25f ? 1u : 0u) + (aq >= 1.75f ? 1u : 0u) + (aq > 2.5f ? 1u : 0u) + (aq >= 3.5f ? 1u : 0u) + (aq > 5.0f ? 1u : 0u);
    return c | ((__float_as_uint(q) >> 31) << 3);
}
__device__ __forceinline__ void p6_quant_row4(const float* src, const float* gain, unsigned char* dst, float* scale_out, int lane) {
    const f32x4* s = (const f32x4*)src + lane; f32x4 v[16]; float mx = 0.f;
#pragma unroll
    for (int j = 0; j < 16; ++j) { v[j] = s[64 * j]; if (gain) v[j] = v[j] * ((const f32x4*)gain)[lane + 64 * j];
        mx = fmaxf(mx, fmaxf(fmaxf(fabsf(v[j][0]), fabsf(v[j][1])), fmaxf(fabsf(v[j][2]), fabsf(v[j][3])))); }
    mx = fmaxf(wave_max(mx), 1e-30f);
    const float sc = mx * (1.0f / 6.0f), inv = 6.0f / mx;
    if (lane == 0) *scale_out = sc;
    unsigned w[8];
#pragma unroll
    for (int d = 0; d < 8; ++d) { unsigned x = 0u;
#pragma unroll
        for (int i = 0; i < 4; ++i) { x |= fp4_code(v[2 * d][i] * inv) << (4 * i); x |= fp4_code(v[2 * d + 1][i] * inv) << (16 + 4 * i); }
        w[d] = x; }
#pragma unroll
    for (int q = 0; q < 2; ++q) *(u32x4*)(dst + 1024 * q + 16 * lane) = (u32x4){w[4 * q], w[4 * q + 1], w[4 * q + 2], w[4 * q + 3]};
}
#ifndef PEER_U_BITS
#define PEER_U_BITS 4
#endif
#ifndef PEER_V_BITS
#define PEER_V_BITS 4
#endif
constexpr int PEER_U_ROWB = PEER_U_BITS == 4 ? 2048 : 3072, PEER_V_ROWB = PEER_V_BITS == 4 ? 2048 : 3072;
__device__ __forceinline__ void p6_quant_regs4(f32x4 (&v)[16], unsigned char* dst, float* scale_out, int lane) {
    float mx = 0.f;
#pragma unroll
    for (int j = 0; j < 16; ++j) mx = fmaxf(mx, fmaxf(fmaxf(fabsf(v[j][0]), fabsf(v[j][1])), fmaxf(fabsf(v[j][2]), fabsf(v[j][3]))));
    mx = fmaxf(wave_max(mx), 1e-30f);
    const float inv = 6.0f / mx;
    if (lane == 0) *scale_out = mx * (1.0f / 6.0f);
    unsigned w[8];
#pragma unroll
    for (int d = 0; d < 8; ++d) { unsigned x = 0u;
#pragma unroll
        for (int i = 0; i < 4; ++i) { x |= fp4_code(v[2 * d][i] * inv) << (4 * i); x |= fp4_code(v[2 * d + 1][i] * inv) << (16 + 4 * i); }
        w[d] = x; }
#pragma unroll
    for (int q = 0; q < 2; ++q) *(u32x4*)(dst + 1024 * q + 16 * lane) = (u32x4){w[4 * q], w[4 * q + 1], w[4 * q + 2], w[4 * q + 3]};
}
__device__ __forceinline__ void p6_tables(const Frame& F) {
    const float* fg = F.in(10); const float* pu = F.in(13); const float* pv = F.in(14);
    const int gw = F.vcu * NWAVES + F.wave, NGW = F.G * NWAVES, lane = F.lane;
#if PEER_U_BITS == 4 && PEER_V_BITS == 4
    if ((NGW & 1) == 0) {
        const bool isv = gw & 1; const float* tab = isv ? pv : pu; unsigned char* dtab = F.ws + (isv ? WS_V : WS_U); float* stab = (float*)(F.ws + (isv ? WS_SCV : WS_SCU));
        const int e0 = gw >> 1, estep = NGW >> 1;
        f32x4 g[16];
#pragma unroll
        for (int j = 0; j < 16; ++j) g[j] = isv ? (f32x4){1.f, 1.f, 1.f, 1.f} : ((const f32x4*)fg)[lane + 64 * j];
        f32x4 va[16], vb[16];
        if (e0 < 16384) {
#pragma unroll
            for (int j = 0; j < 16; ++j) va[j] = ((const f32x4*)(tab + (size_t)e0 * DM))[lane + 64 * j];
        }
#pragma unroll 1
        for (int e = e0; e < 16384; e += 2 * estep) {
            const int e1 = e + estep, e2 = e + 2 * estep;
            if (e1 < 16384) {
#pragma unroll
                for (int j = 0; j < 16; ++j) vb[j] = ((const f32x4*)(tab + (size_t)e1 * DM))[lane + 64 * j];
            }
#pragma unroll
            for (int j = 0; j < 16; ++j) va[j] = va[j] * g[j];
            p6_quant_regs4(va, dtab + (size_t)e * 2048, stab + e, lane);
            if (e2 < 16384) {
#pragma unroll
                for (int j = 0; j < 16; ++j) va[j] = ((const f32x4*)(tab + (size_t)e2 * DM))[lane + 64 * j];
            }
            if (e1 < 16384) {
#pragma unroll
                for (int j = 0; j < 16; ++j) vb[j] = vb[j] * g[j];
                p6_quant_regs4(vb, dtab + (size_t)e1 * 2048, stab + e1, lane);
            }
        }
        return;
    }
#endif
    for (int it = gw; it < 2 * 16384; it += NGW) { const int e = it >> 1;
        if (it & 1) { if (PEER_V_BITS == 4) p6_quant_row4(pv + (size_t)e * DM, nullptr, F.ws + WS_V + (size_t)e * PEER_V_ROWB, (float*)(F.ws + WS_SCV) + e, F.lane);
                      else p6_quant_row(pv + (size_t)e * DM, nullptr, F.ws + WS_V + (size_t)e * PEER_V_ROWB, (float*)(F.ws + WS_SCV) + e, F.lane); }
        else { if (PEER_U_BITS == 4) p6_quant_row4(pu + (size_t)e * DM, fg, F.ws + WS_U + (size_t)e * PEER_U_ROWB, (float*)(F.ws + WS_SCU) + e, F.lane);
               else p6_quant_row(pu + (size_t)e * DM, fg, F.ws + WS_U + (size_t)e * PEER_U_ROWB, (float*)(F.ws + WS_SCU) + e, F.lane); } }
}

__device__ __forceinline__ void rowquant_fp8(const Frame& F, const unsigned char* src, size_t src_pitch, unsigned char* dst, size_t dst_pitch, float* scale, int nrows) {
    const int gw = F.vcu * NWAVES + F.wave, NGW = F.G * NWAVES, lane = F.lane;
    for (int n = gw; n < nrows; n += NGW) {
        const u32x4* s = (const u32x4*)(src + (size_t)n * src_pitch) + lane;
        u32x4 v[8]; float mx = 0.f;
#pragma unroll
        for (int j = 0; j < 8; ++j) { v[j] = s[64 * j];
#pragma unroll
            for (int e = 0; e < 4; ++e) mx = fmaxf(mx, fmaxf(fabsf(bf_lo(v[j][e])), fabsf(bf_hi(v[j][e])))); }
        mx = fmaxf(wave_max(mx), 1e-30f);
        const float inv = 448.0f / mx;
        if (lane == 0) scale[n] = mx * (1.0f / 448.0f);
        asm volatile("" ::: "memory");
        u32x2* d = (u32x2*)(dst + (size_t)n * dst_pitch) + lane;
#pragma unroll
        for (int j = 0; j < 8; ++j) { int p0 = 0, p1 = 0;
            p0 = __builtin_amdgcn_cvt_pk_fp8_f32(bf_lo(v[j].x) * inv, bf_hi(v[j].x) * inv, p0, false); p0 = __builtin_amdgcn_cvt_pk_fp8_f32(bf_lo(v[j].y) * inv, bf_hi(v[j].y) * inv, p0, true);
            p1 = __builtin_amdgcn_cvt_pk_fp8_f32(bf_lo(v[j].z) * inv, bf_hi(v[j].z) * inv, p1, false); p1 = __builtin_amdgcn_cvt_pk_fp8_f32(bf_lo(v[j].w) * inv, bf_hi(v[j].w) * inv, p1, true);
            d[64 * j] = (u32x2){(unsigned)p0, (unsigned)p1}; }
    }
}
template <int LEN>
__device__ __forceinline__ void rowquant_fp8_n(const Frame& F, const unsigned char* src, unsigned char* dst, float* scale, int nrows) {
    const int gw = F.vcu * NWAVES + F.wave, NGW = F.G * NWAVES, lane = F.lane; constexpr int PER = LEN / 64;
    for (int n = gw; n < nrows; n += NGW) {
        const u32x4* s = (const u32x4*)(src + (size_t)n * LEN * 2) + lane * (PER / 8);
        u32x4 v[PER / 8]; float mx = 0.f;
#pragma unroll
        for (int j = 0; j < PER / 8; ++j) { v[j] = s[j];
#pragma unroll
            for (int e = 0; e < 4; ++e) mx = fmaxf(mx, fmaxf(fabsf(bf_lo(v[j][e])), fabsf(bf_hi(v[j][e])))); }
        mx = fmaxf(wave_max(mx), 1e-30f);
        const float inv = 448.0f / mx;
        if (lane == 0) scale[n] = mx * (1.0f / 448.0f);
        u32x2* d = (u32x2*)(dst + (size_t)n * LEN) + lane * (PER / 8);
#pragma unroll
        for (int j = 0; j < PER / 8; ++j) { int p0 = 0, p1 = 0;
            p0 = __builtin_amdgcn_cvt_pk_fp8_f32(bf_lo(v[j].x) * inv, bf_hi(v[j].x) * inv, p0, false); p0 = __builtin_amdgcn_cvt_pk_fp8_f32(bf_lo(v[j].y) * inv, bf_hi(v[j].y) * inv, p0, true);
            p1 = __builtin_amdgcn_cvt_pk_fp8_f32(bf_lo(v[j].z) * inv, bf_hi(v[j].z) * inv, p1, false); p1 = __builtin_amdgcn_cvt_pk_fp8_f32(bf_lo(v[j].w) * inv, bf_hi(v[j].w) * inv, p1, true);
            d[j] = (u32x2){(unsigned)p0, (unsigned)p1}; }
    }
}
__device__ __forceinline__ void p1_quant_weights(const Frame& F) {
    rowquant_fp8(F, F.ws + WS_WIN + (size_t)1280 * DM * 2, (size_t)DM * 2, F.ws + WS_WG8, (size_t)DM, (float*)(F.ws + WS_SW), 12800);
    rowquant_fp8(F, F.ws + WS_H1F, (size_t)DM * 2, F.ws + WS_WBR, (size_t)DM, (float*)(F.ws + WS_SWBR), 4096);
    rowquant_fp8(F, F.ws + WS_WOUT, (size_t)DM * 2, F.ws + WS_WOUT, (size_t)DM * 2, (float*)(F.ws + WS_SWOUT), 4096);
    rowquant_fp8_n<1024>(F, F.ws + WS_WUQ, F.ws + WS_WUQ8, (float*)(F.ws + WS_SWUQ), 3072);
    rowquant_fp8_n<512>(F, F.ws + WS_WUKV, F.ws + WS_WUKV8, (float*)(F.ws + WS_SWUKV), 4096);
}
#define MFMA32(a, b, c) __builtin_amdgcn_mfma_f32_32x32x16_bf16((a), (b), (c), 0, 0, 0)
__device__ __forceinline__ float relu_i(float x) { const int v = __float_as_int(x); return __int_as_float(v > 0 ? v : 0); }
__device__ __forceinline__ int crow(int i, int h) { return (i & 3) + 8 * (i >> 2) + 4 * h; }
__device__ __forceinline__ float half_sum_f(float v) {
#pragma unroll
    for (int o = 1; o < 32; o <<= 1) v += __shfl_xor(v, o);
    return v;
}
__device__ __forceinline__ int half_sum_i(int v) {
#pragma unroll
    for (int o = 1; o < 32; o <<= 1) v += __shfl_xor(v, o);
    return v;
}
__device__ __forceinline__ float half_max_f(float v) {
#pragma unroll
    for (int o = 1; o < 32; o <<= 1) v = fmaxf(v, __shfl_xor(v, o));
    return v;
}
__device__ __forceinline__ float half_min_f(float v) {
#pragma unroll
    for (int o = 1; o < 32; o <<= 1) v = fminf(v, __shfl_xor(v, o));
    return v;
}
constexpr int IDX_PK = 144, IDX_BUF = 64 * IDX_PK;
__device__ __forceinline__ void idx_task(const Frame& F, int b, int s0c) {
    const int lane = F.lane, r = lane & 31, h = lane >> 5, tid = F.tid;
    const int s0 = s0c + 2 * F.wave;
    LAS unsigned char* lds = F.lds;
    const bf16_t* qix = (const bf16_t*)(F.ws + WS_QIX); const bf16_t* kix = (const bf16_t*)(F.ws + WS_KIX); const float* wix = (const float*)(F.ws + WS_WIX);
    unsigned* mask = (unsigned*)(F.ws + WS_MASK);
    const int tok = (r >> 2) & 1, head = (r & 3) + 4 * (r >> 3);
    const bf16_t* qp = qix + (size_t)(b * SEQ + s0 + tok) * 1024 + head * 64 + 8 * h;
    bf16x8 af[4];
#pragma unroll
    for (int ks = 0; ks < 4; ++ks) af[ks] = *(const bf16x8*)(qp + 16 * ks);
    const f32x4* wp = (const f32x4*)(wix + (size_t)(b * SEQ + s0 + h) * 16);
    float w[16];
#pragma unroll
    for (int q = 0; q < 4; ++q) { const f32x4 x = wp[q]; w[4 * q] = x[0]; w[4 * q + 1] = x[1]; w[4 * q + 2] = x[2]; w[4 * q + 3] = x[3]; }
    const int tq = NMETA + s0 + h;
    int tqr = tq - r; asm volatile("" : "+v"(tqr));
    const int ngrp = ((NMETA + s0c + 15) >> 6) + 1;
    const int skey = tid >> 3, spc = tid & 7;
    int brow = b * SEQ - NMETA; asm volatile("" : "+s"(brow));
    const bf16_t* kcur = kix + ((long)brow + skey) * 64 + spc * 8;
    const int sdst = skey * IDX_PK + spc * 16;
    const int boff = r * IDX_PK + 16 * h;
    u32x4 kst = *(const u32x4*)(skey < NMETA ? kix + (size_t)(NTOK + skey) * 64 + spc * 8 : kcur);
    float row[MW];
#pragma unroll
    for (int g = 0; g < MW / 2; ++g) {
        float s0v = -INFINITY, s1v = -INFINITY;
        const int bo = (g & 1) * IDX_BUF;
        if (g < ngrp) *(LAS u32x4*)(lds + bo + sdst) = kst;
        __syncthreads();
        kcur += 64 * 64; asm volatile("" : "+v"(kcur));
        if (g + 1 < ngrp) kst = *(const u32x4*)kcur;
        if (g < ngrp) {
            float x0 = 0.f, x1 = 0.f;
            { bf16x8 bb[4]; f32x16 a0;
#pragma unroll
              for (int ks = 0; ks < 4; ++ks) bb[ks] = *(const LAS bf16x8*)(lds + bo + boff + 32 * ks);
#pragma unroll
              for (int i = 0; i < 16; ++i) a0[i] = 0.f;
#pragma unroll
              for (int ks = 0; ks < 4; ++ks) a0 = MFMA32(af[ks], bb[ks], a0);
#pragma unroll
              for (int i = 0; i < 16; ++i) x0 += w[i] * relu_i(a0[i]); }
            asm volatile("" : "+v"(x0));
            asm volatile("" ::: "memory");
            { bf16x8 bb[4]; f32x16 a1;
#pragma unroll
              for (int ks = 0; ks < 4; ++ks) bb[ks] = *(const LAS bf16x8*)(lds + bo + boff + 32 * IDX_PK + 32 * ks);
#pragma unroll
              for (int i = 0; i < 16; ++i) a1[i] = 0.f;
#pragma unroll
              for (int ks = 0; ks < 4; ++ks) a1 = MFMA32(af[ks], bb[ks], a1);
#pragma unroll
              for (int i = 0; i < 16; ++i) x1 += w[i] * relu_i(a1[i]); }
            s0v = (g * 64 <= tqr) ? x0 : -INFINITY; s1v = (g * 64 + 32 <= tqr) ? x1 : -INFINITY;
        }
        row[2 * g] = s0v; row[2 * g + 1] = s1v;
    }
    float tau = -3.0e38f;
    bool done = (tq + 1 <= 256);
    float mx = -INFINITY, mn = INFINITY;
#pragma unroll
    for (int k = 0; k < MW; ++k) { const float v = row[k]; mx = fmaxf(mx, v); mn = fminf(mn, v > -INFINITY ? v : INFINITY); }
    float lo = half_min_f(mn), hi = half_max_f(mx);
    if (!done) tau = hi;
    for (int it = 0; it < 64; ++it) {
        if (!__any(!done)) break;
        const float mid = lo + (hi - lo) * 0.5f;
        int c = 0;
#pragma unroll
        for (int k = 0; k < MW; ++k) c += (row[k] >= mid) ? 1 : 0;
        c = half_sum_i(c);
        if (!done) {
            if (!(mid > lo && mid < hi)) { tau = hi; done = true; }
            else if (c == 256) { tau = mid; done = true; }
            else if (c > 256) lo = mid;
            else { hi = mid; tau = hi; }
        }
    }
    unsigned* mrow = mask + (size_t)(b * SEQ + s0 + h) * MW;
    unsigned mw = 0u;
#pragma unroll
    for (int k = 0; k < MW; ++k) {
        const unsigned long long bal = __ballot(row[k] >= tau);
        const unsigned wd = h ? (unsigned)(bal >> 32) : (unsigned)bal;
        if ((k & 31) == r) mw = wd;
        if ((k & 31) == 31 || k == MW - 1) { const int kk = (k & ~31) + r; if (kk < MW) mrow[kk] = mw; }
    }
}
__device__ __forceinline__ void p2_indexer(const Frame& F, int qslot) {
    volatile LAS unsigned* qw = (volatile LAS unsigned*)(F.lds + LDSCTL_OFF + 16);
    constexpr int NCH = NTOK / 16;
    for (;;) {
        if (F.tid == 0) qw[0] = atomicAdd(F.ctl + CW_QUEUE + 64 * qslot, 1u);
        __syncthreads();
        const int c = __builtin_amdgcn_readfirstlane((int)qw[0]);
        __syncthreads();
        if (c >= NCH) break;
        const int b = c & 3, tblk = (SEQ / 16 - 1) - (c >> 2);
        idx_task(F, b, tblk * 16);
    }
}
template <bool MLA> struct AttnCfg {
    static constexpr int DQK = MLA ? 192 : 128, NKS = DQK / 64, PK = DQK + 16  , PV = 320, KBYTES = 64 * PK, BUFB = 64 * PK + 64 * PV;
};
struct AttnUnit { int type, b, hx, blk; };
typedef int i32x8 __attribute__((ext_vector_type(8)));
typedef int i32x4 __attribute__((ext_vector_type(4)));
__device__ __forceinline__ i32x8 cat4(i32x4 a, i32x4 b) { return __builtin_shufflevector(a, b, 0, 1, 2, 3, 4, 5, 6, 7); }
template <int NKS> __device__ __forceinline__ void qk_block(f32x16& s, const i32x8 (&k)[NKS], const i32x8 (&q)[NKS]) {
#if defined(__HIP_DEVICE_COMPILE__)
    int sc = 0x7F7F7F7F;
    if constexpr (NKS == 3)
        asm volatile("s_nop 1\n\tv_mfma_scale_f32_32x32x64_f8f6f4 %0, %1, %4, 0, %7, %7 op_sel_hi:[0,0,0]\n\ts_nop 3\n\tv_mfma_scale_f32_32x32x64_f8f6f4 %0, %2, %5, %0, %7, %7 op_sel_hi:[0,0,0]\n\ts_nop 3\n\t"
                     "v_mfma_scale_f32_32x32x64_f8f6f4 %0, %3, %6, %0, %7, %7 op_sel_hi:[0,0,0]\n\ts_nop 15\n\ts_nop 7"
                     : "=&v"(s) : "v"(k[0]), "v"(k[1]), "v"(k[2]), "v"(q[0]), "v"(q[1]), "v"(q[2]), "v"(sc));
    else
        asm volatile("s_nop 1\n\tv_mfma_scale_f32_32x32x64_f8f6f4 %0, %1, %3, 0, %5, %5 op_sel_hi:[0,0,0]\n\ts_nop 3\n\tv_mfma_scale_f32_32x32x64_f8f6f4 %0, %2, %4, %0, %5, %5 op_sel_hi:[0,0,0]\n\ts_nop 15\n\ts_nop 7"
                     : "=&v"(s) : "v"(k[0]), "v"(k[1]), "v"(q[0]), "v"(q[1]), "v"(sc));
#else
    (void)s; (void)k; (void)q;
#endif
}

template <bool MLA>
__device__ __forceinline__ void attn_unit(const Frame& F, const AttnUnit u) {
    typedef AttnCfg<MLA> C;
    const int tid = F.tid, lane = F.lane, wave = F.wave, r = lane & 31, h = lane >> 5;
    LAS unsigned char* lds = F.lds;
    const unsigned char* qn8 = F.ws + WS_QN; const unsigned char* qr8 = F.ws + WS_QR; const unsigned char* kn8 = F.ws + WS_KN; const unsigned char* kpe8 = F.ws + WS_KPE;
    const unsigned char* qb8 = F.ws + WS_QB; const unsigned char* kb8 = F.ws + WS_KB;
    const bf16_t* va = (const bf16_t*)(F.ws + WS_VA); const bf16_t* vb = (const bf16_t*)(F.ws + WS_VB);
    const unsigned* mask = (const unsigned*)(F.ws + WS_MASK);
    const int b = u.b;
    const size_t rowb = (size_t)b * SEQ;
    int head, tw0, ntiles;
    if (MLA) { head = u.hx; tw0 = u.blk * 256 + 32 * wave; ntiles = (NMETA + u.blk * 256 + 255) / 64 + 1; }
    else { head = 4 * u.hx + (wave & 3); tw0 = u.blk * 64 + 32 * (wave >> 2); ntiles = (NMETA + u.blk * 64 + 63) / 64 + 1; }
    const int pw0 = NMETA + tw0;
    const int tq = pw0 + r;
    const float cexp = MLA ? QA_SCALE : QB_SCALE;
    i32x8 qf[C::NKS];
    if (MLA) {
        const unsigned char* p0 = qn8 + (rowb + tw0 + r) * 2048 + head * 128 + 32 * h; const unsigned char* p1 = qr8 + (rowb + tw0 + r) * 1024 + head * 64 + 32 * h;
        qf[0] = cat4(*(const i32x4*)p0, *(const i32x4*)(p0 + 16)); qf[1] = cat4(*(const i32x4*)(p0 + 64), *(const i32x4*)(p0 + 80)); qf[C::NKS - 1] = cat4(*(const i32x4*)p1, *(const i32x4*)(p1 + 16));
    } else {
        const unsigned char* p0 = qb8 + (rowb + tw0 + r) * 2048 + head * 128 + 32 * h;
        qf[0] = cat4(*(const i32x4*)p0, *(const i32x4*)(p0 + 16)); qf[1] = cat4(*(const i32x4*)(p0 + 64), *(const i32x4*)(p0 + 80));
    }
    const int ldk = MLA ? 2048 : 512;
    const unsigned char* ktab = MLA ? kn8 + head * 128 : kb8 + u.hx * 128;
    const bf16_t* vtab = MLA ? va + head * 128 : vb + u.hx * 128;
    const unsigned char* kbase = ktab + (rowb - NMETA) * ldk;
    const bf16_t* vbase = vtab + (rowb - NMETA) * ldk;
    const unsigned char* pbase = kpe8 + (rowb - NMETA) * 64;
    const int kkey = tid >> 3, kpc = tid & 7, pkey = tid >> 2, ppc = tid & 3;
    const unsigned koffs = (unsigned)(kkey * ldk + kpc * 16); const int kdst = kkey * C::PK + kpc * 16;
    const unsigned poffs = (unsigned)(pkey * 64 + ppc * 16); const int pdst = pkey * C::PK + 128 + ppc * 16;
    unsigned soff[2]; int vdst[2];
#pragma unroll
    for (int i = 0; i < 2; ++i) { const int c = tid + 512 * i, key = c >> 4, pc = c & 15; soff[i] = (unsigned)(key * ldk + pc * 8); vdst[i] = C::KBYTES + key * C::PV + pc * 16; }
    u32x4 kst, vst[2], pst = (u32x4){0u, 0u, 0u, 0u};
    {
        kst = *(const u32x4*)(kkey < NMETA ? ktab + (size_t)(NTOK + kkey) * ldk + kpc * 16 : kbase + koffs);
        const int key0 = tid >> 4;
        vst[0] = *(const u32x4*)(key0 < NMETA ? vtab + (size_t)(NTOK + key0) * ldk + (tid & 15) * 8 : vbase + soff[0]);
        vst[1] = *(const u32x4*)(vbase + soff[1]);
        if (MLA && tid < 256) pst = *(const u32x4*)(pkey < NMETA ? kpe8 + (size_t)(NTOK + pkey) * 64 + ppc * 16 : pbase + poffs);
    }
    *(LAS u32x4*)(lds + kdst) = kst;
#pragma unroll
    for (int i = 0; i < 2; ++i) *(LAS u32x4*)(lds + vdst[i]) = vst[i];
    if (MLA && tid < 256) *(LAS u32x4*)(lds + pdst) = pst;
    __syncthreads();
    f32x16 oacc[4];
#pragma unroll
    for (int d = 0; d < 4; ++d)
#pragma unroll
        for (int i = 0; i < 16; ++i) oacc[d][i] = 0.f;
    float mrun = -INFINITY, lrun = 0.f;
    const int koff = r * C::PK + 32 * h;
    const int voff = C::KBYTES + (4 * h + ((lane & 15) >> 2)) * C::PV + (16 * ((lane >> 4) & 1) + 4 * (lane & 3)) * 2;
    const unsigned* mrow = mask + (rowb + tw0 + r) * MW;
    if (ntiles > 1) {
        kst = *(const u32x4*)(kbase + (size_t)64 * ldk + koffs);
        const bf16_t* vb2 = vbase + (size_t)64 * ldk;
#pragma unroll
        for (int i = 0; i < 2; ++i) vst[i] = *(const u32x4*)(vb2 + soff[i]);
        if (MLA && tid < 256) pst = *(const u32x4*)(pbase + (size_t)64 * 64 + poffs);
    }
    for (int kt = 0; kt < ntiles; ++kt) {
        const int cur = (kt & 1) * C::BUFB, nxt = ((kt + 1) & 1) * C::BUFB;
        if (kt + 1 < ntiles) {
            *(LAS u32x4*)(lds + nxt + kdst) = kst;
#pragma unroll
            for (int i = 0; i < 2; ++i) *(LAS u32x4*)(lds + nxt + vdst[i]) = vst[i];
            if (MLA && tid < 256) *(LAS u32x4*)(lds + nxt + pdst) = pst;
        }
        if (kt + 2 < ntiles) {
            kst = *(const u32x4*)(kbase + (size_t)(kt + 2) * 64 * ldk + koffs);
            const bf16_t* vb2 = vbase + (size_t)(kt + 2) * 64 * ldk;
#pragma unroll
            for (int i = 0; i < 2; ++i) vst[i] = *(const u32x4*)(vb2 + soff[i]);
            if (MLA && tid < 256) pst = *(const u32x4*)(pbase + (size_t)(kt + 2) * 64 * 64 + poffs);
        }
        if (kt * 64 <= pw0 + 31) {
            u32x2 mwd = (u32x2){0u, 0u};
            if (!MLA) mwd = *(const u32x2*)(mrow + 2 * kt);
            f32x16 s0, s1;
            if (!MLA) {
                i32x8 kf0[C::NKS], kf1[C::NKS];
#pragma unroll
                for (int ks = 0; ks < C::NKS; ++ks) { kf0[ks] = cat4(*(const LAS i32x4*)(lds + cur + koff + 64 * ks), *(const LAS i32x4*)(lds + cur + koff + 64 * ks + 16));
                    kf1[ks] = cat4(*(const LAS i32x4*)(lds + cur + koff + 32 * C::PK + 64 * ks), *(const LAS i32x4*)(lds + cur + koff + 32 * C::PK + 64 * ks + 16)); }
                qk_block<C::NKS>(s0, kf0, qf);
                qk_block<C::NKS>(s1, kf1, qf);
            } else {
                { i32x8 kf[C::NKS];
#pragma unroll
                  for (int ks = 0; ks < C::NKS; ++ks) kf[ks] = cat4(*(const LAS i32x4*)(lds + cur + koff + 64 * ks), *(const LAS i32x4*)(lds + cur + koff + 64 * ks + 16));
                  qk_block<C::NKS>(s0, kf, qf); }
                { i32x8 kf[C::NKS];
#pragma unroll
                  for (int ks = 0; ks < C::NKS; ++ks) kf[ks] = cat4(*(const LAS i32x4*)(lds + cur + koff + 32 * C::PK + 64 * ks), *(const LAS i32x4*)(lds + cur + koff + 32 * C::PK + 64 * ks + 16));
                  qk_block<C::NKS>(s1, kf, qf); }
            }
#define LDV(dst, kk) do { _Pragma("unroll") for (int d = 0; d < 4; ++d) { \
                const s16x4 lo_ = __builtin_amdgcn_ds_read_tr16_b64_v4i16((LAS s16x4*)(lds + cur + voff + (16 * (kk)) * C::PV + 64 * d)); \
                const s16x4 hi_ = __builtin_amdgcn_ds_read_tr16_b64_v4i16((LAS s16x4*)(lds + cur + voff + (16 * (kk) + 8) * C::PV + 64 * d)); \
                dst[d] = __builtin_shufflevector(lo_, hi_, 0, 1, 2, 3, 4, 5, 6, 7); } } while (0)
            bf16x8 vfa[4], vfb[4];
            if (MLA) {
                if (kt * 64 + 63 > pw0) {
                    const int kb0 = kt * 64 + 4 * h;
#pragma unroll
                    for (int i = 0; i < 16; ++i) { const int key = kb0 + (i & 3) + 8 * (i >> 2); if (key > tq) s0[i] = -INFINITY; if (key + 32 > tq) s1[i] = -INFINITY; }
                }
            } else {
                const unsigned m0 = mwd.x >> (4 * h), m1 = mwd.y >> (4 * h);
#pragma unroll
                for (int i = 0; i < 16; ++i) { const int bit = (i & 3) + 8 * (i >> 2);
                    const unsigned k0 = (unsigned)__builtin_amdgcn_sbfe((int)m0, bit, 1), k1 = (unsigned)__builtin_amdgcn_sbfe((int)m1, bit, 1);
                    s0[i] = __uint_as_float((__float_as_uint(s0[i]) & k0) | (0xFF800000u & ~k0)); s1[i] = __uint_as_float((__float_as_uint(s1[i]) & k1) | (0xFF800000u & ~k1)); }
            }
            float mx = s0[0];
#pragma unroll
            for (int i = 1; i < 16; ++i) mx = fmaxf(mx, s0[i]);
#pragma unroll
            for (int i = 0; i < 16; ++i) mx = fmaxf(mx, s1[i]);
            mx = fmaxf(mx, __shfl_xor(mx, 32));
            const float mcand = mx * cexp;
            const bool move = !__all(mcand - mrun <= 8.0f);
            const float mnew = move ? fmaxf(mrun, mcand) : mrun;
            const float msafe = (mnew == -INFINITY) ? 0.f : mnew;
            const float alpha = move ? __builtin_amdgcn_exp2f(mrun - msafe) : 1.0f;
            mrun = mnew;
            float ps = 0.f;
#pragma unroll
            for (int i = 0; i < 16; ++i) { s0[i] = __builtin_amdgcn_exp2f(__builtin_fmaf(s0[i], cexp, -msafe)); s1[i] = __builtin_amdgcn_exp2f(__builtin_fmaf(s1[i], cexp, -msafe)); ps += s0[i] + s1[i]; }
            lrun = lrun * alpha + ps;
            if (move) {
#pragma unroll
                for (int d = 0; d < 4; ++d)
#pragma unroll
                    for (int i = 0; i < 16; ++i) oacc[d][i] *= alpha;
            }
            LDV(vfa, 0);
            bf16x8 pf[4];
            { u32x4 w;
              w.x = cvt_pk_bf16(s0[0], s0[1]); w.y = cvt_pk_bf16(s0[2], s0[3]); w.z = cvt_pk_bf16(s0[4], s0[5]); w.w = cvt_pk_bf16(s0[6], s0[7]); pf[0] = __builtin_bit_cast(bf16x8, w);
              w.x = cvt_pk_bf16(s0[8], s0[9]); w.y = cvt_pk_bf16(s0[10], s0[11]); w.z = cvt_pk_bf16(s0[12], s0[13]); w.w = cvt_pk_bf16(s0[14], s0[15]); pf[1] = __builtin_bit_cast(bf16x8, w);
              w.x = cvt_pk_bf16(s1[0], s1[1]); w.y = cvt_pk_bf16(s1[2], s1[3]); w.z = cvt_pk_bf16(s1[4], s1[5]); w.w = cvt_pk_bf16(s1[6], s1[7]); pf[2] = __builtin_bit_cast(bf16x8, w);
              w.x = cvt_pk_bf16(s1[8], s1[9]); w.y = cvt_pk_bf16(s1[10], s1[11]); w.z = cvt_pk_bf16(s1[12], s1[13]); w.w = cvt_pk_bf16(s1[14], s1[15]); pf[3] = __builtin_bit_cast(bf16x8, w); }
            LDV(vfb, 1);
#pragma unroll
            for (int d = 0; d < 4; ++d) oacc[d] = MFMA32(vfa[d], pf[0], oacc[d]);
            LDV(vfa, 2);
#pragma unroll
            for (int d = 0; d < 4; ++d) oacc[d] = MFMA32(vfb[d], pf[1], oacc[d]);
            LDV(vfb, 3);
#pragma unroll
            for (int d = 0; d < 4; ++d) oacc[d] = MFMA32(vfa[d], pf[2], oacc[d]);
#pragma unroll
            for (int d = 0; d < 4; ++d) oacc[d] = MFMA32(vfb[d], pf[3], oacc[d]);
#undef LDV
        }
        __syncthreads();
    }
    {
        const float lt = lrun + __shfl_xor(lrun, 32);
        const float vmax = fmaxf(__uint_as_float(F.ctl[CW_VMAX + (MLA ? 64 : 0)]), 1e-30f);
        const float inv = (lt > 0.f ? 1.0f / lt : 0.f) * (440.0f / vmax);
        unsigned char* op = F.ws + WS_OAB + (rowb + tw0 + r) * 4096 + (MLA ? 0 : 2048) + head * 128 + 4 * h;
#pragma unroll
        for (int d = 0; d < 4; ++d)
#pragma unroll
            for (int g = 0; g < 4; ++g) { int p = 0;
                p = __builtin_amdgcn_cvt_pk_fp8_f32(fminf(fmaxf(oacc[d][4 * g] * inv, -448.f), 448.f), fminf(fmaxf(oacc[d][4 * g + 1] * inv, -448.f), 448.f), p, false);
                p = __builtin_amdgcn_cvt_pk_fp8_f32(fminf(fmaxf(oacc[d][4 * g + 2] * inv, -448.f), 448.f), fminf(fmaxf(oacc[d][4 * g + 3] * inv, -448.f), 448.f), p, true);
                *(unsigned*)(op + 32 * d + 8 * g) = (unsigned)p; }
    }
}

constexpr int ATT_NUNITS = 16 * 64 + 64 * 16;
__device__ __forceinline__ void att_decode(int idx, AttnUnit& u) {
    int rem = idx;
    for (int L = 65; L >= 2; --L) {
        const int nm = (L >= 5 && ((L - 5) & 3) == 0) ? 64 : 0;
        if (rem < nm) { u.type = 0; u.blk = (L - 5) >> 2; u.b = rem & 3; u.hx = rem >> 2; return; }
        rem -= nm;
        if (rem < 16) { u.type = 1; u.blk = L - 2; u.b = rem & 3; u.hx = rem >> 2; return; }
        rem -= 16;
    }
    u.type = -1; u.blk = 0; u.b = 0; u.hx = 0;
}
__device__ __forceinline__ void p3_attention(const Frame& F, int qslot) {
    volatile LAS int* qw = (volatile LAS int*)(F.lds + LDSCTL_OFF + 32);
    for (;;) {
        if (F.tid == 0) { const int idx = (int)atomicAdd(F.ctl + CW_QUEUE + 64 * qslot, 1u); AttnUnit u; u.type = -1; u.b = 0; u.hx = 0; u.blk = 0; if (idx < ATT_NUNITS) att_decode(idx, u);
            qw[0] = u.type; qw[1] = u.b; qw[2] = u.hx; qw[3] = u.blk; }
        __syncthreads();
        AttnUnit u; u.type = qw[0]; u.b = qw[1]; u.hx = qw[2]; u.blk = qw[3];
        __syncthreads();
        if (u.type < 0) break;
        if (u.type == 0) attn_unit<true>(F, u); else attn_unit<false>(F, u);
    }
}
__device__ __forceinline__ float pk_idx(float v, int n) { return __uint_as_float((__float_as_uint(v) & ~127u) | (unsigned)n); }
__device__ __forceinline__ void route_task(const Frame& F, int tb, int hd) {
    const int lane = F.lane, r = lane & 31, h = lane >> 5;
    const bf16_t* pq = (const bf16_t*)(F.ws + WS_PQ); const bf16_t* skb = (const bf16_t*)(F.ws + WS_SK);
    int* eid = (int*)(F.ws + WS_EID); float* gate = (float*)(F.ws + WS_GATE);
    LAS float* wl = (LAS float*)(F.lds + F.wave * 16384);
    const int m = tb * 32 + r;
#pragma unroll 1
    for (int c = 0; c < 2; ++c) {
        const bf16_t* qp = pq + (size_t)m * 2048 + hd * 256 + c * 128 + 8 * h;
        bf16x8 qf[8];
#pragma unroll
        for (int ks = 0; ks < 8; ++ks) qf[ks] = *(const bf16x8*)(qp + 16 * ks);
        float v[64];
#pragma unroll
        for (int blk = 0; blk < 4; ++blk) {
            const bf16_t* sp = skb + (size_t)((hd * 2 + c) * 128 + 32 * blk + r) * 128 + 8 * h;
            f32x16 acc;
#pragma unroll
            for (int i = 0; i < 16; ++i) acc[i] = 0.f;
#pragma unroll
            for (int ks = 0; ks < 8; ++ks) acc = MFMA32(*(const bf16x8*)(sp + 16 * ks), qf[ks], acc);
#pragma unroll
            for (int i = 0; i < 16; ++i) v[blk * 16 + i] = pk_idx(acc[i], 32 * blk + (i & 3) + 8 * (i >> 2) + 4 * h);
        }
#pragma unroll 1
        for (int k = 0; k < 16; ++k) {
            float mx = v[0];
#pragma unroll
            for (int j = 1; j < 64; ++j) mx = fmaxf(mx, v[j]);
            mx = fmaxf(mx, __shfl_xor(mx, 32));
            if (h == 0) wl[(c * 16 + k) * 32 + r] = mx;
#pragma unroll
            for (int j = 0; j < 64; ++j) v[j] = (v[j] == mx) ? -INFINITY : v[j];
        }
    }
    LDS_WAIT(); asm volatile("" ::: "memory");
    float cs[50]; int ce[50];
    {
        unsigned t0[16], t1[16];
#pragma unroll
        for (int i = 0; i < 16; ++i) { t0[i] = __float_as_uint(wl[i * 32 + r]); t1[i] = __float_as_uint(wl[(16 + i) * 32 + r]); }
        int n = 0;
#pragma unroll
        for (int i = 0; i < 16; ++i)
#pragma unroll
            for (int j = 0; j < 16; ++j)
                if ((i + 1) * (j + 1) <= 16) {
                    const float s = __uint_as_float(t0[i] & ~127u) + __uint_as_float(t1[j] & ~127u);
                    cs[n] = __uint_as_float((__float_as_uint(s) & ~63u) | (unsigned)n); ce[n] = (int)((t0[i] & 127u) * 128u + (t1[j] & 127u)); ++n;
                }
    }
    float sum = 0.f, first = 0.f;
#pragma unroll 1
    for (int k = 0; k < 16; ++k) {
        float mx = cs[0];
#pragma unroll
        for (int j = 1; j < 50; ++j) mx = fmaxf(mx, cs[j]);
        int se = 0;
#pragma unroll
        for (int j = 0; j < 50; ++j) { const bool hit = (cs[j] == mx); se = hit ? ce[j] : se; cs[j] = hit ? -INFINITY : cs[j]; }
        if (k == 0) first = mx;
        const float ev = __expf(mx - first); sum += ev;
        if (h == 0) { wl[1024 + k * 32 + r] = ev; wl[1536 + k * 32 + r] = __int_as_float(se); }
    }
    LDS_WAIT(); asm volatile("" ::: "memory");
    const float inv = 1.0f / sum;
    if (h == 0) {
        int* ep = eid + (size_t)m * 128 + hd * 16; float* gp = gate + (size_t)m * 128 + hd * 16;
#pragma unroll
        for (int q = 0; q < 4; ++q) {
            *(int4*)(ep + 4 * q) = make_int4(__float_as_int(wl[1536 + (4 * q) * 32 + r]), __float_as_int(wl[1536 + (4 * q + 1) * 32 + r]), __float_as_int(wl[1536 + (4 * q + 2) * 32 + r]), __float_as_int(wl[1536 + (4 * q + 3) * 32 + r]));
            *(f32x4*)(gp + 4 * q) = (f32x4){wl[1024 + (4 * q) * 32 + r] * inv, wl[1024 + (4 * q + 1) * 32 + r] * inv, wl[1024 + (4 * q + 2) * 32 + r] * inv, wl[1024 + (4 * q + 3) * 32 + r] * inv}; }
    }
    LDS_WAIT(); asm volatile("" ::: "memory");
}
__device__ __forceinline__ void p7_routing(const Frame& F) {
    const int gw = F.vcu * NWAVES + F.wave, NGW = F.G * NWAVES;
    for (int it = gw; it < (NTOK / 32) * 8; it += NGW) route_task(F, it >> 3, it & 7);
}

__device__ __forceinline__ float rl_f(float v, int l) { return __int_as_float(__builtin_amdgcn_readlane(__float_as_int(v), l)); }
__device__ __forceinline__ float gelu_tanh(float x) {
    const float u = 0.7978845608028654f * (x + 0.044715f * x * x * x);
    const float e = __expf(2.0f * u);
    const float th = 1.0f - 2.0f / (e + 1.0f);
    return 0.5f * x * (1.0f + th);
}
__device__ __forceinline__ float wave_sum_dpp(float v) {
#define DPP_ADD(ctrl, rmask) v += __int_as_float(__builtin_amdgcn_update_dpp(0, __float_as_int(v), ctrl, rmask, 0xF, false))
    DPP_ADD(0xB1, 0xF); DPP_ADD(0x4E, 0xF); DPP_ADD(0x141, 0xF); DPP_ADD(0x140, 0xF); DPP_ADD(0x142, 0xA); DPP_ADD(0x143, 0xC);
#undef DPP_ADD
    return rl_f(v, 63);
}
typedef unsigned u32x6 __attribute__((ext_vector_type(6)));
typedef float f32x32 __attribute__((ext_vector_type(32)));
struct Row6 { u32x4 q[3]; };
__device__ __forceinline__ void row6_load(Row6& r, const unsigned char* tab, int e, int lane) {
    const u32x4* p = (const u32x4*)(tab + (size_t)e * 3072) + lane;
#pragma unroll
    for (int q = 0; q < 3; ++q) r.q[q] = p[64 * q];
}
__device__ __forceinline__ f32x32 row6_deq(const Row6& r, int g) {
    u32x6 w;
    if (g == 0) { w[0] = r.q[0].x; w[1] = r.q[0].y; w[2] = r.q[0].z; w[3] = r.q[0].w; w[4] = r.q[1].x; w[5] = r.q[1].y; }
    else { w[0] = r.q[1].z; w[1] = r.q[1].w; w[2] = r.q[2].x; w[3] = r.q[2].y; w[4] = r.q[2].z; w[5] = r.q[2].w; }
    return __builtin_amdgcn_cvt_scalef32_pk32_f32_fp6(w, 1.0f);
}
__device__ __forceinline__ float row6_dot(const Row6& r, const f32x2 (&hf)[32]) {
    f32x2 acc0 = (f32x2){0.f, 0.f}, acc1 = (f32x2){0.f, 0.f};
#pragma unroll
    for (int g = 0; g < 2; ++g) { const f32x32 d = row6_deq(r, g);
#pragma unroll
        for (int k = 0; k < 16; k += 2) { acc0 = __builtin_elementwise_fma((f32x2){d[2 * k], d[2 * k + 1]}, hf[16 * g + k], acc0); acc1 = __builtin_elementwise_fma((f32x2){d[2 * k + 2], d[2 * k + 3]}, hf[16 * g + k + 1], acc1); } }
    const f32x2 s = acc0 + acc1;
    return s.x + s.y;
}
__device__ __forceinline__ void row6_axpy(const Row6& r, float c, f32x2 (&o)[32]) {
    const f32x2 c2 = (f32x2){c, c};
#pragma unroll
    for (int g = 0; g < 2; ++g) { const f32x32 d = row6_deq(r, g);
#pragma unroll
        for (int k = 0; k < 16; ++k) o[16 * g + k] = __builtin_elementwise_fma((f32x2){d[2 * k], d[2 * k + 1]}, c2, o[16 * g + k]); }
}
struct Row4 { u32x4 q[2]; };
__device__ __forceinline__ void row4_load(Row4& r, const unsigned char* tab, int e, int lane) {
    const u32x4* p = (const u32x4*)(tab + (size_t)e * 2048) + lane;
    r.q[0] = p[0]; r.q[1] = p[64];
}
__device__ __forceinline__ float row4_dot(const Row4& r, const f32x2 (&hf)[32]) {
    f32x2 acc0 = (f32x2){0.f, 0.f}, acc1 = (f32x2){0.f, 0.f};
#pragma unroll
    for (int d = 0; d < 8; ++d) { const unsigned w = r.q[d >> 2][d & 3];
        acc0 = __builtin_elementwise_fma(__builtin_amdgcn_cvt_scalef32_pk_f32_fp4(w, 1.0f, 0), hf[4 * d], acc0);
        acc1 = __builtin_elementwise_fma(__builtin_amdgcn_cvt_scalef32_pk_f32_fp4(w, 1.0f, 1), hf[4 * d + 1], acc1);
        acc0 = __builtin_elementwise_fma(__builtin_amdgcn_cvt_scalef32_pk_f32_fp4(w, 1.0f, 2), hf[4 * d + 2], acc0);
        acc1 = __builtin_elementwise_fma(__builtin_amdgcn_cvt_scalef32_pk_f32_fp4(w, 1.0f, 3), hf[4 * d + 3], acc1); }
    const f32x2 s = acc0 + acc1;
    return s.x + s.y;
}
__device__ __forceinline__ void row4_axpy(const Row4& r, float c, f32x2 (&o)[32]) {
    const f32x2 c2 = (f32x2){c, c};
#pragma unroll
    for (int d = 0; d < 8; ++d) { const unsigned w = r.q[d >> 2][d & 3];
        o[4 * d] = __builtin_elementwise_fma(__builtin_amdgcn_cvt_scalef32_pk_f32_fp4(w, 1.0f, 0), c2, o[4 * d]);
        o[4 * d + 1] = __builtin_elementwise_fma(__builtin_amdgcn_cvt_scalef32_pk_f32_fp4(w, 1.0f, 1), c2, o[4 * d + 1]);
        o[4 * d + 2] = __builtin_elementwise_fma(__builtin_amdgcn_cvt_scalef32_pk_f32_fp4(w, 1.0f, 2), c2, o[4 * d + 2]);
        o[4 * d + 3] = __builtin_elementwise_fma(__builtin_amdgcn_cvt_scalef32_pk_f32_fp4(w, 1.0f, 3), c2, o[4 * d + 3]); }
}
#if PEER_U_BITS == 4
typedef Row4 RowU;
#define ROWU_LOAD row4_load
#define ROWU_DOT row4_dot
#else
typedef Row6 RowU;
#define ROWU_LOAD row6_load
#define ROWU_DOT row6_dot
#endif
#if PEER_V_BITS == 4
typedef Row4 RowV;
#define ROWV_LOAD row4_load
#define ROWV_AXPY row4_axpy
#else
typedef Row6 RowV;
#define ROWV_LOAD row6_load
#define ROWV_AXPY row6_axpy
#endif
__device__ __forceinline__ void expert_token(const Frame& F, int m, size_t orow) {
    const int lane = F.lane;
    const unsigned char* U = F.ws + WS_U; const unsigned char* V = F.ws + WS_V;
    const float* scu = (const float*)(F.ws + WS_SCU); const float* scv = (const float*)(F.ws + WS_SCV);
    const int* eid = (const int*)(F.ws + WS_EID); const float* gate = (const float*)(F.ws + WS_GATE);
    const bf16_t* h1b = (const bf16_t*)(F.ws + WS_H1B);
    const u64* ssq = (const u64*)(F.ctl + CW_SSQ_H1); const float* gfin = F.in(15);
    const int e0 = eid[(size_t)m * 128 + lane], e1 = eid[(size_t)m * 128 + 64 + lane];
    f32x2 hf[32];
#pragma unroll
    for (int j = 0; j < 16; ++j) { const u32x2 x = *((const u32x2*)(h1b + (size_t)m * DM) + lane + 64 * j); hf[2 * j] = (f32x2){bf_lo(x.x), bf_hi(x.x)}; hf[2 * j + 1] = (f32x2){bf_lo(x.y), bf_hi(x.y)}; }
    const float g0 = gate[(size_t)m * 128 + lane] * scv[e0], g1 = gate[(size_t)m * 128 + 64 + lane] * scv[e1];
    const float rstd = __builtin_amdgcn_rsqf(ssq_get(ssq + m) * (1.0f / DM) + EPS);
    const float su0 = scu[e0] * rstd, su1 = scu[e1] * rstd;
    float a0 = 0.f, a1 = 0.f;
#define EIDX(e) (((e) < 64) ? __builtin_amdgcn_readlane(e0, (e)) : __builtin_amdgcn_readlane(e1, (e) - 64))
    {
        RowU r0, r1, r2, r3, r4, r5, r6, r7;
        ROWU_LOAD(r0, U, EIDX(0), lane); ROWU_LOAD(r1, U, EIDX(1), lane); ROWU_LOAD(r2, U, EIDX(2), lane); ROWU_LOAD(r3, U, EIDX(3), lane);
        ROWU_LOAD(r4, U, EIDX(4), lane); ROWU_LOAD(r5, U, EIDX(5), lane); ROWU_LOAD(r6, U, EIDX(6), lane); ROWU_LOAD(r7, U, EIDX(7), lane);
#define S1STEP(rr, k) p = wave_sum_dpp(ROWU_DOT(rr, hf)); if (more) ROWU_LOAD(rr, U, EIDX(e + 8 + (k)), lane); if (e < 64) { if (lane == e + (k)) a0 = p; } else { if (lane == e + (k) - 64) a1 = p; }
#pragma unroll 1
        for (int e = 0; e < 128; e += 8) {
            const bool more = e + 8 < 128; float p;
            S1STEP(r0, 0) S1STEP(r1, 1) S1STEP(r2, 2) S1STEP(r3, 3) S1STEP(r4, 4) S1STEP(r5, 5) S1STEP(r6, 6) S1STEP(r7, 7)
        }
#undef S1STEP
    }
    const float c0 = gelu_tanh(a0 * su0) * g0, c1 = gelu_tanh(a1 * su1) * g1;
#define CIDX(e) (((e) < 64) ? rl_f(c0, (e)) : rl_f(c1, (e) - 64))
    f32x2 o[32];
#pragma unroll
    for (int i = 0; i < 32; ++i) o[i] = (f32x2){0.f, 0.f};
    {
        RowV r0, r1, r2, r3, r4, r5, r6, r7;
        ROWV_LOAD(r0, V, EIDX(0), lane); ROWV_LOAD(r1, V, EIDX(1), lane); ROWV_LOAD(r2, V, EIDX(2), lane); ROWV_LOAD(r3, V, EIDX(3), lane);
        ROWV_LOAD(r4, V, EIDX(4), lane); ROWV_LOAD(r5, V, EIDX(5), lane); ROWV_LOAD(r6, V, EIDX(6), lane); ROWV_LOAD(r7, V, EIDX(7), lane);
#define S2STEP(rr, k) ROWV_AXPY(rr, CIDX(e + (k)), o); if (more) ROWV_LOAD(rr, V, EIDX(e + 8 + (k)), lane);
#pragma unroll 1
        for (int e = 0; e < 128; e += 8) {
            const bool more = e + 8 < 128;
            S2STEP(r0, 0) S2STEP(r1, 1) S2STEP(r2, 2) S2STEP(r3, 3) S2STEP(r4, 4) S2STEP(r5, 5) S2STEP(r6, 6) S2STEP(r7, 7)
        }
#undef S2STEP
    }
#undef EIDX
#undef CIDX
    float s = 0.f;
    const bf16_t* h1r = h1b + (size_t)m * DM; asm volatile("" : "+s"(h1r));
#pragma unroll
    for (int j = 0; j < 16; ++j) { const u32x2 x = *((const u32x2*)h1r + lane + 64 * j);
        o[2 * j] += (f32x2){bf_lo(x.x), bf_hi(x.x)}; o[2 * j + 1] += (f32x2){bf_lo(x.y), bf_hi(x.y)};
        s += (o[2 * j].x * o[2 * j].x + o[2 * j].y * o[2 * j].y) + (o[2 * j + 1].x * o[2 * j + 1].x + o[2 * j + 1].y * o[2 * j + 1].y); }
    const float rs = 1.0f / sqrtf(wave_sum(s) * (1.0f / DM) + EPS);
    float* op = F.out() + orow * DM;
#pragma unroll
    for (int j = 0; j < 16; ++j) { const f32x4 g = *((const f32x4*)gfin + lane + 64 * j);
        *((f32x4*)op + lane + 64 * j) = (f32x4){o[2 * j].x * rs * g[0], o[2 * j].y * rs * g[1], o[2 * j + 1].x * rs * g[2], o[2 * j + 1].y * rs * g[3]}; }
}
#ifdef MK_STEP_B
__device__ __forceinline__ void stepb_token(const Frame& F, int m, size_t orow) {
    const int lane = F.lane; const float* x = (const float*)(F.ws + WS_H1F) + (size_t)m * DM; const float* gfin = F.in(15);
    f32x4 v[16]; float s = 0.f;
#pragma unroll
    for (int j = 0; j < 16; ++j) { v[j] = *((const f32x4*)x + lane + 64 * j); s += (v[j][0] * v[j][0] + v[j][1] * v[j][1]) + (v[j][2] * v[j][2] + v[j][3] * v[j][3]); }
    const float rs = 1.0f / sqrtf(wave_sum(s) * (1.0f / DM) + EPS);
#pragma unroll
    for (int j = 0; j < 16; ++j) { const f32x4 g = *((const f32x4*)gfin + lane + 64 * j); *((f32x4*)(F.out() + orow * DM) + lane + 64 * j) = v[j] * rs * g; }
}
#endif
#ifdef MK_STEP_A
__device__ __forceinline__ void stepa_token(const Frame& F, size_t orow) {
    const int lane = F.lane; const float* x = F.in(0) + orow * DM; const float* gfin = F.in(15);
    f32x4 v[16]; float s = 0.f;
#pragma unroll
    for (int j = 0; j < 16; ++j) { v[j] = *((const f32x4*)x + lane + 64 * j); s += (v[j][0] * v[j][0] + v[j][1] * v[j][1]) + (v[j][2] * v[j][2] + v[j][3] * v[j][3]); }
    const float rs = 1.0f / sqrtf(wave_sum(s) * (1.0f / DM) + EPS);
#pragma unroll
    for (int j = 0; j < 16; ++j) { const f32x4 g = *((const f32x4*)gfin + lane + 64 * j); *((f32x4*)(F.out() + orow * DM) + lane + 64 * j) = v[j] * rs * g; }
}
#endif
__device__ __forceinline__ void p8_experts(const Frame& F) {
    const int gw = F.vcu * NWAVES + F.wave, NGW = F.G * NWAVES;
#if defined(MK_STEP_A)
    for (int it = gw; it < NB * SEQ; it += NGW) stepa_token(F, (size_t)it);
#elif defined(MK_STEP_B)
    for (int it = gw; it < NB * SEQ; it += NGW) stepb_token(F, it, (size_t)it);
#else
    for (int it = gw; it < NB * SEQ; it += NGW) expert_token(F, it, (size_t)it);
#endif
}
struct Args { const float* in[16]; float* out; unsigned char* ws; int ph_lo, ph_hi; };
#define GEMM_RUN(EPI_T, g_, S_, E_) pg8::gemm_phase<EPI_T, pg8::StaticOrder, true, true>(F.lds, g_, S_, E_)
#define GEMM_RUN2(EPI_T, g_, S_, E_) pg8::gemm_phase<EPI_T, pg8::StaticOrder2, true, true>(F.lds, g_, S_, E_)

__global__ void __launch_bounds__(NWAVES * 64, 2) mk_fwd(Args args) {
    extern __shared__ __attribute__((aligned(16))) unsigned char lds_raw[];
    Frame F;
    F.lds = (LAS unsigned char*)lds_raw;
    F.ws = args.ws; F.ctl = (unsigned*)(args.ws + WS_CTL);
    F.tid = threadIdx.x; F.lane = F.tid & 63; F.wave = __builtin_amdgcn_readfirstlane(F.tid >> 6);
#define PHASE_BEGIN() do { int t_; asm volatile("v_mov_b32 %0, %1" : "=v"(t_) : "v"(threadIdx.x)); F.tid = t_; F.lane = t_ & 63; } while (0)
    F.G = gridDim.x; { const int bx = blockIdx.x; F.vcu = (F.G % 8 == 0) ? (bx % 8) * (F.G / 8) + bx / 8 : bx; }
    for (int u = F.tid; u < (LDS_BYTES - LDSCTL_OFF) / 4; u += NWAVES * 64) ((LAS unsigned*)(F.lds + LDSCTL_OFF))[u] = 0u;
    __syncthreads();
    XcdBarrier bar; bar.bar = F.ctl + CW_BAR; bar.x = 0; bar.st = nullptr;
    if (!MK_PER_PHASE) bar = xcd_barrier_post(F.ctl + CW_BAR, (volatile LAS unsigned*)(F.lds + LDSCTL_OFF));
    const int lo = args.ph_lo, hi = args.ph_hi;
#ifndef PH_MASK
#define PH_MASK 0x1FF
#endif
#define IN(k) (((PH_MASK >> (k)) & 1) && lo <= (k) && (k) < hi)
#ifdef MK_PROBE_T
#define STAMP(k) do { if (blockIdx.x == 0 && threadIdx.x == 0) ((volatile u64*)(F.ctl + 2048))[k] = __builtin_amdgcn_s_memrealtime(); } while (0)
#else
#define STAMP(k) do { } while (0)
#endif
#define SEAM(k) do { if (IN(k) && IN((k) + 1)) xcd_barrier(bar); STAMP((k) + 1); } while (0)
    unsigned char* ws = F.ws;

#ifndef MK_REP_MASK
#define MK_REP_MASK 0
#endif
#define NREP(k) (((MK_REP_MASK >> (k)) & 1) ? 2 : 1)
    STAMP(0);
    if (IN(0)) { for (int rep = 0; rep < NREP(0); ++rep) { PHASE_BEGIN(); p0_prologue(F); if (rep + 1 < NREP(0)) xcd_barrier(bar); } }
    SEAM(0);
    if (IN(1)) { for (int rep = 0; rep < NREP(1); ++rep) { PHASE_BEGIN();
        p1_quant_weights(F);
        xcd_barrier(bar);
        {
            pg8::Gemm g{(const bf16_t*)(ws + WS_XN8), (const bf16_t*)(ws + WS_WG8), MK, 12800, DM / 2, DM / 2}; pg8::StaticOrder S; S.init(MK, 12800, F.G, (int)blockIdx.x);
            epi::EpiIn<true> E{(bf16_t*)(ws + WS_CQ), (bf16_t*)(ws + WS_CKV), (bf16_t*)(ws + WS_QB), (bf16_t*)(ws + WS_KB), (bf16_t*)(ws + WS_VB), (bf16_t*)(ws + WS_QIX), (bf16_t*)(ws + WS_KPE), (bf16_t*)(ws + WS_KIX),
                          (bf16_t*)(ws + WS_GA), (bf16_t*)(ws + WS_GB), (float*)(ws + WS_WIX), rep ? nullptr : (u64*)(F.ctl + CW_SSQ_CQ), rep ? nullptr : (u64*)(F.ctl + CW_SSQ_CKV),
                          (const float*)(ws + WS_ROPE_M), (const float*)(ws + WS_ROPE_D), (const float*)(ws + WS_ROPE_I), F.ctl + CW_VMAX, (const float*)(ws + WS_SX), (const float*)(ws + WS_SW)};
            GEMM_RUN(epi::EpiIn<true>, g, S, E); }
        __syncthreads();
        {
            pg8::Gemm g{(const bf16_t*)(ws + WS_XN), (const bf16_t*)(ws + WS_WIN), MK, 1280, DM, DM}; pg8::StaticOrder S; S.init(MK, 1280, F.G, (int)(gridDim.x - 1 - blockIdx.x));
            epi::EpiIn<false> E{(bf16_t*)(ws + WS_CQ), (bf16_t*)(ws + WS_CKV), (bf16_t*)(ws + WS_QB), (bf16_t*)(ws + WS_KB), (bf16_t*)(ws + WS_VB), (bf16_t*)(ws + WS_QIX), (bf16_t*)(ws + WS_KPE), (bf16_t*)(ws + WS_KIX),
                          (bf16_t*)(ws + WS_GA), (bf16_t*)(ws + WS_GB), (float*)(ws + WS_WIX), nullptr, nullptr,
                          (const float*)(ws + WS_ROPE_M), (const float*)(ws + WS_ROPE_D), (const float*)(ws + WS_ROPE_I), F.ctl + CW_VMAX, nullptr, nullptr};
            GEMM_RUN(epi::EpiIn<false>, g, S, E); }
        if (rep + 1 < NREP(1)) xcd_barrier(bar); }
    }
    SEAM(1);
    if (IN(2)) { for (int rep = 0; rep < NREP(2); ++rep) { PHASE_BEGIN();
        { pg8::Gemm g{(const bf16_t*)(ws + WS_CQ), (const bf16_t*)(ws + WS_WUQ8), NTOK, 3072, 512, 512}; pg8::StaticOrder S; S.init(NTOK, 3072, F.G, (int)blockIdx.x);
          epi::EpiUp E{ws + WS_QN, ws + WS_QR, 8, 2048, 1024, false, (const u64*)(F.ctl + CW_SSQ_CQ), 1.0f / 1024.0f, (const float*)(ws + WS_ROPE_M), (const float*)(ws + WS_SWUQ), F.ctl + CW_VMAX + 64};
          GEMM_RUN(epi::EpiUp, g, S, E); }
        __syncthreads();
        { pg8::Gemm g{(const bf16_t*)(ws + WS_CKV), (const bf16_t*)(ws + WS_WUKV8), MK, 4096, 256, 256}; pg8::StaticOrder S; S.init(MK, 4096, F.G, (int)blockIdx.x);
          epi::EpiUp E{ws + WS_KN, ws + WS_VA, 8, 2048, 4096, true, (const u64*)(F.ctl + CW_SSQ_CKV), 1.0f / 512.0f, nullptr, (const float*)(ws + WS_SWUKV), F.ctl + CW_VMAX + 64};
          GEMM_RUN(epi::EpiUp, g, S, E); }
        __syncthreads();
        p2_indexer(F, rep);
        if (rep + 1 < NREP(2)) xcd_barrier(bar); }
    }
    SEAM(2);
    if (IN(3)) { for (int rep = 0; rep < NREP(3); ++rep) { PHASE_BEGIN(); p3_attention(F, 2 + rep); if (rep + 1 < NREP(3)) xcd_barrier(bar); } }
    SEAM(3);
    if (IN(4)) { for (int rep = 0; rep < NREP(4); ++rep) { PHASE_BEGIN();
        pg8::Gemm g{(const bf16_t*)(ws + WS_OAB), (const bf16_t*)(ws + WS_WBR), NTOK, 4096, 2048, 1024}; pg8::StaticOrder2 S; S.init(NTOK, 4096, F.G, (int)blockIdx.x);
        epi::EpiBranch E{(const bf16_t*)(ws + WS_GA), (const bf16_t*)(ws + WS_GB), (bf16_t*)(ws + WS_MRG), (const unsigned*)(F.ctl + CW_VMAX), (const float*)(ws + WS_SWBR)};
        GEMM_RUN2(epi::EpiBranch, g, S, E);
        if (rep + 1 < NREP(4)) xcd_barrier(bar); }
    }
    SEAM(4);
    if (IN(5)) { for (int rep = 0; rep < NREP(5); ++rep) { PHASE_BEGIN();
        rowquant_fp8(F, ws + WS_MRG, (size_t)DM * 2, ws + WS_MRG, (size_t)DM * 2, (float*)(ws + WS_SMRG), NTOK);
        xcd_barrier(bar);
        pg8::Gemm g{(const bf16_t*)(ws + WS_MRG), (const bf16_t*)(ws + WS_WOUT), NTOK, 4096, 4096, 2048}; pg8::StaticOrder S; S.init(NTOK, 4096, F.G, (int)blockIdx.x);
        epi::EpiOut E{F.in(0), F.in(1), (float*)(ws + WS_H1F), (bf16_t*)(ws + WS_H1B), rep ? nullptr : (u64*)(F.ctl + CW_SSQ_H1), (const float*)(ws + WS_SMRG), (const float*)(ws + WS_SWOUT)};
        GEMM_RUN(epi::EpiOut, g, S, E);
        if (rep + 1 < NREP(5)) xcd_barrier(bar); }
    }
    SEAM(5);
    if (IN(6)) { for (int rep = 0; rep < NREP(6); ++rep) { PHASE_BEGIN();
        pg8::Gemm g{(const bf16_t*)(ws + WS_H1B), (const bf16_t*)(ws + WS_WQ), NTOK, 2048, 4096, 4096}; pg8::StaticOrder S; S.init(NTOK, 2048, F.G, (int)blockIdx.x);
        epi::EpiPQ E{(bf16_t*)(ws + WS_PQ), (const u64*)(F.ctl + CW_SSQ_H1)};
        GEMM_RUN(epi::EpiPQ, g, S, E);
        if (rep + 1 < NREP(6)) xcd_barrier(bar); }
    }
    SEAM(6);
    if (IN(7)) { for (int rep = 0; rep < NREP(7); ++rep) { PHASE_BEGIN();
        if (F.wave & 4) { p6_tables(F); p7_routing(F); } else { p7_routing(F); p6_tables(F); }
        if (rep + 1 < NREP(7)) xcd_barrier(bar); } }
    SEAM(7);
    if (IN(8)) { for (int rep = 0; rep < NREP(8); ++rep) { PHASE_BEGIN(); p8_experts(F); if (rep + 1 < NREP(8)) xcd_barrier(bar); } }
#ifdef MK_PROBE_T
    {   PHASE_BEGIN();
        xcd_barrier(bar); STAMP(9); xcd_barrier(bar);
        const volatile u64* ts = (const volatile u64*)(F.ctl + 2048);
        const float tot = (float)(ts[9] - ts[0]);
        const float f1 = (float)(ts[MK_PROBE_K1 + 1] - ts[MK_PROBE_K1]) / tot, f2 = (float)(ts[MK_PROBE_K2 + 1] - ts[MK_PROBE_K2]) / tot;
        float* o = F.out(); const size_t gt = (size_t)blockIdx.x * 512 + F.tid, NGT = (size_t)gridDim.x * 512;
        for (size_t i = gt; i < (size_t)NB * SEQ * DM / 4; i += NGT) { f32x4 v = ((f32x4*)o)[i]; v = v * (1.0f - f1); if (i == 0) v[0] = 1000.0f * f2; ((f32x4*)o)[i] = v; }
    }
#endif
#undef IN
#undef SEAM
}

extern "C" void kernel_launch(void* const* d_in, const int* in_sizes, int n_in, void* d_out, int out_size, void* d_ws, size_t ws_size, hipStream_t stream) {
    static int grid = 0;
    if (grid == 0) {
        if (n_in != 16 || in_sizes[0] != NB * SEQ * DM || out_size != NB * SEQ * DM || ws_size < WS_END) {
            fprintf(stderr, "kernel_launch: unexpected problem shape (n_in %d, in0 %d, out %d, ws %zu < %zu); nothing launched\n", n_in, n_in > 0 ? in_sizes[0] : -1, out_size, ws_size, (size_t)WS_END); grid = -1; return; }
        int dev = 0, cus = 0, per_cu = 0;
        if (hipGetDevice(&dev) != hipSuccess || hipDeviceGetAttribute(&cus, hipDeviceAttributeMultiprocessorCount, dev) != hipSuccess) { grid = -1; return; }
        if (hipFuncSetAttribute((const void*)mk_fwd, hipFuncAttributeMaxDynamicSharedMemorySize, LDS_BYTES) != hipSuccess) { fprintf(stderr, "kernel_launch: hipFuncSetAttribute failed\n"); grid = -1; return; }
        if (hipOccupancyMaxActiveBlocksPerMultiprocessor(&per_cu, (const void*)mk_fwd, NWAVES * 64, LDS_BYTES) != hipSuccess || per_cu < 1) {
            fprintf(stderr, "kernel_launch: occupancy query reports %d workgroups per CU\n", per_cu); }
        (void)hipGetLastError();
        grid = cus;
    }
    if (grid < 0) return;
    if (hipMemsetAsync((char*)d_ws + WS_CTL, 0, CTL_ZERO_BYTES, stream) != hipSuccess) return;
    Args a{};
    for (int i = 0; i < 16; ++i) a.in[i] = (const float*)d_in[i];
    a.out = (float*)d_out; a.ws = (unsigned char*)d_ws;
#if MK_PER_PHASE
    for (int p = 0; p <= MK_LAST_PHASE; ++p) { a.ph_lo = p; a.ph_hi = p + 1; hipLaunchKernelGGL(mk_fwd, dim3(grid), dim3(NWAVES * 64), LDS_BYTES, stream, a); }
#else
    a.ph_lo = 0; a.ph_hi = MK_LAST_PHASE + 1;
    hipLaunchKernelGGL(mk_fwd, dim3(grid), dim3(NWAVES * 64), LDS_BYTES, stream, a);
#endif
}
```

```cpp
#include <hip/hip_runtime.h>
#include <cstdio>
#include <cstdint>

#define LAS __attribute__((address_space(3)))
#define GAS __attribute__((address_space(1)))
typedef unsigned short bf16_t;
typedef short bf16x8 __attribute__((ext_vector_type(8)));
typedef short s16x4 __attribute__((ext_vector_type(4)));
typedef float f32x2 __attribute__((ext_vector_type(2)));
typedef float f32x4 __attribute__((ext_vector_type(4)));
typedef float f32x16 __attribute__((ext_vector_type(16)));
typedef unsigned u32x2 __attribute__((ext_vector_type(2)));
typedef unsigned u32x4 __attribute__((ext_vector_type(4)));
typedef GAS unsigned gu32;

#ifndef MK_PER_PHASE
#define MK_PER_PHASE 0
#endif
#ifndef MK_LAST_PHASE
#define MK_LAST_PHASE 8
#endif

constexpr int NB = 4, SEQ = 4096, DM = 4096, NMETA = 16, TR = SEQ + NMETA  , TP = 4224  , M = NB * TP  ;
constexpr float EPS = 1e-6f;
constexpr int NV1 = 14080;
constexpr float LOG2E = 1.4426950408889634f;
constexpr float QB_SCALE = 0.08838834764831845f * LOG2E;
constexpr float QA_SCALE = 0.07216878364870323f * LOG2E;
constexpr int NWAVES = 8;
constexpr int NTOK = NB * SEQ;
constexpr int MK = NTOK + 256;
constexpr int MW = 130;
__device__ __forceinline__ int row_pos(int row) { return row < NTOK ? NMETA + (row & (SEQ - 1)) : row - NTOK; }
__device__ __forceinline__ int pos_row(int b, int p) { return p < NMETA ? NTOK + p : b * SEQ + (p - NMETA); }

constexpr size_t HM = 512u * 1024u;
constexpr size_t WS_CTL = 0, CTL_ZERO_BYTES = 2 * HM;
constexpr size_t WS_ROPE_M = 2 * HM;
constexpr size_t WS_ROPE_D = 5 * HM;
constexpr size_t WS_ROPE_I = 7 * HM;
constexpr size_t WS_SK   = 8 * HM;
constexpr size_t WS_WUQ  = 10 * HM;
constexpr size_t WS_WUKV = 22 * HM;
constexpr size_t WS_WBR  = 30 * HM;
constexpr size_t WS_WOUT = 94 * HM;
constexpr size_t WS_WQ   = 158 * HM;
constexpr size_t WS_EID  = 190 * HM;
constexpr size_t WS_GATE = 207 * HM;
constexpr size_t WS_MASK = 224 * HM;
constexpr size_t WS_KPE  = 242 * HM;
constexpr size_t WS_KIX  = 247 * HM;
constexpr size_t WS_WIX  = 252 * HM;
constexpr size_t WS_SCU  = 255 * HM;
constexpr size_t WS_SCV  = 255 * HM + 65536;
constexpr size_t WS_SX   = 255 * HM + 131072;
constexpr size_t WS_SW   = 255 * HM + 200704;
constexpr size_t WS_SWBR = 255 * HM + 294912;
constexpr size_t WS_SWOUT= 255 * HM + 311296;
constexpr size_t WS_SOAB = 255 * HM + 327680;
constexpr size_t WS_SMRG = 255 * HM + 393216;
constexpr size_t R23 = 260 * HM;
constexpr size_t WS_XN   = R23;
constexpr size_t WS_WIN  = R23 + 264 * HM;
constexpr size_t P1O = R23 + 484 * HM;
constexpr size_t WS_CQ   = P1O;
constexpr size_t WS_CKV  = P1O + 66 * HM;
constexpr size_t WS_QB   = P1O + 99 * HM;
constexpr size_t WS_KB   = P1O + 231 * HM;
constexpr size_t WS_VB   = P1O + 264 * HM;
constexpr size_t WS_QIX  = P1O + 297 * HM;
constexpr size_t WS_GA   = P1O + 363 * HM;
constexpr size_t WS_GB   = P1O + 627 * HM;
constexpr size_t R4 = P1O + 892 * HM;
constexpr size_t WS_OAB  = R4;
constexpr size_t WS_XN8  = R4;
constexpr size_t WS_WG8  = R4 + 132 * HM;
constexpr size_t WS_WUQ8 = R4 + 232 * HM;
constexpr size_t WS_WUKV8= R4 + 238 * HM;
constexpr size_t WS_SWUQ = 255 * HM + 458752;
constexpr size_t WS_SWUKV= 255 * HM + 475136;
constexpr size_t WS_PQ   = R4;
constexpr size_t WS_END  = R4 + 264 * HM;
constexpr size_t WS_QN   = R23;
constexpr size_t WS_QR   = R23 + 132 * HM;
constexpr size_t WS_KN   = R23 + 198 * HM;
constexpr size_t WS_VA   = R23 + 330 * HM;
constexpr size_t WS_MRG  = R23;
constexpr size_t WS_U    = R23;
constexpr size_t WS_V    = R23 + 256 * HM;
constexpr size_t WS_H1F  = R23 + 512 * HM;
constexpr size_t WS_H1B  = R23 + 1040 * HM;
static_assert(WS_VA + 132 * HM <= P1O && WS_H1F >= P1O && WS_H1B + 264 * HM <= R4 && WS_GB + 264 * HM <= R4, "ws map");
constexpr int CW_TMO = 0;
constexpr int CW_BAR = 4096;
constexpr int CW_QUEUE = 8192;
constexpr int CW_VMAX = 12288;
constexpr int CW_SSQ_CQ = 16384, CW_SSQ_CKV = 16384 + 2 * 17408, CW_SSQ_H1 = 16384 + 4 * 17408;
static_assert((CW_SSQ_H1 + 2 * 17408) * 4 <= (int)CTL_ZERO_BYTES, "ctl");

constexpr int RING_BYTES = 131072;
constexpr int LDSCTL_OFF = RING_BYTES;
constexpr int LDS_BYTES = 147456;

__device__ __forceinline__ unsigned f2bf(float f) { unsigned u = __float_as_uint(f); return (u + 0x7fffu + ((u >> 16) & 1u)) >> 16; }
__device__ __forceinline__ unsigned pk2(float lo, float hi) { return f2bf(lo) | (f2bf(hi) << 16); }
typedef __bf16 bf16x2_t __attribute__((ext_vector_type(2)));
__device__ __forceinline__ unsigned cvt_pk_bf16(float lo, float hi) { return __builtin_bit_cast(unsigned, __builtin_convertvector((f32x2){lo, hi}, bf16x2_t)); }
__device__ __forceinline__ float bf_lo(unsigned w) { return __uint_as_float(w << 16); }
__device__ __forceinline__ float bf_hi(unsigned w) { return __uint_as_float(w & 0xffff0000u); }
__device__ __forceinline__ u32x4 pack8(f32x4 a, f32x4 b) { u32x4 w; w.x = cvt_pk_bf16(a[0], a[1]); w.y = cvt_pk_bf16(a[2], a[3]); w.z = cvt_pk_bf16(b[0], b[1]); w.w = cvt_pk_bf16(b[2], b[3]); return w; }
__device__ __forceinline__ float wave_sum(float v) {
#pragma unroll
    for (int o = 1; o < 64; o <<= 1) v += __shfl_xor(v, o);
    return v;
}
#define LDS_WAIT() asm volatile("s_waitcnt lgkmcnt(0)" ::: "memory")
#define VM_WAIT() asm volatile("s_waitcnt vmcnt(0)" ::: "memory")
typedef unsigned long long u64;
__device__ __forceinline__ void ssq_add(u64* p, float v) { (void)__hip_atomic_fetch_add(p, (u64)(v * 16777216.0f), __ATOMIC_RELAXED, __HIP_MEMORY_SCOPE_AGENT); }
__device__ __forceinline__ float ssq_get(const u64* p) { return (float)((double)(*p) * (1.0 / 16777216.0)); }
namespace pg8 {
#define PG8_LAS __attribute__((address_space(3)))
typedef unsigned short bf16_t;
typedef short bf16x8 __attribute__((ext_vector_type(8)));
typedef float f32x4 __attribute__((ext_vector_type(4)));
typedef unsigned u32x4 __attribute__((ext_vector_type(4)));
constexpr int BM = 256, BK = 64, HALF = 128, HTB = HALF * BK * 2  , STAGE_BYTES = 8 * HTB, NXCD = 8, WGM = 8;

__host__ __device__ __forceinline__ int lds_byte(int r, int c) { const int st = (r >> 4) * 2 + (c >> 5), rr = r & 15, cc = c & 31, ob = rr * 64 + cc * 2; return st * 1024 + (ob ^ (((ob >> 9) & 1) << 5)); }
__host__ __device__ __forceinline__ void stage_rc(int b, int& R, int& C) { const int st = b / 1024, sb = b % 1024, swz = sb ^ (((sb >> 9) & 1) << 5); R = (st >> 1) * 16 + swz / 64; C = (st & 1) * 32 + (swz % 64) / 2; }
__host__ __device__ __forceinline__ int perm32(int rho) { const int n = rho >> 4, i = rho & 15; return 8 * (i >> 2) + 4 * n + (i & 3); }

typedef int i32x4_t __attribute__((ext_vector_type(4)));
typedef int i32x8_t __attribute__((ext_vector_type(8)));
__device__ __forceinline__ i32x8_t cat8(bf16x8 lo, bf16x8 hi) { const i32x4_t a = __builtin_bit_cast(i32x4_t, lo), b = __builtin_bit_cast(i32x4_t, hi); return __builtin_shufflevector(a, b, 0, 1, 2, 3, 4, 5, 6, 7); }
__device__ __forceinline__ void mfma_f8_acc(f32x4& c, const i32x8_t a, const i32x8_t b) {
#if defined(__HIP_DEVICE_COMPILE__)
    int sc = 0x7F7F7F7F;
    asm volatile("v_mfma_scale_f32_16x16x128_f8f6f4 %0, %1, %2, %0, %3, %3 op_sel_hi:[0,0,0]" : "+v"(c) : "v"(a), "v"(b), "v"(sc));
#else
    (void)c; (void)a; (void)b;
#endif
}
struct Unit { int pm, pn, kh; };
struct Gemm { const bf16_t* A; const bf16_t* Bt; int M, N, K, KL; };

struct StaticOrder {
    int nM, nN, nwg, G, c;
    __host__ __device__ void init(int M, int N, int G_, int c_) { nM = M / BM; nN = N / BM; nwg = nM * nN; G = G_; c = c_; }
    __host__ __device__ bool next(int i, Unit& u) const {
        const long L = (long)i * G + c; if (L >= nwg) return false;
        int wgid = (int)L; { const int q = nwg / NXCD, r = nwg % NXCD, xcd = wgid % NXCD, off = wgid / NXCD; wgid = (xcd < r ? xcd * (q + 1) : r * (q + 1) + (xcd - r) * q) + off; }
        const int nig = WGM * nN, gid = wgid / nig, fm = gid * WGM, gsz = (nM - fm) < WGM ? (nM - fm) : WGM;
        u.pm = fm + ((wgid % nig) % gsz); u.pn = (wgid % nig) / gsz; u.kh = 0; return true;
    }
    __device__ __forceinline__ void a_ready(const Unit&) const {}
    __device__ __forceinline__ void done(const Unit&) const {}
};

struct StaticOrder2 {
    StaticOrder base;
    __host__ __device__ void init(int M, int N, int G_, int c_) { base.init(M, N, G_, c_); }
    __host__ __device__ bool next(int i, Unit& u) const { if (!base.next(i >> 1, u)) return false; u.kh = i & 1; return true; }
    __device__ __forceinline__ void a_ready(const Unit&) const {}
    __device__ __forceinline__ void done(const Unit&) const {}
};

template <class Epi, class Sched, bool ALIGN_EPI = false, bool SP2 = false>
__device__ __forceinline__ void gemm_phase(PG8_LAS unsigned char* lds, const Gemm g, const Sched& S, const Epi& E) {
    int tid_; asm volatile("v_mov_b32 %0, %1" : "=v"(tid_) : "v"(threadIdx.x));
    const int tid = tid_, wid = __builtin_amdgcn_readfirstlane(tid >> 6), lane = tid & 63, wr = wid >> 2, wc = wid & 3, fr = lane & 15, fq = lane >> 4;
    const int K = g.K, nt = g.KL / BK; const size_t khoff = (size_t)g.KL * 2;
    unsigned voffA[2], voffB[2];
#pragma unroll
    for (int i = 0; i < 2; ++i) { int R, C; stage_rc(tid * 16 + i * 8192, R, C); const int Rb = Epi::PERM ? ((R & ~31) + perm32(R & 31)) : R;
        voffA[i] = (unsigned)(R * K + C) * 2u; voffB[i] = (unsigned)(Rb * K + C) * 2u; }
    const size_t kstep = (size_t)(BK * 2);
    const size_t hstep = (size_t)HALF * K * 2;
    const size_t tstep = 2 * hstep;
    const unsigned ldsw = (unsigned)wid * 1024u;
    const int aoff = lds_byte(wr * 64 + fr, fq * 8), boff = lds_byte(wc * 32 + fr, fq * 8);
#define PG8_SA(b, h) (((b) * 2 + (h)) * HTB)
#define PG8_SB(b, h) ((4 + (b) * 2 + (h)) * HTB)
#define PG8_STAGE(bufoff, gbase, voff) do { _Pragma("unroll") for (int _i = 0; _i < 2; ++_i) \
        __builtin_amdgcn_global_load_lds((const unsigned*)((const char*)(gbase) + (voff)[_i]), (PG8_LAS unsigned*)(lds + (bufoff) + ldsw + _i * 8192), 16, 0, 0); } while (0)
#define PG8_LDA(dst, b, h) do { _Pragma("unroll") for (int m = 0; m < 4; ++m) _Pragma("unroll") for (int k = 0; k < 2; ++k) dst[m][k] = *(const PG8_LAS bf16x8*)(lds + PG8_SA(b, h) + aoff + m * 2048 + k * 1024); } while (0)
#define PG8_LDB(dst, b, h) do { _Pragma("unroll") for (int n = 0; n < 2; ++n) _Pragma("unroll") for (int k = 0; k < 2; ++k) dst[n][k] = *(const PG8_LAS bf16x8*)(lds + PG8_SB(b, h) + boff + n * 2048 + k * 1024); } while (0)
#define PG8_MMA(ai, bj, At, Bt) do { __builtin_amdgcn_s_setprio(1); _Pragma("unroll") for (int m = 0; m < 4; ++m) _Pragma("unroll") for (int n = 0; n < 2; ++n) { \
        if constexpr (Epi::FP8) mfma_f8_acc(acc[ai][bj][m][n], cat8(Bt[n][0], Bt[n][1]), cat8(At[m][0], At[m][1])); \
        else { _Pragma("unroll") for (int k = 0; k < 2; ++k) acc[ai][bj][m][n] = __builtin_amdgcn_mfma_f32_16x16x32_bf16(Bt[n][k], At[m][k], acc[ai][bj][m][n], 0, 0, 0); } } \
        __builtin_amdgcn_s_setprio(0); } while (0)
#define PG8_WAIT_V(n) asm volatile("s_waitcnt vmcnt(" #n ")" ::: "memory")
#define PG8_WAIT_L(n) asm volatile("s_waitcnt lgkmcnt(" #n ")" ::: "memory")
#define PG8_BAR __builtin_amdgcn_s_barrier()
#define PG8_SCHED __builtin_amdgcn_sched_barrier(0)
    Unit cur, nxt; int ui = 0;
    if (!S.next(0, cur)) return;
    f32x4 acc[2][2][4][2];
#pragma unroll
    for (int a = 0; a < 2; ++a)
#pragma unroll
        for (int b = 0; b < 2; ++b)
#pragma unroll
            for (int m = 0; m < 4; ++m)
#pragma unroll
                for (int n = 0; n < 2; ++n) acc[a][b][m][n] = (f32x4){0.f, 0.f, 0.f, 0.f};
    bf16x8 At[4][2], B0[2][2], B1[2][2];
    const char* cA = (const char*)g.A + (size_t)cur.pm * tstep + (size_t)cur.kh * khoff; const char* cB = (const char*)g.Bt + (size_t)cur.pn * tstep + (size_t)cur.kh * khoff;
    S.a_ready(cur);
    if constexpr (SP2) {
        PG8_STAGE(PG8_SB(0, 0), cB, voffB); PG8_STAGE(PG8_SB(0, 1), cB + hstep, voffB); PG8_STAGE(PG8_SA(0, 0), cA, voffA); PG8_STAGE(PG8_SA(0, 1), cA + hstep, voffA);
        if (wr == 1) PG8_BAR;
        PG8_WAIT_V(2); PG8_BAR;
        PG8_STAGE(PG8_SB(1, 0), cB + kstep, voffB); PG8_STAGE(PG8_SA(1, 0), cA + kstep, voffA); PG8_STAGE(PG8_SB(1, 1), cB + hstep + kstep, voffB);
        PG8_WAIT_V(6); PG8_BAR;
    } else {
        PG8_STAGE(PG8_SB(0, 0), cB, voffB); PG8_STAGE(PG8_SA(0, 0), cA, voffA); PG8_STAGE(PG8_SB(0, 1), cB + hstep, voffB); PG8_STAGE(PG8_SA(0, 1), cA + hstep, voffA);
        if (wr == 1) PG8_BAR;
        PG8_WAIT_V(4); PG8_BAR;
        PG8_STAGE(PG8_SB(1, 0), cB + kstep, voffB); PG8_STAGE(PG8_SA(1, 0), cA + kstep, voffA); PG8_STAGE(PG8_SB(1, 1), cB + hstep + kstep, voffB);
        PG8_WAIT_V(6); PG8_BAR;
    }
    for (;;) {
        const bool has_next = S.next(ui + 1, nxt);
        const char* nA = has_next ? (const char*)g.A + (size_t)nxt.pm * tstep + (size_t)nxt.kh * khoff : cA; const char* nB = has_next ? (const char*)g.Bt + (size_t)nxt.pn * tstep + (size_t)nxt.kh * khoff : cB;
        for (int t = 0; t < nt; t += 2) {
            const bool last = (t == nt - 2);
            const char* a1 = cA + (size_t)(t + 1) * kstep;
            const char* a2 = last ? nA : cA + (size_t)(t + 2) * kstep; const char* b2 = last ? nB : cB + (size_t)(t + 2) * kstep;
            const char* a3 = a2 + kstep; const char* b3 = b2 + kstep;
            if (last && has_next) S.a_ready(nxt);
            if constexpr (SP2) {
            PG8_LDB(B0, 0, 0); PG8_LDB(B1, 0, 1); PG8_SCHED; PG8_LDA(At, 0, 0); PG8_STAGE(PG8_SA(1, 1), a1 + hstep, voffA);
            PG8_WAIT_V(8); PG8_WAIT_L(0); PG8_BAR; PG8_MMA(0, 0, At, B0); PG8_MMA(0, 1, At, B1); PG8_BAR; PG8_SCHED;
            PG8_LDA(At, 0, 1); PG8_STAGE(PG8_SB(0, 0), b2, voffB); PG8_STAGE(PG8_SB(0, 1), b2 + hstep, voffB); PG8_STAGE(PG8_SA(0, 0), a2, voffA);
            PG8_WAIT_V(8); PG8_WAIT_L(0); PG8_BAR; PG8_MMA(1, 0, At, B0); PG8_MMA(1, 1, At, B1); PG8_BAR; PG8_SCHED;
            PG8_LDB(B0, 1, 0); PG8_LDB(B1, 1, 1); PG8_SCHED; PG8_LDA(At, 1, 0); PG8_STAGE(PG8_SA(0, 1), a2 + hstep, voffA);
            PG8_WAIT_V(8); PG8_WAIT_L(0); PG8_BAR; PG8_MMA(0, 0, At, B0); PG8_MMA(0, 1, At, B1); PG8_BAR; PG8_SCHED;
            PG8_LDA(At, 1, 1); PG8_STAGE(PG8_SB(1, 0), b3, voffB); PG8_STAGE(PG8_SB(1, 1), b3 + hstep, voffB); PG8_STAGE(PG8_SA(1, 0), a3, voffA);
            PG8_WAIT_V(8); PG8_WAIT_L(0); PG8_BAR; PG8_MMA(1, 0, At, B0); PG8_MMA(1, 1, At, B1); PG8_BAR; PG8_SCHED;
            } else {
            PG8_LDB(B0, 0, 0); PG8_SCHED; PG8_LDA(At, 0, 0); PG8_STAGE(PG8_SA(1, 1), a1 + hstep, voffA);
            PG8_WAIT_L(8); PG8_BAR; PG8_WAIT_L(0); PG8_MMA(0, 0, At, B0); PG8_BAR; PG8_SCHED;
            PG8_LDB(B1, 0, 1); PG8_STAGE(PG8_SB(0, 0), b2, voffB);
            PG8_BAR; PG8_WAIT_L(0); PG8_MMA(0, 1, At, B1); PG8_BAR;
            PG8_LDA(At, 0, 1); PG8_STAGE(PG8_SA(0, 0), a2, voffA);
            PG8_BAR; PG8_WAIT_L(0); PG8_MMA(1, 0, At, B0); PG8_BAR; PG8_SCHED;
            PG8_STAGE(PG8_SB(0, 1), b2 + hstep, voffB);
            PG8_WAIT_V(6); PG8_BAR; PG8_MMA(1, 1, At, B1); PG8_BAR;
            PG8_LDB(B0, 1, 0); PG8_SCHED; PG8_LDA(At, 1, 0); PG8_STAGE(PG8_SA(0, 1), a2 + hstep, voffA);
            PG8_WAIT_L(8); PG8_BAR; PG8_WAIT_L(0); PG8_MMA(0, 0, At, B0); PG8_BAR; PG8_SCHED;
            PG8_LDB(B1, 1, 1); PG8_STAGE(PG8_SB(1, 0), b3, voffB);
            PG8_BAR; PG8_WAIT_L(0); PG8_MMA(0, 1, At, B1); PG8_BAR;
            PG8_LDA(At, 1, 1); PG8_STAGE(PG8_SA(1, 0), a3, voffA);
            PG8_BAR; PG8_WAIT_L(0); PG8_MMA(1, 0, At, B0); PG8_BAR; PG8_SCHED;
            PG8_STAGE(PG8_SB(1, 1), b3 + hstep, voffB);
            PG8_WAIT_V(6); PG8_BAR; PG8_MMA(1, 1, At, B1); PG8_BAR;
            }
        }
        if constexpr (ALIGN_EPI) { if (wr == 0) PG8_BAR; }
        if constexpr (!Epi::AFTER_DRAIN) { E(acc, cur, wr, wc, fr, fq); S.done(cur); }
        if (!has_next) break;
        if (!(Epi::SPLITK2 && cur.kh == 0))
#pragma unroll
        for (int a = 0; a < 2; ++a)
#pragma unroll
            for (int b = 0; b < 2; ++b)
#pragma unroll
                for (int m = 0; m < 4; ++m)
#pragma unroll
                    for (int n = 0; n < 2; ++n) acc[a][b][m][n] = (f32x4){0.f, 0.f, 0.f, 0.f};
        cur = nxt; cA = nA; cB = nB; ++ui;
        if constexpr (ALIGN_EPI) { if (wr == 1) PG8_BAR; }
    }
    PG8_WAIT_V(0);
    if constexpr (!ALIGN_EPI) { if (wr == 0) PG8_BAR; }
    PG8_BAR;
    if constexpr (Epi::AFTER_DRAIN) { E.fused(acc, cur, wr, wc, fr, fq, lds, wid, lane); S.done(cur); }
#undef PG8_SA
#undef PG8_SB
#undef PG8_STAGE
#undef PG8_LDA
#undef PG8_LDB
#undef PG8_MMA
#undef PG8_WAIT_V
#undef PG8_WAIT_L
#undef PG8_BAR
#undef PG8_SCHED
}
}
namespace epi {
using pg8::Unit;
typedef f32x4 Acc[2][2][4][2];

__device__ __forceinline__ void rot2(f32x4& v, const f32x4 cs) {
    const float a1 = v[0] * cs[0] - v[1] * cs[1], a2 = v[1] * cs[0] + v[0] * cs[1];
    const float b1 = v[2] * cs[2] - v[3] * cs[3], b2 = v[3] * cs[2] + v[2] * cs[3];
    v = (f32x4){a1, a2, b1, b2};
}
__device__ __forceinline__ float sigm(float x) { return 1.0f / (1.0f + __expf(-x)); }
__device__ __forceinline__ void vmax_publish(unsigned* word, float mx) {
#pragma unroll
    for (int o = 1; o < 64; o <<= 1) mx = fmaxf(mx, __shfl_xor(mx, o));
    if ((threadIdx.x & 63) == 0) atomicMax(word, __float_as_uint(mx));
}
__device__ __forceinline__ float amax8(f32x4 a, f32x4 b) { return fmaxf(fmaxf(fmaxf(fabsf(a[0]), fabsf(a[1])), fmaxf(fabsf(a[2]), fabsf(a[3]))), fmaxf(fmaxf(fabsf(b[0]), fabsf(b[1])), fmaxf(fabsf(b[2]), fabsf(b[3])))); }
__device__ __forceinline__ void unpack8_fp8(const u32x2 w, f32x4& a, f32x4& b) {
    const f32x2 p0 = __builtin_amdgcn_cvt_pk_f32_fp8((int)w.x, false), p1 = __builtin_amdgcn_cvt_pk_f32_fp8((int)w.x, true), p2 = __builtin_amdgcn_cvt_pk_f32_fp8((int)w.y, false), p3 = __builtin_amdgcn_cvt_pk_f32_fp8((int)w.y, true);
    a = (f32x4){p0.x, p0.y, p1.x, p1.y}; b = (f32x4){p2.x, p2.y, p3.x, p3.y};
}
__device__ __forceinline__ float sat8(float x) { return fminf(fmaxf(x, -448.0f), 448.0f); }
__device__ __forceinline__ u32x2 pack8_fp8(f32x4 a, f32x4 b) {
    int p0 = 0, p1 = 0;
    p0 = __builtin_amdgcn_cvt_pk_fp8_f32(sat8(a[0]), sat8(a[1]), p0, false); p0 = __builtin_amdgcn_cvt_pk_fp8_f32(sat8(a[2]), sat8(a[3]), p0, true);
    p1 = __builtin_amdgcn_cvt_pk_fp8_f32(sat8(b[0]), sat8(b[1]), p1, false); p1 = __builtin_amdgcn_cvt_pk_fp8_f32(sat8(b[2]), sat8(b[3]), p1, true);
    return (u32x2){(unsigned)p0, (unsigned)p1};
}

template <bool F8> struct EpiIn {
    static constexpr bool PERM = true, AFTER_DRAIN = false, SPLITK2 = false, FP8 = F8;
    bf16_t *cq, *ckv, *qb, *kb, *vb, *qix, *kpe, *kix, *ga, *gb; float* wix; u64 *ssq_cq, *ssq_ckv;
    const float *ropeM, *ropeD, *ropeI;
    unsigned* vmaxw;
    const float *sx, *sw;
    __device__ __forceinline__ void operator()(const Acc& acc, const Unit& u, int wr, int wc, int fr, int fq) const {
        const int vt = F8 ? (u.pn < 18 ? u.pn : u.pn + 5) : u.pn + 18, rowb = u.pm * 256 + wr * 64 + fr, ct = wc * 32 + 8 * fq;
        f32x4 wsc[2][2];
        if (F8) {
#pragma unroll
            for (int bj = 0; bj < 2; ++bj) { const f32x4* p = (const f32x4*)(sw + u.pn * 256 + ct + bj * 128); wsc[bj][0] = p[0]; wsc[bj][1] = p[1]; }
        }
#define AV(ai_, bj_, m_, n_) (F8 ? acc[ai_][bj_][m_][n_] * rs * wsc[bj_][n_] : acc[ai_][bj_][m_][n_])
        if (vt < 6) {
            bf16_t* dst = vt < 4 ? cq : ckv; const int ld = vt < 4 ? 1024 : 512, cb = (vt < 4 ? vt : vt - 4) * 256 + ct; u64* ssq = vt < 4 ? ssq_cq : ssq_ckv;
#pragma unroll
            for (int ai = 0; ai < 2; ++ai)
#pragma unroll
                for (int m = 0; m < 4; ++m) { const int row = rowb + ai * 128 + m * 16; const float rs = F8 ? sx[row] : 1.f; (void)rs; float s = 0.f;
#pragma unroll
                    for (int bj = 0; bj < 2; ++bj) { const f32x4 v0 = AV(ai, bj, m, 0), v1 = AV(ai, bj, m, 1);
                        s += (v0[0] * v0[0] + v0[1] * v0[1]) + (v0[2] * v0[2] + v0[3] * v0[3]) + (v1[0] * v1[0] + v1[1] * v1[1]) + (v1[2] * v1[2] + v1[3] * v1[3]);
                        *(u32x2*)((unsigned char*)dst + (size_t)row * ld + cb + bj * 128) = pack8_fp8(v0, v1); }
                    s += __shfl_xor(s, 16); s += __shfl_xor(s, 32);
                    if (fq == 0 && ssq) ssq_add(ssq + row, s); }
        } else if (vt < 16) {
            const bool isq = vt < 14; bf16_t* dst = isq ? qb : kb; const int ld = isq ? 2048 : 512, cb = (isq ? vt - 6 : vt - 14) * 256 + ct;
#pragma unroll
            for (int ai = 0; ai < 2; ++ai)
#pragma unroll
                for (int m = 0; m < 4; ++m) { const int row = rowb + ai * 128 + m * 16, t = row_pos(row); const float rs = F8 ? sx[row] : 1.f; (void)rs;
                    f32x4 cs0 = (f32x4){1.f, 0.f, 1.f, 0.f}, cs1 = cs0;
                    if (wc == 0) { const f32x4* p = (const f32x4*)(ropeD + ((size_t)t * 16 + 4 * fq) * 2); cs0 = p[0]; cs1 = p[1]; }
#pragma unroll
                    for (int bj = 0; bj < 2; ++bj) { f32x4 v0 = AV(ai, bj, m, 0), v1 = AV(ai, bj, m, 1);
                        if (wc == 0) { rot2(v0, cs0); rot2(v1, cs1); }
                        *(u32x2*)((unsigned char*)dst + (size_t)row * ld + cb + bj * 128) = pack8_fp8(v0, v1); } }
        } else if (vt < 18) {
            const int cb = (vt - 16) * 256 + ct; float vmx = 0.f;
#pragma unroll
            for (int ai = 0; ai < 2; ++ai)
#pragma unroll
                for (int m = 0; m < 4; ++m) { const int row = rowb + ai * 128 + m * 16; const float rs = F8 ? sx[row] : 1.f; (void)rs;
#pragma unroll
                    for (int bj = 0; bj < 2; ++bj) { const f32x4 v0 = AV(ai, bj, m, 0), v1 = AV(ai, bj, m, 1); vmx = fmaxf(vmx, amax8(v0, v1)); *(u32x2*)((unsigned char*)vb + (size_t)row * 512 + cb + bj * 128) = pack8_fp8(v0, v1); } }
            vmax_publish(vmaxw, vmx);
        } else if (vt < 22) {
            const int cb = (vt - 18) * 256 + ct; const bool rt = ((wc & 1) == 0) && (fq < 2);
#pragma unroll
            for (int ai = 0; ai < 2; ++ai)
#pragma unroll
                for (int m = 0; m < 4; ++m) { const int row = rowb + ai * 128 + m * 16, t = row_pos(row); const float rs = F8 ? sx[row] : 1.f; (void)rs;
                    f32x4 cs0 = (f32x4){1.f, 0.f, 1.f, 0.f}, cs1 = cs0;
                    if (rt) { const f32x4* p = (const f32x4*)(ropeI + ((size_t)t * 8 + 4 * fq) * 2); cs0 = p[0]; cs1 = p[1]; }
#pragma unroll
                    for (int bj = 0; bj < 2; ++bj) { f32x4 v0 = AV(ai, bj, m, 0), v1 = AV(ai, bj, m, 1);
                        if (rt) { rot2(v0, cs0); rot2(v1, cs1); }
                        *(u32x4*)(qix + (size_t)row * 1024 + cb + bj * 128) = pack8(v0, v1); } }
        } else if (vt == 22) {
#pragma unroll
            for (int ai = 0; ai < 2; ++ai)
#pragma unroll
                for (int m = 0; m < 4; ++m) { const int row = rowb + ai * 128 + m * 16, t = row_pos(row); const float rs = F8 ? sx[row] : 1.f; (void)rs;
                    f32x4 v0 = AV(ai, 0, m, 0), v1 = AV(ai, 0, m, 1);
                    if (wc < 2) { const f32x4* p = (const f32x4*)(ropeM + ((size_t)t * 32 + 16 * wc + 4 * fq) * 2); rot2(v0, p[0]); rot2(v1, p[1]);
                        *(u32x2*)((unsigned char*)kpe + (size_t)row * 64 + ct) = pack8_fp8(v0, v1);
                    } else { if (wc == 2 && fq < 2) { const f32x4* p = (const f32x4*)(ropeI + ((size_t)t * 8 + 4 * fq) * 2); rot2(v0, p[0]); rot2(v1, p[1]); }
                        *(u32x4*)(kix + (size_t)row * 64 + (ct - 64)) = pack8(v0, v1); }
                    if (wc == 0 && fq < 2) { float* w = wix + (size_t)row * 16 + 8 * fq; *(f32x4*)w = AV(ai, 1, m, 0); *(f32x4*)(w + 4) = AV(ai, 1, m, 1); } }
        } else {
            const bool isa = vt < 39; bf16_t* dst = isa ? ga : gb; const int cb = (isa ? vt - 23 : vt - 39) * 256 + ct;
#pragma unroll
            for (int ai = 0; ai < 2; ++ai)
#pragma unroll
                for (int m = 0; m < 4; ++m) { const int row = rowb + ai * 128 + m * 16; const float rs = F8 ? sx[row] : 1.f; (void)rs;
#pragma unroll
                    for (int bj = 0; bj < 2; ++bj) { f32x4 v0 = AV(ai, bj, m, 0), v1 = AV(ai, bj, m, 1);
#pragma unroll
                        for (int e = 0; e < 4; ++e) { v0[e] = 256.0f * sigm(v0[e]); v1[e] = 256.0f * sigm(v1[e]); }
                        *(u32x2*)((unsigned char*)dst + (size_t)row * 4096 + cb + bj * 128) = pack8_fp8(v0, v1); } }
        }
#undef AV
    }
};

struct EpiUp {
    static constexpr bool PERM = true, AFTER_DRAIN = false, SPLITK2 = false, FP8 = true;
    unsigned char *d0, *d1; int nt0, ld0, ld1; bool d1_v; const u64* ssq; float invK; const float* rope; const float* sw; unsigned* vmaxw;
    __device__ __forceinline__ void operator()(const Acc& acc, const Unit& u, int wr, int wc, int fr, int fq) const {
        const int vt = u.pn, rowb = u.pm * 256 + wr * 64 + fr, ct = wc * 32 + 8 * fq; const bool first = vt < nt0;
        unsigned char* dst = first ? d0 : d1; const int ld = first ? ld0 : ld1, cb = (first ? vt : vt - nt0) * 256 + ct; const bool rt = (!first) && (rope != nullptr), isv = (!first) && d1_v;
        f32x4 w0[2], w1[2]; float vmx = 0.f;
#pragma unroll
        for (int bj = 0; bj < 2; ++bj) { const f32x4* p = (const f32x4*)(sw + vt * 256 + ct + bj * 128); w0[bj] = p[0]; w1[bj] = p[1]; }
#pragma unroll
        for (int ai = 0; ai < 2; ++ai)
#pragma unroll
            for (int m = 0; m < 4; ++m) { const int row = rowb + ai * 128 + m * 16, t = row_pos(row);
                const float rs = __builtin_amdgcn_rsqf(ssq_get(ssq + row) * invK + EPS);
                f32x4 cs0 = (f32x4){1.f, 0.f, 1.f, 0.f}, cs1 = cs0;
                if (rt) { const f32x4* p = (const f32x4*)(rope + ((size_t)t * 32 + 16 * (wc & 1) + 4 * fq) * 2); cs0 = p[0]; cs1 = p[1]; }
#pragma unroll
                for (int bj = 0; bj < 2; ++bj) { f32x4 v0 = acc[ai][bj][m][0] * rs * w0[bj], v1 = acc[ai][bj][m][1] * rs * w1[bj];
                    if (rt) { rot2(v0, cs0); rot2(v1, cs1); }
                    if (isv) vmx = fmaxf(vmx, amax8(v0, v1));
                    *(u32x2*)(dst + (size_t)row * ld + cb + bj * 128) = pack8_fp8(v0, v1); } }
        if (isv) vmax_publish(vmaxw, vmx);
    }
};

struct EpiBranch {
    static constexpr bool PERM = true, AFTER_DRAIN = false, SPLITK2 = true, FP8 = true;
    const bf16_t *ga, *gb; bf16_t* out; const unsigned* vmaxw; const float* scol;
    __device__ __forceinline__ void operator()(Acc& acc, const Unit& u, int wr, int wc, int fr, int fq) const {
        const int rowb = u.pm * 256 + wr * 64 + fr, cb = u.pn * 256 + wc * 32 + 8 * fq;
        const float vmb = fmaxf(__uint_as_float(vmaxw[0]), 1e-30f), vma = fmaxf(__uint_as_float(vmaxw[64]), 1e-30f);
        if (u.kh == 0) {
            const float rab = vma * __builtin_amdgcn_rcpf(vmb);
#pragma unroll
            for (int ai = 0; ai < 2; ++ai)
#pragma unroll
                for (int m = 0; m < 4; ++m) { const size_t ro = (size_t)(rowb + ai * 128 + m * 16) * 4096 + cb;
#pragma unroll
                    for (int bj = 0; bj < 2; ++bj) { f32x4 a0, a1, b0, b1; unpack8_fp8(*(const u32x2*)((const unsigned char*)ga + ro + bj * 128), a0, a1); unpack8_fp8(*(const u32x2*)((const unsigned char*)gb + ro + bj * 128), b0, b1);
                        f32x4 r0, r1;
#pragma unroll
                        for (int e = 0; e < 4; ++e) { r0[e] = a0[e] * __builtin_amdgcn_rcpf(fmaxf(b0[e], 0.001953125f)); r1[e] = a1[e] * __builtin_amdgcn_rcpf(fmaxf(b1[e], 0.001953125f)); }
                        acc[ai][bj][m][0] = acc[ai][bj][m][0] * (r0 * rab); acc[ai][bj][m][1] = acc[ai][bj][m][1] * (r1 * rab); }
                    asm volatile("" ::: "memory"); }
        } else {
            f32x4 w0[2], w1[2];
#pragma unroll
            for (int bj = 0; bj < 2; ++bj) { const f32x4* p = (const f32x4*)(scol + cb + bj * 128); w0[bj] = p[0]; w1[bj] = p[1]; }
#pragma unroll
            for (int ai = 0; ai < 2; ++ai)
#pragma unroll
                for (int m = 0; m < 4; ++m) { const int row = rowb + ai * 128 + m * 16; const size_t ro = (size_t)row * 4096 + cb; const float rs = vmb * (1.0f / 440.0f);
#pragma unroll
                    for (int bj = 0; bj < 2; ++bj) { f32x4 s0, s1; unpack8_fp8(*(const u32x2*)((const unsigned char*)gb + ro + bj * 128), s0, s1);
                        s0 = s0 * (rs * (1.0f / 256.0f)) * w0[bj]; s1 = s1 * (rs * (1.0f / 256.0f)) * w1[bj];
                        *(u32x4*)(out + ro + bj * 128) = pack8(acc[ai][bj][m][0] * s0, acc[ai][bj][m][1] * s1); } }
        }
    }
};

struct EpiOut {
    static constexpr bool PERM = true, AFTER_DRAIN = false, SPLITK2 = false, FP8 = true;
    const float *x, *meta; float* h1f; bf16_t* h1b; u64* ssq; const float *srow, *scol;
    __device__ __forceinline__ void operator()(const Acc& acc, const Unit& u, int wr, int wc, int fr, int fq) const {
        const int rowb = u.pm * 256 + wr * 64 + fr, cb = u.pn * 256 + wc * 32 + 8 * fq;
#pragma unroll
        for (int ai = 0; ai < 2; ++ai)
#pragma unroll
            for (int m = 0; m < 4; ++m) { const int row = rowb + ai * 128 + m * 16;
                const float* src = x + (size_t)row * DM;
                float s = 0.f; const float rs = srow[row];
#pragma unroll
                for (int bj = 0; bj < 2; ++bj) { const f32x4* wp = (const f32x4*)(scol + cb + bj * 128); f32x4 v0 = acc[ai][bj][m][0] * rs * wp[0], v1 = acc[ai][bj][m][1] * rs * wp[1];
                    v0 = v0 + *(const f32x4*)(src + cb + bj * 128); v1 = v1 + *(const f32x4*)(src + cb + bj * 128 + 4);
                    s += (v0[0] * v0[0] + v0[1] * v0[1]) + (v0[2] * v0[2] + v0[3] * v0[3]) + (v1[0] * v1[0] + v1[1] * v1[1]) + (v1[2] * v1[2] + v1[3] * v1[3]);
                    *(u32x4*)(h1b + (size_t)row * DM + cb + bj * 128) = pack8(v0, v1); }
                s += __shfl_xor(s, 16); s += __shfl_xor(s, 32);
                if (fq == 0 && ssq) ssq_add(ssq + row, s); }
    }
};

struct EpiPQ {
    static constexpr bool PERM = true, AFTER_DRAIN = false, SPLITK2 = false, FP8 = false;
    bf16_t* pq; const u64* ssq;
    __device__ __forceinline__ void operator()(const Acc& acc, const Unit& u, int wr, int wc, int fr, int fq) const {
        const int rowb = u.pm * 256 + wr * 64 + fr, cb = u.pn * 256 + wc * 32 + 8 * fq;
#pragma unroll
        for (int ai = 0; ai < 2; ++ai)
#pragma unroll
            for (int m = 0; m < 4; ++m) { const int row = rowb + ai * 128 + m * 16; const float rs = __builtin_amdgcn_rsqf(ssq_get(ssq + row) * (1.0f / DM) + EPS);
#pragma unroll
                for (int bj = 0; bj < 2; ++bj) *(u32x4*)(pq + (size_t)row * 2048 + cb + bj * 128) = pack8(acc[ai][bj][m][0] * rs, acc[ai][bj][m][1] * rs); }
    }
};
}
#define XB_TMO      128
#define XB_XCNT(j)  (256  + 64 * (j))
#define XB_XSUB(j)  (1280 + 64 * (j))
#define XB_XGEN(j)  (2304 + 64 * (j))
#define XB_TOP      3328
#define XB_TOPGEN   3392
#define XCD_BAR_WORDS 3456
#define XB_SPIN_CAP (1u << 18)
__device__ __forceinline__ unsigned xb_ld(unsigned* p)              { return __hip_atomic_load(p, __ATOMIC_RELAXED, __HIP_MEMORY_SCOPE_AGENT); }
__device__ __forceinline__ unsigned xb_add(unsigned* p, unsigned v) { return __hip_atomic_fetch_add(p, v, __ATOMIC_RELAXED, __HIP_MEMORY_SCOPE_AGENT); }
__device__ __forceinline__ unsigned xb_xcc_id() { return (unsigned)__builtin_amdgcn_s_getreg((3 << 11) | 20) & 0xFu; }
#define XB_SPIN(cond, bar) do { unsigned _sp = 0; while (cond) { __builtin_amdgcn_s_sleep(1); \
    if ((++_sp & 255u) == 0u) { if (xb_ld(&(bar)[XB_TMO])) break; if (_sp > XB_SPIN_CAP) { atomicAdd(&(bar)[XB_TMO], 1u); break; } } } } while (0)
struct XcdBarrier { unsigned* bar; unsigned x; volatile LAS unsigned* st; };
__device__ __forceinline__ XcdBarrier xcd_barrier_post(unsigned* bar, volatile LAS unsigned* st) {
    XcdBarrier b; b.bar = bar; b.x = xb_xcc_id(); b.st = st;
    if (threadIdx.x == 0) (void)xb_add(&bar[XB_XCNT(b.x)], 1u);
    return b;
}
__device__ __forceinline__ void xcd_barrier_complete(unsigned* bar, unsigned x, unsigned& nloc, unsigned& nx) {
    const unsigned G = gridDim.x * gridDim.y * gridDim.z;
    unsigned sum, cnt, mine, sp = 0u;
    for (;;) {
        sum = 0u; cnt = 0u; mine = 0u;
#pragma unroll
        for (unsigned j = 0; j < 16; ++j) { const unsigned c = xb_ld(&bar[XB_XCNT(j)]); sum += c; cnt += (c > 0u) ? 1u : 0u; mine = (j == x) ? c : mine; }
        if (sum == G) break;
        __builtin_amdgcn_s_sleep(1);
        if ((++sp & 255u) == 0u) { if (xb_ld(&bar[XB_TMO])) break; if (sp > XB_SPIN_CAP) { atomicAdd(&bar[XB_TMO], 1u); break; } }
    }
    nloc = mine > 0u ? mine : 1u; nx = cnt > 0u ? cnt : 1u;
}
__device__ __forceinline__ void xcd_barrier(const XcdBarrier& b) {
    asm volatile("s_waitcnt vmcnt(0)" ::: "memory");
    __syncthreads();
    if (threadIdx.x == 0) {
        unsigned* bar = b.bar;
        __builtin_amdgcn_s_waitcnt(0);
        unsigned nloc = b.st[0], nx = b.st[1];
        if (nloc == 0u) { xcd_barrier_complete(bar, b.x, nloc, nx); b.st[0] = nloc; b.st[1] = nx; }
        const unsigned old = xb_add(&bar[XB_XSUB(b.x)], 1u);
        const unsigned gen = old / nloc;
        if (old + 1u == (gen + 1u) * nloc) {
            __builtin_amdgcn_fence(__ATOMIC_RELEASE, "agent");
            asm volatile("s_waitcnt vmcnt(0)" ::: "memory");
            const unsigned og = xb_add(&bar[XB_TOP], 1u);
            const unsigned tg = og / nx;
            if (og + 1u == (tg + 1u) * nx) xb_add(&bar[XB_TOPGEN], 1u);
            else XB_SPIN(xb_ld(&bar[XB_TOPGEN]) == tg, bar);
            __builtin_amdgcn_fence(__ATOMIC_ACQUIRE, "agent");
            xb_add(&bar[XB_XGEN(b.x)], 1u);
            asm volatile("s_waitcnt vmcnt(0)" ::: "memory");
        } else {
            XB_SPIN(xb_ld(&bar[XB_XGEN(b.x)]) == gen, bar);
            __builtin_amdgcn_fence(__ATOMIC_ACQUIRE, "agent");
            asm volatile("s_waitcnt vmcnt(0)" ::: "memory");
        }
    }
    __syncthreads();
}

struct Frame {
    LAS unsigned char* lds;
    unsigned char* ws;
    unsigned* ctl;
    int tid, lane, wave, vcu, G;
    __device__ __forceinline__ const float* in(int i) const { return ((const float* const __attribute__((address_space(4)))*)__builtin_amdgcn_kernarg_segment_ptr())[i]; }
    __device__ __forceinline__ float* out() const { return ((float* const __attribute__((address_space(4)))*)__builtin_amdgcn_kernarg_segment_ptr())[16]; }
};

struct MapId { __device__ __forceinline__ int operator()(int v) const { return v; } };
struct MapIn { __device__ __forceinline__ int operator()(int vn) const {
    const int v = vn < 1280 ? vn + 4608 : (vn < 5888 ? vn - 1280 : vn);
    if (v < 1536) return v;
    if (v < 3584) { const int w = v - 1536, hd = w >> 7; int o = w & 127; if (o < 32) o = (o & 1) ? (o >> 1) + 16 : (o >> 1); return 1600 + hd * 128 + o; }
    if (v < 4096) { const int w = v - 3584, hd = w >> 7; int o = w & 127; if (o < 32) o = (o & 1) ? (o >> 1) + 16 : (o >> 1); return 3648 + hd * 128 + o; }
    if (v < 4608) return 4160 + (v - 4096);
    if (v < 5632) { const int w = v - 4608, hd = w >> 6; int o = w & 63; if (o < 16) o = (o & 1) ? (o >> 1) + 8 : (o >> 1); return 4672 + hd * 64 + o; }
    if (v < 5888) { const int w = v - 5632;
        if (w < 64) return 1536 + ((w & 1) ? (w >> 1) + 32 : (w >> 1));
        if (w < 128) { int o = w - 64; if (o < 16) o = (o & 1) ? (o >> 1) + 8 : (o >> 1); return 5696 + o; }
        if (w < 144) return 5760 + (w - 128);
        return -1; }
    if (v < 9984) return 5776 + (v - 5888);
    return 9872 + (v - 9984);
} };
struct MapUq { __device__ __forceinline__ int operator()(int v) const {
    if (v < 2048) return (v >> 7) * 192 + (v & 127);
    const int w = v - 2048, hd = w >> 6, o = w & 63; return hd * 192 + 128 + ((o & 1) ? (o >> 1) + 32 : (o >> 1)); } };
struct MapUkv { __device__ __forceinline__ int operator()(int v) const {
    if (v < 2048) return (v >> 7) * 256 + (v & 127);
    const int w = v - 2048; return (w >> 7) * 256 + 128 + (w & 127); } };

template <class Map>
__device__ __forceinline__ void p0_transpose_item(const float* W, int K, int Nsrc, int Nvirt, bf16_t* WT, const float* gk, LAS float* scr, int item, int lane, Map map) {
    const int nblk = Nvirt / 32, kb = item / nblk, nb = item % nblk, k0 = 64 * kb, n0 = 32 * nb;
    const int sc = map(n0 + (lane & 31));
    float tv[32];
#pragma unroll
    for (int i = 0; i < 32; ++i) { const int kk = 2 * i + (lane >> 5); tv[i] = (sc >= 0) ? W[(size_t)(k0 + kk) * Nsrc + sc] : 0.f; }
    if (gk) {
#pragma unroll
        for (int i = 0; i < 32; ++i) tv[i] *= gk[k0 + 2 * i + (lane >> 5)]; }
#pragma unroll
    for (int i = 0; i < 32; ++i) scr[(2 * i + (lane >> 5)) * 33 + (lane & 31)] = tv[i];
    LDS_WAIT(); asm volatile("" ::: "memory");
    const int c = lane & 7;
#pragma unroll
    for (int j = 0; j < 4; ++j) { const int n = (lane >> 3) + 8 * j; const LAS float* s = scr + (8 * c) * 33 + n;
        u32x4 o; o.x = pk2(s[0 * 33], s[1 * 33]); o.y = pk2(s[2 * 33], s[3 * 33]); o.z = pk2(s[4 * 33], s[5 * 33]); o.w = pk2(s[6 * 33], s[7 * 33]);
        *(u32x4*)(WT + (size_t)(n0 + n) * K + k0 + 8 * c) = o; }
    LDS_WAIT(); asm volatile("" ::: "memory");
}
__device__ __forceinline__ float wave_max(float v) {
#pragma unroll
    for (int o = 1; o < 64; o <<= 1) v = fmaxf(v, __shfl_xor(v, o));
    return v;
}
__device__ __forceinline__ void p0_xn_row(const Frame& F, int m) {
    const float* x = F.in(0); const float* meta = F.in(1); const float* g = F.in(2);
    bf16_t* o = (bf16_t*)(F.ws + WS_XN) + (size_t)m * DM;
    u32x2* o8 = (u32x2*)o + F.lane;
    if (m >= NTOK + NMETA) {
        unsigned* z8 = (unsigned*)(F.ws + WS_XN8 + (size_t)m * DM) + F.lane;
#pragma unroll
        for (int j = 0; j < 16; ++j) { o8[64 * j] = (u32x2){0u, 0u}; z8[64 * j] = 0u; }
        if (F.lane == 0) ((float*)(F.ws + WS_SX))[m] = 0.f;
        return; }
    const float* src = m < NTOK ? x + (size_t)m * DM : meta + (size_t)(m - NTOK) * DM;
    const f32x4* xr = (const f32x4*)src + F.lane; const f32x4* gr = (const f32x4*)g + F.lane;
    f32x4 v[16]; float s = 0.f;
#pragma unroll
    for (int j = 0; j < 16; ++j) { v[j] = xr[64 * j]; s += (v[j][0] * v[j][0] + v[j][1] * v[j][1]) + (v[j][2] * v[j][2] + v[j][3] * v[j][3]); }
    const float rstd = 1.0f / sqrtf(wave_sum(s) * (1.0f / DM) + EPS);
    float mx = 0.f;
#pragma unroll
    for (int j = 0; j < 16; ++j) { const f32x4 gg = gr[64 * j]; v[j] = v[j] * rstd * gg; o8[64 * j] = (u32x2){pk2(v[j][0], v[j][1]), pk2(v[j][2], v[j][3])};
        mx = fmaxf(mx, fmaxf(fmaxf(fabsf(v[j][0]), fabsf(v[j][1])), fmaxf(fabsf(v[j][2]), fabsf(v[j][3])))); }
    mx = fmaxf(wave_max(mx), 1e-30f);
    const float inv = 448.0f / mx;
    if (F.lane == 0) ((float*)(F.ws + WS_SX))[m] = mx * (1.0f / 448.0f);
    unsigned* q8 = (unsigned*)(F.ws + WS_XN8 + (size_t)m * DM) + F.lane;
#pragma unroll
    for (int j = 0; j < 16; ++j) { f32x4 q = v[j] * inv;
#pragma unroll
        for (int e = 0; e < 4; ++e) q[e] = fminf(fmaxf(q[e], -448.0f), 448.0f);
        int p = 0; p = __builtin_amdgcn_cvt_pk_fp8_f32(q[0], q[1], p, false); p = __builtin_amdgcn_cvt_pk_fp8_f32(q[2], q[3], p, true); q8[64 * j] = (unsigned)p; }
}
__device__ __forceinline__ void p0_prologue(const Frame& F) {
    LAS float* scr = (LAS float*)(F.lds + F.wave * 16384);
    const int gw = F.vcu * NWAVES + F.wave, NGW = F.G * NWAVES;
    const float* w_in = F.in(3); const float* qg = F.in(4); const float* w_uq = F.in(5); const float* kvg = F.in(6); const float* w_ukv = F.in(7);
    const float* w_br = F.in(8); const float* w_out = F.in(9); const float* fg = F.in(10); const float* w_q = F.in(11); const float* sk = F.in(12);
    constexpr int I_IN = 64 * (NV1 / 32), I_UQ = 16 * (3072 / 32), I_UKV = 8 * (4096 / 32), I_BR = 64 * 128, I_OUT = 64 * 128, I_Q = 64 * 64;
    constexpr int NITEMS = I_IN + I_UQ + I_UKV + I_BR + I_OUT + I_Q;
    for (int it = gw; it < NITEMS; it += NGW) {
        int r = it;
        if (r < I_IN) { p0_transpose_item(w_in, 4096, 13968, NV1, (bf16_t*)(F.ws + WS_WIN), nullptr, scr, r, F.lane, MapIn()); continue; } r -= I_IN;
        if (r < I_UQ) { p0_transpose_item(w_uq, 1024, 3072, 3072, (bf16_t*)(F.ws + WS_WUQ), qg, scr, r, F.lane, MapUq()); continue; } r -= I_UQ;
        if (r < I_UKV) { p0_transpose_item(w_ukv, 512, 4096, 4096, (bf16_t*)(F.ws + WS_WUKV), kvg, scr, r, F.lane, MapUkv()); continue; } r -= I_UKV;
        if (r < I_BR) { p0_transpose_item(w_br, 4096, 4096, 4096, (bf16_t*)(F.ws + WS_H1F), nullptr, scr, r, F.lane, MapId()); continue; } r -= I_BR;
        if (r < I_OUT) { p0_transpose_item(w_out, 4096, 4096, 4096, (bf16_t*)(F.ws + WS_WOUT), nullptr, scr, r, F.lane, MapId()); continue; } r -= I_OUT;
        p0_transpose_item(w_q, 4096, 2048, 2048, (bf16_t*)(F.ws + WS_WQ), fg, scr, r, F.lane, MapId());
    }
    for (int m = gw; m < MK; m += NGW) p0_xn_row(F, m);
    const int gt = (F.vcu * NWAVES + F.wave) * 64 + F.lane, NGT = NGW * 64;
    for (int i = gt; i < TP * 56; i += NGT) {
        const int t = i / 56, r = i % 56; int j, rot; float* dst;
        if (r < 32) { j = r; rot = 64; dst = (float*)(F.ws + WS_ROPE_M) + ((size_t)t * 32 + j) * 2; }
        else if (r < 48) { j = r - 32; rot = 32; dst = (float*)(F.ws + WS_ROPE_D) + ((size_t)t * 16 + j) * 2; }
        else { j = r - 48; rot = 16; dst = (float*)(F.ws + WS_ROPE_I) + ((size_t)t * 8 + j) * 2; }
        const float ex = (float)(2 * j) / (float)rot;
        const float inv = powf(500000.0f, -ex);
        const float ang = (float)t * inv;
        const double a = (double)ang, kq = rint(a * 0.15915494309189535), rr = fma(-kq, 6.283185307179586, a);
        const float rf = (float)rr;
        dst[0] = cosf(rf); dst[1] = sinf(rf);
    }
    for (int i = gt; i < 16 * 128 * 128 / 8; i += NGT) { const f32x4* s = (const f32x4*)sk + 2 * (size_t)i; const f32x4 a = s[0], b2 = s[1];
        u32x4 o; o.x = pk2(a[0], a[1]); o.y = pk2(a[2], a[3]); o.z = pk2(b2[0], b2[1]); o.w = pk2(b2[2], b2[3]); ((u32x4*)(F.ws + WS_SK))[i] = o; }
}
__device__ __forceinline__ unsigned fp6_code(float q) {
    const unsigned b = __float_as_uint(q), sgn = (b >> 31) << 5; const float aq = fabsf(q);
    const unsigned sub = (unsigned)rintf(aq * 8.0f);
    unsigned ab = b & 0x7fffffffu; ab = ab + 0x7FFFFu + ((ab >> 20) & 1u);
    const unsigned nrm = (ab >> 20) - (126u << 3);
    unsigned code = aq < 1.0f ? sub : nrm; code = code > 31u ? 31u : code;
    return code | sgn;
}
__device__ __forceinline__ void fp6_pack32(const unsigned (&c)[32], unsigned (&w)[6]) {
#pragma unroll
    for (int i = 0; i < 6; ++i) w[i] = 0u;
#pragma unroll
    for (int k = 0; k < 32; ++k) { const int bit = 6 * k, d = bit >> 5, sh = bit & 31; w[d] |= c[k] << sh; if (sh > 26) w[d + 1] |= c[k] >> (32 - sh); }
}
__device__ __forceinline__ void p6_quant_row(const float* src, const float* gain, unsigned char* dst, float* scale_out, int lane) {
    const f32x4* s = (const f32x4*)src + lane; f32x4 v[16]; float mx = 0.f;
#pragma unroll
    for (int j = 0; j < 16; ++j) { v[j] = s[64 * j]; if (gain) v[j] = v[j] * ((const f32x4*)gain)[lane + 64 * j];
        mx = fmaxf(mx, fmaxf(fmaxf(fabsf(v[j][0]), fabsf(v[j][1])), fmaxf(fabsf(v[j][2]), fabsf(v[j][3])))); }
    mx = fmaxf(wave_max(mx), 1e-30f);
    const float sc = mx * (1.0f / 7.5f), inv = 7.5f / mx;
    if (lane == 0) *scale_out = sc;
    unsigned w[12];
#pragma unroll
    for (int g = 0; g < 2; ++g) { unsigned c[32];
#pragma unroll
        for (int j = 0; j < 8; ++j)
#pragma unroll
            for (int i = 0; i < 4; ++i) c[4 * j + i] = fp6_code(v[8 * g + j][i] * inv);
        unsigned ww[6]; fp6_pack32(c, ww);
#pragma unroll
        for (int i = 0; i < 6; ++i) w[6 * g + i] = ww[i]; }
#pragma unroll
    for (int q = 0; q < 3; ++q) *(u32x4*)(dst + 1024 * q + 16 * lane) = (u32x4){w[4 * q], w[4 * q + 1], w[4 * q + 2], w[4 * q + 3]};
}
__device__ __forceinline__ unsigned fp4_code(float q) {
    const float aq = fabsf(q);
    const unsigned c = (aq > 0.25f ? 1u : 0u) + (aq >= 0.75f ? 1u : 0u) + (aq > 1.25f ? 1u : 0u) + (aq >= 1.75f ? 1u : 0u) + (aq > 2.5f ? 1u : 0u) + (aq >= 3.5f ? 1u : 0u) + (aq > 5.0f ? 1u : 0u);
    return c | ((__float_as_uint(q) >> 31) << 3);
}
__device__ __forceinline__ void p6_quant_row4(const float* src, const float* gain, unsigned char* dst, float* scale_out, int lane) {
    const f32x4* s = (const f32x4*)src + lane; f32x4 v[16]; float mx = 0.f;
#pragma unroll
    for (int j = 0; j < 16; ++j) { v[j] = s[64 * j]; if (gain) v[j] = v[j] * ((const f32x4*)gain)[lane + 64 * j];
        mx = fmaxf(mx, fmaxf(fmaxf(fabsf(v[j][0]), fabsf(v[j][1])), fmaxf(fabsf(v[j][2]), fabsf(v[j][3])))); }
    mx = fmaxf(wave_max(mx), 1e-30f);
    const float sc = mx * (1.0f / 6.0f), inv = 6.0f / mx;
    if (lane == 0) *scale_out = sc;
    unsigned w[8];
#pragma unroll
    for (int d = 0; d < 8; ++d) { unsigned x = 0u;
#pragma unroll
        for (int i = 0; i < 4; ++i) { x |= fp4_code(v[2 * d][i] * inv) << (4 * i); x |= fp4_code(v[2 * d + 1][i] * inv) << (16 + 4 * i); }
        w[d] = x; }
#pragma unroll
    for (int q = 0; q < 2; ++q) *(u32x4*)(dst + 1024 * q + 16 * lane) = (u32x4){w[4 * q], w[4 * q + 1], w[4 * q + 2], w[4 * q + 3]};
}
#ifndef PEER_U_BITS
#define PEER_U_BITS 4
#endif
#ifndef PEER_V_BITS
#define PEER_V_BITS 4
#endif
constexpr int PEER_U_ROWB = PEER_U_BITS == 4 ? 2048 : 3072, PEER_V_ROWB = PEER_V_BITS == 4 ? 2048 : 3072;
__device__ __forceinline__ void p6_quant_regs4(f32x4 (&v)[16], unsigned char* dst, float* scale_out, int lane) {
    float mx = 0.f;
#pragma unroll
    for (int j = 0; j < 16; ++j) mx = fmaxf(mx, fmaxf(fmaxf(fabsf(v[j][0]), fabsf(v[j][1])), fmaxf(fabsf(v[j][2]), fabsf(v[j][3]))));
    mx = fmaxf(wave_max(mx), 1e-30f);
    const float inv = 6.0f / mx;
    if (lane == 0) *scale_out = mx * (1.0f / 6.0f);
    unsigned w[8];
#pragma unroll
    for (int d = 0; d < 8; ++d) { unsigned x = 0u;
#pragma unroll
        for (int i = 0; i < 4; ++i) { x |= fp4_code(v[2 * d][i] * inv) << (4 * i); x |= fp4_code(v[2 * d + 1][i] * inv) << (16 + 4 * i); }
        w[d] = x; }
#pragma unroll
    for (int q = 0; q < 2; ++q) *(u32x4*)(dst + 1024 * q + 16 * lane) = (u32x4){w[4 * q], w[4 * q + 1], w[4 * q + 2], w[4 * q + 3]};
}
__device__ __forceinline__ void p6_tables(const Frame& F) {
    const float* fg = F.in(10); const float* pu = F.in(13); const float* pv = F.in(14);
    const int gw = F.vcu * NWAVES + F.wave, NGW = F.G * NWAVES, lane = F.lane;
#if PEER_U_BITS == 4 && PEER_V_BITS == 4
    if ((NGW & 1) == 0) {
        const bool isv = gw & 1; const float* tab = isv ? pv : pu; unsigned char* dtab = F.ws + (isv ? WS_V : WS_U); float* stab = (float*)(F.ws + (isv ? WS_SCV : WS_SCU));
        const int e0 = gw >> 1, estep = NGW >> 1;
        f32x4 g[16];
#pragma unroll
        for (int j = 0; j < 16; ++j) g[j] = isv ? (f32x4){1.f, 1.f, 1.f, 1.f} : ((const f32x4*)fg)[lane + 64 * j];
        f32x4 va[16], vb[16];
        if (e0 < 16384) {
#pragma unroll
            for (int j = 0; j < 16; ++j) va[j] = ((const f32x4*)(tab + (size_t)e0 * DM))[lane + 64 * j];
        }
#pragma unroll 1
        for (int e = e0; e < 16384; e += 2 * estep) {
            const int e1 = e + estep, e2 = e + 2 * estep;
            if (e1 < 16384) {
#pragma unroll
                for (int j = 0; j < 16; ++j) vb[j] = ((const f32x4*)(tab + (size_t)e1 * DM))[lane + 64 * j];
            }
#pragma unroll
            for (int j = 0; j < 16; ++j) va[j] = va[j] * g[j];
            p6_quant_regs4(va, dtab + (size_t)e * 2048, stab + e, lane);
            if (e2 < 16384) {
#pragma unroll
                for (int j = 0; j < 16; ++j) va[j] = ((const f32x4*)(tab + (size_t)e2 * DM))[lane + 64 * j];
            }
            if (e1 < 16384) {
#pragma unroll
                for (int j = 0; j < 16; ++j) vb[j] = vb[j] * g[j];
                p6_quant_regs4(vb, dtab + (size_t)e1 * 2048, stab + e1, lane);
            }
        }
        return;
    }
#endif
    for (int it = gw; it < 2 * 16384; it += NGW) { const int e = it >> 1;
        if (it & 1) { if (PEER_V_BITS == 4) p6_quant_row4(pv + (size_t)e * DM, nullptr, F.ws + WS_V + (size_t)e * PEER_V_ROWB, (float*)(F.ws + WS_SCV) + e, F.lane);
                      else p6_quant_row(pv + (size_t)e * DM, nullptr, F.ws + WS_V + (size_t)e * PEER_V_ROWB, (float*)(F.ws + WS_SCV) + e, F.lane); }
        else { if (PEER_U_BITS == 4) p6_quant_row4(pu + (size_t)e * DM, fg, F.ws + WS_U + (size_t)e * PEER_U_ROWB, (float*)(F.ws + WS_SCU) + e, F.lane);
               else p6_quant_row(pu + (size_t)e * DM, fg, F.ws + WS_U + (size_t)e * PEER_U_ROWB, (float*)(F.ws + WS_SCU) + e, F.lane); } }
}

__device__ __forceinline__ void rowquant_fp8(const Frame& F, const unsigned char* src, size_t src_pitch, unsigned char* dst, size_t dst_pitch, float* scale, int nrows) {
    const int gw = F.vcu * NWAVES + F.wave, NGW = F.G * NWAVES, lane = F.lane;
    for (int n = gw; n < nrows; n += NGW) {
        const u32x4* s = (const u32x4*)(src + (size_t)n * src_pitch) + lane;
        u32x4 v[8]; float mx = 0.f;
#pragma unroll
        for (int j = 0; j < 8; ++j) { v[j] = s[64 * j];
#pragma unroll
            for (int e = 0; e < 4; ++e) mx = fmaxf(mx, fmaxf(fabsf(bf_lo(v[j][e])), fabsf(bf_hi(v[j][e])))); }
        mx = fmaxf(wave_max(mx), 1e-30f);
        const float inv = 448.0f / mx;
        if (lane == 0) scale[n] = mx * (1.0f / 448.0f);
        asm volatile("" ::: "memory");
        u32x2* d = (u32x2*)(dst + (size_t)n * dst_pitch) + lane;
#pragma unroll
        for (int j = 0; j < 8; ++j) { int p0 = 0, p1 = 0;
            p0 = __builtin_amdgcn_cvt_pk_fp8_f32(bf_lo(v[j].x) * inv, bf_hi(v[j].x) * inv, p0, false); p0 = __builtin_amdgcn_cvt_pk_fp8_f32(bf_lo(v[j].y) * inv, bf_hi(v[j].y) * inv, p0, true);
            p1 = __builtin_amdgcn_cvt_pk_fp8_f32(bf_lo(v[j].z) * inv, bf_hi(v[j].z) * inv, p1, false); p1 = __builtin_amdgcn_cvt_pk_fp8_f32(bf_lo(v[j].w) * inv, bf_hi(v[j].w) * inv, p1, true);
            d[64 * j] = (u32x2){(unsigned)p0, (unsigned)p1}; }
    }
}
template <int LEN>
__device__ __forceinline__ void rowquant_fp8_n(const Frame& F, const unsigned char* src, unsigned char* dst, float* scale, int nrows) {
    const int gw = F.vcu * NWAVES + F.wave, NGW = F.G * NWAVES, lane = F.lane; constexpr int PER = LEN / 64;
    for (int n = gw; n < nrows; n += NGW) {
        const u32x4* s = (const u32x4*)(src + (size_t)n * LEN * 2) + lane * (PER / 8);
        u32x4 v[PER / 8]; float mx = 0.f;
#pragma unroll
        for (int j = 0; j < PER / 8; ++j) { v[j] = s[j];
#pragma unroll
            for (int e = 0; e < 4; ++e) mx = fmaxf(mx, fmaxf(fabsf(bf_lo(v[j][e])), fabsf(bf_hi(v[j][e])))); }
        mx = fmaxf(wave_max(mx), 1e-30f);
        const float inv = 448.0f / mx;
        if (lane == 0) scale[n] = mx * (1.0f / 448.0f);
        u32x2* d = (u32x2*)(dst + (size_t)n * LEN) + lane * (PER / 8);
#pragma unroll
        for (int j = 0; j < PER / 8; ++j) { int p0 = 0, p1 = 0;
            p0 = __builtin_amdgcn_cvt_pk_fp8_f32(bf_lo(v[j].x) * inv, bf_hi(v[j].x) * inv, p0, false); p0 = __builtin_amdgcn_cvt_pk_fp8_f32(bf_lo(v[j].y) * inv, bf_hi(v[j].y) * inv, p0, true);
            p1 = __builtin_amdgcn_cvt_pk_fp8_f32(bf_lo(v[j].z) * inv, bf_hi(v[j].z) * inv, p1, false); p1 = __builtin_amdgcn_cvt_pk_fp8_f32(bf_lo(v[j].w) * inv, bf_hi(v[j].w) * inv, p1, true);
            d[j] = (u32x2){(unsigned)p0, (unsigned)p1}; }
    }
}
__device__ __forceinline__ void p1_quant_weights(const Frame& F) {
    rowquant_fp8(F, F.ws + WS_WIN + (size_t)1280 * DM * 2, (size_t)DM * 2, F.ws + WS_WG8, (size_t)DM, (float*)(F.ws + WS_SW), 12800);
    rowquant_fp8(F, F.ws + WS_H1F, (size_t)DM * 2, F.ws + WS_WBR, (size_t)DM, (float*)(F.ws + WS_SWBR), 4096);
    rowquant_fp8(F, F.ws + WS_WOUT, (size_t)DM * 2, F.ws + WS_WOUT, (size_t)DM * 2, (float*)(F.ws + WS_SWOUT), 4096);
    rowquant_fp8_n<1024>(F, F.ws + WS_WUQ, F.ws + WS_WUQ8, (float*)(F.ws + WS_SWUQ), 3072);
    rowquant_fp8_n<512>(F, F.ws + WS_WUKV, F.ws + WS_WUKV8, (float*)(F.ws + WS_SWUKV), 4096);
}
#define MFMA32(a, b, c) __builtin_amdgcn_mfma_f32_32x32x16_bf16((a), (b), (c), 0, 0, 0)
__device__ __forceinline__ float relu_i(float x) { const int v = __float_as_int(x); return __int_as_float(v > 0 ? v : 0); }
__device__ __forceinline__ int crow(int i, int h) { return (i & 3) + 8 * (i >> 2) + 4 * h; }
__device__ __forceinline__ float half_sum_f(float v) {
#pragma unroll
    for (int o = 1; o < 32; o <<= 1) v += __shfl_xor(v, o);
    return v;
}
__device__ __forceinline__ int half_sum_i(int v) {
#pragma unroll
    for (int o = 1; o < 32; o <<= 1) v += __shfl_xor(v, o);
    return v;
}
__device__ __forceinline__ float half_max_f(float v) {
#pragma unroll
    for (int o = 1; o < 32; o <<= 1) v = fmaxf(v, __shfl_xor(v, o));
    return v;
}
__device__ __forceinline__ float half_min_f(float v) {
#pragma unroll
    for (int o = 1; o < 32; o <<= 1) v = fminf(v, __shfl_xor(v, o));
    return v;
}
constexpr int IDX_PK = 144, IDX_BUF = 64 * IDX_PK;
__device__ __forceinline__ void idx_task(const Frame& F, int b, int s0c) {
    const int lane = F.lane, r = lane & 31, h = lane >> 5, tid = F.tid;
    const int s0 = s0c + 2 * F.wave;
    LAS unsigned char* lds = F.lds;
    const bf16_t* qix = (const bf16_t*)(F.ws + WS_QIX); const bf16_t* kix = (const bf16_t*)(F.ws + WS_KIX); const float* wix = (const float*)(F.ws + WS_WIX);
    unsigned* mask = (unsigned*)(F.ws + WS_MASK);
    const int tok = (r >> 2) & 1, head = (r & 3) + 4 * (r >> 3);
    const bf16_t* qp = qix + (size_t)(b * SEQ + s0 + tok) * 1024 + head * 64 + 8 * h;
    bf16x8 af[4];
#pragma unroll
    for (int ks = 0; ks < 4; ++ks) af[ks] = *(const bf16x8*)(qp + 16 * ks);
    const f32x4* wp = (const f32x4*)(wix + (size_t)(b * SEQ + s0 + h) * 16);
    float w[16];
#pragma unroll
    for (int q = 0; q < 4; ++q) { const f32x4 x = wp[q]; w[4 * q] = x[0]; w[4 * q + 1] = x[1]; w[4 * q + 2] = x[2]; w[4 * q + 3] = x[3]; }
    const int tq = NMETA + s0 + h;
    int tqr = tq - r; asm volatile("" : "+v"(tqr));
    const int ngrp = ((NMETA + s0c + 15) >> 6) + 1;
    const int skey = tid >> 3, spc = tid & 7;
    int brow = b * SEQ - NMETA; asm volatile("" : "+s"(brow));
    const bf16_t* kcur = kix + ((long)brow + skey) * 64 + spc * 8;
    const int sdst = skey * IDX_PK + spc * 16;
    const int boff = r * IDX_PK + 16 * h;
    u32x4 kst = *(const u32x4*)(skey < NMETA ? kix + (size_t)(NTOK + skey) * 64 + spc * 8 : kcur);
    float row[MW];
#pragma unroll
    for (int g = 0; g < MW / 2; ++g) {
        float s0v = -INFINITY, s1v = -INFINITY;
        const int bo = (g & 1) * IDX_BUF;
        if (g < ngrp) *(LAS u32x4*)(lds + bo + sdst) = kst;
        __syncthreads();
        kcur += 64 * 64; asm volatile("" : "+v"(kcur));
        if (g + 1 < ngrp) kst = *(const u32x4*)kcur;
        if (g < ngrp) {
            float x0 = 0.f, x1 = 0.f;
            { bf16x8 bb[4]; f32x16 a0;
#pragma unroll
              for (int ks = 0; ks < 4; ++ks) bb[ks] = *(const LAS bf16x8*)(lds + bo + boff + 32 * ks);
#pragma unroll
              for (int i = 0; i < 16; ++i) a0[i] = 0.f;
#pragma unroll
              for (int ks = 0; ks < 4; ++ks) a0 = MFMA32(af[ks], bb[ks], a0);
#pragma unroll
              for (int i = 0; i < 16; ++i) x0 += w[i] * relu_i(a0[i]); }
            asm volatile("" : "+v"(x0));
            asm volatile("" ::: "memory");
            { bf16x8 bb[4]; f32x16 a1;
#pragma unroll
              for (int ks = 0; ks < 4; ++ks) bb[ks] = *(const LAS bf16x8*)(lds + bo + boff + 32 * IDX_PK + 32 * ks);
#pragma unroll
              for (int i = 0; i < 16; ++i) a1[i] = 0.f;
#pragma unroll
              for (int ks = 0; ks < 4; ++ks) a1 = MFMA32(af[ks], bb[ks], a1);
#pragma unroll
              for (int i = 0; i < 16; ++i) x1 += w[i] * relu_i(a1[i]); }
            s0v = (g * 64 <= tqr) ? x0 : -INFINITY; s1v = (g * 64 + 32 <= tqr) ? x1 : -INFINITY;
        }
        row[2 * g] = s0v; row[2 * g + 1] = s1v;
    }
    float tau = -3.0e38f;
    bool done = (tq + 1 <= 256);
    float mx = -INFINITY, mn = INFINITY;
#pragma unroll
    for (int k = 0; k < MW; ++k) { const float v = row[k]; mx = fmaxf(mx, v); mn = fminf(mn, v > -INFINITY ? v : INFINITY); }
    float lo = half_min_f(mn), hi = half_max_f(mx);
    if (!done) tau = hi;
    for (int it = 0; it < 64; ++it) {
        if (!__any(!done)) break;
        const float mid = lo + (hi - lo) * 0.5f;
        int c = 0;
#pragma unroll
        for (int k = 0; k < MW; ++k) c += (row[k] >= mid) ? 1 : 0;
        c = half_sum_i(c);
        if (!done) {
            if (!(mid > lo && mid < hi)) { tau = hi; done = true; }
            else if (c == 256) { tau = mid; done = true; }
            else if (c > 256) lo = mid;
            else { hi = mid; tau = hi; }
        }
    }
    unsigned* mrow = mask + (size_t)(b * SEQ + s0 + h) * MW;
    unsigned mw = 0u;
#pragma unroll
    for (int k = 0; k < MW; ++k) {
        const unsigned long long bal = __ballot(row[k] >= tau);
        const unsigned wd = h ? (unsigned)(bal >> 32) : (unsigned)bal;
        if ((k & 31) == r) mw = wd;
        if ((k & 31) == 31 || k == MW - 1) { const int kk = (k & ~31) + r; if (kk < MW) mrow[kk] = mw; }
    }
}
__device__ __forceinline__ void p2_indexer(const Frame& F, int qslot) {
    volatile LAS unsigned* qw = (volatile LAS unsigned*)(F.lds + LDSCTL_OFF + 16);
    constexpr int NCH = NTOK / 16;
    for (;;) {
        if (F.tid == 0) qw[0] = atomicAdd(F.ctl + CW_QUEUE + 64 * qslot, 1u);
        __syncthreads();
        const int c = __builtin_amdgcn_readfirstlane((int)qw[0]);
        __syncthreads();
        if (c >= NCH) break;
        const int b = c & 3, tblk = (SEQ / 16 - 1) - (c >> 2);
        idx_task(F, b, tblk * 16);
    }
}
template <bool MLA> struct AttnCfg {
    static constexpr int DQK = MLA ? 192 : 128, NKS = DQK / 64, PK = DQK + 16  , PV = 144  , KBYTES = 64 * PK, BUFB = 64 * PK + 64 * PV;
};
struct AttnUnit { int type, b, hx, blk; };
typedef int i32x8 __attribute__((ext_vector_type(8)));
typedef int i32x4 __attribute__((ext_vector_type(4)));
typedef int i32x2_t __attribute__((ext_vector_type(2)));
__device__ __forceinline__ i32x8 cat4(i32x4 a, i32x4 b) { return __builtin_shufflevector(a, b, 0, 1, 2, 3, 4, 5, 6, 7); }
template <int NKS> __device__ __forceinline__ void qk_block(f32x16& s, const i32x8 (&k)[NKS], const i32x8 (&q)[NKS]) {
#if defined(__HIP_DEVICE_COMPILE__)
    int sc = 0x7F7F7F7F;
    if constexpr (NKS == 3)
        asm volatile("s_nop 1\n\tv_mfma_scale_f32_32x32x64_f8f6f4 %0, %1, %4, 0, %7, %7 op_sel_hi:[0,0,0]\n\ts_nop 3\n\tv_mfma_scale_f32_32x32x64_f8f6f4 %0, %2, %5, %0, %7, %7 op_sel_hi:[0,0,0]\n\ts_nop 3\n\t"
                     "v_mfma_scale_f32_32x32x64_f8f6f4 %0, %3, %6, %0, %7, %7 op_sel_hi:[0,0,0]\n\ts_nop 15\n\ts_nop 7"
                     : "=&v"(s) : "v"(k[0]), "v"(k[1]), "v"(k[2]), "v"(q[0]), "v"(q[1]), "v"(q[2]), "v"(sc));
    else
        asm volatile("s_nop 1\n\tv_mfma_scale_f32_32x32x64_f8f6f4 %0, %1, %3, 0, %5, %5 op_sel_hi:[0,0,0]\n\ts_nop 3\n\tv_mfma_scale_f32_32x32x64_f8f6f4 %0, %2, %4, %0, %5, %5 op_sel_hi:[0,0,0]\n\ts_nop 15\n\ts_nop 7"
                     : "=&v"(s) : "v"(k[0]), "v"(k[1]), "v"(q[0]), "v"(q[1]), "v"(sc));
#else
    (void)s; (void)k; (void)q;
#endif
}

__device__ __forceinline__ void pv_block(f32x16& o0, f32x16& o1, f32x16& o2, f32x16& o3, const i32x8 v0, const i32x8 v1, const i32x8 v2, const i32x8 v3, const i32x8 p) {
#if defined(__HIP_DEVICE_COMPILE__)
    int sc = 0x7F7F7F7F;
    asm volatile("s_nop 1\n\tv_mfma_scale_f32_32x32x64_f8f6f4 %0, %4, %8, %0, %9, %9 op_sel_hi:[0,0,0]\n\tv_mfma_scale_f32_32x32x64_f8f6f4 %1, %5, %8, %1, %9, %9 op_sel_hi:[0,0,0]\n\t"
                 "v_mfma_scale_f32_32x32x64_f8f6f4 %2, %6, %8, %2, %9, %9 op_sel_hi:[0,0,0]\n\tv_mfma_scale_f32_32x32x64_f8f6f4 %3, %7, %8, %3, %9, %9 op_sel_hi:[0,0,0]\n\ts_nop 15\n\ts_nop 7"
                 : "+v"(o0), "+v"(o1), "+v"(o2), "+v"(o3) : "v"(v0), "v"(v1), "v"(v2), "v"(v3), "v"(p), "v"(sc));
#else
    (void)o0; (void)o1; (void)o2; (void)o3; (void)v0; (void)v1; (void)v2; (void)v3; (void)p;
#endif
}
__device__ __forceinline__ int pk4_fp8(float a, float b, float c, float d) { int p = 0; p = __builtin_amdgcn_cvt_pk_fp8_f32(a, b, p, false); return __builtin_amdgcn_cvt_pk_fp8_f32(c, d, p, true); }

template <bool MLA>
__device__ __forceinline__ void attn_unit(const Frame& F, const AttnUnit u) {
    typedef AttnCfg<MLA> C;
    const int tid = F.tid, lane = F.lane, wave = F.wave, r = lane & 31, h = lane >> 5;
    LAS unsigned char* lds = F.lds;
    const unsigned char* qn8 = F.ws + WS_QN; const unsigned char* qr8 = F.ws + WS_QR; const unsigned char* kn8 = F.ws + WS_KN; const unsigned char* kpe8 = F.ws + WS_KPE;
    const unsigned char* qb8 = F.ws + WS_QB; const unsigned char* kb8 = F.ws + WS_KB;
    const unsigned char* va8 = F.ws + WS_VA; const unsigned char* vb8 = F.ws + WS_VB;
    const unsigned* mask = (const unsigned*)(F.ws + WS_MASK);
    const int b = u.b;
    const size_t rowb = (size_t)b * SEQ;
    int head, tw0, ntiles;
    if (MLA) { head = u.hx; tw0 = u.blk * 256 + 32 * wave; ntiles = (NMETA + u.blk * 256 + 255) / 64 + 1; }
    else { head = 4 * u.hx + (wave & 3); tw0 = u.blk * 64 + 32 * (wave >> 2); ntiles = (NMETA + u.blk * 64 + 63) / 64 + 1; }
    const int pw0 = NMETA + tw0;
    const int tq = pw0 + r;
    const float cexp = MLA ? QA_SCALE : QB_SCALE;
    i32x8 qf[C::NKS];
    if (MLA) {
        const unsigned char* p0 = qn8 + (rowb + tw0 + r) * 2048 + head * 128 + 32 * h; const unsigned char* p1 = qr8 + (rowb + tw0 + r) * 1024 + head * 64 + 32 * h;
        qf[0] = cat4(*(const i32x4*)p0, *(const i32x4*)(p0 + 16)); qf[1] = cat4(*(const i32x4*)(p0 + 64), *(const i32x4*)(p0 + 80)); qf[C::NKS - 1] = cat4(*(const i32x4*)p1, *(const i32x4*)(p1 + 16));
    } else {
        const unsigned char* p0 = qb8 + (rowb + tw0 + r) * 2048 + head * 128 + 32 * h;
        qf[0] = cat4(*(const i32x4*)p0, *(const i32x4*)(p0 + 16)); qf[1] = cat4(*(const i32x4*)(p0 + 64), *(const i32x4*)(p0 + 80));
    }
    const int ldk = MLA ? 2048 : 512;
    const unsigned char* ktab = MLA ? kn8 + head * 128 : kb8 + u.hx * 128;
    const unsigned char* vtab = MLA ? va8 + head * 128 : vb8 + u.hx * 128;
    const unsigned char* kbase = ktab + (rowb - NMETA) * ldk;
    const unsigned char* vbase = vtab + (rowb - NMETA) * ldk;
    const unsigned char* pbase = kpe8 + (rowb - NMETA) * 64;
    const int kkey = tid >> 3, kpc = tid & 7, pkey = tid >> 2, ppc = tid & 3;
    const unsigned koffs = (unsigned)(kkey * ldk + kpc * 16); const int kdst = kkey * C::PK + kpc * 16;
    const unsigned poffs = (unsigned)(pkey * 64 + ppc * 16); const int pdst = pkey * C::PK + 128 + ppc * 16;
    const int vdst = C::KBYTES + kkey * C::PV + kpc * 16;
    u32x4 kst, vst, pst = (u32x4){0u, 0u, 0u, 0u};
    {
        kst = *(const u32x4*)(kkey < NMETA ? ktab + (size_t)(NTOK + kkey) * ldk + kpc * 16 : kbase + koffs);
        vst = *(const u32x4*)(kkey < NMETA ? vtab + (size_t)(NTOK + kkey) * ldk + kpc * 16 : vbase + koffs);
        if (MLA && tid < 256) pst = *(const u32x4*)(pkey < NMETA ? kpe8 + (size_t)(NTOK + pkey) * 64 + ppc * 16 : pbase + poffs);
    }
    *(LAS u32x4*)(lds + kdst) = kst;
    *(LAS u32x4*)(lds + vdst) = vst;
    if (MLA && tid < 256) *(LAS u32x4*)(lds + pdst) = pst;
    __syncthreads();
    f32x16 oacc[4];
#pragma unroll
    for (int d = 0; d < 4; ++d)
#pragma unroll
        for (int i = 0; i < 16; ++i) oacc[d][i] = 0.f;
    float mrun = -INFINITY, lrun = 0.f;
    const int koff = r * C::PK + 32 * h;
    const int vq = (lane & 15) >> 1;
    const int voff = C::KBYTES + (4 * h + (vq & 3) + 8 * (vq >> 2)) * C::PV + 16 * ((lane >> 4) & 1) + 8 * (lane & 1);
    const unsigned* mrow = mask + (rowb + tw0 + r) * MW;
    if (ntiles > 1) {
        kst = *(const u32x4*)(kbase + (size_t)64 * ldk + koffs);
        vst = *(const u32x4*)(vbase + (size_t)64 * ldk + koffs);
        if (MLA && tid < 256) pst = *(const u32x4*)(pbase + (size_t)64 * 64 + poffs);
    }
    for (int kt = 0; kt < ntiles; ++kt) {
        const int cur = (kt & 1) * C::BUFB, nxt = ((kt + 1) & 1) * C::BUFB;
        if (kt + 1 < ntiles) {
            *(LAS u32x4*)(lds + nxt + kdst) = kst;
            *(LAS u32x4*)(lds + nxt + vdst) = vst;
            if (MLA && tid < 256) *(LAS u32x4*)(lds + nxt + pdst) = pst;
        }
        if (kt + 2 < ntiles) {
            kst = *(const u32x4*)(kbase + (size_t)(kt + 2) * 64 * ldk + koffs);
            vst = *(const u32x4*)(vbase + (size_t)(kt + 2) * 64 * ldk + koffs);
            if (MLA && tid < 256) pst = *(const u32x4*)(pbase + (size_t)(kt + 2) * 64 * 64 + poffs);
        }
        if (kt * 64 <= pw0 + 31) {
            u32x2 mwd = (u32x2){0u, 0u};
            if (!MLA) mwd = *(const u32x2*)(mrow + 2 * kt);
            f32x16 s0, s1;
            if (!MLA) {
                i32x8 kf0[C::NKS], kf1[C::NKS];
#pragma unroll
                for (int ks = 0; ks < C::NKS; ++ks) { kf0[ks] = cat4(*(const LAS i32x4*)(lds + cur + koff + 64 * ks), *(const LAS i32x4*)(lds + cur + koff + 64 * ks + 16));
                    kf1[ks] = cat4(*(const LAS i32x4*)(lds + cur + koff + 32 * C::PK + 64 * ks), *(const LAS i32x4*)(lds + cur + koff + 32 * C::PK + 64 * ks + 16)); }
                qk_block<C::NKS>(s0, kf0, qf);
                qk_block<C::NKS>(s1, kf1, qf);
            } else {
                { i32x8 kf[C::NKS];
#pragma unroll
                  for (int ks = 0; ks < C::NKS; ++ks) kf[ks] = cat4(*(const LAS i32x4*)(lds + cur + koff + 64 * ks), *(const LAS i32x4*)(lds + cur + koff + 64 * ks + 16));
                  qk_block<C::NKS>(s0, kf, qf); }
                { i32x8 kf[C::NKS];
#pragma unroll
                  for (int ks = 0; ks < C::NKS; ++ks) kf[ks] = cat4(*(const LAS i32x4*)(lds + cur + koff + 32 * C::PK + 64 * ks), *(const LAS i32x4*)(lds + cur + koff + 32 * C::PK + 64 * ks + 16));
                  qk_block<C::NKS>(s1, kf, qf); }
            }
            if (MLA) {
                if (kt * 64 + 63 > pw0) {
                    const int kb0 = kt * 64 + 4 * h;
#pragma unroll
                    for (int i = 0; i < 16; ++i) { const int key = kb0 + (i & 3) + 8 * (i >> 2); if (key > tq) s0[i] = -INFINITY; if (key + 32 > tq) s1[i] = -INFINITY; }
                }
            } else {
                const unsigned m0 = mwd.x >> (4 * h), m1 = mwd.y >> (4 * h);
#pragma unroll
                for (int i = 0; i < 16; ++i) { const int bit = (i & 3) + 8 * (i >> 2);
                    const unsigned k0 = (unsigned)__builtin_amdgcn_sbfe((int)m0, bit, 1), k1 = (unsigned)__builtin_amdgcn_sbfe((int)m1, bit, 1);
                    s0[i] = __uint_as_float((__float_as_uint(s0[i]) & k0) | (0xFF800000u & ~k0)); s1[i] = __uint_as_float((__float_as_uint(s1[i]) & k1) | (0xFF800000u & ~k1)); }
            }
            float mx = s0[0];
#pragma unroll
            for (int i = 1; i < 16; ++i) mx = fmaxf(mx, s0[i]);
#pragma unroll
            for (int i = 0; i < 16; ++i) mx = fmaxf(mx, s1[i]);
            mx = fmaxf(mx, __shfl_xor(mx, 32));
            const float mcand = mx * cexp;
            const bool move = !__all(mcand - mrun <= 8.0f);
            const float mnew = move ? fmaxf(mrun, mcand) : mrun;
            const float msafe = (mnew == -INFINITY) ? 0.f : mnew;
            const float alpha = move ? __builtin_amdgcn_exp2f(mrun - msafe) : 1.0f;
            mrun = mnew;
            float ps = 0.f;
#pragma unroll
            for (int i = 0; i < 16; ++i) { s0[i] = __builtin_amdgcn_exp2f(__builtin_fmaf(s0[i], cexp, -msafe)); s1[i] = __builtin_amdgcn_exp2f(__builtin_fmaf(s1[i], cexp, -msafe)); ps += s0[i] + s1[i]; }
            lrun = lrun * alpha + ps;
            if (move) {
#pragma unroll
                for (int d = 0; d < 4; ++d)
#pragma unroll
                    for (int i = 0; i < 16; ++i) oacc[d][i] *= alpha;
            }
            i32x8 vf[4];
#pragma unroll
            for (int d = 0; d < 4; ++d) {
                const i32x2_t t0 = __builtin_amdgcn_ds_read_tr8_b64_v2i32((LAS i32x2_t*)(lds + cur + voff + 32 * d));
                const i32x2_t t1 = __builtin_amdgcn_ds_read_tr8_b64_v2i32((LAS i32x2_t*)(lds + cur + voff + 16 * C::PV + 32 * d));
                const i32x2_t t2 = __builtin_amdgcn_ds_read_tr8_b64_v2i32((LAS i32x2_t*)(lds + cur + voff + 32 * C::PV + 32 * d));
                const i32x2_t t3 = __builtin_amdgcn_ds_read_tr8_b64_v2i32((LAS i32x2_t*)(lds + cur + voff + 48 * C::PV + 32 * d));
                vf[d] = (i32x8){t0.x, t0.y, t1.x, t1.y, t2.x, t2.y, t3.x, t3.y}; }
            i32x8 pf;
            pf[0] = pk4_fp8(s0[0], s0[1], s0[2], s0[3]); pf[1] = pk4_fp8(s0[4], s0[5], s0[6], s0[7]); pf[2] = pk4_fp8(s0[8], s0[9], s0[10], s0[11]); pf[3] = pk4_fp8(s0[12], s0[13], s0[14], s0[15]);
            pf[4] = pk4_fp8(s1[0], s1[1], s1[2], s1[3]); pf[5] = pk4_fp8(s1[4], s1[5], s1[6], s1[7]); pf[6] = pk4_fp8(s1[8], s1[9], s1[10], s1[11]); pf[7] = pk4_fp8(s1[12], s1[13], s1[14], s1[15]);
            pv_block(oacc[0], oacc[1], oacc[2], oacc[3], vf[0], vf[1], vf[2], vf[3], pf);
        }
        __syncthreads();
    }
    {
        const float lt = lrun + __shfl_xor(lrun, 32);
        const float vmax = fmaxf(__uint_as_float(F.ctl[CW_VMAX + (MLA ? 64 : 0)]), 1e-30f);
        const float inv = (lt > 0.f ? 1.0f / lt : 0.f) * (440.0f / vmax);
        unsigned char* op = F.ws + WS_OAB + (rowb + tw0 + r) * 4096 + (MLA ? 0 : 2048) + head * 128 + 4 * h;
#pragma unroll
        for (int d = 0; d < 4; ++d)
#pragma unroll
            for (int g = 0; g < 4; ++g) { int p = 0;
                p = __builtin_amdgcn_cvt_pk_fp8_f32(fminf(fmaxf(oacc[d][4 * g] * inv, -448.f), 448.f), fminf(fmaxf(oacc[d][4 * g + 1] * inv, -448.f), 448.f), p, false);
                p = __builtin_amdgcn_cvt_pk_fp8_f32(fminf(fmaxf(oacc[d][4 * g + 2] * inv, -448.f), 448.f), fminf(fmaxf(oacc[d][4 * g + 3] * inv, -448.f), 448.f), p, true);
                *(unsigned*)(op + 32 * d + 8 * g) = (unsigned)p; }
    }
}

constexpr int ATT_NUNITS = 16 * 64 + 64 * 16;
__device__ __forceinline__ void att_decode(int idx, AttnUnit& u) {
    int rem = idx;
    for (int L = 65; L >= 2; --L) {
        const int nm = (L >= 5 && ((L - 5) & 3) == 0) ? 64 : 0;
        if (rem < nm) { u.type = 0; u.blk = (L - 5) >> 2; u.b = rem & 3; u.hx = rem >> 2; return; }
        rem -= nm;
        if (rem < 16) { u.type = 1; u.blk = L - 2; u.b = rem & 3; u.hx = rem >> 2; return; }
        rem -= 16;
    }
    u.type = -1; u.blk = 0; u.b = 0; u.hx = 0;
}
__device__ __forceinline__ void p3_attention(const Frame& F, int qslot) {
    volatile LAS int* qw = (volatile LAS int*)(F.lds + LDSCTL_OFF + 32);
    for (;;) {
        if (F.tid == 0) { const int idx = (int)atomicAdd(F.ctl + CW_QUEUE + 64 * qslot, 1u); AttnUnit u; u.type = -1; u.b = 0; u.hx = 0; u.blk = 0; if (idx < ATT_NUNITS) att_decode(idx, u);
            qw[0] = u.type; qw[1] = u.b; qw[2] = u.hx; qw[3] = u.blk; }
        __syncthreads();
        AttnUnit u; u.type = qw[0]; u.b = qw[1]; u.hx = qw[2]; u.blk = qw[3];
        __syncthreads();
        if (u.type < 0) break;
        if (u.type == 0) attn_unit<true>(F, u); else attn_unit<false>(F, u);
    }
}
__device__ __forceinline__ float pk_idx(float v, int n) { return __uint_as_float((__float_as_uint(v) & ~127u) | (unsigned)n); }
__device__ __forceinline__ void route_task(const Frame& F, int tb, int hd) {
    const int lane = F.lane, r = lane & 31, h = lane >> 5;
    const bf16_t* pq = (const bf16_t*)(F.ws + WS_PQ); const bf16_t* skb = (const bf16_t*)(F.ws + WS_SK);
    int* eid = (int*)(F.ws + WS_EID); float* gate = (float*)(F.ws + WS_GATE);
    LAS float* wl = (LAS float*)(F.lds + F.wave * 16384);
    const int m = tb * 32 + r;
#pragma unroll 1
    for (int c = 0; c < 2; ++c) {
        const bf16_t* qp = pq + (size_t)m * 2048 + hd * 256 + c * 128 + 8 * h;
        bf16x8 qf[8];
#pragma unroll
        for (int ks = 0; ks < 8; ++ks) qf[ks] = *(const bf16x8*)(qp + 16 * ks);
        float v[64];
#pragma unroll
        for (int blk = 0; blk < 4; ++blk) {
            const bf16_t* sp = skb + (size_t)((hd * 2 + c) * 128 + 32 * blk + r) * 128 + 8 * h;
            f32x16 acc;
#pragma unroll
            for (int i = 0; i < 16; ++i) acc[i] = 0.f;
#pragma unroll
            for (int ks = 0; ks < 8; ++ks) acc = MFMA32(*(const bf16x8*)(sp + 16 * ks), qf[ks], acc);
#pragma unroll
            for (int i = 0; i < 16; ++i) v[blk * 16 + i] = pk_idx(acc[i], 32 * blk + (i & 3) + 8 * (i >> 2) + 4 * h);
        }
#pragma unroll 1
        for (int k = 0; k < 16; ++k) {
            float mx = v[0];
#pragma unroll
            for (int j = 1; j < 64; ++j) mx = fmaxf(mx, v[j]);
            mx = fmaxf(mx, __shfl_xor(mx, 32));
            if (h == 0) wl[(c * 16 + k) * 32 + r] = mx;
#pragma unroll
            for (int j = 0; j < 64; ++j) v[j] = (v[j] == mx) ? -INFINITY : v[j];
        }
    }
    LDS_WAIT(); asm volatile("" ::: "memory");
    float cs[50]; int ce[50];
    {
        unsigned t0[16], t1[16];
#pragma unroll
        for (int i = 0; i < 16; ++i) { t0[i] = __float_as_uint(wl[i * 32 + r]); t1[i] = __float_as_uint(wl[(16 + i) * 32 + r]); }
        int n = 0;
#pragma unroll
        for (int i = 0; i < 16; ++i)
#pragma unroll
            for (int j = 0; j < 16; ++j)
                if ((i + 1) * (j + 1) <= 16) {
                    const float s = __uint_as_float(t0[i] & ~127u) + __uint_as_float(t1[j] & ~127u);
                    cs[n] = __uint_as_float((__float_as_uint(s) & ~63u) | (unsigned)n); ce[n] = (int)((t0[i] & 127u) * 128u + (t1[j] & 127u)); ++n;
                }
    }
    float sum = 0.f, first = 0.f;
#pragma unroll 1
    for (int k = 0; k < 16; ++k) {
        float mx = cs[0];
#pragma unroll
        for (int j = 1; j < 50; ++j) mx = fmaxf(mx, cs[j]);
        int se = 0;
#pragma unroll
        for (int j = 0; j < 50; ++j) { const bool hit = (cs[j] == mx); se = hit ? ce[j] : se; cs[j] = hit ? -INFINITY : cs[j]; }
        if (k == 0) first = mx;
        const float ev = __expf(mx - first); sum += ev;
        if (h == 0) { wl[1024 + k * 32 + r] = ev; wl[1536 + k * 32 + r] = __int_as_float(se); }
    }
    LDS_WAIT(); asm volatile("" ::: "memory");
    const float inv = 1.0f / sum;
    if (h == 0) {
        int* ep = eid + (size_t)m * 128 + hd * 16; float* gp = gate + (size_t)m * 128 + hd * 16;
#pragma unroll
        for (int q = 0; q < 4; ++q) {
            *(int4*)(ep + 4 * q) = make_int4(__float_as_int(wl[1536 + (4 * q) * 32 + r]), __float_as_int(wl[1536 + (4 * q + 1) * 32 + r]), __float_as_int(wl[1536 + (4 * q + 2) * 32 + r]), __float_as_int(wl[1536 + (4 * q + 3) * 32 + r]));
            *(f32x4*)(gp + 4 * q) = (f32x4){wl[1024 + (4 * q) * 32 + r] * inv, wl[1024 + (4 * q + 1) * 32 + r] * inv, wl[1024 + (4 * q + 2) * 32 + r] * inv, wl[1024 + (4 * q + 3) * 32 + r] * inv}; }
    }
    LDS_WAIT(); asm volatile("" ::: "memory");
}
__device__ __forceinline__ void p7_routing(const Frame& F) {
    const int gw = F.vcu * NWAVES + F.wave, NGW = F.G * NWAVES;
    for (int it = gw; it < (NTOK / 32) * 8; it += NGW) route_task(F, it >> 3, it & 7);
}

__device__ __forceinline__ float rl_f(float v, int l) { return __int_as_float(__builtin_amdgcn_readlane(__float_as_int(v), l)); }
__device__ __forceinline__ float gelu_tanh(float x) {
    const float u = 0.7978845608028654f * (x + 0.044715f * x * x * x);
    const float e = __expf(2.0f * u);
    const float th = 1.0f - 2.0f / (e + 1.0f);
    return 0.5f * x * (1.0f + th);
}
__device__ __forceinline__ float wave_sum_dpp(float v) {
#define DPP_ADD(ctrl, rmask) v += __int_as_float(__builtin_amdgcn_update_dpp(0, __float_as_int(v), ctrl, rmask, 0xF, false))
    DPP_ADD(0xB1, 0xF); DPP_ADD(0x4E, 0xF); DPP_ADD(0x141, 0xF); DPP_ADD(0x140, 0xF); DPP_ADD(0x142, 0xA); DPP_ADD(0x143, 0xC);
#undef DPP_ADD
    return rl_f(v, 63);
}
typedef unsigned u32x6 __attribute__((ext_vector_type(6)));
typedef float f32x32 __attribute__((ext_vector_type(32)));
struct Row6 { u32x4 q[3]; };
__device__ __forceinline__ void row6_load(Row6& r, const unsigned char* tab, int e, int lane) {
    const u32x4* p = (const u32x4*)(tab + (size_t)e * 3072) + lane;
#pragma unroll
    for (int q = 0; q < 3; ++q) r.q[q] = p[64 * q];
}
__device__ __forceinline__ f32x32 row6_deq(const Row6& r, int g) {
    u32x6 w;
    if (g == 0) { w[0] = r.q[0].x; w[1] = r.q[0].y; w[2] = r.q[0].z; w[3] = r.q[0].w; w[4] = r.q[1].x; w[5] = r.q[1].y; }
    else { w[0] = r.q[1].z; w[1] = r.q[1].w; w[2] = r.q[2].x; w[3] = r.q[2].y; w[4] = r.q[2].z; w[5] = r.q[2].w; }
    return __builtin_amdgcn_cvt_scalef32_pk32_f32_fp6(w, 1.0f);
}
__device__ __forceinline__ float row6_dot(const Row6& r, const f32x2 (&hf)[32]) {
    f32x2 acc0 = (f32x2){0.f, 0.f}, acc1 = (f32x2){0.f, 0.f};
#pragma unroll
    for (int g = 0; g < 2; ++g) { const f32x32 d = row6_deq(r, g);
#pragma unroll
        for (int k = 0; k < 16; k += 2) { acc0 = __builtin_elementwise_fma((f32x2){d[2 * k], d[2 * k + 1]}, hf[16 * g + k], acc0); acc1 = __builtin_elementwise_fma((f32x2){d[2 * k + 2], d[2 * k + 3]}, hf[16 * g + k + 1], acc1); } }
    const f32x2 s = acc0 + acc1;
    return s.x + s.y;
}
__device__ __forceinline__ void row6_axpy(const Row6& r, float c, f32x2 (&o)[32]) {
    const f32x2 c2 = (f32x2){c, c};
#pragma unroll
    for (int g = 0; g < 2; ++g) { const f32x32 d = row6_deq(r, g);
#pragma unroll
        for (int k = 0; k < 16; ++k) o[16 * g + k] = __builtin_elementwise_fma((f32x2){d[2 * k], d[2 * k + 1]}, c2, o[16 * g + k]); }
}
struct Row4 { u32x4 q[2]; };
__device__ __forceinline__ void row4_load(Row4& r, const unsigned char* tab, int e, int lane) {
    const u32x4* p = (const u32x4*)(tab + (size_t)e * 2048) + lane;
    r.q[0] = p[0]; r.q[1] = p[64];
}
__device__ __forceinline__ float row4_dot(const Row4& r, const f32x2 (&hf)[32]) {
    f32x2 acc0 = (f32x2){0.f, 0.f}, acc1 = (f32x2){0.f, 0.f};
#pragma unroll
    for (int d = 0; d < 8; ++d) { const unsigned w = r.q[d >> 2][d & 3];
        acc0 = __builtin_elementwise_fma(__builtin_amdgcn_cvt_scalef32_pk_f32_fp4(w, 1.0f, 0), hf[4 * d], acc0);
        acc1 = __builtin_elementwise_fma(__builtin_amdgcn_cvt_scalef32_pk_f32_fp4(w, 1.0f, 1), hf[4 * d + 1], acc1);
        acc0 = __builtin_elementwise_fma(__builtin_amdgcn_cvt_scalef32_pk_f32_fp4(w, 1.0f, 2), hf[4 * d + 2], acc0);
        acc1 = __builtin_elementwise_fma(__builtin_amdgcn_cvt_scalef32_pk_f32_fp4(w, 1.0f, 3), hf[4 * d + 3], acc1); }
    const f32x2 s = acc0 + acc1;
    return s.x + s.y;
}
__device__ __forceinline__ void row4_axpy(const Row4& r, float c, f32x2 (&o)[32]) {
    const f32x2 c2 = (f32x2){c, c};
#pragma unroll
    for (int d = 0; d < 8; ++d) { const unsigned w = r.q[d >> 2][d & 3];
        o[4 * d] = __builtin_elementwise_fma(__builtin_amdgcn_cvt_scalef32_pk_f32_fp4(w, 1.0f, 0), c2, o[4 * d]);
        o[4 * d + 1] = __builtin_elementwise_fma(__builtin_amdgcn_cvt_scalef32_pk_f32_fp4(w, 1.0f, 1), c2, o[4 * d + 1]);
        o[4 * d + 2] = __builtin_elementwise_fma(__builtin_amdgcn_cvt_scalef32_pk_f32_fp4(w, 1.0f, 2), c2, o[4 * d + 2]);
        o[4 * d + 3] = __builtin_elementwise_fma(__builtin_amdgcn_cvt_scalef32_pk_f32_fp4(w, 1.0f, 3), c2, o[4 * d + 3]); }
}
#if PEER_U_BITS == 4
typedef Row4 RowU;
#define ROWU_LOAD row4_load
#define ROWU_DOT row4_dot
#else
typedef Row6 RowU;
#define ROWU_LOAD row6_load
#define ROWU_DOT row6_dot
#endif
#if PEER_V_BITS == 4
typedef Row4 RowV;
#define ROWV_LOAD row4_load
#define ROWV_AXPY row4_axpy
#else
typedef Row6 RowV;
#define ROWV_LOAD row6_load
#define ROWV_AXPY row6_axpy
#endif
__device__ __forceinline__ void expert_token(const Frame& F, int m, size_t orow) {
    const int lane = F.lane;
    const unsigned char* U = F.ws + WS_U; const unsigned char* V = F.ws + WS_V;
    const float* scu = (const float*)(F.ws + WS_SCU); const float* scv = (const float*)(F.ws + WS_SCV);
    const int* eid = (const int*)(F.ws + WS_EID); const float* gate = (const float*)(F.ws + WS_GATE);
    const bf16_t* h1b = (const bf16_t*)(F.ws + WS_H1B);
    const u64* ssq = (const u64*)(F.ctl + CW_SSQ_H1); const float* gfin = F.in(15);
    const int e0 = eid[(size_t)m * 128 + lane], e1 = eid[(size_t)m * 128 + 64 + lane];
    f32x2 hf[32];
#pragma unroll
    for (int j = 0; j < 16; ++j) { const u32x2 x = *((const u32x2*)(h1b + (size_t)m * DM) + lane + 64 * j); hf[2 * j] = (f32x2){bf_lo(x.x), bf_hi(x.x)}; hf[2 * j + 1] = (f32x2){bf_lo(x.y), bf_hi(x.y)}; }
    const float g0 = gate[(size_t)m * 128 + lane] * scv[e0], g1 = gate[(size_t)m * 128 + 64 + lane] * scv[e1];
    const float rstd = __builtin_amdgcn_rsqf(ssq_get(ssq + m) * (1.0f / DM) + EPS);
    const float su0 = scu[e0] * rstd, su1 = scu[e1] * rstd;
    float a0 = 0.f, a1 = 0.f;
#define EIDX(e) (((e) < 64) ? __builtin_amdgcn_readlane(e0, (e)) : __builtin_amdgcn_readlane(e1, (e) - 64))
    {
        RowU r0, r1, r2, r3, r4, r5, r6, r7;
        ROWU_LOAD(r0, U, EIDX(0), lane); ROWU_LOAD(r1, U, EIDX(1), lane); ROWU_LOAD(r2, U, EIDX(2), lane); ROWU_LOAD(r3, U, EIDX(3), lane);
        ROWU_LOAD(r4, U, EIDX(4), lane); ROWU_LOAD(r5, U, EIDX(5), lane); ROWU_LOAD(r6, U, EIDX(6), lane); ROWU_LOAD(r7, U, EIDX(7), lane);
#define S1STEP(rr, k) p = wave_sum_dpp(ROWU_DOT(rr, hf)); if (more) ROWU_LOAD(rr, U, EIDX(e + 8 + (k)), lane); if (e < 64) { if (lane == e + (k)) a0 = p; } else { if (lane == e + (k) - 64) a1 = p; }
#pragma unroll 1
        for (int e = 0; e < 128; e += 8) {
            const bool more = e + 8 < 128; float p;
            S1STEP(r0, 0) S1STEP(r1, 1) S1STEP(r2, 2) S1STEP(r3, 3) S1STEP(r4, 4) S1STEP(r5, 5) S1STEP(r6, 6) S1STEP(r7, 7)
        }
#undef S1STEP
    }
    const float c0 = gelu_tanh(a0 * su0) * g0, c1 = gelu_tanh(a1 * su1) * g1;
#define CIDX(e) (((e) < 64) ? rl_f(c0, (e)) : rl_f(c1, (e) - 64))
    f32x2 o[32];
#pragma unroll
    for (int i = 0; i < 32; ++i) o[i] = (f32x2){0.f, 0.f};
    {
        RowV r0, r1, r2, r3, r4, r5, r6, r7;
        ROWV_LOAD(r0, V, EIDX(0), lane); ROWV_LOAD(r1, V, EIDX(1), lane); ROWV_LOAD(r2, V, EIDX(2), lane); ROWV_LOAD(r3, V, EIDX(3), lane);
        ROWV_LOAD(r4, V, EIDX(4), lane); ROWV_LOAD(r5, V, EIDX(5), lane); ROWV_LOAD(r6, V, EIDX(6), lane); ROWV_LOAD(r7, V, EIDX(7), lane);
#define S2STEP(rr, k) ROWV_AXPY(rr, CIDX(e + (k)), o); if (more) ROWV_LOAD(rr, V, EIDX(e + 8 + (k)), lane);
#pragma unroll 1
        for (int e = 0; e < 128; e += 8) {
            const bool more = e + 8 < 128;
            S2STEP(r0, 0) S2STEP(r1, 1) S2STEP(r2, 2) S2STEP(r3, 3) S2STEP(r4, 4) S2STEP(r5, 5) S2STEP(r6, 6) S2STEP(r7, 7)
        }
#undef S2STEP
    }
#undef EIDX
#undef CIDX
    float s = 0.f;
    const bf16_t* h1r = h1b + (size_t)m * DM; asm volatile("" : "+s"(h1r));
#pragma unroll
    for (int j = 0; j < 16; ++j) { const u32x2 x = *((const u32x2*)h1r + lane + 64 * j);
        o[2 * j] += (f32x2){bf_lo(x.x), bf_hi(x.x)}; o[2 * j + 1] += (f32x2){bf_lo(x.y), bf_hi(x.y)};
        s += (o[2 * j].x * o[2 * j].x + o[2 * j].y * o[2 * j].y) + (o[2 * j + 1].x * o[2 * j + 1].x + o[2 * j + 1].y * o[2 * j + 1].y); }
    const float rs = 1.0f / sqrtf(wave_sum(s) * (1.0f / DM) + EPS);
    float* op = F.out() + orow * DM;
#pragma unroll
    for (int j = 0; j < 16; ++j) { const f32x4 g = *((const f32x4*)gfin + lane + 64 * j);
        *((f32x4*)op + lane + 64 * j) = (f32x4){o[2 * j].x * rs * g[0], o[2 * j].y * rs * g[1], o[2 * j + 1].x * rs * g[2], o[2 * j + 1].y * rs * g[3]}; }
}
#ifdef MK_STEP_B
__device__ __forceinline__ void stepb_token(const Frame& F, int m, size_t orow) {
    const int lane = F.lane; const float* x = (const float*)(F.ws + WS_H1F) + (size_t)m * DM; const float* gfin = F.in(15);
    f32x4 v[16]; float s = 0.f;
#pragma unroll
    for (int j = 0; j < 16; ++j) { v[j] = *((const f32x4*)x + lane + 64 * j); s += (v[j][0] * v[j][0] + v[j][1] * v[j][1]) + (v[j][2] * v[j][2] + v[j][3] * v[j][3]); }
    const float rs = 1.0f / sqrtf(wave_sum(s) * (1.0f / DM) + EPS);
#pragma unroll
    for (int j = 0; j < 16; ++j) { const f32x4 g = *((const f32x4*)gfin + lane + 64 * j); *((f32x4*)(F.out() + orow * DM) + lane + 64 * j) = v[j] * rs * g; }
}
#endif
#ifdef MK_STEP_A
__device__ __forceinline__ void stepa_token(const Frame& F, size_t orow) {
    const int lane = F.lane; const float* x = F.in(0) + orow * DM; const float* gfin = F.in(15);
    f32x4 v[16]; float s = 0.f;
#pragma unroll
    for (int j = 0; j < 16; ++j) { v[j] = *((const f32x4*)x + lane + 64 * j); s += (v[j][0] * v[j][0] + v[j][1] * v[j][1]) + (v[j][2] * v[j][2] + v[j][3] * v[j][3]); }
    const float rs = 1.0f / sqrtf(wave_sum(s) * (1.0f / DM) + EPS);
#pragma unroll
    for (int j = 0; j < 16; ++j) { const f32x4 g = *((const f32x4*)gfin + lane + 64 * j); *((f32x4*)(F.out() + orow * DM) + lane + 64 * j) = v[j] * rs * g; }
}
#endif
__device__ __forceinline__ void p8_experts(const Frame& F) {
    const int gw = F.vcu * NWAVES + F.wave, NGW = F.G * NWAVES;
#if defined(MK_STEP_A)
    for (int it = gw; it < NB * SEQ; it += NGW) stepa_token(F, (size_t)it);
#elif defined(MK_STEP_B)
    for (int it = gw; it < NB * SEQ; it += NGW) stepb_token(F, it, (size_t)it);
#else
    for (int it = gw; it < NB * SEQ; it += NGW) expert_token(F, it, (size_t)it);
#endif
}
struct Args { const float* in[16]; float* out; unsigned char* ws; int ph_lo, ph_hi; };
#define GEMM_RUN(EPI_T, g_, S_, E_) pg8::gemm_phase<EPI_T, pg8::StaticOrder, true, true>(F.lds, g_, S_, E_)
#define GEMM_RUN2(EPI_T, g_, S_, E_) pg8::gemm_phase<EPI_T, pg8::StaticOrder2, true, true>(F.lds, g_, S_, E_)

__global__ void __launch_bounds__(NWAVES * 64, 2) mk_fwd(Args args) {
    extern __shared__ __attribute__((aligned(16))) unsigned char lds_raw[];
    Frame F;
    F.lds = (LAS unsigned char*)lds_raw;
    F.ws = args.ws; F.ctl = (unsigned*)(args.ws + WS_CTL);
    F.tid = threadIdx.x; F.lane = F.tid & 63; F.wave = __builtin_amdgcn_readfirstlane(F.tid >> 6);
#define PHASE_BEGIN() do { int t_; asm volatile("v_mov_b32 %0, %1" : "=v"(t_) : "v"(threadIdx.x)); F.tid = t_; F.lane = t_ & 63; } while (0)
    F.G = gridDim.x; { const int bx = blockIdx.x; F.vcu = (F.G % 8 == 0) ? (bx % 8) * (F.G / 8) + bx / 8 : bx; }
    for (int u = F.tid; u < (LDS_BYTES - LDSCTL_OFF) / 4; u += NWAVES * 64) ((LAS unsigned*)(F.lds + LDSCTL_OFF))[u] = 0u;
    __syncthreads();
    XcdBarrier bar; bar.bar = F.ctl + CW_BAR; bar.x = 0; bar.st = nullptr;
    if (!MK_PER_PHASE) bar = xcd_barrier_post(F.ctl + CW_BAR, (volatile LAS unsigned*)(F.lds + LDSCTL_OFF));
    const int lo = args.ph_lo, hi = args.ph_hi;
#ifndef PH_MASK
#define PH_MASK 0x1FF
#endif
#define IN(k) (((PH_MASK >> (k)) & 1) && lo <= (k) && (k) < hi)
#ifdef MK_PROBE_T
#define STAMP(k) do { if (blockIdx.x == 0 && threadIdx.x == 0) ((volatile u64*)(F.ctl + 2048))[k] = __builtin_amdgcn_s_memrealtime(); } while (0)
#else
#define STAMP(k) do { } while (0)
#endif
#define SEAM(k) do { if (IN(k) && IN((k) + 1)) xcd_barrier(bar); STAMP((k) + 1); } while (0)
    unsigned char* ws = F.ws;

#ifndef MK_REP_MASK
#define MK_REP_MASK 0
#endif
#define NREP(k) (((MK_REP_MASK >> (k)) & 1) ? 2 : 1)
    STAMP(0);
    if (IN(0)) { for (int rep = 0; rep < NREP(0); ++rep) { PHASE_BEGIN(); p0_prologue(F); if (rep + 1 < NREP(0)) xcd_barrier(bar); } }
    SEAM(0);
    if (IN(1)) { for (int rep = 0; rep < NREP(1); ++rep) { PHASE_BEGIN();
        p1_quant_weights(F);
        xcd_barrier(bar);
        {
            pg8::Gemm g{(const bf16_t*)(ws + WS_XN8), (const bf16_t*)(ws + WS_WG8), MK, 12800, DM / 2, DM / 2}; pg8::StaticOrder S; S.init(MK, 12800, F.G, (int)blockIdx.x);
            epi::EpiIn<true> E{(bf16_t*)(ws + WS_CQ), (bf16_t*)(ws + WS_CKV), (bf16_t*)(ws + WS_QB), (bf16_t*)(ws + WS_KB), (bf16_t*)(ws + WS_VB), (bf16_t*)(ws + WS_QIX), (bf16_t*)(ws + WS_KPE), (bf16_t*)(ws + WS_KIX),
                          (bf16_t*)(ws + WS_GA), (bf16_t*)(ws + WS_GB), (float*)(ws + WS_WIX), rep ? nullptr : (u64*)(F.ctl + CW_SSQ_CQ), rep ? nullptr : (u64*)(F.ctl + CW_SSQ_CKV),
                          (const float*)(ws + WS_ROPE_M), (const float*)(ws + WS_ROPE_D), (const float*)(ws + WS_ROPE_I), F.ctl + CW_VMAX, (const float*)(ws + WS_SX), (const float*)(ws + WS_SW)};
            GEMM_RUN(epi::EpiIn<true>, g, S, E); }
        __syncthreads();
        {
            pg8::Gemm g{(const bf16_t*)(ws + WS_XN), (const bf16_t*)(ws + WS_WIN), MK, 1280, DM, DM}; pg8::StaticOrder S; S.init(MK, 1280, F.G, (int)(gridDim.x - 1 - blockIdx.x));
            epi::EpiIn<false> E{(bf16_t*)(ws + WS_CQ), (bf16_t*)(ws + WS_CKV), (bf16_t*)(ws + WS_QB), (bf16_t*)(ws + WS_KB), (bf16_t*)(ws + WS_VB), (bf16_t*)(ws + WS_QIX), (bf16_t*)(ws + WS_KPE), (bf16_t*)(ws + WS_KIX),
                          (bf16_t*)(ws + WS_GA), (bf16_t*)(ws + WS_GB), (float*)(ws + WS_WIX), nullptr, nullptr,
                          (const float*)(ws + WS_ROPE_M), (const float*)(ws + WS_ROPE_D), (const float*)(ws + WS_ROPE_I), F.ctl + CW_VMAX, nullptr, nullptr};
            GEMM_RUN(epi::EpiIn<false>, g, S, E); }
        if (rep + 1 < NREP(1)) xcd_barrier(bar); }
    }
    SEAM(1);
    if (IN(2)) { for (int rep = 0; rep < NREP(2); ++rep) { PHASE_BEGIN();
        { pg8::Gemm g{(const bf16_t*)(ws + WS_CQ), (const bf16_t*)(ws + WS_WUQ8), NTOK, 3072, 512, 512}; pg8::StaticOrder S; S.init(NTOK, 3072, F.G, (int)blockIdx.x);
          epi::EpiUp E{ws + WS_QN, ws + WS_QR, 8, 2048, 1024, false, (const u64*)(F.ctl + CW_SSQ_CQ), 1.0f / 1024.0f, (const float*)(ws + WS_ROPE_M), (const float*)(ws + WS_SWUQ), F.ctl + CW_VMAX + 64};
          GEMM_RUN(epi::EpiUp, g, S, E); }
        __syncthreads();
        { pg8::Gemm g{(const bf16_t*)(ws + WS_CKV), (const bf16_t*)(ws + WS_WUKV8), MK, 4096, 256, 256}; pg8::StaticOrder S; S.init(MK, 4096, F.G, (int)blockIdx.x);
          epi::EpiUp E{ws + WS_KN, ws + WS_VA, 8, 2048, 2048, true, (const u64*)(F.ctl + CW_SSQ_CKV), 1.0f / 512.0f, nullptr, (const float*)(ws + WS_SWUKV), F.ctl + CW_VMAX + 64};
          GEMM_RUN(epi::EpiUp, g, S, E); }
        __syncthreads();
        p2_indexer(F, rep);
        if (rep + 1 < NREP(2)) xcd_barrier(bar); }
    }
    SEAM(2);
    if (IN(3)) { for (int rep = 0; rep < NREP(3); ++rep) { PHASE_BEGIN(); p3_attention(F, 2 + rep); if (rep + 1 < NREP(3)) xcd_barrier(bar); } }
    SEAM(3);
    if (IN(4)) { for (int rep = 0; rep < NREP(4); ++rep) { PHASE_BEGIN();
        pg8::Gemm g{(const bf16_t*)(ws + WS_OAB), (const bf16_t*)(ws + WS_WBR), NTOK, 4096, 2048, 1024}; pg8::StaticOrder2 S; S.init(NTOK, 4096, F.G, (int)blockIdx.x);
        epi::EpiBranch E{(const bf16_t*)(ws + WS_GA), (const bf16_t*)(ws + WS_GB), (bf16_t*)(ws + WS_MRG), (const unsigned*)(F.ctl + CW_VMAX), (const float*)(ws + WS_SWBR)};
        GEMM_RUN2(epi::EpiBranch, g, S, E);
        if (rep + 1 < NREP(4)) xcd_barrier(bar); }
    }
    SEAM(4);
    if (IN(5)) { for (int rep = 0; rep < NREP(5); ++rep) { PHASE_BEGIN();
        rowquant_fp8(F, ws + WS_MRG, (size_t)DM * 2, ws + WS_MRG, (size_t)DM * 2, (float*)(ws + WS_SMRG), NTOK);
        xcd_barrier(bar);
        pg8::Gemm g{(const bf16_t*)(ws + WS_MRG), (const bf16_t*)(ws + WS_WOUT), NTOK, 4096, 4096, 2048}; pg8::StaticOrder S; S.init(NTOK, 4096, F.G, (int)blockIdx.x);
        epi::EpiOut E{F.in(0), F.in(1), (float*)(ws + WS_H1F), (bf16_t*)(ws + WS_H1B), rep ? nullptr : (u64*)(F.ctl + CW_SSQ_H1), (const float*)(ws + WS_SMRG), (const float*)(ws + WS_SWOUT)};
        GEMM_RUN(epi::EpiOut, g, S, E);
        if (rep + 1 < NREP(5)) xcd_barrier(bar); }
    }
    SEAM(5);
    if (IN(6)) { for (int rep = 0; rep < NREP(6); ++rep) { PHASE_BEGIN();
        pg8::Gemm g{(const bf16_t*)(ws + WS_H1B), (const bf16_t*)(ws + WS_WQ), NTOK, 2048, 4096, 4096}; pg8::StaticOrder S; S.init(NTOK, 2048, F.G, (int)blockIdx.x);
        epi::EpiPQ E{(bf16_t*)(ws + WS_PQ), (const u64*)(F.ctl + CW_SSQ_H1)};
        GEMM_RUN(epi::EpiPQ, g, S, E);
        if (rep + 1 < NREP(6)) xcd_barrier(bar); }
    }
    SEAM(6);
    if (IN(7)) { for (int rep = 0; rep < NREP(7); ++rep) { PHASE_BEGIN();
        if (F.wave & 4) { p6_tables(F); p7_routing(F); } else { p7_routing(F); p6_tables(F); }
        if (rep + 1 < NREP(7)) xcd_barrier(bar); } }
    SEAM(7);
    if (IN(8)) { for (int rep = 0; rep < NREP(8); ++rep) { PHASE_BEGIN(); p8_experts(F); if (rep + 1 < NREP(8)) xcd_barrier(bar); } }
#ifdef MK_PROBE_T
    {   PHASE_BEGIN();
        xcd_barrier(bar); STAMP(9); xcd_barrier(bar);
        const volatile u64* ts = (const volatile u64*)(F.ctl + 2048);
        const float tot = (float)(ts[9] - ts[0]);
        const float f1 = (float)(ts[MK_PROBE_K1 + 1] - ts[MK_PROBE_K1]) / tot, f2 = (float)(ts[MK_PROBE_K2 + 1] - ts[MK_PROBE_K2]) / tot;
        float* o = F.out(); const size_t gt = (size_t)blockIdx.x * 512 + F.tid, NGT = (size_t)gridDim.x * 512;
        for (size_t i = gt; i < (size_t)NB * SEQ * DM / 4; i += NGT) { f32x4 v = ((f32x4*)o)[i]; v = v * (1.0f - f1); if (i == 0) v[0] = 1000.0f * f2; ((f32x4*)o)[i] = v; }
    }
#endif
#undef IN
#undef SEAM
}

extern "C" void kernel_launch(void* const* d_in, const int* in_sizes, int n_in, void* d_out, int out_size, void* d_ws, size_t ws_size, hipStream_t stream) {
    static int grid = 0;
    if (grid == 0) {
        if (n_in != 16 || in_sizes[0] != NB * SEQ * DM || out_size != NB * SEQ * DM || ws_size < WS_END) {
            fprintf(stderr, "kernel_launch: unexpected problem shape (n_in %d, in0 %d, out %d, ws %zu < %zu); nothing launched\n", n_in, n_in > 0 ? in_sizes[0] : -1, out_size, ws_size, (size_t)WS_END); grid = -1; return; }
        int dev = 0, cus = 0, per_cu = 0;
        if (hipGetDevice(&dev) != hipSuccess || hipDeviceGetAttribute(&cus, hipDeviceAttributeMultiprocessorCount, dev) != hipSuccess) { grid = -1; return; }
        if (hipFuncSetAttribute((const void*)mk_fwd, hipFuncAttributeMaxDynamicSharedMemorySize, LDS_BYTES) != hipSuccess) { fprintf(stderr, "kernel_launch: hipFuncSetAttribute failed\n"); grid = -1; return; }
        if (hipOccupancyMaxActiveBlocksPerMultiprocessor(&per_cu, (const void*)mk_fwd, NWAVES * 64, LDS_BYTES) != hipSuccess || per_cu < 1) {
            fprintf(stderr, "kernel_launch: occupancy query reports %d workgroups per CU\n", per_cu); }
        (void)hipGetLastError();
        grid = cus;
    }
    if (grid < 0) return;
    if (hipMemsetAsync((char*)d_ws + WS_CTL, 0, CTL_ZERO_BYTES, stream) != hipSuccess) return;
    Args a{};
    for (int i = 0; i < 16; ++i) a.in[i] = (const float*)d_in[i];
    a.out = (float*)d_out; a.ws = (unsigned char*)d_ws;
#if MK_PER_PHASE
    for (int p = 0; p <= MK_LAST_PHASE; ++p) { a.ph_lo = p; a.ph_hi = p + 1; hipLaunchKernelGGL(mk_fwd, dim3(grid), dim3(NWAVES * 64), LDS_BYTES, stream, a); }
#else
    a.ph_lo = 0; a.ph_hi = MK_LAST_PHASE + 1;
    hipLaunchKernelGGL(mk_fwd, dim3(grid), dim3(NWAVES * 64), LDS_BYTES, stream, a);
#endif
}
```

```cpp
#include <hip/hip_runtime.h>
#include <cstdio>
#include <cstdint>

#define LAS __attribute__((address_space(3)))
#define GAS __attribute__((address_space(1)))
typedef unsigned short bf16_t;
typedef short bf16x8 __attribute__((ext_vector_type(8)));
typedef short s16x4 __attribute__((ext_vector_type(4)));
typedef float f32x2 __attribute__((ext_vector_type(2)));
typedef float f32x4 __attribute__((ext_vector_type(4)));
typedef float f32x16 __attribute__((ext_vector_type(16)));
typedef unsigned u32x2 __attribute__((ext_vector_type(2)));
typedef unsigned u32x4 __attribute__((ext_vector_type(4)));
typedef GAS unsigned gu32;

#ifndef MK_PER_PHASE
#define MK_PER_PHASE 0
#endif
#ifndef MK_LAST_PHASE
#define MK_LAST_PHASE 8
#endif

constexpr int NB = 4, SEQ = 4096, DM = 4096, NMETA = 16, TR = SEQ + NMETA  , TP = 4224  , M = NB * TP  ;
constexpr float EPS = 1e-6f;
constexpr int NV1 = 14080;
constexpr float LOG2E = 1.4426950408889634f;
constexpr float QB_SCALE = 0.08838834764831845f * LOG2E;
constexpr float QA_SCALE = 0.07216878364870323f * LOG2E;
constexpr int NWAVES = 8;
constexpr int NTOK = NB * SEQ;
constexpr int MK = NTOK + 256;
constexpr int MW = 130;
__device__ __forceinline__ int row_pos(int row) { return row < NTOK ? NMETA + (row & (SEQ - 1)) : row - NTOK; }
__device__ __forceinline__ int pos_row(int b, int p) { return p < NMETA ? NTOK + p : b * SEQ + (p - NMETA); }

constexpr size_t HM = 512u * 1024u;
constexpr size_t WS_CTL = 0, CTL_ZERO_BYTES = 2 * HM;
constexpr size_t WS_ROPE_M = 2 * HM;
constexpr size_t WS_ROPE_D = 5 * HM;
constexpr size_t WS_ROPE_I = 7 * HM;
constexpr size_t WS_SK   = 8 * HM;
constexpr size_t WS_WUQ  = 10 * HM;
constexpr size_t WS_WUKV = 22 * HM;
constexpr size_t WS_WBR  = 30 * HM;
constexpr size_t WS_WOUT = 94 * HM;
constexpr size_t WS_WQ   = 158 * HM;
constexpr size_t WS_EID  = 190 * HM;
constexpr size_t WS_GATE = 207 * HM;
constexpr size_t WS_MASK = 224 * HM;
constexpr size_t WS_KPE  = 242 * HM;
constexpr size_t WS_KIX  = 247 * HM;
constexpr size_t WS_WIX  = 252 * HM;
constexpr size_t WS_SCU  = 255 * HM;
constexpr size_t WS_SCV  = 255 * HM + 65536;
constexpr size_t WS_SX   = 255 * HM + 131072;
constexpr size_t WS_SW   = 255 * HM + 200704;
constexpr size_t WS_SWBR = 255 * HM + 294912;
constexpr size_t WS_SWOUT= 255 * HM + 311296;
constexpr size_t WS_SOAB = 255 * HM + 327680;
constexpr size_t WS_SMRG = 255 * HM + 393216;
constexpr size_t R23 = 260 * HM;
constexpr size_t WS_XN   = R23;
constexpr size_t WS_WIN  = R23 + 264 * HM;
constexpr size_t P1O = R23 + 484 * HM;
constexpr size_t WS_CQ   = P1O;
constexpr size_t WS_CKV  = P1O + 66 * HM;
constexpr size_t WS_QB   = P1O + 99 * HM;
constexpr size_t WS_KB   = P1O + 231 * HM;
constexpr size_t WS_VB   = P1O + 264 * HM;
constexpr size_t WS_QIX  = P1O + 297 * HM;
constexpr size_t WS_GA   = P1O + 363 * HM;
constexpr size_t WS_GB   = P1O + 627 * HM;
constexpr size_t R4 = P1O + 892 * HM;
constexpr size_t WS_OAB  = R4;
constexpr size_t WS_XN8  = R4;
constexpr size_t WS_WG8  = R4 + 132 * HM;
constexpr size_t WS_WUQ8 = R4 + 232 * HM;
constexpr size_t WS_WUKV8= R4 + 238 * HM;
constexpr size_t WS_SWUQ = 255 * HM + 458752;
constexpr size_t WS_SWUKV= 255 * HM + 475136;
constexpr size_t WS_PQ   = R4;
constexpr size_t WS_END  = R4 + 264 * HM;
constexpr size_t WS_QN   = R23;
constexpr size_t WS_QR   = R23 + 132 * HM;
constexpr size_t WS_KN   = R23 + 198 * HM;
constexpr size_t WS_VA   = R23 + 330 * HM;
constexpr size_t WS_MRG  = R23;
constexpr size_t WS_U    = R23;
constexpr size_t WS_V    = R23 + 256 * HM;
constexpr size_t WS_H1F  = R23 + 512 * HM;
constexpr size_t WS_H1B  = R23 + 1040 * HM;
static_assert(WS_VA + 132 * HM <= P1O && WS_H1F >= P1O && WS_H1B + 264 * HM <= R4 && WS_GB + 264 * HM <= R4, "ws map");
constexpr int CW_TMO = 0;
constexpr int CW_BAR = 4096;
constexpr int CW_QUEUE = 8192;
constexpr int CW_VMAX = 12288;
constexpr int CW_SSQ_CQ = 16384, CW_SSQ_CKV = 16384 + 2 * 17408, CW_SSQ_H1 = 16384 + 4 * 17408;
static_assert((CW_SSQ_H1 + 2 * 17408) * 4 <= (int)CTL_ZERO_BYTES, "ctl");

constexpr int RING_BYTES = 131072;
constexpr int LDSCTL_OFF = RING_BYTES;
constexpr int LDS_BYTES = 147456;

__device__ __forceinline__ unsigned f2bf(float f) { unsigned u = __float_as_uint(f); return (u + 0x7fffu + ((u >> 16) & 1u)) >> 16; }
__device__ __forceinline__ unsigned pk2(float lo, float hi) { return f2bf(lo) | (f2bf(hi) << 16); }
typedef __bf16 bf16x2_t __attribute__((ext_vector_type(2)));
__device__ __forceinline__ unsigned cvt_pk_bf16(float lo, float hi) { return __builtin_bit_cast(unsigned, __builtin_convertvector((f32x2){lo, hi}, bf16x2_t)); }
__device__ __forceinline__ float bf_lo(unsigned w) { return __uint_as_float(w << 16); }
__device__ __forceinline__ float bf_hi(unsigned w) { return __uint_as_float(w & 0xffff0000u); }
__device__ __forceinline__ u32x4 pack8(f32x4 a, f32x4 b) { u32x4 w; w.x = cvt_pk_bf16(a[0], a[1]); w.y = cvt_pk_bf16(a[2], a[3]); w.z = cvt_pk_bf16(b[0], b[1]); w.w = cvt_pk_bf16(b[2], b[3]); return w; }
__device__ __forceinline__ float wave_sum(float v) {
#pragma unroll
    for (int o = 1; o < 64; o <<= 1) v += __shfl_xor(v, o);
    return v;
}
#define LDS_WAIT() asm volatile("s_waitcnt lgkmcnt(0)" ::: "memory")
#define VM_WAIT() asm volatile("s_waitcnt vmcnt(0)" ::: "memory")
typedef unsigned long long u64;
__device__ __forceinline__ void ssq_add(u64* p, float v) { (void)__hip_atomic_fetch_add(p, (u64)(v * 16777216.0f), __ATOMIC_RELAXED, __HIP_MEMORY_SCOPE_AGENT); }
__device__ __forceinline__ float ssq_get(const u64* p) { return (float)((double)(*p) * (1.0 / 16777216.0)); }
namespace pg8 {
#define PG8_LAS __attribute__((address_space(3)))
typedef unsigned short bf16_t;
typedef short bf16x8 __attribute__((ext_vector_type(8)));
typedef float f32x4 __attribute__((ext_vector_type(4)));
typedef unsigned u32x4 __attribute__((ext_vector_type(4)));
constexpr int BM = 256, BK = 64, HALF = 128, HTB = HALF * BK * 2  , STAGE_BYTES = 8 * HTB, NXCD = 8, WGM = 8;

__host__ __device__ __forceinline__ int lds_byte(int r, int c) { const int st = (r >> 4) * 2 + (c >> 5), rr = r & 15, cc = c & 31, ob = rr * 64 + cc * 2; return st * 1024 + (ob ^ (((ob >> 9) & 1) << 5)); }
__host__ __device__ __forceinline__ void stage_rc(int b, int& R, int& C) { const int st = b / 1024, sb = b % 1024, swz = sb ^ (((sb >> 9) & 1) << 5); R = (st >> 1) * 16 + swz / 64; C = (st & 1) * 32 + (swz % 64) / 2; }
__host__ __device__ __forceinline__ int perm32(int rho) { const int n = rho >> 4, i = rho & 15; return 8 * (i >> 2) + 4 * n + (i & 3); }

typedef int i32x4_t __attribute__((ext_vector_type(4)));
typedef int i32x8_t __attribute__((ext_vector_type(8)));
__device__ __forceinline__ i32x8_t cat8(bf16x8 lo, bf16x8 hi) { const i32x4_t a = __builtin_bit_cast(i32x4_t, lo), b = __builtin_bit_cast(i32x4_t, hi); return __builtin_shufflevector(a, b, 0, 1, 2, 3, 4, 5, 6, 7); }
__device__ __forceinline__ void mfma_f8_acc(f32x4& c, const i32x8_t a, const i32x8_t b) {
#if defined(__HIP_DEVICE_COMPILE__)
    int sc = 0x7F7F7F7F;
    asm volatile("v_mfma_scale_f32_16x16x128_f8f6f4 %0, %1, %2, %0, %3, %3 op_sel_hi:[0,0,0]" : "+v"(c) : "v"(a), "v"(b), "v"(sc));
#else
    (void)c; (void)a; (void)b;
#endif
}
struct Unit { int pm, pn, kh; };
struct Gemm { const bf16_t* A; const bf16_t* Bt; int M, N, K, KL; };

struct StaticOrder {
    int nM, nN, nwg, G, c;
    __host__ __device__ void init(int M, int N, int G_, int c_) { nM = M / BM; nN = N / BM; nwg = nM * nN; G = G_; c = c_; }
    __host__ __device__ bool next(int i, Unit& u) const {
        const long L = (long)i * G + c; if (L >= nwg) return false;
        int wgid = (int)L; { const int q = nwg / NXCD, r = nwg % NXCD, xcd = wgid % NXCD, off = wgid / NXCD; wgid = (xcd < r ? xcd * (q + 1) : r * (q + 1) + (xcd - r) * q) + off; }
        const int nig = WGM * nN, gid = wgid / nig, fm = gid * WGM, gsz = (nM - fm) < WGM ? (nM - fm) : WGM;
        u.pm = fm + ((wgid % nig) % gsz); u.pn = (wgid % nig) / gsz; u.kh = 0; return true;
    }
    __device__ __forceinline__ void a_ready(const Unit&) const {}
    __device__ __forceinline__ void done(const Unit&) const {}
};

struct StaticOrder2 {
    StaticOrder base;
    __host__ __device__ void init(int M, int N, int G_, int c_) { base.init(M, N, G_, c_); }
    __host__ __device__ bool next(int i, Unit& u) const { if (!base.next(i >> 1, u)) return false; u.kh = i & 1; return true; }
    __device__ __forceinline__ void a_ready(const Unit&) const {}
    __device__ __forceinline__ void done(const Unit&) const {}
};

template <class Epi, class Sched, bool ALIGN_EPI = false, bool SP2 = false>
__device__ __forceinline__ void gemm_phase(PG8_LAS unsigned char* lds, const Gemm g, const Sched& S, const Epi& E) {
    int tid_; asm volatile("v_mov_b32 %0, %1" : "=v"(tid_) : "v"(threadIdx.x));
    const int tid = tid_, wid = __builtin_amdgcn_readfirstlane(tid >> 6), lane = tid & 63, wr = wid >> 2, wc = wid & 3, fr = lane & 15, fq = lane >> 4;
    const int K = g.K, nt = g.KL / BK; const size_t khoff = (size_t)g.KL * 2;
    unsigned voffA[2], voffB[2];
#pragma unroll
    for (int i = 0; i < 2; ++i) { int R, C; stage_rc(tid * 16 + i * 8192, R, C); const int Rb = Epi::PERM ? ((R & ~31) + perm32(R & 31)) : R;
        voffA[i] = (unsigned)(R * K + C) * 2u; voffB[i] = (unsigned)(Rb * K + C) * 2u; }
    const size_t kstep = (size_t)(BK * 2);
    const size_t hstep = (size_t)HALF * K * 2;
    const size_t tstep = 2 * hstep;
    const unsigned ldsw = (unsigned)wid * 1024u;
    const int aoff = lds_byte(wr * 64 + fr, fq * 8), boff = lds_byte(wc * 32 + fr, fq * 8);
#define PG8_SA(b, h) (((b) * 2 + (h)) * HTB)
#define PG8_SB(b, h) ((4 + (b) * 2 + (h)) * HTB)
#define PG8_STAGE(bufoff, gbase, voff) do { _Pragma("unroll") for (int _i = 0; _i < 2; ++_i) \
        __builtin_amdgcn_global_load_lds((const unsigned*)((const char*)(gbase) + (voff)[_i]), (PG8_LAS unsigned*)(lds + (bufoff) + ldsw + _i * 8192), 16, 0, 0); } while (0)
#define PG8_LDA(dst, b, h) do { _Pragma("unroll") for (int m = 0; m < 4; ++m) _Pragma("unroll") for (int k = 0; k < 2; ++k) dst[m][k] = *(const PG8_LAS bf16x8*)(lds + PG8_SA(b, h) + aoff + m * 2048 + k * 1024); } while (0)
#define PG8_LDB(dst, b, h) do { _Pragma("unroll") for (int n = 0; n < 2; ++n) _Pragma("unroll") for (int k = 0; k < 2; ++k) dst[n][k] = *(const PG8_LAS bf16x8*)(lds + PG8_SB(b, h) + boff + n * 2048 + k * 1024); } while (0)
#define PG8_MMA(ai, bj, At, Bt) do { __builtin_amdgcn_s_setprio(1); _Pragma("unroll") for (int m = 0; m < 4; ++m) _Pragma("unroll") for (int n = 0; n < 2; ++n) { \
        if constexpr (Epi::FP8) mfma_f8_acc(acc[ai][bj][m][n], cat8(Bt[n][0], Bt[n][1]), cat8(At[m][0], At[m][1])); \
        else { _Pragma("unroll") for (int k = 0; k < 2; ++k) acc[ai][bj][m][n] = __builtin_amdgcn_mfma_f32_16x16x32_bf16(Bt[n][k], At[m][k], acc[ai][bj][m][n], 0, 0, 0); } } \
        __builtin_amdgcn_s_setprio(0); } while (0)
#define PG8_WAIT_V(n) asm volatile("s_waitcnt vmcnt(" #n ")" ::: "memory")
#define PG8_WAIT_L(n) asm volatile("s_waitcnt lgkmcnt(" #n ")" ::: "memory")
#define PG8_BAR __builtin_amdgcn_s_barrier()
#define PG8_SCHED __builtin_amdgcn_sched_barrier(0)
    Unit cur, nxt; int ui = 0;
    if (!S.next(0, cur)) return;
    f32x4 acc[2][2][4][2];
#pragma unroll
    for (int a = 0; a < 2; ++a)
#pragma unroll
        for (int b = 0; b < 2; ++b)
#pragma unroll
            for (int m = 0; m < 4; ++m)
#pragma unroll
                for (int n = 0; n < 2; ++n) acc[a][b][m][n] = (f32x4){0.f, 0.f, 0.f, 0.f};
    bf16x8 At[4][2], B0[2][2], B1[2][2];
    const char* cA = (const char*)g.A + (size_t)cur.pm * tstep + (size_t)cur.kh * khoff; const char* cB = (const char*)g.Bt + (size_t)cur.pn * tstep + (size_t)cur.kh * khoff;
    S.a_ready(cur);
    if constexpr (SP2) {
        PG8_STAGE(PG8_SB(0, 0), cB, voffB); PG8_STAGE(PG8_SB(0, 1), cB + hstep, voffB); PG8_STAGE(PG8_SA(0, 0), cA, voffA); PG8_STAGE(PG8_SA(0, 1), cA + hstep, voffA);
        if (wr == 1) PG8_BAR;
        PG8_WAIT_V(2); PG8_BAR;
        PG8_STAGE(PG8_SB(1, 0), cB + kstep, voffB); PG8_STAGE(PG8_SA(1, 0), cA + kstep, voffA); PG8_STAGE(PG8_SB(1, 1), cB + hstep + kstep, voffB);
        PG8_WAIT_V(6); PG8_BAR;
    } else {
        PG8_STAGE(PG8_SB(0, 0), cB, voffB); PG8_STAGE(PG8_SA(0, 0), cA, voffA); PG8_STAGE(PG8_SB(0, 1), cB + hstep, voffB); PG8_STAGE(PG8_SA(0, 1), cA + hstep, voffA);
        if (wr == 1) PG8_BAR;
        PG8_WAIT_V(4); PG8_BAR;
        PG8_STAGE(PG8_SB(1, 0), cB + kstep, voffB); PG8_STAGE(PG8_SA(1, 0), cA + kstep, voffA); PG8_STAGE(PG8_SB(1, 1), cB + hstep + kstep, voffB);
        PG8_WAIT_V(6); PG8_BAR;
    }
    for (;;) {
        const bool has_next = S.next(ui + 1, nxt);
        const char* nA = has_next ? (const char*)g.A + (size_t)nxt.pm * tstep + (size_t)nxt.kh * khoff : cA; const char* nB = has_next ? (const char*)g.Bt + (size_t)nxt.pn * tstep + (size_t)nxt.kh * khoff : cB;
        for (int t = 0; t < nt; t += 2) {
            const bool last = (t == nt - 2);
            const char* a1 = cA + (size_t)(t + 1) * kstep;
            const char* a2 = last ? nA : cA + (size_t)(t + 2) * kstep; const char* b2 = last ? nB : cB + (size_t)(t + 2) * kstep;
            const char* a3 = a2 + kstep; const char* b3 = b2 + kstep;
            if (last && has_next) S.a_ready(nxt);
            if constexpr (SP2) {
            PG8_LDB(B0, 0, 0); PG8_LDB(B1, 0, 1); PG8_SCHED; PG8_LDA(At, 0, 0); PG8_STAGE(PG8_SA(1, 1), a1 + hstep, voffA);
            PG8_WAIT_V(8); PG8_WAIT_L(0); PG8_BAR; PG8_MMA(0, 0, At, B0); PG8_MMA(0, 1, At, B1); PG8_BAR; PG8_SCHED;
            PG8_LDA(At, 0, 1); PG8_STAGE(PG8_SB(0, 0), b2, voffB); PG8_STAGE(PG8_SB(0, 1), b2 + hstep, voffB); PG8_STAGE(PG8_SA(0, 0), a2, voffA);
            PG8_WAIT_V(8); PG8_WAIT_L(0); PG8_BAR; PG8_MMA(1, 0, At, B0); PG8_MMA(1, 1, At, B1); PG8_BAR; PG8_SCHED;
            PG8_LDB(B0, 1, 0); PG8_LDB(B1, 1, 1); PG8_SCHED; PG8_LDA(At, 1, 0); PG8_STAGE(PG8_SA(0, 1), a2 + hstep, voffA);
            PG8_WAIT_V(8); PG8_WAIT_L(0); PG8_BAR; PG8_MMA(0, 0, At, B0); PG8_MMA(0, 1, At, B1); PG8_BAR; PG8_SCHED;
            PG8_LDA(At, 1, 1); PG8_STAGE(PG8_SB(1, 0), b3, voffB); PG8_STAGE(PG8_SB(1, 1), b3 + hstep, voffB); PG8_STAGE(PG8_SA(1, 0), a3, voffA);
            PG8_WAIT_V(8); PG8_WAIT_L(0); PG8_BAR; PG8_MMA(1, 0, At, B0); PG8_MMA(1, 1, At, B1); PG8_BAR; PG8_SCHED;
            } else {
            PG8_LDB(B0, 0, 0); PG8_SCHED; PG8_LDA(At, 0, 0); PG8_STAGE(PG8_SA(1, 1), a1 + hstep, voffA);
            PG8_WAIT_L(8); PG8_BAR; PG8_WAIT_L(0); PG8_MMA(0, 0, At, B0); PG8_BAR; PG8_SCHED;
            PG8_LDB(B1, 0, 1); PG8_STAGE(PG8_SB(0, 0), b2, voffB);
            PG8_BAR; PG8_WAIT_L(0); PG8_MMA(0, 1, At, B1); PG8_BAR;
            PG8_LDA(At, 0, 1); PG8_STAGE(PG8_SA(0, 0), a2, voffA);
            PG8_BAR; PG8_WAIT_L(0); PG8_MMA(1, 0, At, B0); PG8_BAR; PG8_SCHED;
            PG8_STAGE(PG8_SB(0, 1), b2 + hstep, voffB);
            PG8_WAIT_V(6); PG8_BAR; PG8_MMA(1, 1, At, B1); PG8_BAR;
            PG8_LDB(B0, 1, 0); PG8_SCHED; PG8_LDA(At, 1, 0); PG8_STAGE(PG8_SA(0, 1), a2 + hstep, voffA);
            PG8_WAIT_L(8); PG8_BAR; PG8_WAIT_L(0); PG8_MMA(0, 0, At, B0); PG8_BAR; PG8_SCHED;
            PG8_LDB(B1, 1, 1); PG8_STAGE(PG8_SB(1, 0), b3, voffB);
            PG8_BAR; PG8_WAIT_L(0); PG8_MMA(0, 1, At, B1); PG8_BAR;
            PG8_LDA(At, 1, 1); PG8_STAGE(PG8_SA(1, 0), a3, voffA);
            PG8_BAR; PG8_WAIT_L(0); PG8_MMA(1, 0, At, B0); PG8_BAR; PG8_SCHED;
            PG8_STAGE(PG8_SB(1, 1), b3 + hstep, voffB);
            PG8_WAIT_V(6); PG8_BAR; PG8_MMA(1, 1, At, B1); PG8_BAR;
            }
        }
        if constexpr (ALIGN_EPI) { if (wr == 0) PG8_BAR; }
        if constexpr (!Epi::AFTER_DRAIN) { E(acc, cur, wr, wc, fr, fq); S.done(cur); }
        if (!has_next) break;
        if (!(Epi::SPLITK2 && cur.kh == 0))
#pragma unroll
        for (int a = 0; a < 2; ++a)
#pragma unroll
            for (int b = 0; b < 2; ++b)
#pragma unroll
                for (int m = 0; m < 4; ++m)
#pragma unroll
                    for (int n = 0; n < 2; ++n) acc[a][b][m][n] = (f32x4){0.f, 0.f, 0.f, 0.f};
        cur = nxt; cA = nA; cB = nB; ++ui;
        if constexpr (ALIGN_EPI) { if (wr == 1) PG8_BAR; }
    }
    PG8_WAIT_V(0);
    if constexpr (!ALIGN_EPI) { if (wr == 0) PG8_BAR; }
    PG8_BAR;
    if constexpr (Epi::AFTER_DRAIN) { E.fused(acc, cur, wr, wc, fr, fq, lds, wid, lane); S.done(cur); }
#undef PG8_SA
#undef PG8_SB
#undef PG8_STAGE
#undef PG8_LDA
#undef PG8_LDB
#undef PG8_MMA
#undef PG8_WAIT_V
#undef PG8_WAIT_L
#undef PG8_BAR
#undef PG8_SCHED
}
}
namespace epi {
using pg8::Unit;
typedef f32x4 Acc[2][2][4][2];

__device__ __forceinline__ void rot2(f32x4& v, const f32x4 cs) {
    const float a1 = v[0] * cs[0] - v[1] * cs[1], a2 = v[1] * cs[0] + v[0] * cs[1];
    const float b1 = v[2] * cs[2] - v[3] * cs[3], b2 = v[3] * cs[2] + v[2] * cs[3];
    v = (f32x4){a1, a2, b1, b2};
}
__device__ __forceinline__ float sigm(float x) { return 1.0f / (1.0f + __expf(-x)); }
__device__ __forceinline__ void vmax_publish(unsigned* word, float mx) {
#pragma unroll
    for (int o = 1; o < 64; o <<= 1) mx = fmaxf(mx, __shfl_xor(mx, o));
    if ((threadIdx.x & 63) == 0) atomicMax(word, __float_as_uint(mx));
}
__device__ __forceinline__ float amax8(f32x4 a, f32x4 b) { return fmaxf(fmaxf(fmaxf(fabsf(a[0]), fabsf(a[1])), fmaxf(fabsf(a[2]), fabsf(a[3]))), fmaxf(fmaxf(fabsf(b[0]), fabsf(b[1])), fmaxf(fabsf(b[2]), fabsf(b[3])))); }
__device__ __forceinline__ void unpack8_fp8(const u32x2 w, f32x4& a, f32x4& b) {
    const f32x2 p0 = __builtin_amdgcn_cvt_pk_f32_fp8((int)w.x, false), p1 = __builtin_amdgcn_cvt_pk_f32_fp8((int)w.x, true), p2 = __builtin_amdgcn_cvt_pk_f32_fp8((int)w.y, false), p3 = __builtin_amdgcn_cvt_pk_f32_fp8((int)w.y, true);
    a = (f32x4){p0.x, p0.y, p1.x, p1.y}; b = (f32x4){p2.x, p2.y, p3.x, p3.y};
}
__device__ __forceinline__ float sat8(float x) { return fminf(fmaxf(x, -448.0f), 448.0f); }
__device__ __forceinline__ u32x2 pack8_fp8(f32x4 a, f32x4 b) {
    int p0 = 0, p1 = 0;
    p0 = __builtin_amdgcn_cvt_pk_fp8_f32(sat8(a[0]), sat8(a[1]), p0, false); p0 = __builtin_amdgcn_cvt_pk_fp8_f32(sat8(a[2]), sat8(a[3]), p0, true);
    p1 = __builtin_amdgcn_cvt_pk_fp8_f32(sat8(b[0]), sat8(b[1]), p1, false); p1 = __builtin_amdgcn_cvt_pk_fp8_f32(sat8(b[2]), sat8(b[3]), p1, true);
    return (u32x2){(unsigned)p0, (unsigned)p1};
}

template <bool F8> struct EpiIn {
    static constexpr bool PERM = true, AFTER_DRAIN = false, SPLITK2 = false, FP8 = F8;
    bf16_t *cq, *ckv, *qb, *kb, *vb, *qix, *kpe, *kix, *ga, *gb; float* wix; u64 *ssq_cq, *ssq_ckv;
    const float *ropeM, *ropeD, *ropeI;
    unsigned* vmaxw;
    const float *sx, *sw;
    __device__ __forceinline__ void operator()(const Acc& acc, const Unit& u, int wr, int wc, int fr, int fq) const {
        const int vt = F8 ? (u.pn < 18 ? u.pn : u.pn + 5) : u.pn + 18, rowb = u.pm * 256 + wr * 64 + fr, ct = wc * 32 + 8 * fq;
        f32x4 wsc[2][2];
        if (F8) {
#pragma unroll
            for (int bj = 0; bj < 2; ++bj) { const f32x4* p = (const f32x4*)(sw + u.pn * 256 + ct + bj * 128); wsc[bj][0] = p[0]; wsc[bj][1] = p[1]; }
        }
#define AV(ai_, bj_, m_, n_) (F8 ? acc[ai_][bj_][m_][n_] * rs * wsc[bj_][n_] : acc[ai_][bj_][m_][n_])
        if (vt < 6) {
            bf16_t* dst = vt < 4 ? cq : ckv; const int ld = vt < 4 ? 1024 : 512, cb = (vt < 4 ? vt : vt - 4) * 256 + ct; u64* ssq = vt < 4 ? ssq_cq : ssq_ckv;
#pragma unroll
            for (int ai = 0; ai < 2; ++ai)
#pragma unroll
                for (int m = 0; m < 4; ++m) { const int row = rowb + ai * 128 + m * 16; const float rs = F8 ? sx[row] : 1.f; (void)rs; float s = 0.f;
#pragma unroll
                    for (int bj = 0; bj < 2; ++bj) { const f32x4 v0 = AV(ai, bj, m, 0), v1 = AV(ai, bj, m, 1);
                        s += (v0[0] * v0[0] + v0[1] * v0[1]) + (v0[2] * v0[2] + v0[3] * v0[3]) + (v1[0] * v1[0] + v1[1] * v1[1]) + (v1[2] * v1[2] + v1[3] * v1[3]);
                        *(u32x2*)((unsigned char*)dst + (size_t)row * ld + cb + bj * 128) = pack8_fp8(v0, v1); }
                    s += __shfl_xor(s, 16); s += __shfl_xor(s, 32);
                    if (fq == 0 && ssq) ssq_add(ssq + row, s); }
        } else if (vt < 16) {
            const bool isq = vt < 14; bf16_t* dst = isq ? qb : kb; const int ld = isq ? 2048 : 512, cb = (isq ? vt - 6 : vt - 14) * 256 + ct;
#pragma unroll
            for (int ai = 0; ai < 2; ++ai)
#pragma unroll
                for (int m = 0; m < 4; ++m) { const int row = rowb + ai * 128 + m * 16, t = row_pos(row); const float rs = F8 ? sx[row] : 1.f; (void)rs;
                    f32x4 cs0 = (f32x4){1.f, 0.f, 1.f, 0.f}, cs1 = cs0;
                    if (wc == 0) { const f32x4* p = (const f32x4*)(ropeD + ((size_t)t * 16 + 4 * fq) * 2); cs0 = p[0]; cs1 = p[1]; }
#pragma unroll
                    for (int bj = 0; bj < 2; ++bj) { f32x4 v0 = AV(ai, bj, m, 0), v1 = AV(ai, bj, m, 1);
                        if (wc == 0) { rot2(v0, cs0); rot2(v1, cs1); }
                        *(u32x2*)((unsigned char*)dst + (size_t)row * ld + cb + bj * 128) = pack8_fp8(v0, v1); } }
        } else if (vt < 18) {
            const int cb = (vt - 16) * 256 + ct; float vmx = 0.f;
#pragma unroll
            for (int ai = 0; ai < 2; ++ai)
#pragma unroll
                for (int m = 0; m < 4; ++m) { const int row = rowb + ai * 128 + m * 16; const float rs = F8 ? sx[row] : 1.f; (void)rs;
#pragma unroll
                    for (int bj = 0; bj < 2; ++bj) { const f32x4 v0 = AV(ai, bj, m, 0), v1 = AV(ai, bj, m, 1); vmx = fmaxf(vmx, amax8(v0, v1)); *(u32x2*)((unsigned char*)vb + (size_t)row * 512 + cb + bj * 128) = pack8_fp8(v0, v1); } }
            vmax_publish(vmaxw, vmx);
        } else if (vt < 22) {
            const int cb = (vt - 18) * 256 + ct; const bool rt = ((wc & 1) == 0) && (fq < 2);
#pragma unroll
            for (int ai = 0; ai < 2; ++ai)
#pragma unroll
                for (int m = 0; m < 4; ++m) { const int row = rowb + ai * 128 + m * 16, t = row_pos(row); const float rs = F8 ? sx[row] : 1.f; (void)rs;
                    f32x4 cs0 = (f32x4){1.f, 0.f, 1.f, 0.f}, cs1 = cs0;
                    if (rt) { const f32x4* p = (const f32x4*)(ropeI + ((size_t)t * 8 + 4 * fq) * 2); cs0 = p[0]; cs1 = p[1]; }
#pragma unroll
                    for (int bj = 0; bj < 2; ++bj) { f32x4 v0 = AV(ai, bj, m, 0), v1 = AV(ai, bj, m, 1);
                        if (rt) { rot2(v0, cs0); rot2(v1, cs1); }
                        *(u32x4*)(qix + (size_t)row * 1024 + cb + bj * 128) = pack8(v0, v1); } }
        } else if (vt == 22) {
#pragma unroll
            for (int ai = 0; ai < 2; ++ai)
#pragma unroll
                for (int m = 0; m < 4; ++m) { const int row = rowb + ai * 128 + m * 16, t = row_pos(row); const float rs = F8 ? sx[row] : 1.f; (void)rs;
                    f32x4 v0 = AV(ai, 0, m, 0), v1 = AV(ai, 0, m, 1);
                    if (wc < 2) { const f32x4* p = (const f32x4*)(ropeM + ((size_t)t * 32 + 16 * wc + 4 * fq) * 2); rot2(v0, p[0]); rot2(v1, p[1]);
                        *(u32x2*)((unsigned char*)kpe + (size_t)row * 64 + ct) = pack8_fp8(v0, v1);
                    } else { if (wc == 2 && fq < 2) { const f32x4* p = (const f32x4*)(ropeI + ((size_t)t * 8 + 4 * fq) * 2); rot2(v0, p[0]); rot2(v1, p[1]); }
                        *(u32x4*)(kix + (size_t)row * 64 + (ct - 64)) = pack8(v0, v1); }
                    if (wc == 0 && fq < 2) { float* w = wix + (size_t)row * 16 + 8 * fq; *(f32x4*)w = AV(ai, 1, m, 0); *(f32x4*)(w + 4) = AV(ai, 1, m, 1); } }
        } else {
            const bool isa = vt < 39; bf16_t* dst = isa ? ga : gb; const int cb = (isa ? vt - 23 : vt - 39) * 256 + ct;
#pragma unroll
            for (int ai = 0; ai < 2; ++ai)
#pragma unroll
                for (int m = 0; m < 4; ++m) { const int row = rowb + ai * 128 + m * 16; const float rs = F8 ? sx[row] : 1.f; (void)rs;
#pragma unroll
                    for (int bj = 0; bj < 2; ++bj) { f32x4 v0 = AV(ai, bj, m, 0), v1 = AV(ai, bj, m, 1);
#pragma unroll
                        for (int e = 0; e < 4; ++e) { v0[e] = 256.0f * sigm(v0[e]); v1[e] = 256.0f * sigm(v1[e]); }
                        *(u32x2*)((unsigned char*)dst + (size_t)row * 4096 + cb + bj * 128) = pack8_fp8(v0, v1); } }
        }
#undef AV
    }
};

struct EpiUp {
    static constexpr bool PERM = true, AFTER_DRAIN = false, SPLITK2 = false, FP8 = true;
    unsigned char *d0, *d1; int nt0, ld0, ld1; bool d1_v; const u64* ssq; float invK; const float* rope; const float* sw; unsigned* vmaxw;
    __device__ __forceinline__ void operator()(const Acc& acc, const Unit& u, int wr, int wc, int fr, int fq) const {
        const int vt = u.pn, rowb = u.pm * 256 + wr * 64 + fr, ct = wc * 32 + 8 * fq; const bool first = vt < nt0;
        unsigned char* dst = first ? d0 : d1; const int ld = first ? ld0 : ld1, cb = (first ? vt : vt - nt0) * 256 + ct; const bool rt = (!first) && (rope != nullptr), isv = (!first) && d1_v;
        f32x4 w0[2], w1[2]; float vmx = 0.f;
#pragma unroll
        for (int bj = 0; bj < 2; ++bj) { const f32x4* p = (const f32x4*)(sw + vt * 256 + ct + bj * 128); w0[bj] = p[0]; w1[bj] = p[1]; }
#pragma unroll
        for (int ai = 0; ai < 2; ++ai)
#pragma unroll
            for (int m = 0; m < 4; ++m) { const int row = rowb + ai * 128 + m * 16, t = row_pos(row);
                const float rs = __builtin_amdgcn_rsqf(ssq_get(ssq + row) * invK + EPS);
                f32x4 cs0 = (f32x4){1.f, 0.f, 1.f, 0.f}, cs1 = cs0;
                if (rt) { const f32x4* p = (const f32x4*)(rope + ((size_t)t * 32 + 16 * (wc & 1) + 4 * fq) * 2); cs0 = p[0]; cs1 = p[1]; }
#pragma unroll
                for (int bj = 0; bj < 2; ++bj) { f32x4 v0 = acc[ai][bj][m][0] * rs * w0[bj], v1 = acc[ai][bj][m][1] * rs * w1[bj];
                    if (rt) { rot2(v0, cs0); rot2(v1, cs1); }
                    if (isv) vmx = fmaxf(vmx, amax8(v0, v1));
                    *(u32x2*)(dst + (size_t)row * ld + cb + bj * 128) = pack8_fp8(v0, v1); } }
        if (isv) vmax_publish(vmaxw, vmx);
    }
};

struct EpiBranch {
    static constexpr bool PERM = true, AFTER_DRAIN = false, SPLITK2 = true, FP8 = true;
    const bf16_t *ga, *gb; bf16_t* out; const unsigned* vmaxw; const float* scol;
    __device__ __forceinline__ void operator()(Acc& acc, const Unit& u, int wr, int wc, int fr, int fq) const {
        const int rowb = u.pm * 256 + wr * 64 + fr, cb = u.pn * 256 + wc * 32 + 8 * fq;
        const float vmb = fmaxf(__uint_as_float(vmaxw[0]), 1e-30f), vma = fmaxf(__uint_as_float(vmaxw[64]), 1e-30f);
        if (u.kh == 0) {
            const float rab = vma * __builtin_amdgcn_rcpf(vmb);
#pragma unroll
            for (int ai = 0; ai < 2; ++ai)
#pragma unroll
                for (int m = 0; m < 4; ++m) { const size_t ro = (size_t)(rowb + ai * 128 + m * 16) * 4096 + cb;
#pragma unroll
                    for (int bj = 0; bj < 2; ++bj) { f32x4 a0, a1, b0, b1; unpack8_fp8(*(const u32x2*)((const unsigned char*)ga + ro + bj * 128), a0, a1); unpack8_fp8(*(const u32x2*)((const unsigned char*)gb + ro + bj * 128), b0, b1);
                        f32x4 r0, r1;
#pragma unroll
                        for (int e = 0; e < 4; ++e) { r0[e] = a0[e] * __builtin_amdgcn_rcpf(fmaxf(b0[e], 0.001953125f)); r1[e] = a1[e] * __builtin_amdgcn_rcpf(fmaxf(b1[e], 0.001953125f)); }
                        acc[ai][bj][m][0] = acc[ai][bj][m][0] * (r0 * rab); acc[ai][bj][m][1] = acc[ai][bj][m][1] * (r1 * rab); }
                    asm volatile("" ::: "memory"); }
        } else {
            f32x4 w0[2], w1[2];
#pragma unroll
            for (int bj = 0; bj < 2; ++bj) { const f32x4* p = (const f32x4*)(scol + cb + bj * 128); w0[bj] = p[0]; w1[bj] = p[1]; }
#pragma unroll
            for (int ai = 0; ai < 2; ++ai)
#pragma unroll
                for (int m = 0; m < 4; ++m) { const int row = rowb + ai * 128 + m * 16; const size_t ro = (size_t)row * 4096 + cb; const float rs = vmb * (1.0f / 440.0f);
#pragma unroll
                    for (int bj = 0; bj < 2; ++bj) { f32x4 s0, s1; unpack8_fp8(*(const u32x2*)((const unsigned char*)gb + ro + bj * 128), s0, s1);
                        s0 = s0 * (rs * (1.0f / 256.0f)) * w0[bj]; s1 = s1 * (rs * (1.0f / 256.0f)) * w1[bj];
                        *(u32x4*)(out + ro + bj * 128) = pack8(acc[ai][bj][m][0] * s0, acc[ai][bj][m][1] * s1); } }
        }
    }
};

struct EpiOut {
    static constexpr bool PERM = true, AFTER_DRAIN = false, SPLITK2 = false, FP8 = true;
    const float *x, *meta; float* h1f; bf16_t* h1b; u64* ssq; const float *srow, *scol;
    __device__ __forceinline__ void operator()(const Acc& acc, const Unit& u, int wr, int wc, int fr, int fq) const {
        const int rowb = u.pm * 256 + wr * 64 + fr, cb = u.pn * 256 + wc * 32 + 8 * fq;
#pragma unroll
        for (int ai = 0; ai < 2; ++ai)
#pragma unroll
            for (int m = 0; m < 4; ++m) { const int row = rowb + ai * 128 + m * 16;
                const float* src = x + (size_t)row * DM;
                float s = 0.f; const float rs = srow[row];
#pragma unroll
                for (int bj = 0; bj < 2; ++bj) { const f32x4* wp = (const f32x4*)(scol + cb + bj * 128); f32x4 v0 = acc[ai][bj][m][0] * rs * wp[0], v1 = acc[ai][bj][m][1] * rs * wp[1];
                    v0 = v0 + *(const f32x4*)(src + cb + bj * 128); v1 = v1 + *(const f32x4*)(src + cb + bj * 128 + 4);
                    s += (v0[0] * v0[0] + v0[1] * v0[1]) + (v0[2] * v0[2] + v0[3] * v0[3]) + (v1[0] * v1[0] + v1[1] * v1[1]) + (v1[2] * v1[2] + v1[3] * v1[3]);
                    *(u32x4*)(h1b + (size_t)row * DM + cb + bj * 128) = pack8(v0, v1); }
                s += __shfl_xor(s, 16); s += __shfl_xor(s, 32);
                if (fq == 0 && ssq) ssq_add(ssq + row, s); }
    }
};

struct EpiPQ {
    static constexpr bool PERM = true, AFTER_DRAIN = false, SPLITK2 = false, FP8 = false;
    bf16_t* pq; const u64* ssq;
    __device__ __forceinline__ void operator()(const Acc& acc, const Unit& u, int wr, int wc, int fr, int fq) const {
        const int rowb = u.pm * 256 + wr * 64 + fr, cb = u.pn * 256 + wc * 32 + 8 * fq;
#pragma unroll
        for (int ai = 0; ai < 2; ++ai)
#pragma unroll
            for (int m = 0; m < 4; ++m) { const int row = rowb + ai * 128 + m * 16; const float rs = __builtin_amdgcn_rsqf(ssq_get(ssq + row) * (1.0f / DM) + EPS);
#pragma unroll
                for (int bj = 0; bj < 2; ++bj) *(u32x4*)(pq + (size_t)row * 2048 + cb + bj * 128) = pack8(acc[ai][bj][m][0] * rs, acc[ai][bj][m][1] * rs); }
    }
};
}
#define XB_TMO      128
#define XB_XCNT(j)  (256  + 64 * (j))
#define XB_XSUB(j)  (1280 + 64 * (j))
#define XB_XGEN(j)  (2304 + 64 * (j))
#define XB_TOP      3328
#define XB_TOPGEN   3392
#define XCD_BAR_WORDS 3456
#define XB_SPIN_CAP (1u << 18)
__device__ __forceinline__ unsigned xb_ld(unsigned* p)              { return __hip_atomic_load(p, __ATOMIC_RELAXED, __HIP_MEMORY_SCOPE_AGENT); }
__device__ __forceinline__ unsigned xb_add(unsigned* p, unsigned v) { return __hip_atomic_fetch_add(p, v, __ATOMIC_RELAXED, __HIP_MEMORY_SCOPE_AGENT); }
__device__ __forceinline__ unsigned xb_xcc_id() { return (unsigned)__builtin_amdgcn_s_getreg((3 << 11) | 20) & 0xFu; }
#define XB_SPIN(cond, bar) do { unsigned _sp = 0; while (cond) { __builtin_amdgcn_s_sleep(1); \
    if ((++_sp & 255u) == 0u) { if (xb_ld(&(bar)[XB_TMO])) break; if (_sp > XB_SPIN_CAP) { atomicAdd(&(bar)[XB_TMO], 1u); break; } } } } while (0)
struct XcdBarrier { unsigned* bar; unsigned x; volatile LAS unsigned* st; };
__device__ __forceinline__ XcdBarrier xcd_barrier_post(unsigned* bar, volatile LAS unsigned* st) {
    XcdBarrier b; b.bar = bar; b.x = xb_xcc_id(); b.st = st;
    if (threadIdx.x == 0) (void)xb_add(&bar[XB_XCNT(b.x)], 1u);
    return b;
}
__device__ __forceinline__ void xcd_barrier_complete(unsigned* bar, unsigned x, unsigned& nloc, unsigned& nx) {
    const unsigned G = gridDim.x * gridDim.y * gridDim.z;
    unsigned sum, cnt, mine, sp = 0u;
    for (;;) {
        sum = 0u; cnt = 0u; mine = 0u;
#pragma unroll
        for (unsigned j = 0; j < 16; ++j) { const unsigned c = xb_ld(&bar[XB_XCNT(j)]); sum += c; cnt += (c > 0u) ? 1u : 0u; mine = (j == x) ? c : mine; }
        if (sum == G) break;
        __builtin_amdgcn_s_sleep(1);
        if ((++sp & 255u) == 0u) { if (xb_ld(&bar[XB_TMO])) break; if (sp > XB_SPIN_CAP) { atomicAdd(&bar[XB_TMO], 1u); break; } }
    }
    nloc = mine > 0u ? mine : 1u; nx = cnt > 0u ? cnt : 1u;
}
__device__ __forceinline__ void xcd_barrier(const XcdBarrier& b) {
    asm volatile("s_waitcnt vmcnt(0)" ::: "memory");
    __syncthreads();
    if (threadIdx.x == 0) {
        unsigned* bar = b.bar;
        __builtin_amdgcn_s_waitcnt(0);
        unsigned nloc = b.st[0], nx = b.st[1];
        if (nloc == 0u) { xcd_barrier_complete(bar, b.x, nloc, nx); b.st[0] = nloc; b.st[1] = nx; }
        const unsigned old = xb_add(&bar[XB_XSUB(b.x)], 1u);
        const unsigned gen = old / nloc;
        if (old + 1u == (gen + 1u) * nloc) {
            __builtin_amdgcn_fence(__ATOMIC_RELEASE, "agent");
            asm volatile("s_waitcnt vmcnt(0)" ::: "memory");
            const unsigned og = xb_add(&bar[XB_TOP], 1u);
            const unsigned tg = og / nx;
            if (og + 1u == (tg + 1u) * nx) xb_add(&bar[XB_TOPGEN], 1u);
            else XB_SPIN(xb_ld(&bar[XB_TOPGEN]) == tg, bar);
            __builtin_amdgcn_fence(__ATOMIC_ACQUIRE, "agent");
            xb_add(&bar[XB_XGEN(b.x)], 1u);
            asm volatile("s_waitcnt vmcnt(0)" ::: "memory");
        } else {
            XB_SPIN(xb_ld(&bar[XB_XGEN(b.x)]) == gen, bar);
            __builtin_amdgcn_fence(__ATOMIC_ACQUIRE, "agent");
            asm volatile("s_waitcnt vmcnt(0)" ::: "memory");
        }
    }
    __syncthreads();
}

struct Frame {
    LAS unsigned char* lds;
    unsigned char* ws;
    unsigned* ctl;
    int tid, lane, wave, vcu, G;
    __device__ __forceinline__ const float* in(int i) const { return ((const float* const __attribute__((address_space(4)))*)__builtin_amdgcn_kernarg_segment_ptr())[i]; }
    __device__ __forceinline__ float* out() const { return ((float* const __attribute__((address_space(4)))*)__builtin_amdgcn_kernarg_segment_ptr())[16]; }
};

struct MapId { __device__ __forceinline__ int operator()(int v) const { return v; } };
struct MapIn { __device__ __forceinline__ int operator()(int vn) const {
    const int v = vn < 1280 ? vn + 4608 : (vn < 5888 ? vn - 1280 : vn);
    if (v < 1536) return v;
    if (v < 3584) { const int w = v - 1536, hd = w >> 7; int o = w & 127; if (o < 32) o = (o & 1) ? (o >> 1) + 16 : (o >> 1); return 1600 + hd * 128 + o; }
    if (v < 4096) { const int w = v - 3584, hd = w >> 7; int o = w & 127; if (o < 32) o = (o & 1) ? (o >> 1) + 16 : (o >> 1); return 3648 + hd * 128 + o; }
    if (v < 4608) return 4160 + (v - 4096);
    if (v < 5632) { const int w = v - 4608, hd = w >> 6; int o = w & 63; if (o < 16) o = (o & 1) ? (o >> 1) + 8 : (o >> 1); return 4672 + hd * 64 + o; }
    if (v < 5888) { const int w = v - 5632;
        if (w < 64) return 1536 + ((w & 1) ? (w >> 1) + 32 : (w >> 1));
        if (w < 128) { int o = w - 64; if (o < 16) o = (o & 1) ? (o >> 1) + 8 : (o >> 1); return 5696 + o; }
        if (w < 144) return 5760 + (w - 128);
        return -1; }
    if (v < 9984) return 5776 + (v - 5888);
    return 9872 + (v - 9984);
} };
struct MapUq { __device__ __forceinline__ int operator()(int v) const {
    if (v < 2048) return (v >> 7) * 192 + (v & 127);
    const int w = v - 2048, hd = w >> 6, o = w & 63; return hd * 192 + 128 + ((o & 1) ? (o >> 1) + 32 : (o >> 1)); } };
struct MapUkv { __device__ __forceinline__ int operator()(int v) const {
    if (v < 2048) return (v >> 7) * 256 + (v & 127);
    const int w = v - 2048; return (w >> 7) * 256 + 128 + (w & 127); } };

template <class Map>
__device__ __forceinline__ void p0_transpose_item(const float* W, int K, int Nsrc, int Nvirt, bf16_t* WT, const float* gk, LAS float* scr, int item, int lane, Map map) {
    const int nblk = Nvirt / 32, kb = item / nblk, nb = item % nblk, k0 = 64 * kb, n0 = 32 * nb;
    const int sc = map(n0 + (lane & 31));
    float tv[32];
#pragma unroll
    for (int i = 0; i < 32; ++i) { const int kk = 2 * i + (lane >> 5); tv[i] = (sc >= 0) ? W[(size_t)(k0 + kk) * Nsrc + sc] : 0.f; }
    if (gk) {
#pragma unroll
        for (int i = 0; i < 32; ++i) tv[i] *= gk[k0 + 2 * i + (lane >> 5)]; }
#pragma unroll
    for (int i = 0; i < 32; ++i) scr[(2 * i + (lane >> 5)) * 33 + (lane & 31)] = tv[i];
    LDS_WAIT(); asm volatile("" ::: "memory");
    const int c = lane & 7;
#pragma unroll
    for (int j = 0; j < 4; ++j) { const int n = (lane >> 3) + 8 * j; const LAS float* s = scr + (8 * c) * 33 + n;
        u32x4 o; o.x = pk2(s[0 * 33], s[1 * 33]); o.y = pk2(s[2 * 33], s[3 * 33]); o.z = pk2(s[4 * 33], s[5 * 33]); o.w = pk2(s[6 * 33], s[7 * 33]);
        *(u32x4*)(WT + (size_t)(n0 + n) * K + k0 + 8 * c) = o; }
    LDS_WAIT(); asm volatile("" ::: "memory");
}
__device__ __forceinline__ float wave_max(float v) {
#pragma unroll
    for (int o = 1; o < 64; o <<= 1) v = fmaxf(v, __shfl_xor(v, o));
    return v;
}
__device__ __forceinline__ void p0_xn_row(const Frame& F, int m) {
    const float* x = F.in(0); const float* meta = F.in(1); const float* g = F.in(2);
    bf16_t* o = (bf16_t*)(F.ws + WS_XN) + (size_t)m * DM;
    u32x2* o8 = (u32x2*)o + F.lane;
    if (m >= NTOK + NMETA) {
        unsigned* z8 = (unsigned*)(F.ws + WS_XN8 + (size_t)m * DM) + F.lane;
#pragma unroll
        for (int j = 0; j < 16; ++j) { o8[64 * j] = (u32x2){0u, 0u}; z8[64 * j] = 0u; }
        if (F.lane == 0) ((float*)(F.ws + WS_SX))[m] = 0.f;
        return; }
    const float* src = m < NTOK ? x + (size_t)m * DM : meta + (size_t)(m - NTOK) * DM;
    const f32x4* xr = (const f32x4*)src + F.lane; const f32x4* gr = (const f32x4*)g + F.lane;
    f32x4 v[16]; float s = 0.f;
#pragma unroll
    for (int j = 0; j < 16; ++j) { v[j] = xr[64 * j]; s += (v[j][0] * v[j][0] + v[j][1] * v[j][1]) + (v[j][2] * v[j][2] + v[j][3] * v[j][3]); }
    const float rstd = 1.0f / sqrtf(wave_sum(s) * (1.0f / DM) + EPS);
    float mx = 0.f;
#pragma unroll
    for (int j = 0; j < 16; ++j) { const f32x4 gg = gr[64 * j]; v[j] = v[j] * rstd * gg; o8[64 * j] = (u32x2){pk2(v[j][0], v[j][1]), pk2(v[j][2], v[j][3])};
        mx = fmaxf(mx, fmaxf(fmaxf(fabsf(v[j][0]), fabsf(v[j][1])), fmaxf(fabsf(v[j][2]), fabsf(v[j][3])))); }
    mx = fmaxf(wave_max(mx), 1e-30f);
    const float inv = 448.0f / mx;
    if (F.lane == 0) ((float*)(F.ws + WS_SX))[m] = mx * (1.0f / 448.0f);
    unsigned* q8 = (unsigned*)(F.ws + WS_XN8 + (size_t)m * DM) + F.lane;
#pragma unroll
    for (int j = 0; j < 16; ++j) { f32x4 q = v[j] * inv;
#pragma unroll
        for (int e = 0; e < 4; ++e) q[e] = fminf(fmaxf(q[e], -448.0f), 448.0f);
        int p = 0; p = __builtin_amdgcn_cvt_pk_fp8_f32(q[0], q[1], p, false); p = __builtin_amdgcn_cvt_pk_fp8_f32(q[2], q[3], p, true); q8[64 * j] = (unsigned)p; }
}
__device__ __forceinline__ void p0_prologue(const Frame& F) {
    LAS float* scr = (LAS float*)(F.lds + F.wave * 16384);
    const int gw = F.vcu * NWAVES + F.wave, NGW = F.G * NWAVES;
    const float* w_in = F.in(3); const float* qg = F.in(4); const float* w_uq = F.in(5); const float* kvg = F.in(6); const float* w_ukv = F.in(7);
    const float* w_br = F.in(8); const float* w_out = F.in(9); const float* fg = F.in(10); const float* w_q = F.in(11); const float* sk = F.in(12);
    constexpr int I_IN = 64 * (NV1 / 32), I_UQ = 16 * (3072 / 32), I_UKV = 8 * (4096 / 32), I_BR = 64 * 128, I_OUT = 64 * 128, I_Q = 64 * 64;
    constexpr int NITEMS = I_IN + I_UQ + I_UKV + I_BR + I_OUT + I_Q;
    for (int it = gw; it < NITEMS; it += NGW) {
        int r = it;
        if (r < I_IN) { p0_transpose_item(w_in, 4096, 13968, NV1, (bf16_t*)(F.ws + WS_WIN), nullptr, scr, r, F.lane, MapIn()); continue; } r -= I_IN;
        if (r < I_UQ) { p0_transpose_item(w_uq, 1024, 3072, 3072, (bf16_t*)(F.ws + WS_WUQ), qg, scr, r, F.lane, MapUq()); continue; } r -= I_UQ;
        if (r < I_UKV) { p0_transpose_item(w_ukv, 512, 4096, 4096, (bf16_t*)(F.ws + WS_WUKV), kvg, scr, r, F.lane, MapUkv()); continue; } r -= I_UKV;
        if (r < I_BR) { p0_transpose_item(w_br, 4096, 4096, 4096, (bf16_t*)(F.ws + WS_H1F), nullptr, scr, r, F.lane, MapId()); continue; } r -= I_BR;
        if (r < I_OUT) { p0_transpose_item(w_out, 4096, 4096, 4096, (bf16_t*)(F.ws + WS_WOUT), nullptr, scr, r, F.lane, MapId()); continue; } r -= I_OUT;
        p0_transpose_item(w_q, 4096, 2048, 2048, (bf16_t*)(F.ws + WS_WQ), fg, scr, r, F.lane, MapId());
    }
    for (int m = gw; m < MK; m += NGW) p0_xn_row(F, m);
    const int gt = (F.vcu * NWAVES + F.wave) * 64 + F.lane, NGT = NGW * 64;
    for (int i = gt; i < TP * 56; i += NGT) {
        const int t = i / 56, r = i % 56; int j, rot; float* dst;
        if (r < 32) { j = r; rot = 64; dst = (float*)(F.ws + WS_ROPE_M) + ((size_t)t * 32 + j) * 2; }
        else if (r < 48) { j = r - 32; rot = 32; dst = (float*)(F.ws + WS_ROPE_D) + ((size_t)t * 16 + j) * 2; }
        else { j = r - 48; rot = 16; dst = (float*)(F.ws + WS_ROPE_I) + ((size_t)t * 8 + j) * 2; }
        const float ex = (float)(2 * j) / (float)rot;
        const float inv = powf(500000.0f, -ex);
        const float ang = (float)t * inv;
        const double a = (double)ang, kq = rint(a * 0.15915494309189535), rr = fma(-kq, 6.283185307179586, a);
        const float rf = (float)rr;
        dst[0] = cosf(rf); dst[1] = sinf(rf);
    }
    for (int i = gt; i < 16 * 128 * 128 / 8; i += NGT) { const f32x4* s = (const f32x4*)sk + 2 * (size_t)i; const f32x4 a = s[0], b2 = s[1];
        u32x4 o; o.x = pk2(a[0], a[1]); o.y = pk2(a[2], a[3]); o.z = pk2(b2[0], b2[1]); o.w = pk2(b2[2], b2[3]); ((u32x4*)(F.ws + WS_SK))[i] = o; }
}
__device__ __forceinline__ unsigned fp6_code(float q) {
    const unsigned b = __float_as_uint(q), sgn = (b >> 31) << 5; const float aq = fabsf(q);
    const unsigned sub = (unsigned)rintf(aq * 8.0f);
    unsigned ab = b & 0x7fffffffu; ab = ab + 0x7FFFFu + ((ab >> 20) & 1u);
    const unsigned nrm = (ab >> 20) - (126u << 3);
    unsigned code = aq < 1.0f ? sub : nrm; code = code > 31u ? 31u : code;
    return code | sgn;
}
__device__ __forceinline__ void fp6_pack32(const unsigned (&c)[32], unsigned (&w)[6]) {
#pragma unroll
    for (int i = 0; i < 6; ++i) w[i] = 0u;
#pragma unroll
    for (int k = 0; k < 32; ++k) { const int bit = 6 * k, d = bit >> 5, sh = bit & 31; w[d] |= c[k] << sh; if (sh > 26) w[d + 1] |= c[k] >> (32 - sh); }
}
__device__ __forceinline__ void p6_quant_row(const float* src, const float* gain, unsigned char* dst, float* scale_out, int lane) {
    const f32x4* s = (const f32x4*)src + lane; f32x4 v[16]; float mx = 0.f;
#pragma unroll
    for (int j = 0; j < 16; ++j) { v[j] = s[64 * j]; if (gain) v[j] = v[j] * ((const f32x4*)gain)[lane + 64 * j];
        mx = fmaxf(mx, fmaxf(fmaxf(fabsf(v[j][0]), fabsf(v[j][1])), fmaxf(fabsf(v[j][2]), fabsf(v[j][3])))); }
    mx = fmaxf(wave_max(mx), 1e-30f);
    const float sc = mx * (1.0f / 7.5f), inv = 7.5f / mx;
    if (lane == 0) *scale_out = sc;
    unsigned w[12];
#pragma unroll
    for (int g = 0; g < 2; ++g) { unsigned c[32];
#pragma unroll
        for (int j = 0; j < 8; ++j)
#pragma unroll
            for (int i = 0; i < 4; ++i) c[4 * j + i] = fp6_code(v[8 * g + j][i] * inv);
        unsigned ww[6]; fp6_pack32(c, ww);
#pragma unroll
        for (int i = 0; i < 6; ++i) w[6 * g + i] = ww[i]; }
#pragma unroll
    for (int q = 0; q < 3; ++q) *(u32x4*)(dst + 1024 * q + 16 * lane) = (u32x4){w[4 * q], w[4 * q + 1], w[4 * q + 2], w[4 * q + 3]};
}
__device__ __forceinline__ unsigned fp4_code(float q) {
    const float aq = fabsf(q);
    const unsigned c = (aq > 0.25f ? 1u : 0u) + (aq >= 0.75f ? 1u : 0u) + (aq > 1.25f ? 1u : 0u) + (aq >= 1.75f ? 1u : 0u) + (aq > 2.5f ? 1u : 0u) + (aq >= 3.5f ? 1u : 0u) + (aq > 5.0f ? 1u : 0u);
    return c | ((__float_as_uint(q) >> 31) << 3);
}
__device__ __forceinline__ void p6_quant_row4(const float* src, const float* gain, unsigned char* dst, float* scale_out, int lane) {
    const f32x4* s = (const f32x4*)src + lane; f32x4 v[16]; float mx = 0.f;
#pragma unroll
    for (int j = 0; j < 16; ++j) { v[j] = s[64 * j]; if (gain) v[j] = v[j] * ((const f32x4*)gain)[lane + 64 * j];
        mx = fmaxf(mx, fmaxf(fmaxf(fabsf(v[j][0]), fabsf(v[j][1])), fmaxf(fabsf(v[j][2]), fabsf(v[j][3])))); }
    mx = fmaxf(wave_max(mx), 1e-30f);
    const float sc = mx * (1.0f / 6.0f), inv = 6.0f / mx;
    if (lane == 0) *scale_out = sc;
    unsigned w[8];
#pragma unroll
    for (int d = 0; d < 8; ++d) { unsigned x = 0u;
#pragma unroll
        for (int i = 0; i < 4; ++i) { x |= fp4_code(v[2 * d][i] * inv) << (4 * i); x |= fp4_code(v[2 * d + 1][i] * inv) << (16 + 4 * i); }
        w[d] = x; }
#pragma unroll
    for (int q = 0; q < 2; ++q) *(u32x4*)(dst + 1024 * q + 16 * lane) = (u32x4){w[4 * q], w[4 * q + 1], w[4 * q + 2], w[4 * q + 3]};
}
#ifndef PEER_U_BITS
#define PEER_U_BITS 4
#endif
#ifndef PEER_V_BITS
#define PEER_V_BITS 4
#endif
constexpr int PEER_U_ROWB = PEER_U_BITS == 4 ? 2048 : 3072, PEER_V_ROWB = PEER_V_BITS == 4 ? 2048 : 3072;
__device__ __forceinline__ void p6_quant_regs4(f32x4 (&v)[16], unsigned char* dst, float* scale_out, int lane) {
    float mx = 0.f;
#pragma unroll
    for (int j = 0; j < 16; ++j) mx = fmaxf(mx, fmaxf(fmaxf(fabsf(v[j][0]), fabsf(v[j][1])), fmaxf(fabsf(v[j][2]), fabsf(v[j][3]))));
    mx = fmaxf(wave_max(mx), 1e-30f);
    const float inv = 6.0f / mx;
    if (lane == 0) *scale_out = mx * (1.0f / 6.0f);
    unsigned w[8];
#pragma unroll
    for (int d = 0; d < 8; ++d) { unsigned x = 0u;
#pragma unroll
        for (int i = 0; i < 4; ++i) { x |= fp4_code(v[2 * d][i] * inv) << (4 * i); x |= fp4_code(v[2 * d + 1][i] * inv) << (16 + 4 * i); }
        w[d] = x; }
#pragma unroll
    for (int q = 0; q < 2; ++q) *(u32x4*)(dst + 1024 * q + 16 * lane) = (u32x4){w[4 * q], w[4 * q + 1], w[4 * q + 2], w[4 * q + 3]};
}
__device__ __forceinline__ void p6_tables(const Frame& F) {
    const float* fg = F.in(10); const float* pu = F.in(13); const float* pv = F.in(14);
    const int gw = F.vcu * NWAVES + F.wave, NGW = F.G * NWAVES, lane = F.lane;
#if PEER_U_BITS == 4 && PEER_V_BITS == 4
    if ((NGW & 1) == 0) {
        const bool isv = gw & 1; const float* tab = isv ? pv : pu; unsigned char* dtab = F.ws + (isv ? WS_V : WS_U); float* stab = (float*)(F.ws + (isv ? WS_SCV : WS_SCU));
        const int e0 = gw >> 1, estep = NGW >> 1;
        f32x4 g[16];
#pragma unroll
        for (int j = 0; j < 16; ++j) g[j] = isv ? (f32x4){1.f, 1.f, 1.f, 1.f} : ((const f32x4*)fg)[lane + 64 * j];
        f32x4 va[16], vb[16];
        if (e0 < 16384) {
#pragma unroll
            for (int j = 0; j < 16; ++j) va[j] = ((const f32x4*)(tab + (size_t)e0 * DM))[lane + 64 * j];
        }
#pragma unroll 1
        for (int e = e0; e < 16384; e += 2 * estep) {
            const int e1 = e + estep, e2 = e + 2 * estep;
            if (e1 < 16384) {
#pragma unroll
                for (int j = 0; j < 16; ++j) vb[j] = ((const f32x4*)(tab + (size_t)e1 * DM))[lane + 64 * j];
            }
#pragma unroll
            for (int j = 0; j < 16; ++j) va[j] = va[j] * g[j];
            p6_quant_regs4(va, dtab + (size_t)e * 2048, stab + e, lane);
            if (e2 < 16384) {
#pragma unroll
                for (int j = 0; j < 16; ++j) va[j] = ((const f32x4*)(tab + (size_t)e2 * DM))[lane + 64 * j];
            }
            if (e1 < 16384) {
#pragma unroll
                for (int j = 0; j < 16; ++j) vb[j] = vb[j] * g[j];
                p6_quant_regs4(vb, dtab + (size_t)e1 * 2048, stab + e1, lane);
            }
        }
        return;
    }
#endif
    for (int it = gw; it < 2 * 16384; it += NGW) { const int e = it >> 1;
        if (it & 1) { if (PEER_V_BITS == 4) p6_quant_row4(pv + (size_t)e * DM, nullptr, F.ws + WS_V + (size_t)e * PEER_V_ROWB, (float*)(F.ws + WS_SCV) + e, F.lane);
                      else p6_quant_row(pv + (size_t)e * DM, nullptr, F.ws + WS_V + (size_t)e * PEER_V_ROWB, (float*)(F.ws + WS_SCV) + e, F.lane); }
        else { if (PEER_U_BITS == 4) p6_quant_row4(pu + (size_t)e * DM, fg, F.ws + WS_U + (size_t)e * PEER_U_ROWB, (float*)(F.ws + WS_SCU) + e, F.lane);
               else p6_quant_row(pu + (size_t)e * DM, fg, F.ws + WS_U + (size_t)e * PEER_U_ROWB, (float*)(F.ws + WS_SCU) + e, F.lane); } }
}

__device__ __forceinline__ void rowquant_fp8(const Frame& F, const unsigned char* src, size_t src_pitch, unsigned char* dst, size_t dst_pitch, float* scale, int nrows) {
    const int gw = F.vcu * NWAVES + F.wave, NGW = F.G * NWAVES, lane = F.lane;
    for (int n = gw; n < nrows; n += NGW) {
        const u32x4* s = (const u32x4*)(src + (size_t)n * src_pitch) + lane;
        u32x4 v[8]; float mx = 0.f;
#pragma unroll
        for (int j = 0; j < 8; ++j) { v[j] = s[64 * j];
#pragma unroll
            for (int e = 0; e < 4; ++e) mx = fmaxf(mx, fmaxf(fabsf(bf_lo(v[j][e])), fabsf(bf_hi(v[j][e])))); }
        mx = fmaxf(wave_max(mx), 1e-30f);
        const float inv = 448.0f / mx;
        if (lane == 0) scale[n] = mx * (1.0f / 448.0f);
        asm volatile("" ::: "memory");
        u32x2* d = (u32x2*)(dst + (size_t)n * dst_pitch) + lane;
#pragma unroll
        for (int j = 0; j < 8; ++j) { int p0 = 0, p1 = 0;
            p0 = __builtin_amdgcn_cvt_pk_fp8_f32(bf_lo(v[j].x) * inv, bf_hi(v[j].x) * inv, p0, false); p0 = __builtin_amdgcn_cvt_pk_fp8_f32(bf_lo(v[j].y) * inv, bf_hi(v[j].y) * inv, p0, true);
            p1 = __builtin_amdgcn_cvt_pk_fp8_f32(bf_lo(v[j].z) * inv, bf_hi(v[j].z) * inv, p1, false); p1 = __builtin_amdgcn_cvt_pk_fp8_f32(bf_lo(v[j].w) * inv, bf_hi(v[j].w) * inv, p1, true);
            d[64 * j] = (u32x2){(unsigned)p0, (unsigned)p1}; }
    }
}
template <int LEN>
__device__ __forceinline__ void rowquant_fp8_n(const Frame& F, const unsigned char* src, unsigned char* dst, float* scale, int nrows) {
    const int gw = F.vcu * NWAVES + F.wave, NGW = F.G * NWAVES, lane = F.lane; constexpr int PER = LEN / 64;
    for (int n = gw; n < nrows; n += NGW) {
        const u32x4* s = (const u32x4*)(src + (size_t)n * LEN * 2) + lane * (PER / 8);
        u32x4 v[PER / 8]; float mx = 0.f;
#pragma unroll
        for (int j = 0; j < PER / 8; ++j) { v[j] = s[j];
#pragma unroll
            for (int e = 0; e < 4; ++e) mx = fmaxf(mx, fmaxf(fabsf(bf_lo(v[j][e])), fabsf(bf_hi(v[j][e])))); }
        mx = fmaxf(wave_max(mx), 1e-30f);
        const float inv = 448.0f / mx;
        if (lane == 0) scale[n] = mx * (1.0f / 448.0f);
        u32x2* d = (u32x2*)(dst + (size_t)n * LEN) + lane * (PER / 8);
#pragma unroll
        for (int j = 0; j < PER / 8; ++j) { int p0 = 0, p1 = 0;
            p0 = __builtin_amdgcn_cvt_pk_fp8_f32(bf_lo(v[j].x) * inv, bf_hi(v[j].x) * inv, p0, false); p0 = __builtin_amdgcn_cvt_pk_fp8_f32(bf_lo(v[j].y) * inv, bf_hi(v[j].y) * inv, p0, true);
            p1 = __builtin_amdgcn_cvt_pk_fp8_f32(bf_lo(v[j].z) * inv, bf_hi(v[j].z) * inv, p1, false); p1 = __builtin_amdgcn_cvt_pk_fp8_f32(bf_lo(v[j].w) * inv, bf_hi(v[j].w) * inv, p1, true);
            d[j] = (u32x2){(unsigned)p0, (unsigned)p1}; }
    }
}
__device__ __forceinline__ void p1_quant_weights(const Frame& F) {
    rowquant_fp8(F, F.ws + WS_WIN + (size_t)1280 * DM * 2, (size_t)DM * 2, F.ws + WS_WG8, (size_t)DM, (float*)(F.ws + WS_SW), 12800);
    rowquant_fp8(F, F.ws + WS_H1F, (size_t)DM * 2, F.ws + WS_WBR, (size_t)DM, (float*)(F.ws + WS_SWBR), 4096);
    rowquant_fp8(F, F.ws + WS_WOUT, (size_t)DM * 2, F.ws + WS_WOUT, (size_t)DM * 2, (float*)(F.ws + WS_SWOUT), 4096);
    rowquant_fp8_n<1024>(F, F.ws + WS_WUQ, F.ws + WS_WUQ8, (float*)(F.ws + WS_SWUQ), 3072);
    rowquant_fp8_n<512>(F, F.ws + WS_WUKV, F.ws + WS_WUKV8, (float*)(F.ws + WS_SWUKV), 4096);
}
#define MFMA32(a, b, c) __builtin_amdgcn_mfma_f32_32x32x16_bf16((a), (b), (c), 0, 0, 0)
__device__ __forceinline__ float relu_i(float x) { const int v = __float_as_int(x); return __int_as_float(v > 0 ? v : 0); }
__device__ __forceinline__ int crow(int i, int h) { return (i & 3) + 8 * (i >> 2) + 4 * h; }
__device__ __forceinline__ float half_sum_f(float v) {
#pragma unroll
    for (int o = 1; o < 32; o <<= 1) v += __shfl_xor(v, o);
    return v;
}
__device__ __forceinline__ int half_sum_i(int v) {
#pragma unroll
    for (int o = 1; o < 32; o <<= 1) v += __shfl_xor(v, o);
    return v;
}
__device__ __forceinline__ float half_max_f(float v) {
#pragma unroll
    for (int o = 1; o < 32; o <<= 1) v = fmaxf(v, __shfl_xor(v, o));
    return v;
}
__device__ __forceinline__ float half_min_f(float v) {
#pragma unroll
    for (int o = 1; o < 32; o <<= 1) v = fminf(v, __shfl_xor(v, o));
    return v;
}
constexpr int IDX_PK = 144, IDX_BUF = 64 * IDX_PK;
__device__ __forceinline__ void idx_task(const Frame& F, int b, int s0c) {
    const int lane = F.lane, r = lane & 31, h = lane >> 5, tid = F.tid;
    const int s0 = s0c + 2 * F.wave;
    LAS unsigned char* lds = F.lds;
    const bf16_t* qix = (const bf16_t*)(F.ws + WS_QIX); const bf16_t* kix = (const bf16_t*)(F.ws + WS_KIX); const float* wix = (const float*)(F.ws + WS_WIX);
    unsigned* mask = (unsigned*)(F.ws + WS_MASK);
    const int tok = (r >> 2) & 1, head = (r & 3) + 4 * (r >> 3);
    const bf16_t* qp = qix + (size_t)(b * SEQ + s0 + tok) * 1024 + head * 64 + 8 * h;
    bf16x8 af[4];
#pragma unroll
    for (int ks = 0; ks < 4; ++ks) af[ks] = *(const bf16x8*)(qp + 16 * ks);
    const f32x4* wp = (const f32x4*)(wix + (size_t)(b * SEQ + s0 + h) * 16);
    float w[16];
#pragma unroll
    for (int q = 0; q < 4; ++q) { const f32x4 x = wp[q]; w[4 * q] = x[0]; w[4 * q + 1] = x[1]; w[4 * q + 2] = x[2]; w[4 * q + 3] = x[3]; }
    const int tq = NMETA + s0 + h;
    int tqr = tq - r; asm volatile("" : "+v"(tqr));
    const int ngrp = ((NMETA + s0c + 15) >> 6) + 1;
    const int skey = tid >> 3, spc = tid & 7;
    int brow = b * SEQ - NMETA; asm volatile("" : "+s"(brow));
    const bf16_t* kcur = kix + ((long)brow + skey) * 64 + spc * 8;
    const int sdst = skey * IDX_PK + spc * 16;
    const int boff = r * IDX_PK + 16 * h;
    u32x4 kst = *(const u32x4*)(skey < NMETA ? kix + (size_t)(NTOK + skey) * 64 + spc * 8 : kcur);
    float row[MW];
#pragma unroll
    for (int g = 0; g < MW / 2; ++g) {
        float s0v = -INFINITY, s1v = -INFINITY;
        const int bo = (g & 1) * IDX_BUF;
        if (g < ngrp) *(LAS u32x4*)(lds + bo + sdst) = kst;
        __syncthreads();
        kcur += 64 * 64; asm volatile("" : "+v"(kcur));
        if (g + 1 < ngrp) kst = *(const u32x4*)kcur;
        if (g < ngrp) {
            float x0 = 0.f, x1 = 0.f;
            { bf16x8 bb[4]; f32x16 a0;
#pragma unroll
              for (int ks = 0; ks < 4; ++ks) bb[ks] = *(const LAS bf16x8*)(lds + bo + boff + 32 * ks);
#pragma unroll
              for (int i = 0; i < 16; ++i) a0[i] = 0.f;
#pragma unroll
              for (int ks = 0; ks < 4; ++ks) a0 = MFMA32(af[ks], bb[ks], a0);
#pragma unroll
              for (int i = 0; i < 16; ++i) x0 += w[i] * relu_i(a0[i]); }
            asm volatile("" : "+v"(x0));
            asm volatile("" ::: "memory");
            { bf16x8 bb[4]; f32x16 a1;
#pragma unroll
              for (int ks = 0; ks < 4; ++ks) bb[ks] = *(const LAS bf16x8*)(lds + bo + boff + 32 * IDX_PK + 32 * ks);
#pragma unroll
              for (int i = 0; i < 16; ++i) a1[i] = 0.f;
#pragma unroll
              for (int ks = 0; ks < 4; ++ks) a1 = MFMA32(af[ks], bb[ks], a1);
#pragma unroll
              for (int i = 0; i < 16; ++i) x1 += w[i] * relu_i(a1[i]); }
            s0v = (g * 64 <= tqr) ? x0 : -INFINITY; s1v = (g * 64 + 32 <= tqr) ? x1 : -INFINITY;
        }
        row[2 * g] = s0v; row[2 * g + 1] = s1v;
    }
    float tau = -3.0e38f;
    bool done = (tq + 1 <= 256);
    float mx = -INFINITY, mn = INFINITY;
#pragma unroll
    for (int k = 0; k < MW; ++k) { const float v = row[k]; mx = fmaxf(mx, v); mn = fminf(mn, v > -INFINITY ? v : INFINITY); }
    float lo = half_min_f(mn), hi = half_max_f(mx);
    if (!done) tau = hi;
    for (int it = 0; it < 64; ++it) {
        if (!__any(!done)) break;
        const float mid = lo + (hi - lo) * 0.5f;
        int c = 0;
#pragma unroll
        for (int k = 0; k < MW; ++k) c += (row[k] >= mid) ? 1 : 0;
        c = half_sum_i(c);
        if (!done) {
            if (!(mid > lo && mid < hi)) { tau = hi; done = true; }
            else if (c == 256) { tau = mid; done = true; }
            else if (c > 256) lo = mid;
            else { hi = mid; tau = hi; }
        }
    }
    unsigned* mrow = mask + (size_t)(b * SEQ + s0 + h) * MW;
    unsigned mw = 0u;
#pragma unroll
    for (int k = 0; k < MW; ++k) {
        const unsigned long long bal = __ballot(row[k] >= tau);
        const unsigned wd = h ? (unsigned)(bal >> 32) : (unsigned)bal;
        if ((k & 31) == r) mw = wd;
        if ((k & 31) == 31 || k == MW - 1) { const int kk = (k & ~31) + r; if (kk < MW) mrow[kk] = mw; }
    }
}
__device__ __forceinline__ void p2_indexer(const Frame& F, int qslot) {
    volatile LAS unsigned* qw = (volatile LAS unsigned*)(F.lds + LDSCTL_OFF + 16);
    constexpr int NCH = NTOK / 16;
    for (;;) {
        if (F.tid == 0) qw[0] = atomicAdd(F.ctl + CW_QUEUE + 64 * qslot, 1u);
        __syncthreads();
        const int c = __builtin_amdgcn_readfirstlane((int)qw[0]);
        __syncthreads();
        if (c >= NCH) break;
        const int b = c & 3, tblk = (SEQ / 16 - 1) - (c >> 2);
        idx_task(F, b, tblk * 16);
    }
}
template <bool MLA> struct AttnCfg {
    static constexpr int DQK = MLA ? 192 : 128, NKS = DQK / 64, PK = DQK + 16  , PV = 144  , KBYTES = 64 * PK, VBYTES = 64 * PV, VBASE = 2 * KBYTES;
};
struct AttnUnit { int type, b, hx, blk; };
typedef int i32x8 __attribute__((ext_vector_type(8)));
typedef int i32x4 __attribute__((ext_vector_type(4)));
typedef int i32x2_t __attribute__((ext_vector_type(2)));
__device__ __forceinline__ i32x8 cat4(i32x4 a, i32x4 b) { return __builtin_shufflevector(a, b, 0, 1, 2, 3, 4, 5, 6, 7); }
template <int NKS> __device__ __forceinline__ void qk_block(f32x16& s, const i32x8 (&k)[NKS], const i32x8 (&q)[NKS]) {
#if defined(__HIP_DEVICE_COMPILE__)
    int sc = 0x7F7F7F7F;
    if constexpr (NKS == 3)
        asm volatile("s_nop 1\n\tv_mfma_scale_f32_32x32x64_f8f6f4 %0, %1, %4, 0, %7, %7 op_sel_hi:[0,0,0]\n\ts_nop 3\n\tv_mfma_scale_f32_32x32x64_f8f6f4 %0, %2, %5, %0, %7, %7 op_sel_hi:[0,0,0]\n\ts_nop 3\n\t"
                     "v_mfma_scale_f32_32x32x64_f8f6f4 %0, %3, %6, %0, %7, %7 op_sel_hi:[0,0,0]\n\ts_nop 15\n\ts_nop 7"
                     : "=&v"(s) : "v"(k[0]), "v"(k[1]), "v"(k[2]), "v"(q[0]), "v"(q[1]), "v"(q[2]), "v"(sc));
    else
        asm volatile("s_nop 1\n\tv_mfma_scale_f32_32x32x64_f8f6f4 %0, %1, %3, 0, %5, %5 op_sel_hi:[0,0,0]\n\ts_nop 3\n\tv_mfma_scale_f32_32x32x64_f8f6f4 %0, %2, %4, %0, %5, %5 op_sel_hi:[0,0,0]\n\ts_nop 15\n\ts_nop 7"
                     : "=&v"(s) : "v"(k[0]), "v"(k[1]), "v"(q[0]), "v"(q[1]), "v"(sc));
#else
    (void)s; (void)k; (void)q;
#endif
}

__device__ __forceinline__ void pv_block(f32x16& o0, f32x16& o1, f32x16& o2, f32x16& o3, const i32x8 v0, const i32x8 v1, const i32x8 v2, const i32x8 v3, const i32x8 p) {
#if defined(__HIP_DEVICE_COMPILE__)
    int sc = 0x7F7F7F7F;
    asm volatile("s_nop 1\n\tv_mfma_scale_f32_32x32x64_f8f6f4 %0, %4, %8, %0, %9, %9 op_sel_hi:[0,0,0]\n\tv_mfma_scale_f32_32x32x64_f8f6f4 %1, %5, %8, %1, %9, %9 op_sel_hi:[0,0,0]\n\t"
                 "v_mfma_scale_f32_32x32x64_f8f6f4 %2, %6, %8, %2, %9, %9 op_sel_hi:[0,0,0]\n\tv_mfma_scale_f32_32x32x64_f8f6f4 %3, %7, %8, %3, %9, %9 op_sel_hi:[0,0,0]\n\ts_nop 15\n\ts_nop 7"
                 : "+v"(o0), "+v"(o1), "+v"(o2), "+v"(o3) : "v"(v0), "v"(v1), "v"(v2), "v"(v3), "v"(p), "v"(sc));
#else
    (void)o0; (void)o1; (void)o2; (void)o3; (void)v0; (void)v1; (void)v2; (void)v3; (void)p;
#endif
}
__device__ __forceinline__ int pk4_fp8(float a, float b, float c, float d) { int p = 0; p = __builtin_amdgcn_cvt_pk_fp8_f32(a, b, p, false); return __builtin_amdgcn_cvt_pk_fp8_f32(c, d, p, true); }

template <int PVB>
__device__ __forceinline__ void pv_tile(f32x16 (&oacc)[4], LAS unsigned char* lds, int vb, int voff, const i32x8 pf) {
    i32x8 vf[4];
#pragma unroll
    for (int d = 0; d < 4; ++d) {
        const i32x2_t t0 = __builtin_amdgcn_ds_read_tr8_b64_v2i32((LAS i32x2_t*)(lds + vb + voff + 32 * d));
        const i32x2_t t1 = __builtin_amdgcn_ds_read_tr8_b64_v2i32((LAS i32x2_t*)(lds + vb + voff + 16 * PVB + 32 * d));
        const i32x2_t t2 = __builtin_amdgcn_ds_read_tr8_b64_v2i32((LAS i32x2_t*)(lds + vb + voff + 32 * PVB + 32 * d));
        const i32x2_t t3 = __builtin_amdgcn_ds_read_tr8_b64_v2i32((LAS i32x2_t*)(lds + vb + voff + 48 * PVB + 32 * d));
        vf[d] = (i32x8){t0.x, t0.y, t1.x, t1.y, t2.x, t2.y, t3.x, t3.y}; }
    pv_block(oacc[0], oacc[1], oacc[2], oacc[3], vf[0], vf[1], vf[2], vf[3], pf);
}

template <bool MLA>
__device__ __forceinline__ void attn_unit(const Frame& F, const AttnUnit u) {
    typedef AttnCfg<MLA> C;
    const int tid = F.tid, lane = F.lane, wave = F.wave, r = lane & 31, h = lane >> 5;
    LAS unsigned char* lds = F.lds;
    const unsigned char* qn8 = F.ws + WS_QN; const unsigned char* qr8 = F.ws + WS_QR; const unsigned char* kn8 = F.ws + WS_KN; const unsigned char* kpe8 = F.ws + WS_KPE;
    const unsigned char* qb8 = F.ws + WS_QB; const unsigned char* kb8 = F.ws + WS_KB;
    const unsigned char* va8 = F.ws + WS_VA; const unsigned char* vb8 = F.ws + WS_VB;
    const unsigned* mask = (const unsigned*)(F.ws + WS_MASK);
    const int b = u.b;
    const size_t rowb = (size_t)b * SEQ;
    int head, tw0, ntiles;
    if (MLA) { head = u.hx; tw0 = u.blk * 256 + 32 * wave; ntiles = (NMETA + u.blk * 256 + 255) / 64 + 1; }
    else { head = 4 * u.hx + (wave & 3); tw0 = u.blk * 64 + 32 * (wave >> 2); ntiles = (NMETA + u.blk * 64 + 63) / 64 + 1; }
    const int pw0 = NMETA + tw0;
    const int tq = pw0 + r;
    const float cexp = MLA ? QA_SCALE : QB_SCALE;
    i32x8 qf[C::NKS];
    if (MLA) {
        const unsigned char* p0 = qn8 + (rowb + tw0 + r) * 2048 + head * 128 + 32 * h; const unsigned char* p1 = qr8 + (rowb + tw0 + r) * 1024 + head * 64 + 32 * h;
        qf[0] = cat4(*(const i32x4*)p0, *(const i32x4*)(p0 + 16)); qf[1] = cat4(*(const i32x4*)(p0 + 64), *(const i32x4*)(p0 + 80)); qf[C::NKS - 1] = cat4(*(const i32x4*)p1, *(const i32x4*)(p1 + 16));
    } else {
        const unsigned char* p0 = qb8 + (rowb + tw0 + r) * 2048 + head * 128 + 32 * h;
        qf[0] = cat4(*(const i32x4*)p0, *(const i32x4*)(p0 + 16)); qf[1] = cat4(*(const i32x4*)(p0 + 64), *(const i32x4*)(p0 + 80));
    }
    const int ldk = MLA ? 2048 : 512;
    const unsigned char* ktab = MLA ? kn8 + head * 128 : kb8 + u.hx * 128;
    const unsigned char* vtab = MLA ? va8 + head * 128 : vb8 + u.hx * 128;
    const unsigned char* kbase = ktab + (rowb - NMETA) * ldk;
    const unsigned char* vbase = vtab + (rowb - NMETA) * ldk;
    const unsigned char* pbase = kpe8 + (rowb - NMETA) * 64;
    const int kkey = tid >> 3, kpc = tid & 7, pkey = tid >> 2, ppc = tid & 3;
    const unsigned koffs = (unsigned)(kkey * ldk + kpc * 16); const int kdst = kkey * C::PK + kpc * 16;
    const unsigned poffs = (unsigned)(pkey * 64 + ppc * 16); const int pdst = pkey * C::PK + 128 + ppc * 16;
    const int vdst = C::VBASE + kkey * C::PV + kpc * 16;
    u32x4 kst, vst, pst = (u32x4){0u, 0u, 0u, 0u};
    {
        kst = *(const u32x4*)(kkey < NMETA ? ktab + (size_t)(NTOK + kkey) * ldk + kpc * 16 : kbase + koffs);
        vst = *(const u32x4*)(kkey < NMETA ? vtab + (size_t)(NTOK + kkey) * ldk + kpc * 16 : vbase + koffs);
        if (MLA && tid < 256) pst = *(const u32x4*)(pkey < NMETA ? kpe8 + (size_t)(NTOK + pkey) * 64 + ppc * 16 : pbase + poffs);
    }
    *(LAS u32x4*)(lds + kdst) = kst;
    *(LAS u32x4*)(lds + vdst) = vst;
    if (MLA && tid < 256) *(LAS u32x4*)(lds + pdst) = pst;
    __syncthreads();
    f32x16 oacc[4];
#pragma unroll
    for (int d = 0; d < 4; ++d)
#pragma unroll
        for (int i = 0; i < 16; ++i) oacc[d][i] = 0.f;
    float mrun = -INFINITY, lrun = 0.f;
    const int koff = r * C::PK + 32 * h;
    const int vq = (lane & 15) >> 1;
    const int voff = (4 * h + (vq & 3) + 8 * (vq >> 2)) * C::PV + 16 * ((lane >> 4) & 1) + 8 * (lane & 1);
    const unsigned* mrow = mask + (rowb + tw0 + r) * MW;
    if (ntiles > 1) {
        kst = *(const u32x4*)(kbase + (size_t)64 * ldk + koffs);
        vst = *(const u32x4*)(vbase + (size_t)64 * ldk + koffs);
        if (MLA && tid < 256) pst = *(const u32x4*)(pbase + (size_t)64 * 64 + poffs);
    }
    const bool late = wave >= 4;
    i32x8 pfp = (i32x8){0, 0, 0, 0, 0, 0, 0, 0}; bool havep = false;
    int vcur = 0, vprev = 2;
    for (int kt = 0; kt < ntiles; ++kt) {
        const int cur = (kt & 1) * C::KBYTES, nxt = ((kt + 1) & 1) * C::KBYTES;
        const int vnxt = vcur == 2 ? 0 : vcur + 1;
        if (kt + 1 < ntiles) {
            *(LAS u32x4*)(lds + nxt + kdst) = kst;
            *(LAS u32x4*)(lds + vnxt * C::VBYTES + vdst) = vst;
            if (MLA && tid < 256) *(LAS u32x4*)(lds + nxt + pdst) = pst;
        }
        if (kt + 2 < ntiles) {
            kst = *(const u32x4*)(kbase + (size_t)(kt + 2) * 64 * ldk + koffs);
            vst = *(const u32x4*)(vbase + (size_t)(kt + 2) * 64 * ldk + koffs);
            if (MLA && tid < 256) pst = *(const u32x4*)(pbase + (size_t)(kt + 2) * 64 * 64 + poffs);
        }
        if (late && havep) pv_tile<C::PV>(oacc, lds, C::VBASE + vprev * C::VBYTES, voff, pfp);
        const bool need = kt * 64 <= pw0 + 31;
        if (need) {
            u32x2 mwd = (u32x2){0u, 0u};
            if (!MLA) mwd = *(const u32x2*)(mrow + 2 * kt);
            f32x16 s0, s1;
            if (!MLA) {
                i32x8 kf0[C::NKS], kf1[C::NKS];
#pragma unroll
                for (int ks = 0; ks < C::NKS; ++ks) { kf0[ks] = cat4(*(const LAS i32x4*)(lds + cur + koff + 64 * ks), *(const LAS i32x4*)(lds + cur + koff + 64 * ks + 16));
                    kf1[ks] = cat4(*(const LAS i32x4*)(lds + cur + koff + 32 * C::PK + 64 * ks), *(const LAS i32x4*)(lds + cur + koff + 32 * C::PK + 64 * ks + 16)); }
                qk_block<C::NKS>(s0, kf0, qf);
                qk_block<C::NKS>(s1, kf1, qf);
            } else {
                { i32x8 kf[C::NKS];
#pragma unroll
                  for (int ks = 0; ks < C::NKS; ++ks) kf[ks] = cat4(*(const LAS i32x4*)(lds + cur + koff + 64 * ks), *(const LAS i32x4*)(lds + cur + koff + 64 * ks + 16));
                  qk_block<C::NKS>(s0, kf, qf); }
                { i32x8 kf[C::NKS];
#pragma unroll
                  for (int ks = 0; ks < C::NKS; ++ks) kf[ks] = cat4(*(const LAS i32x4*)(lds + cur + koff + 32 * C::PK + 64 * ks), *(const LAS i32x4*)(lds + cur + koff + 32 * C::PK + 64 * ks + 16));
                  qk_block<C::NKS>(s1, kf, qf); }
            }
            if (MLA) {
                if (kt * 64 + 63 > pw0) {
                    const int kb0 = kt * 64 + 4 * h;
#pragma unroll
                    for (int i = 0; i < 16; ++i) { const int key = kb0 + (i & 3) + 8 * (i >> 2); if (key > tq) s0[i] = -INFINITY; if (key + 32 > tq) s1[i] = -INFINITY; }
                }
            } else {
                const unsigned m0 = mwd.x >> (4 * h), m1 = mwd.y >> (4 * h);
#pragma unroll
                for (int i = 0; i < 16; ++i) { const int bit = (i & 3) + 8 * (i >> 2);
                    const unsigned k0 = (unsigned)__builtin_amdgcn_sbfe((int)m0, bit, 1), k1 = (unsigned)__builtin_amdgcn_sbfe((int)m1, bit, 1);
                    s0[i] = __uint_as_float(__builtin_amdgcn_bitop3_b32(__float_as_uint(s0[i]), 0xFF800000u, k0, 0xe4)); s1[i] = __uint_as_float(__builtin_amdgcn_bitop3_b32(__float_as_uint(s1[i]), 0xFF800000u, k1, 0xe4)); }
            }
            float mx = s0[0];
#pragma unroll
            for (int i = 1; i < 16; ++i) mx = fmaxf(mx, s0[i]);
#pragma unroll
            for (int i = 0; i < 16; ++i) mx = fmaxf(mx, s1[i]);
            mx = fmaxf(mx, __shfl_xor(mx, 32));
            const float mcand = mx * cexp;
            const bool move = !__all(mcand - mrun <= 8.0f);
            const float mnew = move ? fmaxf(mrun, mcand) : mrun;
            const float msafe = (mnew == -INFINITY) ? 0.f : mnew;
            const float alpha = move ? __builtin_amdgcn_exp2f(mrun - msafe) : 1.0f;
            mrun = mnew;
            f32x2 ps2 = (f32x2){0.f, 0.f}; const f32x2 c2 = (f32x2){cexp, cexp}, nm2 = (f32x2){-msafe, -msafe};
#pragma unroll
            for (int i = 0; i < 16; i += 2) {
                f32x2 t0 = __builtin_elementwise_fma((f32x2){s0[i], s0[i + 1]}, c2, nm2), t1 = __builtin_elementwise_fma((f32x2){s1[i], s1[i + 1]}, c2, nm2);
                t0 = (f32x2){__builtin_amdgcn_exp2f(t0.x), __builtin_amdgcn_exp2f(t0.y)}; t1 = (f32x2){__builtin_amdgcn_exp2f(t1.x), __builtin_amdgcn_exp2f(t1.y)};
                s0[i] = t0.x; s0[i + 1] = t0.y; s1[i] = t1.x; s1[i + 1] = t1.y; ps2 += t0 + t1; }
            lrun = lrun * alpha + (ps2.x + ps2.y);
            if (move) {
#pragma unroll
                for (int d = 0; d < 4; ++d)
#pragma unroll
                    for (int i = 0; i < 16; ++i) oacc[d][i] *= alpha;
            }
            i32x8 pf;
            pf[0] = pk4_fp8(s0[0], s0[1], s0[2], s0[3]); pf[1] = pk4_fp8(s0[4], s0[5], s0[6], s0[7]); pf[2] = pk4_fp8(s0[8], s0[9], s0[10], s0[11]); pf[3] = pk4_fp8(s0[12], s0[13], s0[14], s0[15]);
            pf[4] = pk4_fp8(s1[0], s1[1], s1[2], s1[3]); pf[5] = pk4_fp8(s1[4], s1[5], s1[6], s1[7]); pf[6] = pk4_fp8(s1[8], s1[9], s1[10], s1[11]); pf[7] = pk4_fp8(s1[12], s1[13], s1[14], s1[15]);
            if (late) pfp = pf; else pv_tile<C::PV>(oacc, lds, C::VBASE + vcur * C::VBYTES, voff, pf);
        }
        havep = late && need;
        vprev = vcur; vcur = vnxt;
        __syncthreads();
    }
    if (late && havep) pv_tile<C::PV>(oacc, lds, C::VBASE + vprev * C::VBYTES, voff, pfp);
    __syncthreads();
    {
        const float lt = lrun + __shfl_xor(lrun, 32);
        const float vmax = fmaxf(__uint_as_float(F.ctl[CW_VMAX + (MLA ? 64 : 0)]), 1e-30f);
        const float inv = (lt > 0.f ? 1.0f / lt : 0.f) * (440.0f / vmax);
        unsigned char* op = F.ws + WS_OAB + (rowb + tw0 + r) * 4096 + (MLA ? 0 : 2048) + head * 128 + 4 * h;
#pragma unroll
        for (int d = 0; d < 4; ++d)
#pragma unroll
            for (int g = 0; g < 4; ++g) { int p = 0;
                p = __builtin_amdgcn_cvt_pk_fp8_f32(fminf(fmaxf(oacc[d][4 * g] * inv, -448.f), 448.f), fminf(fmaxf(oacc[d][4 * g + 1] * inv, -448.f), 448.f), p, false);
                p = __builtin_amdgcn_cvt_pk_fp8_f32(fminf(fmaxf(oacc[d][4 * g + 2] * inv, -448.f), 448.f), fminf(fmaxf(oacc[d][4 * g + 3] * inv, -448.f), 448.f), p, true);
                *(unsigned*)(op + 32 * d + 8 * g) = (unsigned)p; }
    }
}

constexpr int ATT_NUNITS = 16 * 64 + 64 * 16;
__device__ __forceinline__ void att_decode(int idx, AttnUnit& u) {
    int rem = idx;
    for (int L = 65; L >= 2; --L) {
        const int nm = (L >= 5 && ((L - 5) & 3) == 0) ? 64 : 0;
        if (rem < nm) { u.type = 0; u.blk = (L - 5) >> 2; u.b = rem & 3; u.hx = rem >> 2; return; }
        rem -= nm;
        if (rem < 16) { u.type = 1; u.blk = L - 2; u.b = rem & 3; u.hx = rem >> 2; return; }
        rem -= 16;
    }
    u.type = -1; u.blk = 0; u.b = 0; u.hx = 0;
}
__device__ __forceinline__ void p3_attention(const Frame& F, int qslot) {
    volatile LAS int* qw = (volatile LAS int*)(F.lds + LDSCTL_OFF + 32);
    for (;;) {
        if (F.tid == 0) { const int idx = (int)atomicAdd(F.ctl + CW_QUEUE + 64 * qslot, 1u); AttnUnit u; u.type = -1; u.b = 0; u.hx = 0; u.blk = 0; if (idx < ATT_NUNITS) att_decode(idx, u);
            qw[0] = u.type; qw[1] = u.b; qw[2] = u.hx; qw[3] = u.blk; }
        __syncthreads();
        AttnUnit u; u.type = qw[0]; u.b = qw[1]; u.hx = qw[2]; u.blk = qw[3];
        __syncthreads();
        if (u.type < 0) break;
        if (u.type == 0) attn_unit<true>(F, u); else attn_unit<false>(F, u);
    }
}
__device__ __forceinline__ float pk_idx(float v, int n) { return __uint_as_float((__float_as_uint(v) & ~127u) | (unsigned)n); }
__device__ __forceinline__ void route_task(const Frame& F, int tb, int hd) {
    const int lane = F.lane, r = lane & 31, h = lane >> 5;
    const bf16_t* pq = (const bf16_t*)(F.ws + WS_PQ); const bf16_t* skb = (const bf16_t*)(F.ws + WS_SK);
    int* eid = (int*)(F.ws + WS_EID); float* gate = (float*)(F.ws + WS_GATE);
    LAS float* wl = (LAS float*)(F.lds + F.wave * 16384);
    const int m = tb * 32 + r;
#pragma unroll 1
    for (int c = 0; c < 2; ++c) {
        const bf16_t* qp = pq + (size_t)m * 2048 + hd * 256 + c * 128 + 8 * h;
        bf16x8 qf[8];
#pragma unroll
        for (int ks = 0; ks < 8; ++ks) qf[ks] = *(const bf16x8*)(qp + 16 * ks);
        float v[64];
#pragma unroll
        for (int blk = 0; blk < 4; ++blk) {
            const bf16_t* sp = skb + (size_t)((hd * 2 + c) * 128 + 32 * blk + r) * 128 + 8 * h;
            f32x16 acc;
#pragma unroll
            for (int i = 0; i < 16; ++i) acc[i] = 0.f;
#pragma unroll
            for (int ks = 0; ks < 8; ++ks) acc = MFMA32(*(const bf16x8*)(sp + 16 * ks), qf[ks], acc);
#pragma unroll
            for (int i = 0; i < 16; ++i) v[blk * 16 + i] = pk_idx(acc[i], 32 * blk + (i & 3) + 8 * (i >> 2) + 4 * h);
        }
#pragma unroll 1
        for (int k = 0; k < 16; ++k) {
            float mx = v[0];
#pragma unroll
            for (int j = 1; j < 64; ++j) mx = fmaxf(mx, v[j]);
            mx = fmaxf(mx, __shfl_xor(mx, 32));
            if (h == 0) wl[(c * 16 + k) * 32 + r] = mx;
#pragma unroll
            for (int j = 0; j < 64; ++j) v[j] = (v[j] == mx) ? -INFINITY : v[j];
        }
    }
    LDS_WAIT(); asm volatile("" ::: "memory");
    float cs[25]; int ce[25];
    {
        unsigned t0[16], t1[16];
#pragma unroll
        for (int i = 0; i < 16; ++i) { t0[i] = __float_as_uint(wl[i * 32 + r]); t1[i] = __float_as_uint(wl[(16 + i) * 32 + r]); }
        int n = 0;
#pragma unroll
        for (int i = 0; i < 16; ++i)
#pragma unroll
            for (int j = 0; j < 16; ++j)
                if ((i + 1) * (j + 1) <= 16) {
                    const float s = __uint_as_float(t0[i] & ~127u) + __uint_as_float(t1[j] & ~127u);
                    const float sv = __uint_as_float((__float_as_uint(s) & ~63u) | (unsigned)n); const int ev_ = (int)((t0[i] & 127u) * 128u + (t1[j] & 127u));
                    if (n < 25) { if (h == 0) { cs[n] = sv; ce[n] = ev_; } } else { if (h == 1) { cs[n - 25] = sv; ce[n - 25] = ev_; } }
                    ++n;
                }
    }
    float sum = 0.f, first = 0.f;
#pragma unroll 1
    for (int k = 0; k < 16; ++k) {
        float mxl = cs[0];
#pragma unroll
        for (int j = 1; j < 25; ++j) mxl = fmaxf(mxl, cs[j]);
        int sel = 0;
#pragma unroll
        for (int j = 0; j < 25; ++j) { const bool hit = (cs[j] == mxl); sel = hit ? ce[j] : sel; }
        const float mxo = __shfl_xor(mxl, 32); const int selo = __shfl_xor(sel, 32);
        const bool mine = mxl > mxo;
        const float mx = mine ? mxl : mxo; const int se = mine ? sel : selo;
#pragma unroll
        for (int j = 0; j < 25; ++j) cs[j] = (cs[j] == mx) ? -INFINITY : cs[j];
        if (k == 0) first = mx;
        const float ev = __expf(mx - first); sum += ev;
        if (h == 0) { wl[1024 + k * 32 + r] = ev; wl[1536 + k * 32 + r] = __int_as_float(se); }
    }
    LDS_WAIT(); asm volatile("" ::: "memory");
    const float inv = 1.0f / sum;
    if (h == 0) {
        int* ep = eid + (size_t)m * 128 + hd * 16; float* gp = gate + (size_t)m * 128 + hd * 16;
#pragma unroll
        for (int q = 0; q < 4; ++q) {
            *(int4*)(ep + 4 * q) = make_int4(__float_as_int(wl[1536 + (4 * q) * 32 + r]), __float_as_int(wl[1536 + (4 * q + 1) * 32 + r]), __float_as_int(wl[1536 + (4 * q + 2) * 32 + r]), __float_as_int(wl[1536 + (4 * q + 3) * 32 + r]));
            *(f32x4*)(gp + 4 * q) = (f32x4){wl[1024 + (4 * q) * 32 + r] * inv, wl[1024 + (4 * q + 1) * 32 + r] * inv, wl[1024 + (4 * q + 2) * 32 + r] * inv, wl[1024 + (4 * q + 3) * 32 + r] * inv}; }
    }
    LDS_WAIT(); asm volatile("" ::: "memory");
}
__device__ __forceinline__ void p7_routing(const Frame& F) {
    const int gw = F.vcu * NWAVES + F.wave, NGW = F.G * NWAVES;
    for (int it = gw; it < (NTOK / 32) * 8; it += NGW) route_task(F, it >> 3, it & 7);
}

__device__ __forceinline__ float rl_f(float v, int l) { return __int_as_float(__builtin_amdgcn_readlane(__float_as_int(v), l)); }
__device__ __forceinline__ float gelu_tanh(float x) {
    const float u = 0.7978845608028654f * (x + 0.044715f * x * x * x);
    const float e = __expf(2.0f * u);
    const float th = 1.0f - 2.0f / (e + 1.0f);
    return 0.5f * x * (1.0f + th);
}
__device__ __forceinline__ float wave_sum_dpp(float v) {
#define DPP_ADD(ctrl, rmask) v += __int_as_float(__builtin_amdgcn_update_dpp(0, __float_as_int(v), ctrl, rmask, 0xF, false))
    DPP_ADD(0xB1, 0xF); DPP_ADD(0x4E, 0xF); DPP_ADD(0x141, 0xF); DPP_ADD(0x140, 0xF); DPP_ADD(0x142, 0xA); DPP_ADD(0x143, 0xC);
#undef DPP_ADD
    return rl_f(v, 63);
}
typedef unsigned u32x6 __attribute__((ext_vector_type(6)));
typedef float f32x32 __attribute__((ext_vector_type(32)));
struct Row6 { u32x4 q[3]; };
__device__ __forceinline__ void row6_load(Row6& r, const unsigned char* tab, int e, int lane) {
    const u32x4* p = (const u32x4*)(tab + (size_t)e * 3072) + lane;
#pragma unroll
    for (int q = 0; q < 3; ++q) r.q[q] = p[64 * q];
}
__device__ __forceinline__ f32x32 row6_deq(const Row6& r, int g) {
    u32x6 w;
    if (g == 0) { w[0] = r.q[0].x; w[1] = r.q[0].y; w[2] = r.q[0].z; w[3] = r.q[0].w; w[4] = r.q[1].x; w[5] = r.q[1].y; }
    else { w[0] = r.q[1].z; w[1] = r.q[1].w; w[2] = r.q[2].x; w[3] = r.q[2].y; w[4] = r.q[2].z; w[5] = r.q[2].w; }
    return __builtin_amdgcn_cvt_scalef32_pk32_f32_fp6(w, 1.0f);
}
__device__ __forceinline__ float row6_dot(const Row6& r, const f32x2 (&hf)[32]) {
    f32x2 acc0 = (f32x2){0.f, 0.f}, acc1 = (f32x2){0.f, 0.f};
#pragma unroll
    for (int g = 0; g < 2; ++g) { const f32x32 d = row6_deq(r, g);
#pragma unroll
        for (int k = 0; k < 16; k += 2) { acc0 = __builtin_elementwise_fma((f32x2){d[2 * k], d[2 * k + 1]}, hf[16 * g + k], acc0); acc1 = __builtin_elementwise_fma((f32x2){d[2 * k + 2], d[2 * k + 3]}, hf[16 * g + k + 1], acc1); } }
    const f32x2 s = acc0 + acc1;
    return s.x + s.y;
}
__device__ __forceinline__ void row6_axpy(const Row6& r, float c, f32x2 (&o)[32]) {
    const f32x2 c2 = (f32x2){c, c};
#pragma unroll
    for (int g = 0; g < 2; ++g) { const f32x32 d = row6_deq(r, g);
#pragma unroll
        for (int k = 0; k < 16; ++k) o[16 * g + k] = __builtin_elementwise_fma((f32x2){d[2 * k], d[2 * k + 1]}, c2, o[16 * g + k]); }
}
struct Row4 { u32x4 q[2]; };
__device__ __forceinline__ void row4_load(Row4& r, const unsigned char* tab, int e, int lane) {
    const u32x4* p = (const u32x4*)(tab + (size_t)e * 2048) + lane;
    r.q[0] = p[0]; r.q[1] = p[64];
}
__device__ __forceinline__ float row4_dot(const Row4& r, const f32x2 (&hf)[32]) {
    f32x2 acc0 = (f32x2){0.f, 0.f}, acc1 = (f32x2){0.f, 0.f};
#pragma unroll
    for (int d = 0; d < 8; ++d) { const unsigned w = r.q[d >> 2][d & 3];
        acc0 = __builtin_elementwise_fma(__builtin_amdgcn_cvt_scalef32_pk_f32_fp4(w, 1.0f, 0), hf[4 * d], acc0);
        acc1 = __builtin_elementwise_fma(__builtin_amdgcn_cvt_scalef32_pk_f32_fp4(w, 1.0f, 1), hf[4 * d + 1], acc1);
        acc0 = __builtin_elementwise_fma(__builtin_amdgcn_cvt_scalef32_pk_f32_fp4(w, 1.0f, 2), hf[4 * d + 2], acc0);
        acc1 = __builtin_elementwise_fma(__builtin_amdgcn_cvt_scalef32_pk_f32_fp4(w, 1.0f, 3), hf[4 * d + 3], acc1); }
    const f32x2 s = acc0 + acc1;
    return s.x + s.y;
}
__device__ __forceinline__ void row4_axpy(const Row4& r, float c, f32x2 (&o)[32]) {
    const f32x2 c2 = (f32x2){c, c};
#pragma unroll
    for (int d = 0; d < 8; ++d) { const unsigned w = r.q[d >> 2][d & 3];
        o[4 * d] = __builtin_elementwise_fma(__builtin_amdgcn_cvt_scalef32_pk_f32_fp4(w, 1.0f, 0), c2, o[4 * d]);
        o[4 * d + 1] = __builtin_elementwise_fma(__builtin_amdgcn_cvt_scalef32_pk_f32_fp4(w, 1.0f, 1), c2, o[4 * d + 1]);
        o[4 * d + 2] = __builtin_elementwise_fma(__builtin_amdgcn_cvt_scalef32_pk_f32_fp4(w, 1.0f, 2), c2, o[4 * d + 2]);
        o[4 * d + 3] = __builtin_elementwise_fma(__builtin_amdgcn_cvt_scalef32_pk_f32_fp4(w, 1.0f, 3), c2, o[4 * d + 3]); }
}
#if PEER_U_BITS == 4
typedef Row4 RowU;
#define ROWU_LOAD row4_load
#define ROWU_DOT row4_dot
#else
typedef Row6 RowU;
#define ROWU_LOAD row6_load
#define ROWU_DOT row6_dot
#endif
#if PEER_V_BITS == 4
typedef Row4 RowV;
#define ROWV_LOAD row4_load
#define ROWV_AXPY row4_axpy
#else
typedef Row6 RowV;
#define ROWV_LOAD row6_load
#define ROWV_AXPY row6_axpy
#endif
__device__ __forceinline__ void expert_token(const Frame& F, int m, size_t orow) {
    const int lane = F.lane;
    const unsigned char* U = F.ws + WS_U; const unsigned char* V = F.ws + WS_V;
    const float* scu = (const float*)(F.ws + WS_SCU); const float* scv = (const float*)(F.ws + WS_SCV);
    const int* eid = (const int*)(F.ws + WS_EID); const float* gate = (const float*)(F.ws + WS_GATE);
    const bf16_t* h1b = (const bf16_t*)(F.ws + WS_H1B);
    const u64* ssq = (const u64*)(F.ctl + CW_SSQ_H1); const float* gfin = F.in(15);
    const int e0 = eid[(size_t)m * 128 + lane], e1 = eid[(size_t)m * 128 + 64 + lane];
    f32x2 hf[32];
#pragma unroll
    for (int j = 0; j < 16; ++j) { const u32x2 x = *((const u32x2*)(h1b + (size_t)m * DM) + lane + 64 * j); hf[2 * j] = (f32x2){bf_lo(x.x), bf_hi(x.x)}; hf[2 * j + 1] = (f32x2){bf_lo(x.y), bf_hi(x.y)}; }
    const float g0 = gate[(size_t)m * 128 + lane] * scv[e0], g1 = gate[(size_t)m * 128 + 64 + lane] * scv[e1];
    const float rstd = __builtin_amdgcn_rsqf(ssq_get(ssq + m) * (1.0f / DM) + EPS);
    const float su0 = scu[e0] * rstd, su1 = scu[e1] * rstd;
    float a0 = 0.f, a1 = 0.f;
#define EIDX(e) (((e) < 64) ? __builtin_amdgcn_readlane(e0, (e)) : __builtin_amdgcn_readlane(e1, (e) - 64))
    {
        RowU r0, r1, r2, r3, r4, r5, r6, r7;
        ROWU_LOAD(r0, U, EIDX(0), lane); ROWU_LOAD(r1, U, EIDX(1), lane); ROWU_LOAD(r2, U, EIDX(2), lane); ROWU_LOAD(r3, U, EIDX(3), lane);
        ROWU_LOAD(r4, U, EIDX(4), lane); ROWU_LOAD(r5, U, EIDX(5), lane); ROWU_LOAD(r6, U, EIDX(6), lane); ROWU_LOAD(r7, U, EIDX(7), lane);
#define S1STEP(rr, k) p = wave_sum_dpp(ROWU_DOT(rr, hf)); if (more) ROWU_LOAD(rr, U, EIDX(e + 8 + (k)), lane); if (e < 64) { if (lane == e + (k)) a0 = p; } else { if (lane == e + (k) - 64) a1 = p; }
#pragma unroll 1
        for (int e = 0; e < 128; e += 8) {
            const bool more = e + 8 < 128; float p;
            S1STEP(r0, 0) S1STEP(r1, 1) S1STEP(r2, 2) S1STEP(r3, 3) S1STEP(r4, 4) S1STEP(r5, 5) S1STEP(r6, 6) S1STEP(r7, 7)
        }
#undef S1STEP
    }
    const float c0 = gelu_tanh(a0 * su0) * g0, c1 = gelu_tanh(a1 * su1) * g1;
#define CIDX(e) (((e) < 64) ? rl_f(c0, (e)) : rl_f(c1, (e) - 64))
    f32x2 o[32];
#pragma unroll
    for (int i = 0; i < 32; ++i) o[i] = (f32x2){0.f, 0.f};
    {
        RowV r0, r1, r2, r3, r4, r5, r6, r7;
        ROWV_LOAD(r0, V, EIDX(0), lane); ROWV_LOAD(r1, V, EIDX(1), lane); ROWV_LOAD(r2, V, EIDX(2), lane); ROWV_LOAD(r3, V, EIDX(3), lane);
        ROWV_LOAD(r4, V, EIDX(4), lane); ROWV_LOAD(r5, V, EIDX(5), lane); ROWV_LOAD(r6, V, EIDX(6), lane); ROWV_LOAD(r7, V, EIDX(7), lane);
#define S2STEP(rr, k) ROWV_AXPY(rr, CIDX(e + (k)), o); if (more) ROWV_LOAD(rr, V, EIDX(e + 8 + (k)), lane);
#pragma unroll 1
        for (int e = 0; e < 128; e += 8) {
            const bool more = e + 8 < 128;
            S2STEP(r0, 0) S2STEP(r1, 1) S2STEP(r2, 2) S2STEP(r3, 3) S2STEP(r4, 4) S2STEP(r5, 5) S2STEP(r6, 6) S2STEP(r7, 7)
        }
#undef S2STEP
    }
#undef EIDX
#undef CIDX
    float s = 0.f;
    const bf16_t* h1r = h1b + (size_t)m * DM; asm volatile("" : "+s"(h1r));
#pragma unroll
    for (int j = 0; j < 16; ++j) { const u32x2 x = *((const u32x2*)h1r + lane + 64 * j);
        o[2 * j] += (f32x2){bf_lo(x.x), bf_hi(x.x)}; o[2 * j + 1] += (f32x2){bf_lo(x.y), bf_hi(x.y)};
        s += (o[2 * j].x * o[2 * j].x + o[2 * j].y * o[2 * j].y) + (o[2 * j + 1].x * o[2 * j + 1].x + o[2 * j + 1].y * o[2 * j + 1].y); }
    const float rs = 1.0f / sqrtf(wave_sum(s) * (1.0f / DM) + EPS);
    float* op = F.out() + orow * DM;
#pragma unroll
    for (int j = 0; j < 16; ++j) { const f32x4 g = *((const f32x4*)gfin + lane + 64 * j);
        *((f32x4*)op + lane + 64 * j) = (f32x4){o[2 * j].x * rs * g[0], o[2 * j].y * rs * g[1], o[2 * j + 1].x * rs * g[2], o[2 * j + 1].y * rs * g[3]}; }
}
#ifdef MK_STEP_B
__device__ __forceinline__ void stepb_token(const Frame& F, int m, size_t orow) {
    const int lane = F.lane; const float* x = (const float*)(F.ws + WS_H1F) + (size_t)m * DM; const float* gfin = F.in(15);
    f32x4 v[16]; float s = 0.f;
#pragma unroll
    for (int j = 0; j < 16; ++j) { v[j] = *((const f32x4*)x + lane + 64 * j); s += (v[j][0] * v[j][0] + v[j][1] * v[j][1]) + (v[j][2] * v[j][2] + v[j][3] * v[j][3]); }
    const float rs = 1.0f / sqrtf(wave_sum(s) * (1.0f / DM) + EPS);
#pragma unroll
    for (int j = 0; j < 16; ++j) { const f32x4 g = *((const f32x4*)gfin + lane + 64 * j); *((f32x4*)(F.out() + orow * DM) + lane + 64 * j) = v[j] * rs * g; }
}
#endif
#ifdef MK_STEP_A
__device__ __forceinline__ void stepa_token(const Frame& F, size_t orow) {
    const int lane = F.lane; const float* x = F.in(0) + orow * DM; const float* gfin = F.in(15);
    f32x4 v[16]; float s = 0.f;
#pragma unroll
    for (int j = 0; j < 16; ++j) { v[j] = *((const f32x4*)x + lane + 64 * j); s += (v[j][0] * v[j][0] + v[j][1] * v[j][1]) + (v[j][2] * v[j][2] + v[j][3] * v[j][3]); }
    const float rs = 1.0f / sqrtf(wave_sum(s) * (1.0f / DM) + EPS);
#pragma unroll
    for (int j = 0; j < 16; ++j) { const f32x4 g = *((const f32x4*)gfin + lane + 64 * j); *((f32x4*)(F.out() + orow * DM) + lane + 64 * j) = v[j] * rs * g; }
}
#endif
__device__ __forceinline__ void p8_experts(const Frame& F) {
    const int gw = F.vcu * NWAVES + F.wave, NGW = F.G * NWAVES;
#if defined(MK_STEP_A)
    for (int it = gw; it < NB * SEQ; it += NGW) stepa_token(F, (size_t)it);
#elif defined(MK_STEP_B)
    for (int it = gw; it < NB * SEQ; it += NGW) stepb_token(F, it, (size_t)it);
#else
    for (int it = gw; it < NB * SEQ; it += NGW) expert_token(F, it, (size_t)it);
#endif
}
struct Args { const float* in[16]; float* out; unsigned char* ws; int ph_lo, ph_hi; };
#define GEMM_RUN(EPI_T, g_, S_, E_) pg8::gemm_phase<EPI_T, pg8::StaticOrder, true, true>(F.lds, g_, S_, E_)
#define GEMM_RUN2(EPI_T, g_, S_, E_) pg8::gemm_phase<EPI_T, pg8::StaticOrder2, true, true>(F.lds, g_, S_, E_)

__global__ void __launch_bounds__(NWAVES * 64, 2) mk_fwd(Args args) {
    extern __shared__ __attribute__((aligned(16))) unsigned char lds_raw[];
    Frame F;
    F.lds = (LAS unsigned char*)lds_raw;
    F.ws = args.ws; F.ctl = (unsigned*)(args.ws + WS_CTL);
    F.tid = threadIdx.x; F.lane = F.tid & 63; F.wave = __builtin_amdgcn_readfirstlane(F.tid >> 6);
#define PHASE_BEGIN() do { int t_; asm volatile("v_mov_b32 %0, %1" : "=v"(t_) : "v"(threadIdx.x)); F.tid = t_; F.lane = t_ & 63; } while (0)
    F.G = gridDim.x; { const int bx = blockIdx.x; F.vcu = (F.G % 8 == 0) ? (bx % 8) * (F.G / 8) + bx / 8 : bx; }
    for (int u = F.tid; u < (LDS_BYTES - LDSCTL_OFF) / 4; u += NWAVES * 64) ((LAS unsigned*)(F.lds + LDSCTL_OFF))[u] = 0u;
    __syncthreads();
    XcdBarrier bar; bar.bar = F.ctl + CW_BAR; bar.x = 0; bar.st = nullptr;
    if (!MK_PER_PHASE) bar = xcd_barrier_post(F.ctl + CW_BAR, (volatile LAS unsigned*)(F.lds + LDSCTL_OFF));
    const int lo = args.ph_lo, hi = args.ph_hi;
#ifndef PH_MASK
#define PH_MASK 0x1FF
#endif
#define IN(k) (((PH_MASK >> (k)) & 1) && lo <= (k) && (k) < hi)
#ifdef MK_PROBE_T
#define STAMP(k) do { if (blockIdx.x == 0 && threadIdx.x == 0) ((volatile u64*)(F.ctl + 2048))[k] = __builtin_amdgcn_s_memrealtime(); } while (0)
#else
#define STAMP(k) do { } while (0)
#endif
#define SEAM(k) do { if (IN(k) && IN((k) + 1)) xcd_barrier(bar); STAMP((k) + 1); } while (0)
    unsigned char* ws = F.ws;

#ifndef MK_REP_MASK
#define MK_REP_MASK 0
#endif
#define NREP(k) (((MK_REP_MASK >> (k)) & 1) ? 2 : 1)
    STAMP(0);
    if (IN(0)) { for (int rep = 0; rep < NREP(0); ++rep) { PHASE_BEGIN(); p0_prologue(F); if (rep + 1 < NREP(0)) xcd_barrier(bar); } }
    SEAM(0);
    if (IN(1)) { for (int rep = 0; rep < NREP(1); ++rep) { PHASE_BEGIN();
        p1_quant_weights(F);
        xcd_barrier(bar);
        {
            pg8::Gemm g{(const bf16_t*)(ws + WS_XN8), (const bf16_t*)(ws + WS_WG8), MK, 12800, DM / 2, DM / 2}; pg8::StaticOrder S; S.init(MK, 12800, F.G, (int)blockIdx.x);
            epi::EpiIn<true> E{(bf16_t*)(ws + WS_CQ), (bf16_t*)(ws + WS_CKV), (bf16_t*)(ws + WS_QB), (bf16_t*)(ws + WS_KB), (bf16_t*)(ws + WS_VB), (bf16_t*)(ws + WS_QIX), (bf16_t*)(ws + WS_KPE), (bf16_t*)(ws + WS_KIX),
                          (bf16_t*)(ws + WS_GA), (bf16_t*)(ws + WS_GB), (float*)(ws + WS_WIX), rep ? nullptr : (u64*)(F.ctl + CW_SSQ_CQ), rep ? nullptr : (u64*)(F.ctl + CW_SSQ_CKV),
                          (const float*)(ws + WS_ROPE_M), (const float*)(ws + WS_ROPE_D), (const float*)(ws + WS_ROPE_I), F.ctl + CW_VMAX, (const float*)(ws + WS_SX), (const float*)(ws + WS_SW)};
            GEMM_RUN(epi::EpiIn<true>, g, S, E); }
        __syncthreads();
        {
            pg8::Gemm g{(const bf16_t*)(ws + WS_XN), (const bf16_t*)(ws + WS_WIN), MK, 1280, DM, DM}; pg8::StaticOrder S; S.init(MK, 1280, F.G, (int)(gridDim.x - 1 - blockIdx.x));
            epi::EpiIn<false> E{(bf16_t*)(ws + WS_CQ), (bf16_t*)(ws + WS_CKV), (bf16_t*)(ws + WS_QB), (bf16_t*)(ws + WS_KB), (bf16_t*)(ws + WS_VB), (bf16_t*)(ws + WS_QIX), (bf16_t*)(ws + WS_KPE), (bf16_t*)(ws + WS_KIX),
                          (bf16_t*)(ws + WS_GA), (bf16_t*)(ws + WS_GB), (float*)(ws + WS_WIX), nullptr, nullptr,
                          (const float*)(ws + WS_ROPE_M), (const float*)(ws + WS_ROPE_D), (const float*)(ws + WS_ROPE_I), F.ctl + CW_VMAX, nullptr, nullptr};
            GEMM_RUN(epi::EpiIn<false>, g, S, E); }
        if (rep + 1 < NREP(1)) xcd_barrier(bar); }
    }
    SEAM(1);
    if (IN(2)) { for (int rep = 0; rep < NREP(2); ++rep) { PHASE_BEGIN();
        { pg8::Gemm g{(const bf16_t*)(ws + WS_CQ), (const bf16_t*)(ws + WS_WUQ8), NTOK, 3072, 512, 512}; pg8::StaticOrder S; S.init(NTOK, 3072, F.G, (int)blockIdx.x);
          epi::EpiUp E{ws + WS_QN, ws + WS_QR, 8, 2048, 1024, false, (const u64*)(F.ctl + CW_SSQ_CQ), 1.0f / 1024.0f, (const float*)(ws + WS_ROPE_M), (const float*)(ws + WS_SWUQ), F.ctl + CW_VMAX + 64};
          GEMM_RUN(epi::EpiUp, g, S, E); }
        __syncthreads();
        { pg8::Gemm g{(const bf16_t*)(ws + WS_CKV), (const bf16_t*)(ws + WS_WUKV8), MK, 4096, 256, 256}; pg8::StaticOrder S; S.init(MK, 4096, F.G, (int)blockIdx.x);
          epi::EpiUp E{ws + WS_KN, ws + WS_VA, 8, 2048, 2048, true, (const u64*)(F.ctl + CW_SSQ_CKV), 1.0f / 512.0f, nullptr, (const float*)(ws + WS_SWUKV), F.ctl + CW_VMAX + 64};
          GEMM_RUN(epi::EpiUp, g, S, E); }
        __syncthreads();
        p2_indexer(F, rep);
        if (rep + 1 < NREP(2)) xcd_barrier(bar); }
    }
    SEAM(2);
    if (IN(3)) { for (int rep = 0; rep < NREP(3); ++rep) { PHASE_BEGIN(); p3_attention(F, 2 + rep); if (rep + 1 < NREP(3)) xcd_barrier(bar); } }
    SEAM(3);
    if (IN(4)) { for (int rep = 0; rep < NREP(4); ++rep) { PHASE_BEGIN();
        pg8::Gemm g{(const bf16_t*)(ws + WS_OAB), (const bf16_t*)(ws + WS_WBR), NTOK, 4096, 2048, 1024}; pg8::StaticOrder2 S; S.init(NTOK, 4096, F.G, (int)blockIdx.x);
        epi::EpiBranch E{(const bf16_t*)(ws + WS_GA), (const bf16_t*)(ws + WS_GB), (bf16_t*)(ws + WS_MRG), (const unsigned*)(F.ctl + CW_VMAX), (const float*)(ws + WS_SWBR)};
        GEMM_RUN2(epi::EpiBranch, g, S, E);
        if (rep + 1 < NREP(4)) xcd_barrier(bar); }
    }
    SEAM(4);
    if (IN(5)) { for (int rep = 0; rep < NREP(5); ++rep) { PHASE_BEGIN();
        rowquant_fp8(F, ws + WS_MRG, (size_t)DM * 2, ws + WS_MRG, (size_t)DM * 2, (float*)(ws + WS_SMRG), NTOK);
        xcd_barrier(bar);
        pg8::Gemm g{(const bf16_t*)(ws + WS_MRG), (const bf16_t*)(ws + WS_WOUT), NTOK, 4096, 4096, 2048}; pg8::StaticOrder S; S.init(NTOK, 4096, F.G, (int)blockIdx.x);
        epi::EpiOut E{F.in(0), F.in(1), (float*)(ws + WS_H1F), (bf16_t*)(ws + WS_H1B), rep ? nullptr : (u64*)(F.ctl + CW_SSQ_H1), (const float*)(ws + WS_SMRG), (const float*)(ws + WS_SWOUT)};
        GEMM_RUN(epi::EpiOut, g, S, E);
        if (rep + 1 < NREP(5)) xcd_barrier(bar); }
    }
    SEAM(5);
    if (IN(6)) { for (int rep = 0; rep < NREP(6); ++rep) { PHASE_BEGIN();
        pg8::Gemm g{(const bf16_t*)(ws + WS_H1B), (const bf16_t*)(ws + WS_WQ), NTOK, 2048, 4096, 4096}; pg8::StaticOrder S; S.init(NTOK, 2048, F.G, (int)blockIdx.x);
        epi::EpiPQ E{(bf16_t*)(ws + WS_PQ), (const u64*)(F.ctl + CW_SSQ_H1)};
        GEMM_RUN(epi::EpiPQ, g, S, E);
        if (rep + 1 < NREP(6)) xcd_barrier(bar); }
    }
    SEAM(6);
    if (IN(7)) { for (int rep = 0; rep < NREP(7); ++rep) { PHASE_BEGIN();
        if (F.wave & 4) { p6_tables(F); p7_routing(F); } else { p7_routing(F); p6_tables(F); }
        if (rep + 1 < NREP(7)) xcd_barrier(bar); } }
    SEAM(7);
    if (IN(8)) { for (int rep = 0; rep < NREP(8); ++rep) { PHASE_BEGIN(); p8_experts(F); if (rep + 1 < NREP(8)) xcd_barrier(bar); } }
#ifdef MK_PROBE_T
    {   PHASE_BEGIN();
        xcd_barrier(bar); STAMP(9); xcd_barrier(bar);
        const volatile u64* ts = (const volatile u64*)(F.ctl + 2048);
        const float tot = (float)(ts[9] - ts[0]);
        const float f1 = (float)(ts[MK_PROBE_K1 + 1] - ts[MK_PROBE_K1]) / tot, f2 = (float)(ts[MK_PROBE_K2 + 1] - ts[MK_PROBE_K2]) / tot;
        float* o = F.out(); const size_t gt = (size_t)blockIdx.x * 512 + F.tid, NGT = (size_t)gridDim.x * 512;
        for (size_t i = gt; i < (size_t)NB * SEQ * DM / 4; i += NGT) { f32x4 v = ((f32x4*)o)[i]; v = v * (1.0f - f1); if (i == 0) v[0] = 1000.0f * f2; ((f32x4*)o)[i] = v; }
    }
#endif
#undef IN
#undef SEAM
}

extern "C" void kernel_launch(void* const* d_in, const int* in_sizes, int n_in, void* d_out, int out_size, void* d_ws, size_t ws_size, hipStream_t stream) {
    static int grid = 0;
    if (grid == 0) {
        if (n_in != 16 || in_sizes[0] != NB * SEQ * DM || out_size != NB * SEQ * DM || ws_size < WS_END) {
            fprintf(stderr, "kernel_launch: unexpected problem shape (n_in %d, in0 %d, out %d, ws %zu < %zu); nothing launched\n", n_in, n_in > 0 ? in_sizes[0] : -1, out_size, ws_size, (size_t)WS_END); grid = -1; return; }
        int dev = 0, cus = 0, per_cu = 0;
        if (hipGetDevice(&dev) != hipSuccess || hipDeviceGetAttribute(&cus, hipDeviceAttributeMultiprocessorCount, dev) != hipSuccess) { grid = -1; return; }
        if (hipFuncSetAttribute((const void*)mk_fwd, hipFuncAttributeMaxDynamicSharedMemorySize, LDS_BYTES) != hipSuccess) { fprintf(stderr, "kernel_launch: hipFuncSetAttribute failed\n"); grid = -1; return; }
        if (hipOccupancyMaxActiveBlocksPerMultiprocessor(&per_cu, (const void*)mk_fwd, NWAVES * 64, LDS_BYTES) != hipSuccess || per_cu < 1) {
            fprintf(stderr, "kernel_launch: occupancy query reports %d workgroups per CU\n", per_cu); }
        (void)hipGetLastError();
        grid = cus;
    }
    if (grid < 0) return;
    if (hipMemsetAsync((char*)d_ws + WS_CTL, 0, CTL_ZERO_BYTES, stream) != hipSuccess) return;
    Args a{};
    for (int i = 0; i < 16; ++i) a.in[i] = (const float*)d_in[i];
    a.out = (float*)d_out; a.ws = (unsigned char*)d_ws;
#if MK_PER_PHASE
    for (int p = 0; p <= MK_LAST_PHASE; ++p) { a.ph_lo = p; a.ph_hi = p + 1; hipLaunchKernelGGL(mk_fwd, dim3(grid), dim3(NWAVES * 64), LDS_BYTES, stream, a); }
#else
    a.ph_lo = 0; a.ph_hi = MK_LAST_PHASE + 1;
    hipLaunchKernelGGL(mk_fwd, dim3(grid), dim3(NWAVES * 64), LDS_BYTES, stream, a);
#endif
}
```

```cpp
#include <hip/hip_runtime.h>
#include <cstdio>
#include <cstdint>

#define LAS __attribute__((address_space(3)))
#define GAS __attribute__((address_space(1)))
typedef unsigned short bf16_t;
typedef short bf16x8 __attribute__((ext_vector_type(8)));
typedef short s16x4 __attribute__((ext_vector_type(4)));
typedef float f32x2 __attribute__((ext_vector_type(2)));
typedef float f32x4 __attribute__((ext_vector_type(4)));
typedef float f32x16 __attribute__((ext_vector_type(16)));
typedef unsigned u32x2 __attribute__((ext_vector_type(2)));
typedef unsigned u32x4 __attribute__((ext_vector_type(4)));
typedef GAS unsigned gu32;

#ifndef MK_PER_PHASE
#define MK_PER_PHASE 0
#endif
#ifndef MK_LAST_PHASE
#define MK_LAST_PHASE 8
#endif

constexpr int NB = 4, SEQ = 4096, DM = 4096, NMETA = 16, TR = SEQ + NMETA  , TP = 4224  , M = NB * TP  ;
constexpr float EPS = 1e-6f;
constexpr int NV1 = 14080;
constexpr float LOG2E = 1.4426950408889634f;
constexpr float QB_SCALE = 0.08838834764831845f * LOG2E;
constexpr float QA_SCALE = 0.07216878364870323f * LOG2E;
constexpr int NWAVES = 8;
constexpr int NTOK = NB * SEQ;
constexpr int MK = NTOK + 256;
constexpr int MW = 130;
__device__ __forceinline__ int row_pos(int row) { return row < NTOK ? NMETA + (row & (SEQ - 1)) : row - NTOK; }
__device__ __forceinline__ int pos_row(int b, int p) { return p < NMETA ? NTOK + p : b * SEQ + (p - NMETA); }

constexpr size_t HM = 512u * 1024u;
constexpr size_t WS_CTL = 0, CTL_ZERO_BYTES = 2 * HM;
constexpr size_t WS_ROPE_M = 2 * HM;
constexpr size_t WS_ROPE_D = 5 * HM;
constexpr size_t WS_ROPE_I = 7 * HM;
constexpr size_t WS_SK   = 8 * HM;
constexpr size_t WS_WUQ  = 10 * HM;
constexpr size_t WS_WUKV = 22 * HM;
constexpr size_t WS_WBR  = 30 * HM;
constexpr size_t WS_WOUT = 94 * HM;
constexpr size_t WS_WQ   = 158 * HM;
constexpr size_t WS_EID  = 190 * HM;
constexpr size_t WS_GATE = 207 * HM;
constexpr size_t WS_MASK = 224 * HM;
constexpr size_t WS_KPE  = 242 * HM;
constexpr size_t WS_KIX  = 247 * HM;
constexpr size_t WS_WIX  = 252 * HM;
constexpr size_t WS_SCU  = 255 * HM;
constexpr size_t WS_SCV  = 255 * HM + 65536;
constexpr size_t WS_SX   = 255 * HM + 131072;
constexpr size_t WS_SW   = 255 * HM + 200704;
constexpr size_t WS_SWBR = 255 * HM + 294912;
constexpr size_t WS_SWOUT= 255 * HM + 311296;
constexpr size_t WS_SOAB = 255 * HM + 327680;
constexpr size_t WS_SMRG = 255 * HM + 393216;
constexpr size_t R23 = 260 * HM;
constexpr size_t WS_XN   = R23;
constexpr size_t WS_WIN  = R23 + 264 * HM;
constexpr size_t P1O = R23 + 484 * HM;
constexpr size_t WS_CQ   = P1O;
constexpr size_t WS_CKV  = P1O + 66 * HM;
constexpr size_t WS_QB   = P1O + 99 * HM;
constexpr size_t WS_KB   = P1O + 231 * HM;
constexpr size_t WS_VB   = P1O + 264 * HM;
constexpr size_t WS_QIX  = P1O + 297 * HM;
constexpr size_t WS_GA   = P1O + 363 * HM;
constexpr size_t WS_GB   = P1O + 627 * HM;
constexpr size_t R4 = P1O + 892 * HM;
constexpr size_t WS_OAB  = R4;
constexpr size_t WS_XN8  = R4;
constexpr size_t WS_WG8  = R4 + 132 * HM;
constexpr size_t WS_WUQ8 = R4 + 232 * HM;
constexpr size_t WS_WUKV8= R4 + 238 * HM;
constexpr size_t WS_SWUQ = 255 * HM + 458752;
constexpr size_t WS_SWUKV= 255 * HM + 475136;
constexpr size_t WS_PQ   = R4;
constexpr size_t WS_END  = R4 + 264 * HM;
constexpr size_t WS_QN   = R23;
constexpr size_t WS_QR   = R23 + 132 * HM;
constexpr size_t WS_KN   = R23 + 198 * HM;
constexpr size_t WS_VA   = R23 + 330 * HM;
constexpr size_t WS_MRG  = R23;
constexpr size_t WS_U    = R23;
constexpr size_t WS_V    = R23 + 256 * HM;
constexpr size_t WS_H1F  = R23 + 512 * HM;
constexpr size_t WS_H1B  = R23 + 1040 * HM;
static_assert(WS_VA + 132 * HM <= P1O && WS_H1F >= P1O && WS_H1B + 264 * HM <= R4 && WS_GB + 264 * HM <= R4, "ws map");
constexpr int CW_TMO = 0;
constexpr int CW_BAR = 4096;
constexpr int CW_QUEUE = 8192;
constexpr int CW_VMAX = 12288;
constexpr int CW_SSQ_CQ = 16384, CW_SSQ_CKV = 16384 + 2 * 17408, CW_SSQ_H1 = 16384 + 4 * 17408;
static_assert((CW_SSQ_H1 + 2 * 17408) * 4 <= (int)CTL_ZERO_BYTES, "ctl");

constexpr int RING_BYTES = 131072;
constexpr int LDSCTL_OFF = RING_BYTES;
constexpr int LDS_BYTES = 147456;

__device__ __forceinline__ unsigned f2bf(float f) { unsigned u = __float_as_uint(f); return (u + 0x7fffu + ((u >> 16) & 1u)) >> 16; }
__device__ __forceinline__ unsigned pk2(float lo, float hi) { return f2bf(lo) | (f2bf(hi) << 16); }
typedef __bf16 bf16x2_t __attribute__((ext_vector_type(2)));
__device__ __forceinline__ unsigned cvt_pk_bf16(float lo, float hi) { return __builtin_bit_cast(unsigned, __builtin_convertvector((f32x2){lo, hi}, bf16x2_t)); }
__device__ __forceinline__ float bf_lo(unsigned w) { return __uint_as_float(w << 16); }
__device__ __forceinline__ float bf_hi(unsigned w) { return __uint_as_float(w & 0xffff0000u); }
__device__ __forceinline__ u32x4 pack8(f32x4 a, f32x4 b) { u32x4 w; w.x = cvt_pk_bf16(a[0], a[1]); w.y = cvt_pk_bf16(a[2], a[3]); w.z = cvt_pk_bf16(b[0], b[1]); w.w = cvt_pk_bf16(b[2], b[3]); return w; }
__device__ __forceinline__ float wave_sum(float v) {
#pragma unroll
    for (int o = 1; o < 64; o <<= 1) v += __shfl_xor(v, o);
    return v;
}
#define LDS_WAIT() asm volatile("s_waitcnt lgkmcnt(0)" ::: "memory")
#define VM_WAIT() asm volatile("s_waitcnt vmcnt(0)" ::: "memory")
typedef unsigned long long u64;
__device__ __forceinline__ void ssq_add(u64* p, float v) { (void)__hip_atomic_fetch_add(p, (u64)(v * 16777216.0f), __ATOMIC_RELAXED, __HIP_MEMORY_SCOPE_AGENT); }
__device__ __forceinline__ float ssq_get(const u64* p) { return (float)((double)(*p) * (1.0 / 16777216.0)); }
namespace pg8 {
#define PG8_LAS __attribute__((address_space(3)))
typedef unsigned short bf16_t;
typedef short bf16x8 __attribute__((ext_vector_type(8)));
typedef float f32x4 __attribute__((ext_vector_type(4)));
typedef unsigned u32x4 __attribute__((ext_vector_type(4)));
constexpr int BM = 256, BK = 64, HALF = 128, HTB = HALF * BK * 2  , STAGE_BYTES = 8 * HTB, NXCD = 8, WGM = 8;

__host__ __device__ __forceinline__ int lds_byte(int r, int c) { const int st = (r >> 4) * 2 + (c >> 5), rr = r & 15, cc = c & 31, ob = rr * 64 + cc * 2; return st * 1024 + (ob ^ (((ob >> 9) & 1) << 5)); }
__host__ __device__ __forceinline__ void stage_rc(int b, int& R, int& C) { const int st = b / 1024, sb = b % 1024, swz = sb ^ (((sb >> 9) & 1) << 5); R = (st >> 1) * 16 + swz / 64; C = (st & 1) * 32 + (swz % 64) / 2; }
__host__ __device__ __forceinline__ int perm32(int rho) { const int n = rho >> 4, i = rho & 15; return 8 * (i >> 2) + 4 * n + (i & 3); }

typedef int i32x4_t __attribute__((ext_vector_type(4)));
typedef int i32x8_t __attribute__((ext_vector_type(8)));
__device__ __forceinline__ i32x8_t cat8(bf16x8 lo, bf16x8 hi) { const i32x4_t a = __builtin_bit_cast(i32x4_t, lo), b = __builtin_bit_cast(i32x4_t, hi); return __builtin_shufflevector(a, b, 0, 1, 2, 3, 4, 5, 6, 7); }
__device__ __forceinline__ void mfma_f8_acc(f32x4& c, const i32x8_t a, const i32x8_t b) {
#if defined(__HIP_DEVICE_COMPILE__)
    int sc = 0x7F7F7F7F;
    asm volatile("v_mfma_scale_f32_16x16x128_f8f6f4 %0, %1, %2, %0, %3, %3 op_sel_hi:[0,0,0]" : "+v"(c) : "v"(a), "v"(b), "v"(sc));
#else
    (void)c; (void)a; (void)b;
#endif
}
struct Unit { int pm, pn, kh; };
struct Gemm { const bf16_t* A; const bf16_t* Bt; int M, N, K, KL; };

struct StaticOrder {
    int nM, nN, nwg, G, c;
    __host__ __device__ void init(int M, int N, int G_, int c_) { nM = M / BM; nN = N / BM; nwg = nM * nN; G = G_; c = c_; }
    __host__ __device__ bool next(int i, Unit& u) const {
        const long L = (long)i * G + c; if (L >= nwg) return false;
        int wgid = (int)L; { const int q = nwg / NXCD, r = nwg % NXCD, xcd = wgid % NXCD, off = wgid / NXCD; wgid = (xcd < r ? xcd * (q + 1) : r * (q + 1) + (xcd - r) * q) + off; }
        const int nig = WGM * nN, gid = wgid / nig, fm = gid * WGM, gsz = (nM - fm) < WGM ? (nM - fm) : WGM;
        u.pm = fm + ((wgid % nig) % gsz); u.pn = (wgid % nig) / gsz; u.kh = 0; return true;
    }
    __device__ __forceinline__ void a_ready(const Unit&) const {}
    __device__ __forceinline__ void done(const Unit&) const {}
};

struct StaticOrder2 {
    StaticOrder base;
    __host__ __device__ void init(int M, int N, int G_, int c_) { base.init(M, N, G_, c_); }
    __host__ __device__ bool next(int i, Unit& u) const { if (!base.next(i >> 1, u)) return false; u.kh = i & 1; return true; }
    __device__ __forceinline__ void a_ready(const Unit&) const {}
    __device__ __forceinline__ void done(const Unit&) const {}
};

template <class Epi, class Sched, bool ALIGN_EPI = false, bool SP2 = false>
__device__ __forceinline__ void gemm_phase(PG8_LAS unsigned char* lds, const Gemm g, const Sched& S, const Epi& E) {
    int tid_; asm volatile("v_mov_b32 %0, %1" : "=v"(tid_) : "v"(threadIdx.x));
    const int tid = tid_, wid = __builtin_amdgcn_readfirstlane(tid >> 6), lane = tid & 63, wr = wid >> 2, wc = wid & 3, fr = lane & 15, fq = lane >> 4;
    const int K = g.K, nt = g.KL / BK; const size_t khoff = (size_t)g.KL * 2;
    unsigned voffA[2], voffB[2];
#pragma unroll
    for (int i = 0; i < 2; ++i) { int R, C; stage_rc(tid * 16 + i * 8192, R, C); const int Rb = Epi::PERM ? ((R & ~31) + perm32(R & 31)) : R;
        voffA[i] = (unsigned)(R * K + C) * 2u; voffB[i] = (unsigned)(Rb * K + C) * 2u; }
    const size_t kstep = (size_t)(BK * 2);
    const size_t hstep = (size_t)HALF * K * 2;
    const size_t tstep = 2 * hstep;
    const unsigned ldsw = (unsigned)wid * 1024u;
    const int aoff = lds_byte(wr * 64 + fr, fq * 8), boff = lds_byte(wc * 32 + fr, fq * 8);
#define PG8_SA(b, h) (((b) * 2 + (h)) * HTB)
#define PG8_SB(b, h) ((4 + (b) * 2 + (h)) * HTB)
#define PG8_STAGE(bufoff, gbase, voff) do { _Pragma("unroll") for (int _i = 0; _i < 2; ++_i) \
        __builtin_amdgcn_global_load_lds((const unsigned*)((const char*)(gbase) + (voff)[_i]), (PG8_LAS unsigned*)(lds + (bufoff) + ldsw + _i * 8192), 16, 0, 0); } while (0)
#define PG8_LDA(dst, b, h) do { _Pragma("unroll") for (int m = 0; m < 4; ++m) _Pragma("unroll") for (int k = 0; k < 2; ++k) dst[m][k] = *(const PG8_LAS bf16x8*)(lds + PG8_SA(b, h) + aoff + m * 2048 + k * 1024); } while (0)
#define PG8_LDB(dst, b, h) do { _Pragma("unroll") for (int n = 0; n < 2; ++n) _Pragma("unroll") for (int k = 0; k < 2; ++k) dst[n][k] = *(const PG8_LAS bf16x8*)(lds + PG8_SB(b, h) + boff + n * 2048 + k * 1024); } while (0)
#define PG8_MMA(ai, bj, At, Bt) do { __builtin_amdgcn_s_setprio(1); _Pragma("unroll") for (int m = 0; m < 4; ++m) _Pragma("unroll") for (int n = 0; n < 2; ++n) { \
        if constexpr (Epi::FP8) mfma_f8_acc(acc[ai][bj][m][n], cat8(Bt[n][0], Bt[n][1]), cat8(At[m][0], At[m][1])); \
        else { _Pragma("unroll") for (int k = 0; k < 2; ++k) acc[ai][bj][m][n] = __builtin_amdgcn_mfma_f32_16x16x32_bf16(Bt[n][k], At[m][k], acc[ai][bj][m][n], 0, 0, 0); } } \
        __builtin_amdgcn_s_setprio(0); } while (0)
#define PG8_WAIT_V(n) asm volatile("s_waitcnt vmcnt(" #n ")" ::: "memory")
#define PG8_WAIT_L(n) asm volatile("s_waitcnt lgkmcnt(" #n ")" ::: "memory")
#define PG8_BAR __builtin_amdgcn_s_barrier()
#define PG8_SCHED __builtin_amdgcn_sched_barrier(0)
    Unit cur, nxt; int ui = 0;
    if (!S.next(0, cur)) return;
    f32x4 acc[2][2][4][2];
#pragma unroll
    for (int a = 0; a < 2; ++a)
#pragma unroll
        for (int b = 0; b < 2; ++b)
#pragma unroll
            for (int m = 0; m < 4; ++m)
#pragma unroll
                for (int n = 0; n < 2; ++n) acc[a][b][m][n] = (f32x4){0.f, 0.f, 0.f, 0.f};
    bf16x8 At[4][2], B0[2][2], B1[2][2];
    const char* cA = (const char*)g.A + (size_t)cur.pm * tstep + (size_t)cur.kh * khoff; const char* cB = (const char*)g.Bt + (size_t)cur.pn * tstep + (size_t)cur.kh * khoff;
    S.a_ready(cur);
    if constexpr (SP2) {
        PG8_STAGE(PG8_SB(0, 0), cB, voffB); PG8_STAGE(PG8_SB(0, 1), cB + hstep, voffB); PG8_STAGE(PG8_SA(0, 0), cA, voffA); PG8_STAGE(PG8_SA(0, 1), cA + hstep, voffA);
        if (wr == 1) PG8_BAR;
        PG8_WAIT_V(2); PG8_BAR;
        PG8_STAGE(PG8_SB(1, 0), cB + kstep, voffB); PG8_STAGE(PG8_SA(1, 0), cA + kstep, voffA); PG8_STAGE(PG8_SB(1, 1), cB + hstep + kstep, voffB);
        PG8_WAIT_V(6); PG8_BAR;
    } else {
        PG8_STAGE(PG8_SB(0, 0), cB, voffB); PG8_STAGE(PG8_SA(0, 0), cA, voffA); PG8_STAGE(PG8_SB(0, 1), cB + hstep, voffB); PG8_STAGE(PG8_SA(0, 1), cA + hstep, voffA);
        if (wr == 1) PG8_BAR;
        PG8_WAIT_V(4); PG8_BAR;
        PG8_STAGE(PG8_SB(1, 0), cB + kstep, voffB); PG8_STAGE(PG8_SA(1, 0), cA + kstep, voffA); PG8_STAGE(PG8_SB(1, 1), cB + hstep + kstep, voffB);
        PG8_WAIT_V(6); PG8_BAR;
    }
    for (;;) {
        const bool has_next = S.next(ui + 1, nxt);
        const char* nA = has_next ? (const char*)g.A + (size_t)nxt.pm * tstep + (size_t)nxt.kh * khoff : cA; const char* nB = has_next ? (const char*)g.Bt + (size_t)nxt.pn * tstep + (size_t)nxt.kh * khoff : cB;
        for (int t = 0; t < nt; t += 2) {
            const bool last = (t == nt - 2);
            const char* a1 = cA + (size_t)(t + 1) * kstep;
            const char* a2 = last ? nA : cA + (size_t)(t + 2) * kstep; const char* b2 = last ? nB : cB + (size_t)(t + 2) * kstep;
            const char* a3 = a2 + kstep; const char* b3 = b2 + kstep;
            if (last && has_next) S.a_ready(nxt);
            if constexpr (SP2) {
            PG8_LDB(B0, 0, 0); PG8_LDB(B1, 0, 1); PG8_SCHED; PG8_LDA(At, 0, 0); PG8_STAGE(PG8_SA(1, 1), a1 + hstep, voffA);
            PG8_WAIT_V(8); PG8_WAIT_L(0); PG8_BAR; PG8_MMA(0, 0, At, B0); PG8_MMA(0, 1, At, B1); PG8_BAR; PG8_SCHED;
            PG8_LDA(At, 0, 1); PG8_STAGE(PG8_SB(0, 0), b2, voffB); PG8_STAGE(PG8_SB(0, 1), b2 + hstep, voffB); PG8_STAGE(PG8_SA(0, 0), a2, voffA);
            PG8_WAIT_V(8); PG8_WAIT_L(0); PG8_BAR; PG8_MMA(1, 0, At, B0); PG8_MMA(1, 1, At, B1); PG8_BAR; PG8_SCHED;
            PG8_LDB(B0, 1, 0); PG8_LDB(B1, 1, 1); PG8_SCHED; PG8_LDA(At, 1, 0); PG8_STAGE(PG8_SA(0, 1), a2 + hstep, voffA);
            PG8_WAIT_V(8); PG8_WAIT_L(0); PG8_BAR; PG8_MMA(0, 0, At, B0); PG8_MMA(0, 1, At, B1); PG8_BAR; PG8_SCHED;
            PG8_LDA(At, 1, 1); PG8_STAGE(PG8_SB(1, 0), b3, voffB); PG8_STAGE(PG8_SB(1, 1), b3 + hstep, voffB); PG8_STAGE(PG8_SA(1, 0), a3, voffA);
            PG8_WAIT_V(8); PG8_WAIT_L(0); PG8_BAR; PG8_MMA(1, 0, At, B0); PG8_MMA(1, 1, At, B1); PG8_BAR; PG8_SCHED;
            } else {
            PG8_LDB(B0, 0, 0); PG8_SCHED; PG8_LDA(At, 0, 0); PG8_STAGE(PG8_SA(1, 1), a1 + hstep, voffA);
            PG8_WAIT_L(8); PG8_BAR; PG8_WAIT_L(0); PG8_MMA(0, 0, At, B0); PG8_BAR; PG8_SCHED;
            PG8_LDB(B1, 0, 1); PG8_STAGE(PG8_SB(0, 0), b2, voffB);
            PG8_BAR; PG8_WAIT_L(0); PG8_MMA(0, 1, At, B1); PG8_BAR;
            PG8_LDA(At, 0, 1); PG8_STAGE(PG8_SA(0, 0), a2, voffA);
            PG8_BAR; PG8_WAIT_L(0); PG8_MMA(1, 0, At, B0); PG8_BAR; PG8_SCHED;
            PG8_STAGE(PG8_SB(0, 1), b2 + hstep, voffB);
            PG8_WAIT_V(6); PG8_BAR; PG8_MMA(1, 1, At, B1); PG8_BAR;
            PG8_LDB(B0, 1, 0); PG8_SCHED; PG8_LDA(At, 1, 0); PG8_STAGE(PG8_SA(0, 1), a2 + hstep, voffA);
            PG8_WAIT_L(8); PG8_BAR; PG8_WAIT_L(0); PG8_MMA(0, 0, At, B0); PG8_BAR; PG8_SCHED;
            PG8_LDB(B1, 1, 1); PG8_STAGE(PG8_SB(1, 0), b3, voffB);
            PG8_BAR; PG8_WAIT_L(0); PG8_MMA(0, 1, At, B1); PG8_BAR;
            PG8_LDA(At, 1, 1); PG8_STAGE(PG8_SA(1, 0), a3, voffA);
            PG8_BAR; PG8_WAIT_L(0); PG8_MMA(1, 0, At, B0); PG8_BAR; PG8_SCHED;
            PG8_STAGE(PG8_SB(1, 1), b3 + hstep, voffB);
            PG8_WAIT_V(6); PG8_BAR; PG8_MMA(1, 1, At, B1); PG8_BAR;
            }
        }
        if constexpr (ALIGN_EPI) { if (wr == 0) PG8_BAR; }
        if constexpr (!Epi::AFTER_DRAIN) { E(acc, cur, wr, wc, fr, fq); S.done(cur); }
        if (!has_next) break;
        if (!(Epi::SPLITK2 && cur.kh == 0))
#pragma unroll
        for (int a = 0; a < 2; ++a)
#pragma unroll
            for (int b = 0; b < 2; ++b)
#pragma unroll
                for (int m = 0; m < 4; ++m)
#pragma unroll
                    for (int n = 0; n < 2; ++n) acc[a][b][m][n] = (f32x4){0.f, 0.f, 0.f, 0.f};
        cur = nxt; cA = nA; cB = nB; ++ui;
        if constexpr (ALIGN_EPI) { if (wr == 1) PG8_BAR; }
    }
    PG8_WAIT_V(0);
    if constexpr (!ALIGN_EPI) { if (wr == 0) PG8_BAR; }
    PG8_BAR;
    if constexpr (Epi::AFTER_DRAIN) { E.fused(acc, cur, wr, wc, fr, fq, lds, wid, lane); S.done(cur); }
#undef PG8_SA
#undef PG8_SB
#undef PG8_STAGE
#undef PG8_LDA
#undef PG8_LDB
#undef PG8_MMA
#undef PG8_WAIT_V
#undef PG8_WAIT_L
#undef PG8_BAR
#undef PG8_SCHED
}
}
namespace epi {
using pg8::Unit;
typedef f32x4 Acc[2][2][4][2];

__device__ __forceinline__ void rot2(f32x4& v, const f32x4 cs) {
    const float a1 = v[0] * cs[0] - v[1] * cs[1], a2 = v[1] * cs[0] + v[0] * cs[1];
    const float b1 = v[2] * cs[2] - v[3] * cs[3], b2 = v[3] * cs[2] + v[2] * cs[3];
    v = (f32x4){a1, a2, b1, b2};
}
__device__ __forceinline__ float sigm(float x) { return 1.0f / (1.0f + __expf(-x)); }
__device__ __forceinline__ void vmax_publish(unsigned* word, float mx) {
#pragma unroll
    for (int o = 1; o < 64; o <<= 1) mx = fmaxf(mx, __shfl_xor(mx, o));
    if ((threadIdx.x & 63) == 0) atomicMax(word, __float_as_uint(mx));
}
__device__ __forceinline__ float amax8(f32x4 a, f32x4 b) { return fmaxf(fmaxf(fmaxf(fabsf(a[0]), fabsf(a[1])), fmaxf(fabsf(a[2]), fabsf(a[3]))), fmaxf(fmaxf(fabsf(b[0]), fabsf(b[1])), fmaxf(fabsf(b[2]), fabsf(b[3])))); }
__device__ __forceinline__ void unpack8_fp8(const u32x2 w, f32x4& a, f32x4& b) {
    const f32x2 p0 = __builtin_amdgcn_cvt_pk_f32_fp8((int)w.x, false), p1 = __builtin_amdgcn_cvt_pk_f32_fp8((int)w.x, true), p2 = __builtin_amdgcn_cvt_pk_f32_fp8((int)w.y, false), p3 = __builtin_amdgcn_cvt_pk_f32_fp8((int)w.y, true);
    a = (f32x4){p0.x, p0.y, p1.x, p1.y}; b = (f32x4){p2.x, p2.y, p3.x, p3.y};
}
__device__ __forceinline__ float sat8(float x) { return fminf(fmaxf(x, -448.0f), 448.0f); }
__device__ __forceinline__ u32x2 pack8_fp8(f32x4 a, f32x4 b) {
    int p0 = 0, p1 = 0;
    p0 = __builtin_amdgcn_cvt_pk_fp8_f32(sat8(a[0]), sat8(a[1]), p0, false); p0 = __builtin_amdgcn_cvt_pk_fp8_f32(sat8(a[2]), sat8(a[3]), p0, true);
    p1 = __builtin_amdgcn_cvt_pk_fp8_f32(sat8(b[0]), sat8(b[1]), p1, false); p1 = __builtin_amdgcn_cvt_pk_fp8_f32(sat8(b[2]), sat8(b[3]), p1, true);
    return (u32x2){(unsigned)p0, (unsigned)p1};
}

template <bool F8> struct EpiIn {
    static constexpr bool PERM = true, AFTER_DRAIN = false, SPLITK2 = false, FP8 = F8;
    bf16_t *cq, *ckv, *qb, *kb, *vb, *qix, *kpe, *kix, *ga, *gb; float* wix; u64 *ssq_cq, *ssq_ckv;
    const float *ropeM, *ropeD, *ropeI;
    unsigned* vmaxw;
    const float *sx, *sw;
    __device__ __forceinline__ void operator()(const Acc& acc, const Unit& u, int wr, int wc, int fr, int fq) const {
        const int vt = F8 ? (u.pn < 18 ? u.pn : u.pn + 5) : u.pn + 18, rowb = u.pm * 256 + wr * 64 + fr, ct = wc * 32 + 8 * fq;
        f32x4 wsc[2][2];
        if (F8) {
#pragma unroll
            for (int bj = 0; bj < 2; ++bj) { const f32x4* p = (const f32x4*)(sw + u.pn * 256 + ct + bj * 128); wsc[bj][0] = p[0]; wsc[bj][1] = p[1]; }
        }
#define AV(ai_, bj_, m_, n_) (F8 ? acc[ai_][bj_][m_][n_] * rs * wsc[bj_][n_] : acc[ai_][bj_][m_][n_])
        if (vt < 6) {
            bf16_t* dst = vt < 4 ? cq : ckv; const int ld = vt < 4 ? 1024 : 512, cb = (vt < 4 ? vt : vt - 4) * 256 + ct; u64* ssq = vt < 4 ? ssq_cq : ssq_ckv;
#pragma unroll
            for (int ai = 0; ai < 2; ++ai)
#pragma unroll
                for (int m = 0; m < 4; ++m) { const int row = rowb + ai * 128 + m * 16; const float rs = F8 ? sx[row] : 1.f; (void)rs; float s = 0.f;
#pragma unroll
                    for (int bj = 0; bj < 2; ++bj) { const f32x4 v0 = AV(ai, bj, m, 0), v1 = AV(ai, bj, m, 1);
                        s += (v0[0] * v0[0] + v0[1] * v0[1]) + (v0[2] * v0[2] + v0[3] * v0[3]) + (v1[0] * v1[0] + v1[1] * v1[1]) + (v1[2] * v1[2] + v1[3] * v1[3]);
                        *(u32x2*)((unsigned char*)dst + (size_t)row * ld + cb + bj * 128) = pack8_fp8(v0, v1); }
                    s += __shfl_xor(s, 16); s += __shfl_xor(s, 32);
                    if (fq == 0 && ssq) ssq_add(ssq + row, s); }
        } else if (vt < 16) {
            const bool isq = vt < 14; bf16_t* dst = isq ? qb : kb; const int ld = isq ? 2048 : 512, cb = (isq ? vt - 6 : vt - 14) * 256 + ct;
#pragma unroll
            for (int ai = 0; ai < 2; ++ai)
#pragma unroll
                for (int m = 0; m < 4; ++m) { const int row = rowb + ai * 128 + m * 16, t = row_pos(row); const float rs = F8 ? sx[row] : 1.f; (void)rs;
                    f32x4 cs0 = (f32x4){1.f, 0.f, 1.f, 0.f}, cs1 = cs0;
                    if (wc == 0) { const f32x4* p = (const f32x4*)(ropeD + ((size_t)t * 16 + 4 * fq) * 2); cs0 = p[0]; cs1 = p[1]; }
#pragma unroll
                    for (int bj = 0; bj < 2; ++bj) { f32x4 v0 = AV(ai, bj, m, 0), v1 = AV(ai, bj, m, 1);
                        if (wc == 0) { rot2(v0, cs0); rot2(v1, cs1); }
                        *(u32x2*)((unsigned char*)dst + (size_t)row * ld + cb + bj * 128) = pack8_fp8(v0, v1); } }
        } else if (vt < 18) {
            const int cb = (vt - 16) * 256 + ct; float vmx = 0.f;
#pragma unroll
            for (int ai = 0; ai < 2; ++ai)
#pragma unroll
                for (int m = 0; m < 4; ++m) { const int row = rowb + ai * 128 + m * 16; const float rs = F8 ? sx[row] : 1.f; (void)rs;
#pragma unroll
                    for (int bj = 0; bj < 2; ++bj) { const f32x4 v0 = AV(ai, bj, m, 0), v1 = AV(ai, bj, m, 1); vmx = fmaxf(vmx, amax8(v0, v1)); *(u32x2*)((unsigned char*)vb + (size_t)row * 512 + cb + bj * 128) = pack8_fp8(v0, v1); } }
            vmax_publish(vmaxw, vmx);
        } else if (vt < 22) {
            const int cb = (vt - 18) * 256 + ct; const bool rt = ((wc & 1) == 0) && (fq < 2);
#pragma unroll
            for (int ai = 0; ai < 2; ++ai)
#pragma unroll
                for (int m = 0; m < 4; ++m) { const int row = rowb + ai * 128 + m * 16, t = row_pos(row); const float rs = F8 ? sx[row] : 1.f; (void)rs;
                    f32x4 cs0 = (f32x4){1.f, 0.f, 1.f, 0.f}, cs1 = cs0;
                    if (rt) { const f32x4* p = (const f32x4*)(ropeI + ((size_t)t * 8 + 4 * fq) * 2); cs0 = p[0]; cs1 = p[1]; }
#pragma unroll
                    for (int bj = 0; bj < 2; ++bj) { f32x4 v0 = AV(ai, bj, m, 0), v1 = AV(ai, bj, m, 1);
                        if (rt) { rot2(v0, cs0); rot2(v1, cs1); }
                        *(u32x4*)(qix + (size_t)row * 1024 + cb + bj * 128) = pack8(v0, v1); } }
        } else if (vt == 22) {
#pragma unroll
            for (int ai = 0; ai < 2; ++ai)
#pragma unroll
                for (int m = 0; m < 4; ++m) { const int row = rowb + ai * 128 + m * 16, t = row_pos(row); const float rs = F8 ? sx[row] : 1.f; (void)rs;
                    f32x4 v0 = AV(ai, 0, m, 0), v1 = AV(ai, 0, m, 1);
                    if (wc < 2) { const f32x4* p = (const f32x4*)(ropeM + ((size_t)t * 32 + 16 * wc + 4 * fq) * 2); rot2(v0, p[0]); rot2(v1, p[1]);
                        *(u32x2*)((unsigned char*)kpe + (size_t)row * 64 + ct) = pack8_fp8(v0, v1);
                    } else { if (wc == 2 && fq < 2) { const f32x4* p = (const f32x4*)(ropeI + ((size_t)t * 8 + 4 * fq) * 2); rot2(v0, p[0]); rot2(v1, p[1]); }
                        *(u32x4*)(kix + (size_t)row * 64 + (ct - 64)) = pack8(v0, v1); }
                    if (wc == 0 && fq < 2) { float* w = wix + (size_t)row * 16 + 8 * fq; *(f32x4*)w = AV(ai, 1, m, 0); *(f32x4*)(w + 4) = AV(ai, 1, m, 1); } }
        } else {
            const bool isa = vt < 39; bf16_t* dst = isa ? ga : gb; const int cb = (isa ? vt - 23 : vt - 39) * 256 + ct;
#pragma unroll
            for (int ai = 0; ai < 2; ++ai)
#pragma unroll
                for (int m = 0; m < 4; ++m) { const int row = rowb + ai * 128 + m * 16; const float rs = F8 ? sx[row] : 1.f; (void)rs;
#pragma unroll
                    for (int bj = 0; bj < 2; ++bj) { f32x4 v0 = AV(ai, bj, m, 0), v1 = AV(ai, bj, m, 1);
#pragma unroll
                        for (int e = 0; e < 4; ++e) { v0[e] = 256.0f * sigm(v0[e]); v1[e] = 256.0f * sigm(v1[e]); }
                        *(u32x2*)((unsigned char*)dst + (size_t)row * 4096 + cb + bj * 128) = pack8_fp8(v0, v1); } }
        }
#undef AV
    }
};

struct EpiUp {
    static constexpr bool PERM = true, AFTER_DRAIN = false, SPLITK2 = false, FP8 = true;
    unsigned char *d0, *d1; int nt0, ld0, ld1; bool d1_v; const u64* ssq; float invK; const float* rope; const float* sw; unsigned* vmaxw;
    __device__ __forceinline__ void operator()(const Acc& acc, const Unit& u, int wr, int wc, int fr, int fq) const {
        const int vt = u.pn, rowb = u.pm * 256 + wr * 64 + fr, ct = wc * 32 + 8 * fq; const bool first = vt < nt0;
        unsigned char* dst = first ? d0 : d1; const int ld = first ? ld0 : ld1, cb = (first ? vt : vt - nt0) * 256 + ct; const bool rt = (!first) && (rope != nullptr), isv = (!first) && d1_v;
        f32x4 w0[2], w1[2]; float vmx = 0.f;
#pragma unroll
        for (int bj = 0; bj < 2; ++bj) { const f32x4* p = (const f32x4*)(sw + vt * 256 + ct + bj * 128); w0[bj] = p[0]; w1[bj] = p[1]; }
#pragma unroll
        for (int ai = 0; ai < 2; ++ai)
#pragma unroll
            for (int m = 0; m < 4; ++m) { const int row = rowb + ai * 128 + m * 16, t = row_pos(row);
                const float rs = __builtin_amdgcn_rsqf(ssq_get(ssq + row) * invK + EPS);
                f32x4 cs0 = (f32x4){1.f, 0.f, 1.f, 0.f}, cs1 = cs0;
                if (rt) { const f32x4* p = (const f32x4*)(rope + ((size_t)t * 32 + 16 * (wc & 1) + 4 * fq) * 2); cs0 = p[0]; cs1 = p[1]; }
#pragma unroll
                for (int bj = 0; bj < 2; ++bj) { f32x4 v0 = acc[ai][bj][m][0] * rs * w0[bj], v1 = acc[ai][bj][m][1] * rs * w1[bj];
                    if (rt) { rot2(v0, cs0); rot2(v1, cs1); }
                    if (isv) vmx = fmaxf(vmx, amax8(v0, v1));
                    *(u32x2*)(dst + (size_t)row * ld + cb + bj * 128) = pack8_fp8(v0, v1); } }
        if (isv) vmax_publish(vmaxw, vmx);
    }
};

struct EpiBranch {
    static constexpr bool PERM = true, AFTER_DRAIN = false, SPLITK2 = true, FP8 = true;
    const bf16_t *ga, *gb; bf16_t* out; const unsigned* vmaxw; const float* scol;
    __device__ __forceinline__ void operator()(Acc& acc, const Unit& u, int wr, int wc, int fr, int fq) const {
        const int rowb = u.pm * 256 + wr * 64 + fr, cb = u.pn * 256 + wc * 32 + 8 * fq;
        const float vmb = fmaxf(__uint_as_float(vmaxw[0]), 1e-30f), vma = fmaxf(__uint_as_float(vmaxw[64]), 1e-30f);
        if (u.kh == 0) {
            const float rab = vma * __builtin_amdgcn_rcpf(vmb);
#pragma unroll
            for (int ai = 0; ai < 2; ++ai)
#pragma unroll
                for (int m = 0; m < 4; ++m) { const size_t ro = (size_t)(rowb + ai * 128 + m * 16) * 4096 + cb;
#pragma unroll
                    for (int bj = 0; bj < 2; ++bj) { f32x4 a0, a1, b0, b1; unpack8_fp8(*(const u32x2*)((const unsigned char*)ga + ro + bj * 128), a0, a1); unpack8_fp8(*(const u32x2*)((const unsigned char*)gb + ro + bj * 128), b0, b1);
                        f32x4 r0, r1;
#pragma unroll
                        for (int e = 0; e < 4; ++e) { r0[e] = a0[e] * __builtin_amdgcn_rcpf(fmaxf(b0[e], 0.001953125f)); r1[e] = a1[e] * __builtin_amdgcn_rcpf(fmaxf(b1[e], 0.001953125f)); }
                        acc[ai][bj][m][0] = acc[ai][bj][m][0] * (r0 * rab); acc[ai][bj][m][1] = acc[ai][bj][m][1] * (r1 * rab); }
                    asm volatile("" ::: "memory"); }
        } else {
            f32x4 w0[2], w1[2];
#pragma unroll
            for (int bj = 0; bj < 2; ++bj) { const f32x4* p = (const f32x4*)(scol + cb + bj * 128); w0[bj] = p[0]; w1[bj] = p[1]; }
#pragma unroll
            for (int ai = 0; ai < 2; ++ai)
#pragma unroll
                for (int m = 0; m < 4; ++m) { const int row = rowb + ai * 128 + m * 16; const size_t ro = (size_t)row * 4096 + cb; const float rs = vmb * (1.0f / 440.0f);
#pragma unroll
                    for (int bj = 0; bj < 2; ++bj) { f32x4 s0, s1; unpack8_fp8(*(const u32x2*)((const unsigned char*)gb + ro + bj * 128), s0, s1);
                        s0 = s0 * (rs * (1.0f / 256.0f)) * w0[bj]; s1 = s1 * (rs * (1.0f / 256.0f)) * w1[bj];
                        *(u32x4*)(out + ro + bj * 128) = pack8(acc[ai][bj][m][0] * s0, acc[ai][bj][m][1] * s1); } }
        }
    }
};

struct EpiOut {
    static constexpr bool PERM = true, AFTER_DRAIN = false, SPLITK2 = false, FP8 = true;
    const float *x, *meta; float* h1f; bf16_t* h1b; u64* ssq; const float *srow, *scol;
    __device__ __forceinline__ void operator()(const Acc& acc, const Unit& u, int wr, int wc, int fr, int fq) const {
        const int rowb = u.pm * 256 + wr * 64 + fr, cb = u.pn * 256 + wc * 32 + 8 * fq;
#pragma unroll
        for (int ai = 0; ai < 2; ++ai)
#pragma unroll
            for (int m = 0; m < 4; ++m) { const int row = rowb + ai * 128 + m * 16;
                const float* src = x + (size_t)row * DM;
                float s = 0.f; const float rs = srow[row];
#pragma unroll
                for (int bj = 0; bj < 2; ++bj) { const f32x4* wp = (const f32x4*)(scol + cb + bj * 128); f32x4 v0 = acc[ai][bj][m][0] * rs * wp[0], v1 = acc[ai][bj][m][1] * rs * wp[1];
                    v0 = v0 + *(const f32x4*)(src + cb + bj * 128); v1 = v1 + *(const f32x4*)(src + cb + bj * 128 + 4);
                    s += (v0[0] * v0[0] + v0[1] * v0[1]) + (v0[2] * v0[2] + v0[3] * v0[3]) + (v1[0] * v1[0] + v1[1] * v1[1]) + (v1[2] * v1[2] + v1[3] * v1[3]);
                    *(u32x4*)(h1b + (size_t)row * DM + cb + bj * 128) = pack8(v0, v1); }
                s += __shfl_xor(s, 16); s += __shfl_xor(s, 32);
                if (fq == 0 && ssq) ssq_add(ssq + row, s); }
    }
};

struct EpiPQ {
    static constexpr bool PERM = true, AFTER_DRAIN = false, SPLITK2 = false, FP8 = false;
    bf16_t* pq; const u64* ssq;
    __device__ __forceinline__ void operator()(const Acc& acc, const Unit& u, int wr, int wc, int fr, int fq) const {
        const int rowb = u.pm * 256 + wr * 64 + fr, cb = u.pn * 256 + wc * 32 + 8 * fq;
#pragma unroll
        for (int ai = 0; ai < 2; ++ai)
#pragma unroll
            for (int m = 0; m < 4; ++m) { const int row = rowb + ai * 128 + m * 16; const float rs = __builtin_amdgcn_rsqf(ssq_get(ssq + row) * (1.0f / DM) + EPS);
#pragma unroll
                for (int bj = 0; bj < 2; ++bj) *(u32x4*)(pq + (size_t)row * 2048 + cb + bj * 128) = pack8(acc[ai][bj][m][0] * rs, acc[ai][bj][m][1] * rs); }
    }
};
}
#define XB_TMO      128
#define XB_XCNT(j)  (256  + 64 * (j))
#define XB_XSUB(j)  (1280 + 64 * (j))
#define XB_XGEN(j)  (2304 + 64 * (j))
#define XB_TOP      3328
#define XB_TOPGEN   3392
#define XCD_BAR_WORDS 3456
#define XB_SPIN_CAP (1u << 18)
__device__ __forceinline__ unsigned xb_ld(unsigned* p)              { return __hip_atomic_load(p, __ATOMIC_RELAXED, __HIP_MEMORY_SCOPE_AGENT); }
__device__ __forceinline__ unsigned xb_add(unsigned* p, unsigned v) { return __hip_atomic_fetch_add(p, v, __ATOMIC_RELAXED, __HIP_MEMORY_SCOPE_AGENT); }
__device__ __forceinline__ unsigned xb_xcc_id() { return (unsigned)__builtin_amdgcn_s_getreg((3 << 11) | 20) & 0xFu; }
#define XB_SPIN(cond, bar) do { unsigned _sp = 0; while (cond) { __builtin_amdgcn_s_sleep(1); \
    if ((++_sp & 255u) == 0u) { if (xb_ld(&(bar)[XB_TMO])) break; if (_sp > XB_SPIN_CAP) { atomicAdd(&(bar)[XB_TMO], 1u); break; } } } } while (0)
struct XcdBarrier { unsigned* bar; unsigned x; volatile LAS unsigned* st; };
__device__ __forceinline__ XcdBarrier xcd_barrier_post(unsigned* bar, volatile LAS unsigned* st) {
    XcdBarrier b; b.bar = bar; b.x = xb_xcc_id(); b.st = st;
    if (threadIdx.x == 0) (void)xb_add(&bar[XB_XCNT(b.x)], 1u);
    return b;
}
__device__ __forceinline__ void xcd_barrier_complete(unsigned* bar, unsigned x, unsigned& nloc, unsigned& nx) {
    const unsigned G = gridDim.x * gridDim.y * gridDim.z;
    unsigned sum, cnt, mine, sp = 0u;
    for (;;) {
        sum = 0u; cnt = 0u; mine = 0u;
#pragma unroll
        for (unsigned j = 0; j < 16; ++j) { const unsigned c = xb_ld(&bar[XB_XCNT(j)]); sum += c; cnt += (c > 0u) ? 1u : 0u; mine = (j == x) ? c : mine; }
        if (sum == G) break;
        __builtin_amdgcn_s_sleep(1);
        if ((++sp & 255u) == 0u) { if (xb_ld(&bar[XB_TMO])) break; if (sp > XB_SPIN_CAP) { atomicAdd(&bar[XB_TMO], 1u); break; } }
    }
    nloc = mine > 0u ? mine : 1u; nx = cnt > 0u ? cnt : 1u;
}
__device__ __forceinline__ void xcd_barrier(const XcdBarrier& b) {
    asm volatile("s_waitcnt vmcnt(0)" ::: "memory");
    __syncthreads();
    if (threadIdx.x == 0) {
        unsigned* bar = b.bar;
        __builtin_amdgcn_s_waitcnt(0);
        unsigned nloc = b.st[0], nx = b.st[1];
        if (nloc == 0u) { xcd_barrier_complete(bar, b.x, nloc, nx); b.st[0] = nloc; b.st[1] = nx; }
        const unsigned old = xb_add(&bar[XB_XSUB(b.x)], 1u);
        const unsigned gen = old / nloc;
        if (old + 1u == (gen + 1u) * nloc) {
            __builtin_amdgcn_fence(__ATOMIC_RELEASE, "agent");
            asm volatile("s_waitcnt vmcnt(0)" ::: "memory");
            const unsigned og = xb_add(&bar[XB_TOP], 1u);
            const unsigned tg = og / nx;
            if (og + 1u == (tg + 1u) * nx) xb_add(&bar[XB_TOPGEN], 1u);
            else XB_SPIN(xb_ld(&bar[XB_TOPGEN]) == tg, bar);
            __builtin_amdgcn_fence(__ATOMIC_ACQUIRE, "agent");
            xb_add(&bar[XB_XGEN(b.x)], 1u);
            asm volatile("s_waitcnt vmcnt(0)" ::: "memory");
        } else {
            XB_SPIN(xb_ld(&bar[XB_XGEN(b.x)]) == gen, bar);
            __builtin_amdgcn_fence(__ATOMIC_ACQUIRE, "agent");
            asm volatile("s_waitcnt vmcnt(0)" ::: "memory");
        }
    }
    __syncthreads();
}

struct Frame {
    LAS unsigned char* lds;
    unsigned char* ws;
    unsigned* ctl;
    int tid, lane, wave, vcu, G;
    __device__ __forceinline__ const float* in(int i) const { return ((const float* const __attribute__((address_space(4)))*)__builtin_amdgcn_kernarg_segment_ptr())[i]; }
    __device__ __forceinline__ float* out() const { return ((float* const __attribute__((address_space(4)))*)__builtin_amdgcn_kernarg_segment_ptr())[16]; }
};

struct MapId { __device__ __forceinline__ int operator()(int v) const { return v; } };
struct MapIn { __device__ __forceinline__ int operator()(int vn) const {
    const int v = vn < 1280 ? vn + 4608 : (vn < 5888 ? vn - 1280 : vn);
    if (v < 1536) return v;
    if (v < 3584) { const int w = v - 1536, hd = w >> 7; int o = w & 127; if (o < 32) o = (o & 1) ? (o >> 1) + 16 : (o >> 1); return 1600 + hd * 128 + o; }
    if (v < 4096) { const int w = v - 3584, hd = w >> 7; int o = w & 127; if (o < 32) o = (o & 1) ? (o >> 1) + 16 : (o >> 1); return 3648 + hd * 128 + o; }
    if (v < 4608) return 4160 + (v - 4096);
    if (v < 5632) { const int w = v - 4608, hd = w >> 6; int o = w & 63; if (o < 16) o = (o & 1) ? (o >> 1) + 8 : (o >> 1); return 4672 + hd * 64 + o; }
    if (v < 5888) { const int w = v - 5632;
        if (w < 64) return 1536 + ((w & 1) ? (w >> 1) + 32 : (w >> 1));
        if (w < 128) { int o = w - 64; if (o < 16) o = (o & 1) ? (o >> 1) + 8 : (o >> 1); return 5696 + o; }
        if (w < 144) return 5760 + (w - 128);
        return -1; }
    if (v < 9984) return 5776 + (v - 5888);
    return 9872 + (v - 9984);
} };
struct MapUq { __device__ __forceinline__ int operator()(int v) const {
    if (v < 2048) return (v >> 7) * 192 + (v & 127);
    const int w = v - 2048, hd = w >> 6, o = w & 63; return hd * 192 + 128 + ((o & 1) ? (o >> 1) + 32 : (o >> 1)); } };
struct MapUkv { __device__ __forceinline__ int operator()(int v) const {
    if (v < 2048) return (v >> 7) * 256 + (v & 127);
    const int w = v - 2048; return (w >> 7) * 256 + 128 + (w & 127); } };

template <class Map>
__device__ __forceinline__ void p0_transpose_item(const float* W, int K, int Nsrc, int Nvirt, bf16_t* WT, const float* gk, LAS float* scr, int item, int lane, Map map) {
    const int nblk = Nvirt / 32, kb = item / nblk, nb = item % nblk, k0 = 64 * kb, n0 = 32 * nb;
    const int sc = map(n0 + (lane & 31));
    float tv[32];
#pragma unroll
    for (int i = 0; i < 32; ++i) { const int kk = 2 * i + (lane >> 5); tv[i] = (sc >= 0) ? W[(size_t)(k0 + kk) * Nsrc + sc] : 0.f; }
    if (gk) {
#pragma unroll
        for (int i = 0; i < 32; ++i) tv[i] *= gk[k0 + 2 * i + (lane >> 5)]; }
#pragma unroll
    for (int i = 0; i < 32; ++i) scr[(2 * i + (lane >> 5)) * 33 + (lane & 31)] = tv[i];
    LDS_WAIT(); asm volatile("" ::: "memory");
    const int c = lane & 7;
#pragma unroll
    for (int j = 0; j < 4; ++j) { const int n = (lane >> 3) + 8 * j; const LAS float* s = scr + (8 * c) * 33 + n;
        u32x4 o; o.x = pk2(s[0 * 33], s[1 * 33]); o.y = pk2(s[2 * 33], s[3 * 33]); o.z = pk2(s[4 * 33], s[5 * 33]); o.w = pk2(s[6 * 33], s[7 * 33]);
        *(u32x4*)(WT + (size_t)(n0 + n) * K + k0 + 8 * c) = o; }
    LDS_WAIT(); asm volatile("" ::: "memory");
}
__device__ __forceinline__ float wave_max(float v) {
#pragma unroll
    for (int o = 1; o < 64; o <<= 1) v = fmaxf(v, __shfl_xor(v, o));
    return v;
}
__device__ __forceinline__ void p0_xn_row(const Frame& F, int m) {
    const float* x = F.in(0); const float* meta = F.in(1); const float* g = F.in(2);
    bf16_t* o = (bf16_t*)(F.ws + WS_XN) + (size_t)m * DM;
    u32x2* o8 = (u32x2*)o + F.lane;
    if (m >= NTOK + NMETA) {
        unsigned* z8 = (unsigned*)(F.ws + WS_XN8 + (size_t)m * DM) + F.lane;
#pragma unroll
        for (int j = 0; j < 16; ++j) { o8[64 * j] = (u32x2){0u, 0u}; z8[64 * j] = 0u; }
        if (F.lane == 0) ((float*)(F.ws + WS_SX))[m] = 0.f;
        return; }
    const float* src = m < NTOK ? x + (size_t)m * DM : meta + (size_t)(m - NTOK) * DM;
    const f32x4* xr = (const f32x4*)src + F.lane; const f32x4* gr = (const f32x4*)g + F.lane;
    f32x4 v[16]; float s = 0.f;
#pragma unroll
    for (int j = 0; j < 16; ++j) { v[j] = xr[64 * j]; s += (v[j][0] * v[j][0] + v[j][1] * v[j][1]) + (v[j][2] * v[j][2] + v[j][3] * v[j][3]); }
    const float rstd = 1.0f / sqrtf(wave_sum(s) * (1.0f / DM) + EPS);
    float mx = 0.f;
#pragma unroll
    for (int j = 0; j < 16; ++j) { const f32x4 gg = gr[64 * j]; v[j] = v[j] * rstd * gg; o8[64 * j] = (u32x2){pk2(v[j][0], v[j][1]), pk2(v[j][2], v[j][3])};
        mx = fmaxf(mx, fmaxf(fmaxf(fabsf(v[j][0]), fabsf(v[j][1])), fmaxf(fabsf(v[j][2]), fabsf(v[j][3])))); }
    mx = fmaxf(wave_max(mx), 1e-30f);
    const float inv = 448.0f / mx;
    if (F.lane == 0) ((float*)(F.ws + WS_SX))[m] = mx * (1.0f / 448.0f);
    unsigned* q8 = (unsigned*)(F.ws + WS_XN8 + (size_t)m * DM) + F.lane;
#pragma unroll
    for (int j = 0; j < 16; ++j) { f32x4 q = v[j] * inv;
#pragma unroll
        for (int e = 0; e < 4; ++e) q[e] = fminf(fmaxf(q[e], -448.0f), 448.0f);
        int p = 0; p = __builtin_amdgcn_cvt_pk_fp8_f32(q[0], q[1], p, false); p = __builtin_amdgcn_cvt_pk_fp8_f32(q[2], q[3], p, true); q8[64 * j] = (unsigned)p; }
}
__device__ __forceinline__ void p0_prologue(const Frame& F) {
    LAS float* scr = (LAS float*)(F.lds + F.wave * 16384);
    const int gw = F.vcu * NWAVES + F.wave, NGW = F.G * NWAVES;
    const float* w_in = F.in(3); const float* qg = F.in(4); const float* w_uq = F.in(5); const float* kvg = F.in(6); const float* w_ukv = F.in(7);
    const float* w_br = F.in(8); const float* w_out = F.in(9); const float* fg = F.in(10); const float* w_q = F.in(11); const float* sk = F.in(12);
    constexpr int I_IN = 64 * (NV1 / 32), I_UQ = 16 * (3072 / 32), I_UKV = 8 * (4096 / 32), I_BR = 64 * 128, I_OUT = 64 * 128, I_Q = 64 * 64;
    constexpr int NITEMS = I_IN + I_UQ + I_UKV + I_BR + I_OUT + I_Q;
    struct TItem { const float* W; bf16_t* WT; const float* gk; int K, Nsrc, k0, n0, sc; };
    auto decode = [&](int it) -> TItem {
        TItem t; int r = it, nv, mapid;
        if (r < I_IN) { t.W = w_in; t.K = 4096; t.Nsrc = 13968; nv = NV1; t.WT = (bf16_t*)(F.ws + WS_WIN); t.gk = nullptr; mapid = 0; }
        else if ((r -= I_IN) < I_UQ) { t.W = w_uq; t.K = 1024; t.Nsrc = 3072; nv = 3072; t.WT = (bf16_t*)(F.ws + WS_WUQ); t.gk = qg; mapid = 1; }
        else if ((r -= I_UQ) < I_UKV) { t.W = w_ukv; t.K = 512; t.Nsrc = 4096; nv = 4096; t.WT = (bf16_t*)(F.ws + WS_WUKV); t.gk = kvg; mapid = 2; }
        else if ((r -= I_UKV) < I_BR) { t.W = w_br; t.K = 4096; t.Nsrc = 4096; nv = 4096; t.WT = (bf16_t*)(F.ws + WS_H1F); t.gk = nullptr; mapid = 3; }
        else if ((r -= I_BR) < I_OUT) { t.W = w_out; t.K = 4096; t.Nsrc = 4096; nv = 4096; t.WT = (bf16_t*)(F.ws + WS_WOUT); t.gk = nullptr; mapid = 3; }
        else { r -= I_OUT; t.W = w_q; t.K = 4096; t.Nsrc = 2048; nv = 2048; t.WT = (bf16_t*)(F.ws + WS_WQ); t.gk = fg; mapid = 3; }
        const int nblk = nv / 32, kb = r / nblk, nb = r % nblk; t.k0 = 64 * kb; t.n0 = 32 * nb;
        const int v = t.n0 + (F.lane & 31);
        t.sc = mapid == 0 ? MapIn()(v) : (mapid == 1 ? MapUq()(v) : (mapid == 2 ? MapUkv()(v) : v));
        return t; };
#define TLOAD(t, tv) do { _Pragma("unroll") for (int i = 0; i < 32; ++i) { const int kk = 2 * i + (F.lane >> 5); tv[i] = (t.sc >= 0) ? t.W[(size_t)(t.k0 + kk) * t.Nsrc + t.sc] : 0.f; } } while (0)
#define TSTORE(t, tv) do { \
        if (t.gk) { _Pragma("unroll") for (int i = 0; i < 32; ++i) tv[i] *= t.gk[t.k0 + 2 * i + (F.lane >> 5)]; } \
        _Pragma("unroll") for (int i = 0; i < 32; ++i) scr[(2 * i + (F.lane >> 5)) * 33 + (F.lane & 31)] = tv[i]; \
        LDS_WAIT(); asm volatile("" ::: "memory"); \
        const int c_ = F.lane & 7; \
        _Pragma("unroll") for (int j = 0; j < 4; ++j) { const int n = (F.lane >> 3) + 8 * j; const LAS float* s = scr + (8 * c_) * 33 + n; \
            u32x4 o; o.x = pk2(s[0 * 33], s[1 * 33]); o.y = pk2(s[2 * 33], s[3 * 33]); o.z = pk2(s[4 * 33], s[5 * 33]); o.w = pk2(s[6 * 33], s[7 * 33]); \
            *(u32x4*)(t.WT + (size_t)(t.n0 + n) * t.K + t.k0 + 8 * c_) = o; } \
        LDS_WAIT(); asm volatile("" ::: "memory"); } while (0)
    {
        float ta[32], tb[32]; TItem ia, ib;
        int it = gw;
        if (it < NITEMS) { ia = decode(it); TLOAD(ia, ta); }
#pragma unroll 1
        for (; it < NITEMS; it += 2 * NGW) {
            const int i1 = it + NGW, i2 = it + 2 * NGW;
            if (i1 < NITEMS) { ib = decode(i1); TLOAD(ib, tb); }
            TSTORE(ia, ta);
            if (i2 < NITEMS) { ia = decode(i2); TLOAD(ia, ta); }
            if (i1 < NITEMS) TSTORE(ib, tb);
        }
    }
#undef TLOAD
#undef TSTORE
    for (int m = gw; m < MK; m += NGW) p0_xn_row(F, m);
    const int gt = (F.vcu * NWAVES + F.wave) * 64 + F.lane, NGT = NGW * 64;
    for (int i = gt; i < TP * 56; i += NGT) {
        const int t = i / 56, r = i % 56; int j, rot; float* dst;
        if (r < 32) { j = r; rot = 64; dst = (float*)(F.ws + WS_ROPE_M) + ((size_t)t * 32 + j) * 2; }
        else if (r < 48) { j = r - 32; rot = 32; dst = (float*)(F.ws + WS_ROPE_D) + ((size_t)t * 16 + j) * 2; }
        else { j = r - 48; rot = 16; dst = (float*)(F.ws + WS_ROPE_I) + ((size_t)t * 8 + j) * 2; }
        const float ex = (float)(2 * j) / (float)rot;
        const float inv = powf(500000.0f, -ex);
        const float ang = (float)t * inv;
        const double a = (double)ang, kq = rint(a * 0.15915494309189535), rr = fma(-kq, 6.283185307179586, a);
        const float rf = (float)rr;
        dst[0] = cosf(rf); dst[1] = sinf(rf);
    }
    for (int i = gt; i < 16 * 128 * 128 / 8; i += NGT) { const f32x4* s = (const f32x4*)sk + 2 * (size_t)i; const f32x4 a = s[0], b2 = s[1];
        u32x4 o; o.x = pk2(a[0], a[1]); o.y = pk2(a[2], a[3]); o.z = pk2(b2[0], b2[1]); o.w = pk2(b2[2], b2[3]); ((u32x4*)(F.ws + WS_SK))[i] = o; }
}
__device__ __forceinline__ unsigned fp6_code(float q) {
    const unsigned b = __float_as_uint(q), sgn = (b >> 31) << 5; const float aq = fabsf(q);
    const unsigned sub = (unsigned)rintf(aq * 8.0f);
    unsigned ab = b & 0x7fffffffu; ab = ab + 0x7FFFFu + ((ab >> 20) & 1u);
    const unsigned nrm = (ab >> 20) - (126u << 3);
    unsigned code = aq < 1.0f ? sub : nrm; code = code > 31u ? 31u : code;
    return code | sgn;
}
__device__ __forceinline__ void fp6_pack32(const unsigned (&c)[32], unsigned (&w)[6]) {
#pragma unroll
    for (int i = 0; i < 6; ++i) w[i] = 0u;
#pragma unroll
    for (int k = 0; k < 32; ++k) { const int bit = 6 * k, d = bit >> 5, sh = bit & 31; w[d] |= c[k] << sh; if (sh > 26) w[d + 1] |= c[k] >> (32 - sh); }
}
__device__ __forceinline__ void p6_quant_row(const float* src, const float* gain, unsigned char* dst, float* scale_out, int lane) {
    const f32x4* s = (const f32x4*)src + lane; f32x4 v[16]; float mx = 0.f;
#pragma unroll
    for (int j = 0; j < 16; ++j) { v[j] = s[64 * j]; if (gain) v[j] = v[j] * ((const f32x4*)gain)[lane + 64 * j];
        mx = fmaxf(mx, fmaxf(fmaxf(fabsf(v[j][0]), fabsf(v[j][1])), fmaxf(fabsf(v[j][2]), fabsf(v[j][3])))); }
    mx = fmaxf(wave_max(mx), 1e-30f);
    const float sc = mx * (1.0f / 7.5f), inv = 7.5f / mx;
    if (lane == 0) *scale_out = sc;
    unsigned w[12];
#pragma unroll
    for (int g = 0; g < 2; ++g) { unsigned c[32];
#pragma unroll
        for (int j = 0; j < 8; ++j)
#pragma unroll
            for (int i = 0; i < 4; ++i) c[4 * j + i] = fp6_code(v[8 * g + j][i] * inv);
        unsigned ww[6]; fp6_pack32(c, ww);
#pragma unroll
        for (int i = 0; i < 6; ++i) w[6 * g + i] = ww[i]; }
#pragma unroll
    for (int q = 0; q < 3; ++q) *(u32x4*)(dst + 1024 * q + 16 * lane) = (u32x4){w[4 * q], w[4 * q + 1], w[4 * q + 2], w[4 * q + 3]};
}
__device__ __forceinline__ unsigned fp4_code(float q) {
    const float aq = fabsf(q);
    const unsigned c = (aq > 0.25f ? 1u : 0u) + (aq >= 0.75f ? 1u : 0u) + (aq > 1.25f ? 1u : 0u) + (aq >= 1.75f ? 1u : 0u) + (aq > 2.5f ? 1u : 0u) + (aq >= 3.5f ? 1u : 0u) + (aq > 5.0f ? 1u : 0u);
    return c | ((__float_as_uint(q) >> 31) << 3);
}
__device__ __forceinline__ void p6_quant_row4(const float* src, const float* gain, unsigned char* dst, float* scale_out, int lane) {
    const f32x4* s = (const f32x4*)src + lane; f32x4 v[16]; float mx = 0.f;
#pragma unroll
    for (int j = 0; j < 16; ++j) { v[j] = s[64 * j]; if (gain) v[j] = v[j] * ((const f32x4*)gain)[lane + 64 * j];
        mx = fmaxf(mx, fmaxf(fmaxf(fabsf(v[j][0]), fabsf(v[j][1])), fmaxf(fabsf(v[j][2]), fabsf(v[j][3])))); }
    mx = fmaxf(wave_max(mx), 1e-30f);
    const float sc = mx * (1.0f / 6.0f), inv = 6.0f / mx;
    if (lane == 0) *scale_out = sc;
    unsigned w[8];
#pragma unroll
    for (int d = 0; d < 8; ++d) { unsigned x = 0u;
        const f32x4 a = v[2 * d] * inv, b = v[2 * d + 1] * inv;
        x = __builtin_amdgcn_cvt_scalef32_pk_fp4_f32(x, a[0], a[1], 1.0f, 0); x = __builtin_amdgcn_cvt_scalef32_pk_fp4_f32(x, a[2], a[3], 1.0f, 1);
        x = __builtin_amdgcn_cvt_scalef32_pk_fp4_f32(x, b[0], b[1], 1.0f, 2); x = __builtin_amdgcn_cvt_scalef32_pk_fp4_f32(x, b[2], b[3], 1.0f, 3);
        w[d] = x; }
#pragma unroll
    for (int q = 0; q < 2; ++q) *(u32x4*)(dst + 1024 * q + 16 * lane) = (u32x4){w[4 * q], w[4 * q + 1], w[4 * q + 2], w[4 * q + 3]};
}
#ifndef PEER_U_BITS
#define PEER_U_BITS 4
#endif
#ifndef PEER_V_BITS
#define PEER_V_BITS 4
#endif
constexpr int PEER_U_ROWB = PEER_U_BITS == 4 ? 2048 : 3072, PEER_V_ROWB = PEER_V_BITS == 4 ? 2048 : 3072;
__device__ __forceinline__ void p6_quant_regs4(f32x4 (&v)[16], unsigned char* dst, float* scale_out, int lane) {
    float mx = 0.f;
#pragma unroll
    for (int j = 0; j < 16; ++j) mx = fmaxf(mx, fmaxf(fmaxf(fabsf(v[j][0]), fabsf(v[j][1])), fmaxf(fabsf(v[j][2]), fabsf(v[j][3]))));
    mx = fmaxf(wave_max(mx), 1e-30f);
    const float inv = 6.0f / mx;
    if (lane == 0) *scale_out = mx * (1.0f / 6.0f);
    unsigned w[8];
#pragma unroll
    for (int d = 0; d < 8; ++d) { unsigned x = 0u;
        const f32x4 a = v[2 * d] * inv, b = v[2 * d + 1] * inv;
        x = __builtin_amdgcn_cvt_scalef32_pk_fp4_f32(x, a[0], a[1], 1.0f, 0); x = __builtin_amdgcn_cvt_scalef32_pk_fp4_f32(x, a[2], a[3], 1.0f, 1);
        x = __builtin_amdgcn_cvt_scalef32_pk_fp4_f32(x, b[0], b[1], 1.0f, 2); x = __builtin_amdgcn_cvt_scalef32_pk_fp4_f32(x, b[2], b[3], 1.0f, 3);
        w[d] = x; }
#pragma unroll
    for (int q = 0; q < 2; ++q) *(u32x4*)(dst + 1024 * q + 16 * lane) = (u32x4){w[4 * q], w[4 * q + 1], w[4 * q + 2], w[4 * q + 3]};
}
__device__ __forceinline__ void p6_tables(const Frame& F) {
    const float* fg = F.in(10); const float* pu = F.in(13); const float* pv = F.in(14);
    const int gw = F.vcu * NWAVES + F.wave, NGW = F.G * NWAVES, lane = F.lane;
#if PEER_U_BITS == 4 && PEER_V_BITS == 4
    if ((NGW & 1) == 0) {
        const bool isv = gw & 1; const float* tab = isv ? pv : pu; unsigned char* dtab = F.ws + (isv ? WS_V : WS_U); float* stab = (float*)(F.ws + (isv ? WS_SCV : WS_SCU));
        const int e0 = gw >> 1, estep = NGW >> 1;
        f32x4 g[16];
#pragma unroll
        for (int j = 0; j < 16; ++j) g[j] = isv ? (f32x4){1.f, 1.f, 1.f, 1.f} : ((const f32x4*)fg)[lane + 64 * j];
        f32x4 va[16], vb[16];
        if (e0 < 16384) {
#pragma unroll
            for (int j = 0; j < 16; ++j) va[j] = ((const f32x4*)(tab + (size_t)e0 * DM))[lane + 64 * j];
        }
#pragma unroll 1
        for (int e = e0; e < 16384; e += 2 * estep) {
            const int e1 = e + estep, e2 = e + 2 * estep;
            if (e1 < 16384) {
#pragma unroll
                for (int j = 0; j < 16; ++j) vb[j] = ((const f32x4*)(tab + (size_t)e1 * DM))[lane + 64 * j];
            }
#pragma unroll
            for (int j = 0; j < 16; ++j) va[j] = va[j] * g[j];
            p6_quant_regs4(va, dtab + (size_t)e * 2048, stab + e, lane);
            if (e2 < 16384) {
#pragma unroll
                for (int j = 0; j < 16; ++j) va[j] = ((const f32x4*)(tab + (size_t)e2 * DM))[lane + 64 * j];
            }
            if (e1 < 16384) {
#pragma unroll
                for (int j = 0; j < 16; ++j) vb[j] = vb[j] * g[j];
                p6_quant_regs4(vb, dtab + (size_t)e1 * 2048, stab + e1, lane);
            }
        }
        return;
    }
#endif
    for (int it = gw; it < 2 * 16384; it += NGW) { const int e = it >> 1;
        if (it & 1) { if (PEER_V_BITS == 4) p6_quant_row4(pv + (size_t)e * DM, nullptr, F.ws + WS_V + (size_t)e * PEER_V_ROWB, (float*)(F.ws + WS_SCV) + e, F.lane);
                      else p6_quant_row(pv + (size_t)e * DM, nullptr, F.ws + WS_V + (size_t)e * PEER_V_ROWB, (float*)(F.ws + WS_SCV) + e, F.lane); }
        else { if (PEER_U_BITS == 4) p6_quant_row4(pu + (size_t)e * DM, fg, F.ws + WS_U + (size_t)e * PEER_U_ROWB, (float*)(F.ws + WS_SCU) + e, F.lane);
               else p6_quant_row(pu + (size_t)e * DM, fg, F.ws + WS_U + (size_t)e * PEER_U_ROWB, (float*)(F.ws + WS_SCU) + e, F.lane); } }
}

__device__ __forceinline__ void rowquant_fp8(const Frame& F, const unsigned char* src, size_t src_pitch, unsigned char* dst, size_t dst_pitch, float* scale, int nrows) {
    const int gw = F.vcu * NWAVES + F.wave, NGW = F.G * NWAVES, lane = F.lane;
    for (int n = gw; n < nrows; n += NGW) {
        const u32x4* s = (const u32x4*)(src + (size_t)n * src_pitch) + lane;
        u32x4 v[8]; float mx = 0.f;
#pragma unroll
        for (int j = 0; j < 8; ++j) { v[j] = s[64 * j];
#pragma unroll
            for (int e = 0; e < 4; ++e) mx = fmaxf(mx, fmaxf(fabsf(bf_lo(v[j][e])), fabsf(bf_hi(v[j][e])))); }
        mx = fmaxf(wave_max(mx), 1e-30f);
        const float inv = 448.0f / mx;
        if (lane == 0) scale[n] = mx * (1.0f / 448.0f);
        asm volatile("" ::: "memory");
        u32x2* d = (u32x2*)(dst + (size_t)n * dst_pitch) + lane;
#pragma unroll
        for (int j = 0; j < 8; ++j) { int p0 = 0, p1 = 0;
            p0 = __builtin_amdgcn_cvt_pk_fp8_f32(bf_lo(v[j].x) * inv, bf_hi(v[j].x) * inv, p0, false); p0 = __builtin_amdgcn_cvt_pk_fp8_f32(bf_lo(v[j].y) * inv, bf_hi(v[j].y) * inv, p0, true);
            p1 = __builtin_amdgcn_cvt_pk_fp8_f32(bf_lo(v[j].z) * inv, bf_hi(v[j].z) * inv, p1, false); p1 = __builtin_amdgcn_cvt_pk_fp8_f32(bf_lo(v[j].w) * inv, bf_hi(v[j].w) * inv, p1, true);
            d[64 * j] = (u32x2){(unsigned)p0, (unsigned)p1}; }
    }
}
template <int LEN>
__device__ __forceinline__ void rowquant_fp8_n(const Frame& F, const unsigned char* src, unsigned char* dst, float* scale, int nrows) {
    const int gw = F.vcu * NWAVES + F.wave, NGW = F.G * NWAVES, lane = F.lane; constexpr int PER = LEN / 64;
    for (int n = gw; n < nrows; n += NGW) {
        const u32x4* s = (const u32x4*)(src + (size_t)n * LEN * 2) + lane * (PER / 8);
        u32x4 v[PER / 8]; float mx = 0.f;
#pragma unroll
        for (int j = 0; j < PER / 8; ++j) { v[j] = s[j];
#pragma unroll
            for (int e = 0; e < 4; ++e) mx = fmaxf(mx, fmaxf(fabsf(bf_lo(v[j][e])), fabsf(bf_hi(v[j][e])))); }
        mx = fmaxf(wave_max(mx), 1e-30f);
        const float inv = 448.0f / mx;
        if (lane == 0) scale[n] = mx * (1.0f / 448.0f);
        u32x2* d = (u32x2*)(dst + (size_t)n * LEN) + lane * (PER / 8);
#pragma unroll
        for (int j = 0; j < PER / 8; ++j) { int p0 = 0, p1 = 0;
            p0 = __builtin_amdgcn_cvt_pk_fp8_f32(bf_lo(v[j].x) * inv, bf_hi(v[j].x) * inv, p0, false); p0 = __builtin_amdgcn_cvt_pk_fp8_f32(bf_lo(v[j].y) * inv, bf_hi(v[j].y) * inv, p0, true);
            p1 = __builtin_amdgcn_cvt_pk_fp8_f32(bf_lo(v[j].z) * inv, bf_hi(v[j].z) * inv, p1, false); p1 = __builtin_amdgcn_cvt_pk_fp8_f32(bf_lo(v[j].w) * inv, bf_hi(v[j].w) * inv, p1, true);
            d[j] = (u32x2){(unsigned)p0, (unsigned)p1}; }
    }
}
__device__ __forceinline__ void p1_quant_weights(const Frame& F) {
    rowquant_fp8(F, F.ws + WS_WIN + (size_t)1280 * DM * 2, (size_t)DM * 2, F.ws + WS_WG8, (size_t)DM, (float*)(F.ws + WS_SW), 12800);
    rowquant_fp8(F, F.ws + WS_H1F, (size_t)DM * 2, F.ws + WS_WBR, (size_t)DM, (float*)(F.ws + WS_SWBR), 4096);
    rowquant_fp8(F, F.ws + WS_WOUT, (size_t)DM * 2, F.ws + WS_WOUT, (size_t)DM * 2, (float*)(F.ws + WS_SWOUT), 4096);
    rowquant_fp8_n<1024>(F, F.ws + WS_WUQ, F.ws + WS_WUQ8, (float*)(F.ws + WS_SWUQ), 3072);
    rowquant_fp8_n<512>(F, F.ws + WS_WUKV, F.ws + WS_WUKV8, (float*)(F.ws + WS_SWUKV), 4096);
}
#define MFMA32(a, b, c) __builtin_amdgcn_mfma_f32_32x32x16_bf16((a), (b), (c), 0, 0, 0)
__device__ __forceinline__ float relu_i(float x) { const int v = __float_as_int(x); return __int_as_float(v > 0 ? v : 0); }
__device__ __forceinline__ int crow(int i, int h) { return (i & 3) + 8 * (i >> 2) + 4 * h; }
__device__ __forceinline__ float half_sum_f(float v) {
#pragma unroll
    for (int o = 1; o < 32; o <<= 1) v += __shfl_xor(v, o);
    return v;
}
__device__ __forceinline__ int half_sum_i(int v) {
#pragma unroll
    for (int o = 1; o < 32; o <<= 1) v += __shfl_xor(v, o);
    return v;
}
__device__ __forceinline__ float half_max_f(float v) {
#pragma unroll
    for (int o = 1; o < 32; o <<= 1) v = fmaxf(v, __shfl_xor(v, o));
    return v;
}
__device__ __forceinline__ float half_min_f(float v) {
#pragma unroll
    for (int o = 1; o < 32; o <<= 1) v = fminf(v, __shfl_xor(v, o));
    return v;
}
constexpr int IDX_PK = 144, IDX_BUF = 64 * IDX_PK;
__device__ __forceinline__ void idx_task(const Frame& F, int b, int s0c) {
    const int lane = F.lane, r = lane & 31, h = lane >> 5, tid = F.tid;
    const int s0 = s0c + 2 * F.wave;
    LAS unsigned char* lds = F.lds;
    const bf16_t* qix = (const bf16_t*)(F.ws + WS_QIX); const bf16_t* kix = (const bf16_t*)(F.ws + WS_KIX); const float* wix = (const float*)(F.ws + WS_WIX);
    unsigned* mask = (unsigned*)(F.ws + WS_MASK);
    const int tok = (r >> 2) & 1, head = (r & 3) + 4 * (r >> 3);
    const bf16_t* qp = qix + (size_t)(b * SEQ + s0 + tok) * 1024 + head * 64 + 8 * h;
    bf16x8 af[4];
#pragma unroll
    for (int ks = 0; ks < 4; ++ks) af[ks] = *(const bf16x8*)(qp + 16 * ks);
    const f32x4* wp = (const f32x4*)(wix + (size_t)(b * SEQ + s0 + h) * 16);
    float w[16];
#pragma unroll
    for (int q = 0; q < 4; ++q) { const f32x4 x = wp[q]; w[4 * q] = x[0]; w[4 * q + 1] = x[1]; w[4 * q + 2] = x[2]; w[4 * q + 3] = x[3]; }
    const int tq = NMETA + s0 + h;
    int tqr = tq - r; asm volatile("" : "+v"(tqr));
    const int ngrp = ((NMETA + s0c + 15) >> 6) + 1;
    const int skey = tid >> 3, spc = tid & 7;
    int brow = b * SEQ - NMETA; asm volatile("" : "+s"(brow));
    const bf16_t* kcur = kix + ((long)brow + skey) * 64 + spc * 8;
    const int sdst = skey * IDX_PK + spc * 16;
    const int boff = r * IDX_PK + 16 * h;
    u32x4 kst = *(const u32x4*)(skey < NMETA ? kix + (size_t)(NTOK + skey) * 64 + spc * 8 : kcur);
    float row[MW];
#pragma unroll
    for (int g = 0; g < MW / 2; ++g) {
        float s0v = -INFINITY, s1v = -INFINITY;
        const int bo = (g & 1) * IDX_BUF;
        if (g < ngrp) *(LAS u32x4*)(lds + bo + sdst) = kst;
        __syncthreads();
        kcur += 64 * 64; asm volatile("" : "+v"(kcur));
        if (g + 1 < ngrp) kst = *(const u32x4*)kcur;
        if (g < ngrp) {
            float x0 = 0.f, x1 = 0.f;
            { bf16x8 bb[4]; f32x16 a0;
#pragma unroll
              for (int ks = 0; ks < 4; ++ks) bb[ks] = *(const LAS bf16x8*)(lds + bo + boff + 32 * ks);
#pragma unroll
              for (int i = 0; i < 16; ++i) a0[i] = 0.f;
#pragma unroll
              for (int ks = 0; ks < 4; ++ks) a0 = MFMA32(af[ks], bb[ks], a0);
#pragma unroll
              for (int i = 0; i < 16; ++i) x0 += w[i] * relu_i(a0[i]); }
            asm volatile("" : "+v"(x0));
            asm volatile("" ::: "memory");
            { bf16x8 bb[4]; f32x16 a1;
#pragma unroll
              for (int ks = 0; ks < 4; ++ks) bb[ks] = *(const LAS bf16x8*)(lds + bo + boff + 32 * IDX_PK + 32 * ks);
#pragma unroll
              for (int i = 0; i < 16; ++i) a1[i] = 0.f;
#pragma unroll
              for (int ks = 0; ks < 4; ++ks) a1 = MFMA32(af[ks], bb[ks], a1);
#pragma unroll
              for (int i = 0; i < 16; ++i) x1 += w[i] * relu_i(a1[i]); }
            s0v = (g * 64 <= tqr) ? x0 : -INFINITY; s1v = (g * 64 + 32 <= tqr) ? x1 : -INFINITY;
        }
        row[2 * g] = s0v; row[2 * g + 1] = s1v;
    }
    float tau = -3.0e38f;
    bool done = (tq + 1 <= 256);
    float mx = -INFINITY, mn = INFINITY;
#pragma unroll
    for (int k = 0; k < MW; ++k) { const float v = row[k]; mx = fmaxf(mx, v); mn = fminf(mn, v > -INFINITY ? v : INFINITY); }
    float lo = half_min_f(mn), hi = half_max_f(mx);
    if (!done) tau = hi;
    for (int it = 0; it < 64; ++it) {
        if (!__any(!done)) break;
        const float mid = lo + (hi - lo) * 0.5f;
        int c = 0;
#pragma unroll
        for (int k = 0; k < MW; ++k) c += (row[k] >= mid) ? 1 : 0;
        c = half_sum_i(c);
        if (!done) {
            if (!(mid > lo && mid < hi)) { tau = hi; done = true; }
            else if (c == 256) { tau = mid; done = true; }
            else if (c > 256) lo = mid;
            else { hi = mid; tau = hi; }
        }
    }
    unsigned* mrow = mask + (size_t)(b * SEQ + s0 + h) * MW;
    unsigned mw = 0u;
#pragma unroll
    for (int k = 0; k < MW; ++k) {
        const unsigned long long bal = __ballot(row[k] >= tau);
        const unsigned wd = h ? (unsigned)(bal >> 32) : (unsigned)bal;
        if ((k & 31) == r) mw = wd;
        if ((k & 31) == 31 || k == MW - 1) { const int kk = (k & ~31) + r; if (kk < MW) mrow[kk] = mw; }
    }
}
__device__ __forceinline__ void p2_indexer(const Frame& F, int qslot) {
    volatile LAS unsigned* qw = (volatile LAS unsigned*)(F.lds + LDSCTL_OFF + 16);
    constexpr int NCH = NTOK / 16;
    for (;;) {
        if (F.tid == 0) qw[0] = atomicAdd(F.ctl + CW_QUEUE + 64 * qslot, 1u);
        __syncthreads();
        const int c = __builtin_amdgcn_readfirstlane((int)qw[0]);
        __syncthreads();
        if (c >= NCH) break;
        const int b = c & 3, tblk = (SEQ / 16 - 1) - (c >> 2);
        idx_task(F, b, tblk * 16);
    }
}
template <bool MLA> struct AttnCfg {
    static constexpr int DQK = MLA ? 192 : 128, NKS = DQK / 64, PK = DQK + 16  , PV = 144  , KBYTES = 64 * PK, VBYTES = 64 * PV, VBASE = 2 * KBYTES;
};
struct AttnUnit { int type, b, hx, blk; };
typedef int i32x8 __attribute__((ext_vector_type(8)));
typedef int i32x4 __attribute__((ext_vector_type(4)));
typedef int i32x2_t __attribute__((ext_vector_type(2)));
__device__ __forceinline__ i32x8 cat4(i32x4 a, i32x4 b) { return __builtin_shufflevector(a, b, 0, 1, 2, 3, 4, 5, 6, 7); }
template <int NKS> __device__ __forceinline__ void qk_block(f32x16& s, const i32x8 (&k)[NKS], const i32x8 (&q)[NKS]) {
#if defined(__HIP_DEVICE_COMPILE__)
    int sc = 0x7F7F7F7F;
    if constexpr (NKS == 3)
        asm volatile("s_nop 1\n\tv_mfma_scale_f32_32x32x64_f8f6f4 %0, %1, %4, 0, %7, %7 op_sel_hi:[0,0,0]\n\ts_nop 3\n\tv_mfma_scale_f32_32x32x64_f8f6f4 %0, %2, %5, %0, %7, %7 op_sel_hi:[0,0,0]\n\ts_nop 3\n\t"
                     "v_mfma_scale_f32_32x32x64_f8f6f4 %0, %3, %6, %0, %7, %7 op_sel_hi:[0,0,0]\n\ts_nop 15\n\ts_nop 7"
                     : "=&v"(s) : "v"(k[0]), "v"(k[1]), "v"(k[2]), "v"(q[0]), "v"(q[1]), "v"(q[2]), "v"(sc));
    else
        asm volatile("s_nop 1\n\tv_mfma_scale_f32_32x32x64_f8f6f4 %0, %1, %3, 0, %5, %5 op_sel_hi:[0,0,0]\n\ts_nop 3\n\tv_mfma_scale_f32_32x32x64_f8f6f4 %0, %2, %4, %0, %5, %5 op_sel_hi:[0,0,0]\n\ts_nop 15\n\ts_nop 7"
                     : "=&v"(s) : "v"(k[0]), "v"(k[1]), "v"(q[0]), "v"(q[1]), "v"(sc));
#else
    (void)s; (void)k; (void)q;
#endif
}

__device__ __forceinline__ void pv_block(f32x16& o0, f32x16& o1, f32x16& o2, f32x16& o3, const i32x8 v0, const i32x8 v1, const i32x8 v2, const i32x8 v3, const i32x8 p) {
#if defined(__HIP_DEVICE_COMPILE__)
    int sc = 0x7F7F7F7F;
    asm volatile("s_nop 1\n\tv_mfma_scale_f32_32x32x64_f8f6f4 %0, %4, %8, %0, %9, %9 op_sel_hi:[0,0,0]\n\tv_mfma_scale_f32_32x32x64_f8f6f4 %1, %5, %8, %1, %9, %9 op_sel_hi:[0,0,0]\n\t"
                 "v_mfma_scale_f32_32x32x64_f8f6f4 %2, %6, %8, %2, %9, %9 op_sel_hi:[0,0,0]\n\tv_mfma_scale_f32_32x32x64_f8f6f4 %3, %7, %8, %3, %9, %9 op_sel_hi:[0,0,0]\n\ts_nop 15\n\ts_nop 7"
                 : "+v"(o0), "+v"(o1), "+v"(o2), "+v"(o3) : "v"(v0), "v"(v1), "v"(v2), "v"(v3), "v"(p), "v"(sc));
#else
    (void)o0; (void)o1; (void)o2; (void)o3; (void)v0; (void)v1; (void)v2; (void)v3; (void)p;
#endif
}
__device__ __forceinline__ int pk4_fp8(float a, float b, float c, float d) { int p = 0; p = __builtin_amdgcn_cvt_pk_fp8_f32(a, b, p, false); return __builtin_amdgcn_cvt_pk_fp8_f32(c, d, p, true); }

template <int PVB>
__device__ __forceinline__ void pv_tile(f32x16 (&oacc)[4], LAS unsigned char* lds, int vb, int voff, const i32x8 pf) {
    i32x8 vf[4];
#pragma unroll
    for (int d = 0; d < 4; ++d) {
        const i32x2_t t0 = __builtin_amdgcn_ds_read_tr8_b64_v2i32((LAS i32x2_t*)(lds + vb + voff + 32 * d));
        const i32x2_t t1 = __builtin_amdgcn_ds_read_tr8_b64_v2i32((LAS i32x2_t*)(lds + vb + voff + 16 * PVB + 32 * d));
        const i32x2_t t2 = __builtin_amdgcn_ds_read_tr8_b64_v2i32((LAS i32x2_t*)(lds + vb + voff + 32 * PVB + 32 * d));
        const i32x2_t t3 = __builtin_amdgcn_ds_read_tr8_b64_v2i32((LAS i32x2_t*)(lds + vb + voff + 48 * PVB + 32 * d));
        vf[d] = (i32x8){t0.x, t0.y, t1.x, t1.y, t2.x, t2.y, t3.x, t3.y}; }
    pv_block(oacc[0], oacc[1], oacc[2], oacc[3], vf[0], vf[1], vf[2], vf[3], pf);
}

template <bool MLA>
__device__ __forceinline__ void attn_unit(const Frame& F, const AttnUnit u) {
    typedef AttnCfg<MLA> C;
    const int tid = F.tid, lane = F.lane, wave = F.wave, r = lane & 31, h = lane >> 5;
    LAS unsigned char* lds = F.lds;
    const unsigned char* qn8 = F.ws + WS_QN; const unsigned char* qr8 = F.ws + WS_QR; const unsigned char* kn8 = F.ws + WS_KN; const unsigned char* kpe8 = F.ws + WS_KPE;
    const unsigned char* qb8 = F.ws + WS_QB; const unsigned char* kb8 = F.ws + WS_KB;
    const unsigned char* va8 = F.ws + WS_VA; const unsigned char* vb8 = F.ws + WS_VB;
    const unsigned* mask = (const unsigned*)(F.ws + WS_MASK);
    const int b = u.b;
    const size_t rowb = (size_t)b * SEQ;
    int head, tw0, ntiles;
    if (MLA) { head = u.hx; tw0 = u.blk * 256 + 32 * wave; ntiles = (NMETA + u.blk * 256 + 255) / 64 + 1; }
    else { head = 4 * u.hx + (wave & 3); tw0 = u.blk * 64 + 32 * (wave >> 2); ntiles = (NMETA + u.blk * 64 + 63) / 64 + 1; }
    const int pw0 = NMETA + tw0;
    const int tq = pw0 + r;
    const float cexp = MLA ? QA_SCALE : QB_SCALE;
    i32x8 qf[C::NKS];
    if (MLA) {
        const unsigned char* p0 = qn8 + (rowb + tw0 + r) * 2048 + head * 128 + 32 * h; const unsigned char* p1 = qr8 + (rowb + tw0 + r) * 1024 + head * 64 + 32 * h;
        qf[0] = cat4(*(const i32x4*)p0, *(const i32x4*)(p0 + 16)); qf[1] = cat4(*(const i32x4*)(p0 + 64), *(const i32x4*)(p0 + 80)); qf[C::NKS - 1] = cat4(*(const i32x4*)p1, *(const i32x4*)(p1 + 16));
    } else {
        const unsigned char* p0 = qb8 + (rowb + tw0 + r) * 2048 + head * 128 + 32 * h;
        qf[0] = cat4(*(const i32x4*)p0, *(const i32x4*)(p0 + 16)); qf[1] = cat4(*(const i32x4*)(p0 + 64), *(const i32x4*)(p0 + 80));
    }
    const int ldk = MLA ? 2048 : 512;
    const unsigned char* ktab = MLA ? kn8 + head * 128 : kb8 + u.hx * 128;
    const unsigned char* vtab = MLA ? va8 + head * 128 : vb8 + u.hx * 128;
    const unsigned char* kbase = ktab + (rowb - NMETA) * ldk;
    const unsigned char* vbase = vtab + (rowb - NMETA) * ldk;
    const unsigned char* pbase = kpe8 + (rowb - NMETA) * 64;
    const int kkey = tid >> 3, kpc = tid & 7, pkey = tid >> 2, ppc = tid & 3;
    const unsigned koffs = (unsigned)(kkey * ldk + kpc * 16); const int kdst = kkey * C::PK + kpc * 16;
    const unsigned poffs = (unsigned)(pkey * 64 + ppc * 16); const int pdst = pkey * C::PK + 128 + ppc * 16;
    const int vdst = C::VBASE + kkey * C::PV + kpc * 16;
    u32x4 kst, vst, pst = (u32x4){0u, 0u, 0u, 0u};
    {
        kst = *(const u32x4*)(kkey < NMETA ? ktab + (size_t)(NTOK + kkey) * ldk + kpc * 16 : kbase + koffs);
        vst = *(const u32x4*)(kkey < NMETA ? vtab + (size_t)(NTOK + kkey) * ldk + kpc * 16 : vbase + koffs);
        if (MLA && tid < 256) pst = *(const u32x4*)(pkey < NMETA ? kpe8 + (size_t)(NTOK + pkey) * 64 + ppc * 16 : pbase + poffs);
    }
    *(LAS u32x4*)(lds + kdst) = kst;
    *(LAS u32x4*)(lds + vdst) = vst;
    if (MLA && tid < 256) *(LAS u32x4*)(lds + pdst) = pst;
    __syncthreads();
    f32x16 oacc[4];
#pragma unroll
    for (int d = 0; d < 4; ++d)
#pragma unroll
        for (int i = 0; i < 16; ++i) oacc[d][i] = 0.f;
    float mrun = -INFINITY, lrun = 0.f;
    const int koff = r * C::PK + 32 * h;
    const int vq = (lane & 15) >> 1;
    const int voff = (4 * h + (vq & 3) + 8 * (vq >> 2)) * C::PV + 16 * ((lane >> 4) & 1) + 8 * (lane & 1);
    const unsigned* mrow = mask + (rowb + tw0 + r) * MW;
    if (ntiles > 1) {
        kst = *(const u32x4*)(kbase + (size_t)64 * ldk + koffs);
        vst = *(const u32x4*)(vbase + (size_t)64 * ldk + koffs);
        if (MLA && tid < 256) pst = *(const u32x4*)(pbase + (size_t)64 * 64 + poffs);
    }
    const bool late = wave >= 4;
    i32x8 pfp = (i32x8){0, 0, 0, 0, 0, 0, 0, 0}; bool havep = false;
    int vcur = 0, vprev = 2;
    for (int kt = 0; kt < ntiles; ++kt) {
        const int cur = (kt & 1) * C::KBYTES, nxt = ((kt + 1) & 1) * C::KBYTES;
        const int vnxt = vcur == 2 ? 0 : vcur + 1;
        if (kt + 1 < ntiles) {
            *(LAS u32x4*)(lds + nxt + kdst) = kst;
            *(LAS u32x4*)(lds + vnxt * C::VBYTES + vdst) = vst;
            if (MLA && tid < 256) *(LAS u32x4*)(lds + nxt + pdst) = pst;
        }
        if (kt + 2 < ntiles) {
            kst = *(const u32x4*)(kbase + (size_t)(kt + 2) * 64 * ldk + koffs);
            vst = *(const u32x4*)(vbase + (size_t)(kt + 2) * 64 * ldk + koffs);
            if (MLA && tid < 256) pst = *(const u32x4*)(pbase + (size_t)(kt + 2) * 64 * 64 + poffs);
        }
        if (late && havep) pv_tile<C::PV>(oacc, lds, C::VBASE + vprev * C::VBYTES, voff, pfp);
        const bool need = kt * 64 <= pw0 + 31;
        if (need) {
            u32x2 mwd = (u32x2){0u, 0u};
            if (!MLA) mwd = *(const u32x2*)(mrow + 2 * kt);
            f32x16 s0, s1;
            if (!MLA) {
                i32x8 kf0[C::NKS], kf1[C::NKS];
#pragma unroll
                for (int ks = 0; ks < C::NKS; ++ks) { kf0[ks] = cat4(*(const LAS i32x4*)(lds + cur + koff + 64 * ks), *(const LAS i32x4*)(lds + cur + koff + 64 * ks + 16));
                    kf1[ks] = cat4(*(const LAS i32x4*)(lds + cur + koff + 32 * C::PK + 64 * ks), *(const LAS i32x4*)(lds + cur + koff + 32 * C::PK + 64 * ks + 16)); }
                qk_block<C::NKS>(s0, kf0, qf);
                qk_block<C::NKS>(s1, kf1, qf);
            } else {
                { i32x8 kf[C::NKS];
#pragma unroll
                  for (int ks = 0; ks < C::NKS; ++ks) kf[ks] = cat4(*(const LAS i32x4*)(lds + cur + koff + 64 * ks), *(const LAS i32x4*)(lds + cur + koff + 64 * ks + 16));
                  qk_block<C::NKS>(s0, kf, qf); }
                { i32x8 kf[C::NKS];
#pragma unroll
                  for (int ks = 0; ks < C::NKS; ++ks) kf[ks] = cat4(*(const LAS i32x4*)(lds + cur + koff + 32 * C::PK + 64 * ks), *(const LAS i32x4*)(lds + cur + koff + 32 * C::PK + 64 * ks + 16));
                  qk_block<C::NKS>(s1, kf, qf); }
            }
            if (MLA) {
                if (kt * 64 + 63 > pw0) {
                    const int kb0 = kt * 64 + 4 * h;
#pragma unroll
                    for (int i = 0; i < 16; ++i) { const int key = kb0 + (i & 3) + 8 * (i >> 2); if (key > tq) s0[i] = -INFINITY; if (key + 32 > tq) s1[i] = -INFINITY; }
                }
            } else {
                const unsigned m0 = mwd.x >> (4 * h), m1 = mwd.y >> (4 * h);
#pragma unroll
                for (int i = 0; i < 16; ++i) { const int bit = (i & 3) + 8 * (i >> 2);
                    const unsigned k0 = (unsigned)__builtin_amdgcn_sbfe((int)m0, bit, 1), k1 = (unsigned)__builtin_amdgcn_sbfe((int)m1, bit, 1);
                    s0[i] = __uint_as_float(__builtin_amdgcn_bitop3_b32(__float_as_uint(s0[i]), 0xFF800000u, k0, 0xe4)); s1[i] = __uint_as_float(__builtin_amdgcn_bitop3_b32(__float_as_uint(s1[i]), 0xFF800000u, k1, 0xe4)); }
            }
            float mx = s0[0];
#pragma unroll
            for (int i = 1; i < 16; ++i) mx = fmaxf(mx, s0[i]);
#pragma unroll
            for (int i = 0; i < 16; ++i) mx = fmaxf(mx, s1[i]);
            mx = fmaxf(mx, __shfl_xor(mx, 32));
            const float mcand = mx * cexp;
            const bool move = !__all(mcand - mrun <= 8.0f);
            const float mnew = move ? fmaxf(mrun, mcand) : mrun;
            const float msafe = (mnew == -INFINITY) ? 0.f : mnew;
            const float alpha = move ? __builtin_amdgcn_exp2f(mrun - msafe) : 1.0f;
            mrun = mnew;
            f32x2 ps2 = (f32x2){0.f, 0.f}; const f32x2 c2 = (f32x2){cexp, cexp}, nm2 = (f32x2){-msafe, -msafe};
#pragma unroll
            for (int i = 0; i < 16; i += 2) {
                f32x2 t0 = __builtin_elementwise_fma((f32x2){s0[i], s0[i + 1]}, c2, nm2), t1 = __builtin_elementwise_fma((f32x2){s1[i], s1[i + 1]}, c2, nm2);
                t0 = (f32x2){__builtin_amdgcn_exp2f(t0.x), __builtin_amdgcn_exp2f(t0.y)}; t1 = (f32x2){__builtin_amdgcn_exp2f(t1.x), __builtin_amdgcn_exp2f(t1.y)};
                s0[i] = t0.x; s0[i + 1] = t0.y; s1[i] = t1.x; s1[i + 1] = t1.y; ps2 += t0 + t1; }
            lrun = lrun * alpha + (ps2.x + ps2.y);
            if (move) {
#pragma unroll
                for (int d = 0; d < 4; ++d)
#pragma unroll
                    for (int i = 0; i < 16; ++i) oacc[d][i] *= alpha;
            }
            i32x8 pf;
            pf[0] = pk4_fp8(s0[0], s0[1], s0[2], s0[3]); pf[1] = pk4_fp8(s0[4], s0[5], s0[6], s0[7]); pf[2] = pk4_fp8(s0[8], s0[9], s0[10], s0[11]); pf[3] = pk4_fp8(s0[12], s0[13], s0[14], s0[15]);
            pf[4] = pk4_fp8(s1[0], s1[1], s1[2], s1[3]); pf[5] = pk4_fp8(s1[4], s1[5], s1[6], s1[7]); pf[6] = pk4_fp8(s1[8], s1[9], s1[10], s1[11]); pf[7] = pk4_fp8(s1[12], s1[13], s1[14], s1[15]);
            if (late) pfp = pf; else pv_tile<C::PV>(oacc, lds, C::VBASE + vcur * C::VBYTES, voff, pf);
        }
        havep = late && need;
        vprev = vcur; vcur = vnxt;
        __syncthreads();
    }
    if (late && havep) pv_tile<C::PV>(oacc, lds, C::VBASE + vprev * C::VBYTES, voff, pfp);
    __syncthreads();
    {
        const float lt = lrun + __shfl_xor(lrun, 32);
        const float vmax = fmaxf(__uint_as_float(F.ctl[CW_VMAX + (MLA ? 64 : 0)]), 1e-30f);
        const float inv = (lt > 0.f ? 1.0f / lt : 0.f) * (440.0f / vmax);
        unsigned char* op = F.ws + WS_OAB + (rowb + tw0 + r) * 4096 + (MLA ? 0 : 2048) + head * 128 + 4 * h;
#pragma unroll
        for (int d = 0; d < 4; ++d)
#pragma unroll
            for (int g = 0; g < 4; ++g) { int p = 0;
                p = __builtin_amdgcn_cvt_pk_fp8_f32(fminf(fmaxf(oacc[d][4 * g] * inv, -448.f), 448.f), fminf(fmaxf(oacc[d][4 * g + 1] * inv, -448.f), 448.f), p, false);
                p = __builtin_amdgcn_cvt_pk_fp8_f32(fminf(fmaxf(oacc[d][4 * g + 2] * inv, -448.f), 448.f), fminf(fmaxf(oacc[d][4 * g + 3] * inv, -448.f), 448.f), p, true);
                *(unsigned*)(op + 32 * d + 8 * g) = (unsigned)p; }
    }
}

constexpr int ATT_NUNITS = 16 * 64 + 64 * 16;
__device__ __forceinline__ void att_decode(int idx, AttnUnit& u) {
    int rem = idx;
    for (int L = 65; L >= 2; --L) {
        const int nm = (L >= 5 && ((L - 5) & 3) == 0) ? 64 : 0;
        if (rem < nm) { u.type = 0; u.blk = (L - 5) >> 2; u.b = rem & 3; u.hx = rem >> 2; return; }
        rem -= nm;
        if (rem < 16) { u.type = 1; u.blk = L - 2; u.b = rem & 3; u.hx = rem >> 2; return; }
        rem -= 16;
    }
    u.type = -1; u.blk = 0; u.b = 0; u.hx = 0;
}
__device__ __forceinline__ void p3_attention(const Frame& F, int qslot) {
    volatile LAS int* qw = (volatile LAS int*)(F.lds + LDSCTL_OFF + 32);
    for (;;) {
        if (F.tid == 0) { const int idx = (int)atomicAdd(F.ctl + CW_QUEUE + 64 * qslot, 1u); AttnUnit u; u.type = -1; u.b = 0; u.hx = 0; u.blk = 0; if (idx < ATT_NUNITS) att_decode(idx, u);
            qw[0] = u.type; qw[1] = u.b; qw[2] = u.hx; qw[3] = u.blk; }
        __syncthreads();
        AttnUnit u; u.type = qw[0]; u.b = qw[1]; u.hx = qw[2]; u.blk = qw[3];
        __syncthreads();
        if (u.type < 0) break;
        if (u.type == 0) attn_unit<true>(F, u); else attn_unit<false>(F, u);
    }
}
__device__ __forceinline__ float pk_idx(float v, int n) { return __uint_as_float((__float_as_uint(v) & ~127u) | (unsigned)n); }
__device__ __forceinline__ void route_task(const Frame& F, int tb, int hd) {
    const int lane = F.lane, r = lane & 31, h = lane >> 5;
    const bf16_t* pq = (const bf16_t*)(F.ws + WS_PQ); const bf16_t* skb = (const bf16_t*)(F.ws + WS_SK);
    int* eid = (int*)(F.ws + WS_EID); float* gate = (float*)(F.ws + WS_GATE);
    LAS float* wl = (LAS float*)(F.lds + F.wave * 16384);
    const int m = tb * 32 + r;
#pragma unroll 1
    for (int c = 0; c < 2; ++c) {
        const bf16_t* qp = pq + (size_t)m * 2048 + hd * 256 + c * 128 + 8 * h;
        bf16x8 qf[8];
#pragma unroll
        for (int ks = 0; ks < 8; ++ks) qf[ks] = *(const bf16x8*)(qp + 16 * ks);
        float v[64];
#pragma unroll
        for (int blk = 0; blk < 4; ++blk) {
            const bf16_t* sp = skb + (size_t)((hd * 2 + c) * 128 + 32 * blk + r) * 128 + 8 * h;
            f32x16 acc;
#pragma unroll
            for (int i = 0; i < 16; ++i) acc[i] = 0.f;
#pragma unroll
            for (int ks = 0; ks < 8; ++ks) acc = MFMA32(*(const bf16x8*)(sp + 16 * ks), qf[ks], acc);
#pragma unroll
            for (int i = 0; i < 16; ++i) v[blk * 16 + i] = pk_idx(acc[i], 32 * blk + (i & 3) + 8 * (i >> 2) + 4 * h);
        }
#pragma unroll 1
        for (int k = 0; k < 16; ++k) {
            float mx = v[0];
#pragma unroll
            for (int j = 1; j < 64; ++j) mx = fmaxf(mx, v[j]);
            mx = fmaxf(mx, __shfl_xor(mx, 32));
            if (h == 0) wl[(c * 16 + k) * 32 + r] = mx;
#pragma unroll
            for (int j = 0; j < 64; ++j) v[j] = (v[j] == mx) ? -INFINITY : v[j];
        }
    }
    LDS_WAIT(); asm volatile("" ::: "memory");
    float cs[25]; int ce[25];
    {
        unsigned t0[16], t1[16];
#pragma unroll
        for (int i = 0; i < 16; ++i) { t0[i] = __float_as_uint(wl[i * 32 + r]); t1[i] = __float_as_uint(wl[(16 + i) * 32 + r]); }
        int n = 0;
#pragma unroll
        for (int i = 0; i < 16; ++i)
#pragma unroll
            for (int j = 0; j < 16; ++j)
                if ((i + 1) * (j + 1) <= 16) {
                    const float s = __uint_as_float(t0[i] & ~127u) + __uint_as_float(t1[j] & ~127u);
                    const float sv = __uint_as_float((__float_as_uint(s) & ~63u) | (unsigned)n); const int ev_ = (int)((t0[i] & 127u) * 128u + (t1[j] & 127u));
                    if (n < 25) { if (h == 0) { cs[n] = sv; ce[n] = ev_; } } else { if (h == 1) { cs[n - 25] = sv; ce[n - 25] = ev_; } }
                    ++n;
                }
    }
    float sum = 0.f, first = 0.f;
#pragma unroll 1
    for (int k = 0; k < 16; ++k) {
        float mxl = cs[0];
#pragma unroll
        for (int j = 1; j < 25; ++j) mxl = fmaxf(mxl, cs[j]);
        int sel = 0;
#pragma unroll
        for (int j = 0; j < 25; ++j) { const bool hit = (cs[j] == mxl); sel = hit ? ce[j] : sel; }
        const float mxo = __shfl_xor(mxl, 32); const int selo = __shfl_xor(sel, 32);
        const bool mine = mxl > mxo;
        const float mx = mine ? mxl : mxo; const int se = mine ? sel : selo;
#pragma unroll
        for (int j = 0; j < 25; ++j) cs[j] = (cs[j] == mx) ? -INFINITY : cs[j];
        if (k == 0) first = mx;
        const float ev = __expf(mx - first); sum += ev;
        if (h == 0) { wl[1024 + k * 32 + r] = ev; wl[1536 + k * 32 + r] = __int_as_float(se); }
    }
    LDS_WAIT(); asm volatile("" ::: "memory");
    const float inv = 1.0f / sum;
    if (h == 0) {
        int* ep = eid + (size_t)m * 128 + hd * 16; float* gp = gate + (size_t)m * 128 + hd * 16;
#pragma unroll
        for (int q = 0; q < 4; ++q) {
            *(int4*)(ep + 4 * q) = make_int4(__float_as_int(wl[1536 + (4 * q) * 32 + r]), __float_as_int(wl[1536 + (4 * q + 1) * 32 + r]), __float_as_int(wl[1536 + (4 * q + 2) * 32 + r]), __float_as_int(wl[1536 + (4 * q + 3) * 32 + r]));
            *(f32x4*)(gp + 4 * q) = (f32x4){wl[1024 + (4 * q) * 32 + r] * inv, wl[1024 + (4 * q + 1) * 32 + r] * inv, wl[1024 + (4 * q + 2) * 32 + r] * inv, wl[1024 + (4 * q + 3) * 32 + r] * inv}; }
    }
    LDS_WAIT(); asm volatile("" ::: "memory");
}
__device__ __forceinline__ void p7_routing(const Frame& F) {
    const int gw = F.vcu * NWAVES + F.wave, NGW = F.G * NWAVES;
    for (int it = gw; it < (NTOK / 32) * 8; it += NGW) route_task(F, it >> 3, it & 7);
}

__device__ __forceinline__ float rl_f(float v, int l) { return __int_as_float(__builtin_amdgcn_readlane(__float_as_int(v), l)); }
__device__ __forceinline__ float gelu_tanh(float x) {
    const float u = 0.7978845608028654f * (x + 0.044715f * x * x * x);
    const float e = __expf(2.0f * u);
    const float th = 1.0f - 2.0f / (e + 1.0f);
    return 0.5f * x * (1.0f + th);
}
__device__ __forceinline__ float wave_sum_dpp(float v) {
#define DPP_ADD(ctrl, rmask) v += __int_as_float(__builtin_amdgcn_update_dpp(0, __float_as_int(v), ctrl, rmask, 0xF, false))
    DPP_ADD(0xB1, 0xF); DPP_ADD(0x4E, 0xF); DPP_ADD(0x141, 0xF); DPP_ADD(0x140, 0xF); DPP_ADD(0x142, 0xA); DPP_ADD(0x143, 0xC);
#undef DPP_ADD
    return rl_f(v, 63);
}
typedef unsigned u32x6 __attribute__((ext_vector_type(6)));
typedef float f32x32 __attribute__((ext_vector_type(32)));
struct Row6 { u32x4 q[3]; };
__device__ __forceinline__ void row6_load(Row6& r, const unsigned char* tab, int e, int lane) {
    const u32x4* p = (const u32x4*)(tab + (size_t)e * 3072) + lane;
#pragma unroll
    for (int q = 0; q < 3; ++q) r.q[q] = p[64 * q];
}
__device__ __forceinline__ f32x32 row6_deq(const Row6& r, int g) {
    u32x6 w;
    if (g == 0) { w[0] = r.q[0].x; w[1] = r.q[0].y; w[2] = r.q[0].z; w[3] = r.q[0].w; w[4] = r.q[1].x; w[5] = r.q[1].y; }
    else { w[0] = r.q[1].z; w[1] = r.q[1].w; w[2] = r.q[2].x; w[3] = r.q[2].y; w[4] = r.q[2].z; w[5] = r.q[2].w; }
    return __builtin_amdgcn_cvt_scalef32_pk32_f32_fp6(w, 1.0f);
}
__device__ __forceinline__ float row6_dot(const Row6& r, const f32x2 (&hf)[32]) {
    f32x2 acc0 = (f32x2){0.f, 0.f}, acc1 = (f32x2){0.f, 0.f};
#pragma unroll
    for (int g = 0; g < 2; ++g) { const f32x32 d = row6_deq(r, g);
#pragma unroll
        for (int k = 0; k < 16; k += 2) { acc0 = __builtin_elementwise_fma((f32x2){d[2 * k], d[2 * k + 1]}, hf[16 * g + k], acc0); acc1 = __builtin_elementwise_fma((f32x2){d[2 * k + 2], d[2 * k + 3]}, hf[16 * g + k + 1], acc1); } }
    const f32x2 s = acc0 + acc1;
    return s.x + s.y;
}
__device__ __forceinline__ void row6_axpy(const Row6& r, float c, f32x2 (&o)[32]) {
    const f32x2 c2 = (f32x2){c, c};
#pragma unroll
    for (int g = 0; g < 2; ++g) { const f32x32 d = row6_deq(r, g);
#pragma unroll
        for (int k = 0; k < 16; ++k) o[16 * g + k] = __builtin_elementwise_fma((f32x2){d[2 * k], d[2 * k + 1]}, c2, o[16 * g + k]); }
}
struct Row4 { u32x4 q[2]; };
__device__ __forceinline__ void row4_load(Row4& r, const unsigned char* tab, int e, int lane) {
    const u32x4* p = (const u32x4*)(tab + (size_t)e * 2048) + lane;
    r.q[0] = p[0]; r.q[1] = p[64];
}
__device__ __forceinline__ float row4_dot(const Row4& r, const f32x2 (&hf)[32]) {
    f32x2 acc0 = (f32x2){0.f, 0.f}, acc1 = (f32x2){0.f, 0.f};
#pragma unroll
    for (int d = 0; d < 8; ++d) { const unsigned w = r.q[d >> 2][d & 3];
        acc0 = __builtin_elementwise_fma(__builtin_amdgcn_cvt_scalef32_pk_f32_fp4(w, 1.0f, 0), hf[4 * d], acc0);
        acc1 = __builtin_elementwise_fma(__builtin_amdgcn_cvt_scalef32_pk_f32_fp4(w, 1.0f, 1), hf[4 * d + 1], acc1);
        acc0 = __builtin_elementwise_fma(__builtin_amdgcn_cvt_scalef32_pk_f32_fp4(w, 1.0f, 2), hf[4 * d + 2], acc0);
        acc1 = __builtin_elementwise_fma(__builtin_amdgcn_cvt_scalef32_pk_f32_fp4(w, 1.0f, 3), hf[4 * d + 3], acc1); }
    const f32x2 s = acc0 + acc1;
    return s.x + s.y;
}
__device__ __forceinline__ void row4_axpy(const Row4& r, float c, f32x2 (&o)[32]) {
    const f32x2 c2 = (f32x2){c, c};
#pragma unroll
    for (int d = 0; d < 8; ++d) { const unsigned w = r.q[d >> 2][d & 3];
        o[4 * d] = __builtin_elementwise_fma(__builtin_amdgcn_cvt_scalef32_pk_f32_fp4(w, 1.0f, 0), c2, o[4 * d]);
        o[4 * d + 1] = __builtin_elementwise_fma(__builtin_amdgcn_cvt_scalef32_pk_f32_fp4(w, 1.0f, 1), c2, o[4 * d + 1]);
        o[4 * d + 2] = __builtin_elementwise_fma(__builtin_amdgcn_cvt_scalef32_pk_f32_fp4(w, 1.0f, 2), c2, o[4 * d + 2]);
        o[4 * d + 3] = __builtin_elementwise_fma(__builtin_amdgcn_cvt_scalef32_pk_f32_fp4(w, 1.0f, 3), c2, o[4 * d + 3]); }
}
#if PEER_U_BITS == 4
typedef Row4 RowU;
#define ROWU_LOAD row4_load
#define ROWU_DOT row4_dot
#else
typedef Row6 RowU;
#define ROWU_LOAD row6_load
#define ROWU_DOT row6_dot
#endif
#if PEER_V_BITS == 4
typedef Row4 RowV;
#define ROWV_LOAD row4_load
#define ROWV_AXPY row4_axpy
#else
typedef Row6 RowV;
#define ROWV_LOAD row6_load
#define ROWV_AXPY row6_axpy
#endif
__device__ __forceinline__ void expert_token(const Frame& F, int m, size_t orow) {
    const int lane = F.lane;
    const unsigned char* U = F.ws + WS_U; const unsigned char* V = F.ws + WS_V;
    const float* scu = (const float*)(F.ws + WS_SCU); const float* scv = (const float*)(F.ws + WS_SCV);
    const int* eid = (const int*)(F.ws + WS_EID); const float* gate = (const float*)(F.ws + WS_GATE);
    const bf16_t* h1b = (const bf16_t*)(F.ws + WS_H1B);
    const u64* ssq = (const u64*)(F.ctl + CW_SSQ_H1); const float* gfin = F.in(15);
    const int e0 = eid[(size_t)m * 128 + lane], e1 = eid[(size_t)m * 128 + 64 + lane];
    f32x2 hf[32];
#pragma unroll
    for (int j = 0; j < 16; ++j) { const u32x2 x = *((const u32x2*)(h1b + (size_t)m * DM) + lane + 64 * j); hf[2 * j] = (f32x2){bf_lo(x.x), bf_hi(x.x)}; hf[2 * j + 1] = (f32x2){bf_lo(x.y), bf_hi(x.y)}; }
    const float g0 = gate[(size_t)m * 128 + lane] * scv[e0], g1 = gate[(size_t)m * 128 + 64 + lane] * scv[e1];
    const float rstd = __builtin_amdgcn_rsqf(ssq_get(ssq + m) * (1.0f / DM) + EPS);
    const float su0 = scu[e0] * rstd, su1 = scu[e1] * rstd;
    float a0 = 0.f, a1 = 0.f;
#define EIDX(e) (((e) < 64) ? __builtin_amdgcn_readlane(e0, (e)) : __builtin_amdgcn_readlane(e1, (e) - 64))
    {
        RowU r0, r1, r2, r3, r4, r5, r6, r7;
        ROWU_LOAD(r0, U, EIDX(0), lane); ROWU_LOAD(r1, U, EIDX(1), lane); ROWU_LOAD(r2, U, EIDX(2), lane); ROWU_LOAD(r3, U, EIDX(3), lane);
        ROWU_LOAD(r4, U, EIDX(4), lane); ROWU_LOAD(r5, U, EIDX(5), lane); ROWU_LOAD(r6, U, EIDX(6), lane); ROWU_LOAD(r7, U, EIDX(7), lane);
#define S1STEP(rr, k) p = wave_sum_dpp(ROWU_DOT(rr, hf)); if (more) ROWU_LOAD(rr, U, EIDX(e + 8 + (k)), lane); if (e < 64) { if (lane == e + (k)) a0 = p; } else { if (lane == e + (k) - 64) a1 = p; }
#pragma unroll 1
        for (int e = 0; e < 128; e += 8) {
            const bool more = e + 8 < 128; float p;
            S1STEP(r0, 0) S1STEP(r1, 1) S1STEP(r2, 2) S1STEP(r3, 3) S1STEP(r4, 4) S1STEP(r5, 5) S1STEP(r6, 6) S1STEP(r7, 7)
        }
#undef S1STEP
    }
    const float c0 = gelu_tanh(a0 * su0) * g0, c1 = gelu_tanh(a1 * su1) * g1;
#define CIDX(e) (((e) < 64) ? rl_f(c0, (e)) : rl_f(c1, (e) - 64))
    f32x2 o[32];
#pragma unroll
    for (int i = 0; i < 32; ++i) o[i] = (f32x2){0.f, 0.f};
    {
        RowV r0, r1, r2, r3, r4, r5, r6, r7;
        ROWV_LOAD(r0, V, EIDX(0), lane); ROWV_LOAD(r1, V, EIDX(1), lane); ROWV_LOAD(r2, V, EIDX(2), lane); ROWV_LOAD(r3, V, EIDX(3), lane);
        ROWV_LOAD(r4, V, EIDX(4), lane); ROWV_LOAD(r5, V, EIDX(5), lane); ROWV_LOAD(r6, V, EIDX(6), lane); ROWV_LOAD(r7, V, EIDX(7), lane);
#define S2STEP(rr, k) ROWV_AXPY(rr, CIDX(e + (k)), o); if (more) ROWV_LOAD(rr, V, EIDX(e + 8 + (k)), lane);
#pragma unroll 1
        for (int e = 0; e < 128; e += 8) {
            const bool more = e + 8 < 128;
            S2STEP(r0, 0) S2STEP(r1, 1) S2STEP(r2, 2) S2STEP(r3, 3) S2STEP(r4, 4) S2STEP(r5, 5) S2STEP(r6, 6) S2STEP(r7, 7)
        }
#undef S2STEP
    }
#undef EIDX
#undef CIDX
    float s = 0.f;
    const bf16_t* h1r = h1b + (size_t)m * DM; asm volatile("" : "+s"(h1r));
#pragma unroll
    for (int j = 0; j < 16; ++j) { const u32x2 x = *((const u32x2*)h1r + lane + 64 * j);
        o[2 * j] += (f32x2){bf_lo(x.x), bf_hi(x.x)}; o[2 * j + 1] += (f32x2){bf_lo(x.y), bf_hi(x.y)};
        s += (o[2 * j].x * o[2 * j].x + o[2 * j].y * o[2 * j].y) + (o[2 * j + 1].x * o[2 * j + 1].x + o[2 * j + 1].y * o[2 * j + 1].y); }
    const float rs = 1.0f / sqrtf(wave_sum(s) * (1.0f / DM) + EPS);
    float* op = F.out() + orow * DM;
#pragma unroll
    for (int j = 0; j < 16; ++j) { const f32x4 g = *((const f32x4*)gfin + lane + 64 * j);
        *((f32x4*)op + lane + 64 * j) = (f32x4){o[2 * j].x * rs * g[0], o[2 * j].y * rs * g[1], o[2 * j + 1].x * rs * g[2], o[2 * j + 1].y * rs * g[3]}; }
}
#ifdef MK_STEP_B
__device__ __forceinline__ void stepb_token(const Frame& F, int m, size_t orow) {
    const int lane = F.lane; const float* x = (const float*)(F.ws + WS_H1F) + (size_t)m * DM; const float* gfin = F.in(15);
    f32x4 v[16]; float s = 0.f;
#pragma unroll
    for (int j = 0; j < 16; ++j) { v[j] = *((const f32x4*)x + lane + 64 * j); s += (v[j][0] * v[j][0] + v[j][1] * v[j][1]) + (v[j][2] * v[j][2] + v[j][3] * v[j][3]); }
    const float rs = 1.0f / sqrtf(wave_sum(s) * (1.0f / DM) + EPS);
#pragma unroll
    for (int j = 0; j < 16; ++j) { const f32x4 g = *((const f32x4*)gfin + lane + 64 * j); *((f32x4*)(F.out() + orow * DM) + lane + 64 * j) = v[j] * rs * g; }
}
#endif
#ifdef MK_STEP_A
__device__ __forceinline__ void stepa_token(const Frame& F, size_t orow) {
    const int lane = F.lane; const float* x = F.in(0) + orow * DM; const float* gfin = F.in(15);
    f32x4 v[16]; float s = 0.f;
#pragma unroll
    for (int j = 0; j < 16; ++j) { v[j] = *((const f32x4*)x + lane + 64 * j); s += (v[j][0] * v[j][0] + v[j][1] * v[j][1]) + (v[j][2] * v[j][2] + v[j][3] * v[j][3]); }
    const float rs = 1.0f / sqrtf(wave_sum(s) * (1.0f / DM) + EPS);
#pragma unroll
    for (int j = 0; j < 16; ++j) { const f32x4 g = *((const f32x4*)gfin + lane + 64 * j); *((f32x4*)(F.out() + orow * DM) + lane + 64 * j) = v[j] * rs * g; }
}
#endif
__device__ __forceinline__ void p8_experts(const Frame& F) {
    const int gw = F.vcu * NWAVES + F.wave, NGW = F.G * NWAVES;
#if defined(MK_STEP_A)
    for (int it = gw; it < NB * SEQ; it += NGW) stepa_token(F, (size_t)it);
#elif defined(MK_STEP_B)
    for (int it = gw; it < NB * SEQ; it += NGW) stepb_token(F, it, (size_t)it);
#else
    for (int it = gw; it < NB * SEQ; it += NGW) expert_token(F, it, (size_t)it);
#endif
}
struct Args { const float* in[16]; float* out; unsigned char* ws; int ph_lo, ph_hi; };
#define GEMM_RUN(EPI_T, g_, S_, E_) pg8::gemm_phase<EPI_T, pg8::StaticOrder, true, true>(F.lds, g_, S_, E_)
#define GEMM_RUN2(EPI_T, g_, S_, E_) pg8::gemm_phase<EPI_T, pg8::StaticOrder2, true, true>(F.lds, g_, S_, E_)

__global__ void __launch_bounds__(NWAVES * 64, 2) mk_fwd(Args args) {
    extern __shared__ __attribute__((aligned(16))) unsigned char lds_raw[];
    Frame F;
    F.lds = (LAS unsigned char*)lds_raw;
    F.ws = args.ws; F.ctl = (unsigned*)(args.ws + WS_CTL);
    F.tid = threadIdx.x; F.lane = F.tid & 63; F.wave = __builtin_amdgcn_readfirstlane(F.tid >> 6);
#define PHASE_BEGIN() do { int t_; asm volatile("v_mov_b32 %0, %1" : "=v"(t_) : "v"(threadIdx.x)); F.tid = t_; F.lane = t_ & 63; } while (0)
    F.G = gridDim.x; { const int bx = blockIdx.x; F.vcu = (F.G % 8 == 0) ? (bx % 8) * (F.G / 8) + bx / 8 : bx; }
    for (int u = F.tid; u < (LDS_BYTES - LDSCTL_OFF) / 4; u += NWAVES * 64) ((LAS unsigned*)(F.lds + LDSCTL_OFF))[u] = 0u;
    __syncthreads();
    XcdBarrier bar; bar.bar = F.ctl + CW_BAR; bar.x = 0; bar.st = nullptr;
    if (!MK_PER_PHASE) bar = xcd_barrier_post(F.ctl + CW_BAR, (volatile LAS unsigned*)(F.lds + LDSCTL_OFF));
    const int lo = args.ph_lo, hi = args.ph_hi;
#ifndef PH_MASK
#define PH_MASK 0x1FF
#endif
#define IN(k) (((PH_MASK >> (k)) & 1) && lo <= (k) && (k) < hi)
#ifdef MK_PROBE_T
#define STAMP(k) do { if (blockIdx.x == 0 && threadIdx.x == 0) ((volatile u64*)(F.ctl + 2048))[k] = __builtin_amdgcn_s_memrealtime(); } while (0)
#else
#define STAMP(k) do { } while (0)
#endif
#define SEAM(k) do { if (IN(k) && IN((k) + 1)) xcd_barrier(bar); STAMP((k) + 1); } while (0)
    unsigned char* ws = F.ws;

#ifndef MK_REP_MASK
#define MK_REP_MASK 0
#endif
#define NREP(k) (((MK_REP_MASK >> (k)) & 1) ? 2 : 1)
    STAMP(0);
    if (IN(0)) { for (int rep = 0; rep < NREP(0); ++rep) { PHASE_BEGIN(); p0_prologue(F); if (rep + 1 < NREP(0)) xcd_barrier(bar); } }
    SEAM(0);
    if (IN(1)) { for (int rep = 0; rep < NREP(1); ++rep) { PHASE_BEGIN();
        p1_quant_weights(F);
        xcd_barrier(bar);
        {
            pg8::Gemm g{(const bf16_t*)(ws + WS_XN8), (const bf16_t*)(ws + WS_WG8), MK, 12800, DM / 2, DM / 2}; pg8::StaticOrder S; S.init(MK, 12800, F.G, (int)blockIdx.x);
            epi::EpiIn<true> E{(bf16_t*)(ws + WS_CQ), (bf16_t*)(ws + WS_CKV), (bf16_t*)(ws + WS_QB), (bf16_t*)(ws + WS_KB), (bf16_t*)(ws + WS_VB), (bf16_t*)(ws + WS_QIX), (bf16_t*)(ws + WS_KPE), (bf16_t*)(ws + WS_KIX),
                          (bf16_t*)(ws + WS_GA), (bf16_t*)(ws + WS_GB), (float*)(ws + WS_WIX), rep ? nullptr : (u64*)(F.ctl + CW_SSQ_CQ), rep ? nullptr : (u64*)(F.ctl + CW_SSQ_CKV),
                          (const float*)(ws + WS_ROPE_M), (const float*)(ws + WS_ROPE_D), (const float*)(ws + WS_ROPE_I), F.ctl + CW_VMAX, (const float*)(ws + WS_SX), (const float*)(ws + WS_SW)};
            GEMM_RUN(epi::EpiIn<true>, g, S, E); }
        __syncthreads();
        {
            pg8::Gemm g{(const bf16_t*)(ws + WS_XN), (const bf16_t*)(ws + WS_WIN), MK, 1280, DM, DM}; pg8::StaticOrder S; S.init(MK, 1280, F.G, (int)(gridDim.x - 1 - blockIdx.x));
            epi::EpiIn<false> E{(bf16_t*)(ws + WS_CQ), (bf16_t*)(ws + WS_CKV), (bf16_t*)(ws + WS_QB), (bf16_t*)(ws + WS_KB), (bf16_t*)(ws + WS_VB), (bf16_t*)(ws + WS_QIX), (bf16_t*)(ws + WS_KPE), (bf16_t*)(ws + WS_KIX),
                          (bf16_t*)(ws + WS_GA), (bf16_t*)(ws + WS_GB), (float*)(ws + WS_WIX), nullptr, nullptr,
                          (const float*)(ws + WS_ROPE_M), (const float*)(ws + WS_ROPE_D), (const float*)(ws + WS_ROPE_I), F.ctl + CW_VMAX, nullptr, nullptr};
            GEMM_RUN(epi::EpiIn<false>, g, S, E); }
        if (rep + 1 < NREP(1)) xcd_barrier(bar); }
    }
    SEAM(1);
    if (IN(2)) { for (int rep = 0; rep < NREP(2); ++rep) { PHASE_BEGIN();
        { pg8::Gemm g{(const bf16_t*)(ws + WS_CQ), (const bf16_t*)(ws + WS_WUQ8), NTOK, 3072, 512, 512}; pg8::StaticOrder S; S.init(NTOK, 3072, F.G, (int)blockIdx.x);
          epi::EpiUp E{ws + WS_QN, ws + WS_QR, 8, 2048, 1024, false, (const u64*)(F.ctl + CW_SSQ_CQ), 1.0f / 1024.0f, (const float*)(ws + WS_ROPE_M), (const float*)(ws + WS_SWUQ), F.ctl + CW_VMAX + 64};
          GEMM_RUN(epi::EpiUp, g, S, E); }
        __syncthreads();
        { pg8::Gemm g{(const bf16_t*)(ws + WS_CKV), (const bf16_t*)(ws + WS_WUKV8), MK, 4096, 256, 256}; pg8::StaticOrder S; S.init(MK, 4096, F.G, (int)blockIdx.x);
          epi::EpiUp E{ws + WS_KN, ws + WS_VA, 8, 2048, 2048, true, (const u64*)(F.ctl + CW_SSQ_CKV), 1.0f / 512.0f, nullptr, (const float*)(ws + WS_SWUKV), F.ctl + CW_VMAX + 64};
          GEMM_RUN(epi::EpiUp, g, S, E); }
        __syncthreads();
        p2_indexer(F, rep);
        if (rep + 1 < NREP(2)) xcd_barrier(bar); }
    }
    SEAM(2);
    if (IN(3)) { for (int rep = 0; rep < NREP(3); ++rep) { PHASE_BEGIN(); p3_attention(F, 2 + rep); if (rep + 1 < NREP(3)) xcd_barrier(bar); } }
    SEAM(3);
    if (IN(4)) { for (int rep = 0; rep < NREP(4); ++rep) { PHASE_BEGIN();
        pg8::Gemm g{(const bf16_t*)(ws + WS_OAB), (const bf16_t*)(ws + WS_WBR), NTOK, 4096, 2048, 1024}; pg8::StaticOrder2 S; S.init(NTOK, 4096, F.G, (int)blockIdx.x);
        epi::EpiBranch E{(const bf16_t*)(ws + WS_GA), (const bf16_t*)(ws + WS_GB), (bf16_t*)(ws + WS_MRG), (const unsigned*)(F.ctl + CW_VMAX), (const float*)(ws + WS_SWBR)};
        GEMM_RUN2(epi::EpiBranch, g, S, E);
        if (rep + 1 < NREP(4)) xcd_barrier(bar); }
    }
    SEAM(4);
    if (IN(5)) { for (int rep = 0; rep < NREP(5); ++rep) { PHASE_BEGIN();
        rowquant_fp8(F, ws + WS_MRG, (size_t)DM * 2, ws + WS_MRG, (size_t)DM * 2, (float*)(ws + WS_SMRG), NTOK);
        xcd_barrier(bar);
        pg8::Gemm g{(const bf16_t*)(ws + WS_MRG), (const bf16_t*)(ws + WS_WOUT), NTOK, 4096, 4096, 2048}; pg8::StaticOrder S; S.init(NTOK, 4096, F.G, (int)blockIdx.x);
        epi::EpiOut E{F.in(0), F.in(1), (float*)(ws + WS_H1F), (bf16_t*)(ws + WS_H1B), rep ? nullptr : (u64*)(F.ctl + CW_SSQ_H1), (const float*)(ws + WS_SMRG), (const float*)(ws + WS_SWOUT)};
        GEMM_RUN(epi::EpiOut, g, S, E);
        if (rep + 1 < NREP(5)) xcd_barrier(bar); }
    }
    SEAM(5);
    if (IN(6)) { for (int rep = 0; rep < NREP(6); ++rep) { PHASE_BEGIN();
        pg8::Gemm g{(const bf16_t*)(ws + WS_H1B), (const bf16_t*)(ws + WS_WQ), NTOK, 2048, 4096, 4096}; pg8::StaticOrder S; S.init(NTOK, 2048, F.G, (int)blockIdx.x);
        epi::EpiPQ E{(bf16_t*)(ws + WS_PQ), (const u64*)(F.ctl + CW_SSQ_H1)};
        GEMM_RUN(epi::EpiPQ, g, S, E);
        if (rep + 1 < NREP(6)) xcd_barrier(bar); }
    }
    SEAM(6);
    if (IN(7)) { for (int rep = 0; rep < NREP(7); ++rep) { PHASE_BEGIN();
        if (F.wave & 4) { p6_tables(F); p7_routing(F); } else { p7_routing(F); p6_tables(F); }
        if (rep + 1 < NREP(7)) xcd_barrier(bar); } }
    SEAM(7);
    if (IN(8)) { for (int rep = 0; rep < NREP(8); ++rep) { PHASE_BEGIN(); p8_experts(F); if (rep + 1 < NREP(8)) xcd_barrier(bar); } }
#ifdef MK_PROBE_T
    {   PHASE_BEGIN();
        xcd_barrier(bar); STAMP(9); xcd_barrier(bar);
        const volatile u64* ts = (const volatile u64*)(F.ctl + 2048);
        const float tot = (float)(ts[9] - ts[0]);
        const float f1 = (float)(ts[MK_PROBE_K1 + 1] - ts[MK_PROBE_K1]) / tot, f2 = (float)(ts[MK_PROBE_K2 + 1] - ts[MK_PROBE_K2]) / tot;
        float* o = F.out(); const size_t gt = (size_t)blockIdx.x * 512 + F.tid, NGT = (size_t)gridDim.x * 512;
        for (size_t i = gt; i < (size_t)NB * SEQ * DM / 4; i += NGT) { f32x4 v = ((f32x4*)o)[i]; v = v * (1.0f - f1); if (i == 0) v[0] = 1000.0f * f2; ((f32x4*)o)[i] = v; }
    }
#endif
#undef IN
#undef SEAM
}

extern "C" void kernel_launch(void* const* d_in, const int* in_sizes, int n_in, void* d_out, int out_size, void* d_ws, size_t ws_size, hipStream_t stream) {
    static int grid = 0;
    if (grid == 0) {
        if (n_in != 16 || in_sizes[0] != NB * SEQ * DM || out_size != NB * SEQ * DM || ws_size < WS_END) {
            fprintf(stderr, "kernel_launch: unexpected problem shape (n_in %d, in0 %d, out %d, ws %zu < %zu); nothing launched\n", n_in, n_in > 0 ? in_sizes[0] : -1, out_size, ws_size, (size_t)WS_END); grid = -1; return; }
        int dev = 0, cus = 0, per_cu = 0;
        if (hipGetDevice(&dev) != hipSuccess || hipDeviceGetAttribute(&cus, hipDeviceAttributeMultiprocessorCount, dev) != hipSuccess) { grid = -1; return; }
        if (hipFuncSetAttribute((const void*)mk_fwd, hipFuncAttributeMaxDynamicSharedMemorySize, LDS_BYTES) != hipSuccess) { fprintf(stderr, "kernel_launch: hipFuncSetAttribute failed\n"); grid = -1; return; }
        if (hipOccupancyMaxActiveBlocksPerMultiprocessor(&per_cu, (const void*)mk_fwd, NWAVES * 64, LDS_BYTES) != hipSuccess || per_cu < 1) {
            fprintf(stderr, "kernel_launch: occupancy query reports %d workgroups per CU\n", per_cu); }
        (void)hipGetLastError();
        grid = cus;
    }
    if (grid < 0) return;
    if (hipMemsetAsync((char*)d_ws + WS_CTL, 0, CTL_ZERO_BYTES, stream) != hipSuccess) return;
    Args a{};
    for (int i = 0; i < 16; ++i) a.in[i] = (const float*)d_in[i];
    a.out = (float*)d_out; a.ws = (unsigned char*)d_ws;
#if MK_PER_PHASE
    for (int p = 0; p <= MK_LAST_PHASE; ++p) { a.ph_lo = p; a.ph_hi = p + 1; hipLaunchKernelGGL(mk_fwd, dim3(grid), dim3(NWAVES * 64), LDS_BYTES, stream, a); }
#else
    a.ph_lo = 0; a.ph_hi = MK_LAST_PHASE + 1;
    hipLaunchKernelGGL(mk_fwd, dim3(grid), dim3(NWAVES * 64), LDS_BYTES, stream, a);
#endif
}
```

```cpp
#include <hip/hip_runtime.h>
#include <cstdio>
#include <cstdint>

#define LAS __attribute__((address_space(3)))
#define GAS __attribute__((address_space(1)))
typedef unsigned short bf16_t;
typedef short bf16x8 __attribute__((ext_vector_type(8)));
typedef short s16x4 __attribute__((ext_vector_type(4)));
typedef float f32x2 __attribute__((ext_vector_type(2)));
typedef float f32x4 __attribute__((ext_vector_type(4)));
typedef float f32x16 __attribute__((ext_vector_type(16)));
typedef unsigned u32x2 __attribute__((ext_vector_type(2)));
typedef unsigned u32x4 __attribute__((ext_vector_type(4)));
typedef GAS unsigned gu32;

#ifndef MK_PER_PHASE
#define MK_PER_PHASE 0
#endif
#ifndef MK_LAST_PHASE
#define MK_LAST_PHASE 8
#endif

constexpr int NB = 4, SEQ = 4096, DM = 4096, NMETA = 16, TR = SEQ + NMETA  , TP = 4224  , M = NB * TP  ;
constexpr float EPS = 1e-6f;
constexpr int NV1 = 14080;
constexpr float LOG2E = 1.4426950408889634f;
constexpr float QB_SCALE = 0.08838834764831845f * LOG2E;
constexpr float QA_SCALE = 0.07216878364870323f * LOG2E;
constexpr int NWAVES = 8;
constexpr int NTOK = NB * SEQ;
constexpr int MK = NTOK + 256;
constexpr int MW = 130;
__device__ __forceinline__ int row_pos(int row) { return row < NTOK ? NMETA + (row & (SEQ - 1)) : row - NTOK; }
__device__ __forceinline__ int pos_row(int b, int p) { return p < NMETA ? NTOK + p : b * SEQ + (p - NMETA); }

constexpr size_t HM = 512u * 1024u;
constexpr size_t WS_CTL = 0, CTL_ZERO_BYTES = 2 * HM;
constexpr size_t WS_ROPE_M = 2 * HM;
constexpr size_t WS_ROPE_D = 5 * HM;
constexpr size_t WS_ROPE_I = 7 * HM;
constexpr size_t WS_SK   = 8 * HM;
constexpr size_t WS_WUQ  = 10 * HM;
constexpr size_t WS_WUKV = 22 * HM;
constexpr size_t WS_WBR  = 30 * HM;
constexpr size_t WS_WOUT = 94 * HM;
constexpr size_t WS_WQ   = 158 * HM;
constexpr size_t WS_EID  = 190 * HM;
constexpr size_t WS_GATE = 207 * HM;
constexpr size_t WS_MASK = 224 * HM;
constexpr size_t WS_KPE  = 242 * HM;
constexpr size_t WS_KIX  = 247 * HM;
constexpr size_t WS_WIX  = 252 * HM;
constexpr size_t WS_SCU  = 255 * HM;
constexpr size_t WS_SCV  = 255 * HM + 65536;
constexpr size_t WS_SX   = 255 * HM + 131072;
constexpr size_t WS_SW   = 255 * HM + 200704;
constexpr size_t WS_SWBR = 255 * HM + 294912;
constexpr size_t WS_SWOUT= 255 * HM + 311296;
constexpr size_t WS_SOAB = 255 * HM + 327680;
constexpr size_t WS_SMRG = 255 * HM + 393216;
constexpr size_t R23 = 260 * HM;
constexpr size_t WS_XN   = R23;
constexpr size_t WS_WIN  = R23 + 264 * HM;
constexpr size_t P1O = R23 + 484 * HM;
constexpr size_t WS_CQ   = P1O;
constexpr size_t WS_CKV  = P1O + 66 * HM;
constexpr size_t WS_QB   = P1O + 99 * HM;
constexpr size_t WS_KB   = P1O + 231 * HM;
constexpr size_t WS_VB   = P1O + 264 * HM;
constexpr size_t WS_QIX  = P1O + 297 * HM;
constexpr size_t WS_GA   = P1O + 363 * HM;
constexpr size_t WS_GB   = P1O + 627 * HM;
constexpr size_t R4 = P1O + 892 * HM;
constexpr size_t WS_OAB  = R4;
constexpr size_t WS_XN8  = R4;
constexpr size_t WS_WG8  = R4 + 132 * HM;
constexpr size_t WS_WUQ8 = R4 + 232 * HM;
constexpr size_t WS_WUKV8= R4 + 238 * HM;
constexpr size_t WS_SWUQ = 255 * HM + 458752;
constexpr size_t WS_SWUKV= 255 * HM + 475136;
constexpr size_t WS_PQ   = R4;
constexpr size_t WS_END  = R4 + 264 * HM;
constexpr size_t WS_QN   = R23;
constexpr size_t WS_QR   = R23 + 132 * HM;
constexpr size_t WS_KN   = R23 + 198 * HM;
constexpr size_t WS_VA   = R23 + 330 * HM;
constexpr size_t WS_MRG  = R23;
constexpr size_t WS_U    = R23;
constexpr size_t WS_V    = R23 + 256 * HM;
constexpr size_t WS_H1F  = R23 + 512 * HM;
constexpr size_t WS_H1B  = R23 + 1040 * HM;
static_assert(WS_VA + 132 * HM <= P1O && WS_H1F >= P1O && WS_H1B + 264 * HM <= R4 && WS_GB + 264 * HM <= R4, "ws map");
constexpr int CW_TMO = 0;
constexpr int CW_BAR = 4096;
constexpr int CW_QUEUE = 8192;
constexpr int CW_VMAX = 12288;
constexpr int CW_SSQ_CQ = 16384, CW_SSQ_CKV = 16384 + 2 * 17408, CW_SSQ_H1 = 16384 + 4 * 17408;
constexpr int CW_SSQ_OA = 16384 + 6 * 17408, CW_SSQ_OB = 16384 + 8 * 17408;
constexpr int CW_WNORM = 12288 + 128;
static_assert((CW_SSQ_OB + 2 * 17408) * 4 <= (int)CTL_ZERO_BYTES, "ctl");

constexpr int RING_BYTES = 131072;
constexpr int LDSCTL_OFF = RING_BYTES;
constexpr int LDS_BYTES = 147456;

__device__ __forceinline__ unsigned f2bf(float f) { unsigned u = __float_as_uint(f); return (u + 0x7fffu + ((u >> 16) & 1u)) >> 16; }
__device__ __forceinline__ unsigned pk2(float lo, float hi) { return f2bf(lo) | (f2bf(hi) << 16); }
typedef __bf16 bf16x2_t __attribute__((ext_vector_type(2)));
__device__ __forceinline__ unsigned cvt_pk_bf16(float lo, float hi) { return __builtin_bit_cast(unsigned, __builtin_convertvector((f32x2){lo, hi}, bf16x2_t)); }
__device__ __forceinline__ float bf_lo(unsigned w) { return __uint_as_float(w << 16); }
__device__ __forceinline__ float bf_hi(unsigned w) { return __uint_as_float(w & 0xffff0000u); }
__device__ __forceinline__ u32x4 pack8(f32x4 a, f32x4 b) { u32x4 w; w.x = cvt_pk_bf16(a[0], a[1]); w.y = cvt_pk_bf16(a[2], a[3]); w.z = cvt_pk_bf16(b[0], b[1]); w.w = cvt_pk_bf16(b[2], b[3]); return w; }
__device__ __forceinline__ float wave_sum(float v) {
#pragma unroll
    for (int o = 1; o < 64; o <<= 1) v += __shfl_xor(v, o);
    return v;
}
#define LDS_WAIT() asm volatile("s_waitcnt lgkmcnt(0)" ::: "memory")
#define VM_WAIT() asm volatile("s_waitcnt vmcnt(0)" ::: "memory")
typedef unsigned long long u64;
__device__ __forceinline__ void ssq_add(u64* p, float v) { (void)__hip_atomic_fetch_add(p, (u64)(v * 16777216.0f), __ATOMIC_RELAXED, __HIP_MEMORY_SCOPE_AGENT); }
__device__ __forceinline__ float ssq_get(const u64* p) { return (float)((double)(*p) * (1.0 / 16777216.0)); }
namespace pg8 {
#define PG8_LAS __attribute__((address_space(3)))
typedef unsigned short bf16_t;
typedef short bf16x8 __attribute__((ext_vector_type(8)));
typedef float f32x4 __attribute__((ext_vector_type(4)));
typedef unsigned u32x4 __attribute__((ext_vector_type(4)));
constexpr int BM = 256, BK = 64, HALF = 128, HTB = HALF * BK * 2  , STAGE_BYTES = 8 * HTB, NXCD = 8, WGM = 8;

__host__ __device__ __forceinline__ int lds_byte(int r, int c) { const int st = (r >> 4) * 2 + (c >> 5), rr = r & 15, cc = c & 31, ob = rr * 64 + cc * 2; return st * 1024 + (ob ^ (((ob >> 9) & 1) << 5)); }
__host__ __device__ __forceinline__ void stage_rc(int b, int& R, int& C) { const int st = b / 1024, sb = b % 1024, swz = sb ^ (((sb >> 9) & 1) << 5); R = (st >> 1) * 16 + swz / 64; C = (st & 1) * 32 + (swz % 64) / 2; }
__host__ __device__ __forceinline__ int perm32(int rho) { const int n = rho >> 4, i = rho & 15; return 8 * (i >> 2) + 4 * n + (i & 3); }

typedef int i32x4_t __attribute__((ext_vector_type(4)));
typedef int i32x8_t __attribute__((ext_vector_type(8)));
__device__ __forceinline__ i32x8_t cat8(bf16x8 lo, bf16x8 hi) { const i32x4_t a = __builtin_bit_cast(i32x4_t, lo), b = __builtin_bit_cast(i32x4_t, hi); return __builtin_shufflevector(a, b, 0, 1, 2, 3, 4, 5, 6, 7); }
__device__ __forceinline__ void mfma_f8_acc(f32x4& c, const i32x8_t a, const i32x8_t b) {
#if defined(__HIP_DEVICE_COMPILE__)
    int sc = 0x7F7F7F7F;
    asm volatile("v_mfma_scale_f32_16x16x128_f8f6f4 %0, %1, %2, %0, %3, %3 op_sel_hi:[0,0,0]" : "+v"(c) : "v"(a), "v"(b), "v"(sc));
#else
    (void)c; (void)a; (void)b;
#endif
}
struct Unit { int pm, pn, kh; };
struct Gemm { const bf16_t* A; const bf16_t* Bt; int M, N, K, KL; };

struct StaticOrder {
    int nM, nN, nwg, G, c;
    __host__ __device__ void init(int M, int N, int G_, int c_) { nM = M / BM; nN = N / BM; nwg = nM * nN; G = G_; c = c_; }
    __host__ __device__ bool next(int i, Unit& u) const {
        const long L = (long)i * G + c; if (L >= nwg) return false;
        int wgid = (int)L; { const int q = nwg / NXCD, r = nwg % NXCD, xcd = wgid % NXCD, off = wgid / NXCD; wgid = (xcd < r ? xcd * (q + 1) : r * (q + 1) + (xcd - r) * q) + off; }
        const int nig = WGM * nN, gid = wgid / nig, fm = gid * WGM, gsz = (nM - fm) < WGM ? (nM - fm) : WGM;
        u.pm = fm + ((wgid % nig) % gsz); u.pn = (wgid % nig) / gsz; u.kh = 0; return true;
    }
    __device__ __forceinline__ void a_ready(const Unit&) const {}
    __device__ __forceinline__ void done(const Unit&) const {}
};

struct StaticOrder2 {
    StaticOrder base;
    __host__ __device__ void init(int M, int N, int G_, int c_) { base.init(M, N, G_, c_); }
    __host__ __device__ bool next(int i, Unit& u) const { if (!base.next(i >> 1, u)) return false; u.kh = i & 1; return true; }
    __device__ __forceinline__ void a_ready(const Unit&) const {}
    __device__ __forceinline__ void done(const Unit&) const {}
};

template <class Epi, class Sched, bool ALIGN_EPI = false, bool SP2 = false>
__device__ __forceinline__ void gemm_phase(PG8_LAS unsigned char* lds, const Gemm g, const Sched& S, const Epi& E) {
    int tid_; asm volatile("v_mov_b32 %0, %1" : "=v"(tid_) : "v"(threadIdx.x));
    const int tid = tid_, wid = __builtin_amdgcn_readfirstlane(tid >> 6), lane = tid & 63, wr = wid >> 2, wc = wid & 3, fr = lane & 15, fq = lane >> 4;
    const int K = g.K, nt = g.KL / BK; const size_t khoff = (size_t)g.KL * 2;
    unsigned voffA[2], voffB[2];
#pragma unroll
    for (int i = 0; i < 2; ++i) { int R, C; stage_rc(tid * 16 + i * 8192, R, C); const int Rb = Epi::PERM ? ((R & ~31) + perm32(R & 31)) : R;
        voffA[i] = (unsigned)(R * K + C) * 2u; voffB[i] = (unsigned)(Rb * K + C) * 2u; }
    const size_t kstep = (size_t)(BK * 2);
    const size_t hstep = (size_t)HALF * K * 2;
    const size_t tstep = 2 * hstep;
    const unsigned ldsw = (unsigned)wid * 1024u;
    const int aoff = lds_byte(wr * 64 + fr, fq * 8), boff = lds_byte(wc * 32 + fr, fq * 8);
#define PG8_SA(b, h) (((b) * 2 + (h)) * HTB)
#define PG8_SB(b, h) ((4 + (b) * 2 + (h)) * HTB)
#define PG8_STAGE(bufoff, gbase, voff) do { _Pragma("unroll") for (int _i = 0; _i < 2; ++_i) \
        __builtin_amdgcn_global_load_lds((const unsigned*)((const char*)(gbase) + (voff)[_i]), (PG8_LAS unsigned*)(lds + (bufoff) + ldsw + _i * 8192), 16, 0, 0); } while (0)
#define PG8_LDA(dst, b, h) do { _Pragma("unroll") for (int m = 0; m < 4; ++m) _Pragma("unroll") for (int k = 0; k < 2; ++k) dst[m][k] = *(const PG8_LAS bf16x8*)(lds + PG8_SA(b, h) + aoff + m * 2048 + k * 1024); } while (0)
#define PG8_LDB(dst, b, h) do { _Pragma("unroll") for (int n = 0; n < 2; ++n) _Pragma("unroll") for (int k = 0; k < 2; ++k) dst[n][k] = *(const PG8_LAS bf16x8*)(lds + PG8_SB(b, h) + boff + n * 2048 + k * 1024); } while (0)
#define PG8_MMA(ai, bj, At, Bt) do { __builtin_amdgcn_s_setprio(1); _Pragma("unroll") for (int m = 0; m < 4; ++m) _Pragma("unroll") for (int n = 0; n < 2; ++n) { \
        if constexpr (Epi::FP8) mfma_f8_acc(acc[ai][bj][m][n], cat8(Bt[n][0], Bt[n][1]), cat8(At[m][0], At[m][1])); \
        else { _Pragma("unroll") for (int k = 0; k < 2; ++k) acc[ai][bj][m][n] = __builtin_amdgcn_mfma_f32_16x16x32_bf16(Bt[n][k], At[m][k], acc[ai][bj][m][n], 0, 0, 0); } } \
        __builtin_amdgcn_s_setprio(0); } while (0)
#define PG8_WAIT_V(n) asm volatile("s_waitcnt vmcnt(" #n ")" ::: "memory")
#define PG8_WAIT_L(n) asm volatile("s_waitcnt lgkmcnt(" #n ")" ::: "memory")
#define PG8_BAR __builtin_amdgcn_s_barrier()
#define PG8_SCHED __builtin_amdgcn_sched_barrier(0)
    Unit cur, nxt; int ui = 0;
    if (!S.next(0, cur)) return;
    f32x4 acc[2][2][4][2];
#pragma unroll
    for (int a = 0; a < 2; ++a)
#pragma unroll
        for (int b = 0; b < 2; ++b)
#pragma unroll
            for (int m = 0; m < 4; ++m)
#pragma unroll
                for (int n = 0; n < 2; ++n) acc[a][b][m][n] = (f32x4){0.f, 0.f, 0.f, 0.f};
    bf16x8 At[4][2], B0[2][2], B1[2][2];
    const char* cA = (const char*)g.A + (size_t)cur.pm * tstep + (size_t)cur.kh * khoff; const char* cB = (const char*)g.Bt + (size_t)cur.pn * tstep + (size_t)cur.kh * khoff;
    S.a_ready(cur);
    if constexpr (SP2) {
        PG8_STAGE(PG8_SB(0, 0), cB, voffB); PG8_STAGE(PG8_SB(0, 1), cB + hstep, voffB); PG8_STAGE(PG8_SA(0, 0), cA, voffA); PG8_STAGE(PG8_SA(0, 1), cA + hstep, voffA);
        if (wr == 1) PG8_BAR;
        PG8_WAIT_V(2); PG8_BAR;
        PG8_STAGE(PG8_SB(1, 0), cB + kstep, voffB); PG8_STAGE(PG8_SA(1, 0), cA + kstep, voffA); PG8_STAGE(PG8_SB(1, 1), cB + hstep + kstep, voffB);
        PG8_WAIT_V(6); PG8_BAR;
    } else {
        PG8_STAGE(PG8_SB(0, 0), cB, voffB); PG8_STAGE(PG8_SA(0, 0), cA, voffA); PG8_STAGE(PG8_SB(0, 1), cB + hstep, voffB); PG8_STAGE(PG8_SA(0, 1), cA + hstep, voffA);
        if (wr == 1) PG8_BAR;
        PG8_WAIT_V(4); PG8_BAR;
        PG8_STAGE(PG8_SB(1, 0), cB + kstep, voffB); PG8_STAGE(PG8_SA(1, 0), cA + kstep, voffA); PG8_STAGE(PG8_SB(1, 1), cB + hstep + kstep, voffB);
        PG8_WAIT_V(6); PG8_BAR;
    }
    for (;;) {
        const bool has_next = S.next(ui + 1, nxt);
        const char* nA = has_next ? (const char*)g.A + (size_t)nxt.pm * tstep + (size_t)nxt.kh * khoff : cA; const char* nB = has_next ? (const char*)g.Bt + (size_t)nxt.pn * tstep + (size_t)nxt.kh * khoff : cB;
        for (int t = 0; t < nt; t += 2) {
            const bool last = (t == nt - 2);
            const char* a1 = cA + (size_t)(t + 1) * kstep;
            const char* a2 = last ? nA : cA + (size_t)(t + 2) * kstep; const char* b2 = last ? nB : cB + (size_t)(t + 2) * kstep;
            const char* a3 = a2 + kstep; const char* b3 = b2 + kstep;
            if (last && has_next) S.a_ready(nxt);
            if constexpr (SP2) {
            PG8_LDB(B0, 0, 0); PG8_LDB(B1, 0, 1); PG8_SCHED; PG8_LDA(At, 0, 0); PG8_STAGE(PG8_SA(1, 1), a1 + hstep, voffA);
            PG8_WAIT_V(8); PG8_WAIT_L(0); PG8_BAR; PG8_MMA(0, 0, At, B0); PG8_MMA(0, 1, At, B1); PG8_BAR; PG8_SCHED;
            PG8_LDA(At, 0, 1); PG8_STAGE(PG8_SB(0, 0), b2, voffB); PG8_STAGE(PG8_SB(0, 1), b2 + hstep, voffB); PG8_STAGE(PG8_SA(0, 0), a2, voffA);
            PG8_WAIT_V(8); PG8_WAIT_L(0); PG8_BAR; PG8_MMA(1, 0, At, B0); PG8_MMA(1, 1, At, B1); PG8_BAR; PG8_SCHED;
            PG8_LDB(B0, 1, 0); PG8_LDB(B1, 1, 1); PG8_SCHED; PG8_LDA(At, 1, 0); PG8_STAGE(PG8_SA(0, 1), a2 + hstep, voffA);
            PG8_WAIT_V(8); PG8_WAIT_L(0); PG8_BAR; PG8_MMA(0, 0, At, B0); PG8_MMA(0, 1, At, B1); PG8_BAR; PG8_SCHED;
            PG8_LDA(At, 1, 1); PG8_STAGE(PG8_SB(1, 0), b3, voffB); PG8_STAGE(PG8_SB(1, 1), b3 + hstep, voffB); PG8_STAGE(PG8_SA(1, 0), a3, voffA);
            PG8_WAIT_V(8); PG8_WAIT_L(0); PG8_BAR; PG8_MMA(1, 0, At, B0); PG8_MMA(1, 1, At, B1); PG8_BAR; PG8_SCHED;
            } else {
            PG8_LDB(B0, 0, 0); PG8_SCHED; PG8_LDA(At, 0, 0); PG8_STAGE(PG8_SA(1, 1), a1 + hstep, voffA);
            PG8_WAIT_L(8); PG8_BAR; PG8_WAIT_L(0); PG8_MMA(0, 0, At, B0); PG8_BAR; PG8_SCHED;
            PG8_LDB(B1, 0, 1); PG8_STAGE(PG8_SB(0, 0), b2, voffB);
            PG8_BAR; PG8_WAIT_L(0); PG8_MMA(0, 1, At, B1); PG8_BAR;
            PG8_LDA(At, 0, 1); PG8_STAGE(PG8_SA(0, 0), a2, voffA);
            PG8_BAR; PG8_WAIT_L(0); PG8_MMA(1, 0, At, B0); PG8_BAR; PG8_SCHED;
            PG8_STAGE(PG8_SB(0, 1), b2 + hstep, voffB);
            PG8_WAIT_V(6); PG8_BAR; PG8_MMA(1, 1, At, B1); PG8_BAR;
            PG8_LDB(B0, 1, 0); PG8_SCHED; PG8_LDA(At, 1, 0); PG8_STAGE(PG8_SA(0, 1), a2 + hstep, voffA);
            PG8_WAIT_L(8); PG8_BAR; PG8_WAIT_L(0); PG8_MMA(0, 0, At, B0); PG8_BAR; PG8_SCHED;
            PG8_LDB(B1, 1, 1); PG8_STAGE(PG8_SB(1, 0), b3, voffB);
            PG8_BAR; PG8_WAIT_L(0); PG8_MMA(0, 1, At, B1); PG8_BAR;
            PG8_LDA(At, 1, 1); PG8_STAGE(PG8_SA(1, 0), a3, voffA);
            PG8_BAR; PG8_WAIT_L(0); PG8_MMA(1, 0, At, B0); PG8_BAR; PG8_SCHED;
            PG8_STAGE(PG8_SB(1, 1), b3 + hstep, voffB);
            PG8_WAIT_V(6); PG8_BAR; PG8_MMA(1, 1, At, B1); PG8_BAR;
            }
        }
        if constexpr (ALIGN_EPI) { if (wr == 0) PG8_BAR; }
        if constexpr (!Epi::AFTER_DRAIN) { E(acc, cur, wr, wc, fr, fq); S.done(cur); }
        if (!has_next) break;
        if (!(Epi::SPLITK2 && cur.kh == 0))
#pragma unroll
        for (int a = 0; a < 2; ++a)
#pragma unroll
            for (int b = 0; b < 2; ++b)
#pragma unroll
                for (int m = 0; m < 4; ++m)
#pragma unroll
                    for (int n = 0; n < 2; ++n) acc[a][b][m][n] = (f32x4){0.f, 0.f, 0.f, 0.f};
        cur = nxt; cA = nA; cB = nB; ++ui;
        if constexpr (ALIGN_EPI) { if (wr == 1) PG8_BAR; }
    }
    PG8_WAIT_V(0);
    if constexpr (!ALIGN_EPI) { if (wr == 0) PG8_BAR; }
    PG8_BAR;
    if constexpr (Epi::AFTER_DRAIN) { E.fused(acc, cur, wr, wc, fr, fq, lds, wid, lane); S.done(cur); }
#undef PG8_SA
#undef PG8_SB
#undef PG8_STAGE
#undef PG8_LDA
#undef PG8_LDB
#undef PG8_MMA
#undef PG8_WAIT_V
#undef PG8_WAIT_L
#undef PG8_BAR
#undef PG8_SCHED
}
}
namespace epi {
using pg8::Unit;
typedef f32x4 Acc[2][2][4][2];

__device__ __forceinline__ void rot2(f32x4& v, const f32x4 cs) {
    const float a1 = v[0] * cs[0] - v[1] * cs[1], a2 = v[1] * cs[0] + v[0] * cs[1];
    const float b1 = v[2] * cs[2] - v[3] * cs[3], b2 = v[3] * cs[2] + v[2] * cs[3];
    v = (f32x4){a1, a2, b1, b2};
}
__device__ __forceinline__ float sigm(float x) { return 1.0f / (1.0f + __expf(-x)); }
__device__ __forceinline__ void vmax_publish(unsigned* word, float mx) {
#pragma unroll
    for (int o = 1; o < 64; o <<= 1) mx = fmaxf(mx, __shfl_xor(mx, o));
    if ((threadIdx.x & 63) == 0) atomicMax(word, __float_as_uint(mx));
}
__device__ __forceinline__ float amax8(f32x4 a, f32x4 b) { return fmaxf(fmaxf(fmaxf(fabsf(a[0]), fabsf(a[1])), fmaxf(fabsf(a[2]), fabsf(a[3]))), fmaxf(fmaxf(fabsf(b[0]), fabsf(b[1])), fmaxf(fabsf(b[2]), fabsf(b[3])))); }
__device__ __forceinline__ void unpack8_fp8(const u32x2 w, f32x4& a, f32x4& b) {
    const f32x2 p0 = __builtin_amdgcn_cvt_pk_f32_fp8((int)w.x, false), p1 = __builtin_amdgcn_cvt_pk_f32_fp8((int)w.x, true), p2 = __builtin_amdgcn_cvt_pk_f32_fp8((int)w.y, false), p3 = __builtin_amdgcn_cvt_pk_f32_fp8((int)w.y, true);
    a = (f32x4){p0.x, p0.y, p1.x, p1.y}; b = (f32x4){p2.x, p2.y, p3.x, p3.y};
}
__device__ __forceinline__ float sat8(float x) { return fminf(fmaxf(x, -448.0f), 448.0f); }
__device__ __forceinline__ u32x2 pack8_fp8(f32x4 a, f32x4 b) {
    int p0 = 0, p1 = 0;
    p0 = __builtin_amdgcn_cvt_pk_fp8_f32(sat8(a[0]), sat8(a[1]), p0, false); p0 = __builtin_amdgcn_cvt_pk_fp8_f32(sat8(a[2]), sat8(a[3]), p0, true);
    p1 = __builtin_amdgcn_cvt_pk_fp8_f32(sat8(b[0]), sat8(b[1]), p1, false); p1 = __builtin_amdgcn_cvt_pk_fp8_f32(sat8(b[2]), sat8(b[3]), p1, true);
    return (u32x2){(unsigned)p0, (unsigned)p1};
}

template <bool F8> struct EpiIn {
    static constexpr bool PERM = true, AFTER_DRAIN = false, SPLITK2 = false, FP8 = F8;
    bf16_t *cq, *ckv, *qb, *kb, *vb, *qix, *kpe, *kix, *ga, *gb; float* wix; u64 *ssq_cq, *ssq_ckv;
    const float *ropeM, *ropeD, *ropeI;
    unsigned* vmaxw;
    const float *sx, *sw;
    __device__ __forceinline__ void operator()(const Acc& acc, const Unit& u, int wr, int wc, int fr, int fq) const {
        const int vt = F8 ? (u.pn < 18 ? u.pn : u.pn + 5) : u.pn + 18, rowb = u.pm * 256 + wr * 64 + fr, ct = wc * 32 + 8 * fq;
        f32x4 wsc[2][2];
        if (F8) {
#pragma unroll
            for (int bj = 0; bj < 2; ++bj) { const f32x4* p = (const f32x4*)(sw + u.pn * 256 + ct + bj * 128); wsc[bj][0] = p[0]; wsc[bj][1] = p[1]; }
        }
#define AV(ai_, bj_, m_, n_) (F8 ? acc[ai_][bj_][m_][n_] * rs * wsc[bj_][n_] : acc[ai_][bj_][m_][n_])
        if (vt < 6) {
            bf16_t* dst = vt < 4 ? cq : ckv; const int ld = vt < 4 ? 1024 : 512, cb = (vt < 4 ? vt : vt - 4) * 256 + ct; u64* ssq = vt < 4 ? ssq_cq : ssq_ckv;
#pragma unroll
            for (int ai = 0; ai < 2; ++ai)
#pragma unroll
                for (int m = 0; m < 4; ++m) { const int row = rowb + ai * 128 + m * 16; const float rs = F8 ? sx[row] : 1.f; (void)rs; float s = 0.f;
#pragma unroll
                    for (int bj = 0; bj < 2; ++bj) { const f32x4 v0 = AV(ai, bj, m, 0), v1 = AV(ai, bj, m, 1);
                        s += (v0[0] * v0[0] + v0[1] * v0[1]) + (v0[2] * v0[2] + v0[3] * v0[3]) + (v1[0] * v1[0] + v1[1] * v1[1]) + (v1[2] * v1[2] + v1[3] * v1[3]);
                        *(u32x2*)((unsigned char*)dst + (size_t)row * ld + cb + bj * 128) = pack8_fp8(v0, v1); }
                    s += __shfl_xor(s, 16); s += __shfl_xor(s, 32);
                    if (fq == 0 && ssq) ssq_add(ssq + row, s); }
        } else if (vt < 16) {
            const bool isq = vt < 14; bf16_t* dst = isq ? qb : kb; const int ld = isq ? 2048 : 512, cb = (isq ? vt - 6 : vt - 14) * 256 + ct;
#pragma unroll
            for (int ai = 0; ai < 2; ++ai)
#pragma unroll
                for (int m = 0; m < 4; ++m) { const int row = rowb + ai * 128 + m * 16, t = row_pos(row); const float rs = F8 ? sx[row] : 1.f; (void)rs;
                    f32x4 cs0 = (f32x4){1.f, 0.f, 1.f, 0.f}, cs1 = cs0;
                    if (wc == 0) { const f32x4* p = (const f32x4*)(ropeD + ((size_t)t * 16 + 4 * fq) * 2); cs0 = p[0]; cs1 = p[1]; }
#pragma unroll
                    for (int bj = 0; bj < 2; ++bj) { f32x4 v0 = AV(ai, bj, m, 0), v1 = AV(ai, bj, m, 1);
                        if (wc == 0) { rot2(v0, cs0); rot2(v1, cs1); }
                        *(u32x2*)((unsigned char*)dst + (size_t)row * ld + cb + bj * 128) = pack8_fp8(v0, v1); } }
        } else if (vt < 18) {
            const int cb = (vt - 16) * 256 + ct; float vmx = 0.f;
#pragma unroll
            for (int ai = 0; ai < 2; ++ai)
#pragma unroll
                for (int m = 0; m < 4; ++m) { const int row = rowb + ai * 128 + m * 16; const float rs = F8 ? sx[row] : 1.f; (void)rs;
#pragma unroll
                    for (int bj = 0; bj < 2; ++bj) { const f32x4 v0 = AV(ai, bj, m, 0), v1 = AV(ai, bj, m, 1); vmx = fmaxf(vmx, amax8(v0, v1)); *(u32x2*)((unsigned char*)vb + (size_t)row * 512 + cb + bj * 128) = pack8_fp8(v0, v1); } }
            vmax_publish(vmaxw, vmx);
        } else if (vt < 22) {
            const int cb = (vt - 18) * 256 + ct; const bool rt = ((wc & 1) == 0) && (fq < 2);
#pragma unroll
            for (int ai = 0; ai < 2; ++ai)
#pragma unroll
                for (int m = 0; m < 4; ++m) { const int row = rowb + ai * 128 + m * 16, t = row_pos(row); const float rs = F8 ? sx[row] : 1.f; (void)rs;
                    f32x4 cs0 = (f32x4){1.f, 0.f, 1.f, 0.f}, cs1 = cs0;
                    if (rt) { const f32x4* p = (const f32x4*)(ropeI + ((size_t)t * 8 + 4 * fq) * 2); cs0 = p[0]; cs1 = p[1]; }
#pragma unroll
                    for (int bj = 0; bj < 2; ++bj) { f32x4 v0 = AV(ai, bj, m, 0), v1 = AV(ai, bj, m, 1);
                        if (rt) { rot2(v0, cs0); rot2(v1, cs1); }
                        *(u32x4*)(qix + (size_t)row * 1024 + cb + bj * 128) = pack8(v0, v1); } }
        } else if (vt == 22) {
#pragma unroll
            for (int ai = 0; ai < 2; ++ai)
#pragma unroll
                for (int m = 0; m < 4; ++m) { const int row = rowb + ai * 128 + m * 16, t = row_pos(row); const float rs = F8 ? sx[row] : 1.f; (void)rs;
                    f32x4 v0 = AV(ai, 0, m, 0), v1 = AV(ai, 0, m, 1);
                    if (wc < 2) { const f32x4* p = (const f32x4*)(ropeM + ((size_t)t * 32 + 16 * wc + 4 * fq) * 2); rot2(v0, p[0]); rot2(v1, p[1]);
                        *(u32x2*)((unsigned char*)kpe + (size_t)row * 64 + ct) = pack8_fp8(v0, v1);
                    } else { if (wc == 2 && fq < 2) { const f32x4* p = (const f32x4*)(ropeI + ((size_t)t * 8 + 4 * fq) * 2); rot2(v0, p[0]); rot2(v1, p[1]); }
                        *(u32x4*)(kix + (size_t)row * 64 + (ct - 64)) = pack8(v0, v1); }
                    if (wc == 0 && fq < 2) { float* w = wix + (size_t)row * 16 + 8 * fq; *(f32x4*)w = AV(ai, 1, m, 0); *(f32x4*)(w + 4) = AV(ai, 1, m, 1); } }
        } else {
            const bool isa = vt < 39; bf16_t* dst = isa ? ga : gb; const int cb = (isa ? vt - 23 : vt - 39) * 256 + ct;
#pragma unroll
            for (int ai = 0; ai < 2; ++ai)
#pragma unroll
                for (int m = 0; m < 4; ++m) { const int row = rowb + ai * 128 + m * 16; const float rs = F8 ? sx[row] : 1.f; (void)rs;
#pragma unroll
                    for (int bj = 0; bj < 2; ++bj) { f32x4 v0 = AV(ai, bj, m, 0), v1 = AV(ai, bj, m, 1);
#pragma unroll
                        for (int e = 0; e < 4; ++e) { v0[e] = 256.0f * sigm(v0[e]); v1[e] = 256.0f * sigm(v1[e]); }
                        *(u32x2*)((unsigned char*)dst + (size_t)row * 4096 + cb + bj * 128) = pack8_fp8(v0, v1); } }
        }
#undef AV
    }
};

struct EpiUp {
    static constexpr bool PERM = true, AFTER_DRAIN = false, SPLITK2 = false, FP8 = true;
    unsigned char *d0, *d1; int nt0, ld0, ld1; bool d1_v; const u64* ssq; float invK; const float* rope; const float* sw; unsigned* vmaxw;
    __device__ __forceinline__ void operator()(const Acc& acc, const Unit& u, int wr, int wc, int fr, int fq) const {
        const int vt = u.pn, rowb = u.pm * 256 + wr * 64 + fr, ct = wc * 32 + 8 * fq; const bool first = vt < nt0;
        unsigned char* dst = first ? d0 : d1; const int ld = first ? ld0 : ld1, cb = (first ? vt : vt - nt0) * 256 + ct; const bool rt = (!first) && (rope != nullptr), isv = (!first) && d1_v;
        f32x4 w0[2], w1[2]; float vmx = 0.f;
#pragma unroll
        for (int bj = 0; bj < 2; ++bj) { const f32x4* p = (const f32x4*)(sw + vt * 256 + ct + bj * 128); w0[bj] = p[0]; w1[bj] = p[1]; }
#pragma unroll
        for (int ai = 0; ai < 2; ++ai)
#pragma unroll
            for (int m = 0; m < 4; ++m) { const int row = rowb + ai * 128 + m * 16, t = row_pos(row);
                const float rs = __builtin_amdgcn_rsqf(ssq_get(ssq + row) * invK + EPS);
                f32x4 cs0 = (f32x4){1.f, 0.f, 1.f, 0.f}, cs1 = cs0;
                if (rt) { const f32x4* p = (const f32x4*)(rope + ((size_t)t * 32 + 16 * (wc & 1) + 4 * fq) * 2); cs0 = p[0]; cs1 = p[1]; }
#pragma unroll
                for (int bj = 0; bj < 2; ++bj) { f32x4 v0 = acc[ai][bj][m][0] * rs * w0[bj], v1 = acc[ai][bj][m][1] * rs * w1[bj];
                    if (rt) { rot2(v0, cs0); rot2(v1, cs1); }
                    if (isv) vmx = fmaxf(vmx, amax8(v0, v1));
                    *(u32x2*)(dst + (size_t)row * ld + cb + bj * 128) = pack8_fp8(v0, v1); } }
        if (isv) vmax_publish(vmaxw, vmx);
    }
};

struct EpiBranch {
    static constexpr bool PERM = true, AFTER_DRAIN = false, SPLITK2 = true, FP8 = true;
    const bf16_t *ga, *gb; unsigned char* out; const unsigned* vmaxw; const float* scol; const u64 *ssqa, *ssqb; const unsigned* wnorm; float* smrg;
    __device__ __forceinline__ void operator()(Acc& acc, const Unit& u, int wr, int wc, int fr, int fq) const {
        const int rowb = u.pm * 256 + wr * 64 + fr, cb = u.pn * 256 + wc * 32 + 8 * fq;
        const float vmb = fmaxf(__uint_as_float(vmaxw[0]), 1e-30f), vma = fmaxf(__uint_as_float(vmaxw[64]), 1e-30f);
        if (u.kh == 0) {
            const float rab = vma * __builtin_amdgcn_rcpf(vmb);
#pragma unroll
            for (int ai = 0; ai < 2; ++ai)
#pragma unroll
                for (int m = 0; m < 4; ++m) { const size_t ro = (size_t)(rowb + ai * 128 + m * 16) * 4096 + cb;
#pragma unroll
                    for (int bj = 0; bj < 2; ++bj) { f32x4 a0, a1, b0, b1; unpack8_fp8(*(const u32x2*)((const unsigned char*)ga + ro + bj * 128), a0, a1); unpack8_fp8(*(const u32x2*)((const unsigned char*)gb + ro + bj * 128), b0, b1);
                        f32x4 r0, r1;
#pragma unroll
                        for (int e = 0; e < 4; ++e) { r0[e] = a0[e] * __builtin_amdgcn_rcpf(fmaxf(b0[e], 0.001953125f)); r1[e] = a1[e] * __builtin_amdgcn_rcpf(fmaxf(b1[e], 0.001953125f)); }
                        acc[ai][bj][m][0] = acc[ai][bj][m][0] * (r0 * rab); acc[ai][bj][m][1] = acc[ai][bj][m][1] * (r1 * rab); }
                    asm volatile("" ::: "memory"); }
        } else {
            f32x4 w0[2], w1[2];
#pragma unroll
            for (int bj = 0; bj < 2; ++bj) { const f32x4* p = (const f32x4*)(scol + cb + bj * 128); w0[bj] = p[0]; w1[bj] = p[1]; }
            const float ca = sqrtf(__uint_as_float(wnorm[0])), cbn = sqrtf(__uint_as_float(wnorm[64]));
#pragma unroll
            for (int ai = 0; ai < 2; ++ai)
#pragma unroll
                for (int m = 0; m < 4; ++m) { const int row = rowb + ai * 128 + m * 16; const size_t ro = (size_t)row * 4096 + cb; const float rs = vmb * (1.0f / 440.0f);
                    const float bound = fmaxf(sqrtf(ssq_get(ssqa + row)) * ca + sqrtf(ssq_get(ssqb + row)) * cbn, 1e-30f), qs = 380.0f / bound;
                    if (u.pn == 0 && wc == 0 && fq == 0) smrg[row] = bound * (1.0f / 380.0f);
#pragma unroll
                    for (int bj = 0; bj < 2; ++bj) { f32x4 s0, s1; unpack8_fp8(*(const u32x2*)((const unsigned char*)gb + ro + bj * 128), s0, s1);
                        s0 = s0 * (rs * (1.0f / 256.0f) * qs) * w0[bj]; s1 = s1 * (rs * (1.0f / 256.0f) * qs) * w1[bj];
                        *(u32x2*)(out + (size_t)row * 8192 + cb + bj * 128) = pack8_fp8(acc[ai][bj][m][0] * s0, acc[ai][bj][m][1] * s1); } }
        }
    }
};

struct EpiOut {
    static constexpr bool PERM = true, AFTER_DRAIN = false, SPLITK2 = false, FP8 = true;
    const float *x, *meta; float* h1f; bf16_t* h1b; u64* ssq; const float *srow, *scol;
    __device__ __forceinline__ void operator()(const Acc& acc, const Unit& u, int wr, int wc, int fr, int fq) const {
        const int rowb = u.pm * 256 + wr * 64 + fr, cb = u.pn * 256 + wc * 32 + 8 * fq;
#pragma unroll
        for (int ai = 0; ai < 2; ++ai)
#pragma unroll
            for (int m = 0; m < 4; ++m) { const int row = rowb + ai * 128 + m * 16;
                const float* src = x + (size_t)row * DM;
                float s = 0.f; const float rs = srow[row];
#pragma unroll
                for (int bj = 0; bj < 2; ++bj) { const f32x4* wp = (const f32x4*)(scol + cb + bj * 128); f32x4 v0 = acc[ai][bj][m][0] * rs * wp[0], v1 = acc[ai][bj][m][1] * rs * wp[1];
                    v0 = v0 + *(const f32x4*)(src + cb + bj * 128); v1 = v1 + *(const f32x4*)(src + cb + bj * 128 + 4);
                    s += (v0[0] * v0[0] + v0[1] * v0[1]) + (v0[2] * v0[2] + v0[3] * v0[3]) + (v1[0] * v1[0] + v1[1] * v1[1]) + (v1[2] * v1[2] + v1[3] * v1[3]);
                    *(u32x4*)(h1b + (size_t)row * DM + cb + bj * 128) = pack8(v0, v1); }
                s += __shfl_xor(s, 16); s += __shfl_xor(s, 32);
                if (fq == 0 && ssq) ssq_add(ssq + row, s); }
    }
};

struct EpiPQ {
    static constexpr bool PERM = true, AFTER_DRAIN = false, SPLITK2 = false, FP8 = false;
    bf16_t* pq; const u64* ssq;
    __device__ __forceinline__ void operator()(const Acc& acc, const Unit& u, int wr, int wc, int fr, int fq) const {
        const int rowb = u.pm * 256 + wr * 64 + fr, cb = u.pn * 256 + wc * 32 + 8 * fq;
#pragma unroll
        for (int ai = 0; ai < 2; ++ai)
#pragma unroll
            for (int m = 0; m < 4; ++m) { const int row = rowb + ai * 128 + m * 16; const float rs = __builtin_amdgcn_rsqf(ssq_get(ssq + row) * (1.0f / DM) + EPS);
#pragma unroll
                for (int bj = 0; bj < 2; ++bj) *(u32x4*)(pq + (size_t)row * 2048 + cb + bj * 128) = pack8(acc[ai][bj][m][0] * rs, acc[ai][bj][m][1] * rs); }
    }
};
}
#define XB_TMO      128
#define XB_XCNT(j)  (256  + 64 * (j))
#define XB_XSUB(j)  (1280 + 64 * (j))
#define XB_XGEN(j)  (2304 + 64 * (j))
#define XB_TOP      3328
#define XB_TOPGEN   3392
#define XCD_BAR_WORDS 3456
#define XB_SPIN_CAP (1u << 18)
__device__ __forceinline__ unsigned xb_ld(unsigned* p)              { return __hip_atomic_load(p, __ATOMIC_RELAXED, __HIP_MEMORY_SCOPE_AGENT); }
__device__ __forceinline__ unsigned xb_add(unsigned* p, unsigned v) { return __hip_atomic_fetch_add(p, v, __ATOMIC_RELAXED, __HIP_MEMORY_SCOPE_AGENT); }
__device__ __forceinline__ unsigned xb_xcc_id() { return (unsigned)__builtin_amdgcn_s_getreg((3 << 11) | 20) & 0xFu; }
#define XB_SPIN(cond, bar) do { unsigned _sp = 0; while (cond) { __builtin_amdgcn_s_sleep(1); \
    if ((++_sp & 255u) == 0u) { if (xb_ld(&(bar)[XB_TMO])) break; if (_sp > XB_SPIN_CAP) { atomicAdd(&(bar)[XB_TMO], 1u); break; } } } } while (0)
struct XcdBarrier { unsigned* bar; unsigned x; volatile LAS unsigned* st; };
__device__ __forceinline__ XcdBarrier xcd_barrier_post(unsigned* bar, volatile LAS unsigned* st) {
    XcdBarrier b; b.bar = bar; b.x = xb_xcc_id(); b.st = st;
    if (threadIdx.x == 0) (void)xb_add(&bar[XB_XCNT(b.x)], 1u);
    return b;
}
__device__ __forceinline__ void xcd_barrier_complete(unsigned* bar, unsigned x, unsigned& nloc, unsigned& nx) {
    const unsigned G = gridDim.x * gridDim.y * gridDim.z;
    unsigned sum, cnt, mine, sp = 0u;
    for (;;) {
        sum = 0u; cnt = 0u; mine = 0u;
#pragma unroll
        for (unsigned j = 0; j < 16; ++j) { const unsigned c = xb_ld(&bar[XB_XCNT(j)]); sum += c; cnt += (c > 0u) ? 1u : 0u; mine = (j == x) ? c : mine; }
        if (sum == G) break;
        __builtin_amdgcn_s_sleep(1);
        if ((++sp & 255u) == 0u) { if (xb_ld(&bar[XB_TMO])) break; if (sp > XB_SPIN_CAP) { atomicAdd(&bar[XB_TMO], 1u); break; } }
    }
    nloc = mine > 0u ? mine : 1u; nx = cnt > 0u ? cnt : 1u;
}
__device__ __forceinline__ void xcd_barrier(const XcdBarrier& b) {
    asm volatile("s_waitcnt vmcnt(0)" ::: "memory");
    __syncthreads();
    if (threadIdx.x == 0) {
        unsigned* bar = b.bar;
        __builtin_amdgcn_s_waitcnt(0);
        unsigned nloc = b.st[0], nx = b.st[1];
        if (nloc == 0u) { xcd_barrier_complete(bar, b.x, nloc, nx); b.st[0] = nloc; b.st[1] = nx; }
        const unsigned old = xb_add(&bar[XB_XSUB(b.x)], 1u);
        const unsigned gen = old / nloc;
        if (old + 1u == (gen + 1u) * nloc) {
            __builtin_amdgcn_fence(__ATOMIC_RELEASE, "agent");
            asm volatile("s_waitcnt vmcnt(0)" ::: "memory");
            const unsigned og = xb_add(&bar[XB_TOP], 1u);
            const unsigned tg = og / nx;
            if (og + 1u == (tg + 1u) * nx) xb_add(&bar[XB_TOPGEN], 1u);
            else XB_SPIN(xb_ld(&bar[XB_TOPGEN]) == tg, bar);
            __builtin_amdgcn_fence(__ATOMIC_ACQUIRE, "agent");
            xb_add(&bar[XB_XGEN(b.x)], 1u);
            asm volatile("s_waitcnt vmcnt(0)" ::: "memory");
        } else {
            XB_SPIN(xb_ld(&bar[XB_XGEN(b.x)]) == gen, bar);
            __builtin_amdgcn_fence(__ATOMIC_ACQUIRE, "agent");
            asm volatile("s_waitcnt vmcnt(0)" ::: "memory");
        }
    }
    __syncthreads();
}

struct Frame {
    LAS unsigned char* lds;
    unsigned char* ws;
    unsigned* ctl;
    int tid, lane, wave, vcu, G;
    __device__ __forceinline__ const float* in(int i) const { return ((const float* const __attribute__((address_space(4)))*)__builtin_amdgcn_kernarg_segment_ptr())[i]; }
    __device__ __forceinline__ float* out() const { return ((float* const __attribute__((address_space(4)))*)__builtin_amdgcn_kernarg_segment_ptr())[16]; }
};

struct MapId { __device__ __forceinline__ int operator()(int v) const { return v; } };
struct MapIn { __device__ __forceinline__ int operator()(int vn) const {
    const int v = vn < 1280 ? vn + 4608 : (vn < 5888 ? vn - 1280 : vn);
    if (v < 1536) return v;
    if (v < 3584) { const int w = v - 1536, hd = w >> 7; int o = w & 127; if (o < 32) o = (o & 1) ? (o >> 1) + 16 : (o >> 1); return 1600 + hd * 128 + o; }
    if (v < 4096) { const int w = v - 3584, hd = w >> 7; int o = w & 127; if (o < 32) o = (o & 1) ? (o >> 1) + 16 : (o >> 1); return 3648 + hd * 128 + o; }
    if (v < 4608) return 4160 + (v - 4096);
    if (v < 5632) { const int w = v - 4608, hd = w >> 6; int o = w & 63; if (o < 16) o = (o & 1) ? (o >> 1) + 8 : (o >> 1); return 4672 + hd * 64 + o; }
    if (v < 5888) { const int w = v - 5632;
        if (w < 64) return 1536 + ((w & 1) ? (w >> 1) + 32 : (w >> 1));
        if (w < 128) { int o = w - 64; if (o < 16) o = (o & 1) ? (o >> 1) + 8 : (o >> 1); return 5696 + o; }
        if (w < 144) return 5760 + (w - 128);
        return -1; }
    if (v < 9984) return 5776 + (v - 5888);
    return 9872 + (v - 9984);
} };
struct MapUq { __device__ __forceinline__ int operator()(int v) const {
    if (v < 2048) return (v >> 7) * 192 + (v & 127);
    const int w = v - 2048, hd = w >> 6, o = w & 63; return hd * 192 + 128 + ((o & 1) ? (o >> 1) + 32 : (o >> 1)); } };
struct MapUkv { __device__ __forceinline__ int operator()(int v) const {
    if (v < 2048) return (v >> 7) * 256 + (v & 127);
    const int w = v - 2048; return (w >> 7) * 256 + 128 + (w & 127); } };

template <class Map>
__device__ __forceinline__ void p0_transpose_item(const float* W, int K, int Nsrc, int Nvirt, bf16_t* WT, const float* gk, LAS float* scr, int item, int lane, Map map) {
    const int nblk = Nvirt / 32, kb = item / nblk, nb = item % nblk, k0 = 64 * kb, n0 = 32 * nb;
    const int sc = map(n0 + (lane & 31));
    float tv[32];
#pragma unroll
    for (int i = 0; i < 32; ++i) { const int kk = 2 * i + (lane >> 5); tv[i] = (sc >= 0) ? W[(size_t)(k0 + kk) * Nsrc + sc] : 0.f; }
    if (gk) {
#pragma unroll
        for (int i = 0; i < 32; ++i) tv[i] *= gk[k0 + 2 * i + (lane >> 5)]; }
#pragma unroll
    for (int i = 0; i < 32; ++i) scr[(2 * i + (lane >> 5)) * 33 + (lane & 31)] = tv[i];
    LDS_WAIT(); asm volatile("" ::: "memory");
    const int c = lane & 7;
#pragma unroll
    for (int j = 0; j < 4; ++j) { const int n = (lane >> 3) + 8 * j; const LAS float* s = scr + (8 * c) * 33 + n;
        u32x4 o; o.x = pk2(s[0 * 33], s[1 * 33]); o.y = pk2(s[2 * 33], s[3 * 33]); o.z = pk2(s[4 * 33], s[5 * 33]); o.w = pk2(s[6 * 33], s[7 * 33]);
        *(u32x4*)(WT + (size_t)(n0 + n) * K + k0 + 8 * c) = o; }
    LDS_WAIT(); asm volatile("" ::: "memory");
}
__device__ __forceinline__ float wave_max(float v) {
#pragma unroll
    for (int o = 1; o < 64; o <<= 1) v = fmaxf(v, __shfl_xor(v, o));
    return v;
}
__device__ __forceinline__ void p0_xn_row(const Frame& F, int m) {
    const float* x = F.in(0); const float* meta = F.in(1); const float* g = F.in(2);
    bf16_t* o = (bf16_t*)(F.ws + WS_XN) + (size_t)m * DM;
    u32x2* o8 = (u32x2*)o + F.lane;
    if (m >= NTOK + NMETA) {
        unsigned* z8 = (unsigned*)(F.ws + WS_XN8 + (size_t)m * DM) + F.lane;
#pragma unroll
        for (int j = 0; j < 16; ++j) { o8[64 * j] = (u32x2){0u, 0u}; z8[64 * j] = 0u; }
        if (F.lane == 0) ((float*)(F.ws + WS_SX))[m] = 0.f;
        return; }
    const float* src = m < NTOK ? x + (size_t)m * DM : meta + (size_t)(m - NTOK) * DM;
    const f32x4* xr = (const f32x4*)src + F.lane; const f32x4* gr = (const f32x4*)g + F.lane;
    f32x4 v[16]; float s = 0.f;
#pragma unroll
    for (int j = 0; j < 16; ++j) { v[j] = xr[64 * j]; s += (v[j][0] * v[j][0] + v[j][1] * v[j][1]) + (v[j][2] * v[j][2] + v[j][3] * v[j][3]); }
    const float rstd = 1.0f / sqrtf(wave_sum(s) * (1.0f / DM) + EPS);
    float mx = 0.f;
#pragma unroll
    for (int j = 0; j < 16; ++j) { const f32x4 gg = gr[64 * j]; v[j] = v[j] * rstd * gg; o8[64 * j] = (u32x2){pk2(v[j][0], v[j][1]), pk2(v[j][2], v[j][3])};
        mx = fmaxf(mx, fmaxf(fmaxf(fabsf(v[j][0]), fabsf(v[j][1])), fmaxf(fabsf(v[j][2]), fabsf(v[j][3])))); }
    mx = fmaxf(wave_max(mx), 1e-30f);
    const float inv = 448.0f / mx;
    if (F.lane == 0) ((float*)(F.ws + WS_SX))[m] = mx * (1.0f / 448.0f);
    unsigned* q8 = (unsigned*)(F.ws + WS_XN8 + (size_t)m * DM) + F.lane;
#pragma unroll
    for (int j = 0; j < 16; ++j) { f32x4 q = v[j] * inv;
#pragma unroll
        for (int e = 0; e < 4; ++e) q[e] = fminf(fmaxf(q[e], -448.0f), 448.0f);
        int p = 0; p = __builtin_amdgcn_cvt_pk_fp8_f32(q[0], q[1], p, false); p = __builtin_amdgcn_cvt_pk_fp8_f32(q[2], q[3], p, true); q8[64 * j] = (unsigned)p; }
}
__device__ __forceinline__ void p0_prologue(const Frame& F) {
    LAS float* scr = (LAS float*)(F.lds + F.wave * 16384);
    const int gw = F.vcu * NWAVES + F.wave, NGW = F.G * NWAVES;
    const float* w_in = F.in(3); const float* qg = F.in(4); const float* w_uq = F.in(5); const float* kvg = F.in(6); const float* w_ukv = F.in(7);
    const float* w_br = F.in(8); const float* w_out = F.in(9); const float* fg = F.in(10); const float* w_q = F.in(11); const float* sk = F.in(12);
    constexpr int I_IN = 64 * (NV1 / 32), I_UQ = 16 * (3072 / 32), I_UKV = 8 * (4096 / 32), I_BR = 64 * 128, I_OUT = 64 * 128, I_Q = 64 * 64;
    constexpr int NITEMS = I_IN + I_UQ + I_UKV + I_BR + I_OUT + I_Q;
    struct TItem { const float* W; bf16_t* WT; const float* gk; int K, Nsrc, k0, n0, sc; };
    auto decode = [&](int it) -> TItem {
        TItem t; int r = it, nv, mapid;
        if (r < I_IN) { t.W = w_in; t.K = 4096; t.Nsrc = 13968; nv = NV1; t.WT = (bf16_t*)(F.ws + WS_WIN); t.gk = nullptr; mapid = 0; }
        else if ((r -= I_IN) < I_UQ) { t.W = w_uq; t.K = 1024; t.Nsrc = 3072; nv = 3072; t.WT = (bf16_t*)(F.ws + WS_WUQ); t.gk = qg; mapid = 1; }
        else if ((r -= I_UQ) < I_UKV) { t.W = w_ukv; t.K = 512; t.Nsrc = 4096; nv = 4096; t.WT = (bf16_t*)(F.ws + WS_WUKV); t.gk = kvg; mapid = 2; }
        else if ((r -= I_UKV) < I_BR) { t.W = w_br; t.K = 4096; t.Nsrc = 4096; nv = 4096; t.WT = (bf16_t*)(F.ws + WS_H1F); t.gk = nullptr; mapid = 3; }
        else if ((r -= I_BR) < I_OUT) { t.W = w_out; t.K = 4096; t.Nsrc = 4096; nv = 4096; t.WT = (bf16_t*)(F.ws + WS_WOUT); t.gk = nullptr; mapid = 3; }
        else { r -= I_OUT; t.W = w_q; t.K = 4096; t.Nsrc = 2048; nv = 2048; t.WT = (bf16_t*)(F.ws + WS_WQ); t.gk = fg; mapid = 3; }
        const int nblk = nv / 32, kb = r / nblk, nb = r % nblk; t.k0 = 64 * kb; t.n0 = 32 * nb;
        const int v = t.n0 + (F.lane & 31);
        t.sc = mapid == 0 ? MapIn()(v) : (mapid == 1 ? MapUq()(v) : (mapid == 2 ? MapUkv()(v) : v));
        return t; };
#define TLOAD(t, tv) do { _Pragma("unroll") for (int i = 0; i < 32; ++i) { const int kk = 2 * i + (F.lane >> 5); tv[i] = (t.sc >= 0) ? t.W[(size_t)(t.k0 + kk) * t.Nsrc + t.sc] : 0.f; } } while (0)
#define TSTORE(t, tv) do { \
        if (t.gk) { _Pragma("unroll") for (int i = 0; i < 32; ++i) tv[i] *= t.gk[t.k0 + 2 * i + (F.lane >> 5)]; } \
        _Pragma("unroll") for (int i = 0; i < 32; ++i) scr[(2 * i + (F.lane >> 5)) * 33 + (F.lane & 31)] = tv[i]; \
        LDS_WAIT(); asm volatile("" ::: "memory"); \
        const int c_ = F.lane & 7; \
        _Pragma("unroll") for (int j = 0; j < 4; ++j) { const int n = (F.lane >> 3) + 8 * j; const LAS float* s = scr + (8 * c_) * 33 + n; \
            u32x4 o; o.x = pk2(s[0 * 33], s[1 * 33]); o.y = pk2(s[2 * 33], s[3 * 33]); o.z = pk2(s[4 * 33], s[5 * 33]); o.w = pk2(s[6 * 33], s[7 * 33]); \
            *(u32x4*)(t.WT + (size_t)(t.n0 + n) * t.K + t.k0 + 8 * c_) = o; } \
        LDS_WAIT(); asm volatile("" ::: "memory"); } while (0)
    {
        float ta[32], tb[32]; TItem ia, ib;
        int it = gw;
        if (it < NITEMS) { ia = decode(it); TLOAD(ia, ta); }
#pragma unroll 1
        for (; it < NITEMS; it += 2 * NGW) {
            const int i1 = it + NGW, i2 = it + 2 * NGW;
            if (i1 < NITEMS) { ib = decode(i1); TLOAD(ib, tb); }
            TSTORE(ia, ta);
            if (i2 < NITEMS) { ia = decode(i2); TLOAD(ia, ta); }
            if (i1 < NITEMS) TSTORE(ib, tb);
        }
    }
#undef TLOAD
#undef TSTORE
    for (int m = gw; m < MK; m += NGW) p0_xn_row(F, m);
    const int gt = (F.vcu * NWAVES + F.wave) * 64 + F.lane, NGT = NGW * 64;
    for (int i = gt; i < TP * 56; i += NGT) {
        const int t = i / 56, r = i % 56; int j, rot; float* dst;
        if (r < 32) { j = r; rot = 64; dst = (float*)(F.ws + WS_ROPE_M) + ((size_t)t * 32 + j) * 2; }
        else if (r < 48) { j = r - 32; rot = 32; dst = (float*)(F.ws + WS_ROPE_D) + ((size_t)t * 16 + j) * 2; }
        else { j = r - 48; rot = 16; dst = (float*)(F.ws + WS_ROPE_I) + ((size_t)t * 8 + j) * 2; }
        const float ex = (float)(2 * j) / (float)rot;
        const float inv = powf(500000.0f, -ex);
        const float ang = (float)t * inv;
        const double a = (double)ang, kq = rint(a * 0.15915494309189535), rr = fma(-kq, 6.283185307179586, a);
        const float rf = (float)rr;
        dst[0] = cosf(rf); dst[1] = sinf(rf);
    }
    for (int i = gt; i < 16 * 128 * 128 / 8; i += NGT) { const f32x4* s = (const f32x4*)sk + 2 * (size_t)i; const f32x4 a = s[0], b2 = s[1];
        u32x4 o; o.x = pk2(a[0], a[1]); o.y = pk2(a[2], a[3]); o.z = pk2(b2[0], b2[1]); o.w = pk2(b2[2], b2[3]); ((u32x4*)(F.ws + WS_SK))[i] = o; }
}
__device__ __forceinline__ unsigned fp6_code(float q) {
    const unsigned b = __float_as_uint(q), sgn = (b >> 31) << 5; const float aq = fabsf(q);
    const unsigned sub = (unsigned)rintf(aq * 8.0f);
    unsigned ab = b & 0x7fffffffu; ab = ab + 0x7FFFFu + ((ab >> 20) & 1u);
    const unsigned nrm = (ab >> 20) - (126u << 3);
    unsigned code = aq < 1.0f ? sub : nrm; code = code > 31u ? 31u : code;
    return code | sgn;
}
__device__ __forceinline__ void fp6_pack32(const unsigned (&c)[32], unsigned (&w)[6]) {
#pragma unroll
    for (int i = 0; i < 6; ++i) w[i] = 0u;
#pragma unroll
    for (int k = 0; k < 32; ++k) { const int bit = 6 * k, d = bit >> 5, sh = bit & 31; w[d] |= c[k] << sh; if (sh > 26) w[d + 1] |= c[k] >> (32 - sh); }
}
__device__ __forceinline__ void p6_quant_row(const float* src, const float* gain, unsigned char* dst, float* scale_out, int lane) {
    const f32x4* s = (const f32x4*)src + lane; f32x4 v[16]; float mx = 0.f;
#pragma unroll
    for (int j = 0; j < 16; ++j) { v[j] = s[64 * j]; if (gain) v[j] = v[j] * ((const f32x4*)gain)[lane + 64 * j];
        mx = fmaxf(mx, fmaxf(fmaxf(fabsf(v[j][0]), fabsf(v[j][1])), fmaxf(fabsf(v[j][2]), fabsf(v[j][3])))); }
    mx = fmaxf(wave_max(mx), 1e-30f);
    const float sc = mx * (1.0f / 7.5f), inv = 7.5f / mx;
    if (lane == 0) *scale_out = sc;
    unsigned w[12];
#pragma unroll
    for (int g = 0; g < 2; ++g) { unsigned c[32];
#pragma unroll
        for (int j = 0; j < 8; ++j)
#pragma unroll
            for (int i = 0; i < 4; ++i) c[4 * j + i] = fp6_code(v[8 * g + j][i] * inv);
        unsigned ww[6]; fp6_pack32(c, ww);
#pragma unroll
        for (int i = 0; i < 6; ++i) w[6 * g + i] = ww[i]; }
#pragma unroll
    for (int q = 0; q < 3; ++q) *(u32x4*)(dst + 1024 * q + 16 * lane) = (u32x4){w[4 * q], w[4 * q + 1], w[4 * q + 2], w[4 * q + 3]};
}
__device__ __forceinline__ unsigned fp4_code(float q) {
    const float aq = fabsf(q);
    const unsigned c = (aq > 0.25f ? 1u : 0u) + (aq >= 0.75f ? 1u : 0u) + (aq > 1.25f ? 1u : 0u) + (aq >= 1.75f ? 1u : 0u) + (aq > 2.5f ? 1u : 0u) + (aq >= 3.5f ? 1u : 0u) + (aq > 5.0f ? 1u : 0u);
    return c | ((__float_as_uint(q) >> 31) << 3);
}
__device__ __forceinline__ void p6_quant_row4(const float* src, const float* gain, unsigned char* dst, float* scale_out, int lane) {
    const f32x4* s = (const f32x4*)src + lane; f32x4 v[16]; float mx = 0.f;
#pragma unroll
    for (int j = 0; j < 16; ++j) { v[j] = s[64 * j]; if (gain) v[j] = v[j] * ((const f32x4*)gain)[lane + 64 * j];
        mx = fmaxf(mx, fmaxf(fmaxf(fabsf(v[j][0]), fabsf(v[j][1])), fmaxf(fabsf(v[j][2]), fabsf(v[j][3])))); }
    mx = fmaxf(wave_max(mx), 1e-30f);
    const float sc = mx * (1.0f / 6.0f), inv = 6.0f / mx;
    if (lane == 0) *scale_out = sc;
    unsigned w[8];
#pragma unroll
    for (int d = 0; d < 8; ++d) { unsigned x = 0u;
        const f32x4 a = v[2 * d] * inv, b = v[2 * d + 1] * inv;
        x = __builtin_amdgcn_cvt_scalef32_pk_fp4_f32(x, a[0], a[1], 1.0f, 0); x = __builtin_amdgcn_cvt_scalef32_pk_fp4_f32(x, a[2], a[3], 1.0f, 1);
        x = __builtin_amdgcn_cvt_scalef32_pk_fp4_f32(x, b[0], b[1], 1.0f, 2); x = __builtin_amdgcn_cvt_scalef32_pk_fp4_f32(x, b[2], b[3], 1.0f, 3);
        w[d] = x; }
#pragma unroll
    for (int q = 0; q < 2; ++q) *(u32x4*)(dst + 1024 * q + 16 * lane) = (u32x4){w[4 * q], w[4 * q + 1], w[4 * q + 2], w[4 * q + 3]};
}
#ifndef PEER_U_BITS
#define PEER_U_BITS 4
#endif
#ifndef PEER_V_BITS
#define PEER_V_BITS 4
#endif
constexpr int PEER_U_ROWB = PEER_U_BITS == 4 ? 2048 : 3072, PEER_V_ROWB = PEER_V_BITS == 4 ? 2048 : 3072;
__device__ __forceinline__ void p6_quant_regs4(f32x4 (&v)[16], unsigned char* dst, float* scale_out, int lane) {
    float mx = 0.f;
#pragma unroll
    for (int j = 0; j < 16; ++j) mx = fmaxf(mx, fmaxf(fmaxf(fabsf(v[j][0]), fabsf(v[j][1])), fmaxf(fabsf(v[j][2]), fabsf(v[j][3]))));
    mx = fmaxf(wave_max(mx), 1e-30f);
    const float inv = 6.0f / mx;
    if (lane == 0) *scale_out = mx * (1.0f / 6.0f);
    unsigned w[8];
#pragma unroll
    for (int d = 0; d < 8; ++d) { unsigned x = 0u;
        const f32x4 a = v[2 * d] * inv, b = v[2 * d + 1] * inv;
        x = __builtin_amdgcn_cvt_scalef32_pk_fp4_f32(x, a[0], a[1], 1.0f, 0); x = __builtin_amdgcn_cvt_scalef32_pk_fp4_f32(x, a[2], a[3], 1.0f, 1);
        x = __builtin_amdgcn_cvt_scalef32_pk_fp4_f32(x, b[0], b[1], 1.0f, 2); x = __builtin_amdgcn_cvt_scalef32_pk_fp4_f32(x, b[2], b[3], 1.0f, 3);
        w[d] = x; }
#pragma unroll
    for (int q = 0; q < 2; ++q) *(u32x4*)(dst + 1024 * q + 16 * lane) = (u32x4){w[4 * q], w[4 * q + 1], w[4 * q + 2], w[4 * q + 3]};
}
__device__ __forceinline__ void p6_tables(const Frame& F) {
    const float* fg = F.in(10); const float* pu = F.in(13); const float* pv = F.in(14);
    const int gw = F.vcu * NWAVES + F.wave, NGW = F.G * NWAVES, lane = F.lane;
#if PEER_U_BITS == 4 && PEER_V_BITS == 4
    if ((NGW & 1) == 0) {
        const bool isv = gw & 1; const float* tab = isv ? pv : pu; unsigned char* dtab = F.ws + (isv ? WS_V : WS_U); float* stab = (float*)(F.ws + (isv ? WS_SCV : WS_SCU));
        const int e0 = gw >> 1, estep = NGW >> 1;
        f32x4 g[16];
#pragma unroll
        for (int j = 0; j < 16; ++j) g[j] = isv ? (f32x4){1.f, 1.f, 1.f, 1.f} : ((const f32x4*)fg)[lane + 64 * j];
        f32x4 va[16], vb[16];
        if (e0 < 16384) {
#pragma unroll
            for (int j = 0; j < 16; ++j) va[j] = ((const f32x4*)(tab + (size_t)e0 * DM))[lane + 64 * j];
        }
#pragma unroll 1
        for (int e = e0; e < 16384; e += 2 * estep) {
            const int e1 = e + estep, e2 = e + 2 * estep;
            if (e1 < 16384) {
#pragma unroll
                for (int j = 0; j < 16; ++j) vb[j] = ((const f32x4*)(tab + (size_t)e1 * DM))[lane + 64 * j];
            }
#pragma unroll
            for (int j = 0; j < 16; ++j) va[j] = va[j] * g[j];
            p6_quant_regs4(va, dtab + (size_t)e * 2048, stab + e, lane);
            if (e2 < 16384) {
#pragma unroll
                for (int j = 0; j < 16; ++j) va[j] = ((const f32x4*)(tab + (size_t)e2 * DM))[lane + 64 * j];
            }
            if (e1 < 16384) {
#pragma unroll
                for (int j = 0; j < 16; ++j) vb[j] = vb[j] * g[j];
                p6_quant_regs4(vb, dtab + (size_t)e1 * 2048, stab + e1, lane);
            }
        }
        return;
    }
#endif
    for (int it = gw; it < 2 * 16384; it += NGW) { const int e = it >> 1;
        if (it & 1) { if (PEER_V_BITS == 4) p6_quant_row4(pv + (size_t)e * DM, nullptr, F.ws + WS_V + (size_t)e * PEER_V_ROWB, (float*)(F.ws + WS_SCV) + e, F.lane);
                      else p6_quant_row(pv + (size_t)e * DM, nullptr, F.ws + WS_V + (size_t)e * PEER_V_ROWB, (float*)(F.ws + WS_SCV) + e, F.lane); }
        else { if (PEER_U_BITS == 4) p6_quant_row4(pu + (size_t)e * DM, fg, F.ws + WS_U + (size_t)e * PEER_U_ROWB, (float*)(F.ws + WS_SCU) + e, F.lane);
               else p6_quant_row(pu + (size_t)e * DM, fg, F.ws + WS_U + (size_t)e * PEER_U_ROWB, (float*)(F.ws + WS_SCU) + e, F.lane); } }
}

__device__ __forceinline__ void rowquant_fp8(const Frame& F, const unsigned char* src, size_t src_pitch, unsigned char* dst, size_t dst_pitch, float* scale, int nrows, unsigned* halfnorm = nullptr) {
    const int gw = F.vcu * NWAVES + F.wave, NGW = F.G * NWAVES, lane = F.lane;
    for (int n = gw; n < nrows; n += NGW) {
        const u32x4* s = (const u32x4*)(src + (size_t)n * src_pitch) + lane;
        u32x4 v[8]; float mx = 0.f;
#pragma unroll
        for (int j = 0; j < 8; ++j) { v[j] = s[64 * j];
#pragma unroll
            for (int e = 0; e < 4; ++e) mx = fmaxf(mx, fmaxf(fabsf(bf_lo(v[j][e])), fabsf(bf_hi(v[j][e])))); }
        if (halfnorm) { float q0 = 0.f, q1 = 0.f;
#pragma unroll
            for (int j = 0; j < 8; ++j)
#pragma unroll
                for (int e = 0; e < 4; ++e) { const float a = bf_lo(v[j][e]), b = bf_hi(v[j][e]); if (j < 4) q0 += a * a + b * b; else q1 += a * a + b * b; }
            q0 = wave_sum(q0); q1 = wave_sum(q1);
            if (lane == 0) { atomicMax(halfnorm, __float_as_uint(q0)); atomicMax(halfnorm + 64, __float_as_uint(q1)); } }
        mx = fmaxf(wave_max(mx), 1e-30f);
        const float inv = 448.0f / mx;
        if (lane == 0) scale[n] = mx * (1.0f / 448.0f);
        asm volatile("" ::: "memory");
        u32x2* d = (u32x2*)(dst + (size_t)n * dst_pitch) + lane;
#pragma unroll
        for (int j = 0; j < 8; ++j) { int p0 = 0, p1 = 0;
            p0 = __builtin_amdgcn_cvt_pk_fp8_f32(bf_lo(v[j].x) * inv, bf_hi(v[j].x) * inv, p0, false); p0 = __builtin_amdgcn_cvt_pk_fp8_f32(bf_lo(v[j].y) * inv, bf_hi(v[j].y) * inv, p0, true);
            p1 = __builtin_amdgcn_cvt_pk_fp8_f32(bf_lo(v[j].z) * inv, bf_hi(v[j].z) * inv, p1, false); p1 = __builtin_amdgcn_cvt_pk_fp8_f32(bf_lo(v[j].w) * inv, bf_hi(v[j].w) * inv, p1, true);
            d[64 * j] = (u32x2){(unsigned)p0, (unsigned)p1}; }
    }
}
template <int LEN>
__device__ __forceinline__ void rowquant_fp8_n(const Frame& F, const unsigned char* src, unsigned char* dst, float* scale, int nrows) {
    const int gw = F.vcu * NWAVES + F.wave, NGW = F.G * NWAVES, lane = F.lane; constexpr int PER = LEN / 64;
    for (int n = gw; n < nrows; n += NGW) {
        const u32x4* s = (const u32x4*)(src + (size_t)n * LEN * 2) + lane * (PER / 8);
        u32x4 v[PER / 8]; float mx = 0.f;
#pragma unroll
        for (int j = 0; j < PER / 8; ++j) { v[j] = s[j];
#pragma unroll
            for (int e = 0; e < 4; ++e) mx = fmaxf(mx, fmaxf(fabsf(bf_lo(v[j][e])), fabsf(bf_hi(v[j][e])))); }
        mx = fmaxf(wave_max(mx), 1e-30f);
        const float inv = 448.0f / mx;
        if (lane == 0) scale[n] = mx * (1.0f / 448.0f);
        u32x2* d = (u32x2*)(dst + (size_t)n * LEN) + lane * (PER / 8);
#pragma unroll
        for (int j = 0; j < PER / 8; ++j) { int p0 = 0, p1 = 0;
            p0 = __builtin_amdgcn_cvt_pk_fp8_f32(bf_lo(v[j].x) * inv, bf_hi(v[j].x) * inv, p0, false); p0 = __builtin_amdgcn_cvt_pk_fp8_f32(bf_lo(v[j].y) * inv, bf_hi(v[j].y) * inv, p0, true);
            p1 = __builtin_amdgcn_cvt_pk_fp8_f32(bf_lo(v[j].z) * inv, bf_hi(v[j].z) * inv, p1, false); p1 = __builtin_amdgcn_cvt_pk_fp8_f32(bf_lo(v[j].w) * inv, bf_hi(v[j].w) * inv, p1, true);
            d[j] = (u32x2){(unsigned)p0, (unsigned)p1}; }
    }
}
__device__ __forceinline__ void p1_quant_weights(const Frame& F) {
    rowquant_fp8(F, F.ws + WS_WIN + (size_t)1280 * DM * 2, (size_t)DM * 2, F.ws + WS_WG8, (size_t)DM, (float*)(F.ws + WS_SW), 12800);
    rowquant_fp8(F, F.ws + WS_H1F, (size_t)DM * 2, F.ws + WS_WBR, (size_t)DM, (float*)(F.ws + WS_SWBR), 4096, F.ctl + CW_WNORM);
    rowquant_fp8(F, F.ws + WS_WOUT, (size_t)DM * 2, F.ws + WS_WOUT, (size_t)DM * 2, (float*)(F.ws + WS_SWOUT), 4096);
    rowquant_fp8_n<1024>(F, F.ws + WS_WUQ, F.ws + WS_WUQ8, (float*)(F.ws + WS_SWUQ), 3072);
    rowquant_fp8_n<512>(F, F.ws + WS_WUKV, F.ws + WS_WUKV8, (float*)(F.ws + WS_SWUKV), 4096);
}
#define MFMA32(a, b, c) __builtin_amdgcn_mfma_f32_32x32x16_bf16((a), (b), (c), 0, 0, 0)
__device__ __forceinline__ float relu_i(float x) { const int v = __float_as_int(x); return __int_as_float(v > 0 ? v : 0); }
__device__ __forceinline__ int crow(int i, int h) { return (i & 3) + 8 * (i >> 2) + 4 * h; }
__device__ __forceinline__ float half_sum_f(float v) {
#pragma unroll
    for (int o = 1; o < 32; o <<= 1) v += __shfl_xor(v, o);
    return v;
}
__device__ __forceinline__ int half_sum_i(int v) {
#pragma unroll
    for (int o = 1; o < 32; o <<= 1) v += __shfl_xor(v, o);
    return v;
}
__device__ __forceinline__ float half_max_f(float v) {
#pragma unroll
    for (int o = 1; o < 32; o <<= 1) v = fmaxf(v, __shfl_xor(v, o));
    return v;
}
__device__ __forceinline__ float half_min_f(float v) {
#pragma unroll
    for (int o = 1; o < 32; o <<= 1) v = fminf(v, __shfl_xor(v, o));
    return v;
}
constexpr int IDX_PK = 144, IDX_BUF = 64 * IDX_PK;
__device__ __forceinline__ void idx_task(const Frame& F, int b, int s0c) {
    const int lane = F.lane, r = lane & 31, h = lane >> 5, tid = F.tid;
    const int s0 = s0c + 2 * F.wave;
    LAS unsigned char* lds = F.lds;
    const bf16_t* qix = (const bf16_t*)(F.ws + WS_QIX); const bf16_t* kix = (const bf16_t*)(F.ws + WS_KIX); const float* wix = (const float*)(F.ws + WS_WIX);
    unsigned* mask = (unsigned*)(F.ws + WS_MASK);
    const int tok = (r >> 2) & 1, head = (r & 3) + 4 * (r >> 3);
    const bf16_t* qp = qix + (size_t)(b * SEQ + s0 + tok) * 1024 + head * 64 + 8 * h;
    bf16x8 af[4];
#pragma unroll
    for (int ks = 0; ks < 4; ++ks) af[ks] = *(const bf16x8*)(qp + 16 * ks);
    const f32x4* wp = (const f32x4*)(wix + (size_t)(b * SEQ + s0 + h) * 16);
    float w[16];
#pragma unroll
    for (int q = 0; q < 4; ++q) { const f32x4 x = wp[q]; w[4 * q] = x[0]; w[4 * q + 1] = x[1]; w[4 * q + 2] = x[2]; w[4 * q + 3] = x[3]; }
    const int tq = NMETA + s0 + h;
    int tqr = tq - r; asm volatile("" : "+v"(tqr));
    const int ngrp = ((NMETA + s0c + 15) >> 6) + 1;
    const int skey = tid >> 3, spc = tid & 7;
    int brow = b * SEQ - NMETA; asm volatile("" : "+s"(brow));
    const bf16_t* kcur = kix + ((long)brow + skey) * 64 + spc * 8;
    const int sdst = skey * IDX_PK + spc * 16;
    const int boff = r * IDX_PK + 16 * h;
    u32x4 kst = *(const u32x4*)(skey < NMETA ? kix + (size_t)(NTOK + skey) * 64 + spc * 8 : kcur);
    float row[MW];
#pragma unroll
    for (int g = 0; g < MW / 2; ++g) {
        float s0v = -INFINITY, s1v = -INFINITY;
        const int bo = (g & 1) * IDX_BUF;
        if (g < ngrp) *(LAS u32x4*)(lds + bo + sdst) = kst;
        __syncthreads();
        kcur += 64 * 64; asm volatile("" : "+v"(kcur));
        if (g + 1 < ngrp) kst = *(const u32x4*)kcur;
        if (g < ngrp) {
            float x0 = 0.f, x1 = 0.f;
            { bf16x8 bb[4]; f32x16 a0;
#pragma unroll
              for (int ks = 0; ks < 4; ++ks) bb[ks] = *(const LAS bf16x8*)(lds + bo + boff + 32 * ks);
#pragma unroll
              for (int i = 0; i < 16; ++i) a0[i] = 0.f;
#pragma unroll
              for (int ks = 0; ks < 4; ++ks) a0 = MFMA32(af[ks], bb[ks], a0);
#pragma unroll
              for (int i = 0; i < 16; ++i) x0 += w[i] * relu_i(a0[i]); }
            asm volatile("" : "+v"(x0));
            asm volatile("" ::: "memory");
            { bf16x8 bb[4]; f32x16 a1;
#pragma unroll
              for (int ks = 0; ks < 4; ++ks) bb[ks] = *(const LAS bf16x8*)(lds + bo + boff + 32 * IDX_PK + 32 * ks);
#pragma unroll
              for (int i = 0; i < 16; ++i) a1[i] = 0.f;
#pragma unroll
              for (int ks = 0; ks < 4; ++ks) a1 = MFMA32(af[ks], bb[ks], a1);
#pragma unroll
              for (int i = 0; i < 16; ++i) x1 += w[i] * relu_i(a1[i]); }
            s0v = (g * 64 <= tqr) ? x0 : -INFINITY; s1v = (g * 64 + 32 <= tqr) ? x1 : -INFINITY;
        }
        row[2 * g] = s0v; row[2 * g + 1] = s1v;
    }
    float tau = -3.0e38f;
    bool done = (tq + 1 <= 256);
    float mx = -INFINITY, mn = INFINITY;
#pragma unroll
    for (int k = 0; k < MW; ++k) { const float v = row[k]; mx = fmaxf(mx, v); mn = fminf(mn, v > -INFINITY ? v : INFINITY); }
    float lo = half_min_f(mn), hi = half_max_f(mx);
    if (!done) tau = hi;
    for (int it = 0; it < 64; ++it) {
        if (!__any(!done)) break;
        const float mid = lo + (hi - lo) * 0.5f;
        int c = 0;
#pragma unroll
        for (int k = 0; k < MW; ++k) c += (row[k] >= mid) ? 1 : 0;
        c = half_sum_i(c);
        if (!done) {
            if (!(mid > lo && mid < hi)) { tau = hi; done = true; }
            else if (c == 256) { tau = mid; done = true; }
            else if (c > 256) lo = mid;
            else { hi = mid; tau = hi; }
        }
    }
    unsigned* mrow = mask + (size_t)(b * SEQ + s0 + h) * MW;
    unsigned mw = 0u;
#pragma unroll
    for (int k = 0; k < MW; ++k) {
        const unsigned long long bal = __ballot(row[k] >= tau);
        const unsigned wd = h ? (unsigned)(bal >> 32) : (unsigned)bal;
        if ((k & 31) == r) mw = wd;
        if ((k & 31) == 31 || k == MW - 1) { const int kk = (k & ~31) + r; if (kk < MW) mrow[kk] = mw; }
    }
}
__device__ __forceinline__ void p2_indexer(const Frame& F, int qslot) {
    volatile LAS unsigned* qw = (volatile LAS unsigned*)(F.lds + LDSCTL_OFF + 16);
    constexpr int NCH = NTOK / 16;
    for (;;) {
        if (F.tid == 0) qw[0] = atomicAdd(F.ctl + CW_QUEUE + 64 * qslot, 1u);
        __syncthreads();
        const int c = __builtin_amdgcn_readfirstlane((int)qw[0]);
        __syncthreads();
        if (c >= NCH) break;
        const int b = c & 3, tblk = (SEQ / 16 - 1) - (c >> 2);
        idx_task(F, b, tblk * 16);
    }
}
template <bool MLA> struct AttnCfg {
    static constexpr int DQK = MLA ? 192 : 128, NKS = DQK / 64, PK = DQK + 16  , PV = 144  , KBYTES = 64 * PK, VBYTES = 64 * PV, VBASE = 2 * KBYTES;
};
struct AttnUnit { int type, b, hx, blk; };
typedef int i32x8 __attribute__((ext_vector_type(8)));
typedef int i32x4 __attribute__((ext_vector_type(4)));
typedef int i32x2_t __attribute__((ext_vector_type(2)));
__device__ __forceinline__ i32x8 cat4(i32x4 a, i32x4 b) { return __builtin_shufflevector(a, b, 0, 1, 2, 3, 4, 5, 6, 7); }
template <int NKS> __device__ __forceinline__ void qk_block(f32x16& s, const i32x8 (&k)[NKS], const i32x8 (&q)[NKS]) {
#if defined(__HIP_DEVICE_COMPILE__)
    int sc = 0x7F7F7F7F;
    if constexpr (NKS == 3)
        asm volatile("s_nop 1\n\tv_mfma_scale_f32_32x32x64_f8f6f4 %0, %1, %4, 0, %7, %7 op_sel_hi:[0,0,0]\n\ts_nop 3\n\tv_mfma_scale_f32_32x32x64_f8f6f4 %0, %2, %5, %0, %7, %7 op_sel_hi:[0,0,0]\n\ts_nop 3\n\t"
                     "v_mfma_scale_f32_32x32x64_f8f6f4 %0, %3, %6, %0, %7, %7 op_sel_hi:[0,0,0]\n\ts_nop 15\n\ts_nop 7"
                     : "=&v"(s) : "v"(k[0]), "v"(k[1]), "v"(k[2]), "v"(q[0]), "v"(q[1]), "v"(q[2]), "v"(sc));
    else
        asm volatile("s_nop 1\n\tv_mfma_scale_f32_32x32x64_f8f6f4 %0, %1, %3, 0, %5, %5 op_sel_hi:[0,0,0]\n\ts_nop 3\n\tv_mfma_scale_f32_32x32x64_f8f6f4 %0, %2, %4, %0, %5, %5 op_sel_hi:[0,0,0]\n\ts_nop 15\n\ts_nop 7"
                     : "=&v"(s) : "v"(k[0]), "v"(k[1]), "v"(q[0]), "v"(q[1]), "v"(sc));
#else
    (void)s; (void)k; (void)q;
#endif
}

__device__ __forceinline__ void pv_block(f32x16& o0, f32x16& o1, f32x16& o2, f32x16& o3, const i32x8 v0, const i32x8 v1, const i32x8 v2, const i32x8 v3, const i32x8 p) {
#if defined(__HIP_DEVICE_COMPILE__)
    int sc = 0x7F7F7F7F;
    asm volatile("s_nop 1\n\tv_mfma_scale_f32_32x32x64_f8f6f4 %0, %4, %8, %0, %9, %9 op_sel_hi:[0,0,0]\n\tv_mfma_scale_f32_32x32x64_f8f6f4 %1, %5, %8, %1, %9, %9 op_sel_hi:[0,0,0]\n\t"
                 "v_mfma_scale_f32_32x32x64_f8f6f4 %2, %6, %8, %2, %9, %9 op_sel_hi:[0,0,0]\n\tv_mfma_scale_f32_32x32x64_f8f6f4 %3, %7, %8, %3, %9, %9 op_sel_hi:[0,0,0]\n\ts_nop 15\n\ts_nop 7"
                 : "+v"(o0), "+v"(o1), "+v"(o2), "+v"(o3) : "v"(v0), "v"(v1), "v"(v2), "v"(v3), "v"(p), "v"(sc));
#else
    (void)o0; (void)o1; (void)o2; (void)o3; (void)v0; (void)v1; (void)v2; (void)v3; (void)p;
#endif
}
__device__ __forceinline__ int pk4_fp8(float a, float b, float c, float d) { int p = 0; p = __builtin_amdgcn_cvt_pk_fp8_f32(a, b, p, false); return __builtin_amdgcn_cvt_pk_fp8_f32(c, d, p, true); }

template <int PVB>
__device__ __forceinline__ void pv_tile(f32x16 (&oacc)[4], LAS unsigned char* lds, int vb, int voff, const i32x8 pf) {
    i32x8 vf[4];
#pragma unroll
    for (int d = 0; d < 4; ++d) {
        const i32x2_t t0 = __builtin_amdgcn_ds_read_tr8_b64_v2i32((LAS i32x2_t*)(lds + vb + voff + 32 * d));
        const i32x2_t t1 = __builtin_amdgcn_ds_read_tr8_b64_v2i32((LAS i32x2_t*)(lds + vb + voff + 16 * PVB + 32 * d));
        const i32x2_t t2 = __builtin_amdgcn_ds_read_tr8_b64_v2i32((LAS i32x2_t*)(lds + vb + voff + 32 * PVB + 32 * d));
        const i32x2_t t3 = __builtin_amdgcn_ds_read_tr8_b64_v2i32((LAS i32x2_t*)(lds + vb + voff + 48 * PVB + 32 * d));
        vf[d] = (i32x8){t0.x, t0.y, t1.x, t1.y, t2.x, t2.y, t3.x, t3.y}; }
    pv_block(oacc[0], oacc[1], oacc[2], oacc[3], vf[0], vf[1], vf[2], vf[3], pf);
}

template <bool MLA>
__device__ __forceinline__ void attn_unit(const Frame& F, const AttnUnit u) {
    typedef AttnCfg<MLA> C;
    const int tid = F.tid, lane = F.lane, wave = F.wave, r = lane & 31, h = lane >> 5;
    LAS unsigned char* lds = F.lds;
    const unsigned char* qn8 = F.ws + WS_QN; const unsigned char* qr8 = F.ws + WS_QR; const unsigned char* kn8 = F.ws + WS_KN; const unsigned char* kpe8 = F.ws + WS_KPE;
    const unsigned char* qb8 = F.ws + WS_QB; const unsigned char* kb8 = F.ws + WS_KB;
    const unsigned char* va8 = F.ws + WS_VA; const unsigned char* vb8 = F.ws + WS_VB;
    const unsigned* mask = (const unsigned*)(F.ws + WS_MASK);
    const int b = u.b;
    const size_t rowb = (size_t)b * SEQ;
    int head, tw0, ntiles;
    if (MLA) { head = u.hx; tw0 = u.blk * 256 + 32 * wave; ntiles = (NMETA + u.blk * 256 + 255) / 64 + 1; }
    else { head = 4 * u.hx + (wave & 3); tw0 = u.blk * 64 + 32 * (wave >> 2); ntiles = (NMETA + u.blk * 64 + 63) / 64 + 1; }
    const int pw0 = NMETA + tw0;
    const int tq = pw0 + r;
    const float cexp = MLA ? QA_SCALE : QB_SCALE;
    i32x8 qf[C::NKS];
    if (MLA) {
        const unsigned char* p0 = qn8 + (rowb + tw0 + r) * 2048 + head * 128 + 32 * h; const unsigned char* p1 = qr8 + (rowb + tw0 + r) * 1024 + head * 64 + 32 * h;
        qf[0] = cat4(*(const i32x4*)p0, *(const i32x4*)(p0 + 16)); qf[1] = cat4(*(const i32x4*)(p0 + 64), *(const i32x4*)(p0 + 80)); qf[C::NKS - 1] = cat4(*(const i32x4*)p1, *(const i32x4*)(p1 + 16));
    } else {
        const unsigned char* p0 = qb8 + (rowb + tw0 + r) * 2048 + head * 128 + 32 * h;
        qf[0] = cat4(*(const i32x4*)p0, *(const i32x4*)(p0 + 16)); qf[1] = cat4(*(const i32x4*)(p0 + 64), *(const i32x4*)(p0 + 80));
    }
    const int ldk = MLA ? 2048 : 512;
    const unsigned char* ktab = MLA ? kn8 + head * 128 : kb8 + u.hx * 128;
    const unsigned char* vtab = MLA ? va8 + head * 128 : vb8 + u.hx * 128;
    const unsigned char* kbase = ktab + (rowb - NMETA) * ldk;
    const unsigned char* vbase = vtab + (rowb - NMETA) * ldk;
    const unsigned char* pbase = kpe8 + (rowb - NMETA) * 64;
    const int kkey = tid >> 3, kpc = tid & 7, pkey = tid >> 2, ppc = tid & 3;
    const unsigned koffs = (unsigned)(kkey * ldk + kpc * 16); const int kdst = kkey * C::PK + kpc * 16;
    const unsigned poffs = (unsigned)(pkey * 64 + ppc * 16); const int pdst = pkey * C::PK + 128 + ppc * 16;
    const int vdst = C::VBASE + kkey * C::PV + kpc * 16;
    u32x4 kst, vst, pst = (u32x4){0u, 0u, 0u, 0u};
    {
        kst = *(const u32x4*)(kkey < NMETA ? ktab + (size_t)(NTOK + kkey) * ldk + kpc * 16 : kbase + koffs);
        vst = *(const u32x4*)(kkey < NMETA ? vtab + (size_t)(NTOK + kkey) * ldk + kpc * 16 : vbase + koffs);
        if (MLA && tid < 256) pst = *(const u32x4*)(pkey < NMETA ? kpe8 + (size_t)(NTOK + pkey) * 64 + ppc * 16 : pbase + poffs);
    }
    *(LAS u32x4*)(lds + kdst) = kst;
    *(LAS u32x4*)(lds + vdst) = vst;
    if (MLA && tid < 256) *(LAS u32x4*)(lds + pdst) = pst;
    __syncthreads();
    f32x16 oacc[4];
#pragma unroll
    for (int d = 0; d < 4; ++d)
#pragma unroll
        for (int i = 0; i < 16; ++i) oacc[d][i] = 0.f;
    float mrun = -INFINITY, lrun = 0.f;
    const int koff = r * C::PK + 32 * h;
    const int vq = (lane & 15) >> 1;
    const int voff = (4 * h + (vq & 3) + 8 * (vq >> 2)) * C::PV + 16 * ((lane >> 4) & 1) + 8 * (lane & 1);
    const unsigned* mrow = mask + (rowb + tw0 + r) * MW;
    if (ntiles > 1) {
        kst = *(const u32x4*)(kbase + (size_t)64 * ldk + koffs);
        vst = *(const u32x4*)(vbase + (size_t)64 * ldk + koffs);
        if (MLA && tid < 256) pst = *(const u32x4*)(pbase + (size_t)64 * 64 + poffs);
    }
    const bool late = wave >= 4;
    i32x8 pfp = (i32x8){0, 0, 0, 0, 0, 0, 0, 0}; bool havep = false;
    int vcur = 0, vprev = 2;
    for (int kt = 0; kt < ntiles; ++kt) {
        const int cur = (kt & 1) * C::KBYTES, nxt = ((kt + 1) & 1) * C::KBYTES;
        const int vnxt = vcur == 2 ? 0 : vcur + 1;
        if (kt + 1 < ntiles) {
            *(LAS u32x4*)(lds + nxt + kdst) = kst;
            *(LAS u32x4*)(lds + vnxt * C::VBYTES + vdst) = vst;
            if (MLA && tid < 256) *(LAS u32x4*)(lds + nxt + pdst) = pst;
        }
        if (kt + 2 < ntiles) {
            kst = *(const u32x4*)(kbase + (size_t)(kt + 2) * 64 * ldk + koffs);
            vst = *(const u32x4*)(vbase + (size_t)(kt + 2) * 64 * ldk + koffs);
            if (MLA && tid < 256) pst = *(const u32x4*)(pbase + (size_t)(kt + 2) * 64 * 64 + poffs);
        }
        if (late && havep) pv_tile<C::PV>(oacc, lds, C::VBASE + vprev * C::VBYTES, voff, pfp);
        const bool need = kt * 64 <= pw0 + 31;
        if (need) {
            u32x2 mwd = (u32x2){0u, 0u};
            if (!MLA) mwd = *(const u32x2*)(mrow + 2 * kt);
            f32x16 s0, s1;
            if (!MLA) {
                i32x8 kf0[C::NKS], kf1[C::NKS];
#pragma unroll
                for (int ks = 0; ks < C::NKS; ++ks) { kf0[ks] = cat4(*(const LAS i32x4*)(lds + cur + koff + 64 * ks), *(const LAS i32x4*)(lds + cur + koff + 64 * ks + 16));
                    kf1[ks] = cat4(*(const LAS i32x4*)(lds + cur + koff + 32 * C::PK + 64 * ks), *(const LAS i32x4*)(lds + cur + koff + 32 * C::PK + 64 * ks + 16)); }
                qk_block<C::NKS>(s0, kf0, qf);
                qk_block<C::NKS>(s1, kf1, qf);
            } else {
                { i32x8 kf[C::NKS];
#pragma unroll
                  for (int ks = 0; ks < C::NKS; ++ks) kf[ks] = cat4(*(const LAS i32x4*)(lds + cur + koff + 64 * ks), *(const LAS i32x4*)(lds + cur + koff + 64 * ks + 16));
                  qk_block<C::NKS>(s0, kf, qf); }
                { i32x8 kf[C::NKS];
#pragma unroll
                  for (int ks = 0; ks < C::NKS; ++ks) kf[ks] = cat4(*(const LAS i32x4*)(lds + cur + koff + 32 * C::PK + 64 * ks), *(const LAS i32x4*)(lds + cur + koff + 32 * C::PK + 64 * ks + 16));
                  qk_block<C::NKS>(s1, kf, qf); }
            }
            if (MLA) {
                if (kt * 64 + 63 > pw0) {
                    const int kb0 = kt * 64 + 4 * h;
#pragma unroll
                    for (int i = 0; i < 16; ++i) { const int key = kb0 + (i & 3) + 8 * (i >> 2); if (key > tq) s0[i] = -INFINITY; if (key + 32 > tq) s1[i] = -INFINITY; }
                }
            } else {
                const unsigned m0 = mwd.x >> (4 * h), m1 = mwd.y >> (4 * h);
#pragma unroll
                for (int i = 0; i < 16; ++i) { const int bit = (i & 3) + 8 * (i >> 2);
                    const unsigned k0 = (unsigned)__builtin_amdgcn_sbfe((int)m0, bit, 1), k1 = (unsigned)__builtin_amdgcn_sbfe((int)m1, bit, 1);
                    s0[i] = __uint_as_float(__builtin_amdgcn_bitop3_b32(__float_as_uint(s0[i]), 0xFF800000u, k0, 0xe4)); s1[i] = __uint_as_float(__builtin_amdgcn_bitop3_b32(__float_as_uint(s1[i]), 0xFF800000u, k1, 0xe4)); }
            }
            float mx = s0[0];
#pragma unroll
            for (int i = 1; i < 16; ++i) mx = fmaxf(mx, s0[i]);
#pragma unroll
            for (int i = 0; i < 16; ++i) mx = fmaxf(mx, s1[i]);
            mx = fmaxf(mx, __shfl_xor(mx, 32));
            const float mcand = mx * cexp;
            const bool move = !__all(mcand - mrun <= 8.0f);
            const float mnew = move ? fmaxf(mrun, mcand) : mrun;
            const float msafe = (mnew == -INFINITY) ? 0.f : mnew;
            const float alpha = move ? __builtin_amdgcn_exp2f(mrun - msafe) : 1.0f;
            mrun = mnew;
            f32x2 ps2 = (f32x2){0.f, 0.f}; const f32x2 c2 = (f32x2){cexp, cexp}, nm2 = (f32x2){-msafe, -msafe};
#pragma unroll
            for (int i = 0; i < 16; i += 2) {
                f32x2 t0 = __builtin_elementwise_fma((f32x2){s0[i], s0[i + 1]}, c2, nm2), t1 = __builtin_elementwise_fma((f32x2){s1[i], s1[i + 1]}, c2, nm2);
                t0 = (f32x2){__builtin_amdgcn_exp2f(t0.x), __builtin_amdgcn_exp2f(t0.y)}; t1 = (f32x2){__builtin_amdgcn_exp2f(t1.x), __builtin_amdgcn_exp2f(t1.y)};
                s0[i] = t0.x; s0[i + 1] = t0.y; s1[i] = t1.x; s1[i + 1] = t1.y; ps2 += t0 + t1; }
            lrun = lrun * alpha + (ps2.x + ps2.y);
            if (move) {
#pragma unroll
                for (int d = 0; d < 4; ++d)
#pragma unroll
                    for (int i = 0; i < 16; ++i) oacc[d][i] *= alpha;
            }
            i32x8 pf;
            pf[0] = pk4_fp8(s0[0], s0[1], s0[2], s0[3]); pf[1] = pk4_fp8(s0[4], s0[5], s0[6], s0[7]); pf[2] = pk4_fp8(s0[8], s0[9], s0[10], s0[11]); pf[3] = pk4_fp8(s0[12], s0[13], s0[14], s0[15]);
            pf[4] = pk4_fp8(s1[0], s1[1], s1[2], s1[3]); pf[5] = pk4_fp8(s1[4], s1[5], s1[6], s1[7]); pf[6] = pk4_fp8(s1[8], s1[9], s1[10], s1[11]); pf[7] = pk4_fp8(s1[12], s1[13], s1[14], s1[15]);
            if (late) pfp = pf; else pv_tile<C::PV>(oacc, lds, C::VBASE + vcur * C::VBYTES, voff, pf);
        }
        havep = late && need;
        vprev = vcur; vcur = vnxt;
        __syncthreads();
    }
    if (late && havep) pv_tile<C::PV>(oacc, lds, C::VBASE + vprev * C::VBYTES, voff, pfp);
    __syncthreads();
    {
        const float lt = lrun + __shfl_xor(lrun, 32);
        const float vmax = fmaxf(__uint_as_float(F.ctl[CW_VMAX + (MLA ? 64 : 0)]), 1e-30f);
        const float inv = (lt > 0.f ? 1.0f / lt : 0.f) * (440.0f / vmax);
        {
            const float il = lt > 0.f ? 1.0f / lt : 0.f; float q = 0.f;
#pragma unroll
            for (int d = 0; d < 4; ++d)
#pragma unroll
                for (int i = 0; i < 16; ++i) { const float x = oacc[d][i] * il; q += x * x; }
            q += __shfl_xor(q, 32);
            if (h == 0) ssq_add((u64*)(F.ctl + (MLA ? CW_SSQ_OA : CW_SSQ_OB)) + (rowb + tw0 + r), q); }
        unsigned char* op = F.ws + WS_OAB + (rowb + tw0 + r) * 4096 + (MLA ? 0 : 2048) + head * 128 + 4 * h;
#pragma unroll
        for (int d = 0; d < 4; ++d)
#pragma unroll
            for (int g = 0; g < 4; ++g) { int p = 0;
                p = __builtin_amdgcn_cvt_pk_fp8_f32(fminf(fmaxf(oacc[d][4 * g] * inv, -448.f), 448.f), fminf(fmaxf(oacc[d][4 * g + 1] * inv, -448.f), 448.f), p, false);
                p = __builtin_amdgcn_cvt_pk_fp8_f32(fminf(fmaxf(oacc[d][4 * g + 2] * inv, -448.f), 448.f), fminf(fmaxf(oacc[d][4 * g + 3] * inv, -448.f), 448.f), p, true);
                *(unsigned*)(op + 32 * d + 8 * g) = (unsigned)p; }
    }
}

constexpr int ATT_NUNITS = 16 * 64 + 64 * 16;
__device__ __forceinline__ void att_decode(int idx, AttnUnit& u) {
    int rem = idx;
    for (int L = 65; L >= 2; --L) {
        const int nm = (L >= 5 && ((L - 5) & 3) == 0) ? 64 : 0;
        if (rem < nm) { u.type = 0; u.blk = (L - 5) >> 2; u.b = rem & 3; u.hx = rem >> 2; return; }
        rem -= nm;
        if (rem < 16) { u.type = 1; u.blk = L - 2; u.b = rem & 3; u.hx = rem >> 2; return; }
        rem -= 16;
    }
    u.type = -1; u.blk = 0; u.b = 0; u.hx = 0;
}
__device__ __forceinline__ void p3_attention(const Frame& F, int qslot) {
    volatile LAS int* qw = (volatile LAS int*)(F.lds + LDSCTL_OFF + 32);
    for (;;) {
        if (F.tid == 0) { const int idx = (int)atomicAdd(F.ctl + CW_QUEUE + 64 * qslot, 1u); AttnUnit u; u.type = -1; u.b = 0; u.hx = 0; u.blk = 0; if (idx < ATT_NUNITS) att_decode(idx, u);
            qw[0] = u.type; qw[1] = u.b; qw[2] = u.hx; qw[3] = u.blk; }
        __syncthreads();
        AttnUnit u; u.type = qw[0]; u.b = qw[1]; u.hx = qw[2]; u.blk = qw[3];
        __syncthreads();
        if (u.type < 0) break;
        if (u.type == 0) attn_unit<true>(F, u); else attn_unit<false>(F, u);
    }
}
__device__ __forceinline__ float pk_idx(float v, int n) { return __uint_as_float((__float_as_uint(v) & ~127u) | (unsigned)n); }
__device__ __forceinline__ void route_task(const Frame& F, int tb, int hd) {
    const int lane = F.lane, r = lane & 31, h = lane >> 5;
    const bf16_t* pq = (const bf16_t*)(F.ws + WS_PQ); const bf16_t* skb = (const bf16_t*)(F.ws + WS_SK);
    int* eid = (int*)(F.ws + WS_EID); float* gate = (float*)(F.ws + WS_GATE);
    LAS float* wl = (LAS float*)(F.lds + F.wave * 16384);
    const int m = tb * 32 + r;
#pragma unroll 1
    for (int c = 0; c < 2; ++c) {
        const bf16_t* qp = pq + (size_t)m * 2048 + hd * 256 + c * 128 + 8 * h;
        bf16x8 qf[8];
#pragma unroll
        for (int ks = 0; ks < 8; ++ks) qf[ks] = *(const bf16x8*)(qp + 16 * ks);
        float v[64];
#pragma unroll
        for (int blk = 0; blk < 4; ++blk) {
            const bf16_t* sp = skb + (size_t)((hd * 2 + c) * 128 + 32 * blk + r) * 128 + 8 * h;
            f32x16 acc;
#pragma unroll
            for (int i = 0; i < 16; ++i) acc[i] = 0.f;
#pragma unroll
            for (int ks = 0; ks < 8; ++ks) acc = MFMA32(*(const bf16x8*)(sp + 16 * ks), qf[ks], acc);
#pragma unroll
            for (int i = 0; i < 16; ++i) v[blk * 16 + i] = pk_idx(acc[i], 32 * blk + (i & 3) + 8 * (i >> 2) + 4 * h);
        }
#pragma unroll 1
        for (int k = 0; k < 16; ++k) {
            float mx = v[0];
#pragma unroll
            for (int j = 1; j < 64; ++j) mx = fmaxf(mx, v[j]);
            mx = fmaxf(mx, __shfl_xor(mx, 32));
            if (h == 0) wl[(c * 16 + k) * 32 + r] = mx;
#pragma unroll
            for (int j = 0; j < 64; ++j) v[j] = (v[j] == mx) ? -INFINITY : v[j];
        }
    }
    LDS_WAIT(); asm volatile("" ::: "memory");
    float cs[25]; int ce[25];
    {
        unsigned t0[16], t1[16];
#pragma unroll
        for (int i = 0; i < 16; ++i) { t0[i] = __float_as_uint(wl[i * 32 + r]); t1[i] = __float_as_uint(wl[(16 + i) * 32 + r]); }
        int n = 0;
#pragma unroll
        for (int i = 0; i < 16; ++i)
#pragma unroll
            for (int j = 0; j < 16; ++j)
                if ((i + 1) * (j + 1) <= 16) {
                    const float s = __uint_as_float(t0[i] & ~127u) + __uint_as_float(t1[j] & ~127u);
                    const float sv = __uint_as_float((__float_as_uint(s) & ~63u) | (unsigned)n); const int ev_ = (int)((t0[i] & 127u) * 128u + (t1[j] & 127u));
                    if (n < 25) { if (h == 0) { cs[n] = sv; ce[n] = ev_; } } else { if (h == 1) { cs[n - 25] = sv; ce[n - 25] = ev_; } }
                    ++n;
                }
    }
    float sum = 0.f, first = 0.f;
#pragma unroll 1
    for (int k = 0; k < 16; ++k) {
        float mxl = cs[0];
#pragma unroll
        for (int j = 1; j < 25; ++j) mxl = fmaxf(mxl, cs[j]);
        int sel = 0;
#pragma unroll
        for (int j = 0; j < 25; ++j) { const bool hit = (cs[j] == mxl); sel = hit ? ce[j] : sel; }
        const float mxo = __shfl_xor(mxl, 32); const int selo = __shfl_xor(sel, 32);
        const bool mine = mxl > mxo;
        const float mx = mine ? mxl : mxo; const int se = mine ? sel : selo;
#pragma unroll
        for (int j = 0; j < 25; ++j) cs[j] = (cs[j] == mx) ? -INFINITY : cs[j];
        if (k == 0) first = mx;
        const float ev = __expf(mx - first); sum += ev;
        if (h == 0) { wl[1024 + k * 32 + r] = ev; wl[1536 + k * 32 + r] = __int_as_float(se); }
    }
    LDS_WAIT(); asm volatile("" ::: "memory");
    const float inv = 1.0f / sum;
    if (h == 0) {
        int* ep = eid + (size_t)m * 128 + hd * 16; float* gp = gate + (size_t)m * 128 + hd * 16;
#pragma unroll
        for (int q = 0; q < 4; ++q) {
            *(int4*)(ep + 4 * q) = make_int4(__float_as_int(wl[1536 + (4 * q) * 32 + r]), __float_as_int(wl[1536 + (4 * q + 1) * 32 + r]), __float_as_int(wl[1536 + (4 * q + 2) * 32 + r]), __float_as_int(wl[1536 + (4 * q + 3) * 32 + r]));
            *(f32x4*)(gp + 4 * q) = (f32x4){wl[1024 + (4 * q) * 32 + r] * inv, wl[1024 + (4 * q + 1) * 32 + r] * inv, wl[1024 + (4 * q + 2) * 32 + r] * inv, wl[1024 + (4 * q + 3) * 32 + r] * inv}; }
    }
    LDS_WAIT(); asm volatile("" ::: "memory");
}
__device__ __forceinline__ void p7_routing(const Frame& F) {
    const int gw = F.vcu * NWAVES + F.wave, NGW = F.G * NWAVES;
    for (int it = gw; it < (NTOK / 32) * 8; it += NGW) route_task(F, it >> 3, it & 7);
}

__device__ __forceinline__ float rl_f(float v, int l) { return __int_as_float(__builtin_amdgcn_readlane(__float_as_int(v), l)); }
__device__ __forceinline__ float gelu_tanh(float x) {
    const float u = 0.7978845608028654f * (x + 0.044715f * x * x * x);
    const float e = __expf(2.0f * u);
    const float th = 1.0f - 2.0f / (e + 1.0f);
    return 0.5f * x * (1.0f + th);
}
__device__ __forceinline__ float wave_sum_dpp(float v) {
#define DPP_ADD(ctrl, rmask) v += __int_as_float(__builtin_amdgcn_update_dpp(0, __float_as_int(v), ctrl, rmask, 0xF, false))
    DPP_ADD(0xB1, 0xF); DPP_ADD(0x4E, 0xF); DPP_ADD(0x141, 0xF); DPP_ADD(0x140, 0xF); DPP_ADD(0x142, 0xA); DPP_ADD(0x143, 0xC);
#undef DPP_ADD
    return rl_f(v, 63);
}
typedef unsigned u32x6 __attribute__((ext_vector_type(6)));
typedef float f32x32 __attribute__((ext_vector_type(32)));
struct Row6 { u32x4 q[3]; };
__device__ __forceinline__ void row6_load(Row6& r, const unsigned char* tab, int e, int lane) {
    const u32x4* p = (const u32x4*)(tab + (size_t)e * 3072) + lane;
#pragma unroll
    for (int q = 0; q < 3; ++q) r.q[q] = p[64 * q];
}
__device__ __forceinline__ f32x32 row6_deq(const Row6& r, int g) {
    u32x6 w;
    if (g == 0) { w[0] = r.q[0].x; w[1] = r.q[0].y; w[2] = r.q[0].z; w[3] = r.q[0].w; w[4] = r.q[1].x; w[5] = r.q[1].y; }
    else { w[0] = r.q[1].z; w[1] = r.q[1].w; w[2] = r.q[2].x; w[3] = r.q[2].y; w[4] = r.q[2].z; w[5] = r.q[2].w; }
    return __builtin_amdgcn_cvt_scalef32_pk32_f32_fp6(w, 1.0f);
}
__device__ __forceinline__ float row6_dot(const Row6& r, const f32x2 (&hf)[32]) {
    f32x2 acc0 = (f32x2){0.f, 0.f}, acc1 = (f32x2){0.f, 0.f};
#pragma unroll
    for (int g = 0; g < 2; ++g) { const f32x32 d = row6_deq(r, g);
#pragma unroll
        for (int k = 0; k < 16; k += 2) { acc0 = __builtin_elementwise_fma((f32x2){d[2 * k], d[2 * k + 1]}, hf[16 * g + k], acc0); acc1 = __builtin_elementwise_fma((f32x2){d[2 * k + 2], d[2 * k + 3]}, hf[16 * g + k + 1], acc1); } }
    const f32x2 s = acc0 + acc1;
    return s.x + s.y;
}
__device__ __forceinline__ void row6_axpy(const Row6& r, float c, f32x2 (&o)[32]) {
    const f32x2 c2 = (f32x2){c, c};
#pragma unroll
    for (int g = 0; g < 2; ++g) { const f32x32 d = row6_deq(r, g);
#pragma unroll
        for (int k = 0; k < 16; ++k) o[16 * g + k] = __builtin_elementwise_fma((f32x2){d[2 * k], d[2 * k + 1]}, c2, o[16 * g + k]); }
}
struct Row4 { u32x4 q[2]; };
__device__ __forceinline__ void row4_load(Row4& r, const unsigned char* tab, int e, int lane) {
    const u32x4* p = (const u32x4*)(tab + (size_t)e * 2048) + lane;
    r.q[0] = p[0]; r.q[1] = p[64];
}
__device__ __forceinline__ float row4_dot(const Row4& r, const f32x2 (&hf)[32]) {
    f32x2 acc0 = (f32x2){0.f, 0.f}, acc1 = (f32x2){0.f, 0.f};
#pragma unroll
    for (int d = 0; d < 8; ++d) { const unsigned w = r.q[d >> 2][d & 3];
        acc0 = __builtin_elementwise_fma(__builtin_amdgcn_cvt_scalef32_pk_f32_fp4(w, 1.0f, 0), hf[4 * d], acc0);
        acc1 = __builtin_elementwise_fma(__builtin_amdgcn_cvt_scalef32_pk_f32_fp4(w, 1.0f, 1), hf[4 * d + 1], acc1);
        acc0 = __builtin_elementwise_fma(__builtin_amdgcn_cvt_scalef32_pk_f32_fp4(w, 1.0f, 2), hf[4 * d + 2], acc0);
        acc1 = __builtin_elementwise_fma(__builtin_amdgcn_cvt_scalef32_pk_f32_fp4(w, 1.0f, 3), hf[4 * d + 3], acc1); }
    const f32x2 s = acc0 + acc1;
    return s.x + s.y;
}
__device__ __forceinline__ void row4_axpy(const Row4& r, float c, f32x2 (&o)[32]) {
    const f32x2 c2 = (f32x2){c, c};
#pragma unroll
    for (int d = 0; d < 8; ++d) { const unsigned w = r.q[d >> 2][d & 3];
        o[4 * d] = __builtin_elementwise_fma(__builtin_amdgcn_cvt_scalef32_pk_f32_fp4(w, 1.0f, 0), c2, o[4 * d]);
        o[4 * d + 1] = __builtin_elementwise_fma(__builtin_amdgcn_cvt_scalef32_pk_f32_fp4(w, 1.0f, 1), c2, o[4 * d + 1]);
        o[4 * d + 2] = __builtin_elementwise_fma(__builtin_amdgcn_cvt_scalef32_pk_f32_fp4(w, 1.0f, 2), c2, o[4 * d + 2]);
        o[4 * d + 3] = __builtin_elementwise_fma(__builtin_amdgcn_cvt_scalef32_pk_f32_fp4(w, 1.0f, 3), c2, o[4 * d + 3]); }
}
#if PEER_U_BITS == 4
typedef Row4 RowU;
#define ROWU_LOAD row4_load
#define ROWU_DOT row4_dot
#else
typedef Row6 RowU;
#define ROWU_LOAD row6_load
#define ROWU_DOT row6_dot
#endif
#if PEER_V_BITS == 4
typedef Row4 RowV;
#define ROWV_LOAD row4_load
#define ROWV_AXPY row4_axpy
#else
typedef Row6 RowV;
#define ROWV_LOAD row6_load
#define ROWV_AXPY row6_axpy
#endif
__device__ __forceinline__ void expert_token(const Frame& F, int m, size_t orow) {
    const int lane = F.lane;
    const unsigned char* U = F.ws + WS_U; const unsigned char* V = F.ws + WS_V;
    const float* scu = (const float*)(F.ws + WS_SCU); const float* scv = (const float*)(F.ws + WS_SCV);
    const int* eid = (const int*)(F.ws + WS_EID); const float* gate = (const float*)(F.ws + WS_GATE);
    const bf16_t* h1b = (const bf16_t*)(F.ws + WS_H1B);
    const u64* ssq = (const u64*)(F.ctl + CW_SSQ_H1); const float* gfin = F.in(15);
    const int e0 = eid[(size_t)m * 128 + lane], e1 = eid[(size_t)m * 128 + 64 + lane];
    f32x2 hf[32];
#pragma unroll
    for (int j = 0; j < 16; ++j) { const u32x2 x = *((const u32x2*)(h1b + (size_t)m * DM) + lane + 64 * j); hf[2 * j] = (f32x2){bf_lo(x.x), bf_hi(x.x)}; hf[2 * j + 1] = (f32x2){bf_lo(x.y), bf_hi(x.y)}; }
    const float g0 = gate[(size_t)m * 128 + lane] * scv[e0], g1 = gate[(size_t)m * 128 + 64 + lane] * scv[e1];
    const float rstd = __builtin_amdgcn_rsqf(ssq_get(ssq + m) * (1.0f / DM) + EPS);
    const float su0 = scu[e0] * rstd, su1 = scu[e1] * rstd;
    float a0 = 0.f, a1 = 0.f;
#define EIDX(e) (((e) < 64) ? __builtin_amdgcn_readlane(e0, (e)) : __builtin_amdgcn_readlane(e1, (e) - 64))
    {
        RowU r0, r1, r2, r3, r4, r5, r6, r7;
        ROWU_LOAD(r0, U, EIDX(0), lane); ROWU_LOAD(r1, U, EIDX(1), lane); ROWU_LOAD(r2, U, EIDX(2), lane); ROWU_LOAD(r3, U, EIDX(3), lane);
        ROWU_LOAD(r4, U, EIDX(4), lane); ROWU_LOAD(r5, U, EIDX(5), lane); ROWU_LOAD(r6, U, EIDX(6), lane); ROWU_LOAD(r7, U, EIDX(7), lane);
#define S1STEP(rr, k) p = wave_sum_dpp(ROWU_DOT(rr, hf)); if (more) ROWU_LOAD(rr, U, EIDX(e + 8 + (k)), lane); if (e < 64) { if (lane == e + (k)) a0 = p; } else { if (lane == e + (k) - 64) a1 = p; }
#pragma unroll 1
        for (int e = 0; e < 128; e += 8) {
            const bool more = e + 8 < 128; float p;
            S1STEP(r0, 0) S1STEP(r1, 1) S1STEP(r2, 2) S1STEP(r3, 3) S1STEP(r4, 4) S1STEP(r5, 5) S1STEP(r6, 6) S1STEP(r7, 7)
        }
#undef S1STEP
    }
    const float c0 = gelu_tanh(a0 * su0) * g0, c1 = gelu_tanh(a1 * su1) * g1;
#define CIDX(e) (((e) < 64) ? rl_f(c0, (e)) : rl_f(c1, (e) - 64))
    f32x2 o[32];
#pragma unroll
    for (int i = 0; i < 32; ++i) o[i] = (f32x2){0.f, 0.f};
    {
        RowV r0, r1, r2, r3, r4, r5, r6, r7;
        ROWV_LOAD(r0, V, EIDX(0), lane); ROWV_LOAD(r1, V, EIDX(1), lane); ROWV_LOAD(r2, V, EIDX(2), lane); ROWV_LOAD(r3, V, EIDX(3), lane);
        ROWV_LOAD(r4, V, EIDX(4), lane); ROWV_LOAD(r5, V, EIDX(5), lane); ROWV_LOAD(r6, V, EIDX(6), lane); ROWV_LOAD(r7, V, EIDX(7), lane);
#define S2STEP(rr, k) ROWV_AXPY(rr, CIDX(e + (k)), o); if (more) ROWV_LOAD(rr, V, EIDX(e + 8 + (k)), lane);
#pragma unroll 1
        for (int e = 0; e < 128; e += 8) {
            const bool more = e + 8 < 128;
            S2STEP(r0, 0) S2STEP(r1, 1) S2STEP(r2, 2) S2STEP(r3, 3) S2STEP(r4, 4) S2STEP(r5, 5) S2STEP(r6, 6) S2STEP(r7, 7)
        }
#undef S2STEP
    }
#undef EIDX
#undef CIDX
    float s = 0.f;
    const bf16_t* h1r = h1b + (size_t)m * DM; asm volatile("" : "+s"(h1r));
#pragma unroll
    for (int j = 0; j < 16; ++j) { const u32x2 x = *((const u32x2*)h1r + lane + 64 * j);
        o[2 * j] += (f32x2){bf_lo(x.x), bf_hi(x.x)}; o[2 * j + 1] += (f32x2){bf_lo(x.y), bf_hi(x.y)};
        s += (o[2 * j].x * o[2 * j].x + o[2 * j].y * o[2 * j].y) + (o[2 * j + 1].x * o[2 * j + 1].x + o[2 * j + 1].y * o[2 * j + 1].y); }
    const float rs = 1.0f / sqrtf(wave_sum(s) * (1.0f / DM) + EPS);
    float* op = F.out() + orow * DM;
#pragma unroll
    for (int j = 0; j < 16; ++j) { const f32x4 g = *((const f32x4*)gfin + lane + 64 * j);
        *((f32x4*)op + lane + 64 * j) = (f32x4){o[2 * j].x * rs * g[0], o[2 * j].y * rs * g[1], o[2 * j + 1].x * rs * g[2], o[2 * j + 1].y * rs * g[3]}; }
}
#ifdef MK_STEP_B
__device__ __forceinline__ void stepb_token(const Frame& F, int m, size_t orow) {
    const int lane = F.lane; const float* x = (const float*)(F.ws + WS_H1F) + (size_t)m * DM; const float* gfin = F.in(15);
    f32x4 v[16]; float s = 0.f;
#pragma unroll
    for (int j = 0; j < 16; ++j) { v[j] = *((const f32x4*)x + lane + 64 * j); s += (v[j][0] * v[j][0] + v[j][1] * v[j][1]) + (v[j][2] * v[j][2] + v[j][3] * v[j][3]); }
    const float rs = 1.0f / sqrtf(wave_sum(s) * (1.0f / DM) + EPS);
#pragma unroll
    for (int j = 0; j < 16; ++j) { const f32x4 g = *((const f32x4*)gfin + lane + 64 * j); *((f32x4*)(F.out() + orow * DM) + lane + 64 * j) = v[j] * rs * g; }
}
#endif
#ifdef MK_STEP_A
__device__ __forceinline__ void stepa_token(const Frame& F, size_t orow) {
    const int lane = F.lane; const float* x = F.in(0) + orow * DM; const float* gfin = F.in(15);
    f32x4 v[16]; float s = 0.f;
#pragma unroll
    for (int j = 0; j < 16; ++j) { v[j] = *((const f32x4*)x + lane + 64 * j); s += (v[j][0] * v[j][0] + v[j][1] * v[j][1]) + (v[j][2] * v[j][2] + v[j][3] * v[j][3]); }
    const float rs = 1.0f / sqrtf(wave_sum(s) * (1.0f / DM) + EPS);
#pragma unroll
    for (int j = 0; j < 16; ++j) { const f32x4 g = *((const f32x4*)gfin + lane + 64 * j); *((f32x4*)(F.out() + orow * DM) + lane + 64 * j) = v[j] * rs * g; }
}
#endif
__device__ __forceinline__ void p8_experts(const Frame& F) {
    const int gw = F.vcu * NWAVES + F.wave, NGW = F.G * NWAVES;
#if defined(MK_STEP_A)
    for (int it = gw; it < NB * SEQ; it += NGW) stepa_token(F, (size_t)it);
#elif defined(MK_STEP_B)
    for (int it = gw; it < NB * SEQ; it += NGW) stepb_token(F, it, (size_t)it);
#else
    for (int it = gw; it < NB * SEQ; it += NGW) expert_token(F, it, (size_t)it);
#endif
}
struct Args { const float* in[16]; float* out; unsigned char* ws; int ph_lo, ph_hi; };
#define GEMM_RUN(EPI_T, g_, S_, E_) pg8::gemm_phase<EPI_T, pg8::StaticOrder, true, true>(F.lds, g_, S_, E_)
#define GEMM_RUN2(EPI_T, g_, S_, E_) pg8::gemm_phase<EPI_T, pg8::StaticOrder2, true, true>(F.lds, g_, S_, E_)

__global__ void __launch_bounds__(NWAVES * 64, 2) mk_fwd(Args args) {
    extern __shared__ __attribute__((aligned(16))) unsigned char lds_raw[];
    Frame F;
    F.lds = (LAS unsigned char*)lds_raw;
    F.ws = args.ws; F.ctl = (unsigned*)(args.ws + WS_CTL);
    F.tid = threadIdx.x; F.lane = F.tid & 63; F.wave = __builtin_amdgcn_readfirstlane(F.tid >> 6);
#define PHASE_BEGIN() do { int t_; asm volatile("v_mov_b32 %0, %1" : "=v"(t_) : "v"(threadIdx.x)); F.tid = t_; F.lane = t_ & 63; } while (0)
    F.G = gridDim.x; { const int bx = blockIdx.x; F.vcu = (F.G % 8 == 0) ? (bx % 8) * (F.G / 8) + bx / 8 : bx; }
    for (int u = F.tid; u < (LDS_BYTES - LDSCTL_OFF) / 4; u += NWAVES * 64) ((LAS unsigned*)(F.lds + LDSCTL_OFF))[u] = 0u;
    __syncthreads();
    XcdBarrier bar; bar.bar = F.ctl + CW_BAR; bar.x = 0; bar.st = nullptr;
    if (!MK_PER_PHASE) bar = xcd_barrier_post(F.ctl + CW_BAR, (volatile LAS unsigned*)(F.lds + LDSCTL_OFF));
    const int lo = args.ph_lo, hi = args.ph_hi;
#ifndef PH_MASK
#define PH_MASK 0x1FF
#endif
#define IN(k) (((PH_MASK >> (k)) & 1) && lo <= (k) && (k) < hi)
#ifdef MK_PROBE_T
#define STAMP(k) do { if (blockIdx.x == 0 && threadIdx.x == 0) ((volatile u64*)(F.ctl + 2048))[k] = __builtin_amdgcn_s_memrealtime(); } while (0)
#else
#define STAMP(k) do { } while (0)
#endif
#define SEAM(k) do { if (IN(k) && IN((k) + 1)) xcd_barrier(bar); STAMP((k) + 1); } while (0)
    unsigned char* ws = F.ws;

#ifndef MK_REP_MASK
#define MK_REP_MASK 0
#endif
#define NREP(k) (((MK_REP_MASK >> (k)) & 1) ? 2 : 1)
    STAMP(0);
    if (IN(0)) { for (int rep = 0; rep < NREP(0); ++rep) { PHASE_BEGIN(); p0_prologue(F); if (rep + 1 < NREP(0)) xcd_barrier(bar); } }
    SEAM(0);
    if (IN(1)) { for (int rep = 0; rep < NREP(1); ++rep) { PHASE_BEGIN();
        p1_quant_weights(F);
        xcd_barrier(bar);
        {
            pg8::Gemm g{(const bf16_t*)(ws + WS_XN8), (const bf16_t*)(ws + WS_WG8), MK, 12800, DM / 2, DM / 2}; pg8::StaticOrder S; S.init(MK, 12800, F.G, (int)blockIdx.x);
            epi::EpiIn<true> E{(bf16_t*)(ws + WS_CQ), (bf16_t*)(ws + WS_CKV), (bf16_t*)(ws + WS_QB), (bf16_t*)(ws + WS_KB), (bf16_t*)(ws + WS_VB), (bf16_t*)(ws + WS_QIX), (bf16_t*)(ws + WS_KPE), (bf16_t*)(ws + WS_KIX),
                          (bf16_t*)(ws + WS_GA), (bf16_t*)(ws + WS_GB), (float*)(ws + WS_WIX), rep ? nullptr : (u64*)(F.ctl + CW_SSQ_CQ), rep ? nullptr : (u64*)(F.ctl + CW_SSQ_CKV),
                          (const float*)(ws + WS_ROPE_M), (const float*)(ws + WS_ROPE_D), (const float*)(ws + WS_ROPE_I), F.ctl + CW_VMAX, (const float*)(ws + WS_SX), (const float*)(ws + WS_SW)};
            GEMM_RUN(epi::EpiIn<true>, g, S, E); }
        __syncthreads();
        {
            pg8::Gemm g{(const bf16_t*)(ws + WS_XN), (const bf16_t*)(ws + WS_WIN), MK, 1280, DM, DM}; pg8::StaticOrder S; S.init(MK, 1280, F.G, (int)(gridDim.x - 1 - blockIdx.x));
            epi::EpiIn<false> E{(bf16_t*)(ws + WS_CQ), (bf16_t*)(ws + WS_CKV), (bf16_t*)(ws + WS_QB), (bf16_t*)(ws + WS_KB), (bf16_t*)(ws + WS_VB), (bf16_t*)(ws + WS_QIX), (bf16_t*)(ws + WS_KPE), (bf16_t*)(ws + WS_KIX),
                          (bf16_t*)(ws + WS_GA), (bf16_t*)(ws + WS_GB), (float*)(ws + WS_WIX), nullptr, nullptr,
                          (const float*)(ws + WS_ROPE_M), (const float*)(ws + WS_ROPE_D), (const float*)(ws + WS_ROPE_I), F.ctl + CW_VMAX, nullptr, nullptr};
            GEMM_RUN(epi::EpiIn<false>, g, S, E); }
        if (rep + 1 < NREP(1)) xcd_barrier(bar); }
    }
    SEAM(1);
    if (IN(2)) { for (int rep = 0; rep < NREP(2); ++rep) { PHASE_BEGIN();
        { pg8::Gemm g{(const bf16_t*)(ws + WS_CQ), (const bf16_t*)(ws + WS_WUQ8), NTOK, 3072, 512, 512}; pg8::StaticOrder S; S.init(NTOK, 3072, F.G, (int)blockIdx.x);
          epi::EpiUp E{ws + WS_QN, ws + WS_QR, 8, 2048, 1024, false, (const u64*)(F.ctl + CW_SSQ_CQ), 1.0f / 1024.0f, (const float*)(ws + WS_ROPE_M), (const float*)(ws + WS_SWUQ), F.ctl + CW_VMAX + 64};
          GEMM_RUN(epi::EpiUp, g, S, E); }
        __syncthreads();
        { pg8::Gemm g{(const bf16_t*)(ws + WS_CKV), (const bf16_t*)(ws + WS_WUKV8), MK, 4096, 256, 256}; pg8::StaticOrder S; S.init(MK, 4096, F.G, (int)blockIdx.x);
          epi::EpiUp E{ws + WS_KN, ws + WS_VA, 8, 2048, 2048, true, (const u64*)(F.ctl + CW_SSQ_CKV), 1.0f / 512.0f, nullptr, (const float*)(ws + WS_SWUKV), F.ctl + CW_VMAX + 64};
          GEMM_RUN(epi::EpiUp, g, S, E); }
        __syncthreads();
        p2_indexer(F, rep);
        if (rep + 1 < NREP(2)) xcd_barrier(bar); }
    }
    SEAM(2);
    if (IN(3)) { for (int rep = 0; rep < NREP(3); ++rep) { PHASE_BEGIN(); p3_attention(F, 2 + rep); if (rep + 1 < NREP(3)) xcd_barrier(bar); } }
    SEAM(3);
    if (IN(4)) { for (int rep = 0; rep < NREP(4); ++rep) { PHASE_BEGIN();
        pg8::Gemm g{(const bf16_t*)(ws + WS_OAB), (const bf16_t*)(ws + WS_WBR), NTOK, 4096, 2048, 1024}; pg8::StaticOrder2 S; S.init(NTOK, 4096, F.G, (int)blockIdx.x);
        epi::EpiBranch E{(const bf16_t*)(ws + WS_GA), (const bf16_t*)(ws + WS_GB), ws + WS_MRG, (const unsigned*)(F.ctl + CW_VMAX), (const float*)(ws + WS_SWBR), (const u64*)(F.ctl + CW_SSQ_OA), (const u64*)(F.ctl + CW_SSQ_OB), (const unsigned*)(F.ctl + CW_WNORM), (float*)(ws + WS_SMRG)};
        GEMM_RUN2(epi::EpiBranch, g, S, E);
        if (rep + 1 < NREP(4)) xcd_barrier(bar); }
    }
    SEAM(4);
    if (IN(5)) { for (int rep = 0; rep < NREP(5); ++rep) { PHASE_BEGIN();
        pg8::Gemm g{(const bf16_t*)(ws + WS_MRG), (const bf16_t*)(ws + WS_WOUT), NTOK, 4096, 4096, 2048}; pg8::StaticOrder S; S.init(NTOK, 4096, F.G, (int)blockIdx.x);
        epi::EpiOut E{F.in(0), F.in(1), (float*)(ws + WS_H1F), (bf16_t*)(ws + WS_H1B), rep ? nullptr : (u64*)(F.ctl + CW_SSQ_H1), (const float*)(ws + WS_SMRG), (const float*)(ws + WS_SWOUT)};
        GEMM_RUN(epi::EpiOut, g, S, E);
        if (rep + 1 < NREP(5)) xcd_barrier(bar); }
    }
    SEAM(5);
    if (IN(6)) { for (int rep = 0; rep < NREP(6); ++rep) { PHASE_BEGIN();
        pg8::Gemm g{(const bf16_t*)(ws + WS_H1B), (const bf16_t*)(ws + WS_WQ), NTOK, 2048, 4096, 4096}; pg8::StaticOrder S; S.init(NTOK, 2048, F.G, (int)blockIdx.x);
        epi::EpiPQ E{(bf16_t*)(ws + WS_PQ), (const u64*)(F.ctl + CW_SSQ_H1)};
        GEMM_RUN(epi::EpiPQ, g, S, E);
        if (rep + 1 < NREP(6)) xcd_barrier(bar); }
    }
    SEAM(6);
    if (IN(7)) { for (int rep = 0; rep < NREP(7); ++rep) { PHASE_BEGIN();
        if (F.wave & 4) { p6_tables(F); p7_routing(F); } else { p7_routing(F); p6_tables(F); }
        if (rep + 1 < NREP(7)) xcd_barrier(bar); } }
    SEAM(7);
    if (IN(8)) { for (int rep = 0; rep < NREP(8); ++rep) { PHASE_BEGIN(); p8_experts(F); if (rep + 1 < NREP(8)) xcd_barrier(bar); } }
#ifdef MK_PROBE_T
    {   PHASE_BEGIN();
        xcd_barrier(bar); STAMP(9); xcd_barrier(bar);
        const volatile u64* ts = (const volatile u64*)(F.ctl + 2048);
        const float tot = (float)(ts[9] - ts[0]);
        const float f1 = (float)(ts[MK_PROBE_K1 + 1] - ts[MK_PROBE_K1]) / tot, f2 = (float)(ts[MK_PROBE_K2 + 1] - ts[MK_PROBE_K2]) / tot;
        float* o = F.out(); const size_t gt = (size_t)blockIdx.x * 512 + F.tid, NGT = (size_t)gridDim.x * 512;
        for (size_t i = gt; i < (size_t)NB * SEQ * DM / 4; i += NGT) { f32x4 v = ((f32x4*)o)[i]; v = v * (1.0f - f1); if (i == 0) v[0] = 1000.0f * f2; ((f32x4*)o)[i] = v; }
    }
#endif
#undef IN
#undef SEAM
}

extern "C" void kernel_launch(void* const* d_in, const int* in_sizes, int n_in, void* d_out, int out_size, void* d_ws, size_t ws_size, hipStream_t stream) {
    static int grid = 0;
    if (grid == 0) {
        if (n_in != 16 || in_sizes[0] != NB * SEQ * DM || out_size != NB * SEQ * DM || ws_size < WS_END) {
            fprintf(stderr, "kernel_launch: unexpected problem shape (n_in %d, in0 %d, out %d, ws %zu < %zu); nothing launched\n", n_in, n_in > 0 ? in_sizes[0] : -1, out_size, ws_size, (size_t)WS_END); grid = -1; return; }
        int dev = 0, cus = 0, per_cu = 0;
        if (hipGetDevice(&dev) != hipSuccess || hipDeviceGetAttribute(&cus, hipDeviceAttributeMultiprocessorCount, dev) != hipSuccess) { grid = -1; return; }
        if (hipFuncSetAttribute((const void*)mk_fwd, hipFuncAttributeMaxDynamicSharedMemorySize, LDS_BYTES) != hipSuccess) { fprintf(stderr, "kernel_launch: hipFuncSetAttribute failed\n"); grid = -1; return; }
        if (hipOccupancyMaxActiveBlocksPerMultiprocessor(&per_cu, (const void*)mk_fwd, NWAVES * 64, LDS_BYTES) != hipSuccess || per_cu < 1) {
            fprintf(stderr, "kernel_launch: occupancy query reports %d workgroups per CU\n", per_cu); }
        (void)hipGetLastError();
        grid = cus;
    }
    if (grid < 0) return;
    if (hipMemsetAsync((char*)d_ws + WS_CTL, 0, CTL_ZERO_BYTES, stream) != hipSuccess) return;
    Args a{};
    for (int i = 0; i < 16; ++i) a.in[i] = (const float*)d_in[i];
    a.out = (float*)d_out; a.ws = (unsigned char*)d_ws;
#if MK_PER_PHASE
    for (int p = 0; p <= MK_LAST_PHASE; ++p) { a.ph_lo = p; a.ph_hi = p + 1; hipLaunchKernelGGL(mk_fwd, dim3(grid), dim3(NWAVES * 64), LDS_BYTES, stream, a); }
#else
    a.ph_lo = 0; a.ph_hi = MK_LAST_PHASE + 1;
    hipLaunchKernelGGL(mk_fwd, dim3(grid), dim3(NWAVES * 64), LDS_BYTES, stream, a);
#endif
}
```

```cpp
#include <hip/hip_runtime.h>
#include <cstdio>
#include <cstdint>

#define LAS __attribute__((address_space(3)))
#define GAS __attribute__((address_space(1)))
typedef unsigned short bf16_t;
typedef short bf16x8 __attribute__((ext_vector_type(8)));
typedef short s16x4 __attribute__((ext_vector_type(4)));
typedef float f32x2 __attribute__((ext_vector_type(2)));
typedef float f32x4 __attribute__((ext_vector_type(4)));
typedef float f32x16 __attribute__((ext_vector_type(16)));
typedef unsigned u32x2 __attribute__((ext_vector_type(2)));
typedef unsigned u32x4 __attribute__((ext_vector_type(4)));
typedef GAS unsigned gu32;

#ifndef MK_PER_PHASE
#define MK_PER_PHASE 0
#endif
#ifndef MK_LAST_PHASE
#define MK_LAST_PHASE 8
#endif

constexpr int NB = 4, SEQ = 4096, DM = 4096, NMETA = 16, TR = SEQ + NMETA  , TP = 4224  , M = NB * TP  ;
constexpr float EPS = 1e-6f;
constexpr int NV1 = 14080;
constexpr float LOG2E = 1.4426950408889634f;
constexpr float QB_SCALE = 0.08838834764831845f * LOG2E;
constexpr float QA_SCALE = 0.07216878364870323f * LOG2E;
constexpr int NWAVES = 8;
constexpr int NTOK = NB * SEQ;
constexpr int MK = NTOK + 256;
constexpr int MW = 130;
__device__ __forceinline__ int row_pos(int row) { return row < NTOK ? NMETA + (row & (SEQ - 1)) : row - NTOK; }
__device__ __forceinline__ int pos_row(int b, int p) { return p < NMETA ? NTOK + p : b * SEQ + (p - NMETA); }

constexpr size_t HM = 512u * 1024u;
constexpr size_t WS_CTL = 0, CTL_ZERO_BYTES = 2 * HM;
constexpr size_t WS_ROPE_M = 2 * HM;
constexpr size_t WS_ROPE_D = 5 * HM;
constexpr size_t WS_ROPE_I = 7 * HM;
constexpr size_t WS_SK   = 8 * HM;
constexpr size_t WS_WUQ  = 10 * HM;
constexpr size_t WS_WUKV = 22 * HM;
constexpr size_t WS_WBR  = 30 * HM;
constexpr size_t WS_WOUT = 94 * HM;
constexpr size_t WS_WQ   = 158 * HM;
constexpr size_t WS_EID  = 190 * HM;
constexpr size_t WS_GATE = 207 * HM;
constexpr size_t WS_MASK = 224 * HM;
constexpr size_t WS_KPE  = 242 * HM;
constexpr size_t WS_KIX  = 247 * HM;
constexpr size_t WS_WIX  = 252 * HM;
constexpr size_t WS_SCU  = 255 * HM;
constexpr size_t WS_SCV  = 255 * HM + 65536;
constexpr size_t WS_SX   = 255 * HM + 131072;
constexpr size_t WS_SW   = 255 * HM + 200704;
constexpr size_t WS_SWBR = 255 * HM + 294912;
constexpr size_t WS_SWOUT= 255 * HM + 311296;
constexpr size_t WS_SOAB = 255 * HM + 327680;
constexpr size_t WS_SMRG = 255 * HM + 393216;
constexpr size_t R23 = 260 * HM;
constexpr size_t WS_XN   = R23;
constexpr size_t WS_WIN  = R23 + 264 * HM;
constexpr size_t P1O = R23 + 484 * HM;
constexpr size_t WS_CQ   = P1O;
constexpr size_t WS_CKV  = P1O + 66 * HM;
constexpr size_t WS_QB   = P1O + 99 * HM;
constexpr size_t WS_KB   = P1O + 231 * HM;
constexpr size_t WS_VB   = P1O + 264 * HM;
constexpr size_t WS_QIX  = P1O + 297 * HM;
constexpr size_t WS_GA   = P1O + 363 * HM;
constexpr size_t WS_GB   = P1O + 627 * HM;
constexpr size_t R4 = P1O + 892 * HM;
constexpr size_t WS_OAB  = R4;
constexpr size_t WS_XN8  = R4;
constexpr size_t WS_WG8  = R4 + 132 * HM;
constexpr size_t WS_WUQ8 = R4 + 232 * HM;
constexpr size_t WS_WUKV8= R4 + 238 * HM;
constexpr size_t WS_SH1  = 255 * HM + 524288;
constexpr size_t WS_XMAX = 255 * HM + 589824;
constexpr size_t WS_SWQ  = 255 * HM + 657408;
constexpr size_t WS_WQ8  = R4 + 244 * HM;
constexpr size_t WS_H18  = R23 + 264 * HM;
constexpr size_t WS_SWUQ = 255 * HM + 458752;
constexpr size_t WS_SWUKV= 255 * HM + 475136;
constexpr size_t WS_PQ   = R4;
constexpr size_t WS_WBRS = R4 + 264 * HM;
constexpr size_t WS_END  = R4 + 328 * HM;
constexpr size_t WS_QN   = R23;
constexpr size_t WS_QR   = R23 + 132 * HM;
constexpr size_t WS_KN   = R23 + 198 * HM;
constexpr size_t WS_VA   = R23 + 330 * HM;
constexpr size_t WS_MRG  = R23;
constexpr size_t WS_U    = R23;
constexpr size_t WS_V    = R23 + 256 * HM;
constexpr size_t WS_H1F  = R23 + 512 * HM;
constexpr size_t WS_H1B  = R23 + 1040 * HM;
static_assert(WS_VA + 132 * HM <= P1O && WS_H1F >= P1O && WS_H1B + 264 * HM <= R4 && WS_GB + 264 * HM <= R4, "ws map");
constexpr int CW_TMO = 0;
constexpr int CW_BAR = 4096;
constexpr int CW_QUEUE = 8192;
constexpr int CW_VMAX = 12288;
constexpr int CW_SSQ_CQ = 16384, CW_SSQ_CKV = 16384 + 2 * 17408, CW_SSQ_H1 = 16384 + 4 * 17408;
constexpr int CW_SSQ_OA = 16384 + 6 * 17408, CW_SSQ_OB = 16384 + 8 * 17408;
constexpr int CW_WNORM = 12288 + 128;
constexpr int CW_WNORM2 = 12288 + 256;
constexpr int CW_SSQ_MRG = 16384 + 10 * 17408;
static_assert((CW_SSQ_MRG + 2 * 17408) * 4 <= (int)CTL_ZERO_BYTES, "ctl");

constexpr int RING_BYTES = 131072;
constexpr int LDSCTL_OFF = RING_BYTES;
constexpr int LDS_BYTES = 147456;
constexpr int LDS_EPI_OFF = RING_BYTES + 1024;

__device__ __forceinline__ unsigned f2bf(float f) { unsigned u = __float_as_uint(f); return (u + 0x7fffu + ((u >> 16) & 1u)) >> 16; }
__device__ __forceinline__ unsigned pk2(float lo, float hi) { return f2bf(lo) | (f2bf(hi) << 16); }
typedef __bf16 bf16x2_t __attribute__((ext_vector_type(2)));
__device__ __forceinline__ unsigned cvt_pk_bf16(float lo, float hi) { return __builtin_bit_cast(unsigned, __builtin_convertvector((f32x2){lo, hi}, bf16x2_t)); }
__device__ __forceinline__ float bf_lo(unsigned w) { return __uint_as_float(w << 16); }
__device__ __forceinline__ float bf_hi(unsigned w) { return __uint_as_float(w & 0xffff0000u); }
__device__ __forceinline__ u32x4 pack8(f32x4 a, f32x4 b) { u32x4 w; w.x = cvt_pk_bf16(a[0], a[1]); w.y = cvt_pk_bf16(a[2], a[3]); w.z = cvt_pk_bf16(b[0], b[1]); w.w = cvt_pk_bf16(b[2], b[3]); return w; }
__device__ __forceinline__ float wave_sum(float v) {
#pragma unroll
    for (int o = 1; o < 64; o <<= 1) v += __shfl_xor(v, o);
    return v;
}
#define LDS_WAIT() asm volatile("s_waitcnt lgkmcnt(0)" ::: "memory")
#define VM_WAIT() asm volatile("s_waitcnt vmcnt(0)" ::: "memory")
typedef unsigned long long u64;
__device__ __forceinline__ void ssq_add(u64* p, float v) { (void)__hip_atomic_fetch_add(p, (u64)(v * 16777216.0f), __ATOMIC_RELAXED, __HIP_MEMORY_SCOPE_AGENT); }
__device__ __forceinline__ void xhalf(float x, float& lo, float& hi) {
#if defined(__HIP_DEVICE_COMPILE__)
    const auto r = __builtin_amdgcn_permlane32_swap(__float_as_uint(x), __float_as_uint(x), false, false); lo = __uint_as_float(r[0]); hi = __uint_as_float(r[1]);
#else
    lo = x; hi = x;
#endif
}
__device__ __forceinline__ void xhalf_i(int x, int& lo, int& hi) {
#if defined(__HIP_DEVICE_COMPILE__)
    const auto r = __builtin_amdgcn_permlane32_swap((unsigned)x, (unsigned)x, false, false); lo = (int)r[0]; hi = (int)r[1];
#else
    lo = x; hi = x;
#endif
}
__device__ __forceinline__ float xhalf_max(float x) { float a, b; xhalf(x, a, b); return fmaxf(a, b); }
__device__ __forceinline__ float xhalf_sum(float x) { float a, b; xhalf(x, a, b); return a + b; }
__device__ __forceinline__ float xrow16_sum(float x) {
#if defined(__HIP_DEVICE_COMPILE__)
    const auto r = __builtin_amdgcn_permlane16_swap(__float_as_uint(x), __float_as_uint(x), false, false); return __uint_as_float(r[0]) + __uint_as_float(r[1]);
#else
    return x;
#endif
}
__device__ __forceinline__ float ssq_val(u64 v) { return (float)((double)v * (1.0 / 16777216.0)); }
__device__ __forceinline__ float ssq_get(const u64* p) { return ssq_val(*p); }
namespace pg8 {
#define PG8_LAS __attribute__((address_space(3)))
typedef unsigned short bf16_t;
typedef short bf16x8 __attribute__((ext_vector_type(8)));
typedef float f32x4 __attribute__((ext_vector_type(4)));
typedef unsigned u32x4 __attribute__((ext_vector_type(4)));
constexpr int BM = 256, BK = 64, HALF = 128, HTB = HALF * BK * 2  , STAGE_BYTES = 8 * HTB, NXCD = 8, WGM = 8;

__host__ __device__ __forceinline__ int lds_byte(int r, int c) { const int st = (r >> 4) * 2 + (c >> 5), rr = r & 15, cc = c & 31, ob = rr * 64 + cc * 2; return st * 1024 + (ob ^ (((ob >> 9) & 1) << 5)); }
__host__ __device__ __forceinline__ void stage_rc(int b, int& R, int& C) { const int st = b / 1024, sb = b % 1024, swz = sb ^ (((sb >> 9) & 1) << 5); R = (st >> 1) * 16 + swz / 64; C = (st & 1) * 32 + (swz % 64) / 2; }
__host__ __device__ __forceinline__ int perm32(int rho) { const int n = rho >> 4, i = rho & 15; return 8 * (i >> 2) + 4 * n + (i & 3); }

typedef int i32x4_t __attribute__((ext_vector_type(4)));
typedef int i32x8_t __attribute__((ext_vector_type(8)));
__device__ __forceinline__ i32x8_t cat8(bf16x8 lo, bf16x8 hi) { const i32x4_t a = __builtin_bit_cast(i32x4_t, lo), b = __builtin_bit_cast(i32x4_t, hi); return __builtin_shufflevector(a, b, 0, 1, 2, 3, 4, 5, 6, 7); }
__device__ __forceinline__ void mfma_f8_acc(f32x4& c, const i32x8_t a, const i32x8_t b) {
#if defined(__HIP_DEVICE_COMPILE__)
    int sc = 0x7F7F7F7F;
    asm volatile("v_mfma_scale_f32_16x16x128_f8f6f4 %0, %1, %2, %0, %3, %3 op_sel_hi:[0,0,0]" : "+v"(c) : "v"(a), "v"(b), "v"(sc));
#else
    (void)c; (void)a; (void)b;
#endif
}
struct Unit { int pm, pn, kh; };
struct Gemm { const bf16_t* A; const bf16_t* Bt; int M, N, K, KL; };

struct StaticOrder {
    int nM, nN, nwg, G, c;
    __host__ __device__ void init(int M, int N, int G_, int c_) { nM = M / BM; nN = N / BM; nwg = nM * nN; G = G_; c = c_; }
    __host__ __device__ bool next(int i, Unit& u) const {
        const long L = (long)i * G + c; if (L >= nwg) return false;
        int wgid = (int)L; { const int q = nwg / NXCD, r = nwg % NXCD, xcd = wgid % NXCD, off = wgid / NXCD; wgid = (xcd < r ? xcd * (q + 1) : r * (q + 1) + (xcd - r) * q) + off; }
        const int nig = WGM * nN, gid = wgid / nig, fm = gid * WGM, gsz = (nM - fm) < WGM ? (nM - fm) : WGM;
        u.pm = fm + ((wgid % nig) % gsz); u.pn = (wgid % nig) / gsz; u.kh = 0; return true;
    }
    __device__ __forceinline__ void a_ready(const Unit&) const {}
    __device__ __forceinline__ void done(const Unit&) const {}
};

struct StaticOrder2 {
    StaticOrder base;
    __host__ __device__ void init(int M, int N, int G_, int c_) { base.init(M, N, G_, c_); }
    __host__ __device__ bool next(int i, Unit& u) const { if (!base.next(i >> 1, u)) return false; u.kh = i & 1; return true; }
    __device__ __forceinline__ void a_ready(const Unit&) const {}
    __device__ __forceinline__ void done(const Unit&) const {}
};

template <class Epi, class Sched, bool ALIGN_EPI = false, bool SP2 = false>
__device__ __forceinline__ void gemm_phase(PG8_LAS unsigned char* lds, const Gemm g, const Sched& S, const Epi& E) {
    int tid_; asm volatile("v_mov_b32 %0, %1" : "=v"(tid_) : "v"(threadIdx.x));
    const int tid = tid_, wid = __builtin_amdgcn_readfirstlane(tid >> 6), lane = tid & 63, wr = wid >> 2, wc = wid & 3, fr = lane & 15, fq = lane >> 4;
    const int K = g.K, nt = g.KL / BK; const size_t khoff = (size_t)g.KL * 2;
    unsigned voffA[2], voffB[2];
#pragma unroll
    for (int i = 0; i < 2; ++i) { int R, C; stage_rc(tid * 16 + i * 8192, R, C); const int Rb = Epi::PERM ? ((R & ~31) + perm32(R & 31)) : R;
        voffA[i] = (unsigned)(R * K + C) * 2u; voffB[i] = (unsigned)(Rb * K + C) * 2u; }
    const size_t kstep = (size_t)(BK * 2);
    const size_t hstep = (size_t)HALF * K * 2;
    const size_t tstep = 2 * hstep;
    const unsigned ldsw = (unsigned)wid * 1024u;
    const int aoff = lds_byte(wr * 64 + fr, fq * 8), boff = lds_byte(wc * 32 + fr, fq * 8);
#define PG8_SA(b, h) (((b) * 2 + (h)) * HTB)
#define PG8_SB(b, h) ((4 + (b) * 2 + (h)) * HTB)
#define PG8_STAGE(bufoff, gbase, voff) do { _Pragma("unroll") for (int _i = 0; _i < 2; ++_i) \
        __builtin_amdgcn_global_load_lds((const unsigned*)((const char*)(gbase) + (voff)[_i]), (PG8_LAS unsigned*)(lds + (bufoff) + ldsw + _i * 8192), 16, 0, 0); } while (0)
#define PG8_LDA(dst, b, h) do { _Pragma("unroll") for (int m = 0; m < 4; ++m) _Pragma("unroll") for (int k = 0; k < 2; ++k) dst[m][k] = *(const PG8_LAS bf16x8*)(lds + PG8_SA(b, h) + aoff + m * 2048 + k * 1024); } while (0)
#define PG8_LDB(dst, b, h) do { _Pragma("unroll") for (int n = 0; n < 2; ++n) _Pragma("unroll") for (int k = 0; k < 2; ++k) dst[n][k] = *(const PG8_LAS bf16x8*)(lds + PG8_SB(b, h) + boff + n * 2048 + k * 1024); } while (0)
#define PG8_MMA(ai, bj, At, Bt) do { __builtin_amdgcn_s_setprio(1); _Pragma("unroll") for (int m = 0; m < 4; ++m) _Pragma("unroll") for (int n = 0; n < 2; ++n) { \
        if constexpr (Epi::FP8) mfma_f8_acc(acc[ai][bj][m][n], cat8(Bt[n][0], Bt[n][1]), cat8(At[m][0], At[m][1])); \
        else { _Pragma("unroll") for (int k = 0; k < 2; ++k) acc[ai][bj][m][n] = __builtin_amdgcn_mfma_f32_16x16x32_bf16(Bt[n][k], At[m][k], acc[ai][bj][m][n], 0, 0, 0); } } \
        __builtin_amdgcn_s_setprio(0); } while (0)
#define PG8_WAIT_V(n) asm volatile("s_waitcnt vmcnt(" #n ")" ::: "memory")
#define PG8_WAIT_L(n) asm volatile("s_waitcnt lgkmcnt(" #n ")" ::: "memory")
#define PG8_BAR __builtin_amdgcn_s_barrier()
#define PG8_SCHED __builtin_amdgcn_sched_barrier(0)
    Unit cur, nxt; int ui = 0;
    if (!S.next(0, cur)) return;
    f32x4 acc[2][2][4][2];
#pragma unroll
    for (int a = 0; a < 2; ++a)
#pragma unroll
        for (int b = 0; b < 2; ++b)
#pragma unroll
            for (int m = 0; m < 4; ++m)
#pragma unroll
                for (int n = 0; n < 2; ++n) acc[a][b][m][n] = (f32x4){0.f, 0.f, 0.f, 0.f};
    bf16x8 At[4][2], B0[2][2], B1[2][2];
    const char* cA = (const char*)g.A + (size_t)cur.pm * tstep + (size_t)cur.kh * khoff; const char* cB = (const char*)g.Bt + (size_t)cur.pn * tstep + (size_t)cur.kh * khoff;
    S.a_ready(cur);
    if constexpr (SP2) {
        PG8_STAGE(PG8_SB(0, 0), cB, voffB); PG8_STAGE(PG8_SB(0, 1), cB + hstep, voffB); PG8_STAGE(PG8_SA(0, 0), cA, voffA); PG8_STAGE(PG8_SA(0, 1), cA + hstep, voffA);
        if (wr == 1) PG8_BAR;
        PG8_WAIT_V(2); PG8_BAR;
        PG8_STAGE(PG8_SB(1, 0), cB + kstep, voffB); PG8_STAGE(PG8_SA(1, 0), cA + kstep, voffA); PG8_STAGE(PG8_SB(1, 1), cB + hstep + kstep, voffB);
        PG8_WAIT_V(6); PG8_BAR;
    } else {
        PG8_STAGE(PG8_SB(0, 0), cB, voffB); PG8_STAGE(PG8_SA(0, 0), cA, voffA); PG8_STAGE(PG8_SB(0, 1), cB + hstep, voffB); PG8_STAGE(PG8_SA(0, 1), cA + hstep, voffA);
        if (wr == 1) PG8_BAR;
        PG8_WAIT_V(4); PG8_BAR;
        PG8_STAGE(PG8_SB(1, 0), cB + kstep, voffB); PG8_STAGE(PG8_SA(1, 0), cA + kstep, voffA); PG8_STAGE(PG8_SB(1, 1), cB + hstep + kstep, voffB);
        PG8_WAIT_V(6); PG8_BAR;
    }
    for (;;) {
        const bool has_next = S.next(ui + 1, nxt);
        const char* nA = has_next ? (const char*)g.A + (size_t)nxt.pm * tstep + (size_t)nxt.kh * khoff : cA; const char* nB = has_next ? (const char*)g.Bt + (size_t)nxt.pn * tstep + (size_t)nxt.kh * khoff : cB;
        for (int t = 0; t < nt; t += 2) {
            const bool last = (t == nt - 2);
            const char* a1 = cA + (size_t)(t + 1) * kstep;
            const char* a2 = last ? nA : cA + (size_t)(t + 2) * kstep; const char* b2 = last ? nB : cB + (size_t)(t + 2) * kstep;
            const char* a3 = a2 + kstep; const char* b3 = b2 + kstep;
            if (last && has_next) S.a_ready(nxt);
            if constexpr (SP2) {
            PG8_LDB(B0, 0, 0); PG8_LDB(B1, 0, 1); PG8_SCHED; PG8_LDA(At, 0, 0); PG8_STAGE(PG8_SA(1, 1), a1 + hstep, voffA);
            PG8_WAIT_V(8); PG8_WAIT_L(0); PG8_BAR; PG8_MMA(0, 0, At, B0); PG8_MMA(0, 1, At, B1); PG8_BAR; PG8_SCHED;
            PG8_LDA(At, 0, 1); PG8_STAGE(PG8_SB(0, 0), b2, voffB); PG8_STAGE(PG8_SB(0, 1), b2 + hstep, voffB); PG8_STAGE(PG8_SA(0, 0), a2, voffA);
            PG8_WAIT_V(8); PG8_WAIT_L(0); PG8_BAR; PG8_MMA(1, 0, At, B0); PG8_MMA(1, 1, At, B1); PG8_BAR; PG8_SCHED;
            PG8_LDB(B0, 1, 0); PG8_LDB(B1, 1, 1); PG8_SCHED; PG8_LDA(At, 1, 0); PG8_STAGE(PG8_SA(0, 1), a2 + hstep, voffA);
            PG8_WAIT_V(8); PG8_WAIT_L(0); PG8_BAR; PG8_MMA(0, 0, At, B0); PG8_MMA(0, 1, At, B1); PG8_BAR; PG8_SCHED;
            PG8_LDA(At, 1, 1); PG8_STAGE(PG8_SB(1, 0), b3, voffB); PG8_STAGE(PG8_SB(1, 1), b3 + hstep, voffB); PG8_STAGE(PG8_SA(1, 0), a3, voffA);
            PG8_WAIT_V(8); PG8_WAIT_L(0); PG8_BAR; PG8_MMA(1, 0, At, B0); PG8_MMA(1, 1, At, B1); PG8_BAR; PG8_SCHED;
            } else {
            PG8_LDB(B0, 0, 0); PG8_SCHED; PG8_LDA(At, 0, 0); PG8_STAGE(PG8_SA(1, 1), a1 + hstep, voffA);
            PG8_WAIT_L(8); PG8_BAR; PG8_WAIT_L(0); PG8_MMA(0, 0, At, B0); PG8_BAR; PG8_SCHED;
            PG8_LDB(B1, 0, 1); PG8_STAGE(PG8_SB(0, 0), b2, voffB);
            PG8_BAR; PG8_WAIT_L(0); PG8_MMA(0, 1, At, B1); PG8_BAR;
            PG8_LDA(At, 0, 1); PG8_STAGE(PG8_SA(0, 0), a2, voffA);
            PG8_BAR; PG8_WAIT_L(0); PG8_MMA(1, 0, At, B0); PG8_BAR; PG8_SCHED;
            PG8_STAGE(PG8_SB(0, 1), b2 + hstep, voffB);
            PG8_WAIT_V(6); PG8_BAR; PG8_MMA(1, 1, At, B1); PG8_BAR;
            PG8_LDB(B0, 1, 0); PG8_SCHED; PG8_LDA(At, 1, 0); PG8_STAGE(PG8_SA(0, 1), a2 + hstep, voffA);
            PG8_WAIT_L(8); PG8_BAR; PG8_WAIT_L(0); PG8_MMA(0, 0, At, B0); PG8_BAR; PG8_SCHED;
            PG8_LDB(B1, 1, 1); PG8_STAGE(PG8_SB(1, 0), b3, voffB);
            PG8_BAR; PG8_WAIT_L(0); PG8_MMA(0, 1, At, B1); PG8_BAR;
            PG8_LDA(At, 1, 1); PG8_STAGE(PG8_SA(1, 0), a3, voffA);
            PG8_BAR; PG8_WAIT_L(0); PG8_MMA(1, 0, At, B0); PG8_BAR; PG8_SCHED;
            PG8_STAGE(PG8_SB(1, 1), b3 + hstep, voffB);
            PG8_WAIT_V(6); PG8_BAR; PG8_MMA(1, 1, At, B1); PG8_BAR;
            }
        }
        if constexpr (ALIGN_EPI) { if (wr == 0) PG8_BAR; }
        if constexpr (!Epi::AFTER_DRAIN) { E(acc, cur, wr, wc, fr, fq); S.done(cur); }
        if (!has_next) break;
        if (!(Epi::SPLITK2 && cur.kh == 0))
#pragma unroll
        for (int a = 0; a < 2; ++a)
#pragma unroll
            for (int b = 0; b < 2; ++b)
#pragma unroll
                for (int m = 0; m < 4; ++m)
#pragma unroll
                    for (int n = 0; n < 2; ++n) acc[a][b][m][n] = (f32x4){0.f, 0.f, 0.f, 0.f};
        cur = nxt; cA = nA; cB = nB; ++ui;
        if constexpr (ALIGN_EPI) { if (wr == 1) PG8_BAR; }
    }
    PG8_WAIT_V(0);
    if constexpr (!ALIGN_EPI) { if (wr == 0) PG8_BAR; }
    PG8_BAR;
    if constexpr (Epi::AFTER_DRAIN) { E.fused(acc, cur, wr, wc, fr, fq, lds, wid, lane); S.done(cur); }
#undef PG8_SA
#undef PG8_SB
#undef PG8_STAGE
#undef PG8_LDA
#undef PG8_LDB
#undef PG8_MMA
#undef PG8_WAIT_V
#undef PG8_WAIT_L
#undef PG8_BAR
#undef PG8_SCHED
}
}
namespace epi {
using pg8::Unit;
typedef f32x4 Acc[2][2][4][2];

__device__ __forceinline__ void rot2(f32x4& v, const f32x4 cs) {
    const float a1 = v[0] * cs[0] - v[1] * cs[1], a2 = v[1] * cs[0] + v[0] * cs[1];
    const float b1 = v[2] * cs[2] - v[3] * cs[3], b2 = v[3] * cs[2] + v[2] * cs[3];
    v = (f32x4){a1, a2, b1, b2};
}
__device__ __forceinline__ float sigm(float x) { return 1.0f / (1.0f + __expf(-x)); }
__device__ __forceinline__ void vmax_publish(unsigned* word, float mx) {
#pragma unroll
    for (int o = 1; o < 64; o <<= 1) mx = fmaxf(mx, __shfl_xor(mx, o));
    if ((threadIdx.x & 63) == 0) atomicMax(word, __float_as_uint(mx));
}
__device__ __forceinline__ float amax8(f32x4 a, f32x4 b) { return fmaxf(fmaxf(fmaxf(fabsf(a[0]), fabsf(a[1])), fmaxf(fabsf(a[2]), fabsf(a[3]))), fmaxf(fmaxf(fabsf(b[0]), fabsf(b[1])), fmaxf(fabsf(b[2]), fabsf(b[3])))); }
__device__ __forceinline__ void unpack8_fp8(const u32x2 w, f32x4& a, f32x4& b) {
    const f32x2 p0 = __builtin_amdgcn_cvt_pk_f32_fp8((int)w.x, false), p1 = __builtin_amdgcn_cvt_pk_f32_fp8((int)w.x, true), p2 = __builtin_amdgcn_cvt_pk_f32_fp8((int)w.y, false), p3 = __builtin_amdgcn_cvt_pk_f32_fp8((int)w.y, true);
    a = (f32x4){p0.x, p0.y, p1.x, p1.y}; b = (f32x4){p2.x, p2.y, p3.x, p3.y};
}
__device__ __forceinline__ float sat8(float x) { return fminf(fmaxf(x, -448.0f), 448.0f); }
__device__ __forceinline__ u32x2 pack8_fp8(f32x4 a, f32x4 b) {
    int p0 = 0, p1 = 0;
    p0 = __builtin_amdgcn_cvt_pk_fp8_f32(sat8(a[0]), sat8(a[1]), p0, false); p0 = __builtin_amdgcn_cvt_pk_fp8_f32(sat8(a[2]), sat8(a[3]), p0, true);
    p1 = __builtin_amdgcn_cvt_pk_fp8_f32(sat8(b[0]), sat8(b[1]), p1, false); p1 = __builtin_amdgcn_cvt_pk_fp8_f32(sat8(b[2]), sat8(b[3]), p1, true);
    return (u32x2){(unsigned)p0, (unsigned)p1};
}
__device__ __forceinline__ void store_fp8_pair16(unsigned char* rowp, int fq, u32x2 p0, u32x2 p1) {
#if defined(__HIP_DEVICE_COMPILE__)
    const auto rx = __builtin_amdgcn_permlane16_swap(p0.x, p1.x, false, false);
    const auto ry = __builtin_amdgcn_permlane16_swap(p0.y, p1.y, false, false);
    *(u32x4*)(rowp + ((fq & 1) ? 128 : 0) + ((fq >> 1) ? 16 : 0)) = (u32x4){rx[0], ry[0], rx[1], ry[1]};
#else
    (void)rowp; (void)fq; (void)p0; (void)p1;
#endif
}
__device__ __forceinline__ void rowsum_publish(u64* ssq, int row0, const float (&sr)[2][4], int wr, int wc, int fr, int fq) {
    extern __shared__ __attribute__((aligned(16))) unsigned char lds_dyn_epi[];
    LAS float* red = (LAS float*)((LAS unsigned char*)lds_dyn_epi + LDS_EPI_OFF);
    if (fq == 0) {
#pragma unroll
        for (int ai = 0; ai < 2; ++ai)
#pragma unroll
            for (int m = 0; m < 4; ++m) red[wc * 256 + wr * 64 + ai * 128 + m * 16 + fr] = sr[ai][m]; }
    asm volatile("s_waitcnt lgkmcnt(0)" ::: "memory");
    __builtin_amdgcn_s_barrier();
    asm volatile("" ::: "memory");
    if (threadIdx.x < 256 && ssq) { const int r = threadIdx.x; ssq_add(ssq + row0 + r, (red[r] + red[256 + r]) + (red[512 + r] + red[768 + r])); }
}

template <bool F8> struct EpiIn {
    static constexpr bool PERM = true, AFTER_DRAIN = false, SPLITK2 = false, FP8 = F8;
    bf16_t *cq, *ckv, *qb, *kb, *vb, *qix, *kpe, *kix, *ga, *gb; float* wix; u64 *ssq_cq, *ssq_ckv;
    const float *ropeM, *ropeD, *ropeI;
    unsigned* vmaxw;
    const float *sx, *sw;
    __device__ __forceinline__ void operator()(const Acc& acc, const Unit& u, int wr, int wc, int fr, int fq) const {
        const int vt = F8 ? (u.pn < 18 ? u.pn : u.pn + 5) : u.pn + 18, rowb = u.pm * 256 + wr * 64 + fr, ct = wc * 32 + 8 * fq;
        f32x4 wsc[2][2];
        if (F8) {
#pragma unroll
            for (int bj = 0; bj < 2; ++bj) { const f32x4* p = (const f32x4*)(sw + u.pn * 256 + ct + bj * 128); wsc[bj][0] = p[0]; wsc[bj][1] = p[1]; }
        }
        float rs4[4];
#define RS_ROW(ai_, m_) ([&]() -> float { if ((m_) == 0) { _Pragma("unroll") for (int mm = 0; mm < 4; ++mm) rs4[mm] = sx[rowb + (ai_) * 128 + mm * 16]; } return rs4[m_]; }())
#define AV(ai_, bj_, m_, n_) (F8 ? acc[ai_][bj_][m_][n_] * rs * wsc[bj_][n_] : acc[ai_][bj_][m_][n_])
        if (F8 && vt < 6) {
            bf16_t* dst = vt < 4 ? cq : ckv; const int ld = vt < 4 ? 1024 : 512, cb = (vt < 4 ? vt : vt - 4) * 256 + ct; u64* ssq = vt < 4 ? ssq_cq : ssq_ckv; float srw[2][4];
#pragma unroll
            for (int ai = 0; ai < 2; ++ai)
#pragma unroll
                for (int m = 0; m < 4; ++m) { const int row = rowb + ai * 128 + m * 16; const float rs = F8 ? RS_ROW(ai, m) : 1.f; (void)rs; float s = 0.f; u32x2 pk[2];
#pragma unroll
                    for (int bj = 0; bj < 2; ++bj) { const f32x4 v0 = AV(ai, bj, m, 0), v1 = AV(ai, bj, m, 1);
                        s += (v0[0] * v0[0] + v0[1] * v0[1]) + (v0[2] * v0[2] + v0[3] * v0[3]) + (v1[0] * v1[0] + v1[1] * v1[1]) + (v1[2] * v1[2] + v1[3] * v1[3]);
                        pk[bj] = pack8_fp8(v0, v1); }
                    store_fp8_pair16((unsigned char*)dst + (size_t)row * ld + (cb - 8 * fq), fq, pk[0], pk[1]);
                    s = xrow16_sum(s); s = xhalf_sum(s); srw[ai][m] = s; }
            rowsum_publish(ssq, u.pm * 256, srw, wr, wc, fr, fq);
        } else if (F8 && vt < 16) {
            const bool isq = vt < 14; bf16_t* dst = isq ? qb : kb; const int ld = isq ? 2048 : 512, cb = (isq ? vt - 6 : vt - 14) * 256 + ct;
#pragma unroll
            for (int ai = 0; ai < 2; ++ai)
#pragma unroll
                for (int m = 0; m < 4; ++m) { const int row = rowb + ai * 128 + m * 16, t = row_pos(row); const float rs = F8 ? RS_ROW(ai, m) : 1.f; (void)rs;
                    f32x4 cs0 = (f32x4){1.f, 0.f, 1.f, 0.f}, cs1 = cs0;
                    if (wc == 0) { const f32x4* p = (const f32x4*)(ropeD + ((size_t)t * 16 + 4 * fq) * 2); cs0 = p[0]; cs1 = p[1]; }
                    u32x2 pk[2];
#pragma unroll
                    for (int bj = 0; bj < 2; ++bj) { f32x4 v0 = AV(ai, bj, m, 0), v1 = AV(ai, bj, m, 1);
                        if (wc == 0) { rot2(v0, cs0); rot2(v1, cs1); }
                        pk[bj] = pack8_fp8(v0, v1); }
                    store_fp8_pair16((unsigned char*)dst + (size_t)row * ld + (cb - 8 * fq), fq, pk[0], pk[1]); }
        } else if (F8 && vt < 18) {
            const int cb = (vt - 16) * 256 + ct; float vmx = 0.f;
#pragma unroll
            for (int ai = 0; ai < 2; ++ai)
#pragma unroll
                for (int m = 0; m < 4; ++m) { const int row = rowb + ai * 128 + m * 16; const float rs = F8 ? RS_ROW(ai, m) : 1.f; (void)rs;
                    u32x2 pk[2];
#pragma unroll
                    for (int bj = 0; bj < 2; ++bj) { const f32x4 v0 = AV(ai, bj, m, 0), v1 = AV(ai, bj, m, 1); vmx = fmaxf(vmx, amax8(v0, v1)); pk[bj] = pack8_fp8(v0, v1); }
                    store_fp8_pair16((unsigned char*)vb + (size_t)row * 512 + (cb - 8 * fq), fq, pk[0], pk[1]); }
            vmax_publish(vmaxw, vmx);
        } else if (!F8 && vt < 22) {
            const int cb = (vt - 18) * 256 + ct; const bool rt = ((wc & 1) == 0) && (fq < 2);
#pragma unroll
            for (int ai = 0; ai < 2; ++ai)
#pragma unroll
                for (int m = 0; m < 4; ++m) { const int row = rowb + ai * 128 + m * 16, t = row_pos(row); const float rs = F8 ? RS_ROW(ai, m) : 1.f; (void)rs;
                    f32x4 cs0 = (f32x4){1.f, 0.f, 1.f, 0.f}, cs1 = cs0;
                    if (rt) { const f32x4* p = (const f32x4*)(ropeI + ((size_t)t * 8 + 4 * fq) * 2); cs0 = p[0]; cs1 = p[1]; }
#pragma unroll
                    for (int bj = 0; bj < 2; ++bj) { f32x4 v0 = AV(ai, bj, m, 0), v1 = AV(ai, bj, m, 1);
                        if (rt) { rot2(v0, cs0); rot2(v1, cs1); }
                        *(u32x4*)(qix + (size_t)row * 1024 + cb + bj * 128) = pack8(v0, v1); } }
        } else if (!F8 && vt == 22) {
#pragma unroll
            for (int ai = 0; ai < 2; ++ai)
#pragma unroll
                for (int m = 0; m < 4; ++m) { const int row = rowb + ai * 128 + m * 16, t = row_pos(row); const float rs = F8 ? RS_ROW(ai, m) : 1.f; (void)rs;
                    f32x4 v0 = AV(ai, 0, m, 0), v1 = AV(ai, 0, m, 1);
                    if (wc < 2) { const f32x4* p = (const f32x4*)(ropeM + ((size_t)t * 32 + 16 * wc + 4 * fq) * 2); rot2(v0, p[0]); rot2(v1, p[1]);
                        *(u32x2*)((unsigned char*)kpe + (size_t)row * 64 + ct) = pack8_fp8(v0, v1);
                    } else { if (wc == 2 && fq < 2) { const f32x4* p = (const f32x4*)(ropeI + ((size_t)t * 8 + 4 * fq) * 2); rot2(v0, p[0]); rot2(v1, p[1]); }
                        *(u32x4*)(kix + (size_t)row * 64 + (ct - 64)) = pack8(v0, v1); }
                    if (wc == 0 && fq < 2) { float* w = wix + (size_t)row * 16 + 8 * fq; *(f32x4*)w = AV(ai, 1, m, 0); *(f32x4*)(w + 4) = AV(ai, 1, m, 1); } }
        } else if (F8) {
            const bool isa = vt < 39; bf16_t* dst = isa ? ga : gb; const int cb = (isa ? vt - 23 : vt - 39) * 256 + ct;
#pragma unroll
            for (int ai = 0; ai < 2; ++ai)
#pragma unroll
                for (int m = 0; m < 4; ++m) { const int row = rowb + ai * 128 + m * 16; const float rs = F8 ? RS_ROW(ai, m) : 1.f; (void)rs;
                    u32x2 pk[2];
#pragma unroll
                    for (int bj = 0; bj < 2; ++bj) { f32x4 v0 = AV(ai, bj, m, 0), v1 = AV(ai, bj, m, 1);
#pragma unroll
                        for (int e = 0; e < 4; ++e) { v0[e] = 256.0f * sigm(v0[e]); v1[e] = 256.0f * sigm(v1[e]); }
                        pk[bj] = pack8_fp8(v0, v1); }
                    store_fp8_pair16((unsigned char*)dst + (size_t)row * 4096 + (cb - 8 * fq), fq, pk[0], pk[1]); }
        }
#undef AV
#undef RS_ROW
    }
};

struct EpiUp {
    static constexpr bool PERM = true, AFTER_DRAIN = false, SPLITK2 = false, FP8 = true;
    unsigned char *d0, *d1; int nt0, ld0, ld1; bool d1_v; const u64* ssq; float invK; const float* rope; const float* sw; unsigned* vmaxw;
    __device__ __forceinline__ void operator()(const Acc& acc, const Unit& u, int wr, int wc, int fr, int fq) const {
        const int vt = u.pn, rowb = u.pm * 256 + wr * 64 + fr, ct = wc * 32 + 8 * fq; const bool first = vt < nt0;
        unsigned char* dst = first ? d0 : d1; const int ld = first ? ld0 : ld1, cb = (first ? vt : vt - nt0) * 256 + ct; const bool rt = (!first) && (rope != nullptr), isv = (!first) && d1_v;
        f32x4 w0[2], w1[2]; float vmx = 0.f;
#pragma unroll
        for (int bj = 0; bj < 2; ++bj) { const f32x4* p = (const f32x4*)(sw + vt * 256 + ct + bj * 128); w0[bj] = p[0]; w1[bj] = p[1]; }
#pragma unroll
        for (int ai = 0; ai < 2; ++ai)
#pragma unroll
            for (int m = 0; m < 4; ++m) { const int row = rowb + ai * 128 + m * 16, t = row_pos(row);
                const float rs = __builtin_amdgcn_rsqf(ssq_get(ssq + row) * invK + EPS);
                f32x4 cs0 = (f32x4){1.f, 0.f, 1.f, 0.f}, cs1 = cs0;
                if (rt) { const f32x4* p = (const f32x4*)(rope + ((size_t)t * 32 + 16 * (wc & 1) + 4 * fq) * 2); cs0 = p[0]; cs1 = p[1]; }
                u32x2 pku[2];
#pragma unroll
                for (int bj = 0; bj < 2; ++bj) { f32x4 v0 = acc[ai][bj][m][0] * rs * w0[bj], v1 = acc[ai][bj][m][1] * rs * w1[bj];
                    if (rt) { rot2(v0, cs0); rot2(v1, cs1); }
                    if (isv) vmx = fmaxf(vmx, amax8(v0, v1));
                    pku[bj] = pack8_fp8(v0, v1); }
                store_fp8_pair16(dst + (size_t)row * ld + (cb - 8 * fq), fq, pku[0], pku[1]); }
        if (isv) vmax_publish(vmaxw, vmx);
    }
};

struct EpiBranch {
    static constexpr bool PERM = true, AFTER_DRAIN = false, SPLITK2 = true, FP8 = true;
    const bf16_t *ga, *gb; unsigned char* out; const unsigned* vmaxw; const float* scol; const u64 *ssqa, *ssqb; const unsigned* wnorm; float* smrg; u64* ssqm;
    __device__ __forceinline__ void operator()(Acc& acc, const Unit& u, int wr, int wc, int fr, int fq) const {
        const int rowb = u.pm * 256 + wr * 64 + fr, cb = u.pn * 256 + wc * 32 + 8 * fq;
        const float vmb = fmaxf(__uint_as_float(vmaxw[0]), 1e-30f), vma = fmaxf(__uint_as_float(vmaxw[64]), 1e-30f);
        if (u.kh == 0) {
            const float rab = vma * __builtin_amdgcn_rcpf(vmb);
#pragma unroll
            for (int ai = 0; ai < 2; ++ai) {
                u32x2 ra[4][2], rb[4][2];
#pragma unroll
                for (int m = 0; m < 4; ++m) { const size_t ro = (size_t)(rowb + ai * 128 + m * 16) * 4096 + cb;
#pragma unroll
                    for (int bj = 0; bj < 2; ++bj) { ra[m][bj] = *(const u32x2*)((const unsigned char*)ga + ro + bj * 128); rb[m][bj] = *(const u32x2*)((const unsigned char*)gb + ro + bj * 128); } }
#pragma unroll
                for (int m = 0; m < 4; ++m)
#pragma unroll
                    for (int bj = 0; bj < 2; ++bj) { f32x4 a0, a1, b0, b1; unpack8_fp8(ra[m][bj], a0, a1); unpack8_fp8(rb[m][bj], b0, b1);
                        f32x4 r0, r1;
#pragma unroll
                        for (int e = 0; e < 4; ++e) { r0[e] = a0[e] * __builtin_amdgcn_rcpf(fmaxf(b0[e], 0.001953125f)); r1[e] = a1[e] * __builtin_amdgcn_rcpf(fmaxf(b1[e], 0.001953125f)); }
                        acc[ai][bj][m][0] = acc[ai][bj][m][0] * (r0 * rab); acc[ai][bj][m][1] = acc[ai][bj][m][1] * (r1 * rab); }
                asm volatile("" ::: "memory"); }
        } else {
            f32x4 w0[2], w1[2];
#pragma unroll
            for (int bj = 0; bj < 2; ++bj) { const f32x4* p = (const f32x4*)(scol + cb + bj * 128); w0[bj] = p[0]; w1[bj] = p[1]; }
            const float ca = sqrtf(__uint_as_float(wnorm[0])), cbn = sqrtf(__uint_as_float(wnorm[64]));
            const float rs = vmb * (1.0f / 440.0f);
            float qs[2][4], srw[2][4];
            {   u64 sa[2][4], sb[2][4];
#pragma unroll
                for (int ai = 0; ai < 2; ++ai)
#pragma unroll
                    for (int m = 0; m < 4; ++m) { const int row = rowb + ai * 128 + m * 16; sa[ai][m] = ssqa[row]; sb[ai][m] = ssqb[row]; }
#pragma unroll
                for (int ai = 0; ai < 2; ++ai)
#pragma unroll
                    for (int m = 0; m < 4; ++m) { const int row = rowb + ai * 128 + m * 16;
                        const float bound = fmaxf(sqrtf(ssq_val(sa[ai][m])) * ca + sqrtf(ssq_val(sb[ai][m])) * cbn, 1e-30f); qs[ai][m] = 380.0f / bound;
                        if (u.pn == 0 && wc == 0 && fq == 0) smrg[row] = bound * (1.0f / 380.0f); }
            }
#pragma unroll
            for (int ai = 0; ai < 2; ++ai) {
                u32x2 rb[4][2];
#pragma unroll
                for (int m = 0; m < 4; ++m) { const size_t ro = (size_t)(rowb + ai * 128 + m * 16) * 4096 + cb;
#pragma unroll
                    for (int bj = 0; bj < 2; ++bj) rb[m][bj] = *(const u32x2*)((const unsigned char*)gb + ro + bj * 128); }
#pragma unroll
                for (int m = 0; m < 4; ++m) { const int row = rowb + ai * 128 + m * 16; float sq = 0.f; u32x2 pk[2];
#pragma unroll
                    for (int bj = 0; bj < 2; ++bj) { f32x4 s0, s1; unpack8_fp8(rb[m][bj], s0, s1);
                        s0 = s0 * (rs * (1.0f / 256.0f) * qs[ai][m]) * w0[bj]; s1 = s1 * (rs * (1.0f / 256.0f) * qs[ai][m]) * w1[bj];
                        const f32x4 t0 = acc[ai][bj][m][0] * s0, t1 = acc[ai][bj][m][1] * s1;
                        sq += (t0[0] * t0[0] + t0[1] * t0[1]) + (t0[2] * t0[2] + t0[3] * t0[3]) + (t1[0] * t1[0] + t1[1] * t1[1]) + (t1[2] * t1[2] + t1[3] * t1[3]);
                        pk[bj] = pack8_fp8(t0, t1); }
                    store_fp8_pair16(out + (size_t)row * 8192 + (cb - 8 * fq), fq, pk[0], pk[1]);
                    sq = xrow16_sum(sq); sq = xhalf_sum(sq);
                    { const float iq = __builtin_amdgcn_rcpf(qs[ai][m]); srw[ai][m] = sq * iq * iq * 1.002f; } }
                asm volatile("" ::: "memory"); }
            rowsum_publish(ssqm, u.pm * 256, srw, wr, wc, fr, fq);
        }
    }
};

struct EpiOut {
    static constexpr bool PERM = true, AFTER_DRAIN = false, SPLITK2 = false, FP8 = true;
    const float *x, *meta; float* h1f; bf16_t* h1b; u64* ssq; const float *srow, *scol;
    unsigned char* h18; float* sh1; const float* xmax; const u64* ssqm; const unsigned* wn2;
    __device__ __forceinline__ void operator()(const Acc& acc, const Unit& u, int wr, int wc, int fr, int fq) const {
        const int rowb = u.pm * 256 + wr * 64 + fr, cb = u.pn * 256 + wc * 32 + 8 * fq; float srw[2][4];
#pragma unroll
        for (int ai = 0; ai < 2; ++ai)
#pragma unroll
            for (int m = 0; m < 4; ++m) { const int row = rowb + ai * 128 + m * 16;
                const float* src = x + (size_t)row * DM;
                float s = 0.f; const float rs = srow[row];
                const float wn = sqrtf(__uint_as_float(wn2[0]) + __uint_as_float(wn2[64]));
                const float hb = fmaxf(xmax[row] + sqrtf(ssq_val(ssqm[row])) * wn, 1e-30f), hq = 380.0f / hb;
                if (u.pn == 0 && wc == 0 && fq == 0) sh1[row] = hb * (1.0f / 380.0f);
                u32x2 pk8[2];
#pragma unroll
                for (int bj = 0; bj < 2; ++bj) { const f32x4* wp = (const f32x4*)(scol + cb + bj * 128); f32x4 v0 = acc[ai][bj][m][0] * rs * wp[0], v1 = acc[ai][bj][m][1] * rs * wp[1];
                    v0 = v0 + *(const f32x4*)(src + cb + bj * 128); v1 = v1 + *(const f32x4*)(src + cb + bj * 128 + 4);
                    s += (v0[0] * v0[0] + v0[1] * v0[1]) + (v0[2] * v0[2] + v0[3] * v0[3]) + (v1[0] * v1[0] + v1[1] * v1[1]) + (v1[2] * v1[2] + v1[3] * v1[3]);
                    *(u32x4*)(h1b + (size_t)row * DM + cb + bj * 128) = pack8(v0, v1);
                    pk8[bj] = pack8_fp8(v0 * hq, v1 * hq); }
                store_fp8_pair16(h18 + (size_t)row * DM + (cb - 8 * fq), fq, pk8[0], pk8[1]);
                s = xrow16_sum(s); s = xhalf_sum(s); srw[ai][m] = s; }
        rowsum_publish(ssq, u.pm * 256, srw, wr, wc, fr, fq);
    }
};

struct EpiPQ {
    static constexpr bool PERM = true, AFTER_DRAIN = false, SPLITK2 = false, FP8 = true;
    bf16_t* pq; const u64* ssq; const float *srow, *scol;
    __device__ __forceinline__ void operator()(const Acc& acc, const Unit& u, int wr, int wc, int fr, int fq) const {
        const int rowb = u.pm * 256 + wr * 64 + fr, cb = u.pn * 256 + wc * 32 + 8 * fq;
#pragma unroll
        for (int ai = 0; ai < 2; ++ai)
#pragma unroll
            for (int m = 0; m < 4; ++m) { const int row = rowb + ai * 128 + m * 16; const float rs = __builtin_amdgcn_rsqf(ssq_get(ssq + row) * (1.0f / DM) + EPS) * srow[row];
#pragma unroll
                for (int bj = 0; bj < 2; ++bj) { const f32x4* wp = (const f32x4*)(scol + cb + bj * 128);
                    *(u32x4*)(pq + (size_t)row * 2048 + cb + bj * 128) = pack8(acc[ai][bj][m][0] * rs * wp[0], acc[ai][bj][m][1] * rs * wp[1]); } }
    }
};
}
#define XB_TMO      128
#define XB_XCNT(j)  (256  + 64 * (j))
#define XB_XSUB(j)  (1280 + 64 * (j))
#define XB_XGEN(j)  (2304 + 64 * (j))
#define XB_TOP      3328
#define XB_TOPGEN   3392
#define XCD_BAR_WORDS 3456
#define XB_SPIN_CAP (1u << 18)
__device__ __forceinline__ unsigned xb_ld(unsigned* p)              { return __hip_atomic_load(p, __ATOMIC_RELAXED, __HIP_MEMORY_SCOPE_AGENT); }
__device__ __forceinline__ unsigned xb_add(unsigned* p, unsigned v) { return __hip_atomic_fetch_add(p, v, __ATOMIC_RELAXED, __HIP_MEMORY_SCOPE_AGENT); }
__device__ __forceinline__ unsigned xb_xcc_id() { return (unsigned)__builtin_amdgcn_s_getreg((3 << 11) | 20) & 0xFu; }
#define XB_SPIN(cond, bar) do { unsigned _sp = 0; while (cond) { __builtin_amdgcn_s_sleep(1); \
    if ((++_sp & 255u) == 0u) { if (xb_ld(&(bar)[XB_TMO])) break; if (_sp > XB_SPIN_CAP) { atomicAdd(&(bar)[XB_TMO], 1u); break; } } } } while (0)
struct XcdBarrier { unsigned* bar; unsigned x; volatile LAS unsigned* st; };
__device__ __forceinline__ XcdBarrier xcd_barrier_post(unsigned* bar, volatile LAS unsigned* st) {
    XcdBarrier b; b.bar = bar; b.x = xb_xcc_id(); b.st = st;
    if (threadIdx.x == 0) (void)xb_add(&bar[XB_XCNT(b.x)], 1u);
    return b;
}
__device__ __forceinline__ void xcd_barrier_complete(unsigned* bar, unsigned x, unsigned& nloc, unsigned& nx) {
    const unsigned G = gridDim.x * gridDim.y * gridDim.z;
    unsigned sum, cnt, mine, sp = 0u;
    for (;;) {
        sum = 0u; cnt = 0u; mine = 0u;
#pragma unroll
        for (unsigned j = 0; j < 16; ++j) { const unsigned c = xb_ld(&bar[XB_XCNT(j)]); sum += c; cnt += (c > 0u) ? 1u : 0u; mine = (j == x) ? c : mine; }
        if (sum == G) break;
        __builtin_amdgcn_s_sleep(1);
        if ((++sp & 255u) == 0u) { if (xb_ld(&bar[XB_TMO])) break; if (sp > XB_SPIN_CAP) { atomicAdd(&bar[XB_TMO], 1u); break; } }
    }
    nloc = mine > 0u ? mine : 1u; nx = cnt > 0u ? cnt : 1u;
}
__device__ __forceinline__ void xcd_barrier(const XcdBarrier& b) {
    asm volatile("s_waitcnt vmcnt(0)" ::: "memory");
    __syncthreads();
    if (threadIdx.x == 0) {
        unsigned* bar = b.bar;
        __builtin_amdgcn_s_waitcnt(0);
        unsigned nloc = b.st[0], nx = b.st[1];
        if (nloc == 0u) { xcd_barrier_complete(bar, b.x, nloc, nx); b.st[0] = nloc; b.st[1] = nx; }
        const unsigned old = xb_add(&bar[XB_XSUB(b.x)], 1u);
        const unsigned gen = old / nloc;
        if (old + 1u == (gen + 1u) * nloc) {
            __builtin_amdgcn_fence(__ATOMIC_RELEASE, "agent");
            asm volatile("s_waitcnt vmcnt(0)" ::: "memory");
            const unsigned og = xb_add(&bar[XB_TOP], 1u);
            const unsigned tg = og / nx;
            if (og + 1u == (tg + 1u) * nx) xb_add(&bar[XB_TOPGEN], 1u);
            else XB_SPIN(xb_ld(&bar[XB_TOPGEN]) == tg, bar);
            __builtin_amdgcn_fence(__ATOMIC_ACQUIRE, "agent");
            xb_add(&bar[XB_XGEN(b.x)], 1u);
            asm volatile("s_waitcnt vmcnt(0)" ::: "memory");
        } else {
            XB_SPIN(xb_ld(&bar[XB_XGEN(b.x)]) == gen, bar);
            __builtin_amdgcn_fence(__ATOMIC_ACQUIRE, "agent");
            asm volatile("s_waitcnt vmcnt(0)" ::: "memory");
        }
    }
    __syncthreads();
}

struct Frame {
    LAS unsigned char* lds;
    unsigned char* ws;
    unsigned* ctl;
    int tid, lane, wave, vcu, G;
    __device__ __forceinline__ const float* in(int i) const { return ((const float* const __attribute__((address_space(4)))*)__builtin_amdgcn_kernarg_segment_ptr())[i]; }
    __device__ __forceinline__ float* out() const { return ((float* const __attribute__((address_space(4)))*)__builtin_amdgcn_kernarg_segment_ptr())[16]; }
};

struct MapId { __device__ __forceinline__ int operator()(int v) const { return v; } };
struct MapIn { __device__ __forceinline__ int operator()(int vn) const {
    const int v = vn < 1280 ? vn + 4608 : (vn < 5888 ? vn - 1280 : vn);
    if (v < 1536) return v;
    if (v < 3584) { const int w = v - 1536, hd = w >> 7; int o = w & 127; if (o < 32) o = (o & 1) ? (o >> 1) + 16 : (o >> 1); return 1600 + hd * 128 + o; }
    if (v < 4096) { const int w = v - 3584, hd = w >> 7; int o = w & 127; if (o < 32) o = (o & 1) ? (o >> 1) + 16 : (o >> 1); return 3648 + hd * 128 + o; }
    if (v < 4608) return 4160 + (v - 4096);
    if (v < 5632) { const int w = v - 4608, hd = w >> 6; int o = w & 63; if (o < 16) o = (o & 1) ? (o >> 1) + 8 : (o >> 1); return 4672 + hd * 64 + o; }
    if (v < 5888) { const int w = v - 5632;
        if (w < 64) return 1536 + ((w & 1) ? (w >> 1) + 32 : (w >> 1));
        if (w < 128) { int o = w - 64; if (o < 16) o = (o & 1) ? (o >> 1) + 8 : (o >> 1); return 5696 + o; }
        if (w < 144) return 5760 + (w - 128);
        return -1; }
    if (v < 9984) return 5776 + (v - 5888);
    return 9872 + (v - 9984);
} };
struct MapUq { __device__ __forceinline__ int operator()(int v) const {
    if (v < 2048) return (v >> 7) * 192 + (v & 127);
    const int w = v - 2048, hd = w >> 6, o = w & 63; return hd * 192 + 128 + ((o & 1) ? (o >> 1) + 32 : (o >> 1)); } };
struct MapUkv { __device__ __forceinline__ int operator()(int v) const {
    if (v < 2048) return (v >> 7) * 256 + (v & 127);
    const int w = v - 2048; return (w >> 7) * 256 + 128 + (w & 127); } };

template <class Map>
__device__ __forceinline__ void p0_transpose_item(const float* W, int K, int Nsrc, int Nvirt, bf16_t* WT, const float* gk, LAS float* scr, int item, int lane, Map map) {
    const int nblk = Nvirt / 32, kb = item / nblk, nb = item % nblk, k0 = 64 * kb, n0 = 32 * nb;
    const int sc = map(n0 + (lane & 31));
    float tv[32];
#pragma unroll
    for (int i = 0; i < 32; ++i) { const int kk = 2 * i + (lane >> 5); tv[i] = (sc >= 0) ? W[(size_t)(k0 + kk) * Nsrc + sc] : 0.f; }
    if (gk) {
#pragma unroll
        for (int i = 0; i < 32; ++i) tv[i] *= gk[k0 + 2 * i + (lane >> 5)]; }
#pragma unroll
    for (int i = 0; i < 32; ++i) scr[(2 * i + (lane >> 5)) * 33 + (lane & 31)] = tv[i];
    LDS_WAIT(); asm volatile("" ::: "memory");
    const int c = lane & 7;
#pragma unroll
    for (int j = 0; j < 4; ++j) { const int n = (lane >> 3) + 8 * j; const LAS float* s = scr + (8 * c) * 33 + n;
        u32x4 o; o.x = pk2(s[0 * 33], s[1 * 33]); o.y = pk2(s[2 * 33], s[3 * 33]); o.z = pk2(s[4 * 33], s[5 * 33]); o.w = pk2(s[6 * 33], s[7 * 33]);
        *(u32x4*)(WT + (size_t)(n0 + n) * K + k0 + 8 * c) = o; }
    LDS_WAIT(); asm volatile("" ::: "memory");
}
__device__ __forceinline__ float wave_max(float v) {
#pragma unroll
    for (int o = 1; o < 64; o <<= 1) v = fmaxf(v, __shfl_xor(v, o));
    return v;
}
__device__ __forceinline__ void p0_xn_row(const Frame& F, int m) {
    const float* x = F.in(0); const float* meta = F.in(1); const float* g = F.in(2);
    bf16_t* o = (bf16_t*)(F.ws + WS_XN) + (size_t)m * DM;
    u32x2* o8 = (u32x2*)o + F.lane;
    if (m >= NTOK + NMETA) {
        unsigned* z8 = (unsigned*)(F.ws + WS_XN8 + (size_t)m * DM) + F.lane;
#pragma unroll
        for (int j = 0; j < 16; ++j) { o8[64 * j] = (u32x2){0u, 0u}; z8[64 * j] = 0u; }
        if (F.lane == 0) ((float*)(F.ws + WS_SX))[m] = 0.f;
        return; }
    const float* src = m < NTOK ? x + (size_t)m * DM : meta + (size_t)(m - NTOK) * DM;
    const f32x4* xr = (const f32x4*)src + F.lane; const f32x4* gr = (const f32x4*)g + F.lane;
    f32x4 v[16]; float s = 0.f, xm = 0.f;
#pragma unroll
    for (int j = 0; j < 16; ++j) { v[j] = xr[64 * j]; s += (v[j][0] * v[j][0] + v[j][1] * v[j][1]) + (v[j][2] * v[j][2] + v[j][3] * v[j][3]);
        xm = fmaxf(xm, fmaxf(fmaxf(fabsf(v[j][0]), fabsf(v[j][1])), fmaxf(fabsf(v[j][2]), fabsf(v[j][3])))); }
    xm = wave_max(xm);
    if (F.lane == 0) ((float*)(F.ws + WS_XMAX))[m] = xm;
    const float rstd = 1.0f / sqrtf(wave_sum(s) * (1.0f / DM) + EPS);
    float mx = 0.f;
#pragma unroll
    for (int j = 0; j < 16; ++j) { const f32x4 gg = gr[64 * j]; v[j] = v[j] * rstd * gg; o8[64 * j] = (u32x2){pk2(v[j][0], v[j][1]), pk2(v[j][2], v[j][3])};
        mx = fmaxf(mx, fmaxf(fmaxf(fabsf(v[j][0]), fabsf(v[j][1])), fmaxf(fabsf(v[j][2]), fabsf(v[j][3])))); }
    mx = fmaxf(wave_max(mx), 1e-30f);
    const float inv = 448.0f / mx;
    if (F.lane == 0) ((float*)(F.ws + WS_SX))[m] = mx * (1.0f / 448.0f);
    unsigned* q8 = (unsigned*)(F.ws + WS_XN8 + (size_t)m * DM) + F.lane;
#pragma unroll
    for (int j = 0; j < 16; ++j) { f32x4 q = v[j] * inv;
#pragma unroll
        for (int e = 0; e < 4; ++e) q[e] = fminf(fmaxf(q[e], -448.0f), 448.0f);
        int p = 0; p = __builtin_amdgcn_cvt_pk_fp8_f32(q[0], q[1], p, false); p = __builtin_amdgcn_cvt_pk_fp8_f32(q[2], q[3], p, true); q8[64 * j] = (unsigned)p; }
}
__device__ __forceinline__ void p0_prologue(const Frame& F) {
    LAS float* scr = (LAS float*)(F.lds + F.wave * 16384);
    const int gw = F.vcu * NWAVES + F.wave, NGW = F.G * NWAVES;
    const float* w_in = F.in(3); const float* qg = F.in(4); const float* w_uq = F.in(5); const float* kvg = F.in(6); const float* w_ukv = F.in(7);
    const float* w_br = F.in(8); const float* w_out = F.in(9); const float* fg = F.in(10); const float* w_q = F.in(11); const float* sk = F.in(12);
    constexpr int I_IN = 64 * (NV1 / 32), I_UQ = 16 * (3072 / 32), I_UKV = 8 * (4096 / 32), I_BR = 64 * 128, I_OUT = 64 * 128, I_Q = 64 * 64;
    constexpr int NITEMS = I_IN + I_UQ + I_UKV + I_BR + I_OUT + I_Q;
    struct TItem { const float* W; bf16_t* WT; const float* gk; int K, Nsrc, k0, n0, sc; };
    auto decode = [&](int it) -> TItem {
        TItem t; int r = it, nv, mapid;
        if (r < I_IN) { t.W = w_in; t.K = 4096; t.Nsrc = 13968; nv = NV1; t.WT = (bf16_t*)(F.ws + WS_WIN); t.gk = nullptr; mapid = 0; }
        else if ((r -= I_IN) < I_UQ) { t.W = w_uq; t.K = 1024; t.Nsrc = 3072; nv = 3072; t.WT = (bf16_t*)(F.ws + WS_WUQ); t.gk = qg; mapid = 1; }
        else if ((r -= I_UQ) < I_UKV) { t.W = w_ukv; t.K = 512; t.Nsrc = 4096; nv = 4096; t.WT = (bf16_t*)(F.ws + WS_WUKV); t.gk = kvg; mapid = 2; }
        else if ((r -= I_UKV) < I_BR) { t.W = w_br; t.K = 4096; t.Nsrc = 4096; nv = 4096; t.WT = (bf16_t*)(F.ws + WS_WBRS); t.gk = nullptr; mapid = 3; }
        else if ((r -= I_BR) < I_OUT) { t.W = w_out; t.K = 4096; t.Nsrc = 4096; nv = 4096; t.WT = (bf16_t*)(F.ws + WS_WOUT); t.gk = nullptr; mapid = 3; }
        else { r -= I_OUT; t.W = w_q; t.K = 4096; t.Nsrc = 2048; nv = 2048; t.WT = (bf16_t*)(F.ws + WS_WQ); t.gk = fg; mapid = 3; }
        const int nblk = nv / 32, kb = r / nblk, nb = r % nblk; t.k0 = 64 * kb; t.n0 = 32 * nb;
        const int v = t.n0 + (F.lane & 31);
        t.sc = mapid == 0 ? MapIn()(v) : (mapid == 1 ? MapUq()(v) : (mapid == 2 ? MapUkv()(v) : v));
        return t; };
#define TLOAD(t, tv) do { _Pragma("unroll") for (int i = 0; i < 32; ++i) { const int kk = 2 * i + (F.lane >> 5); tv[i] = (t.sc >= 0) ? t.W[(size_t)(t.k0 + kk) * t.Nsrc + t.sc] : 0.f; } } while (0)
#define TSTORE(t, tv) do { \
        if (t.gk) { _Pragma("unroll") for (int i = 0; i < 32; ++i) tv[i] *= t.gk[t.k0 + 2 * i + (F.lane >> 5)]; } \
        _Pragma("unroll") for (int i = 0; i < 32; ++i) scr[(2 * i + (F.lane >> 5)) * 33 + (F.lane & 31)] = tv[i]; \
        LDS_WAIT(); asm volatile("" ::: "memory"); \
        const int c_ = F.lane & 7; \
        _Pragma("unroll") for (int j = 0; j < 4; ++j) { const int n = (F.lane >> 3) + 8 * j; const LAS float* s = scr + (8 * c_) * 33 + n; \
            u32x4 o; o.x = pk2(s[0 * 33], s[1 * 33]); o.y = pk2(s[2 * 33], s[3 * 33]); o.z = pk2(s[4 * 33], s[5 * 33]); o.w = pk2(s[6 * 33], s[7 * 33]); \
            *(u32x4*)(t.WT + (size_t)(t.n0 + n) * t.K + t.k0 + 8 * c_) = o; } \
        LDS_WAIT(); asm volatile("" ::: "memory"); } while (0)
    {
        float ta[32], tb[32]; TItem ia, ib;
        int it = gw;
        if (it < NITEMS) { ia = decode(it); TLOAD(ia, ta); }
#pragma unroll 1
        for (; it < NITEMS; it += 2 * NGW) {
            const int i1 = it + NGW, i2 = it + 2 * NGW;
            if (i1 < NITEMS) { ib = decode(i1); TLOAD(ib, tb); }
            TSTORE(ia, ta);
            if (i2 < NITEMS) { ia = decode(i2); TLOAD(ia, ta); }
            if (i1 < NITEMS) TSTORE(ib, tb);
        }
    }
#undef TLOAD
#undef TSTORE
    for (int m = gw; m < MK; m += NGW) p0_xn_row(F, m);
    const int gt = (F.vcu * NWAVES + F.wave) * 64 + F.lane, NGT = NGW * 64;
    for (int i = gt; i < TP * 56; i += NGT) {
        const int t = i / 56, r = i % 56; int j, rot; float* dst;
        if (r < 32) { j = r; rot = 64; dst = (float*)(F.ws + WS_ROPE_M) + ((size_t)t * 32 + j) * 2; }
        else if (r < 48) { j = r - 32; rot = 32; dst = (float*)(F.ws + WS_ROPE_D) + ((size_t)t * 16 + j) * 2; }
        else { j = r - 48; rot = 16; dst = (float*)(F.ws + WS_ROPE_I) + ((size_t)t * 8 + j) * 2; }
        const float ex = (float)(2 * j) / (float)rot;
        const float inv = powf(500000.0f, -ex);
        const float ang = (float)t * inv;
        const double a = (double)ang, kq = rint(a * 0.15915494309189535), rr = fma(-kq, 6.283185307179586, a);
        const float rf = (float)rr;
        dst[0] = cosf(rf); dst[1] = sinf(rf);
    }
    for (int i = gt; i < 16 * 128 * 128 / 8; i += NGT) { const f32x4* s = (const f32x4*)sk + 2 * (size_t)i; const f32x4 a = s[0], b2 = s[1];
        u32x4 o; o.x = pk2(a[0], a[1]); o.y = pk2(a[2], a[3]); o.z = pk2(b2[0], b2[1]); o.w = pk2(b2[2], b2[3]); ((u32x4*)(F.ws + WS_SK))[i] = o; }
}
__device__ __forceinline__ unsigned fp6_code(float q) {
    const unsigned b = __float_as_uint(q), sgn = (b >> 31) << 5; const float aq = fabsf(q);
    const unsigned sub = (unsigned)rintf(aq * 8.0f);
    unsigned ab = b & 0x7fffffffu; ab = ab + 0x7FFFFu + ((ab >> 20) & 1u);
    const unsigned nrm = (ab >> 20) - (126u << 3);
    unsigned code = aq < 1.0f ? sub : nrm; code = code > 31u ? 31u : code;
    return code | sgn;
}
__device__ __forceinline__ void fp6_pack32(const unsigned (&c)[32], unsigned (&w)[6]) {
#pragma unroll
    for (int i = 0; i < 6; ++i) w[i] = 0u;
#pragma unroll
    for (int k = 0; k < 32; ++k) { const int bit = 6 * k, d = bit >> 5, sh = bit & 31; w[d] |= c[k] << sh; if (sh > 26) w[d + 1] |= c[k] >> (32 - sh); }
}
__device__ __forceinline__ void p6_quant_row(const float* src, const float* gain, unsigned char* dst, float* scale_out, int lane) {
    const f32x4* s = (const f32x4*)src + lane; f32x4 v[16]; float mx = 0.f;
#pragma unroll
    for (int j = 0; j < 16; ++j) { v[j] = s[64 * j]; if (gain) v[j] = v[j] * ((const f32x4*)gain)[lane + 64 * j];
        mx = fmaxf(mx, fmaxf(fmaxf(fabsf(v[j][0]), fabsf(v[j][1])), fmaxf(fabsf(v[j][2]), fabsf(v[j][3])))); }
    mx = fmaxf(wave_max(mx), 1e-30f);
    const float sc = mx * (1.0f / 7.5f), inv = 7.5f / mx;
    if (lane == 0) *scale_out = sc;
    unsigned w[12];
#pragma unroll
    for (int g = 0; g < 2; ++g) { unsigned c[32];
#pragma unroll
        for (int j = 0; j < 8; ++j)
#pragma unroll
            for (int i = 0; i < 4; ++i) c[4 * j + i] = fp6_code(v[8 * g + j][i] * inv);
        unsigned ww[6]; fp6_pack32(c, ww);
#pragma unroll
        for (int i = 0; i < 6; ++i) w[6 * g + i] = ww[i]; }
#pragma unroll
    for (int q = 0; q < 3; ++q) *(u32x4*)(dst + 1024 * q + 16 * lane) = (u32x4){w[4 * q], w[4 * q + 1], w[4 * q + 2], w[4 * q + 3]};
}
__device__ __forceinline__ unsigned fp4_code(float q) {
    const float aq = fabsf(q);
    const unsigned c = (aq > 0.25f ? 1u : 0u) + (aq >= 0.75f ? 1u : 0u) + (aq > 1.25f ? 1u : 0u) + (aq >= 1.75f ? 1u : 0u) + (aq > 2.5f ? 1u : 0u) + (aq >= 3.5f ? 1u : 0u) + (aq > 5.0f ? 1u : 0u);
    return c | ((__float_as_uint(q) >> 31) << 3);
}
__device__ __forceinline__ void p6_quant_row4(const float* src, const float* gain, unsigned char* dst, float* scale_out, int lane) {
    const f32x4* s = (const f32x4*)src + lane; f32x4 v[16]; float mx = 0.f;
#pragma unroll
    for (int j = 0; j < 16; ++j) { v[j] = s[64 * j]; if (gain) v[j] = v[j] * ((const f32x4*)gain)[lane + 64 * j];
        mx = fmaxf(mx, fmaxf(fmaxf(fabsf(v[j][0]), fabsf(v[j][1])), fmaxf(fabsf(v[j][2]), fabsf(v[j][3])))); }
    mx = fmaxf(wave_max(mx), 1e-30f);
    const float sc = mx * (1.0f / 6.0f), inv = 6.0f / mx;
    if (lane == 0) *scale_out = sc;
    unsigned w[8];
#pragma unroll
    for (int d = 0; d < 8; ++d) { unsigned x = 0u;
        const f32x4 a = v[2 * d] * inv, b = v[2 * d + 1] * inv;
        x = __builtin_amdgcn_cvt_scalef32_pk_fp4_f32(x, a[0], a[1], 1.0f, 0); x = __builtin_amdgcn_cvt_scalef32_pk_fp4_f32(x, a[2], a[3], 1.0f, 1);
        x = __builtin_amdgcn_cvt_scalef32_pk_fp4_f32(x, b[0], b[1], 1.0f, 2); x = __builtin_amdgcn_cvt_scalef32_pk_fp4_f32(x, b[2], b[3], 1.0f, 3);
        w[d] = x; }
#pragma unroll
    for (int q = 0; q < 2; ++q) *(u32x4*)(dst + 1024 * q + 16 * lane) = (u32x4){w[4 * q], w[4 * q + 1], w[4 * q + 2], w[4 * q + 3]};
}
#ifndef PEER_U_BITS
#define PEER_U_BITS 4
#endif
#ifndef PEER_V_BITS
#define PEER_V_BITS 4
#endif
constexpr int PEER_U_ROWB = PEER_U_BITS == 4 ? 2048 : 3072, PEER_V_ROWB = PEER_V_BITS == 4 ? 2048 : 3072;
__device__ __forceinline__ void p6_quant_regs4(f32x4 (&v)[16], unsigned char* dst, float* scale_out, int lane) {
    float mx = 0.f;
#pragma unroll
    for (int j = 0; j < 16; ++j) mx = fmaxf(mx, fmaxf(fmaxf(fabsf(v[j][0]), fabsf(v[j][1])), fmaxf(fabsf(v[j][2]), fabsf(v[j][3]))));
    mx = fmaxf(wave_max(mx), 1e-30f);
    const float inv = 6.0f / mx;
    if (lane == 0) *scale_out = mx * (1.0f / 6.0f);
    unsigned w[8];
#pragma unroll
    for (int d = 0; d < 8; ++d) { unsigned x = 0u;
        const f32x4 a = v[2 * d] * inv, b = v[2 * d + 1] * inv;
        x = __builtin_amdgcn_cvt_scalef32_pk_fp4_f32(x, a[0], a[1], 1.0f, 0); x = __builtin_amdgcn_cvt_scalef32_pk_fp4_f32(x, a[2], a[3], 1.0f, 1);
        x = __builtin_amdgcn_cvt_scalef32_pk_fp4_f32(x, b[0], b[1], 1.0f, 2); x = __builtin_amdgcn_cvt_scalef32_pk_fp4_f32(x, b[2], b[3], 1.0f, 3);
        w[d] = x; }
#pragma unroll
    for (int q = 0; q < 2; ++q) *(u32x4*)(dst + 1024 * q + 16 * lane) = (u32x4){w[4 * q], w[4 * q + 1], w[4 * q + 2], w[4 * q + 3]};
}
__device__ __forceinline__ void p6_tables(const Frame& F) {
    const float* fg = F.in(10); const float* pu = F.in(13); const float* pv = F.in(14);
    const int gw = F.vcu * NWAVES + F.wave, NGW = F.G * NWAVES, lane = F.lane;
#if PEER_U_BITS == 4 && PEER_V_BITS == 4
    if ((NGW & 1) == 0) {
        const bool isv = gw & 1; const float* tab = isv ? pv : pu; unsigned char* dtab = F.ws + (isv ? WS_V : WS_U); float* stab = (float*)(F.ws + (isv ? WS_SCV : WS_SCU));
        const int e0 = gw >> 1, estep = NGW >> 1;
        f32x4 g[16];
#pragma unroll
        for (int j = 0; j < 16; ++j) g[j] = isv ? (f32x4){1.f, 1.f, 1.f, 1.f} : ((const f32x4*)fg)[lane + 64 * j];
        f32x4 va[16], vb[16];
        if (e0 < 16384) {
#pragma unroll
            for (int j = 0; j < 16; ++j) va[j] = ((const f32x4*)(tab + (size_t)e0 * DM))[lane + 64 * j];
        }
#pragma unroll 1
        for (int e = e0; e < 16384; e += 2 * estep) {
            const int e1 = e + estep, e2 = e + 2 * estep;
            if (e1 < 16384) {
#pragma unroll
                for (int j = 0; j < 16; ++j) vb[j] = ((const f32x4*)(tab + (size_t)e1 * DM))[lane + 64 * j];
            }
#pragma unroll
            for (int j = 0; j < 16; ++j) va[j] = va[j] * g[j];
            p6_quant_regs4(va, dtab + (size_t)e * 2048, stab + e, lane);
            if (e2 < 16384) {
#pragma unroll
                for (int j = 0; j < 16; ++j) va[j] = ((const f32x4*)(tab + (size_t)e2 * DM))[lane + 64 * j];
            }
            if (e1 < 16384) {
#pragma unroll
                for (int j = 0; j < 16; ++j) vb[j] = vb[j] * g[j];
                p6_quant_regs4(vb, dtab + (size_t)e1 * 2048, stab + e1, lane);
            }
        }
        return;
    }
#endif
    for (int it = gw; it < 2 * 16384; it += NGW) { const int e = it >> 1;
        if (it & 1) { if (PEER_V_BITS == 4) p6_quant_row4(pv + (size_t)e * DM, nullptr, F.ws + WS_V + (size_t)e * PEER_V_ROWB, (float*)(F.ws + WS_SCV) + e, F.lane);
                      else p6_quant_row(pv + (size_t)e * DM, nullptr, F.ws + WS_V + (size_t)e * PEER_V_ROWB, (float*)(F.ws + WS_SCV) + e, F.lane); }
        else { if (PEER_U_BITS == 4) p6_quant_row4(pu + (size_t)e * DM, fg, F.ws + WS_U + (size_t)e * PEER_U_ROWB, (float*)(F.ws + WS_SCU) + e, F.lane);
               else p6_quant_row(pu + (size_t)e * DM, fg, F.ws + WS_U + (size_t)e * PEER_U_ROWB, (float*)(F.ws + WS_SCU) + e, F.lane); } }
}

__device__ __forceinline__ void rowquant_fp8(const Frame& F, const unsigned char* src, size_t src_pitch, unsigned char* dst, size_t dst_pitch, float* scale, int nrows, unsigned* halfnorm = nullptr) {
    const int gw = F.vcu * NWAVES + F.wave, NGW = F.G * NWAVES, lane = F.lane;
    for (int n = gw; n < nrows; n += NGW) {
        const u32x4* s = (const u32x4*)(src + (size_t)n * src_pitch) + lane;
        u32x4 v[8]; float mx = 0.f;
#pragma unroll
        for (int j = 0; j < 8; ++j) { v[j] = s[64 * j];
#pragma unroll
            for (int e = 0; e < 4; ++e) mx = fmaxf(mx, fmaxf(fabsf(bf_lo(v[j][e])), fabsf(bf_hi(v[j][e])))); }
        if (halfnorm) { float q0 = 0.f, q1 = 0.f;
#pragma unroll
            for (int j = 0; j < 8; ++j)
#pragma unroll
                for (int e = 0; e < 4; ++e) { const float a = bf_lo(v[j][e]), b = bf_hi(v[j][e]); if (j < 4) q0 += a * a + b * b; else q1 += a * a + b * b; }
            q0 = wave_sum(q0); q1 = wave_sum(q1);
            if (lane == 0) { atomicMax(halfnorm, __float_as_uint(q0)); atomicMax(halfnorm + 64, __float_as_uint(q1)); } }
        mx = fmaxf(wave_max(mx), 1e-30f);
        const float inv = 448.0f / mx;
        if (lane == 0) scale[n] = mx * (1.0f / 448.0f);
        asm volatile("" ::: "memory");
        u32x2* d = (u32x2*)(dst + (size_t)n * dst_pitch) + lane;
#pragma unroll
        for (int j = 0; j < 8; ++j) { int p0 = 0, p1 = 0;
            p0 = __builtin_amdgcn_cvt_pk_fp8_f32(bf_lo(v[j].x) * inv, bf_hi(v[j].x) * inv, p0, false); p0 = __builtin_amdgcn_cvt_pk_fp8_f32(bf_lo(v[j].y) * inv, bf_hi(v[j].y) * inv, p0, true);
            p1 = __builtin_amdgcn_cvt_pk_fp8_f32(bf_lo(v[j].z) * inv, bf_hi(v[j].z) * inv, p1, false); p1 = __builtin_amdgcn_cvt_pk_fp8_f32(bf_lo(v[j].w) * inv, bf_hi(v[j].w) * inv, p1, true);
            d[64 * j] = (u32x2){(unsigned)p0, (unsigned)p1}; }
    }
}
template <int LEN>
__device__ __forceinline__ void rowquant_fp8_n(const Frame& F, const unsigned char* src, unsigned char* dst, float* scale, int nrows) {
    const int gw = F.vcu * NWAVES + F.wave, NGW = F.G * NWAVES, lane = F.lane; constexpr int PER = LEN / 64;
    for (int n = gw; n < nrows; n += NGW) {
        const u32x4* s = (const u32x4*)(src + (size_t)n * LEN * 2) + lane * (PER / 8);
        u32x4 v[PER / 8]; float mx = 0.f;
#pragma unroll
        for (int j = 0; j < PER / 8; ++j) { v[j] = s[j];
#pragma unroll
            for (int e = 0; e < 4; ++e) mx = fmaxf(mx, fmaxf(fabsf(bf_lo(v[j][e])), fabsf(bf_hi(v[j][e])))); }
        mx = fmaxf(wave_max(mx), 1e-30f);
        const float inv = 448.0f / mx;
        if (lane == 0) scale[n] = mx * (1.0f / 448.0f);
        u32x2* d = (u32x2*)(dst + (size_t)n * LEN) + lane * (PER / 8);
#pragma unroll
        for (int j = 0; j < PER / 8; ++j) { int p0 = 0, p1 = 0;
            p0 = __builtin_amdgcn_cvt_pk_fp8_f32(bf_lo(v[j].x) * inv, bf_hi(v[j].x) * inv, p0, false); p0 = __builtin_amdgcn_cvt_pk_fp8_f32(bf_lo(v[j].y) * inv, bf_hi(v[j].y) * inv, p0, true);
            p1 = __builtin_amdgcn_cvt_pk_fp8_f32(bf_lo(v[j].z) * inv, bf_hi(v[j].z) * inv, p1, false); p1 = __builtin_amdgcn_cvt_pk_fp8_f32(bf_lo(v[j].w) * inv, bf_hi(v[j].w) * inv, p1, true);
            d[j] = (u32x2){(unsigned)p0, (unsigned)p1}; }
    }
}
__device__ __forceinline__ void p1_quant_weights(const Frame& F) {
    rowquant_fp8(F, F.ws + WS_WIN + (size_t)1280 * DM * 2, (size_t)DM * 2, F.ws + WS_WG8, (size_t)DM, (float*)(F.ws + WS_SW), 12800);
}
__device__ __forceinline__ void p1_quant_weights_late(const Frame& F) {
    rowquant_fp8(F, F.ws + WS_WBRS, (size_t)DM * 2, F.ws + WS_WBR, (size_t)DM, (float*)(F.ws + WS_SWBR), 4096, F.ctl + CW_WNORM);
    rowquant_fp8(F, F.ws + WS_WOUT, (size_t)DM * 2, F.ws + WS_WOUT, (size_t)DM * 2, (float*)(F.ws + WS_SWOUT), 4096, F.ctl + CW_WNORM2);
    rowquant_fp8(F, F.ws + WS_WQ, (size_t)DM * 2, F.ws + WS_WQ8, (size_t)DM, (float*)(F.ws + WS_SWQ), 2048);
    rowquant_fp8_n<1024>(F, F.ws + WS_WUQ, F.ws + WS_WUQ8, (float*)(F.ws + WS_SWUQ), 3072);
    rowquant_fp8_n<512>(F, F.ws + WS_WUKV, F.ws + WS_WUKV8, (float*)(F.ws + WS_SWUKV), 4096);
}
#define MFMA32(a, b, c) __builtin_amdgcn_mfma_f32_32x32x16_bf16((a), (b), (c), 0, 0, 0)
__device__ __forceinline__ float relu_i(float x) { const int v = __float_as_int(x); return __int_as_float(v > 0 ? v : 0); }
__device__ __forceinline__ int crow(int i, int h) { return (i & 3) + 8 * (i >> 2) + 4 * h; }
__device__ __forceinline__ float half_sum_f(float v) {
#pragma unroll
    for (int o = 1; o < 32; o <<= 1) v += __shfl_xor(v, o);
    return v;
}
__device__ __forceinline__ int half_sum_i(int v) {
#pragma unroll
    for (int o = 1; o < 32; o <<= 1) v += __shfl_xor(v, o);
    return v;
}
__device__ __forceinline__ int half_sum_i_dpp(int v, int h) {
#define DPP_ADDI(ctrl, rmask) v += __builtin_amdgcn_update_dpp(0, v, ctrl, rmask, 0xF, false)
    DPP_ADDI(0xB1, 0xF); DPP_ADDI(0x4E, 0xF); DPP_ADDI(0x141, 0xF); DPP_ADDI(0x140, 0xF); DPP_ADDI(0x142, 0xA);
#undef DPP_ADDI
    const int s0 = __builtin_amdgcn_readlane(v, 31), s1 = __builtin_amdgcn_readlane(v, 63);
    return h ? s1 : s0;
}
__device__ __forceinline__ void count_ge4(int& c, float r0, float r1, float r2, float r3, float mid) {
#if defined(__HIP_DEVICE_COMPILE__)
    unsigned long long m0, m1, m2, m3;
    asm volatile("v_cmp_ge_f32 %1, %5, %9\n\tv_cmp_ge_f32 %2, %6, %9\n\tv_cmp_ge_f32 %3, %7, %9\n\tv_cmp_ge_f32 %4, %8, %9\n\t"
                 "v_addc_co_u32 %0, vcc, 0, %0, %1\n\tv_addc_co_u32 %0, vcc, 0, %0, %2\n\tv_addc_co_u32 %0, vcc, 0, %0, %3\n\tv_addc_co_u32 %0, vcc, 0, %0, %4"
                 : "+v"(c), "=&s"(m0), "=&s"(m1), "=&s"(m2), "=&s"(m3) : "v"(r0), "v"(r1), "v"(r2), "v"(r3), "v"(mid) : "vcc");
#else
    (void)c; (void)r0; (void)r1; (void)r2; (void)r3; (void)mid;
#endif
}
__device__ __forceinline__ float half_max_f(float v) {
#pragma unroll
    for (int o = 1; o < 32; o <<= 1) v = fmaxf(v, __shfl_xor(v, o));
    return v;
}
__device__ __forceinline__ float half_min_f(float v) {
#pragma unroll
    for (int o = 1; o < 32; o <<= 1) v = fminf(v, __shfl_xor(v, o));
    return v;
}
constexpr int IDX_PK = 144, IDX_BUF = 64 * IDX_PK;
__device__ __forceinline__ void idx_task(const Frame& F, int b, int s0c) {
    const int lane = F.lane, r = lane & 31, h = lane >> 5, tid = F.tid;
    const int s0 = s0c + 2 * F.wave;
    LAS unsigned char* lds = F.lds;
    const bf16_t* qix = (const bf16_t*)(F.ws + WS_QIX); const bf16_t* kix = (const bf16_t*)(F.ws + WS_KIX); const float* wix = (const float*)(F.ws + WS_WIX);
    unsigned* mask = (unsigned*)(F.ws + WS_MASK);
    const int tok = (r >> 2) & 1, head = (r & 3) + 4 * (r >> 3);
    const bf16_t* qp = qix + (size_t)(b * SEQ + s0 + tok) * 1024 + head * 64 + 8 * h;
    bf16x8 af[4];
#pragma unroll
    for (int ks = 0; ks < 4; ++ks) af[ks] = *(const bf16x8*)(qp + 16 * ks);
    const f32x4* wp = (const f32x4*)(wix + (size_t)(b * SEQ + s0 + h) * 16);
    float w[16];
#pragma unroll
    for (int q = 0; q < 4; ++q) { const f32x4 x = wp[q]; w[4 * q] = x[0]; w[4 * q + 1] = x[1]; w[4 * q + 2] = x[2]; w[4 * q + 3] = x[3]; }
    const int tq = NMETA + s0 + h;
    int tqr = tq - r; asm volatile("" : "+v"(tqr));
    const int ngrp = ((NMETA + s0c + 15) >> 6) + 1;
    const int skey = tid >> 3, spc = tid & 7;
    int brow = b * SEQ - NMETA; asm volatile("" : "+s"(brow));
    const GAS bf16_t* kcur = (const GAS bf16_t*)(kix + ((long)brow + skey) * 64 + spc * 8);
    const int sdst = skey * IDX_PK + spc * 16;
    const int boff = r * IDX_PK + 16 * h;
    u32x4 kst[3];
    kst[0] = *(const GAS u32x4*)(skey < NMETA ? (const GAS bf16_t*)(kix + (size_t)(NTOK + skey) * 64 + spc * 8) : kcur);
    kcur += 64 * 64; asm volatile("" : "+v"(kcur));
    if (1 < ngrp) kst[1] = *(const GAS u32x4*)kcur;
    kcur += 64 * 64; asm volatile("" : "+v"(kcur));
    if (2 < ngrp) kst[2] = *(const GAS u32x4*)kcur;
    float row[MW];
#pragma unroll
    for (int g = 0; g < MW / 2; ++g) {
        float s0v = -INFINITY, s1v = -INFINITY;
        const int bo = (g & 3) * IDX_BUF;
        if ((g & 1) == 0) {
            if (g < ngrp) *(LAS u32x4*)(lds + bo + sdst) = kst[g % 3];
            if (g + 1 < MW / 2 && g + 1 < ngrp) *(LAS u32x4*)(lds + ((g + 1) & 3) * IDX_BUF + sdst) = kst[(g + 1) % 3];
            __syncthreads();
            kcur += 64 * 64; asm volatile("" : "+v"(kcur));
            if (g + 3 < ngrp) kst[g % 3] = *(const GAS u32x4*)kcur;
            kcur += 64 * 64; asm volatile("" : "+v"(kcur));
            if (g + 4 < ngrp) kst[(g + 1) % 3] = *(const GAS u32x4*)kcur;
        }
        if (g < ngrp) {
            float x0 = 0.f, x1 = 0.f;
            {
                f32x16 a0, a1;
                { bf16x8 bb[4];
#pragma unroll
                  for (int ks = 0; ks < 4; ++ks) bb[ks] = *(const LAS bf16x8*)(lds + bo + boff + 32 * ks);
#pragma unroll
                  for (int i = 0; i < 16; ++i) a0[i] = 0.f;
#pragma unroll
                  for (int ks = 0; ks < 4; ++ks) a0 = MFMA32(af[ks], bb[ks], a0); }
                asm volatile("" ::: "memory");
                { bf16x8 bb[4];
#pragma unroll
                  for (int ks = 0; ks < 4; ++ks) bb[ks] = *(const LAS bf16x8*)(lds + bo + boff + 32 * IDX_PK + 32 * ks);
#pragma unroll
                  for (int i = 0; i < 16; ++i) a1[i] = 0.f;
#pragma unroll
                  for (int ks = 0; ks < 4; ++ks) a1 = MFMA32(af[ks], bb[ks], a1); }
#pragma unroll
                for (int i = 0; i < 16; ++i) x0 += w[i] * relu_i(a0[i]);
                asm volatile("" : "+v"(x0));
#pragma unroll
                for (int i = 0; i < 16; ++i) x1 += w[i] * relu_i(a1[i]);
            }
            s0v = (g * 64 <= tqr) ? x0 : -INFINITY; s1v = (g * 64 + 32 <= tqr) ? x1 : -INFINITY;
        }
        row[2 * g] = s0v; row[2 * g + 1] = s1v;
    }
    float tau = -3.0e38f;
    bool done = (tq + 1 <= 256);
    float mx = -INFINITY, mn = INFINITY;
#pragma unroll
    for (int k = 0; k < MW; ++k) { const float v = row[k]; mx = fmaxf(mx, v); mn = fminf(mn, v > -INFINITY ? v : INFINITY); }
    float lo = half_min_f(mn), hi = half_max_f(mx);
    if (!done) tau = hi;
    int clo = tq + 1, chi = 1;
    for (int it = 0; it < 128; ++it) {
        if (!__any(!done)) break;
        const float midb = lo + (hi - lo) * 0.5f;
        float mid = midb;
        if (it & 1) {
            const float f = (float)(256 - chi) * __builtin_amdgcn_rcpf((float)max(clo - chi, 1));
            const float mi = hi - (hi - lo) * f;
            if (mi > lo && mi < hi) mid = mi;
        }
        int c = 0;
#pragma unroll
        for (int k = 0; k + 3 < MW; k += 4) count_ge4(c, row[k], row[k + 1], row[k + 2], row[k + 3], mid);
#pragma unroll
        for (int k = MW & ~3; k < MW; ++k) c += (row[k] >= mid) ? 1 : 0;
        c = half_sum_i_dpp(c, h);
        if (!done) {
            if (!(midb > lo && midb < hi)) { tau = hi; done = true; }
            else if (c == 256) { tau = mid; done = true; }
            else if (c > 256) { lo = mid; clo = c; }
            else { hi = mid; tau = hi; chi = c; }
        }
    }
    unsigned* mrow = mask + (size_t)(b * SEQ + s0 + h) * MW;
    unsigned mw = 0u;
#pragma unroll
    for (int k = 0; k < MW; ++k) {
        const unsigned long long bal = __ballot(row[k] >= tau);
        const unsigned wd = h ? (unsigned)(bal >> 32) : (unsigned)bal;
        if ((k & 31) == r) mw = wd;
        if ((k & 31) == 31 || k == MW - 1) { const int kk = (k & ~31) + r; if (kk < MW) mrow[kk] = mw; }
    }
}
__device__ __forceinline__ void p2_indexer(const Frame& F, int qslot) {
    volatile LAS unsigned* qw = (volatile LAS unsigned*)(F.lds + LDSCTL_OFF + 16);
    constexpr int NCH = NTOK / 16;
    for (;;) {
        if (F.tid == 0) qw[0] = atomicAdd(F.ctl + CW_QUEUE + 64 * qslot, 1u);
        __syncthreads();
        const int c = __builtin_amdgcn_readfirstlane((int)qw[0]);
        __syncthreads();
        if (c >= NCH) break;
        const int b = c & 3, tblk = (SEQ / 16 - 1) - (c >> 2);
        idx_task(F, b, tblk * 16);
    }
}
template <bool MLA> struct AttnCfg {
    static constexpr int DQK = MLA ? 192 : 128, NKS = DQK / 64, PK = DQK + 16  , PV = 144  , KBYTES = 64 * PK, VBYTES = 64 * PV, VBASE = 2 * KBYTES;
};
struct AttnUnit { int type, b, hx, blk; };
typedef int i32x8 __attribute__((ext_vector_type(8)));
typedef int i32x4 __attribute__((ext_vector_type(4)));
typedef int i32x2_t __attribute__((ext_vector_type(2)));
__device__ __forceinline__ i32x8 cat4(i32x4 a, i32x4 b) { return __builtin_shufflevector(a, b, 0, 1, 2, 3, 4, 5, 6, 7); }
template <int NKS, bool TAIL = true> __device__ __forceinline__ void qk_block(f32x16& s, const i32x8 (&k)[NKS], const i32x8 (&q)[NKS]) {
#if defined(__HIP_DEVICE_COMPILE__)
    int sc = 0x7F7F7F7F;
    if constexpr (NKS == 3 && TAIL)
        asm volatile("s_nop 1\n\tv_mfma_scale_f32_32x32x64_f8f6f4 %0, %1, %4, 0, %7, %7 op_sel_hi:[0,0,0]\n\ts_nop 3\n\tv_mfma_scale_f32_32x32x64_f8f6f4 %0, %2, %5, %0, %7, %7 op_sel_hi:[0,0,0]\n\ts_nop 3\n\t"
                     "v_mfma_scale_f32_32x32x64_f8f6f4 %0, %3, %6, %0, %7, %7 op_sel_hi:[0,0,0]\n\ts_nop 15\n\ts_nop 7"
                     : "=&v"(s) : "v"(k[0]), "v"(k[1]), "v"(k[2]), "v"(q[0]), "v"(q[1]), "v"(q[2]), "v"(sc));
    else if constexpr (NKS == 3)
        asm volatile("s_nop 1\n\tv_mfma_scale_f32_32x32x64_f8f6f4 %0, %1, %4, 0, %7, %7 op_sel_hi:[0,0,0]\n\ts_nop 3\n\tv_mfma_scale_f32_32x32x64_f8f6f4 %0, %2, %5, %0, %7, %7 op_sel_hi:[0,0,0]\n\ts_nop 3\n\t"
                     "v_mfma_scale_f32_32x32x64_f8f6f4 %0, %3, %6, %0, %7, %7 op_sel_hi:[0,0,0]"
                     : "=&v"(s) : "v"(k[0]), "v"(k[1]), "v"(k[2]), "v"(q[0]), "v"(q[1]), "v"(q[2]), "v"(sc));
    else if constexpr (TAIL)
        asm volatile("s_nop 1\n\tv_mfma_scale_f32_32x32x64_f8f6f4 %0, %1, %3, 0, %5, %5 op_sel_hi:[0,0,0]\n\ts_nop 3\n\tv_mfma_scale_f32_32x32x64_f8f6f4 %0, %2, %4, %0, %5, %5 op_sel_hi:[0,0,0]\n\ts_nop 15\n\ts_nop 7"
                     : "=&v"(s) : "v"(k[0]), "v"(k[1]), "v"(q[0]), "v"(q[1]), "v"(sc));
    else
        asm volatile("s_nop 1\n\tv_mfma_scale_f32_32x32x64_f8f6f4 %0, %1, %3, 0, %5, %5 op_sel_hi:[0,0,0]\n\ts_nop 3\n\tv_mfma_scale_f32_32x32x64_f8f6f4 %0, %2, %4, %0, %5, %5 op_sel_hi:[0,0,0]"
                     : "=&v"(s) : "v"(k[0]), "v"(k[1]), "v"(q[0]), "v"(q[1]), "v"(sc));
#else
    (void)s; (void)k; (void)q;
#endif
}

__device__ __forceinline__ void pv_block(f32x16& o0, f32x16& o1, f32x16& o2, f32x16& o3, const i32x8 v0, const i32x8 v1, const i32x8 v2, const i32x8 v3, const i32x8 p) {
#if defined(__HIP_DEVICE_COMPILE__)
    int sc = 0x7F7F7F7F;
    asm volatile("s_nop 1\n\tv_mfma_scale_f32_32x32x64_f8f6f4 %0, %4, %8, %0, %9, %9 op_sel_hi:[0,0,0]\n\tv_mfma_scale_f32_32x32x64_f8f6f4 %1, %5, %8, %1, %9, %9 op_sel_hi:[0,0,0]\n\t"
                 "v_mfma_scale_f32_32x32x64_f8f6f4 %2, %6, %8, %2, %9, %9 op_sel_hi:[0,0,0]\n\tv_mfma_scale_f32_32x32x64_f8f6f4 %3, %7, %8, %3, %9, %9 op_sel_hi:[0,0,0]\n\ts_nop 15\n\ts_nop 7"
                 : "+v"(o0), "+v"(o1), "+v"(o2), "+v"(o3) : "v"(v0), "v"(v1), "v"(v2), "v"(v3), "v"(p), "v"(sc));
#else
    (void)o0; (void)o1; (void)o2; (void)o3; (void)v0; (void)v1; (void)v2; (void)v3; (void)p;
#endif
}
__device__ __forceinline__ int pk4_fp8(float a, float b, float c, float d) { int p = 0; p = __builtin_amdgcn_cvt_pk_fp8_f32(a, b, p, false); return __builtin_amdgcn_cvt_pk_fp8_f32(c, d, p, true); }

template <int PVB>
__device__ __forceinline__ void pv_tile(f32x16 (&oacc)[4], LAS unsigned char* lds, int vb, int voff, const i32x8 pf) {
    i32x8 vf[4];
#pragma unroll
    for (int d = 0; d < 4; ++d) {
        const i32x2_t t0 = __builtin_amdgcn_ds_read_tr8_b64_v2i32((LAS i32x2_t*)(lds + vb + voff + 32 * d));
        const i32x2_t t1 = __builtin_amdgcn_ds_read_tr8_b64_v2i32((LAS i32x2_t*)(lds + vb + voff + 16 * PVB + 32 * d));
        const i32x2_t t2 = __builtin_amdgcn_ds_read_tr8_b64_v2i32((LAS i32x2_t*)(lds + vb + voff + 32 * PVB + 32 * d));
        const i32x2_t t3 = __builtin_amdgcn_ds_read_tr8_b64_v2i32((LAS i32x2_t*)(lds + vb + voff + 48 * PVB + 32 * d));
        vf[d] = (i32x8){t0.x, t0.y, t1.x, t1.y, t2.x, t2.y, t3.x, t3.y}; }
    pv_block(oacc[0], oacc[1], oacc[2], oacc[3], vf[0], vf[1], vf[2], vf[3], pf);
}

template <bool MLA>
__device__ __forceinline__ void attn_unit(const Frame& F, const AttnUnit u) {
    typedef AttnCfg<MLA> C;
    const int tid = F.tid, lane = F.lane, wave = F.wave, r = lane & 31, h = lane >> 5;
    LAS unsigned char* lds = F.lds;
    const unsigned char* qn8 = F.ws + WS_QN; const unsigned char* qr8 = F.ws + WS_QR; const unsigned char* kn8 = F.ws + WS_KN; const unsigned char* kpe8 = F.ws + WS_KPE;
    const unsigned char* qb8 = F.ws + WS_QB; const unsigned char* kb8 = F.ws + WS_KB;
    const unsigned char* va8 = F.ws + WS_VA; const unsigned char* vb8 = F.ws + WS_VB;
    const unsigned* mask = (const unsigned*)(F.ws + WS_MASK);
    const int b = u.b;
    const size_t rowb = (size_t)b * SEQ;
    int head, tw0, ntiles;
    if (MLA) { head = u.hx; tw0 = u.blk * 256 + 32 * wave; ntiles = (NMETA + u.blk * 256 + 255) / 64 + 1; }
    else { head = 4 * u.hx + (wave & 3); tw0 = u.blk * 64 + 32 * (wave >> 2); ntiles = (NMETA + u.blk * 64 + 63) / 64 + 1; }
    const int pw0 = NMETA + tw0;
    const int tq = pw0 + r;
    const float cexp = MLA ? QA_SCALE : QB_SCALE;
    i32x8 qf[C::NKS];
    if (MLA) {
        const unsigned char* p0 = qn8 + (rowb + tw0 + r) * 2048 + head * 128 + 32 * h; const unsigned char* p1 = qr8 + (rowb + tw0 + r) * 1024 + head * 64 + 32 * h;
        qf[0] = cat4(*(const i32x4*)p0, *(const i32x4*)(p0 + 16)); qf[1] = cat4(*(const i32x4*)(p0 + 64), *(const i32x4*)(p0 + 80)); qf[C::NKS - 1] = cat4(*(const i32x4*)p1, *(const i32x4*)(p1 + 16));
    } else {
        const unsigned char* p0 = qb8 + (rowb + tw0 + r) * 2048 + head * 128 + 32 * h;
        qf[0] = cat4(*(const i32x4*)p0, *(const i32x4*)(p0 + 16)); qf[1] = cat4(*(const i32x4*)(p0 + 64), *(const i32x4*)(p0 + 80));
    }
    const int ldk = MLA ? 2048 : 512;
    const unsigned char* ktab = MLA ? kn8 + head * 128 : kb8 + u.hx * 128;
    const unsigned char* vtab = MLA ? va8 + head * 128 : vb8 + u.hx * 128;
    const unsigned char* kbase = ktab + (rowb - NMETA) * ldk;
    const unsigned char* vbase = vtab + (rowb - NMETA) * ldk;
    const unsigned char* pbase = kpe8 + (rowb - NMETA) * 64;
    const int kkey = tid >> 3, kpc = tid & 7, pkey = tid >> 2, ppc = tid & 3;
    const unsigned koffs = (unsigned)(kkey * ldk + kpc * 16); const int kdst = kkey * C::PK + kpc * 16;
    const unsigned poffs = (unsigned)(pkey * 64 + ppc * 16); const int pdst = pkey * C::PK + 128 + ppc * 16;
    const int vdst = C::VBASE + kkey * C::PV + kpc * 16;
    u32x4 kst, vst, pst = (u32x4){0u, 0u, 0u, 0u};
    {
        kst = *(const u32x4*)(kkey < NMETA ? ktab + (size_t)(NTOK + kkey) * ldk + kpc * 16 : kbase + koffs);
        vst = *(const u32x4*)(kkey < NMETA ? vtab + (size_t)(NTOK + kkey) * ldk + kpc * 16 : vbase + koffs);
        if (MLA && tid < 256) pst = *(const u32x4*)(pkey < NMETA ? kpe8 + (size_t)(NTOK + pkey) * 64 + ppc * 16 : pbase + poffs);
    }
    *(LAS u32x4*)(lds + kdst) = kst;
    *(LAS u32x4*)(lds + vdst) = vst;
    if (MLA && tid < 256) *(LAS u32x4*)(lds + pdst) = pst;
    __syncthreads();
    f32x16 oacc[4];
#pragma unroll
    for (int d = 0; d < 4; ++d)
#pragma unroll
        for (int i = 0; i < 16; ++i) oacc[d][i] = 0.f;
    float mrun = -INFINITY, lrun = 0.f;
    const int koff = r * C::PK + 32 * h;
    const int vq = (lane & 15) >> 1;
    const int voff = (4 * h + (vq & 3) + 8 * (vq >> 2)) * C::PV + 16 * ((lane >> 4) & 1) + 8 * (lane & 1);
    const unsigned* mrow = mask + (rowb + tw0 + r) * MW;
    if (ntiles > 1) {
        kst = *(const u32x4*)(kbase + (size_t)64 * ldk + koffs);
        vst = *(const u32x4*)(vbase + (size_t)64 * ldk + koffs);
        if (MLA && tid < 256) pst = *(const u32x4*)(pbase + (size_t)64 * 64 + poffs);
    }
    const bool late = wave >= 4;
    u32x2 mwn = (u32x2){0u, 0u};
    if (!MLA) mwn = *(const u32x2*)mrow;
    i32x8 pfp = (i32x8){0, 0, 0, 0, 0, 0, 0, 0}; bool havep = false;
    int vcur = 0, vprev = 2;
    for (int kt = 0; kt < ntiles; ++kt) {
        const int cur = (kt & 1) * C::KBYTES, nxt = ((kt + 1) & 1) * C::KBYTES;
        const int vnxt = vcur == 2 ? 0 : vcur + 1;
        if (kt + 1 < ntiles) {
            *(LAS u32x4*)(lds + nxt + kdst) = kst;
            *(LAS u32x4*)(lds + vnxt * C::VBYTES + vdst) = vst;
            if (MLA && tid < 256) *(LAS u32x4*)(lds + nxt + pdst) = pst;
        }
        const u32x2 mwd = mwn;
        if (!MLA && kt + 1 < ntiles) mwn = *(const u32x2*)(mrow + 2 * (kt + 1));
        if (kt + 2 < ntiles) {
            kst = *(const u32x4*)(kbase + (size_t)(kt + 2) * 64 * ldk + koffs);
            vst = *(const u32x4*)(vbase + (size_t)(kt + 2) * 64 * ldk + koffs);
            if (MLA && tid < 256) pst = *(const u32x4*)(pbase + (size_t)(kt + 2) * 64 * 64 + poffs);
        }
        if (late && havep) pv_tile<C::PV>(oacc, lds, C::VBASE + vprev * C::VBYTES, voff, pfp);
        const bool need = kt * 64 <= pw0 + 31;
        if (need) {
            f32x16 s0, s1;
            if (!MLA) {
                i32x8 kf0[C::NKS], kf1[C::NKS];
#pragma unroll
                for (int ks = 0; ks < C::NKS; ++ks) { kf0[ks] = cat4(*(const LAS i32x4*)(lds + cur + koff + 64 * ks), *(const LAS i32x4*)(lds + cur + koff + 64 * ks + 16));
                    kf1[ks] = cat4(*(const LAS i32x4*)(lds + cur + koff + 32 * C::PK + 64 * ks), *(const LAS i32x4*)(lds + cur + koff + 32 * C::PK + 64 * ks + 16)); }
                qk_block<C::NKS, false>(s0, kf0, qf);
                qk_block<C::NKS>(s1, kf1, qf);
            } else {
                i32x8 kf0[C::NKS], kf1[C::NKS];
#pragma unroll
                for (int ks = 0; ks < C::NKS; ++ks) kf0[ks] = cat4(*(const LAS i32x4*)(lds + cur + koff + 64 * ks), *(const LAS i32x4*)(lds + cur + koff + 64 * ks + 16));
#pragma unroll
                for (int ks = 0; ks < C::NKS; ++ks) kf1[ks] = cat4(*(const LAS i32x4*)(lds + cur + koff + 32 * C::PK + 64 * ks), *(const LAS i32x4*)(lds + cur + koff + 32 * C::PK + 64 * ks + 16));
                qk_block<C::NKS, false>(s0, kf0, qf);
                qk_block<C::NKS>(s1, kf1, qf);
            }
            if (MLA) {
                if (kt * 64 + 63 > pw0) {
                    const int kb0 = kt * 64 + 4 * h;
#pragma unroll
                    for (int i = 0; i < 16; ++i) { const int key = kb0 + (i & 3) + 8 * (i >> 2); if (key > tq) s0[i] = -INFINITY; if (key + 32 > tq) s1[i] = -INFINITY; }
                }
            } else {
                const unsigned m0 = mwd.x >> (4 * h), m1 = mwd.y >> (4 * h);
#pragma unroll
                for (int i = 0; i < 16; ++i) { const int bit = (i & 3) + 8 * (i >> 2);
                    const unsigned k0 = (unsigned)__builtin_amdgcn_sbfe((int)m0, bit, 1), k1 = (unsigned)__builtin_amdgcn_sbfe((int)m1, bit, 1);
                    s0[i] = __uint_as_float(__builtin_amdgcn_bitop3_b32(__float_as_uint(s0[i]), 0xFF800000u, k0, 0xe4)); s1[i] = __uint_as_float(__builtin_amdgcn_bitop3_b32(__float_as_uint(s1[i]), 0xFF800000u, k1, 0xe4)); }
            }
            float mx = s0[0];
#pragma unroll
            for (int i = 1; i < 16; ++i) mx = fmaxf(mx, s0[i]);
#pragma unroll
            for (int i = 0; i < 16; ++i) mx = fmaxf(mx, s1[i]);
            mx = xhalf_max(mx);
            const float mcand = mx * cexp;
            const bool move = !__all(mcand - mrun <= 8.0f);
            const float mnew = move ? fmaxf(mrun, mcand) : mrun;
            const float msafe = (mnew == -INFINITY) ? 0.f : mnew;
            const float alpha = move ? __builtin_amdgcn_exp2f(mrun - msafe) : 1.0f;
            mrun = mnew;
            f32x2 ps2 = (f32x2){0.f, 0.f}; const f32x2 c2 = (f32x2){cexp, cexp}, nm2 = (f32x2){-msafe, -msafe};
#pragma unroll
            for (int i = 0; i < 16; i += 2) {
                f32x2 t0 = __builtin_elementwise_fma((f32x2){s0[i], s0[i + 1]}, c2, nm2), t1 = __builtin_elementwise_fma((f32x2){s1[i], s1[i + 1]}, c2, nm2);
                t0 = (f32x2){__builtin_amdgcn_exp2f(t0.x), __builtin_amdgcn_exp2f(t0.y)}; t1 = (f32x2){__builtin_amdgcn_exp2f(t1.x), __builtin_amdgcn_exp2f(t1.y)};
                s0[i] = t0.x; s0[i + 1] = t0.y; s1[i] = t1.x; s1[i + 1] = t1.y; ps2 += t0 + t1; }
            lrun = lrun * alpha + (ps2.x + ps2.y);
            if (move) {
#pragma unroll
                for (int d = 0; d < 4; ++d)
#pragma unroll
                    for (int i = 0; i < 16; ++i) oacc[d][i] *= alpha;
            }
            i32x8 pf;
            pf[0] = pk4_fp8(s0[0], s0[1], s0[2], s0[3]); pf[1] = pk4_fp8(s0[4], s0[5], s0[6], s0[7]); pf[2] = pk4_fp8(s0[8], s0[9], s0[10], s0[11]); pf[3] = pk4_fp8(s0[12], s0[13], s0[14], s0[15]);
            pf[4] = pk4_fp8(s1[0], s1[1], s1[2], s1[3]); pf[5] = pk4_fp8(s1[4], s1[5], s1[6], s1[7]); pf[6] = pk4_fp8(s1[8], s1[9], s1[10], s1[11]); pf[7] = pk4_fp8(s1[12], s1[13], s1[14], s1[15]);
            if (late) pfp = pf; else pv_tile<C::PV>(oacc, lds, C::VBASE + vcur * C::VBYTES, voff, pf);
        }
        havep = late && need;
        vprev = vcur; vcur = vnxt;
        __syncthreads();
    }
    if (late && havep) pv_tile<C::PV>(oacc, lds, C::VBASE + vprev * C::VBYTES, voff, pfp);
    __syncthreads();
    {
        const float lt = xhalf_sum(lrun);
        const float vmax = fmaxf(__uint_as_float(F.ctl[CW_VMAX + (MLA ? 64 : 0)]), 1e-30f);
        const float inv = (lt > 0.f ? 1.0f / lt : 0.f) * (440.0f / vmax);
        {
            const float il = lt > 0.f ? 1.0f / lt : 0.f; float q = 0.f;
#pragma unroll
            for (int d = 0; d < 4; ++d)
#pragma unroll
                for (int i = 0; i < 16; ++i) { const float x = oacc[d][i] * il; q += x * x; }
            q = xhalf_sum(q);
            if (h == 0) ssq_add((u64*)(F.ctl + (MLA ? CW_SSQ_OA : CW_SSQ_OB)) + (rowb + tw0 + r), q); }
        unsigned char* op = F.ws + WS_OAB + (rowb + tw0 + r) * 4096 + (MLA ? 0 : 2048) + head * 128 + 16 * h;
#pragma unroll
        for (int d = 0; d < 4; ++d) { unsigned gq[4];
#pragma unroll
            for (int g = 0; g < 4; ++g) { int p = 0;
                p = __builtin_amdgcn_cvt_pk_fp8_f32(fminf(fmaxf(oacc[d][4 * g] * inv, -448.f), 448.f), fminf(fmaxf(oacc[d][4 * g + 1] * inv, -448.f), 448.f), p, false);
                p = __builtin_amdgcn_cvt_pk_fp8_f32(fminf(fmaxf(oacc[d][4 * g + 2] * inv, -448.f), 448.f), fminf(fmaxf(oacc[d][4 * g + 3] * inv, -448.f), 448.f), p, true);
                gq[g] = (unsigned)p; }
#if defined(__HIP_DEVICE_COMPILE__)
            const auto s02 = __builtin_amdgcn_permlane32_swap(gq[0], gq[2], false, false);
            const auto s13 = __builtin_amdgcn_permlane32_swap(gq[1], gq[3], false, false);
            *(u32x4*)(op + 32 * d) = (u32x4){s02[0], s02[1], s13[0], s13[1]};
#endif
        }
    }
}

constexpr int ATT_NUNITS = 16 * 64 + 64 * 16;
__device__ __forceinline__ void att_decode(int idx, AttnUnit& u) {
    int rem = idx;
    for (int L = 65; L >= 2; --L) {
        const int nm = (L >= 5 && ((L - 5) & 3) == 0) ? 64 : 0;
        if (rem < nm) { u.type = 0; u.blk = (L - 5) >> 2; u.b = rem & 3; u.hx = rem >> 2; return; }
        rem -= nm;
        if (rem < 16) { u.type = 1; u.blk = L - 2; u.b = rem & 3; u.hx = rem >> 2; return; }
        rem -= 16;
    }
    u.type = -1; u.blk = 0; u.b = 0; u.hx = 0;
}
__device__ __forceinline__ void p3_attention(const Frame& F, int qslot) {
    volatile LAS int* qw = (volatile LAS int*)(F.lds + LDSCTL_OFF + 32);
    for (;;) {
        if (F.tid == 0) { const int idx = (int)atomicAdd(F.ctl + CW_QUEUE + 64 * qslot, 1u); AttnUnit u; u.type = -1; u.b = 0; u.hx = 0; u.blk = 0; if (idx < ATT_NUNITS) att_decode(idx, u);
            qw[0] = u.type; qw[1] = u.b; qw[2] = u.hx; qw[3] = u.blk; }
        __syncthreads();
        AttnUnit u; u.type = qw[0]; u.b = qw[1]; u.hx = qw[2]; u.blk = qw[3];
        __syncthreads();
        if (u.type < 0) break;
        if (u.type == 0) attn_unit<true>(F, u); else attn_unit<false>(F, u);
    }
}
__device__ __forceinline__ float pk_idx(float v, int n) { return __uint_as_float((__float_as_uint(v) & ~127u) | (unsigned)n); }
__device__ __forceinline__ void route_task(const Frame& F, int tb, int hd) {
    const int lane = F.lane, r = lane & 31, h = lane >> 5;
    const bf16_t* pq = (const bf16_t*)(F.ws + WS_PQ); const bf16_t* skb = (const bf16_t*)(F.ws + WS_SK);
    int* eid = (int*)(F.ws + WS_EID); float* gate = (float*)(F.ws + WS_GATE);
    LAS float* wl = (LAS float*)(F.lds + F.wave * 16384);
    const int m = tb * 32 + r;
#pragma unroll 1
    for (int c = 0; c < 2; ++c) {
        const bf16_t* qp = pq + (size_t)m * 2048 + hd * 256 + c * 128 + 8 * h;
        bf16x8 qf[8];
#pragma unroll
        for (int ks = 0; ks < 8; ++ks) qf[ks] = *(const bf16x8*)(qp + 16 * ks);
        float v[64];
#pragma unroll
        for (int blk = 0; blk < 4; ++blk) {
            const bf16_t* sp = skb + (size_t)((hd * 2 + c) * 128 + 32 * blk + r) * 128 + 8 * h;
            f32x16 acc; float zr = 0.f; asm volatile("" : "+v"(zr));
#pragma unroll
            for (int i = 0; i < 16; ++i) acc[i] = zr;
#pragma unroll
            for (int ks = 0; ks < 8; ++ks) acc = MFMA32(*(const bf16x8*)(sp + 16 * ks), qf[ks], acc);
#pragma unroll
            for (int i = 0; i < 16; ++i) v[blk * 16 + i] = pk_idx(acc[i], 32 * blk + (i & 3) + 8 * (i >> 2) + 4 * h);
        }
#pragma unroll 1
        for (int k = 0; k < 16; ++k) {
            float mx = v[0];
#pragma unroll
            for (int j = 1; j < 64; ++j) mx = fmaxf(mx, v[j]);
            mx = xhalf_max(mx);
            if (h == 0) wl[(c * 16 + k) * 32 + r] = mx;
#pragma unroll
            for (int j = 0; j < 64; ++j) v[j] = (v[j] == mx) ? -INFINITY : v[j];
        }
    }
    LDS_WAIT(); asm volatile("" ::: "memory");
    float cs[25]; int ce[25];
    {
        unsigned t0[16], t1[16];
#pragma unroll
        for (int i = 0; i < 16; ++i) { t0[i] = __float_as_uint(wl[i * 32 + r]); t1[i] = __float_as_uint(wl[(16 + i) * 32 + r]); }
        int n = 0;
#pragma unroll
        for (int i = 0; i < 16; ++i)
#pragma unroll
            for (int j = 0; j < 16; ++j)
                if ((i + 1) * (j + 1) <= 16) {
                    const float s = __uint_as_float(t0[i] & ~127u) + __uint_as_float(t1[j] & ~127u);
                    const float sv = __uint_as_float((__float_as_uint(s) & ~63u) | (unsigned)n); const int ev_ = (int)((t0[i] & 127u) * 128u + (t1[j] & 127u));
                    if (n < 25) { cs[n] = sv; ce[n] = ev_; } else { cs[n - 25] = h ? sv : cs[n - 25]; ce[n - 25] = h ? ev_ : ce[n - 25]; }
                    ++n;
                }
    }
    float sum = 0.f, first = 0.f;
#pragma unroll 1
    for (int k = 0; k < 16; ++k) {
        float mxl = cs[0];
#pragma unroll
        for (int j = 1; j < 25; ++j) mxl = fmaxf(mxl, cs[j]);
        int sel = 0;
#pragma unroll
        for (int j = 0; j < 25; ++j) { const bool hit = (cs[j] == mxl); sel = hit ? ce[j] : sel; }
        float mx0, mx1; int se0, se1; xhalf(mxl, mx0, mx1); xhalf_i(sel, se0, se1);
        const bool lowins = mx0 > mx1;
        const float mx = lowins ? mx0 : mx1; const int se = lowins ? se0 : se1;
#pragma unroll
        for (int j = 0; j < 25; ++j) cs[j] = (cs[j] == mx) ? -INFINITY : cs[j];
        if (k == 0) first = mx;
        const float ev = __expf(mx - first); sum += ev;
        if (h == 0) { wl[1024 + k * 32 + r] = ev; wl[1536 + k * 32 + r] = __int_as_float(se); }
    }
    LDS_WAIT(); asm volatile("" ::: "memory");
    const float inv = 1.0f / sum;
    if (h == 0) {
        int* ep = eid + (size_t)m * 128 + hd * 16; float* gp = gate + (size_t)m * 128 + hd * 16;
#pragma unroll
        for (int q = 0; q < 4; ++q) {
            *(int4*)(ep + 4 * q) = make_int4(__float_as_int(wl[1536 + (4 * q) * 32 + r]), __float_as_int(wl[1536 + (4 * q + 1) * 32 + r]), __float_as_int(wl[1536 + (4 * q + 2) * 32 + r]), __float_as_int(wl[1536 + (4 * q + 3) * 32 + r]));
            *(f32x4*)(gp + 4 * q) = (f32x4){wl[1024 + (4 * q) * 32 + r] * inv, wl[1024 + (4 * q + 1) * 32 + r] * inv, wl[1024 + (4 * q + 2) * 32 + r] * inv, wl[1024 + (4 * q + 3) * 32 + r] * inv}; }
    }
    LDS_WAIT(); asm volatile("" ::: "memory");
}
__device__ __forceinline__ void p7_routing(const Frame& F) {
    const int gw = F.vcu * NWAVES + F.wave, NGW = F.G * NWAVES;
    for (int it = gw; it < (NTOK / 64) * 8; it += NGW) route_task(F, 2 * (it >> 3), it & 7);
}

__device__ __forceinline__ float rl_f(float v, int l) { return __int_as_float(__builtin_amdgcn_readlane(__float_as_int(v), l)); }
__device__ __forceinline__ float gelu_tanh(float x) {
    const float u = 0.7978845608028654f * (x + 0.044715f * x * x * x);
    const float e = __expf(2.0f * u);
    const float th = 1.0f - 2.0f / (e + 1.0f);
    return 0.5f * x * (1.0f + th);
}
__device__ __forceinline__ float wave_sum_dpp(float v) {
#define DPP_ADD(ctrl, rmask) v += __int_as_float(__builtin_amdgcn_update_dpp(0, __float_as_int(v), ctrl, rmask, 0xF, false))
    DPP_ADD(0xB1, 0xF); DPP_ADD(0x4E, 0xF); DPP_ADD(0x141, 0xF); DPP_ADD(0x140, 0xF); DPP_ADD(0x142, 0xA); DPP_ADD(0x143, 0xC);
#undef DPP_ADD
    return rl_f(v, 63);
}
typedef unsigned u32x6 __attribute__((ext_vector_type(6)));
typedef float f32x32 __attribute__((ext_vector_type(32)));
struct Row6 { u32x4 q[3]; };
__device__ __forceinline__ void row6_load(Row6& r, const unsigned char* tab, int e, int lane) {
    const u32x4* p = (const u32x4*)(tab + (size_t)e * 3072) + lane;
#pragma unroll
    for (int q = 0; q < 3; ++q) r.q[q] = p[64 * q];
}
__device__ __forceinline__ f32x32 row6_deq(const Row6& r, int g) {
    u32x6 w;
    if (g == 0) { w[0] = r.q[0].x; w[1] = r.q[0].y; w[2] = r.q[0].z; w[3] = r.q[0].w; w[4] = r.q[1].x; w[5] = r.q[1].y; }
    else { w[0] = r.q[1].z; w[1] = r.q[1].w; w[2] = r.q[2].x; w[3] = r.q[2].y; w[4] = r.q[2].z; w[5] = r.q[2].w; }
    return __builtin_amdgcn_cvt_scalef32_pk32_f32_fp6(w, 1.0f);
}
__device__ __forceinline__ float row6_dot(const Row6& r, const f32x2 (&hf)[32]) {
    f32x2 acc0 = (f32x2){0.f, 0.f}, acc1 = (f32x2){0.f, 0.f};
#pragma unroll
    for (int g = 0; g < 2; ++g) { const f32x32 d = row6_deq(r, g);
#pragma unroll
        for (int k = 0; k < 16; k += 2) { acc0 = __builtin_elementwise_fma((f32x2){d[2 * k], d[2 * k + 1]}, hf[16 * g + k], acc0); acc1 = __builtin_elementwise_fma((f32x2){d[2 * k + 2], d[2 * k + 3]}, hf[16 * g + k + 1], acc1); } }
    const f32x2 s = acc0 + acc1;
    return s.x + s.y;
}
__device__ __forceinline__ void row6_axpy(const Row6& r, float c, f32x2 (&o)[32]) {
    const f32x2 c2 = (f32x2){c, c};
#pragma unroll
    for (int g = 0; g < 2; ++g) { const f32x32 d = row6_deq(r, g);
#pragma unroll
        for (int k = 0; k < 16; ++k) o[16 * g + k] = __builtin_elementwise_fma((f32x2){d[2 * k], d[2 * k + 1]}, c2, o[16 * g + k]); }
}
struct Row4 { u32x4 q[2]; };
__device__ __forceinline__ void row4_load(Row4& r, const unsigned char* tab, int e, int lane) {
    const u32x4* p = (const u32x4*)(tab + (size_t)e * 2048) + lane;
    r.q[0] = p[0]; r.q[1] = p[64];
}
__device__ __forceinline__ float row4_dot(const Row4& r, const f32x2 (&hf)[32]) {
    f32x2 acc0 = (f32x2){0.f, 0.f}, acc1 = (f32x2){0.f, 0.f};
#pragma unroll
    for (int d = 0; d < 8; ++d) { const unsigned w = r.q[d >> 2][d & 3];
        acc0 = __builtin_elementwise_fma(__builtin_amdgcn_cvt_scalef32_pk_f32_fp4(w, 1.0f, 0), hf[4 * d], acc0);
        acc1 = __builtin_elementwise_fma(__builtin_amdgcn_cvt_scalef32_pk_f32_fp4(w, 1.0f, 1), hf[4 * d + 1], acc1);
        acc0 = __builtin_elementwise_fma(__builtin_amdgcn_cvt_scalef32_pk_f32_fp4(w, 1.0f, 2), hf[4 * d + 2], acc0);
        acc1 = __builtin_elementwise_fma(__builtin_amdgcn_cvt_scalef32_pk_f32_fp4(w, 1.0f, 3), hf[4 * d + 3], acc1); }
    const f32x2 s = acc0 + acc1;
    return s.x + s.y;
}
__device__ __forceinline__ void row4_axpy(const Row4& r, float c, f32x2 (&o)[32]) {
    const f32x2 c2 = (f32x2){c, c};
#pragma unroll
    for (int d = 0; d < 8; ++d) { const unsigned w = r.q[d >> 2][d & 3];
        o[4 * d] = __builtin_elementwise_fma(__builtin_amdgcn_cvt_scalef32_pk_f32_fp4(w, 1.0f, 0), c2, o[4 * d]);
        o[4 * d + 1] = __builtin_elementwise_fma(__builtin_amdgcn_cvt_scalef32_pk_f32_fp4(w, 1.0f, 1), c2, o[4 * d + 1]);
        o[4 * d + 2] = __builtin_elementwise_fma(__builtin_amdgcn_cvt_scalef32_pk_f32_fp4(w, 1.0f, 2), c2, o[4 * d + 2]);
        o[4 * d + 3] = __builtin_elementwise_fma(__builtin_amdgcn_cvt_scalef32_pk_f32_fp4(w, 1.0f, 3), c2, o[4 * d + 3]); }
}
#if PEER_U_BITS == 4
typedef Row4 RowU;
#define ROWU_LOAD row4_load
#define ROWU_DOT row4_dot
#else
typedef Row6 RowU;
#define ROWU_LOAD row6_load
#define ROWU_DOT row6_dot
#endif
#if PEER_V_BITS == 4
typedef Row4 RowV;
#define ROWV_LOAD row4_load
#define ROWV_AXPY row4_axpy
#else
typedef Row6 RowV;
#define ROWV_LOAD row6_load
#define ROWV_AXPY row6_axpy
#endif
__device__ __forceinline__ void expert_token(const Frame& F, int m, size_t orow) {
    const int lane = F.lane;
    const unsigned char* U = F.ws + WS_U; const unsigned char* V = F.ws + WS_V;
    const float* scu = (const float*)(F.ws + WS_SCU); const float* scv = (const float*)(F.ws + WS_SCV);
    const int* eid = (const int*)(F.ws + WS_EID); const float* gate = (const float*)(F.ws + WS_GATE);
    const bf16_t* h1b = (const bf16_t*)(F.ws + WS_H1B);
    const u64* ssq = (const u64*)(F.ctl + CW_SSQ_H1); const float* gfin = F.in(15);
    const int e0 = eid[(size_t)m * 128 + lane], e1 = eid[(size_t)m * 128 + 64 + lane];
    f32x2 hf[32];
#pragma unroll
    for (int j = 0; j < 16; ++j) { const u32x2 x = *((const u32x2*)(h1b + (size_t)m * DM) + lane + 64 * j); hf[2 * j] = (f32x2){bf_lo(x.x), bf_hi(x.x)}; hf[2 * j + 1] = (f32x2){bf_lo(x.y), bf_hi(x.y)}; }
    const float g0 = gate[(size_t)m * 128 + lane] * scv[e0], g1 = gate[(size_t)m * 128 + 64 + lane] * scv[e1];
    const float rstd = __builtin_amdgcn_rsqf(ssq_get(ssq + m) * (1.0f / DM) + EPS);
    const float su0 = scu[e0] * rstd, su1 = scu[e1] * rstd;
    float a0 = 0.f, a1 = 0.f;
#define EIDX(e) (((e) < 64) ? __builtin_amdgcn_readlane(e0, (e)) : __builtin_amdgcn_readlane(e1, (e) - 64))
    {
        RowU r0, r1, r2, r3, r4, r5, r6, r7;
        ROWU_LOAD(r0, U, EIDX(0), lane); ROWU_LOAD(r1, U, EIDX(1), lane); ROWU_LOAD(r2, U, EIDX(2), lane); ROWU_LOAD(r3, U, EIDX(3), lane);
        ROWU_LOAD(r4, U, EIDX(4), lane); ROWU_LOAD(r5, U, EIDX(5), lane); ROWU_LOAD(r6, U, EIDX(6), lane); ROWU_LOAD(r7, U, EIDX(7), lane);
#define S1STEP(rr, k) p = wave_sum_dpp(ROWU_DOT(rr, hf)); if (more) ROWU_LOAD(rr, U, EIDX(e + 8 + (k)), lane); if (e < 64) { if (lane == e + (k)) a0 = p; } else { if (lane == e + (k) - 64) a1 = p; }
#pragma unroll 1
        for (int e = 0; e < 128; e += 8) {
            const bool more = e + 8 < 128; float p;
            S1STEP(r0, 0) S1STEP(r1, 1) S1STEP(r2, 2) S1STEP(r3, 3) S1STEP(r4, 4) S1STEP(r5, 5) S1STEP(r6, 6) S1STEP(r7, 7)
        }
#undef S1STEP
    }
    const float c0 = gelu_tanh(a0 * su0) * g0, c1 = gelu_tanh(a1 * su1) * g1;
#define CIDX(e) (((e) < 64) ? rl_f(c0, (e)) : rl_f(c1, (e) - 64))
    f32x2 o[32]; float zo = 0.f; asm volatile("" : "+v"(zo));
#pragma unroll
    for (int i = 0; i < 32; ++i) o[i] = (f32x2){zo, zo};
    {
        RowV r0, r1, r2, r3, r4, r5, r6, r7;
        ROWV_LOAD(r0, V, EIDX(0), lane); ROWV_LOAD(r1, V, EIDX(1), lane); ROWV_LOAD(r2, V, EIDX(2), lane); ROWV_LOAD(r3, V, EIDX(3), lane);
        ROWV_LOAD(r4, V, EIDX(4), lane); ROWV_LOAD(r5, V, EIDX(5), lane); ROWV_LOAD(r6, V, EIDX(6), lane); ROWV_LOAD(r7, V, EIDX(7), lane);
#define S2STEP(rr, k) ROWV_AXPY(rr, CIDX(e + (k)), o); if (more) ROWV_LOAD(rr, V, EIDX(e + 8 + (k)), lane);
#pragma unroll 1
        for (int e = 0; e < 128; e += 8) {
            const bool more = e + 8 < 128;
            S2STEP(r0, 0) S2STEP(r1, 1) S2STEP(r2, 2) S2STEP(r3, 3) S2STEP(r4, 4) S2STEP(r5, 5) S2STEP(r6, 6) S2STEP(r7, 7)
        }
#undef S2STEP
    }
#undef EIDX
#undef CIDX
    float s = 0.f;
    const GAS bf16_t* h1r = (const GAS bf16_t*)(h1b + (size_t)m * DM); asm volatile("" : "+s"(h1r));
#pragma unroll
    for (int j = 0; j < 16; ++j) { const u32x2 x = *((const GAS u32x2*)h1r + lane + 64 * j);
        o[2 * j] += (f32x2){bf_lo(x.x), bf_hi(x.x)}; o[2 * j + 1] += (f32x2){bf_lo(x.y), bf_hi(x.y)};
        s += (o[2 * j].x * o[2 * j].x + o[2 * j].y * o[2 * j].y) + (o[2 * j + 1].x * o[2 * j + 1].x + o[2 * j + 1].y * o[2 * j + 1].y); }
    const float rs = 1.0f / sqrtf(wave_sum(s) * (1.0f / DM) + EPS);
    float* op = F.out() + orow * DM;
#pragma unroll
    for (int j = 0; j < 16; ++j) { const f32x4 g = *((const f32x4*)gfin + lane + 64 * j);
        *((f32x4*)op + lane + 64 * j) = (f32x4){o[2 * j].x * rs * g[0], o[2 * j].y * rs * g[1], o[2 * j + 1].x * rs * g[2], o[2 * j + 1].y * rs * g[3]}; }
}
#ifdef MK_STEP_B
__device__ __forceinline__ void stepb_token(const Frame& F, int m, size_t orow) {
    const int lane = F.lane; const float* x = (const float*)(F.ws + WS_H1F) + (size_t)m * DM; const float* gfin = F.in(15);
    f32x4 v[16]; float s = 0.f;
#pragma unroll
    for (int j = 0; j < 16; ++j) { v[j] = *((const f32x4*)x + lane + 64 * j); s += (v[j][0] * v[j][0] + v[j][1] * v[j][1]) + (v[j][2] * v[j][2] + v[j][3] * v[j][3]); }
    const float rs = 1.0f / sqrtf(wave_sum(s) * (1.0f / DM) + EPS);
#pragma unroll
    for (int j = 0; j < 16; ++j) { const f32x4 g = *((const f32x4*)gfin + lane + 64 * j); *((f32x4*)(F.out() + orow * DM) + lane + 64 * j) = v[j] * rs * g; }
}
#endif
#ifdef MK_STEP_A
__device__ __forceinline__ void stepa_token(const Frame& F, size_t orow) {
    const int lane = F.lane; const float* x = F.in(0) + orow * DM; const float* gfin = F.in(15);
    f32x4 v[16]; float s = 0.f;
#pragma unroll
    for (int j = 0; j < 16; ++j) { v[j] = *((const f32x4*)x + lane + 64 * j); s += (v[j][0] * v[j][0] + v[j][1] * v[j][1]) + (v[j][2] * v[j][2] + v[j][3] * v[j][3]); }
    const float rs = 1.0f / sqrtf(wave_sum(s) * (1.0f / DM) + EPS);
#pragma unroll
    for (int j = 0; j < 16; ++j) { const f32x4 g = *((const f32x4*)gfin + lane + 64 * j); *((f32x4*)(F.out() + orow * DM) + lane + 64 * j) = v[j] * rs * g; }
}
#endif
__device__ __forceinline__ void p8_experts(const Frame& F) {
    const int gw = F.vcu * NWAVES + F.wave, NGW = F.G * NWAVES;
#if defined(MK_STEP_A)
    for (int it = gw; it < NB * SEQ; it += NGW) stepa_token(F, (size_t)it);
#elif defined(MK_STEP_B)
    for (int it = gw; it < NB * SEQ; it += NGW) stepb_token(F, it, (size_t)it);
#else
    const int slot = (F.wave < 4) ? F.wave : ((F.wave + 2) & 3);
#pragma unroll 1
    for (int u = F.vcu; u < NTOK / 64; u += F.G) {
#pragma unroll 1
        for (int j = 0; j < 8; ++j) {
            if (j == slot) { Frame F2 = F; asm volatile("" : "+v"(F2.lane)); route_task(F2, 2 * u + 1, F.wave); }
            if (j == 4) __syncthreads();
            const int it = 64 * u + 32 * (j >> 2) + 4 * F.wave + (j & 3); expert_token(F, it, (size_t)it);
        }
    }
#endif
}
struct Args { const float* in[16]; float* out; unsigned char* ws; int ph_lo, ph_hi; };
#define GEMM_RUN(EPI_T, g_, S_, E_) pg8::gemm_phase<EPI_T, pg8::StaticOrder, true, true>(F.lds, g_, S_, E_)
#define GEMM_RUN2(EPI_T, g_, S_, E_) pg8::gemm_phase<EPI_T, pg8::StaticOrder2, true, true>(F.lds, g_, S_, E_)

__global__ void __launch_bounds__(NWAVES * 64, 2) mk_fwd(Args args) {
    extern __shared__ __attribute__((aligned(16))) unsigned char lds_raw[];
    Frame F;
    F.lds = (LAS unsigned char*)lds_raw;
    F.ws = args.ws; F.ctl = (unsigned*)(args.ws + WS_CTL);
    F.tid = threadIdx.x; F.lane = F.tid & 63; F.wave = __builtin_amdgcn_readfirstlane(F.tid >> 6);
#define PHASE_BEGIN() do { int t_; asm volatile("v_mov_b32 %0, %1" : "=v"(t_) : "v"(threadIdx.x)); F.tid = t_; F.lane = t_ & 63; } while (0)
    F.G = gridDim.x; { const int bx = blockIdx.x; F.vcu = (F.G % 8 == 0) ? (bx % 8) * (F.G / 8) + bx / 8 : bx; }
    for (int u = F.tid; u < (LDS_BYTES - LDSCTL_OFF) / 4; u += NWAVES * 64) ((LAS unsigned*)(F.lds + LDSCTL_OFF))[u] = 0u;
    __syncthreads();
    XcdBarrier bar; bar.bar = F.ctl + CW_BAR; bar.x = 0; bar.st = nullptr;
    if (!MK_PER_PHASE) bar = xcd_barrier_post(F.ctl + CW_BAR, (volatile LAS unsigned*)(F.lds + LDSCTL_OFF));
    const int lo = args.ph_lo, hi = args.ph_hi;
#ifndef PH_MASK
#define PH_MASK 0x1FF
#endif
#define IN(k) (((PH_MASK >> (k)) & 1) && lo <= (k) && (k) < hi)
#ifdef MK_PROBE_T
#define STAMP(k) do { if (blockIdx.x == 0 && threadIdx.x == 0) ((volatile u64*)(F.ctl + 2048))[k] = __builtin_amdgcn_s_memrealtime(); } while (0)
#else
#define STAMP(k) do { } while (0)
#endif
#define SEAM(k) do { if (IN(k) && IN((k) + 1)) xcd_barrier(bar); STAMP((k) + 1); } while (0)
    unsigned char* ws = F.ws;

#ifndef MK_REP_MASK
#define MK_REP_MASK 0
#endif
#define NREP(k) (((MK_REP_MASK >> (k)) & 1) ? 2 : 1)
    STAMP(0);
    if (IN(0)) { for (int rep = 0; rep < NREP(0); ++rep) { PHASE_BEGIN(); p0_prologue(F); if (rep + 1 < NREP(0)) xcd_barrier(bar); } }
    SEAM(0);
    if (IN(1)) { for (int rep = 0; rep < NREP(1); ++rep) { PHASE_BEGIN();
        int p1_ns = 0, p1_sidx = 0; bool p1_short = false;
        {   const int G = F.G, NT8 = (MK / 256) * (12800 / 256), NTB = (MK / 256) * (1280 / 256);
            auto p1_units = [&](int b) { const int rb = G - 1 - b; return (b < NT8 ? (NT8 - b + G - 1) / G : 0) + 2 * (rb < NTB ? (NTB - rb + G - 1) / G : 0); };
            int umax = 0;
            for (int b = 0; b < G; ++b) umax = max(umax, p1_units(b));
            for (int b = 0; b < G; ++b) { const int sl = p1_units(b) < umax ? 1 : 0; p1_ns += sl; if (b < (int)blockIdx.x) p1_sidx += sl; }
            p1_short = p1_units((int)blockIdx.x) < umax; }
        p1_quant_weights(F);
        if (p1_ns == 0) p1_quant_weights_late(F);
        xcd_barrier(bar);
        {
            pg8::Gemm g{(const bf16_t*)(ws + WS_XN8), (const bf16_t*)(ws + WS_WG8), MK, 12800, DM / 2, DM / 2}; pg8::StaticOrder S; S.init(MK, 12800, F.G, (int)blockIdx.x);
            epi::EpiIn<true> E{(bf16_t*)(ws + WS_CQ), (bf16_t*)(ws + WS_CKV), (bf16_t*)(ws + WS_QB), (bf16_t*)(ws + WS_KB), (bf16_t*)(ws + WS_VB), (bf16_t*)(ws + WS_QIX), (bf16_t*)(ws + WS_KPE), (bf16_t*)(ws + WS_KIX),
                          (bf16_t*)(ws + WS_GA), (bf16_t*)(ws + WS_GB), (float*)(ws + WS_WIX), rep ? nullptr : (u64*)(F.ctl + CW_SSQ_CQ), rep ? nullptr : (u64*)(F.ctl + CW_SSQ_CKV),
                          (const float*)(ws + WS_ROPE_M), (const float*)(ws + WS_ROPE_D), (const float*)(ws + WS_ROPE_I), F.ctl + CW_VMAX, (const float*)(ws + WS_SX), (const float*)(ws + WS_SW)};
            GEMM_RUN(epi::EpiIn<true>, g, S, E); }
        __syncthreads();
        {
            pg8::Gemm g{(const bf16_t*)(ws + WS_XN), (const bf16_t*)(ws + WS_WIN), MK, 1280, DM, DM}; pg8::StaticOrder S; S.init(MK, 1280, F.G, (int)(gridDim.x - 1 - blockIdx.x));
            epi::EpiIn<false> E{(bf16_t*)(ws + WS_CQ), (bf16_t*)(ws + WS_CKV), (bf16_t*)(ws + WS_QB), (bf16_t*)(ws + WS_KB), (bf16_t*)(ws + WS_VB), (bf16_t*)(ws + WS_QIX), (bf16_t*)(ws + WS_KPE), (bf16_t*)(ws + WS_KIX),
                          (bf16_t*)(ws + WS_GA), (bf16_t*)(ws + WS_GB), (float*)(ws + WS_WIX), nullptr, nullptr,
                          (const float*)(ws + WS_ROPE_M), (const float*)(ws + WS_ROPE_D), (const float*)(ws + WS_ROPE_I), F.ctl + CW_VMAX, nullptr, nullptr};
            GEMM_RUN(epi::EpiIn<false>, g, S, E); }
        if (p1_short) { Frame FS = F; FS.vcu = p1_sidx; FS.G = p1_ns; p1_quant_weights_late(FS); }
        if (rep + 1 < NREP(1)) xcd_barrier(bar); }
    }
    SEAM(1);
    if (IN(2)) { for (int rep = 0; rep < NREP(2); ++rep) { PHASE_BEGIN();
        { pg8::Gemm g{(const bf16_t*)(ws + WS_CQ), (const bf16_t*)(ws + WS_WUQ8), NTOK, 3072, 512, 512}; pg8::StaticOrder S; S.init(NTOK, 3072, F.G, (int)blockIdx.x);
          epi::EpiUp E{ws + WS_QN, ws + WS_QR, 8, 2048, 1024, false, (const u64*)(F.ctl + CW_SSQ_CQ), 1.0f / 1024.0f, (const float*)(ws + WS_ROPE_M), (const float*)(ws + WS_SWUQ), F.ctl + CW_VMAX + 64};
          GEMM_RUN(epi::EpiUp, g, S, E); }
        __syncthreads();
        { pg8::Gemm g{(const bf16_t*)(ws + WS_CKV), (const bf16_t*)(ws + WS_WUKV8), MK, 4096, 256, 256}; pg8::StaticOrder S; S.init(MK, 4096, F.G, (int)blockIdx.x);
          epi::EpiUp E{ws + WS_KN, ws + WS_VA, 8, 2048, 2048, true, (const u64*)(F.ctl + CW_SSQ_CKV), 1.0f / 512.0f, nullptr, (const float*)(ws + WS_SWUKV), F.ctl + CW_VMAX + 64};
          GEMM_RUN(epi::EpiUp, g, S, E); }
        __syncthreads();
        p2_indexer(F, rep);
        if (rep + 1 < NREP(2)) xcd_barrier(bar); }
    }
    SEAM(2);
    if (IN(3)) { for (int rep = 0; rep < NREP(3); ++rep) { PHASE_BEGIN(); p3_attention(F, 2 + rep); if (rep + 1 < NREP(3)) xcd_barrier(bar); } }
    SEAM(3);
    if (IN(4)) { for (int rep = 0; rep < NREP(4); ++rep) { PHASE_BEGIN();
        pg8::Gemm g{(const bf16_t*)(ws + WS_OAB), (const bf16_t*)(ws + WS_WBR), NTOK, 4096, 2048, 1024}; pg8::StaticOrder2 S; S.init(NTOK, 4096, F.G, (int)blockIdx.x);
        epi::EpiBranch E{(const bf16_t*)(ws + WS_GA), (const bf16_t*)(ws + WS_GB), ws + WS_MRG, (const unsigned*)(F.ctl + CW_VMAX), (const float*)(ws + WS_SWBR), (const u64*)(F.ctl + CW_SSQ_OA), (const u64*)(F.ctl + CW_SSQ_OB), (const unsigned*)(F.ctl + CW_WNORM), (float*)(ws + WS_SMRG), rep ? nullptr : (u64*)(F.ctl + CW_SSQ_MRG)};
        GEMM_RUN2(epi::EpiBranch, g, S, E);
        if (rep + 1 < NREP(4)) xcd_barrier(bar); }
    }
    SEAM(4);
    if (IN(5)) { for (int rep = 0; rep < NREP(5); ++rep) { PHASE_BEGIN();
        pg8::Gemm g{(const bf16_t*)(ws + WS_MRG), (const bf16_t*)(ws + WS_WOUT), NTOK, 4096, 4096, 2048}; pg8::StaticOrder S; S.init(NTOK, 4096, F.G, (int)blockIdx.x);
        epi::EpiOut E{F.in(0), F.in(1), (float*)(ws + WS_H1F), (bf16_t*)(ws + WS_H1B), rep ? nullptr : (u64*)(F.ctl + CW_SSQ_H1), (const float*)(ws + WS_SMRG), (const float*)(ws + WS_SWOUT),
                       ws + WS_H18, (float*)(ws + WS_SH1), (const float*)(ws + WS_XMAX), (const u64*)(F.ctl + CW_SSQ_MRG), (const unsigned*)(F.ctl + CW_WNORM2)};
        GEMM_RUN(epi::EpiOut, g, S, E);
        if (rep + 1 < NREP(5)) xcd_barrier(bar); }
    }
    SEAM(5);
    if (IN(6)) { for (int rep = 0; rep < NREP(6); ++rep) { PHASE_BEGIN();
        pg8::Gemm g{(const bf16_t*)(ws + WS_H18), (const bf16_t*)(ws + WS_WQ8), NTOK, 2048, 2048, 2048}; pg8::StaticOrder S; S.init(NTOK, 2048, F.G, (int)blockIdx.x);
        epi::EpiPQ E{(bf16_t*)(ws + WS_PQ), (const u64*)(F.ctl + CW_SSQ_H1), (const float*)(ws + WS_SH1), (const float*)(ws + WS_SWQ)};
        GEMM_RUN(epi::EpiPQ, g, S, E);
        if (rep + 1 < NREP(6)) xcd_barrier(bar); }
    }
    SEAM(6);
    if (IN(7)) { for (int rep = 0; rep < NREP(7); ++rep) { PHASE_BEGIN();
        if (F.wave & 4) { p6_tables(F); p7_routing(F); } else { p7_routing(F); p6_tables(F); }
        if (rep + 1 < NREP(7)) xcd_barrier(bar); } }
    SEAM(7);
    if (IN(8)) { for (int rep = 0; rep < NREP(8); ++rep) { PHASE_BEGIN(); p8_experts(F); if (rep + 1 < NREP(8)) xcd_barrier(bar); } }
#ifdef MK_PROBE_T
    {   PHASE_BEGIN();
        xcd_barrier(bar); STAMP(9); xcd_barrier(bar);
        const volatile u64* ts = (const volatile u64*)(F.ctl + 2048);
        const float tot = (float)(ts[9] - ts[0]);
        const float f1 = (float)(ts[MK_PROBE_K1 + 1] - ts[MK_PROBE_K1]) / tot, f2 = (float)(ts[MK_PROBE_K2 + 1] - ts[MK_PROBE_K2]) / tot;
        float* o = F.out(); const size_t gt = (size_t)blockIdx.x * 512 + F.tid, NGT = (size_t)gridDim.x * 512;
        for (size_t i = gt; i < (size_t)NB * SEQ * DM / 4; i += NGT) { f32x4 v = ((f32x4*)o)[i]; v = v * (1.0f - f1); if (i == 0) v[0] = 1000.0f * f2; ((f32x4*)o)[i] = v; }
    }
#endif
#undef IN
#undef SEAM
}

extern "C" void kernel_launch(void* const* d_in, const int* in_sizes, int n_in, void* d_out, int out_size, void* d_ws, size_t ws_size, hipStream_t stream) {
    static int grid = 0;
    if (grid == 0) {
        if (n_in != 16 || in_sizes[0] != NB * SEQ * DM || out_size != NB * SEQ * DM || ws_size < WS_END) {
            fprintf(stderr, "kernel_launch: unexpected problem shape (n_in %d, in0 %d, out %d, ws %zu < %zu); nothing launched\n", n_in, n_in > 0 ? in_sizes[0] : -1, out_size, ws_size, (size_t)WS_END); grid = -1; return; }
        int dev = 0, cus = 0, per_cu = 0;
        if (hipGetDevice(&dev) != hipSuccess || hipDeviceGetAttribute(&cus, hipDeviceAttributeMultiprocessorCount, dev) != hipSuccess) { grid = -1; return; }
        if (hipFuncSetAttribute((const void*)mk_fwd, hipFuncAttributeMaxDynamicSharedMemorySize, LDS_BYTES) != hipSuccess) { fprintf(stderr, "kernel_launch: hipFuncSetAttribute failed\n"); grid = -1; return; }
        if (hipOccupancyMaxActiveBlocksPerMultiprocessor(&per_cu, (const void*)mk_fwd, NWAVES * 64, LDS_BYTES) != hipSuccess || per_cu < 1) {
            fprintf(stderr, "kernel_launch: occupancy query reports %d workgroups per CU\n", per_cu); }
        (void)hipGetLastError();
        grid = cus;
    }
    if (grid < 0) return;
    if (hipMemsetAsync((char*)d_ws + WS_CTL, 0, CTL_ZERO_BYTES, stream) != hipSuccess) return;
    Args a{};
    for (int i = 0; i < 16; ++i) a.in[i] = (const float*)d_in[i];
    a.out = (float*)d_out; a.ws = (unsigned char*)d_ws;
#if MK_PER_PHASE
    for (int p = 0; p <= MK_LAST_PHASE; ++p) { a.ph_lo = p; a.ph_hi = p + 1; hipLaunchKernelGGL(mk_fwd, dim3(grid), dim3(NWAVES * 64), LDS_BYTES, stream, a); }
#else
    a.ph_lo = 0; a.ph_hi = MK_LAST_PHASE + 1;
    hipLaunchKernelGGL(mk_fwd, dim3(grid), dim3(NWAVES * 64), LDS_BYTES, stream, a);
#endif
}
```

```cpp
#include <hip/hip_runtime.h>
#include <cstdio>
#include <cstdint>

#define LAS __attribute__((address_space(3)))
#define GAS __attribute__((address_space(1)))
typedef unsigned short bf16_t;
typedef short bf16x8 __attribute__((ext_vector_type(8)));
typedef short s16x4 __attribute__((ext_vector_type(4)));
typedef float f32x2 __attribute__((ext_vector_type(2)));
typedef float f32x4 __attribute__((ext_vector_type(4)));
typedef float f32x16 __attribute__((ext_vector_type(16)));
typedef unsigned u32x2 __attribute__((ext_vector_type(2)));
typedef unsigned u32x4 __attribute__((ext_vector_type(4)));
typedef GAS unsigned gu32;

#ifndef MK_PER_PHASE
#define MK_PER_PHASE 0
#endif
#ifndef MK_LAST_PHASE
#define MK_LAST_PHASE 8
#endif

constexpr int NB = 4, SEQ = 4096, DM = 4096, NMETA = 16, TR = SEQ + NMETA  , TP = 4224  , M = NB * TP  ;
constexpr float EPS = 1e-6f;
constexpr int NV1 = 14080;
constexpr float LOG2E = 1.4426950408889634f;
constexpr float QB_SCALE = 0.08838834764831845f * LOG2E;
constexpr float QA_SCALE = 0.07216878364870323f * LOG2E;
constexpr int NWAVES = 8;
constexpr int NTOK = NB * SEQ;
constexpr int MK = NTOK + 256;
constexpr int MW = 130;
__device__ __forceinline__ int row_pos(int row) { return row < NTOK ? NMETA + (row & (SEQ - 1)) : row - NTOK; }
__device__ __forceinline__ int pos_row(int b, int p) { return p < NMETA ? NTOK + p : b * SEQ + (p - NMETA); }

constexpr size_t HM = 512u * 1024u;
constexpr size_t WS_CTL = 0, CTL_ZERO_BYTES = 2 * HM;
constexpr size_t WS_ROPE_M = 2 * HM;
constexpr size_t WS_ROPE_D = 5 * HM;
constexpr size_t WS_ROPE_I = 7 * HM;
constexpr size_t WS_SK   = 8 * HM;
constexpr size_t WS_WUQ  = 10 * HM;
constexpr size_t WS_WUKV = 22 * HM;
constexpr size_t WS_WBR  = 30 * HM;
constexpr size_t WS_WOUT = 94 * HM;
constexpr size_t WS_WQ   = 158 * HM;
constexpr size_t WS_EID  = 190 * HM;
constexpr size_t WS_GATE = 207 * HM;
constexpr size_t WS_MASK = 224 * HM;
constexpr size_t WS_KPE  = 242 * HM;
constexpr size_t WS_KIX  = 247 * HM;
constexpr size_t WS_WIX  = 252 * HM;
constexpr size_t WS_SCU  = 255 * HM;
constexpr size_t WS_SCV  = 255 * HM + 65536;
constexpr size_t WS_SX   = 255 * HM + 131072;
constexpr size_t WS_SW   = 255 * HM + 200704;
constexpr size_t WS_SWBR = 255 * HM + 294912;
constexpr size_t WS_SWOUT= 255 * HM + 311296;
constexpr size_t WS_SOAB = 255 * HM + 327680;
constexpr size_t WS_SMRG = 255 * HM + 393216;
constexpr size_t R23 = 260 * HM;
constexpr size_t WS_XN   = R23;
constexpr size_t WS_WIN  = R23 + 264 * HM;
constexpr size_t P1O = R23 + 484 * HM;
constexpr size_t WS_CQ   = P1O;
constexpr size_t WS_CKV  = P1O + 66 * HM;
constexpr size_t WS_QB   = P1O + 99 * HM;
constexpr size_t WS_KB   = P1O + 231 * HM;
constexpr size_t WS_VB   = P1O + 264 * HM;
constexpr size_t WS_QIX  = P1O + 297 * HM;
constexpr size_t WS_GA   = P1O + 363 * HM;
constexpr size_t WS_GB   = P1O + 627 * HM;
constexpr size_t R4 = P1O + 892 * HM;
constexpr size_t WS_OAB  = R4;
constexpr size_t WS_XN8  = R4;
constexpr size_t WS_WG8  = R4 + 132 * HM;
constexpr size_t WS_WUQ8 = R4 + 232 * HM;
constexpr size_t WS_WUKV8= R4 + 238 * HM;
constexpr size_t WS_SH1  = 255 * HM + 524288;
constexpr size_t WS_XMAX = 255 * HM + 589824;
constexpr size_t WS_SWQ  = 255 * HM + 657408;
constexpr size_t WS_WQ8  = R4 + 244 * HM;
constexpr size_t WS_H18  = R23 + 264 * HM;
constexpr size_t WS_SWUQ = 255 * HM + 458752;
constexpr size_t WS_SWUKV= 255 * HM + 475136;
constexpr size_t WS_PQ   = R4;
constexpr size_t WS_WBRS = R4 + 264 * HM;
constexpr size_t WS_END  = R4 + 328 * HM;
constexpr size_t WS_QN   = R23;
constexpr size_t WS_QR   = R23 + 132 * HM;
constexpr size_t WS_KN   = R23 + 198 * HM;
constexpr size_t WS_VA   = R23 + 330 * HM;
constexpr size_t WS_MRG  = R23;
constexpr size_t WS_U    = R23;
constexpr size_t WS_V    = R23 + 256 * HM;
constexpr size_t WS_H1F  = R23 + 512 * HM;
constexpr size_t WS_H1B  = R23 + 1040 * HM;
static_assert(WS_VA + 132 * HM <= P1O && WS_H1F >= P1O && WS_H1B + 264 * HM <= R4 && WS_GB + 264 * HM <= R4, "ws map");
constexpr int CW_TMO = 0;
constexpr int CW_BAR = 4096;
constexpr int CW_QUEUE = 8192;
constexpr int CW_VMAX = 12288;
constexpr int CW_SSQ_CQ = 16384, CW_SSQ_CKV = 16384 + 2 * 17408, CW_SSQ_H1 = 16384 + 4 * 17408;
constexpr int CW_SSQ_OA = 16384 + 6 * 17408, CW_SSQ_OB = 16384 + 8 * 17408;
constexpr int CW_WNORM = 12288 + 128;
constexpr int CW_WNORM2 = 12288 + 256;
constexpr int CW_SSQ_MRG = 16384 + 10 * 17408;
static_assert((CW_SSQ_MRG + 2 * 17408) * 4 <= (int)CTL_ZERO_BYTES, "ctl");

constexpr int RING_BYTES = 131072;
constexpr int LDSCTL_OFF = RING_BYTES;
constexpr int LDS_BYTES = 147456;

__device__ __forceinline__ unsigned f2bf(float f) { unsigned u = __float_as_uint(f); return (u + 0x7fffu + ((u >> 16) & 1u)) >> 16; }
__device__ __forceinline__ unsigned pk2(float lo, float hi) { return f2bf(lo) | (f2bf(hi) << 16); }
typedef __bf16 bf16x2_t __attribute__((ext_vector_type(2)));
__device__ __forceinline__ unsigned cvt_pk_bf16(float lo, float hi) { return __builtin_bit_cast(unsigned, __builtin_convertvector((f32x2){lo, hi}, bf16x2_t)); }
__device__ __forceinline__ float bf_lo(unsigned w) { return __uint_as_float(w << 16); }
__device__ __forceinline__ float bf_hi(unsigned w) { return __uint_as_float(w & 0xffff0000u); }
__device__ __forceinline__ u32x4 pack8(f32x4 a, f32x4 b) { u32x4 w; w.x = cvt_pk_bf16(a[0], a[1]); w.y = cvt_pk_bf16(a[2], a[3]); w.z = cvt_pk_bf16(b[0], b[1]); w.w = cvt_pk_bf16(b[2], b[3]); return w; }
__device__ __forceinline__ float wave_sum(float v) {
#pragma unroll
    for (int o = 1; o < 64; o <<= 1) v += __shfl_xor(v, o);
    return v;
}
#define LDS_WAIT() asm volatile("s_waitcnt lgkmcnt(0)" ::: "memory")
#define VM_WAIT() asm volatile("s_waitcnt vmcnt(0)" ::: "memory")
typedef unsigned long long u64;
__device__ __forceinline__ void ssq_add(u64* p, float v) { (void)__hip_atomic_fetch_add(p, (u64)(v * 16777216.0f), __ATOMIC_RELAXED, __HIP_MEMORY_SCOPE_AGENT); }
__device__ __forceinline__ void xhalf(float x, float& lo, float& hi) {
#if defined(__HIP_DEVICE_COMPILE__)
    const auto r = __builtin_amdgcn_permlane32_swap(__float_as_uint(x), __float_as_uint(x), false, false); lo = __uint_as_float(r[0]); hi = __uint_as_float(r[1]);
#else
    lo = x; hi = x;
#endif
}
__device__ __forceinline__ void xhalf_i(int x, int& lo, int& hi) {
#if defined(__HIP_DEVICE_COMPILE__)
    const auto r = __builtin_amdgcn_permlane32_swap((unsigned)x, (unsigned)x, false, false); lo = (int)r[0]; hi = (int)r[1];
#else
    lo = x; hi = x;
#endif
}
__device__ __forceinline__ float xhalf_max(float x) { float a, b; xhalf(x, a, b); return fmaxf(a, b); }
__device__ __forceinline__ float xhalf_sum(float x) { float a, b; xhalf(x, a, b); return a + b; }
__device__ __forceinline__ float xrow16_sum(float x) {
#if defined(__HIP_DEVICE_COMPILE__)
    const auto r = __builtin_amdgcn_permlane16_swap(__float_as_uint(x), __float_as_uint(x), false, false); return __uint_as_float(r[0]) + __uint_as_float(r[1]);
#else
    return x;
#endif
}
__device__ __forceinline__ float ssq_val(u64 v) { return (float)((double)v * (1.0 / 16777216.0)); }
__device__ __forceinline__ float ssq_get(const u64* p) { return ssq_val(*p); }
namespace pg8 {
#define PG8_LAS __attribute__((address_space(3)))
typedef unsigned short bf16_t;
typedef short bf16x8 __attribute__((ext_vector_type(8)));
typedef float f32x4 __attribute__((ext_vector_type(4)));
typedef unsigned u32x4 __attribute__((ext_vector_type(4)));
constexpr int BM = 256, BK = 64, HALF = 128, HTB = HALF * BK * 2  , STAGE_BYTES = 8 * HTB, NXCD = 8, WGM = 8;

__host__ __device__ __forceinline__ int lds_byte(int r, int c) { const int st = (r >> 4) * 2 + (c >> 5), rr = r & 15, cc = c & 31, ob = rr * 64 + cc * 2; return st * 1024 + (ob ^ (((ob >> 9) & 1) << 5)); }
__host__ __device__ __forceinline__ void stage_rc(int b, int& R, int& C) { const int st = b / 1024, sb = b % 1024, swz = sb ^ (((sb >> 9) & 1) << 5); R = (st >> 1) * 16 + swz / 64; C = (st & 1) * 32 + (swz % 64) / 2; }
__host__ __device__ __forceinline__ int perm32(int rho) { const int n = rho >> 4, i = rho & 15; return 8 * (i >> 2) + 4 * n + (i & 3); }

typedef int i32x4_t __attribute__((ext_vector_type(4)));
typedef int i32x8_t __attribute__((ext_vector_type(8)));
__device__ __forceinline__ i32x8_t cat8(bf16x8 lo, bf16x8 hi) { const i32x4_t a = __builtin_bit_cast(i32x4_t, lo), b = __builtin_bit_cast(i32x4_t, hi); return __builtin_shufflevector(a, b, 0, 1, 2, 3, 4, 5, 6, 7); }
__device__ __forceinline__ void mfma_f8_acc(f32x4& c, const i32x8_t a, const i32x8_t b) {
#if defined(__HIP_DEVICE_COMPILE__)
    int sc = 0x7F7F7F7F;
    asm volatile("v_mfma_scale_f32_16x16x128_f8f6f4 %0, %1, %2, %0, %3, %3 op_sel_hi:[0,0,0]" : "+v"(c) : "v"(a), "v"(b), "v"(sc));
#else
    (void)c; (void)a; (void)b;
#endif
}
struct Unit { int pm, pn, kh; };
struct Gemm { const bf16_t* A; const bf16_t* Bt; int M, N, K, KL; };

struct StaticOrder {
    int nM, nN, nwg, G, c;
    __host__ __device__ void init(int M, int N, int G_, int c_) { nM = M / BM; nN = N / BM; nwg = nM * nN; G = G_; c = c_; }
    __host__ __device__ bool next(int i, Unit& u) const {
        const long L = (long)i * G + c; if (L >= nwg) return false;
        int wgid = (int)L; { const int q = nwg / NXCD, r = nwg % NXCD, xcd = wgid % NXCD, off = wgid / NXCD; wgid = (xcd < r ? xcd * (q + 1) : r * (q + 1) + (xcd - r) * q) + off; }
        const int nig = WGM * nN, gid = wgid / nig, fm = gid * WGM, gsz = (nM - fm) < WGM ? (nM - fm) : WGM;
        u.pm = fm + ((wgid % nig) % gsz); u.pn = (wgid % nig) / gsz; u.kh = 0; return true;
    }
    __device__ __forceinline__ void a_ready(const Unit&) const {}
    __device__ __forceinline__ void done(const Unit&) const {}
};

struct StaticOrder2 {
    StaticOrder base;
    __host__ __device__ void init(int M, int N, int G_, int c_) { base.init(M, N, G_, c_); }
    __host__ __device__ bool next(int i, Unit& u) const { if (!base.next(i >> 1, u)) return false; u.kh = i & 1; return true; }
    __device__ __forceinline__ void a_ready(const Unit&) const {}
    __device__ __forceinline__ void done(const Unit&) const {}
};

template <class Epi, class Sched, bool ALIGN_EPI = false, bool SP2 = false>
__device__ __forceinline__ void gemm_phase(PG8_LAS unsigned char* lds, const Gemm g, const Sched& S, const Epi& E) {
    int tid_; asm volatile("v_mov_b32 %0, %1" : "=v"(tid_) : "v"(threadIdx.x));
    const int tid = tid_, wid = __builtin_amdgcn_readfirstlane(tid >> 6), lane = tid & 63, wr = wid >> 2, wc = wid & 3, fr = lane & 15, fq = lane >> 4;
    const int K = g.K, nt = g.KL / BK; const size_t khoff = (size_t)g.KL * 2;
    unsigned voffA[2], voffB[2];
#pragma unroll
    for (int i = 0; i < 2; ++i) { int R, C; stage_rc(tid * 16 + i * 8192, R, C); const int Rb = Epi::PERM ? ((R & ~31) + perm32(R & 31)) : R;
        voffA[i] = (unsigned)(R * K + C) * 2u; voffB[i] = (unsigned)(Rb * K + C) * 2u; }
    const size_t kstep = (size_t)(BK * 2);
    const size_t hstep = (size_t)HALF * K * 2;
    const size_t tstep = 2 * hstep;
    const unsigned ldsw = (unsigned)wid * 1024u;
    const int aoff = lds_byte(wr * 64 + fr, fq * 8), boff = lds_byte(wc * 32 + fr, fq * 8);
#define PG8_SA(b, h) (((b) * 2 + (h)) * HTB)
#define PG8_SB(b, h) ((4 + (b) * 2 + (h)) * HTB)
#define PG8_STAGE(bufoff, gbase, voff) do { _Pragma("unroll") for (int _i = 0; _i < 2; ++_i) \
        __builtin_amdgcn_global_load_lds((const unsigned*)((const char*)(gbase) + (voff)[_i]), (PG8_LAS unsigned*)(lds + (bufoff) + ldsw + _i * 8192), 16, 0, 0); } while (0)
#define PG8_LDA(dst, b, h) do { _Pragma("unroll") for (int m = 0; m < 4; ++m) _Pragma("unroll") for (int k = 0; k < 2; ++k) dst[m][k] = *(const PG8_LAS bf16x8*)(lds + PG8_SA(b, h) + aoff + m * 2048 + k * 1024); } while (0)
#define PG8_LDB(dst, b, h) do { _Pragma("unroll") for (int n = 0; n < 2; ++n) _Pragma("unroll") for (int k = 0; k < 2; ++k) dst[n][k] = *(const PG8_LAS bf16x8*)(lds + PG8_SB(b, h) + boff + n * 2048 + k * 1024); } while (0)
#define PG8_MMA(ai, bj, At, Bt) do { __builtin_amdgcn_s_setprio(1); _Pragma("unroll") for (int m = 0; m < 4; ++m) _Pragma("unroll") for (int n = 0; n < 2; ++n) { \
        if constexpr (Epi::FP8) mfma_f8_acc(acc[ai][bj][m][n], cat8(Bt[n][0], Bt[n][1]), cat8(At[m][0], At[m][1])); \
        else { _Pragma("unroll") for (int k = 0; k < 2; ++k) acc[ai][bj][m][n] = __builtin_amdgcn_mfma_f32_16x16x32_bf16(Bt[n][k], At[m][k], acc[ai][bj][m][n], 0, 0, 0); } } \
        __builtin_amdgcn_s_setprio(0); } while (0)
#define PG8_WAIT_V(n) asm volatile("s_waitcnt vmcnt(" #n ")" ::: "memory")
#define PG8_WAIT_L(n) asm volatile("s_waitcnt lgkmcnt(" #n ")" ::: "memory")
#define PG8_BAR __builtin_amdgcn_s_barrier()
#define PG8_SCHED __builtin_amdgcn_sched_barrier(0)
    Unit cur, nxt; int ui = 0;
    if (!S.next(0, cur)) return;
    f32x4 acc[2][2][4][2];
#pragma unroll
    for (int a = 0; a < 2; ++a)
#pragma unroll
        for (int b = 0; b < 2; ++b)
#pragma unroll
            for (int m = 0; m < 4; ++m)
#pragma unroll
                for (int n = 0; n < 2; ++n) acc[a][b][m][n] = (f32x4){0.f, 0.f, 0.f, 0.f};
    bf16x8 At[4][2], B0[2][2], B1[2][2];
    const char* cA = (const char*)g.A + (size_t)cur.pm * tstep + (size_t)cur.kh * khoff; const char* cB = (const char*)g.Bt + (size_t)cur.pn * tstep + (size_t)cur.kh * khoff;
    S.a_ready(cur);
    if constexpr (SP2) {
        PG8_STAGE(PG8_SB(0, 0), cB, voffB); PG8_STAGE(PG8_SB(0, 1), cB + hstep, voffB); PG8_STAGE(PG8_SA(0, 0), cA, voffA); PG8_STAGE(PG8_SA(0, 1), cA + hstep, voffA);
        if (wr == 1) PG8_BAR;
        PG8_WAIT_V(2); PG8_BAR;
        PG8_STAGE(PG8_SB(1, 0), cB + kstep, voffB); PG8_STAGE(PG8_SA(1, 0), cA + kstep, voffA); PG8_STAGE(PG8_SB(1, 1), cB + hstep + kstep, voffB);
        PG8_WAIT_V(6); PG8_BAR;
    } else {
        PG8_STAGE(PG8_SB(0, 0), cB, voffB); PG8_STAGE(PG8_SA(0, 0), cA, voffA); PG8_STAGE(PG8_SB(0, 1), cB + hstep, voffB); PG8_STAGE(PG8_SA(0, 1), cA + hstep, voffA);
        if (wr == 1) PG8_BAR;
        PG8_WAIT_V(4); PG8_BAR;
        PG8_STAGE(PG8_SB(1, 0), cB + kstep, voffB); PG8_STAGE(PG8_SA(1, 0), cA + kstep, voffA); PG8_STAGE(PG8_SB(1, 1), cB + hstep + kstep, voffB);
        PG8_WAIT_V(6); PG8_BAR;
    }
    for (;;) {
        const bool has_next = S.next(ui + 1, nxt);
        const char* nA = has_next ? (const char*)g.A + (size_t)nxt.pm * tstep + (size_t)nxt.kh * khoff : cA; const char* nB = has_next ? (const char*)g.Bt + (size_t)nxt.pn * tstep + (size_t)nxt.kh * khoff : cB;
        for (int t = 0; t < nt; t += 2) {
            const bool last = (t == nt - 2);
            const char* a1 = cA + (size_t)(t + 1) * kstep;
            const char* a2 = last ? nA : cA + (size_t)(t + 2) * kstep; const char* b2 = last ? nB : cB + (size_t)(t + 2) * kstep;
            const char* a3 = a2 + kstep; const char* b3 = b2 + kstep;
            if (last && has_next) S.a_ready(nxt);
            if constexpr (SP2) {
            PG8_LDB(B0, 0, 0); PG8_LDB(B1, 0, 1); PG8_SCHED; PG8_LDA(At, 0, 0); PG8_STAGE(PG8_SA(1, 1), a1 + hstep, voffA);
            PG8_WAIT_V(8); PG8_WAIT_L(0); PG8_BAR; PG8_MMA(0, 0, At, B0); PG8_MMA(0, 1, At, B1); PG8_BAR; PG8_SCHED;
            PG8_LDA(At, 0, 1); PG8_STAGE(PG8_SB(0, 0), b2, voffB); PG8_STAGE(PG8_SB(0, 1), b2 + hstep, voffB); PG8_STAGE(PG8_SA(0, 0), a2, voffA);
            PG8_WAIT_V(8); PG8_WAIT_L(0); PG8_BAR; PG8_MMA(1, 0, At, B0); PG8_MMA(1, 1, At, B1); PG8_BAR; PG8_SCHED;
            PG8_LDB(B0, 1, 0); PG8_LDB(B1, 1, 1); PG8_SCHED; PG8_LDA(At, 1, 0); PG8_STAGE(PG8_SA(0, 1), a2 + hstep, voffA);
            PG8_WAIT_V(8); PG8_WAIT_L(0); PG8_BAR; PG8_MMA(0, 0, At, B0); PG8_MMA(0, 1, At, B1); PG8_BAR; PG8_SCHED;
            PG8_LDA(At, 1, 1); PG8_STAGE(PG8_SB(1, 0), b3, voffB); PG8_STAGE(PG8_SB(1, 1), b3 + hstep, voffB); PG8_STAGE(PG8_SA(1, 0), a3, voffA);
            PG8_WAIT_V(8); PG8_WAIT_L(0); PG8_BAR; PG8_MMA(1, 0, At, B0); PG8_MMA(1, 1, At, B1); PG8_BAR; PG8_SCHED;
            } else {
            PG8_LDB(B0, 0, 0); PG8_SCHED; PG8_LDA(At, 0, 0); PG8_STAGE(PG8_SA(1, 1), a1 + hstep, voffA);
            PG8_WAIT_L(8); PG8_BAR; PG8_WAIT_L(0); PG8_MMA(0, 0, At, B0); PG8_BAR; PG8_SCHED;
            PG8_LDB(B1, 0, 1); PG8_STAGE(PG8_SB(0, 0), b2, voffB);
            PG8_BAR; PG8_WAIT_L(0); PG8_MMA(0, 1, At, B1); PG8_BAR;
            PG8_LDA(At, 0, 1); PG8_STAGE(PG8_SA(0, 0), a2, voffA);
            PG8_BAR; PG8_WAIT_L(0); PG8_MMA(1, 0, At, B0); PG8_BAR; PG8_SCHED;
            PG8_STAGE(PG8_SB(0, 1), b2 + hstep, voffB);
            PG8_WAIT_V(6); PG8_BAR; PG8_MMA(1, 1, At, B1); PG8_BAR;
            PG8_LDB(B0, 1, 0); PG8_SCHED; PG8_LDA(At, 1, 0); PG8_STAGE(PG8_SA(0, 1), a2 + hstep, voffA);
            PG8_WAIT_L(8); PG8_BAR; PG8_WAIT_L(0); PG8_MMA(0, 0, At, B0); PG8_BAR; PG8_SCHED;
            PG8_LDB(B1, 1, 1); PG8_STAGE(PG8_SB(1, 0), b3, voffB);
            PG8_BAR; PG8_WAIT_L(0); PG8_MMA(0, 1, At, B1); PG8_BAR;
            PG8_LDA(At, 1, 1); PG8_STAGE(PG8_SA(1, 0), a3, voffA);
            PG8_BAR; PG8_WAIT_L(0); PG8_MMA(1, 0, At, B0); PG8_BAR; PG8_SCHED;
            PG8_STAGE(PG8_SB(1, 1), b3 + hstep, voffB);
            PG8_WAIT_V(6); PG8_BAR; PG8_MMA(1, 1, At, B1); PG8_BAR;
            }
        }
        if constexpr (ALIGN_EPI) { if (wr == 0) PG8_BAR; }
        if constexpr (!Epi::AFTER_DRAIN) { E(acc, cur, wr, wc, fr, fq); S.done(cur); }
        if (!has_next) break;
        if (!(Epi::SPLITK2 && cur.kh == 0))
#pragma unroll
        for (int a = 0; a < 2; ++a)
#pragma unroll
            for (int b = 0; b < 2; ++b)
#pragma unroll
                for (int m = 0; m < 4; ++m)
#pragma unroll
                    for (int n = 0; n < 2; ++n) acc[a][b][m][n] = (f32x4){0.f, 0.f, 0.f, 0.f};
        cur = nxt; cA = nA; cB = nB; ++ui;
        if constexpr (ALIGN_EPI) { if (wr == 1) PG8_BAR; }
    }
    PG8_WAIT_V(0);
    if constexpr (!ALIGN_EPI) { if (wr == 0) PG8_BAR; }
    PG8_BAR;
    if constexpr (Epi::AFTER_DRAIN) { E.fused(acc, cur, wr, wc, fr, fq, lds, wid, lane); S.done(cur); }
#undef PG8_SA
#undef PG8_SB
#undef PG8_STAGE
#undef PG8_LDA
#undef PG8_LDB
#undef PG8_MMA
#undef PG8_WAIT_V
#undef PG8_WAIT_L
#undef PG8_BAR
#undef PG8_SCHED
}
}
namespace epi {
using pg8::Unit;
typedef f32x4 Acc[2][2][4][2];

__device__ __forceinline__ void rot2(f32x4& v, const f32x4 cs) {
    const float a1 = v[0] * cs[0] - v[1] * cs[1], a2 = v[1] * cs[0] + v[0] * cs[1];
    const float b1 = v[2] * cs[2] - v[3] * cs[3], b2 = v[3] * cs[2] + v[2] * cs[3];
    v = (f32x4){a1, a2, b1, b2};
}
__device__ __forceinline__ float sigm(float x) { return 1.0f / (1.0f + __expf(-x)); }
__device__ __forceinline__ void vmax_publish(unsigned* word, float mx) {
#pragma unroll
    for (int o = 1; o < 64; o <<= 1) mx = fmaxf(mx, __shfl_xor(mx, o));
    if ((threadIdx.x & 63) == 0) atomicMax(word, __float_as_uint(mx));
}
__device__ __forceinline__ float amax8(f32x4 a, f32x4 b) { return fmaxf(fmaxf(fmaxf(fabsf(a[0]), fabsf(a[1])), fmaxf(fabsf(a[2]), fabsf(a[3]))), fmaxf(fmaxf(fabsf(b[0]), fabsf(b[1])), fmaxf(fabsf(b[2]), fabsf(b[3])))); }
__device__ __forceinline__ void unpack8_fp8(const u32x2 w, f32x4& a, f32x4& b) {
    const f32x2 p0 = __builtin_amdgcn_cvt_pk_f32_fp8((int)w.x, false), p1 = __builtin_amdgcn_cvt_pk_f32_fp8((int)w.x, true), p2 = __builtin_amdgcn_cvt_pk_f32_fp8((int)w.y, false), p3 = __builtin_amdgcn_cvt_pk_f32_fp8((int)w.y, true);
    a = (f32x4){p0.x, p0.y, p1.x, p1.y}; b = (f32x4){p2.x, p2.y, p3.x, p3.y};
}
__device__ __forceinline__ float sat8(float x) { return fminf(fmaxf(x, -448.0f), 448.0f); }
__device__ __forceinline__ u32x2 pack8_fp8(f32x4 a, f32x4 b) {
    int p0 = 0, p1 = 0;
    p0 = __builtin_amdgcn_cvt_pk_fp8_f32(sat8(a[0]), sat8(a[1]), p0, false); p0 = __builtin_amdgcn_cvt_pk_fp8_f32(sat8(a[2]), sat8(a[3]), p0, true);
    p1 = __builtin_amdgcn_cvt_pk_fp8_f32(sat8(b[0]), sat8(b[1]), p1, false); p1 = __builtin_amdgcn_cvt_pk_fp8_f32(sat8(b[2]), sat8(b[3]), p1, true);
    return (u32x2){(unsigned)p0, (unsigned)p1};
}
__device__ __forceinline__ size_t gate_frag_off(int pm, int j, int wr, int wc, int ai, int m, int lane) {
    return ((((size_t)(pm * 16 + j) * 8 + (wr * 4 + wc)) * 8 + (ai * 4 + m)) * 64 + lane) * 16;
}
__device__ __forceinline__ void store_fp8_pair16(unsigned char* rowp, int fq, u32x2 p0, u32x2 p1) {
#if defined(__HIP_DEVICE_COMPILE__)
    const auto rx = __builtin_amdgcn_permlane16_swap(p0.x, p1.x, false, false);
    const auto ry = __builtin_amdgcn_permlane16_swap(p0.y, p1.y, false, false);
    *(u32x4*)(rowp + ((fq & 1) ? 128 : 0) + ((fq >> 1) ? 16 : 0)) = (u32x4){rx[0], ry[0], rx[1], ry[1]};
#else
    (void)rowp; (void)fq; (void)p0; (void)p1;
#endif
}

template <bool F8> struct EpiIn {
    static constexpr bool PERM = true, AFTER_DRAIN = false, SPLITK2 = false, FP8 = F8;
    bf16_t *cq, *ckv, *qb, *kb, *vb, *qix, *kpe, *kix, *ga, *gb; float* wix; u64 *ssq_cq, *ssq_ckv;
    const float *ropeM, *ropeD, *ropeI;
    unsigned* vmaxw;
    const float *sx, *sw;
    __device__ __forceinline__ void operator()(const Acc& acc, const Unit& u, int wr, int wc, int fr, int fq) const {
        const int vt = F8 ? (u.pn < 18 ? u.pn : u.pn + 5) : u.pn + 18, rowb = u.pm * 256 + wr * 64 + fr, ct = wc * 32 + 8 * fq;
        f32x4 wsc[2][2];
        if (F8) {
#pragma unroll
            for (int bj = 0; bj < 2; ++bj) { const f32x4* p = (const f32x4*)(sw + u.pn * 256 + ct + bj * 128); wsc[bj][0] = p[0]; wsc[bj][1] = p[1]; }
        }
#define AV(ai_, bj_, m_, n_) (F8 ? acc[ai_][bj_][m_][n_] * rs * wsc[bj_][n_] : acc[ai_][bj_][m_][n_])
        if (vt < 6) {
            bf16_t* dst = vt < 4 ? cq : ckv; const int ld = vt < 4 ? 1024 : 512, cb = (vt < 4 ? vt : vt - 4) * 256 + ct; u64* ssq = vt < 4 ? ssq_cq : ssq_ckv;
#pragma unroll
            for (int ai = 0; ai < 2; ++ai)
#pragma unroll
                for (int m = 0; m < 4; ++m) { const int row = rowb + ai * 128 + m * 16; const float rs = F8 ? sx[row] : 1.f; (void)rs; float s = 0.f; u32x2 pk[2];
#pragma unroll
                    for (int bj = 0; bj < 2; ++bj) { const f32x4 v0 = AV(ai, bj, m, 0), v1 = AV(ai, bj, m, 1);
                        s += (v0[0] * v0[0] + v0[1] * v0[1]) + (v0[2] * v0[2] + v0[3] * v0[3]) + (v1[0] * v1[0] + v1[1] * v1[1]) + (v1[2] * v1[2] + v1[3] * v1[3]);
                        pk[bj] = pack8_fp8(v0, v1); }
                    store_fp8_pair16((unsigned char*)dst + (size_t)row * ld + (cb - 8 * fq), fq, pk[0], pk[1]);
                    s = xrow16_sum(s); s = xhalf_sum(s);
                    if (fq == 0 && ssq) ssq_add(ssq + row, s); }
        } else if (vt < 16) {
            const bool isq = vt < 14; bf16_t* dst = isq ? qb : kb; const int ld = isq ? 2048 : 512, cb = (isq ? vt - 6 : vt - 14) * 256 + ct;
#pragma unroll
            for (int ai = 0; ai < 2; ++ai)
#pragma unroll
                for (int m = 0; m < 4; ++m) { const int row = rowb + ai * 128 + m * 16, t = row_pos(row); const float rs = F8 ? sx[row] : 1.f; (void)rs;
                    f32x4 cs0 = (f32x4){1.f, 0.f, 1.f, 0.f}, cs1 = cs0;
                    if (wc == 0) { const f32x4* p = (const f32x4*)(ropeD + ((size_t)t * 16 + 4 * fq) * 2); cs0 = p[0]; cs1 = p[1]; }
                    u32x2 pk[2];
#pragma unroll
                    for (int bj = 0; bj < 2; ++bj) { f32x4 v0 = AV(ai, bj, m, 0), v1 = AV(ai, bj, m, 1);
                        if (wc == 0) { rot2(v0, cs0); rot2(v1, cs1); }
                        pk[bj] = pack8_fp8(v0, v1); }
                    store_fp8_pair16((unsigned char*)dst + (size_t)row * ld + (cb - 8 * fq), fq, pk[0], pk[1]); }
        } else if (vt < 18) {
            const int cb = (vt - 16) * 256 + ct; float vmx = 0.f;
#pragma unroll
            for (int ai = 0; ai < 2; ++ai)
#pragma unroll
                for (int m = 0; m < 4; ++m) { const int row = rowb + ai * 128 + m * 16; const float rs = F8 ? sx[row] : 1.f; (void)rs;
                    u32x2 pk[2];
#pragma unroll
                    for (int bj = 0; bj < 2; ++bj) { const f32x4 v0 = AV(ai, bj, m, 0), v1 = AV(ai, bj, m, 1); vmx = fmaxf(vmx, amax8(v0, v1)); pk[bj] = pack8_fp8(v0, v1); }
                    store_fp8_pair16((unsigned char*)vb + (size_t)row * 512 + (cb - 8 * fq), fq, pk[0], pk[1]); }
            vmax_publish(vmaxw, vmx);
        } else if (vt < 22) {
            const int cb = (vt - 18) * 256 + ct; const bool rt = ((wc & 1) == 0) && (fq < 2);
#pragma unroll
            for (int ai = 0; ai < 2; ++ai)
#pragma unroll
                for (int m = 0; m < 4; ++m) { const int row = rowb + ai * 128 + m * 16, t = row_pos(row); const float rs = F8 ? sx[row] : 1.f; (void)rs;
                    f32x4 cs0 = (f32x4){1.f, 0.f, 1.f, 0.f}, cs1 = cs0;
                    if (rt) { const f32x4* p = (const f32x4*)(ropeI + ((size_t)t * 8 + 4 * fq) * 2); cs0 = p[0]; cs1 = p[1]; }
#pragma unroll
                    for (int bj = 0; bj < 2; ++bj) { f32x4 v0 = AV(ai, bj, m, 0), v1 = AV(ai, bj, m, 1);
                        if (rt) { rot2(v0, cs0); rot2(v1, cs1); }
                        *(u32x4*)(qix + (size_t)row * 1024 + cb + bj * 128) = pack8(v0, v1); } }
        } else if (vt == 22) {
#pragma unroll
            for (int ai = 0; ai < 2; ++ai)
#pragma unroll
                for (int m = 0; m < 4; ++m) { const int row = rowb + ai * 128 + m * 16, t = row_pos(row); const float rs = F8 ? sx[row] : 1.f; (void)rs;
                    f32x4 v0 = AV(ai, 0, m, 0), v1 = AV(ai, 0, m, 1);
                    if (wc < 2) { const f32x4* p = (const f32x4*)(ropeM + ((size_t)t * 32 + 16 * wc + 4 * fq) * 2); rot2(v0, p[0]); rot2(v1, p[1]);
                        *(u32x2*)((unsigned char*)kpe + (size_t)row * 64 + ct) = pack8_fp8(v0, v1);
                    } else { if (wc == 2 && fq < 2) { const f32x4* p = (const f32x4*)(ropeI + ((size_t)t * 8 + 4 * fq) * 2); rot2(v0, p[0]); rot2(v1, p[1]); }
                        *(u32x4*)(kix + (size_t)row * 64 + (ct - 64)) = pack8(v0, v1); }
                    if (wc == 0 && fq < 2) { float* w = wix + (size_t)row * 16 + 8 * fq; *(f32x4*)w = AV(ai, 1, m, 0); *(f32x4*)(w + 4) = AV(ai, 1, m, 1); } }
        } else {
            const bool isa = vt < 39; bf16_t* dst = isa ? ga : gb; const int cb = (isa ? vt - 23 : vt - 39) * 256 + ct;
#pragma unroll
            for (int ai = 0; ai < 2; ++ai)
#pragma unroll
                for (int m = 0; m < 4; ++m) { const int row = rowb + ai * 128 + m * 16; const float rs = F8 ? sx[row] : 1.f; (void)rs;
                    u32x2 pk[2];
#pragma unroll
                    for (int bj = 0; bj < 2; ++bj) { f32x4 v0 = AV(ai, bj, m, 0), v1 = AV(ai, bj, m, 1);
#pragma unroll
                        for (int e = 0; e < 4; ++e) { v0[e] = 256.0f * sigm(v0[e]); v1[e] = 256.0f * sigm(v1[e]); }
                        pk[bj] = pack8_fp8(v0, v1); }
                    *(u32x4*)((unsigned char*)dst + gate_frag_off(u.pm, isa ? vt - 23 : vt - 39, wr, wc, ai, m, fr + 16 * fq)) = (u32x4){pk[0].x, pk[0].y, pk[1].x, pk[1].y}; }
        }
#undef AV
    }
};

struct EpiUp {
    static constexpr bool PERM = true, AFTER_DRAIN = false, SPLITK2 = false, FP8 = true;
    unsigned char *d0, *d1; int nt0, ld0, ld1; bool d1_v; const u64* ssq; float invK; const float* rope; const float* sw; unsigned* vmaxw;
    __device__ __forceinline__ void operator()(const Acc& acc, const Unit& u, int wr, int wc, int fr, int fq) const {
        const int vt = u.pn, rowb = u.pm * 256 + wr * 64 + fr, ct = wc * 32 + 8 * fq; const bool first = vt < nt0;
        unsigned char* dst = first ? d0 : d1; const int ld = first ? ld0 : ld1, cb = (first ? vt : vt - nt0) * 256 + ct; const bool rt = (!first) && (rope != nullptr), isv = (!first) && d1_v;
        f32x4 w0[2], w1[2]; float vmx = 0.f;
#pragma unroll
        for (int bj = 0; bj < 2; ++bj) { const f32x4* p = (const f32x4*)(sw + vt * 256 + ct + bj * 128); w0[bj] = p[0]; w1[bj] = p[1]; }
#pragma unroll
        for (int ai = 0; ai < 2; ++ai)
#pragma unroll
            for (int m = 0; m < 4; ++m) { const int row = rowb + ai * 128 + m * 16, t = row_pos(row);
                const float rs = __builtin_amdgcn_rsqf(ssq_get(ssq + row) * invK + EPS);
                f32x4 cs0 = (f32x4){1.f, 0.f, 1.f, 0.f}, cs1 = cs0;
                if (rt) { const f32x4* p = (const f32x4*)(rope + ((size_t)t * 32 + 16 * (wc & 1) + 4 * fq) * 2); cs0 = p[0]; cs1 = p[1]; }
                u32x2 pku[2];
#pragma unroll
                for (int bj = 0; bj < 2; ++bj) { f32x4 v0 = acc[ai][bj][m][0] * rs * w0[bj], v1 = acc[ai][bj][m][1] * rs * w1[bj];
                    if (rt) { rot2(v0, cs0); rot2(v1, cs1); }
                    if (isv) vmx = fmaxf(vmx, amax8(v0, v1));
                    pku[bj] = pack8_fp8(v0, v1); }
                store_fp8_pair16(dst + (size_t)row * ld + (cb - 8 * fq), fq, pku[0], pku[1]); }
        if (isv) vmax_publish(vmaxw, vmx);
    }
};

struct EpiBranch {
    static constexpr bool PERM = true, AFTER_DRAIN = false, SPLITK2 = true, FP8 = true;
    const bf16_t *ga, *gb; unsigned char* out; const unsigned* vmaxw; const float* scol; const u64 *ssqa, *ssqb; const unsigned* wnorm; float* smrg; u64* ssqm;
    __device__ __forceinline__ void operator()(Acc& acc, const Unit& u, int wr, int wc, int fr, int fq) const {
        const int rowb = u.pm * 256 + wr * 64 + fr, cb = u.pn * 256 + wc * 32 + 8 * fq;
        const float vmb = fmaxf(__uint_as_float(vmaxw[0]), 1e-30f), vma = fmaxf(__uint_as_float(vmaxw[64]), 1e-30f);
        if (u.kh == 0) {
            const float rab = vma * __builtin_amdgcn_rcpf(vmb);
#pragma unroll
            for (int ai = 0; ai < 2; ++ai) {
                u32x2 ra[4][2], rb[4][2];
#pragma unroll
                for (int m = 0; m < 4; ++m) { const size_t ro = gate_frag_off(u.pm, u.pn, wr, wc, ai, m, fr + 16 * fq);
                    const u32x4 va = *(const u32x4*)((const unsigned char*)ga + ro), vb = *(const u32x4*)((const unsigned char*)gb + ro);
                    ra[m][0] = (u32x2){va.x, va.y}; ra[m][1] = (u32x2){va.z, va.w}; rb[m][0] = (u32x2){vb.x, vb.y}; rb[m][1] = (u32x2){vb.z, vb.w}; }
#pragma unroll
                for (int m = 0; m < 4; ++m)
#pragma unroll
                    for (int bj = 0; bj < 2; ++bj) { f32x4 a0, a1, b0, b1; unpack8_fp8(ra[m][bj], a0, a1); unpack8_fp8(rb[m][bj], b0, b1);
                        f32x4 r0, r1;
#pragma unroll
                        for (int e = 0; e < 4; ++e) { r0[e] = a0[e] * __builtin_amdgcn_rcpf(fmaxf(b0[e], 0.001953125f)); r1[e] = a1[e] * __builtin_amdgcn_rcpf(fmaxf(b1[e], 0.001953125f)); }
                        acc[ai][bj][m][0] = acc[ai][bj][m][0] * (r0 * rab); acc[ai][bj][m][1] = acc[ai][bj][m][1] * (r1 * rab); }
                asm volatile("" ::: "memory"); }
        } else {
            f32x4 w0[2], w1[2];
#pragma unroll
            for (int bj = 0; bj < 2; ++bj) { const f32x4* p = (const f32x4*)(scol + cb + bj * 128); w0[bj] = p[0]; w1[bj] = p[1]; }
            const float ca = sqrtf(__uint_as_float(wnorm[0])), cbn = sqrtf(__uint_as_float(wnorm[64]));
            const float rs = vmb * (1.0f / 440.0f);
            float qs[2][4];
            {   u64 sa[2][4], sb[2][4];
#pragma unroll
                for (int ai = 0; ai < 2; ++ai)
#pragma unroll
                    for (int m = 0; m < 4; ++m) { const int row = rowb + ai * 128 + m * 16; sa[ai][m] = ssqa[row]; sb[ai][m] = ssqb[row]; }
#pragma unroll
                for (int ai = 0; ai < 2; ++ai)
#pragma unroll
                    for (int m = 0; m < 4; ++m) { const int row = rowb + ai * 128 + m * 16;
                        const float bound = fmaxf(sqrtf(ssq_val(sa[ai][m])) * ca + sqrtf(ssq_val(sb[ai][m])) * cbn, 1e-30f); qs[ai][m] = 380.0f / bound;
                        if (u.pn == 0 && wc == 0 && fq == 0) smrg[row] = bound * (1.0f / 380.0f); }
            }
#pragma unroll
            for (int ai = 0; ai < 2; ++ai) {
                u32x2 rb[4][2];
#pragma unroll
                for (int m = 0; m < 4; ++m) { const u32x4 vb = *(const u32x4*)((const unsigned char*)gb + gate_frag_off(u.pm, u.pn, wr, wc, ai, m, fr + 16 * fq));
                    rb[m][0] = (u32x2){vb.x, vb.y}; rb[m][1] = (u32x2){vb.z, vb.w}; }
#pragma unroll
                for (int m = 0; m < 4; ++m) { const int row = rowb + ai * 128 + m * 16; float sq = 0.f; u32x2 pk[2];
#pragma unroll
                    for (int bj = 0; bj < 2; ++bj) { f32x4 s0, s1; unpack8_fp8(rb[m][bj], s0, s1);
                        s0 = s0 * (rs * (1.0f / 256.0f) * qs[ai][m]) * w0[bj]; s1 = s1 * (rs * (1.0f / 256.0f) * qs[ai][m]) * w1[bj];
                        const f32x4 t0 = acc[ai][bj][m][0] * s0, t1 = acc[ai][bj][m][1] * s1;
                        sq += (t0[0] * t0[0] + t0[1] * t0[1]) + (t0[2] * t0[2] + t0[3] * t0[3]) + (t1[0] * t1[0] + t1[1] * t1[1]) + (t1[2] * t1[2] + t1[3] * t1[3]);
                        pk[bj] = pack8_fp8(t0, t1); }
                    store_fp8_pair16(out + (size_t)row * 8192 + (cb - 8 * fq), fq, pk[0], pk[1]);
                    sq = xrow16_sum(sq); sq = xhalf_sum(sq);
                    if (fq == 0 && ssqm) { const float iq = __builtin_amdgcn_rcpf(qs[ai][m]); ssq_add(ssqm + row, sq * iq * iq * 1.002f); } }
                asm volatile("" ::: "memory"); }
        }
    }
};

struct EpiOut {
    static constexpr bool PERM = true, AFTER_DRAIN = false, SPLITK2 = false, FP8 = true;
    const float *x, *meta; float* h1f; bf16_t* h1b; u64* ssq; const float *srow, *scol;
    unsigned char* h18; float* sh1; const float* xmax; const u64* ssqm; const unsigned* wn2;
    __device__ __forceinline__ void operator()(const Acc& acc, const Unit& u, int wr, int wc, int fr, int fq) const {
        const int rowb = u.pm * 256 + wr * 64 + fr, cb = u.pn * 256 + wc * 32 + 8 * fq;
#pragma unroll
        for (int ai = 0; ai < 2; ++ai)
#pragma unroll
            for (int m = 0; m < 4; ++m) { const int row = rowb + ai * 128 + m * 16;
                const float* src = x + (size_t)row * DM;
                float s = 0.f; const float rs = srow[row];
                const float wn = sqrtf(__uint_as_float(wn2[0]) + __uint_as_float(wn2[64]));
                const float hb = fmaxf(xmax[row] + sqrtf(ssq_val(ssqm[row])) * wn, 1e-30f), hq = 380.0f / hb;
                if (u.pn == 0 && wc == 0 && fq == 0) sh1[row] = hb * (1.0f / 380.0f);
                u32x2 pk8[2];
#pragma unroll
                for (int bj = 0; bj < 2; ++bj) { const f32x4* wp = (const f32x4*)(scol + cb + bj * 128); f32x4 v0 = acc[ai][bj][m][0] * rs * wp[0], v1 = acc[ai][bj][m][1] * rs * wp[1];
                    v0 = v0 + *(const f32x4*)(src + cb + bj * 128); v1 = v1 + *(const f32x4*)(src + cb + bj * 128 + 4);
                    s += (v0[0] * v0[0] + v0[1] * v0[1]) + (v0[2] * v0[2] + v0[3] * v0[3]) + (v1[0] * v1[0] + v1[1] * v1[1]) + (v1[2] * v1[2] + v1[3] * v1[3]);
                    *(u32x4*)(h1b + (size_t)row * DM + cb + bj * 128) = pack8(v0, v1);
                    pk8[bj] = pack8_fp8(v0 * hq, v1 * hq); }
                store_fp8_pair16(h18 + (size_t)row * DM + (cb - 8 * fq), fq, pk8[0], pk8[1]);
                s = xrow16_sum(s); s = xhalf_sum(s);
                if (fq == 0 && ssq) ssq_add(ssq + row, s); }
    }
};

struct EpiPQ {
    static constexpr bool PERM = true, AFTER_DRAIN = false, SPLITK2 = false, FP8 = true;
    bf16_t* pq; const u64* ssq; const float *srow, *scol;
    __device__ __forceinline__ void operator()(const Acc& acc, const Unit& u, int wr, int wc, int fr, int fq) const {
        const int rowb = u.pm * 256 + wr * 64 + fr, cb = u.pn * 256 + wc * 32 + 8 * fq;
#pragma unroll
        for (int ai = 0; ai < 2; ++ai)
#pragma unroll
            for (int m = 0; m < 4; ++m) { const int row = rowb + ai * 128 + m * 16; const float rs = __builtin_amdgcn_rsqf(ssq_get(ssq + row) * (1.0f / DM) + EPS) * srow[row];
#pragma unroll
                for (int bj = 0; bj < 2; ++bj) { const f32x4* wp = (const f32x4*)(scol + cb + bj * 128);
                    *(u32x4*)(pq + (size_t)row * 2048 + cb + bj * 128) = pack8(acc[ai][bj][m][0] * rs * wp[0], acc[ai][bj][m][1] * rs * wp[1]); } }
    }
};
}
#define XB_TMO      128
#define XB_XCNT(j)  (256  + 64 * (j))
#define XB_XSUB(j)  (1280 + 64 * (j))
#define XB_XGEN(j)  (2304 + 64 * (j))
#define XB_TOP      3328
#define XB_TOPGEN   3392
#define XCD_BAR_WORDS 3456
#define XB_SPIN_CAP (1u << 18)
__device__ __forceinline__ unsigned xb_ld(unsigned* p)              { return __hip_atomic_load(p, __ATOMIC_RELAXED, __HIP_MEMORY_SCOPE_AGENT); }
__device__ __forceinline__ unsigned xb_add(unsigned* p, unsigned v) { return __hip_atomic_fetch_add(p, v, __ATOMIC_RELAXED, __HIP_MEMORY_SCOPE_AGENT); }
__device__ __forceinline__ unsigned xb_xcc_id() { return (unsigned)__builtin_amdgcn_s_getreg((3 << 11) | 20) & 0xFu; }
#define XB_SPIN(cond, bar) do { unsigned _sp = 0; while (cond) { __builtin_amdgcn_s_sleep(1); \
    if ((++_sp & 255u) == 0u) { if (xb_ld(&(bar)[XB_TMO])) break; if (_sp > XB_SPIN_CAP) { atomicAdd(&(bar)[XB_TMO], 1u); break; } } } } while (0)
struct XcdBarrier { unsigned* bar; unsigned x; volatile LAS unsigned* st; };
__device__ __forceinline__ XcdBarrier xcd_barrier_post(unsigned* bar, volatile LAS unsigned* st) {
    XcdBarrier b; b.bar = bar; b.x = xb_xcc_id(); b.st = st;
    if (threadIdx.x == 0) (void)xb_add(&bar[XB_XCNT(b.x)], 1u);
    return b;
}
__device__ __forceinline__ void xcd_barrier_complete(unsigned* bar, unsigned x, unsigned& nloc, unsigned& nx) {
    const unsigned G = gridDim.x * gridDim.y * gridDim.z;
    unsigned sum, cnt, mine, sp = 0u;
    for (;;) {
        sum = 0u; cnt = 0u; mine = 0u;
#pragma unroll
        for (unsigned j = 0; j < 16; ++j) { const unsigned c = xb_ld(&bar[XB_XCNT(j)]); sum += c; cnt += (c > 0u) ? 1u : 0u; mine = (j == x) ? c : mine; }
        if (sum == G) break;
        __builtin_amdgcn_s_sleep(1);
        if ((++sp & 255u) == 0u) { if (xb_ld(&bar[XB_TMO])) break; if (sp > XB_SPIN_CAP) { atomicAdd(&bar[XB_TMO], 1u); break; } }
    }
    nloc = mine > 0u ? mine : 1u; nx = cnt > 0u ? cnt : 1u;
}
__device__ __forceinline__ void xcd_barrier(const XcdBarrier& b) {
    asm volatile("s_waitcnt vmcnt(0)" ::: "memory");
    __syncthreads();
    if (threadIdx.x == 0) {
        unsigned* bar = b.bar;
        __builtin_amdgcn_s_waitcnt(0);
        unsigned nloc = b.st[0], nx = b.st[1];
        if (nloc == 0u) { xcd_barrier_complete(bar, b.x, nloc, nx); b.st[0] = nloc; b.st[1] = nx; }
        const unsigned old = xb_add(&bar[XB_XSUB(b.x)], 1u);
        const unsigned gen = old / nloc;
        if (old + 1u == (gen + 1u) * nloc) {
            __builtin_amdgcn_fence(__ATOMIC_RELEASE, "agent");
            asm volatile("s_waitcnt vmcnt(0)" ::: "memory");
            const unsigned og = xb_add(&bar[XB_TOP], 1u);
            const unsigned tg = og / nx;
            if (og + 1u == (tg + 1u) * nx) xb_add(&bar[XB_TOPGEN], 1u);
            else XB_SPIN(xb_ld(&bar[XB_TOPGEN]) == tg, bar);
            __builtin_amdgcn_fence(__ATOMIC_ACQUIRE, "agent");
            xb_add(&bar[XB_XGEN(b.x)], 1u);
            asm volatile("s_waitcnt vmcnt(0)" ::: "memory");
        } else {
            XB_SPIN(xb_ld(&bar[XB_XGEN(b.x)]) == gen, bar);
            __builtin_amdgcn_fence(__ATOMIC_ACQUIRE, "agent");
            asm volatile("s_waitcnt vmcnt(0)" ::: "memory");
        }
    }
    __syncthreads();
}

struct Frame {
    LAS unsigned char* lds;
    unsigned char* ws;
    unsigned* ctl;
    int tid, lane, wave, vcu, G;
    __device__ __forceinline__ const float* in(int i) const { return ((const float* const __attribute__((address_space(4)))*)__builtin_amdgcn_kernarg_segment_ptr())[i]; }
    __device__ __forceinline__ float* out() const { return ((float* const __attribute__((address_space(4)))*)__builtin_amdgcn_kernarg_segment_ptr())[16]; }
};

struct MapId { __device__ __forceinline__ int operator()(int v) const { return v; } };
struct MapIn { __device__ __forceinline__ int operator()(int vn) const {
    const int v = vn < 1280 ? vn + 4608 : (vn < 5888 ? vn - 1280 : vn);
    if (v < 1536) return v;
    if (v < 3584) { const int w = v - 1536, hd = w >> 7; int o = w & 127; if (o < 32) o = (o & 1) ? (o >> 1) + 16 : (o >> 1); return 1600 + hd * 128 + o; }
    if (v < 4096) { const int w = v - 3584, hd = w >> 7; int o = w & 127; if (o < 32) o = (o & 1) ? (o >> 1) + 16 : (o >> 1); return 3648 + hd * 128 + o; }
    if (v < 4608) return 4160 + (v - 4096);
    if (v < 5632) { const int w = v - 4608, hd = w >> 6; int o = w & 63; if (o < 16) o = (o & 1) ? (o >> 1) + 8 : (o >> 1); return 4672 + hd * 64 + o; }
    if (v < 5888) { const int w = v - 5632;
        if (w < 64) return 1536 + ((w & 1) ? (w >> 1) + 32 : (w >> 1));
        if (w < 128) { int o = w - 64; if (o < 16) o = (o & 1) ? (o >> 1) + 8 : (o >> 1); return 5696 + o; }
        if (w < 144) return 5760 + (w - 128);
        return -1; }
    if (v < 9984) return 5776 + (v - 5888);
    return 9872 + (v - 9984);
} };
struct MapUq { __device__ __forceinline__ int operator()(int v) const {
    if (v < 2048) return (v >> 7) * 192 + (v & 127);
    const int w = v - 2048, hd = w >> 6, o = w & 63; return hd * 192 + 128 + ((o & 1) ? (o >> 1) + 32 : (o >> 1)); } };
struct MapUkv { __device__ __forceinline__ int operator()(int v) const {
    if (v < 2048) return (v >> 7) * 256 + (v & 127);
    const int w = v - 2048; return (w >> 7) * 256 + 128 + (w & 127); } };

template <class Map>
__device__ __forceinline__ void p0_transpose_item(const float* W, int K, int Nsrc, int Nvirt, bf16_t* WT, const float* gk, LAS float* scr, int item, int lane, Map map) {
    const int nblk = Nvirt / 32, kb = item / nblk, nb = item % nblk, k0 = 64 * kb, n0 = 32 * nb;
    const int sc = map(n0 + (lane & 31));
    float tv[32];
#pragma unroll
    for (int i = 0; i < 32; ++i) { const int kk = 2 * i + (lane >> 5); tv[i] = (sc >= 0) ? W[(size_t)(k0 + kk) * Nsrc + sc] : 0.f; }
    if (gk) {
#pragma unroll
        for (int i = 0; i < 32; ++i) tv[i] *= gk[k0 + 2 * i + (lane >> 5)]; }
#pragma unroll
    for (int i = 0; i < 32; ++i) scr[(2 * i + (lane >> 5)) * 33 + (lane & 31)] = tv[i];
    LDS_WAIT(); asm volatile("" ::: "memory");
    const int c = lane & 7;
#pragma unroll
    for (int j = 0; j < 4; ++j) { const int n = (lane >> 3) + 8 * j; const LAS float* s = scr + (8 * c) * 33 + n;
        u32x4 o; o.x = pk2(s[0 * 33], s[1 * 33]); o.y = pk2(s[2 * 33], s[3 * 33]); o.z = pk2(s[4 * 33], s[5 * 33]); o.w = pk2(s[6 * 33], s[7 * 33]);
        *(u32x4*)(WT + (size_t)(n0 + n) * K + k0 + 8 * c) = o; }
    LDS_WAIT(); asm volatile("" ::: "memory");
}
__device__ __forceinline__ float wave_max(float v) {
#pragma unroll
    for (int o = 1; o < 64; o <<= 1) v = fmaxf(v, __shfl_xor(v, o));
    return v;
}
__device__ __forceinline__ void p0_xn_row(const Frame& F, int m) {
    const float* x = F.in(0); const float* meta = F.in(1); const float* g = F.in(2);
    bf16_t* o = (bf16_t*)(F.ws + WS_XN) + (size_t)m * DM;
    u32x2* o8 = (u32x2*)o + F.lane;
    if (m >= NTOK + NMETA) {
        unsigned* z8 = (unsigned*)(F.ws + WS_XN8 + (size_t)m * DM) + F.lane;
#pragma unroll
        for (int j = 0; j < 16; ++j) { o8[64 * j] = (u32x2){0u, 0u}; z8[64 * j] = 0u; }
        if (F.lane == 0) ((float*)(F.ws + WS_SX))[m] = 0.f;
        return; }
    const float* src = m < NTOK ? x + (size_t)m * DM : meta + (size_t)(m - NTOK) * DM;
    const f32x4* xr = (const f32x4*)src + F.lane; const f32x4* gr = (const f32x4*)g + F.lane;
    f32x4 v[16]; float s = 0.f, xm = 0.f;
#pragma unroll
    for (int j = 0; j < 16; ++j) { v[j] = xr[64 * j]; s += (v[j][0] * v[j][0] + v[j][1] * v[j][1]) + (v[j][2] * v[j][2] + v[j][3] * v[j][3]);
        xm = fmaxf(xm, fmaxf(fmaxf(fabsf(v[j][0]), fabsf(v[j][1])), fmaxf(fabsf(v[j][2]), fabsf(v[j][3])))); }
    xm = wave_max(xm);
    if (F.lane == 0) ((float*)(F.ws + WS_XMAX))[m] = xm;
    const float rstd = 1.0f / sqrtf(wave_sum(s) * (1.0f / DM) + EPS);
    float mx = 0.f;
#pragma unroll
    for (int j = 0; j < 16; ++j) { const f32x4 gg = gr[64 * j]; v[j] = v[j] * rstd * gg; o8[64 * j] = (u32x2){pk2(v[j][0], v[j][1]), pk2(v[j][2], v[j][3])};
        mx = fmaxf(mx, fmaxf(fmaxf(fabsf(v[j][0]), fabsf(v[j][1])), fmaxf(fabsf(v[j][2]), fabsf(v[j][3])))); }
    mx = fmaxf(wave_max(mx), 1e-30f);
    const float inv = 448.0f / mx;
    if (F.lane == 0) ((float*)(F.ws + WS_SX))[m] = mx * (1.0f / 448.0f);
    unsigned* q8 = (unsigned*)(F.ws + WS_XN8 + (size_t)m * DM) + F.lane;
#pragma unroll
    for (int j = 0; j < 16; ++j) { f32x4 q = v[j] * inv;
#pragma unroll
        for (int e = 0; e < 4; ++e) q[e] = fminf(fmaxf(q[e], -448.0f), 448.0f);
        int p = 0; p = __builtin_amdgcn_cvt_pk_fp8_f32(q[0], q[1], p, false); p = __builtin_amdgcn_cvt_pk_fp8_f32(q[2], q[3], p, true); q8[64 * j] = (unsigned)p; }
}
__device__ __forceinline__ void p0_prologue(const Frame& F) {
    LAS float* scr = (LAS float*)(F.lds + F.wave * 16384);
    const int gw = F.vcu * NWAVES + F.wave, NGW = F.G * NWAVES;
    const float* w_in = F.in(3); const float* qg = F.in(4); const float* w_uq = F.in(5); const float* kvg = F.in(6); const float* w_ukv = F.in(7);
    const float* w_br = F.in(8); const float* w_out = F.in(9); const float* fg = F.in(10); const float* w_q = F.in(11); const float* sk = F.in(12);
    constexpr int I_IN = 64 * (NV1 / 32), I_UQ = 16 * (3072 / 32), I_UKV = 8 * (4096 / 32), I_BR = 64 * 128, I_OUT = 64 * 128, I_Q = 64 * 64;
    constexpr int NITEMS = I_IN + I_UQ + I_UKV + I_BR + I_OUT + I_Q;
    struct TItem { const float* W; bf16_t* WT; const float* gk; int K, Nsrc, k0, n0, sc; };
    auto decode = [&](int it) -> TItem {
        TItem t; int r = it, nv, mapid;
        if (r < I_IN) { t.W = w_in; t.K = 4096; t.Nsrc = 13968; nv = NV1; t.WT = (bf16_t*)(F.ws + WS_WIN); t.gk = nullptr; mapid = 0; }
        else if ((r -= I_IN) < I_UQ) { t.W = w_uq; t.K = 1024; t.Nsrc = 3072; nv = 3072; t.WT = (bf16_t*)(F.ws + WS_WUQ); t.gk = qg; mapid = 1; }
        else if ((r -= I_UQ) < I_UKV) { t.W = w_ukv; t.K = 512; t.Nsrc = 4096; nv = 4096; t.WT = (bf16_t*)(F.ws + WS_WUKV); t.gk = kvg; mapid = 2; }
        else if ((r -= I_UKV) < I_BR) { t.W = w_br; t.K = 4096; t.Nsrc = 4096; nv = 4096; t.WT = (bf16_t*)(F.ws + WS_WBRS); t.gk = nullptr; mapid = 3; }
        else if ((r -= I_BR) < I_OUT) { t.W = w_out; t.K = 4096; t.Nsrc = 4096; nv = 4096; t.WT = (bf16_t*)(F.ws + WS_WOUT); t.gk = nullptr; mapid = 3; }
        else { r -= I_OUT; t.W = w_q; t.K = 4096; t.Nsrc = 2048; nv = 2048; t.WT = (bf16_t*)(F.ws + WS_WQ); t.gk = fg; mapid = 3; }
        const int nblk = nv / 32, kb = r / nblk, nb = r % nblk; t.k0 = 64 * kb; t.n0 = 32 * nb;
        const int v = t.n0 + (F.lane & 31);
        t.sc = mapid == 0 ? MapIn()(v) : (mapid == 1 ? MapUq()(v) : (mapid == 2 ? MapUkv()(v) : v));
        return t; };
#define TLOAD(t, tv) do { _Pragma("unroll") for (int i = 0; i < 32; ++i) { const int kk = 2 * i + (F.lane >> 5); tv[i] = (t.sc >= 0) ? t.W[(size_t)(t.k0 + kk) * t.Nsrc + t.sc] : 0.f; } } while (0)
#define TSTORE(t, tv) do { \
        if (t.gk) { _Pragma("unroll") for (int i = 0; i < 32; ++i) tv[i] *= t.gk[t.k0 + 2 * i + (F.lane >> 5)]; } \
        _Pragma("unroll") for (int i = 0; i < 32; ++i) scr[(2 * i + (F.lane >> 5)) * 33 + (F.lane & 31)] = tv[i]; \
        LDS_WAIT(); asm volatile("" ::: "memory"); \
        const int c_ = F.lane & 7; \
        _Pragma("unroll") for (int j = 0; j < 4; ++j) { const int n = (F.lane >> 3) + 8 * j; const LAS float* s = scr + (8 * c_) * 33 + n; \
            u32x4 o; o.x = pk2(s[0 * 33], s[1 * 33]); o.y = pk2(s[2 * 33], s[3 * 33]); o.z = pk2(s[4 * 33], s[5 * 33]); o.w = pk2(s[6 * 33], s[7 * 33]); \
            *(u32x4*)(t.WT + (size_t)(t.n0 + n) * t.K + t.k0 + 8 * c_) = o; } \
        LDS_WAIT(); asm volatile("" ::: "memory"); } while (0)
    {
        float ta[32], tb[32]; TItem ia, ib;
        int it = gw;
        if (it < NITEMS) { ia = decode(it); TLOAD(ia, ta); }
#pragma unroll 1
        for (; it < NITEMS; it += 2 * NGW) {
            const int i1 = it + NGW, i2 = it + 2 * NGW;
            if (i1 < NITEMS) { ib = decode(i1); TLOAD(ib, tb); }
            TSTORE(ia, ta);
            if (i2 < NITEMS) { ia = decode(i2); TLOAD(ia, ta); }
            if (i1 < NITEMS) TSTORE(ib, tb);
        }
    }
#undef TLOAD
#undef TSTORE
    for (int m = gw; m < MK; m += NGW) p0_xn_row(F, m);
    const int gt = (F.vcu * NWAVES + F.wave) * 64 + F.lane, NGT = NGW * 64;
    for (int i = gt; i < TP * 56; i += NGT) {
        const int t = i / 56, r = i % 56; int j, rot; float* dst;
        if (r < 32) { j = r; rot = 64; dst = (float*)(F.ws + WS_ROPE_M) + ((size_t)t * 32 + j) * 2; }
        else if (r < 48) { j = r - 32; rot = 32; dst = (float*)(F.ws + WS_ROPE_D) + ((size_t)t * 16 + j) * 2; }
        else { j = r - 48; rot = 16; dst = (float*)(F.ws + WS_ROPE_I) + ((size_t)t * 8 + j) * 2; }
        const float ex = (float)(2 * j) / (float)rot;
        const float inv = powf(500000.0f, -ex);
        const float ang = (float)t * inv;
        const double a = (double)ang, kq = rint(a * 0.15915494309189535), rr = fma(-kq, 6.283185307179586, a);
        const float rf = (float)rr;
        dst[0] = cosf(rf); dst[1] = sinf(rf);
    }
    for (int i = gt; i < 16 * 128 * 128 / 8; i += NGT) { const f32x4* s = (const f32x4*)sk + 2 * (size_t)i; const f32x4 a = s[0], b2 = s[1];
        u32x4 o; o.x = pk2(a[0], a[1]); o.y = pk2(a[2], a[3]); o.z = pk2(b2[0], b2[1]); o.w = pk2(b2[2], b2[3]); ((u32x4*)(F.ws + WS_SK))[i] = o; }
}
__device__ __forceinline__ unsigned fp6_code(float q) {
    const unsigned b = __float_as_uint(q), sgn = (b >> 31) << 5; const float aq = fabsf(q);
    const unsigned sub = (unsigned)rintf(aq * 8.0f);
    unsigned ab = b & 0x7fffffffu; ab = ab + 0x7FFFFu + ((ab >> 20) & 1u);
    const unsigned nrm = (ab >> 20) - (126u << 3);
    unsigned code = aq < 1.0f ? sub : nrm; code = code > 31u ? 31u : code;
    return code | sgn;
}
__device__ __forceinline__ void fp6_pack32(const unsigned (&c)[32], unsigned (&w)[6]) {
#pragma unroll
    for (int i = 0; i < 6; ++i) w[i] = 0u;
#pragma unroll
    for (int k = 0; k < 32; ++k) { const int bit = 6 * k, d = bit >> 5, sh = bit & 31; w[d] |= c[k] << sh; if (sh > 26) w[d + 1] |= c[k] >> (32 - sh); }
}
__device__ __forceinline__ void p6_quant_row(const float* src, const float* gain, unsigned char* dst, float* scale_out, int lane) {
    const f32x4* s = (const f32x4*)src + lane; f32x4 v[16]; float mx = 0.f;
#pragma unroll
    for (int j = 0; j < 16; ++j) { v[j] = s[64 * j]; if (gain) v[j] = v[j] * ((const f32x4*)gain)[lane + 64 * j];
        mx = fmaxf(mx, fmaxf(fmaxf(fabsf(v[j][0]), fabsf(v[j][1])), fmaxf(fabsf(v[j][2]), fabsf(v[j][3])))); }
    mx = fmaxf(wave_max(mx), 1e-30f);
    const float sc = mx * (1.0f / 7.5f), inv = 7.5f / mx;
    if (lane == 0) *scale_out = sc;
    unsigned w[12];
#pragma unroll
    for (int g = 0; g < 2; ++g) { unsigned c[32];
#pragma unroll
        for (int j = 0; j < 8; ++j)
#pragma unroll
            for (int i = 0; i < 4; ++i) c[4 * j + i] = fp6_code(v[8 * g + j][i] * inv);
        unsigned ww[6]; fp6_pack32(c, ww);
#pragma unroll
        for (int i = 0; i < 6; ++i) w[6 * g + i] = ww[i]; }
#pragma unroll
    for (int q = 0; q < 3; ++q) *(u32x4*)(dst + 1024 * q + 16 * lane) = (u32x4){w[4 * q], w[4 * q + 1], w[4 * q + 2], w[4 * q + 3]};
}
__device__ __forceinline__ unsigned fp4_code(float q) {
    const float aq = fabsf(q);
    const unsigned c = (aq > 0.25f ? 1u : 0u) + (aq >= 0.75f ? 1u : 0u) + (aq > 1.25f ? 1u : 0u) + (aq >= 1.75f ? 1u : 0u) + (aq > 2.5f ? 1u : 0u) + (aq >= 3.5f ? 1u : 0u) + (aq > 5.0f ? 1u : 0u);
    return c | ((__float_as_uint(q) >> 31) << 3);
}
__device__ __forceinline__ void p6_quant_row4(const float* src, const float* gain, unsigned char* dst, float* scale_out, int lane) {
    const f32x4* s = (const f32x4*)src + lane; f32x4 v[16]; float mx = 0.f;
#pragma unroll
    for (int j = 0; j < 16; ++j) { v[j] = s[64 * j]; if (gain) v[j] = v[j] * ((const f32x4*)gain)[lane + 64 * j];
        mx = fmaxf(mx, fmaxf(fmaxf(fabsf(v[j][0]), fabsf(v[j][1])), fmaxf(fabsf(v[j][2]), fabsf(v[j][3])))); }
    mx = fmaxf(wave_max(mx), 1e-30f);
    const float sc = mx * (1.0f / 6.0f), inv = 6.0f / mx;
    if (lane == 0) *scale_out = sc;
    unsigned w[8];
#pragma unroll
    for (int d = 0; d < 8; ++d) { unsigned x = 0u;
        const f32x4 a = v[2 * d] * inv, b = v[2 * d + 1] * inv;
        x = __builtin_amdgcn_cvt_scalef32_pk_fp4_f32(x, a[0], a[1], 1.0f, 0); x = __builtin_amdgcn_cvt_scalef32_pk_fp4_f32(x, a[2], a[3], 1.0f, 1);
        x = __builtin_amdgcn_cvt_scalef32_pk_fp4_f32(x, b[0], b[1], 1.0f, 2); x = __builtin_amdgcn_cvt_scalef32_pk_fp4_f32(x, b[2], b[3], 1.0f, 3);
        w[d] = x; }
#pragma unroll
    for (int q = 0; q < 2; ++q) *(u32x4*)(dst + 1024 * q + 16 * lane) = (u32x4){w[4 * q], w[4 * q + 1], w[4 * q + 2], w[4 * q + 3]};
}
#ifndef PEER_U_BITS
#define PEER_U_BITS 4
#endif
#ifndef PEER_V_BITS
#define PEER_V_BITS 4
#endif
constexpr int PEER_U_ROWB = PEER_U_BITS == 4 ? 2048 : 3072, PEER_V_ROWB = PEER_V_BITS == 4 ? 2048 : 3072;
__device__ __forceinline__ void p6_quant_regs4(f32x4 (&v)[16], unsigned char* dst, float* scale_out, int lane) {
    float mx = 0.f;
#pragma unroll
    for (int j = 0; j < 16; ++j) mx = fmaxf(mx, fmaxf(fmaxf(fabsf(v[j][0]), fabsf(v[j][1])), fmaxf(fabsf(v[j][2]), fabsf(v[j][3]))));
    mx = fmaxf(wave_max(mx), 1e-30f);
    const float inv = 6.0f / mx;
    if (lane == 0) *scale_out = mx * (1.0f / 6.0f);
    unsigned w[8];
#pragma unroll
    for (int d = 0; d < 8; ++d) { unsigned x = 0u;
        const f32x4 a = v[2 * d] * inv, b = v[2 * d + 1] * inv;
        x = __builtin_amdgcn_cvt_scalef32_pk_fp4_f32(x, a[0], a[1], 1.0f, 0); x = __builtin_amdgcn_cvt_scalef32_pk_fp4_f32(x, a[2], a[3], 1.0f, 1);
        x = __builtin_amdgcn_cvt_scalef32_pk_fp4_f32(x, b[0], b[1], 1.0f, 2); x = __builtin_amdgcn_cvt_scalef32_pk_fp4_f32(x, b[2], b[3], 1.0f, 3);
        w[d] = x; }
#pragma unroll
    for (int q = 0; q < 2; ++q) *(u32x4*)(dst + 1024 * q + 16 * lane) = (u32x4){w[4 * q], w[4 * q + 1], w[4 * q + 2], w[4 * q + 3]};
}
__device__ __forceinline__ void p6_tables(const Frame& F) {
    const float* fg = F.in(10); const float* pu = F.in(13); const float* pv = F.in(14);
    const int gw = F.vcu * NWAVES + F.wave, NGW = F.G * NWAVES, lane = F.lane;
#if PEER_U_BITS == 4 && PEER_V_BITS == 4
    if ((NGW & 1) == 0) {
        const bool isv = gw & 1; const float* tab = isv ? pv : pu; unsigned char* dtab = F.ws + (isv ? WS_V : WS_U); float* stab = (float*)(F.ws + (isv ? WS_SCV : WS_SCU));
        const int e0 = gw >> 1, estep = NGW >> 1;
        f32x4 g[16];
#pragma unroll
        for (int j = 0; j < 16; ++j) g[j] = isv ? (f32x4){1.f, 1.f, 1.f, 1.f} : ((const f32x4*)fg)[lane + 64 * j];
        f32x4 va[16], vb[16];
        if (e0 < 16384) {
#pragma unroll
            for (int j = 0; j < 16; ++j) va[j] = ((const f32x4*)(tab + (size_t)e0 * DM))[lane + 64 * j];
        }
#pragma unroll 1
        for (int e = e0; e < 16384; e += 2 * estep) {
            const int e1 = e + estep, e2 = e + 2 * estep;
            if (e1 < 16384) {
#pragma unroll
                for (int j = 0; j < 16; ++j) vb[j] = ((const f32x4*)(tab + (size_t)e1 * DM))[lane + 64 * j];
            }
#pragma unroll
            for (int j = 0; j < 16; ++j) va[j] = va[j] * g[j];
            p6_quant_regs4(va, dtab + (size_t)e * 2048, stab + e, lane);
            if (e2 < 16384) {
#pragma unroll
                for (int j = 0; j < 16; ++j) va[j] = ((const f32x4*)(tab + (size_t)e2 * DM))[lane + 64 * j];
            }
            if (e1 < 16384) {
#pragma unroll
                for (int j = 0; j < 16; ++j) vb[j] = vb[j] * g[j];
                p6_quant_regs4(vb, dtab + (size_t)e1 * 2048, stab + e1, lane);
            }
        }
        return;
    }
#endif
    for (int it = gw; it < 2 * 16384; it += NGW) { const int e = it >> 1;
        if (it & 1) { if (PEER_V_BITS == 4) p6_quant_row4(pv + (size_t)e * DM, nullptr, F.ws + WS_V + (size_t)e * PEER_V_ROWB, (float*)(F.ws + WS_SCV) + e, F.lane);
                      else p6_quant_row(pv + (size_t)e * DM, nullptr, F.ws + WS_V + (size_t)e * PEER_V_ROWB, (float*)(F.ws + WS_SCV) + e, F.lane); }
        else { if (PEER_U_BITS == 4) p6_quant_row4(pu + (size_t)e * DM, fg, F.ws + WS_U + (size_t)e * PEER_U_ROWB, (float*)(F.ws + WS_SCU) + e, F.lane);
               else p6_quant_row(pu + (size_t)e * DM, fg, F.ws + WS_U + (size_t)e * PEER_U_ROWB, (float*)(F.ws + WS_SCU) + e, F.lane); } }
}

__device__ __forceinline__ void rowquant_fp8(const Frame& F, const unsigned char* src, size_t src_pitch, unsigned char* dst, size_t dst_pitch, float* scale, int nrows, unsigned* halfnorm = nullptr) {
    const int gw = F.vcu * NWAVES + F.wave, NGW = F.G * NWAVES, lane = F.lane;
    for (int n = gw; n < nrows; n += NGW) {
        const u32x4* s = (const u32x4*)(src + (size_t)n * src_pitch) + lane;
        u32x4 v[8]; float mx = 0.f;
#pragma unroll
        for (int j = 0; j < 8; ++j) { v[j] = s[64 * j];
#pragma unroll
            for (int e = 0; e < 4; ++e) mx = fmaxf(mx, fmaxf(fabsf(bf_lo(v[j][e])), fabsf(bf_hi(v[j][e])))); }
        if (halfnorm) { float q0 = 0.f, q1 = 0.f;
#pragma unroll
            for (int j = 0; j < 8; ++j)
#pragma unroll
                for (int e = 0; e < 4; ++e) { const float a = bf_lo(v[j][e]), b = bf_hi(v[j][e]); if (j < 4) q0 += a * a + b * b; else q1 += a * a + b * b; }
            q0 = wave_sum(q0); q1 = wave_sum(q1);
            if (lane == 0) { atomicMax(halfnorm, __float_as_uint(q0)); atomicMax(halfnorm + 64, __float_as_uint(q1)); } }
        mx = fmaxf(wave_max(mx), 1e-30f);
        const float inv = 448.0f / mx;
        if (lane == 0) scale[n] = mx * (1.0f / 448.0f);
        asm volatile("" ::: "memory");
        u32x2* d = (u32x2*)(dst + (size_t)n * dst_pitch) + lane;
#pragma unroll
        for (int j = 0; j < 8; ++j) { int p0 = 0, p1 = 0;
            p0 = __builtin_amdgcn_cvt_pk_fp8_f32(bf_lo(v[j].x) * inv, bf_hi(v[j].x) * inv, p0, false); p0 = __builtin_amdgcn_cvt_pk_fp8_f32(bf_lo(v[j].y) * inv, bf_hi(v[j].y) * inv, p0, true);
            p1 = __builtin_amdgcn_cvt_pk_fp8_f32(bf_lo(v[j].z) * inv, bf_hi(v[j].z) * inv, p1, false); p1 = __builtin_amdgcn_cvt_pk_fp8_f32(bf_lo(v[j].w) * inv, bf_hi(v[j].w) * inv, p1, true);
            d[64 * j] = (u32x2){(unsigned)p0, (unsigned)p1}; }
    }
}
template <int LEN>
__device__ __forceinline__ void rowquant_fp8_n(const Frame& F, const unsigned char* src, unsigned char* dst, float* scale, int nrows) {
    const int gw = F.vcu * NWAVES + F.wave, NGW = F.G * NWAVES, lane = F.lane; constexpr int PER = LEN / 64;
    for (int n = gw; n < nrows; n += NGW) {
        const u32x4* s = (const u32x4*)(src + (size_t)n * LEN * 2) + lane * (PER / 8);
        u32x4 v[PER / 8]; float mx = 0.f;
#pragma unroll
        for (int j = 0; j < PER / 8; ++j) { v[j] = s[j];
#pragma unroll
            for (int e = 0; e < 4; ++e) mx = fmaxf(mx, fmaxf(fabsf(bf_lo(v[j][e])), fabsf(bf_hi(v[j][e])))); }
        mx = fmaxf(wave_max(mx), 1e-30f);
        const float inv = 448.0f / mx;
        if (lane == 0) scale[n] = mx * (1.0f / 448.0f);
        u32x2* d = (u32x2*)(dst + (size_t)n * LEN) + lane * (PER / 8);
#pragma unroll
        for (int j = 0; j < PER / 8; ++j) { int p0 = 0, p1 = 0;
            p0 = __builtin_amdgcn_cvt_pk_fp8_f32(bf_lo(v[j].x) * inv, bf_hi(v[j].x) * inv, p0, false); p0 = __builtin_amdgcn_cvt_pk_fp8_f32(bf_lo(v[j].y) * inv, bf_hi(v[j].y) * inv, p0, true);
            p1 = __builtin_amdgcn_cvt_pk_fp8_f32(bf_lo(v[j].z) * inv, bf_hi(v[j].z) * inv, p1, false); p1 = __builtin_amdgcn_cvt_pk_fp8_f32(bf_lo(v[j].w) * inv, bf_hi(v[j].w) * inv, p1, true);
            d[j] = (u32x2){(unsigned)p0, (unsigned)p1}; }
    }
}
__device__ __forceinline__ void p1_quant_weights(const Frame& F) {
    rowquant_fp8(F, F.ws + WS_WIN + (size_t)1280 * DM * 2, (size_t)DM * 2, F.ws + WS_WG8, (size_t)DM, (float*)(F.ws + WS_SW), 12800);
}
__device__ __forceinline__ void p1_quant_weights_late(const Frame& F) {
    rowquant_fp8(F, F.ws + WS_WBRS, (size_t)DM * 2, F.ws + WS_WBR, (size_t)DM, (float*)(F.ws + WS_SWBR), 4096, F.ctl + CW_WNORM);
    rowquant_fp8(F, F.ws + WS_WOUT, (size_t)DM * 2, F.ws + WS_WOUT, (size_t)DM * 2, (float*)(F.ws + WS_SWOUT), 4096, F.ctl + CW_WNORM2);
    rowquant_fp8(F, F.ws + WS_WQ, (size_t)DM * 2, F.ws + WS_WQ8, (size_t)DM, (float*)(F.ws + WS_SWQ), 2048);
    rowquant_fp8_n<1024>(F, F.ws + WS_WUQ, F.ws + WS_WUQ8, (float*)(F.ws + WS_SWUQ), 3072);
    rowquant_fp8_n<512>(F, F.ws + WS_WUKV, F.ws + WS_WUKV8, (float*)(F.ws + WS_SWUKV), 4096);
}
#define MFMA32(a, b, c) __builtin_amdgcn_mfma_f32_32x32x16_bf16((a), (b), (c), 0, 0, 0)
__device__ __forceinline__ float relu_i(float x) { const int v = __float_as_int(x); return __int_as_float(v > 0 ? v : 0); }
__device__ __forceinline__ int crow(int i, int h) { return (i & 3) + 8 * (i >> 2) + 4 * h; }
__device__ __forceinline__ float half_sum_f(float v) {
#pragma unroll
    for (int o = 1; o < 32; o <<= 1) v += __shfl_xor(v, o);
    return v;
}
__device__ __forceinline__ int half_sum_i(int v) {
#pragma unroll
    for (int o = 1; o < 32; o <<= 1) v += __shfl_xor(v, o);
    return v;
}
__device__ __forceinline__ int half_sum_i_dpp(int v, int h) {
#define DPP_ADDI(ctrl, rmask) v += __builtin_amdgcn_update_dpp(0, v, ctrl, rmask, 0xF, false)
    DPP_ADDI(0xB1, 0xF); DPP_ADDI(0x4E, 0xF); DPP_ADDI(0x141, 0xF); DPP_ADDI(0x140, 0xF); DPP_ADDI(0x142, 0xA);
#undef DPP_ADDI
    const int s0 = __builtin_amdgcn_readlane(v, 31), s1 = __builtin_amdgcn_readlane(v, 63);
    return h ? s1 : s0;
}
__device__ __forceinline__ void count_ge4(int& c, float r0, float r1, float r2, float r3, float mid) {
#if defined(__HIP_DEVICE_COMPILE__)
    unsigned long long m0, m1, m2, m3;
    asm volatile("v_cmp_ge_f32 %1, %5, %9\n\tv_cmp_ge_f32 %2, %6, %9\n\tv_cmp_ge_f32 %3, %7, %9\n\tv_cmp_ge_f32 %4, %8, %9\n\t"
                 "v_addc_co_u32 %0, vcc, 0, %0, %1\n\tv_addc_co_u32 %0, vcc, 0, %0, %2\n\tv_addc_co_u32 %0, vcc, 0, %0, %3\n\tv_addc_co_u32 %0, vcc, 0, %0, %4"
                 : "+v"(c), "=&s"(m0), "=&s"(m1), "=&s"(m2), "=&s"(m3) : "v"(r0), "v"(r1), "v"(r2), "v"(r3), "v"(mid) : "vcc");
#else
    (void)c; (void)r0; (void)r1; (void)r2; (void)r3; (void)mid;
#endif
}
__device__ __forceinline__ float half_max_f(float v) {
#pragma unroll
    for (int o = 1; o < 32; o <<= 1) v = fmaxf(v, __shfl_xor(v, o));
    return v;
}
__device__ __forceinline__ float half_min_f(float v) {
#pragma unroll
    for (int o = 1; o < 32; o <<= 1) v = fminf(v, __shfl_xor(v, o));
    return v;
}
constexpr int IDX_PK = 144, IDX_BUF = 64 * IDX_PK;
__device__ __forceinline__ void idx_task(const Frame& F, int b, int s0c) {
    const int lane = F.lane, r = lane & 31, h = lane >> 5, tid = F.tid;
    const int s0 = s0c + 2 * F.wave;
    LAS unsigned char* lds = F.lds;
    const bf16_t* qix = (const bf16_t*)(F.ws + WS_QIX); const bf16_t* kix = (const bf16_t*)(F.ws + WS_KIX); const float* wix = (const float*)(F.ws + WS_WIX);
    unsigned* mask = (unsigned*)(F.ws + WS_MASK);
    const int tok = (r >> 2) & 1, head = (r & 3) + 4 * (r >> 3);
    const bf16_t* qp = qix + (size_t)(b * SEQ + s0 + tok) * 1024 + head * 64 + 8 * h;
    bf16x8 af[4];
#pragma unroll
    for (int ks = 0; ks < 4; ++ks) af[ks] = *(const bf16x8*)(qp + 16 * ks);
    const f32x4* wp = (const f32x4*)(wix + (size_t)(b * SEQ + s0 + h) * 16);
    float w[16];
#pragma unroll
    for (int q = 0; q < 4; ++q) { const f32x4 x = wp[q]; w[4 * q] = x[0]; w[4 * q + 1] = x[1]; w[4 * q + 2] = x[2]; w[4 * q + 3] = x[3]; }
    const int tq = NMETA + s0 + h;
    int tqr = tq - r; asm volatile("" : "+v"(tqr));
    const int ngrp = ((NMETA + s0c + 15) >> 6) + 1;
    const int skey = tid >> 3, spc = tid & 7;
    int brow = b * SEQ - NMETA; asm volatile("" : "+s"(brow));
    const GAS bf16_t* kcur = (const GAS bf16_t*)(kix + ((long)brow + skey) * 64 + spc * 8);
    const int sdst = skey * IDX_PK + spc * 16;
    const int boff = r * IDX_PK + 16 * h;
    u32x4 kst[3];
    kst[0] = *(const GAS u32x4*)(skey < NMETA ? (const GAS bf16_t*)(kix + (size_t)(NTOK + skey) * 64 + spc * 8) : kcur);
    kcur += 64 * 64; asm volatile("" : "+v"(kcur));
    if (1 < ngrp) kst[1] = *(const GAS u32x4*)kcur;
    kcur += 64 * 64; asm volatile("" : "+v"(kcur));
    if (2 < ngrp) kst[2] = *(const GAS u32x4*)kcur;
    float row[MW];
#pragma unroll
    for (int g = 0; g < MW / 2; ++g) {
        float s0v = -INFINITY, s1v = -INFINITY;
        const int bo = (g & 1) * IDX_BUF;
        if (g < ngrp) *(LAS u32x4*)(lds + bo + sdst) = kst[g % 3];
        __syncthreads();
        kcur += 64 * 64; asm volatile("" : "+v"(kcur));
        if (g + 3 < ngrp) kst[g % 3] = *(const GAS u32x4*)kcur;
        if (g < ngrp) {
            float x0 = 0.f, x1 = 0.f;
            {
                f32x16 a0, a1;
                { bf16x8 bb[4];
#pragma unroll
                  for (int ks = 0; ks < 4; ++ks) bb[ks] = *(const LAS bf16x8*)(lds + bo + boff + 32 * ks);
#pragma unroll
                  for (int i = 0; i < 16; ++i) a0[i] = 0.f;
#pragma unroll
                  for (int ks = 0; ks < 4; ++ks) a0 = MFMA32(af[ks], bb[ks], a0); }
                asm volatile("" ::: "memory");
                { bf16x8 bb[4];
#pragma unroll
                  for (int ks = 0; ks < 4; ++ks) bb[ks] = *(const LAS bf16x8*)(lds + bo + boff + 32 * IDX_PK + 32 * ks);
#pragma unroll
                  for (int i = 0; i < 16; ++i) a1[i] = 0.f;
#pragma unroll
                  for (int ks = 0; ks < 4; ++ks) a1 = MFMA32(af[ks], bb[ks], a1); }
#pragma unroll
                for (int i = 0; i < 16; ++i) x0 += w[i] * relu_i(a0[i]);
                asm volatile("" : "+v"(x0));
#pragma unroll
                for (int i = 0; i < 16; ++i) x1 += w[i] * relu_i(a1[i]);
            }
            s0v = (g * 64 <= tqr) ? x0 : -INFINITY; s1v = (g * 64 + 32 <= tqr) ? x1 : -INFINITY;
        }
        row[2 * g] = s0v; row[2 * g + 1] = s1v;
    }
    float tau = -3.0e38f;
    bool done = (tq + 1 <= 256);
    float mx = -INFINITY, mn = INFINITY;
#pragma unroll
    for (int k = 0; k < MW; ++k) { const float v = row[k]; mx = fmaxf(mx, v); mn = fminf(mn, v > -INFINITY ? v : INFINITY); }
    float lo = half_min_f(mn), hi = half_max_f(mx);
    if (!done) tau = hi;
    int clo = tq + 1, chi = 1;
    for (int it = 0; it < 128; ++it) {
        if (!__any(!done)) break;
        const float midb = lo + (hi - lo) * 0.5f;
        float mid = midb;
        if (it & 1) {
            const float f = (float)(256 - chi) * __builtin_amdgcn_rcpf((float)max(clo - chi, 1));
            const float mi = hi - (hi - lo) * f;
            if (mi > lo && mi < hi) mid = mi;
        }
        int c = 0;
#pragma unroll
        for (int k = 0; k + 3 < MW; k += 4) count_ge4(c, row[k], row[k + 1], row[k + 2], row[k + 3], mid);
#pragma unroll
        for (int k = MW & ~3; k < MW; ++k) c += (row[k] >= mid) ? 1 : 0;
        c = half_sum_i_dpp(c, h);
        if (!done) {
            if (!(midb > lo && midb < hi)) { tau = hi; done = true; }
            else if (c == 256) { tau = mid; done = true; }
            else if (c > 256) { lo = mid; clo = c; }
            else { hi = mid; tau = hi; chi = c; }
        }
    }
    unsigned* mrow = mask + (size_t)(b * SEQ + s0 + h) * MW;
    unsigned mw = 0u;
#pragma unroll
    for (int k = 0; k < MW; ++k) {
        const unsigned long long bal = __ballot(row[k] >= tau);
        const unsigned wd = h ? (unsigned)(bal >> 32) : (unsigned)bal;
        if ((k & 31) == r) mw = wd;
        if ((k & 31) == 31 || k == MW - 1) { const int kk = (k & ~31) + r; if (kk < MW) mrow[kk] = mw; }
    }
}
__device__ __forceinline__ void p2_indexer(const Frame& F, int qslot) {
    volatile LAS unsigned* qw = (volatile LAS unsigned*)(F.lds + LDSCTL_OFF + 16);
    constexpr int NCH = NTOK / 16;
    for (;;) {
        if (F.tid == 0) qw[0] = atomicAdd(F.ctl + CW_QUEUE + 64 * qslot, 1u);
        __syncthreads();
        const int c = __builtin_amdgcn_readfirstlane((int)qw[0]);
        __syncthreads();
        if (c >= NCH) break;
        const int b = c & 3, tblk = (SEQ / 16 - 1) - (c >> 2);
        idx_task(F, b, tblk * 16);
    }
}
template <bool MLA> struct AttnCfg {
    static constexpr int DQK = MLA ? 192 : 128, NKS = DQK / 64, PK = DQK + 16  , PV = 144  , KBYTES = 64 * PK, VBYTES = 64 * PV, VBASE = 2 * KBYTES;
};
struct AttnUnit { int type, b, hx, blk; };
typedef int i32x8 __attribute__((ext_vector_type(8)));
typedef int i32x4 __attribute__((ext_vector_type(4)));
typedef int i32x2_t __attribute__((ext_vector_type(2)));
__device__ __forceinline__ i32x8 cat4(i32x4 a, i32x4 b) { return __builtin_shufflevector(a, b, 0, 1, 2, 3, 4, 5, 6, 7); }
template <int NKS> __device__ __forceinline__ void qk_block(f32x16& s, const i32x8 (&k)[NKS], const i32x8 (&q)[NKS]) {
#if defined(__HIP_DEVICE_COMPILE__)
    int sc = 0x7F7F7F7F;
    if constexpr (NKS == 3)
        asm volatile("s_nop 1\n\tv_mfma_scale_f32_32x32x64_f8f6f4 %0, %1, %4, 0, %7, %7 op_sel_hi:[0,0,0]\n\ts_nop 3\n\tv_mfma_scale_f32_32x32x64_f8f6f4 %0, %2, %5, %0, %7, %7 op_sel_hi:[0,0,0]\n\ts_nop 3\n\t"
                     "v_mfma_scale_f32_32x32x64_f8f6f4 %0, %3, %6, %0, %7, %7 op_sel_hi:[0,0,0]\n\ts_nop 15\n\ts_nop 7"
                     : "=&v"(s) : "v"(k[0]), "v"(k[1]), "v"(k[2]), "v"(q[0]), "v"(q[1]), "v"(q[2]), "v"(sc));
    else
        asm volatile("s_nop 1\n\tv_mfma_scale_f32_32x32x64_f8f6f4 %0, %1, %3, 0, %5, %5 op_sel_hi:[0,0,0]\n\ts_nop 3\n\tv_mfma_scale_f32_32x32x64_f8f6f4 %0, %2, %4, %0, %5, %5 op_sel_hi:[0,0,0]\n\ts_nop 15\n\ts_nop 7"
                     : "=&v"(s) : "v"(k[0]), "v"(k[1]), "v"(q[0]), "v"(q[1]), "v"(sc));
#else
    (void)s; (void)k; (void)q;
#endif
}

__device__ __forceinline__ void pv_block(f32x16& o0, f32x16& o1, f32x16& o2, f32x16& o3, const i32x8 v0, const i32x8 v1, const i32x8 v2, const i32x8 v3, const i32x8 p) {
#if defined(__HIP_DEVICE_COMPILE__)
    int sc = 0x7F7F7F7F;
    asm volatile("s_nop 1\n\tv_mfma_scale_f32_32x32x64_f8f6f4 %0, %4, %8, %0, %9, %9 op_sel_hi:[0,0,0]\n\tv_mfma_scale_f32_32x32x64_f8f6f4 %1, %5, %8, %1, %9, %9 op_sel_hi:[0,0,0]\n\t"
                 "v_mfma_scale_f32_32x32x64_f8f6f4 %2, %6, %8, %2, %9, %9 op_sel_hi:[0,0,0]\n\tv_mfma_scale_f32_32x32x64_f8f6f4 %3, %7, %8, %3, %9, %9 op_sel_hi:[0,0,0]\n\ts_nop 15\n\ts_nop 7"
                 : "+v"(o0), "+v"(o1), "+v"(o2), "+v"(o3) : "v"(v0), "v"(v1), "v"(v2), "v"(v3), "v"(p), "v"(sc));
#else
    (void)o0; (void)o1; (void)o2; (void)o3; (void)v0; (void)v1; (void)v2; (void)v3; (void)p;
#endif
}
__device__ __forceinline__ int pk4_fp8(float a, float b, float c, float d) { int p = 0; p = __builtin_amdgcn_cvt_pk_fp8_f32(a, b, p, false); return __builtin_amdgcn_cvt_pk_fp8_f32(c, d, p, true); }

template <int PVB>
__device__ __forceinline__ void pv_tile(f32x16 (&oacc)[4], LAS unsigned char* lds, int vb, int voff, const i32x8 pf) {
    i32x8 vf[4];
#pragma unroll
    for (int d = 0; d < 4; ++d) {
        const i32x2_t t0 = __builtin_amdgcn_ds_read_tr8_b64_v2i32((LAS i32x2_t*)(lds + vb + voff + 32 * d));
        const i32x2_t t1 = __builtin_amdgcn_ds_read_tr8_b64_v2i32((LAS i32x2_t*)(lds + vb + voff + 16 * PVB + 32 * d));
        const i32x2_t t2 = __builtin_amdgcn_ds_read_tr8_b64_v2i32((LAS i32x2_t*)(lds + vb + voff + 32 * PVB + 32 * d));
        const i32x2_t t3 = __builtin_amdgcn_ds_read_tr8_b64_v2i32((LAS i32x2_t*)(lds + vb + voff + 48 * PVB + 32 * d));
        vf[d] = (i32x8){t0.x, t0.y, t1.x, t1.y, t2.x, t2.y, t3.x, t3.y}; }
    pv_block(oacc[0], oacc[1], oacc[2], oacc[3], vf[0], vf[1], vf[2], vf[3], pf);
}

template <bool MLA>
__device__ __forceinline__ void attn_unit(const Frame& F, const AttnUnit u) {
    typedef AttnCfg<MLA> C;
    const int tid = F.tid, lane = F.lane, wave = F.wave, r = lane & 31, h = lane >> 5;
    LAS unsigned char* lds = F.lds;
    const unsigned char* qn8 = F.ws + WS_QN; const unsigned char* qr8 = F.ws + WS_QR; const unsigned char* kn8 = F.ws + WS_KN; const unsigned char* kpe8 = F.ws + WS_KPE;
    const unsigned char* qb8 = F.ws + WS_QB; const unsigned char* kb8 = F.ws + WS_KB;
    const unsigned char* va8 = F.ws + WS_VA; const unsigned char* vb8 = F.ws + WS_VB;
    const unsigned* mask = (const unsigned*)(F.ws + WS_MASK);
    const int b = u.b;
    const size_t rowb = (size_t)b * SEQ;
    int head, tw0, ntiles;
    if (MLA) { head = u.hx; tw0 = u.blk * 256 + 32 * wave; ntiles = (NMETA + u.blk * 256 + 255) / 64 + 1; }
    else { head = 4 * u.hx + (wave & 3); tw0 = u.blk * 64 + 32 * (wave >> 2); ntiles = (NMETA + u.blk * 64 + 63) / 64 + 1; }
    const int pw0 = NMETA + tw0;
    const int tq = pw0 + r;
    const float cexp = MLA ? QA_SCALE : QB_SCALE;
    i32x8 qf[C::NKS];
    if (MLA) {
        const unsigned char* p0 = qn8 + (rowb + tw0 + r) * 2048 + head * 128 + 32 * h; const unsigned char* p1 = qr8 + (rowb + tw0 + r) * 1024 + head * 64 + 32 * h;
        qf[0] = cat4(*(const i32x4*)p0, *(const i32x4*)(p0 + 16)); qf[1] = cat4(*(const i32x4*)(p0 + 64), *(const i32x4*)(p0 + 80)); qf[C::NKS - 1] = cat4(*(const i32x4*)p1, *(const i32x4*)(p1 + 16));
    } else {
        const unsigned char* p0 = qb8 + (rowb + tw0 + r) * 2048 + head * 128 + 32 * h;
        qf[0] = cat4(*(const i32x4*)p0, *(const i32x4*)(p0 + 16)); qf[1] = cat4(*(const i32x4*)(p0 + 64), *(const i32x4*)(p0 + 80));
    }
    const int ldk = MLA ? 2048 : 512;
    const unsigned char* ktab = MLA ? kn8 + head * 128 : kb8 + u.hx * 128;
    const unsigned char* vtab = MLA ? va8 + head * 128 : vb8 + u.hx * 128;
    const unsigned char* kbase = ktab + (rowb - NMETA) * ldk;
    const unsigned char* vbase = vtab + (rowb - NMETA) * ldk;
    const unsigned char* pbase = kpe8 + (rowb - NMETA) * 64;
    const int kkey = tid >> 3, kpc = tid & 7, pkey = tid >> 2, ppc = tid & 3;
    const unsigned koffs = (unsigned)(kkey * ldk + kpc * 16); const int kdst = kkey * C::PK + kpc * 16;
    const unsigned poffs = (unsigned)(pkey * 64 + ppc * 16); const int pdst = pkey * C::PK + 128 + ppc * 16;
    const int vdst = C::VBASE + kkey * C::PV + kpc * 16;
    u32x4 kst, vst, pst = (u32x4){0u, 0u, 0u, 0u};
    {
        kst = *(const u32x4*)(kkey < NMETA ? ktab + (size_t)(NTOK + kkey) * ldk + kpc * 16 : kbase + koffs);
        vst = *(const u32x4*)(kkey < NMETA ? vtab + (size_t)(NTOK + kkey) * ldk + kpc * 16 : vbase + koffs);
        if (MLA && tid < 256) pst = *(const u32x4*)(pkey < NMETA ? kpe8 + (size_t)(NTOK + pkey) * 64 + ppc * 16 : pbase + poffs);
    }
    *(LAS u32x4*)(lds + kdst) = kst;
    *(LAS u32x4*)(lds + vdst) = vst;
    if (MLA && tid < 256) *(LAS u32x4*)(lds + pdst) = pst;
    __syncthreads();
    f32x16 oacc[4];
#pragma unroll
    for (int d = 0; d < 4; ++d)
#pragma unroll
        for (int i = 0; i < 16; ++i) oacc[d][i] = 0.f;
    float mrun = -INFINITY, lrun = 0.f;
    const int koff = r * C::PK + 32 * h;
    const int vq = (lane & 15) >> 1;
    const int voff = (4 * h + (vq & 3) + 8 * (vq >> 2)) * C::PV + 16 * ((lane >> 4) & 1) + 8 * (lane & 1);
    const unsigned* mrow = mask + (rowb + tw0 + r) * MW;
    if (ntiles > 1) {
        kst = *(const u32x4*)(kbase + (size_t)64 * ldk + koffs);
        vst = *(const u32x4*)(vbase + (size_t)64 * ldk + koffs);
        if (MLA && tid < 256) pst = *(const u32x4*)(pbase + (size_t)64 * 64 + poffs);
    }
    const bool late = wave >= 4;
    u32x2 mwn = (u32x2){0u, 0u};
    if (!MLA) mwn = *(const u32x2*)mrow;
    i32x8 pfp = (i32x8){0, 0, 0, 0, 0, 0, 0, 0}; bool havep = false;
    int vcur = 0, vprev = 2;
    for (int kt = 0; kt < ntiles; ++kt) {
        const int cur = (kt & 1) * C::KBYTES, nxt = ((kt + 1) & 1) * C::KBYTES;
        const int vnxt = vcur == 2 ? 0 : vcur + 1;
        if (kt + 1 < ntiles) {
            *(LAS u32x4*)(lds + nxt + kdst) = kst;
            *(LAS u32x4*)(lds + vnxt * C::VBYTES + vdst) = vst;
            if (MLA && tid < 256) *(LAS u32x4*)(lds + nxt + pdst) = pst;
        }
        const u32x2 mwd = mwn;
        if (!MLA && kt + 1 < ntiles) mwn = *(const u32x2*)(mrow + 2 * (kt + 1));
        if (kt + 2 < ntiles) {
            kst = *(const u32x4*)(kbase + (size_t)(kt + 2) * 64 * ldk + koffs);
            vst = *(const u32x4*)(vbase + (size_t)(kt + 2) * 64 * ldk + koffs);
            if (MLA && tid < 256) pst = *(const u32x4*)(pbase + (size_t)(kt + 2) * 64 * 64 + poffs);
        }
        if (late && havep) pv_tile<C::PV>(oacc, lds, C::VBASE + vprev * C::VBYTES, voff, pfp);
        const bool need = kt * 64 <= pw0 + 31;
        if (need) {
            f32x16 s0, s1;
            if (!MLA) {
                i32x8 kf0[C::NKS], kf1[C::NKS];
#pragma unroll
                for (int ks = 0; ks < C::NKS; ++ks) { kf0[ks] = cat4(*(const LAS i32x4*)(lds + cur + koff + 64 * ks), *(const LAS i32x4*)(lds + cur + koff + 64 * ks + 16));
                    kf1[ks] = cat4(*(const LAS i32x4*)(lds + cur + koff + 32 * C::PK + 64 * ks), *(const LAS i32x4*)(lds + cur + koff + 32 * C::PK + 64 * ks + 16)); }
                qk_block<C::NKS>(s0, kf0, qf);
                qk_block<C::NKS>(s1, kf1, qf);
            } else {
                { i32x8 kf[C::NKS];
#pragma unroll
                  for (int ks = 0; ks < C::NKS; ++ks) kf[ks] = cat4(*(const LAS i32x4*)(lds + cur + koff + 64 * ks), *(const LAS i32x4*)(lds + cur + koff + 64 * ks + 16));
                  qk_block<C::NKS>(s0, kf, qf); }
                { i32x8 kf[C::NKS];
#pragma unroll
                  for (int ks = 0; ks < C::NKS; ++ks) kf[ks] = cat4(*(const LAS i32x4*)(lds + cur + koff + 32 * C::PK + 64 * ks), *(const LAS i32x4*)(lds + cur + koff + 32 * C::PK + 64 * ks + 16));
                  qk_block<C::NKS>(s1, kf, qf); }
            }
            if (MLA) {
                if (kt * 64 + 63 > pw0) {
                    const int kb0 = kt * 64 + 4 * h;
#pragma unroll
                    for (int i = 0; i < 16; ++i) { const int key = kb0 + (i & 3) + 8 * (i >> 2); if (key > tq) s0[i] = -INFINITY; if (key + 32 > tq) s1[i] = -INFINITY; }
                }
            } else {
                const unsigned m0 = mwd.x >> (4 * h), m1 = mwd.y >> (4 * h);
#pragma unroll
                for (int i = 0; i < 16; ++i) { const int bit = (i & 3) + 8 * (i >> 2);
                    const unsigned k0 = (unsigned)__builtin_amdgcn_sbfe((int)m0, bit, 1), k1 = (unsigned)__builtin_amdgcn_sbfe((int)m1, bit, 1);
                    s0[i] = __uint_as_float(__builtin_amdgcn_bitop3_b32(__float_as_uint(s0[i]), 0xFF800000u, k0, 0xe4)); s1[i] = __uint_as_float(__builtin_amdgcn_bitop3_b32(__float_as_uint(s1[i]), 0xFF800000u, k1, 0xe4)); }
            }
            float mx = s0[0];
#pragma unroll
            for (int i = 1; i < 16; ++i) mx = fmaxf(mx, s0[i]);
#pragma unroll
            for (int i = 0; i < 16; ++i) mx = fmaxf(mx, s1[i]);
            mx = xhalf_max(mx);
            const float mcand = mx * cexp;
            const bool move = !__all(mcand - mrun <= 8.0f);
            const float mnew = move ? fmaxf(mrun, mcand) : mrun;
            const float msafe = (mnew == -INFINITY) ? 0.f : mnew;
            const float alpha = move ? __builtin_amdgcn_exp2f(mrun - msafe) : 1.0f;
            mrun = mnew;
            f32x2 ps2 = (f32x2){0.f, 0.f}; const f32x2 c2 = (f32x2){cexp, cexp}, nm2 = (f32x2){-msafe, -msafe};
#pragma unroll
            for (int i = 0; i < 16; i += 2) {
                f32x2 t0 = __builtin_elementwise_fma((f32x2){s0[i], s0[i + 1]}, c2, nm2), t1 = __builtin_elementwise_fma((f32x2){s1[i], s1[i + 1]}, c2, nm2);
                t0 = (f32x2){__builtin_amdgcn_exp2f(t0.x), __builtin_amdgcn_exp2f(t0.y)}; t1 = (f32x2){__builtin_amdgcn_exp2f(t1.x), __builtin_amdgcn_exp2f(t1.y)};
                s0[i] = t0.x; s0[i + 1] = t0.y; s1[i] = t1.x; s1[i + 1] = t1.y; ps2 += t0 + t1; }
            lrun = lrun * alpha + (ps2.x + ps2.y);
            if (move) {
#pragma unroll
                for (int d = 0; d < 4; ++d)
#pragma unroll
                    for (int i = 0; i < 16; ++i) oacc[d][i] *= alpha;
            }
            i32x8 pf;
            pf[0] = pk4_fp8(s0[0], s0[1], s0[2], s0[3]); pf[1] = pk4_fp8(s0[4], s0[5], s0[6], s0[7]); pf[2] = pk4_fp8(s0[8], s0[9], s0[10], s0[11]); pf[3] = pk4_fp8(s0[12], s0[13], s0[14], s0[15]);
            pf[4] = pk4_fp8(s1[0], s1[1], s1[2], s1[3]); pf[5] = pk4_fp8(s1[4], s1[5], s1[6], s1[7]); pf[6] = pk4_fp8(s1[8], s1[9], s1[10], s1[11]); pf[7] = pk4_fp8(s1[12], s1[13], s1[14], s1[15]);
            if (late) pfp = pf; else pv_tile<C::PV>(oacc, lds, C::VBASE + vcur * C::VBYTES, voff, pf);
        }
        havep = late && need;
        vprev = vcur; vcur = vnxt;
        __syncthreads();
    }
    if (late && havep) pv_tile<C::PV>(oacc, lds, C::VBASE + vprev * C::VBYTES, voff, pfp);
    __syncthreads();
    {
        const float lt = xhalf_sum(lrun);
        const float vmax = fmaxf(__uint_as_float(F.ctl[CW_VMAX + (MLA ? 64 : 0)]), 1e-30f);
        const float inv = (lt > 0.f ? 1.0f / lt : 0.f) * (440.0f / vmax);
        {
            const float il = lt > 0.f ? 1.0f / lt : 0.f; float q = 0.f;
#pragma unroll
            for (int d = 0; d < 4; ++d)
#pragma unroll
                for (int i = 0; i < 16; ++i) { const float x = oacc[d][i] * il; q += x * x; }
            q = xhalf_sum(q);
            if (h == 0) ssq_add((u64*)(F.ctl + (MLA ? CW_SSQ_OA : CW_SSQ_OB)) + (rowb + tw0 + r), q); }
        unsigned char* op = F.ws + WS_OAB + (rowb + tw0 + r) * 4096 + (MLA ? 0 : 2048) + head * 128 + 16 * h;
#pragma unroll
        for (int d = 0; d < 4; ++d) { unsigned gq[4];
#pragma unroll
            for (int g = 0; g < 4; ++g) { int p = 0;
                p = __builtin_amdgcn_cvt_pk_fp8_f32(fminf(fmaxf(oacc[d][4 * g] * inv, -448.f), 448.f), fminf(fmaxf(oacc[d][4 * g + 1] * inv, -448.f), 448.f), p, false);
                p = __builtin_amdgcn_cvt_pk_fp8_f32(fminf(fmaxf(oacc[d][4 * g + 2] * inv, -448.f), 448.f), fminf(fmaxf(oacc[d][4 * g + 3] * inv, -448.f), 448.f), p, true);
                gq[g] = (unsigned)p; }
#if defined(__HIP_DEVICE_COMPILE__)
            const auto s02 = __builtin_amdgcn_permlane32_swap(gq[0], gq[2], false, false);
            const auto s13 = __builtin_amdgcn_permlane32_swap(gq[1], gq[3], false, false);
            *(u32x4*)(op + 32 * d) = (u32x4){s02[0], s02[1], s13[0], s13[1]};
#endif
        }
    }
}

constexpr int ATT_NUNITS = 16 * 64 + 64 * 16;
__device__ __forceinline__ void att_decode(int idx, AttnUnit& u) {
    int rem = idx;
    for (int L = 65; L >= 2; --L) {
        const int nm = (L >= 5 && ((L - 5) & 3) == 0) ? 64 : 0;
        if (rem < nm) { u.type = 0; u.blk = (L - 5) >> 2; u.b = rem & 3; u.hx = rem >> 2; return; }
        rem -= nm;
        if (rem < 16) { u.type = 1; u.blk = L - 2; u.b = rem & 3; u.hx = rem >> 2; return; }
        rem -= 16;
    }
    u.type = -1; u.blk = 0; u.b = 0; u.hx = 0;
}
__device__ __forceinline__ void p3_attention(const Frame& F, int qslot) {
    volatile LAS int* qw = (volatile LAS int*)(F.lds + LDSCTL_OFF + 32);
    for (;;) {
        if (F.tid == 0) { const int idx = (int)atomicAdd(F.ctl + CW_QUEUE + 64 * qslot, 1u); AttnUnit u; u.type = -1; u.b = 0; u.hx = 0; u.blk = 0; if (idx < ATT_NUNITS) att_decode(idx, u);
            qw[0] = u.type; qw[1] = u.b; qw[2] = u.hx; qw[3] = u.blk; }
        __syncthreads();
        AttnUnit u; u.type = qw[0]; u.b = qw[1]; u.hx = qw[2]; u.blk = qw[3];
        __syncthreads();
        if (u.type < 0) break;
        if (u.type == 0) attn_unit<true>(F, u); else attn_unit<false>(F, u);
    }
}
__device__ __forceinline__ float pk_idx(float v, int n) { return __uint_as_float((__float_as_uint(v) & ~127u) | (unsigned)n); }
__device__ __forceinline__ void route_task(const Frame& F, int tb, int hd) {
    const int lane = F.lane, r = lane & 31, h = lane >> 5;
    const bf16_t* pq = (const bf16_t*)(F.ws + WS_PQ); const bf16_t* skb = (const bf16_t*)(F.ws + WS_SK);
    int* eid = (int*)(F.ws + WS_EID); float* gate = (float*)(F.ws + WS_GATE);
    LAS float* wl = (LAS float*)(F.lds + F.wave * 16384);
    const int m = tb * 32 + r;
#pragma unroll 1
    for (int c = 0; c < 2; ++c) {
        const bf16_t* qp = pq + (size_t)m * 2048 + hd * 256 + c * 128 + 8 * h;
        bf16x8 qf[8];
#pragma unroll
        for (int ks = 0; ks < 8; ++ks) qf[ks] = *(const bf16x8*)(qp + 16 * ks);
        float v[64];
#pragma unroll
        for (int blk = 0; blk < 4; ++blk) {
            const bf16_t* sp = skb + (size_t)((hd * 2 + c) * 128 + 32 * blk + r) * 128 + 8 * h;
            f32x16 acc; float zr = 0.f; asm volatile("" : "+v"(zr));
#pragma unroll
            for (int i = 0; i < 16; ++i) acc[i] = zr;
#pragma unroll
            for (int ks = 0; ks < 8; ++ks) acc = MFMA32(*(const bf16x8*)(sp + 16 * ks), qf[ks], acc);
#pragma unroll
            for (int i = 0; i < 16; ++i) v[blk * 16 + i] = pk_idx(acc[i], 32 * blk + (i & 3) + 8 * (i >> 2) + 4 * h);
        }
#pragma unroll 1
        for (int k = 0; k < 16; ++k) {
            float mx = v[0];
#pragma unroll
            for (int j = 1; j < 64; ++j) mx = fmaxf(mx, v[j]);
            mx = xhalf_max(mx);
            if (h == 0) wl[(c * 16 + k) * 32 + r] = mx;
#pragma unroll
            for (int j = 0; j < 64; ++j) v[j] = (v[j] == mx) ? -INFINITY : v[j];
        }
    }
    LDS_WAIT(); asm volatile("" ::: "memory");
    float cs[25]; int ce[25];
    {
        unsigned t0[16], t1[16];
#pragma unroll
        for (int i = 0; i < 16; ++i) { t0[i] = __float_as_uint(wl[i * 32 + r]); t1[i] = __float_as_uint(wl[(16 + i) * 32 + r]); }
        int n = 0;
#pragma unroll
        for (int i = 0; i < 16; ++i)
#pragma unroll
            for (int j = 0; j < 16; ++j)
                if ((i + 1) * (j + 1) <= 16) {
                    const float s = __uint_as_float(t0[i] & ~127u) + __uint_as_float(t1[j] & ~127u);
                    const float sv = __uint_as_float((__float_as_uint(s) & ~63u) | (unsigned)n); const int ev_ = (int)((t0[i] & 127u) * 128u + (t1[j] & 127u));
                    if (n < 25) { cs[n] = sv; ce[n] = ev_; } else { cs[n - 25] = h ? sv : cs[n - 25]; ce[n - 25] = h ? ev_ : ce[n - 25]; }
                    ++n;
                }
    }
    float sum = 0.f, first = 0.f;
#pragma unroll 1
    for (int k = 0; k < 16; ++k) {
        float mxl = cs[0];
#pragma unroll
        for (int j = 1; j < 25; ++j) mxl = fmaxf(mxl, cs[j]);
        int sel = 0;
#pragma unroll
        for (int j = 0; j < 25; ++j) { const bool hit = (cs[j] == mxl); sel = hit ? ce[j] : sel; }
        float mx0, mx1; int se0, se1; xhalf(mxl, mx0, mx1); xhalf_i(sel, se0, se1);
        const bool lowins = mx0 > mx1;
        const float mx = lowins ? mx0 : mx1; const int se = lowins ? se0 : se1;
#pragma unroll
        for (int j = 0; j < 25; ++j) cs[j] = (cs[j] == mx) ? -INFINITY : cs[j];
        if (k == 0) first = mx;
        const float ev = __expf(mx - first); sum += ev;
        if (h == 0) { wl[1024 + k * 32 + r] = ev; wl[1536 + k * 32 + r] = __int_as_float(se); }
    }
    LDS_WAIT(); asm volatile("" ::: "memory");
    const float inv = 1.0f / sum;
    if (h == 0) {
        int* ep = eid + (size_t)m * 128 + hd * 16; float* gp = gate + (size_t)m * 128 + hd * 16;
#pragma unroll
        for (int q = 0; q < 4; ++q) {
            *(int4*)(ep + 4 * q) = make_int4(__float_as_int(wl[1536 + (4 * q) * 32 + r]), __float_as_int(wl[1536 + (4 * q + 1) * 32 + r]), __float_as_int(wl[1536 + (4 * q + 2) * 32 + r]), __float_as_int(wl[1536 + (4 * q + 3) * 32 + r]));
            *(f32x4*)(gp + 4 * q) = (f32x4){wl[1024 + (4 * q) * 32 + r] * inv, wl[1024 + (4 * q + 1) * 32 + r] * inv, wl[1024 + (4 * q + 2) * 32 + r] * inv, wl[1024 + (4 * q + 3) * 32 + r] * inv}; }
    }
    LDS_WAIT(); asm volatile("" ::: "memory");
}
__device__ __forceinline__ void p7_routing(const Frame& F) {
    const int gw = F.vcu * NWAVES + F.wave, NGW = F.G * NWAVES;
    for (int it = gw; it < (NTOK / 64) * 8; it += NGW) route_task(F, 2 * (it >> 3), it & 7);
}

__device__ __forceinline__ float rl_f(float v, int l) { return __int_as_float(__builtin_amdgcn_readlane(__float_as_int(v), l)); }
__device__ __forceinline__ float gelu_tanh(float x) {
    const float u = 0.7978845608028654f * (x + 0.044715f * x * x * x);
    const float e = __expf(2.0f * u);
    const float th = 1.0f - 2.0f / (e + 1.0f);
    return 0.5f * x * (1.0f + th);
}
__device__ __forceinline__ float wave_sum_dpp(float v) {
#define DPP_ADD(ctrl, rmask) v += __int_as_float(__builtin_amdgcn_update_dpp(0, __float_as_int(v), ctrl, rmask, 0xF, false))
    DPP_ADD(0xB1, 0xF); DPP_ADD(0x4E, 0xF); DPP_ADD(0x141, 0xF); DPP_ADD(0x140, 0xF); DPP_ADD(0x142, 0xA); DPP_ADD(0x143, 0xC);
#undef DPP_ADD
    return rl_f(v, 63);
}
typedef unsigned u32x6 __attribute__((ext_vector_type(6)));
typedef float f32x32 __attribute__((ext_vector_type(32)));
struct Row6 { u32x4 q[3]; };
__device__ __forceinline__ void row6_load(Row6& r, const unsigned char* tab, int e, int lane) {
    const u32x4* p = (const u32x4*)(tab + (size_t)e * 3072) + lane;
#pragma unroll
    for (int q = 0; q < 3; ++q) r.q[q] = p[64 * q];
}
__device__ __forceinline__ f32x32 row6_deq(const Row6& r, int g) {
    u32x6 w;
    if (g == 0) { w[0] = r.q[0].x; w[1] = r.q[0].y; w[2] = r.q[0].z; w[3] = r.q[0].w; w[4] = r.q[1].x; w[5] = r.q[1].y; }
    else { w[0] = r.q[1].z; w[1] = r.q[1].w; w[2] = r.q[2].x; w[3] = r.q[2].y; w[4] = r.q[2].z; w[5] = r.q[2].w; }
    return __builtin_amdgcn_cvt_scalef32_pk32_f32_fp6(w, 1.0f);
}
__device__ __forceinline__ float row6_dot(const Row6& r, const f32x2 (&hf)[32]) {
    f32x2 acc0 = (f32x2){0.f, 0.f}, acc1 = (f32x2){0.f, 0.f};
#pragma unroll
    for (int g = 0; g < 2; ++g) { const f32x32 d = row6_deq(r, g);
#pragma unroll
        for (int k = 0; k < 16; k += 2) { acc0 = __builtin_elementwise_fma((f32x2){d[2 * k], d[2 * k + 1]}, hf[16 * g + k], acc0); acc1 = __builtin_elementwise_fma((f32x2){d[2 * k + 2], d[2 * k + 3]}, hf[16 * g + k + 1], acc1); } }
    const f32x2 s = acc0 + acc1;
    return s.x + s.y;
}
__device__ __forceinline__ void row6_axpy(const Row6& r, float c, f32x2 (&o)[32]) {
    const f32x2 c2 = (f32x2){c, c};
#pragma unroll
    for (int g = 0; g < 2; ++g) { const f32x32 d = row6_deq(r, g);
#pragma unroll
        for (int k = 0; k < 16; ++k) o[16 * g + k] = __builtin_elementwise_fma((f32x2){d[2 * k], d[2 * k + 1]}, c2, o[16 * g + k]); }
}
struct Row4 { u32x4 q[2]; };
__device__ __forceinline__ void row4_load(Row4& r, const unsigned char* tab, int e, int lane) {
    const u32x4* p = (const u32x4*)(tab + (size_t)e * 2048) + lane;
    r.q[0] = p[0]; r.q[1] = p[64];
}
__device__ __forceinline__ float row4_dot(const Row4& r, const f32x2 (&hf)[32]) {
    f32x2 acc0 = (f32x2){0.f, 0.f}, acc1 = (f32x2){0.f, 0.f};
#pragma unroll
    for (int d = 0; d < 8; ++d) { const unsigned w = r.q[d >> 2][d & 3];
        acc0 = __builtin_elementwise_fma(__builtin_amdgcn_cvt_scalef32_pk_f32_fp4(w, 1.0f, 0), hf[4 * d], acc0);
        acc1 = __builtin_elementwise_fma(__builtin_amdgcn_cvt_scalef32_pk_f32_fp4(w, 1.0f, 1), hf[4 * d + 1], acc1);
        acc0 = __builtin_elementwise_fma(__builtin_amdgcn_cvt_scalef32_pk_f32_fp4(w, 1.0f, 2), hf[4 * d + 2], acc0);
        acc1 = __builtin_elementwise_fma(__builtin_amdgcn_cvt_scalef32_pk_f32_fp4(w, 1.0f, 3), hf[4 * d + 3], acc1); }
    const f32x2 s = acc0 + acc1;
    return s.x + s.y;
}
__device__ __forceinline__ void row4_axpy(const Row4& r, float c, f32x2 (&o)[32]) {
    const f32x2 c2 = (f32x2){c, c};
#pragma unroll
    for (int d = 0; d < 8; ++d) { const unsigned w = r.q[d >> 2][d & 3];
        o[4 * d] = __builtin_elementwise_fma(__builtin_amdgcn_cvt_scalef32_pk_f32_fp4(w, 1.0f, 0), c2, o[4 * d]);
        o[4 * d + 1] = __builtin_elementwise_fma(__builtin_amdgcn_cvt_scalef32_pk_f32_fp4(w, 1.0f, 1), c2, o[4 * d + 1]);
        o[4 * d + 2] = __builtin_elementwise_fma(__builtin_amdgcn_cvt_scalef32_pk_f32_fp4(w, 1.0f, 2), c2, o[4 * d + 2]);
        o[4 * d + 3] = __builtin_elementwise_fma(__builtin_amdgcn_cvt_scalef32_pk_f32_fp4(w, 1.0f, 3), c2, o[4 * d + 3]); }
}
#if PEER_U_BITS == 4
typedef Row4 RowU;
#define ROWU_LOAD row4_load
#define ROWU_DOT row4_dot
#else
typedef Row6 RowU;
#define ROWU_LOAD row6_load
#define ROWU_DOT row6_dot
#endif
#if PEER_V_BITS == 4
typedef Row4 RowV;
#define ROWV_LOAD row4_load
#define ROWV_AXPY row4_axpy
#else
typedef Row6 RowV;
#define ROWV_LOAD row6_load
#define ROWV_AXPY row6_axpy
#endif
__device__ __forceinline__ void expert_token(const Frame& F, int m, size_t orow) {
    const int lane = F.lane;
    const unsigned char* U = F.ws + WS_U; const unsigned char* V = F.ws + WS_V;
    const float* scu = (const float*)(F.ws + WS_SCU); const float* scv = (const float*)(F.ws + WS_SCV);
    const int* eid = (const int*)(F.ws + WS_EID); const float* gate = (const float*)(F.ws + WS_GATE);
    const bf16_t* h1b = (const bf16_t*)(F.ws + WS_H1B);
    const u64* ssq = (const u64*)(F.ctl + CW_SSQ_H1); const float* gfin = F.in(15);
    const int e0 = eid[(size_t)m * 128 + lane], e1 = eid[(size_t)m * 128 + 64 + lane];
    f32x2 hf[32];
#pragma unroll
    for (int j = 0; j < 16; ++j) { const u32x2 x = *((const u32x2*)(h1b + (size_t)m * DM) + lane + 64 * j); hf[2 * j] = (f32x2){bf_lo(x.x), bf_hi(x.x)}; hf[2 * j + 1] = (f32x2){bf_lo(x.y), bf_hi(x.y)}; }
    const float g0 = gate[(size_t)m * 128 + lane] * scv[e0], g1 = gate[(size_t)m * 128 + 64 + lane] * scv[e1];
    const float rstd = __builtin_amdgcn_rsqf(ssq_get(ssq + m) * (1.0f / DM) + EPS);
    const float su0 = scu[e0] * rstd, su1 = scu[e1] * rstd;
    float a0 = 0.f, a1 = 0.f;
#define EIDX(e) (((e) < 64) ? __builtin_amdgcn_readlane(e0, (e)) : __builtin_amdgcn_readlane(e1, (e) - 64))
    {
        RowU r0, r1, r2, r3, r4, r5, r6, r7;
        ROWU_LOAD(r0, U, EIDX(0), lane); ROWU_LOAD(r1, U, EIDX(1), lane); ROWU_LOAD(r2, U, EIDX(2), lane); ROWU_LOAD(r3, U, EIDX(3), lane);
        ROWU_LOAD(r4, U, EIDX(4), lane); ROWU_LOAD(r5, U, EIDX(5), lane); ROWU_LOAD(r6, U, EIDX(6), lane); ROWU_LOAD(r7, U, EIDX(7), lane);
#define S1STEP(rr, k) p = wave_sum_dpp(ROWU_DOT(rr, hf)); if (more) ROWU_LOAD(rr, U, EIDX(e + 8 + (k)), lane); if (e < 64) { if (lane == e + (k)) a0 = p; } else { if (lane == e + (k) - 64) a1 = p; }
#pragma unroll 1
        for (int e = 0; e < 128; e += 8) {
            const bool more = e + 8 < 128; float p;
            S1STEP(r0, 0) S1STEP(r1, 1) S1STEP(r2, 2) S1STEP(r3, 3) S1STEP(r4, 4) S1STEP(r5, 5) S1STEP(r6, 6) S1STEP(r7, 7)
        }
#undef S1STEP
    }
    const float c0 = gelu_tanh(a0 * su0) * g0, c1 = gelu_tanh(a1 * su1) * g1;
#define CIDX(e) (((e) < 64) ? rl_f(c0, (e)) : rl_f(c1, (e) - 64))
    f32x2 o[32]; float zo = 0.f; asm volatile("" : "+v"(zo));
#pragma unroll
    for (int i = 0; i < 32; ++i) o[i] = (f32x2){zo, zo};
    {
        RowV r0, r1, r2, r3, r4, r5, r6, r7;
        ROWV_LOAD(r0, V, EIDX(0), lane); ROWV_LOAD(r1, V, EIDX(1), lane); ROWV_LOAD(r2, V, EIDX(2), lane); ROWV_LOAD(r3, V, EIDX(3), lane);
        ROWV_LOAD(r4, V, EIDX(4), lane); ROWV_LOAD(r5, V, EIDX(5), lane); ROWV_LOAD(r6, V, EIDX(6), lane); ROWV_LOAD(r7, V, EIDX(7), lane);
#define S2STEP(rr, k) ROWV_AXPY(rr, CIDX(e + (k)), o); if (more) ROWV_LOAD(rr, V, EIDX(e + 8 + (k)), lane);
#pragma unroll 1
        for (int e = 0; e < 128; e += 8) {
            const bool more = e + 8 < 128;
            S2STEP(r0, 0) S2STEP(r1, 1) S2STEP(r2, 2) S2STEP(r3, 3) S2STEP(r4, 4) S2STEP(r5, 5) S2STEP(r6, 6) S2STEP(r7, 7)
        }
#undef S2STEP
    }
#undef EIDX
#undef CIDX
    float s = 0.f;
    const GAS bf16_t* h1r = (const GAS bf16_t*)(h1b + (size_t)m * DM); asm volatile("" : "+s"(h1r));
#pragma unroll
    for (int j = 0; j < 16; ++j) { const u32x2 x = *((const GAS u32x2*)h1r + lane + 64 * j);
        o[2 * j] += (f32x2){bf_lo(x.x), bf_hi(x.x)}; o[2 * j + 1] += (f32x2){bf_lo(x.y), bf_hi(x.y)};
        s += (o[2 * j].x * o[2 * j].x + o[2 * j].y * o[2 * j].y) + (o[2 * j + 1].x * o[2 * j + 1].x + o[2 * j + 1].y * o[2 * j + 1].y); }
    const float rs = 1.0f / sqrtf(wave_sum(s) * (1.0f / DM) + EPS);
    float* op = F.out() + orow * DM;
#pragma unroll
    for (int j = 0; j < 16; ++j) { const f32x4 g = *((const f32x4*)gfin + lane + 64 * j);
        *((f32x4*)op + lane + 64 * j) = (f32x4){o[2 * j].x * rs * g[0], o[2 * j].y * rs * g[1], o[2 * j + 1].x * rs * g[2], o[2 * j + 1].y * rs * g[3]}; }
}
#ifdef MK_STEP_B
__device__ __forceinline__ void stepb_token(const Frame& F, int m, size_t orow) {
    const int lane = F.lane; const float* x = (const float*)(F.ws + WS_H1F) + (size_t)m * DM; const float* gfin = F.in(15);
    f32x4 v[16]; float s = 0.f;
#pragma unroll
    for (int j = 0; j < 16; ++j) { v[j] = *((const f32x4*)x + lane + 64 * j); s += (v[j][0] * v[j][0] + v[j][1] * v[j][1]) + (v[j][2] * v[j][2] + v[j][3] * v[j][3]); }
    const float rs = 1.0f / sqrtf(wave_sum(s) * (1.0f / DM) + EPS);
#pragma unroll
    for (int j = 0; j < 16; ++j) { const f32x4 g = *((const f32x4*)gfin + lane + 64 * j); *((f32x4*)(F.out() + orow * DM) + lane + 64 * j) = v[j] * rs * g; }
}
#endif
#ifdef MK_STEP_A
__device__ __forceinline__ void stepa_token(const Frame& F, size_t orow) {
    const int lane = F.lane; const float* x = F.in(0) + orow * DM; const float* gfin = F.in(15);
    f32x4 v[16]; float s = 0.f;
#pragma unroll
    for (int j = 0; j < 16; ++j) { v[j] = *((const f32x4*)x + lane + 64 * j); s += (v[j][0] * v[j][0] + v[j][1] * v[j][1]) + (v[j][2] * v[j][2] + v[j][3] * v[j][3]); }
    const float rs = 1.0f / sqrtf(wave_sum(s) * (1.0f / DM) + EPS);
#pragma unroll
    for (int j = 0; j < 16; ++j) { const f32x4 g = *((const f32x4*)gfin + lane + 64 * j); *((f32x4*)(F.out() + orow * DM) + lane + 64 * j) = v[j] * rs * g; }
}
#endif
__device__ __forceinline__ void p8_experts(const Frame& F) {
    const int gw = F.vcu * NWAVES + F.wave, NGW = F.G * NWAVES;
#if defined(MK_STEP_A)
    for (int it = gw; it < NB * SEQ; it += NGW) stepa_token(F, (size_t)it);
#elif defined(MK_STEP_B)
    for (int it = gw; it < NB * SEQ; it += NGW) stepb_token(F, it, (size_t)it);
#else
    const int slot = (F.wave < 4) ? F.wave : ((F.wave + 2) & 3);
#pragma unroll 1
    for (int u = F.vcu; u < NTOK / 64; u += F.G) {
#pragma unroll 1
        for (int j = 0; j < 8; ++j) {
            if (j == slot) { Frame F2 = F; asm volatile("" : "+v"(F2.lane)); route_task(F2, 2 * u + 1, F.wave); }
            if (j == 4) __syncthreads();
            const int it = 64 * u + 32 * (j >> 2) + 4 * F.wave + (j & 3); expert_token(F, it, (size_t)it);
        }
    }
#endif
}
struct Args { const float* in[16]; float* out; unsigned char* ws; int ph_lo, ph_hi; };
#define GEMM_RUN(EPI_T, g_, S_, E_) pg8::gemm_phase<EPI_T, pg8::StaticOrder, true, true>(F.lds, g_, S_, E_)
#define GEMM_RUN2(EPI_T, g_, S_, E_) pg8::gemm_phase<EPI_T, pg8::StaticOrder2, true, true>(F.lds, g_, S_, E_)

__global__ void __launch_bounds__(NWAVES * 64, 2) mk_fwd(Args args) {
    extern __shared__ __attribute__((aligned(16))) unsigned char lds_raw[];
    Frame F;
    F.lds = (LAS unsigned char*)lds_raw;
    F.ws = args.ws; F.ctl = (unsigned*)(args.ws + WS_CTL);
    F.tid = threadIdx.x; F.lane = F.tid & 63; F.wave = __builtin_amdgcn_readfirstlane(F.tid >> 6);
#define PHASE_BEGIN() do { int t_; asm volatile("v_mov_b32 %0, %1" : "=v"(t_) : "v"(threadIdx.x)); F.tid = t_; F.lane = t_ & 63; } while (0)
    F.G = gridDim.x; { const int bx = blockIdx.x; F.vcu = (F.G % 8 == 0) ? (bx % 8) * (F.G / 8) + bx / 8 : bx; }
    for (int u = F.tid; u < (LDS_BYTES - LDSCTL_OFF) / 4; u += NWAVES * 64) ((LAS unsigned*)(F.lds + LDSCTL_OFF))[u] = 0u;
    __syncthreads();
    XcdBarrier bar; bar.bar = F.ctl + CW_BAR; bar.x = 0; bar.st = nullptr;
    if (!MK_PER_PHASE) bar = xcd_barrier_post(F.ctl + CW_BAR, (volatile LAS unsigned*)(F.lds + LDSCTL_OFF));
    const int lo = args.ph_lo, hi = args.ph_hi;
#ifndef PH_MASK
#define PH_MASK 0x1FF
#endif
#define IN(k) (((PH_MASK >> (k)) & 1) && lo <= (k) && (k) < hi)
#ifdef MK_PROBE_T
#define STAMP(k) do { if (blockIdx.x == 0 && threadIdx.x == 0) ((volatile u64*)(F.ctl + 2048))[k] = __builtin_amdgcn_s_memrealtime(); } while (0)
#else
#define STAMP(k) do { } while (0)
#endif
#define SEAM(k) do { if (IN(k) && IN((k) + 1)) xcd_barrier(bar); STAMP((k) + 1); } while (0)
    unsigned char* ws = F.ws;

#ifndef MK_REP_MASK
#define MK_REP_MASK 0
#endif
#define NREP(k) (((MK_REP_MASK >> (k)) & 1) ? 2 : 1)
    STAMP(0);
    if (IN(0)) { for (int rep = 0; rep < NREP(0); ++rep) { PHASE_BEGIN(); p0_prologue(F); if (rep + 1 < NREP(0)) xcd_barrier(bar); } }
    SEAM(0);
    if (IN(1)) { for (int rep = 0; rep < NREP(1); ++rep) { PHASE_BEGIN();
        int p1_ns = 0, p1_sidx = 0; bool p1_short = false;
        {   const int G = F.G, NT8 = (MK / 256) * (12800 / 256), NTB = (MK / 256) * (1280 / 256);
            auto p1_units = [&](int b) { const int rb = G - 1 - b; return (b < NT8 ? (NT8 - b + G - 1) / G : 0) + 2 * (rb < NTB ? (NTB - rb + G - 1) / G : 0); };
            int umax = 0;
            for (int b = 0; b < G; ++b) umax = max(umax, p1_units(b));
            for (int b = 0; b < G; ++b) { const int sl = p1_units(b) < umax ? 1 : 0; p1_ns += sl; if (b < (int)blockIdx.x) p1_sidx += sl; }
            p1_short = p1_units((int)blockIdx.x) < umax; }
        p1_quant_weights(F);
        if (p1_ns == 0) p1_quant_weights_late(F);
        xcd_barrier(bar);
        {
            pg8::Gemm g{(const bf16_t*)(ws + WS_XN8), (const bf16_t*)(ws + WS_WG8), MK, 12800, DM / 2, DM / 2}; pg8::StaticOrder S; S.init(MK, 12800, F.G, (int)blockIdx.x);
            epi::EpiIn<true> E{(bf16_t*)(ws + WS_CQ), (bf16_t*)(ws + WS_CKV), (bf16_t*)(ws + WS_QB), (bf16_t*)(ws + WS_KB), (bf16_t*)(ws + WS_VB), (bf16_t*)(ws + WS_QIX), (bf16_t*)(ws + WS_KPE), (bf16_t*)(ws + WS_KIX),
                          (bf16_t*)(ws + WS_GA), (bf16_t*)(ws + WS_GB), (float*)(ws + WS_WIX), rep ? nullptr : (u64*)(F.ctl + CW_SSQ_CQ), rep ? nullptr : (u64*)(F.ctl + CW_SSQ_CKV),
                          (const float*)(ws + WS_ROPE_M), (const float*)(ws + WS_ROPE_D), (const float*)(ws + WS_ROPE_I), F.ctl + CW_VMAX, (const float*)(ws + WS_SX), (const float*)(ws + WS_SW)};
            GEMM_RUN(epi::EpiIn<true>, g, S, E); }
        __syncthreads();
        {
            pg8::Gemm g{(const bf16_t*)(ws + WS_XN), (const bf16_t*)(ws + WS_WIN), MK, 1280, DM, DM}; pg8::StaticOrder S; S.init(MK, 1280, F.G, (int)(gridDim.x - 1 - blockIdx.x));
            epi::EpiIn<false> E{(bf16_t*)(ws + WS_CQ), (bf16_t*)(ws + WS_CKV), (bf16_t*)(ws + WS_QB), (bf16_t*)(ws + WS_KB), (bf16_t*)(ws + WS_VB), (bf16_t*)(ws + WS_QIX), (bf16_t*)(ws + WS_KPE), (bf16_t*)(ws + WS_KIX),
                          (bf16_t*)(ws + WS_GA), (bf16_t*)(ws + WS_GB), (float*)(ws + WS_WIX), nullptr, nullptr,
                          (const float*)(ws + WS_ROPE_M), (const float*)(ws + WS_ROPE_D), (const float*)(ws + WS_ROPE_I), F.ctl + CW_VMAX, nullptr, nullptr};
            GEMM_RUN(epi::EpiIn<false>, g, S, E); }
        if (p1_short) { Frame FS = F; FS.vcu = p1_sidx; FS.G = p1_ns; p1_quant_weights_late(FS); }
        if (rep + 1 < NREP(1)) xcd_barrier(bar); }
    }
    SEAM(1);
    if (IN(2)) { for (int rep = 0; rep < NREP(2); ++rep) { PHASE_BEGIN();
        { pg8::Gemm g{(const bf16_t*)(ws + WS_CQ), (const bf16_t*)(ws + WS_WUQ8), NTOK, 3072, 512, 512}; pg8::StaticOrder S; S.init(NTOK, 3072, F.G, (int)blockIdx.x);
          epi::EpiUp E{ws + WS_QN, ws + WS_QR, 8, 2048, 1024, false, (const u64*)(F.ctl + CW_SSQ_CQ), 1.0f / 1024.0f, (const float*)(ws + WS_ROPE_M), (const float*)(ws + WS_SWUQ), F.ctl + CW_VMAX + 64};
          GEMM_RUN(epi::EpiUp, g, S, E); }
        __syncthreads();
        { pg8::Gemm g{(const bf16_t*)(ws + WS_CKV), (const bf16_t*)(ws + WS_WUKV8), MK, 4096, 256, 256}; pg8::StaticOrder S; S.init(MK, 4096, F.G, (int)blockIdx.x);
          epi::EpiUp E{ws + WS_KN, ws + WS_VA, 8, 2048, 2048, true, (const u64*)(F.ctl + CW_SSQ_CKV), 1.0f / 512.0f, nullptr, (const float*)(ws + WS_SWUKV), F.ctl + CW_VMAX + 64};
          GEMM_RUN(epi::EpiUp, g, S, E); }
        __syncthreads();
        p2_indexer(F, rep);
        if (rep + 1 < NREP(2)) xcd_barrier(bar); }
    }
    SEAM(2);
    if (IN(3)) { for (int rep = 0; rep < NREP(3); ++rep) { PHASE_BEGIN(); p3_attention(F, 2 + rep); if (rep + 1 < NREP(3)) xcd_barrier(bar); } }
    SEAM(3);
    if (IN(4)) { for (int rep = 0; rep < NREP(4); ++rep) { PHASE_BEGIN();
        pg8::Gemm g{(const bf16_t*)(ws + WS_OAB), (const bf16_t*)(ws + WS_WBR), NTOK, 4096, 2048, 1024}; pg8::StaticOrder2 S; S.init(NTOK, 4096, F.G, (int)blockIdx.x);
        epi::EpiBranch E{(const bf16_t*)(ws + WS_GA), (const bf16_t*)(ws + WS_GB), ws + WS_MRG, (const unsigned*)(F.ctl + CW_VMAX), (const float*)(ws + WS_SWBR), (const u64*)(F.ctl + CW_SSQ_OA), (const u64*)(F.ctl + CW_SSQ_OB), (const unsigned*)(F.ctl + CW_WNORM), (float*)(ws + WS_SMRG), rep ? nullptr : (u64*)(F.ctl + CW_SSQ_MRG)};
        GEMM_RUN2(epi::EpiBranch, g, S, E);
        if (rep + 1 < NREP(4)) xcd_barrier(bar); }
    }
    SEAM(4);
    if (IN(5)) { for (int rep = 0; rep < NREP(5); ++rep) { PHASE_BEGIN();
        pg8::Gemm g{(const bf16_t*)(ws + WS_MRG), (const bf16_t*)(ws + WS_WOUT), NTOK, 4096, 4096, 2048}; pg8::StaticOrder S; S.init(NTOK, 4096, F.G, (int)blockIdx.x);
        epi::EpiOut E{F.in(0), F.in(1), (float*)(ws + WS_H1F), (bf16_t*)(ws + WS_H1B), rep ? nullptr : (u64*)(F.ctl + CW_SSQ_H1), (const float*)(ws + WS_SMRG), (const float*)(ws + WS_SWOUT),
                       ws + WS_H18, (float*)(ws + WS_SH1), (const float*)(ws + WS_XMAX), (const u64*)(F.ctl + CW_SSQ_MRG), (const unsigned*)(F.ctl + CW_WNORM2)};
        GEMM_RUN(epi::EpiOut, g, S, E);
        if (rep + 1 < NREP(5)) xcd_barrier(bar); }
    }
    SEAM(5);
    if (IN(6)) { for (int rep = 0; rep < NREP(6); ++rep) { PHASE_BEGIN();
        pg8::Gemm g{(const bf16_t*)(ws + WS_H18), (const bf16_t*)(ws + WS_WQ8), NTOK, 2048, 2048, 2048}; pg8::StaticOrder S; S.init(NTOK, 2048, F.G, (int)blockIdx.x);
        epi::EpiPQ E{(bf16_t*)(ws + WS_PQ), (const u64*)(F.ctl + CW_SSQ_H1), (const float*)(ws + WS_SH1), (const float*)(ws + WS_SWQ)};
        GEMM_RUN(epi::EpiPQ, g, S, E);
        if (rep + 1 < NREP(6)) xcd_barrier(bar); }
    }
    SEAM(6);
    if (IN(7)) { for (int rep = 0; rep < NREP(7); ++rep) { PHASE_BEGIN();
        if (F.wave & 4) { p6_tables(F); p7_routing(F); } else { p7_routing(F); p6_tables(F); }
        if (rep + 1 < NREP(7)) xcd_barrier(bar); } }
    SEAM(7);
    if (IN(8)) { for (int rep = 0; rep < NREP(8); ++rep) { PHASE_BEGIN(); p8_experts(F); if (rep + 1 < NREP(8)) xcd_barrier(bar); } }
#ifdef MK_PROBE_T
    {   PHASE_BEGIN();
        xcd_barrier(bar); STAMP(9); xcd_barrier(bar);
        const volatile u64* ts = (const volatile u64*)(F.ctl + 2048);
        const float tot = (float)(ts[9] - ts[0]);
        const float f1 = (float)(ts[MK_PROBE_K1 + 1] - ts[MK_PROBE_K1]) / tot, f2 = (float)(ts[MK_PROBE_K2 + 1] - ts[MK_PROBE_K2]) / tot;
        float* o = F.out(); const size_t gt = (size_t)blockIdx.x * 512 + F.tid, NGT = (size_t)gridDim.x * 512;
        for (size_t i = gt; i < (size_t)NB * SEQ * DM / 4; i += NGT) { f32x4 v = ((f32x4*)o)[i]; v = v * (1.0f - f1); if (i == 0) v[0] = 1000.0f * f2; ((f32x4*)o)[i] = v; }
    }
#endif
#undef IN
#undef SEAM
}

extern "C" void kernel_launch(void* const* d_in, const int* in_sizes, int n_in, void* d_out, int out_size, void* d_ws, size_t ws_size, hipStream_t stream) {
    static int grid = 0;
    if (grid == 0) {
        if (n_in != 16 || in_sizes[0] != NB * SEQ * DM || out_size != NB * SEQ * DM || ws_size < WS_END) {
            fprintf(stderr, "kernel_launch: unexpected problem shape (n_in %d, in0 %d, out %d, ws %zu < %zu); nothing launched\n", n_in, n_in > 0 ? in_sizes[0] : -1, out_size, ws_size, (size_t)WS_END); grid = -1; return; }
        int dev = 0, cus = 0, per_cu = 0;
        if (hipGetDevice(&dev) != hipSuccess || hipDeviceGetAttribute(&cus, hipDeviceAttributeMultiprocessorCount, dev) != hipSuccess) { grid = -1; return; }
        if (hipFuncSetAttribute((const void*)mk_fwd, hipFuncAttributeMaxDynamicSharedMemorySize, LDS_BYTES) != hipSuccess) { fprintf(stderr, "kernel_launch: hipFuncSetAttribute failed\n"); grid = -1; return; }
        if (hipOccupancyMaxActiveBlocksPerMultiprocessor(&per_cu, (const void*)mk_fwd, NWAVES * 64, LDS_BYTES) != hipSuccess || per_cu < 1) {
            fprintf(stderr, "kernel_launch: occupancy query reports %d workgroups per CU\n", per_cu); }
        (void)hipGetLastError();
        grid = cus;
    }
    if (grid < 0) return;
    if (hipMemsetAsync((char*)d_ws + WS_CTL, 0, CTL_ZERO_BYTES, stream) != hipSuccess) return;
    Args a{};
    for (int i = 0; i < 16; ++i) a.in[i] = (const float*)d_in[i];
    a.out = (float*)d_out; a.ws = (unsigned char*)d_ws;
#if MK_PER_PHASE
    for (int p = 0; p <= MK_LAST_PHASE; ++p) { a.ph_lo = p; a.ph_hi = p + 1; hipLaunchKernelGGL(mk_fwd, dim3(grid), dim3(NWAVES * 64), LDS_BYTES, stream, a); }
#else
    a.ph_lo = 0; a.ph_hi = MK_LAST_PHASE + 1;
    hipLaunchKernelGGL(mk_fwd, dim3(grid), dim3(NWAVES * 64), LDS_BYTES, stream, a);
#endif
}
```
